# Optimizing an MI355X kernel written in HIP

```python
import jax
import jax.numpy as jnp
from jax import lax
import numpy as np

D_MODEL = 1024
BATCH = 2
SEQ = 8192
DEPTH = 2

GRID_W = 64
CTX_LEN = 256
HEAD_DIM = 64
N_GROUPS = 4
BRANCH_WIDTH = N_GROUPS * HEAD_DIM
N_BRANCH = 4
CHUNK = 128
CONV_WIDTH = 31
WIN_ROWS = 8
WIN_COLS = 16
QB_COLS = 16
KB_COLS = QB_COLS + WIN_COLS
ROPE_BASE = 10000.0
N_EXPERTS = 16
EXPERT_FF = 1024
EC_CAPACITY = 2
EPS = 1e-6
NEG_INF = -1e30
A_END = 2 * BRANCH_WIDTH
B_END = A_END + BRANCH_WIDTH
C_END = B_END + 2 * BRANCH_WIDTH
Q_END = C_END + BRANCH_WIDTH
K_END = Q_END + BRANCH_WIDTH
V_END = K_END + BRANCH_WIDTH
IN_COLS = V_END + N_BRANCH * D_MODEL
SPLITS = [A_END, B_END, C_END, Q_END, K_END, V_END]

kernel_name = 'hybrid_diffusion_trunk'


def rmsnorm(x, g):
    x32 = x.astype(jnp.float32)
    y = x32 * lax.rsqrt(jnp.mean(x32 * x32, axis=-1, keepdims=True) + EPS)
    return (y * g).astype(x.dtype)


def layernorm(x, g, b):
    x32 = x.astype(jnp.float32)
    mu = jnp.mean(x32, axis=-1, keepdims=True)
    var = jnp.mean(jnp.square(x32 - mu), axis=-1, keepdims=True)
    return ((x32 - mu) * lax.rsqrt(var + EPS) * g + b).astype(x.dtype)


def heads(z):
    return z.reshape(*z.shape[:-1], N_GROUPS, HEAD_DIM)


def chunk_gmlp(z, ln_g, ln_b, w_s, b_s):
    z = jax.nn.gelu(z)
    u, v = jnp.split(z, 2, axis=-1)
    v = layernorm(v, ln_g, ln_b)
    bsz, n, _ = v.shape
    v = v.reshape(bsz, n // CHUNK, CHUNK, N_GROUPS, HEAD_DIM)
    mixed = jnp.einsum('bcpgd,gqp->bcqgd', v, w_s) + b_s.T[None, None, :, :, None]
    return u * mixed.reshape(bsz, n, BRANCH_WIDTH)


def fourier_mix(z):
    bsz, n, _ = z.shape
    zg = z.astype(jnp.float32).reshape(bsz, n, N_GROUPS, HEAD_DIM)
    f = jnp.fft.fft2(zg, axes=(1, 3), norm='ortho').real
    return f.reshape(bsz, n, BRANCH_WIDTH).astype(z.dtype)


def conformer_conv(z, conv_w, conv_b, ln_g, ln_b):
    a, gt = jnp.split(z, 2, axis=-1)
    y = a * jax.nn.sigmoid(gt)
    y = lax.conv_general_dilated(
        y, conv_w[:, None, :], window_strides=(1,),
        padding=[(CONV_WIDTH // 2, CONV_WIDTH // 2)],
        dimension_numbers=('NWC', 'WIO', 'NWC'),
        feature_group_count=BRANCH_WIDTH) + conv_b
    return jax.nn.silu(layernorm(y, ln_g, ln_b))


def axial_rope(x, rows, cols):
    half = HEAD_DIM // 2
    quarter = half // 2
    inv = ROPE_BASE ** (-jnp.arange(quarter, dtype=jnp.float32) / quarter)

    def rot(xp, pos):
        ang = pos.astype(jnp.float32)[:, None] * inv[None, :]
        cos = jnp.cos(ang)[None, :, None, :]
        sin = jnp.sin(ang)[None, :, None, :]
        x1, x2 = jnp.split(xp.astype(jnp.float32), 2, axis=-1)
        return jnp.concatenate([x1 * cos - x2 * sin, x1 * sin + x2 * cos], axis=-1)

    out = jnp.concatenate([rot(x[..., :half], rows), rot(x[..., half:], cols)], axis=-1)
    return out.astype(x.dtype)


def neighbourhood_attention(q, k, v, kc, vc, rpb):
    bsz, n, nh, dh = q.shape
    n_rows = n // GRID_W
    wr = min(WIN_ROWS, n_rows)
    n_cb = GRID_W // QB_COLS
    n_win = wr * KB_COLS
    t = jnp.arange(n)
    qs = q * (dh ** -0.5)
    q_rot = axial_rope(qs, t // GRID_W, t % GRID_W)
    k_rot = axial_rope(k, t // GRID_W, t % GRID_W)
    r = jnp.arange(n_rows)
    key_rows = jnp.clip(r - wr // 2, 0, n_rows - wr)[:, None] + jnp.arange(wr)[None, :]
    jb = jnp.arange(n_cb)
    key_cols = (jnp.clip(jb * QB_COLS - WIN_COLS // 2, 0, GRID_W - KB_COLS)[:, None]
                + jnp.arange(KB_COLS)[None, :])
    q_cols = jb[:, None] * QB_COLS + jnp.arange(QB_COLS)[None, :]
    c_start = jnp.clip(q_cols - WIN_COLS // 2, 0, GRID_W - WIN_COLS)
    kcol = key_cols[:, None, :]
    col_ok = (kcol >= c_start[..., None]) & (kcol < c_start[..., None] + WIN_COLS)
    d_row = key_rows - r[:, None] + (WIN_ROWS - 1)
    d_col = jnp.clip(kcol - q_cols[..., None], 1 - WIN_COLS, WIN_COLS - 1) + (WIN_COLS - 1)
    bias = rpb[:, d_row[:, None, None, :, None], d_col[None, :, :, None, :]].astype(jnp.float32)
    bias = jnp.where(col_ok[None, None, :, :, None, :], bias, NEG_INF)
    bias = bias.reshape(nh, n_rows, n_cb, QB_COLS, n_win)
    key_idx = (key_rows[:, None, :, None] * GRID_W + key_cols[None, :, None, :]).reshape(n_rows, n_cb, n_win)
    k_win = k_rot[:, key_idx]
    v_win = v[:, key_idx]
    q_rot = q_rot.reshape(bsz, n_rows, n_cb, QB_COLS, nh, dh)
    q_pl = qs.reshape(bsz, n_rows, n_cb, QB_COLS, nh, dh)
    s_win = jnp.einsum('brjqhd,brjkhd->bhrjqk', q_rot, k_win).astype(jnp.float32) + bias
    s_ctx = jnp.einsum('brjqhd,bchd->bhrjqc', q_pl, kc).astype(jnp.float32)
    p = jax.nn.softmax(jnp.concatenate([s_win, s_ctx], axis=-1), axis=-1).astype(v.dtype)
    out = (jnp.einsum('bhrjqk,brjkhd->brjqhd', p[..., :n_win], v_win)
           + jnp.einsum('bhrjqc,bchd->brjqhd', p[..., n_win:], vc))
    return out.reshape(bsz, n, nh * dh)


def context_attention(q, k, v):
    bsz, n, nh, dh = q.shape
    s = jnp.einsum('bqhd,bkhd->bhqk', q * (dh ** -0.5), k).astype(jnp.float32)
    p = jax.nn.softmax(s, axis=-1).astype(v.dtype)
    return jnp.einsum('bhqk,bkhd->bqhd', p, v).reshape(bsz, n, nh * dh)


def merge_branches(a, b, cc, d, zg, w_a, w_b, w_c, w_d, w_o):
    ga, gb, gc, gd = jnp.split(jax.nn.sigmoid(zg), N_BRANCH, axis=-1)
    m = ga * (a @ w_a) + gb * (b @ w_b) + gc * (cc @ w_c) + gd * (d @ w_d)
    return m @ w_o


def expert_choice_ffn(h, router, w_gate, w_up, w_down):
    bsz, n, d = h.shape
    cap = EC_CAPACITY * n // N_EXPERTS
    aff = jax.nn.softmax((h @ router).astype(jnp.float32), axis=-1)
    gate, idx = lax.top_k(jnp.swapaxes(aff, 1, 2), cap)
    xe = jax.vmap(lambda hb, ib: hb[ib])(h, idx)
    a = jnp.einsum('becd,edf->becf', xe, w_gate)
    u = jnp.einsum('becd,edf->becf', xe, w_up)
    y = jnp.einsum('becf,efd->becd', jax.nn.silu(a) * u, w_down) * gate[..., None].astype(h.dtype)
    return jax.vmap(lambda ib, yb: jnp.zeros((n, d), h.dtype).at[ib.reshape(-1)].add(yb.reshape(-1, d)))(idx, y)


def setup_inputs(seed: int = 0) -> dict:
    key = jax.random.key(seed)
    ks = jax.random.split(key, 28)
    L, D, W = DEPTH, D_MODEL, BRANCH_WIDTH

    def nrm(k, shape, s):
        return jax.random.normal(k, shape, jnp.float32) * s

    return {
        'x': nrm(ks[0], (BATCH, SEQ, D), 1.0),
        'c': nrm(ks[1], (BATCH, D), 1.0),
        'ctx': nrm(ks[2], (BATCH, CTX_LEN, D), 1.0),
        'c_ctx': nrm(ks[3], (D,), 1.0),
        'w_mod': nrm(ks[4], (L, D, 6 * D), 0.5 * D ** -0.5),
        'b_mod': nrm(ks[5], (L, 6 * D), 0.02),
        'norm1_g': 1.0 + nrm(ks[6], (L, D), 0.02),
        'norm2_g': 1.0 + nrm(ks[7], (L, D), 0.02),
        'w_in': nrm(ks[8], (L, D, IN_COLS), D ** -0.5),
        'sgu_ln_g': 1.0 + nrm(ks[9], (L, W), 0.02),
        'sgu_ln_b': nrm(ks[10], (L, W), 0.02),
        'w_spatial': nrm(ks[11], (L, N_GROUPS, CHUNK, CHUNK), CHUNK ** -0.5),
        'b_spatial': 1.0 + nrm(ks[12], (L, N_GROUPS, CHUNK), 0.02),
        'w_a_out': nrm(ks[13], (L, W, D), W ** -0.5),
        'w_b_out': nrm(ks[14], (L, W, D), W ** -0.5),
        'conv_w': nrm(ks[15], (L, CONV_WIDTH, W), CONV_WIDTH ** -0.5),
        'conv_b': nrm(ks[16], (L, W), 0.02),
        'conv_ln_g': 1.0 + nrm(ks[17], (L, W), 0.02),
        'conv_ln_b': nrm(ks[18], (L, W), 0.02),
        'w_c_out': nrm(ks[19], (L, W, D), W ** -0.5),
        'rpb': nrm(ks[20], (L, N_GROUPS, 2 * WIN_ROWS - 1, 2 * WIN_COLS - 1), 0.1),
        'w_d_out': nrm(ks[21], (L, W, D), W ** -0.5),
        'w_out': nrm(ks[22], (L, D, D), D ** -0.5),
        'w_router': nrm(ks[23], (L, D, N_EXPERTS), D ** -0.5),
        'w_gate_e': nrm(ks[24], (L, N_EXPERTS, D, EXPERT_FF), D ** -0.5),
        'w_up_e': nrm(ks[25], (L, N_EXPERTS, D, EXPERT_FF), D ** -0.5),
        'w_down_e': nrm(ks[26], (L, N_EXPERTS, EXPERT_FF, D), EXPERT_FF ** -0.5),
        'final_norm_g': 1.0 + nrm(ks[27], (D,), 0.02),
    }


def reference(x, c, ctx, c_ctx, w_mod, b_mod, norm1_g, norm2_g, w_in, sgu_ln_g, sgu_ln_b,
              w_spatial, b_spatial, w_a_out, w_b_out, conv_w, conv_b, conv_ln_g, conv_ln_b,
              w_c_out, rpb, w_d_out, w_out, w_router, w_gate_e, w_up_e, w_down_e, final_norm_g):
    xc = ctx
    silu_c = jax.nn.silu(c)
    silu_cc = jax.nn.silu(c_ctx)
    for l in range(DEPTH):
        last = l == DEPTH - 1
        mod = (silu_c @ w_mod[l] + b_mod[l])[:, None, :]
        sh1, sc1, gt1, sh2, sc2, gt2 = jnp.split(mod, 6, axis=-1)
        cmod = silu_cc @ w_mod[l] + b_mod[l]
        csh1, csc1, cgt1, csh2, csc2, cgt2 = jnp.split(cmod, 6, axis=-1)

        h = rmsnorm(x, norm1_g[l]) * (1 + sc1) + sh1
        hc = rmsnorm(xc, norm1_g[l]) * (1 + csc1) + csh1
        za, zb, zcv, zq, zk, zv, zg = jnp.split(h @ w_in[l], SPLITS, axis=-1)
        if last:
            zkc, zvc = jnp.split(hc @ w_in[l][:, Q_END:V_END], 2, axis=-1)
        else:
            cza, czb, czcv, czq, zkc, zvc, czg = jnp.split(hc @ w_in[l], SPLITS, axis=-1)
        kc, vc = heads(zkc), heads(zvc)
        d_lat = neighbourhood_attention(heads(zq), heads(zk), heads(zv), kc, vc, rpb[l])
        mix = merge_branches(
            chunk_gmlp(za, sgu_ln_g[l], sgu_ln_b[l], w_spatial[l], b_spatial[l]),
            fourier_mix(zb),
            conformer_conv(zcv, conv_w[l], conv_b[l], conv_ln_g[l], conv_ln_b[l]),
            d_lat, zg, w_a_out[l], w_b_out[l], w_c_out[l], w_d_out[l], w_out[l])
        x = x + gt1 * mix
        if not last:
            cmix = merge_branches(
                chunk_gmlp(cza, sgu_ln_g[l], sgu_ln_b[l], w_spatial[l], b_spatial[l]),
                fourier_mix(czb),
                conformer_conv(czcv, conv_w[l], conv_b[l], conv_ln_g[l], conv_ln_b[l]),
                context_attention(heads(czq), kc, vc),
                czg, w_a_out[l], w_b_out[l], w_c_out[l], w_d_out[l], w_out[l])
            xc = xc + cgt1 * cmix

        h2 = rmsnorm(x, norm2_g[l]) * (1 + sc2) + sh2
        x = x + gt2 * expert_choice_ffn(h2, w_router[l], w_gate_e[l], w_up_e[l], w_down_e[l])
        if not last:
            hc2 = rmsnorm(xc, norm2_g[l]) * (1 + csc2) + csh2
            xc = xc + cgt2 * expert_choice_ffn(hc2, w_router[l], w_gate_e[l], w_up_e[l], w_down_e[l])
    return rmsnorm(x, final_norm_g)
```

```cpp
#include <hip/hip_runtime.h>
#include <cstdio>
#include <cstdint>
#define N_LAUNCHES 1
namespace pg8 {
#define PG8_LAS __attribute__((address_space(3)))
typedef unsigned short bf16_t;
typedef short bf16x8 __attribute__((ext_vector_type(8)));
typedef float f32x4 __attribute__((ext_vector_type(4)));
typedef unsigned u32x4 __attribute__((ext_vector_type(4)));
constexpr int BM = 256, BK = 64, HALF = 128, HTB = HALF * BK * 2  , STAGE_BYTES = 8 * HTB, NXCD = 8, WGM = 8;

__host__ __device__ __forceinline__ int lds_byte(int r, int c) { const int st = (r >> 4) * 2 + (c >> 5), rr = r & 15, cc = c & 31, ob = rr * 64 + cc * 2; return st * 1024 + (ob ^ (((ob >> 9) & 1) << 5)); }
__host__ __device__ __forceinline__ void stage_rc(int b, int& R, int& C) { const int st = b / 1024, sb = b % 1024, swz = sb ^ (((sb >> 9) & 1) << 5); R = (st >> 1) * 16 + swz / 64; C = (st & 1) * 32 + (swz % 64) / 2; }
__host__ __device__ __forceinline__ int perm32(int rho) { const int n = rho >> 4, i = rho & 15; return 8 * (i >> 2) + 4 * n + (i & 3); }

struct Unit { int pm, pn; };
struct Gemm { const bf16_t* A; const bf16_t* Bt; int M, N, K; };

struct StaticOrder {
    int nM, nN, nwg, G, c;
    __host__ __device__ void init(int M, int N, int G_, int c_) { nM = M / BM; nN = N / BM; nwg = nM * nN; G = G_; c = c_; }
    __host__ __device__ bool next(int i, Unit& u) const {
        const long L = (long)i * G + c; if (L >= nwg) return false;
        int wgid = (int)L; { const int q = nwg / NXCD, r = nwg % NXCD, xcd = wgid % NXCD, off = wgid / NXCD; wgid = (xcd < r ? xcd * (q + 1) : r * (q + 1) + (xcd - r) * q) + off; }
        const int nig = WGM * nN, gid = wgid / nig, fm = gid * WGM, gsz = (nM - fm) < WGM ? (nM - fm) : WGM;
        u.pm = fm + ((wgid % nig) % gsz); u.pn = (wgid % nig) / gsz; return true;
    }
    __device__ __forceinline__ void a_ready(const Unit&) const {}
    __device__ __forceinline__ void done(const Unit&) const {}
};
__device__ __forceinline__ unsigned cvt_pk_bf16(float lo, float hi) { unsigned r; asm volatile("v_cvt_pk_bf16_f32 %0, %1, %2" : "=v"(r) : "v"(lo), "v"(hi)); return r; }
typedef float f32x2 __attribute__((ext_vector_type(2)));
template <class Epi, class Sched, bool ALIGN_EPI = false, bool SP2 = false>
__device__ __forceinline__ void gemm_phase(PG8_LAS unsigned char* lds, const Gemm g, const Sched& S, const Epi& E) {
    int tid_l = threadIdx.x; asm volatile("" : "+v"(tid_l));
    const int tid = tid_l, wid = __builtin_amdgcn_readfirstlane(tid >> 6), lane = tid & 63, wr = wid >> 2, wc = wid & 3, fr = lane & 15, fq = lane >> 4;
    const int K = g.K, nt = K / BK;
    unsigned voffA[2], voffB[2];
#pragma unroll
    for (int i = 0; i < 2; ++i) { int R, C; stage_rc(tid * 16 + i * 8192, R, C); const int Rb = Epi::PERM ? ((R & ~31) + perm32(R & 31)) : R;
        voffA[i] = (unsigned)(R * K + C) * 2u; voffB[i] = (unsigned)(Rb * K + C) * 2u; }
    const size_t kstep = (size_t)(BK * 2);
    const size_t hstep = (size_t)HALF * K * 2;
    const size_t tstep = 2 * hstep;
    const unsigned ldsw = (unsigned)wid * 1024u;
    const int aoff = lds_byte(wr * 64 + fr, fq * 8), boff = lds_byte(wc * 32 + fr, fq * 8);
#define PG8_SA(b, h) (((b) * 2 + (h)) * HTB)
#define PG8_SB(b, h) ((4 + (b) * 2 + (h)) * HTB)
#define PG8_STAGE(bufoff, gbase, voff) do { _Pragma("unroll") for (int _i = 0; _i < 2; ++_i) \
        __builtin_amdgcn_global_load_lds((const unsigned*)((const char*)(gbase) + (voff)[_i]), (PG8_LAS unsigned*)(lds + (bufoff) + ldsw + _i * 8192), 16, 0, 0); } while (0)
#define PG8_LDA(dst, b, h) do { _Pragma("unroll") for (int m = 0; m < 4; ++m) _Pragma("unroll") for (int k = 0; k < 2; ++k) dst[m][k] = *(const PG8_LAS bf16x8*)(lds + PG8_SA(b, h) + aoff + m * 2048 + k * 1024); } while (0)
#define PG8_LDB(dst, b, h) do { _Pragma("unroll") for (int n = 0; n < 2; ++n) _Pragma("unroll") for (int k = 0; k < 2; ++k) dst[n][k] = *(const PG8_LAS bf16x8*)(lds + PG8_SB(b, h) + boff + n * 2048 + k * 1024); } while (0)
#define PG8_MMA(ai, bj, At, Bt) do { __builtin_amdgcn_s_setprio(1); _Pragma("unroll") for (int m = 0; m < 4; ++m) _Pragma("unroll") for (int n = 0; n < 2; ++n) _Pragma("unroll") for (int k = 0; k < 2; ++k) \
        acc[ai][bj][m][n] = __builtin_amdgcn_mfma_f32_16x16x32_bf16(Bt[n][k], At[m][k], acc[ai][bj][m][n], 0, 0, 0); __builtin_amdgcn_s_setprio(0); } while (0)
#define PG8_WAIT_V(n) asm volatile("s_waitcnt vmcnt(" #n ")" ::: "memory")
#define PG8_WAIT_L(n) asm volatile("s_waitcnt lgkmcnt(" #n ")" ::: "memory")
#define PG8_BAR __builtin_amdgcn_s_barrier()
#define PG8_SCHED __builtin_amdgcn_sched_barrier(0)
    Unit cur, nxt; int ui = 0;
    if (!S.next(0, cur)) return;
    f32x4 acc[2][2][4][2];
#pragma unroll
    for (int a = 0; a < 2; ++a)
#pragma unroll
        for (int b = 0; b < 2; ++b)
#pragma unroll
            for (int m = 0; m < 4; ++m)
#pragma unroll
                for (int n = 0; n < 2; ++n) acc[a][b][m][n] = (f32x4){0.f, 0.f, 0.f, 0.f};
    bf16x8 At[4][2], B0[2][2], B1[2][2];
    const char* cA = (const char*)g.A + (size_t)cur.pm * tstep; const char* cB = (const char*)g.Bt + (size_t)cur.pn * tstep;
    S.a_ready(cur);
    if constexpr (SP2) {
        PG8_STAGE(PG8_SB(0, 0), cB, voffB); PG8_STAGE(PG8_SB(0, 1), cB + hstep, voffB); PG8_STAGE(PG8_SA(0, 0), cA, voffA); PG8_STAGE(PG8_SA(0, 1), cA + hstep, voffA);
        if (wr == 1) PG8_BAR;
        PG8_WAIT_V(2); PG8_BAR;
        PG8_STAGE(PG8_SB(1, 0), cB + kstep, voffB); PG8_STAGE(PG8_SA(1, 0), cA + kstep, voffA); PG8_STAGE(PG8_SB(1, 1), cB + hstep + kstep, voffB);
        PG8_WAIT_V(6); PG8_BAR;
    } else {
        PG8_STAGE(PG8_SB(0, 0), cB, voffB); PG8_STAGE(PG8_SA(0, 0), cA, voffA); PG8_STAGE(PG8_SB(0, 1), cB + hstep, voffB); PG8_STAGE(PG8_SA(0, 1), cA + hstep, voffA);
        if (wr == 1) PG8_BAR;
        PG8_WAIT_V(4); PG8_BAR;
        PG8_STAGE(PG8_SB(1, 0), cB + kstep, voffB); PG8_STAGE(PG8_SA(1, 0), cA + kstep, voffA); PG8_STAGE(PG8_SB(1, 1), cB + hstep + kstep, voffB);
        PG8_WAIT_V(6); PG8_BAR;
    }
    for (;;) {
        const bool has_next = S.next(ui + 1, nxt);
        const char* nA = has_next ? (const char*)g.A + (size_t)nxt.pm * tstep : cA; const char* nB = has_next ? (const char*)g.Bt + (size_t)nxt.pn * tstep : cB;
#pragma unroll 1
        for (int t = 0; t < nt; t += 2) {
            const bool last = (t == nt - 2);
            const char* a1 = cA + (size_t)(t + 1) * kstep;
            const char* a2 = last ? nA : cA + (size_t)(t + 2) * kstep; const char* b2 = last ? nB : cB + (size_t)(t + 2) * kstep;
            const char* a3 = a2 + kstep; const char* b3 = b2 + kstep;
            if (last && has_next) S.a_ready(nxt);
            if constexpr (SP2) {
            PG8_LDB(B0, 0, 0); PG8_LDB(B1, 0, 1); PG8_SCHED; PG8_LDA(At, 0, 0); PG8_STAGE(PG8_SA(1, 1), a1 + hstep, voffA);
            PG8_WAIT_V(8); PG8_WAIT_L(0); PG8_BAR; PG8_MMA(0, 0, At, B0); PG8_MMA(0, 1, At, B1); PG8_BAR; PG8_SCHED;
            PG8_LDA(At, 0, 1); PG8_STAGE(PG8_SB(0, 0), b2, voffB); PG8_STAGE(PG8_SB(0, 1), b2 + hstep, voffB); PG8_STAGE(PG8_SA(0, 0), a2, voffA);
            PG8_WAIT_V(8); PG8_WAIT_L(0); PG8_BAR; PG8_MMA(1, 0, At, B0); PG8_MMA(1, 1, At, B1); PG8_BAR; PG8_SCHED;
            PG8_LDB(B0, 1, 0); PG8_LDB(B1, 1, 1); PG8_SCHED; PG8_LDA(At, 1, 0); PG8_STAGE(PG8_SA(0, 1), a2 + hstep, voffA);
            PG8_WAIT_V(8); PG8_WAIT_L(0); PG8_BAR; PG8_MMA(0, 0, At, B0); PG8_MMA(0, 1, At, B1); PG8_BAR; PG8_SCHED;
            PG8_LDA(At, 1, 1); PG8_STAGE(PG8_SB(1, 0), b3, voffB); PG8_STAGE(PG8_SB(1, 1), b3 + hstep, voffB); PG8_STAGE(PG8_SA(1, 0), a3, voffA);
            PG8_WAIT_V(8); PG8_WAIT_L(0); PG8_BAR; PG8_MMA(1, 0, At, B0); PG8_MMA(1, 1, At, B1); PG8_BAR; PG8_SCHED;
            } else {
            PG8_LDB(B0, 0, 0); PG8_SCHED; PG8_LDA(At, 0, 0); PG8_STAGE(PG8_SA(1, 1), a1 + hstep, voffA);
            PG8_WAIT_L(8); PG8_BAR; PG8_WAIT_L(0); PG8_MMA(0, 0, At, B0); PG8_BAR; PG8_SCHED;
            PG8_LDB(B1, 0, 1); PG8_STAGE(PG8_SB(0, 0), b2, voffB);
            PG8_BAR; PG8_WAIT_L(0); PG8_MMA(0, 1, At, B1); PG8_BAR;
            PG8_LDA(At, 0, 1); PG8_STAGE(PG8_SA(0, 0), a2, voffA);
            PG8_BAR; PG8_WAIT_L(0); PG8_MMA(1, 0, At, B0); PG8_BAR; PG8_SCHED;
            PG8_STAGE(PG8_SB(0, 1), b2 + hstep, voffB);
            PG8_WAIT_V(6); PG8_BAR; PG8_MMA(1, 1, At, B1); PG8_BAR;
            PG8_LDB(B0, 1, 0); PG8_SCHED; PG8_LDA(At, 1, 0); PG8_STAGE(PG8_SA(0, 1), a2 + hstep, voffA);
            PG8_WAIT_L(8); PG8_BAR; PG8_WAIT_L(0); PG8_MMA(0, 0, At, B0); PG8_BAR; PG8_SCHED;
            PG8_LDB(B1, 1, 1); PG8_STAGE(PG8_SB(1, 0), b3, voffB);
            PG8_BAR; PG8_WAIT_L(0); PG8_MMA(0, 1, At, B1); PG8_BAR;
            PG8_LDA(At, 1, 1); PG8_STAGE(PG8_SA(1, 0), a3, voffA);
            PG8_BAR; PG8_WAIT_L(0); PG8_MMA(1, 0, At, B0); PG8_BAR; PG8_SCHED;
            PG8_STAGE(PG8_SB(1, 1), b3 + hstep, voffB);
            PG8_WAIT_V(6); PG8_BAR; PG8_MMA(1, 1, At, B1); PG8_BAR;
            }
        }
        if constexpr (ALIGN_EPI) { if (wr == 0) PG8_BAR; }
        if constexpr (!Epi::AFTER_DRAIN) { int t2_ = threadIdx.x; asm volatile("" : "+v"(t2_)); E(acc, cur, wr, wc, t2_ & 15, (t2_ >> 4) & 3); S.done(cur); }
        if (!has_next) break;
#pragma unroll
        for (int a = 0; a < 2; ++a)
#pragma unroll
            for (int b = 0; b < 2; ++b)
#pragma unroll
                for (int m = 0; m < 4; ++m)
#pragma unroll
                    for (int n = 0; n < 2; ++n) acc[a][b][m][n] = (f32x4){0.f, 0.f, 0.f, 0.f};
        cur = nxt; cA = nA; cB = nB; ++ui;
        if constexpr (ALIGN_EPI) { if (wr == 1) PG8_BAR; }
    }
    PG8_WAIT_V(0);
    if constexpr (!ALIGN_EPI) { if (wr == 0) PG8_BAR; }
    PG8_BAR;
    if constexpr (Epi::AFTER_DRAIN) { E.fused(acc, cur, wr, wc, fr, fq, lds, wid, lane); S.done(cur); }
#undef PG8_SA
#undef PG8_SB
#undef PG8_STAGE
#undef PG8_LDA
#undef PG8_LDB
#undef PG8_MMA
#undef PG8_WAIT_V
#undef PG8_WAIT_L
#undef PG8_BAR
#undef PG8_SCHED
}
}
#define GAS __attribute__((address_space(1)))
#define LAS __attribute__((address_space(3)))
typedef unsigned short bf16;
typedef unsigned v4u __attribute__((ext_vector_type(4)));
typedef float f32x4 __attribute__((ext_vector_type(4)));
typedef short bf16x8 __attribute__((ext_vector_type(8)));
typedef GAS unsigned gu32;
typedef GAS unsigned long long gu64;
#define RLX_AGENT __ATOMIC_RELAXED, __HIP_MEMORY_SCOPE_AGENT
#define LDS_WAIT() asm volatile("s_waitcnt lgkmcnt(0)" ::: "memory")
#define VM_WAIT() asm volatile("s_waitcnt vmcnt(0)" ::: "memory")
__device__ __forceinline__ unsigned long long rt() { return __builtin_amdgcn_s_memrealtime(); }
__device__ __forceinline__ unsigned f2bf(float f) { unsigned u = __builtin_bit_cast(unsigned, f); return (u + 0x7fffu + ((u >> 16) & 1u)) >> 16; }
__device__ __forceinline__ unsigned pk2(float lo, float hi) { return f2bf(lo) | (f2bf(hi) << 16); }

#define XB_TMO      128
#define XB_XCNT(j)  (256  + 64 * (j))
#define XB_XSUB(j)  (1280 + 64 * (j))
#define XB_XGEN(j)  (2304 + 64 * (j))
#define XB_TOP      3328
#define XB_TOPGEN   3392
#define XCD_BAR_WORDS 3456
#define XB_SPIN_CAP (1u << 18)

__device__ __forceinline__ unsigned xb_ld(unsigned* p)              { return __hip_atomic_load(p, __ATOMIC_RELAXED, __HIP_MEMORY_SCOPE_AGENT); }
__device__ __forceinline__ unsigned xb_add(unsigned* p, unsigned v) { return __hip_atomic_fetch_add(p, v, __ATOMIC_RELAXED, __HIP_MEMORY_SCOPE_AGENT); }
__device__ __forceinline__ unsigned xb_xcc_id() { return (unsigned)__builtin_amdgcn_s_getreg((3 << 11) | 20) & 0xFu; }
#define XB_SPIN(cond, bar) do { unsigned _sp = 0; while (cond) { __builtin_amdgcn_s_sleep(1); \
    if ((++_sp & 255u) == 0u) { if (xb_ld(&(bar)[XB_TMO])) break; if (_sp > XB_SPIN_CAP) { atomicAdd(&(bar)[XB_TMO], 1u); break; } } } } while (0)

struct XcdBarrier {
    unsigned* bar; unsigned x;
    volatile LAS unsigned* st;
};

__device__ __forceinline__ XcdBarrier xcd_barrier_post(unsigned* bar, volatile LAS unsigned* st) {
    XcdBarrier b; b.bar = bar; b.x = xb_xcc_id(); b.st = st;
    if (threadIdx.x == 0) (void)xb_add(&bar[XB_XCNT(b.x)], 1u);
    return b;
}
__device__ __forceinline__ void xcd_barrier_complete(unsigned* bar, unsigned x, unsigned& nloc, unsigned& nx) {
    const unsigned G = gridDim.x * gridDim.y * gridDim.z;
    unsigned sum, cnt, mine, sp = 0u;
    for (;;) {
        sum = 0u; cnt = 0u; mine = 0u;
#pragma unroll
        for (unsigned j = 0; j < 16; ++j) { const unsigned c = xb_ld(&bar[XB_XCNT(j)]); sum += c; cnt += (c > 0u) ? 1u : 0u; mine = (j == x) ? c : mine; }
        if (sum == G) break;
        __builtin_amdgcn_s_sleep(1);
        if ((++sp & 255u) == 0u) { if (xb_ld(&bar[XB_TMO])) break; if (sp > XB_SPIN_CAP) { atomicAdd(&bar[XB_TMO], 1u); break; } }
    }
    nloc = mine > 0u ? mine : 1u; nx = cnt > 0u ? cnt : 1u;
}

__device__ __forceinline__ void xcd_barrier(const XcdBarrier& b) {
    asm volatile("s_waitcnt vmcnt(0)" ::: "memory");
    __syncthreads();
    if (threadIdx.x == 0) {
        unsigned* bar = b.bar;
        __builtin_amdgcn_s_waitcnt(0);
        unsigned nloc = b.st[0], nx = b.st[1];
        if (nloc == 0u) { xcd_barrier_complete(bar, b.x, nloc, nx); b.st[0] = nloc; b.st[1] = nx; }
        const unsigned old = xb_add(&bar[XB_XSUB(b.x)], 1u);
        const unsigned gen = old / nloc;
        if (old + 1u == (gen + 1u) * nloc) {
            __builtin_amdgcn_fence(__ATOMIC_RELEASE, "agent");
            asm volatile("s_waitcnt vmcnt(0)" ::: "memory");
            const unsigned og = xb_add(&bar[XB_TOP], 1u);
            const unsigned tg = og / nx;
            if (og + 1u == (tg + 1u) * nx) xb_add(&bar[XB_TOPGEN], 1u);
            else XB_SPIN(xb_ld(&bar[XB_TOPGEN]) == tg, bar);
            __builtin_amdgcn_fence(__ATOMIC_ACQUIRE, "agent");
            xb_add(&bar[XB_XGEN(b.x)], 1u);
            asm volatile("s_waitcnt vmcnt(0)" ::: "memory");
        } else {
            XB_SPIN(xb_ld(&bar[XB_XGEN(b.x)]) == gen, bar);
            __builtin_amdgcn_fence(__ATOMIC_ACQUIRE, "agent");
            asm volatile("s_waitcnt vmcnt(0)" ::: "memory");
        }
    }
    __syncthreads();
}
constexpr int DM = 1024, SEQ = 8192, NBATCH = 2, CTXL = 256;
constexpr int ML = NBATCH * SEQ, MC = NBATCH * CTXL, MT = ML + MC;
constexpr int NIN = 6400;
constexpr int NE = 16, ESTR = 2304, CAPL = 1024, CAPC = 32;
constexpr int NPH = 24;
constexpr size_t MiB = 1u << 20;
constexpr size_t WS_CTL = 0, CTL_ZERO_BYTES = 1 * MiB;
constexpr size_t WS_MOD = 1 * MiB;
constexpr size_t WS_ROPEC = 1 * MiB + 256 * 1024, WS_ROPES = WS_ROPEC + 8192;
constexpr size_t WS_TW = 1 * MiB + 512 * 1024;
constexpr size_t WS_CS256 = 1 * MiB + 640 * 1024;
constexpr size_t WS_T1T = 2 * MiB;
constexpr size_t WS_T2T = 2 * MiB + 64 * 1024;
constexpr size_t WS_WSP = 2 * MiB + 256 * 1024;
constexpr size_t WS_AFF = 3 * MiB;
constexpr size_t WS_SEL = 5 * MiB;
constexpr size_t WS_IDX = 7 * MiB, WS_GATE = 7 * MiB + 256 * 1024;
constexpr size_t WS_WIN = 16 * MiB, WS_WBR = 29 * MiB, WS_WO = 31 * MiB, WS_WGU = 33 * MiB, WS_WDN = 97 * MiB;
constexpr size_t WS_X = 130 * MiB;
constexpr size_t WS_H = 196 * MiB;
constexpr size_t WS_BR = 229 * MiB;
constexpr size_t WS_MB = 262 * MiB;
constexpr size_t WS_FA = 295 * MiB;
constexpr size_t WS_Z = 311 * MiB;
constexpr size_t ZROW = (size_t)MT * 2;
constexpr size_t WS_AUV = WS_Z, WS_YF = WS_AUV + 512 * ZROW, WS_CY = WS_YF + 512 * ZROW, WS_QPL = WS_CY + 256 * ZROW, WS_QROT = WS_QPL + 256 * ZROW,
                 WS_KR = WS_QROT + 256 * ZROW, WS_VV = WS_KR + 256 * ZROW, WS_G = WS_VV + 256 * ZROW, WS_ZEND = WS_G + 4096 * ZROW;
constexpr size_t WS_P32 = WS_Z;
constexpr size_t WS_XE = WS_Z, WS_ACT = WS_Z + 72 * MiB;
constexpr size_t WS_END = 518 * MiB;
static_assert(WS_G == WS_P32 + (size_t)MT * 1024 * 4 + 8 * 256 * ZROW / 8 - 256 * ZROW || true, "");
static_assert(WS_ZEND <= WS_END && WS_ACT + 72 * MiB <= WS_ZEND && WS_P32 + (size_t)MT * 4096 <= WS_VV, "ws map");
constexpr int CW_BAR = 4096;
constexpr int LDS_BYTES = 155648, MISC_OFF = 154624;

struct Args { const float* in[28]; float* out; unsigned char* ws; int ph_lo, ph_hi; };

__device__ __forceinline__ float bflo(unsigned w) { return __uint_as_float(w << 16); }
__device__ __forceinline__ float bfhi(unsigned w) { return __uint_as_float(w & 0xffff0000u); }
__device__ __forceinline__ float sigm(float x) { return __builtin_amdgcn_rcpf(1.f + __expf(-x)); }
__device__ __forceinline__ float wave_sum(float v) {
#pragma unroll
    for (int o = 1; o < 64; o <<= 1) v += __shfl_xor(v, o);
    return v;
}
__device__ __forceinline__ void st4bf(bf16* p, f32x4 v) { uint2 w; w.x = pk2(v[0], v[1]); w.y = pk2(v[2], v[3]); *(uint2*)p = w; }

using pg8::Unit;
struct EpiIn {
    static constexpr bool PERM = false, AFTER_DRAIN = false;
    bf16 *AUV, *YF, *CY, *QPL, *QROT, *KR, *VV, *G; const float* ropeC; const float* ropeS;
    __device__ __forceinline__ void operator()(const f32x4 (&acc)[2][2][4][2], const Unit& u, int wr, int wc, int fr, int fq) const {
        const int pn = u.pn, row0 = u.pm * 256 + wr * 64 + fr, cl0 = wc * 32 + 4 * fq;
        if (pn < 2) {
#pragma unroll
            for (int ai = 0; ai < 2; ++ai)
#pragma unroll
                for (int m = 0; m < 4; ++m) { const size_t row = row0 + ai * 128 + m * 16;
#pragma unroll
                    for (int bj = 0; bj < 2; ++bj)
#pragma unroll
                        for (int n = 0; n < 2; ++n) { f32x4 v = acc[ai][bj][m][n];
#pragma unroll
                            for (int j = 0; j < 4; ++j) { const float x = v[j]; v[j] = x * sigm(1.5957691216f * (x + 0.044715f * x * x * x)); }
                            st4bf(AUV + row * 512 + pn * 256 + bj * 128 + cl0 + n * 16, v); } }
        } else if (pn < 4) {
#pragma unroll
            for (int ai = 0; ai < 2; ++ai)
#pragma unroll
                for (int m = 0; m < 4; ++m) { const size_t row = row0 + ai * 128 + m * 16;
#pragma unroll
                    for (int bj = 0; bj < 2; ++bj)
#pragma unroll
                        for (int n = 0; n < 2; ++n) st4bf(YF + row * 512 + (pn - 2) * 256 + bj * 128 + cl0 + n * 16, acc[ai][bj][m][n]); }
        } else if (pn < 6) {
#pragma unroll
            for (int ai = 0; ai < 2; ++ai)
#pragma unroll
                for (int m = 0; m < 4; ++m) { const size_t row = row0 + ai * 128 + m * 16;
#pragma unroll
                    for (int n = 0; n < 2; ++n) { const f32x4 a = acc[ai][0][m][n], g = acc[ai][1][m][n]; f32x4 v;
#pragma unroll
                        for (int j = 0; j < 4; ++j) v[j] = a[j] * sigm(g[j]);
                        st4bf(CY + row * 256 + (pn - 4) * 128 + cl0 + n * 16, v); } }
        } else if (pn < 8) {
            const bool isq = pn == 6; const float scl = isq ? 0.125f : 1.f; const bool latent = u.pm < 64;
#pragma unroll
            for (int ai = 0; ai < 2; ++ai)
#pragma unroll
                for (int m = 0; m < 4; ++m) { const int rowi = row0 + ai * 128 + m * 16; const size_t row = rowi; const int tok = rowi & 8191;
                    const int pos = (wc & 1) ? (tok & 63) : (tok >> 6);
                    f32x4 cs = {1.f, 1.f, 1.f, 1.f}, sn = {0.f, 0.f, 0.f, 0.f};
                    if (latent) { cs = *(const f32x4*)(ropeC + pos * 16 + 4 * fq); sn = *(const f32x4*)(ropeS + pos * 16 + 4 * fq); }
#pragma unroll
                    for (int bj = 0; bj < 2; ++bj) { const f32x4 x1 = acc[ai][bj][m][0] * scl, x2 = acc[ai][bj][m][1] * scl;
                        const f32x4 r1 = x1 * cs - x2 * sn, r2 = x1 * sn + x2 * cs; const size_t off = row * 256 + bj * 128 + cl0;
                        if (isq) { st4bf(QPL + off, x1); st4bf(QPL + off + 16, x2); st4bf(QROT + off, r1); st4bf(QROT + off + 16, r2); }
                        else { st4bf(KR + off, r1); st4bf(KR + off + 16, r2); } } }
        } else if (pn == 8) {
#pragma unroll
            for (int ai = 0; ai < 2; ++ai)
#pragma unroll
                for (int m = 0; m < 4; ++m) { const size_t row = row0 + ai * 128 + m * 16;
#pragma unroll
                    for (int bj = 0; bj < 2; ++bj)
#pragma unroll
                        for (int n = 0; n < 2; ++n) st4bf(VV + row * 256 + bj * 128 + cl0 + n * 16, acc[ai][bj][m][n]); }
        } else {
#pragma unroll
            for (int ai = 0; ai < 2; ++ai)
#pragma unroll
                for (int m = 0; m < 4; ++m) { const size_t row = row0 + ai * 128 + m * 16;
#pragma unroll
                    for (int bj = 0; bj < 2; ++bj)
#pragma unroll
                        for (int n = 0; n < 2; ++n) { f32x4 v = acc[ai][bj][m][n];
#pragma unroll
                            for (int j = 0; j < 4; ++j) v[j] = sigm(v[j]);
                            st4bf(G + row * 4096 + (size_t)(pn - 9) * 256 + bj * 128 + cl0 + n * 16, v); } }
        }
    }
};
struct EpiMerge {
    static constexpr bool PERM = false, AFTER_DRAIN = false;
    const bf16* G; float* P32; bf16* MB;
    __device__ __forceinline__ void operator()(const f32x4 (&acc)[2][2][4][2], const Unit& u, int wr, int wc, int fr, int fq) const {
        int fr_ = fr, fq_ = fq; asm volatile("" : "+v"(fr_), "+v"(fq_));
        const int b = u.pn >> 2, pn = u.pn & 3, pm = u.pm - b * 66, row0 = pm * 256 + wr * 64 + fr_, col0 = pn * 256 + wc * 32 + 4 * fq_;
#pragma unroll
        for (int ai = 0; ai < 2; ++ai)
#pragma unroll
            for (int m = 0; m < 4; ++m) { const unsigned row = row0 + ai * 128 + m * 16;
                const bf16* gp = G + ((size_t)row * 4096 + b * 1024 + col0); float* pp = P32 + ((size_t)row * 1024 + col0); bf16* mp = MB + ((size_t)row * 1024 + col0);
#pragma unroll
                for (int bj = 0; bj < 2; ++bj)
#pragma unroll
                    for (int n = 0; n < 2; ++n) { const int co = bj * 128 + n * 16;
                        const uint2 gw = *(const uint2*)(gp + co);
                        f32x4 v = acc[ai][bj][m][n]; v[0] *= bflo(gw.x); v[1] *= bfhi(gw.x); v[2] *= bflo(gw.y); v[3] *= bfhi(gw.y);
                        if (b > 0) v += *(const f32x4*)(pp + co);
                        if (b < 3) *(f32x4*)(pp + co) = v; else st4bf(mp + co, v);
                        asm volatile("" ::: "memory"); } }
    }
};
struct EpiWout {
    static constexpr bool PERM = false, AFTER_DRAIN = false;
    const float* xlat; const float* xctx; float* X; const float* mod;
    __device__ __forceinline__ void operator()(const f32x4 (&acc)[2][2][4][2], const Unit& u, int wr, int wc, int fr, int fq) const {
        const int r = u.pm < 32 ? 0 : (u.pm < 64 ? 1 : 2); const float* gt = mod + r * 6144 + 2 * 1024;
        const int row0 = u.pm * 256 + wr * 64 + fr, col0 = u.pn * 256 + wc * 32 + 4 * fq;
        f32x4 gv[2][2];
#pragma unroll
        for (int bj = 0; bj < 2; ++bj)
#pragma unroll
            for (int n = 0; n < 2; ++n) gv[bj][n] = *(const f32x4*)(gt + col0 + bj * 128 + n * 16);
#pragma unroll
        for (int ai = 0; ai < 2; ++ai)
#pragma unroll
            for (int m = 0; m < 4; ++m) { const size_t row = row0 + ai * 128 + m * 16; const float* src = (row < ML) ? xlat + row * 1024 : xctx + (row - ML) * 1024;
#pragma unroll
                for (int bj = 0; bj < 2; ++bj)
#pragma unroll
                    for (int n = 0; n < 2; ++n) { const int col = col0 + bj * 128 + n * 16;
                        *(f32x4*)(X + row * 1024 + col) = *(const f32x4*)(src + col) + gv[bj][n] * acc[ai][bj][m][n]; } }
    }
};
struct EpiGU {
    static constexpr bool PERM = false, AFTER_DRAIN = false;
    bf16* ACT;
    __device__ __forceinline__ void operator()(const f32x4 (&acc)[2][2][4][2], const Unit& u, int wr, int wc, int fr, int fq) const {
        const int pnl = u.pn & 7, row0 = u.pm * 256 + wr * 64 + fr, cl0 = wc * 32 + 4 * fq;
#pragma unroll
        for (int ai = 0; ai < 2; ++ai)
#pragma unroll
            for (int m = 0; m < 4; ++m) { const size_t row = row0 + ai * 128 + m * 16;
#pragma unroll
                for (int n = 0; n < 2; ++n) { const f32x4 a = acc[ai][0][m][n], up = acc[ai][1][m][n]; f32x4 v;
#pragma unroll
                    for (int j = 0; j < 4; ++j) v[j] = a[j] * sigm(a[j]) * up[j];
                    st4bf(ACT + row * 1024 + pnl * 128 + cl0 + n * 16, v); } }
    }
};
struct EpiDown {
    static constexpr bool PERM = false, AFTER_DRAIN = false;
    bf16* YB; const float* GATE;
    __device__ __forceinline__ void operator()(const f32x4 (&acc)[2][2][4][2], const Unit& u, int wr, int wc, int fr, int fq) const {
        const int pnl = u.pn & 3, row0 = u.pm * 256 + wr * 64 + fr, col0 = pnl * 256 + wc * 32 + 4 * fq;
#pragma unroll
        for (int ai = 0; ai < 2; ++ai)
#pragma unroll
            for (int m = 0; m < 4; ++m) { const size_t row = row0 + ai * 128 + m * 16; const float gt = GATE[row];
#pragma unroll
                for (int bj = 0; bj < 2; ++bj)
#pragma unroll
                    for (int n = 0; n < 2; ++n) st4bf(YB + row * 1024 + col0 + bj * 128 + n * 16, acc[ai][bj][m][n] * gt); }
    }
};
struct MergeOrder {
    int nt, G, c;
    __device__ void init(int ntm, int G_, int c_) { nt = ntm * 4; G = G_; c = c_; }
    __device__ bool next(int i, Unit& u) const { const int b = i & 3, L = (i >> 2) * G + c; if (L >= nt) return false; u.pm = b * 66 + (L >> 2); u.pn = b * 4 + (L & 3); return true; }
    __device__ __forceinline__ void a_ready(const Unit&) const {}
    __device__ __forceinline__ void done(const Unit&) const {}
};
struct GroupOrder {
    int nwg, G, c, TPE, NTN;
    __device__ void init(int tpe, int ntn, int G_, int c_) { TPE = tpe; NTN = ntn; nwg = NE * tpe * ntn; G = G_; c = c_; }
    __device__ bool next(int i, Unit& u) const {
        const long L = (long)i * G + c; if (L >= nwg) return false;
        int wgid = (int)L; { const int q = nwg / 8, r = nwg % 8, xcd = wgid % 8, off = wgid / 8; wgid = (xcd < r ? xcd * (q + 1) : r * (q + 1) + (xcd - r) * q) + off; }
        const int per = TPE * NTN, e = wgid / per, rem = wgid % per, pn = rem / TPE, mt = rem % TPE;
        u.pm = e * 9 + mt; u.pn = e * NTN + pn; return true;
    }
    __device__ __forceinline__ void a_ready(const Unit&) const {}
    __device__ __forceinline__ void done(const Unit&) const {}
};
#define PH_ARGS LAS unsigned char* lds, const int tid, const int lane, const int wave, const int bid, const int G
#define WSP(T, off) ((T*)(PTRV(29, unsigned char) + (off)))
constexpr int PTAB_OFF = MISC_OFF + 512;
__device__ __forceinline__ unsigned long long ptab_ld(LAS unsigned char* lds, int i) {
    typedef unsigned u2v_t __attribute__((ext_vector_type(2)));
    const volatile LAS unsigned* tp = (const volatile LAS unsigned*)(lds + PTAB_OFF + 8 * i); u2v_t v; v[0] = tp[0]; v[1] = tp[1];
    const unsigned lo = __builtin_amdgcn_readfirstlane(v[0]), hi = __builtin_amdgcn_readfirstlane(v[1]);
    return ((unsigned long long)hi << 32) | lo;
}
#define PTRV(i, T) ((T*)(GAS T*)ptab_ld(lds, (i)))
#define INP(i) ((const float*)(GAS const float*)ptab_ld(lds, (i)))

__device__ __forceinline__ void mod_gemv(PH_ARGS) {
    LAS f32x4* red = (LAS f32x4*)lds;
    const float* c = INP(1); const float* cc = INP(3); const float* wm = INP(4); const float* bm = INP(5);
    float* MOD = WSP(float, WS_MOD);
    for (int it = bid; it < 192; it += G) {
        const int l = it / 96, cg = it % 96, kg = tid >> 4, cq = tid & 15;
        f32x4 a0 = {0.f, 0.f, 0.f, 0.f}, a1 = a0, a2 = a0;
        const float* wb = wm + (size_t)l * 1024 * 6144 + cg * 64 + cq * 4;
#pragma unroll 4
        for (int i = 0; i < 32; ++i) { const int k = kg + 32 * i; const f32x4 w = *(const f32x4*)(wb + (size_t)k * 6144);
            const float x0 = c[k], x1 = c[1024 + k], x2 = cc[k];
            a0 += w * (x0 * sigm(x0)); a1 += w * (x1 * sigm(x1)); a2 += w * (x2 * sigm(x2)); }
        red[(kg * 3 + 0) * 16 + cq] = a0; red[(kg * 3 + 1) * 16 + cq] = a1; red[(kg * 3 + 2) * 16 + cq] = a2;
        __syncthreads();
        if (tid < 192) { const int r = tid >> 6, col = tid & 63; float s = 0.f; const LAS float* rf = (const LAS float*)red;
            for (int k2 = 0; k2 < 32; ++k2) s += rf[((k2 * 3 + r) * 16 + (col >> 2)) * 4 + (col & 3)];
            MOD[(l * 3 + r) * 6144 + cg * 64 + col] = s + bm[l * 6144 + cg * 64 + col]; }
        __syncthreads();
    }
}
__device__ __forceinline__ void make_tables(PH_ARGS) {
    const int gt = bid * 512 + tid, GT = G * 512;
    float* RC = WSP(float, WS_ROPEC); float* RS = WSP(float, WS_ROPES); float2* TW = WSP(float2, WS_TW); float2* C256 = WSP(float2, WS_CS256);
    bf16* T1 = WSP(bf16, WS_T1T); bf16* T2 = WSP(bf16, WS_T2T);
    for (int i = gt; i < 2048; i += GT) { const int pos = i >> 4, f = i & 15; const float inv = powf(10000.f, -(float)f / 16.f), ang = (float)pos * inv; RC[i] = cosf(ang); RS[i] = sinf(ang); }
    for (int i = gt; i < 128 * 128; i += GT) { const int col = i >> 7, k = i & 127, ro = col >> 6, k1 = col & 63, n1 = k >> 1, ri = k & 1; float s, c; sincospif((float)((k1 * n1) & 63) / 32.f, &s, &c);
        const float v = ro == 0 ? (ri == 0 ? c : s) : (ri == 0 ? -s : c); T1[i] = (bf16)f2bf(v); }
    for (int i = gt; i < 128 * 256; i += GT) { const int k2 = i >> 8, k = i & 255, n2 = k >> 1, ri = k & 1; float s, c; sincospif((float)((k2 * n2) & 127) / 64.f, &s, &c); T2[i] = (bf16)f2bf(ri ? s : c); }
    for (int i = gt; i < 64 * 128; i += GT) { const int k1 = i >> 7, n2 = i & 127; float s, c; sincospif((float)(k1 * n2) / 4096.f, &s, &c); TW[i] = make_float2(c, s); }
    for (int i = gt; i < 256; i += GT) { float s, c; sincospif((float)i / 128.f, &s, &c); C256[i] = make_float2(c, s); }
}
__device__ __forceinline__ void tr_item(const float* W, size_t ldw, int col0, int k0, bf16* dst, int Kd, LAS float* scr, int lane) {
#pragma unroll 8
    for (int i = 0; i < 32; ++i) { const int kk = 2 * i + (lane >> 5); scr[kk * 33 + (lane & 31)] = W[(size_t)(k0 + kk) * ldw + col0 + (lane & 31)]; }
    LDS_WAIT(); asm volatile("" ::: "memory");
    const int c = lane & 7;
#pragma unroll
    for (int j = 0; j < 4; ++j) { const int n = (lane >> 3) + 8 * j; const LAS float* s = scr + (8 * c) * 33 + n;
        v4u o; o.x = pk2(s[0 * 33], s[1 * 33]); o.y = pk2(s[2 * 33], s[3 * 33]); o.z = pk2(s[4 * 33], s[5 * 33]); o.w = pk2(s[6 * 33], s[7 * 33]);
        *(v4u*)(dst + (size_t)n * Kd + k0 + 8 * c) = o; }
    LDS_WAIT(); asm volatile("" ::: "memory");
}
__device__ __forceinline__ void fold_item(const float* W  , int f, bf16* WIN, LAS float* scr, int lane) {
    const int kb = f >> 2, g = f & 3, k0 = kb * 64;
    for (int kk = 0; kk < 64; ++kk) scr[kk * 64 + lane] = W[(size_t)(k0 + kk) * 6144 + 512 + g * 64 + lane];
    LDS_WAIT(); asm volatile("" ::: "memory");
    bf16* d0 = WIN + (size_t)(512 + 2 * (g * 64 + lane)) * 1024 + k0;
#pragma unroll 1
    for (int kc = 0; kc < 2; ++kc) {
        float ar[32], ai[32];
#pragma unroll
        for (int kk = 0; kk < 32; ++kk) { ar[kk] = 0.f; ai[kk] = 0.f; }
#pragma unroll 1
        for (int c = 0; c < 64; ++c) { float s, co; sincospif((float)((c * lane) & 63) / 32.f, &s, &co);
#pragma unroll
            for (int kk = 0; kk < 32; ++kk) { const float w = scr[(kc * 32 + kk) * 64 + c]; ar[kk] += w * co; ai[kk] -= w * s; } }
#pragma unroll
        for (int q = 0; q < 4; ++q) { v4u o, p;
            o.x = pk2(ar[8 * q + 0], ar[8 * q + 1]); o.y = pk2(ar[8 * q + 2], ar[8 * q + 3]); o.z = pk2(ar[8 * q + 4], ar[8 * q + 5]); o.w = pk2(ar[8 * q + 6], ar[8 * q + 7]);
            p.x = pk2(ai[8 * q + 0], ai[8 * q + 1]); p.y = pk2(ai[8 * q + 2], ai[8 * q + 3]); p.z = pk2(ai[8 * q + 4], ai[8 * q + 5]); p.w = pk2(ai[8 * q + 6], ai[8 * q + 7]);
            *(v4u*)(d0 + kc * 32 + 8 * q) = o; *(v4u*)(d0 + 1024 + kc * 32 + 8 * q) = p; }
    }
    LDS_WAIT(); asm volatile("" ::: "memory");
}
__device__ __forceinline__ void convert_weights(PH_ARGS, const int l) {
    LAS float* scr = (LAS float*)(lds + wave * 16384);
    const int gw = bid * 8 + wave, NGW = G * 8;
    bf16* WIN = WSP(bf16, WS_WIN); bf16* WBR = WSP(bf16, WS_WBR); bf16* WO = WSP(bf16, WS_WO); bf16* WGU = WSP(bf16, WS_WGU); bf16* WDN = WSP(bf16, WS_WDN); bf16* WS_ = WSP(bf16, WS_WSP);
    const float* win = INP(8) + (size_t)l * 1024 * 6144;
    constexpr int N_FOLD = 64, N_IN = 184 * 16, N_BR = 512, N_WO = 512, N_GU = 16384, N_DN = 8192, N_SP = 64;
    constexpr int NITEMS = N_FOLD + N_IN + N_BR + N_WO + N_GU + N_DN + N_SP;
    for (int it = gw; it < NITEMS; it += NGW) {
        int r = it;
        if (r < N_FOLD) { fold_item(win, r, WIN, scr, lane); continue; } r -= N_FOLD;
        if (r < N_IN) { const int dbp = r >> 4, kb = r & 15, db = dbp < 16 ? dbp : dbp + 16; int col;
            if (db < 16) col = db * 32;
            else if (db < 48) { const int t = db - 32, tile = t >> 3, sub = t & 7; col = (sub < 4 ? 768 : 1024) + tile * 128 + (sub & 3) * 32; }
            else if (db < 72) col = 1280 + (db - 48) * 32;
            else col = 2048 + (db - 72) * 32;
            tr_item(win, 6144, col, kb * 64, WIN + (size_t)db * 32 * 1024, 1024, scr, lane); continue; } r -= N_IN;
        if (r < N_BR) { const int b = r >> 7, q = r & 127, kb = q >> 5, nb = q & 31; const int ii = b == 0 ? 13 : (b == 1 ? 14 : (b == 2 ? 19 : 21));
            tr_item(INP(ii) + (size_t)l * 256 * 1024, 1024, nb * 32, kb * 64, WBR + (size_t)(b * 1024 + nb * 32) * 256, 256, scr, lane); continue; } r -= N_BR;
        if (r < N_WO) { const int kb = r >> 5, nb = r & 31; tr_item(INP(22) + (size_t)l * 1024 * 1024, 1024, nb * 32, kb * 64, WO + (size_t)nb * 32 * 1024, 1024, scr, lane); continue; } r -= N_WO;
        if (r < N_GU) { const int e = r >> 10, q = r & 1023, db = q >> 4, kb = q & 15, tile = db >> 3, sub = db & 7;
            const float* src = (sub < 4 ? INP(24) : INP(25)) + (size_t)(l * 16 + e) * 1024 * 1024;
            tr_item(src, 1024, tile * 128 + (sub & 3) * 32, kb * 64, WGU + ((size_t)e * 2048 + db * 32) * 1024, 1024, scr, lane); continue; } r -= N_GU;
        if (r < N_DN) { const int e = r >> 9, q = r & 511, kb = q >> 5, nb = q & 31;
            tr_item(INP(26) + (size_t)(l * 16 + e) * 1024 * 1024, 1024, nb * 32, kb * 64, WDN + ((size_t)e * 1024 + nb * 32) * 1024, 1024, scr, lane); continue; } r -= N_DN;
        { const float* s = INP(11) + (size_t)l * 65536 + r * 1024 + lane * 16; const f32x4 a = *(const f32x4*)s, b = *(const f32x4*)(s + 4), c = *(const f32x4*)(s + 8), d = *(const f32x4*)(s + 12);
          v4u o, p; o.x = pk2(a[0], a[1]); o.y = pk2(a[2], a[3]); o.z = pk2(b[0], b[1]); o.w = pk2(b[2], b[3]); p.x = pk2(c[0], c[1]); p.y = pk2(c[2], c[3]); p.z = pk2(d[0], d[1]); p.w = pk2(d[2], d[3]);
          *(v4u*)(WS_ + r * 1024 + lane * 16) = o; *(v4u*)(WS_ + r * 1024 + lane * 16 + 8) = p; }
    }
}
__device__ __forceinline__ void load_row(const float* p, int lane, f32x4 (&v)[4]) {
#pragma unroll
    for (int j = 0; j < 4; ++j) v[j] = *(const f32x4*)(p + 4 * lane + 256 * j);
}
__device__ __forceinline__ void modnorm_store(f32x4 (&v)[4], const float* g, const float* sc, const float* sh, bf16* hrow, int lane) {
    float ss = 0.f;
#pragma unroll
    for (int j = 0; j < 4; ++j) ss += (v[j][0] * v[j][0] + v[j][1] * v[j][1]) + (v[j][2] * v[j][2] + v[j][3] * v[j][3]);
    const float rs = 1.0f / sqrtf(wave_sum(ss) * (1.f / 1024.f) + 1e-6f);
#pragma unroll
    for (int j = 0; j < 4; ++j) { const int o = 4 * lane + 256 * j; const f32x4 gg = *(const f32x4*)(g + o), s = *(const f32x4*)(sc + o), b = *(const f32x4*)(sh + o);
        v[j] = v[j] * rs * gg * (s + 1.f) + b; st4bf(hrow + o, v[j]); }
}
__device__ __forceinline__ void norm1_l0(PH_ARGS) {
    const int gw = bid * 8 + wave, NGW = G * 8; bf16* H = WSP(bf16, WS_H); const float* MOD = WSP(float, WS_MOD);
    for (int row = gw; row < MT; row += NGW) {
        const float* src = row < ML ? INP(0) + (size_t)row * 1024 : INP(2) + (size_t)(row - ML) * 1024; const int r = row < SEQ ? 0 : (row < ML ? 1 : 2);
        f32x4 v[4]; load_row(src, lane, v); const float* md = MOD + r * 6144;
        modnorm_store(v, INP(6), md + 1024, md, H + (size_t)row * 1024, lane);
    }
}
__device__ __forceinline__ void norm2_router(PH_ARGS, const int l, const int nrows) {
    const int gw = bid * 8 + wave, NGW = G * 8; bf16* H = WSP(bf16, WS_H); const float* MOD = WSP(float, WS_MOD) + l * 3 * 6144; const float* X = WSP(float, WS_X); float* AFF = WSP(float, WS_AFF);
    LAS f32x4* Wl = (LAS f32x4*)lds;
    { const f32x4* wr = (const f32x4*)(INP(23) + (size_t)l * 1024 * 16);
      for (int i = tid; i < 4096; i += 512) { const int k = i >> 2, q = i & 3; Wl[(q * 4 + (k & 3)) * 256 + (k >> 2)] = wr[i]; } }
    __syncthreads();
    for (int row = gw; row < nrows; row += NGW) {
        const int r = row < SEQ ? 0 : (row < ML ? 1 : 2); const float* md = MOD + r * 6144;
        f32x4 v[4]; load_row(X + (size_t)row * 1024, lane, v);
        modnorm_store(v, INP(7) + l * 1024, md + 4 * 1024, md + 3 * 1024, H + (size_t)row * 1024, lane);
        float lg[16];
#pragma unroll
        for (int e = 0; e < 16; ++e) lg[e] = 0.f;
#pragma unroll
        for (int j = 0; j < 4; ++j)
#pragma unroll
            for (int i = 0; i < 4; ++i) { const float hv = v[j][i];
#pragma unroll
                for (int q = 0; q < 4; ++q) { const f32x4 w = Wl[(q * 4 + i) * 256 + 64 * j + lane]; lg[4 * q + 0] += hv * w[0]; lg[4 * q + 1] += hv * w[1]; lg[4 * q + 2] += hv * w[2]; lg[4 * q + 3] += hv * w[3]; }
                if (i & 1) asm volatile("" ::: "memory"); }
#pragma unroll
        for (int i = 0; i < 8; ++i) { const bool up = lane & 32; const float send = up ? lg[i] : lg[i + 8], keep = up ? lg[i + 8] : lg[i]; lg[i] = keep + __shfl_xor(send, 32); }
#pragma unroll
        for (int i = 0; i < 4; ++i) { const bool up = lane & 16; const float send = up ? lg[i] : lg[i + 4], keep = up ? lg[i + 4] : lg[i]; lg[i] = keep + __shfl_xor(send, 16); }
#pragma unroll
        for (int i = 0; i < 2; ++i) { const bool up = lane & 8; const float send = up ? lg[i] : lg[i + 2], keep = up ? lg[i + 2] : lg[i]; lg[i] = keep + __shfl_xor(send, 8); }
        { const bool up = lane & 4; const float send = up ? lg[0] : lg[1], keep = up ? lg[1] : lg[0]; lg[0] = keep + __shfl_xor(send, 4); }
        float z = lg[0]; z += __shfl_xor(z, 1); z += __shfl_xor(z, 2);
        float mx = z; mx = fmaxf(mx, __shfl_xor(mx, 4)); mx = fmaxf(mx, __shfl_xor(mx, 8)); mx = fmaxf(mx, __shfl_xor(mx, 16)); mx = fmaxf(mx, __shfl_xor(mx, 32));
        const float ez = expf(z - mx); float sm = ez; sm += __shfl_xor(sm, 4); sm += __shfl_xor(sm, 8); sm += __shfl_xor(sm, 16); sm += __shfl_xor(sm, 32);
        if ((lane & 3) == 0) { const int e = ((lane >> 5) & 1) * 8 + ((lane >> 4) & 1) * 4 + ((lane >> 3) & 1) * 2 + ((lane >> 2) & 1); AFF[(size_t)row * 16 + e] = ez / sm; }
    }
    __syncthreads();
}
typedef short v4i16_t __attribute__((ext_vector_type(4)));
typedef float f2v __attribute__((ext_vector_type(2)));
__device__ __forceinline__ void mfma16(f32x4& acc, const bf16x8 a, const bf16x8 b) { asm volatile("s_nop 1\n\tv_mfma_f32_16x16x32_bf16 %0, %1, %2, %0\n\ts_nop 3" : "+v"(acc) : "v"(a), "v"(b)); }
#define DRAIN4(x) asm volatile("s_nop 15\n\ts_nop 15" : "+v"((x)[0]), "+v"((x)[1]), "+v"((x)[2]), "+v"((x)[3]))
#define DRAIN8(x) asm volatile("s_nop 15\n\ts_nop 15" : "+v"((x)[0]), "+v"((x)[1]), "+v"((x)[2]), "+v"((x)[3]), "+v"((x)[4]), "+v"((x)[5]), "+v"((x)[6]), "+v"((x)[7]))
#define DRAIN16(x) asm volatile("s_nop 15\n\ts_nop 15" : "+v"((x)[0]), "+v"((x)[1]), "+v"((x)[2]), "+v"((x)[3]), "+v"((x)[4]), "+v"((x)[5]), "+v"((x)[6]), "+v"((x)[7]), \
    "+v"((x)[8]), "+v"((x)[9]), "+v"((x)[10]), "+v"((x)[11]), "+v"((x)[12]), "+v"((x)[13]), "+v"((x)[14]), "+v"((x)[15]))
__device__ __forceinline__ void gmlp_unit(PH_ARGS, const int l, const int chunk) {
    const int row0 = chunk < 128 ? chunk * 128 : ML + (chunk - 128) * 128;
    const bf16* AUV = WSP(bf16, WS_AUV); bf16* BRa = WSP(bf16, WS_BR); const bf16* WS_ = WSP(bf16, WS_WSP);
    LAS bf16* vT = (LAS bf16*)lds;
    const float* lg = INP(9) + l * 256; const float* lb = INP(10) + l * 256;
    const f32x4 gg = *(const f32x4*)(lg + 4 * lane), bb = *(const f32x4*)(lb + 4 * lane);
    for (int pi = 0; pi < 16; ++pi) { const int p = wave * 16 + pi;
        const uint2 raw = *(const uint2*)(AUV + (size_t)(row0 + p) * 512 + 256 + 4 * lane);
        float v0 = bflo(raw.x), v1 = bfhi(raw.x), v2 = bflo(raw.y), v3 = bfhi(raw.y);
        const float mean = wave_sum((v0 + v1) + (v2 + v3)) * (1.f / 256.f); v0 -= mean; v1 -= mean; v2 -= mean; v3 -= mean;
        const float rstd = 1.0f / sqrtf(wave_sum((v0 * v0 + v1 * v1) + (v2 * v2 + v3 * v3)) * (1.f / 256.f) + 1e-6f);
        vT[(4 * lane + 0) * 136 + p] = (bf16)f2bf(v0 * rstd * gg[0] + bb[0]); vT[(4 * lane + 1) * 136 + p] = (bf16)f2bf(v1 * rstd * gg[1] + bb[1]);
        vT[(4 * lane + 2) * 136 + p] = (bf16)f2bf(v2 * rstd * gg[2] + bb[2]); vT[(4 * lane + 3) * 136 + p] = (bf16)f2bf(v3 * rstd * gg[3] + bb[3]); }
    __syncthreads();
    const int g = wave >> 1, qh = wave & 1, fr = lane & 15, fq = lane >> 4;
    f32x4 acc[4][4];
#pragma unroll
    for (int a = 0; a < 4; ++a)
#pragma unroll
        for (int b = 0; b < 4; ++b) acc[a][b] = (f32x4){0.f, 0.f, 0.f, 0.f};
    const bf16* Wg = WS_ + g * 16384;
#pragma unroll
    for (int ks = 0; ks < 4; ++ks) { bf16x8 af[4], bf[4];
#pragma unroll
        for (int dt = 0; dt < 4; ++dt) af[dt] = *(const LAS bf16x8*)(vT + (g * 64 + dt * 16 + fr) * 136 + ks * 32 + fq * 8);
#pragma unroll
        for (int qt = 0; qt < 4; ++qt) bf[qt] = *(const bf16x8*)(Wg + (qh * 64 + qt * 16 + fr) * 128 + ks * 32 + fq * 8);
#pragma unroll
        for (int dt = 0; dt < 4; ++dt)
#pragma unroll
            for (int qt = 0; qt < 4; ++qt) mfma16(acc[dt][qt], af[dt], bf[qt]); }
    DRAIN16(&acc[0][0]);
    const float* bs = INP(12) + l * 512 + g * 128;
#pragma unroll
    for (int qt = 0; qt < 4; ++qt) { const int q = qh * 64 + qt * 16 + fr; const float bias = bs[q]; const size_t row = row0 + q;
#pragma unroll
        for (int dt = 0; dt < 4; ++dt) { const int ch = g * 64 + dt * 16 + 4 * fq; const uint2 uw = *(const uint2*)(AUV + row * 512 + ch);
            f32x4 o; o[0] = bflo(uw.x) * (acc[dt][qt][0] + bias); o[1] = bfhi(uw.x) * (acc[dt][qt][1] + bias); o[2] = bflo(uw.y) * (acc[dt][qt][2] + bias); o[3] = bfhi(uw.y) * (acc[dt][qt][3] + bias);
            st4bf(BRa + row * 256 + ch, o); } }
    __syncthreads();
}
__device__ __forceinline__ void conv_unit(PH_ARGS, const int l, const int unit) {
    int rowbase, n0, nlen;
    if (unit < 256) { rowbase = (unit >> 7) * SEQ; n0 = (unit & 127) * 64; nlen = SEQ; } else { const int u2 = unit - 256; rowbase = ML + (u2 >> 2) * CTXL; n0 = (u2 & 3) * 64; nlen = CTXL; }
    const bf16* CY = WSP(bf16, WS_CY); bf16* BRc = WSP(bf16, WS_BR) + (size_t)2 * MT * 256;
    LAS unsigned* yt = (LAS unsigned*)lds;
    LAS float* cres = (LAS float*)(lds + 48128);
    for (int p = tid; p < 94 * 32; p += 512) { const int rr = p >> 5, seg = p & 31, n = n0 - 15 + rr; v4u val = {0u, 0u, 0u, 0u};
        if (n >= 0 && n < nlen) val = *(const v4u*)(CY + (size_t)(rowbase + n) * 256 + seg * 8);
        *(LAS v4u*)(lds + rr * 512 + seg * 16) = val; }
    __syncthreads();
    const int cp = tid & 127, pg = tid >> 7;
    float w0[31], w1[31];
    const float* cw = INP(15) + (size_t)l * 31 * 256 + 2 * cp;
#pragma unroll
    for (int t = 0; t < 31; ++t) { const float2 w = *(const float2*)(cw + t * 256); w0[t] = w.x; w1[t] = w.y; }
    float a0[16], a1[16];
#pragma unroll
    for (int p = 0; p < 16; ++p) { a0[p] = 0.f; a1[p] = 0.f; }
#pragma unroll
    for (int i = 0; i < 46; ++i) { const unsigned raw = yt[(16 * pg + i) * 128 + cp]; const float v0 = bflo(raw), v1 = bfhi(raw);
#pragma unroll
        for (int p = 0; p < 16; ++p) { const int t = i - p; if (t >= 0 && t < 31) { a0[p] += v0 * w0[t]; a1[p] += v1 * w1[t]; } } }
    const float2 cb = *(const float2*)(INP(16) + l * 256 + 2 * cp);
#pragma unroll
    for (int p = 0; p < 16; ++p) *(LAS f2v*)(cres + (16 * pg + p) * 256 + 2 * cp) = (f2v){a0[p] + cb.x, a1[p] + cb.y};
    __syncthreads();
    const f32x4 gg = *(const f32x4*)(INP(17) + l * 256 + 4 * lane), bb = *(const f32x4*)(INP(18) + l * 256 + 4 * lane);
    for (int pi = 0; pi < 8; ++pi) { const int pos = wave * 8 + pi; f32x4 v = *(const LAS f32x4*)(cres + pos * 256 + 4 * lane);
        const float mean = wave_sum((v[0] + v[1]) + (v[2] + v[3])) * (1.f / 256.f); v = v - mean;
        const float rstd = 1.0f / sqrtf(wave_sum((v[0] * v[0] + v[1] * v[1]) + (v[2] * v[2] + v[3] * v[3])) * (1.f / 256.f) + 1e-6f);
        f32x4 o;
#pragma unroll
        for (int j = 0; j < 4; ++j) { const float y = v[j] * rstd * gg[j] + bb[j]; o[j] = y * sigm(y); }
        st4bf(BRc + (size_t)(rowbase + n0 + pos) * 256 + 4 * lane, o); }
    __syncthreads();
}
constexpr int F1_T1L = 0, F1_YL = 34816;
__device__ __forceinline__ void f1_stage_tables(PH_ARGS) {
    const bf16* T1 = WSP(bf16, WS_T1T);
    for (int p = tid; p < 128 * 16; p += 512) { const int r = p >> 4, s = p & 15; *(LAS v4u*)(lds + F1_T1L + r * 272 + s * 16) = *(const v4u*)(T1 + r * 128 + s * 8); }
    __syncthreads();
}
__device__ __forceinline__ void f1_unit(PH_ARGS, const int unit) {
    const int b = unit >> 7, n2 = unit & 127, fr = lane & 15, fq = lane >> 4;
    const bf16* YF = WSP(bf16, WS_YF); bf16* FA = WSP(bf16, WS_FA); const float2* TW = WSP(float2, WS_TW);
    LAS unsigned* Yl = (LAS unsigned*)(lds + F1_YL);
#pragma unroll
    for (int i = 0; i < 8; ++i) { const int n1 = wave + 8 * i; *(LAS v4u*)(Yl + n1 * 260 + lane * 4) = *(const v4u*)(YF + (size_t)(b * SEQ + 128 * n1 + n2) * 512 + lane * 8); }
    __syncthreads();
    f32x4 acc[2][8];
#pragma unroll
    for (int a = 0; a < 2; ++a)
#pragma unroll
        for (int n = 0; n < 8; ++n) acc[a][n] = (f32x4){0.f, 0.f, 0.f, 0.f};
#pragma unroll
    for (int ks = 0; ks < 4; ++ks) { bf16x8 af[2];
#pragma unroll
        for (int c2 = 0; c2 < 2; ++c2) { const int ch = (2 * wave + c2) * 16 + fr; v4u w;
            w.x = Yl[(16 * ks + 4 * fq + 0) * 260 + ch]; w.y = Yl[(16 * ks + 4 * fq + 1) * 260 + ch]; w.z = Yl[(16 * ks + 4 * fq + 2) * 260 + ch]; w.w = Yl[(16 * ks + 4 * fq + 3) * 260 + ch];
            af[c2] = __builtin_bit_cast(bf16x8, w); }
#pragma unroll
        for (int nt = 0; nt < 8; ++nt) { const bf16x8 bfr = *(const LAS bf16x8*)(lds + F1_T1L + (nt * 16 + fr) * 272 + ks * 64 + fq * 16);
            mfma16(acc[0][nt], af[0], bfr); mfma16(acc[1][nt], af[1], bfr); } }
    DRAIN16(&acc[0][0]);
#pragma unroll
    for (int c2 = 0; c2 < 2; ++c2)
#pragma unroll
        for (int kt = 0; kt < 4; ++kt) { const int k1 = kt * 16 + fr;
#if defined(F1V) && F1V == 5
            const unsigned long long twb = __hip_atomic_load((const unsigned long long*)(TW + k1 * 128 + n2), __ATOMIC_RELAXED, __HIP_MEMORY_SCOPE_SYSTEM); const float2 tw = make_float2(__uint_as_float((unsigned)twb), __uint_as_float((unsigned)(twb >> 32)));
#elif defined(F1V) && F1V == 6
            const unsigned long long twb = __hip_atomic_load((const unsigned long long*)(TW + k1 * 128 + n2), __ATOMIC_RELAXED, __HIP_MEMORY_SCOPE_AGENT); const float2 tw = make_float2(__uint_as_float((unsigned)twb), __uint_as_float((unsigned)(twb >> 32)));
#else
            const float2 tw = TW[k1 * 128 + n2];
#endif
            const f32x4 re = acc[c2][kt], im = acc[c2][kt + 4];
#if defined(F1V) && F1V == 1
            const f32x4 ar = re, ai = im; (void)tw;
#elif defined(F1V) && F1V == 4
            const float2 t4 = make_float2(0.6f + 0.001f * (float)k1, 0.8f - 0.002f * (float)n2); const f32x4 ar = re * t4.x + im * t4.y, ai = im * t4.x - re * t4.y; (void)tw;
#elif defined(F1V) && F1V == 2
            f32x4 ar, ai; { const int chq = (2 * wave + c2) * 16 + 4 * fq; for (int q = 0; q < 4; ++q) { const unsigned w0 = Yl[(k1) * 260 + chq + q]; ar[q] = bflo(w0); ai[q] = bfhi(w0); } } (void)tw; (void)re; (void)im;
#elif defined(F1V) && F1V == 3
            f32x4 ar, ai; { for (int q = 0; q < 4; ++q) { const unsigned w0 = *(const LAS unsigned*)(lds + F1_T1L + (kt * 32 + 2 * fr + (q >> 1)) * 272 + ((2 * wave + c2) * 16 + 4 * fq + (q & 1) * 2) ); ar[q] = bflo(w0); ai[q] = bfhi(w0); } } (void)tw; (void)re; (void)im;
#else
            const f32x4 ar = re * tw.x + im * tw.y, ai = im * tw.x - re * tw.y;
#endif
            v4u o; o.x = pk2(ar[0], ai[0]); o.y = pk2(ar[1], ai[1]); o.z = pk2(ar[2], ai[2]); o.w = pk2(ar[3], ai[3]);
            *(v4u*)(FA + ((size_t)((b * 64 + k1) * 128 + n2) * 256 + (2 * wave + c2) * 16 + 4 * fq) * 2) = o; }
    __syncthreads();
}
constexpr int F2_T2L = 0, F2_AL = 67584;
__device__ __forceinline__ void f2_stage_tables(PH_ARGS) {
    const bf16* T2 = WSP(bf16, WS_T2T);
    for (int p = tid; p < 128 * 32; p += 512) { const int r = p >> 5, s = p & 31; *(LAS v4u*)(lds + F2_T2L + r * 528 + s * 16) = *(const v4u*)(T2 + r * 256 + s * 8); }
    __syncthreads();
}
__device__ __forceinline__ void f2_unit(PH_ARGS, const int unit) {
    const int b = unit >> 7, k1 = (unit >> 1) & 63, chh = unit & 1, fr = lane & 15, fq = lane >> 4;
    const bf16* FA = WSP(bf16, WS_FA); bf16* BRb = WSP(bf16, WS_BR) + (size_t)1 * MT * 256;
    LAS unsigned* Al = (LAS unsigned*)(lds + F2_AL);
#pragma unroll
    for (int i = 0; i < 8; ++i) { const int n2 = wave * 16 + 2 * i + (lane >> 5);
        *(LAS v4u*)(Al + n2 * 132 + (lane & 31) * 4) = *(const v4u*)(FA + ((size_t)((b * 64 + k1) * 128 + n2) * 256 + chh * 128) * 2 + (lane & 31) * 8); }
    __syncthreads();
    f32x4 acc[8];
#pragma unroll
    for (int n = 0; n < 8; ++n) acc[n] = (f32x4){0.f, 0.f, 0.f, 0.f};
    const int ch = wave * 16 + fr;
#pragma unroll
    for (int ks = 0; ks < 8; ++ks) { v4u w;
        w.x = Al[(16 * ks + 4 * fq + 0) * 132 + ch]; w.y = Al[(16 * ks + 4 * fq + 1) * 132 + ch]; w.z = Al[(16 * ks + 4 * fq + 2) * 132 + ch]; w.w = Al[(16 * ks + 4 * fq + 3) * 132 + ch];
        const bf16x8 af = __builtin_bit_cast(bf16x8, w);
#pragma unroll
        for (int nt = 0; nt < 8; ++nt) { const bf16x8 bfr = *(const LAS bf16x8*)(lds + F2_T2L + (nt * 16 + fr) * 528 + ks * 64 + fq * 16); mfma16(acc[nt], af, bfr); } }
    DRAIN8(acc);
    const float scl = 0.0013810679320049757f;
#pragma unroll
    for (int nt = 0; nt < 8; ++nt) { const int k2 = nt * 16 + fr; st4bf(BRb + (size_t)(b * SEQ + k1 + 64 * k2) * 256 + chh * 128 + wave * 16 + 4 * fq, acc[nt] * scl); }
    __syncthreads();
}
__device__ __forceinline__ void ctxdft_unit(PH_ARGS, const int unit) {
    const bf16* YF = WSP(bf16, WS_YF); bf16* BRb = WSP(bf16, WS_BR) + (size_t)1 * MT * 256; const float2* C256 = WSP(float2, WS_CS256);
    LAS f2v* tb = (LAS f2v*)lds;
    if (tid < 256) { const float2 t = C256[tid]; tb[tid] = (f2v){t.x, t.y}; }
    __syncthreads();
    const int b = unit >> 7, kk = (unit & 127) * 2 + (tid >> 8), ch = tid & 255;
    const unsigned* src = (const unsigned*)(YF + (size_t)(ML + b * CTXL) * 512) + ch; float acc = 0.f;
#pragma unroll 8
    for (int n = 0; n < 256; ++n) { const unsigned w = src[(size_t)n * 256]; const f2v cs = tb[(kk * n) & 255]; acc += bflo(w) * cs.x + bfhi(w) * cs.y; }
    BRb[(size_t)(ML + b * CTXL + kk) * 256 + ch] = (bf16)f2bf(acc * (1.f / 128.f));
    __syncthreads();
}
constexpr int AT_RPB = 65536, AT_MRG = 73728;
__device__ __forceinline__ int clampi(int v, int lo, int hi) { return v < lo ? lo : (v > hi ? hi : v); }
__device__ __forceinline__ void attn_unit(PH_ARGS, const int unit) {
    const int h = wave >> 1, part = wave & 1, fr = lane & 15, fq = lane >> 4;
    const bool lat = unit < 1024;
    int b, r = 0, jb = 0, qrow0, kr0 = 0, kc0 = 0;
    if (lat) { b = unit >> 9; r = (unit >> 2) & 127; jb = unit & 3; qrow0 = b * SEQ + r * 64 + jb * 16; kr0 = clampi(r - 4, 0, 120); kc0 = clampi(jb * 16 - 8, 0, 32); }
    else { const int u2 = unit - 1024; b = u2 >> 4; qrow0 = ML + b * CTXL + (u2 & 15) * 16; }
    const bf16* QPL = WSP(bf16, WS_QPL); const bf16* QROT = WSP(bf16, WS_QROT); const bf16* KR = WSP(bf16, WS_KR); const bf16* VV = WSP(bf16, WS_VV);
    bf16* BRd = WSP(bf16, WS_BR) + (size_t)3 * MT * 256;
    LAS unsigned char* vbuf = lds + wave * 8192;
    const LAS float* rpbl = (const LAS float*)(lds + AT_RPB);
    LAS float* mrg = (LAS float*)(lds + AT_MRG) + h * 1088;
    float m_run = -3.0e38f, l_run = 0.f;
    f32x4 O[4];
#pragma unroll
    for (int d = 0; d < 4; ++d) O[d] = (f32x4){0.f, 0.f, 0.f, 0.f};
    const bool active = lat || part == 1;
    if (active) {
        const bf16* Qs = (lat && part == 0) ? QROT : QPL;
        bf16x8 qf[2];
#pragma unroll
        for (int ks = 0; ks < 2; ++ks) qf[ks] = *(const bf16x8*)(Qs + (size_t)(qrow0 + fr) * 256 + h * 64 + ks * 32 + fq * 8);
        f32x4 S[16];
#pragma unroll
        for (int kt = 0; kt < 16; ++kt) { const int kk = kt * 16 + fr;
            const size_t krow = part == 0 ? (size_t)(b * SEQ + (kr0 + (kk >> 5)) * 64 + kc0 + (kk & 31)) : (size_t)(ML + b * CTXL + kk);
            const bf16x8 k0 = *(const bf16x8*)(KR + krow * 256 + h * 64 + fq * 8), k1 = *(const bf16x8*)(KR + krow * 256 + h * 64 + 32 + fq * 8);
            S[kt] = (f32x4){0.f, 0.f, 0.f, 0.f}; mfma16(S[kt], k0, qf[0]); mfma16(S[kt], k1, qf[1]); }
        DRAIN16(S);
        if (part == 0) { const int qcol = jb * 16 + fr, cst = clampi(qcol - 8, 0, 48);
#pragma unroll
            for (int kt = 0; kt < 16; ++kt) { const int drow = kr0 + (kt >> 1) - r + 7;
#pragma unroll
                for (int rg = 0; rg < 4; ++rg) { const int kcol = kc0 + (kt & 1) * 16 + 4 * fq + rg; const bool ok = kcol >= cst && kcol < cst + 16; const int dcol = clampi(kcol - qcol, -15, 15) + 15;
                    S[kt][rg] = ok ? S[kt][rg] + rpbl[h * 465 + drow * 31 + dcol] : -1.0e30f; } } }
        float m = S[0][0];
#pragma unroll
        for (int kt = 0; kt < 16; ++kt) m = fmaxf(fmaxf(m, fmaxf(S[kt][0], S[kt][1])), fmaxf(S[kt][2], S[kt][3]));
        m = fmaxf(m, __shfl_xor(m, 16)); m = fmaxf(m, __shfl_xor(m, 32));
        float ls = 0.f;
#pragma unroll
        for (int kt = 0; kt < 16; ++kt) {
#pragma unroll
            for (int rg = 0; rg < 4; ++rg) { const float p = __expf(S[kt][rg] - m); S[kt][rg] = p; ls += p; } }
        ls += __shfl_xor(ls, 16); ls += __shfl_xor(ls, 32);
#pragma unroll
        for (int c = 0; c < 4; ++c) {
#pragma unroll
            for (int i = 0; i < 8; ++i) { const int p = i * 64 + lane, key = p >> 3, seg = p & 7, kk = c * 64 + key;
                const size_t vrow = part == 0 ? (size_t)(b * SEQ + (kr0 + (kk >> 5)) * 64 + kc0 + (kk & 31)) : (size_t)(ML + b * CTXL + kk);
                *(LAS v4u*)(vbuf + key * 128 + ((((seg >> 1) ^ ((key >> 1) & 3))) << 5) + ((seg & 1) << 4)) = *(const v4u*)(VV + vrow * 256 + h * 64 + seg * 8); }
#pragma unroll
            for (int ksl = 0; ksl < 2; ++ksl) { const int ks = 2 * c + ksl;
                v4u pw; pw.x = pk2(S[2 * ks][0], S[2 * ks][1]); pw.y = pk2(S[2 * ks][2], S[2 * ks][3]); pw.z = pk2(S[2 * ks + 1][0], S[2 * ks + 1][1]); pw.w = pk2(S[2 * ks + 1][2], S[2 * ks + 1][3]);
                const bf16x8 pf = __builtin_bit_cast(bf16x8, pw);
#pragma unroll
                for (int dt = 0; dt < 4; ++dt) { v4i16_t t0, t1;
                    { const int key = ksl * 32 + 4 * fq + (fr >> 2); t0 = __builtin_amdgcn_ds_read_tr16_b64_v4i16((LAS v4i16_t*)(vbuf + key * 128 + ((dt ^ ((key >> 1) & 3)) << 5) + (fr & 3) * 8)); }
                    { const int key = ksl * 32 + 16 + 4 * fq + (fr >> 2); t1 = __builtin_amdgcn_ds_read_tr16_b64_v4i16((LAS v4i16_t*)(vbuf + key * 128 + ((dt ^ ((key >> 1) & 3)) << 5) + (fr & 3) * 8)); }
                    const bf16x8 vf = (bf16x8){t0[0], t0[1], t0[2], t0[3], t1[0], t1[1], t1[2], t1[3]};
                    mfma16(O[dt], vf, pf); } }
        }
        DRAIN4(O);
        m_run = m; l_run = ls;
    }
    if (part == 1) {
#pragma unroll
        for (int dt = 0; dt < 4; ++dt) *(LAS f32x4*)(mrg + fr * 64 + dt * 16 + 4 * fq) = O[dt];
        if (fq == 0) { mrg[1024 + fr] = m_run; mrg[1040 + fr] = l_run; }
    }
    __syncthreads();
    if (part == 0) {
        const float m1 = mrg[1024 + fr], l1 = mrg[1040 + fr], M = fmaxf(m_run, m1), a0 = __expf(m_run - M), a1 = __expf(m1 - M), inv = 1.f / (l_run * a0 + l1 * a1);
#pragma unroll
        for (int dt = 0; dt < 4; ++dt) { const f32x4 o1 = *(const LAS f32x4*)(mrg + fr * 64 + dt * 16 + 4 * fq);
            st4bf(BRd + (size_t)(qrow0 + fr) * 256 + h * 64 + dt * 16 + 4 * fq, (O[dt] * a0 + o1 * a1) * inv); }
    }
    __syncthreads();
}
__device__ __forceinline__ int block_excl_scan(int v, LAS int* ws8, int lane, int wave) {
    int x = v;
#pragma unroll
    for (int o = 1; o < 64; o <<= 1) { const int y = __shfl_up(x, o); if (lane >= o) x += y; }
    if (lane == 63) ws8[wave] = x;
    __syncthreads();
    int base = 0;
#pragma unroll
    for (int w = 0; w < 8; ++w) base += (w < wave) ? ws8[w] : 0;
    __syncthreads();
    return base + x - v;
}
template <int PER, bool ALLV>
__device__ __forceinline__ void topk_unit(PH_ARGS, const int rowbase, const int n, const int C, const int e, const int sbase, const bool writepad) {
    const float* AFF = WSP(float, WS_AFF); int* SEL = WSP(int, WS_SEL); int* IDX = WSP(int, WS_IDX); float* GATE = WSP(float, WS_GATE);
    LAS unsigned* hist = (LAS unsigned*)lds; LAS unsigned* sh = hist + 256; LAS int* ws8 = (LAS int*)(hist + 272);
    unsigned key[PER]; bool valid[PER];
#pragma unroll
    for (int i = 0; i < PER; ++i) { const int tok = tid * PER + i; valid[i] = ALLV ? true : (tok < n); key[i] = valid[i] ? __float_as_uint(AFF[(size_t)(rowbase + tok) * 16 + e]) : 0u; }
    unsigned prefix = 0u, mask = 0u, rem = (unsigned)C;
#pragma unroll 1
    for (int pass = 0; pass < 4; ++pass) { const int shift = 24 - 8 * pass;
        if (tid < 256) hist[tid] = 0u;
        __syncthreads();
#pragma unroll
        for (int i = 0; i < PER; ++i) if (valid[i] && (key[i] & mask) == prefix) atomicAdd((unsigned*)&hist[(key[i] >> shift) & 255u], 1u);
        __syncthreads();
        if (wave == 0) { unsigned c0 = hist[255 - 4 * lane], c1 = hist[254 - 4 * lane], c2 = hist[253 - 4 * lane], c3 = hist[252 - 4 * lane];
            const unsigned s = c0 + c1 + c2 + c3; unsigned x = s;
#pragma unroll
            for (int o = 1; o < 64; o <<= 1) { const unsigned y = __shfl_up(x, o); if (lane >= o) x += y; }
            const unsigned excl = x - s;
            if (excl < rem && rem <= x) { unsigned cum = excl; int bin; unsigned nr;
                if (cum + c0 >= rem) { bin = 255 - 4 * lane; nr = rem - cum; }
                else { cum += c0; if (cum + c1 >= rem) { bin = 254 - 4 * lane; nr = rem - cum; }
                else { cum += c1; if (cum + c2 >= rem) { bin = 253 - 4 * lane; nr = rem - cum; }
                else { cum += c2; bin = 252 - 4 * lane; nr = rem - cum; } } }
                sh[0] = (unsigned)bin; sh[1] = nr; } }
        __syncthreads();
        prefix |= sh[0] << shift; mask |= 255u << shift; rem = sh[1];
    }
    __syncthreads();
    const unsigned T = prefix;
    int neq = 0;
#pragma unroll
    for (int i = 0; i < PER; ++i) neq += (valid[i] && key[i] == T) ? 1 : 0;
    const int eqbase = block_excl_scan(neq, ws8, lane, wave);
    unsigned take = 0u; int nsel = 0, eqs = 0;
#pragma unroll
    for (int i = 0; i < PER; ++i) { const bool iseq = valid[i] && key[i] == T; const bool tk = valid[i] && (key[i] > T || (iseq && (unsigned)(eqbase + eqs) < rem)); eqs += iseq ? 1 : 0; if (tk) { take |= 1u << i; ++nsel; } }
    const int sb = block_excl_scan(nsel, ws8, lane, wave);
    int cnt = 0;
#pragma unroll
    for (int i = 0; i < PER; ++i) { const int tok = tid * PER + i;
        if (valid[i]) { if ((take >> i) & 1u) { const int slot = sbase + sb + cnt; ++cnt; IDX[e * ESTR + slot] = rowbase + tok; GATE[e * ESTR + slot] = __uint_as_float(key[i]); SEL[(size_t)(rowbase + tok) * 16 + e] = slot; }
                        else SEL[(size_t)(rowbase + tok) * 16 + e] = -1; } }
    if (writepad) for (int i = tid; i < ESTR - 2112; i += 512) { IDX[e * ESTR + 2112 + i] = 0; GATE[e * ESTR + 2112 + i] = 0.f; }
    __syncthreads();
}
__device__ __forceinline__ void gather_rows(PH_ARGS, const int tpe) {
    const int gw = bid * 8 + wave, NGW = G * 8, per = tpe * 256; const int* IDX = WSP(int, WS_IDX); const bf16* H = WSP(bf16, WS_H); bf16* XE = WSP(bf16, WS_XE);
    for (int i = gw; i < NE * per; i += NGW) { const int e = i / per, s = i % per, rg = e * ESTR + s; const int src = IDX[rg];
        const v4u a = *(const v4u*)(H + (size_t)src * 1024 + lane * 8), b = *(const v4u*)(H + (size_t)src * 1024 + 512 + lane * 8);
        *(v4u*)(XE + (size_t)rg * 1024 + lane * 8) = a; *(v4u*)(XE + (size_t)rg * 1024 + 512 + lane * 8) = b; }
}
__device__ __forceinline__ void combine_rows(PH_ARGS, const int l) {
    const int gw = bid * 8 + wave, NGW = G * 8; const int nrows = l == 0 ? MT : ML;
    const int* SEL = WSP(int, WS_SEL); const bf16* YB = WSP(bf16, WS_XE); float* X = WSP(float, WS_X); bf16* H = WSP(bf16, WS_H); const float* MOD = WSP(float, WS_MOD);
    for (int row = gw; row < nrows; row += NGW) {
        const int r = row < SEQ ? 0 : (row < ML ? 1 : 2);
        float acc[2][8];
#pragma unroll
        for (int j = 0; j < 2; ++j)
#pragma unroll
            for (int i = 0; i < 8; ++i) acc[j][i] = 0.f;
        const int myslot = lane < 16 ? SEL[(size_t)row * 16 + lane] : -1;
#pragma unroll
        for (int e = 0; e < 16; ++e) { const int s = __shfl(myslot, e);
            if (s >= 0) { const bf16* y = YB + (size_t)(e * ESTR + s) * 1024 + lane * 8;
#pragma unroll
                for (int j = 0; j < 2; ++j) { const v4u w = *(const v4u*)(y + 512 * j);
                    acc[j][0] += bflo(w.x); acc[j][1] += bfhi(w.x); acc[j][2] += bflo(w.y); acc[j][3] += bfhi(w.y); acc[j][4] += bflo(w.z); acc[j][5] += bfhi(w.z); acc[j][6] += bflo(w.w); acc[j][7] += bfhi(w.w); } } }
        const float* gt2 = MOD + (l * 3 + r) * 6144 + 5 * 1024; float* xr = X + (size_t)row * 1024;
        float xv[2][8]; float ss = 0.f;
#pragma unroll
        for (int j = 0; j < 2; ++j) { const int o = 8 * lane + 512 * j; const f32x4 x0 = *(const f32x4*)(xr + o), x1 = *(const f32x4*)(xr + o + 4), g0 = *(const f32x4*)(gt2 + o), g1 = *(const f32x4*)(gt2 + o + 4);
#pragma unroll
            for (int i = 0; i < 4; ++i) { xv[j][i] = x0[i] + g0[i] * acc[j][i]; xv[j][4 + i] = x1[i] + g1[i] * acc[j][4 + i]; }
#pragma unroll
            for (int i = 0; i < 8; ++i) ss += xv[j][i] * xv[j][i]; }
        const float rs = 1.0f / sqrtf(wave_sum(ss) * (1.f / 1024.f) + 1e-6f);
        if (l == 0) {
            const float* md = MOD + (1 * 3 + r) * 6144; const float* g = INP(6) + 1024;
#pragma unroll
            for (int j = 0; j < 2; ++j) { const int o = 8 * lane + 512 * j;
                *(f32x4*)(xr + o) = (f32x4){xv[j][0], xv[j][1], xv[j][2], xv[j][3]}; *(f32x4*)(xr + o + 4) = (f32x4){xv[j][4], xv[j][5], xv[j][6], xv[j][7]};
                float hv[8];
#pragma unroll
                for (int i = 0; i < 8; ++i) hv[i] = xv[j][i] * rs * g[o + i] * (1.f + md[1024 + o + i]) + md[o + i];
                v4u w; w.x = pk2(hv[0], hv[1]); w.y = pk2(hv[2], hv[3]); w.z = pk2(hv[4], hv[5]); w.w = pk2(hv[6], hv[7]);
                *(v4u*)(H + (size_t)row * 1024 + o) = w; }
        } else {
            const float* g = INP(27); float* orow = PTRV(28, float) + (size_t)row * 1024;
#pragma unroll
            for (int j = 0; j < 2; ++j) { const int o = 8 * lane + 512 * j;
                *(f32x4*)(orow + o) = (f32x4){xv[j][0] * rs * g[o + 0], xv[j][1] * rs * g[o + 1], xv[j][2] * rs * g[o + 2], xv[j][3] * rs * g[o + 3]};
                *(f32x4*)(orow + o + 4) = (f32x4){xv[j][4] * rs * g[o + 4], xv[j][5] * rs * g[o + 5], xv[j][6] * rs * g[o + 6], xv[j][7] * rs * g[o + 7]}; }
        }
    }
}


#ifdef DBG_STOP
__device__ __forceinline__ void debug_out(PH_ARGS) {
    float* out = PTRV(28, float);
    const int gt = bid * 512 + tid, GT = G * 512;
    for (size_t i = gt; i < (size_t)ML * 1024; i += GT) { const size_t row = i >> 10; const int c = (int)(i & 1023); float v = 0.f;
#if DBG_STOP == 2
        v = bflo(WSP(bf16, WS_H)[row * 1024 + c]) + WSP(float, WS_MOD)[(i % 36864)] + bflo(WSP(bf16, WS_WIN)[i % (6400 * 1024)]) + bflo(WSP(bf16, WS_WGU)[i]) + bflo(WSP(bf16, WS_WDN)[i]) + bflo(WSP(bf16, WS_WO)[i % (1024*1024)]) + bflo(WSP(bf16, WS_WBR)[i % (1024*1024)]);
#elif DBG_STOP == 3
        v = bflo(WSP(bf16, WS_AUV)[row * 512 + (c & 511)]) + bflo(WSP(bf16, WS_YF)[row * 512 + (c & 511)]) + bflo(WSP(bf16, WS_CY)[row * 256 + (c & 255)]) + bflo(WSP(bf16, WS_QPL)[row * 256 + (c & 255)])
          + bflo(WSP(bf16, WS_QROT)[row * 256 + (c & 255)]) + bflo(WSP(bf16, WS_KR)[row * 256 + (c & 255)]) + bflo(WSP(bf16, WS_VV)[row * 256 + (c & 255)])
          + bflo(WSP(bf16, WS_G)[row * 4096 + c]) + bflo(WSP(bf16, WS_G)[row * 4096 + 1024 + c]) + bflo(WSP(bf16, WS_G)[row * 4096 + 2048 + c]) + bflo(WSP(bf16, WS_G)[row * 4096 + 3072 + c]);
#elif DBG_STOP == 4
        v = bflo(WSP(bf16, WS_BR)[(size_t)(0 * MT + row) * 256 + (c & 255)]) + bflo(WSP(bf16, WS_BR)[(size_t)(2 * MT + row) * 256 + (c & 255)]) + bflo(WSP(bf16, WS_FA)[i % ((size_t)8 << 20)]);
#elif DBG_STOP == 21
        v = bflo(WSP(bf16, WS_T1T)[i % 16384]) * 1.001f + bflo(WSP(bf16, WS_T2T)[i % 32768]) * 1.003f + WSP(float, WS_TW)[i % 16384] + WSP(float, WS_ROPEC)[i % 2048] + WSP(float, WS_ROPES)[i % 2048] + WSP(float, WS_CS256)[i % 512] + bflo(WSP(bf16, WS_WSP)[i % 65536]);
#elif DBG_STOP == 31 || DBG_STOP == 44
        v = WSP(float, WS_TW)[i % 16384] * 1.001f + WSP(float, WS_TW)[(i + 5) % 16384];
#elif DBG_STOP == 45 || DBG_STOP == 32
        { const int e2 = (int)(i % 16384), j = e2 >> 1, k1 = j >> 7, n2 = j & 127; float s, c; sincospif((float)(k1 * n2) / 4096.f, &s, &c); v = (WSP(float, WS_TW)[e2] - ((e2 & 1) ? s : c)) * 1.0e6f; }
#elif DBG_STOP == 41
        v = bflo(WSP(bf16, WS_BR)[(size_t)(0 * MT + row) * 256 + (c & 255)]) * 1.001f + bflo(WSP(bf16, WS_BR)[(size_t)(0 * MT + row) * 256 + ((c + 7) & 255)]);
#elif DBG_STOP == 42
        v = bflo(WSP(bf16, WS_BR)[(size_t)(2 * MT + row) * 256 + (c & 255)]) * 1.001f + bflo(WSP(bf16, WS_BR)[(size_t)(2 * MT + row) * 256 + ((c + 7) & 255)]);
#elif DBG_STOP == 43
        v = bflo(WSP(bf16, WS_FA)[i % ((size_t)8 << 20)]) * 1.001f + bflo(WSP(bf16, WS_FA)[(i + 7) % ((size_t)8 << 20)]);
#elif DBG_STOP == 5
        v = bflo(WSP(bf16, WS_BR)[(size_t)(1 * MT + row) * 256 + (c & 255)]) + bflo(WSP(bf16, WS_BR)[(size_t)(3 * MT + row) * 256 + (c & 255)]);
#elif DBG_STOP == 6
        v = bflo(WSP(bf16, WS_MB)[row * 1024 + c]);
#elif DBG_STOP == 7
        v = WSP(float, WS_X)[row * 1024 + c];
#elif DBG_STOP == 8
        v = bflo(WSP(bf16, WS_H)[row * 1024 + c]) + WSP(float, WS_AFF)[row * 16 + (c & 15)];
#elif DBG_STOP == 9
        v = (float)WSP(int, WS_SEL)[row * 16 + (c & 15)] + WSP(float, WS_GATE)[i % (16 * 2304)] + (float)WSP(int, WS_IDX)[i % (16 * 2304)];
#elif DBG_STOP == 10
        v = bflo(WSP(bf16, WS_XE)[i]) + bflo(WSP(bf16, WS_XE)[i + (size_t)ML * 1024]);
#elif DBG_STOP == 11
        v = bflo(WSP(bf16, WS_ACT)[i]) + bflo(WSP(bf16, WS_ACT)[i + (size_t)ML * 1024]);
#elif DBG_STOP == 12
        v = bflo(WSP(bf16, WS_XE)[i]) + bflo(WSP(bf16, WS_XE)[i + (size_t)ML * 1024]);
#else
        v = WSP(float, WS_X)[row * 1024 + c] + bflo(WSP(bf16, WS_H)[row * 1024 + c]);
#endif
#ifdef DBG_AMP
        v = (float)(__float_as_uint(v) & 0xFFFFu);
#endif
        out[i] = v; }
}
#endif
__global__ void __launch_bounds__(512, 2) mega(Args A) {
    extern __shared__ __attribute__((aligned(16))) unsigned char lds_raw[];
    LAS unsigned char* lds0 = (LAS unsigned char*)lds_raw;
    volatile LAS unsigned* MISC = (volatile LAS unsigned*)(lds0 + MISC_OFF);
    const int tid = threadIdx.x, lane = tid & 63, wave = __builtin_amdgcn_readfirstlane(tid >> 6), bid = blockIdx.x, G = gridDim.x;
    for (int u = tid; u < (LDS_BYTES - MISC_OFF) / 4; u += 512) ((LAS unsigned*)(lds0 + MISC_OFF))[u] = 0u;
    __syncthreads();
    if (tid == 0) { typedef unsigned u2v_t __attribute__((ext_vector_type(2)));
#pragma unroll
        for (int i = 0; i < 30; ++i) { const unsigned long long p = i < 28 ? (unsigned long long)A.in[i] : (i == 28 ? (unsigned long long)A.out : (unsigned long long)A.ws);
            *(LAS u2v_t*)(lds0 + PTAB_OFF + 8 * i) = (u2v_t){(unsigned)p, (unsigned)(p >> 32)}; } }
    __syncthreads();
    const int lo = A.ph_lo, hi = A.ph_hi;
    XcdBarrier bar; bar.bar = (unsigned*)(A.ws + WS_CTL) + CW_BAR; bar.x = 0; bar.st = nullptr;
    if (hi - lo > 1) bar = xcd_barrier_post((unsigned*)(A.ws + WS_CTL) + CW_BAR, MISC + 8);
#define PH_CALL lds, tl_, (tl_ & 63), wv_, bl_, G_
#pragma unroll 1
    for (int ph = lo; ph < hi; ++ph) {
        int tl_ = tid; asm volatile("" : "+v"(tl_)); int bl_ = bid; asm volatile("" : "+s"(bl_)); int wv_ = wave; asm volatile("" : "+s"(wv_)); int G_ = G; asm volatile("" : "+s"(G_)); unsigned ldsb_ = (unsigned)(uintptr_t)lds0; asm volatile("" : "+s"(ldsb_)); LAS unsigned char* lds = (LAS unsigned char*)(uintptr_t)ldsb_;
        const int l = ph < 13 ? 0 : 1, kind = ph >= 99 ? 99 : (ph < 2 ? ph : 2 + (ph - 2 - 11 * l));
        const int ntm = l == 0 ? 66 : 64, tpe = l == 0 ? 9 : 8;
        switch (kind) {
#ifdef DBG_STOP
        case 99: debug_out(PH_CALL); break;
#endif
        case 0: {
#ifndef DIS_MOD
            mod_gemv(PH_CALL); make_tables(PH_CALL);
#endif
#ifndef DIS_CVT
            convert_weights(PH_CALL, 0);
#endif
        } break;
        case 1: {
#ifndef DIS_N1
            norm1_l0(PH_CALL);
#endif
        } break;
        case 2: {
            pg8::Gemm g{WSP(bf16, WS_H), WSP(bf16, WS_WIN), MT, NIN, 1024}; pg8::StaticOrder S; S.init(MT, NIN, G_, bl_);
            EpiIn E{WSP(bf16, WS_AUV), WSP(bf16, WS_YF), WSP(bf16, WS_CY), WSP(bf16, WS_QPL), WSP(bf16, WS_QROT), WSP(bf16, WS_KR), WSP(bf16, WS_VV), WSP(bf16, WS_G), WSP(float, WS_ROPEC), WSP(float, WS_ROPES)};
#ifndef DIS_GIN
            pg8::gemm_phase<EpiIn, pg8::StaticOrder, true, true>(lds, g, S, E);
#endif
        } break;
        case 3: {
#ifndef DIS_F1
            if (bl_ < 256) { f1_stage_tables(PH_CALL); for (int u = bl_; u < 256; u += G_) f1_unit(PH_CALL, u); }
#endif
            const int nconv = l == 0 ? 264 : 256, ngm = l == 0 ? 132 : 128;
#ifndef DIS_CONV
            for (int u = bl_; u < nconv; u += G_) conv_unit(PH_CALL, l, u);
#endif
#ifndef DIS_GMLP
            for (int u = G_ - 1 - bl_; u < ngm; u += G_) gmlp_unit(PH_CALL, l, u);
#endif
#ifndef DIS_CDFT
            if (l == 0) for (int u = bl_; u < 256; u += G_) ctxdft_unit(PH_CALL, u);
#endif
        } break;
        case 4: {
#ifndef DIS_F2
            if (bl_ < 256) { f2_stage_tables(PH_CALL); for (int u = bl_; u < 256; u += G_) f2_unit(PH_CALL, u); }
#endif
            { LAS float* rp = (LAS float*)(lds + AT_RPB); const float* src = INP(20) + l * 1860; for (int i = tl_; i < 1860; i += 512) rp[i] = src[i]; }
            __syncthreads();
            const int nat = l == 0 ? 1056 : 1024;
#ifndef DIS_ATT
            for (int u = bl_; u < nat; u += G_) attn_unit(PH_CALL, u);
#endif
        } break;
        case 5: {
            pg8::Gemm g{WSP(bf16, WS_BR), WSP(bf16, WS_WBR), 4 * MT, 4096, 256}; MergeOrder S; S.init(ntm, G_, bl_);
            EpiMerge E{WSP(bf16, WS_G), WSP(float, WS_P32), WSP(bf16, WS_MB)};
#ifndef DIS_GMRG
            pg8::gemm_phase<EpiMerge, MergeOrder, true, true>(lds, g, S, E);
#endif
        } break;
        case 6: {
            pg8::Gemm g{WSP(bf16, WS_MB), WSP(bf16, WS_WO), ntm * 256, 1024, 1024}; pg8::StaticOrder S; S.init(ntm * 256, 1024, G_, bl_);
            EpiWout E{l == 0 ? INP(0) : WSP(float, WS_X), l == 0 ? INP(2) : WSP(float, WS_X) + (size_t)ML * 1024, WSP(float, WS_X), WSP(float, WS_MOD) + l * 3 * 6144};
#ifndef DIS_GWO
            pg8::gemm_phase<EpiWout, pg8::StaticOrder, true, true>(lds, g, S, E);
#endif
        } break;
        case 7: {
#ifndef DIS_N2
            norm2_router(PH_CALL, l, ntm * 256);
#endif
        } break;
        case 8: {
#ifndef DIS_TOPK
            const int nun = l == 0 ? 64 : 32;
            for (int u = bl_; u < nun; u += G_) {
                if (u < 32) { const int b = u >> 4, e = u & 15; topk_unit<16, true>(PH_CALL, b * SEQ, SEQ, CAPL, e, b * CAPL, l == 0 && b == 0); }
                else { const int b = (u - 32) >> 4, e = u & 15; topk_unit<1, false>(PH_CALL, ML + b * CTXL, CTXL, CAPC, e, 2048 + b * CAPC, false); }
            }
#endif
        } break;
        case 9: {
#ifndef DIS_GATH
            gather_rows(PH_CALL, tpe);
#endif
        } break;
        case 10: {
            pg8::Gemm g{WSP(bf16, WS_XE), WSP(bf16, WS_WGU), NE * ESTR, NE * 2048, 1024}; GroupOrder S; S.init(tpe, 8, G_, bl_);
            EpiGU E{WSP(bf16, WS_ACT)};
#ifndef DIS_GGU
            pg8::gemm_phase<EpiGU, GroupOrder, true, true>(lds, g, S, E);
#endif
        } break;
        case 11: {
            pg8::Gemm g{WSP(bf16, WS_ACT), WSP(bf16, WS_WDN), NE * ESTR, NE * 1024, 1024}; GroupOrder S; S.init(tpe, 4, G_, bl_);
            EpiDown E{WSP(bf16, WS_XE), WSP(float, WS_GATE)};
#ifndef DIS_GDN
            pg8::gemm_phase<EpiDown, GroupOrder, true, true>(lds, g, S, E);
#endif
        } break;
        default: {
#ifndef DIS_COMB
            combine_rows(PH_CALL, l);
#endif
#ifndef DIS_CVT
            if (l == 0) convert_weights(PH_CALL, 1);
#endif
        } break;
        }
        if (ph + 1 < hi) { XcdBarrier b2 = bar; b2.bar = (unsigned*)(PTRV(29, unsigned char) + WS_CTL) + CW_BAR; unsigned bx_ = bar.x; asm volatile("" : "+s"(bx_)); b2.x = bx_; b2.st = (volatile LAS unsigned*)(lds + MISC_OFF) + 8; xcd_barrier(b2); }
    }
}

extern "C" void kernel_launch(void* const* d_in, const int* in_sizes, int n_in, void* d_out, int out_size, void* d_ws, size_t ws_size, hipStream_t stream) {
    static int grid = 0;
    if (grid == 0) {
        if (n_in != 28 || ws_size < WS_END) { fprintf(stderr, "kernel_launch: unexpected n_in %d / ws %zu\n", n_in, ws_size); grid = -1; return; }
        int dev = 0, cus = 0;
        if (hipGetDevice(&dev) != hipSuccess || hipDeviceGetAttribute(&cus, hipDeviceAttributeMultiprocessorCount, dev) != hipSuccess) { grid = -1; return; }
        if (hipFuncSetAttribute((const void*)mega, hipFuncAttributeMaxDynamicSharedMemorySize, LDS_BYTES) != hipSuccess) { fprintf(stderr, "kernel_launch: hipFuncSetAttribute failed\n"); grid = -1; return; }
        (void)hipGetLastError();
        grid = cus;
    }
    if (grid < 0) return;
    (void)hipMemsetAsync((char*)d_ws + WS_CTL, 0, CTL_ZERO_BYTES, stream);
    Args a{};
    for (int i = 0; i < 28; ++i) a.in[i] = (const float*)d_in[i];
    a.out = (float*)d_out; a.ws = (unsigned char*)d_ws;
#ifdef DBG_STOP
    for (int p = 0; p < (DBG_STOP > 20 ? DBG_STOP / 10 : DBG_STOP); ++p) { a.ph_lo = p; a.ph_hi = p + 1; hipLaunchKernelGGL(mega, dim3(grid), dim3(512), LDS_BYTES, stream, a); }
    a.ph_lo = 99; a.ph_hi = 100; hipLaunchKernelGGL(mega, dim3(grid), dim3(512), LDS_BYTES, stream, a);
#elif N_LAUNCHES == 1
    a.ph_lo = 0; a.ph_hi = NPH;
    hipLaunchKernelGGL(mega, dim3(grid), dim3(512), LDS_BYTES, stream, a);
#else
    for (int p = 0; p < NPH; ++p) { a.ph_lo = p; a.ph_hi = p + 1; hipLaunchKernelGGL(mega, dim3(grid), dim3(512), LDS_BYTES, stream, a); }
#endif
}
```

```cpp
#include <hip/hip_runtime.h>
#include <cstdio>
#include <cstdint>
#define N_LAUNCHES 1
namespace pg8 {
#define PG8_LAS __attribute__((address_space(3)))
typedef unsigned short bf16_t;
typedef short bf16x8 __attribute__((ext_vector_type(8)));
typedef float f32x4 __attribute__((ext_vector_type(4)));
typedef unsigned u32x4 __attribute__((ext_vector_type(4)));
constexpr int BM = 256, BK = 64, HALF = 128, HTB = HALF * BK * 2  , STAGE_BYTES = 8 * HTB, NXCD = 8, WGM = 8;

__host__ __device__ __forceinline__ int lds_byte(int r, int c) { const int st = (r >> 4) * 2 + (c >> 5), rr = r & 15, cc = c & 31, ob = rr * 64 + cc * 2; return st * 1024 + (ob ^ (((ob >> 9) & 1) << 5)); }
__host__ __device__ __forceinline__ void stage_rc(int b, int& R, int& C) { const int st = b / 1024, sb = b % 1024, swz = sb ^ (((sb >> 9) & 1) << 5); R = (st >> 1) * 16 + swz / 64; C = (st & 1) * 32 + (swz % 64) / 2; }
__host__ __device__ __forceinline__ int perm32(int rho) { const int n = rho >> 4, i = rho & 15; return 8 * (i >> 2) + 4 * n + (i & 3); }

struct Unit { int pm, pn; };
struct Gemm { const bf16_t* A; const bf16_t* Bt; int M, N, K; };

struct StaticOrder {
    int nM, nN, nwg, G, c;
    __host__ __device__ void init(int M, int N, int G_, int c_) { nM = M / BM; nN = N / BM; nwg = nM * nN; G = G_; c = c_; }
    __host__ __device__ bool next(int i, Unit& u) const {
        const long L = (long)i * G + c; if (L >= nwg) return false;
        int wgid = (int)L; { const int q = nwg / NXCD, r = nwg % NXCD, xcd = wgid % NXCD, off = wgid / NXCD; wgid = (xcd < r ? xcd * (q + 1) : r * (q + 1) + (xcd - r) * q) + off; }
        const int nig = WGM * nN, gid = wgid / nig, fm = gid * WGM, gsz = (nM - fm) < WGM ? (nM - fm) : WGM;
        u.pm = fm + ((wgid % nig) % gsz); u.pn = (wgid % nig) / gsz; return true;
    }
    __device__ __forceinline__ void a_ready(const Unit&) const {}
    __device__ __forceinline__ void done(const Unit&) const {}
};
__device__ __forceinline__ unsigned cvt_pk_bf16(float lo, float hi) { unsigned r; asm volatile("v_cvt_pk_bf16_f32 %0, %1, %2" : "=v"(r) : "v"(lo), "v"(hi)); return r; }
typedef float f32x2 __attribute__((ext_vector_type(2)));
template <class Epi, class Sched, bool ALIGN_EPI = false, bool SP2 = false>
__device__ __forceinline__ void gemm_phase(PG8_LAS unsigned char* lds, const Gemm g, const Sched& S, const Epi& E) {
    int tid_l = threadIdx.x; asm volatile("" : "+v"(tid_l));
    const int tid = tid_l, wid = __builtin_amdgcn_readfirstlane(tid >> 6), lane = tid & 63, wr = wid >> 2, wc = wid & 3, fr = lane & 15, fq = lane >> 4;
    const int K = g.K, nt = K / BK;
    unsigned voffA[2], voffB[2];
#pragma unroll
    for (int i = 0; i < 2; ++i) { int R, C; stage_rc(tid * 16 + i * 8192, R, C); const int Rb = Epi::PERM ? ((R & ~31) + perm32(R & 31)) : R;
        voffA[i] = (unsigned)(R * K + C) * 2u; voffB[i] = (unsigned)(Rb * K + C) * 2u; }
    const size_t kstep = (size_t)(BK * 2);
    const size_t hstep = (size_t)HALF * K * 2;
    const size_t tstep = 2 * hstep;
    const unsigned ldsw = (unsigned)wid * 1024u;
    const int aoff = lds_byte(wr * 64 + fr, fq * 8), boff = lds_byte(wc * 32 + fr, fq * 8);
#define PG8_SA(b, h) (((b) * 2 + (h)) * HTB)
#define PG8_SB(b, h) ((4 + (b) * 2 + (h)) * HTB)
#define PG8_STAGE(bufoff, gbase, voff) do { _Pragma("unroll") for (int _i = 0; _i < 2; ++_i) \
        __builtin_amdgcn_global_load_lds((const unsigned*)((const char*)(gbase) + (voff)[_i]), (PG8_LAS unsigned*)(lds + (bufoff) + ldsw + _i * 8192), 16, 0, 0); } while (0)
#define PG8_LDA(dst, b, h) do { _Pragma("unroll") for (int m = 0; m < 4; ++m) _Pragma("unroll") for (int k = 0; k < 2; ++k) dst[m][k] = *(const PG8_LAS bf16x8*)(lds + PG8_SA(b, h) + aoff + m * 2048 + k * 1024); } while (0)
#define PG8_LDB(dst, b, h) do { _Pragma("unroll") for (int n = 0; n < 2; ++n) _Pragma("unroll") for (int k = 0; k < 2; ++k) dst[n][k] = *(const PG8_LAS bf16x8*)(lds + PG8_SB(b, h) + boff + n * 2048 + k * 1024); } while (0)
#define PG8_MMA(ai, bj, At, Bt) do { __builtin_amdgcn_s_setprio(1); _Pragma("unroll") for (int m = 0; m < 4; ++m) _Pragma("unroll") for (int n = 0; n < 2; ++n) _Pragma("unroll") for (int k = 0; k < 2; ++k) \
        acc[ai][bj][m][n] = __builtin_amdgcn_mfma_f32_16x16x32_bf16(Bt[n][k], At[m][k], acc[ai][bj][m][n], 0, 0, 0); __builtin_amdgcn_s_setprio(0); } while (0)
#define PG8_WAIT_V(n) asm volatile("s_waitcnt vmcnt(" #n ")" ::: "memory")
#define PG8_WAIT_L(n) asm volatile("s_waitcnt lgkmcnt(" #n ")" ::: "memory")
#define PG8_BAR __builtin_amdgcn_s_barrier()
#define PG8_SCHED __builtin_amdgcn_sched_barrier(0)
    Unit cur, nxt; int ui = 0;
    if (!S.next(0, cur)) return;
    f32x4 acc[2][2][4][2];
#pragma unroll
    for (int a = 0; a < 2; ++a)
#pragma unroll
        for (int b = 0; b < 2; ++b)
#pragma unroll
            for (int m = 0; m < 4; ++m)
#pragma unroll
                for (int n = 0; n < 2; ++n) acc[a][b][m][n] = (f32x4){0.f, 0.f, 0.f, 0.f};
    bf16x8 At[4][2], B0[2][2], B1[2][2];
    const char* cA = (const char*)g.A + (size_t)cur.pm * tstep; const char* cB = (const char*)g.Bt + (size_t)cur.pn * tstep;
    S.a_ready(cur);
    if constexpr (SP2) {
        PG8_STAGE(PG8_SB(0, 0), cB, voffB); PG8_STAGE(PG8_SB(0, 1), cB + hstep, voffB); PG8_STAGE(PG8_SA(0, 0), cA, voffA); PG8_STAGE(PG8_SA(0, 1), cA + hstep, voffA);
        if (wr == 1) PG8_BAR;
        PG8_WAIT_V(2); PG8_BAR;
        PG8_STAGE(PG8_SB(1, 0), cB + kstep, voffB); PG8_STAGE(PG8_SA(1, 0), cA + kstep, voffA); PG8_STAGE(PG8_SB(1, 1), cB + hstep + kstep, voffB);
        PG8_WAIT_V(6); PG8_BAR;
    } else {
        PG8_STAGE(PG8_SB(0, 0), cB, voffB); PG8_STAGE(PG8_SA(0, 0), cA, voffA); PG8_STAGE(PG8_SB(0, 1), cB + hstep, voffB); PG8_STAGE(PG8_SA(0, 1), cA + hstep, voffA);
        if (wr == 1) PG8_BAR;
        PG8_WAIT_V(4); PG8_BAR;
        PG8_STAGE(PG8_SB(1, 0), cB + kstep, voffB); PG8_STAGE(PG8_SA(1, 0), cA + kstep, voffA); PG8_STAGE(PG8_SB(1, 1), cB + hstep + kstep, voffB);
        PG8_WAIT_V(6); PG8_BAR;
    }
    for (;;) {
        const bool has_next = S.next(ui + 1, nxt);
        const char* nA = has_next ? (const char*)g.A + (size_t)nxt.pm * tstep : cA; const char* nB = has_next ? (const char*)g.Bt + (size_t)nxt.pn * tstep : cB;
#pragma unroll 1
        for (int t = 0; t < nt; t += 2) {
            const bool last = (t == nt - 2);
            const char* a1 = cA + (size_t)(t + 1) * kstep;
            const char* a2 = last ? nA : cA + (size_t)(t + 2) * kstep; const char* b2 = last ? nB : cB + (size_t)(t + 2) * kstep;
            const char* a3 = a2 + kstep; const char* b3 = b2 + kstep;
            if (last && has_next) S.a_ready(nxt);
            if constexpr (SP2) {
            PG8_LDB(B0, 0, 0); PG8_LDB(B1, 0, 1); PG8_SCHED; PG8_LDA(At, 0, 0); PG8_STAGE(PG8_SA(1, 1), a1 + hstep, voffA);
            PG8_WAIT_V(8); PG8_WAIT_L(0); PG8_BAR; PG8_MMA(0, 0, At, B0); PG8_MMA(0, 1, At, B1); PG8_BAR; PG8_SCHED;
            PG8_LDA(At, 0, 1); PG8_STAGE(PG8_SB(0, 0), b2, voffB); PG8_STAGE(PG8_SB(0, 1), b2 + hstep, voffB); PG8_STAGE(PG8_SA(0, 0), a2, voffA);
            PG8_WAIT_V(8); PG8_WAIT_L(0); PG8_BAR; PG8_MMA(1, 0, At, B0); PG8_MMA(1, 1, At, B1); PG8_BAR; PG8_SCHED;
            PG8_LDB(B0, 1, 0); PG8_LDB(B1, 1, 1); PG8_SCHED; PG8_LDA(At, 1, 0); PG8_STAGE(PG8_SA(0, 1), a2 + hstep, voffA);
            PG8_WAIT_V(8); PG8_WAIT_L(0); PG8_BAR; PG8_MMA(0, 0, At, B0); PG8_MMA(0, 1, At, B1); PG8_BAR; PG8_SCHED;
            PG8_LDA(At, 1, 1); PG8_STAGE(PG8_SB(1, 0), b3, voffB); PG8_STAGE(PG8_SB(1, 1), b3 + hstep, voffB); PG8_STAGE(PG8_SA(1, 0), a3, voffA);
            PG8_WAIT_V(8); PG8_WAIT_L(0); PG8_BAR; PG8_MMA(1, 0, At, B0); PG8_MMA(1, 1, At, B1); PG8_BAR; PG8_SCHED;
            } else {
            PG8_LDB(B0, 0, 0); PG8_SCHED; PG8_LDA(At, 0, 0); PG8_STAGE(PG8_SA(1, 1), a1 + hstep, voffA);
            PG8_WAIT_L(8); PG8_BAR; PG8_WAIT_L(0); PG8_MMA(0, 0, At, B0); PG8_BAR; PG8_SCHED;
            PG8_LDB(B1, 0, 1); PG8_STAGE(PG8_SB(0, 0), b2, voffB);
            PG8_BAR; PG8_WAIT_L(0); PG8_MMA(0, 1, At, B1); PG8_BAR;
            PG8_LDA(At, 0, 1); PG8_STAGE(PG8_SA(0, 0), a2, voffA);
            PG8_BAR; PG8_WAIT_L(0); PG8_MMA(1, 0, At, B0); PG8_BAR; PG8_SCHED;
            PG8_STAGE(PG8_SB(0, 1), b2 + hstep, voffB);
            PG8_WAIT_V(6); PG8_BAR; PG8_MMA(1, 1, At, B1); PG8_BAR;
            PG8_LDB(B0, 1, 0); PG8_SCHED; PG8_LDA(At, 1, 0); PG8_STAGE(PG8_SA(0, 1), a2 + hstep, voffA);
            PG8_WAIT_L(8); PG8_BAR; PG8_WAIT_L(0); PG8_MMA(0, 0, At, B0); PG8_BAR; PG8_SCHED;
            PG8_LDB(B1, 1, 1); PG8_STAGE(PG8_SB(1, 0), b3, voffB);
            PG8_BAR; PG8_WAIT_L(0); PG8_MMA(0, 1, At, B1); PG8_BAR;
            PG8_LDA(At, 1, 1); PG8_STAGE(PG8_SA(1, 0), a3, voffA);
            PG8_BAR; PG8_WAIT_L(0); PG8_MMA(1, 0, At, B0); PG8_BAR; PG8_SCHED;
            PG8_STAGE(PG8_SB(1, 1), b3 + hstep, voffB);
            PG8_WAIT_V(6); PG8_BAR; PG8_MMA(1, 1, At, B1); PG8_BAR;
            }
        }
        if constexpr (ALIGN_EPI) { if (wr == 0) PG8_BAR; }
        if constexpr (!Epi::AFTER_DRAIN) { int t2_ = threadIdx.x; asm volatile("" : "+v"(t2_)); E(acc, cur, wr, wc, t2_ & 15, (t2_ >> 4) & 3); S.done(cur); }
        if (!has_next) break;
#pragma unroll
        for (int a = 0; a < 2; ++a)
#pragma unroll
            for (int b = 0; b < 2; ++b)
#pragma unroll
                for (int m = 0; m < 4; ++m)
#pragma unroll
                    for (int n = 0; n < 2; ++n) acc[a][b][m][n] = (f32x4){0.f, 0.f, 0.f, 0.f};
        cur = nxt; cA = nA; cB = nB; ++ui;
        if constexpr (ALIGN_EPI) { if (wr == 1) PG8_BAR; }
    }
    PG8_WAIT_V(0);
    if constexpr (!ALIGN_EPI) { if (wr == 0) PG8_BAR; }
    PG8_BAR;
    if constexpr (Epi::AFTER_DRAIN) { E.fused(acc, cur, wr, wc, fr, fq, lds, wid, lane); S.done(cur); }
#undef PG8_SA
#undef PG8_SB
#undef PG8_STAGE
#undef PG8_LDA
#undef PG8_LDB
#undef PG8_MMA
#undef PG8_WAIT_V
#undef PG8_WAIT_L
#undef PG8_BAR
#undef PG8_SCHED
}
}
#define GAS __attribute__((address_space(1)))
#define LAS __attribute__((address_space(3)))
typedef unsigned short bf16;
typedef unsigned v4u __attribute__((ext_vector_type(4)));
typedef float f32x4 __attribute__((ext_vector_type(4)));
typedef short bf16x8 __attribute__((ext_vector_type(8)));
typedef GAS unsigned gu32;
typedef GAS unsigned long long gu64;
#define RLX_AGENT __ATOMIC_RELAXED, __HIP_MEMORY_SCOPE_AGENT
#define LDS_WAIT() asm volatile("s_waitcnt lgkmcnt(0)" ::: "memory")
#define VM_WAIT() asm volatile("s_waitcnt vmcnt(0)" ::: "memory")
__device__ __forceinline__ unsigned long long rt() { return __builtin_amdgcn_s_memrealtime(); }
__device__ __forceinline__ unsigned f2bf(float f) { unsigned u = __builtin_bit_cast(unsigned, f); return (u + 0x7fffu + ((u >> 16) & 1u)) >> 16; }
__device__ __forceinline__ unsigned pk2(float lo, float hi) { return f2bf(lo) | (f2bf(hi) << 16); }

#define XB_TMO      128
#define XB_XCNT(j)  (256  + 64 * (j))
#define XB_XSUB(j)  (1280 + 64 * (j))
#define XB_XGEN(j)  (2304 + 64 * (j))
#define XB_TOP      3328
#define XB_TOPGEN   3392
#define XCD_BAR_WORDS 3456
#define XB_SPIN_CAP (1u << 18)

__device__ __forceinline__ unsigned xb_ld(unsigned* p)              { return __hip_atomic_load(p, __ATOMIC_RELAXED, __HIP_MEMORY_SCOPE_AGENT); }
__device__ __forceinline__ unsigned xb_add(unsigned* p, unsigned v) { return __hip_atomic_fetch_add(p, v, __ATOMIC_RELAXED, __HIP_MEMORY_SCOPE_AGENT); }
__device__ __forceinline__ unsigned xb_xcc_id() { return (unsigned)__builtin_amdgcn_s_getreg((3 << 11) | 20) & 0xFu; }
#define XB_SPIN(cond, bar) do { unsigned _sp = 0; while (cond) { __builtin_amdgcn_s_sleep(1); \
    if ((++_sp & 255u) == 0u) { if (xb_ld(&(bar)[XB_TMO])) break; if (_sp > XB_SPIN_CAP) { atomicAdd(&(bar)[XB_TMO], 1u); break; } } } } while (0)

struct XcdBarrier {
    unsigned* bar; unsigned x;
    volatile LAS unsigned* st;
};

__device__ __forceinline__ XcdBarrier xcd_barrier_post(unsigned* bar, volatile LAS unsigned* st) {
    XcdBarrier b; b.bar = bar; b.x = xb_xcc_id(); b.st = st;
    if (threadIdx.x == 0) (void)xb_add(&bar[XB_XCNT(b.x)], 1u);
    return b;
}
__device__ __forceinline__ void xcd_barrier_complete(unsigned* bar, unsigned x, unsigned& nloc, unsigned& nx) {
    const unsigned G = gridDim.x * gridDim.y * gridDim.z;
    unsigned sum, cnt, mine, sp = 0u;
    for (;;) {
        sum = 0u; cnt = 0u; mine = 0u;
#pragma unroll
        for (unsigned j = 0; j < 16; ++j) { const unsigned c = xb_ld(&bar[XB_XCNT(j)]); sum += c; cnt += (c > 0u) ? 1u : 0u; mine = (j == x) ? c : mine; }
        if (sum == G) break;
        __builtin_amdgcn_s_sleep(1);
        if ((++sp & 255u) == 0u) { if (xb_ld(&bar[XB_TMO])) break; if (sp > XB_SPIN_CAP) { atomicAdd(&bar[XB_TMO], 1u); break; } }
    }
    nloc = mine > 0u ? mine : 1u; nx = cnt > 0u ? cnt : 1u;
}

__device__ __forceinline__ void xcd_barrier(const XcdBarrier& b) {
    asm volatile("s_waitcnt vmcnt(0)" ::: "memory");
    __syncthreads();
    if (threadIdx.x == 0) {
        unsigned* bar = b.bar;
        __builtin_amdgcn_s_waitcnt(0);
        unsigned nloc = b.st[0], nx = b.st[1];
        if (nloc == 0u) { xcd_barrier_complete(bar, b.x, nloc, nx); b.st[0] = nloc; b.st[1] = nx; }
        const unsigned old = xb_add(&bar[XB_XSUB(b.x)], 1u);
        const unsigned gen = old / nloc;
        if (old + 1u == (gen + 1u) * nloc) {
            __builtin_amdgcn_fence(__ATOMIC_RELEASE, "agent");
            asm volatile("s_waitcnt vmcnt(0)" ::: "memory");
            const unsigned og = xb_add(&bar[XB_TOP], 1u);
            const unsigned tg = og / nx;
            if (og + 1u == (tg + 1u) * nx) xb_add(&bar[XB_TOPGEN], 1u);
            else XB_SPIN(xb_ld(&bar[XB_TOPGEN]) == tg, bar);
            __builtin_amdgcn_fence(__ATOMIC_ACQUIRE, "agent");
            xb_add(&bar[XB_XGEN(b.x)], 1u);
            asm volatile("s_waitcnt vmcnt(0)" ::: "memory");
        } else {
            XB_SPIN(xb_ld(&bar[XB_XGEN(b.x)]) == gen, bar);
            __builtin_amdgcn_fence(__ATOMIC_ACQUIRE, "agent");
            asm volatile("s_waitcnt vmcnt(0)" ::: "memory");
        }
    }
    __syncthreads();
}
constexpr int DM = 1024, SEQ = 8192, NBATCH = 2, CTXL = 256;
constexpr int ML = NBATCH * SEQ, MC = NBATCH * CTXL, MT = ML + MC;
constexpr int NIN = 6400;
constexpr int NE = 16, ESTR = 2304, CAPL = 1024, CAPC = 32;
constexpr int NPH = 24;
constexpr size_t MiB = 1u << 20;
constexpr size_t WS_CTL = 0, CTL_ZERO_BYTES = 1 * MiB;
constexpr size_t WS_MOD = 1 * MiB;
constexpr size_t WS_ROPEC = 1 * MiB + 256 * 1024, WS_ROPES = WS_ROPEC + 8192;
constexpr size_t WS_TW = 1 * MiB + 512 * 1024;
constexpr size_t WS_CS256 = 1 * MiB + 640 * 1024;
constexpr size_t WS_T1T = 2 * MiB;
constexpr size_t WS_T2T = 2 * MiB + 64 * 1024;
constexpr size_t WS_WSP = 2 * MiB + 256 * 1024;
constexpr size_t WS_AFF = 3 * MiB;
constexpr size_t WS_SEL = 5 * MiB;
constexpr size_t WS_IDX = 7 * MiB, WS_GATE = 7 * MiB + 256 * 1024;
constexpr size_t WS_WIN = 16 * MiB, WS_WBR = 29 * MiB, WS_WO = 31 * MiB, WS_WGU = 33 * MiB, WS_WDN = 97 * MiB;
constexpr size_t WS_X = 130 * MiB;
constexpr size_t WS_H = 196 * MiB;
constexpr size_t WS_BR = 229 * MiB;
constexpr size_t WS_MB = 262 * MiB;
constexpr size_t WS_FA = 295 * MiB;
constexpr size_t WS_Z = 311 * MiB;
constexpr size_t ZROW = (size_t)MT * 2;
constexpr size_t WS_AUV = WS_Z, WS_YF = WS_AUV + 512 * ZROW, WS_CY = WS_YF + 512 * ZROW, WS_QPL = WS_CY + 256 * ZROW, WS_QROT = WS_QPL + 256 * ZROW,
                 WS_KR = WS_QROT + 256 * ZROW, WS_VV = WS_KR + 256 * ZROW, WS_G = WS_VV + 256 * ZROW, WS_ZEND = WS_G + 4096 * ZROW;
constexpr size_t WS_P32 = WS_Z;
constexpr size_t WS_XE = WS_Z, WS_ACT = WS_Z + 72 * MiB;
constexpr size_t WS_END = 518 * MiB;
static_assert(WS_G == WS_P32 + (size_t)MT * 1024 * 4 + 8 * 256 * ZROW / 8 - 256 * ZROW || true, "");
static_assert(WS_ZEND <= WS_END && WS_ACT + 72 * MiB <= WS_ZEND && WS_P32 + (size_t)MT * 4096 <= WS_VV, "ws map");
constexpr int CW_BAR = 4096;
constexpr int LDS_BYTES = 155648, MISC_OFF = 154624;

struct Args { const float* in[28]; float* out; unsigned char* ws; int ph_lo, ph_hi; };

__device__ __forceinline__ float bflo(unsigned w) { return __uint_as_float(w << 16); }
__device__ __forceinline__ float bfhi(unsigned w) { return __uint_as_float(w & 0xffff0000u); }
__device__ __forceinline__ float sigm(float x) { return __builtin_amdgcn_rcpf(1.f + __expf(-x)); }
__device__ __forceinline__ float wave_sum(float v) {
#pragma unroll
    for (int o = 1; o < 64; o <<= 1) v += __shfl_xor(v, o);
    return v;
}
__device__ __forceinline__ void st4bf(bf16* p, f32x4 v) { uint2 w; w.x = pk2(v[0], v[1]); w.y = pk2(v[2], v[3]); *(uint2*)p = w; }

using pg8::Unit;
struct EpiIn {
    static constexpr bool PERM = false, AFTER_DRAIN = false;
    bf16 *AUV, *YF, *CY, *QPL, *QROT, *KR, *VV, *G; const float* ropeC; const float* ropeS;
    __device__ __forceinline__ void operator()(const f32x4 (&acc)[2][2][4][2], const Unit& u, int wr, int wc, int fr, int fq) const {
        const int pn = u.pn, row0 = u.pm * 256 + wr * 64 + fr, cl0 = wc * 32 + 4 * fq;
        if (pn < 2) {
#pragma unroll
            for (int ai = 0; ai < 2; ++ai)
#pragma unroll
                for (int m = 0; m < 4; ++m) { const size_t row = row0 + ai * 128 + m * 16;
#pragma unroll
                    for (int bj = 0; bj < 2; ++bj)
#pragma unroll
                        for (int n = 0; n < 2; ++n) { f32x4 v = acc[ai][bj][m][n];
#pragma unroll
                            for (int j = 0; j < 4; ++j) { const float x = v[j]; v[j] = x * sigm(1.5957691216f * (x + 0.044715f * x * x * x)); }
                            st4bf(AUV + row * 512 + pn * 256 + bj * 128 + cl0 + n * 16, v); } }
        } else if (pn < 4) {
#pragma unroll
            for (int ai = 0; ai < 2; ++ai)
#pragma unroll
                for (int m = 0; m < 4; ++m) { const size_t row = row0 + ai * 128 + m * 16;
#pragma unroll
                    for (int bj = 0; bj < 2; ++bj)
#pragma unroll
                        for (int n = 0; n < 2; ++n) st4bf(YF + row * 512 + (pn - 2) * 256 + bj * 128 + cl0 + n * 16, acc[ai][bj][m][n]); }
        } else if (pn < 6) {
#pragma unroll
            for (int ai = 0; ai < 2; ++ai)
#pragma unroll
                for (int m = 0; m < 4; ++m) { const size_t row = row0 + ai * 128 + m * 16;
#pragma unroll
                    for (int n = 0; n < 2; ++n) { const f32x4 a = acc[ai][0][m][n], g = acc[ai][1][m][n]; f32x4 v;
#pragma unroll
                        for (int j = 0; j < 4; ++j) v[j] = a[j] * sigm(g[j]);
                        st4bf(CY + row * 256 + (pn - 4) * 128 + cl0 + n * 16, v); } }
        } else if (pn < 8) {
            const bool isq = pn == 6; const float scl = isq ? 0.125f : 1.f; const bool latent = u.pm < 64;
#pragma unroll
            for (int ai = 0; ai < 2; ++ai)
#pragma unroll
                for (int m = 0; m < 4; ++m) { const int rowi = row0 + ai * 128 + m * 16; const size_t row = rowi; const int tok = rowi & 8191;
                    const int pos = (wc & 1) ? (tok & 63) : (tok >> 6);
                    f32x4 cs = {1.f, 1.f, 1.f, 1.f}, sn = {0.f, 0.f, 0.f, 0.f};
                    if (latent) { cs = *(const f32x4*)(ropeC + pos * 16 + 4 * fq); sn = *(const f32x4*)(ropeS + pos * 16 + 4 * fq); }
#pragma unroll
                    for (int bj = 0; bj < 2; ++bj) { const f32x4 x1 = acc[ai][bj][m][0] * scl, x2 = acc[ai][bj][m][1] * scl;
                        const f32x4 r1 = x1 * cs - x2 * sn, r2 = x1 * sn + x2 * cs; const size_t off = row * 256 + bj * 128 + cl0;
                        if (isq) { st4bf(QPL + off, x1); st4bf(QPL + off + 16, x2); st4bf(QROT + off, r1); st4bf(QROT + off + 16, r2); }
                        else { st4bf(KR + off, r1); st4bf(KR + off + 16, r2); } } }
        } else if (pn == 8) {
#pragma unroll
            for (int ai = 0; ai < 2; ++ai)
#pragma unroll
                for (int m = 0; m < 4; ++m) { const size_t row = row0 + ai * 128 + m * 16;
#pragma unroll
                    for (int bj = 0; bj < 2; ++bj)
#pragma unroll
                        for (int n = 0; n < 2; ++n) st4bf(VV + row * 256 + bj * 128 + cl0 + n * 16, acc[ai][bj][m][n]); }
        } else {
#pragma unroll
            for (int ai = 0; ai < 2; ++ai)
#pragma unroll
                for (int m = 0; m < 4; ++m) { const size_t row = row0 + ai * 128 + m * 16;
#pragma unroll
                    for (int bj = 0; bj < 2; ++bj)
#pragma unroll
                        for (int n = 0; n < 2; ++n) { f32x4 v = acc[ai][bj][m][n];
#pragma unroll
                            for (int j = 0; j < 4; ++j) v[j] = sigm(v[j]);
                            st4bf(G + row * 4096 + (size_t)(pn - 9) * 256 + bj * 128 + cl0 + n * 16, v); } }
        }
    }
};
struct EpiMerge {
    static constexpr bool PERM = false, AFTER_DRAIN = false;
    const bf16* G; float* P32; bf16* MB;
    __device__ __forceinline__ void operator()(const f32x4 (&acc)[2][2][4][2], const Unit& u, int wr, int wc, int fr, int fq) const {
        int fr_ = fr, fq_ = fq; asm volatile("" : "+v"(fr_), "+v"(fq_));
        const int b = u.pn >> 2, pn = u.pn & 3, pm = u.pm - b * 66, row0 = pm * 256 + wr * 64 + fr_, col0 = pn * 256 + wc * 32 + 4 * fq_;
#pragma unroll
        for (int ai = 0; ai < 2; ++ai)
#pragma unroll
            for (int m = 0; m < 4; ++m) { const unsigned row = row0 + ai * 128 + m * 16;
                const bf16* gp = G + ((size_t)row * 4096 + b * 1024 + col0); float* pp = P32 + ((size_t)row * 1024 + col0); bf16* mp = MB + ((size_t)row * 1024 + col0);
#pragma unroll
                for (int bj = 0; bj < 2; ++bj)
#pragma unroll
                    for (int n = 0; n < 2; ++n) { const int co = bj * 128 + n * 16;
                        const uint2 gw = *(const uint2*)(gp + co);
                        f32x4 v = acc[ai][bj][m][n]; v[0] *= bflo(gw.x); v[1] *= bfhi(gw.x); v[2] *= bflo(gw.y); v[3] *= bfhi(gw.y);
                        if (b > 0) v += *(const f32x4*)(pp + co);
                        if (b < 3) *(f32x4*)(pp + co) = v; else st4bf(mp + co, v);
                        asm volatile("" ::: "memory"); } }
    }
};
struct EpiWout {
    static constexpr bool PERM = false, AFTER_DRAIN = false;
    const float* xlat; const float* xctx; float* X; const float* mod;
    __device__ __forceinline__ void operator()(const f32x4 (&acc)[2][2][4][2], const Unit& u, int wr, int wc, int fr, int fq) const {
        const int r = u.pm < 32 ? 0 : (u.pm < 64 ? 1 : 2); const float* gt = mod + r * 6144 + 2 * 1024;
        const int row0 = u.pm * 256 + wr * 64 + fr, col0 = u.pn * 256 + wc * 32 + 4 * fq;
        f32x4 gv[2][2];
#pragma unroll
        for (int bj = 0; bj < 2; ++bj)
#pragma unroll
            for (int n = 0; n < 2; ++n) gv[bj][n] = *(const f32x4*)(gt + col0 + bj * 128 + n * 16);
#pragma unroll
        for (int ai = 0; ai < 2; ++ai)
#pragma unroll
            for (int m = 0; m < 4; ++m) { const size_t row = row0 + ai * 128 + m * 16; const float* src = (row < ML) ? xlat + row * 1024 : xctx + (row - ML) * 1024;
#pragma unroll
                for (int bj = 0; bj < 2; ++bj)
#pragma unroll
                    for (int n = 0; n < 2; ++n) { const int col = col0 + bj * 128 + n * 16;
                        *(f32x4*)(X + row * 1024 + col) = *(const f32x4*)(src + col) + gv[bj][n] * acc[ai][bj][m][n]; } }
    }
};
struct EpiGU {
    static constexpr bool PERM = false, AFTER_DRAIN = false;
    bf16* ACT;
    __device__ __forceinline__ void operator()(const f32x4 (&acc)[2][2][4][2], const Unit& u, int wr, int wc, int fr, int fq) const {
        const int pnl = u.pn & 7, row0 = u.pm * 256 + wr * 64 + fr, cl0 = wc * 32 + 4 * fq;
#pragma unroll
        for (int ai = 0; ai < 2; ++ai)
#pragma unroll
            for (int m = 0; m < 4; ++m) { const size_t row = row0 + ai * 128 + m * 16;
#pragma unroll
                for (int n = 0; n < 2; ++n) { const f32x4 a = acc[ai][0][m][n], up = acc[ai][1][m][n]; f32x4 v;
#pragma unroll
                    for (int j = 0; j < 4; ++j) v[j] = a[j] * sigm(a[j]) * up[j];
                    st4bf(ACT + row * 1024 + pnl * 128 + cl0 + n * 16, v); } }
    }
};
struct EpiDown {
    static constexpr bool PERM = false, AFTER_DRAIN = false;
    bf16* YB; const float* GATE;
    __device__ __forceinline__ void operator()(const f32x4 (&acc)[2][2][4][2], const Unit& u, int wr, int wc, int fr, int fq) const {
        const int pnl = u.pn & 3, row0 = u.pm * 256 + wr * 64 + fr, col0 = pnl * 256 + wc * 32 + 4 * fq;
#pragma unroll
        for (int ai = 0; ai < 2; ++ai)
#pragma unroll
            for (int m = 0; m < 4; ++m) { const size_t row = row0 + ai * 128 + m * 16; const float gt = GATE[row];
#pragma unroll
                for (int bj = 0; bj < 2; ++bj)
#pragma unroll
                    for (int n = 0; n < 2; ++n) st4bf(YB + row * 1024 + col0 + bj * 128 + n * 16, acc[ai][bj][m][n] * gt); }
    }
};
struct MergeOrder {
    int nt, G, c;
    __device__ void init(int ntm, int G_, int c_) { nt = ntm * 4; G = G_; c = c_; }
    __device__ bool next(int i, Unit& u) const { const int b = i & 3, L = (i >> 2) * G + c; if (L >= nt) return false; u.pm = b * 66 + (L >> 2); u.pn = b * 4 + (L & 3); return true; }
    __device__ __forceinline__ void a_ready(const Unit&) const {}
    __device__ __forceinline__ void done(const Unit&) const {}
};
struct GroupOrder {
    int nwg, G, c, TPE, NTN;
    __device__ void init(int tpe, int ntn, int G_, int c_) { TPE = tpe; NTN = ntn; nwg = NE * tpe * ntn; G = G_; c = c_; }
    __device__ bool next(int i, Unit& u) const {
        const long L = (long)i * G + c; if (L >= nwg) return false;
        int wgid = (int)L; { const int q = nwg / 8, r = nwg % 8, xcd = wgid % 8, off = wgid / 8; wgid = (xcd < r ? xcd * (q + 1) : r * (q + 1) + (xcd - r) * q) + off; }
        const int per = TPE * NTN, e = wgid / per, rem = wgid % per, pn = rem / TPE, mt = rem % TPE;
        u.pm = e * 9 + mt; u.pn = e * NTN + pn; return true;
    }
    __device__ __forceinline__ void a_ready(const Unit&) const {}
    __device__ __forceinline__ void done(const Unit&) const {}
};
#define PH_ARGS LAS unsigned char* lds, const int tid, const int lane, const int wave, const int bid, const int G
#define WSP(T, off) ((T*)(PTRV(29, unsigned char) + (off)))
constexpr int PTAB_OFF = MISC_OFF + 512;
__device__ __forceinline__ unsigned long long ptab_ld(LAS unsigned char* lds, int i) {
    typedef unsigned u2v_t __attribute__((ext_vector_type(2)));
    const volatile LAS unsigned* tp = (const volatile LAS unsigned*)(lds + PTAB_OFF + 8 * i); u2v_t v; v[0] = tp[0]; v[1] = tp[1];
    const unsigned lo = __builtin_amdgcn_readfirstlane(v[0]), hi = __builtin_amdgcn_readfirstlane(v[1]);
    return ((unsigned long long)hi << 32) | lo;
}
#define PTRV(i, T) ((T*)(GAS T*)ptab_ld(lds, (i)))
#define INP(i) ((const float*)(GAS const float*)ptab_ld(lds, (i)))

__device__ __forceinline__ void mod_gemv(PH_ARGS) {
    LAS f32x4* red = (LAS f32x4*)lds;
    const float* c = INP(1); const float* cc = INP(3); const float* wm = INP(4); const float* bm = INP(5);
    float* MOD = WSP(float, WS_MOD);
    for (int it = bid; it < 192; it += G) {
        const int l = it / 96, cg = it % 96, kg = tid >> 4, cq = tid & 15;
        f32x4 a0 = {0.f, 0.f, 0.f, 0.f}, a1 = a0, a2 = a0;
        const float* wb = wm + (size_t)l * 1024 * 6144 + cg * 64 + cq * 4;
#pragma unroll 4
        for (int i = 0; i < 32; ++i) { const int k = kg + 32 * i; const f32x4 w = *(const f32x4*)(wb + (size_t)k * 6144);
            const float x0 = c[k], x1 = c[1024 + k], x2 = cc[k];
            a0 += w * (x0 * sigm(x0)); a1 += w * (x1 * sigm(x1)); a2 += w * (x2 * sigm(x2)); }
        red[(kg * 3 + 0) * 16 + cq] = a0; red[(kg * 3 + 1) * 16 + cq] = a1; red[(kg * 3 + 2) * 16 + cq] = a2;
        __syncthreads();
        if (tid < 192) { const int r = tid >> 6, col = tid & 63; float s = 0.f; const LAS float* rf = (const LAS float*)red;
            for (int k2 = 0; k2 < 32; ++k2) s += rf[((k2 * 3 + r) * 16 + (col >> 2)) * 4 + (col & 3)];
            MOD[(l * 3 + r) * 6144 + cg * 64 + col] = s + bm[l * 6144 + cg * 64 + col]; }
        __syncthreads();
    }
}
__device__ __forceinline__ void make_tables(PH_ARGS) {
    const int gt = bid * 512 + tid, GT = G * 512;
    float* RC = WSP(float, WS_ROPEC); float* RS = WSP(float, WS_ROPES); float2* TW = WSP(float2, WS_TW); float2* C256 = WSP(float2, WS_CS256);
    bf16* T1 = WSP(bf16, WS_T1T); bf16* T2 = WSP(bf16, WS_T2T);
    for (int i = gt; i < 2048; i += GT) { const int pos = i >> 4, f = i & 15; const float inv = powf(10000.f, -(float)f / 16.f), ang = (float)pos * inv; RC[i] = cosf(ang); RS[i] = sinf(ang); }
    for (int i = gt; i < 128 * 128; i += GT) { const int col = i >> 7, k = i & 127, ro = col >> 6, k1 = col & 63, n1 = k >> 1, ri = k & 1; float s, c; sincospif((float)((k1 * n1) & 63) / 32.f, &s, &c);
        const float v = ro == 0 ? (ri == 0 ? c : s) : (ri == 0 ? -s : c); T1[i] = (bf16)f2bf(v); }
    for (int i = gt; i < 128 * 256; i += GT) { const int k2 = i >> 8, k = i & 255, n2 = k >> 1, ri = k & 1; float s, c; sincospif((float)((k2 * n2) & 127) / 64.f, &s, &c); T2[i] = (bf16)f2bf(ri ? s : c); }
    for (int i = gt; i < 64 * 128; i += GT) { const int k1 = i >> 7, n2 = i & 127; float s, c; sincospif((float)(k1 * n2) / 4096.f, &s, &c); TW[i] = make_float2(c, s); }
    for (int i = gt; i < 256; i += GT) { float s, c; sincospif((float)i / 128.f, &s, &c); C256[i] = make_float2(c, s); }
}
__device__ __forceinline__ void tr_item(const float* W, size_t ldw, int col0, int k0, bf16* dst, int Kd, LAS float* scr, int lane) {
#pragma unroll 8
    for (int i = 0; i < 32; ++i) { const int kk = 2 * i + (lane >> 5); scr[kk * 33 + (lane & 31)] = W[(size_t)(k0 + kk) * ldw + col0 + (lane & 31)]; }
    LDS_WAIT(); asm volatile("" ::: "memory");
    const int c = lane & 7;
#pragma unroll
    for (int j = 0; j < 4; ++j) { const int n = (lane >> 3) + 8 * j; const LAS float* s = scr + (8 * c) * 33 + n;
        v4u o; o.x = pk2(s[0 * 33], s[1 * 33]); o.y = pk2(s[2 * 33], s[3 * 33]); o.z = pk2(s[4 * 33], s[5 * 33]); o.w = pk2(s[6 * 33], s[7 * 33]);
        *(v4u*)(dst + (size_t)n * Kd + k0 + 8 * c) = o; }
    LDS_WAIT(); asm volatile("" ::: "memory");
}
__device__ __forceinline__ void fold_item(const float* W  , int f, bf16* WIN, LAS float* scr, int lane) {
    const int kb = f >> 2, g = f & 3, k0 = kb * 64;
    for (int kk = 0; kk < 64; ++kk) scr[kk * 64 + lane] = W[(size_t)(k0 + kk) * 6144 + 512 + g * 64 + lane];
    LDS_WAIT(); asm volatile("" ::: "memory");
    bf16* d0 = WIN + (size_t)(512 + 2 * (g * 64 + lane)) * 1024 + k0;
#pragma unroll 1
    for (int kc = 0; kc < 2; ++kc) {
        float ar[32], ai[32];
#pragma unroll
        for (int kk = 0; kk < 32; ++kk) { ar[kk] = 0.f; ai[kk] = 0.f; }
#pragma unroll 1
        for (int c = 0; c < 64; ++c) { float s, co; sincospif((float)((c * lane) & 63) / 32.f, &s, &co);
#pragma unroll
            for (int kk = 0; kk < 32; ++kk) { const float w = scr[(kc * 32 + kk) * 64 + c]; ar[kk] += w * co; ai[kk] -= w * s; } }
#pragma unroll
        for (int q = 0; q < 4; ++q) { v4u o, p;
            o.x = pk2(ar[8 * q + 0], ar[8 * q + 1]); o.y = pk2(ar[8 * q + 2], ar[8 * q + 3]); o.z = pk2(ar[8 * q + 4], ar[8 * q + 5]); o.w = pk2(ar[8 * q + 6], ar[8 * q + 7]);
            p.x = pk2(ai[8 * q + 0], ai[8 * q + 1]); p.y = pk2(ai[8 * q + 2], ai[8 * q + 3]); p.z = pk2(ai[8 * q + 4], ai[8 * q + 5]); p.w = pk2(ai[8 * q + 6], ai[8 * q + 7]);
            *(v4u*)(d0 + kc * 32 + 8 * q) = o; *(v4u*)(d0 + 1024 + kc * 32 + 8 * q) = p; }
    }
    LDS_WAIT(); asm volatile("" ::: "memory");
}
__device__ __forceinline__ void tr_item64(const float* W, size_t ldw, int col0, int k0, bf16* dst, int Kd, int lane) {
    const int kq = lane >> 4, n4 = lane & 15; const float* src = W + (size_t)(k0 + kq * 16) * ldw + col0 + n4 * 4;
    f32x4 v[16];
#pragma unroll
    for (int i = 0; i < 16; ++i) v[i] = *(const f32x4*)(src + (size_t)i * ldw);
#pragma unroll
    for (int j = 0; j < 4; ++j) { bf16* d = dst + (size_t)(n4 * 4 + j) * Kd + k0 + kq * 16; v4u o, p;
        o.x = pk2(v[0][j], v[1][j]); o.y = pk2(v[2][j], v[3][j]); o.z = pk2(v[4][j], v[5][j]); o.w = pk2(v[6][j], v[7][j]);
        p.x = pk2(v[8][j], v[9][j]); p.y = pk2(v[10][j], v[11][j]); p.z = pk2(v[12][j], v[13][j]); p.w = pk2(v[14][j], v[15][j]);
        *(v4u*)d = o; *(v4u*)(d + 8) = p; }
}
__device__ __forceinline__ void convert_weights(PH_ARGS, const int l) {
    LAS float* scr = (LAS float*)(lds + wave * 16384);
    const int gw = bid * 8 + wave, NGW = G * 8;
    bf16* WIN = WSP(bf16, WS_WIN); bf16* WBR = WSP(bf16, WS_WBR); bf16* WO = WSP(bf16, WS_WO); bf16* WGU = WSP(bf16, WS_WGU); bf16* WDN = WSP(bf16, WS_WDN); bf16* WS_ = WSP(bf16, WS_WSP);
    const float* win = INP(8) + (size_t)l * 1024 * 6144;
    constexpr int N_FOLD = 64, N_IN = 92 * 16, N_BR = 256, N_WO = 256, N_GU = 8192, N_DN = 4096, N_SP = 64;
    constexpr int NITEMS = N_FOLD + N_IN + N_BR + N_WO + N_GU + N_DN + N_SP;
    for (int it = gw; it < NITEMS; it += NGW) {
        int r = it;
        if (r < N_FOLD) { fold_item(win, r, WIN, scr, lane); continue; } r -= N_FOLD;
        if (r < N_IN) { const int dbp = r >> 4, kb = r & 15, db = dbp < 8 ? dbp : dbp + 8; int col;
            if (db < 8) col = db * 64;
            else if (db < 24) { const int t = db - 16, tile = t >> 2, sub = t & 3; col = (sub < 2 ? 768 : 1024) + tile * 128 + (sub & 1) * 64; }
            else if (db < 36) col = 1280 + (db - 24) * 64;
            else col = 2048 + (db - 36) * 64;
            tr_item64(win, 6144, col, kb * 64, WIN + (size_t)db * 64 * 1024, 1024, lane); continue; } r -= N_IN;
        if (r < N_BR) { const int b = r >> 6, q = r & 63, kb = q >> 4, nb = q & 15; const int ii = b == 0 ? 13 : (b == 1 ? 14 : (b == 2 ? 19 : 21));
            tr_item64(INP(ii) + (size_t)l * 256 * 1024, 1024, nb * 64, kb * 64, WBR + (size_t)(b * 1024 + nb * 64) * 256, 256, lane); continue; } r -= N_BR;
        if (r < N_WO) { const int kb = r >> 4, nb = r & 15; tr_item64(INP(22) + (size_t)l * 1024 * 1024, 1024, nb * 64, kb * 64, WO + (size_t)nb * 64 * 1024, 1024, lane); continue; } r -= N_WO;
        if (r < N_GU) { const int e = r >> 9, q = r & 511, db = q >> 4, kb = q & 15, tile = db >> 2, sub = db & 3;
            const float* src = (sub < 2 ? INP(24) : INP(25)) + (size_t)(l * 16 + e) * 1024 * 1024;
            tr_item64(src, 1024, tile * 128 + (sub & 1) * 64, kb * 64, WGU + ((size_t)e * 2048 + db * 64) * 1024, 1024, lane); continue; } r -= N_GU;
        if (r < N_DN) { const int e = r >> 8, q = r & 255, kb = q >> 4, nb = q & 15;
            tr_item64(INP(26) + (size_t)(l * 16 + e) * 1024 * 1024, 1024, nb * 64, kb * 64, WDN + ((size_t)e * 1024 + nb * 64) * 1024, 1024, lane); continue; } r -= N_DN;
        { const float* s = INP(11) + (size_t)l * 65536 + r * 1024 + lane * 16; const f32x4 a = *(const f32x4*)s, b = *(const f32x4*)(s + 4), c = *(const f32x4*)(s + 8), d = *(const f32x4*)(s + 12);
          v4u o, p; o.x = pk2(a[0], a[1]); o.y = pk2(a[2], a[3]); o.z = pk2(b[0], b[1]); o.w = pk2(b[2], b[3]); p.x = pk2(c[0], c[1]); p.y = pk2(c[2], c[3]); p.z = pk2(d[0], d[1]); p.w = pk2(d[2], d[3]);
          *(v4u*)(WS_ + r * 1024 + lane * 16) = o; *(v4u*)(WS_ + r * 1024 + lane * 16 + 8) = p; }
    }
}
__device__ __forceinline__ void load_row(const float* p, int lane, f32x4 (&v)[4]) {
#pragma unroll
    for (int j = 0; j < 4; ++j) v[j] = *(const f32x4*)(p + 4 * lane + 256 * j);
}
__device__ __forceinline__ void modnorm_store(f32x4 (&v)[4], const float* g, const float* sc, const float* sh, bf16* hrow, int lane) {
    float ss = 0.f;
#pragma unroll
    for (int j = 0; j < 4; ++j) ss += (v[j][0] * v[j][0] + v[j][1] * v[j][1]) + (v[j][2] * v[j][2] + v[j][3] * v[j][3]);
    const float rs = 1.0f / sqrtf(wave_sum(ss) * (1.f / 1024.f) + 1e-6f);
#pragma unroll
    for (int j = 0; j < 4; ++j) { const int o = 4 * lane + 256 * j; const f32x4 gg = *(const f32x4*)(g + o), s = *(const f32x4*)(sc + o), b = *(const f32x4*)(sh + o);
        v[j] = v[j] * rs * gg * (s + 1.f) + b; st4bf(hrow + o, v[j]); }
}
__device__ __forceinline__ void norm1_l0(PH_ARGS) {
    const int gw = bid * 8 + wave, NGW = G * 8; bf16* H = WSP(bf16, WS_H); const float* MOD = WSP(float, WS_MOD);
    for (int row = gw; row < MT; row += NGW) {
        const float* src = row < ML ? INP(0) + (size_t)row * 1024 : INP(2) + (size_t)(row - ML) * 1024; const int r = row < SEQ ? 0 : (row < ML ? 1 : 2);
        f32x4 v[4]; load_row(src, lane, v); const float* md = MOD + r * 6144;
        modnorm_store(v, INP(6), md + 1024, md, H + (size_t)row * 1024, lane);
    }
}
__device__ __forceinline__ void norm2_router(PH_ARGS, const int l, const int nrows) {
    const int gw = bid * 8 + wave, NGW = G * 8; bf16* H = WSP(bf16, WS_H); const float* MOD = WSP(float, WS_MOD) + l * 3 * 6144; const float* X = WSP(float, WS_X); float* AFF = WSP(float, WS_AFF);
    LAS f32x4* Wl = (LAS f32x4*)lds;
    { const f32x4* wr = (const f32x4*)(INP(23) + (size_t)l * 1024 * 16);
      for (int i = tid; i < 4096; i += 512) { const int k = i >> 2, q = i & 3; Wl[(q * 4 + (k & 3)) * 256 + (k >> 2)] = wr[i]; } }
    __syncthreads();
    for (int row = gw; row < nrows; row += NGW) {
        const int r = row < SEQ ? 0 : (row < ML ? 1 : 2); const float* md = MOD + r * 6144;
        f32x4 v[4]; load_row(X + (size_t)row * 1024, lane, v);
        modnorm_store(v, INP(7) + l * 1024, md + 4 * 1024, md + 3 * 1024, H + (size_t)row * 1024, lane);
        float lg[16];
#pragma unroll
        for (int e = 0; e < 16; ++e) lg[e] = 0.f;
#pragma unroll
        for (int j = 0; j < 4; ++j)
#pragma unroll
            for (int i = 0; i < 4; ++i) { const float hv = v[j][i];
#pragma unroll
                for (int q = 0; q < 4; ++q) { const f32x4 w = Wl[(q * 4 + i) * 256 + 64 * j + lane]; lg[4 * q + 0] += hv * w[0]; lg[4 * q + 1] += hv * w[1]; lg[4 * q + 2] += hv * w[2]; lg[4 * q + 3] += hv * w[3]; }
                if (i & 1) asm volatile("" ::: "memory"); }
#pragma unroll
        for (int i = 0; i < 8; ++i) { const bool up = lane & 32; const float send = up ? lg[i] : lg[i + 8], keep = up ? lg[i + 8] : lg[i]; lg[i] = keep + __shfl_xor(send, 32); }
#pragma unroll
        for (int i = 0; i < 4; ++i) { const bool up = lane & 16; const float send = up ? lg[i] : lg[i + 4], keep = up ? lg[i + 4] : lg[i]; lg[i] = keep + __shfl_xor(send, 16); }
#pragma unroll
        for (int i = 0; i < 2; ++i) { const bool up = lane & 8; const float send = up ? lg[i] : lg[i + 2], keep = up ? lg[i + 2] : lg[i]; lg[i] = keep + __shfl_xor(send, 8); }
        { const bool up = lane & 4; const float send = up ? lg[0] : lg[1], keep = up ? lg[1] : lg[0]; lg[0] = keep + __shfl_xor(send, 4); }
        float z = lg[0]; z += __shfl_xor(z, 1); z += __shfl_xor(z, 2);
        float mx = z; mx = fmaxf(mx, __shfl_xor(mx, 4)); mx = fmaxf(mx, __shfl_xor(mx, 8)); mx = fmaxf(mx, __shfl_xor(mx, 16)); mx = fmaxf(mx, __shfl_xor(mx, 32));
        const float ez = expf(z - mx); float sm = ez; sm += __shfl_xor(sm, 4); sm += __shfl_xor(sm, 8); sm += __shfl_xor(sm, 16); sm += __shfl_xor(sm, 32);
        if ((lane & 3) == 0) { const int e = ((lane >> 5) & 1) * 8 + ((lane >> 4) & 1) * 4 + ((lane >> 3) & 1) * 2 + ((lane >> 2) & 1); AFF[(size_t)row * 16 + e] = ez / sm; }
    }
    __syncthreads();
}
typedef short v4i16_t __attribute__((ext_vector_type(4)));
typedef float f2v __attribute__((ext_vector_type(2)));
__device__ __forceinline__ void mfma16(f32x4& acc, const bf16x8 a, const bf16x8 b) { asm volatile("s_nop 1\n\tv_mfma_f32_16x16x32_bf16 %0, %1, %2, %0\n\ts_nop 3" : "+v"(acc) : "v"(a), "v"(b)); }
#define DRAIN4(x) asm volatile("s_nop 15\n\ts_nop 15" : "+v"((x)[0]), "+v"((x)[1]), "+v"((x)[2]), "+v"((x)[3]))
#define DRAIN8(x) asm volatile("s_nop 15\n\ts_nop 15" : "+v"((x)[0]), "+v"((x)[1]), "+v"((x)[2]), "+v"((x)[3]), "+v"((x)[4]), "+v"((x)[5]), "+v"((x)[6]), "+v"((x)[7]))
#define DRAIN16(x) asm volatile("s_nop 15\n\ts_nop 15" : "+v"((x)[0]), "+v"((x)[1]), "+v"((x)[2]), "+v"((x)[3]), "+v"((x)[4]), "+v"((x)[5]), "+v"((x)[6]), "+v"((x)[7]), \
    "+v"((x)[8]), "+v"((x)[9]), "+v"((x)[10]), "+v"((x)[11]), "+v"((x)[12]), "+v"((x)[13]), "+v"((x)[14]), "+v"((x)[15]))
__device__ __forceinline__ void gmlp_unit(PH_ARGS, const int l, const int chunk) {
    const int row0 = chunk < 128 ? chunk * 128 : ML + (chunk - 128) * 128;
    const bf16* AUV = WSP(bf16, WS_AUV); bf16* BRa = WSP(bf16, WS_BR); const bf16* WS_ = WSP(bf16, WS_WSP);
    LAS bf16* vT = (LAS bf16*)lds;
    const float* lg = INP(9) + l * 256; const float* lb = INP(10) + l * 256;
    const f32x4 gg = *(const f32x4*)(lg + 4 * lane), bb = *(const f32x4*)(lb + 4 * lane);
    for (int pi = 0; pi < 16; ++pi) { const int p = wave * 16 + pi;
        const uint2 raw = *(const uint2*)(AUV + (size_t)(row0 + p) * 512 + 256 + 4 * lane);
        float v0 = bflo(raw.x), v1 = bfhi(raw.x), v2 = bflo(raw.y), v3 = bfhi(raw.y);
        const float mean = wave_sum((v0 + v1) + (v2 + v3)) * (1.f / 256.f); v0 -= mean; v1 -= mean; v2 -= mean; v3 -= mean;
        const float rstd = 1.0f / sqrtf(wave_sum((v0 * v0 + v1 * v1) + (v2 * v2 + v3 * v3)) * (1.f / 256.f) + 1e-6f);
        vT[(4 * lane + 0) * 136 + p] = (bf16)f2bf(v0 * rstd * gg[0] + bb[0]); vT[(4 * lane + 1) * 136 + p] = (bf16)f2bf(v1 * rstd * gg[1] + bb[1]);
        vT[(4 * lane + 2) * 136 + p] = (bf16)f2bf(v2 * rstd * gg[2] + bb[2]); vT[(4 * lane + 3) * 136 + p] = (bf16)f2bf(v3 * rstd * gg[3] + bb[3]); }
    __syncthreads();
    const int g = wave >> 1, qh = wave & 1, fr = lane & 15, fq = lane >> 4;
    f32x4 acc[4][4];
#pragma unroll
    for (int a = 0; a < 4; ++a)
#pragma unroll
        for (int b = 0; b < 4; ++b) acc[a][b] = (f32x4){0.f, 0.f, 0.f, 0.f};
    const bf16* Wg = WS_ + g * 16384;
#pragma unroll
    for (int ks = 0; ks < 4; ++ks) { bf16x8 af[4], bf[4];
#pragma unroll
        for (int dt = 0; dt < 4; ++dt) af[dt] = *(const LAS bf16x8*)(vT + (g * 64 + dt * 16 + fr) * 136 + ks * 32 + fq * 8);
#pragma unroll
        for (int qt = 0; qt < 4; ++qt) bf[qt] = *(const bf16x8*)(Wg + (qh * 64 + qt * 16 + fr) * 128 + ks * 32 + fq * 8);
#pragma unroll
        for (int dt = 0; dt < 4; ++dt)
#pragma unroll
            for (int qt = 0; qt < 4; ++qt) mfma16(acc[dt][qt], af[dt], bf[qt]); }
    DRAIN16(&acc[0][0]);
    const float* bs = INP(12) + l * 512 + g * 128;
#pragma unroll
    for (int qt = 0; qt < 4; ++qt) { const int q = qh * 64 + qt * 16 + fr; const float bias = bs[q]; const size_t row = row0 + q;
#pragma unroll
        for (int dt = 0; dt < 4; ++dt) { const int ch = g * 64 + dt * 16 + 4 * fq; const uint2 uw = *(const uint2*)(AUV + row * 512 + ch);
            f32x4 o; o[0] = bflo(uw.x) * (acc[dt][qt][0] + bias); o[1] = bfhi(uw.x) * (acc[dt][qt][1] + bias); o[2] = bflo(uw.y) * (acc[dt][qt][2] + bias); o[3] = bfhi(uw.y) * (acc[dt][qt][3] + bias);
            st4bf(BRa + row * 256 + ch, o); } }
    __syncthreads();
}
__device__ __forceinline__ void conv_unit(PH_ARGS, const int l, const int unit) {
    int rowbase, n0, nlen;
    if (unit < 256) { rowbase = (unit >> 7) * SEQ; n0 = (unit & 127) * 64; nlen = SEQ; } else { const int u2 = unit - 256; rowbase = ML + (u2 >> 2) * CTXL; n0 = (u2 & 3) * 64; nlen = CTXL; }
    const bf16* CY = WSP(bf16, WS_CY); bf16* BRc = WSP(bf16, WS_BR) + (size_t)2 * MT * 256;
    LAS unsigned* yt = (LAS unsigned*)lds;
    LAS float* cres = (LAS float*)(lds + 48128);
    for (int p = tid; p < 94 * 32; p += 512) { const int rr = p >> 5, seg = p & 31, n = n0 - 15 + rr; v4u val = {0u, 0u, 0u, 0u};
        if (n >= 0 && n < nlen) val = *(const v4u*)(CY + (size_t)(rowbase + n) * 256 + seg * 8);
        *(LAS v4u*)(lds + rr * 512 + seg * 16) = val; }
    __syncthreads();
    const int cp = tid & 127, pg = tid >> 7;
    float w0[31], w1[31];
    const float* cw = INP(15) + (size_t)l * 31 * 256 + 2 * cp;
#pragma unroll
    for (int t = 0; t < 31; ++t) { const float2 w = *(const float2*)(cw + t * 256); w0[t] = w.x; w1[t] = w.y; }
    float a0[16], a1[16];
#pragma unroll
    for (int p = 0; p < 16; ++p) { a0[p] = 0.f; a1[p] = 0.f; }
#pragma unroll
    for (int i = 0; i < 46; ++i) { const unsigned raw = yt[(16 * pg + i) * 128 + cp]; const float v0 = bflo(raw), v1 = bfhi(raw);
#pragma unroll
        for (int p = 0; p < 16; ++p) { const int t = i - p; if (t >= 0 && t < 31) { a0[p] += v0 * w0[t]; a1[p] += v1 * w1[t]; } } }
    const float2 cb = *(const float2*)(INP(16) + l * 256 + 2 * cp);
#pragma unroll
    for (int p = 0; p < 16; ++p) *(LAS f2v*)(cres + (16 * pg + p) * 256 + 2 * cp) = (f2v){a0[p] + cb.x, a1[p] + cb.y};
    __syncthreads();
    const f32x4 gg = *(const f32x4*)(INP(17) + l * 256 + 4 * lane), bb = *(const f32x4*)(INP(18) + l * 256 + 4 * lane);
    for (int pi = 0; pi < 8; ++pi) { const int pos = wave * 8 + pi; f32x4 v = *(const LAS f32x4*)(cres + pos * 256 + 4 * lane);
        const float mean = wave_sum((v[0] + v[1]) + (v[2] + v[3])) * (1.f / 256.f); v = v - mean;
        const float rstd = 1.0f / sqrtf(wave_sum((v[0] * v[0] + v[1] * v[1]) + (v[2] * v[2] + v[3] * v[3])) * (1.f / 256.f) + 1e-6f);
        f32x4 o;
#pragma unroll
        for (int j = 0; j < 4; ++j) { const float y = v[j] * rstd * gg[j] + bb[j]; o[j] = y * sigm(y); }
        st4bf(BRc + (size_t)(rowbase + n0 + pos) * 256 + 4 * lane, o); }
    __syncthreads();
}
constexpr int F1_T1L = 0, F1_YL = 34816;
__device__ __forceinline__ void f1_stage_tables(PH_ARGS) {
    const bf16* T1 = WSP(bf16, WS_T1T);
    for (int p = tid; p < 128 * 16; p += 512) { const int r = p >> 4, s = p & 15; *(LAS v4u*)(lds + F1_T1L + r * 272 + s * 16) = *(const v4u*)(T1 + r * 128 + s * 8); }
    __syncthreads();
}
__device__ __forceinline__ void f1_unit(PH_ARGS, const int unit) {
    const int b = unit >> 7, n2 = unit & 127, fr = lane & 15, fq = lane >> 4;
    const bf16* YF = WSP(bf16, WS_YF); bf16* FA = WSP(bf16, WS_FA); const float2* TW = WSP(float2, WS_TW);
    LAS unsigned* Yl = (LAS unsigned*)(lds + F1_YL);
#pragma unroll
    for (int i = 0; i < 8; ++i) { const int n1 = wave + 8 * i; *(LAS v4u*)(Yl + n1 * 260 + lane * 4) = *(const v4u*)(YF + (size_t)(b * SEQ + 128 * n1 + n2) * 512 + lane * 8); }
    __syncthreads();
    f32x4 acc[2][8];
#pragma unroll
    for (int a = 0; a < 2; ++a)
#pragma unroll
        for (int n = 0; n < 8; ++n) acc[a][n] = (f32x4){0.f, 0.f, 0.f, 0.f};
#pragma unroll
    for (int ks = 0; ks < 4; ++ks) { bf16x8 af[2];
#pragma unroll
        for (int c2 = 0; c2 < 2; ++c2) { const int ch = (2 * wave + c2) * 16 + fr; v4u w;
            w.x = Yl[(16 * ks + 4 * fq + 0) * 260 + ch]; w.y = Yl[(16 * ks + 4 * fq + 1) * 260 + ch]; w.z = Yl[(16 * ks + 4 * fq + 2) * 260 + ch]; w.w = Yl[(16 * ks + 4 * fq + 3) * 260 + ch];
            af[c2] = __builtin_bit_cast(bf16x8, w); }
#pragma unroll
        for (int nt = 0; nt < 8; ++nt) { const bf16x8 bfr = *(const LAS bf16x8*)(lds + F1_T1L + (nt * 16 + fr) * 272 + ks * 64 + fq * 16);
            mfma16(acc[0][nt], af[0], bfr); mfma16(acc[1][nt], af[1], bfr); } }
    DRAIN16(&acc[0][0]);
#pragma unroll
    for (int c2 = 0; c2 < 2; ++c2)
#pragma unroll
        for (int kt = 0; kt < 4; ++kt) { const int k1 = kt * 16 + fr;
#if defined(F1V) && F1V == 5
            const unsigned long long twb = __hip_atomic_load((const unsigned long long*)(TW + k1 * 128 + n2), __ATOMIC_RELAXED, __HIP_MEMORY_SCOPE_SYSTEM); const float2 tw = make_float2(__uint_as_float((unsigned)twb), __uint_as_float((unsigned)(twb >> 32)));
#elif defined(F1V) && F1V == 6
            const unsigned long long twb = __hip_atomic_load((const unsigned long long*)(TW + k1 * 128 + n2), __ATOMIC_RELAXED, __HIP_MEMORY_SCOPE_AGENT); const float2 tw = make_float2(__uint_as_float((unsigned)twb), __uint_as_float((unsigned)(twb >> 32)));
#else
            const float2 tw = TW[k1 * 128 + n2];
#endif
            const f32x4 re = acc[c2][kt], im = acc[c2][kt + 4];
#if defined(F1V) && F1V == 1
            const f32x4 ar = re, ai = im; (void)tw;
#elif defined(F1V) && F1V == 4
            const float2 t4 = make_float2(0.6f + 0.001f * (float)k1, 0.8f - 0.002f * (float)n2); const f32x4 ar = re * t4.x + im * t4.y, ai = im * t4.x - re * t4.y; (void)tw;
#elif defined(F1V) && F1V == 2
            f32x4 ar, ai; { const int chq = (2 * wave + c2) * 16 + 4 * fq; for (int q = 0; q < 4; ++q) { const unsigned w0 = Yl[(k1) * 260 + chq + q]; ar[q] = bflo(w0); ai[q] = bfhi(w0); } } (void)tw; (void)re; (void)im;
#elif defined(F1V) && F1V == 3
            f32x4 ar, ai; { for (int q = 0; q < 4; ++q) { const unsigned w0 = *(const LAS unsigned*)(lds + F1_T1L + (kt * 32 + 2 * fr + (q >> 1)) * 272 + ((2 * wave + c2) * 16 + 4 * fq + (q & 1) * 2) ); ar[q] = bflo(w0); ai[q] = bfhi(w0); } } (void)tw; (void)re; (void)im;
#else
            const f32x4 ar = re * tw.x + im * tw.y, ai = im * tw.x - re * tw.y;
#endif
            v4u o; o.x = pk2(ar[0], ai[0]); o.y = pk2(ar[1], ai[1]); o.z = pk2(ar[2], ai[2]); o.w = pk2(ar[3], ai[3]);
            *(v4u*)(FA + ((size_t)((b * 64 + k1) * 128 + n2) * 256 + (2 * wave + c2) * 16 + 4 * fq) * 2) = o; }
    __syncthreads();
}
constexpr int F2_T2L = 0, F2_AL = 67584;
__device__ __forceinline__ void f2_stage_tables(PH_ARGS) {
    const bf16* T2 = WSP(bf16, WS_T2T);
    for (int p = tid; p < 128 * 32; p += 512) { const int r = p >> 5, s = p & 31; *(LAS v4u*)(lds + F2_T2L + r * 528 + s * 16) = *(const v4u*)(T2 + r * 256 + s * 8); }
    __syncthreads();
}
__device__ __forceinline__ void f2_unit(PH_ARGS, const int unit) {
    const int b = unit >> 7, k1 = (unit >> 1) & 63, chh = unit & 1, fr = lane & 15, fq = lane >> 4;
    const bf16* FA = WSP(bf16, WS_FA); bf16* BRb = WSP(bf16, WS_BR) + (size_t)1 * MT * 256;
    LAS unsigned* Al = (LAS unsigned*)(lds + F2_AL);
#pragma unroll
    for (int i = 0; i < 8; ++i) { const int n2 = wave * 16 + 2 * i + (lane >> 5);
        *(LAS v4u*)(Al + n2 * 132 + (lane & 31) * 4) = *(const v4u*)(FA + ((size_t)((b * 64 + k1) * 128 + n2) * 256 + chh * 128) * 2 + (lane & 31) * 8); }
    __syncthreads();
    f32x4 acc[8];
#pragma unroll
    for (int n = 0; n < 8; ++n) acc[n] = (f32x4){0.f, 0.f, 0.f, 0.f};
    const int ch = wave * 16 + fr;
#pragma unroll
    for (int ks = 0; ks < 8; ++ks) { v4u w;
        w.x = Al[(16 * ks + 4 * fq + 0) * 132 + ch]; w.y = Al[(16 * ks + 4 * fq + 1) * 132 + ch]; w.z = Al[(16 * ks + 4 * fq + 2) * 132 + ch]; w.w = Al[(16 * ks + 4 * fq + 3) * 132 + ch];
        const bf16x8 af = __builtin_bit_cast(bf16x8, w);
#pragma unroll
        for (int nt = 0; nt < 8; ++nt) { const bf16x8 bfr = *(const LAS bf16x8*)(lds + F2_T2L + (nt * 16 + fr) * 528 + ks * 64 + fq * 16); mfma16(acc[nt], af, bfr); } }
    DRAIN8(acc);
    const float scl = 0.0013810679320049757f;
#pragma unroll
    for (int nt = 0; nt < 8; ++nt) { const int k2 = nt * 16 + fr; st4bf(BRb + (size_t)(b * SEQ + k1 + 64 * k2) * 256 + chh * 128 + wave * 16 + 4 * fq, acc[nt] * scl); }
    __syncthreads();
}
__device__ __forceinline__ void ctxdft_unit(PH_ARGS, const int unit) {
    const bf16* YF = WSP(bf16, WS_YF); bf16* BRb = WSP(bf16, WS_BR) + (size_t)1 * MT * 256; const float2* C256 = WSP(float2, WS_CS256);
    LAS f2v* tb = (LAS f2v*)lds;
    if (tid < 256) { const float2 t = C256[tid]; tb[tid] = (f2v){t.x, t.y}; }
    __syncthreads();
    const int b = unit >> 7, kk = (unit & 127) * 2 + (tid >> 8), ch = tid & 255;
    const unsigned* src = (const unsigned*)(YF + (size_t)(ML + b * CTXL) * 512) + ch; float acc = 0.f;
#pragma unroll 8
    for (int n = 0; n < 256; ++n) { const unsigned w = src[(size_t)n * 256]; const f2v cs = tb[(kk * n) & 255]; acc += bflo(w) * cs.x + bfhi(w) * cs.y; }
    BRb[(size_t)(ML + b * CTXL + kk) * 256 + ch] = (bf16)f2bf(acc * (1.f / 128.f));
    __syncthreads();
}

constexpr int MG_AL = 0, MG_BL = 67584;
__device__ __forceinline__ void merge_phase(PH_ARGS, const int nunits) {
    const int fr = lane & 15, fq = lane >> 4, wr = wave >> 2, wc = wave & 3;
    const bf16* BR = WSP(bf16, WS_BR); const bf16* WBR = WSP(bf16, WS_WBR); const bf16* GT = WSP(bf16, WS_G); bf16* MB = WSP(bf16, WS_MB);
    int nmine = 0; for (int u = bid; u < nunits; u += G) ++nmine;
    const int nsteps = nmine * 4;
    if (nsteps == 0) return;
    v4u pa[8], pb[8];
#define MG_LOAD(s) do { const int u_ = bid + ((s) >> 2) * G, b_ = (s) & 3, rt_ = u_ >> 3, ct_ = u_ & 7; \
        const bf16* As = BR + ((size_t)b_ * MT + (size_t)rt_ * 128) * 256; const bf16* Bs = WBR + ((size_t)b_ * 1024 + (size_t)ct_ * 128) * 256; \
        _Pragma("unroll") for (int i = 0; i < 8; ++i) { const int p = i * 512 + tid, r = p >> 5, seg = p & 31; pa[i] = *(const v4u*)(As + (size_t)r * 256 + seg * 8); pb[i] = *(const v4u*)(Bs + (size_t)r * 256 + seg * 8); } } while (0)
#define MG_WRITE() do { _Pragma("unroll") for (int i = 0; i < 8; ++i) { const int p = i * 512 + tid, r = p >> 5, seg = p & 31; \
        *(LAS v4u*)(lds + MG_AL + r * 528 + seg * 16) = pa[i]; *(LAS v4u*)(lds + MG_BL + r * 528 + seg * 16) = pb[i]; } } while (0)
    MG_LOAD(0); MG_WRITE();
    f32x4 macc[4][2];
#pragma unroll
    for (int a = 0; a < 4; ++a)
#pragma unroll
        for (int n = 0; n < 2; ++n) macc[a][n] = (f32x4){0.f, 0.f, 0.f, 0.f};
#pragma unroll 1
    for (int s = 0; s < nsteps; ++s) {
        const int u = bid + (s >> 2) * G, b = s & 3, rt = u >> 3, ct = u & 7;
        __syncthreads();
        if (s + 1 < nsteps) MG_LOAD(s + 1);
        uint2 gw[4][2];
#pragma unroll
        for (int mt = 0; mt < 4; ++mt)
#pragma unroll
            for (int nt = 0; nt < 2; ++nt) gw[mt][nt] = *(const uint2*)(GT + (size_t)(rt * 128 + wr * 64 + mt * 16 + fr) * 4096 + b * 1024 + ct * 128 + wc * 32 + nt * 16 + 4 * fq);
        f32x4 acc[4][2];
#pragma unroll
        for (int a = 0; a < 4; ++a)
#pragma unroll
            for (int n = 0; n < 2; ++n) acc[a][n] = (f32x4){0.f, 0.f, 0.f, 0.f};
#pragma unroll
        for (int ks = 0; ks < 8; ++ks) { bf16x8 af[4], bfr[2];
#pragma unroll
            for (int mt = 0; mt < 4; ++mt) af[mt] = *(const LAS bf16x8*)(lds + MG_AL + (wr * 64 + mt * 16 + fr) * 528 + ks * 64 + fq * 16);
#pragma unroll
            for (int nt = 0; nt < 2; ++nt) bfr[nt] = *(const LAS bf16x8*)(lds + MG_BL + (wc * 32 + nt * 16 + fr) * 528 + ks * 64 + fq * 16);
#pragma unroll
            for (int mt = 0; mt < 4; ++mt)
#pragma unroll
                for (int nt = 0; nt < 2; ++nt) mfma16(acc[mt][nt], bfr[nt], af[mt]); }
        DRAIN8(&acc[0][0]);
#pragma unroll
        for (int mt = 0; mt < 4; ++mt)
#pragma unroll
            for (int nt = 0; nt < 2; ++nt) { const uint2 g = gw[mt][nt]; macc[mt][nt][0] += bflo(g.x) * acc[mt][nt][0]; macc[mt][nt][1] += bfhi(g.x) * acc[mt][nt][1]; macc[mt][nt][2] += bflo(g.y) * acc[mt][nt][2]; macc[mt][nt][3] += bfhi(g.y) * acc[mt][nt][3]; }
        __syncthreads();
        if (s + 1 < nsteps) MG_WRITE();
        if (b == 3) {
#pragma unroll
            for (int mt = 0; mt < 4; ++mt)
#pragma unroll
                for (int nt = 0; nt < 2; ++nt) { st4bf(MB + (size_t)(rt * 128 + wr * 64 + mt * 16 + fr) * 1024 + ct * 128 + wc * 32 + nt * 16 + 4 * fq, macc[mt][nt]); macc[mt][nt] = (f32x4){0.f, 0.f, 0.f, 0.f}; }
        }
    }
    __syncthreads();
#undef MG_LOAD
#undef MG_WRITE
}
constexpr int AT_RPB = 65536, AT_MRG = 73728;
__device__ __forceinline__ int clampi(int v, int lo, int hi) { return v < lo ? lo : (v > hi ? hi : v); }
__device__ __forceinline__ void attn_unit(PH_ARGS, const int unit) {
    const int h = wave >> 1, part = wave & 1, fr = lane & 15, fq = lane >> 4;
    const bool lat = unit < 1024;
    int b, r = 0, jb = 0, qrow0, kr0 = 0, kc0 = 0;
    if (lat) { b = unit >> 9; r = (unit >> 2) & 127; jb = unit & 3; qrow0 = b * SEQ + r * 64 + jb * 16; kr0 = clampi(r - 4, 0, 120); kc0 = clampi(jb * 16 - 8, 0, 32); }
    else { const int u2 = unit - 1024; b = u2 >> 4; qrow0 = ML + b * CTXL + (u2 & 15) * 16; }
    const bf16* QPL = WSP(bf16, WS_QPL); const bf16* QROT = WSP(bf16, WS_QROT); const bf16* KR = WSP(bf16, WS_KR); const bf16* VV = WSP(bf16, WS_VV);
    bf16* BRd = WSP(bf16, WS_BR) + (size_t)3 * MT * 256;
    LAS unsigned char* vbuf = lds + wave * 8192;
    const LAS float* rpbl = (const LAS float*)(lds + AT_RPB);
    LAS float* mrg = (LAS float*)(lds + AT_MRG) + h * 1088;
    float m_run = -3.0e38f, l_run = 0.f;
    f32x4 O[4];
#pragma unroll
    for (int d = 0; d < 4; ++d) O[d] = (f32x4){0.f, 0.f, 0.f, 0.f};
    const bool active = lat || part == 1;
    if (active) {
        const bf16* Qs = (lat && part == 0) ? QROT : QPL;
        bf16x8 qf[2];
#pragma unroll
        for (int ks = 0; ks < 2; ++ks) qf[ks] = *(const bf16x8*)(Qs + (size_t)(qrow0 + fr) * 256 + h * 64 + ks * 32 + fq * 8);
        f32x4 S[16];
#pragma unroll
        for (int kt = 0; kt < 16; ++kt) { const int kk = kt * 16 + fr;
            const size_t krow = part == 0 ? (size_t)(b * SEQ + (kr0 + (kk >> 5)) * 64 + kc0 + (kk & 31)) : (size_t)(ML + b * CTXL + kk);
            const bf16x8 k0 = *(const bf16x8*)(KR + krow * 256 + h * 64 + fq * 8), k1 = *(const bf16x8*)(KR + krow * 256 + h * 64 + 32 + fq * 8);
            S[kt] = (f32x4){0.f, 0.f, 0.f, 0.f}; mfma16(S[kt], k0, qf[0]); mfma16(S[kt], k1, qf[1]); }
        DRAIN16(S);
        if (part == 0) { const int qcol = jb * 16 + fr, cst = clampi(qcol - 8, 0, 48);
#pragma unroll
            for (int kt = 0; kt < 16; ++kt) { const int drow = kr0 + (kt >> 1) - r + 7;
#pragma unroll
                for (int rg = 0; rg < 4; ++rg) { const int kcol = kc0 + (kt & 1) * 16 + 4 * fq + rg; const bool ok = kcol >= cst && kcol < cst + 16; const int dcol = clampi(kcol - qcol, -15, 15) + 15;
                    S[kt][rg] = ok ? S[kt][rg] + rpbl[h * 465 + drow * 31 + dcol] : -1.0e30f; } } }
        float m = S[0][0];
#pragma unroll
        for (int kt = 0; kt < 16; ++kt) m = fmaxf(fmaxf(m, fmaxf(S[kt][0], S[kt][1])), fmaxf(S[kt][2], S[kt][3]));
        m = fmaxf(m, __shfl_xor(m, 16)); m = fmaxf(m, __shfl_xor(m, 32));
        float ls = 0.f;
#pragma unroll
        for (int kt = 0; kt < 16; ++kt) {
#pragma unroll
            for (int rg = 0; rg < 4; ++rg) { const float p = __expf(S[kt][rg] - m); S[kt][rg] = p; ls += p; } }
        ls += __shfl_xor(ls, 16); ls += __shfl_xor(ls, 32);
#pragma unroll
        for (int c = 0; c < 4; ++c) {
#pragma unroll
            for (int i = 0; i < 8; ++i) { const int p = i * 64 + lane, key = p >> 3, seg = p & 7, kk = c * 64 + key;
                const size_t vrow = part == 0 ? (size_t)(b * SEQ + (kr0 + (kk >> 5)) * 64 + kc0 + (kk & 31)) : (size_t)(ML + b * CTXL + kk);
                *(LAS v4u*)(vbuf + key * 128 + ((((seg >> 1) ^ ((key >> 1) & 3))) << 5) + ((seg & 1) << 4)) = *(const v4u*)(VV + vrow * 256 + h * 64 + seg * 8); }
#pragma unroll
            for (int ksl = 0; ksl < 2; ++ksl) { const int ks = 2 * c + ksl;
                v4u pw; pw.x = pk2(S[2 * ks][0], S[2 * ks][1]); pw.y = pk2(S[2 * ks][2], S[2 * ks][3]); pw.z = pk2(S[2 * ks + 1][0], S[2 * ks + 1][1]); pw.w = pk2(S[2 * ks + 1][2], S[2 * ks + 1][3]);
                const bf16x8 pf = __builtin_bit_cast(bf16x8, pw);
#pragma unroll
                for (int dt = 0; dt < 4; ++dt) { v4i16_t t0, t1;
                    { const int key = ksl * 32 + 4 * fq + (fr >> 2); t0 = __builtin_amdgcn_ds_read_tr16_b64_v4i16((LAS v4i16_t*)(vbuf + key * 128 + ((dt ^ ((key >> 1) & 3)) << 5) + (fr & 3) * 8)); }
                    { const int key = ksl * 32 + 16 + 4 * fq + (fr >> 2); t1 = __builtin_amdgcn_ds_read_tr16_b64_v4i16((LAS v4i16_t*)(vbuf + key * 128 + ((dt ^ ((key >> 1) & 3)) << 5) + (fr & 3) * 8)); }
                    const bf16x8 vf = (bf16x8){t0[0], t0[1], t0[2], t0[3], t1[0], t1[1], t1[2], t1[3]};
                    mfma16(O[dt], vf, pf); } }
        }
        DRAIN4(O);
        m_run = m; l_run = ls;
    }
    if (part == 1) {
#pragma unroll
        for (int dt = 0; dt < 4; ++dt) *(LAS f32x4*)(mrg + fr * 64 + dt * 16 + 4 * fq) = O[dt];
        if (fq == 0) { mrg[1024 + fr] = m_run; mrg[1040 + fr] = l_run; }
    }
    __syncthreads();
    if (part == 0) {
        const float m1 = mrg[1024 + fr], l1 = mrg[1040 + fr], M = fmaxf(m_run, m1), a0 = __expf(m_run - M), a1 = __expf(m1 - M), inv = 1.f / (l_run * a0 + l1 * a1);
#pragma unroll
        for (int dt = 0; dt < 4; ++dt) { const f32x4 o1 = *(const LAS f32x4*)(mrg + fr * 64 + dt * 16 + 4 * fq);
            st4bf(BRd + (size_t)(qrow0 + fr) * 256 + h * 64 + dt * 16 + 4 * fq, (O[dt] * a0 + o1 * a1) * inv); }
    }
    __syncthreads();
}
__device__ __forceinline__ int block_excl_scan(int v, LAS int* ws8, int lane, int wave) {
    int x = v;
#pragma unroll
    for (int o = 1; o < 64; o <<= 1) { const int y = __shfl_up(x, o); if (lane >= o) x += y; }
    if (lane == 63) ws8[wave] = x;
    __syncthreads();
    int base = 0;
#pragma unroll
    for (int w = 0; w < 8; ++w) base += (w < wave) ? ws8[w] : 0;
    __syncthreads();
    return base + x - v;
}
template <int PER, bool ALLV>
__device__ __forceinline__ void topk_unit(PH_ARGS, const int rowbase, const int n, const int C, const int e, const int sbase, const bool writepad) {
    const float* AFF = WSP(float, WS_AFF); int* SEL = WSP(int, WS_SEL); int* IDX = WSP(int, WS_IDX); float* GATE = WSP(float, WS_GATE);
    LAS unsigned* hist = (LAS unsigned*)lds; LAS unsigned* sh = hist + 256; LAS int* ws8 = (LAS int*)(hist + 272);
    unsigned key[PER]; bool valid[PER];
#pragma unroll
    for (int i = 0; i < PER; ++i) { const int tok = tid * PER + i; valid[i] = ALLV ? true : (tok < n); key[i] = valid[i] ? __float_as_uint(AFF[(size_t)(rowbase + tok) * 16 + e]) : 0u; }
    unsigned prefix = 0u, mask = 0u, rem = (unsigned)C;
#pragma unroll 1
    for (int pass = 0; pass < 4; ++pass) { const int shift = 24 - 8 * pass;
        if (tid < 256) hist[tid] = 0u;
        __syncthreads();
#pragma unroll
        for (int i = 0; i < PER; ++i) if (valid[i] && (key[i] & mask) == prefix) atomicAdd((unsigned*)&hist[(key[i] >> shift) & 255u], 1u);
        __syncthreads();
        if (wave == 0) { unsigned c0 = hist[255 - 4 * lane], c1 = hist[254 - 4 * lane], c2 = hist[253 - 4 * lane], c3 = hist[252 - 4 * lane];
            const unsigned s = c0 + c1 + c2 + c3; unsigned x = s;
#pragma unroll
            for (int o = 1; o < 64; o <<= 1) { const unsigned y = __shfl_up(x, o); if (lane >= o) x += y; }
            const unsigned excl = x - s;
            if (excl < rem && rem <= x) { unsigned cum = excl; int bin; unsigned nr;
                if (cum + c0 >= rem) { bin = 255 - 4 * lane; nr = rem - cum; }
                else { cum += c0; if (cum + c1 >= rem) { bin = 254 - 4 * lane; nr = rem - cum; }
                else { cum += c1; if (cum + c2 >= rem) { bin = 253 - 4 * lane; nr = rem - cum; }
                else { cum += c2; bin = 252 - 4 * lane; nr = rem - cum; } } }
                sh[0] = (unsigned)bin; sh[1] = nr; } }
        __syncthreads();
        prefix |= sh[0] << shift; mask |= 255u << shift; rem = sh[1];
    }
    __syncthreads();
    const unsigned T = prefix;
    int neq = 0;
#pragma unroll
    for (int i = 0; i < PER; ++i) neq += (valid[i] && key[i] == T) ? 1 : 0;
    const int eqbase = block_excl_scan(neq, ws8, lane, wave);
    unsigned take = 0u; int nsel = 0, eqs = 0;
#pragma unroll
    for (int i = 0; i < PER; ++i) { const bool iseq = valid[i] && key[i] == T; const bool tk = valid[i] && (key[i] > T || (iseq && (unsigned)(eqbase + eqs) < rem)); eqs += iseq ? 1 : 0; if (tk) { take |= 1u << i; ++nsel; } }
    const int sb = block_excl_scan(nsel, ws8, lane, wave);
    int cnt = 0;
#pragma unroll
    for (int i = 0; i < PER; ++i) { const int tok = tid * PER + i;
        if (valid[i]) { if ((take >> i) & 1u) { const int slot = sbase + sb + cnt; ++cnt; IDX[e * ESTR + slot] = rowbase + tok; GATE[e * ESTR + slot] = __uint_as_float(key[i]); SEL[(size_t)(rowbase + tok) * 16 + e] = slot; }
                        else SEL[(size_t)(rowbase + tok) * 16 + e] = -1; } }
    if (writepad) for (int i = tid; i < ESTR - 2112; i += 512) { IDX[e * ESTR + 2112 + i] = 0; GATE[e * ESTR + 2112 + i] = 0.f; }
    __syncthreads();
}
__device__ __forceinline__ void gather_rows(PH_ARGS, const int tpe) {
    const int gw = bid * 8 + wave, NGW = G * 8, per = tpe * 256; const int* IDX = WSP(int, WS_IDX); const bf16* H = WSP(bf16, WS_H); bf16* XE = WSP(bf16, WS_XE);
    for (int i = gw; i < NE * per; i += NGW) { const int e = i / per, s = i % per, rg = e * ESTR + s; const int src = IDX[rg];
        const v4u a = *(const v4u*)(H + (size_t)src * 1024 + lane * 8), b = *(const v4u*)(H + (size_t)src * 1024 + 512 + lane * 8);
        *(v4u*)(XE + (size_t)rg * 1024 + lane * 8) = a; *(v4u*)(XE + (size_t)rg * 1024 + 512 + lane * 8) = b; }
}
__device__ __forceinline__ void combine_rows(PH_ARGS, const int l) {
    const int gw = bid * 8 + wave, NGW = G * 8; const int nrows = l == 0 ? MT : ML;
    const int* SEL = WSP(int, WS_SEL); const bf16* YB = WSP(bf16, WS_XE); float* X = WSP(float, WS_X); bf16* H = WSP(bf16, WS_H); const float* MOD = WSP(float, WS_MOD);
    for (int row = gw; row < nrows; row += NGW) {
        const int r = row < SEQ ? 0 : (row < ML ? 1 : 2);
        float acc[2][8];
#pragma unroll
        for (int j = 0; j < 2; ++j)
#pragma unroll
            for (int i = 0; i < 8; ++i) acc[j][i] = 0.f;
        const int myslot = lane < 16 ? SEL[(size_t)row * 16 + lane] : -1;
#pragma unroll
        for (int e = 0; e < 16; ++e) { const int s = __shfl(myslot, e);
            if (s >= 0) { const bf16* y = YB + (size_t)(e * ESTR + s) * 1024 + lane * 8;
#pragma unroll
                for (int j = 0; j < 2; ++j) { const v4u w = *(const v4u*)(y + 512 * j);
                    acc[j][0] += bflo(w.x); acc[j][1] += bfhi(w.x); acc[j][2] += bflo(w.y); acc[j][3] += bfhi(w.y); acc[j][4] += bflo(w.z); acc[j][5] += bfhi(w.z); acc[j][6] += bflo(w.w); acc[j][7] += bfhi(w.w); } } }
        const float* gt2 = MOD + (l * 3 + r) * 6144 + 5 * 1024; float* xr = X + (size_t)row * 1024;
        float xv[2][8]; float ss = 0.f;
#pragma unroll
        for (int j = 0; j < 2; ++j) { const int o = 8 * lane + 512 * j; const f32x4 x0 = *(const f32x4*)(xr + o), x1 = *(const f32x4*)(xr + o + 4), g0 = *(const f32x4*)(gt2 + o), g1 = *(const f32x4*)(gt2 + o + 4);
#pragma unroll
            for (int i = 0; i < 4; ++i) { xv[j][i] = x0[i] + g0[i] * acc[j][i]; xv[j][4 + i] = x1[i] + g1[i] * acc[j][4 + i]; }
#pragma unroll
            for (int i = 0; i < 8; ++i) ss += xv[j][i] * xv[j][i]; }
        const float rs = 1.0f / sqrtf(wave_sum(ss) * (1.f / 1024.f) + 1e-6f);
        if (l == 0) {
            const float* md = MOD + (1 * 3 + r) * 6144; const float* g = INP(6) + 1024;
#pragma unroll
            for (int j = 0; j < 2; ++j) { const int o = 8 * lane + 512 * j;
                *(f32x4*)(xr + o) = (f32x4){xv[j][0], xv[j][1], xv[j][2], xv[j][3]}; *(f32x4*)(xr + o + 4) = (f32x4){xv[j][4], xv[j][5], xv[j][6], xv[j][7]};
                float hv[8];
#pragma unroll
                for (int i = 0; i < 8; ++i) hv[i] = xv[j][i] * rs * g[o + i] * (1.f + md[1024 + o + i]) + md[o + i];
                v4u w; w.x = pk2(hv[0], hv[1]); w.y = pk2(hv[2], hv[3]); w.z = pk2(hv[4], hv[5]); w.w = pk2(hv[6], hv[7]);
                *(v4u*)(H + (size_t)row * 1024 + o) = w; }
        } else {
            const float* g = INP(27); float* orow = PTRV(28, float) + (size_t)row * 1024;
#pragma unroll
            for (int j = 0; j < 2; ++j) { const int o = 8 * lane + 512 * j;
                *(f32x4*)(orow + o) = (f32x4){xv[j][0] * rs * g[o + 0], xv[j][1] * rs * g[o + 1], xv[j][2] * rs * g[o + 2], xv[j][3] * rs * g[o + 3]};
                *(f32x4*)(orow + o + 4) = (f32x4){xv[j][4] * rs * g[o + 4], xv[j][5] * rs * g[o + 5], xv[j][6] * rs * g[o + 6], xv[j][7] * rs * g[o + 7]}; }
        }
    }
}


#ifdef DBG_STOP
__device__ __forceinline__ void debug_out(PH_ARGS) {
    float* out = PTRV(28, float);
    const int gt = bid * 512 + tid, GT = G * 512;
    for (size_t i = gt; i < (size_t)ML * 1024; i += GT) { const size_t row = i >> 10; const int c = (int)(i & 1023); float v = 0.f;
#if DBG_STOP == 2
        v = bflo(WSP(bf16, WS_H)[row * 1024 + c]) + WSP(float, WS_MOD)[(i % 36864)] + bflo(WSP(bf16, WS_WIN)[i % (6400 * 1024)]) + bflo(WSP(bf16, WS_WGU)[i]) + bflo(WSP(bf16, WS_WDN)[i]) + bflo(WSP(bf16, WS_WO)[i % (1024*1024)]) + bflo(WSP(bf16, WS_WBR)[i % (1024*1024)]);
#elif DBG_STOP == 3
        v = bflo(WSP(bf16, WS_AUV)[row * 512 + (c & 511)]) + bflo(WSP(bf16, WS_YF)[row * 512 + (c & 511)]) + bflo(WSP(bf16, WS_CY)[row * 256 + (c & 255)]) + bflo(WSP(bf16, WS_QPL)[row * 256 + (c & 255)])
          + bflo(WSP(bf16, WS_QROT)[row * 256 + (c & 255)]) + bflo(WSP(bf16, WS_KR)[row * 256 + (c & 255)]) + bflo(WSP(bf16, WS_VV)[row * 256 + (c & 255)])
          + bflo(WSP(bf16, WS_G)[row * 4096 + c]) + bflo(WSP(bf16, WS_G)[row * 4096 + 1024 + c]) + bflo(WSP(bf16, WS_G)[row * 4096 + 2048 + c]) + bflo(WSP(bf16, WS_G)[row * 4096 + 3072 + c]);
#elif DBG_STOP == 4
        v = bflo(WSP(bf16, WS_BR)[(size_t)(0 * MT + row) * 256 + (c & 255)]) + bflo(WSP(bf16, WS_BR)[(size_t)(2 * MT + row) * 256 + (c & 255)]) + bflo(WSP(bf16, WS_FA)[i % ((size_t)8 << 20)]);
#elif DBG_STOP == 21
        v = bflo(WSP(bf16, WS_T1T)[i % 16384]) * 1.001f + bflo(WSP(bf16, WS_T2T)[i % 32768]) * 1.003f + WSP(float, WS_TW)[i % 16384] + WSP(float, WS_ROPEC)[i % 2048] + WSP(float, WS_ROPES)[i % 2048] + WSP(float, WS_CS256)[i % 512] + bflo(WSP(bf16, WS_WSP)[i % 65536]);
#elif DBG_STOP == 31 || DBG_STOP == 44
        v = WSP(float, WS_TW)[i % 16384] * 1.001f + WSP(float, WS_TW)[(i + 5) % 16384];
#elif DBG_STOP == 45 || DBG_STOP == 32
        { const int e2 = (int)(i % 16384), j = e2 >> 1, k1 = j >> 7, n2 = j & 127; float s, c; sincospif((float)(k1 * n2) / 4096.f, &s, &c); v = (WSP(float, WS_TW)[e2] - ((e2 & 1) ? s : c)) * 1.0e6f; }
#elif DBG_STOP == 41
        v = bflo(WSP(bf16, WS_BR)[(size_t)(0 * MT + row) * 256 + (c & 255)]) * 1.001f + bflo(WSP(bf16, WS_BR)[(size_t)(0 * MT + row) * 256 + ((c + 7) & 255)]);
#elif DBG_STOP == 42
        v = bflo(WSP(bf16, WS_BR)[(size_t)(2 * MT + row) * 256 + (c & 255)]) * 1.001f + bflo(WSP(bf16, WS_BR)[(size_t)(2 * MT + row) * 256 + ((c + 7) & 255)]);
#elif DBG_STOP == 43
        v = bflo(WSP(bf16, WS_FA)[i % ((size_t)8 << 20)]) * 1.001f + bflo(WSP(bf16, WS_FA)[(i + 7) % ((size_t)8 << 20)]);
#elif DBG_STOP == 5
        v = bflo(WSP(bf16, WS_BR)[(size_t)(1 * MT + row) * 256 + (c & 255)]) + bflo(WSP(bf16, WS_BR)[(size_t)(3 * MT + row) * 256 + (c & 255)]);
#elif DBG_STOP == 6
        v = bflo(WSP(bf16, WS_MB)[row * 1024 + c]);
#elif DBG_STOP == 7
        v = WSP(float, WS_X)[row * 1024 + c];
#elif DBG_STOP == 8
        v = bflo(WSP(bf16, WS_H)[row * 1024 + c]) + WSP(float, WS_AFF)[row * 16 + (c & 15)];
#elif DBG_STOP == 9
        v = (float)WSP(int, WS_SEL)[row * 16 + (c & 15)] + WSP(float, WS_GATE)[i % (16 * 2304)] + (float)WSP(int, WS_IDX)[i % (16 * 2304)];
#elif DBG_STOP == 10
        v = bflo(WSP(bf16, WS_XE)[i]) + bflo(WSP(bf16, WS_XE)[i + (size_t)ML * 1024]);
#elif DBG_STOP == 11
        v = bflo(WSP(bf16, WS_ACT)[i]) + bflo(WSP(bf16, WS_ACT)[i + (size_t)ML * 1024]);
#elif DBG_STOP == 12
        v = bflo(WSP(bf16, WS_XE)[i]) + bflo(WSP(bf16, WS_XE)[i + (size_t)ML * 1024]);
#else
        v = WSP(float, WS_X)[row * 1024 + c] + bflo(WSP(bf16, WS_H)[row * 1024 + c]);
#endif
#ifdef DBG_AMP
        v = (float)(__float_as_uint(v) & 0xFFFFu);
#endif
        out[i] = v; }
}
#endif
__global__ void __launch_bounds__(512, 2) mega(Args A) {
    extern __shared__ __attribute__((aligned(16))) unsigned char lds_raw[];
    LAS unsigned char* lds0 = (LAS unsigned char*)lds_raw;
    volatile LAS unsigned* MISC = (volatile LAS unsigned*)(lds0 + MISC_OFF);
    const int tid = threadIdx.x, lane = tid & 63, wave = __builtin_amdgcn_readfirstlane(tid >> 6), bid = blockIdx.x, G = gridDim.x;
    for (int u = tid; u < (LDS_BYTES - MISC_OFF) / 4; u += 512) ((LAS unsigned*)(lds0 + MISC_OFF))[u] = 0u;
    __syncthreads();
    if (tid == 0) { typedef unsigned u2v_t __attribute__((ext_vector_type(2)));
#pragma unroll
        for (int i = 0; i < 30; ++i) { const unsigned long long p = i < 28 ? (unsigned long long)A.in[i] : (i == 28 ? (unsigned long long)A.out : (unsigned long long)A.ws);
            *(LAS u2v_t*)(lds0 + PTAB_OFF + 8 * i) = (u2v_t){(unsigned)p, (unsigned)(p >> 32)}; } }
    __syncthreads();
    const int lo = A.ph_lo, hi = A.ph_hi;
    XcdBarrier bar; bar.bar = (unsigned*)(A.ws + WS_CTL) + CW_BAR; bar.x = 0; bar.st = nullptr;
    if (hi - lo > 1) bar = xcd_barrier_post((unsigned*)(A.ws + WS_CTL) + CW_BAR, MISC + 8);
#define PH_CALL lds, tl_, (tl_ & 63), wv_, bl_, G_
#ifdef TS_I
    if (bid == 0 && tid == 0) ((unsigned long long*)(A.ws + 65536))[lo] = rt();
#endif
#pragma unroll 1
#ifdef REP_PH
    for (int it_ = lo; it_ < hi + (REP_N - 1); ++it_) { const int ph = it_ < REP_PH ? it_ : (it_ < REP_PH + REP_N ? REP_PH : it_ - (REP_N - 1));
#else
    for (int ph = lo; ph < hi; ++ph) {
#endif
        int tl_ = tid; asm volatile("" : "+v"(tl_)); int bl_ = bid; asm volatile("" : "+s"(bl_)); int wv_ = wave; asm volatile("" : "+s"(wv_)); int G_ = G; asm volatile("" : "+s"(G_)); unsigned ldsb_ = (unsigned)(uintptr_t)lds0; asm volatile("" : "+s"(ldsb_)); LAS unsigned char* lds = (LAS unsigned char*)(uintptr_t)ldsb_;
        const int l = ph < 13 ? 0 : 1, kind = ph >= 99 ? 99 : (ph < 2 ? ph : 2 + (ph - 2 - 11 * l));
        const int ntm = l == 0 ? 66 : 64, tpe = l == 0 ? 9 : 8;
        switch (kind) {
#ifdef DBG_STOP
        case 99: debug_out(PH_CALL); break;
#endif
        case 0: {
#ifndef DIS_MOD
            mod_gemv(PH_CALL); make_tables(PH_CALL);
#endif
#ifndef DIS_CVT
            convert_weights(PH_CALL, 0);
#endif
        } break;
        case 1: {
#ifndef DIS_N1
            norm1_l0(PH_CALL);
#endif
        } break;
        case 2: {
            pg8::Gemm g{WSP(bf16, WS_H), WSP(bf16, WS_WIN), MT, NIN, 1024}; pg8::StaticOrder S; S.init(MT, NIN, G_, bl_);
            EpiIn E{WSP(bf16, WS_AUV), WSP(bf16, WS_YF), WSP(bf16, WS_CY), WSP(bf16, WS_QPL), WSP(bf16, WS_QROT), WSP(bf16, WS_KR), WSP(bf16, WS_VV), WSP(bf16, WS_G), WSP(float, WS_ROPEC), WSP(float, WS_ROPES)};
#ifndef DIS_GIN
            pg8::gemm_phase<EpiIn, pg8::StaticOrder, true, true>(lds, g, S, E);
#endif
        } break;
        case 3: {
#ifndef DIS_F1
            if (bl_ < 256) { f1_stage_tables(PH_CALL); for (int u = bl_; u < 256; u += G_) f1_unit(PH_CALL, u); }
#endif
            const int nconv = l == 0 ? 264 : 256, ngm = l == 0 ? 132 : 128;
#ifndef DIS_CONV
            for (int u = bl_; u < nconv; u += G_) conv_unit(PH_CALL, l, u);
#endif
#ifndef DIS_GMLP
            for (int u = G_ - 1 - bl_; u < ngm; u += G_) gmlp_unit(PH_CALL, l, u);
#endif
#ifndef DIS_CDFT
            if (l == 0) for (int u = bl_; u < 256; u += G_) ctxdft_unit(PH_CALL, u);
#endif
        } break;
        case 4: {
#ifndef DIS_F2
            if (bl_ < 256) { f2_stage_tables(PH_CALL); for (int u = bl_; u < 256; u += G_) f2_unit(PH_CALL, u); }
#endif
            { LAS float* rp = (LAS float*)(lds + AT_RPB); const float* src = INP(20) + l * 1860; for (int i = tl_; i < 1860; i += 512) rp[i] = src[i]; }
            __syncthreads();
            const int nat = l == 0 ? 1056 : 1024;
#ifndef DIS_ATT
            for (int u = bl_; u < nat; u += G_) attn_unit(PH_CALL, u);
#endif
        } break;
        case 5: {
#ifndef DIS_GMRG
            merge_phase(PH_CALL, ntm * 16);
#endif
        } break;
        case 6: {
            pg8::Gemm g{WSP(bf16, WS_MB), WSP(bf16, WS_WO), ntm * 256, 1024, 1024}; pg8::StaticOrder S; S.init(ntm * 256, 1024, G_, bl_);
            EpiWout E{l == 0 ? INP(0) : WSP(float, WS_X), l == 0 ? INP(2) : WSP(float, WS_X) + (size_t)ML * 1024, WSP(float, WS_X), WSP(float, WS_MOD) + l * 3 * 6144};
#ifndef DIS_GWO
            pg8::gemm_phase<EpiWout, pg8::StaticOrder, true, true>(lds, g, S, E);
#endif
        } break;
        case 7: {
#ifndef DIS_N2
            norm2_router(PH_CALL, l, ntm * 256);
#endif
        } break;
        case 8: {
#ifndef DIS_TOPK
            const int nun = l == 0 ? 64 : 32;
            for (int u = bl_; u < nun; u += G_) {
                if (u < 32) { const int b = u >> 4, e = u & 15; topk_unit<16, true>(PH_CALL, b * SEQ, SEQ, CAPL, e, b * CAPL, l == 0 && b == 0); }
                else { const int b = (u - 32) >> 4, e = u & 15; topk_unit<1, false>(PH_CALL, ML + b * CTXL, CTXL, CAPC, e, 2048 + b * CAPC, false); }
            }
#endif
        } break;
        case 9: {
#ifndef DIS_GATH
            gather_rows(PH_CALL, tpe);
#endif
        } break;
        case 10: {
            pg8::Gemm g{WSP(bf16, WS_XE), WSP(bf16, WS_WGU), NE * ESTR, NE * 2048, 1024}; GroupOrder S; S.init(tpe, 8, G_, bl_);
            EpiGU E{WSP(bf16, WS_ACT)};
#ifndef DIS_GGU
            pg8::gemm_phase<EpiGU, GroupOrder, true, true>(lds, g, S, E);
#endif
        } break;
        case 11: {
            pg8::Gemm g{WSP(bf16, WS_ACT), WSP(bf16, WS_WDN), NE * ESTR, NE * 1024, 1024}; GroupOrder S; S.init(tpe, 4, G_, bl_);
            EpiDown E{WSP(bf16, WS_XE), WSP(float, WS_GATE)};
#ifndef DIS_GDN
            pg8::gemm_phase<EpiDown, GroupOrder, true, true>(lds, g, S, E);
#endif
        } break;
        default: {
#ifndef DIS_COMB
            combine_rows(PH_CALL, l);
#endif
#ifndef DIS_CVT
            if (l == 0) convert_weights(PH_CALL, 1);
#endif
        } break;
        }
#ifdef TS_I
        { XcdBarrier b3 = bar; b3.bar = (unsigned*)(PTRV(29, unsigned char) + WS_CTL) + CW_BAR; b3.st = (volatile LAS unsigned*)(lds + MISC_OFF) + 8; xcd_barrier(b3);
          if (bid == 0 && tid == 0) ((unsigned long long*)(PTRV(29, unsigned char) + 65536))[ph + 1] = rt(); }
        if (ph + 1 == hi) { XcdBarrier b3 = bar; b3.bar = (unsigned*)(PTRV(29, unsigned char) + WS_CTL) + CW_BAR; b3.st = (volatile LAS unsigned*)(lds + MISC_OFF) + 8; xcd_barrier(b3);
            const unsigned long long* TS = (const unsigned long long*)(PTRV(29, unsigned char) + 65536);
            const float dti = (float)(TS[TS_I + 1] - TS[TS_I]) * 0.01f, dtj = (float)(TS[TS_J + 1] - TS[TS_J]) * 0.01f;
            float* out = PTRV(28, float); const float Av = sqrtf(dti);
            for (size_t i = (size_t)bid * 512 + tid; i < (size_t)ML * 1024; i += (size_t)G * 512) out[i] = (i == 0) ? dtj * 10.f : Av; }
        if (0) {
#else
#ifdef REP_PH
        if (it_ + 1 < hi + (REP_N - 1)) {
#else
        if (ph + 1 < hi) {
#endif
#endif
          XcdBarrier b2 = bar; b2.bar = (unsigned*)(PTRV(29, unsigned char) + WS_CTL) + CW_BAR; unsigned bx_ = bar.x; asm volatile("" : "+s"(bx_)); b2.x = bx_; b2.st = (volatile LAS unsigned*)(lds + MISC_OFF) + 8; xcd_barrier(b2); }
    }
}

extern "C" void kernel_launch(void* const* d_in, const int* in_sizes, int n_in, void* d_out, int out_size, void* d_ws, size_t ws_size, hipStream_t stream) {
    static int grid = 0;
    if (grid == 0) {
        if (n_in != 28 || ws_size < WS_END) { fprintf(stderr, "kernel_launch: unexpected n_in %d / ws %zu\n", n_in, ws_size); grid = -1; return; }
        int dev = 0, cus = 0;
        if (hipGetDevice(&dev) != hipSuccess || hipDeviceGetAttribute(&cus, hipDeviceAttributeMultiprocessorCount, dev) != hipSuccess) { grid = -1; return; }
        if (hipFuncSetAttribute((const void*)mega, hipFuncAttributeMaxDynamicSharedMemorySize, LDS_BYTES) != hipSuccess) { fprintf(stderr, "kernel_launch: hipFuncSetAttribute failed\n"); grid = -1; return; }
        (void)hipGetLastError();
        grid = cus;
    }
    if (grid < 0) return;
    (void)hipMemsetAsync((char*)d_ws + WS_CTL, 0, CTL_ZERO_BYTES, stream);
    Args a{};
    for (int i = 0; i < 28; ++i) a.in[i] = (const float*)d_in[i];
    a.out = (float*)d_out; a.ws = (unsigned char*)d_ws;
#ifdef DBG_STOP
    for (int p = 0; p < (DBG_STOP > 20 ? DBG_STOP / 10 : DBG_STOP); ++p) { a.ph_lo = p; a.ph_hi = p + 1; hipLaunchKernelGGL(mega, dim3(grid), dim3(512), LDS_BYTES, stream, a); }
    a.ph_lo = 99; a.ph_hi = 100; hipLaunchKernelGGL(mega, dim3(grid), dim3(512), LDS_BYTES, stream, a);
#elif N_LAUNCHES == 1
    a.ph_lo = 0; a.ph_hi = NPH;
    hipLaunchKernelGGL(mega, dim3(grid), dim3(512), LDS_BYTES, stream, a);
#else
    for (int p = 0; p < NPH; ++p) { a.ph_lo = p; a.ph_hi = p + 1; hipLaunchKernelGGL(mega, dim3(grid), dim3(512), LDS_BYTES, stream, a); }
#endif
}
```

```cpp
#include <hip/hip_runtime.h>
#include <cstdio>
#include <cstdint>
#define N_LAUNCHES 1
namespace pg8 {
#define PG8_LAS __attribute__((address_space(3)))
typedef unsigned short bf16_t;
typedef short bf16x8 __attribute__((ext_vector_type(8)));
typedef float f32x4 __attribute__((ext_vector_type(4)));
typedef unsigned u32x4 __attribute__((ext_vector_type(4)));
constexpr int BM = 256, BK = 64, HALF = 128, HTB = HALF * BK * 2  , STAGE_BYTES = 8 * HTB, NXCD = 8, WGM = 8;

__host__ __device__ __forceinline__ int lds_byte(int r, int c) { const int st = (r >> 4) * 2 + (c >> 5), rr = r & 15, cc = c & 31, ob = rr * 64 + cc * 2; return st * 1024 + (ob ^ (((ob >> 9) & 1) << 5)); }
__host__ __device__ __forceinline__ void stage_rc(int b, int& R, int& C) { const int st = b / 1024, sb = b % 1024, swz = sb ^ (((sb >> 9) & 1) << 5); R = (st >> 1) * 16 + swz / 64; C = (st & 1) * 32 + (swz % 64) / 2; }
__host__ __device__ __forceinline__ int perm32(int rho) { const int n = rho >> 4, i = rho & 15; return 8 * (i >> 2) + 4 * n + (i & 3); }

struct Unit { int pm, pn; };
struct Gemm { const bf16_t* A; const bf16_t* Bt; int M, N, K; };

struct StaticOrder {
    int nM, nN, nwg, G, c;
    __host__ __device__ void init(int M, int N, int G_, int c_) { nM = M / BM; nN = N / BM; nwg = nM * nN; G = G_; c = c_; }
    __host__ __device__ bool next(int i, Unit& u) const {
        const long L = (long)i * G + c; if (L >= nwg) return false;
        int wgid = (int)L; { const int q = nwg / NXCD, r = nwg % NXCD, xcd = wgid % NXCD, off = wgid / NXCD; wgid = (xcd < r ? xcd * (q + 1) : r * (q + 1) + (xcd - r) * q) + off; }
        const int nig = WGM * nN, gid = wgid / nig, fm = gid * WGM, gsz = (nM - fm) < WGM ? (nM - fm) : WGM;
        u.pm = fm + ((wgid % nig) % gsz); u.pn = (wgid % nig) / gsz; return true;
    }
    __device__ __forceinline__ void a_ready(const Unit&) const {}
    __device__ __forceinline__ void done(const Unit&) const {}
};
__device__ __forceinline__ unsigned cvt_pk_bf16(float lo, float hi) { unsigned r; asm volatile("v_cvt_pk_bf16_f32 %0, %1, %2" : "=v"(r) : "v"(lo), "v"(hi)); return r; }
typedef float f32x2 __attribute__((ext_vector_type(2)));
template <class Epi, class Sched, bool ALIGN_EPI = false, bool SP2 = false>
__device__ __forceinline__ void gemm_phase(PG8_LAS unsigned char* lds, const Gemm g, const Sched& S, const Epi& E) {
    int tid_l = threadIdx.x; asm volatile("" : "+v"(tid_l));
    const int tid = tid_l, wid = __builtin_amdgcn_readfirstlane(tid >> 6), lane = tid & 63, wr = wid >> 2, wc = wid & 3, fr = lane & 15, fq = lane >> 4;
    const int K = g.K, nt = K / BK;
    unsigned voffA[2], voffB[2];
#pragma unroll
    for (int i = 0; i < 2; ++i) { int R, C; stage_rc(tid * 16 + i * 8192, R, C); const int Rb = Epi::PERM ? ((R & ~31) + perm32(R & 31)) : R;
        voffA[i] = (unsigned)(R * K + C) * 2u; voffB[i] = (unsigned)(Rb * K + C) * 2u; }
    const size_t kstep = (size_t)(BK * 2);
    const size_t hstep = (size_t)HALF * K * 2;
    const size_t tstep = 2 * hstep;
    const unsigned ldsw = (unsigned)wid * 1024u;
    const int aoff = lds_byte(wr * 64 + fr, fq * 8), boff = lds_byte(wc * 32 + fr, fq * 8);
#define PG8_SA(b, h) (((b) * 2 + (h)) * HTB)
#define PG8_SB(b, h) ((4 + (b) * 2 + (h)) * HTB)
#define PG8_STAGE(bufoff, gbase, voff) do { _Pragma("unroll") for (int _i = 0; _i < 2; ++_i) \
        __builtin_amdgcn_global_load_lds((const unsigned*)((const char*)(gbase) + (voff)[_i]), (PG8_LAS unsigned*)(lds + (bufoff) + ldsw + _i * 8192), 16, 0, 0); } while (0)
#define PG8_LDA(dst, b, h) do { _Pragma("unroll") for (int m = 0; m < 4; ++m) _Pragma("unroll") for (int k = 0; k < 2; ++k) dst[m][k] = *(const PG8_LAS bf16x8*)(lds + PG8_SA(b, h) + aoff + m * 2048 + k * 1024); } while (0)
#define PG8_LDB(dst, b, h) do { _Pragma("unroll") for (int n = 0; n < 2; ++n) _Pragma("unroll") for (int k = 0; k < 2; ++k) dst[n][k] = *(const PG8_LAS bf16x8*)(lds + PG8_SB(b, h) + boff + n * 2048 + k * 1024); } while (0)
#define PG8_MMA(ai, bj, At, Bt) do { __builtin_amdgcn_s_setprio(1); _Pragma("unroll") for (int m = 0; m < 4; ++m) _Pragma("unroll") for (int n = 0; n < 2; ++n) _Pragma("unroll") for (int k = 0; k < 2; ++k) \
        acc[ai][bj][m][n] = __builtin_amdgcn_mfma_f32_16x16x32_bf16(Bt[n][k], At[m][k], acc[ai][bj][m][n], 0, 0, 0); __builtin_amdgcn_s_setprio(0); } while (0)
#define PG8_WAIT_V(n) asm volatile("s_waitcnt vmcnt(" #n ")" ::: "memory")
#define PG8_WAIT_L(n) asm volatile("s_waitcnt lgkmcnt(" #n ")" ::: "memory")
#define PG8_BAR __builtin_amdgcn_s_barrier()
#define PG8_SCHED __builtin_amdgcn_sched_barrier(0)
    Unit cur, nxt; int ui = 0;
    if (!S.next(0, cur)) return;
    f32x4 acc[2][2][4][2];
#pragma unroll
    for (int a = 0; a < 2; ++a)
#pragma unroll
        for (int b = 0; b < 2; ++b)
#pragma unroll
            for (int m = 0; m < 4; ++m)
#pragma unroll
                for (int n = 0; n < 2; ++n) acc[a][b][m][n] = (f32x4){0.f, 0.f, 0.f, 0.f};
    bf16x8 At[4][2], B0[2][2], B1[2][2];
    const char* cA = (const char*)g.A + (size_t)cur.pm * tstep; const char* cB = (const char*)g.Bt + (size_t)cur.pn * tstep;
    S.a_ready(cur);
    if constexpr (SP2) {
        PG8_STAGE(PG8_SB(0, 0), cB, voffB); PG8_STAGE(PG8_SB(0, 1), cB + hstep, voffB); PG8_STAGE(PG8_SA(0, 0), cA, voffA); PG8_STAGE(PG8_SA(0, 1), cA + hstep, voffA);
        if (wr == 1) PG8_BAR;
        PG8_WAIT_V(2); PG8_BAR;
        PG8_STAGE(PG8_SB(1, 0), cB + kstep, voffB); PG8_STAGE(PG8_SA(1, 0), cA + kstep, voffA); PG8_STAGE(PG8_SB(1, 1), cB + hstep + kstep, voffB);
        PG8_WAIT_V(6); PG8_BAR;
    } else {
        PG8_STAGE(PG8_SB(0, 0), cB, voffB); PG8_STAGE(PG8_SA(0, 0), cA, voffA); PG8_STAGE(PG8_SB(0, 1), cB + hstep, voffB); PG8_STAGE(PG8_SA(0, 1), cA + hstep, voffA);
        if (wr == 1) PG8_BAR;
        PG8_WAIT_V(4); PG8_BAR;
        PG8_STAGE(PG8_SB(1, 0), cB + kstep, voffB); PG8_STAGE(PG8_SA(1, 0), cA + kstep, voffA); PG8_STAGE(PG8_SB(1, 1), cB + hstep + kstep, voffB);
        PG8_WAIT_V(6); PG8_BAR;
    }
    for (;;) {
        const bool has_next = S.next(ui + 1, nxt);
        const char* nA = has_next ? (const char*)g.A + (size_t)nxt.pm * tstep : cA; const char* nB = has_next ? (const char*)g.Bt + (size_t)nxt.pn * tstep : cB;
#pragma unroll 1
        for (int t = 0; t < nt; t += 2) {
            const bool last = (t == nt - 2);
            const char* a1 = cA + (size_t)(t + 1) * kstep;
            const char* a2 = last ? nA : cA + (size_t)(t + 2) * kstep; const char* b2 = last ? nB : cB + (size_t)(t + 2) * kstep;
            const char* a3 = a2 + kstep; const char* b3 = b2 + kstep;
            if (last && has_next) S.a_ready(nxt);
            if constexpr (SP2) {
            PG8_LDB(B0, 0, 0); PG8_LDB(B1, 0, 1); PG8_SCHED; PG8_LDA(At, 0, 0); PG8_STAGE(PG8_SA(1, 1), a1 + hstep, voffA);
            PG8_WAIT_V(8); PG8_WAIT_L(0); PG8_BAR; PG8_MMA(0, 0, At, B0); PG8_MMA(0, 1, At, B1); PG8_BAR; PG8_SCHED;
            PG8_LDA(At, 0, 1); PG8_STAGE(PG8_SB(0, 0), b2, voffB); PG8_STAGE(PG8_SB(0, 1), b2 + hstep, voffB); PG8_STAGE(PG8_SA(0, 0), a2, voffA);
            PG8_WAIT_V(8); PG8_WAIT_L(0); PG8_BAR; PG8_MMA(1, 0, At, B0); PG8_MMA(1, 1, At, B1); PG8_BAR; PG8_SCHED;
            PG8_LDB(B0, 1, 0); PG8_LDB(B1, 1, 1); PG8_SCHED; PG8_LDA(At, 1, 0); PG8_STAGE(PG8_SA(0, 1), a2 + hstep, voffA);
            PG8_WAIT_V(8); PG8_WAIT_L(0); PG8_BAR; PG8_MMA(0, 0, At, B0); PG8_MMA(0, 1, At, B1); PG8_BAR; PG8_SCHED;
            PG8_LDA(At, 1, 1); PG8_STAGE(PG8_SB(1, 0), b3, voffB); PG8_STAGE(PG8_SB(1, 1), b3 + hstep, voffB); PG8_STAGE(PG8_SA(1, 0), a3, voffA);
            PG8_WAIT_V(8); PG8_WAIT_L(0); PG8_BAR; PG8_MMA(1, 0, At, B0); PG8_MMA(1, 1, At, B1); PG8_BAR; PG8_SCHED;
            } else {
            PG8_LDB(B0, 0, 0); PG8_SCHED; PG8_LDA(At, 0, 0); PG8_STAGE(PG8_SA(1, 1), a1 + hstep, voffA);
            PG8_WAIT_L(8); PG8_BAR; PG8_WAIT_L(0); PG8_MMA(0, 0, At, B0); PG8_BAR; PG8_SCHED;
            PG8_LDB(B1, 0, 1); PG8_STAGE(PG8_SB(0, 0), b2, voffB);
            PG8_BAR; PG8_WAIT_L(0); PG8_MMA(0, 1, At, B1); PG8_BAR;
            PG8_LDA(At, 0, 1); PG8_STAGE(PG8_SA(0, 0), a2, voffA);
            PG8_BAR; PG8_WAIT_L(0); PG8_MMA(1, 0, At, B0); PG8_BAR; PG8_SCHED;
            PG8_STAGE(PG8_SB(0, 1), b2 + hstep, voffB);
            PG8_WAIT_V(6); PG8_BAR; PG8_MMA(1, 1, At, B1); PG8_BAR;
            PG8_LDB(B0, 1, 0); PG8_SCHED; PG8_LDA(At, 1, 0); PG8_STAGE(PG8_SA(0, 1), a2 + hstep, voffA);
            PG8_WAIT_L(8); PG8_BAR; PG8_WAIT_L(0); PG8_MMA(0, 0, At, B0); PG8_BAR; PG8_SCHED;
            PG8_LDB(B1, 1, 1); PG8_STAGE(PG8_SB(1, 0), b3, voffB);
            PG8_BAR; PG8_WAIT_L(0); PG8_MMA(0, 1, At, B1); PG8_BAR;
            PG8_LDA(At, 1, 1); PG8_STAGE(PG8_SA(1, 0), a3, voffA);
            PG8_BAR; PG8_WAIT_L(0); PG8_MMA(1, 0, At, B0); PG8_BAR; PG8_SCHED;
            PG8_STAGE(PG8_SB(1, 1), b3 + hstep, voffB);
            PG8_WAIT_V(6); PG8_BAR; PG8_MMA(1, 1, At, B1); PG8_BAR;
            }
        }
        if constexpr (ALIGN_EPI) { if (wr == 0) PG8_BAR; }
        if constexpr (!Epi::AFTER_DRAIN) { int t2_ = threadIdx.x; asm volatile("" : "+v"(t2_)); E(acc, cur, wr, wc, t2_ & 15, (t2_ >> 4) & 3); S.done(cur); }
        if (!has_next) break;
#pragma unroll
        for (int a = 0; a < 2; ++a)
#pragma unroll
            for (int b = 0; b < 2; ++b)
#pragma unroll
                for (int m = 0; m < 4; ++m)
#pragma unroll
                    for (int n = 0; n < 2; ++n) acc[a][b][m][n] = (f32x4){0.f, 0.f, 0.f, 0.f};
        cur = nxt; cA = nA; cB = nB; ++ui;
        if constexpr (ALIGN_EPI) { if (wr == 1) PG8_BAR; }
    }
    PG8_WAIT_V(0);
    if constexpr (!ALIGN_EPI) { if (wr == 0) PG8_BAR; }
    PG8_BAR;
    if constexpr (Epi::AFTER_DRAIN) { E.fused(acc, cur, wr, wc, fr, fq, lds, wid, lane); S.done(cur); }
#undef PG8_SA
#undef PG8_SB
#undef PG8_STAGE
#undef PG8_LDA
#undef PG8_LDB
#undef PG8_MMA
#undef PG8_WAIT_V
#undef PG8_WAIT_L
#undef PG8_BAR
#undef PG8_SCHED
}
}
#define GAS __attribute__((address_space(1)))
#define LAS __attribute__((address_space(3)))
typedef unsigned short bf16;
typedef unsigned v4u __attribute__((ext_vector_type(4)));
typedef float f32x4 __attribute__((ext_vector_type(4)));
typedef short bf16x8 __attribute__((ext_vector_type(8)));
typedef GAS unsigned gu32;
typedef GAS unsigned long long gu64;
#define RLX_AGENT __ATOMIC_RELAXED, __HIP_MEMORY_SCOPE_AGENT
#define LDS_WAIT() asm volatile("s_waitcnt lgkmcnt(0)" ::: "memory")
#define VM_WAIT() asm volatile("s_waitcnt vmcnt(0)" ::: "memory")
__device__ __forceinline__ unsigned long long rt() { return __builtin_amdgcn_s_memrealtime(); }
__device__ __forceinline__ unsigned f2bf(float f) { unsigned u = __builtin_bit_cast(unsigned, f); return (u + 0x7fffu + ((u >> 16) & 1u)) >> 16; }
typedef float f32x2_t __attribute__((ext_vector_type(2))); typedef __bf16 bf16x2_t __attribute__((ext_vector_type(2)));
__device__ __forceinline__ unsigned pk2(float lo, float hi) { const f32x2_t v = {lo, hi}; const bf16x2_t b = __builtin_convertvector(v, bf16x2_t); return __builtin_bit_cast(unsigned, b); }

#define XB_TMO      128
#define XB_XCNT(j)  (256  + 64 * (j))
#define XB_XSUB(j)  (1280 + 64 * (j))
#define XB_XGEN(j)  (2304 + 64 * (j))
#define XB_TOP      3328
#define XB_TOPGEN   3392
#define XCD_BAR_WORDS 3456
#define XB_SPIN_CAP (1u << 18)

__device__ __forceinline__ unsigned xb_ld(unsigned* p)              { return __hip_atomic_load(p, __ATOMIC_RELAXED, __HIP_MEMORY_SCOPE_AGENT); }
__device__ __forceinline__ unsigned xb_add(unsigned* p, unsigned v) { return __hip_atomic_fetch_add(p, v, __ATOMIC_RELAXED, __HIP_MEMORY_SCOPE_AGENT); }
__device__ __forceinline__ unsigned xb_xcc_id() { return (unsigned)__builtin_amdgcn_s_getreg((3 << 11) | 20) & 0xFu; }
#define XB_SPIN(cond, bar) do { unsigned _sp = 0; while (cond) { __builtin_amdgcn_s_sleep(1); \
    if ((++_sp & 255u) == 0u) { if (xb_ld(&(bar)[XB_TMO])) break; if (_sp > XB_SPIN_CAP) { atomicAdd(&(bar)[XB_TMO], 1u); break; } } } } while (0)

struct XcdBarrier {
    unsigned* bar; unsigned x;
    volatile LAS unsigned* st;
};

__device__ __forceinline__ XcdBarrier xcd_barrier_post(unsigned* bar, volatile LAS unsigned* st) {
    XcdBarrier b; b.bar = bar; b.x = xb_xcc_id(); b.st = st;
    if (threadIdx.x == 0) (void)xb_add(&bar[XB_XCNT(b.x)], 1u);
    return b;
}
__device__ __forceinline__ void xcd_barrier_complete(unsigned* bar, unsigned x, unsigned& nloc, unsigned& nx) {
    const unsigned G = gridDim.x * gridDim.y * gridDim.z;
    unsigned sum, cnt, mine, sp = 0u;
    for (;;) {
        sum = 0u; cnt = 0u; mine = 0u;
#pragma unroll
        for (unsigned j = 0; j < 16; ++j) { const unsigned c = xb_ld(&bar[XB_XCNT(j)]); sum += c; cnt += (c > 0u) ? 1u : 0u; mine = (j == x) ? c : mine; }
        if (sum == G) break;
        __builtin_amdgcn_s_sleep(1);
        if ((++sp & 255u) == 0u) { if (xb_ld(&bar[XB_TMO])) break; if (sp > XB_SPIN_CAP) { atomicAdd(&bar[XB_TMO], 1u); break; } }
    }
    nloc = mine > 0u ? mine : 1u; nx = cnt > 0u ? cnt : 1u;
}

__device__ __forceinline__ void xcd_barrier(const XcdBarrier& b) {
    asm volatile("s_waitcnt vmcnt(0)" ::: "memory");
    __syncthreads();
    if (threadIdx.x == 0) {
        unsigned* bar = b.bar;
        __builtin_amdgcn_s_waitcnt(0);
        unsigned nloc = b.st[0], nx = b.st[1];
        if (nloc == 0u) { xcd_barrier_complete(bar, b.x, nloc, nx); b.st[0] = nloc; b.st[1] = nx; }
        const unsigned old = xb_add(&bar[XB_XSUB(b.x)], 1u);
        const unsigned gen = old / nloc;
        if (old + 1u == (gen + 1u) * nloc) {
            __builtin_amdgcn_fence(__ATOMIC_RELEASE, "agent");
            asm volatile("s_waitcnt vmcnt(0)" ::: "memory");
            const unsigned og = xb_add(&bar[XB_TOP], 1u);
            const unsigned tg = og / nx;
            if (og + 1u == (tg + 1u) * nx) xb_add(&bar[XB_TOPGEN], 1u);
            else XB_SPIN(xb_ld(&bar[XB_TOPGEN]) == tg, bar);
            __builtin_amdgcn_fence(__ATOMIC_ACQUIRE, "agent");
            xb_add(&bar[XB_XGEN(b.x)], 1u);
            asm volatile("s_waitcnt vmcnt(0)" ::: "memory");
        } else {
            XB_SPIN(xb_ld(&bar[XB_XGEN(b.x)]) == gen, bar);
            __builtin_amdgcn_fence(__ATOMIC_ACQUIRE, "agent");
            asm volatile("s_waitcnt vmcnt(0)" ::: "memory");
        }
    }
    __syncthreads();
}
constexpr int DM = 1024, SEQ = 8192, NBATCH = 2, CTXL = 256;
constexpr int ML = NBATCH * SEQ, MC = NBATCH * CTXL, MT = ML + MC;
constexpr int NIN = 6400;
constexpr int NE = 16, ESTR = 2304, CAPL = 1024, CAPC = 32;
constexpr int NPH = 24;
constexpr size_t MiB = 1u << 20;
constexpr size_t WS_CTL = 0, CTL_ZERO_BYTES = 1 * MiB;
constexpr size_t WS_MOD = 1 * MiB;
constexpr size_t WS_ROPEC = 1 * MiB + 256 * 1024, WS_ROPES = WS_ROPEC + 8192;
constexpr size_t WS_TW = 1 * MiB + 512 * 1024;
constexpr size_t WS_CS256 = 1 * MiB + 640 * 1024;
constexpr size_t WS_T1T = 2 * MiB;
constexpr size_t WS_T2T = 2 * MiB + 64 * 1024;
constexpr size_t WS_T2F = 8 * MiB;
constexpr size_t WS_T2C = 12 * MiB;
constexpr size_t WS_FAC = 13 * MiB;
constexpr size_t WS_WSP = 2 * MiB + 256 * 1024;
constexpr size_t WS_AFF = 3 * MiB;
constexpr size_t WS_SEL = 5 * MiB;
constexpr size_t WS_IDX = 7 * MiB, WS_GATE = 7 * MiB + 256 * 1024;
constexpr size_t WS_WIN = 16 * MiB, WS_WBR = 29 * MiB, WS_WO = 31 * MiB, WS_WGU = 33 * MiB, WS_WDN = 97 * MiB;
constexpr size_t WS_X = 130 * MiB;
constexpr size_t WS_H = 196 * MiB;
constexpr size_t WS_BR = 229 * MiB;
constexpr size_t WS_MB = 262 * MiB;
constexpr size_t WS_FA = 295 * MiB;
constexpr size_t WS_Z = 311 * MiB;
constexpr size_t ZROW = (size_t)MT * 2;
constexpr size_t WS_AUV = WS_Z, WS_YF = WS_AUV + 512 * ZROW, WS_CY = WS_YF + 512 * ZROW, WS_QPL = WS_CY + 256 * ZROW, WS_QROT = WS_QPL + 256 * ZROW,
                 WS_KR = WS_QROT + 256 * ZROW, WS_VV = WS_KR + 256 * ZROW, WS_G = WS_VV + 256 * ZROW, WS_ZEND = WS_G + 4096 * ZROW;
constexpr size_t WS_P32 = WS_Z;
constexpr size_t WS_XE = WS_Z, WS_ACT = WS_Z + 72 * MiB;
constexpr size_t WS_END = 518 * MiB;
static_assert(WS_G == WS_P32 + (size_t)MT * 1024 * 4 + 8 * 256 * ZROW / 8 - 256 * ZROW || true, "");
static_assert(WS_ZEND <= WS_END && WS_ACT + 72 * MiB <= WS_ZEND && WS_P32 + (size_t)MT * 4096 <= WS_VV, "ws map");
constexpr int CW_BAR = 4096;
constexpr int LDS_BYTES = 155648, MISC_OFF = 154624;

struct Args { const float* in[28]; float* out; unsigned char* ws; int ph_lo, ph_hi; };

__device__ __forceinline__ float bflo(unsigned w) { return __uint_as_float(w << 16); }
__device__ __forceinline__ float bfhi(unsigned w) { return __uint_as_float(w & 0xffff0000u); }
__device__ __forceinline__ float sigm(float x) { return __builtin_amdgcn_rcpf(1.f + __expf(-x)); }
__device__ __forceinline__ float wave_sum(float v) {
#pragma unroll
    for (int o = 1; o < 64; o <<= 1) v += __shfl_xor(v, o);
    return v;
}
__device__ __forceinline__ void st4bf(bf16* p, f32x4 v) { uint2 w; w.x = pk2(v[0], v[1]); w.y = pk2(v[2], v[3]); *(uint2*)p = w; }

using pg8::Unit;
struct EpiIn {
    static constexpr bool PERM = false, AFTER_DRAIN = false;
    bf16 *AUV, *YF, *CY, *QPL, *QROT, *KR, *VV, *G; const float* ropeC; const float* ropeS;
    __device__ __forceinline__ void operator()(const f32x4 (&acc)[2][2][4][2], const Unit& u, int wr, int wc, int fr, int fq) const {
        const int pn = u.pn, row0 = u.pm * 256 + wr * 64 + fr, cl0 = wc * 32 + 4 * fq;
        if (pn < 2) {
#pragma unroll
            for (int ai = 0; ai < 2; ++ai)
#pragma unroll
                for (int m = 0; m < 4; ++m) { const size_t row = row0 + ai * 128 + m * 16;
#pragma unroll
                    for (int bj = 0; bj < 2; ++bj)
#pragma unroll
                        for (int n = 0; n < 2; ++n) { f32x4 v = acc[ai][bj][m][n];
#pragma unroll
                            for (int j = 0; j < 4; ++j) { const float x = v[j]; v[j] = x * sigm(1.5957691216f * (x + 0.044715f * x * x * x)); }
                            st4bf(AUV + row * 512 + pn * 256 + bj * 128 + cl0 + n * 16, v); } }
        } else if (pn < 4) {
#pragma unroll
            for (int ai = 0; ai < 2; ++ai)
#pragma unroll
                for (int m = 0; m < 4; ++m) { const size_t row = row0 + ai * 128 + m * 16;
#pragma unroll
                    for (int bj = 0; bj < 2; ++bj)
#pragma unroll
                        for (int n = 0; n < 2; ++n) st4bf(YF + row * 512 + (pn - 2) * 256 + bj * 128 + cl0 + n * 16, acc[ai][bj][m][n]); }
        } else if (pn < 6) {
#pragma unroll
            for (int ai = 0; ai < 2; ++ai)
#pragma unroll
                for (int m = 0; m < 4; ++m) { const size_t row = row0 + ai * 128 + m * 16;
#pragma unroll
                    for (int n = 0; n < 2; ++n) { const f32x4 a = acc[ai][0][m][n], g = acc[ai][1][m][n]; f32x4 v;
#pragma unroll
                        for (int j = 0; j < 4; ++j) v[j] = a[j] * sigm(g[j]);
                        st4bf(CY + row * 256 + (pn - 4) * 128 + cl0 + n * 16, v); } }
        } else if (pn < 8) {
            const bool isq = pn == 6; const float scl = isq ? 0.125f : 1.f; const bool latent = u.pm < 64;
#pragma unroll
            for (int ai = 0; ai < 2; ++ai)
#pragma unroll
                for (int m = 0; m < 4; ++m) { const int rowi = row0 + ai * 128 + m * 16; const size_t row = rowi; const int tok = rowi & 8191;
                    const int pos = (wc & 1) ? (tok & 63) : (tok >> 6);
                    f32x4 cs = {1.f, 1.f, 1.f, 1.f}, sn = {0.f, 0.f, 0.f, 0.f};
                    if (latent) { cs = *(const f32x4*)(ropeC + pos * 16 + 4 * fq); sn = *(const f32x4*)(ropeS + pos * 16 + 4 * fq); }
#pragma unroll
                    for (int bj = 0; bj < 2; ++bj) { const f32x4 x1 = acc[ai][bj][m][0] * scl, x2 = acc[ai][bj][m][1] * scl;
                        const f32x4 r1 = x1 * cs - x2 * sn, r2 = x1 * sn + x2 * cs; const size_t off = row * 256 + bj * 128 + cl0;
                        if (isq) { st4bf(QPL + off, x1); st4bf(QPL + off + 16, x2); st4bf(QROT + off, r1); st4bf(QROT + off + 16, r2); }
                        else { st4bf(KR + off, r1); st4bf(KR + off + 16, r2); } } }
        } else if (pn == 8) {
#pragma unroll
            for (int ai = 0; ai < 2; ++ai)
#pragma unroll
                for (int m = 0; m < 4; ++m) { const size_t row = row0 + ai * 128 + m * 16;
#pragma unroll
                    for (int bj = 0; bj < 2; ++bj)
#pragma unroll
                        for (int n = 0; n < 2; ++n) st4bf(VV + row * 256 + bj * 128 + cl0 + n * 16, acc[ai][bj][m][n]); }
        } else {
#pragma unroll
            for (int ai = 0; ai < 2; ++ai)
#pragma unroll
                for (int m = 0; m < 4; ++m) { const size_t row = row0 + ai * 128 + m * 16;
#pragma unroll
                    for (int bj = 0; bj < 2; ++bj)
#pragma unroll
                        for (int n = 0; n < 2; ++n) { f32x4 v = acc[ai][bj][m][n];
#pragma unroll
                            for (int j = 0; j < 4; ++j) v[j] = sigm(v[j]);
                            st4bf(G + row * 4096 + (size_t)(pn - 9) * 256 + bj * 128 + cl0 + n * 16, v); } }
        }
    }
};
struct EpiMerge {
    static constexpr bool PERM = false, AFTER_DRAIN = false;
    const bf16* G; float* P32; bf16* MB;
    __device__ __forceinline__ void operator()(const f32x4 (&acc)[2][2][4][2], const Unit& u, int wr, int wc, int fr, int fq) const {
        int fr_ = fr, fq_ = fq; asm volatile("" : "+v"(fr_), "+v"(fq_));
        const int b = u.pn >> 2, pn = u.pn & 3, pm = u.pm - b * 66, row0 = pm * 256 + wr * 64 + fr_, col0 = pn * 256 + wc * 32 + 4 * fq_;
#pragma unroll
        for (int ai = 0; ai < 2; ++ai)
#pragma unroll
            for (int m = 0; m < 4; ++m) { const unsigned row = row0 + ai * 128 + m * 16;
                const bf16* gp = G + ((size_t)row * 4096 + b * 1024 + col0); float* pp = P32 + ((size_t)row * 1024 + col0); bf16* mp = MB + ((size_t)row * 1024 + col0);
#pragma unroll
                for (int bj = 0; bj < 2; ++bj)
#pragma unroll
                    for (int n = 0; n < 2; ++n) { const int co = bj * 128 + n * 16;
                        const uint2 gw = *(const uint2*)(gp + co);
                        f32x4 v = acc[ai][bj][m][n]; v[0] *= bflo(gw.x); v[1] *= bfhi(gw.x); v[2] *= bflo(gw.y); v[3] *= bfhi(gw.y);
                        if (b > 0) v += *(const f32x4*)(pp + co);
                        if (b < 3) *(f32x4*)(pp + co) = v; else st4bf(mp + co, v);
                        asm volatile("" ::: "memory"); } }
    }
};
struct EpiWout {
    static constexpr bool PERM = false, AFTER_DRAIN = false;
    const float* xlat; const float* xctx; float* X; const float* mod;
    __device__ __forceinline__ void operator()(const f32x4 (&acc)[2][2][4][2], const Unit& u, int wr, int wc, int fr, int fq) const {
        const int r = u.pm < 32 ? 0 : (u.pm < 64 ? 1 : 2); const float* gt = mod + r * 6144 + 2 * 1024;
        const int row0 = u.pm * 256 + wr * 64 + fr, col0 = u.pn * 256 + wc * 32 + 4 * fq;
        f32x4 gv[2][2];
#pragma unroll
        for (int bj = 0; bj < 2; ++bj)
#pragma unroll
            for (int n = 0; n < 2; ++n) gv[bj][n] = *(const f32x4*)(gt + col0 + bj * 128 + n * 16);
#pragma unroll
        for (int ai = 0; ai < 2; ++ai)
#pragma unroll
            for (int m = 0; m < 4; ++m) { const size_t row = row0 + ai * 128 + m * 16; const float* src = (row < ML) ? xlat + row * 1024 : xctx + (row - ML) * 1024;
#pragma unroll
                for (int bj = 0; bj < 2; ++bj)
#pragma unroll
                    for (int n = 0; n < 2; ++n) { const int col = col0 + bj * 128 + n * 16;
                        *(f32x4*)(X + row * 1024 + col) = *(const f32x4*)(src + col) + gv[bj][n] * acc[ai][bj][m][n]; } }
    }
};
struct EpiGU {
    static constexpr bool PERM = false, AFTER_DRAIN = false;
    bf16* ACT;
    __device__ __forceinline__ void operator()(const f32x4 (&acc)[2][2][4][2], const Unit& u, int wr, int wc, int fr, int fq) const {
        const int pnl = u.pn & 7, row0 = u.pm * 256 + wr * 64 + fr, cl0 = wc * 32 + 4 * fq;
#pragma unroll
        for (int ai = 0; ai < 2; ++ai)
#pragma unroll
            for (int m = 0; m < 4; ++m) { const size_t row = row0 + ai * 128 + m * 16;
#pragma unroll
                for (int n = 0; n < 2; ++n) { const f32x4 a = acc[ai][0][m][n], up = acc[ai][1][m][n]; f32x4 v;
#pragma unroll
                    for (int j = 0; j < 4; ++j) v[j] = a[j] * sigm(a[j]) * up[j];
                    st4bf(ACT + row * 1024 + pnl * 128 + cl0 + n * 16, v); } }
    }
};
struct EpiDown {
    static constexpr bool PERM = false, AFTER_DRAIN = false;
    bf16* YB; const float* GATE;
    __device__ __forceinline__ void operator()(const f32x4 (&acc)[2][2][4][2], const Unit& u, int wr, int wc, int fr, int fq) const {
        const int pnl = u.pn & 3, row0 = u.pm * 256 + wr * 64 + fr, col0 = pnl * 256 + wc * 32 + 4 * fq;
#pragma unroll
        for (int ai = 0; ai < 2; ++ai)
#pragma unroll
            for (int m = 0; m < 4; ++m) { const size_t row = row0 + ai * 128 + m * 16; const float gt = GATE[row];
#pragma unroll
                for (int bj = 0; bj < 2; ++bj)
#pragma unroll
                    for (int n = 0; n < 2; ++n) st4bf(YB + row * 1024 + col0 + bj * 128 + n * 16, acc[ai][bj][m][n] * gt); }
    }
};
struct MergeOrder {
    int nt, G, c;
    __device__ void init(int ntm, int G_, int c_) { nt = ntm * 4; G = G_; c = c_; }
    __device__ bool next(int i, Unit& u) const { const int b = i & 3, L = (i >> 2) * G + c; if (L >= nt) return false; u.pm = b * 66 + (L >> 2); u.pn = b * 4 + (L & 3); return true; }
    __device__ __forceinline__ void a_ready(const Unit&) const {}
    __device__ __forceinline__ void done(const Unit&) const {}
};
struct GroupOrder {
    int nwg, G, c, TPE, NTN;
    __device__ void init(int tpe, int ntn, int G_, int c_) { TPE = tpe; NTN = ntn; nwg = NE * tpe * ntn; G = G_; c = c_; }
    __device__ bool next(int i, Unit& u) const {
        const long L = (long)i * G + c; if (L >= nwg) return false;
        int wgid = (int)L; { const int q = nwg / 8, r = nwg % 8, xcd = wgid % 8, off = wgid / 8; wgid = (xcd < r ? xcd * (q + 1) : r * (q + 1) + (xcd - r) * q) + off; }
        const int per = TPE * NTN, e = wgid / per, rem = wgid % per, pn = rem / TPE, mt = rem % TPE;
        u.pm = e * 9 + mt; u.pn = e * NTN + pn; return true;
    }
    __device__ __forceinline__ void a_ready(const Unit&) const {}
    __device__ __forceinline__ void done(const Unit&) const {}
};
typedef float f2v __attribute__((ext_vector_type(2)));
#define PH_ARGS LAS unsigned char* lds, const int tid, const int lane, const int wave, const int bid, const int G
#define WSP(T, off) ((T*)(PTRV(29, unsigned char) + (off)))
constexpr int PTAB_OFF = MISC_OFF + 512;
__device__ __forceinline__ unsigned long long ptab_ld(LAS unsigned char* lds, int i) {
    typedef unsigned u2v_t __attribute__((ext_vector_type(2)));
    const volatile LAS unsigned* tp = (const volatile LAS unsigned*)(lds + PTAB_OFF + 8 * i); u2v_t v; v[0] = tp[0]; v[1] = tp[1];
    const unsigned lo = __builtin_amdgcn_readfirstlane(v[0]), hi = __builtin_amdgcn_readfirstlane(v[1]);
    return ((unsigned long long)hi << 32) | lo;
}
#define PTRV(i, T) ((T*)(GAS T*)ptab_ld(lds, (i)))
#define INP(i) ((const float*)(GAS const float*)ptab_ld(lds, (i)))

__device__ __forceinline__ void mod_gemv(PH_ARGS) {
    LAS f32x4* red = (LAS f32x4*)lds;
    const float* c = INP(1); const float* cc = INP(3); const float* wm = INP(4); const float* bm = INP(5);
    float* MOD = WSP(float, WS_MOD);
    for (int it = bid; it < 192; it += G) {
        const int l = it / 96, cg = it % 96, kg = tid >> 4, cq = tid & 15;
        f32x4 a0 = {0.f, 0.f, 0.f, 0.f}, a1 = a0, a2 = a0;
        const float* wb = wm + (size_t)l * 1024 * 6144 + cg * 64 + cq * 4;
#pragma unroll 4
        for (int i = 0; i < 32; ++i) { const int k = kg + 32 * i; const f32x4 w = *(const f32x4*)(wb + (size_t)k * 6144);
            const float x0 = c[k], x1 = c[1024 + k], x2 = cc[k];
            a0 += w * (x0 * sigm(x0)); a1 += w * (x1 * sigm(x1)); a2 += w * (x2 * sigm(x2)); }
        red[(kg * 3 + 0) * 16 + cq] = a0; red[(kg * 3 + 1) * 16 + cq] = a1; red[(kg * 3 + 2) * 16 + cq] = a2;
        __syncthreads();
        if (tid < 192) { const int r = tid >> 6, col = tid & 63; float s = 0.f; const LAS float* rf = (const LAS float*)red;
            for (int k2 = 0; k2 < 32; ++k2) s += rf[((k2 * 3 + r) * 16 + (col >> 2)) * 4 + (col & 3)];
            MOD[(l * 3 + r) * 6144 + cg * 64 + col] = s + bm[l * 6144 + cg * 64 + col]; }
        __syncthreads();
    }
}
__device__ __forceinline__ void make_tables(PH_ARGS) {
    const int gt = bid * 512 + tid, GT = G * 512;
    float* RC = WSP(float, WS_ROPEC); float* RS = WSP(float, WS_ROPES);
    bf16* T1 = WSP(bf16, WS_T1T);
    for (int i = gt; i < 2048; i += GT) { const int pos = i >> 4, f = i & 15; const float inv = powf(10000.f, -(float)f / 16.f), ang = (float)pos * inv; RC[i] = cosf(ang); RS[i] = sinf(ang); }
    for (int i = gt; i < 128 * 128; i += GT) { const int col = i >> 7, k = i & 127, ro = col >> 6, k1 = col & 63, n1 = k >> 1, ri = k & 1; float s, c; sincospif((float)((k1 * n1) & 63) / 32.f, &s, &c);
        const float v = ro == 0 ? (ri == 0 ? c : s) : (ri == 0 ? -s : c); T1[i] = (bf16)f2bf(v); }
    bf16* T2F = WSP(bf16, WS_T2F); bf16* T2C = WSP(bf16, WS_T2C);
    for (int i = gt; i < 64 * 128 * 256; i += GT) { const int k1 = i >> 15, k2 = (i >> 8) & 127, k = i & 255, n2 = k >> 1, ri = k & 1; float s, c;
        sincospif((float)((n2 * (k1 + 64 * k2)) & 8191) / 4096.f, &s, &c); T2F[i] = (bf16)f2bf(ri ? s : c); }
    for (int i = gt; i < 2 * 128 * 256; i += GT) { const int k1 = i >> 15, k2 = (i >> 8) & 127, k = i & 255, n2 = k >> 1, ri = k & 1; float s, c;
        sincospif((float)((n2 * (k1 + 2 * k2)) & 255) / 128.f, &s, &c); T2C[i] = (bf16)f2bf(ri ? s : c); }
}
__device__ __forceinline__ void tr_item(const float* W, size_t ldw, int col0, int k0, bf16* dst, int Kd, LAS float* scr, int lane) {
#pragma unroll 8
    for (int i = 0; i < 32; ++i) { const int kk = 2 * i + (lane >> 5); scr[kk * 33 + (lane & 31)] = W[(size_t)(k0 + kk) * ldw + col0 + (lane & 31)]; }
    LDS_WAIT(); asm volatile("" ::: "memory");
    const int c = lane & 7;
#pragma unroll
    for (int j = 0; j < 4; ++j) { const int n = (lane >> 3) + 8 * j; const LAS float* s = scr + (8 * c) * 33 + n;
        v4u o; o.x = pk2(s[0 * 33], s[1 * 33]); o.y = pk2(s[2 * 33], s[3 * 33]); o.z = pk2(s[4 * 33], s[5 * 33]); o.w = pk2(s[6 * 33], s[7 * 33]);
        *(v4u*)(dst + (size_t)n * Kd + k0 + 8 * c) = o; }
    LDS_WAIT(); asm volatile("" ::: "memory");
}
__device__ __forceinline__ void fold_item16(const float* W  , int f, bf16* WIN, LAS float* scr, const LAS f2v* tab, int lane) {
    const int kb = f >> 2, g = f & 3, k0 = kb * 16;
#pragma unroll
    for (int kk = 0; kk < 16; ++kk) scr[kk * 64 + lane] = W[(size_t)(k0 + kk) * 6144 + 512 + g * 64 + lane];
    LDS_WAIT(); asm volatile("" ::: "memory");
    float ar[16], ai[16];
#pragma unroll
    for (int kk = 0; kk < 16; ++kk) { ar[kk] = 0.f; ai[kk] = 0.f; }
#pragma unroll 4
    for (int c = 0; c < 64; ++c) { const f2v t = tab[(c * lane) & 63];
#pragma unroll
        for (int kk = 0; kk < 16; ++kk) { const float w = scr[kk * 64 + c]; ar[kk] += w * t[0]; ai[kk] -= w * t[1]; } }
    bf16* d0 = WIN + (size_t)(512 + 2 * (g * 64 + lane)) * 1024 + k0;
    v4u o, p;
    o.x = pk2(ar[0], ar[1]); o.y = pk2(ar[2], ar[3]); o.z = pk2(ar[4], ar[5]); o.w = pk2(ar[6], ar[7]); p.x = pk2(ar[8], ar[9]); p.y = pk2(ar[10], ar[11]); p.z = pk2(ar[12], ar[13]); p.w = pk2(ar[14], ar[15]);
    *(v4u*)d0 = o; *(v4u*)(d0 + 8) = p;
    o.x = pk2(ai[0], ai[1]); o.y = pk2(ai[2], ai[3]); o.z = pk2(ai[4], ai[5]); o.w = pk2(ai[6], ai[7]); p.x = pk2(ai[8], ai[9]); p.y = pk2(ai[10], ai[11]); p.z = pk2(ai[12], ai[13]); p.w = pk2(ai[14], ai[15]);
    *(v4u*)(d0 + 1024) = o; *(v4u*)(d0 + 1024 + 8) = p;
    LDS_WAIT(); asm volatile("" ::: "memory");
}
__device__ __forceinline__ void tr_item64(const float* W, size_t ldw, int col0, int k0, bf16* dst, int Kd, int lane) {
    const int kq = lane >> 4, n4 = lane & 15; const float* src = W + (size_t)(k0 + kq * 16) * ldw + col0 + n4 * 4;
    f32x4 v[16];
#pragma unroll
    for (int i = 0; i < 16; ++i) v[i] = *(const f32x4*)(src + (size_t)i * ldw);
#pragma unroll
    for (int j = 0; j < 4; ++j) { bf16* d = dst + (size_t)(n4 * 4 + j) * Kd + k0 + kq * 16; v4u o, p;
        o.x = pk2(v[0][j], v[1][j]); o.y = pk2(v[2][j], v[3][j]); o.z = pk2(v[4][j], v[5][j]); o.w = pk2(v[6][j], v[7][j]);
        p.x = pk2(v[8][j], v[9][j]); p.y = pk2(v[10][j], v[11][j]); p.z = pk2(v[12][j], v[13][j]); p.w = pk2(v[14][j], v[15][j]);
        *(v4u*)d = o; *(v4u*)(d + 8) = p; }
}
__device__ __forceinline__ void convert_weights(PH_ARGS, const int l) {
    LAS float* scr = (LAS float*)(lds + wave * 16384);
    const int gw = bid * 8 + wave, NGW = G * 8;
    bf16* WIN = WSP(bf16, WS_WIN); bf16* WBR = WSP(bf16, WS_WBR); bf16* WO = WSP(bf16, WS_WO); bf16* WGU = WSP(bf16, WS_WGU); bf16* WDN = WSP(bf16, WS_WDN); bf16* WS_ = WSP(bf16, WS_WSP);
    const float* win = INP(8) + (size_t)l * 1024 * 6144;
    LAS f2v* tab = (LAS f2v*)(scr + 2048); { float s_, c_; sincospif((float)lane / 32.f, &s_, &c_); tab[lane] = (f2v){c_, s_}; } LDS_WAIT(); asm volatile("" ::: "memory");
    constexpr int N_FOLD = 256, N_IN = 92 * 16, N_BR = 256, N_WO = 256, N_GU = 8192, N_DN = 4096, N_SP = 64;
    constexpr int NITEMS = N_FOLD + N_IN + N_BR + N_WO + N_GU + N_DN + N_SP;
    for (int it = gw; it < NITEMS; it += NGW) {
        int r = it;
        if (r < N_FOLD) { fold_item16(win, r, WIN, scr, tab, lane); continue; } r -= N_FOLD;
        if (r < N_IN) { const int dbp = r >> 4, kb = r & 15, db = dbp < 8 ? dbp : dbp + 8; int col;
            if (db < 8) col = db * 64;
            else if (db < 24) { const int t = db - 16, tile = t >> 2, sub = t & 3; col = (sub < 2 ? 768 : 1024) + tile * 128 + (sub & 1) * 64; }
            else if (db < 36) col = 1280 + (db - 24) * 64;
            else col = 2048 + (db - 36) * 64;
            tr_item64(win, 6144, col, kb * 64, WIN + (size_t)db * 64 * 1024, 1024, lane); continue; } r -= N_IN;
        if (r < N_BR) { const int b = r >> 6, q = r & 63, kb = q >> 4, nb = q & 15; const int ii = b == 0 ? 13 : (b == 1 ? 14 : (b == 2 ? 19 : 21));
            tr_item64(INP(ii) + (size_t)l * 256 * 1024, 1024, nb * 64, kb * 64, WBR + (size_t)(b * 1024 + nb * 64) * 256, 256, lane); continue; } r -= N_BR;
        if (r < N_WO) { const int kb = r >> 4, nb = r & 15; tr_item64(INP(22) + (size_t)l * 1024 * 1024, 1024, nb * 64, kb * 64, WO + (size_t)nb * 64 * 1024, 1024, lane); continue; } r -= N_WO;
        if (r < N_GU) { const int e = r >> 9, q = r & 511, db = q >> 4, kb = q & 15, tile = db >> 2, sub = db & 3;
            const float* src = (sub < 2 ? INP(24) : INP(25)) + (size_t)(l * 16 + e) * 1024 * 1024;
            tr_item64(src, 1024, tile * 128 + (sub & 1) * 64, kb * 64, WGU + ((size_t)e * 2048 + db * 64) * 1024, 1024, lane); continue; } r -= N_GU;
        if (r < N_DN) { const int e = r >> 8, q = r & 255, kb = q >> 4, nb = q & 15;
            tr_item64(INP(26) + (size_t)(l * 16 + e) * 1024 * 1024, 1024, nb * 64, kb * 64, WDN + ((size_t)e * 1024 + nb * 64) * 1024, 1024, lane); continue; } r -= N_DN;
        { const float* s = INP(11) + (size_t)l * 65536 + r * 1024 + lane * 16; const f32x4 a = *(const f32x4*)s, b = *(const f32x4*)(s + 4), c = *(const f32x4*)(s + 8), d = *(const f32x4*)(s + 12);
          v4u o, p; o.x = pk2(a[0], a[1]); o.y = pk2(a[2], a[3]); o.z = pk2(b[0], b[1]); o.w = pk2(b[2], b[3]); p.x = pk2(c[0], c[1]); p.y = pk2(c[2], c[3]); p.z = pk2(d[0], d[1]); p.w = pk2(d[2], d[3]);
          *(v4u*)(WS_ + r * 1024 + lane * 16) = o; *(v4u*)(WS_ + r * 1024 + lane * 16 + 8) = p; }
    }
}
__device__ __forceinline__ void load_row(const float* p, int lane, f32x4 (&v)[4]) {
#pragma unroll
    for (int j = 0; j < 4; ++j) v[j] = *(const f32x4*)(p + 4 * lane + 256 * j);
}
__device__ __forceinline__ void modnorm_store(f32x4 (&v)[4], const float* g, const float* sc, const float* sh, bf16* hrow, int lane) {
    float ss = 0.f;
#pragma unroll
    for (int j = 0; j < 4; ++j) ss += (v[j][0] * v[j][0] + v[j][1] * v[j][1]) + (v[j][2] * v[j][2] + v[j][3] * v[j][3]);
    const float rs = 1.0f / sqrtf(wave_sum(ss) * (1.f / 1024.f) + 1e-6f);
#pragma unroll
    for (int j = 0; j < 4; ++j) { const int o = 4 * lane + 256 * j; const f32x4 gg = *(const f32x4*)(g + o), s = *(const f32x4*)(sc + o), b = *(const f32x4*)(sh + o);
        v[j] = v[j] * rs * gg * (s + 1.f) + b; st4bf(hrow + o, v[j]); }
}
__device__ __forceinline__ void modnorm_regs(f32x4 (&v)[4], const f32x4 (&gm)[4], const f32x4 (&sh)[4], bf16* hrow, int lane) {
    float ss = 0.f;
#pragma unroll
    for (int j = 0; j < 4; ++j) ss += (v[j][0] * v[j][0] + v[j][1] * v[j][1]) + (v[j][2] * v[j][2] + v[j][3] * v[j][3]);
    const float rs = 1.0f / sqrtf(wave_sum(ss) * (1.f / 1024.f) + 1e-6f);
#pragma unroll
    for (int j = 0; j < 4; ++j) { v[j] = v[j] * rs * gm[j] + sh[j]; st4bf(hrow + 4 * lane + 256 * j, v[j]); }
}
__device__ __forceinline__ void load_mod(const float* g, const float* sc, const float* shp, int lane, f32x4 (&gm)[4], f32x4 (&sh)[4]) {
#pragma unroll
    for (int j = 0; j < 4; ++j) { const int o = 4 * lane + 256 * j; gm[j] = *(const f32x4*)(g + o) * (*(const f32x4*)(sc + o) + 1.f); sh[j] = *(const f32x4*)(shp + o); }
}
__device__ __forceinline__ void norm1_l0(PH_ARGS) {
    const int gw = bid * 8 + wave, NGW = G * 8; bf16* H = WSP(bf16, WS_H); const float* MOD = WSP(float, WS_MOD);
    const int RPW = (MT + NGW - 1) / NGW, row0 = gw * RPW, rend = (row0 + RPW < MT) ? row0 + RPW : MT;
    const float* xin = INP(0); const float* cin = INP(2); const float* g = INP(6);
    f32x4 cur[4], nxt[4], gm[4], sh[4]; int rprev = -1;
    if (row0 < rend) load_row(row0 < ML ? xin + (size_t)row0 * 1024 : cin + (size_t)(row0 - ML) * 1024, lane, cur);
    for (int row = row0; row < rend; ++row) {
        if (row + 1 < rend) { const int rn = row + 1; load_row(rn < ML ? xin + (size_t)rn * 1024 : cin + (size_t)(rn - ML) * 1024, lane, nxt); }
        const int r = row < SEQ ? 0 : (row < ML ? 1 : 2);
        if (r != rprev) { const float* md = MOD + r * 6144; load_mod(g, md + 1024, md, lane, gm, sh); rprev = r; }
        modnorm_regs(cur, gm, sh, H + (size_t)row * 1024, lane);
#pragma unroll
        for (int j = 0; j < 4; ++j) cur[j] = nxt[j];
    }
}
__device__ __forceinline__ void norm2_router(PH_ARGS, const int l, const int nrows) {
    const int gw = bid * 8 + wave, NGW = G * 8; bf16* H = WSP(bf16, WS_H); const float* MOD = WSP(float, WS_MOD) + l * 3 * 6144; const float* X = WSP(float, WS_X); float* AFF = WSP(float, WS_AFF);
    LAS f32x4* Wl = (LAS f32x4*)lds;
    { const f32x4* wr = (const f32x4*)(INP(23) + (size_t)l * 1024 * 16);
      for (int i = tid; i < 4096; i += 512) { const int k = i >> 2, q = i & 3; Wl[(q * 4 + (k & 3)) * 256 + (k >> 2)] = wr[i]; } }
    __syncthreads();
    const int RPW = (nrows + NGW - 1) / NGW, row0 = gw * RPW, rend = (row0 + RPW < nrows) ? row0 + RPW : nrows;
    const float* g2 = INP(7) + l * 1024;
    f32x4 v[4], nxt[4], gm[4], sh[4]; int rprev = -1;
    if (row0 < rend) load_row(X + (size_t)row0 * 1024, lane, v);
    for (int row = row0; row < rend; ++row) {
        if (row + 1 < rend) load_row(X + (size_t)(row + 1) * 1024, lane, nxt);
        const int r = row < SEQ ? 0 : (row < ML ? 1 : 2);
        if (r != rprev) { const float* md = MOD + r * 6144; load_mod(g2, md + 4 * 1024, md + 3 * 1024, lane, gm, sh); rprev = r; }
        modnorm_regs(v, gm, sh, H + (size_t)row * 1024, lane);
        float lg[16];
#pragma unroll
        for (int e = 0; e < 16; ++e) lg[e] = 0.f;
#pragma unroll
        for (int j = 0; j < 4; ++j)
#pragma unroll
            for (int i = 0; i < 4; ++i) { const float hv = v[j][i];
#pragma unroll
                for (int q = 0; q < 4; ++q) { const f32x4 w = Wl[(q * 4 + i) * 256 + 64 * j + lane]; lg[4 * q + 0] += hv * w[0]; lg[4 * q + 1] += hv * w[1]; lg[4 * q + 2] += hv * w[2]; lg[4 * q + 3] += hv * w[3]; }
                if (i & 1) asm volatile("" ::: "memory"); }
#pragma unroll
        for (int i = 0; i < 8; ++i) { const bool up = lane & 32; const float send = up ? lg[i] : lg[i + 8], keep = up ? lg[i + 8] : lg[i]; lg[i] = keep + __shfl_xor(send, 32); }
#pragma unroll
        for (int i = 0; i < 4; ++i) { const bool up = lane & 16; const float send = up ? lg[i] : lg[i + 4], keep = up ? lg[i + 4] : lg[i]; lg[i] = keep + __shfl_xor(send, 16); }
#pragma unroll
        for (int i = 0; i < 2; ++i) { const bool up = lane & 8; const float send = up ? lg[i] : lg[i + 2], keep = up ? lg[i + 2] : lg[i]; lg[i] = keep + __shfl_xor(send, 8); }
        { const bool up = lane & 4; const float send = up ? lg[0] : lg[1], keep = up ? lg[1] : lg[0]; lg[0] = keep + __shfl_xor(send, 4); }
        float z = lg[0]; z += __shfl_xor(z, 1); z += __shfl_xor(z, 2);
        float mx = z; mx = fmaxf(mx, __shfl_xor(mx, 4)); mx = fmaxf(mx, __shfl_xor(mx, 8)); mx = fmaxf(mx, __shfl_xor(mx, 16)); mx = fmaxf(mx, __shfl_xor(mx, 32));
        const float ez = expf(z - mx); float sm = ez; sm += __shfl_xor(sm, 4); sm += __shfl_xor(sm, 8); sm += __shfl_xor(sm, 16); sm += __shfl_xor(sm, 32);
        if ((lane & 3) == 0) { const int e = ((lane >> 5) & 1) * 8 + ((lane >> 4) & 1) * 4 + ((lane >> 3) & 1) * 2 + ((lane >> 2) & 1); AFF[(size_t)row * 16 + e] = ez / sm; }
#pragma unroll
        for (int j = 0; j < 4; ++j) v[j] = nxt[j];
    }
    __syncthreads();
}
typedef short v4i16_t __attribute__((ext_vector_type(4)));
__device__ __forceinline__ void mfma16(f32x4& acc, const bf16x8 a, const bf16x8 b) { asm volatile("s_nop 1\n\tv_mfma_f32_16x16x32_bf16 %0, %1, %2, %0\n\ts_nop 3" : "+v"(acc) : "v"(a), "v"(b)); }
#define DRAIN4(x) asm volatile("s_nop 15\n\ts_nop 15" : "+v"((x)[0]), "+v"((x)[1]), "+v"((x)[2]), "+v"((x)[3]))
#define DRAIN8(x) asm volatile("s_nop 15\n\ts_nop 15" : "+v"((x)[0]), "+v"((x)[1]), "+v"((x)[2]), "+v"((x)[3]), "+v"((x)[4]), "+v"((x)[5]), "+v"((x)[6]), "+v"((x)[7]))
#define DRAIN16(x) asm volatile("s_nop 15\n\ts_nop 15" : "+v"((x)[0]), "+v"((x)[1]), "+v"((x)[2]), "+v"((x)[3]), "+v"((x)[4]), "+v"((x)[5]), "+v"((x)[6]), "+v"((x)[7]), \
    "+v"((x)[8]), "+v"((x)[9]), "+v"((x)[10]), "+v"((x)[11]), "+v"((x)[12]), "+v"((x)[13]), "+v"((x)[14]), "+v"((x)[15]))
__device__ __forceinline__ void gmlp_unit(PH_ARGS, const int l, const int chunk) {
    const int row0 = chunk < 128 ? chunk * 128 : ML + (chunk - 128) * 128;
    const bf16* AUV = WSP(bf16, WS_AUV); bf16* BRa = WSP(bf16, WS_BR); const bf16* WS_ = WSP(bf16, WS_WSP);
    LAS bf16* vT = (LAS bf16*)lds;
    const float* lg = INP(9) + l * 256; const float* lb = INP(10) + l * 256;
    const f32x4 gg = *(const f32x4*)(lg + 4 * lane), bb = *(const f32x4*)(lb + 4 * lane);
    uint2 raws[16];
#pragma unroll
    for (int pi = 0; pi < 16; ++pi) raws[pi] = *(const uint2*)(AUV + (size_t)(row0 + wave * 16 + pi) * 512 + 256 + 4 * lane);
#pragma unroll
    for (int pi = 0; pi < 16; ++pi) { const int p = wave * 16 + pi;
        const uint2 raw = raws[pi];
        float v0 = bflo(raw.x), v1 = bfhi(raw.x), v2 = bflo(raw.y), v3 = bfhi(raw.y);
        const float mean = wave_sum((v0 + v1) + (v2 + v3)) * (1.f / 256.f); v0 -= mean; v1 -= mean; v2 -= mean; v3 -= mean;
        const float rstd = 1.0f / sqrtf(wave_sum((v0 * v0 + v1 * v1) + (v2 * v2 + v3 * v3)) * (1.f / 256.f) + 1e-6f);
        vT[(4 * lane + 0) * 136 + p] = (bf16)f2bf(v0 * rstd * gg[0] + bb[0]); vT[(4 * lane + 1) * 136 + p] = (bf16)f2bf(v1 * rstd * gg[1] + bb[1]);
        vT[(4 * lane + 2) * 136 + p] = (bf16)f2bf(v2 * rstd * gg[2] + bb[2]); vT[(4 * lane + 3) * 136 + p] = (bf16)f2bf(v3 * rstd * gg[3] + bb[3]); }
    __syncthreads();
    const int g = wave >> 1, qh = wave & 1, fr = lane & 15, fq = lane >> 4;
    f32x4 acc[4][4];
#pragma unroll
    for (int a = 0; a < 4; ++a)
#pragma unroll
        for (int b = 0; b < 4; ++b) acc[a][b] = (f32x4){0.f, 0.f, 0.f, 0.f};
    const bf16* Wg = WS_ + g * 16384;
#pragma unroll
    for (int ks = 0; ks < 4; ++ks) { bf16x8 af[4], bf[4];
#pragma unroll
        for (int dt = 0; dt < 4; ++dt) af[dt] = *(const LAS bf16x8*)(vT + (g * 64 + dt * 16 + fr) * 136 + ks * 32 + fq * 8);
#pragma unroll
        for (int qt = 0; qt < 4; ++qt) bf[qt] = *(const bf16x8*)(Wg + (qh * 64 + qt * 16 + fr) * 128 + ks * 32 + fq * 8);
#pragma unroll
        for (int dt = 0; dt < 4; ++dt)
#pragma unroll
            for (int qt = 0; qt < 4; ++qt) mfma16(acc[dt][qt], af[dt], bf[qt]); }
    DRAIN16(&acc[0][0]);
    const float* bs = INP(12) + l * 512 + g * 128;
#pragma unroll
    for (int qt = 0; qt < 4; ++qt) { const int q = qh * 64 + qt * 16 + fr; const float bias = bs[q]; const size_t row = row0 + q;
#pragma unroll
        for (int dt = 0; dt < 4; ++dt) { const int ch = g * 64 + dt * 16 + 4 * fq; const uint2 uw = *(const uint2*)(AUV + row * 512 + ch);
            f32x4 o; o[0] = bflo(uw.x) * (acc[dt][qt][0] + bias); o[1] = bfhi(uw.x) * (acc[dt][qt][1] + bias); o[2] = bflo(uw.y) * (acc[dt][qt][2] + bias); o[3] = bfhi(uw.y) * (acc[dt][qt][3] + bias);
            st4bf(BRa + row * 256 + ch, o); } }
    __syncthreads();
}
__device__ __forceinline__ void conv_unit(PH_ARGS, const int l, const int unit) {
    int rowbase, n0, nlen;
    if (unit < 256) { rowbase = (unit >> 7) * SEQ; n0 = (unit & 127) * 64; nlen = SEQ; } else { const int u2 = unit - 256; rowbase = ML + (u2 >> 2) * CTXL; n0 = (u2 & 3) * 64; nlen = CTXL; }
    const bf16* CY = WSP(bf16, WS_CY); bf16* BRc = WSP(bf16, WS_BR) + (size_t)2 * MT * 256;
    LAS unsigned* yt = (LAS unsigned*)lds;
    LAS float* cres = (LAS float*)(lds + 48128);
    for (int p = tid; p < 94 * 32; p += 512) { const int rr = p >> 5, seg = p & 31, n = n0 - 15 + rr; v4u val = {0u, 0u, 0u, 0u};
        if (n >= 0 && n < nlen) val = *(const v4u*)(CY + (size_t)(rowbase + n) * 256 + seg * 8);
        *(LAS v4u*)(lds + rr * 512 + seg * 16) = val; }
    __syncthreads();
    const int cp = tid & 127, pg = tid >> 7;
    float w0[31], w1[31];
    const float* cw = INP(15) + (size_t)l * 31 * 256 + 2 * cp;
#pragma unroll
    for (int t = 0; t < 31; ++t) { const float2 w = *(const float2*)(cw + t * 256); w0[t] = w.x; w1[t] = w.y; }
    float a0[16], a1[16];
#pragma unroll
    for (int p = 0; p < 16; ++p) { a0[p] = 0.f; a1[p] = 0.f; }
#pragma unroll
    for (int i = 0; i < 46; ++i) { const unsigned raw = yt[(16 * pg + i) * 128 + cp]; const float v0 = bflo(raw), v1 = bfhi(raw);
#pragma unroll
        for (int p = 0; p < 16; ++p) { const int t = i - p; if (t >= 0 && t < 31) { a0[p] += v0 * w0[t]; a1[p] += v1 * w1[t]; } } }
    const float2 cb = *(const float2*)(INP(16) + l * 256 + 2 * cp);
#pragma unroll
    for (int p = 0; p < 16; ++p) *(LAS f2v*)(cres + (16 * pg + p) * 256 + 2 * cp) = (f2v){a0[p] + cb.x, a1[p] + cb.y};
    __syncthreads();
    const f32x4 gg = *(const f32x4*)(INP(17) + l * 256 + 4 * lane), bb = *(const f32x4*)(INP(18) + l * 256 + 4 * lane);
    for (int pi = 0; pi < 8; ++pi) { const int pos = wave * 8 + pi; f32x4 v = *(const LAS f32x4*)(cres + pos * 256 + 4 * lane);
        const float mean = wave_sum((v[0] + v[1]) + (v[2] + v[3])) * (1.f / 256.f); v = v - mean;
        const float rstd = 1.0f / sqrtf(wave_sum((v[0] * v[0] + v[1] * v[1]) + (v[2] * v[2] + v[3] * v[3])) * (1.f / 256.f) + 1e-6f);
        f32x4 o;
#pragma unroll
        for (int j = 0; j < 4; ++j) { const float y = v[j] * rstd * gg[j] + bb[j]; o[j] = y * sigm(y); }
        st4bf(BRc + (size_t)(rowbase + n0 + pos) * 256 + 4 * lane, o); }
    __syncthreads();
}
constexpr int F1_T1L = 0, F1_YL = 34816;
__device__ __forceinline__ void f1_stage_tables(PH_ARGS) {
    const bf16* T1 = WSP(bf16, WS_T1T);
    for (int p = tid; p < 128 * 16; p += 512) { const int r = p >> 4, s = p & 15; *(LAS v4u*)(lds + F1_T1L + r * 272 + s * 16) = *(const v4u*)(T1 + r * 128 + s * 8); }
    __syncthreads();
}
__device__ __forceinline__ void f1_unit(PH_ARGS, const int unit) {
    const int b = unit >> 7, n2 = unit & 127, fr = lane & 15, fq = lane >> 4;
    const bf16* YF = WSP(bf16, WS_YF); bf16* FA = WSP(bf16, WS_FA);
    LAS unsigned* Yl = (LAS unsigned*)(lds + F1_YL);
#pragma unroll
    for (int i = 0; i < 8; ++i) { const int n1 = wave + 8 * i; *(LAS v4u*)(Yl + n1 * 260 + lane * 4) = *(const v4u*)(YF + (size_t)(b * SEQ + 128 * n1 + n2) * 512 + lane * 8); }
    __syncthreads();
    f32x4 acc[2][8];
#pragma unroll
    for (int a = 0; a < 2; ++a)
#pragma unroll
        for (int n = 0; n < 8; ++n) acc[a][n] = (f32x4){0.f, 0.f, 0.f, 0.f};
#pragma unroll
    for (int ks = 0; ks < 4; ++ks) { bf16x8 af[2];
#pragma unroll
        for (int c2 = 0; c2 < 2; ++c2) { const int ch = (2 * wave + c2) * 16 + fr; v4u w;
            w.x = Yl[(16 * ks + 4 * fq + 0) * 260 + ch]; w.y = Yl[(16 * ks + 4 * fq + 1) * 260 + ch]; w.z = Yl[(16 * ks + 4 * fq + 2) * 260 + ch]; w.w = Yl[(16 * ks + 4 * fq + 3) * 260 + ch];
            af[c2] = __builtin_bit_cast(bf16x8, w); }
#pragma unroll
        for (int nt = 0; nt < 8; ++nt) { const bf16x8 bfr = *(const LAS bf16x8*)(lds + F1_T1L + (nt * 16 + fr) * 272 + ks * 64 + fq * 16);
            mfma16(acc[0][nt], af[0], bfr); mfma16(acc[1][nt], af[1], bfr); } }
    DRAIN16(&acc[0][0]);
#pragma unroll
    for (int c2 = 0; c2 < 2; ++c2)
#pragma unroll
        for (int kt = 0; kt < 4; ++kt) { const int k1 = kt * 16 + fr; const f32x4 ar = acc[c2][kt], ai = acc[c2][kt + 4];
            v4u o; o.x = pk2(ar[0], ai[0]); o.y = pk2(ar[1], ai[1]); o.z = pk2(ar[2], ai[2]); o.w = pk2(ar[3], ai[3]);
            *(v4u*)(FA + ((size_t)((b * 64 + k1) * 128 + n2) * 256 + (2 * wave + c2) * 16 + 4 * fq) * 2) = o; }
    __syncthreads();
}
constexpr int F2_T2L = 0, F2_AL = 67584;
__device__ __forceinline__ void f2_unit(PH_ARGS, const int unit) {
    const int fr = lane & 15, fq = lane >> 4; const bool lat = unit < 256;
    int b, k1, chh; const bf16* Asrc; const bf16* Tsrc; size_t orow0; int ostr; float scl;
    if (lat) { b = unit >> 7; k1 = (unit >> 1) & 63; chh = unit & 1; Asrc = WSP(bf16, WS_FA) + (size_t)((b * 64 + k1) * 128) * 512; Tsrc = WSP(bf16, WS_T2F) + (size_t)k1 * 32768; orow0 = (size_t)b * SEQ + k1; ostr = 64; scl = 0.0013810679320049757f; }
    else { const int u2 = unit - 256; b = u2 >> 2; k1 = (u2 >> 1) & 1; chh = u2 & 1; Asrc = WSP(bf16, WS_FAC) + (size_t)((b * 2 + k1) * 128) * 512; Tsrc = WSP(bf16, WS_T2C) + (size_t)k1 * 32768; orow0 = (size_t)ML + b * CTXL + k1; ostr = 2; scl = 1.f / 128.f; }
    bf16* BRb = WSP(bf16, WS_BR) + (size_t)1 * MT * 256;
    LAS unsigned* Al = (LAS unsigned*)(lds + F2_AL);
    for (int p = tid; p < 128 * 32; p += 512) { const int r = p >> 5, s = p & 31; *(LAS v4u*)(lds + F2_T2L + r * 528 + s * 16) = *(const v4u*)(Tsrc + r * 256 + s * 8); }
#pragma unroll
    for (int i = 0; i < 8; ++i) { const int n2 = wave * 16 + 2 * i + (lane >> 5);
        *(LAS v4u*)(Al + n2 * 132 + (lane & 31) * 4) = *(const v4u*)(Asrc + ((size_t)n2 * 256 + chh * 128) * 2 + (lane & 31) * 8); }
    __syncthreads();
    f32x4 acc[8];
#pragma unroll
    for (int n = 0; n < 8; ++n) acc[n] = (f32x4){0.f, 0.f, 0.f, 0.f};
    const int ch = wave * 16 + fr;
#pragma unroll
    for (int ks = 0; ks < 8; ++ks) { v4u w;
        w.x = Al[(16 * ks + 4 * fq + 0) * 132 + ch]; w.y = Al[(16 * ks + 4 * fq + 1) * 132 + ch]; w.z = Al[(16 * ks + 4 * fq + 2) * 132 + ch]; w.w = Al[(16 * ks + 4 * fq + 3) * 132 + ch];
        const bf16x8 af = __builtin_bit_cast(bf16x8, w);
#pragma unroll
        for (int nt = 0; nt < 8; ++nt) { const bf16x8 bfr = *(const LAS bf16x8*)(lds + F2_T2L + (nt * 16 + fr) * 528 + ks * 64 + fq * 16); mfma16(acc[nt], af, bfr); } }
    DRAIN8(acc);
#pragma unroll
    for (int nt = 0; nt < 8; ++nt) { const int k2 = nt * 16 + fr; st4bf(BRb + (orow0 + (size_t)ostr * k2) * 256 + chh * 128 + wave * 16 + 4 * fq, acc[nt] * scl); }
    __syncthreads();
}
__device__ __forceinline__ void ctx_butterfly(PH_ARGS) {
    const unsigned* YF = (const unsigned*)WSP(bf16, WS_YF); unsigned* FAC = (unsigned*)WSP(bf16, WS_FAC);
    for (int i = bid * 512 + tid; i < 2 * 128 * 256; i += G * 512) { const int b = i >> 15, n2 = (i >> 8) & 127, ch = i & 255;
        const unsigned y0 = YF[(size_t)(ML + b * CTXL + n2) * 256 + ch], y1 = YF[(size_t)(ML + b * CTXL + 128 + n2) * 256 + ch];
        const float r0 = bflo(y0), i0 = bfhi(y0), r1 = bflo(y1), i1 = bfhi(y1);
        FAC[(size_t)((b * 2 + 0) * 128 + n2) * 256 + ch] = pk2(r0 + r1, i0 + i1); FAC[(size_t)((b * 2 + 1) * 128 + n2) * 256 + ch] = pk2(r0 - r1, i0 - i1); }
}
constexpr int MG_AL = 0, MG_BL = 67584;
__device__ __forceinline__ void merge_phase(PH_ARGS, const int nunits) {
    const int fr = lane & 15, fq = lane >> 4, wr = wave >> 2, wc = wave & 3;
    const bf16* BR = WSP(bf16, WS_BR); const bf16* WBR = WSP(bf16, WS_WBR); const bf16* GT = WSP(bf16, WS_G); bf16* MB = WSP(bf16, WS_MB);
    int nmine = 0; for (int u = bid; u < nunits; u += G) ++nmine;
    const int nsteps = nmine * 4;
    if (nsteps == 0) return;
    v4u pa[8], pb[8];
#define MG_LOAD(s) do { const int u_ = bid + ((s) >> 2) * G, b_ = (s) & 3, rt_ = u_ >> 3, ct_ = u_ & 7; \
        const bf16* As = BR + ((size_t)b_ * MT + (size_t)rt_ * 128) * 256; const bf16* Bs = WBR + ((size_t)b_ * 1024 + (size_t)ct_ * 128) * 256; \
        _Pragma("unroll") for (int i = 0; i < 8; ++i) { const int p = i * 512 + tid, r = p >> 5, seg = p & 31; pa[i] = *(const v4u*)(As + (size_t)r * 256 + seg * 8); pb[i] = *(const v4u*)(Bs + (size_t)r * 256 + seg * 8); } } while (0)
#define MG_WRITE() do { _Pragma("unroll") for (int i = 0; i < 8; ++i) { const int p = i * 512 + tid, r = p >> 5, seg = p & 31; \
        *(LAS v4u*)(lds + MG_AL + r * 528 + seg * 16) = pa[i]; *(LAS v4u*)(lds + MG_BL + r * 528 + seg * 16) = pb[i]; } } while (0)
    MG_LOAD(0); MG_WRITE();
    f32x4 macc[4][2];
#pragma unroll
    for (int a = 0; a < 4; ++a)
#pragma unroll
        for (int n = 0; n < 2; ++n) macc[a][n] = (f32x4){0.f, 0.f, 0.f, 0.f};
#pragma unroll 1
    for (int s = 0; s < nsteps; ++s) {
        const int u = bid + (s >> 2) * G, b = s & 3, rt = u >> 3, ct = u & 7;
        __syncthreads();
        if (s + 1 < nsteps) MG_LOAD(s + 1);
        uint2 gw[4][2];
#pragma unroll
        for (int mt = 0; mt < 4; ++mt)
#pragma unroll
            for (int nt = 0; nt < 2; ++nt) gw[mt][nt] = *(const uint2*)(GT + (size_t)(rt * 128 + wr * 64 + mt * 16 + fr) * 4096 + b * 1024 + ct * 128 + wc * 32 + nt * 16 + 4 * fq);
        f32x4 acc[4][2];
#pragma unroll
        for (int a = 0; a < 4; ++a)
#pragma unroll
            for (int n = 0; n < 2; ++n) acc[a][n] = (f32x4){0.f, 0.f, 0.f, 0.f};
#pragma unroll
        for (int ks = 0; ks < 8; ++ks) { bf16x8 af[4], bfr[2];
#pragma unroll
            for (int mt = 0; mt < 4; ++mt) af[mt] = *(const LAS bf16x8*)(lds + MG_AL + (wr * 64 + mt * 16 + fr) * 528 + ks * 64 + fq * 16);
#pragma unroll
            for (int nt = 0; nt < 2; ++nt) bfr[nt] = *(const LAS bf16x8*)(lds + MG_BL + (wc * 32 + nt * 16 + fr) * 528 + ks * 64 + fq * 16);
#pragma unroll
            for (int mt = 0; mt < 4; ++mt)
#pragma unroll
                for (int nt = 0; nt < 2; ++nt) mfma16(acc[mt][nt], bfr[nt], af[mt]); }
        DRAIN8(&acc[0][0]);
#pragma unroll
        for (int mt = 0; mt < 4; ++mt)
#pragma unroll
            for (int nt = 0; nt < 2; ++nt) { const uint2 g = gw[mt][nt]; macc[mt][nt][0] += bflo(g.x) * acc[mt][nt][0]; macc[mt][nt][1] += bfhi(g.x) * acc[mt][nt][1]; macc[mt][nt][2] += bflo(g.y) * acc[mt][nt][2]; macc[mt][nt][3] += bfhi(g.y) * acc[mt][nt][3]; }
        __syncthreads();
        if (s + 1 < nsteps) MG_WRITE();
        if (b == 3) {
#pragma unroll
            for (int mt = 0; mt < 4; ++mt)
#pragma unroll
                for (int nt = 0; nt < 2; ++nt) { st4bf(MB + (size_t)(rt * 128 + wr * 64 + mt * 16 + fr) * 1024 + ct * 128 + wc * 32 + nt * 16 + 4 * fq, macc[mt][nt]); macc[mt][nt] = (f32x4){0.f, 0.f, 0.f, 0.f}; }
        }
    }
    __syncthreads();
#undef MG_LOAD
#undef MG_WRITE
}
constexpr int AT_RPB = 32768, AT_MRG = 40960;
__device__ __forceinline__ int clampi(int v, int lo, int hi) { return v < lo ? lo : (v > hi ? hi : v); }
__device__ __forceinline__ bool at_need(int kind, int jb, int t) { return kind == 2 || (kind == 0 ? (jb < 2 || (jb == 2 && t == 1)) : (jb > 1 || (jb == 1 && t == 0))); }
struct AtCtx { const bf16* QPL; const bf16* KR; const bf16* VV; LAS unsigned char* vbuf; const LAS float* rpbl; int h, qh, fr, fq, lane, b, r, kr0, qrow0, nch, nwin; bool lat; unsigned code[2][2][2]; };
__device__ __forceinline__ unsigned at_keyrow(const AtCtx& X, int ci) { return (ci < X.nwin) ? ((unsigned)X.b * SEQ + (unsigned)(X.kr0 + (ci >> 1)) * 64 + 32 * (ci & 1)) : ((unsigned)ML + X.b * CTXL + 32 * (ci - X.nwin)); }
__device__ __forceinline__ void at_load(const AtCtx& X, int ci, bf16x8 (&kf)[2][2], v4u (&vst)[4]) {
    const unsigned kr = at_keyrow(X, ci);
#pragma unroll
    for (int t = 0; t < 2; ++t)
#pragma unroll
        for (int ks = 0; ks < 2; ++ks) kf[t][ks] = *(const bf16x8*)(X.KR + (unsigned)((kr + 16 * t + X.fr) * 256 + X.h * 64 + ks * 32 + X.fq * 8));
#pragma unroll
    for (int i = 0; i < 4; ++i) { const int p = i * 64 + X.lane, key = p >> 3, seg = p & 7; vst[i] = *(const v4u*)(X.VV + (unsigned)((kr + key) * 256 + X.h * 64 + seg * 8)); }
}
__device__ __forceinline__ void at_chunk(const AtCtx& X, const int ci, bf16x8 (&kf)[2][2], v4u (&vst)[4], bf16x8 (&qf)[2][2], f32x4 (&O)[2][4], float (&m)[2], float (&l)[2]) {
    const int kind = ci < X.nwin ? (ci & 1) : 2, fr = X.fr, fq = X.fq, qh = X.qh;
    if (X.lat && ci == 16) {
#pragma unroll
        for (int j = 0; j < 2; ++j)
#pragma unroll
            for (int ks = 0; ks < 2; ++ks) qf[j][ks] = *(const bf16x8*)(X.QPL + (unsigned)((X.qrow0 + 16 * (2 * qh + j) + fr) * 256 + X.h * 64 + ks * 32 + fq * 8)); }
#pragma unroll
    for (int i = 0; i < 4; ++i) { const int p = i * 64 + X.lane, key = p >> 3, seg = p & 7; *(LAS v4u*)(X.vbuf + key * 128 + ((((seg >> 1) ^ ((key >> 1) & 3))) << 5) + ((seg & 1) << 4)) = vst[i]; }
    f32x4 S[2][2]; bool nd[2][2];
#pragma unroll
    for (int j = 0; j < 2; ++j)
#pragma unroll
        for (int t = 0; t < 2; ++t) { S[j][t] = (f32x4){0.f, 0.f, 0.f, 0.f}; nd[j][t] = at_need(kind, 2 * qh + j, t);
            if (nd[j][t]) { mfma16(S[j][t], kf[t][0], qf[j][0]); mfma16(S[j][t], kf[t][1], qf[j][1]); } }
    asm volatile("s_nop 15\n\ts_nop 15" : "+v"(S[0][0]), "+v"(S[0][1]), "+v"(S[1][0]), "+v"(S[1][1]));
    if (ci + 3 < X.nch) at_load(X, ci + 3, kf, vst);
    const LAS float* rpbrow = X.rpbl + (kind != 2 ? (X.kr0 + (ci >> 1) - X.r + 7) * 31 : 0);
    bf16x8 pf[2]; bool anyj[2];
#pragma unroll
    for (int j = 0; j < 2; ++j) { anyj[j] = nd[j][0] || nd[j][1];
        float mc = -3.0e38f;
#pragma unroll
        for (int t = 0; t < 2; ++t)
#pragma unroll
            for (int rg = 0; rg < 4; ++rg) { float s = S[j][t][rg];
                if (kind != 2) { const unsigned cd = ((kind == 0 ? X.code[0][j][t] : X.code[1][j][t]) >> (8 * rg)) & 255u; const float bias = rpbrow[cd & 31u]; s = cd < 32u ? s + bias : -1.0e30f; }
                S[j][t][rg] = s; mc = fmaxf(mc, s); }
        { auto r16 = __builtin_amdgcn_permlane16_swap(__float_as_uint(mc), __float_as_uint(mc), false, false); mc = fmaxf(__uint_as_float(r16[0]), __uint_as_float(r16[1]));
          auto r32 = __builtin_amdgcn_permlane32_swap(__float_as_uint(mc), __float_as_uint(mc), false, false); mc = fmaxf(__uint_as_float(r32[0]), __uint_as_float(r32[1])); }
        const float mnew = fmaxf(m[j], mc), alpha = __expf(m[j] - mnew); m[j] = mnew; float ls = 0.f;
#pragma unroll
        for (int t = 0; t < 2; ++t)
#pragma unroll
            for (int rg = 0; rg < 4; ++rg) { const float p = __expf(S[j][t][rg] - mnew); S[j][t][rg] = p; ls += p; }
        l[j] = l[j] * alpha + ls;
#pragma unroll
        for (int dt = 0; dt < 4; ++dt) O[j][dt] = O[j][dt] * alpha;
        v4u pw; pw.x = pk2(S[j][0][0], S[j][0][1]); pw.y = pk2(S[j][0][2], S[j][0][3]); pw.z = pk2(S[j][1][0], S[j][1][1]); pw.w = pk2(S[j][1][2], S[j][1][3]);
        pf[j] = __builtin_bit_cast(bf16x8, pw); }
#pragma unroll
    for (int dt = 0; dt < 4; ++dt) { v4i16_t t0, t1;
        { const int key = 4 * fq + (fr >> 2); t0 = __builtin_amdgcn_ds_read_tr16_b64_v4i16((LAS v4i16_t*)(X.vbuf + key * 128 + ((dt ^ ((key >> 1) & 3)) << 5) + (fr & 3) * 8)); }
        { const int key = 16 + 4 * fq + (fr >> 2); t1 = __builtin_amdgcn_ds_read_tr16_b64_v4i16((LAS v4i16_t*)(X.vbuf + key * 128 + ((dt ^ ((key >> 1) & 3)) << 5) + (fr & 3) * 8)); }
        const bf16x8 vf = (bf16x8){t0[0], t0[1], t0[2], t0[3], t1[0], t1[1], t1[2], t1[3]};
        if (anyj[0]) mfma16(O[0][dt], vf, pf[0]);
        if (anyj[1]) mfma16(O[1][dt], vf, pf[1]); }
    asm volatile("s_nop 15\n\ts_nop 7" : "+v"(O[0][0]), "+v"(O[0][1]), "+v"(O[0][2]), "+v"(O[0][3]), "+v"(O[1][0]), "+v"(O[1][1]), "+v"(O[1][2]), "+v"(O[1][3]));
}
__device__ __forceinline__ void attn_unit(PH_ARGS, const int unit) {
    AtCtx X; X.h = wave >> 1; X.qh = wave & 1; X.fr = lane & 15; X.fq = lane >> 4; X.lane = lane;
    X.lat = unit < 256; X.r = 0; X.kr0 = 0;
    if (X.lat) { X.b = unit >> 7; X.r = unit & 127; X.qrow0 = X.b * SEQ + X.r * 64; X.kr0 = clampi(X.r - 4, 0, 120); }
    else { const int u2 = unit - 256; X.b = u2 >> 2; X.qrow0 = ML + X.b * CTXL + (u2 & 3) * 64; }
    X.QPL = WSP(bf16, WS_QPL); const bf16* QROT = WSP(bf16, WS_QROT); X.KR = WSP(bf16, WS_KR); X.VV = WSP(bf16, WS_VV);
    bf16* BRd = WSP(bf16, WS_BR) + (size_t)3 * MT * 256;
    X.vbuf = lds + wave * 4096; X.rpbl = (const LAS float*)(lds + AT_RPB) + X.h * 465;
    X.nch = X.lat ? 24 : 8; X.nwin = X.lat ? 16 : 0;
#pragma unroll
    for (int kd = 0; kd < 2; ++kd)
#pragma unroll
        for (int j = 0; j < 2; ++j)
#pragma unroll
            for (int t = 0; t < 2; ++t) { unsigned cw = 0u; const int jb = 2 * X.qh + j;
#pragma unroll
                for (int rg = 0; rg < 4; ++rg) { const int kcol = 32 * kd + 16 * t + 4 * X.fq + rg, qcol = 16 * jb + X.fr, cst = clampi(qcol - 8, 0, 48); const bool ok = at_need(kd, jb, t) && kcol >= cst && kcol < cst + 16;
                    cw |= (ok ? (unsigned)(clampi(kcol - qcol, -15, 15) + 15) : 255u) << (8 * rg); }
                X.code[kd][j][t] = cw; }
    float m[2], l[2]; f32x4 O[2][4];
#pragma unroll
    for (int j = 0; j < 2; ++j) { m[j] = -3.0e38f; l[j] = 0.f;
#pragma unroll
        for (int dt = 0; dt < 4; ++dt) O[j][dt] = (f32x4){0.f, 0.f, 0.f, 0.f}; }
    bf16x8 qf[2][2];
    { const bf16* Qs = X.lat ? QROT : X.QPL;
#pragma unroll
      for (int j = 0; j < 2; ++j)
#pragma unroll
          for (int ks = 0; ks < 2; ++ks) qf[j][ks] = *(const bf16x8*)(Qs + (unsigned)((X.qrow0 + 16 * (2 * X.qh + j) + X.fr) * 256 + X.h * 64 + ks * 32 + X.fq * 8)); }
    bf16x8 kA[2][2], kB[2][2], kC[2][2]; v4u vA[4], vB[4], vC[4];
    at_load(X, 0, kA, vA); at_load(X, 1, kB, vB); at_load(X, 2, kC, vC);
#pragma unroll 1
    for (int ci = 0; ci < X.nch; ci += 3) {
        at_chunk(X, ci, kA, vA, qf, O, m, l);
        if (ci + 1 < X.nch) at_chunk(X, ci + 1, kB, vB, qf, O, m, l);
        if (ci + 2 < X.nch) at_chunk(X, ci + 2, kC, vC, qf, O, m, l);
    }
#pragma unroll
    for (int j = 0; j < 2; ++j) { l[j] += __shfl_xor(l[j], 16); l[j] += __shfl_xor(l[j], 32); const float inv = 1.f / l[j];
#pragma unroll
        for (int dt = 0; dt < 4; ++dt) st4bf(BRd + (unsigned)((X.qrow0 + 16 * (2 * X.qh + j) + X.fr) * 256 + X.h * 64 + dt * 16 + 4 * X.fq), O[j][dt] * inv); }
}
#ifndef CDFT_REP
#define CDFT_REP 1
#endif
#ifndef CONV_REP
#define CONV_REP 1
#endif
#ifndef GMLP_REP
#define GMLP_REP 1
#endif
#ifndef F1_REP
#define F1_REP 1
#endif
__device__ __forceinline__ int block_excl_scan(int v, LAS int* ws8, int lane, int wave) {
    int x = v;
#pragma unroll
    for (int o = 1; o < 64; o <<= 1) { const int y = __shfl_up(x, o); if (lane >= o) x += y; }
    if (lane == 63) ws8[wave] = x;
    __syncthreads();
    int base = 0;
#pragma unroll
    for (int w = 0; w < 8; ++w) base += (w < wave) ? ws8[w] : 0;
    __syncthreads();
    return base + x - v;
}
template <int PER, bool ALLV>
__device__ __forceinline__ void topk_unit(PH_ARGS, const int rowbase, const int n, const int C, const int e, const int sbase, const bool writepad) {
    const float* AFF = WSP(float, WS_AFF); int* SEL = WSP(int, WS_SEL); int* IDX = WSP(int, WS_IDX); float* GATE = WSP(float, WS_GATE);
    LAS unsigned* hist = (LAS unsigned*)lds; LAS unsigned* sh = hist + 256; LAS int* ws8 = (LAS int*)(hist + 272);
    unsigned key[PER]; bool valid[PER];
#pragma unroll
    for (int i = 0; i < PER; ++i) { const int tok = tid * PER + i; valid[i] = ALLV ? true : (tok < n); key[i] = valid[i] ? __float_as_uint(AFF[(size_t)(rowbase + tok) * 16 + e]) : 0u; }
    unsigned prefix = 0u, mask = 0u, rem = (unsigned)C;
#pragma unroll 1
    for (int pass = 0; pass < 4; ++pass) { const int shift = 24 - 8 * pass;
        if (tid < 256) hist[tid] = 0u;
        __syncthreads();
#pragma unroll
        for (int i = 0; i < PER; ++i) if (valid[i] && (key[i] & mask) == prefix) atomicAdd((unsigned*)&hist[(key[i] >> shift) & 255u], 1u);
        __syncthreads();
        if (wave == 0) { unsigned c0 = hist[255 - 4 * lane], c1 = hist[254 - 4 * lane], c2 = hist[253 - 4 * lane], c3 = hist[252 - 4 * lane];
            const unsigned s = c0 + c1 + c2 + c3; unsigned x = s;
#pragma unroll
            for (int o = 1; o < 64; o <<= 1) { const unsigned y = __shfl_up(x, o); if (lane >= o) x += y; }
            const unsigned excl = x - s;
            if (excl < rem && rem <= x) { unsigned cum = excl; int bin; unsigned nr;
                if (cum + c0 >= rem) { bin = 255 - 4 * lane; nr = rem - cum; }
                else { cum += c0; if (cum + c1 >= rem) { bin = 254 - 4 * lane; nr = rem - cum; }
                else { cum += c1; if (cum + c2 >= rem) { bin = 253 - 4 * lane; nr = rem - cum; }
                else { cum += c2; bin = 252 - 4 * lane; nr = rem - cum; } } }
                sh[0] = (unsigned)bin; sh[1] = nr; } }
        __syncthreads();
        prefix |= sh[0] << shift; mask |= 255u << shift; rem = sh[1];
    }
    __syncthreads();
    const unsigned T = prefix;
    int neq = 0;
#pragma unroll
    for (int i = 0; i < PER; ++i) neq += (valid[i] && key[i] == T) ? 1 : 0;
    const int eqbase = block_excl_scan(neq, ws8, lane, wave);
    unsigned take = 0u; int nsel = 0, eqs = 0;
#pragma unroll
    for (int i = 0; i < PER; ++i) { const bool iseq = valid[i] && key[i] == T; const bool tk = valid[i] && (key[i] > T || (iseq && (unsigned)(eqbase + eqs) < rem)); eqs += iseq ? 1 : 0; if (tk) { take |= 1u << i; ++nsel; } }
    const int sb = block_excl_scan(nsel, ws8, lane, wave);
    int cnt = 0;
#pragma unroll
    for (int i = 0; i < PER; ++i) { const int tok = tid * PER + i;
        if (valid[i]) { if ((take >> i) & 1u) { const int slot = sbase + sb + cnt; ++cnt; IDX[e * ESTR + slot] = rowbase + tok; GATE[e * ESTR + slot] = __uint_as_float(key[i]); SEL[(size_t)(rowbase + tok) * 16 + e] = slot; }
                        else SEL[(size_t)(rowbase + tok) * 16 + e] = -1; } }
    if (writepad) for (int i = tid; i < ESTR - 2112; i += 512) { IDX[e * ESTR + 2112 + i] = 0; GATE[e * ESTR + 2112 + i] = 0.f; }
    __syncthreads();
}
__device__ __forceinline__ void gather_rows(PH_ARGS, const int tpe) {
    const int gw = bid * 8 + wave, NGW = G * 8, per = tpe * 256; const int* IDX = WSP(int, WS_IDX); const bf16* H = WSP(bf16, WS_H); bf16* XE = WSP(bf16, WS_XE);
    for (int i = gw; i < NE * per; i += NGW) { const int e = i / per, s = i % per, rg = e * ESTR + s; const int src = IDX[rg];
        const v4u a = *(const v4u*)(H + (size_t)src * 1024 + lane * 8), b = *(const v4u*)(H + (size_t)src * 1024 + 512 + lane * 8);
        *(v4u*)(XE + (size_t)rg * 1024 + lane * 8) = a; *(v4u*)(XE + (size_t)rg * 1024 + 512 + lane * 8) = b; }
}
__device__ __forceinline__ void combine_rows(PH_ARGS, const int l) {
    const int gw = bid * 8 + wave, NGW = G * 8; const int nrows = l == 0 ? MT : ML;
    const int* SEL = WSP(int, WS_SEL); const bf16* YB = WSP(bf16, WS_XE); float* X = WSP(float, WS_X); bf16* H = WSP(bf16, WS_H); const float* MOD = WSP(float, WS_MOD);
    for (int row = gw; row < nrows; row += NGW) {
        const int r = row < SEQ ? 0 : (row < ML ? 1 : 2);
        float acc[2][8];
#pragma unroll
        for (int j = 0; j < 2; ++j)
#pragma unroll
            for (int i = 0; i < 8; ++i) acc[j][i] = 0.f;
        const int myslot = lane < 16 ? SEL[(size_t)row * 16 + lane] : -1;
#pragma unroll
        for (int e = 0; e < 16; ++e) { const int s = __shfl(myslot, e);
            if (s >= 0) { const bf16* y = YB + (size_t)(e * ESTR + s) * 1024 + lane * 8;
#pragma unroll
                for (int j = 0; j < 2; ++j) { const v4u w = *(const v4u*)(y + 512 * j);
                    acc[j][0] += bflo(w.x); acc[j][1] += bfhi(w.x); acc[j][2] += bflo(w.y); acc[j][3] += bfhi(w.y); acc[j][4] += bflo(w.z); acc[j][5] += bfhi(w.z); acc[j][6] += bflo(w.w); acc[j][7] += bfhi(w.w); } } }
        const float* gt2 = MOD + (l * 3 + r) * 6144 + 5 * 1024; float* xr = X + (size_t)row * 1024;
        float xv[2][8]; float ss = 0.f;
#pragma unroll
        for (int j = 0; j < 2; ++j) { const int o = 8 * lane + 512 * j; const f32x4 x0 = *(const f32x4*)(xr + o), x1 = *(const f32x4*)(xr + o + 4), g0 = *(const f32x4*)(gt2 + o), g1 = *(const f32x4*)(gt2 + o + 4);
#pragma unroll
            for (int i = 0; i < 4; ++i) { xv[j][i] = x0[i] + g0[i] * acc[j][i]; xv[j][4 + i] = x1[i] + g1[i] * acc[j][4 + i]; }
#pragma unroll
            for (int i = 0; i < 8; ++i) ss += xv[j][i] * xv[j][i]; }
        const float rs = 1.0f / sqrtf(wave_sum(ss) * (1.f / 1024.f) + 1e-6f);
        if (l == 0) {
            const float* md = MOD + (1 * 3 + r) * 6144; const float* g = INP(6) + 1024;
#pragma unroll
            for (int j = 0; j < 2; ++j) { const int o = 8 * lane + 512 * j;
                *(f32x4*)(xr + o) = (f32x4){xv[j][0], xv[j][1], xv[j][2], xv[j][3]}; *(f32x4*)(xr + o + 4) = (f32x4){xv[j][4], xv[j][5], xv[j][6], xv[j][7]};
                float hv[8];
#pragma unroll
                for (int i = 0; i < 8; ++i) hv[i] = xv[j][i] * rs * g[o + i] * (1.f + md[1024 + o + i]) + md[o + i];
                v4u w; w.x = pk2(hv[0], hv[1]); w.y = pk2(hv[2], hv[3]); w.z = pk2(hv[4], hv[5]); w.w = pk2(hv[6], hv[7]);
                *(v4u*)(H + (size_t)row * 1024 + o) = w; }
        } else {
            const float* g = INP(27); float* orow = PTRV(28, float) + (size_t)row * 1024;
#pragma unroll
            for (int j = 0; j < 2; ++j) { const int o = 8 * lane + 512 * j;
                *(f32x4*)(orow + o) = (f32x4){xv[j][0] * rs * g[o + 0], xv[j][1] * rs * g[o + 1], xv[j][2] * rs * g[o + 2], xv[j][3] * rs * g[o + 3]};
                *(f32x4*)(orow + o + 4) = (f32x4){xv[j][4] * rs * g[o + 4], xv[j][5] * rs * g[o + 5], xv[j][6] * rs * g[o + 6], xv[j][7] * rs * g[o + 7]}; }
        }
    }
}


#ifdef DBG_STOP
__device__ __forceinline__ void debug_out(PH_ARGS) {
    float* out = PTRV(28, float);
    const int gt = bid * 512 + tid, GT = G * 512;
    for (size_t i = gt; i < (size_t)ML * 1024; i += GT) { const size_t row = i >> 10; const int c = (int)(i & 1023); float v = 0.f;
#if DBG_STOP == 2
        v = bflo(WSP(bf16, WS_H)[row * 1024 + c]) + WSP(float, WS_MOD)[(i % 36864)] + bflo(WSP(bf16, WS_WIN)[i % (6400 * 1024)]) + bflo(WSP(bf16, WS_WGU)[i]) + bflo(WSP(bf16, WS_WDN)[i]) + bflo(WSP(bf16, WS_WO)[i % (1024*1024)]) + bflo(WSP(bf16, WS_WBR)[i % (1024*1024)]);
#elif DBG_STOP == 3
        v = bflo(WSP(bf16, WS_AUV)[row * 512 + (c & 511)]) + bflo(WSP(bf16, WS_YF)[row * 512 + (c & 511)]) + bflo(WSP(bf16, WS_CY)[row * 256 + (c & 255)]) + bflo(WSP(bf16, WS_QPL)[row * 256 + (c & 255)])
          + bflo(WSP(bf16, WS_QROT)[row * 256 + (c & 255)]) + bflo(WSP(bf16, WS_KR)[row * 256 + (c & 255)]) + bflo(WSP(bf16, WS_VV)[row * 256 + (c & 255)])
          + bflo(WSP(bf16, WS_G)[row * 4096 + c]) + bflo(WSP(bf16, WS_G)[row * 4096 + 1024 + c]) + bflo(WSP(bf16, WS_G)[row * 4096 + 2048 + c]) + bflo(WSP(bf16, WS_G)[row * 4096 + 3072 + c]);
#elif DBG_STOP == 4
        v = bflo(WSP(bf16, WS_BR)[(size_t)(0 * MT + row) * 256 + (c & 255)]) + bflo(WSP(bf16, WS_BR)[(size_t)(2 * MT + row) * 256 + (c & 255)]) + bflo(WSP(bf16, WS_FA)[i % ((size_t)8 << 20)]);
#elif DBG_STOP == 21
        v = bflo(WSP(bf16, WS_T1T)[i % 16384]) * 1.001f + WSP(float, WS_ROPEC)[i % 2048] + WSP(float, WS_ROPES)[i % 2048] + bflo(WSP(bf16, WS_WSP)[i % 65536]);
#elif DBG_STOP == 31 || DBG_STOP == 44
        v = 0.f;
#elif DBG_STOP == 45 || DBG_STOP == 32
        v = 0.f;
#elif DBG_STOP == 41
        v = bflo(WSP(bf16, WS_BR)[(size_t)(0 * MT + row) * 256 + (c & 255)]) * 1.001f + bflo(WSP(bf16, WS_BR)[(size_t)(0 * MT + row) * 256 + ((c + 7) & 255)]);
#elif DBG_STOP == 42
        v = bflo(WSP(bf16, WS_BR)[(size_t)(2 * MT + row) * 256 + (c & 255)]) * 1.001f + bflo(WSP(bf16, WS_BR)[(size_t)(2 * MT + row) * 256 + ((c + 7) & 255)]);
#elif DBG_STOP == 43
        v = bflo(WSP(bf16, WS_FA)[i % ((size_t)8 << 20)]) * 1.001f + bflo(WSP(bf16, WS_FA)[(i + 7) % ((size_t)8 << 20)]);
#elif DBG_STOP == 5
        v = bflo(WSP(bf16, WS_BR)[(size_t)(1 * MT + row) * 256 + (c & 255)]) + bflo(WSP(bf16, WS_BR)[(size_t)(3 * MT + row) * 256 + (c & 255)]);
#elif DBG_STOP == 6
        v = bflo(WSP(bf16, WS_MB)[row * 1024 + c]);
#elif DBG_STOP == 7
        v = WSP(float, WS_X)[row * 1024 + c];
#elif DBG_STOP == 8
        v = bflo(WSP(bf16, WS_H)[row * 1024 + c]) + WSP(float, WS_AFF)[row * 16 + (c & 15)];
#elif DBG_STOP == 9
        v = (float)WSP(int, WS_SEL)[row * 16 + (c & 15)] + WSP(float, WS_GATE)[i % (16 * 2304)] + (float)WSP(int, WS_IDX)[i % (16 * 2304)];
#elif DBG_STOP == 10
        v = bflo(WSP(bf16, WS_XE)[i]) + bflo(WSP(bf16, WS_XE)[i + (size_t)ML * 1024]);
#elif DBG_STOP == 11
        v = bflo(WSP(bf16, WS_ACT)[i]) + bflo(WSP(bf16, WS_ACT)[i + (size_t)ML * 1024]);
#elif DBG_STOP == 12
        v = bflo(WSP(bf16, WS_XE)[i]) + bflo(WSP(bf16, WS_XE)[i + (size_t)ML * 1024]);
#else
        v = WSP(float, WS_X)[row * 1024 + c] + bflo(WSP(bf16, WS_H)[row * 1024 + c]);
#endif
#ifdef DBG_AMP
        v = (float)(__float_as_uint(v) & 0xFFFFu);
#endif
        out[i] = v; }
}
#endif
__global__ void __launch_bounds__(512, 2) mega(Args A) {
    extern __shared__ __attribute__((aligned(16))) unsigned char lds_raw[];
    LAS unsigned char* lds0 = (LAS unsigned char*)lds_raw;
    volatile LAS unsigned* MISC = (volatile LAS unsigned*)(lds0 + MISC_OFF);
    const int tid = threadIdx.x, lane = tid & 63, wave = __builtin_amdgcn_readfirstlane(tid >> 6), bid = blockIdx.x, G = gridDim.x;
    for (int u = tid; u < (LDS_BYTES - MISC_OFF) / 4; u += 512) ((LAS unsigned*)(lds0 + MISC_OFF))[u] = 0u;
    __syncthreads();
    if (tid == 0) { typedef unsigned u2v_t __attribute__((ext_vector_type(2)));
#pragma unroll
        for (int i = 0; i < 30; ++i) { const unsigned long long p = i < 28 ? (unsigned long long)A.in[i] : (i == 28 ? (unsigned long long)A.out : (unsigned long long)A.ws);
            *(LAS u2v_t*)(lds0 + PTAB_OFF + 8 * i) = (u2v_t){(unsigned)p, (unsigned)(p >> 32)}; } }
    __syncthreads();
    const int lo = A.ph_lo, hi = A.ph_hi;
    XcdBarrier bar; bar.bar = (unsigned*)(A.ws + WS_CTL) + CW_BAR; bar.x = 0; bar.st = nullptr;
    if (hi - lo > 1) bar = xcd_barrier_post((unsigned*)(A.ws + WS_CTL) + CW_BAR, MISC + 8);
#define PH_CALL lds, tl_, (tl_ & 63), wv_, bl_, G_
#define PH_CALLV lds, tl_, (tl_ & 63), wv_, vb_, G_
#ifdef TS_I
    if (bid == 0 && tid == 0) ((unsigned long long*)(A.ws + 65536))[lo] = rt();
#endif
#pragma unroll 1
#ifdef REP_PH
    for (int it_ = lo; it_ < hi + (REP_N - 1); ++it_) { const int ph = it_ < REP_PH ? it_ : (it_ < REP_PH + REP_N ? REP_PH : it_ - (REP_N - 1));
#else
    for (int ph = lo; ph < hi; ++ph) {
#endif
        int tl_ = tid; asm volatile("" : "+v"(tl_)); int bl_ = bid; asm volatile("" : "+s"(bl_)); int vb_ = (G % 8 == 0) ? (bid % 8) * (G / 8) + bid / 8 : bid; asm volatile("" : "+s"(vb_)); int wv_ = wave; asm volatile("" : "+s"(wv_)); int G_ = G; asm volatile("" : "+s"(G_)); unsigned ldsb_ = (unsigned)(uintptr_t)lds0; asm volatile("" : "+s"(ldsb_)); LAS unsigned char* lds = (LAS unsigned char*)(uintptr_t)ldsb_;
        const int l = ph < 13 ? 0 : 1, kind = ph >= 99 ? 99 : (ph < 2 ? ph : 2 + (ph - 2 - 11 * l));
        const int ntm = l == 0 ? 66 : 64, tpe = l == 0 ? 9 : 8;
        switch (kind) {
#ifdef DBG_STOP
        case 99: debug_out(PH_CALL); break;
#endif
        case 0: {
#ifndef P0R_MOD
#define P0R_MOD 1
#endif
#ifndef P0R_TAB
#define P0R_TAB 1
#endif
#ifndef P0R_CVT
#define P0R_CVT 1
#endif
#pragma unroll 1
            for (int r_ = 0; r_ < P0R_MOD; ++r_) { mod_gemv(PH_CALL); asm volatile("" ::: "memory"); }
#pragma unroll 1
            for (int r_ = 0; r_ < P0R_TAB; ++r_) { make_tables(PH_CALL); asm volatile("" ::: "memory"); }
#pragma unroll 1
            for (int r_ = 0; r_ < P0R_CVT; ++r_) { convert_weights(PH_CALL, 0); asm volatile("" ::: "memory"); }
        } break;
        case 1: {
#ifndef DIS_N1
            norm1_l0(PH_CALL);
#endif
        } break;
        case 2: {
            pg8::Gemm g{WSP(bf16, WS_H), WSP(bf16, WS_WIN), MT, NIN, 1024}; pg8::StaticOrder S; S.init(MT, NIN, G_, bl_);
            EpiIn E{WSP(bf16, WS_AUV), WSP(bf16, WS_YF), WSP(bf16, WS_CY), WSP(bf16, WS_QPL), WSP(bf16, WS_QROT), WSP(bf16, WS_KR), WSP(bf16, WS_VV), WSP(bf16, WS_G), WSP(float, WS_ROPEC), WSP(float, WS_ROPES)};
#ifndef DIS_GIN
            pg8::gemm_phase<EpiIn, pg8::StaticOrder, true, true>(lds, g, S, E);
#endif
        } break;
        case 3: {
#ifndef DIS_F1
            if (bl_ < 256) { f1_stage_tables(PH_CALL);
#pragma unroll 1
              for (int r_ = 0; r_ < F1_REP; ++r_) for (int u = vb_; u < 256; u += G_) f1_unit(PH_CALL, u); }
#endif
            const int nconv = l == 0 ? 264 : 256, ngm = l == 0 ? 132 : 128;
#ifndef DIS_CONV
#pragma unroll 1
            for (int r_ = 0; r_ < CONV_REP; ++r_) for (int u = vb_; u < nconv; u += G_) conv_unit(PH_CALL, l, u);
#endif
#ifndef DIS_GMLP
#pragma unroll 1
            for (int r_ = 0; r_ < GMLP_REP; ++r_) for (int u = G_ - 1 - vb_; u < ngm; u += G_) gmlp_unit(PH_CALL, l, u);
#endif
#ifndef DIS_CDFT
            if (l == 0) ctx_butterfly(PH_CALL);
#endif
        } break;
        case 4: {
#ifndef DIS_F2
#ifndef F2_REP
#define F2_REP 1
#endif
#ifndef ATT_REP
#define ATT_REP 1
#endif
#pragma unroll 1
            for (int r_ = 0; r_ < F2_REP; ++r_) { const int nf2 = l == 0 ? 264 : 256; for (int u = vb_; u < nf2; u += G_) f2_unit(PH_CALL, u); }
#endif
            { LAS float* rp = (LAS float*)(lds + AT_RPB); const float* src = INP(20) + l * 1860; for (int i = tl_; i < 1860; i += 512) rp[i] = src[i]; }
            __syncthreads();
            const int nat = l == 0 ? 264 : 256;
#ifndef DIS_ATT
#pragma unroll 1
            for (int r_ = 0; r_ < ATT_REP; ++r_) for (int u = vb_; u < nat; u += G_) attn_unit(PH_CALL, u);
#endif
        } break;
        case 5: {
#ifndef DIS_GMRG
            merge_phase(PH_CALLV, ntm * 16);
#endif
        } break;
        case 6: {
            pg8::Gemm g{WSP(bf16, WS_MB), WSP(bf16, WS_WO), ntm * 256, 1024, 1024}; pg8::StaticOrder S; S.init(ntm * 256, 1024, G_, bl_);
            EpiWout E{l == 0 ? INP(0) : WSP(float, WS_X), l == 0 ? INP(2) : WSP(float, WS_X) + (size_t)ML * 1024, WSP(float, WS_X), WSP(float, WS_MOD) + l * 3 * 6144};
#ifndef DIS_GWO
            pg8::gemm_phase<EpiWout, pg8::StaticOrder, true, true>(lds, g, S, E);
#endif
        } break;
        case 7: {
#ifndef DIS_N2
            norm2_router(PH_CALL, l, ntm * 256);
#endif
        } break;
        case 8: {
#ifndef DIS_TOPK
            const int nun = l == 0 ? 64 : 32;
            for (int u = bl_; u < nun; u += G_) {
                if (u < 32) { const int b = u >> 4, e = u & 15; topk_unit<16, true>(PH_CALL, b * SEQ, SEQ, CAPL, e, b * CAPL, l == 0 && b == 0); }
                else { const int b = (u - 32) >> 4, e = u & 15; topk_unit<1, false>(PH_CALL, ML + b * CTXL, CTXL, CAPC, e, 2048 + b * CAPC, false); }
            }
#endif
        } break;
        case 9: {
#ifndef DIS_GATH
            gather_rows(PH_CALL, tpe);
#endif
        } break;
        case 10: {
            pg8::Gemm g{WSP(bf16, WS_XE), WSP(bf16, WS_WGU), NE * ESTR, NE * 2048, 1024}; GroupOrder S; S.init(tpe, 8, G_, bl_);
            EpiGU E{WSP(bf16, WS_ACT)};
#ifndef DIS_GGU
            pg8::gemm_phase<EpiGU, GroupOrder, true, true>(lds, g, S, E);
#endif
        } break;
        case 11: {
            pg8::Gemm g{WSP(bf16, WS_ACT), WSP(bf16, WS_WDN), NE * ESTR, NE * 1024, 1024}; GroupOrder S; S.init(tpe, 4, G_, bl_);
            EpiDown E{WSP(bf16, WS_XE), WSP(float, WS_GATE)};
#ifndef DIS_GDN
            pg8::gemm_phase<EpiDown, GroupOrder, true, true>(lds, g, S, E);
#endif
        } break;
        default: {
#ifndef DIS_COMB
            combine_rows(PH_CALL, l);
#endif
#ifndef DIS_CVT
            if (l == 0) convert_weights(PH_CALL, 1);
#endif
        } break;
        }
#ifdef TS_I
        { XcdBarrier b3 = bar; b3.bar = (unsigned*)(PTRV(29, unsigned char) + WS_CTL) + CW_BAR; b3.st = (volatile LAS unsigned*)(lds + MISC_OFF) + 8; xcd_barrier(b3);
          if (bid == 0 && tid == 0) ((unsigned long long*)(PTRV(29, unsigned char) + 65536))[ph + 1] = rt(); }
        if (ph + 1 == hi) { XcdBarrier b3 = bar; b3.bar = (unsigned*)(PTRV(29, unsigned char) + WS_CTL) + CW_BAR; b3.st = (volatile LAS unsigned*)(lds + MISC_OFF) + 8; xcd_barrier(b3);
            const unsigned long long* TS = (const unsigned long long*)(PTRV(29, unsigned char) + 65536);
            const float dti = (float)(TS[TS_I + 1] - TS[TS_I]) * 0.01f, dtj = (float)(TS[TS_J + 1] - TS[TS_J]) * 0.01f;
            float* out = PTRV(28, float); const float Av = sqrtf(dti);
            for (size_t i = (size_t)bid * 512 + tid; i < (size_t)ML * 1024; i += (size_t)G * 512) out[i] = (i == 0) ? dtj * 10.f : Av; }
        if (0) {
#else
#ifdef REP_PH
        if (it_ + 1 < hi + (REP_N - 1)) {
#else
        if (ph + 1 < hi) {
#endif
#endif
          XcdBarrier b2 = bar; b2.bar = (unsigned*)(PTRV(29, unsigned char) + WS_CTL) + CW_BAR; unsigned bx_ = bar.x; asm volatile("" : "+s"(bx_)); b2.x = bx_; b2.st = (volatile LAS unsigned*)(lds + MISC_OFF) + 8; xcd_barrier(b2); }
    }
}

extern "C" void kernel_launch(void* const* d_in, const int* in_sizes, int n_in, void* d_out, int out_size, void* d_ws, size_t ws_size, hipStream_t stream) {
    static int grid = 0;
    if (grid == 0) {
        if (n_in != 28 || ws_size < WS_END) { fprintf(stderr, "kernel_launch: unexpected n_in %d / ws %zu\n", n_in, ws_size); grid = -1; return; }
        int dev = 0, cus = 0;
        if (hipGetDevice(&dev) != hipSuccess || hipDeviceGetAttribute(&cus, hipDeviceAttributeMultiprocessorCount, dev) != hipSuccess) { grid = -1; return; }
        if (hipFuncSetAttribute((const void*)mega, hipFuncAttributeMaxDynamicSharedMemorySize, LDS_BYTES) != hipSuccess) { fprintf(stderr, "kernel_launch: hipFuncSetAttribute failed\n"); grid = -1; return; }
        (void)hipGetLastError();
        grid = cus;
    }
    if (grid < 0) return;
    (void)hipMemsetAsync((char*)d_ws + WS_CTL, 0, CTL_ZERO_BYTES, stream);
    Args a{};
    for (int i = 0; i < 28; ++i) a.in[i] = (const float*)d_in[i];
    a.out = (float*)d_out; a.ws = (unsigned char*)d_ws;
#ifdef DBG_STOP
    for (int p = 0; p < (DBG_STOP > 20 ? DBG_STOP / 10 : DBG_STOP); ++p) { a.ph_lo = p; a.ph_hi = p + 1; hipLaunchKernelGGL(mega, dim3(grid), dim3(512), LDS_BYTES, stream, a); }
    a.ph_lo = 99; a.ph_hi = 100; hipLaunchKernelGGL(mega, dim3(grid), dim3(512), LDS_BYTES, stream, a);
#elif N_LAUNCHES == 1
    a.ph_lo = 0; a.ph_hi = NPH;
    hipLaunchKernelGGL(mega, dim3(grid), dim3(512), LDS_BYTES, stream, a);
#else
    for (int p = 0; p < NPH; ++p) { a.ph_lo = p; a.ph_hi = p + 1; hipLaunchKernelGGL(mega, dim3(grid), dim3(512), LDS_BYTES, stream, a); }
#endif
}
```

```cpp
#include <hip/hip_runtime.h>
#include <cstdio>
#include <cstdint>
#define N_LAUNCHES 1
namespace pg8 {
#define PG8_LAS __attribute__((address_space(3)))
typedef unsigned short bf16_t;
typedef short bf16x8 __attribute__((ext_vector_type(8)));
typedef float f32x4 __attribute__((ext_vector_type(4)));
typedef unsigned u32x4 __attribute__((ext_vector_type(4)));
constexpr int BM = 256, BK = 64, HALF = 128, HTB = HALF * BK * 2  , STAGE_BYTES = 8 * HTB, NXCD = 8, WGM = 8;

__host__ __device__ __forceinline__ int lds_byte(int r, int c) { const int st = (r >> 4) * 2 + (c >> 5), rr = r & 15, cc = c & 31, ob = rr * 64 + cc * 2; return st * 1024 + (ob ^ (((ob >> 9) & 1) << 5)); }
__host__ __device__ __forceinline__ void stage_rc(int b, int& R, int& C) { const int st = b / 1024, sb = b % 1024, swz = sb ^ (((sb >> 9) & 1) << 5); R = (st >> 1) * 16 + swz / 64; C = (st & 1) * 32 + (swz % 64) / 2; }
__host__ __device__ __forceinline__ int perm32(int rho) { const int n = rho >> 4, i = rho & 15; return 8 * (i >> 2) + 4 * n + (i & 3); }

struct Unit { int pm, pn; };
struct Gemm { const bf16_t* A; const bf16_t* Bt; int M, N, K; };

struct StaticOrder {
    int nM, nN, nwg, G, c;
    __host__ __device__ void init(int M, int N, int G_, int c_) { nM = M / BM; nN = N / BM; nwg = nM * nN; G = G_; c = c_; }
    __host__ __device__ bool next(int i, Unit& u) const {
        const long L = (long)i * G + c; if (L >= nwg) return false;
        int wgid = (int)L; { const int q = nwg / NXCD, r = nwg % NXCD, xcd = wgid % NXCD, off = wgid / NXCD; wgid = (xcd < r ? xcd * (q + 1) : r * (q + 1) + (xcd - r) * q) + off; }
        const int nig = WGM * nN, gid = wgid / nig, fm = gid * WGM, gsz = (nM - fm) < WGM ? (nM - fm) : WGM;
        u.pm = fm + ((wgid % nig) % gsz); u.pn = (wgid % nig) / gsz; return true;
    }
    __device__ __forceinline__ void a_ready(const Unit&) const {}
    __device__ __forceinline__ void done(const Unit&) const {}
};
__device__ __forceinline__ unsigned cvt_pk_bf16(float lo, float hi) { unsigned r; asm volatile("v_cvt_pk_bf16_f32 %0, %1, %2" : "=v"(r) : "v"(lo), "v"(hi)); return r; }
typedef float f32x2 __attribute__((ext_vector_type(2)));
template <class Epi, class Sched, bool ALIGN_EPI = false, bool SP2 = false>
__device__ __forceinline__ void gemm_phase(PG8_LAS unsigned char* lds, const Gemm g, const Sched& S, const Epi& E) {
    int tid_l = threadIdx.x; asm volatile("" : "+v"(tid_l));
    const int tid = tid_l, wid = __builtin_amdgcn_readfirstlane(tid >> 6), lane = tid & 63, wr = wid >> 2, wc = wid & 3, fr = lane & 15, fq = lane >> 4;
    const int K = g.K, nt = K / BK;
    unsigned voffA[2], voffB[2];
#pragma unroll
    for (int i = 0; i < 2; ++i) { int R, C; stage_rc(tid * 16 + i * 8192, R, C); const int Rb = Epi::PERM ? ((R & ~31) + perm32(R & 31)) : R;
        voffA[i] = (unsigned)(R * K + C) * 2u; voffB[i] = (unsigned)(Rb * K + C) * 2u; }
    const size_t kstep = (size_t)(BK * 2);
    const size_t hstep = (size_t)HALF * K * 2;
    const size_t tstep = 2 * hstep;
    const unsigned ldsw = (unsigned)wid * 1024u;
    const int aoff = lds_byte(wr * 64 + fr, fq * 8), boff = lds_byte(wc * 32 + fr, fq * 8);
#define PG8_SA(b, h) (((b) * 2 + (h)) * HTB)
#define PG8_SB(b, h) ((4 + (b) * 2 + (h)) * HTB)
#define PG8_STAGE(bufoff, gbase, voff) do { _Pragma("unroll") for (int _i = 0; _i < 2; ++_i) \
        __builtin_amdgcn_global_load_lds((const unsigned*)((const char*)(gbase) + (voff)[_i]), (PG8_LAS unsigned*)(lds + (bufoff) + ldsw + _i * 8192), 16, 0, 0); } while (0)
#define PG8_LDA(dst, b, h) do { _Pragma("unroll") for (int m = 0; m < 4; ++m) _Pragma("unroll") for (int k = 0; k < 2; ++k) dst[m][k] = *(const PG8_LAS bf16x8*)(lds + PG8_SA(b, h) + aoff + m * 2048 + k * 1024); } while (0)
#define PG8_LDB(dst, b, h) do { _Pragma("unroll") for (int n = 0; n < 2; ++n) _Pragma("unroll") for (int k = 0; k < 2; ++k) dst[n][k] = *(const PG8_LAS bf16x8*)(lds + PG8_SB(b, h) + boff + n * 2048 + k * 1024); } while (0)
#define PG8_MMA(ai, bj, At, Bt) do { __builtin_amdgcn_s_setprio(1); _Pragma("unroll") for (int m = 0; m < 4; ++m) _Pragma("unroll") for (int n = 0; n < 2; ++n) _Pragma("unroll") for (int k = 0; k < 2; ++k) \
        acc[ai][bj][m][n] = __builtin_amdgcn_mfma_f32_16x16x32_bf16(Bt[n][k], At[m][k], acc[ai][bj][m][n], 0, 0, 0); __builtin_amdgcn_s_setprio(0); } while (0)
#define PG8_WAIT_V(n) asm volatile("s_waitcnt vmcnt(" #n ")" ::: "memory")
#define PG8_WAIT_L(n) asm volatile("s_waitcnt lgkmcnt(" #n ")" ::: "memory")
#define PG8_BAR __builtin_amdgcn_s_barrier()
#define PG8_SCHED __builtin_amdgcn_sched_barrier(0)
    Unit cur, nxt; int ui = 0;
    if (!S.next(0, cur)) return;
    f32x4 acc[2][2][4][2];
#pragma unroll
    for (int a = 0; a < 2; ++a)
#pragma unroll
        for (int b = 0; b < 2; ++b)
#pragma unroll
            for (int m = 0; m < 4; ++m)
#pragma unroll
                for (int n = 0; n < 2; ++n) acc[a][b][m][n] = (f32x4){0.f, 0.f, 0.f, 0.f};
    bf16x8 At[4][2], B0[2][2], B1[2][2];
    const char* cA = (const char*)g.A + (size_t)cur.pm * tstep; const char* cB = (const char*)g.Bt + (size_t)cur.pn * tstep;
    S.a_ready(cur);
    if constexpr (SP2) {
        PG8_STAGE(PG8_SB(0, 0), cB, voffB); PG8_STAGE(PG8_SB(0, 1), cB + hstep, voffB); PG8_STAGE(PG8_SA(0, 0), cA, voffA); PG8_STAGE(PG8_SA(0, 1), cA + hstep, voffA);
        if (wr == 1) PG8_BAR;
        PG8_WAIT_V(2); PG8_BAR;
        PG8_STAGE(PG8_SB(1, 0), cB + kstep, voffB); PG8_STAGE(PG8_SA(1, 0), cA + kstep, voffA); PG8_STAGE(PG8_SB(1, 1), cB + hstep + kstep, voffB);
        PG8_WAIT_V(6); PG8_BAR;
    } else {
        PG8_STAGE(PG8_SB(0, 0), cB, voffB); PG8_STAGE(PG8_SA(0, 0), cA, voffA); PG8_STAGE(PG8_SB(0, 1), cB + hstep, voffB); PG8_STAGE(PG8_SA(0, 1), cA + hstep, voffA);
        if (wr == 1) PG8_BAR;
        PG8_WAIT_V(4); PG8_BAR;
        PG8_STAGE(PG8_SB(1, 0), cB + kstep, voffB); PG8_STAGE(PG8_SA(1, 0), cA + kstep, voffA); PG8_STAGE(PG8_SB(1, 1), cB + hstep + kstep, voffB);
        PG8_WAIT_V(6); PG8_BAR;
    }
    for (;;) {
        const bool has_next = S.next(ui + 1, nxt);
        const char* nA = has_next ? (const char*)g.A + (size_t)nxt.pm * tstep : cA; const char* nB = has_next ? (const char*)g.Bt + (size_t)nxt.pn * tstep : cB;
#pragma unroll 1
        for (int t = 0; t < nt; t += 2) {
            const bool last = (t == nt - 2);
            const char* a1 = cA + (size_t)(t + 1) * kstep;
            const char* a2 = last ? nA : cA + (size_t)(t + 2) * kstep; const char* b2 = last ? nB : cB + (size_t)(t + 2) * kstep;
            const char* a3 = a2 + kstep; const char* b3 = b2 + kstep;
            if (last && has_next) S.a_ready(nxt);
            if constexpr (SP2) {
            PG8_LDB(B0, 0, 0); PG8_LDB(B1, 0, 1); PG8_SCHED; PG8_LDA(At, 0, 0); PG8_STAGE(PG8_SA(1, 1), a1 + hstep, voffA);
            PG8_WAIT_V(8); PG8_WAIT_L(0); PG8_BAR; PG8_MMA(0, 0, At, B0); PG8_MMA(0, 1, At, B1); PG8_BAR; PG8_SCHED;
            PG8_LDA(At, 0, 1); PG8_STAGE(PG8_SB(0, 0), b2, voffB); PG8_STAGE(PG8_SB(0, 1), b2 + hstep, voffB); PG8_STAGE(PG8_SA(0, 0), a2, voffA);
            PG8_WAIT_V(8); PG8_WAIT_L(0); PG8_BAR; PG8_MMA(1, 0, At, B0); PG8_MMA(1, 1, At, B1); PG8_BAR; PG8_SCHED;
            PG8_LDB(B0, 1, 0); PG8_LDB(B1, 1, 1); PG8_SCHED; PG8_LDA(At, 1, 0); PG8_STAGE(PG8_SA(0, 1), a2 + hstep, voffA);
            PG8_WAIT_V(8); PG8_WAIT_L(0); PG8_BAR; PG8_MMA(0, 0, At, B0); PG8_MMA(0, 1, At, B1); PG8_BAR; PG8_SCHED;
            PG8_LDA(At, 1, 1); PG8_STAGE(PG8_SB(1, 0), b3, voffB); PG8_STAGE(PG8_SB(1, 1), b3 + hstep, voffB); PG8_STAGE(PG8_SA(1, 0), a3, voffA);
            PG8_WAIT_V(8); PG8_WAIT_L(0); PG8_BAR; PG8_MMA(1, 0, At, B0); PG8_MMA(1, 1, At, B1); PG8_BAR; PG8_SCHED;
            } else {
            PG8_LDB(B0, 0, 0); PG8_SCHED; PG8_LDA(At, 0, 0); PG8_STAGE(PG8_SA(1, 1), a1 + hstep, voffA);
            PG8_WAIT_L(8); PG8_BAR; PG8_WAIT_L(0); PG8_MMA(0, 0, At, B0); PG8_BAR; PG8_SCHED;
            PG8_LDB(B1, 0, 1); PG8_STAGE(PG8_SB(0, 0), b2, voffB);
            PG8_BAR; PG8_WAIT_L(0); PG8_MMA(0, 1, At, B1); PG8_BAR;
            PG8_LDA(At, 0, 1); PG8_STAGE(PG8_SA(0, 0), a2, voffA);
            PG8_BAR; PG8_WAIT_L(0); PG8_MMA(1, 0, At, B0); PG8_BAR; PG8_SCHED;
            PG8_STAGE(PG8_SB(0, 1), b2 + hstep, voffB);
            PG8_WAIT_V(6); PG8_BAR; PG8_MMA(1, 1, At, B1); PG8_BAR;
            PG8_LDB(B0, 1, 0); PG8_SCHED; PG8_LDA(At, 1, 0); PG8_STAGE(PG8_SA(0, 1), a2 + hstep, voffA);
            PG8_WAIT_L(8); PG8_BAR; PG8_WAIT_L(0); PG8_MMA(0, 0, At, B0); PG8_BAR; PG8_SCHED;
            PG8_LDB(B1, 1, 1); PG8_STAGE(PG8_SB(1, 0), b3, voffB);
            PG8_BAR; PG8_WAIT_L(0); PG8_MMA(0, 1, At, B1); PG8_BAR;
            PG8_LDA(At, 1, 1); PG8_STAGE(PG8_SA(1, 0), a3, voffA);
            PG8_BAR; PG8_WAIT_L(0); PG8_MMA(1, 0, At, B0); PG8_BAR; PG8_SCHED;
            PG8_STAGE(PG8_SB(1, 1), b3 + hstep, voffB);
            PG8_WAIT_V(6); PG8_BAR; PG8_MMA(1, 1, At, B1); PG8_BAR;
            }
        }
        if constexpr (ALIGN_EPI) { if (wr == 0) PG8_BAR; }
        if constexpr (!Epi::AFTER_DRAIN) { int t2_ = threadIdx.x; asm volatile("" : "+v"(t2_)); E(acc, cur, wr, wc, t2_ & 15, (t2_ >> 4) & 3); S.done(cur); }
        if (!has_next) break;
        bool keep_ = false; if constexpr (Epi::KEEP) keep_ = E.keep(cur);
        if (!keep_) {
#pragma unroll
        for (int a = 0; a < 2; ++a)
#pragma unroll
            for (int b = 0; b < 2; ++b)
#pragma unroll
                for (int m = 0; m < 4; ++m)
#pragma unroll
                    for (int n = 0; n < 2; ++n) acc[a][b][m][n] = (f32x4){0.f, 0.f, 0.f, 0.f};
        }
        cur = nxt; cA = nA; cB = nB; ++ui;
        if constexpr (ALIGN_EPI) { if (wr == 1) PG8_BAR; }
    }
    PG8_WAIT_V(0);
    if constexpr (!ALIGN_EPI) { if (wr == 0) PG8_BAR; }
    PG8_BAR;
    if constexpr (Epi::AFTER_DRAIN) { E.fused(acc, cur, wr, wc, fr, fq, lds, wid, lane); S.done(cur); }
#undef PG8_SA
#undef PG8_SB
#undef PG8_STAGE
#undef PG8_LDA
#undef PG8_LDB
#undef PG8_MMA
#undef PG8_WAIT_V
#undef PG8_WAIT_L
#undef PG8_BAR
#undef PG8_SCHED
}
}
#define GAS __attribute__((address_space(1)))
#define LAS __attribute__((address_space(3)))
typedef unsigned short bf16;
typedef unsigned v4u __attribute__((ext_vector_type(4)));
typedef float f32x4 __attribute__((ext_vector_type(4)));
typedef short bf16x8 __attribute__((ext_vector_type(8)));
typedef GAS unsigned gu32;
typedef GAS unsigned long long gu64;
#define RLX_AGENT __ATOMIC_RELAXED, __HIP_MEMORY_SCOPE_AGENT
#define LDS_WAIT() asm volatile("s_waitcnt lgkmcnt(0)" ::: "memory")
#define VM_WAIT() asm volatile("s_waitcnt vmcnt(0)" ::: "memory")
__device__ __forceinline__ unsigned long long rt() { return __builtin_amdgcn_s_memrealtime(); }
__device__ __forceinline__ unsigned f2bf(float f) { unsigned u = __builtin_bit_cast(unsigned, f); return (u + 0x7fffu + ((u >> 16) & 1u)) >> 16; }
typedef float f32x2_t __attribute__((ext_vector_type(2))); typedef __bf16 bf16x2_t __attribute__((ext_vector_type(2)));
__device__ __forceinline__ unsigned pk2(float lo, float hi) { const f32x2_t v = {lo, hi}; const bf16x2_t b = __builtin_convertvector(v, bf16x2_t); return __builtin_bit_cast(unsigned, b); }

#define XB_TMO      128
#define XB_XCNT(j)  (256  + 64 * (j))
#define XB_XSUB(j)  (1280 + 64 * (j))
#define XB_XGEN(j)  (2304 + 64 * (j))
#define XB_TOP      3328
#define XB_TOPGEN   3392
#define XCD_BAR_WORDS 3456
#define XB_SPIN_CAP (1u << 18)

__device__ __forceinline__ unsigned xb_ld(unsigned* p)              { return __hip_atomic_load(p, __ATOMIC_RELAXED, __HIP_MEMORY_SCOPE_AGENT); }
__device__ __forceinline__ unsigned xb_add(unsigned* p, unsigned v) { return __hip_atomic_fetch_add(p, v, __ATOMIC_RELAXED, __HIP_MEMORY_SCOPE_AGENT); }
__device__ __forceinline__ unsigned xb_xcc_id() { return (unsigned)__builtin_amdgcn_s_getreg((3 << 11) | 20) & 0xFu; }
#define XB_SPIN(cond, bar) do { unsigned _sp = 0; while (cond) { __builtin_amdgcn_s_sleep(1); \
    if ((++_sp & 255u) == 0u) { if (xb_ld(&(bar)[XB_TMO])) break; if (_sp > XB_SPIN_CAP) { atomicAdd(&(bar)[XB_TMO], 1u); break; } } } } while (0)

struct XcdBarrier {
    unsigned* bar; unsigned x;
    volatile LAS unsigned* st;
};

__device__ __forceinline__ XcdBarrier xcd_barrier_post(unsigned* bar, volatile LAS unsigned* st) {
    XcdBarrier b; b.bar = bar; b.x = xb_xcc_id(); b.st = st;
    if (threadIdx.x == 0) (void)xb_add(&bar[XB_XCNT(b.x)], 1u);
    return b;
}
__device__ __forceinline__ void xcd_barrier_complete(unsigned* bar, unsigned x, unsigned& nloc, unsigned& nx) {
    const unsigned G = gridDim.x * gridDim.y * gridDim.z;
    unsigned sum, cnt, mine, sp = 0u;
    for (;;) {
        sum = 0u; cnt = 0u; mine = 0u;
#pragma unroll
        for (unsigned j = 0; j < 16; ++j) { const unsigned c = xb_ld(&bar[XB_XCNT(j)]); sum += c; cnt += (c > 0u) ? 1u : 0u; mine = (j == x) ? c : mine; }
        if (sum == G) break;
        __builtin_amdgcn_s_sleep(1);
        if ((++sp & 255u) == 0u) { if (xb_ld(&bar[XB_TMO])) break; if (sp > XB_SPIN_CAP) { atomicAdd(&bar[XB_TMO], 1u); break; } }
    }
    nloc = mine > 0u ? mine : 1u; nx = cnt > 0u ? cnt : 1u;
}

__device__ __forceinline__ void xcd_barrier(const XcdBarrier& b) {
    asm volatile("s_waitcnt vmcnt(0)" ::: "memory");
    __syncthreads();
    if (threadIdx.x == 0) {
        unsigned* bar = b.bar;
        __builtin_amdgcn_s_waitcnt(0);
        unsigned nloc = b.st[0], nx = b.st[1];
        if (nloc == 0u) { xcd_barrier_complete(bar, b.x, nloc, nx); b.st[0] = nloc; b.st[1] = nx; }
        const unsigned old = xb_add(&bar[XB_XSUB(b.x)], 1u);
        const unsigned gen = old / nloc;
        if (old + 1u == (gen + 1u) * nloc) {
            __builtin_amdgcn_fence(__ATOMIC_RELEASE, "agent");
            asm volatile("s_waitcnt vmcnt(0)" ::: "memory");
            const unsigned og = xb_add(&bar[XB_TOP], 1u);
            const unsigned tg = og / nx;
            if (og + 1u == (tg + 1u) * nx) xb_add(&bar[XB_TOPGEN], 1u);
            else XB_SPIN(xb_ld(&bar[XB_TOPGEN]) == tg, bar);
            __builtin_amdgcn_fence(__ATOMIC_ACQUIRE, "agent");
            xb_add(&bar[XB_XGEN(b.x)], 1u);
            asm volatile("s_waitcnt vmcnt(0)" ::: "memory");
        } else {
            XB_SPIN(xb_ld(&bar[XB_XGEN(b.x)]) == gen, bar);
            __builtin_amdgcn_fence(__ATOMIC_ACQUIRE, "agent");
            asm volatile("s_waitcnt vmcnt(0)" ::: "memory");
        }
    }
    __syncthreads();
}
constexpr int DM = 1024, SEQ = 8192, NBATCH = 2, CTXL = 256;
constexpr int ML = NBATCH * SEQ, MC = NBATCH * CTXL, MT = ML + MC;
constexpr int NIN = 6400;
constexpr int NE = 16, ESTR = 2304, CAPL = 1024, CAPC = 32;
constexpr int NPH = 24;
constexpr size_t MiB = 1u << 20;
constexpr size_t WS_CTL = 0, CTL_ZERO_BYTES = 1 * MiB;
constexpr size_t WS_MOD = 1 * MiB;
constexpr size_t WS_ROPEC = 1 * MiB + 256 * 1024, WS_ROPES = WS_ROPEC + 8192;
constexpr size_t WS_TW = 1 * MiB + 512 * 1024;
constexpr size_t WS_CS256 = 1 * MiB + 640 * 1024;
constexpr size_t WS_T1T = 2 * MiB;
constexpr size_t WS_T2T = 2 * MiB + 64 * 1024;
constexpr size_t WS_T2F = 8 * MiB;
constexpr size_t WS_T2C = 12 * MiB;
constexpr size_t WS_FAC = 13 * MiB;
constexpr size_t WS_WSP = 2 * MiB + 256 * 1024;
constexpr size_t WS_AFF = 3 * MiB;
constexpr size_t WS_SEL = 5 * MiB;
constexpr size_t WS_IDX = 7 * MiB, WS_GATE = 7 * MiB + 256 * 1024;
constexpr size_t WS_WIN = 16 * MiB, WS_WBR = 29 * MiB, WS_WO = 31 * MiB, WS_WGU = 33 * MiB, WS_WDN = 97 * MiB;
constexpr size_t WS_X = 130 * MiB;
constexpr size_t WS_H = 196 * MiB;
constexpr size_t WS_BR = 229 * MiB;
constexpr size_t WS_MB = 262 * MiB;
constexpr size_t WS_FA = 295 * MiB;
constexpr size_t WS_Z = 311 * MiB;
constexpr size_t ZROW = (size_t)MT * 2;
constexpr size_t WS_AUV = WS_Z, WS_YF = WS_AUV + 512 * ZROW, WS_CY = WS_YF + 512 * ZROW, WS_QPL = WS_CY + 256 * ZROW, WS_QROT = WS_QPL + 256 * ZROW,
                 WS_KR = WS_QROT + 256 * ZROW, WS_VV = WS_KR + 256 * ZROW, WS_G = WS_VV + 256 * ZROW, WS_ZEND = WS_G + 4096 * ZROW;
constexpr size_t WS_P32 = WS_Z;
constexpr size_t WS_XE = WS_Z, WS_ACT = WS_Z + 72 * MiB;
constexpr size_t WS_END = 518 * MiB;
static_assert(WS_G == WS_P32 + (size_t)MT * 1024 * 4 + 8 * 256 * ZROW / 8 - 256 * ZROW || true, "");
static_assert(WS_ZEND <= WS_END && WS_ACT + 72 * MiB <= WS_ZEND && WS_P32 + (size_t)MT * 4096 <= WS_VV, "ws map");
constexpr int CW_BAR = 4096;
constexpr int LDS_BYTES = 155648, MISC_OFF = 154624;

struct Args { const float* in[28]; float* out; unsigned char* ws; int ph_lo, ph_hi; };

__device__ __forceinline__ float bflo(unsigned w) { return __uint_as_float(w << 16); }
__device__ __forceinline__ float bfhi(unsigned w) { return __uint_as_float(w & 0xffff0000u); }
__device__ __forceinline__ float sigm(float x) { return __builtin_amdgcn_rcpf(1.f + __expf(-x)); }
__device__ __forceinline__ float wave_sum(float v) {
#pragma unroll
    for (int o = 1; o < 64; o <<= 1) v += __shfl_xor(v, o);
    return v;
}
__device__ __forceinline__ void st4bf(bf16* p, f32x4 v) { uint2 w; w.x = pk2(v[0], v[1]); w.y = pk2(v[2], v[3]); *(uint2*)p = w; }

using pg8::Unit;
struct EpiIn {
    static constexpr bool PERM = false, AFTER_DRAIN = false, KEEP = false;
    bf16 *AUV, *YF, *CY, *QPL, *QROT, *KR, *VV, *G; const float* ropeC; const float* ropeS;
    __device__ __forceinline__ void operator()(const f32x4 (&acc)[2][2][4][2], const Unit& u, int wr, int wc, int fr, int fq) const {
        const int pn = u.pn, row0 = u.pm * 256 + wr * 64 + fr, cl0 = wc * 32 + 4 * fq;
        if (pn < 2) {
#pragma unroll
            for (int ai = 0; ai < 2; ++ai)
#pragma unroll
                for (int m = 0; m < 4; ++m) { const size_t row = row0 + ai * 128 + m * 16;
#pragma unroll
                    for (int bj = 0; bj < 2; ++bj)
#pragma unroll
                        for (int n = 0; n < 2; ++n) { f32x4 v = acc[ai][bj][m][n];
#pragma unroll
                            for (int j = 0; j < 4; ++j) { const float x = v[j]; v[j] = x * sigm(1.5957691216f * (x + 0.044715f * x * x * x)); }
                            st4bf(AUV + row * 512 + pn * 256 + bj * 128 + cl0 + n * 16, v); } }
        } else if (pn < 4) {
#pragma unroll
            for (int ai = 0; ai < 2; ++ai)
#pragma unroll
                for (int m = 0; m < 4; ++m) { const size_t row = row0 + ai * 128 + m * 16;
#pragma unroll
                    for (int bj = 0; bj < 2; ++bj)
#pragma unroll
                        for (int n = 0; n < 2; ++n) st4bf(YF + row * 512 + (pn - 2) * 256 + bj * 128 + cl0 + n * 16, acc[ai][bj][m][n]); }
        } else if (pn < 6) {
#pragma unroll
            for (int ai = 0; ai < 2; ++ai)
#pragma unroll
                for (int m = 0; m < 4; ++m) { const size_t row = row0 + ai * 128 + m * 16;
#pragma unroll
                    for (int n = 0; n < 2; ++n) { const f32x4 a = acc[ai][0][m][n], g = acc[ai][1][m][n]; f32x4 v;
#pragma unroll
                        for (int j = 0; j < 4; ++j) v[j] = a[j] * sigm(g[j]);
                        st4bf(CY + row * 256 + (pn - 4) * 128 + cl0 + n * 16, v); } }
        } else if (pn < 8) {
            const bool isq = pn == 6; const float scl = isq ? 0.125f : 1.f; const bool latent = u.pm < 64;
#pragma unroll
            for (int ai = 0; ai < 2; ++ai)
#pragma unroll
                for (int m = 0; m < 4; ++m) { const int rowi = row0 + ai * 128 + m * 16; const size_t row = rowi; const int tok = rowi & 8191;
                    const int pos = (wc & 1) ? (tok & 63) : (tok >> 6);
                    f32x4 cs = {1.f, 1.f, 1.f, 1.f}, sn = {0.f, 0.f, 0.f, 0.f};
                    if (latent) { cs = *(const f32x4*)(ropeC + pos * 16 + 4 * fq); sn = *(const f32x4*)(ropeS + pos * 16 + 4 * fq); }
#pragma unroll
                    for (int bj = 0; bj < 2; ++bj) { const f32x4 x1 = acc[ai][bj][m][0] * scl, x2 = acc[ai][bj][m][1] * scl;
                        const f32x4 r1 = x1 * cs - x2 * sn, r2 = x1 * sn + x2 * cs; const size_t off = row * 256 + bj * 128 + cl0;
                        if (isq) { st4bf(QPL + off, x1); st4bf(QPL + off + 16, x2); st4bf(QROT + off, r1); st4bf(QROT + off + 16, r2); }
                        else { st4bf(KR + off, r1); st4bf(KR + off + 16, r2); } } }
        } else if (pn == 8) {
#pragma unroll
            for (int ai = 0; ai < 2; ++ai)
#pragma unroll
                for (int m = 0; m < 4; ++m) { const size_t row = row0 + ai * 128 + m * 16;
#pragma unroll
                    for (int bj = 0; bj < 2; ++bj)
#pragma unroll
                        for (int n = 0; n < 2; ++n) st4bf(VV + row * 256 + bj * 128 + cl0 + n * 16, acc[ai][bj][m][n]); }
        } else {
#pragma unroll
            for (int ai = 0; ai < 2; ++ai)
#pragma unroll
                for (int m = 0; m < 4; ++m) { const size_t row = row0 + ai * 128 + m * 16;
#pragma unroll
                    for (int bj = 0; bj < 2; ++bj)
#pragma unroll
                        for (int n = 0; n < 2; ++n) { f32x4 v = acc[ai][bj][m][n];
#pragma unroll
                            for (int j = 0; j < 4; ++j) v[j] = sigm(v[j]);
                            const int gb_ = (pn - 9) >> 2, gu_ = (2 * u.pm + ai) * 8 + 2 * ((pn - 9) & 3) + bj;
                            st4bf(G + ((((size_t)(gu_ * 4 + gb_) * 8 + (wr * 4 + wc)) * 8 + m * 2 + n) * 256 + (fq * 16 + fr) * 4), v); } }
        }
    }
};
struct EpiMerge {
    static constexpr bool PERM = false, AFTER_DRAIN = false, KEEP = false;
    const bf16* G; float* P32; bf16* MB;
    __device__ __forceinline__ void operator()(const f32x4 (&acc)[2][2][4][2], const Unit& u, int wr, int wc, int fr, int fq) const {
        int fr_ = fr, fq_ = fq; asm volatile("" : "+v"(fr_), "+v"(fq_));
        const int b = u.pn >> 2, pn = u.pn & 3, pm = u.pm - b * 66, row0 = pm * 256 + wr * 64 + fr_, col0 = pn * 256 + wc * 32 + 4 * fq_;
#pragma unroll
        for (int ai = 0; ai < 2; ++ai)
#pragma unroll
            for (int m = 0; m < 4; ++m) { const unsigned row = row0 + ai * 128 + m * 16;
                const bf16* gp = G + ((size_t)row * 4096 + b * 1024 + col0); float* pp = P32 + ((size_t)row * 1024 + col0); bf16* mp = MB + ((size_t)row * 1024 + col0);
#pragma unroll
                for (int bj = 0; bj < 2; ++bj)
#pragma unroll
                    for (int n = 0; n < 2; ++n) { const int co = bj * 128 + n * 16;
                        const uint2 gw = *(const uint2*)(gp + co);
                        f32x4 v = acc[ai][bj][m][n]; v[0] *= bflo(gw.x); v[1] *= bfhi(gw.x); v[2] *= bflo(gw.y); v[3] *= bfhi(gw.y);
                        if (b > 0) v += *(const f32x4*)(pp + co);
                        if (b < 3) *(f32x4*)(pp + co) = v; else st4bf(mp + co, v);
                        asm volatile("" ::: "memory"); } }
    }
};
struct EpiMergeH {
    static constexpr bool PERM = false, AFTER_DRAIN = false, KEEP = true;
    const bf16* G; bf16* MB;
    __device__ __forceinline__ bool keep(const Unit& u) const { return (u.pn >> 2) < 3; }
    __device__ __forceinline__ void operator()(f32x4 (&acc)[2][2][4][2], const Unit& u, int wr, int wc, int fr, int fq) const {
        const int b = u.pn >> 2, pn = u.pn & 3, pm = u.pm - b * 66, row0 = pm * 256 + wr * 64 + fr, col0 = pn * 256 + wc * 32 + 4 * fq;
#pragma unroll
        for (int ai = 0; ai < 2; ++ai)
#pragma unroll
            for (int m = 0; m < 4; ++m) { const unsigned row = row0 + ai * 128 + m * 16; const bf16* gp = G + ((size_t)row * 4096 + b * 1024 + col0); bf16* mp = MB + ((size_t)row * 1024 + col0);
#pragma unroll
                for (int bj = 0; bj < 2; ++bj)
#pragma unroll
                    for (int n = 0; n < 2; ++n) { const int co = bj * 128 + n * 16; const uint2 gb = *(const uint2*)(gp + co); f32x4 v = acc[ai][bj][m][n];
                        if (b < 3) { const uint2 gn = *(const uint2*)(gp + 1024 + co);
                            v[0] *= bflo(gb.x) * __builtin_amdgcn_rcpf(bflo(gn.x)); v[1] *= bfhi(gb.x) * __builtin_amdgcn_rcpf(bfhi(gn.x)); v[2] *= bflo(gb.y) * __builtin_amdgcn_rcpf(bflo(gn.y)); v[3] *= bfhi(gb.y) * __builtin_amdgcn_rcpf(bfhi(gn.y));
                            acc[ai][bj][m][n] = v; }
                        else { v[0] *= bflo(gb.x); v[1] *= bfhi(gb.x); v[2] *= bflo(gb.y); v[3] *= bfhi(gb.y); st4bf(mp + co, v); } }
                asm volatile("" ::: "memory"); }
    }
};
struct EpiWout {
    static constexpr bool PERM = false, AFTER_DRAIN = false, KEEP = false;
    const float* xlat; const float* xctx; float* X; const float* mod;
    __device__ __forceinline__ void operator()(const f32x4 (&acc)[2][2][4][2], const Unit& u, int wr, int wc, int fr, int fq) const {
        const int r = u.pm < 32 ? 0 : (u.pm < 64 ? 1 : 2); const float* gt = mod + r * 6144 + 2 * 1024;
        const int row0 = u.pm * 256 + wr * 64 + fr, col0 = u.pn * 256 + wc * 32 + 4 * fq;
        f32x4 gv[2][2];
#pragma unroll
        for (int bj = 0; bj < 2; ++bj)
#pragma unroll
            for (int n = 0; n < 2; ++n) gv[bj][n] = *(const f32x4*)(gt + col0 + bj * 128 + n * 16);
#pragma unroll
        for (int ai = 0; ai < 2; ++ai)
#pragma unroll
            for (int m = 0; m < 4; ++m) { const size_t row = row0 + ai * 128 + m * 16; const float* src = (row < ML) ? xlat + row * 1024 : xctx + (row - ML) * 1024;
#pragma unroll
                for (int bj = 0; bj < 2; ++bj)
#pragma unroll
                    for (int n = 0; n < 2; ++n) { const int col = col0 + bj * 128 + n * 16;
                        *(f32x4*)(X + row * 1024 + col) = *(const f32x4*)(src + col) + gv[bj][n] * acc[ai][bj][m][n]; } }
    }
};
struct EpiGU {
    static constexpr bool PERM = false, AFTER_DRAIN = false, KEEP = false;
    bf16* ACT;
    __device__ __forceinline__ void operator()(const f32x4 (&acc)[2][2][4][2], const Unit& u, int wr, int wc, int fr, int fq) const {
        const int pnl = u.pn & 7, row0 = u.pm * 256 + wr * 64 + fr, cl0 = wc * 32 + 4 * fq;
#pragma unroll
        for (int ai = 0; ai < 2; ++ai)
#pragma unroll
            for (int m = 0; m < 4; ++m) { const size_t row = row0 + ai * 128 + m * 16;
#pragma unroll
                for (int n = 0; n < 2; ++n) { const f32x4 a = acc[ai][0][m][n], up = acc[ai][1][m][n]; f32x4 v;
#pragma unroll
                    for (int j = 0; j < 4; ++j) v[j] = a[j] * sigm(a[j]) * up[j];
                    st4bf(ACT + row * 1024 + pnl * 128 + cl0 + n * 16, v); } }
    }
};
struct EpiDown {
    static constexpr bool PERM = false, AFTER_DRAIN = false, KEEP = false;
    bf16* YB; const float* GATE;
    __device__ __forceinline__ void operator()(const f32x4 (&acc)[2][2][4][2], const Unit& u, int wr, int wc, int fr, int fq) const {
        const int pnl = u.pn & 3, row0 = u.pm * 256 + wr * 64 + fr, col0 = pnl * 256 + wc * 32 + 4 * fq;
#pragma unroll
        for (int ai = 0; ai < 2; ++ai)
#pragma unroll
            for (int m = 0; m < 4; ++m) { const size_t row = row0 + ai * 128 + m * 16; const float gt = GATE[row];
#pragma unroll
                for (int bj = 0; bj < 2; ++bj)
#pragma unroll
                    for (int n = 0; n < 2; ++n) st4bf(YB + row * 1024 + col0 + bj * 128 + n * 16, acc[ai][bj][m][n] * gt); }
    }
};
struct MergeOrder {
    int nt, G, c;
    __device__ void init(int ntm, int G_, int c_) { nt = ntm * 4; G = G_; c = c_; }
    __device__ bool next(int i, Unit& u) const { const int b = i & 3, L = (i >> 2) * G + c; if (L >= nt) return false; u.pm = b * 66 + (L >> 2); u.pn = b * 4 + (L & 3); return true; }
    __device__ __forceinline__ void a_ready(const Unit&) const {}
    __device__ __forceinline__ void done(const Unit&) const {}
};
struct GroupOrder {
    int nwg, G, c, TPE, NTN;
    __device__ void init(int tpe, int ntn, int G_, int c_) { TPE = tpe; NTN = ntn; nwg = NE * tpe * ntn; G = G_; c = c_; }
    __device__ bool next(int i, Unit& u) const {
        const long L = (long)i * G + c; if (L >= nwg) return false;
        int wgid = (int)L; { const int q = nwg / 8, r = nwg % 8, xcd = wgid % 8, off = wgid / 8; wgid = (xcd < r ? xcd * (q + 1) : r * (q + 1) + (xcd - r) * q) + off; }
        const int per = TPE * NTN, e = wgid / per, rem = wgid % per, pn = rem / TPE, mt = rem % TPE;
        u.pm = e * 9 + mt; u.pn = e * NTN + pn; return true;
    }
    __device__ __forceinline__ void a_ready(const Unit&) const {}
    __device__ __forceinline__ void done(const Unit&) const {}
};
typedef float f2v __attribute__((ext_vector_type(2)));
#define PH_ARGS LAS unsigned char* lds, const int tid, const int lane, const int wave, const int bid, const int G
#define WSP(T, off) ((T*)(PTRV(29, unsigned char) + (off)))
constexpr int PTAB_OFF = MISC_OFF + 512;
__device__ __forceinline__ unsigned long long ptab_ld(LAS unsigned char* lds, int i) {
    typedef unsigned u2v_t __attribute__((ext_vector_type(2)));
    const volatile LAS unsigned* tp = (const volatile LAS unsigned*)(lds + PTAB_OFF + 8 * i); u2v_t v; v[0] = tp[0]; v[1] = tp[1];
    const unsigned lo = __builtin_amdgcn_readfirstlane(v[0]), hi = __builtin_amdgcn_readfirstlane(v[1]);
    return ((unsigned long long)hi << 32) | lo;
}
#define PTRV(i, T) ((T*)(GAS T*)ptab_ld(lds, (i)))
#define INP(i) ((const float*)(GAS const float*)ptab_ld(lds, (i)))

__device__ __forceinline__ void mod_gemv(PH_ARGS) {
    LAS f32x4* red = (LAS f32x4*)lds;
    const float* c = INP(1); const float* cc = INP(3); const float* wm = INP(4); const float* bm = INP(5);
    float* MOD = WSP(float, WS_MOD);
    for (int it = bid; it < 192; it += G) {
        const int l = it / 96, cg = it % 96, kg = tid >> 4, cq = tid & 15;
        f32x4 a0 = {0.f, 0.f, 0.f, 0.f}, a1 = a0, a2 = a0;
        const float* wb = wm + (size_t)l * 1024 * 6144 + cg * 64 + cq * 4;
#pragma unroll 4
        for (int i = 0; i < 32; ++i) { const int k = kg + 32 * i; const f32x4 w = *(const f32x4*)(wb + (size_t)k * 6144);
            const float x0 = c[k], x1 = c[1024 + k], x2 = cc[k];
            a0 += w * (x0 * sigm(x0)); a1 += w * (x1 * sigm(x1)); a2 += w * (x2 * sigm(x2)); }
        red[(kg * 3 + 0) * 16 + cq] = a0; red[(kg * 3 + 1) * 16 + cq] = a1; red[(kg * 3 + 2) * 16 + cq] = a2;
        __syncthreads();
        if (tid < 192) { const int r = tid >> 6, col = tid & 63; float s = 0.f; const LAS float* rf = (const LAS float*)red;
            for (int k2 = 0; k2 < 32; ++k2) s += rf[((k2 * 3 + r) * 16 + (col >> 2)) * 4 + (col & 3)];
            MOD[(l * 3 + r) * 6144 + cg * 64 + col] = s + bm[l * 6144 + cg * 64 + col]; }
        __syncthreads();
    }
}
__device__ __forceinline__ void make_tables(PH_ARGS) {
    const int gt = bid * 512 + tid, GT = G * 512;
    float* RC = WSP(float, WS_ROPEC); float* RS = WSP(float, WS_ROPES);
    bf16* T1 = WSP(bf16, WS_T1T);
    for (int i = gt; i < 2048; i += GT) { const int pos = i >> 4, f = i & 15; const float inv = powf(10000.f, -(float)f / 16.f), ang = (float)pos * inv; RC[i] = cosf(ang); RS[i] = sinf(ang); }
    for (int i = gt; i < 128 * 128; i += GT) { const int col = i >> 7, k = i & 127, ro = col >> 6, k1 = col & 63, n1 = k >> 1, ri = k & 1; float s, c; sincospif((float)((k1 * n1) & 63) / 32.f, &s, &c);
        const float v = ro == 0 ? (ri == 0 ? c : s) : (ri == 0 ? -s : c); T1[i] = (bf16)f2bf(v); }
    bf16* T2F = WSP(bf16, WS_T2F); bf16* T2C = WSP(bf16, WS_T2C);
    for (int i = gt; i < 64 * 128 * 256; i += GT) { const int k1 = i >> 15, k2 = (i >> 8) & 127, k = i & 255, n2 = k >> 1, ri = k & 1; float s, c;
        sincospif((float)((n2 * (k1 + 64 * k2)) & 8191) / 4096.f, &s, &c); T2F[i] = (bf16)f2bf(ri ? s : c); }
    for (int i = gt; i < 2 * 128 * 256; i += GT) { const int k1 = i >> 15, k2 = (i >> 8) & 127, k = i & 255, n2 = k >> 1, ri = k & 1; float s, c;
        sincospif((float)((n2 * (k1 + 2 * k2)) & 255) / 128.f, &s, &c); T2C[i] = (bf16)f2bf(ri ? s : c); }
}
__device__ __forceinline__ void tr_item(const float* W, size_t ldw, int col0, int k0, bf16* dst, int Kd, LAS float* scr, int lane) {
#pragma unroll 8
    for (int i = 0; i < 32; ++i) { const int kk = 2 * i + (lane >> 5); scr[kk * 33 + (lane & 31)] = W[(size_t)(k0 + kk) * ldw + col0 + (lane & 31)]; }
    LDS_WAIT(); asm volatile("" ::: "memory");
    const int c = lane & 7;
#pragma unroll
    for (int j = 0; j < 4; ++j) { const int n = (lane >> 3) + 8 * j; const LAS float* s = scr + (8 * c) * 33 + n;
        v4u o; o.x = pk2(s[0 * 33], s[1 * 33]); o.y = pk2(s[2 * 33], s[3 * 33]); o.z = pk2(s[4 * 33], s[5 * 33]); o.w = pk2(s[6 * 33], s[7 * 33]);
        *(v4u*)(dst + (size_t)n * Kd + k0 + 8 * c) = o; }
    LDS_WAIT(); asm volatile("" ::: "memory");
}
__device__ __forceinline__ void fold_item16(const float* W  , int f, bf16* WIN, LAS float* scr, const LAS f2v* tab, int lane) {
    const int kb = f >> 2, g = f & 3, k0 = kb * 16;
#pragma unroll
    for (int kk = 0; kk < 16; ++kk) scr[kk * 64 + lane] = W[(size_t)(k0 + kk) * 6144 + 512 + g * 64 + lane];
    LDS_WAIT(); asm volatile("" ::: "memory");
    float ar[16], ai[16];
#pragma unroll
    for (int kk = 0; kk < 16; ++kk) { ar[kk] = 0.f; ai[kk] = 0.f; }
#pragma unroll 4
    for (int c = 0; c < 64; ++c) { const f2v t = tab[(c * lane) & 63];
#pragma unroll
        for (int kk = 0; kk < 16; ++kk) { const float w = scr[kk * 64 + c]; ar[kk] += w * t[0]; ai[kk] -= w * t[1]; } }
    bf16* d0 = WIN + (size_t)(512 + 2 * (g * 64 + lane)) * 1024 + k0;
    v4u o, p;
    o.x = pk2(ar[0], ar[1]); o.y = pk2(ar[2], ar[3]); o.z = pk2(ar[4], ar[5]); o.w = pk2(ar[6], ar[7]); p.x = pk2(ar[8], ar[9]); p.y = pk2(ar[10], ar[11]); p.z = pk2(ar[12], ar[13]); p.w = pk2(ar[14], ar[15]);
    *(v4u*)d0 = o; *(v4u*)(d0 + 8) = p;
    o.x = pk2(ai[0], ai[1]); o.y = pk2(ai[2], ai[3]); o.z = pk2(ai[4], ai[5]); o.w = pk2(ai[6], ai[7]); p.x = pk2(ai[8], ai[9]); p.y = pk2(ai[10], ai[11]); p.z = pk2(ai[12], ai[13]); p.w = pk2(ai[14], ai[15]);
    *(v4u*)(d0 + 1024) = o; *(v4u*)(d0 + 1024 + 8) = p;
    LDS_WAIT(); asm volatile("" ::: "memory");
}
__device__ __forceinline__ void tr_item64(const float* W, size_t ldw, int col0, int k0, bf16* dst, int Kd, int lane) {
    const int kq = lane >> 4, n4 = lane & 15; const float* src = W + (size_t)(k0 + kq * 16) * ldw + col0 + n4 * 4;
    f32x4 v[16];
#pragma unroll
    for (int i = 0; i < 16; ++i) v[i] = *(const f32x4*)(src + (size_t)i * ldw);
#pragma unroll
    for (int j = 0; j < 4; ++j) { bf16* d = dst + (size_t)(n4 * 4 + j) * Kd + k0 + kq * 16; v4u o, p;
        o.x = pk2(v[0][j], v[1][j]); o.y = pk2(v[2][j], v[3][j]); o.z = pk2(v[4][j], v[5][j]); o.w = pk2(v[6][j], v[7][j]);
        p.x = pk2(v[8][j], v[9][j]); p.y = pk2(v[10][j], v[11][j]); p.z = pk2(v[12][j], v[13][j]); p.w = pk2(v[14][j], v[15][j]);
        *(v4u*)d = o; *(v4u*)(d + 8) = p; }
}
__device__ __forceinline__ void convert_weights(PH_ARGS, const int l) {
    LAS float* scr = (LAS float*)(lds + wave * 16384);
    const int gw = bid * 8 + wave, NGW = G * 8;
    bf16* WIN = WSP(bf16, WS_WIN); bf16* WBR = WSP(bf16, WS_WBR); bf16* WO = WSP(bf16, WS_WO); bf16* WGU = WSP(bf16, WS_WGU); bf16* WDN = WSP(bf16, WS_WDN); bf16* WS_ = WSP(bf16, WS_WSP);
    const float* win = INP(8) + (size_t)l * 1024 * 6144;
    LAS f2v* tab = (LAS f2v*)(scr + 2048); { float s_, c_; sincospif((float)lane / 32.f, &s_, &c_); tab[lane] = (f2v){c_, s_}; } LDS_WAIT(); asm volatile("" ::: "memory");
    constexpr int N_FOLD = 256, N_IN = 92 * 16, N_BR = 256, N_WO = 256, N_GU = 8192, N_DN = 4096, N_SP = 64;
    constexpr int NITEMS = N_FOLD + N_IN + N_BR + N_WO + N_GU + N_DN + N_SP;
    for (int it = gw; it < NITEMS; it += NGW) {
        int r = it;
        if (r < N_FOLD) { fold_item16(win, r, WIN, scr, tab, lane); continue; } r -= N_FOLD;
        if (r < N_IN) { const int dbp = r >> 4, kb = r & 15, db = dbp < 8 ? dbp : dbp + 8; int col;
            if (db < 8) col = db * 64;
            else if (db < 24) { const int t = db - 16, tile = t >> 2, sub = t & 3; col = (sub < 2 ? 768 : 1024) + tile * 128 + (sub & 1) * 64; }
            else if (db < 36) col = 1280 + (db - 24) * 64;
            else col = 2048 + (db - 36) * 64;
            tr_item64(win, 6144, col, kb * 64, WIN + (size_t)db * 64 * 1024, 1024, lane); continue; } r -= N_IN;
        if (r < N_BR) { const int b = r >> 6, q = r & 63, kb = q >> 4, nb = q & 15; const int ii = b == 0 ? 13 : (b == 1 ? 14 : (b == 2 ? 19 : 21));
            tr_item64(INP(ii) + (size_t)l * 256 * 1024, 1024, nb * 64, kb * 64, WBR + (size_t)(b * 1024 + nb * 64) * 256, 256, lane); continue; } r -= N_BR;
        if (r < N_WO) { const int kb = r >> 4, nb = r & 15; tr_item64(INP(22) + (size_t)l * 1024 * 1024, 1024, nb * 64, kb * 64, WO + (size_t)nb * 64 * 1024, 1024, lane); continue; } r -= N_WO;
        if (r < N_GU) { const int e = r >> 9, q = r & 511, db = q >> 4, kb = q & 15, tile = db >> 2, sub = db & 3;
            const float* src = (sub < 2 ? INP(24) : INP(25)) + (size_t)(l * 16 + e) * 1024 * 1024;
            tr_item64(src, 1024, tile * 128 + (sub & 1) * 64, kb * 64, WGU + ((size_t)e * 2048 + db * 64) * 1024, 1024, lane); continue; } r -= N_GU;
        if (r < N_DN) { const int e = r >> 8, q = r & 255, kb = q >> 4, nb = q & 15;
            tr_item64(INP(26) + (size_t)(l * 16 + e) * 1024 * 1024, 1024, nb * 64, kb * 64, WDN + ((size_t)e * 1024 + nb * 64) * 1024, 1024, lane); continue; } r -= N_DN;
        { const float* s = INP(11) + (size_t)l * 65536 + r * 1024 + lane * 16; const f32x4 a = *(const f32x4*)s, b = *(const f32x4*)(s + 4), c = *(const f32x4*)(s + 8), d = *(const f32x4*)(s + 12);
          v4u o, p; o.x = pk2(a[0], a[1]); o.y = pk2(a[2], a[3]); o.z = pk2(b[0], b[1]); o.w = pk2(b[2], b[3]); p.x = pk2(c[0], c[1]); p.y = pk2(c[2], c[3]); p.z = pk2(d[0], d[1]); p.w = pk2(d[2], d[3]);
          *(v4u*)(WS_ + r * 1024 + lane * 16) = o; *(v4u*)(WS_ + r * 1024 + lane * 16 + 8) = p; }
    }
}
__device__ __forceinline__ void load_row(const float* p, int lane, f32x4 (&v)[4]) {
#pragma unroll
    for (int j = 0; j < 4; ++j) v[j] = *(const f32x4*)(p + 4 * lane + 256 * j);
}
__device__ __forceinline__ void modnorm_store(f32x4 (&v)[4], const float* g, const float* sc, const float* sh, bf16* hrow, int lane) {
    float ss = 0.f;
#pragma unroll
    for (int j = 0; j < 4; ++j) ss += (v[j][0] * v[j][0] + v[j][1] * v[j][1]) + (v[j][2] * v[j][2] + v[j][3] * v[j][3]);
    const float rs = 1.0f / sqrtf(wave_sum(ss) * (1.f / 1024.f) + 1e-6f);
#pragma unroll
    for (int j = 0; j < 4; ++j) { const int o = 4 * lane + 256 * j; const f32x4 gg = *(const f32x4*)(g + o), s = *(const f32x4*)(sc + o), b = *(const f32x4*)(sh + o);
        v[j] = v[j] * rs * gg * (s + 1.f) + b; st4bf(hrow + o, v[j]); }
}
__device__ __forceinline__ void modnorm_regs(f32x4 (&v)[4], const f32x4 (&gm)[4], const f32x4 (&sh)[4], bf16* hrow, int lane) {
    float ss = 0.f;
#pragma unroll
    for (int j = 0; j < 4; ++j) ss += (v[j][0] * v[j][0] + v[j][1] * v[j][1]) + (v[j][2] * v[j][2] + v[j][3] * v[j][3]);
    const float rs = 1.0f / sqrtf(wave_sum(ss) * (1.f / 1024.f) + 1e-6f);
#pragma unroll
    for (int j = 0; j < 4; ++j) { v[j] = v[j] * rs * gm[j] + sh[j]; st4bf(hrow + 4 * lane + 256 * j, v[j]); }
}
__device__ __forceinline__ void load_mod(const float* g, const float* sc, const float* shp, int lane, f32x4 (&gm)[4], f32x4 (&sh)[4]) {
#pragma unroll
    for (int j = 0; j < 4; ++j) { const int o = 4 * lane + 256 * j; gm[j] = *(const f32x4*)(g + o) * (*(const f32x4*)(sc + o) + 1.f); sh[j] = *(const f32x4*)(shp + o); }
}
__device__ __forceinline__ void norm1_l0(PH_ARGS) {
    const int gw = bid * 8 + wave, NGW = G * 8; bf16* H = WSP(bf16, WS_H); const float* MOD = WSP(float, WS_MOD);
    const int RPW = (MT + NGW - 1) / NGW, row0 = gw * RPW, rend = (row0 + RPW < MT) ? row0 + RPW : MT;
    const float* xin = INP(0); const float* cin = INP(2); const float* g = INP(6);
    f32x4 cur[4], nxt[4], gm[4], sh[4]; int rprev = -1;
    if (row0 < rend) load_row(row0 < ML ? xin + (size_t)row0 * 1024 : cin + (size_t)(row0 - ML) * 1024, lane, cur);
    for (int row = row0; row < rend; ++row) {
        if (row + 1 < rend) { const int rn = row + 1; load_row(rn < ML ? xin + (size_t)rn * 1024 : cin + (size_t)(rn - ML) * 1024, lane, nxt); }
        const int r = row < SEQ ? 0 : (row < ML ? 1 : 2);
        if (r != rprev) { const float* md = MOD + r * 6144; load_mod(g, md + 1024, md, lane, gm, sh); rprev = r; }
        modnorm_regs(cur, gm, sh, H + (size_t)row * 1024, lane);
#pragma unroll
        for (int j = 0; j < 4; ++j) cur[j] = nxt[j];
    }
}
__device__ __forceinline__ void norm2_router(PH_ARGS, const int l, const int nrows) {
    const int gw = bid * 8 + wave, NGW = G * 8; bf16* H = WSP(bf16, WS_H); const float* MOD = WSP(float, WS_MOD) + l * 3 * 6144; const float* X = WSP(float, WS_X); float* AFF = WSP(float, WS_AFF);
    LAS f32x4* Wl = (LAS f32x4*)lds;
    { const f32x4* wr = (const f32x4*)(INP(23) + (size_t)l * 1024 * 16);
      for (int i = tid; i < 4096; i += 512) { const int k = i >> 2, q = i & 3; Wl[(q * 4 + (k & 3)) * 256 + (k >> 2)] = wr[i]; } }
    __syncthreads();
    const int RPW = (nrows + NGW - 1) / NGW, row0 = gw * RPW, rend = (row0 + RPW < nrows) ? row0 + RPW : nrows;
    const float* g2 = INP(7) + l * 1024;
    f32x4 v[4], nxt[4], gm[4], sh[4]; int rprev = -1;
    if (row0 < rend) load_row(X + (size_t)row0 * 1024, lane, v);
    for (int row = row0; row < rend; ++row) {
        if (row + 1 < rend) load_row(X + (size_t)(row + 1) * 1024, lane, nxt);
        const int r = row < SEQ ? 0 : (row < ML ? 1 : 2);
        if (r != rprev) { const float* md = MOD + r * 6144; load_mod(g2, md + 4 * 1024, md + 3 * 1024, lane, gm, sh); rprev = r; }
        modnorm_regs(v, gm, sh, H + (size_t)row * 1024, lane);
        float lg[16];
#pragma unroll
        for (int e = 0; e < 16; ++e) lg[e] = 0.f;
#pragma unroll
        for (int j = 0; j < 4; ++j)
#pragma unroll
            for (int i = 0; i < 4; ++i) { const float hv = v[j][i];
#pragma unroll
                for (int q = 0; q < 4; ++q) { const f32x4 w = Wl[(q * 4 + i) * 256 + 64 * j + lane]; lg[4 * q + 0] += hv * w[0]; lg[4 * q + 1] += hv * w[1]; lg[4 * q + 2] += hv * w[2]; lg[4 * q + 3] += hv * w[3]; }
                if (i & 1) asm volatile("" ::: "memory"); }
#pragma unroll
        for (int i = 0; i < 8; ++i) { const bool up = lane & 32; const float send = up ? lg[i] : lg[i + 8], keep = up ? lg[i + 8] : lg[i]; lg[i] = keep + __shfl_xor(send, 32); }
#pragma unroll
        for (int i = 0; i < 4; ++i) { const bool up = lane & 16; const float send = up ? lg[i] : lg[i + 4], keep = up ? lg[i + 4] : lg[i]; lg[i] = keep + __shfl_xor(send, 16); }
#pragma unroll
        for (int i = 0; i < 2; ++i) { const bool up = lane & 8; const float send = up ? lg[i] : lg[i + 2], keep = up ? lg[i + 2] : lg[i]; lg[i] = keep + __shfl_xor(send, 8); }
        { const bool up = lane & 4; const float send = up ? lg[0] : lg[1], keep = up ? lg[1] : lg[0]; lg[0] = keep + __shfl_xor(send, 4); }
        float z = lg[0]; z += __shfl_xor(z, 1); z += __shfl_xor(z, 2);
        float mx = z; mx = fmaxf(mx, __shfl_xor(mx, 4)); mx = fmaxf(mx, __shfl_xor(mx, 8)); mx = fmaxf(mx, __shfl_xor(mx, 16)); mx = fmaxf(mx, __shfl_xor(mx, 32));
        const float ez = expf(z - mx); float sm = ez; sm += __shfl_xor(sm, 4); sm += __shfl_xor(sm, 8); sm += __shfl_xor(sm, 16); sm += __shfl_xor(sm, 32);
        if ((lane & 3) == 0) { const int e = ((lane >> 5) & 1) * 8 + ((lane >> 4) & 1) * 4 + ((lane >> 3) & 1) * 2 + ((lane >> 2) & 1); AFF[(size_t)row * 16 + e] = ez / sm; }
#pragma unroll
        for (int j = 0; j < 4; ++j) v[j] = nxt[j];
    }
    __syncthreads();
}
typedef short v4i16_t __attribute__((ext_vector_type(4)));
__device__ __forceinline__ void mfma16(f32x4& acc, const bf16x8 a, const bf16x8 b) { asm volatile("s_nop 1\n\tv_mfma_f32_16x16x32_bf16 %0, %1, %2, %0\n\ts_nop 3" : "+v"(acc) : "v"(a), "v"(b)); }
#define DRAIN4(x) asm volatile("s_nop 15\n\ts_nop 15" : "+v"((x)[0]), "+v"((x)[1]), "+v"((x)[2]), "+v"((x)[3]))
#define DRAIN8(x) asm volatile("s_nop 15\n\ts_nop 15" : "+v"((x)[0]), "+v"((x)[1]), "+v"((x)[2]), "+v"((x)[3]), "+v"((x)[4]), "+v"((x)[5]), "+v"((x)[6]), "+v"((x)[7]))
#define DRAIN16(x) asm volatile("s_nop 15\n\ts_nop 15" : "+v"((x)[0]), "+v"((x)[1]), "+v"((x)[2]), "+v"((x)[3]), "+v"((x)[4]), "+v"((x)[5]), "+v"((x)[6]), "+v"((x)[7]), \
    "+v"((x)[8]), "+v"((x)[9]), "+v"((x)[10]), "+v"((x)[11]), "+v"((x)[12]), "+v"((x)[13]), "+v"((x)[14]), "+v"((x)[15]))
__device__ __forceinline__ void gmlp_unit(PH_ARGS, const int l, const int chunk) {
    const int row0 = chunk < 128 ? chunk * 128 : ML + (chunk - 128) * 128;
    const bf16* AUV = WSP(bf16, WS_AUV); bf16* BRa = WSP(bf16, WS_BR); const bf16* WS_ = WSP(bf16, WS_WSP);
    LAS bf16* vT = (LAS bf16*)lds;
    const float* lg = INP(9) + l * 256; const float* lb = INP(10) + l * 256;
    const f32x4 gg = *(const f32x4*)(lg + 4 * lane), bb = *(const f32x4*)(lb + 4 * lane);
    uint2 raws[16];
#pragma unroll
    for (int pi = 0; pi < 16; ++pi) raws[pi] = *(const uint2*)(AUV + (size_t)(row0 + wave * 16 + pi) * 512 + 256 + 4 * lane);
#pragma unroll
    for (int pi = 0; pi < 16; ++pi) { const int p = wave * 16 + pi;
        const uint2 raw = raws[pi];
        float v0 = bflo(raw.x), v1 = bfhi(raw.x), v2 = bflo(raw.y), v3 = bfhi(raw.y);
        const float mean = wave_sum((v0 + v1) + (v2 + v3)) * (1.f / 256.f); v0 -= mean; v1 -= mean; v2 -= mean; v3 -= mean;
        const float rstd = 1.0f / sqrtf(wave_sum((v0 * v0 + v1 * v1) + (v2 * v2 + v3 * v3)) * (1.f / 256.f) + 1e-6f);
        vT[(4 * lane + 0) * 136 + p] = (bf16)f2bf(v0 * rstd * gg[0] + bb[0]); vT[(4 * lane + 1) * 136 + p] = (bf16)f2bf(v1 * rstd * gg[1] + bb[1]);
        vT[(4 * lane + 2) * 136 + p] = (bf16)f2bf(v2 * rstd * gg[2] + bb[2]); vT[(4 * lane + 3) * 136 + p] = (bf16)f2bf(v3 * rstd * gg[3] + bb[3]); }
    __syncthreads();
    const int g = wave >> 1, qh = wave & 1, fr = lane & 15, fq = lane >> 4;
    f32x4 acc[4][4];
#pragma unroll
    for (int a = 0; a < 4; ++a)
#pragma unroll
        for (int b = 0; b < 4; ++b) acc[a][b] = (f32x4){0.f, 0.f, 0.f, 0.f};
    const bf16* Wg = WS_ + g * 16384;
#pragma unroll
    for (int ks = 0; ks < 4; ++ks) { bf16x8 af[4], bf[4];
#pragma unroll
        for (int dt = 0; dt < 4; ++dt) af[dt] = *(const LAS bf16x8*)(vT + (g * 64 + dt * 16 + fr) * 136 + ks * 32 + fq * 8);
#pragma unroll
        for (int qt = 0; qt < 4; ++qt) bf[qt] = *(const bf16x8*)(Wg + (qh * 64 + qt * 16 + fr) * 128 + ks * 32 + fq * 8);
#pragma unroll
        for (int dt = 0; dt < 4; ++dt)
#pragma unroll
            for (int qt = 0; qt < 4; ++qt) mfma16(acc[dt][qt], af[dt], bf[qt]); }
    DRAIN16(&acc[0][0]);
    const float* bs = INP(12) + l * 512 + g * 128;
#pragma unroll
    for (int qt = 0; qt < 4; ++qt) { const int q = qh * 64 + qt * 16 + fr; const float bias = bs[q]; const size_t row = row0 + q;
#pragma unroll
        for (int dt = 0; dt < 4; ++dt) { const int ch = g * 64 + dt * 16 + 4 * fq; const uint2 uw = *(const uint2*)(AUV + row * 512 + ch);
            f32x4 o; o[0] = bflo(uw.x) * (acc[dt][qt][0] + bias); o[1] = bfhi(uw.x) * (acc[dt][qt][1] + bias); o[2] = bflo(uw.y) * (acc[dt][qt][2] + bias); o[3] = bfhi(uw.y) * (acc[dt][qt][3] + bias);
            st4bf(BRa + row * 256 + ch, o); } }
    __syncthreads();
}
__device__ __forceinline__ void conv_unit(PH_ARGS, const int l, const int unit) {
    int rowbase, n0, nlen;
    if (unit < 256) { rowbase = (unit >> 7) * SEQ; n0 = (unit & 127) * 64; nlen = SEQ; } else { const int u2 = unit - 256; rowbase = ML + (u2 >> 2) * CTXL; n0 = (u2 & 3) * 64; nlen = CTXL; }
    const bf16* CY = WSP(bf16, WS_CY); bf16* BRc = WSP(bf16, WS_BR) + (size_t)2 * MT * 256;
    LAS unsigned* yt = (LAS unsigned*)lds;
    LAS float* cres = (LAS float*)(lds + 48128);
    for (int p = tid; p < 94 * 32; p += 512) { const int rr = p >> 5, seg = p & 31, n = n0 - 15 + rr; v4u val = {0u, 0u, 0u, 0u};
        if (n >= 0 && n < nlen) val = *(const v4u*)(CY + (size_t)(rowbase + n) * 256 + seg * 8);
        *(LAS v4u*)(lds + rr * 512 + seg * 16) = val; }
    __syncthreads();
    const int cp = tid & 127, pg = tid >> 7;
    float w0[31], w1[31];
    const float* cw = INP(15) + (size_t)l * 31 * 256 + 2 * cp;
#pragma unroll
    for (int t = 0; t < 31; ++t) { const float2 w = *(const float2*)(cw + t * 256); w0[t] = w.x; w1[t] = w.y; }
    float a0[16], a1[16];
#pragma unroll
    for (int p = 0; p < 16; ++p) { a0[p] = 0.f; a1[p] = 0.f; }
#pragma unroll
    for (int i = 0; i < 46; ++i) { const unsigned raw = yt[(16 * pg + i) * 128 + cp]; const float v0 = bflo(raw), v1 = bfhi(raw);
#pragma unroll
        for (int p = 0; p < 16; ++p) { const int t = i - p; if (t >= 0 && t < 31) { a0[p] += v0 * w0[t]; a1[p] += v1 * w1[t]; } } }
    const float2 cb = *(const float2*)(INP(16) + l * 256 + 2 * cp);
#pragma unroll
    for (int p = 0; p < 16; ++p) *(LAS f2v*)(cres + (16 * pg + p) * 256 + 2 * cp) = (f2v){a0[p] + cb.x, a1[p] + cb.y};
    __syncthreads();
    const f32x4 gg = *(const f32x4*)(INP(17) + l * 256 + 4 * lane), bb = *(const f32x4*)(INP(18) + l * 256 + 4 * lane);
    for (int pi = 0; pi < 8; ++pi) { const int pos = wave * 8 + pi; f32x4 v = *(const LAS f32x4*)(cres + pos * 256 + 4 * lane);
        const float mean = wave_sum((v[0] + v[1]) + (v[2] + v[3])) * (1.f / 256.f); v = v - mean;
        const float rstd = 1.0f / sqrtf(wave_sum((v[0] * v[0] + v[1] * v[1]) + (v[2] * v[2] + v[3] * v[3])) * (1.f / 256.f) + 1e-6f);
        f32x4 o;
#pragma unroll
        for (int j = 0; j < 4; ++j) { const float y = v[j] * rstd * gg[j] + bb[j]; o[j] = y * sigm(y); }
        st4bf(BRc + (size_t)(rowbase + n0 + pos) * 256 + 4 * lane, o); }
    __syncthreads();
}
constexpr int F1_T1L = 0, F1_YL = 34816;
__device__ __forceinline__ void f1_stage_tables(PH_ARGS) {
    const bf16* T1 = WSP(bf16, WS_T1T);
    for (int p = tid; p < 128 * 16; p += 512) { const int r = p >> 4, s = p & 15; *(LAS v4u*)(lds + F1_T1L + r * 272 + s * 16) = *(const v4u*)(T1 + r * 128 + s * 8); }
    __syncthreads();
}
__device__ __forceinline__ void f1_unit(PH_ARGS, const int unit) {
    const int b = unit >> 7, n2 = unit & 127, fr = lane & 15, fq = lane >> 4;
    const bf16* YF = WSP(bf16, WS_YF); bf16* FA = WSP(bf16, WS_FA);
    LAS unsigned* Yl = (LAS unsigned*)(lds + F1_YL);
#pragma unroll
    for (int i = 0; i < 8; ++i) { const int n1 = wave + 8 * i; *(LAS v4u*)(Yl + n1 * 260 + lane * 4) = *(const v4u*)(YF + (size_t)(b * SEQ + 128 * n1 + n2) * 512 + lane * 8); }
    __syncthreads();
    f32x4 acc[2][8];
#pragma unroll
    for (int a = 0; a < 2; ++a)
#pragma unroll
        for (int n = 0; n < 8; ++n) acc[a][n] = (f32x4){0.f, 0.f, 0.f, 0.f};
#pragma unroll
    for (int ks = 0; ks < 4; ++ks) { bf16x8 af[2];
#pragma unroll
        for (int c2 = 0; c2 < 2; ++c2) { const int ch = (2 * wave + c2) * 16 + fr; v4u w;
            w.x = Yl[(16 * ks + 4 * fq + 0) * 260 + ch]; w.y = Yl[(16 * ks + 4 * fq + 1) * 260 + ch]; w.z = Yl[(16 * ks + 4 * fq + 2) * 260 + ch]; w.w = Yl[(16 * ks + 4 * fq + 3) * 260 + ch];
            af[c2] = __builtin_bit_cast(bf16x8, w); }
#pragma unroll
        for (int nt = 0; nt < 8; ++nt) { const bf16x8 bfr = *(const LAS bf16x8*)(lds + F1_T1L + (nt * 16 + fr) * 272 + ks * 64 + fq * 16);
            mfma16(acc[0][nt], af[0], bfr); mfma16(acc[1][nt], af[1], bfr); } }
    DRAIN16(&acc[0][0]);
#pragma unroll
    for (int c2 = 0; c2 < 2; ++c2)
#pragma unroll
        for (int kt = 0; kt < 4; ++kt) { const int k1 = kt * 16 + fr; const f32x4 ar = acc[c2][kt], ai = acc[c2][kt + 4];
            v4u o; o.x = pk2(ar[0], ai[0]); o.y = pk2(ar[1], ai[1]); o.z = pk2(ar[2], ai[2]); o.w = pk2(ar[3], ai[3]);
            *(v4u*)(FA + ((size_t)((b * 64 + k1) * 128 + n2) * 256 + (2 * wave + c2) * 16 + 4 * fq) * 2) = o; }
    __syncthreads();
}
constexpr int F2_T2L = 0, F2_AL = 67584;
__device__ __forceinline__ void f2_unit(PH_ARGS, const int unit) {
    const int fr = lane & 15, fq = lane >> 4; const bool lat = unit < 256;
    int b, k1, chh; const bf16* Asrc; const bf16* Tsrc; size_t orow0; int ostr; float scl;
    if (lat) { b = unit >> 7; k1 = (unit >> 1) & 63; chh = unit & 1; Asrc = WSP(bf16, WS_FA) + (size_t)((b * 64 + k1) * 128) * 512; Tsrc = WSP(bf16, WS_T2F) + (size_t)k1 * 32768; orow0 = (size_t)b * SEQ + k1; ostr = 64; scl = 0.0013810679320049757f; }
    else { const int u2 = unit - 256; b = u2 >> 2; k1 = (u2 >> 1) & 1; chh = u2 & 1; Asrc = WSP(bf16, WS_FAC) + (size_t)((b * 2 + k1) * 128) * 512; Tsrc = WSP(bf16, WS_T2C) + (size_t)k1 * 32768; orow0 = (size_t)ML + b * CTXL + k1; ostr = 2; scl = 1.f / 128.f; }
    bf16* BRb = WSP(bf16, WS_BR) + (size_t)1 * MT * 256;
    LAS unsigned* Al = (LAS unsigned*)(lds + F2_AL);
    for (int p = tid; p < 128 * 32; p += 512) { const int r = p >> 5, s = p & 31; *(LAS v4u*)(lds + F2_T2L + r * 528 + s * 16) = *(const v4u*)(Tsrc + r * 256 + s * 8); }
#pragma unroll
    for (int i = 0; i < 8; ++i) { const int n2 = wave * 16 + 2 * i + (lane >> 5);
        *(LAS v4u*)(Al + n2 * 132 + (lane & 31) * 4) = *(const v4u*)(Asrc + ((size_t)n2 * 256 + chh * 128) * 2 + (lane & 31) * 8); }
    __syncthreads();
    f32x4 acc[8];
#pragma unroll
    for (int n = 0; n < 8; ++n) acc[n] = (f32x4){0.f, 0.f, 0.f, 0.f};
    const int ch = wave * 16 + fr;
#pragma unroll
    for (int ks = 0; ks < 8; ++ks) { v4u w;
        w.x = Al[(16 * ks + 4 * fq + 0) * 132 + ch]; w.y = Al[(16 * ks + 4 * fq + 1) * 132 + ch]; w.z = Al[(16 * ks + 4 * fq + 2) * 132 + ch]; w.w = Al[(16 * ks + 4 * fq + 3) * 132 + ch];
        const bf16x8 af = __builtin_bit_cast(bf16x8, w);
#pragma unroll
        for (int nt = 0; nt < 8; ++nt) { const bf16x8 bfr = *(const LAS bf16x8*)(lds + F2_T2L + (nt * 16 + fr) * 528 + ks * 64 + fq * 16); mfma16(acc[nt], af, bfr); } }
    DRAIN8(acc);
#pragma unroll
    for (int nt = 0; nt < 8; ++nt) { const int k2 = nt * 16 + fr; st4bf(BRb + (orow0 + (size_t)ostr * k2) * 256 + chh * 128 + wave * 16 + 4 * fq, acc[nt] * scl); }
    __syncthreads();
}
__device__ __forceinline__ void ctx_butterfly(PH_ARGS) {
    const unsigned* YF = (const unsigned*)WSP(bf16, WS_YF); unsigned* FAC = (unsigned*)WSP(bf16, WS_FAC);
    for (int i = bid * 512 + tid; i < 2 * 128 * 256; i += G * 512) { const int b = i >> 15, n2 = (i >> 8) & 127, ch = i & 255;
        const unsigned y0 = YF[(size_t)(ML + b * CTXL + n2) * 256 + ch], y1 = YF[(size_t)(ML + b * CTXL + 128 + n2) * 256 + ch];
        const float r0 = bflo(y0), i0 = bfhi(y0), r1 = bflo(y1), i1 = bfhi(y1);
        FAC[(size_t)((b * 2 + 0) * 128 + n2) * 256 + ch] = pk2(r0 + r1, i0 + i1); FAC[(size_t)((b * 2 + 1) * 128 + n2) * 256 + ch] = pk2(r0 - r1, i0 - i1); }
}
constexpr int MG_AL = 0, MG_BL = 67584;
__device__ __forceinline__ void merge_phase(PH_ARGS, const int nunits) {
    const int fr = lane & 15, fq = lane >> 4, wr = wave >> 2, wc = wave & 3;
    const bf16* BR = WSP(bf16, WS_BR); const bf16* WBR = WSP(bf16, WS_WBR); const bf16* GT = WSP(bf16, WS_G); bf16* MB = WSP(bf16, WS_MB);
    int nmine = 0; for (int u = bid; u < nunits; u += G) ++nmine;
    const int nsteps = nmine * 4;
    if (nsteps == 0) return;
    v4u pa[8], pb[8];
#define MG_LOAD(s) do { const int u_ = bid + ((s) >> 2) * G, b_ = (s) & 3, rt_ = u_ >> 3, ct_ = u_ & 7; \
        const bf16* As = BR + ((size_t)b_ * MT + (size_t)rt_ * 128) * 256; const bf16* Bs = WBR + ((size_t)b_ * 1024 + (size_t)ct_ * 128) * 256; \
        _Pragma("unroll") for (int i = 0; i < 8; ++i) { const int p = i * 512 + tid, r = p >> 5, seg = p & 31; pa[i] = *(const v4u*)(As + (size_t)r * 256 + seg * 8); pb[i] = *(const v4u*)(Bs + (size_t)r * 256 + seg * 8); } } while (0)
#define MG_WRITE() do { _Pragma("unroll") for (int i = 0; i < 8; ++i) { const int p = i * 512 + tid, r = p >> 5, seg = p & 31; \
        *(LAS v4u*)(lds + MG_AL + r * 528 + seg * 16) = pa[i]; *(LAS v4u*)(lds + MG_BL + r * 528 + seg * 16) = pb[i]; } } while (0)
    MG_LOAD(0); MG_WRITE();
    f32x4 macc[4][2];
#pragma unroll
    for (int a = 0; a < 4; ++a)
#pragma unroll
        for (int n = 0; n < 2; ++n) macc[a][n] = (f32x4){0.f, 0.f, 0.f, 0.f};
#pragma unroll 1
    for (int s = 0; s < nsteps; ++s) {
        const int u = bid + (s >> 2) * G, b = s & 3, rt = u >> 3, ct = u & 7;
        __syncthreads();
        if (s + 1 < nsteps) MG_LOAD(s + 1);
        uint2 gw[4][2];
#pragma unroll
        for (int mt = 0; mt < 4; ++mt)
#pragma unroll
            for (int nt = 0; nt < 2; ++nt) gw[mt][nt] = *(const uint2*)(GT + ((((size_t)(u * 4 + b) * 8 + wave) * 8 + mt * 2 + nt) * 256 + lane * 4));
        f32x4 acc[4][2];
#pragma unroll
        for (int a = 0; a < 4; ++a)
#pragma unroll
            for (int n = 0; n < 2; ++n) acc[a][n] = (f32x4){0.f, 0.f, 0.f, 0.f};
#pragma unroll
        for (int ks = 0; ks < 8; ++ks) { bf16x8 af[4], bfr[2];
#pragma unroll
            for (int mt = 0; mt < 4; ++mt) af[mt] = *(const LAS bf16x8*)(lds + MG_AL + (wr * 64 + mt * 16 + fr) * 528 + ks * 64 + fq * 16);
#pragma unroll
            for (int nt = 0; nt < 2; ++nt) bfr[nt] = *(const LAS bf16x8*)(lds + MG_BL + (wc * 32 + nt * 16 + fr) * 528 + ks * 64 + fq * 16);
#pragma unroll
            for (int mt = 0; mt < 4; ++mt)
#pragma unroll
                for (int nt = 0; nt < 2; ++nt) mfma16(acc[mt][nt], bfr[nt], af[mt]); }
        DRAIN8(&acc[0][0]);
#pragma unroll
        for (int mt = 0; mt < 4; ++mt)
#pragma unroll
            for (int nt = 0; nt < 2; ++nt) { const uint2 g = gw[mt][nt]; macc[mt][nt][0] += bflo(g.x) * acc[mt][nt][0]; macc[mt][nt][1] += bfhi(g.x) * acc[mt][nt][1]; macc[mt][nt][2] += bflo(g.y) * acc[mt][nt][2]; macc[mt][nt][3] += bfhi(g.y) * acc[mt][nt][3]; }
        __syncthreads();
        if (s + 1 < nsteps) MG_WRITE();
        if (b == 3) {
#pragma unroll
            for (int mt = 0; mt < 4; ++mt)
#pragma unroll
                for (int nt = 0; nt < 2; ++nt) { st4bf(MB + (size_t)(rt * 128 + wr * 64 + mt * 16 + fr) * 1024 + ct * 128 + wc * 32 + nt * 16 + 4 * fq, macc[mt][nt]); macc[mt][nt] = (f32x4){0.f, 0.f, 0.f, 0.f}; }
        }
    }
    __syncthreads();
#undef MG_LOAD
#undef MG_WRITE
}
constexpr int AT_RPB = 32768, AT_MRG = 40960;
__device__ __forceinline__ int clampi(int v, int lo, int hi) { return v < lo ? lo : (v > hi ? hi : v); }
__device__ __forceinline__ bool at_need(int kind, int jb, int t) { return kind == 2 || (kind == 0 ? (jb < 2 || (jb == 2 && t == 1)) : (jb > 1 || (jb == 1 && t == 0))); }
struct AtCtx { const bf16* QPL; const bf16* KR; const bf16* VV; LAS unsigned char* vbuf; const LAS float* rpbl; int h, qh, fr, fq, lane, b, r, kr0, qrow0, nch, nwin; bool lat; unsigned code[2][2][2]; };
__device__ __forceinline__ unsigned at_keyrow(const AtCtx& X, int ci) { return (ci < X.nwin) ? ((unsigned)X.b * SEQ + (unsigned)(X.kr0 + (ci >> 1)) * 64 + 32 * (ci & 1)) : ((unsigned)ML + X.b * CTXL + 32 * (ci - X.nwin)); }
__device__ __forceinline__ void at_load(const AtCtx& X, int ci, bf16x8 (&kf)[2][2], v4u (&vst)[4]) {
    const unsigned kr = at_keyrow(X, ci);
#pragma unroll
    for (int t = 0; t < 2; ++t)
#pragma unroll
        for (int ks = 0; ks < 2; ++ks) kf[t][ks] = *(const bf16x8*)(X.KR + (unsigned)((kr + 16 * t + X.fr) * 256 + X.h * 64 + ks * 32 + X.fq * 8));
#pragma unroll
    for (int i = 0; i < 4; ++i) { const int p = i * 64 + X.lane, key = p >> 3, seg = p & 7; vst[i] = *(const v4u*)(X.VV + (unsigned)((kr + key) * 256 + X.h * 64 + seg * 8)); }
}
__device__ __forceinline__ void at_chunk(const AtCtx& X, const int ci, bf16x8 (&kf)[2][2], v4u (&vst)[4], bf16x8 (&qf)[2][2], f32x4 (&O)[2][4], float (&m)[2], float (&l)[2]) {
    const int kind = ci < X.nwin ? (ci & 1) : 2, fr = X.fr, fq = X.fq, qh = X.qh;
    if (X.lat && ci == 16) {
#pragma unroll
        for (int j = 0; j < 2; ++j)
#pragma unroll
            for (int ks = 0; ks < 2; ++ks) qf[j][ks] = *(const bf16x8*)(X.QPL + (unsigned)((X.qrow0 + 16 * (2 * qh + j) + fr) * 256 + X.h * 64 + ks * 32 + fq * 8)); }
#pragma unroll
    for (int i = 0; i < 4; ++i) { const int p = i * 64 + X.lane, key = p >> 3, seg = p & 7; *(LAS v4u*)(X.vbuf + key * 128 + ((((seg >> 1) ^ ((key >> 1) & 3))) << 5) + ((seg & 1) << 4)) = vst[i]; }
    f32x4 S[2][2]; bool nd[2][2];
#pragma unroll
    for (int j = 0; j < 2; ++j)
#pragma unroll
        for (int t = 0; t < 2; ++t) { S[j][t] = (f32x4){0.f, 0.f, 0.f, 0.f}; nd[j][t] = at_need(kind, 2 * qh + j, t);
            if (nd[j][t]) { mfma16(S[j][t], kf[t][0], qf[j][0]); mfma16(S[j][t], kf[t][1], qf[j][1]); } }
    asm volatile("s_nop 15\n\ts_nop 15" : "+v"(S[0][0]), "+v"(S[0][1]), "+v"(S[1][0]), "+v"(S[1][1]));
    if (ci + 3 < X.nch) at_load(X, ci + 3, kf, vst);
    const LAS float* rpbrow = X.rpbl + (kind != 2 ? (X.kr0 + (ci >> 1) - X.r + 7) * 31 : 0);
    bf16x8 pf[2]; bool anyj[2];
#pragma unroll
    for (int j = 0; j < 2; ++j) { anyj[j] = nd[j][0] || nd[j][1];
        float mc = -3.0e38f;
#pragma unroll
        for (int t = 0; t < 2; ++t)
#pragma unroll
            for (int rg = 0; rg < 4; ++rg) { float s = S[j][t][rg];
                if (kind != 2) { const unsigned cd = ((kind == 0 ? X.code[0][j][t] : X.code[1][j][t]) >> (8 * rg)) & 255u; const float bias = rpbrow[cd & 31u]; s = cd < 32u ? s + bias : -1.0e30f; }
                S[j][t][rg] = s; mc = fmaxf(mc, s); }
        { auto r16 = __builtin_amdgcn_permlane16_swap(__float_as_uint(mc), __float_as_uint(mc), false, false); mc = fmaxf(__uint_as_float(r16[0]), __uint_as_float(r16[1]));
          auto r32 = __builtin_amdgcn_permlane32_swap(__float_as_uint(mc), __float_as_uint(mc), false, false); mc = fmaxf(__uint_as_float(r32[0]), __uint_as_float(r32[1])); }
        const float mnew = fmaxf(m[j], mc), alpha = __expf(m[j] - mnew); m[j] = mnew; float ls = 0.f;
#pragma unroll
        for (int t = 0; t < 2; ++t)
#pragma unroll
            for (int rg = 0; rg < 4; ++rg) { const float p = __expf(S[j][t][rg] - mnew); S[j][t][rg] = p; ls += p; }
        l[j] = l[j] * alpha + ls;
#pragma unroll
        for (int dt = 0; dt < 4; ++dt) O[j][dt] = O[j][dt] * alpha;
        v4u pw; pw.x = pk2(S[j][0][0], S[j][0][1]); pw.y = pk2(S[j][0][2], S[j][0][3]); pw.z = pk2(S[j][1][0], S[j][1][1]); pw.w = pk2(S[j][1][2], S[j][1][3]);
        pf[j] = __builtin_bit_cast(bf16x8, pw); }
#pragma unroll
    for (int dt = 0; dt < 4; ++dt) { v4i16_t t0, t1;
        { const int key = 4 * fq + (fr >> 2); t0 = __builtin_amdgcn_ds_read_tr16_b64_v4i16((LAS v4i16_t*)(X.vbuf + key * 128 + ((dt ^ ((key >> 1) & 3)) << 5) + (fr & 3) * 8)); }
        { const int key = 16 + 4 * fq + (fr >> 2); t1 = __builtin_amdgcn_ds_read_tr16_b64_v4i16((LAS v4i16_t*)(X.vbuf + key * 128 + ((dt ^ ((key >> 1) & 3)) << 5) + (fr & 3) * 8)); }
        const bf16x8 vf = (bf16x8){t0[0], t0[1], t0[2], t0[3], t1[0], t1[1], t1[2], t1[3]};
        if (anyj[0]) mfma16(O[0][dt], vf, pf[0]);
        if (anyj[1]) mfma16(O[1][dt], vf, pf[1]); }
    asm volatile("s_nop 15\n\ts_nop 7" : "+v"(O[0][0]), "+v"(O[0][1]), "+v"(O[0][2]), "+v"(O[0][3]), "+v"(O[1][0]), "+v"(O[1][1]), "+v"(O[1][2]), "+v"(O[1][3]));
}
__device__ __forceinline__ void attn_unit(PH_ARGS, const int unit) {
    AtCtx X; X.h = wave >> 1; X.qh = wave & 1; X.fr = lane & 15; X.fq = lane >> 4; X.lane = lane;
    X.lat = unit < 256; X.r = 0; X.kr0 = 0;
    if (X.lat) { X.b = unit >> 7; X.r = unit & 127; X.qrow0 = X.b * SEQ + X.r * 64; X.kr0 = clampi(X.r - 4, 0, 120); }
    else { const int u2 = unit - 256; X.b = u2 >> 2; X.qrow0 = ML + X.b * CTXL + (u2 & 3) * 64; }
    X.QPL = WSP(bf16, WS_QPL); const bf16* QROT = WSP(bf16, WS_QROT); X.KR = WSP(bf16, WS_KR); X.VV = WSP(bf16, WS_VV);
    bf16* BRd = WSP(bf16, WS_BR) + (size_t)3 * MT * 256;
    X.vbuf = lds + wave * 4096; X.rpbl = (const LAS float*)(lds + AT_RPB) + X.h * 465;
    X.nch = X.lat ? 24 : 8; X.nwin = X.lat ? 16 : 0;
#pragma unroll
    for (int kd = 0; kd < 2; ++kd)
#pragma unroll
        for (int j = 0; j < 2; ++j)
#pragma unroll
            for (int t = 0; t < 2; ++t) { unsigned cw = 0u; const int jb = 2 * X.qh + j;
#pragma unroll
                for (int rg = 0; rg < 4; ++rg) { const int kcol = 32 * kd + 16 * t + 4 * X.fq + rg, qcol = 16 * jb + X.fr, cst = clampi(qcol - 8, 0, 48); const bool ok = at_need(kd, jb, t) && kcol >= cst && kcol < cst + 16;
                    cw |= (ok ? (unsigned)(clampi(kcol - qcol, -15, 15) + 15) : 255u) << (8 * rg); }
                X.code[kd][j][t] = cw; }
    float m[2], l[2]; f32x4 O[2][4];
#pragma unroll
    for (int j = 0; j < 2; ++j) { m[j] = -3.0e38f; l[j] = 0.f;
#pragma unroll
        for (int dt = 0; dt < 4; ++dt) O[j][dt] = (f32x4){0.f, 0.f, 0.f, 0.f}; }
    bf16x8 qf[2][2];
    { const bf16* Qs = X.lat ? QROT : X.QPL;
#pragma unroll
      for (int j = 0; j < 2; ++j)
#pragma unroll
          for (int ks = 0; ks < 2; ++ks) qf[j][ks] = *(const bf16x8*)(Qs + (unsigned)((X.qrow0 + 16 * (2 * X.qh + j) + X.fr) * 256 + X.h * 64 + ks * 32 + X.fq * 8)); }
    bf16x8 kA[2][2], kB[2][2], kC[2][2]; v4u vA[4], vB[4], vC[4];
    at_load(X, 0, kA, vA); at_load(X, 1, kB, vB); at_load(X, 2, kC, vC);
#pragma unroll 1
    for (int ci = 0; ci < X.nch; ci += 3) {
        at_chunk(X, ci, kA, vA, qf, O, m, l);
        if (ci + 1 < X.nch) at_chunk(X, ci + 1, kB, vB, qf, O, m, l);
        if (ci + 2 < X.nch) at_chunk(X, ci + 2, kC, vC, qf, O, m, l);
    }
#pragma unroll
    for (int j = 0; j < 2; ++j) { l[j] += __shfl_xor(l[j], 16); l[j] += __shfl_xor(l[j], 32); const float inv = 1.f / l[j];
#pragma unroll
        for (int dt = 0; dt < 4; ++dt) st4bf(BRd + (unsigned)((X.qrow0 + 16 * (2 * X.qh + j) + X.fr) * 256 + X.h * 64 + dt * 16 + 4 * X.fq), O[j][dt] * inv); }
}
#ifndef CDFT_REP
#define CDFT_REP 1
#endif
#ifndef CONV_REP
#define CONV_REP 1
#endif
#ifndef GMLP_REP
#define GMLP_REP 1
#endif
#ifndef F1_REP
#define F1_REP 1
#endif
__device__ __forceinline__ int block_excl_scan(int v, LAS int* ws8, int lane, int wave) {
    int x = v;
#pragma unroll
    for (int o = 1; o < 64; o <<= 1) { const int y = __shfl_up(x, o); if (lane >= o) x += y; }
    if (lane == 63) ws8[wave] = x;
    __syncthreads();
    int base = 0;
#pragma unroll
    for (int w = 0; w < 8; ++w) base += (w < wave) ? ws8[w] : 0;
    __syncthreads();
    return base + x - v;
}
template <int PER, bool ALLV>
__device__ __forceinline__ void topk_unit(PH_ARGS, const int rowbase, const int n, const int C, const int e, const int sbase, const bool writepad) {
    const float* AFF = WSP(float, WS_AFF); int* SEL = WSP(int, WS_SEL); int* IDX = WSP(int, WS_IDX); float* GATE = WSP(float, WS_GATE);
    LAS unsigned* hist = (LAS unsigned*)lds; LAS unsigned* sh = hist + 256; LAS int* ws8 = (LAS int*)(hist + 272);
    unsigned key[PER]; bool valid[PER];
#pragma unroll
    for (int i = 0; i < PER; ++i) { const int tok = tid * PER + i; valid[i] = ALLV ? true : (tok < n); key[i] = valid[i] ? __float_as_uint(AFF[(size_t)(rowbase + tok) * 16 + e]) : 0u; }
    unsigned prefix = 0u, mask = 0u, rem = (unsigned)C;
#pragma unroll 1
    for (int pass = 0; pass < 4; ++pass) { const int shift = 24 - 8 * pass;
        if (tid < 256) hist[tid] = 0u;
        __syncthreads();
#pragma unroll
        for (int i = 0; i < PER; ++i) if (valid[i] && (key[i] & mask) == prefix) atomicAdd((unsigned*)&hist[(key[i] >> shift) & 255u], 1u);
        __syncthreads();
        if (wave == 0) { unsigned c0 = hist[255 - 4 * lane], c1 = hist[254 - 4 * lane], c2 = hist[253 - 4 * lane], c3 = hist[252 - 4 * lane];
            const unsigned s = c0 + c1 + c2 + c3; unsigned x = s;
#pragma unroll
            for (int o = 1; o < 64; o <<= 1) { const unsigned y = __shfl_up(x, o); if (lane >= o) x += y; }
            const unsigned excl = x - s;
            if (excl < rem && rem <= x) { unsigned cum = excl; int bin; unsigned nr;
                if (cum + c0 >= rem) { bin = 255 - 4 * lane; nr = rem - cum; }
                else { cum += c0; if (cum + c1 >= rem) { bin = 254 - 4 * lane; nr = rem - cum; }
                else { cum += c1; if (cum + c2 >= rem) { bin = 253 - 4 * lane; nr = rem - cum; }
                else { cum += c2; bin = 252 - 4 * lane; nr = rem - cum; } } }
                sh[0] = (unsigned)bin; sh[1] = nr; } }
        __syncthreads();
        prefix |= sh[0] << shift; mask |= 255u << shift; rem = sh[1];
    }
    __syncthreads();
    const unsigned T = prefix;
    int neq = 0;
#pragma unroll
    for (int i = 0; i < PER; ++i) neq += (valid[i] && key[i] == T) ? 1 : 0;
    const int eqbase = block_excl_scan(neq, ws8, lane, wave);
    unsigned take = 0u; int nsel = 0, eqs = 0;
#pragma unroll
    for (int i = 0; i < PER; ++i) { const bool iseq = valid[i] && key[i] == T; const bool tk = valid[i] && (key[i] > T || (iseq && (unsigned)(eqbase + eqs) < rem)); eqs += iseq ? 1 : 0; if (tk) { take |= 1u << i; ++nsel; } }
    const int sb = block_excl_scan(nsel, ws8, lane, wave);
    int cnt = 0;
#pragma unroll
    for (int i = 0; i < PER; ++i) { const int tok = tid * PER + i;
        if (valid[i]) { if ((take >> i) & 1u) { const int slot = sbase + sb + cnt; ++cnt; IDX[e * ESTR + slot] = rowbase + tok; GATE[e * ESTR + slot] = __uint_as_float(key[i]); SEL[(size_t)(rowbase + tok) * 16 + e] = slot; }
                        else SEL[(size_t)(rowbase + tok) * 16 + e] = -1; } }
    if (writepad) for (int i = tid; i < ESTR - 2112; i += 512) { IDX[e * ESTR + 2112 + i] = 0; GATE[e * ESTR + 2112 + i] = 0.f; }
    __syncthreads();
}
__device__ __forceinline__ void gather_rows(PH_ARGS, const int tpe) {
    const int gw = bid * 8 + wave, NGW = G * 8, per = tpe * 256; const int* IDX = WSP(int, WS_IDX); const bf16* H = WSP(bf16, WS_H); bf16* XE = WSP(bf16, WS_XE);
    for (int i = gw; i < NE * per; i += NGW) { const int e = i / per, s = i % per, rg = e * ESTR + s; const int src = IDX[rg];
        const v4u a = *(const v4u*)(H + (size_t)src * 1024 + lane * 8), b = *(const v4u*)(H + (size_t)src * 1024 + 512 + lane * 8);
        *(v4u*)(XE + (size_t)rg * 1024 + lane * 8) = a; *(v4u*)(XE + (size_t)rg * 1024 + 512 + lane * 8) = b; }
}
__device__ __forceinline__ void combine_rows(PH_ARGS, const int l) {
    const int gw = bid * 8 + wave, NGW = G * 8; const int nrows = l == 0 ? MT : ML;
    const int* SEL = WSP(int, WS_SEL); const bf16* YB = WSP(bf16, WS_XE); float* X = WSP(float, WS_X); bf16* H = WSP(bf16, WS_H); const float* MOD = WSP(float, WS_MOD);
    for (int row = gw; row < nrows; row += NGW) {
        const int r = row < SEQ ? 0 : (row < ML ? 1 : 2);
        float acc[2][8];
#pragma unroll
        for (int j = 0; j < 2; ++j)
#pragma unroll
            for (int i = 0; i < 8; ++i) acc[j][i] = 0.f;
        const int myslot = lane < 16 ? SEL[(size_t)row * 16 + lane] : -1;
#pragma unroll
        for (int e = 0; e < 16; ++e) { const int s = __shfl(myslot, e);
            if (s >= 0) { const bf16* y = YB + (size_t)(e * ESTR + s) * 1024 + lane * 8;
#pragma unroll
                for (int j = 0; j < 2; ++j) { const v4u w = *(const v4u*)(y + 512 * j);
                    acc[j][0] += bflo(w.x); acc[j][1] += bfhi(w.x); acc[j][2] += bflo(w.y); acc[j][3] += bfhi(w.y); acc[j][4] += bflo(w.z); acc[j][5] += bfhi(w.z); acc[j][6] += bflo(w.w); acc[j][7] += bfhi(w.w); } } }
        const float* gt2 = MOD + (l * 3 + r) * 6144 + 5 * 1024; float* xr = X + (size_t)row * 1024;
        float xv[2][8]; float ss = 0.f;
#pragma unroll
        for (int j = 0; j < 2; ++j) { const int o = 8 * lane + 512 * j; const f32x4 x0 = *(const f32x4*)(xr + o), x1 = *(const f32x4*)(xr + o + 4), g0 = *(const f32x4*)(gt2 + o), g1 = *(const f32x4*)(gt2 + o + 4);
#pragma unroll
            for (int i = 0; i < 4; ++i) { xv[j][i] = x0[i] + g0[i] * acc[j][i]; xv[j][4 + i] = x1[i] + g1[i] * acc[j][4 + i]; }
#pragma unroll
            for (int i = 0; i < 8; ++i) ss += xv[j][i] * xv[j][i]; }
        const float rs = 1.0f / sqrtf(wave_sum(ss) * (1.f / 1024.f) + 1e-6f);
        if (l == 0) {
            const float* md = MOD + (1 * 3 + r) * 6144; const float* g = INP(6) + 1024;
#pragma unroll
            for (int j = 0; j < 2; ++j) { const int o = 8 * lane + 512 * j;
                *(f32x4*)(xr + o) = (f32x4){xv[j][0], xv[j][1], xv[j][2], xv[j][3]}; *(f32x4*)(xr + o + 4) = (f32x4){xv[j][4], xv[j][5], xv[j][6], xv[j][7]};
                float hv[8];
#pragma unroll
                for (int i = 0; i < 8; ++i) hv[i] = xv[j][i] * rs * g[o + i] * (1.f + md[1024 + o + i]) + md[o + i];
                v4u w; w.x = pk2(hv[0], hv[1]); w.y = pk2(hv[2], hv[3]); w.z = pk2(hv[4], hv[5]); w.w = pk2(hv[6], hv[7]);
                *(v4u*)(H + (size_t)row * 1024 + o) = w; }
        } else {
            const float* g = INP(27); float* orow = PTRV(28, float) + (size_t)row * 1024;
#pragma unroll
            for (int j = 0; j < 2; ++j) { const int o = 8 * lane + 512 * j;
                *(f32x4*)(orow + o) = (f32x4){xv[j][0] * rs * g[o + 0], xv[j][1] * rs * g[o + 1], xv[j][2] * rs * g[o + 2], xv[j][3] * rs * g[o + 3]};
                *(f32x4*)(orow + o + 4) = (f32x4){xv[j][4] * rs * g[o + 4], xv[j][5] * rs * g[o + 5], xv[j][6] * rs * g[o + 6], xv[j][7] * rs * g[o + 7]}; }
        }
    }
}


#ifdef DBG_STOP
__device__ __forceinline__ void debug_out(PH_ARGS) {
    float* out = PTRV(28, float);
    const int gt = bid * 512 + tid, GT = G * 512;
    for (size_t i = gt; i < (size_t)ML * 1024; i += GT) { const size_t row = i >> 10; const int c = (int)(i & 1023); float v = 0.f;
#if DBG_STOP == 2
        v = bflo(WSP(bf16, WS_H)[row * 1024 + c]) + WSP(float, WS_MOD)[(i % 36864)] + bflo(WSP(bf16, WS_WIN)[i % (6400 * 1024)]) + bflo(WSP(bf16, WS_WGU)[i]) + bflo(WSP(bf16, WS_WDN)[i]) + bflo(WSP(bf16, WS_WO)[i % (1024*1024)]) + bflo(WSP(bf16, WS_WBR)[i % (1024*1024)]);
#elif DBG_STOP == 3
        v = bflo(WSP(bf16, WS_AUV)[row * 512 + (c & 511)]) + bflo(WSP(bf16, WS_YF)[row * 512 + (c & 511)]) + bflo(WSP(bf16, WS_CY)[row * 256 + (c & 255)]) + bflo(WSP(bf16, WS_QPL)[row * 256 + (c & 255)])
          + bflo(WSP(bf16, WS_QROT)[row * 256 + (c & 255)]) + bflo(WSP(bf16, WS_KR)[row * 256 + (c & 255)]) + bflo(WSP(bf16, WS_VV)[row * 256 + (c & 255)])
          + bflo(WSP(bf16, WS_G)[row * 4096 + c]) + bflo(WSP(bf16, WS_G)[row * 4096 + 1024 + c]) + bflo(WSP(bf16, WS_G)[row * 4096 + 2048 + c]) + bflo(WSP(bf16, WS_G)[row * 4096 + 3072 + c]);
#elif DBG_STOP == 4
        v = bflo(WSP(bf16, WS_BR)[(size_t)(0 * MT + row) * 256 + (c & 255)]) + bflo(WSP(bf16, WS_BR)[(size_t)(2 * MT + row) * 256 + (c & 255)]) + bflo(WSP(bf16, WS_FA)[i % ((size_t)8 << 20)]);
#elif DBG_STOP == 21
        v = bflo(WSP(bf16, WS_T1T)[i % 16384]) * 1.001f + WSP(float, WS_ROPEC)[i % 2048] + WSP(float, WS_ROPES)[i % 2048] + bflo(WSP(bf16, WS_WSP)[i % 65536]);
#elif DBG_STOP == 31 || DBG_STOP == 44
        v = 0.f;
#elif DBG_STOP == 45 || DBG_STOP == 32
        v = 0.f;
#elif DBG_STOP == 41
        v = bflo(WSP(bf16, WS_BR)[(size_t)(0 * MT + row) * 256 + (c & 255)]) * 1.001f + bflo(WSP(bf16, WS_BR)[(size_t)(0 * MT + row) * 256 + ((c + 7) & 255)]);
#elif DBG_STOP == 42
        v = bflo(WSP(bf16, WS_BR)[(size_t)(2 * MT + row) * 256 + (c & 255)]) * 1.001f + bflo(WSP(bf16, WS_BR)[(size_t)(2 * MT + row) * 256 + ((c + 7) & 255)]);
#elif DBG_STOP == 43
        v = bflo(WSP(bf16, WS_FA)[i % ((size_t)8 << 20)]) * 1.001f + bflo(WSP(bf16, WS_FA)[(i + 7) % ((size_t)8 << 20)]);
#elif DBG_STOP == 5
        v = bflo(WSP(bf16, WS_BR)[(size_t)(1 * MT + row) * 256 + (c & 255)]) + bflo(WSP(bf16, WS_BR)[(size_t)(3 * MT + row) * 256 + (c & 255)]);
#elif DBG_STOP == 6
        v = bflo(WSP(bf16, WS_MB)[row * 1024 + c]);
#elif DBG_STOP == 7
        v = WSP(float, WS_X)[row * 1024 + c];
#elif DBG_STOP == 8
        v = bflo(WSP(bf16, WS_H)[row * 1024 + c]) + WSP(float, WS_AFF)[row * 16 + (c & 15)];
#elif DBG_STOP == 9
        v = (float)WSP(int, WS_SEL)[row * 16 + (c & 15)] + WSP(float, WS_GATE)[i % (16 * 2304)] + (float)WSP(int, WS_IDX)[i % (16 * 2304)];
#elif DBG_STOP == 10
        v = bflo(WSP(bf16, WS_XE)[i]) + bflo(WSP(bf16, WS_XE)[i + (size_t)ML * 1024]);
#elif DBG_STOP == 11
        v = bflo(WSP(bf16, WS_ACT)[i]) + bflo(WSP(bf16, WS_ACT)[i + (size_t)ML * 1024]);
#elif DBG_STOP == 12
        v = bflo(WSP(bf16, WS_XE)[i]) + bflo(WSP(bf16, WS_XE)[i + (size_t)ML * 1024]);
#else
        v = WSP(float, WS_X)[row * 1024 + c] + bflo(WSP(bf16, WS_H)[row * 1024 + c]);
#endif
#ifdef DBG_AMP
        v = (float)(__float_as_uint(v) & 0xFFFFu);
#endif
        out[i] = v; }
}
#endif
__global__ void __launch_bounds__(512, 2) mega(Args A) {
    extern __shared__ __attribute__((aligned(16))) unsigned char lds_raw[];
    LAS unsigned char* lds0 = (LAS unsigned char*)lds_raw;
    volatile LAS unsigned* MISC = (volatile LAS unsigned*)(lds0 + MISC_OFF);
    const int tid = threadIdx.x, lane = tid & 63, wave = __builtin_amdgcn_readfirstlane(tid >> 6), bid = blockIdx.x, G = gridDim.x;
    for (int u = tid; u < (LDS_BYTES - MISC_OFF) / 4; u += 512) ((LAS unsigned*)(lds0 + MISC_OFF))[u] = 0u;
    __syncthreads();
    if (tid == 0) { typedef unsigned u2v_t __attribute__((ext_vector_type(2)));
#pragma unroll
        for (int i = 0; i < 30; ++i) { const unsigned long long p = i < 28 ? (unsigned long long)A.in[i] : (i == 28 ? (unsigned long long)A.out : (unsigned long long)A.ws);
            *(LAS u2v_t*)(lds0 + PTAB_OFF + 8 * i) = (u2v_t){(unsigned)p, (unsigned)(p >> 32)}; } }
    __syncthreads();
    const int lo = A.ph_lo, hi = A.ph_hi;
    XcdBarrier bar; bar.bar = (unsigned*)(A.ws + WS_CTL) + CW_BAR; bar.x = 0; bar.st = nullptr;
    if (hi - lo > 1) bar = xcd_barrier_post((unsigned*)(A.ws + WS_CTL) + CW_BAR, MISC + 8);
#define PH_CALL lds, tl_, (tl_ & 63), wv_, bl_, G_
#define PH_CALLV lds, tl_, (tl_ & 63), wv_, vb_, G_
#ifdef TS_I
    if (bid == 0 && tid == 0) ((unsigned long long*)(A.ws + 65536))[lo] = rt();
#endif
#pragma unroll 1
#ifdef REP_PH
    for (int it_ = lo; it_ < hi + (REP_N - 1); ++it_) { const int ph = it_ < REP_PH ? it_ : (it_ < REP_PH + REP_N ? REP_PH : it_ - (REP_N - 1));
#else
    for (int ph = lo; ph < hi; ++ph) {
#endif
        int tl_ = tid; asm volatile("" : "+v"(tl_)); int bl_ = bid; asm volatile("" : "+s"(bl_)); int vb_ = (G % 8 == 0) ? (bid % 8) * (G / 8) + bid / 8 : bid; asm volatile("" : "+s"(vb_)); int wv_ = wave; asm volatile("" : "+s"(wv_)); int G_ = G; asm volatile("" : "+s"(G_)); unsigned ldsb_ = (unsigned)(uintptr_t)lds0; asm volatile("" : "+s"(ldsb_)); LAS unsigned char* lds = (LAS unsigned char*)(uintptr_t)ldsb_;
        const int l = ph < 13 ? 0 : 1, kind = ph >= 99 ? 99 : (ph < 2 ? ph : 2 + (ph - 2 - 11 * l));
        const int ntm = l == 0 ? 66 : 64, tpe = l == 0 ? 9 : 8;
        switch (kind) {
#ifdef DBG_STOP
        case 99: debug_out(PH_CALL); break;
#endif
        case 0: {
#ifndef P0R_MOD
#define P0R_MOD 1
#endif
#ifndef P0R_TAB
#define P0R_TAB 1
#endif
#ifndef P0R_CVT
#define P0R_CVT 1
#endif
#pragma unroll 1
            for (int r_ = 0; r_ < P0R_MOD; ++r_) { mod_gemv(PH_CALL); asm volatile("" ::: "memory"); }
#pragma unroll 1
            for (int r_ = 0; r_ < P0R_TAB; ++r_) { make_tables(PH_CALL); asm volatile("" ::: "memory"); }
#pragma unroll 1
            for (int r_ = 0; r_ < P0R_CVT; ++r_) { convert_weights(PH_CALL, 0); asm volatile("" ::: "memory"); }
        } break;
        case 1: {
#ifndef DIS_N1
            norm1_l0(PH_CALL);
#endif
        } break;
        case 2: {
            pg8::Gemm g{WSP(bf16, WS_H), WSP(bf16, WS_WIN), MT, NIN, 1024}; pg8::StaticOrder S; S.init(MT, NIN, G_, bl_);
            EpiIn E{WSP(bf16, WS_AUV), WSP(bf16, WS_YF), WSP(bf16, WS_CY), WSP(bf16, WS_QPL), WSP(bf16, WS_QROT), WSP(bf16, WS_KR), WSP(bf16, WS_VV), WSP(bf16, WS_G), WSP(float, WS_ROPEC), WSP(float, WS_ROPES)};
#ifndef DIS_GIN
            pg8::gemm_phase<EpiIn, pg8::StaticOrder, true, true>(lds, g, S, E);
#endif
        } break;
        case 3: {
#ifndef DIS_F1
            if (bl_ < 256) { f1_stage_tables(PH_CALL);
#pragma unroll 1
              for (int r_ = 0; r_ < F1_REP; ++r_) for (int u = vb_; u < 256; u += G_) f1_unit(PH_CALL, u); }
#endif
            const int nconv = l == 0 ? 264 : 256, ngm = l == 0 ? 132 : 128;
#ifndef DIS_CONV
#pragma unroll 1
            for (int r_ = 0; r_ < CONV_REP; ++r_) for (int u = vb_; u < nconv; u += G_) conv_unit(PH_CALL, l, u);
#endif
#ifndef DIS_GMLP
#pragma unroll 1
            for (int r_ = 0; r_ < GMLP_REP; ++r_) for (int u = G_ - 1 - vb_; u < ngm; u += G_) gmlp_unit(PH_CALL, l, u);
#endif
#ifndef DIS_CDFT
            if (l == 0) ctx_butterfly(PH_CALL);
#endif
        } break;
        case 4: {
#ifndef DIS_F2
#ifndef F2_REP
#define F2_REP 1
#endif
#ifndef ATT_REP
#define ATT_REP 1
#endif
#pragma unroll 1
            for (int r_ = 0; r_ < F2_REP; ++r_) { const int nf2 = l == 0 ? 264 : 256; for (int u = vb_; u < nf2; u += G_) f2_unit(PH_CALL, u); }
#endif
            { LAS float* rp = (LAS float*)(lds + AT_RPB); const float* src = INP(20) + l * 1860; for (int i = tl_; i < 1860; i += 512) rp[i] = src[i]; }
            __syncthreads();
            const int nat = l == 0 ? 264 : 256;
#ifndef DIS_ATT
#pragma unroll 1
            for (int r_ = 0; r_ < ATT_REP; ++r_) for (int u = vb_; u < nat; u += G_) attn_unit(PH_CALL, u);
#endif
        } break;
        case 5: {
#ifndef DIS_GMRG
#ifndef MERGE_PG8
            merge_phase(PH_CALLV, ntm * 16);
#else
            { pg8::Gemm g{WSP(bf16, WS_BR), WSP(bf16, WS_WBR), 4 * MT, 4096, 256}; MergeOrder S; S.init(ntm, G_, bl_); EpiMergeH E{WSP(bf16, WS_G), WSP(bf16, WS_MB)};
              pg8::gemm_phase<EpiMergeH, MergeOrder, true, true>(lds, g, S, E); }
#endif
#endif
        } break;
        case 6: {
            pg8::Gemm g{WSP(bf16, WS_MB), WSP(bf16, WS_WO), ntm * 256, 1024, 1024}; pg8::StaticOrder S; S.init(ntm * 256, 1024, G_, bl_);
            EpiWout E{l == 0 ? INP(0) : WSP(float, WS_X), l == 0 ? INP(2) : WSP(float, WS_X) + (size_t)ML * 1024, WSP(float, WS_X), WSP(float, WS_MOD) + l * 3 * 6144};
#ifndef DIS_GWO
            pg8::gemm_phase<EpiWout, pg8::StaticOrder, true, true>(lds, g, S, E);
#endif
        } break;
        case 7: {
#ifndef DIS_N2
            norm2_router(PH_CALL, l, ntm * 256);
#endif
        } break;
        case 8: {
#ifndef DIS_TOPK
            const int nun = l == 0 ? 64 : 32;
            for (int u = bl_; u < nun; u += G_) {
                if (u < 32) { const int b = u >> 4, e = u & 15; topk_unit<16, true>(PH_CALL, b * SEQ, SEQ, CAPL, e, b * CAPL, l == 0 && b == 0); }
                else { const int b = (u - 32) >> 4, e = u & 15; topk_unit<1, false>(PH_CALL, ML + b * CTXL, CTXL, CAPC, e, 2048 + b * CAPC, false); }
            }
#endif
        } break;
        case 9: {
#ifndef DIS_GATH
            gather_rows(PH_CALL, tpe);
#endif
        } break;
        case 10: {
            pg8::Gemm g{WSP(bf16, WS_XE), WSP(bf16, WS_WGU), NE * ESTR, NE * 2048, 1024}; GroupOrder S; S.init(tpe, 8, G_, bl_);
            EpiGU E{WSP(bf16, WS_ACT)};
#ifndef DIS_GGU
            pg8::gemm_phase<EpiGU, GroupOrder, true, true>(lds, g, S, E);
#endif
        } break;
        case 11: {
            pg8::Gemm g{WSP(bf16, WS_ACT), WSP(bf16, WS_WDN), NE * ESTR, NE * 1024, 1024}; GroupOrder S; S.init(tpe, 4, G_, bl_);
            EpiDown E{WSP(bf16, WS_XE), WSP(float, WS_GATE)};
#ifndef DIS_GDN
            pg8::gemm_phase<EpiDown, GroupOrder, true, true>(lds, g, S, E);
#endif
        } break;
        default: {
#ifndef DIS_COMB
            combine_rows(PH_CALL, l);
#endif
#ifndef DIS_CVT
            if (l == 0) convert_weights(PH_CALL, 1);
#endif
        } break;
        }
#ifdef TS_I
        { XcdBarrier b3 = bar; b3.bar = (unsigned*)(PTRV(29, unsigned char) + WS_CTL) + CW_BAR; b3.st = (volatile LAS unsigned*)(lds + MISC_OFF) + 8; xcd_barrier(b3);
          if (bid == 0 && tid == 0) ((unsigned long long*)(PTRV(29, unsigned char) + 65536))[ph + 1] = rt(); }
        if (ph + 1 == hi) { XcdBarrier b3 = bar; b3.bar = (unsigned*)(PTRV(29, unsigned char) + WS_CTL) + CW_BAR; b3.st = (volatile LAS unsigned*)(lds + MISC_OFF) + 8; xcd_barrier(b3);
            const unsigned long long* TS = (const unsigned long long*)(PTRV(29, unsigned char) + 65536);
            const float dti = (float)(TS[TS_I + 1] - TS[TS_I]) * 0.01f, dtj = (float)(TS[TS_J + 1] - TS[TS_J]) * 0.01f;
            float* out = PTRV(28, float); const float Av = sqrtf(dti);
            for (size_t i = (size_t)bid * 512 + tid; i < (size_t)ML * 1024; i += (size_t)G * 512) out[i] = (i == 0) ? dtj * 10.f : Av; }
        if (0) {
#else
#ifdef REP_PH
        if (it_ + 1 < hi + (REP_N - 1)) {
#else
        if (ph + 1 < hi) {
#endif
#endif
          XcdBarrier b2 = bar; b2.bar = (unsigned*)(PTRV(29, unsigned char) + WS_CTL) + CW_BAR; unsigned bx_ = bar.x; asm volatile("" : "+s"(bx_)); b2.x = bx_; b2.st = (volatile LAS unsigned*)(lds + MISC_OFF) + 8; xcd_barrier(b2); }
    }
}

extern "C" void kernel_launch(void* const* d_in, const int* in_sizes, int n_in, void* d_out, int out_size, void* d_ws, size_t ws_size, hipStream_t stream) {
    static int grid = 0;
    if (grid == 0) {
        if (n_in != 28 || ws_size < WS_END) { fprintf(stderr, "kernel_launch: unexpected n_in %d / ws %zu\n", n_in, ws_size); grid = -1; return; }
        int dev = 0, cus = 0;
        if (hipGetDevice(&dev) != hipSuccess || hipDeviceGetAttribute(&cus, hipDeviceAttributeMultiprocessorCount, dev) != hipSuccess) { grid = -1; return; }
        if (hipFuncSetAttribute((const void*)mega, hipFuncAttributeMaxDynamicSharedMemorySize, LDS_BYTES) != hipSuccess) { fprintf(stderr, "kernel_launch: hipFuncSetAttribute failed\n"); grid = -1; return; }
        (void)hipGetLastError();
        grid = cus;
    }
    if (grid < 0) return;
    (void)hipMemsetAsync((char*)d_ws + WS_CTL, 0, CTL_ZERO_BYTES, stream);
    Args a{};
    for (int i = 0; i < 28; ++i) a.in[i] = (const float*)d_in[i];
    a.out = (float*)d_out; a.ws = (unsigned char*)d_ws;
#ifdef DBG_STOP
    for (int p = 0; p < (DBG_STOP > 20 ? DBG_STOP / 10 : DBG_STOP); ++p) { a.ph_lo = p; a.ph_hi = p + 1; hipLaunchKernelGGL(mega, dim3(grid), dim3(512), LDS_BYTES, stream, a); }
    a.ph_lo = 99; a.ph_hi = 100; hipLaunchKernelGGL(mega, dim3(grid), dim3(512), LDS_BYTES, stream, a);
#elif N_LAUNCHES == 1
    a.ph_lo = 0; a.ph_hi = NPH;
    hipLaunchKernelGGL(mega, dim3(grid), dim3(512), LDS_BYTES, stream, a);
#else
    for (int p = 0; p < NPH; ++p) { a.ph_lo = p; a.ph_hi = p + 1; hipLaunchKernelGGL(mega, dim3(grid), dim3(512), LDS_BYTES, stream, a); }
#endif
}
```

```cpp
#include <hip/hip_runtime.h>
#include <cstdio>
#include <cstdint>
#define N_LAUNCHES 1
namespace pg8 {
#define PG8_LAS __attribute__((address_space(3)))
typedef unsigned short bf16_t;
typedef short bf16x8 __attribute__((ext_vector_type(8)));
typedef float f32x4 __attribute__((ext_vector_type(4)));
typedef unsigned u32x4 __attribute__((ext_vector_type(4)));
constexpr int BM = 256, BK = 64, HALF = 128, HTB = HALF * BK * 2  , STAGE_BYTES = 8 * HTB, NXCD = 8, WGM = 8;

__host__ __device__ __forceinline__ int lds_byte(int r, int c) { const int st = (r >> 4) * 2 + (c >> 5), rr = r & 15, cc = c & 31, ob = rr * 64 + cc * 2; return st * 1024 + (ob ^ (((ob >> 9) & 1) << 5)); }
__host__ __device__ __forceinline__ void stage_rc(int b, int& R, int& C) { const int st = b / 1024, sb = b % 1024, swz = sb ^ (((sb >> 9) & 1) << 5); R = (st >> 1) * 16 + swz / 64; C = (st & 1) * 32 + (swz % 64) / 2; }
__host__ __device__ __forceinline__ int perm32(int rho) { const int n = rho >> 4, i = rho & 15; return 8 * (i >> 2) + 4 * n + (i & 3); }

struct Unit { int pm, pn; };
struct Gemm { const bf16_t* A; const bf16_t* Bt; int M, N, K; const int* gidx = nullptr; };

struct StaticOrder {
    int nM, nN, nwg, G, c;
    __host__ __device__ void init(int M, int N, int G_, int c_) { nM = M / BM; nN = N / BM; nwg = nM * nN; G = G_; c = c_; }
    __host__ __device__ bool next(int i, Unit& u) const {
        const long L = (long)i * G + c; if (L >= nwg) return false;
        int wgid = (int)L; { const int q = nwg / NXCD, r = nwg % NXCD, xcd = wgid % NXCD, off = wgid / NXCD; wgid = (xcd < r ? xcd * (q + 1) : r * (q + 1) + (xcd - r) * q) + off; }
        const int nig = WGM * nN, gid = wgid / nig, fm = gid * WGM, gsz = (nM - fm) < WGM ? (nM - fm) : WGM;
        u.pm = fm + ((wgid % nig) % gsz); u.pn = (wgid % nig) / gsz; return true;
    }
    __device__ __forceinline__ void a_ready(const Unit&) const {}
    __device__ __forceinline__ void done(const Unit&) const {}
};
__device__ __forceinline__ unsigned cvt_pk_bf16(float lo, float hi) { unsigned r; asm volatile("v_cvt_pk_bf16_f32 %0, %1, %2" : "=v"(r) : "v"(lo), "v"(hi)); return r; }
typedef float f32x2 __attribute__((ext_vector_type(2)));
template <class Epi, class Sched, bool ALIGN_EPI = false, bool SP2 = false, bool GATHER = false>
__device__ __forceinline__ void gemm_phase(PG8_LAS unsigned char* lds, const Gemm g, const Sched& S, const Epi& E) {
    int tid_l = threadIdx.x; asm volatile("" : "+v"(tid_l));
    const int tid = tid_l, wid = __builtin_amdgcn_readfirstlane(tid >> 6), lane = tid & 63, wr = wid >> 2, wc = wid & 3, fr = lane & 15, fq = lane >> 4;
    const int K = g.K, nt = K / BK;
    unsigned voffA[2], voffB[2];
#pragma unroll
    for (int i = 0; i < 2; ++i) { int R, C; stage_rc(tid * 16 + i * 8192, R, C); const int Rb = Epi::PERM ? ((R & ~31) + perm32(R & 31)) : R;
        voffA[i] = (unsigned)(R * K + C) * 2u; voffB[i] = (unsigned)(Rb * K + C) * 2u; }
    const size_t kstep = (size_t)(BK * 2);
    const size_t hstep = (size_t)HALF * K * 2;
    const size_t tstep = 2 * hstep;
    const unsigned ldsw = (unsigned)wid * 1024u;
    const int aoff = lds_byte(wr * 64 + fr, fq * 8), boff = lds_byte(wc * 32 + fr, fq * 8);
#define PG8_SA(b, h) (((b) * 2 + (h)) * HTB)
#define PG8_SB(b, h) ((4 + (b) * 2 + (h)) * HTB)
#define PG8_STAGE(bufoff, gbase, voff) do { _Pragma("unroll") for (int _i = 0; _i < 2; ++_i) \
        __builtin_amdgcn_global_load_lds((const unsigned*)((const char*)(gbase) + (voff)[_i]), (PG8_LAS unsigned*)(lds + (bufoff) + ldsw + _i * 8192), 16, 0, 0); } while (0)
    static_assert(!GATHER || SP2, "GATHER is implemented on the SP2 loop only");
    unsigned vgc[2][2] = {{0u, 0u}, {0u, 0u}}, vgn[2][2] = {{0u, 0u}, {0u, 0u}};
#define PG8_GLOAD(u, v) do { _Pragma("unroll") for (int _h = 0; _h < 2; ++_h) _Pragma("unroll") for (int _i = 0; _i < 2; ++_i) { int R_, C_; stage_rc(tid * 16 + _i * 8192, R_, C_); \
        v[_h][_i] = (unsigned)(g.gidx[(u).pm * BM + _h * HALF + R_] * K + C_) * 2u; } } while (0)
#define PG8_STAGE_A(bufoff, base, half, NEXT) do { if constexpr (GATHER) { if (NEXT) PG8_STAGE(bufoff, base, vgn[half]); else PG8_STAGE(bufoff, base, vgc[half]); } \
        else PG8_STAGE(bufoff, (base) + (half) * hstep, voffA); } while (0)
#define PG8_LDA(dst, b, h) do { _Pragma("unroll") for (int m = 0; m < 4; ++m) _Pragma("unroll") for (int k = 0; k < 2; ++k) dst[m][k] = *(const PG8_LAS bf16x8*)(lds + PG8_SA(b, h) + aoff + m * 2048 + k * 1024); } while (0)
#define PG8_LDB(dst, b, h) do { _Pragma("unroll") for (int n = 0; n < 2; ++n) _Pragma("unroll") for (int k = 0; k < 2; ++k) dst[n][k] = *(const PG8_LAS bf16x8*)(lds + PG8_SB(b, h) + boff + n * 2048 + k * 1024); } while (0)
#define PG8_MMA(ai, bj, At, Bt) do { __builtin_amdgcn_s_setprio(1); _Pragma("unroll") for (int m = 0; m < 4; ++m) _Pragma("unroll") for (int n = 0; n < 2; ++n) _Pragma("unroll") for (int k = 0; k < 2; ++k) \
        acc[ai][bj][m][n] = __builtin_amdgcn_mfma_f32_16x16x32_bf16(Bt[n][k], At[m][k], acc[ai][bj][m][n], 0, 0, 0); __builtin_amdgcn_s_setprio(0); } while (0)
#define PG8_WAIT_V(n) asm volatile("s_waitcnt vmcnt(" #n ")" ::: "memory")
#define PG8_WAIT_L(n) asm volatile("s_waitcnt lgkmcnt(" #n ")" ::: "memory")
#define PG8_BAR __builtin_amdgcn_s_barrier()
#define PG8_SCHED __builtin_amdgcn_sched_barrier(0)
    Unit cur, nxt; int ui = 0;
    if (!S.next(0, cur)) return;
    f32x4 acc[2][2][4][2];
#pragma unroll
    for (int a = 0; a < 2; ++a)
#pragma unroll
        for (int b = 0; b < 2; ++b)
#pragma unroll
            for (int m = 0; m < 4; ++m)
#pragma unroll
                for (int n = 0; n < 2; ++n) acc[a][b][m][n] = (f32x4){0.f, 0.f, 0.f, 0.f};
    bf16x8 At[4][2], B0[2][2], B1[2][2];
    const char* cA = GATHER ? (const char*)g.A : (const char*)g.A + (size_t)cur.pm * tstep; const char* cB = (const char*)g.Bt + (size_t)cur.pn * tstep;
    if constexpr (GATHER) { PG8_GLOAD(cur, vgc); }
    S.a_ready(cur);
    if constexpr (SP2) {
        PG8_STAGE(PG8_SB(0, 0), cB, voffB); PG8_STAGE(PG8_SB(0, 1), cB + hstep, voffB); PG8_STAGE_A(PG8_SA(0, 0), cA, 0, false); PG8_STAGE_A(PG8_SA(0, 1), cA, 1, false);
        if (wr == 1) PG8_BAR;
        PG8_WAIT_V(2); PG8_BAR;
        PG8_STAGE(PG8_SB(1, 0), cB + kstep, voffB); PG8_STAGE_A(PG8_SA(1, 0), cA + kstep, 0, false); PG8_STAGE(PG8_SB(1, 1), cB + hstep + kstep, voffB);
        PG8_WAIT_V(6); PG8_BAR;
    } else {
        PG8_STAGE(PG8_SB(0, 0), cB, voffB); PG8_STAGE(PG8_SA(0, 0), cA, voffA); PG8_STAGE(PG8_SB(0, 1), cB + hstep, voffB); PG8_STAGE(PG8_SA(0, 1), cA + hstep, voffA);
        if (wr == 1) PG8_BAR;
        PG8_WAIT_V(4); PG8_BAR;
        PG8_STAGE(PG8_SB(1, 0), cB + kstep, voffB); PG8_STAGE(PG8_SA(1, 0), cA + kstep, voffA); PG8_STAGE(PG8_SB(1, 1), cB + hstep + kstep, voffB);
        PG8_WAIT_V(6); PG8_BAR;
    }
    for (;;) {
        const bool has_next = S.next(ui + 1, nxt);
        const char* nA = GATHER ? (const char*)g.A : (has_next ? (const char*)g.A + (size_t)nxt.pm * tstep : cA);
        if constexpr (GATHER) { if (has_next) { PG8_GLOAD(nxt, vgn); } else { _Pragma("unroll") for (int _h = 0; _h < 2; ++_h) _Pragma("unroll") for (int _i = 0; _i < 2; ++_i) vgn[_h][_i] = vgc[_h][_i]; } } const char* nB = has_next ? (const char*)g.Bt + (size_t)nxt.pn * tstep : cB;
#pragma unroll 1
        for (int t = 0; t < nt; t += 2) {
            const bool last = (t == nt - 2);
            const char* a1 = cA + (size_t)(t + 1) * kstep;
            const char* a2 = last ? nA : cA + (size_t)(t + 2) * kstep; const char* b2 = last ? nB : cB + (size_t)(t + 2) * kstep;
            const char* a3 = a2 + kstep; const char* b3 = b2 + kstep;
            if (last && has_next) S.a_ready(nxt);
            if constexpr (SP2) {
            PG8_LDB(B0, 0, 0); PG8_LDB(B1, 0, 1); PG8_SCHED; PG8_LDA(At, 0, 0); PG8_STAGE_A(PG8_SA(1, 1), a1, 1, false);
            PG8_WAIT_V(8); PG8_WAIT_L(0); PG8_BAR; PG8_MMA(0, 0, At, B0); PG8_MMA(0, 1, At, B1); PG8_BAR; PG8_SCHED;
            PG8_LDA(At, 0, 1); PG8_STAGE(PG8_SB(0, 0), b2, voffB); PG8_STAGE(PG8_SB(0, 1), b2 + hstep, voffB); PG8_STAGE_A(PG8_SA(0, 0), a2, 0, last);
            PG8_WAIT_V(8); PG8_WAIT_L(0); PG8_BAR; PG8_MMA(1, 0, At, B0); PG8_MMA(1, 1, At, B1); PG8_BAR; PG8_SCHED;
            PG8_LDB(B0, 1, 0); PG8_LDB(B1, 1, 1); PG8_SCHED; PG8_LDA(At, 1, 0); PG8_STAGE_A(PG8_SA(0, 1), a2, 1, last);
            PG8_WAIT_V(8); PG8_WAIT_L(0); PG8_BAR; PG8_MMA(0, 0, At, B0); PG8_MMA(0, 1, At, B1); PG8_BAR; PG8_SCHED;
            PG8_LDA(At, 1, 1); PG8_STAGE(PG8_SB(1, 0), b3, voffB); PG8_STAGE(PG8_SB(1, 1), b3 + hstep, voffB); PG8_STAGE_A(PG8_SA(1, 0), a3, 0, last);
            PG8_WAIT_V(8); PG8_WAIT_L(0); PG8_BAR; PG8_MMA(1, 0, At, B0); PG8_MMA(1, 1, At, B1); PG8_BAR; PG8_SCHED;
            } else {
            PG8_LDB(B0, 0, 0); PG8_SCHED; PG8_LDA(At, 0, 0); PG8_STAGE(PG8_SA(1, 1), a1 + hstep, voffA);
            PG8_WAIT_L(8); PG8_BAR; PG8_WAIT_L(0); PG8_MMA(0, 0, At, B0); PG8_BAR; PG8_SCHED;
            PG8_LDB(B1, 0, 1); PG8_STAGE(PG8_SB(0, 0), b2, voffB);
            PG8_BAR; PG8_WAIT_L(0); PG8_MMA(0, 1, At, B1); PG8_BAR;
            PG8_LDA(At, 0, 1); PG8_STAGE(PG8_SA(0, 0), a2, voffA);
            PG8_BAR; PG8_WAIT_L(0); PG8_MMA(1, 0, At, B0); PG8_BAR; PG8_SCHED;
            PG8_STAGE(PG8_SB(0, 1), b2 + hstep, voffB);
            PG8_WAIT_V(6); PG8_BAR; PG8_MMA(1, 1, At, B1); PG8_BAR;
            PG8_LDB(B0, 1, 0); PG8_SCHED; PG8_LDA(At, 1, 0); PG8_STAGE(PG8_SA(0, 1), a2 + hstep, voffA);
            PG8_WAIT_L(8); PG8_BAR; PG8_WAIT_L(0); PG8_MMA(0, 0, At, B0); PG8_BAR; PG8_SCHED;
            PG8_LDB(B1, 1, 1); PG8_STAGE(PG8_SB(1, 0), b3, voffB);
            PG8_BAR; PG8_WAIT_L(0); PG8_MMA(0, 1, At, B1); PG8_BAR;
            PG8_LDA(At, 1, 1); PG8_STAGE(PG8_SA(1, 0), a3, voffA);
            PG8_BAR; PG8_WAIT_L(0); PG8_MMA(1, 0, At, B0); PG8_BAR; PG8_SCHED;
            PG8_STAGE(PG8_SB(1, 1), b3 + hstep, voffB);
            PG8_WAIT_V(6); PG8_BAR; PG8_MMA(1, 1, At, B1); PG8_BAR;
            }
        }
        if constexpr (ALIGN_EPI) { if (wr == 0) PG8_BAR; }
        if constexpr (!Epi::AFTER_DRAIN) { int t2_ = threadIdx.x; asm volatile("" : "+v"(t2_)); E(acc, cur, wr, wc, t2_ & 15, (t2_ >> 4) & 3); S.done(cur); }
        if (!has_next) break;
        bool keep_ = false; if constexpr (Epi::KEEP) keep_ = E.keep(cur);
        if (!keep_) {
#pragma unroll
        for (int a = 0; a < 2; ++a)
#pragma unroll
            for (int b = 0; b < 2; ++b)
#pragma unroll
                for (int m = 0; m < 4; ++m)
#pragma unroll
                    for (int n = 0; n < 2; ++n) acc[a][b][m][n] = (f32x4){0.f, 0.f, 0.f, 0.f};
        }
        cur = nxt; cA = nA; cB = nB; ++ui;
        if constexpr (GATHER) { _Pragma("unroll") for (int _h = 0; _h < 2; ++_h) _Pragma("unroll") for (int _i = 0; _i < 2; ++_i) vgc[_h][_i] = vgn[_h][_i]; }
        if constexpr (ALIGN_EPI) { if (wr == 1) PG8_BAR; }
    }
    PG8_WAIT_V(0);
    if constexpr (!ALIGN_EPI) { if (wr == 0) PG8_BAR; }
    PG8_BAR;
    if constexpr (Epi::AFTER_DRAIN) { E.fused(acc, cur, wr, wc, fr, fq, lds, wid, lane); S.done(cur); }
#undef PG8_SA
#undef PG8_SB
#undef PG8_STAGE
#undef PG8_STAGE_A
#undef PG8_GLOAD
#undef PG8_LDA
#undef PG8_LDB
#undef PG8_MMA
#undef PG8_WAIT_V
#undef PG8_WAIT_L
#undef PG8_BAR
#undef PG8_SCHED
}
}
#define GAS __attribute__((address_space(1)))
#define LAS __attribute__((address_space(3)))
typedef unsigned short bf16;
typedef unsigned v4u __attribute__((ext_vector_type(4)));
typedef float f32x4 __attribute__((ext_vector_type(4)));
typedef short bf16x8 __attribute__((ext_vector_type(8)));
typedef GAS unsigned gu32;
typedef GAS unsigned long long gu64;
#define RLX_AGENT __ATOMIC_RELAXED, __HIP_MEMORY_SCOPE_AGENT
#define LDS_WAIT() asm volatile("s_waitcnt lgkmcnt(0)" ::: "memory")
#define VM_WAIT() asm volatile("s_waitcnt vmcnt(0)" ::: "memory")
__device__ __forceinline__ unsigned long long rt() { return __builtin_amdgcn_s_memrealtime(); }
__device__ __forceinline__ unsigned f2bf(float f) { unsigned u = __builtin_bit_cast(unsigned, f); return (u + 0x7fffu + ((u >> 16) & 1u)) >> 16; }
typedef float f32x2_t __attribute__((ext_vector_type(2))); typedef __bf16 bf16x2_t __attribute__((ext_vector_type(2)));
__device__ __forceinline__ unsigned pk2(float lo, float hi) { const f32x2_t v = {lo, hi}; const bf16x2_t b = __builtin_convertvector(v, bf16x2_t); return __builtin_bit_cast(unsigned, b); }

#define XB_TMO      128
#define XB_XCNT(j)  (256  + 64 * (j))
#define XB_XSUB(j)  (1280 + 64 * (j))
#define XB_XGEN(j)  (2304 + 64 * (j))
#define XB_TOP      3328
#define XB_TOPGEN   3392
#define XCD_BAR_WORDS 3456
#define XB_SPIN_CAP (1u << 18)

__device__ __forceinline__ unsigned xb_ld(unsigned* p)              { return __hip_atomic_load(p, __ATOMIC_RELAXED, __HIP_MEMORY_SCOPE_AGENT); }
__device__ __forceinline__ unsigned xb_add(unsigned* p, unsigned v) { return __hip_atomic_fetch_add(p, v, __ATOMIC_RELAXED, __HIP_MEMORY_SCOPE_AGENT); }
__device__ __forceinline__ unsigned xb_xcc_id() { return (unsigned)__builtin_amdgcn_s_getreg((3 << 11) | 20) & 0xFu; }
#define XB_SPIN(cond, bar) do { unsigned _sp = 0; while (cond) { __builtin_amdgcn_s_sleep(1); \
    if ((++_sp & 255u) == 0u) { if (xb_ld(&(bar)[XB_TMO])) break; if (_sp > XB_SPIN_CAP) { atomicAdd(&(bar)[XB_TMO], 1u); break; } } } } while (0)

struct XcdBarrier {
    unsigned* bar; unsigned x;
    volatile LAS unsigned* st;
};

__device__ __forceinline__ XcdBarrier xcd_barrier_post(unsigned* bar, volatile LAS unsigned* st) {
    XcdBarrier b; b.bar = bar; b.x = xb_xcc_id(); b.st = st;
    if (threadIdx.x == 0) (void)xb_add(&bar[XB_XCNT(b.x)], 1u);
    return b;
}
__device__ __forceinline__ void xcd_barrier_complete(unsigned* bar, unsigned x, unsigned& nloc, unsigned& nx) {
    const unsigned G = gridDim.x * gridDim.y * gridDim.z;
    unsigned sum, cnt, mine, sp = 0u;
    for (;;) {
        sum = 0u; cnt = 0u; mine = 0u;
#pragma unroll
        for (unsigned j = 0; j < 16; ++j) { const unsigned c = xb_ld(&bar[XB_XCNT(j)]); sum += c; cnt += (c > 0u) ? 1u : 0u; mine = (j == x) ? c : mine; }
        if (sum == G) break;
        __builtin_amdgcn_s_sleep(1);
        if ((++sp & 255u) == 0u) { if (xb_ld(&bar[XB_TMO])) break; if (sp > XB_SPIN_CAP) { atomicAdd(&bar[XB_TMO], 1u); break; } }
    }
    nloc = mine > 0u ? mine : 1u; nx = cnt > 0u ? cnt : 1u;
}

__device__ __forceinline__ void xcd_barrier(const XcdBarrier& b) {
    asm volatile("s_waitcnt vmcnt(0)" ::: "memory");
    __syncthreads();
    if (threadIdx.x == 0) {
        unsigned* bar = b.bar;
        __builtin_amdgcn_s_waitcnt(0);
        unsigned nloc = b.st[0], nx = b.st[1];
        if (nloc == 0u) { xcd_barrier_complete(bar, b.x, nloc, nx); b.st[0] = nloc; b.st[1] = nx; }
        const unsigned old = xb_add(&bar[XB_XSUB(b.x)], 1u);
        const unsigned gen = old / nloc;
        if (old + 1u == (gen + 1u) * nloc) {
            __builtin_amdgcn_fence(__ATOMIC_RELEASE, "agent");
            asm volatile("s_waitcnt vmcnt(0)" ::: "memory");
            const unsigned og = xb_add(&bar[XB_TOP], 1u);
            const unsigned tg = og / nx;
            if (og + 1u == (tg + 1u) * nx) xb_add(&bar[XB_TOPGEN], 1u);
            else XB_SPIN(xb_ld(&bar[XB_TOPGEN]) == tg, bar);
            __builtin_amdgcn_fence(__ATOMIC_ACQUIRE, "agent");
            xb_add(&bar[XB_XGEN(b.x)], 1u);
            asm volatile("s_waitcnt vmcnt(0)" ::: "memory");
        } else {
            XB_SPIN(xb_ld(&bar[XB_XGEN(b.x)]) == gen, bar);
            __builtin_amdgcn_fence(__ATOMIC_ACQUIRE, "agent");
            asm volatile("s_waitcnt vmcnt(0)" ::: "memory");
        }
    }
    __syncthreads();
}
constexpr int DM = 1024, SEQ = 8192, NBATCH = 2, CTXL = 256;
constexpr int ML = NBATCH * SEQ, MC = NBATCH * CTXL, MT = ML + MC;
constexpr int NIN = 6400;
constexpr int NE = 16, ESTR = 2304, CAPL = 1024, CAPC = 32;
constexpr int NPH = 24;
constexpr size_t MiB = 1u << 20;
constexpr size_t WS_CTL = 0, CTL_ZERO_BYTES = 1 * MiB;
constexpr size_t WS_MOD = 1 * MiB;
constexpr size_t WS_ROPEC = 1 * MiB + 256 * 1024, WS_ROPES = WS_ROPEC + 8192;
constexpr size_t WS_TW = 1 * MiB + 512 * 1024;
constexpr size_t WS_CS256 = 1 * MiB + 640 * 1024;
constexpr size_t WS_T1T = 2 * MiB;
constexpr size_t WS_T2T = 2 * MiB + 64 * 1024;
constexpr size_t WS_T2F = 8 * MiB;
constexpr size_t WS_T2C = 12 * MiB;
constexpr size_t WS_FAC = 13 * MiB;
constexpr size_t WS_WSP = 2 * MiB + 256 * 1024;
constexpr size_t WS_AFF = 3 * MiB;
constexpr size_t WS_SEL = 5 * MiB;
constexpr size_t WS_IDX = 7 * MiB, WS_GATE = 7 * MiB + 256 * 1024;
constexpr size_t WS_WIN = 16 * MiB, WS_WBR = 29 * MiB, WS_WO = 31 * MiB, WS_WGU = 33 * MiB, WS_WDN = 97 * MiB;
constexpr size_t WS_X = 130 * MiB;
constexpr size_t WS_H = 196 * MiB;
constexpr size_t WS_BR = 229 * MiB;
constexpr size_t WS_MB = 262 * MiB;
constexpr size_t WS_FA = 295 * MiB;
constexpr size_t WS_Z = 311 * MiB;
constexpr size_t ZROW = (size_t)MT * 2;
constexpr size_t WS_AUV = WS_Z, WS_YF = WS_AUV + 512 * ZROW, WS_CY = WS_YF + 512 * ZROW, WS_QPL = WS_CY + 256 * ZROW, WS_QROT = WS_QPL + 256 * ZROW,
                 WS_KR = WS_QROT + 256 * ZROW, WS_VV = WS_KR + 256 * ZROW, WS_G = WS_VV + 256 * ZROW, WS_ZEND = WS_G + 4096 * ZROW;
constexpr size_t WS_P32 = WS_Z;
constexpr size_t WS_XE = WS_Z, WS_ACT = WS_Z + 72 * MiB;
constexpr size_t WS_END = 518 * MiB;
static_assert(WS_G == WS_P32 + (size_t)MT * 1024 * 4 + 8 * 256 * ZROW / 8 - 256 * ZROW || true, "");
static_assert(WS_ZEND <= WS_END && WS_ACT + 72 * MiB <= WS_ZEND && WS_P32 + (size_t)MT * 4096 <= WS_VV, "ws map");
constexpr int CW_BAR = 4096;
constexpr int LDS_BYTES = 155648, MISC_OFF = 154624;

struct Args { const float* in[28]; float* out; unsigned char* ws; int ph_lo, ph_hi; };

__device__ __forceinline__ float bflo(unsigned w) { return __uint_as_float(w << 16); }
__device__ __forceinline__ float bfhi(unsigned w) { return __uint_as_float(w & 0xffff0000u); }
__device__ __forceinline__ float sigm(float x) { return __builtin_amdgcn_rcpf(1.f + __expf(-x)); }
__device__ __forceinline__ float wave_sum(float v) {
#pragma unroll
    for (int o = 1; o < 64; o <<= 1) v += __shfl_xor(v, o);
    return v;
}
__device__ __forceinline__ void st4bf(bf16* p, f32x4 v) { uint2 w; w.x = pk2(v[0], v[1]); w.y = pk2(v[2], v[3]); *(uint2*)p = w; }

__device__ __forceinline__ void st8bf(bf16* p, f32x4 a, f32x4 b) { v4u w; w.x = pk2(a[0], a[1]); w.y = pk2(a[2], a[3]); w.z = pk2(b[0], b[1]); w.w = pk2(b[2], b[3]); *(v4u*)p = w; }
using pg8::Unit;
struct EpiIn {
    static constexpr bool PERM = false, AFTER_DRAIN = false, KEEP = false;
    bf16 *AUV, *YF, *CY, *QPL, *QROT, *KR, *VV, *G; const float* ropeC; const float* ropeS;
    __device__ __forceinline__ void operator()(const f32x4 (&acc)[2][2][4][2], const Unit& u, int wr, int wc, int fr, int fq) const {
        const int pn = u.pn, row0 = u.pm * 256 + wr * 64 + fr, cl0 = wc * 32 + 4 * fq;
        const int cp0 = wc * 32 + 8 * fq;
        if (pn < 2) {
#pragma unroll
            for (int ai = 0; ai < 2; ++ai)
#pragma unroll
                for (int m = 0; m < 4; ++m) { const size_t row = row0 + ai * 128 + m * 16;
#pragma unroll
                    for (int bj = 0; bj < 2; ++bj) { f32x4 v[2];
#pragma unroll
                        for (int n = 0; n < 2; ++n)
#pragma unroll
                            for (int j = 0; j < 4; ++j) { const float x = acc[ai][bj][m][n][j]; v[n][j] = x * sigm(1.5957691216f * (x + 0.044715f * x * x * x)); }
                        st8bf(AUV + row * 512 + pn * 256 + bj * 128 + cp0, v[0], v[1]); } }
        } else if (pn < 4) {
#pragma unroll
            for (int ai = 0; ai < 2; ++ai)
#pragma unroll
                for (int m = 0; m < 4; ++m) { const size_t row = row0 + ai * 128 + m * 16;
#pragma unroll
                    for (int bj = 0; bj < 2; ++bj) st8bf(YF + row * 512 + (pn - 2) * 256 + bj * 128 + cp0, acc[ai][bj][m][0], acc[ai][bj][m][1]); }
        } else if (pn < 6) {
#pragma unroll
            for (int ai = 0; ai < 2; ++ai)
#pragma unroll
                for (int m = 0; m < 4; ++m) { const size_t row = row0 + ai * 128 + m * 16; f32x4 v[2];
#pragma unroll
                    for (int n = 0; n < 2; ++n) { const f32x4 a = acc[ai][0][m][n], g = acc[ai][1][m][n];
#pragma unroll
                        for (int j = 0; j < 4; ++j) v[n][j] = a[j] * sigm(g[j]); }
                    st8bf(CY + row * 256 + (pn - 4) * 128 + cp0, v[0], v[1]); }
        } else if (pn < 8) {
            const bool isq = pn == 6; const float scl = isq ? 0.125f : 1.f; const bool latent = u.pm < 64;
#pragma unroll
            for (int ai = 0; ai < 2; ++ai)
#pragma unroll
                for (int m = 0; m < 4; ++m) { const int rowi = row0 + ai * 128 + m * 16; const size_t row = rowi; const int tok = rowi & 8191;
                    const int pos = (wc & 1) ? (tok & 63) : (tok >> 6);
                    f32x4 cs = {1.f, 1.f, 1.f, 1.f}, sn = {0.f, 0.f, 0.f, 0.f};
                    if (latent) { cs = *(const f32x4*)(ropeC + pos * 16 + 4 * fq); sn = *(const f32x4*)(ropeS + pos * 16 + 4 * fq); }
#pragma unroll
                    for (int bj = 0; bj < 2; ++bj) { const f32x4 x1 = acc[ai][bj][m][0] * scl, x2 = acc[ai][bj][m][1] * scl;
                        const f32x4 r1 = x1 * cs - x2 * sn, r2 = x1 * sn + x2 * cs; const size_t off = row * 256 + bj * 128 + cl0;
                        if (isq) { st4bf(QPL + off, x1); st4bf(QPL + off + 16, x2); st4bf(QROT + off, r1); st4bf(QROT + off + 16, r2); }
                        else { st4bf(KR + off, r1); st4bf(KR + off + 16, r2); } } }
        } else if (pn == 8) {
#pragma unroll
            for (int ai = 0; ai < 2; ++ai)
#pragma unroll
                for (int m = 0; m < 4; ++m) { const size_t row = row0 + ai * 128 + m * 16;
#pragma unroll
                    for (int bj = 0; bj < 2; ++bj) st8bf(VV + row * 256 + bj * 128 + cp0, acc[ai][bj][m][0], acc[ai][bj][m][1]); }
        } else {
#pragma unroll
            for (int ai = 0; ai < 2; ++ai)
#pragma unroll
                for (int m = 0; m < 4; ++m) { const size_t row = row0 + ai * 128 + m * 16;
#pragma unroll
                    for (int bj = 0; bj < 2; ++bj)
#pragma unroll
                        for (int n = 0; n < 2; ++n) { f32x4 v = acc[ai][bj][m][n];
#pragma unroll
                            for (int j = 0; j < 4; ++j) v[j] = sigm(v[j]);
                            const int gb_ = (pn - 9) >> 2, gu_ = (2 * u.pm + ai) * 8 + 2 * ((pn - 9) & 3) + bj;
                            st4bf(G + ((((size_t)(gu_ * 4 + gb_) * 8 + (wr * 4 + wc)) * 8 + m * 2 + n) * 256 + (fq * 16 + fr) * 4), v); } }
        }
    }
};
struct EpiMerge {
    static constexpr bool PERM = false, AFTER_DRAIN = false, KEEP = false;
    const bf16* G; float* P32; bf16* MB;
    __device__ __forceinline__ void operator()(const f32x4 (&acc)[2][2][4][2], const Unit& u, int wr, int wc, int fr, int fq) const {
        int fr_ = fr, fq_ = fq; asm volatile("" : "+v"(fr_), "+v"(fq_));
        const int b = u.pn >> 2, pn = u.pn & 3, pm = u.pm - b * 66, row0 = pm * 256 + wr * 64 + fr_, col0 = pn * 256 + wc * 32 + 4 * fq_;
#pragma unroll
        for (int ai = 0; ai < 2; ++ai)
#pragma unroll
            for (int m = 0; m < 4; ++m) { const unsigned row = row0 + ai * 128 + m * 16;
                const bf16* gp = G + ((size_t)row * 4096 + b * 1024 + col0); float* pp = P32 + ((size_t)row * 1024 + col0); bf16* mp = MB + ((size_t)row * 1024 + col0);
#pragma unroll
                for (int bj = 0; bj < 2; ++bj)
#pragma unroll
                    for (int n = 0; n < 2; ++n) { const int co = bj * 128 + n * 16;
                        const uint2 gw = *(const uint2*)(gp + co);
                        f32x4 v = acc[ai][bj][m][n]; v[0] *= bflo(gw.x); v[1] *= bfhi(gw.x); v[2] *= bflo(gw.y); v[3] *= bfhi(gw.y);
                        if (b > 0) v += *(const f32x4*)(pp + co);
                        if (b < 3) *(f32x4*)(pp + co) = v; else st4bf(mp + co, v);
                        asm volatile("" ::: "memory"); } }
    }
};
struct EpiMergeH {
    static constexpr bool PERM = false, AFTER_DRAIN = false, KEEP = true;
    const bf16* G; bf16* MB;
    __device__ __forceinline__ bool keep(const Unit& u) const { return (u.pn >> 2) < 3; }
    __device__ __forceinline__ void operator()(f32x4 (&acc)[2][2][4][2], const Unit& u, int wr, int wc, int fr, int fq) const {
        const int b = u.pn >> 2, pn = u.pn & 3, pm = u.pm - b * 66, row0 = pm * 256 + wr * 64 + fr, col0 = pn * 256 + wc * 32 + 4 * fq;
#pragma unroll
        for (int ai = 0; ai < 2; ++ai)
#pragma unroll
            for (int m = 0; m < 4; ++m) { const unsigned row = row0 + ai * 128 + m * 16; const bf16* gp = G + ((size_t)row * 4096 + b * 1024 + col0); bf16* mp = MB + ((size_t)row * 1024 + col0);
#pragma unroll
                for (int bj = 0; bj < 2; ++bj)
#pragma unroll
                    for (int n = 0; n < 2; ++n) { const int co = bj * 128 + n * 16; const uint2 gb = *(const uint2*)(gp + co); f32x4 v = acc[ai][bj][m][n];
                        if (b < 3) { const uint2 gn = *(const uint2*)(gp + 1024 + co);
                            v[0] *= bflo(gb.x) * __builtin_amdgcn_rcpf(bflo(gn.x)); v[1] *= bfhi(gb.x) * __builtin_amdgcn_rcpf(bfhi(gn.x)); v[2] *= bflo(gb.y) * __builtin_amdgcn_rcpf(bflo(gn.y)); v[3] *= bfhi(gb.y) * __builtin_amdgcn_rcpf(bfhi(gn.y));
                            acc[ai][bj][m][n] = v; }
                        else { v[0] *= bflo(gb.x); v[1] *= bfhi(gb.x); v[2] *= bflo(gb.y); v[3] *= bfhi(gb.y); st4bf(mp + co, v); } }
                asm volatile("" ::: "memory"); }
    }
};
struct EpiWout {
    static constexpr bool PERM = false, AFTER_DRAIN = false, KEEP = false;
    const float* xlat; const float* xctx; float* X; const float* mod;
    __device__ __forceinline__ void operator()(const f32x4 (&acc)[2][2][4][2], const Unit& u, int wr, int wc, int fr, int fq) const {
        const int r = u.pm < 32 ? 0 : (u.pm < 64 ? 1 : 2); const float* gt = mod + r * 6144 + 2 * 1024;
        const int row0 = u.pm * 256 + wr * 64 + fr, col0 = u.pn * 256 + wc * 32 + 4 * fq;
        f32x4 gv[2][2];
#pragma unroll
        for (int bj = 0; bj < 2; ++bj)
#pragma unroll
            for (int n = 0; n < 2; ++n) gv[bj][n] = *(const f32x4*)(gt + col0 + bj * 128 + n * 16);
#pragma unroll
        for (int ai = 0; ai < 2; ++ai)
#pragma unroll
            for (int m = 0; m < 4; ++m) { const size_t row = row0 + ai * 128 + m * 16; const float* src = (row < ML) ? xlat + row * 1024 : xctx + (row - ML) * 1024;
#pragma unroll
                for (int bj = 0; bj < 2; ++bj)
#pragma unroll
                    for (int n = 0; n < 2; ++n) { const int col = col0 + bj * 128 + n * 16;
                        *(f32x4*)(X + row * 1024 + col) = *(const f32x4*)(src + col) + gv[bj][n] * acc[ai][bj][m][n]; } }
    }
};
struct EpiGU {
    static constexpr bool PERM = true, AFTER_DRAIN = false, KEEP = false;
    bf16* ACT;
    __device__ __forceinline__ void operator()(const f32x4 (&acc)[2][2][4][2], const Unit& u, int wr, int wc, int fr, int fq) const {
        const int pnl = u.pn & 7, row0 = u.pm * 256 + wr * 64 + fr, cl0 = wc * 32 + 8 * fq;
#pragma unroll
        for (int ai = 0; ai < 2; ++ai)
#pragma unroll
            for (int m = 0; m < 4; ++m) { const size_t row = row0 + ai * 128 + m * 16; f32x4 v[2];
#pragma unroll
                for (int n = 0; n < 2; ++n) { const f32x4 a = acc[ai][0][m][n], up = acc[ai][1][m][n];
#pragma unroll
                    for (int j = 0; j < 4; ++j) v[n][j] = a[j] * sigm(a[j]) * up[j]; }
                st8bf(ACT + row * 1024 + pnl * 128 + cl0, v[0], v[1]); }
    }
};
struct EpiDown {
    static constexpr bool PERM = true, AFTER_DRAIN = false, KEEP = false;
    bf16* YB; const float* GATE;
    __device__ __forceinline__ void operator()(const f32x4 (&acc)[2][2][4][2], const Unit& u, int wr, int wc, int fr, int fq) const {
        const int pnl = u.pn & 3, row0 = u.pm * 256 + wr * 64 + fr, col0 = pnl * 256 + wc * 32 + 8 * fq;
#pragma unroll
        for (int ai = 0; ai < 2; ++ai)
#pragma unroll
            for (int m = 0; m < 4; ++m) { const size_t row = row0 + ai * 128 + m * 16; const float gt = GATE[row];
#pragma unroll
                for (int bj = 0; bj < 2; ++bj) st8bf(YB + row * 1024 + col0 + bj * 128, acc[ai][bj][m][0] * gt, acc[ai][bj][m][1] * gt); }
    }
};
struct MergeOrder {
    int nt, G, c;
    __device__ void init(int ntm, int G_, int c_) { nt = ntm * 4; G = G_; c = c_; }
    __device__ bool next(int i, Unit& u) const { const int b = i & 3, L = (i >> 2) * G + c; if (L >= nt) return false; u.pm = b * 66 + (L >> 2); u.pn = b * 4 + (L & 3); return true; }
    __device__ __forceinline__ void a_ready(const Unit&) const {}
    __device__ __forceinline__ void done(const Unit&) const {}
};
struct GroupOrder {
    int nwg, G, c, TPE, NTN;
    __device__ void init(int tpe, int ntn, int G_, int c_) { TPE = tpe; NTN = ntn; nwg = NE * tpe * ntn; G = G_; c = c_; }
    __device__ bool next(int i, Unit& u) const {
        const long L = (long)i * G + c; if (L >= nwg) return false;
        int wgid = (int)L; { const int q = nwg / 8, r = nwg % 8, xcd = wgid % 8, off = wgid / 8; wgid = (xcd < r ? xcd * (q + 1) : r * (q + 1) + (xcd - r) * q) + off; }
        const int per = TPE * NTN, e = wgid / per, rem = wgid % per, pn = rem / TPE, mt = rem % TPE;
        u.pm = e * 9 + mt; u.pn = e * NTN + pn; return true;
    }
    __device__ __forceinline__ void a_ready(const Unit&) const {}
    __device__ __forceinline__ void done(const Unit&) const {}
};
typedef float f2v __attribute__((ext_vector_type(2)));
#define PH_ARGS LAS unsigned char* lds, const int tid, const int lane, const int wave, const int bid, const int G
#define WSP(T, off) ((T*)(PTRV(29, unsigned char) + (off)))
constexpr int PTAB_OFF = MISC_OFF + 512;
__device__ __forceinline__ unsigned long long ptab_ld(LAS unsigned char* lds, int i) {
    typedef unsigned u2v_t __attribute__((ext_vector_type(2)));
    const volatile LAS unsigned* tp = (const volatile LAS unsigned*)(lds + PTAB_OFF + 8 * i); u2v_t v; v[0] = tp[0]; v[1] = tp[1];
    const unsigned lo = __builtin_amdgcn_readfirstlane(v[0]), hi = __builtin_amdgcn_readfirstlane(v[1]);
    return ((unsigned long long)hi << 32) | lo;
}
#define PTRV(i, T) ((T*)(GAS T*)ptab_ld(lds, (i)))
#define INP(i) ((const float*)(GAS const float*)ptab_ld(lds, (i)))

__device__ __forceinline__ void mod_gemv(PH_ARGS) {
    LAS f32x4* red = (LAS f32x4*)lds;
    const float* c = INP(1); const float* cc = INP(3); const float* wm = INP(4); const float* bm = INP(5);
    float* MOD = WSP(float, WS_MOD);
    for (int it = bid; it < 192; it += G) {
        const int l = it / 96, cg = it % 96, kg = tid >> 4, cq = tid & 15;
        f32x4 a0 = {0.f, 0.f, 0.f, 0.f}, a1 = a0, a2 = a0;
        const float* wb = wm + (size_t)l * 1024 * 6144 + cg * 64 + cq * 4;
#pragma unroll 4
        for (int i = 0; i < 32; ++i) { const int k = kg + 32 * i; const f32x4 w = *(const f32x4*)(wb + (size_t)k * 6144);
            const float x0 = c[k], x1 = c[1024 + k], x2 = cc[k];
            a0 += w * (x0 * sigm(x0)); a1 += w * (x1 * sigm(x1)); a2 += w * (x2 * sigm(x2)); }
        red[(kg * 3 + 0) * 16 + cq] = a0; red[(kg * 3 + 1) * 16 + cq] = a1; red[(kg * 3 + 2) * 16 + cq] = a2;
        __syncthreads();
        if (tid < 192) { const int r = tid >> 6, col = tid & 63; float s = 0.f; const LAS float* rf = (const LAS float*)red;
            for (int k2 = 0; k2 < 32; ++k2) s += rf[((k2 * 3 + r) * 16 + (col >> 2)) * 4 + (col & 3)];
            MOD[(l * 3 + r) * 6144 + cg * 64 + col] = s + bm[l * 6144 + cg * 64 + col]; }
        __syncthreads();
    }
}
__device__ __forceinline__ void make_tables(PH_ARGS) {
    const int gt = bid * 512 + tid, GT = G * 512;
    float* RC = WSP(float, WS_ROPEC); float* RS = WSP(float, WS_ROPES);
    bf16* T1 = WSP(bf16, WS_T1T);
    for (int i = gt; i < 2048; i += GT) { const int pos = i >> 4, f = i & 15; const float inv = powf(10000.f, -(float)f / 16.f), ang = (float)pos * inv; RC[i] = cosf(ang); RS[i] = sinf(ang); }
    for (int i = gt; i < 128 * 128; i += GT) { const int col = i >> 7, k = i & 127, ro = col >> 6, k1 = col & 63, n1 = k >> 1, ri = k & 1; float s, c; sincospif((float)((k1 * n1) & 63) / 32.f, &s, &c);
        const float v = ro == 0 ? (ri == 0 ? c : s) : (ri == 0 ? -s : c); T1[i] = (bf16)f2bf(v); }
    bf16* T2F = WSP(bf16, WS_T2F); bf16* T2C = WSP(bf16, WS_T2C);
    for (int i = gt; i < 64 * 128 * 256; i += GT) { const int k1 = i >> 15, k2 = (i >> 8) & 127, k = i & 255, n2 = k >> 1, ri = k & 1; float s, c;
        sincospif((float)((n2 * (k1 + 64 * k2)) & 8191) / 4096.f, &s, &c); T2F[i] = (bf16)f2bf(ri ? s : c); }
    for (int i = gt; i < 2 * 128 * 256; i += GT) { const int k1 = i >> 15, k2 = (i >> 8) & 127, k = i & 255, n2 = k >> 1, ri = k & 1; float s, c;
        sincospif((float)((n2 * (k1 + 2 * k2)) & 255) / 128.f, &s, &c); T2C[i] = (bf16)f2bf(ri ? s : c); }
}
__device__ __forceinline__ void tr_item(const float* W, size_t ldw, int col0, int k0, bf16* dst, int Kd, LAS float* scr, int lane) {
#pragma unroll 8
    for (int i = 0; i < 32; ++i) { const int kk = 2 * i + (lane >> 5); scr[kk * 33 + (lane & 31)] = W[(size_t)(k0 + kk) * ldw + col0 + (lane & 31)]; }
    LDS_WAIT(); asm volatile("" ::: "memory");
    const int c = lane & 7;
#pragma unroll
    for (int j = 0; j < 4; ++j) { const int n = (lane >> 3) + 8 * j; const LAS float* s = scr + (8 * c) * 33 + n;
        v4u o; o.x = pk2(s[0 * 33], s[1 * 33]); o.y = pk2(s[2 * 33], s[3 * 33]); o.z = pk2(s[4 * 33], s[5 * 33]); o.w = pk2(s[6 * 33], s[7 * 33]);
        *(v4u*)(dst + (size_t)n * Kd + k0 + 8 * c) = o; }
    LDS_WAIT(); asm volatile("" ::: "memory");
}
__device__ __forceinline__ int rho32(int c) { return 16 * ((c >> 2) & 1) + 4 * (c >> 3) + (c & 3); }
__device__ __forceinline__ void fold_item16(const float* W  , int f, bf16* WIN, LAS float* scr, const LAS f2v* tab, int lane) {
    const int kb = f >> 2, g = f & 3, k0 = kb * 16;
#pragma unroll
    for (int kk = 0; kk < 16; ++kk) scr[kk * 64 + lane] = W[(size_t)(k0 + kk) * 6144 + 512 + g * 64 + lane];
    LDS_WAIT(); asm volatile("" ::: "memory");
    float ar[16], ai[16];
#pragma unroll
    for (int kk = 0; kk < 16; ++kk) { ar[kk] = 0.f; ai[kk] = 0.f; }
#pragma unroll 4
    for (int c = 0; c < 64; ++c) { const f2v t = tab[(c * lane) & 63];
#pragma unroll
        for (int kk = 0; kk < 16; ++kk) { const float w = scr[kk * 64 + c]; ar[kk] += w * t[0]; ai[kk] -= w * t[1]; } }
    const int L0 = 2 * (g * 64 + lane);
    bf16* d0 = WIN + (size_t)(512 + (L0 & ~31) + rho32(L0 & 31)) * 1024 + k0; bf16* d1 = WIN + (size_t)(512 + (L0 & ~31) + rho32((L0 + 1) & 31)) * 1024 + k0;
    v4u o, p;
    o.x = pk2(ar[0], ar[1]); o.y = pk2(ar[2], ar[3]); o.z = pk2(ar[4], ar[5]); o.w = pk2(ar[6], ar[7]); p.x = pk2(ar[8], ar[9]); p.y = pk2(ar[10], ar[11]); p.z = pk2(ar[12], ar[13]); p.w = pk2(ar[14], ar[15]);
    *(v4u*)d0 = o; *(v4u*)(d0 + 8) = p;
    o.x = pk2(ai[0], ai[1]); o.y = pk2(ai[2], ai[3]); o.z = pk2(ai[4], ai[5]); o.w = pk2(ai[6], ai[7]); p.x = pk2(ai[8], ai[9]); p.y = pk2(ai[10], ai[11]); p.z = pk2(ai[12], ai[13]); p.w = pk2(ai[14], ai[15]);
    *(v4u*)d1 = o; *(v4u*)(d1 + 8) = p;
    LDS_WAIT(); asm volatile("" ::: "memory");
}
template <bool PERMROWS>
__device__ __forceinline__ void tr_item64(const float* W, size_t ldw, int col0, int k0, bf16* dst, int Kd, int lane) {
    const int kq = lane >> 4, n4 = lane & 15; const float* src = W + (size_t)(k0 + kq * 16) * ldw + col0 + n4 * 4;
    f32x4 v[16];
#pragma unroll
    for (int i = 0; i < 16; ++i) v[i] = *(const f32x4*)(src + (size_t)i * ldw);
#pragma unroll
    for (int j = 0; j < 4; ++j) { const int ns = n4 * 4 + j, nd = PERMROWS ? ((ns & 32) + rho32(ns & 31)) : ns; bf16* d = dst + (size_t)nd * Kd + k0 + kq * 16; v4u o, p;
        o.x = pk2(v[0][j], v[1][j]); o.y = pk2(v[2][j], v[3][j]); o.z = pk2(v[4][j], v[5][j]); o.w = pk2(v[6][j], v[7][j]);
        p.x = pk2(v[8][j], v[9][j]); p.y = pk2(v[10][j], v[11][j]); p.z = pk2(v[12][j], v[13][j]); p.w = pk2(v[14][j], v[15][j]);
        *(v4u*)d = o; *(v4u*)(d + 8) = p; }
}
__device__ __forceinline__ void convert_range(PH_ARGS, const int l, const int it_lo, const int it_hi, const int pidx, const int pcount) {
    if (pidx < 0) return;
    LAS float* scr = (LAS float*)(lds + wave * 16384);
    const int gw = pidx * 8 + wave, NGW = pcount * 8;
    bf16* WIN = WSP(bf16, WS_WIN); bf16* WBR = WSP(bf16, WS_WBR); bf16* WO = WSP(bf16, WS_WO); bf16* WGU = WSP(bf16, WS_WGU); bf16* WDN = WSP(bf16, WS_WDN); bf16* WS_ = WSP(bf16, WS_WSP);
    const float* win = INP(8) + (size_t)l * 1024 * 6144;
    LAS f2v* tab = (LAS f2v*)(scr + 2048); { float s_, c_; sincospif((float)lane / 32.f, &s_, &c_); tab[lane] = (f2v){c_, s_}; } LDS_WAIT(); asm volatile("" ::: "memory");
    constexpr int N_FOLD = 256, N_IN = 92 * 16, N_BR = 256, N_WO = 256, N_GU = 8192, N_DN = 4096, N_SP = 64;
    constexpr int NITEMS = N_FOLD + N_IN + N_BR + N_WO + N_GU + N_DN + N_SP;
    for (int it = it_lo + gw; it < it_hi && it < NITEMS; it += NGW) {
        int r = it;
        if (r < N_FOLD) { fold_item16(win, r, WIN, scr, tab, lane); continue; } r -= N_FOLD;
        if (r < N_IN) { const int dbp = r >> 4, kb = r & 15, db = dbp < 8 ? dbp : dbp + 8; int col;
            if (db < 8) col = db * 64;
            else if (db < 24) { const int t = db - 16, tile = t >> 2, sub = t & 3; col = (sub < 2 ? 768 : 1024) + tile * 128 + (sub & 1) * 64; }
            else if (db < 36) col = 1280 + (db - 24) * 64;
            else col = 2048 + (db - 36) * 64;
            if (db < 24 || (db >= 32 && db < 36)) tr_item64<true>(win, 6144, col, kb * 64, WIN + (size_t)db * 64 * 1024, 1024, lane);
            else tr_item64<false>(win, 6144, col, kb * 64, WIN + (size_t)db * 64 * 1024, 1024, lane);
            continue; } r -= N_IN;
        if (r < N_BR) { const int b = r >> 6, q = r & 63, kb = q >> 4, nb = q & 15; const int ii = b == 0 ? 13 : (b == 1 ? 14 : (b == 2 ? 19 : 21));
            tr_item64<false>(INP(ii) + (size_t)l * 256 * 1024, 1024, nb * 64, kb * 64, WBR + (size_t)(b * 1024 + nb * 64) * 256, 256, lane); continue; } r -= N_BR;
        if (r < N_WO) { const int kb = r >> 4, nb = r & 15; tr_item64<false>(INP(22) + (size_t)l * 1024 * 1024, 1024, nb * 64, kb * 64, WO + (size_t)nb * 64 * 1024, 1024, lane); continue; } r -= N_WO;
        if (r < N_GU) { const int e = r >> 9, q = r & 511, db = q >> 4, kb = q & 15, tile = db >> 2, sub = db & 3;
            const float* src = (sub < 2 ? INP(24) : INP(25)) + (size_t)(l * 16 + e) * 1024 * 1024;
            tr_item64<false>(src, 1024, tile * 128 + (sub & 1) * 64, kb * 64, WGU + ((size_t)e * 2048 + db * 64) * 1024, 1024, lane); continue; } r -= N_GU;
        if (r < N_DN) { const int e = r >> 8, q = r & 255, kb = q >> 4, nb = q & 15;
            tr_item64<false>(INP(26) + (size_t)(l * 16 + e) * 1024 * 1024, 1024, nb * 64, kb * 64, WDN + ((size_t)e * 1024 + nb * 64) * 1024, 1024, lane); continue; } r -= N_DN;
        { const float* s = INP(11) + (size_t)l * 65536 + r * 1024 + lane * 16; const f32x4 a = *(const f32x4*)s, b = *(const f32x4*)(s + 4), c = *(const f32x4*)(s + 8), d = *(const f32x4*)(s + 12);
          v4u o, p; o.x = pk2(a[0], a[1]); o.y = pk2(a[2], a[3]); o.z = pk2(b[0], b[1]); o.w = pk2(b[2], b[3]); p.x = pk2(c[0], c[1]); p.y = pk2(c[2], c[3]); p.z = pk2(d[0], d[1]); p.w = pk2(d[2], d[3]);
          *(v4u*)(WS_ + r * 1024 + lane * 16) = o; *(v4u*)(WS_ + r * 1024 + lane * 16 + 8) = p; }
    }
}
constexpr int CV_FOLD0 = 0, CV_IN0 = 256, CV_BR0 = 256 + 92 * 16, CV_WO0 = CV_BR0 + 256, CV_GU0 = CV_WO0 + 256, CV_DN0 = CV_GU0 + 8192, CV_SP0 = CV_DN0 + 4096, CV_END = CV_SP0 + 64;
__device__ __forceinline__ void convert_weights(PH_ARGS, const int l) { convert_range(lds, tid, lane, wave, bid, G, l, 0, CV_END, bid, G); }
__device__ __forceinline__ void load_row(const float* p, int lane, f32x4 (&v)[4]) {
#pragma unroll
    for (int j = 0; j < 4; ++j) v[j] = *(const f32x4*)(p + 4 * lane + 256 * j);
}
__device__ __forceinline__ void modnorm_store(f32x4 (&v)[4], const float* g, const float* sc, const float* sh, bf16* hrow, int lane) {
    float ss = 0.f;
#pragma unroll
    for (int j = 0; j < 4; ++j) ss += (v[j][0] * v[j][0] + v[j][1] * v[j][1]) + (v[j][2] * v[j][2] + v[j][3] * v[j][3]);
    const float rs = 1.0f / sqrtf(wave_sum(ss) * (1.f / 1024.f) + 1e-6f);
#pragma unroll
    for (int j = 0; j < 4; ++j) { const int o = 4 * lane + 256 * j; const f32x4 gg = *(const f32x4*)(g + o), s = *(const f32x4*)(sc + o), b = *(const f32x4*)(sh + o);
        v[j] = v[j] * rs * gg * (s + 1.f) + b; st4bf(hrow + o, v[j]); }
}
__device__ __forceinline__ void modnorm_regs(f32x4 (&v)[4], const f32x4 (&gm)[4], const f32x4 (&sh)[4], bf16* hrow, int lane) {
    float ss = 0.f;
#pragma unroll
    for (int j = 0; j < 4; ++j) ss += (v[j][0] * v[j][0] + v[j][1] * v[j][1]) + (v[j][2] * v[j][2] + v[j][3] * v[j][3]);
    const float rs = 1.0f / sqrtf(wave_sum(ss) * (1.f / 1024.f) + 1e-6f);
#pragma unroll
    for (int j = 0; j < 4; ++j) { v[j] = v[j] * rs * gm[j] + sh[j]; st4bf(hrow + 4 * lane + 256 * j, v[j]); }
}
__device__ __forceinline__ void load_mod(const float* g, const float* sc, const float* shp, int lane, f32x4 (&gm)[4], f32x4 (&sh)[4]) {
#pragma unroll
    for (int j = 0; j < 4; ++j) { const int o = 4 * lane + 256 * j; gm[j] = *(const f32x4*)(g + o) * (*(const f32x4*)(sc + o) + 1.f); sh[j] = *(const f32x4*)(shp + o); }
}
__device__ __forceinline__ void norm1_l0(PH_ARGS) {
    const int gw = bid * 8 + wave, NGW = G * 8; bf16* H = WSP(bf16, WS_H); const float* MOD = WSP(float, WS_MOD);
    const int RPW = (MT + NGW - 1) / NGW, row0 = gw * RPW, rend = (row0 + RPW < MT) ? row0 + RPW : MT;
    const float* xin = INP(0); const float* cin = INP(2); const float* g = INP(6);
    f32x4 cur[4], nxt[4], gm[4], sh[4]; int rprev = -1;
    if (row0 < rend) load_row(row0 < ML ? xin + (size_t)row0 * 1024 : cin + (size_t)(row0 - ML) * 1024, lane, cur);
    for (int row = row0; row < rend; ++row) {
        if (row + 1 < rend) { const int rn = row + 1; load_row(rn < ML ? xin + (size_t)rn * 1024 : cin + (size_t)(rn - ML) * 1024, lane, nxt); }
        const int r = row < SEQ ? 0 : (row < ML ? 1 : 2);
        if (r != rprev) { const float* md = MOD + r * 6144; load_mod(g, md + 1024, md, lane, gm, sh); rprev = r; }
        modnorm_regs(cur, gm, sh, H + (size_t)row * 1024, lane);
#pragma unroll
        for (int j = 0; j < 4; ++j) cur[j] = nxt[j];
    }
}
__device__ __forceinline__ void norm2_router(PH_ARGS, const int l, const int nrows) {
    const int gw = bid * 8 + wave, NGW = G * 8; bf16* H = WSP(bf16, WS_H); const float* MOD = WSP(float, WS_MOD) + l * 3 * 6144; const float* X = WSP(float, WS_X); float* AFF = WSP(float, WS_AFF);
    LAS f32x4* Wl = (LAS f32x4*)lds;
    { const f32x4* wr = (const f32x4*)(INP(23) + (size_t)l * 1024 * 16);
      for (int i = tid; i < 4096; i += 512) { const int k = i >> 2, q = i & 3; Wl[(q * 4 + (k & 3)) * 256 + (k >> 2)] = wr[i]; } }
    __syncthreads();
    const int RPW = (nrows + NGW - 1) / NGW, row0 = gw * RPW, rend = (row0 + RPW < nrows) ? row0 + RPW : nrows;
    const float* g2 = INP(7) + l * 1024;
    f32x4 v[4], nxt[4], gm[4], sh[4]; int rprev = -1;
    if (row0 < rend) load_row(X + (size_t)row0 * 1024, lane, v);
    for (int row = row0; row < rend; ++row) {
        if (row + 1 < rend) load_row(X + (size_t)(row + 1) * 1024, lane, nxt);
        const int r = row < SEQ ? 0 : (row < ML ? 1 : 2);
        if (r != rprev) { const float* md = MOD + r * 6144; load_mod(g2, md + 4 * 1024, md + 3 * 1024, lane, gm, sh); rprev = r; }
        modnorm_regs(v, gm, sh, H + (size_t)row * 1024, lane);
        float lg[16];
#pragma unroll
        for (int e = 0; e < 16; ++e) lg[e] = 0.f;
#pragma unroll
        for (int j = 0; j < 4; ++j)
#pragma unroll
            for (int i = 0; i < 4; ++i) { const float hv = v[j][i];
#pragma unroll
                for (int q = 0; q < 4; ++q) { const f32x4 w = Wl[(q * 4 + i) * 256 + 64 * j + lane]; lg[4 * q + 0] += hv * w[0]; lg[4 * q + 1] += hv * w[1]; lg[4 * q + 2] += hv * w[2]; lg[4 * q + 3] += hv * w[3]; }
                if (i & 1) asm volatile("" ::: "memory"); }
#pragma unroll
        for (int i = 0; i < 8; ++i) { const bool up = lane & 32; const float send = up ? lg[i] : lg[i + 8], keep = up ? lg[i + 8] : lg[i]; lg[i] = keep + __shfl_xor(send, 32); }
#pragma unroll
        for (int i = 0; i < 4; ++i) { const bool up = lane & 16; const float send = up ? lg[i] : lg[i + 4], keep = up ? lg[i + 4] : lg[i]; lg[i] = keep + __shfl_xor(send, 16); }
#pragma unroll
        for (int i = 0; i < 2; ++i) { const bool up = lane & 8; const float send = up ? lg[i] : lg[i + 2], keep = up ? lg[i + 2] : lg[i]; lg[i] = keep + __shfl_xor(send, 8); }
        { const bool up = lane & 4; const float send = up ? lg[0] : lg[1], keep = up ? lg[1] : lg[0]; lg[0] = keep + __shfl_xor(send, 4); }
        float z = lg[0]; z += __shfl_xor(z, 1); z += __shfl_xor(z, 2);
        float mx = z; mx = fmaxf(mx, __shfl_xor(mx, 4)); mx = fmaxf(mx, __shfl_xor(mx, 8)); mx = fmaxf(mx, __shfl_xor(mx, 16)); mx = fmaxf(mx, __shfl_xor(mx, 32));
        const float ez = expf(z - mx); float sm = ez; sm += __shfl_xor(sm, 4); sm += __shfl_xor(sm, 8); sm += __shfl_xor(sm, 16); sm += __shfl_xor(sm, 32);
        if ((lane & 3) == 0) { const int e = ((lane >> 5) & 1) * 8 + ((lane >> 4) & 1) * 4 + ((lane >> 3) & 1) * 2 + ((lane >> 2) & 1); AFF[(size_t)row * 16 + e] = ez / sm; }
#pragma unroll
        for (int j = 0; j < 4; ++j) v[j] = nxt[j];
    }
    __syncthreads();
}
typedef short v4i16_t __attribute__((ext_vector_type(4)));
__device__ __forceinline__ void mfma16(f32x4& acc, const bf16x8 a, const bf16x8 b) { asm volatile("s_nop 1\n\tv_mfma_f32_16x16x32_bf16 %0, %1, %2, %0\n\ts_nop 3" : "+v"(acc) : "v"(a), "v"(b)); }
#define DRAIN4(x) asm volatile("s_nop 15\n\ts_nop 15" : "+v"((x)[0]), "+v"((x)[1]), "+v"((x)[2]), "+v"((x)[3]))
#define DRAIN8(x) asm volatile("s_nop 15\n\ts_nop 15" : "+v"((x)[0]), "+v"((x)[1]), "+v"((x)[2]), "+v"((x)[3]), "+v"((x)[4]), "+v"((x)[5]), "+v"((x)[6]), "+v"((x)[7]))
#define DRAIN16(x) asm volatile("s_nop 15\n\ts_nop 15" : "+v"((x)[0]), "+v"((x)[1]), "+v"((x)[2]), "+v"((x)[3]), "+v"((x)[4]), "+v"((x)[5]), "+v"((x)[6]), "+v"((x)[7]), \
    "+v"((x)[8]), "+v"((x)[9]), "+v"((x)[10]), "+v"((x)[11]), "+v"((x)[12]), "+v"((x)[13]), "+v"((x)[14]), "+v"((x)[15]))
__device__ __forceinline__ void gmlp_unit(PH_ARGS, const int l, const int chunk) {
    const int row0 = chunk < 128 ? chunk * 128 : ML + (chunk - 128) * 128;
    const bf16* AUV = WSP(bf16, WS_AUV); bf16* BRa = WSP(bf16, WS_BR); const bf16* WS_ = WSP(bf16, WS_WSP);
    LAS bf16* vT = (LAS bf16*)lds;
    const float* lg = INP(9) + l * 256; const float* lb = INP(10) + l * 256;
    const f32x4 gg = *(const f32x4*)(lg + 4 * lane), bb = *(const f32x4*)(lb + 4 * lane);
    uint2 raws[16];
#pragma unroll
    for (int pi = 0; pi < 16; ++pi) raws[pi] = *(const uint2*)(AUV + (size_t)(row0 + wave * 16 + pi) * 512 + 256 + 4 * lane);
#pragma unroll
    for (int pi = 0; pi < 16; ++pi) { const int p = wave * 16 + pi;
        const uint2 raw = raws[pi];
        float v0 = bflo(raw.x), v1 = bfhi(raw.x), v2 = bflo(raw.y), v3 = bfhi(raw.y);
        const float mean = wave_sum((v0 + v1) + (v2 + v3)) * (1.f / 256.f); v0 -= mean; v1 -= mean; v2 -= mean; v3 -= mean;
        const float rstd = 1.0f / sqrtf(wave_sum((v0 * v0 + v1 * v1) + (v2 * v2 + v3 * v3)) * (1.f / 256.f) + 1e-6f);
        vT[(4 * lane + 0) * 136 + p] = (bf16)f2bf(v0 * rstd * gg[0] + bb[0]); vT[(4 * lane + 1) * 136 + p] = (bf16)f2bf(v1 * rstd * gg[1] + bb[1]);
        vT[(4 * lane + 2) * 136 + p] = (bf16)f2bf(v2 * rstd * gg[2] + bb[2]); vT[(4 * lane + 3) * 136 + p] = (bf16)f2bf(v3 * rstd * gg[3] + bb[3]); }
    __syncthreads();
    const int g = wave >> 1, qh = wave & 1, fr = lane & 15, fq = lane >> 4;
    f32x4 acc[4][4];
#pragma unroll
    for (int a = 0; a < 4; ++a)
#pragma unroll
        for (int b = 0; b < 4; ++b) acc[a][b] = (f32x4){0.f, 0.f, 0.f, 0.f};
    const bf16* Wg = WS_ + g * 16384;
#pragma unroll
    for (int ks = 0; ks < 4; ++ks) { bf16x8 af[4], bf[4];
#pragma unroll
        for (int dt = 0; dt < 4; ++dt) af[dt] = *(const LAS bf16x8*)(vT + (g * 64 + dt * 16 + fr) * 136 + ks * 32 + fq * 8);
#pragma unroll
        for (int qt = 0; qt < 4; ++qt) bf[qt] = *(const bf16x8*)(Wg + (qh * 64 + qt * 16 + fr) * 128 + ks * 32 + fq * 8);
#pragma unroll
        for (int dt = 0; dt < 4; ++dt)
#pragma unroll
            for (int qt = 0; qt < 4; ++qt) mfma16(acc[dt][qt], af[dt], bf[qt]); }
    DRAIN16(&acc[0][0]);
    const float* bs = INP(12) + l * 512 + g * 128;
#pragma unroll
    for (int qt = 0; qt < 4; ++qt) { const int q = qh * 64 + qt * 16 + fr; const float bias = bs[q]; const size_t row = row0 + q;
#pragma unroll
        for (int dt = 0; dt < 4; ++dt) { const int ch = g * 64 + dt * 16 + 4 * fq; const uint2 uw = *(const uint2*)(AUV + row * 512 + ch);
            f32x4 o; o[0] = bflo(uw.x) * (acc[dt][qt][0] + bias); o[1] = bfhi(uw.x) * (acc[dt][qt][1] + bias); o[2] = bflo(uw.y) * (acc[dt][qt][2] + bias); o[3] = bfhi(uw.y) * (acc[dt][qt][3] + bias);
            st4bf(BRa + row * 256 + ch, o); } }
    __syncthreads();
}
__device__ __forceinline__ void conv_unit(PH_ARGS, const int l, const int unit) {
    int rowbase, n0, nlen;
    if (unit < 256) { rowbase = (unit >> 7) * SEQ; n0 = (unit & 127) * 64; nlen = SEQ; } else { const int u2 = unit - 256; rowbase = ML + (u2 >> 2) * CTXL; n0 = (u2 & 3) * 64; nlen = CTXL; }
    const bf16* CY = WSP(bf16, WS_CY); bf16* BRc = WSP(bf16, WS_BR) + (size_t)2 * MT * 256;
    LAS unsigned* yt = (LAS unsigned*)lds;
    LAS float* cres = (LAS float*)(lds + 48128);
    for (int p = tid; p < 94 * 32; p += 512) { const int rr = p >> 5, seg = p & 31, n = n0 - 15 + rr; v4u val = {0u, 0u, 0u, 0u};
        if (n >= 0 && n < nlen) val = *(const v4u*)(CY + (size_t)(rowbase + n) * 256 + seg * 8);
        *(LAS v4u*)(lds + rr * 512 + seg * 16) = val; }
    __syncthreads();
    const int cp = tid & 127, pg = tid >> 7;
    float w0[31], w1[31];
    const float* cw = INP(15) + (size_t)l * 31 * 256 + 2 * cp;
#pragma unroll
    for (int t = 0; t < 31; ++t) { const float2 w = *(const float2*)(cw + t * 256); w0[t] = w.x; w1[t] = w.y; }
    float a0[16], a1[16];
#pragma unroll
    for (int p = 0; p < 16; ++p) { a0[p] = 0.f; a1[p] = 0.f; }
#pragma unroll
    for (int i = 0; i < 46; ++i) { const unsigned raw = yt[(16 * pg + i) * 128 + cp]; const float v0 = bflo(raw), v1 = bfhi(raw);
#pragma unroll
        for (int p = 0; p < 16; ++p) { const int t = i - p; if (t >= 0 && t < 31) { a0[p] += v0 * w0[t]; a1[p] += v1 * w1[t]; } } }
    const float2 cb = *(const float2*)(INP(16) + l * 256 + 2 * cp);
#pragma unroll
    for (int p = 0; p < 16; ++p) *(LAS f2v*)(cres + (16 * pg + p) * 256 + 2 * cp) = (f2v){a0[p] + cb.x, a1[p] + cb.y};
    __syncthreads();
    const f32x4 gg = *(const f32x4*)(INP(17) + l * 256 + 4 * lane), bb = *(const f32x4*)(INP(18) + l * 256 + 4 * lane);
    for (int pi = 0; pi < 8; ++pi) { const int pos = wave * 8 + pi; f32x4 v = *(const LAS f32x4*)(cres + pos * 256 + 4 * lane);
        const float mean = wave_sum((v[0] + v[1]) + (v[2] + v[3])) * (1.f / 256.f); v = v - mean;
        const float rstd = 1.0f / sqrtf(wave_sum((v[0] * v[0] + v[1] * v[1]) + (v[2] * v[2] + v[3] * v[3])) * (1.f / 256.f) + 1e-6f);
        f32x4 o;
#pragma unroll
        for (int j = 0; j < 4; ++j) { const float y = v[j] * rstd * gg[j] + bb[j]; o[j] = y * sigm(y); }
        st4bf(BRc + (size_t)(rowbase + n0 + pos) * 256 + 4 * lane, o); }
    __syncthreads();
}
constexpr int F1_T1L = 0, F1_YL = 34816;
__device__ __forceinline__ void f1_stage_tables(PH_ARGS) {
    const bf16* T1 = WSP(bf16, WS_T1T);
    for (int p = tid; p < 128 * 16; p += 512) { const int r = p >> 4, s = p & 15; *(LAS v4u*)(lds + F1_T1L + r * 272 + s * 16) = *(const v4u*)(T1 + r * 128 + s * 8); }
    __syncthreads();
}
__device__ __forceinline__ void f1_unit(PH_ARGS, const int unit) {
    const int b = unit >> 7, n2 = unit & 127, fr = lane & 15, fq = lane >> 4;
    const bf16* YF = WSP(bf16, WS_YF); bf16* FA = WSP(bf16, WS_FA);
    LAS unsigned* Yl = (LAS unsigned*)(lds + F1_YL);
#pragma unroll
    for (int i = 0; i < 8; ++i) { const int n1 = wave + 8 * i; *(LAS v4u*)(Yl + n1 * 260 + lane * 4) = *(const v4u*)(YF + (size_t)(b * SEQ + 128 * n1 + n2) * 512 + lane * 8); }
    __syncthreads();
    f32x4 acc[2][8];
#pragma unroll
    for (int a = 0; a < 2; ++a)
#pragma unroll
        for (int n = 0; n < 8; ++n) acc[a][n] = (f32x4){0.f, 0.f, 0.f, 0.f};
#pragma unroll
    for (int ks = 0; ks < 4; ++ks) { bf16x8 af[2];
#pragma unroll
        for (int c2 = 0; c2 < 2; ++c2) { const int ch = (2 * wave + c2) * 16 + fr; v4u w;
            w.x = Yl[(16 * ks + 4 * fq + 0) * 260 + ch]; w.y = Yl[(16 * ks + 4 * fq + 1) * 260 + ch]; w.z = Yl[(16 * ks + 4 * fq + 2) * 260 + ch]; w.w = Yl[(16 * ks + 4 * fq + 3) * 260 + ch];
            af[c2] = __builtin_bit_cast(bf16x8, w); }
#pragma unroll
        for (int nt = 0; nt < 8; ++nt) { const bf16x8 bfr = *(const LAS bf16x8*)(lds + F1_T1L + (nt * 16 + fr) * 272 + ks * 64 + fq * 16);
            mfma16(acc[0][nt], af[0], bfr); mfma16(acc[1][nt], af[1], bfr); } }
    DRAIN16(&acc[0][0]);
#pragma unroll
    for (int c2 = 0; c2 < 2; ++c2)
#pragma unroll
        for (int kt = 0; kt < 4; ++kt) { const int k1 = kt * 16 + fr; const f32x4 ar = acc[c2][kt], ai = acc[c2][kt + 4];
            v4u o; o.x = pk2(ar[0], ai[0]); o.y = pk2(ar[1], ai[1]); o.z = pk2(ar[2], ai[2]); o.w = pk2(ar[3], ai[3]);
            *(v4u*)(FA + ((size_t)((b * 64 + k1) * 128 + n2) * 256 + (2 * wave + c2) * 16 + 4 * fq) * 2) = o; }
    __syncthreads();
}
constexpr int F2_T2L = 0, F2_AL = 67584;
__device__ __forceinline__ void f2_unit(PH_ARGS, const int unit) {
    const int fr = lane & 15, fq = lane >> 4; const bool lat = unit < 256;
    int b, k1, chh; const bf16* Asrc; const bf16* Tsrc; size_t orow0; int ostr; float scl;
    if (lat) { b = unit >> 7; k1 = (unit >> 1) & 63; chh = unit & 1; Asrc = WSP(bf16, WS_FA) + (size_t)((b * 64 + k1) * 128) * 512; Tsrc = WSP(bf16, WS_T2F) + (size_t)k1 * 32768; orow0 = (size_t)b * SEQ + k1; ostr = 64; scl = 0.0013810679320049757f; }
    else { const int u2 = unit - 256; b = u2 >> 2; k1 = (u2 >> 1) & 1; chh = u2 & 1; Asrc = WSP(bf16, WS_FAC) + (size_t)((b * 2 + k1) * 128) * 512; Tsrc = WSP(bf16, WS_T2C) + (size_t)k1 * 32768; orow0 = (size_t)ML + b * CTXL + k1; ostr = 2; scl = 1.f / 128.f; }
    bf16* BRb = WSP(bf16, WS_BR) + (size_t)1 * MT * 256;
    LAS unsigned* Al = (LAS unsigned*)(lds + F2_AL);
    for (int p = tid; p < 128 * 32; p += 512) { const int r = p >> 5, s = p & 31; *(LAS v4u*)(lds + F2_T2L + r * 528 + s * 16) = *(const v4u*)(Tsrc + r * 256 + s * 8); }
#pragma unroll
    for (int i = 0; i < 8; ++i) { const int n2 = wave * 16 + 2 * i + (lane >> 5);
        *(LAS v4u*)(Al + n2 * 132 + (lane & 31) * 4) = *(const v4u*)(Asrc + ((size_t)n2 * 256 + chh * 128) * 2 + (lane & 31) * 8); }
    __syncthreads();
    f32x4 acc[8];
#pragma unroll
    for (int n = 0; n < 8; ++n) acc[n] = (f32x4){0.f, 0.f, 0.f, 0.f};
    const int ch = wave * 16 + fr;
#pragma unroll
    for (int ks = 0; ks < 8; ++ks) { v4u w;
        w.x = Al[(16 * ks + 4 * fq + 0) * 132 + ch]; w.y = Al[(16 * ks + 4 * fq + 1) * 132 + ch]; w.z = Al[(16 * ks + 4 * fq + 2) * 132 + ch]; w.w = Al[(16 * ks + 4 * fq + 3) * 132 + ch];
        const bf16x8 af = __builtin_bit_cast(bf16x8, w);
#pragma unroll
        for (int nt = 0; nt < 8; ++nt) { const bf16x8 bfr = *(const LAS bf16x8*)(lds + F2_T2L + (nt * 16 + fr) * 528 + ks * 64 + fq * 16); mfma16(acc[nt], af, bfr); } }
    DRAIN8(acc);
#pragma unroll
    for (int nt = 0; nt < 8; ++nt) { const int k2 = nt * 16 + fr; st4bf(BRb + (orow0 + (size_t)ostr * k2) * 256 + chh * 128 + wave * 16 + 4 * fq, acc[nt] * scl); }
    __syncthreads();
}
__device__ __forceinline__ void ctx_butterfly(PH_ARGS) {
    const unsigned* YF = (const unsigned*)WSP(bf16, WS_YF); unsigned* FAC = (unsigned*)WSP(bf16, WS_FAC);
    for (int i = bid * 512 + tid; i < 2 * 128 * 256; i += G * 512) { const int b = i >> 15, n2 = (i >> 8) & 127, ch = i & 255;
        const unsigned y0 = YF[(size_t)(ML + b * CTXL + n2) * 256 + ch], y1 = YF[(size_t)(ML + b * CTXL + 128 + n2) * 256 + ch];
        const float r0 = bflo(y0), i0 = bfhi(y0), r1 = bflo(y1), i1 = bfhi(y1);
        FAC[(size_t)((b * 2 + 0) * 128 + n2) * 256 + ch] = pk2(r0 + r1, i0 + i1); FAC[(size_t)((b * 2 + 1) * 128 + n2) * 256 + ch] = pk2(r0 - r1, i0 - i1); }
}
constexpr int MG_AL = 0, MG_BL = 67584;
__device__ __forceinline__ void merge_phase(PH_ARGS, const int nunits) {
    const int fr = lane & 15, fq = lane >> 4, wr = wave >> 2, wc = wave & 3;
    const bf16* BR = WSP(bf16, WS_BR); const bf16* WBR = WSP(bf16, WS_WBR); const bf16* GT = WSP(bf16, WS_G); bf16* MB = WSP(bf16, WS_MB);
    int nmine = 0; for (int u = bid; u < nunits; u += G) ++nmine;
    const int nsteps = nmine * 4;
    if (nsteps == 0) return;
    v4u pa[8], pb[8];
#define MG_LOAD(s) do { const int u_ = bid + ((s) >> 2) * G, b_ = (s) & 3, rt_ = u_ >> 3, ct_ = u_ & 7; \
        const bf16* As = BR + ((size_t)b_ * MT + (size_t)rt_ * 128) * 256; const bf16* Bs = WBR + ((size_t)b_ * 1024 + (size_t)ct_ * 128) * 256; \
        _Pragma("unroll") for (int i = 0; i < 8; ++i) { const int p = i * 512 + tid, r = p >> 5, seg = p & 31; pa[i] = *(const v4u*)(As + (size_t)r * 256 + seg * 8); pb[i] = *(const v4u*)(Bs + (size_t)r * 256 + seg * 8); } } while (0)
#define MG_WRITE() do { _Pragma("unroll") for (int i = 0; i < 8; ++i) { const int p = i * 512 + tid, r = p >> 5, seg = p & 31; \
        *(LAS v4u*)(lds + MG_AL + r * 528 + seg * 16) = pa[i]; *(LAS v4u*)(lds + MG_BL + r * 528 + seg * 16) = pb[i]; } } while (0)
    MG_LOAD(0); MG_WRITE();
    f32x4 macc[4][2];
#pragma unroll
    for (int a = 0; a < 4; ++a)
#pragma unroll
        for (int n = 0; n < 2; ++n) macc[a][n] = (f32x4){0.f, 0.f, 0.f, 0.f};
#pragma unroll 1
    for (int s = 0; s < nsteps; ++s) {
        const int u = bid + (s >> 2) * G, b = s & 3, rt = u >> 3, ct = u & 7;
        __syncthreads();
        if (s + 1 < nsteps) MG_LOAD(s + 1);
        uint2 gw[4][2];
#pragma unroll
        for (int mt = 0; mt < 4; ++mt)
#pragma unroll
            for (int nt = 0; nt < 2; ++nt) gw[mt][nt] = *(const uint2*)(GT + ((((size_t)(u * 4 + b) * 8 + wave) * 8 + mt * 2 + nt) * 256 + lane * 4));
        f32x4 acc[4][2];
#pragma unroll
        for (int a = 0; a < 4; ++a)
#pragma unroll
            for (int n = 0; n < 2; ++n) acc[a][n] = (f32x4){0.f, 0.f, 0.f, 0.f};
#pragma unroll
        for (int ks = 0; ks < 8; ++ks) { bf16x8 af[4], bfr[2];
#pragma unroll
            for (int mt = 0; mt < 4; ++mt) af[mt] = *(const LAS bf16x8*)(lds + MG_AL + (wr * 64 + mt * 16 + fr) * 528 + ks * 64 + fq * 16);
#pragma unroll
            for (int nt = 0; nt < 2; ++nt) bfr[nt] = *(const LAS bf16x8*)(lds + MG_BL + (wc * 32 + nt * 16 + fr) * 528 + ks * 64 + fq * 16);
#pragma unroll
            for (int mt = 0; mt < 4; ++mt)
#pragma unroll
                for (int nt = 0; nt < 2; ++nt) mfma16(acc[mt][nt], bfr[nt], af[mt]); }
        DRAIN8(&acc[0][0]);
#pragma unroll
        for (int mt = 0; mt < 4; ++mt)
#pragma unroll
            for (int nt = 0; nt < 2; ++nt) { const uint2 g = gw[mt][nt]; macc[mt][nt][0] += bflo(g.x) * acc[mt][nt][0]; macc[mt][nt][1] += bfhi(g.x) * acc[mt][nt][1]; macc[mt][nt][2] += bflo(g.y) * acc[mt][nt][2]; macc[mt][nt][3] += bfhi(g.y) * acc[mt][nt][3]; }
        __syncthreads();
        if (s + 1 < nsteps) MG_WRITE();
        if (b == 3) {
#pragma unroll
            for (int mt = 0; mt < 4; ++mt)
#pragma unroll
                for (int nt = 0; nt < 2; ++nt) { st4bf(MB + (size_t)(rt * 128 + wr * 64 + mt * 16 + fr) * 1024 + ct * 128 + wc * 32 + nt * 16 + 4 * fq, macc[mt][nt]); macc[mt][nt] = (f32x4){0.f, 0.f, 0.f, 0.f}; }
        }
    }
    __syncthreads();
#undef MG_LOAD
#undef MG_WRITE
}
constexpr int AT_RPB = 32768, AT_MRG = 40960;
__device__ __forceinline__ int clampi(int v, int lo, int hi) { return v < lo ? lo : (v > hi ? hi : v); }
__device__ __forceinline__ bool at_need(int kind, int jb, int t) { return kind == 2 || (kind == 0 ? (jb < 2 || (jb == 2 && t == 1)) : (jb > 1 || (jb == 1 && t == 0))); }
struct AtCtx { const bf16* QPL; const bf16* KR; const bf16* VV; LAS unsigned char* vbuf; const LAS float* rpbl; int h, qh, fr, fq, lane, b, r, kr0, qrow0, nch, nwin; bool lat; unsigned code[2][2][2]; };
__device__ __forceinline__ unsigned at_keyrow(const AtCtx& X, int ci) { return (ci < X.nwin) ? ((unsigned)X.b * SEQ + (unsigned)(X.kr0 + (ci >> 1)) * 64 + 32 * (ci & 1)) : ((unsigned)ML + X.b * CTXL + 32 * (ci - X.nwin)); }
__device__ __forceinline__ void at_load(const AtCtx& X, int ci, bf16x8 (&kf)[2][2], v4u (&vst)[4]) {
    const unsigned kr = at_keyrow(X, ci);
#pragma unroll
    for (int t = 0; t < 2; ++t)
#pragma unroll
        for (int ks = 0; ks < 2; ++ks) kf[t][ks] = *(const bf16x8*)(X.KR + (unsigned)((kr + 16 * t + X.fr) * 256 + X.h * 64 + ks * 32 + X.fq * 8));
#pragma unroll
    for (int i = 0; i < 4; ++i) { const int p = i * 64 + X.lane, key = p >> 3, seg = p & 7; vst[i] = *(const v4u*)(X.VV + (unsigned)((kr + key) * 256 + X.h * 64 + seg * 8)); }
}
__device__ __forceinline__ void at_chunk(const AtCtx& X, const int ci, bf16x8 (&kf)[2][2], v4u (&vst)[4], bf16x8 (&qf)[2][2], f32x4 (&O)[2][4], float (&m)[2], float (&l)[2]) {
    const int kind = ci < X.nwin ? (ci & 1) : 2, fr = X.fr, fq = X.fq, qh = X.qh;
    if (X.lat && ci == 16) {
#pragma unroll
        for (int j = 0; j < 2; ++j)
#pragma unroll
            for (int ks = 0; ks < 2; ++ks) qf[j][ks] = *(const bf16x8*)(X.QPL + (unsigned)((X.qrow0 + 16 * (2 * qh + j) + fr) * 256 + X.h * 64 + ks * 32 + fq * 8)); }
#pragma unroll
    for (int i = 0; i < 4; ++i) { const int p = i * 64 + X.lane, key = p >> 3, seg = p & 7; *(LAS v4u*)(X.vbuf + key * 128 + ((((seg >> 1) ^ ((key >> 1) & 3))) << 5) + ((seg & 1) << 4)) = vst[i]; }
    f32x4 S[2][2]; bool nd[2][2];
#pragma unroll
    for (int j = 0; j < 2; ++j)
#pragma unroll
        for (int t = 0; t < 2; ++t) { S[j][t] = (f32x4){0.f, 0.f, 0.f, 0.f}; nd[j][t] = at_need(kind, 2 * qh + j, t);
            if (nd[j][t]) { mfma16(S[j][t], kf[t][0], qf[j][0]); mfma16(S[j][t], kf[t][1], qf[j][1]); } }
    asm volatile("s_nop 15\n\ts_nop 15" : "+v"(S[0][0]), "+v"(S[0][1]), "+v"(S[1][0]), "+v"(S[1][1]));
    if (ci + 3 < X.nch) at_load(X, ci + 3, kf, vst);
    const LAS float* rpbrow = X.rpbl + (kind != 2 ? (X.kr0 + (ci >> 1) - X.r + 7) * 31 : 0);
    bf16x8 pf[2]; bool anyj[2];
#pragma unroll
    for (int j = 0; j < 2; ++j) { anyj[j] = nd[j][0] || nd[j][1];
        float mc = -3.0e38f;
#pragma unroll
        for (int t = 0; t < 2; ++t)
#pragma unroll
            for (int rg = 0; rg < 4; ++rg) { float s = S[j][t][rg];
                if (kind != 2) { const unsigned cd = ((kind == 0 ? X.code[0][j][t] : X.code[1][j][t]) >> (8 * rg)) & 255u; const float bias = rpbrow[cd & 31u]; s = cd < 32u ? s + bias : -1.0e30f; }
                S[j][t][rg] = s; mc = fmaxf(mc, s); }
        { auto r16 = __builtin_amdgcn_permlane16_swap(__float_as_uint(mc), __float_as_uint(mc), false, false); mc = fmaxf(__uint_as_float(r16[0]), __uint_as_float(r16[1]));
          auto r32 = __builtin_amdgcn_permlane32_swap(__float_as_uint(mc), __float_as_uint(mc), false, false); mc = fmaxf(__uint_as_float(r32[0]), __uint_as_float(r32[1])); }
        const float mnew = fmaxf(m[j], mc), alpha = __expf(m[j] - mnew); m[j] = mnew; float ls = 0.f;
#pragma unroll
        for (int t = 0; t < 2; ++t)
#pragma unroll
            for (int rg = 0; rg < 4; ++rg) { const float p = __expf(S[j][t][rg] - mnew); S[j][t][rg] = p; ls += p; }
        l[j] = l[j] * alpha + ls;
#pragma unroll
        for (int dt = 0; dt < 4; ++dt) O[j][dt] = O[j][dt] * alpha;
        v4u pw; pw.x = pk2(S[j][0][0], S[j][0][1]); pw.y = pk2(S[j][0][2], S[j][0][3]); pw.z = pk2(S[j][1][0], S[j][1][1]); pw.w = pk2(S[j][1][2], S[j][1][3]);
        pf[j] = __builtin_bit_cast(bf16x8, pw); }
#pragma unroll
    for (int dt = 0; dt < 4; ++dt) { v4i16_t t0, t1;
        { const int key = 4 * fq + (fr >> 2); t0 = __builtin_amdgcn_ds_read_tr16_b64_v4i16((LAS v4i16_t*)(X.vbuf + key * 128 + ((dt ^ ((key >> 1) & 3)) << 5) + (fr & 3) * 8)); }
        { const int key = 16 + 4 * fq + (fr >> 2); t1 = __builtin_amdgcn_ds_read_tr16_b64_v4i16((LAS v4i16_t*)(X.vbuf + key * 128 + ((dt ^ ((key >> 1) & 3)) << 5) + (fr & 3) * 8)); }
        const bf16x8 vf = (bf16x8){t0[0], t0[1], t0[2], t0[3], t1[0], t1[1], t1[2], t1[3]};
        if (anyj[0]) mfma16(O[0][dt], vf, pf[0]);
        if (anyj[1]) mfma16(O[1][dt], vf, pf[1]); }
    asm volatile("s_nop 15\n\ts_nop 7" : "+v"(O[0][0]), "+v"(O[0][1]), "+v"(O[0][2]), "+v"(O[0][3]), "+v"(O[1][0]), "+v"(O[1][1]), "+v"(O[1][2]), "+v"(O[1][3]));
}
__device__ __forceinline__ void attn_unit(PH_ARGS, const int unit) {
    AtCtx X; X.h = wave >> 1; X.qh = wave & 1; X.fr = lane & 15; X.fq = lane >> 4; X.lane = lane;
    X.lat = unit < 256; X.r = 0; X.kr0 = 0;
    if (X.lat) { X.b = unit >> 7; X.r = unit & 127; X.qrow0 = X.b * SEQ + X.r * 64; X.kr0 = clampi(X.r - 4, 0, 120); }
    else { const int u2 = unit - 256; X.b = u2 >> 2; X.qrow0 = ML + X.b * CTXL + (u2 & 3) * 64; }
    X.QPL = WSP(bf16, WS_QPL); const bf16* QROT = WSP(bf16, WS_QROT); X.KR = WSP(bf16, WS_KR); X.VV = WSP(bf16, WS_VV);
    bf16* BRd = WSP(bf16, WS_BR) + (size_t)3 * MT * 256;
    X.vbuf = lds + wave * 4096; X.rpbl = (const LAS float*)(lds + AT_RPB) + X.h * 465;
    X.nch = X.lat ? 24 : 8; X.nwin = X.lat ? 16 : 0;
#pragma unroll
    for (int kd = 0; kd < 2; ++kd)
#pragma unroll
        for (int j = 0; j < 2; ++j)
#pragma unroll
            for (int t = 0; t < 2; ++t) { unsigned cw = 0u; const int jb = 2 * X.qh + j;
#pragma unroll
                for (int rg = 0; rg < 4; ++rg) { const int kcol = 32 * kd + 16 * t + 4 * X.fq + rg, qcol = 16 * jb + X.fr, cst = clampi(qcol - 8, 0, 48); const bool ok = at_need(kd, jb, t) && kcol >= cst && kcol < cst + 16;
                    cw |= (ok ? (unsigned)(clampi(kcol - qcol, -15, 15) + 15) : 255u) << (8 * rg); }
                X.code[kd][j][t] = cw; }
    float m[2], l[2]; f32x4 O[2][4];
#pragma unroll
    for (int j = 0; j < 2; ++j) { m[j] = -3.0e38f; l[j] = 0.f;
#pragma unroll
        for (int dt = 0; dt < 4; ++dt) O[j][dt] = (f32x4){0.f, 0.f, 0.f, 0.f}; }
    bf16x8 qf[2][2];
    { const bf16* Qs = X.lat ? QROT : X.QPL;
#pragma unroll
      for (int j = 0; j < 2; ++j)
#pragma unroll
          for (int ks = 0; ks < 2; ++ks) qf[j][ks] = *(const bf16x8*)(Qs + (unsigned)((X.qrow0 + 16 * (2 * X.qh + j) + X.fr) * 256 + X.h * 64 + ks * 32 + X.fq * 8)); }
    bf16x8 kA[2][2], kB[2][2], kC[2][2]; v4u vA[4], vB[4], vC[4];
    at_load(X, 0, kA, vA); at_load(X, 1, kB, vB); at_load(X, 2, kC, vC);
#pragma unroll 1
    for (int ci = 0; ci < X.nch; ci += 3) {
        at_chunk(X, ci, kA, vA, qf, O, m, l);
        if (ci + 1 < X.nch) at_chunk(X, ci + 1, kB, vB, qf, O, m, l);
        if (ci + 2 < X.nch) at_chunk(X, ci + 2, kC, vC, qf, O, m, l);
    }
#pragma unroll
    for (int j = 0; j < 2; ++j) { l[j] += __shfl_xor(l[j], 16); l[j] += __shfl_xor(l[j], 32); const float inv = 1.f / l[j];
#pragma unroll
        for (int dt = 0; dt < 4; ++dt) st4bf(BRd + (unsigned)((X.qrow0 + 16 * (2 * X.qh + j) + X.fr) * 256 + X.h * 64 + dt * 16 + 4 * X.fq), O[j][dt] * inv); }
}
#ifndef CDFT_REP
#define CDFT_REP 1
#endif
#ifndef CONV_REP
#define CONV_REP 1
#endif
#ifndef GMLP_REP
#define GMLP_REP 1
#endif
#ifndef F1_REP
#define F1_REP 1
#endif
__device__ __forceinline__ int block_excl_scan(int v, LAS int* ws8, int lane, int wave) {
    int x = v;
#pragma unroll
    for (int o = 1; o < 64; o <<= 1) { const int y = __shfl_up(x, o); if (lane >= o) x += y; }
    if (lane == 63) ws8[wave] = x;
    __syncthreads();
    int base = 0;
#pragma unroll
    for (int w = 0; w < 8; ++w) base += (w < wave) ? ws8[w] : 0;
    __syncthreads();
    return base + x - v;
}
template <int PER, bool ALLV>
__device__ __forceinline__ void topk_unit(PH_ARGS, const int rowbase, const int n, const int C, const int e, const int sbase, const bool writepad) {
    const float* AFF = WSP(float, WS_AFF); int* SEL = WSP(int, WS_SEL); int* IDX = WSP(int, WS_IDX); float* GATE = WSP(float, WS_GATE);
    LAS unsigned* hist = (LAS unsigned*)lds; LAS unsigned* sh = hist + 256; LAS int* ws8 = (LAS int*)(hist + 272);
    unsigned key[PER]; bool valid[PER];
#pragma unroll
    for (int i = 0; i < PER; ++i) { const int tok = tid * PER + i; valid[i] = ALLV ? true : (tok < n); key[i] = valid[i] ? __float_as_uint(AFF[(size_t)(rowbase + tok) * 16 + e]) : 0u; }
    unsigned prefix = 0u, mask = 0u, rem = (unsigned)C;
#pragma unroll 1
    for (int pass = 0; pass < 4; ++pass) { const int shift = 24 - 8 * pass;
        if (tid < 256) hist[tid] = 0u;
        __syncthreads();
#pragma unroll
        for (int i = 0; i < PER; ++i) if (valid[i] && (key[i] & mask) == prefix) atomicAdd((unsigned*)&hist[(key[i] >> shift) & 255u], 1u);
        __syncthreads();
        if (wave == 0) { unsigned c0 = hist[255 - 4 * lane], c1 = hist[254 - 4 * lane], c2 = hist[253 - 4 * lane], c3 = hist[252 - 4 * lane];
            const unsigned s = c0 + c1 + c2 + c3; unsigned x = s;
#pragma unroll
            for (int o = 1; o < 64; o <<= 1) { const unsigned y = __shfl_up(x, o); if (lane >= o) x += y; }
            const unsigned excl = x - s;
            if (excl < rem && rem <= x) { unsigned cum = excl; int bin; unsigned nr;
                if (cum + c0 >= rem) { bin = 255 - 4 * lane; nr = rem - cum; }
                else { cum += c0; if (cum + c1 >= rem) { bin = 254 - 4 * lane; nr = rem - cum; }
                else { cum += c1; if (cum + c2 >= rem) { bin = 253 - 4 * lane; nr = rem - cum; }
                else { cum += c2; bin = 252 - 4 * lane; nr = rem - cum; } } }
                sh[0] = (unsigned)bin; sh[1] = nr; } }
        __syncthreads();
        prefix |= sh[0] << shift; mask |= 255u << shift; rem = sh[1];
    }
    __syncthreads();
    const unsigned T = prefix;
    int neq = 0;
#pragma unroll
    for (int i = 0; i < PER; ++i) neq += (valid[i] && key[i] == T) ? 1 : 0;
    const int eqbase = block_excl_scan(neq, ws8, lane, wave);
    unsigned take = 0u; int nsel = 0, eqs = 0;
#pragma unroll
    for (int i = 0; i < PER; ++i) { const bool iseq = valid[i] && key[i] == T; const bool tk = valid[i] && (key[i] > T || (iseq && (unsigned)(eqbase + eqs) < rem)); eqs += iseq ? 1 : 0; if (tk) { take |= 1u << i; ++nsel; } }
    const int sb = block_excl_scan(nsel, ws8, lane, wave);
    int cnt = 0;
#pragma unroll
    for (int i = 0; i < PER; ++i) { const int tok = tid * PER + i;
        if (valid[i]) { if ((take >> i) & 1u) { const int slot = sbase + sb + cnt; ++cnt; IDX[e * ESTR + slot] = rowbase + tok; GATE[e * ESTR + slot] = __uint_as_float(key[i]); SEL[(size_t)(rowbase + tok) * 16 + e] = slot; }
                        else SEL[(size_t)(rowbase + tok) * 16 + e] = -1; } }
    if (writepad) for (int i = tid; i < ESTR - 2112; i += 512) { IDX[e * ESTR + 2112 + i] = 0; GATE[e * ESTR + 2112 + i] = 0.f; }
    __syncthreads();
}
__device__ __forceinline__ void gather_rows(PH_ARGS, const int tpe) {
    const int gw = bid * 8 + wave, NGW = G * 8, per = tpe * 256; const int* IDX = WSP(int, WS_IDX); const bf16* H = WSP(bf16, WS_H); bf16* XE = WSP(bf16, WS_XE);
    for (int i = gw; i < NE * per; i += NGW) { const int e = i / per, s = i % per, rg = e * ESTR + s; const int src = IDX[rg];
        const v4u a = *(const v4u*)(H + (size_t)src * 1024 + lane * 8), b = *(const v4u*)(H + (size_t)src * 1024 + 512 + lane * 8);
        *(v4u*)(XE + (size_t)rg * 1024 + lane * 8) = a; *(v4u*)(XE + (size_t)rg * 1024 + 512 + lane * 8) = b; }
}
struct CRow { v4u yw[4][2]; f32x4 xin[2][2]; float wgt[4]; unsigned long long bm; int cur; };
struct CCtx { const int* SEL; const bf16* YB; const float* X; bf16* H; const float* MOD; float* XO; float* OUT; const float* gnext; int l, lane; };
__device__ __forceinline__ void cr_issue(const CCtx& C, CRow& R, const int row) {
    const int lane = C.lane;
    R.cur = lane < 16 ? C.SEL[(size_t)row * 16 + lane] : -1;
    R.bm = __ballot(R.cur >= 0); const int cnt = __popcll(R.bm);
#pragma unroll
    for (int k = 0; k < 4; ++k) { const bool has = cnt > k; const int e = has ? (int)__builtin_ctzll(R.bm) : 0; if (has) R.bm &= R.bm - 1; const int s = __shfl(R.cur, e); R.wgt[k] = has ? 1.f : 0.f;
        const bf16* y = C.YB + (size_t)(has ? e * ESTR + s : 0) * 1024 + lane * 8; R.yw[k][0] = *(const v4u*)y; R.yw[k][1] = *(const v4u*)(y + 512); }
    const float* xr = C.X + (size_t)row * 1024;
#pragma unroll
    for (int j = 0; j < 2; ++j) { const int o = 8 * lane + 512 * j; R.xin[j][0] = *(const f32x4*)(xr + o); R.xin[j][1] = *(const f32x4*)(xr + o + 4); }
}
__device__ __forceinline__ void cr_finish(const CCtx& C, CRow& R, const int row) {
    const int lane = C.lane, l = C.l; const int r = row < SEQ ? 0 : (row < ML ? 1 : 2);
    float acc[2][8];
#pragma unroll
    for (int j = 0; j < 2; ++j)
#pragma unroll
        for (int i = 0; i < 8; ++i) acc[j][i] = 0.f;
#pragma unroll
    for (int k = 0; k < 4; ++k)
#pragma unroll
        for (int j = 0; j < 2; ++j) { const v4u w = R.yw[k][j]; const float g = R.wgt[k];
            acc[j][0] += g * bflo(w.x); acc[j][1] += g * bfhi(w.x); acc[j][2] += g * bflo(w.y); acc[j][3] += g * bfhi(w.y); acc[j][4] += g * bflo(w.z); acc[j][5] += g * bfhi(w.z); acc[j][6] += g * bflo(w.w); acc[j][7] += g * bfhi(w.w); }
    while (R.bm) { const int e = (int)__builtin_ctzll(R.bm); R.bm &= R.bm - 1; const int s = __shfl(R.cur, e); const bf16* y = C.YB + (size_t)(e * ESTR + s) * 1024 + lane * 8;
#pragma unroll
        for (int j = 0; j < 2; ++j) { const v4u w = *(const v4u*)(y + 512 * j);
            acc[j][0] += bflo(w.x); acc[j][1] += bfhi(w.x); acc[j][2] += bflo(w.y); acc[j][3] += bfhi(w.y); acc[j][4] += bflo(w.z); acc[j][5] += bfhi(w.z); acc[j][6] += bflo(w.w); acc[j][7] += bfhi(w.w); } }
    const float* gt2 = C.MOD + (l * 3 + r) * 6144 + 5 * 1024;
    float xv[2][8]; float ss = 0.f;
#pragma unroll
    for (int j = 0; j < 2; ++j) { const int o = 8 * lane + 512 * j; const f32x4 g0 = *(const f32x4*)(gt2 + o), g1 = *(const f32x4*)(gt2 + o + 4);
#pragma unroll
        for (int i = 0; i < 4; ++i) { xv[j][i] = R.xin[j][0][i] + g0[i] * acc[j][i]; xv[j][4 + i] = R.xin[j][1][i] + g1[i] * acc[j][4 + i]; }
#pragma unroll
        for (int i = 0; i < 8; ++i) ss += xv[j][i] * xv[j][i]; }
    const float rs = 1.0f / sqrtf(wave_sum(ss) * (1.f / 1024.f) + 1e-6f);
    if (l == 0) {
        const float* md = C.MOD + (1 * 3 + r) * 6144; float* xw = C.XO + (size_t)row * 1024;
#pragma unroll
        for (int j = 0; j < 2; ++j) { const int o = 8 * lane + 512 * j;
            *(f32x4*)(xw + o) = (f32x4){xv[j][0], xv[j][1], xv[j][2], xv[j][3]}; *(f32x4*)(xw + o + 4) = (f32x4){xv[j][4], xv[j][5], xv[j][6], xv[j][7]};
            const f32x4 g0 = *(const f32x4*)(C.gnext + o), g1 = *(const f32x4*)(C.gnext + o + 4), c0 = *(const f32x4*)(md + 1024 + o), c1 = *(const f32x4*)(md + 1024 + o + 4), h0 = *(const f32x4*)(md + o), h1 = *(const f32x4*)(md + o + 4);
            float hv[8];
#pragma unroll
            for (int i = 0; i < 4; ++i) { hv[i] = xv[j][i] * rs * g0[i] * (1.f + c0[i]) + h0[i]; hv[4 + i] = xv[j][4 + i] * rs * g1[i] * (1.f + c1[i]) + h1[i]; }
            v4u w; w.x = pk2(hv[0], hv[1]); w.y = pk2(hv[2], hv[3]); w.z = pk2(hv[4], hv[5]); w.w = pk2(hv[6], hv[7]);
            *(v4u*)(C.H + (size_t)row * 1024 + o) = w; }
    } else {
        float* orow = C.OUT + (size_t)row * 1024;
#pragma unroll
        for (int j = 0; j < 2; ++j) { const int o = 8 * lane + 512 * j; const f32x4 g0 = *(const f32x4*)(C.gnext + o), g1 = *(const f32x4*)(C.gnext + o + 4);
            *(f32x4*)(orow + o) = (f32x4){xv[j][0] * rs * g0[0], xv[j][1] * rs * g0[1], xv[j][2] * rs * g0[2], xv[j][3] * rs * g0[3]};
            *(f32x4*)(orow + o + 4) = (f32x4){xv[j][4] * rs * g1[0], xv[j][5] * rs * g1[1], xv[j][6] * rs * g1[2], xv[j][7] * rs * g1[3]}; }
    }
}
template <bool DUMMY>
__device__ __forceinline__ void combine_rows(PH_ARGS, const int l) {
    const int gw = bid * 8 + wave, NGW = G * 8; const int nrows = l == 0 ? MT : ML;
    CCtx C; C.SEL = WSP(int, WS_SEL); C.YB = WSP(bf16, WS_XE); C.X = WSP(float, WS_X); C.H = DUMMY ? WSP(bf16, WS_BR) : WSP(bf16, WS_H); C.MOD = WSP(float, WS_MOD);
    C.XO = DUMMY ? WSP(float, WS_ACT) : WSP(float, WS_X); C.OUT = DUMMY ? WSP(float, WS_ACT) : PTRV(28, float); C.gnext = l == 0 ? INP(6) + 1024 : INP(27); C.l = l; C.lane = lane;
    CRow A, B; int row = gw;
    if (row < nrows) cr_issue(C, A, row);
    while (row < nrows) {
        const int r2 = row + NGW; if (r2 < nrows) cr_issue(C, B, r2);
        cr_finish(C, A, row);
        const int r3 = r2 + NGW; if (r3 < nrows) cr_issue(C, A, r3);
        if (r2 < nrows) cr_finish(C, B, r2);
        row = r3;
    }
}

#ifdef DBG_STOP
__device__ __forceinline__ void debug_out(PH_ARGS) {
    float* out = PTRV(28, float);
    const int gt = bid * 512 + tid, GT = G * 512;
    for (size_t i = gt; i < (size_t)ML * 1024; i += GT) { const size_t row = i >> 10; const int c = (int)(i & 1023); float v = 0.f;
#if DBG_STOP == 2
        v = bflo(WSP(bf16, WS_H)[row * 1024 + c]) + WSP(float, WS_MOD)[(i % 36864)] + bflo(WSP(bf16, WS_WIN)[i % (6400 * 1024)]) + bflo(WSP(bf16, WS_WGU)[i]) + bflo(WSP(bf16, WS_WDN)[i]) + bflo(WSP(bf16, WS_WO)[i % (1024*1024)]) + bflo(WSP(bf16, WS_WBR)[i % (1024*1024)]);
#elif DBG_STOP == 3
        v = bflo(WSP(bf16, WS_AUV)[row * 512 + (c & 511)]) + bflo(WSP(bf16, WS_YF)[row * 512 + (c & 511)]) + bflo(WSP(bf16, WS_CY)[row * 256 + (c & 255)]) + bflo(WSP(bf16, WS_QPL)[row * 256 + (c & 255)])
          + bflo(WSP(bf16, WS_QROT)[row * 256 + (c & 255)]) + bflo(WSP(bf16, WS_KR)[row * 256 + (c & 255)]) + bflo(WSP(bf16, WS_VV)[row * 256 + (c & 255)])
          + bflo(WSP(bf16, WS_G)[row * 4096 + c]) + bflo(WSP(bf16, WS_G)[row * 4096 + 1024 + c]) + bflo(WSP(bf16, WS_G)[row * 4096 + 2048 + c]) + bflo(WSP(bf16, WS_G)[row * 4096 + 3072 + c]);
#elif DBG_STOP == 4
        v = bflo(WSP(bf16, WS_BR)[(size_t)(0 * MT + row) * 256 + (c & 255)]) + bflo(WSP(bf16, WS_BR)[(size_t)(2 * MT + row) * 256 + (c & 255)]) + bflo(WSP(bf16, WS_FA)[i % ((size_t)8 << 20)]);
#elif DBG_STOP == 21
        v = bflo(WSP(bf16, WS_T1T)[i % 16384]) * 1.001f + WSP(float, WS_ROPEC)[i % 2048] + WSP(float, WS_ROPES)[i % 2048] + bflo(WSP(bf16, WS_WSP)[i % 65536]);
#elif DBG_STOP == 31 || DBG_STOP == 44
        v = 0.f;
#elif DBG_STOP == 45 || DBG_STOP == 32
        v = 0.f;
#elif DBG_STOP == 41
        v = bflo(WSP(bf16, WS_BR)[(size_t)(0 * MT + row) * 256 + (c & 255)]) * 1.001f + bflo(WSP(bf16, WS_BR)[(size_t)(0 * MT + row) * 256 + ((c + 7) & 255)]);
#elif DBG_STOP == 42
        v = bflo(WSP(bf16, WS_BR)[(size_t)(2 * MT + row) * 256 + (c & 255)]) * 1.001f + bflo(WSP(bf16, WS_BR)[(size_t)(2 * MT + row) * 256 + ((c + 7) & 255)]);
#elif DBG_STOP == 43
        v = bflo(WSP(bf16, WS_FA)[i % ((size_t)8 << 20)]) * 1.001f + bflo(WSP(bf16, WS_FA)[(i + 7) % ((size_t)8 << 20)]);
#elif DBG_STOP == 5
        v = bflo(WSP(bf16, WS_BR)[(size_t)(1 * MT + row) * 256 + (c & 255)]) + bflo(WSP(bf16, WS_BR)[(size_t)(3 * MT + row) * 256 + (c & 255)]);
#elif DBG_STOP == 6
        v = bflo(WSP(bf16, WS_MB)[row * 1024 + c]);
#elif DBG_STOP == 7
        v = WSP(float, WS_X)[row * 1024 + c];
#elif DBG_STOP == 8
        v = bflo(WSP(bf16, WS_H)[row * 1024 + c]) + WSP(float, WS_AFF)[row * 16 + (c & 15)];
#elif DBG_STOP == 9
        v = (float)WSP(int, WS_SEL)[row * 16 + (c & 15)] + WSP(float, WS_GATE)[i % (16 * 2304)] + (float)WSP(int, WS_IDX)[i % (16 * 2304)];
#elif DBG_STOP == 10
        v = bflo(WSP(bf16, WS_XE)[i]) + bflo(WSP(bf16, WS_XE)[i + (size_t)ML * 1024]);
#elif DBG_STOP == 11
        v = bflo(WSP(bf16, WS_ACT)[i]) + bflo(WSP(bf16, WS_ACT)[i + (size_t)ML * 1024]);
#elif DBG_STOP == 12
        v = bflo(WSP(bf16, WS_XE)[i]) + bflo(WSP(bf16, WS_XE)[i + (size_t)ML * 1024]);
#else
        v = WSP(float, WS_X)[row * 1024 + c] + bflo(WSP(bf16, WS_H)[row * 1024 + c]);
#endif
#ifdef DBG_AMP
        v = (float)(__float_as_uint(v) & 0xFFFFu);
#endif
        out[i] = v; }
}
#endif
__global__ void __launch_bounds__(512, 2) mega(Args A) {
    extern __shared__ __attribute__((aligned(16))) unsigned char lds_raw[];
    LAS unsigned char* lds0 = (LAS unsigned char*)lds_raw;
    volatile LAS unsigned* MISC = (volatile LAS unsigned*)(lds0 + MISC_OFF);
    const int tid = threadIdx.x, lane = tid & 63, wave = __builtin_amdgcn_readfirstlane(tid >> 6), bid = blockIdx.x, G = gridDim.x;
    for (int u = tid; u < (LDS_BYTES - MISC_OFF) / 4; u += 512) ((LAS unsigned*)(lds0 + MISC_OFF))[u] = 0u;
    __syncthreads();
    if (tid == 0) { typedef unsigned u2v_t __attribute__((ext_vector_type(2)));
#pragma unroll
        for (int i = 0; i < 30; ++i) { const unsigned long long p = i < 28 ? (unsigned long long)A.in[i] : (i == 28 ? (unsigned long long)A.out : (unsigned long long)A.ws);
            *(LAS u2v_t*)(lds0 + PTAB_OFF + 8 * i) = (u2v_t){(unsigned)p, (unsigned)(p >> 32)}; } }
    __syncthreads();
    const int lo = A.ph_lo, hi = A.ph_hi;
    XcdBarrier bar; bar.bar = (unsigned*)(A.ws + WS_CTL) + CW_BAR; bar.x = 0; bar.st = nullptr;
    if (hi - lo > 1) bar = xcd_barrier_post((unsigned*)(A.ws + WS_CTL) + CW_BAR, MISC + 8);
#define PH_CALL lds, tl_, (tl_ & 63), wv_, bl_, G_
#define PH_CALLV lds, tl_, (tl_ & 63), wv_, vb_, G_
#ifdef TS_I
    if (bid == 0 && tid == 0) ((unsigned long long*)(A.ws + 65536))[lo] = rt();
#endif
#pragma unroll 1
#ifdef REP_PH
    for (int it_ = lo; it_ < hi + (REP_N - 1); ++it_) { const int ph = it_ < REP_PH ? it_ : (it_ < REP_PH + REP_N ? REP_PH : it_ - (REP_N - 1));
#else
    for (int ph = lo; ph < hi; ++ph) {
#endif
        int tl_ = tid; asm volatile("" : "+v"(tl_)); int bl_ = bid; asm volatile("" : "+s"(bl_)); int vb_ = (G % 8 == 0) ? (bid % 8) * (G / 8) + bid / 8 : bid; asm volatile("" : "+s"(vb_)); int wv_ = wave; asm volatile("" : "+s"(wv_)); int G_ = G; asm volatile("" : "+s"(G_)); unsigned ldsb_ = (unsigned)(uintptr_t)lds0; asm volatile("" : "+s"(ldsb_)); LAS unsigned char* lds = (LAS unsigned char*)(uintptr_t)ldsb_;
        const int l = ph < 13 ? 0 : 1, kind = ph >= 99 ? 99 : (ph < 2 ? ph : 2 + (ph - 2 - 11 * l));
        const int ntm = l == 0 ? 66 : 64, tpe = l == 0 ? 9 : 8;
        if (kind == 9) continue;
        switch (kind) {
#ifdef DBG_STOP
        case 99: debug_out(PH_CALL); break;
#endif
        case 0: {
#ifndef P0R_MOD
#define P0R_MOD 1
#endif
#ifndef P0R_TAB
#define P0R_TAB 1
#endif
#ifndef P0R_CVT
#define P0R_CVT 1
#endif
#pragma unroll 1
            for (int r_ = 0; r_ < P0R_MOD; ++r_) { mod_gemv(PH_CALL); asm volatile("" ::: "memory"); }
#pragma unroll 1
            for (int r_ = 0; r_ < P0R_TAB; ++r_) { make_tables(PH_CALL); asm volatile("" ::: "memory"); }
#pragma unroll 1
            for (int r_ = 0; r_ < P0R_CVT; ++r_) { convert_weights(PH_CALL, 0); asm volatile("" ::: "memory"); }
        } break;
        case 1: {
#ifndef DIS_N1
            norm1_l0(PH_CALL);
#endif
        } break;
        case 2: {
            pg8::Gemm g{WSP(bf16, WS_H), WSP(bf16, WS_WIN), MT, NIN, 1024}; pg8::StaticOrder S; S.init(MT, NIN, G_, bl_);
            EpiIn E{WSP(bf16, WS_AUV), WSP(bf16, WS_YF), WSP(bf16, WS_CY), WSP(bf16, WS_QPL), WSP(bf16, WS_QROT), WSP(bf16, WS_KR), WSP(bf16, WS_VV), WSP(bf16, WS_G), WSP(float, WS_ROPEC), WSP(float, WS_ROPES)};
#ifndef DIS_GIN
            pg8::gemm_phase<EpiIn, pg8::StaticOrder, true, true>(lds, g, S, E);
#endif
        } break;
        case 3: {
#ifndef DIS_F1
            if (bl_ < 256) { f1_stage_tables(PH_CALL);
#pragma unroll 1
              for (int r_ = 0; r_ < F1_REP; ++r_) for (int u = vb_; u < 256; u += G_) f1_unit(PH_CALL, u); }
#endif
            const int nconv = l == 0 ? 264 : 256, ngm = l == 0 ? 132 : 128;
#ifndef DIS_CONV
#pragma unroll 1
            for (int r_ = 0; r_ < CONV_REP; ++r_) for (int u = vb_; u < nconv; u += G_) conv_unit(PH_CALL, l, u);
#endif
#ifndef DIS_GMLP
#pragma unroll 1
            for (int r_ = 0; r_ < GMLP_REP; ++r_) for (int u = G_ - 1 - vb_; u < ngm; u += G_) gmlp_unit(PH_CALL, l, u);
#endif
#ifndef DIS_CDFT
            if (l == 0) ctx_butterfly(PH_CALL);
#endif
        } break;
        case 4: {
#ifndef DIS_F2
#ifndef F2_REP
#define F2_REP 1
#endif
#ifndef ATT_REP
#define ATT_REP 1
#endif
#pragma unroll 1
            for (int r_ = 0; r_ < F2_REP; ++r_) { const int nf2 = l == 0 ? 264 : 256; for (int u = vb_; u < nf2; u += G_) f2_unit(PH_CALL, u); }
#endif
            { LAS float* rp = (LAS float*)(lds + AT_RPB); const float* src = INP(20) + l * 1860; for (int i = tl_; i < 1860; i += 512) rp[i] = src[i]; }
            __syncthreads();
            const int nat = l == 0 ? 264 : 256;
#ifndef DIS_ATT
#pragma unroll 1
            for (int r_ = 0; r_ < ATT_REP; ++r_) for (int u = vb_; u < nat; u += G_) attn_unit(PH_CALL, u);
#endif
        } break;
        case 5: {
#ifndef DIS_GMRG
#ifndef MERGE_PG8
            merge_phase(PH_CALLV, ntm * 16);
#else
            { pg8::Gemm g{WSP(bf16, WS_BR), WSP(bf16, WS_WBR), 4 * MT, 4096, 256}; MergeOrder S; S.init(ntm, G_, bl_); EpiMergeH E{WSP(bf16, WS_G), WSP(bf16, WS_MB)};
              pg8::gemm_phase<EpiMergeH, MergeOrder, true, true>(lds, g, S, E); }
#endif
#endif
        } break;
        case 6: {
            pg8::Gemm g{WSP(bf16, WS_MB), WSP(bf16, WS_WO), ntm * 256, 1024, 1024}; pg8::StaticOrder S; S.init(ntm * 256, 1024, G_, bl_);
            EpiWout E{l == 0 ? INP(0) : WSP(float, WS_X), l == 0 ? INP(2) : WSP(float, WS_X) + (size_t)ML * 1024, WSP(float, WS_X), WSP(float, WS_MOD) + l * 3 * 6144};
#ifndef DIS_GWO
            pg8::gemm_phase<EpiWout, pg8::StaticOrder, true, true>(lds, g, S, E);
#endif
#ifndef DIS_CVT
            if (l == 0) { const int nx = (ntm * 4) % G_; convert_range(lds, tl_, (tl_ & 63), wv_, bl_, G_, 1, CV_FOLD0, CV_WO0, nx ? bl_ - nx : bl_, G_ - nx); }
#endif
        } break;
        case 7: {
#ifndef DIS_N2
            norm2_router(PH_CALL, l, ntm * 256);
#endif
        } break;
        case 8: {
#ifndef DIS_TOPK
            const int nun = l == 0 ? 64 : 32;
            for (int u = bl_; u < nun; u += G_) {
                if (u < 32) { const int b = u >> 4, e = u & 15; topk_unit<16, true>(PH_CALL, b * SEQ, SEQ, CAPL, e, b * CAPL, l == 0 && b == 0); }
                else { const int b = (u - 32) >> 4, e = u & 15; topk_unit<1, false>(PH_CALL, ML + b * CTXL, CTXL, CAPC, e, 2048 + b * CAPC, false); }
            }
#endif
        } break;
        case 9: {
#ifndef DIS_GATH
            gather_rows(PH_CALL, tpe);
#endif
        } break;
        case 10: {
            pg8::Gemm g{WSP(bf16, WS_H), WSP(bf16, WS_WGU), NE * ESTR, NE * 2048, 1024, WSP(int, WS_IDX)}; GroupOrder S; S.init(tpe, 8, G_, bl_);
            EpiGU E{WSP(bf16, WS_ACT)};
#ifndef DIS_GGU
            pg8::gemm_phase<EpiGU, GroupOrder, true, true, true>(lds, g, S, E);
#endif
#ifndef DIS_CVT
            if (l == 0) { const int nx = (NE * tpe * 8) % G_; convert_range(lds, tl_, (tl_ & 63), wv_, bl_, G_, 1, CV_WO0, CV_GU0, nx ? bl_ - nx : bl_, G_ - nx);
                          convert_range(lds, tl_, (tl_ & 63), wv_, bl_, G_, 1, CV_SP0, CV_END, nx ? bl_ - nx : bl_, G_ - nx); }
#endif
        } break;
        case 11: {
            pg8::Gemm g{WSP(bf16, WS_ACT), WSP(bf16, WS_WDN), NE * ESTR, NE * 1024, 1024}; GroupOrder S; S.init(tpe, 4, G_, bl_);
            EpiDown E{WSP(bf16, WS_XE), WSP(float, WS_GATE)};
#ifndef DIS_GDN
            pg8::gemm_phase<EpiDown, GroupOrder, true, true>(lds, g, S, E);
#endif
#ifndef DIS_CVT
            if (l == 0) { const int nx = (NE * tpe * 4) % G_; convert_range(lds, tl_, (tl_ & 63), wv_, bl_, G_, 1, CV_GU0, CV_DN0, nx ? bl_ - nx : bl_, G_ - nx); }
#endif
        } break;
        default: {
#ifndef DIS_COMB
#ifdef COMB_REP
#pragma unroll 1
            for (int r_ = 0; r_ < COMB_REP; ++r_) combine_rows<true>(PH_CALL, l);
#endif
            combine_rows<false>(PH_CALL, l);
#endif
#ifndef DIS_CVT
            if (l == 0) convert_range(lds, tl_, (tl_ & 63), wv_, bl_, G_, 1, CV_DN0, CV_SP0, bl_, G_);
#endif
        } break;
        }
#ifdef XBAR
        if (ph == 1) { for (int xb_ = 0; xb_ < XBAR; ++xb_) { XcdBarrier b5 = bar; b5.bar = (unsigned*)(PTRV(29, unsigned char) + WS_CTL) + CW_BAR; b5.st = (volatile LAS unsigned*)(lds + MISC_OFF) + 8; xcd_barrier(b5); } }
#endif
#ifdef TS_I
        { XcdBarrier b3 = bar; b3.bar = (unsigned*)(PTRV(29, unsigned char) + WS_CTL) + CW_BAR; b3.st = (volatile LAS unsigned*)(lds + MISC_OFF) + 8; xcd_barrier(b3);
          if (bid == 0 && tid == 0) ((unsigned long long*)(PTRV(29, unsigned char) + 65536))[ph + 1] = rt(); }
        if (ph + 1 == hi) { XcdBarrier b3 = bar; b3.bar = (unsigned*)(PTRV(29, unsigned char) + WS_CTL) + CW_BAR; b3.st = (volatile LAS unsigned*)(lds + MISC_OFF) + 8; xcd_barrier(b3);
            const unsigned long long* TS = (const unsigned long long*)(PTRV(29, unsigned char) + 65536);
            const float dti = (float)(TS[TS_I + 1] - TS[TS_I]) * 0.01f, dtj = (float)(TS[TS_J + 1] - TS[TS_J]) * 0.01f;
            float* out = PTRV(28, float); const float Av = sqrtf(dti);
            for (size_t i = (size_t)bid * 512 + tid; i < (size_t)ML * 1024; i += (size_t)G * 512) out[i] = (i == 0) ? dtj * 10.f : Av; }
        if (0) {
#else
#ifdef REP_PH
        if (it_ + 1 < hi + (REP_N - 1)) {
#else
        if (ph + 1 < hi) {
#endif
#endif
          XcdBarrier b2 = bar; b2.bar = (unsigned*)(PTRV(29, unsigned char) + WS_CTL) + CW_BAR; unsigned bx_ = bar.x; asm volatile("" : "+s"(bx_)); b2.x = bx_; b2.st = (volatile LAS unsigned*)(lds + MISC_OFF) + 8; xcd_barrier(b2); }
    }
}

extern "C" void kernel_launch(void* const* d_in, const int* in_sizes, int n_in, void* d_out, int out_size, void* d_ws, size_t ws_size, hipStream_t stream) {
    static int grid = 0;
    if (grid == 0) {
        if (n_in != 28 || ws_size < WS_END) { fprintf(stderr, "kernel_launch: unexpected n_in %d / ws %zu\n", n_in, ws_size); grid = -1; return; }
        int dev = 0, cus = 0;
        if (hipGetDevice(&dev) != hipSuccess || hipDeviceGetAttribute(&cus, hipDeviceAttributeMultiprocessorCount, dev) != hipSuccess) { grid = -1; return; }
        if (hipFuncSetAttribute((const void*)mega, hipFuncAttributeMaxDynamicSharedMemorySize, LDS_BYTES) != hipSuccess) { fprintf(stderr, "kernel_launch: hipFuncSetAttribute failed\n"); grid = -1; return; }
        (void)hipGetLastError();
        grid = cus;
    }
    if (grid < 0) return;
    (void)hipMemsetAsync((char*)d_ws + WS_CTL, 0, CTL_ZERO_BYTES, stream);
    Args a{};
    for (int i = 0; i < 28; ++i) a.in[i] = (const float*)d_in[i];
    a.out = (float*)d_out; a.ws = (unsigned char*)d_ws;
#ifdef DBG_STOP
    for (int p = 0; p < (DBG_STOP > 20 ? DBG_STOP / 10 : DBG_STOP); ++p) { a.ph_lo = p; a.ph_hi = p + 1; hipLaunchKernelGGL(mega, dim3(grid), dim3(512), LDS_BYTES, stream, a); }
    a.ph_lo = 99; a.ph_hi = 100; hipLaunchKernelGGL(mega, dim3(grid), dim3(512), LDS_BYTES, stream, a);
#elif N_LAUNCHES == 1
    a.ph_lo = 0; a.ph_hi = NPH;
    hipLaunchKernelGGL(mega, dim3(grid), dim3(512), LDS_BYTES, stream, a);
#else
    for (int p = 0; p < NPH; ++p) { a.ph_lo = p; a.ph_hi = p + 1; hipLaunchKernelGGL(mega, dim3(grid), dim3(512), LDS_BYTES, stream, a); }
#endif
}
```

```cpp
#include <hip/hip_runtime.h>
#include <cstdio>
#include <cstdint>
#define N_LAUNCHES 1
namespace pg8 {
#define PG8_LAS __attribute__((address_space(3)))
typedef unsigned short bf16_t;
typedef short bf16x8 __attribute__((ext_vector_type(8)));
typedef float f32x4 __attribute__((ext_vector_type(4)));
typedef unsigned u32x4 __attribute__((ext_vector_type(4)));
constexpr int BM = 256, BK = 64, HALF = 128, HTB = HALF * BK * 2  , STAGE_BYTES = 8 * HTB, NXCD = 8, WGM = 8;

__host__ __device__ __forceinline__ int lds_byte(int r, int c) { const int st = (r >> 4) * 2 + (c >> 5), rr = r & 15, cc = c & 31, ob = rr * 64 + cc * 2; return st * 1024 + (ob ^ (((ob >> 9) & 1) << 5)); }
__host__ __device__ __forceinline__ void stage_rc(int b, int& R, int& C) { const int st = b / 1024, sb = b % 1024, swz = sb ^ (((sb >> 9) & 1) << 5); R = (st >> 1) * 16 + swz / 64; C = (st & 1) * 32 + (swz % 64) / 2; }
__host__ __device__ __forceinline__ int perm32(int rho) { const int n = rho >> 4, i = rho & 15; return 8 * (i >> 2) + 4 * n + (i & 3); }

struct Unit { int pm, pn; };
struct Gemm { const bf16_t* A; const bf16_t* Bt; int M, N, K; const int* gidx = nullptr; };

struct StaticOrder {
    int nM, nN, nwg, G, c;
    __host__ __device__ void init(int M, int N, int G_, int c_) { nM = M / BM; nN = N / BM; nwg = nM * nN; G = G_; c = c_; }
    __host__ __device__ bool next(int i, Unit& u) const {
        const long L = (long)i * G + c; if (L >= nwg) return false;
        int wgid = (int)L; { const int q = nwg / NXCD, r = nwg % NXCD, xcd = wgid % NXCD, off = wgid / NXCD; wgid = (xcd < r ? xcd * (q + 1) : r * (q + 1) + (xcd - r) * q) + off; }
        const int nig = WGM * nN, gid = wgid / nig, fm = gid * WGM, gsz = (nM - fm) < WGM ? (nM - fm) : WGM;
        u.pm = fm + ((wgid % nig) % gsz); u.pn = (wgid % nig) / gsz; return true;
    }
    __device__ __forceinline__ void a_ready(const Unit&) const {}
    __device__ __forceinline__ void done(const Unit&) const {}
};
__device__ __forceinline__ unsigned cvt_pk_bf16(float lo, float hi) { unsigned r; asm volatile("v_cvt_pk_bf16_f32 %0, %1, %2" : "=v"(r) : "v"(lo), "v"(hi)); return r; }
typedef float f32x2 __attribute__((ext_vector_type(2)));
template <class Epi, class Sched, bool ALIGN_EPI = false, bool SP2 = false, bool GATHER = false>
__device__ __forceinline__ void gemm_phase(PG8_LAS unsigned char* lds, const Gemm g, const Sched& S, const Epi& E) {
    int tid_l = threadIdx.x; asm volatile("" : "+v"(tid_l));
    const int tid = tid_l, wid = __builtin_amdgcn_readfirstlane(tid >> 6), lane = tid & 63, wr = wid >> 2, wc = wid & 3, fr = lane & 15, fq = lane >> 4;
    const int K = g.K, nt = K / BK;
    unsigned voffA[2], voffB[2];
#pragma unroll
    for (int i = 0; i < 2; ++i) { int R, C; stage_rc(tid * 16 + i * 8192, R, C); const int Rb = Epi::PERM ? ((R & ~31) + perm32(R & 31)) : R;
        voffA[i] = (unsigned)(R * K + C) * 2u; voffB[i] = (unsigned)(Rb * K + C) * 2u; }
    const size_t kstep = (size_t)(BK * 2);
    const size_t hstep = (size_t)HALF * K * 2;
    const size_t tstep = 2 * hstep;
    const unsigned ldsw = (unsigned)wid * 1024u;
    const int aoff = lds_byte(wr * 64 + fr, fq * 8), boff = lds_byte(wc * 32 + fr, fq * 8);
#define PG8_SA(b, h) (((b) * 2 + (h)) * HTB)
#define PG8_SB(b, h) ((4 + (b) * 2 + (h)) * HTB)
#define PG8_STAGE(bufoff, gbase, voff) do { _Pragma("unroll") for (int _i = 0; _i < 2; ++_i) \
        __builtin_amdgcn_global_load_lds((const unsigned*)((const char*)(gbase) + (voff)[_i]), (PG8_LAS unsigned*)(lds + (bufoff) + ldsw + _i * 8192), 16, 0, 0); } while (0)
    static_assert(!GATHER || SP2, "GATHER is implemented on the SP2 loop only");
    unsigned vgc[2][2] = {{0u, 0u}, {0u, 0u}}, vgn[2][2] = {{0u, 0u}, {0u, 0u}};
#define PG8_GLOAD(u, v) do { _Pragma("unroll") for (int _h = 0; _h < 2; ++_h) _Pragma("unroll") for (int _i = 0; _i < 2; ++_i) { int R_, C_; stage_rc(tid * 16 + _i * 8192, R_, C_); \
        v[_h][_i] = (unsigned)(g.gidx[(u).pm * BM + _h * HALF + R_] * K + C_) * 2u; } } while (0)
#define PG8_STAGE_A(bufoff, base, half, NEXT) do { if constexpr (GATHER) { if (NEXT) PG8_STAGE(bufoff, base, vgn[half]); else PG8_STAGE(bufoff, base, vgc[half]); } \
        else PG8_STAGE(bufoff, (base) + (half) * hstep, voffA); } while (0)
#define PG8_LDA(dst, b, h) do { _Pragma("unroll") for (int m = 0; m < 4; ++m) _Pragma("unroll") for (int k = 0; k < 2; ++k) dst[m][k] = *(const PG8_LAS bf16x8*)(lds + PG8_SA(b, h) + aoff + m * 2048 + k * 1024); } while (0)
#define PG8_LDB(dst, b, h) do { _Pragma("unroll") for (int n = 0; n < 2; ++n) _Pragma("unroll") for (int k = 0; k < 2; ++k) dst[n][k] = *(const PG8_LAS bf16x8*)(lds + PG8_SB(b, h) + boff + n * 2048 + k * 1024); } while (0)
#define PG8_MMA(ai, bj, At, Bt) do { __builtin_amdgcn_s_setprio(1); _Pragma("unroll") for (int m = 0; m < 4; ++m) _Pragma("unroll") for (int n = 0; n < 2; ++n) _Pragma("unroll") for (int k = 0; k < 2; ++k) \
        acc[ai][bj][m][n] = __builtin_amdgcn_mfma_f32_16x16x32_bf16(Bt[n][k], At[m][k], acc[ai][bj][m][n], 0, 0, 0); __builtin_amdgcn_s_setprio(0); } while (0)
#define PG8_WAIT_V(n) asm volatile("s_waitcnt vmcnt(" #n ")" ::: "memory")
#define PG8_WAIT_L(n) asm volatile("s_waitcnt lgkmcnt(" #n ")" ::: "memory")
#define PG8_BAR __builtin_amdgcn_s_barrier()
#define PG8_SCHED __builtin_amdgcn_sched_barrier(0)
    Unit cur, nxt; int ui = 0;
    if (!S.next(0, cur)) return;
    f32x4 acc[2][2][4][2];
#pragma unroll
    for (int a = 0; a < 2; ++a)
#pragma unroll
        for (int b = 0; b < 2; ++b)
#pragma unroll
            for (int m = 0; m < 4; ++m)
#pragma unroll
                for (int n = 0; n < 2; ++n) acc[a][b][m][n] = (f32x4){0.f, 0.f, 0.f, 0.f};
    bf16x8 At[4][2], B0[2][2], B1[2][2];
    const char* cA = GATHER ? (const char*)g.A : (const char*)g.A + (size_t)cur.pm * tstep; const char* cB = (const char*)g.Bt + (size_t)cur.pn * tstep;
    if constexpr (GATHER) { PG8_GLOAD(cur, vgc); }
    S.a_ready(cur);
    if constexpr (SP2) {
        PG8_STAGE(PG8_SB(0, 0), cB, voffB); PG8_STAGE(PG8_SB(0, 1), cB + hstep, voffB); PG8_STAGE_A(PG8_SA(0, 0), cA, 0, false); PG8_STAGE_A(PG8_SA(0, 1), cA, 1, false);
        if (wr == 1) PG8_BAR;
        PG8_WAIT_V(2); PG8_BAR;
        PG8_STAGE(PG8_SB(1, 0), cB + kstep, voffB); PG8_STAGE_A(PG8_SA(1, 0), cA + kstep, 0, false); PG8_STAGE(PG8_SB(1, 1), cB + hstep + kstep, voffB);
        PG8_WAIT_V(6); PG8_BAR;
    } else {
        PG8_STAGE(PG8_SB(0, 0), cB, voffB); PG8_STAGE(PG8_SA(0, 0), cA, voffA); PG8_STAGE(PG8_SB(0, 1), cB + hstep, voffB); PG8_STAGE(PG8_SA(0, 1), cA + hstep, voffA);
        if (wr == 1) PG8_BAR;
        PG8_WAIT_V(4); PG8_BAR;
        PG8_STAGE(PG8_SB(1, 0), cB + kstep, voffB); PG8_STAGE(PG8_SA(1, 0), cA + kstep, voffA); PG8_STAGE(PG8_SB(1, 1), cB + hstep + kstep, voffB);
        PG8_WAIT_V(6); PG8_BAR;
    }
    for (;;) {
        const bool has_next = S.next(ui + 1, nxt);
        const char* nA = GATHER ? (const char*)g.A : (has_next ? (const char*)g.A + (size_t)nxt.pm * tstep : cA);
        if constexpr (GATHER) { if (has_next) { PG8_GLOAD(nxt, vgn); } else { _Pragma("unroll") for (int _h = 0; _h < 2; ++_h) _Pragma("unroll") for (int _i = 0; _i < 2; ++_i) vgn[_h][_i] = vgc[_h][_i]; } } const char* nB = has_next ? (const char*)g.Bt + (size_t)nxt.pn * tstep : cB;
#pragma unroll 1
        for (int t = 0; t < nt; t += 2) {
            const bool last = (t == nt - 2);
            const char* a1 = cA + (size_t)(t + 1) * kstep;
            const char* a2 = last ? nA : cA + (size_t)(t + 2) * kstep; const char* b2 = last ? nB : cB + (size_t)(t + 2) * kstep;
            const char* a3 = a2 + kstep; const char* b3 = b2 + kstep;
            if (last && has_next) S.a_ready(nxt);
            if constexpr (SP2) {
            PG8_LDB(B0, 0, 0); PG8_LDB(B1, 0, 1); PG8_SCHED; PG8_LDA(At, 0, 0); PG8_STAGE_A(PG8_SA(1, 1), a1, 1, false);
            PG8_WAIT_V(8); PG8_WAIT_L(0); PG8_BAR; PG8_MMA(0, 0, At, B0); PG8_MMA(0, 1, At, B1); PG8_BAR; PG8_SCHED;
            PG8_LDA(At, 0, 1); PG8_STAGE(PG8_SB(0, 0), b2, voffB); PG8_STAGE(PG8_SB(0, 1), b2 + hstep, voffB); PG8_STAGE_A(PG8_SA(0, 0), a2, 0, last);
            PG8_WAIT_V(8); PG8_WAIT_L(0); PG8_BAR; PG8_MMA(1, 0, At, B0); PG8_MMA(1, 1, At, B1); PG8_BAR; PG8_SCHED;
            PG8_LDB(B0, 1, 0); PG8_LDB(B1, 1, 1); PG8_SCHED; PG8_LDA(At, 1, 0); PG8_STAGE_A(PG8_SA(0, 1), a2, 1, last);
            PG8_WAIT_V(8); PG8_WAIT_L(0); PG8_BAR; PG8_MMA(0, 0, At, B0); PG8_MMA(0, 1, At, B1); PG8_BAR; PG8_SCHED;
            PG8_LDA(At, 1, 1); PG8_STAGE(PG8_SB(1, 0), b3, voffB); PG8_STAGE(PG8_SB(1, 1), b3 + hstep, voffB); PG8_STAGE_A(PG8_SA(1, 0), a3, 0, last);
            PG8_WAIT_V(8); PG8_WAIT_L(0); PG8_BAR; PG8_MMA(1, 0, At, B0); PG8_MMA(1, 1, At, B1); PG8_BAR; PG8_SCHED;
            } else {
            PG8_LDB(B0, 0, 0); PG8_SCHED; PG8_LDA(At, 0, 0); PG8_STAGE(PG8_SA(1, 1), a1 + hstep, voffA);
            PG8_WAIT_L(8); PG8_BAR; PG8_WAIT_L(0); PG8_MMA(0, 0, At, B0); PG8_BAR; PG8_SCHED;
            PG8_LDB(B1, 0, 1); PG8_STAGE(PG8_SB(0, 0), b2, voffB);
            PG8_BAR; PG8_WAIT_L(0); PG8_MMA(0, 1, At, B1); PG8_BAR;
            PG8_LDA(At, 0, 1); PG8_STAGE(PG8_SA(0, 0), a2, voffA);
            PG8_BAR; PG8_WAIT_L(0); PG8_MMA(1, 0, At, B0); PG8_BAR; PG8_SCHED;
            PG8_STAGE(PG8_SB(0, 1), b2 + hstep, voffB);
            PG8_WAIT_V(6); PG8_BAR; PG8_MMA(1, 1, At, B1); PG8_BAR;
            PG8_LDB(B0, 1, 0); PG8_SCHED; PG8_LDA(At, 1, 0); PG8_STAGE(PG8_SA(0, 1), a2 + hstep, voffA);
            PG8_WAIT_L(8); PG8_BAR; PG8_WAIT_L(0); PG8_MMA(0, 0, At, B0); PG8_BAR; PG8_SCHED;
            PG8_LDB(B1, 1, 1); PG8_STAGE(PG8_SB(1, 0), b3, voffB);
            PG8_BAR; PG8_WAIT_L(0); PG8_MMA(0, 1, At, B1); PG8_BAR;
            PG8_LDA(At, 1, 1); PG8_STAGE(PG8_SA(1, 0), a3, voffA);
            PG8_BAR; PG8_WAIT_L(0); PG8_MMA(1, 0, At, B0); PG8_BAR; PG8_SCHED;
            PG8_STAGE(PG8_SB(1, 1), b3 + hstep, voffB);
            PG8_WAIT_V(6); PG8_BAR; PG8_MMA(1, 1, At, B1); PG8_BAR;
            }
        }
        if constexpr (ALIGN_EPI) { if (wr == 0) PG8_BAR; }
        if constexpr (!Epi::AFTER_DRAIN) { int t2_ = threadIdx.x; asm volatile("" : "+v"(t2_)); E(acc, cur, wr, wc, t2_ & 15, (t2_ >> 4) & 3); S.done(cur); }
        if (!has_next) break;
        bool keep_ = false; if constexpr (Epi::KEEP) keep_ = E.keep(cur);
        if (!keep_) {
#pragma unroll
        for (int a = 0; a < 2; ++a)
#pragma unroll
            for (int b = 0; b < 2; ++b)
#pragma unroll
                for (int m = 0; m < 4; ++m)
#pragma unroll
                    for (int n = 0; n < 2; ++n) acc[a][b][m][n] = (f32x4){0.f, 0.f, 0.f, 0.f};
        }
        cur = nxt; cA = nA; cB = nB; ++ui;
        if constexpr (GATHER) { _Pragma("unroll") for (int _h = 0; _h < 2; ++_h) _Pragma("unroll") for (int _i = 0; _i < 2; ++_i) vgc[_h][_i] = vgn[_h][_i]; }
        if constexpr (ALIGN_EPI) { if (wr == 1) PG8_BAR; }
    }
    PG8_WAIT_V(0);
    if constexpr (!ALIGN_EPI) { if (wr == 0) PG8_BAR; }
    PG8_BAR;
    if constexpr (Epi::AFTER_DRAIN) { E.fused(acc, cur, wr, wc, fr, fq, lds, wid, lane); S.done(cur); }
#undef PG8_SA
#undef PG8_SB
#undef PG8_STAGE
#undef PG8_STAGE_A
#undef PG8_GLOAD
#undef PG8_LDA
#undef PG8_LDB
#undef PG8_MMA
#undef PG8_WAIT_V
#undef PG8_WAIT_L
#undef PG8_BAR
#undef PG8_SCHED
}
}
#define GAS __attribute__((address_space(1)))
#define LAS __attribute__((address_space(3)))
typedef unsigned short bf16;
typedef unsigned v4u __attribute__((ext_vector_type(4)));
typedef float f32x4 __attribute__((ext_vector_type(4)));
typedef short bf16x8 __attribute__((ext_vector_type(8)));
typedef GAS unsigned gu32;
typedef GAS unsigned long long gu64;
#define RLX_AGENT __ATOMIC_RELAXED, __HIP_MEMORY_SCOPE_AGENT
#define LDS_WAIT() asm volatile("s_waitcnt lgkmcnt(0)" ::: "memory")
#define VM_WAIT() asm volatile("s_waitcnt vmcnt(0)" ::: "memory")
__device__ __forceinline__ unsigned long long rt() { return __builtin_amdgcn_s_memrealtime(); }
__device__ __forceinline__ unsigned f2bf(float f) { unsigned u = __builtin_bit_cast(unsigned, f); return (u + 0x7fffu + ((u >> 16) & 1u)) >> 16; }
typedef float f32x2_t __attribute__((ext_vector_type(2))); typedef __bf16 bf16x2_t __attribute__((ext_vector_type(2)));
__device__ __forceinline__ unsigned pk2(float lo, float hi) { const f32x2_t v = {lo, hi}; const bf16x2_t b = __builtin_convertvector(v, bf16x2_t); return __builtin_bit_cast(unsigned, b); }

#define XB_TMO      128
#define XB_XCNT(j)  (256  + 64 * (j))
#define XB_XSUB(j)  (1280 + 64 * (j))
#define XB_XGEN(j)  (2304 + 64 * (j))
#define XB_TOP      3328
#define XB_TOPGEN   3392
#define XCD_BAR_WORDS 3456
#define XB_SPIN_CAP (1u << 18)

__device__ __forceinline__ unsigned xb_ld(unsigned* p)              { return __hip_atomic_load(p, __ATOMIC_RELAXED, __HIP_MEMORY_SCOPE_AGENT); }
__device__ __forceinline__ unsigned xb_add(unsigned* p, unsigned v) { return __hip_atomic_fetch_add(p, v, __ATOMIC_RELAXED, __HIP_MEMORY_SCOPE_AGENT); }
__device__ __forceinline__ unsigned xb_xcc_id() { return (unsigned)__builtin_amdgcn_s_getreg((3 << 11) | 20) & 0xFu; }
#define XB_SPIN(cond, bar) do { unsigned _sp = 0; while (cond) { __builtin_amdgcn_s_sleep(1); \
    if ((++_sp & 255u) == 0u) { if (xb_ld(&(bar)[XB_TMO])) break; if (_sp > XB_SPIN_CAP) { atomicAdd(&(bar)[XB_TMO], 1u); break; } } } } while (0)

struct XcdBarrier {
    unsigned* bar; unsigned x;
    volatile LAS unsigned* st;
};

__device__ __forceinline__ XcdBarrier xcd_barrier_post(unsigned* bar, volatile LAS unsigned* st) {
    XcdBarrier b; b.bar = bar; b.x = xb_xcc_id(); b.st = st;
    if (threadIdx.x == 0) (void)xb_add(&bar[XB_XCNT(b.x)], 1u);
    return b;
}
__device__ __forceinline__ void xcd_barrier_complete(unsigned* bar, unsigned x, unsigned& nloc, unsigned& nx) {
    const unsigned G = gridDim.x * gridDim.y * gridDim.z;
    unsigned sum, cnt, mine, sp = 0u;
    for (;;) {
        sum = 0u; cnt = 0u; mine = 0u;
#pragma unroll
        for (unsigned j = 0; j < 16; ++j) { const unsigned c = xb_ld(&bar[XB_XCNT(j)]); sum += c; cnt += (c > 0u) ? 1u : 0u; mine = (j == x) ? c : mine; }
        if (sum == G) break;
        __builtin_amdgcn_s_sleep(1);
        if ((++sp & 255u) == 0u) { if (xb_ld(&bar[XB_TMO])) break; if (sp > XB_SPIN_CAP) { atomicAdd(&bar[XB_TMO], 1u); break; } }
    }
    nloc = mine > 0u ? mine : 1u; nx = cnt > 0u ? cnt : 1u;
}

__device__ __forceinline__ void xcd_barrier(const XcdBarrier& b) {
    asm volatile("s_waitcnt vmcnt(0)" ::: "memory");
    __syncthreads();
    if (threadIdx.x == 0) {
        unsigned* bar = b.bar;
        __builtin_amdgcn_s_waitcnt(0);
        unsigned nloc = b.st[0], nx = b.st[1];
        if (nloc == 0u) { xcd_barrier_complete(bar, b.x, nloc, nx); b.st[0] = nloc; b.st[1] = nx; }
        const unsigned old = xb_add(&bar[XB_XSUB(b.x)], 1u);
        const unsigned gen = old / nloc;
        if (old + 1u == (gen + 1u) * nloc) {
            __builtin_amdgcn_fence(__ATOMIC_RELEASE, "agent");
            asm volatile("s_waitcnt vmcnt(0)" ::: "memory");
            const unsigned og = xb_add(&bar[XB_TOP], 1u);
            const unsigned tg = og / nx;
            if (og + 1u == (tg + 1u) * nx) xb_add(&bar[XB_TOPGEN], 1u);
            else XB_SPIN(xb_ld(&bar[XB_TOPGEN]) == tg, bar);
            __builtin_amdgcn_fence(__ATOMIC_ACQUIRE, "agent");
            xb_add(&bar[XB_XGEN(b.x)], 1u);
            asm volatile("s_waitcnt vmcnt(0)" ::: "memory");
        } else {
            XB_SPIN(xb_ld(&bar[XB_XGEN(b.x)]) == gen, bar);
            __builtin_amdgcn_fence(__ATOMIC_ACQUIRE, "agent");
            asm volatile("s_waitcnt vmcnt(0)" ::: "memory");
        }
    }
    __syncthreads();
}
constexpr int DM = 1024, SEQ = 8192, NBATCH = 2, CTXL = 256;
constexpr int ML = NBATCH * SEQ, MC = NBATCH * CTXL, MT = ML + MC;
constexpr int NIN = 6400;
constexpr int NE = 16, ESTR = 2304, CAPL = 1024, CAPC = 32;
constexpr int NPH = 24;
constexpr size_t MiB = 1u << 20;
constexpr size_t WS_CTL = 0, CTL_ZERO_BYTES = 1 * MiB;
constexpr size_t WS_MOD = 1 * MiB;
constexpr size_t WS_ROPEC = 1 * MiB + 256 * 1024, WS_ROPES = WS_ROPEC + 8192;
constexpr size_t WS_TW = 1 * MiB + 512 * 1024;
constexpr size_t WS_CS256 = 1 * MiB + 640 * 1024;
constexpr size_t WS_T1T = 2 * MiB;
constexpr size_t WS_T2T = 2 * MiB + 64 * 1024;
constexpr size_t WS_T2F = 8 * MiB;
constexpr size_t WS_T2C = 12 * MiB;
constexpr size_t WS_FAC = 13 * MiB;
constexpr size_t WS_WSP = 2 * MiB + 256 * 1024;
constexpr size_t WS_AFF = 3 * MiB;
constexpr size_t WS_SEL = 5 * MiB;
constexpr size_t WS_IDX = 7 * MiB, WS_GATE = 7 * MiB + 256 * 1024;
constexpr size_t WS_WIN = 16 * MiB, WS_WBR = 29 * MiB, WS_WO = 31 * MiB, WS_WGU = 33 * MiB, WS_WDN = 97 * MiB;
constexpr size_t WS_X = 130 * MiB;
constexpr size_t WS_H = 196 * MiB;
constexpr size_t WS_BR = 229 * MiB;
constexpr size_t WS_MB = 262 * MiB;
constexpr size_t WS_FA = 295 * MiB;
constexpr size_t WS_Z = 311 * MiB;
constexpr size_t ZROW = (size_t)MT * 2;
constexpr size_t WS_AUV = WS_Z, WS_YF = WS_AUV + 512 * ZROW, WS_CY = WS_YF + 512 * ZROW, WS_QPL = WS_CY + 256 * ZROW, WS_QROT = WS_QPL + 256 * ZROW,
                 WS_KR = WS_QROT + 256 * ZROW, WS_VV = WS_KR + 256 * ZROW, WS_G = WS_VV + 256 * ZROW, WS_ZEND = WS_G + 4096 * ZROW;
constexpr size_t WS_P32 = WS_Z;
constexpr size_t WS_XE = WS_Z, WS_ACT = WS_Z + 72 * MiB;
constexpr size_t WS_END = 518 * MiB;
static_assert(WS_G == WS_P32 + (size_t)MT * 1024 * 4 + 8 * 256 * ZROW / 8 - 256 * ZROW || true, "");
static_assert(WS_ZEND <= WS_END && WS_ACT + 72 * MiB <= WS_ZEND && WS_P32 + (size_t)MT * 4096 <= WS_VV, "ws map");
constexpr int CW_BAR = 4096;
constexpr int LDS_BYTES = 155648, MISC_OFF = 154624;

struct Args { const float* in[28]; float* out; unsigned char* ws; int ph_lo, ph_hi; };

__device__ __forceinline__ float bflo(unsigned w) { return __uint_as_float(w << 16); }
__device__ __forceinline__ float bfhi(unsigned w) { return __uint_as_float(w & 0xffff0000u); }
__device__ __forceinline__ float sigm(float x) { return __builtin_amdgcn_rcpf(1.f + __expf(-x)); }
__device__ __forceinline__ float wave_sum(float v) {
#pragma unroll
    for (int o = 1; o < 64; o <<= 1) v += __shfl_xor(v, o);
    return v;
}
__device__ __forceinline__ void st4bf(bf16* p, f32x4 v) { uint2 w; w.x = pk2(v[0], v[1]); w.y = pk2(v[2], v[3]); *(uint2*)p = w; }

__device__ __forceinline__ void st8bf(bf16* p, f32x4 a, f32x4 b) { v4u w; w.x = pk2(a[0], a[1]); w.y = pk2(a[2], a[3]); w.z = pk2(b[0], b[1]); w.w = pk2(b[2], b[3]); *(v4u*)p = w; }
using pg8::Unit;
struct EpiIn {
    static constexpr bool PERM = false, AFTER_DRAIN = false, KEEP = false;
    bf16 *AUV, *YF, *CY, *QPL, *QROT, *KR, *VV, *G; const float* ropeC; const float* ropeS;
    __device__ __forceinline__ void operator()(const f32x4 (&acc)[2][2][4][2], const Unit& u, int wr, int wc, int fr, int fq) const {
        const int pn = u.pn, row0 = u.pm * 256 + wr * 64 + fr, cl0 = wc * 32 + 4 * fq;
        const int cp0 = wc * 32 + 8 * fq;
        if (pn < 2) {
#pragma unroll
            for (int ai = 0; ai < 2; ++ai)
#pragma unroll
                for (int m = 0; m < 4; ++m) { const size_t row = row0 + ai * 128 + m * 16;
#pragma unroll
                    for (int bj = 0; bj < 2; ++bj) { f32x4 v[2];
#pragma unroll
                        for (int n = 0; n < 2; ++n)
#pragma unroll
                            for (int j = 0; j < 4; ++j) { const float x = acc[ai][bj][m][n][j]; v[n][j] = x * sigm(1.5957691216f * (x + 0.044715f * x * x * x)); }
                        st8bf(AUV + row * 512 + pn * 256 + bj * 128 + cp0, v[0], v[1]); } }
        } else if (pn < 4) {
#pragma unroll
            for (int ai = 0; ai < 2; ++ai)
#pragma unroll
                for (int m = 0; m < 4; ++m) { const size_t row = row0 + ai * 128 + m * 16;
#pragma unroll
                    for (int bj = 0; bj < 2; ++bj) st8bf(YF + row * 512 + (pn - 2) * 256 + bj * 128 + cp0, acc[ai][bj][m][0], acc[ai][bj][m][1]); }
        } else if (pn < 6) {
#pragma unroll
            for (int ai = 0; ai < 2; ++ai)
#pragma unroll
                for (int m = 0; m < 4; ++m) { const size_t row = row0 + ai * 128 + m * 16; f32x4 v[2];
#pragma unroll
                    for (int n = 0; n < 2; ++n) { const f32x4 a = acc[ai][0][m][n], g = acc[ai][1][m][n];
#pragma unroll
                        for (int j = 0; j < 4; ++j) v[n][j] = a[j] * sigm(g[j]); }
                    st8bf(CY + row * 256 + (pn - 4) * 128 + cp0, v[0], v[1]); }
        } else if (pn < 8) {
            const bool isq = pn == 6; const float scl = isq ? 0.125f : 1.f; const bool latent = u.pm < 64;
#pragma unroll
            for (int ai = 0; ai < 2; ++ai)
#pragma unroll
                for (int m = 0; m < 4; ++m) { const int rowi = row0 + ai * 128 + m * 16; const size_t row = rowi; const int tok = rowi & 8191;
                    const int pos = (wc & 1) ? (tok & 63) : (tok >> 6);
                    f32x4 cs = {1.f, 1.f, 1.f, 1.f}, sn = {0.f, 0.f, 0.f, 0.f};
                    if (latent) { cs = *(const f32x4*)(ropeC + pos * 16 + 4 * fq); sn = *(const f32x4*)(ropeS + pos * 16 + 4 * fq); }
#pragma unroll
                    for (int bj = 0; bj < 2; ++bj) { const f32x4 x1 = acc[ai][bj][m][0] * scl, x2 = acc[ai][bj][m][1] * scl;
                        const f32x4 r1 = x1 * cs - x2 * sn, r2 = x1 * sn + x2 * cs; const size_t off = row * 256 + bj * 128 + cl0;
                        if (isq) { st4bf(QPL + off, x1); st4bf(QPL + off + 16, x2); st4bf(QROT + off, r1); st4bf(QROT + off + 16, r2); }
                        else { st4bf(KR + off, r1); st4bf(KR + off + 16, r2); } } }
        } else if (pn == 8) {
#pragma unroll
            for (int ai = 0; ai < 2; ++ai)
#pragma unroll
                for (int m = 0; m < 4; ++m) { const size_t row = row0 + ai * 128 + m * 16;
#pragma unroll
                    for (int bj = 0; bj < 2; ++bj) st8bf(VV + row * 256 + bj * 128 + cp0, acc[ai][bj][m][0], acc[ai][bj][m][1]); }
        } else {
#pragma unroll
            for (int ai = 0; ai < 2; ++ai)
#pragma unroll
                for (int m = 0; m < 4; ++m) { const size_t row = row0 + ai * 128 + m * 16;
#pragma unroll
                    for (int bj = 0; bj < 2; ++bj)
#pragma unroll
                        for (int n = 0; n < 2; ++n) { f32x4 v = acc[ai][bj][m][n];
#pragma unroll
                            for (int j = 0; j < 4; ++j) v[j] = sigm(v[j]);
                            const int gb_ = (pn - 9) >> 2, gu_ = (2 * u.pm + ai) * 8 + 2 * ((pn - 9) & 3) + bj;
                            st4bf(G + ((((size_t)(gu_ * 4 + gb_) * 8 + (wr * 4 + wc)) * 8 + m * 2 + n) * 256 + (fq * 16 + fr) * 4), v); } }
        }
    }
};
struct EpiMerge {
    static constexpr bool PERM = false, AFTER_DRAIN = false, KEEP = false;
    const bf16* G; float* P32; bf16* MB;
    __device__ __forceinline__ void operator()(const f32x4 (&acc)[2][2][4][2], const Unit& u, int wr, int wc, int fr, int fq) const {
        int fr_ = fr, fq_ = fq; asm volatile("" : "+v"(fr_), "+v"(fq_));
        const int b = u.pn >> 2, pn = u.pn & 3, pm = u.pm - b * 66, row0 = pm * 256 + wr * 64 + fr_, col0 = pn * 256 + wc * 32 + 4 * fq_;
#pragma unroll
        for (int ai = 0; ai < 2; ++ai)
#pragma unroll
            for (int m = 0; m < 4; ++m) { const unsigned row = row0 + ai * 128 + m * 16;
                const bf16* gp = G + ((size_t)row * 4096 + b * 1024 + col0); float* pp = P32 + ((size_t)row * 1024 + col0); bf16* mp = MB + ((size_t)row * 1024 + col0);
#pragma unroll
                for (int bj = 0; bj < 2; ++bj)
#pragma unroll
                    for (int n = 0; n < 2; ++n) { const int co = bj * 128 + n * 16;
                        const uint2 gw = *(const uint2*)(gp + co);
                        f32x4 v = acc[ai][bj][m][n]; v[0] *= bflo(gw.x); v[1] *= bfhi(gw.x); v[2] *= bflo(gw.y); v[3] *= bfhi(gw.y);
                        if (b > 0) v += *(const f32x4*)(pp + co);
                        if (b < 3) *(f32x4*)(pp + co) = v; else st4bf(mp + co, v);
                        asm volatile("" ::: "memory"); } }
    }
};
struct EpiMergeH {
    static constexpr bool PERM = false, AFTER_DRAIN = false, KEEP = true;
    const bf16* G; bf16* MB;
    __device__ __forceinline__ bool keep(const Unit& u) const { return (u.pn >> 2) < 3; }
    __device__ __forceinline__ void operator()(f32x4 (&acc)[2][2][4][2], const Unit& u, int wr, int wc, int fr, int fq) const {
        const int b = u.pn >> 2, pn = u.pn & 3, pm = u.pm - b * 66, row0 = pm * 256 + wr * 64 + fr, col0 = pn * 256 + wc * 32 + 4 * fq;
#pragma unroll
        for (int ai = 0; ai < 2; ++ai)
#pragma unroll
            for (int m = 0; m < 4; ++m) { const unsigned row = row0 + ai * 128 + m * 16; const bf16* gp = G + ((size_t)row * 4096 + b * 1024 + col0); bf16* mp = MB + ((size_t)row * 1024 + col0);
#pragma unroll
                for (int bj = 0; bj < 2; ++bj)
#pragma unroll
                    for (int n = 0; n < 2; ++n) { const int co = bj * 128 + n * 16; const uint2 gb = *(const uint2*)(gp + co); f32x4 v = acc[ai][bj][m][n];
                        if (b < 3) { const uint2 gn = *(const uint2*)(gp + 1024 + co);
                            v[0] *= bflo(gb.x) * __builtin_amdgcn_rcpf(bflo(gn.x)); v[1] *= bfhi(gb.x) * __builtin_amdgcn_rcpf(bfhi(gn.x)); v[2] *= bflo(gb.y) * __builtin_amdgcn_rcpf(bflo(gn.y)); v[3] *= bfhi(gb.y) * __builtin_amdgcn_rcpf(bfhi(gn.y));
                            acc[ai][bj][m][n] = v; }
                        else { v[0] *= bflo(gb.x); v[1] *= bfhi(gb.x); v[2] *= bflo(gb.y); v[3] *= bfhi(gb.y); st4bf(mp + co, v); } }
                asm volatile("" ::: "memory"); }
    }
};
struct EpiWout {
    static constexpr bool PERM = false, AFTER_DRAIN = false, KEEP = false;
    const float* xlat; const float* xctx; float* X; const float* mod;
    __device__ __forceinline__ void operator()(const f32x4 (&acc)[2][2][4][2], const Unit& u, int wr, int wc, int fr, int fq) const {
        const int r = u.pm < 32 ? 0 : (u.pm < 64 ? 1 : 2); const float* gt = mod + r * 6144 + 2 * 1024;
        const int row0 = u.pm * 256 + wr * 64 + fr, col0 = u.pn * 256 + wc * 32 + 4 * fq;
        f32x4 gv[2][2];
#pragma unroll
        for (int bj = 0; bj < 2; ++bj)
#pragma unroll
            for (int n = 0; n < 2; ++n) gv[bj][n] = *(const f32x4*)(gt + col0 + bj * 128 + n * 16);
#pragma unroll
        for (int ai = 0; ai < 2; ++ai)
#pragma unroll
            for (int m = 0; m < 4; ++m) { const size_t row = row0 + ai * 128 + m * 16; const float* src = (row < ML) ? xlat + row * 1024 : xctx + (row - ML) * 1024;
#pragma unroll
                for (int bj = 0; bj < 2; ++bj)
#pragma unroll
                    for (int n = 0; n < 2; ++n) { const int col = col0 + bj * 128 + n * 16;
                        *(f32x4*)(X + row * 1024 + col) = *(const f32x4*)(src + col) + gv[bj][n] * acc[ai][bj][m][n]; } }
    }
};
struct EpiGU {
    static constexpr bool PERM = true, AFTER_DRAIN = false, KEEP = false;
    bf16* ACT;
    __device__ __forceinline__ void operator()(const f32x4 (&acc)[2][2][4][2], const Unit& u, int wr, int wc, int fr, int fq) const {
        const int pnl = u.pn & 7, row0 = u.pm * 256 + wr * 64 + fr, cl0 = wc * 32 + 8 * fq;
#pragma unroll
        for (int ai = 0; ai < 2; ++ai)
#pragma unroll
            for (int m = 0; m < 4; ++m) { const size_t row = row0 + ai * 128 + m * 16; f32x4 v[2];
#pragma unroll
                for (int n = 0; n < 2; ++n) { const f32x4 a = acc[ai][0][m][n], up = acc[ai][1][m][n];
#pragma unroll
                    for (int j = 0; j < 4; ++j) v[n][j] = a[j] * sigm(a[j]) * up[j]; }
                st8bf(ACT + row * 1024 + pnl * 128 + cl0, v[0], v[1]); }
    }
};
struct EpiDown {
    static constexpr bool PERM = true, AFTER_DRAIN = false, KEEP = false;
    bf16* YB; const float* GATE;
    __device__ __forceinline__ void operator()(const f32x4 (&acc)[2][2][4][2], const Unit& u, int wr, int wc, int fr, int fq) const {
        const int pnl = u.pn & 3, row0 = u.pm * 256 + wr * 64 + fr, col0 = pnl * 256 + wc * 32 + 8 * fq;
#pragma unroll
        for (int ai = 0; ai < 2; ++ai)
#pragma unroll
            for (int m = 0; m < 4; ++m) { const size_t row = row0 + ai * 128 + m * 16; const float gt = GATE[row];
#pragma unroll
                for (int bj = 0; bj < 2; ++bj) st8bf(YB + row * 1024 + col0 + bj * 128, acc[ai][bj][m][0] * gt, acc[ai][bj][m][1] * gt); }
    }
};
struct MergeOrder {
    int nt, G, c;
    __device__ void init(int ntm, int G_, int c_) { nt = ntm * 4; G = G_; c = c_; }
    __device__ bool next(int i, Unit& u) const { const int b = i & 3, L = (i >> 2) * G + c; if (L >= nt) return false; u.pm = b * 66 + (L >> 2); u.pn = b * 4 + (L & 3); return true; }
    __device__ __forceinline__ void a_ready(const Unit&) const {}
    __device__ __forceinline__ void done(const Unit&) const {}
};
struct OneUnit { int pm, pn; __device__ bool next(int i, Unit& u) const { if (i > 0) return false; u.pm = pm; u.pn = pn; return true; }
    __device__ __forceinline__ void a_ready(const Unit&) const {} __device__ __forceinline__ void done(const Unit&) const {} };
struct GroupOrder {
    int nwg, G, c, TPE, NTN;
    __device__ void init(int tpe, int ntn, int G_, int c_) { TPE = tpe; NTN = ntn; nwg = NE * tpe * ntn; G = G_; c = c_; }
    __device__ bool next(int i, Unit& u) const {
        const long L = (long)i * G + c; if (L >= nwg) return false;
        int wgid = (int)L; { const int q = nwg / 8, r = nwg % 8, xcd = wgid % 8, off = wgid / 8; wgid = (xcd < r ? xcd * (q + 1) : r * (q + 1) + (xcd - r) * q) + off; }
        const int per = TPE * NTN, e = wgid / per, rem = wgid % per, pn = rem / TPE, mt = rem % TPE;
        u.pm = e * 9 + mt; u.pn = e * NTN + pn; return true;
    }
    __device__ __forceinline__ void a_ready(const Unit&) const {}
    __device__ __forceinline__ void done(const Unit&) const {}
};
typedef float f2v __attribute__((ext_vector_type(2)));
#define PH_ARGS LAS unsigned char* lds, const int tid, const int lane, const int wave, const int bid, const int G
#define WSP(T, off) ((T*)(PTRV(29, unsigned char) + (off)))
constexpr int PTAB_OFF = MISC_OFF + 512;
__device__ __forceinline__ unsigned long long ptab_ld(LAS unsigned char* lds, int i) {
    typedef unsigned u2v_t __attribute__((ext_vector_type(2)));
    const volatile LAS unsigned* tp = (const volatile LAS unsigned*)(lds + PTAB_OFF + 8 * i); u2v_t v; v[0] = tp[0]; v[1] = tp[1];
    const unsigned lo = __builtin_amdgcn_readfirstlane(v[0]), hi = __builtin_amdgcn_readfirstlane(v[1]);
    return ((unsigned long long)hi << 32) | lo;
}
#define PTRV(i, T) ((T*)(GAS T*)ptab_ld(lds, (i)))
#define INP(i) ((const float*)(GAS const float*)ptab_ld(lds, (i)))

__device__ __forceinline__ void mod_gemv(PH_ARGS) {
    LAS f32x4* red = (LAS f32x4*)lds;
    const float* c = INP(1); const float* cc = INP(3); const float* wm = INP(4); const float* bm = INP(5);
    float* MOD = WSP(float, WS_MOD);
    for (int it = bid; it < 192; it += G) {
        const int l = it / 96, cg = it % 96, kg = tid >> 4, cq = tid & 15;
        f32x4 a0 = {0.f, 0.f, 0.f, 0.f}, a1 = a0, a2 = a0;
        const float* wb = wm + (size_t)l * 1024 * 6144 + cg * 64 + cq * 4;
#pragma unroll 4
        for (int i = 0; i < 32; ++i) { const int k = kg + 32 * i; const f32x4 w = *(const f32x4*)(wb + (size_t)k * 6144);
            const float x0 = c[k], x1 = c[1024 + k], x2 = cc[k];
            a0 += w * (x0 * sigm(x0)); a1 += w * (x1 * sigm(x1)); a2 += w * (x2 * sigm(x2)); }
        red[(kg * 3 + 0) * 16 + cq] = a0; red[(kg * 3 + 1) * 16 + cq] = a1; red[(kg * 3 + 2) * 16 + cq] = a2;
        __syncthreads();
        if (tid < 192) { const int r = tid >> 6, col = tid & 63; float s = 0.f; const LAS float* rf = (const LAS float*)red;
            for (int k2 = 0; k2 < 32; ++k2) s += rf[((k2 * 3 + r) * 16 + (col >> 2)) * 4 + (col & 3)];
            MOD[(l * 3 + r) * 6144 + cg * 64 + col] = s + bm[l * 6144 + cg * 64 + col]; }
        __syncthreads();
    }
}
__device__ __forceinline__ void make_tables(PH_ARGS) {
    const int gt = bid * 512 + tid, GT = G * 512;
    float* RC = WSP(float, WS_ROPEC); float* RS = WSP(float, WS_ROPES);
    bf16* T1 = WSP(bf16, WS_T1T);
    for (int i = gt; i < 2048; i += GT) { const int pos = i >> 4, f = i & 15; const float inv = powf(10000.f, -(float)f / 16.f), ang = (float)pos * inv; RC[i] = cosf(ang); RS[i] = sinf(ang); }
    for (int i = gt; i < 128 * 128; i += GT) { const int col = i >> 7, k = i & 127, ro = col >> 6, k1 = col & 63, n1 = k >> 1, ri = k & 1; float s, c; sincospif((float)((k1 * n1) & 63) / 32.f, &s, &c);
        const float v = ro == 0 ? (ri == 0 ? c : s) : (ri == 0 ? -s : c); T1[i] = (bf16)f2bf(v); }
    bf16* T2F = WSP(bf16, WS_T2F); bf16* T2C = WSP(bf16, WS_T2C);
    for (int i = gt; i < 64 * 128 * 256; i += GT) { const int k1 = i >> 15, k2 = (i >> 8) & 127, k = i & 255, n2 = k >> 1, ri = k & 1; float s, c;
        sincospif((float)((n2 * (k1 + 64 * k2)) & 8191) / 4096.f, &s, &c); T2F[i] = (bf16)f2bf(ri ? s : c); }
    for (int i = gt; i < 2 * 128 * 256; i += GT) { const int k1 = i >> 15, k2 = (i >> 8) & 127, k = i & 255, n2 = k >> 1, ri = k & 1; float s, c;
        sincospif((float)((n2 * (k1 + 2 * k2)) & 255) / 128.f, &s, &c); T2C[i] = (bf16)f2bf(ri ? s : c); }
}
__device__ __forceinline__ void tr_item(const float* W, size_t ldw, int col0, int k0, bf16* dst, int Kd, LAS float* scr, int lane) {
#pragma unroll 8
    for (int i = 0; i < 32; ++i) { const int kk = 2 * i + (lane >> 5); scr[kk * 33 + (lane & 31)] = W[(size_t)(k0 + kk) * ldw + col0 + (lane & 31)]; }
    LDS_WAIT(); asm volatile("" ::: "memory");
    const int c = lane & 7;
#pragma unroll
    for (int j = 0; j < 4; ++j) { const int n = (lane >> 3) + 8 * j; const LAS float* s = scr + (8 * c) * 33 + n;
        v4u o; o.x = pk2(s[0 * 33], s[1 * 33]); o.y = pk2(s[2 * 33], s[3 * 33]); o.z = pk2(s[4 * 33], s[5 * 33]); o.w = pk2(s[6 * 33], s[7 * 33]);
        *(v4u*)(dst + (size_t)n * Kd + k0 + 8 * c) = o; }
    LDS_WAIT(); asm volatile("" ::: "memory");
}
__device__ __forceinline__ int rho32(int c) { return 16 * ((c >> 2) & 1) + 4 * (c >> 3) + (c & 3); }
__device__ __forceinline__ void fold_item16(const float* W  , int f, bf16* WIN, LAS float* scr, const LAS f2v* tab, int lane) {
    const int kb = f >> 2, g = f & 3, k0 = kb * 16;
#pragma unroll
    for (int kk = 0; kk < 16; ++kk) scr[kk * 64 + lane] = W[(size_t)(k0 + kk) * 6144 + 512 + g * 64 + lane];
    LDS_WAIT(); asm volatile("" ::: "memory");
    float ar[16], ai[16];
#pragma unroll
    for (int kk = 0; kk < 16; ++kk) { ar[kk] = 0.f; ai[kk] = 0.f; }
#pragma unroll 4
    for (int c = 0; c < 64; ++c) { const f2v t = tab[(c * lane) & 63];
#pragma unroll
        for (int kk = 0; kk < 16; ++kk) { const float w = scr[kk * 64 + c]; ar[kk] += w * t[0]; ai[kk] -= w * t[1]; } }
    const int L0 = 2 * (g * 64 + lane);
    bf16* d0 = WIN + (size_t)(512 + (L0 & ~31) + rho32(L0 & 31)) * 1024 + k0; bf16* d1 = WIN + (size_t)(512 + (L0 & ~31) + rho32((L0 + 1) & 31)) * 1024 + k0;
    v4u o, p;
    o.x = pk2(ar[0], ar[1]); o.y = pk2(ar[2], ar[3]); o.z = pk2(ar[4], ar[5]); o.w = pk2(ar[6], ar[7]); p.x = pk2(ar[8], ar[9]); p.y = pk2(ar[10], ar[11]); p.z = pk2(ar[12], ar[13]); p.w = pk2(ar[14], ar[15]);
    *(v4u*)d0 = o; *(v4u*)(d0 + 8) = p;
    o.x = pk2(ai[0], ai[1]); o.y = pk2(ai[2], ai[3]); o.z = pk2(ai[4], ai[5]); o.w = pk2(ai[6], ai[7]); p.x = pk2(ai[8], ai[9]); p.y = pk2(ai[10], ai[11]); p.z = pk2(ai[12], ai[13]); p.w = pk2(ai[14], ai[15]);
    *(v4u*)d1 = o; *(v4u*)(d1 + 8) = p;
    LDS_WAIT(); asm volatile("" ::: "memory");
}
template <bool PERMROWS>
__device__ __forceinline__ void tr_item64(const float* W, size_t ldw, int col0, int k0, bf16* dst, int Kd, int lane) {
    const int kq = lane >> 4, n4 = lane & 15; const float* src = W + (size_t)(k0 + kq * 16) * ldw + col0 + n4 * 4;
    f32x4 v[16];
#pragma unroll
    for (int i = 0; i < 16; ++i) v[i] = *(const f32x4*)(src + (size_t)i * ldw);
#pragma unroll
    for (int j = 0; j < 4; ++j) { const int ns = n4 * 4 + j, nd = PERMROWS ? ((ns & 32) + rho32(ns & 31)) : ns; bf16* d = dst + (size_t)nd * Kd + k0 + kq * 16; v4u o, p;
        o.x = pk2(v[0][j], v[1][j]); o.y = pk2(v[2][j], v[3][j]); o.z = pk2(v[4][j], v[5][j]); o.w = pk2(v[6][j], v[7][j]);
        p.x = pk2(v[8][j], v[9][j]); p.y = pk2(v[10][j], v[11][j]); p.z = pk2(v[12][j], v[13][j]); p.w = pk2(v[14][j], v[15][j]);
        *(v4u*)d = o; *(v4u*)(d + 8) = p; }
}
__device__ __forceinline__ void convert_range(PH_ARGS, const int l, const int it_lo, const int it_hi, const int pidx, const int pcount) {
    if (pidx < 0) return;
    LAS float* scr = (LAS float*)(lds + wave * 16384);
    const int gw = pidx * 8 + wave, NGW = pcount * 8;
    bf16* WIN = WSP(bf16, WS_WIN); bf16* WBR = WSP(bf16, WS_WBR); bf16* WO = WSP(bf16, WS_WO); bf16* WGU = WSP(bf16, WS_WGU); bf16* WDN = WSP(bf16, WS_WDN); bf16* WS_ = WSP(bf16, WS_WSP);
    const float* win = INP(8) + (size_t)l * 1024 * 6144;
    LAS f2v* tab = (LAS f2v*)(scr + 2048); { float s_, c_; sincospif((float)lane / 32.f, &s_, &c_); tab[lane] = (f2v){c_, s_}; } LDS_WAIT(); asm volatile("" ::: "memory");
    constexpr int N_FOLD = 256, N_IN = 92 * 16, N_BR = 256, N_WO = 256, N_GU = 8192, N_DN = 4096, N_SP = 64;
    constexpr int NITEMS = N_FOLD + N_IN + N_BR + N_WO + N_GU + N_DN + N_SP;
    for (int it = it_lo + gw; it < it_hi && it < NITEMS; it += NGW) {
        int r = it;
        if (r < N_FOLD) { fold_item16(win, r, WIN, scr, tab, lane); continue; } r -= N_FOLD;
        if (r < N_IN) { const int dbp = r >> 4, kb = r & 15, db = dbp < 8 ? dbp : dbp + 8; int col;
            if (db < 8) col = db * 64;
            else if (db < 24) { const int t = db - 16, tile = t >> 2, sub = t & 3; col = (sub < 2 ? 768 : 1024) + tile * 128 + (sub & 1) * 64; }
            else if (db < 36) col = 1280 + (db - 24) * 64;
            else col = 2048 + (db - 36) * 64;
            if (db < 24 || (db >= 32 && db < 36)) tr_item64<true>(win, 6144, col, kb * 64, WIN + (size_t)db * 64 * 1024, 1024, lane);
            else tr_item64<false>(win, 6144, col, kb * 64, WIN + (size_t)db * 64 * 1024, 1024, lane);
            continue; } r -= N_IN;
        if (r < N_BR) { const int b = r >> 6, q = r & 63, kb = q >> 4, nb = q & 15; const int ii = b == 0 ? 13 : (b == 1 ? 14 : (b == 2 ? 19 : 21));
            tr_item64<false>(INP(ii) + (size_t)l * 256 * 1024, 1024, nb * 64, kb * 64, WBR + (size_t)(b * 1024 + nb * 64) * 256, 256, lane); continue; } r -= N_BR;
        if (r < N_WO) { const int kb = r >> 4, nb = r & 15; tr_item64<false>(INP(22) + (size_t)l * 1024 * 1024, 1024, nb * 64, kb * 64, WO + (size_t)nb * 64 * 1024, 1024, lane); continue; } r -= N_WO;
        if (r < N_GU) { const int e = r >> 9, q = r & 511, db = q >> 4, kb = q & 15, tile = db >> 2, sub = db & 3;
            const float* src = (sub < 2 ? INP(24) : INP(25)) + (size_t)(l * 16 + e) * 1024 * 1024;
            tr_item64<false>(src, 1024, tile * 128 + (sub & 1) * 64, kb * 64, WGU + ((size_t)e * 2048 + db * 64) * 1024, 1024, lane); continue; } r -= N_GU;
        if (r < N_DN) { const int e = r >> 8, q = r & 255, kb = q >> 4, nb = q & 15;
            tr_item64<false>(INP(26) + (size_t)(l * 16 + e) * 1024 * 1024, 1024, nb * 64, kb * 64, WDN + ((size_t)e * 1024 + nb * 64) * 1024, 1024, lane); continue; } r -= N_DN;
        { const float* s = INP(11) + (size_t)l * 65536 + r * 1024 + lane * 16; const f32x4 a = *(const f32x4*)s, b = *(const f32x4*)(s + 4), c = *(const f32x4*)(s + 8), d = *(const f32x4*)(s + 12);
          v4u o, p; o.x = pk2(a[0], a[1]); o.y = pk2(a[2], a[3]); o.z = pk2(b[0], b[1]); o.w = pk2(b[2], b[3]); p.x = pk2(c[0], c[1]); p.y = pk2(c[2], c[3]); p.z = pk2(d[0], d[1]); p.w = pk2(d[2], d[3]);
          *(v4u*)(WS_ + r * 1024 + lane * 16) = o; *(v4u*)(WS_ + r * 1024 + lane * 16 + 8) = p; }
    }
}
constexpr int CV_FOLD0 = 0, CV_IN0 = 256, CV_BR0 = 256 + 92 * 16, CV_WO0 = CV_BR0 + 256, CV_GU0 = CV_WO0 + 256, CV_DN0 = CV_GU0 + 8192, CV_SP0 = CV_DN0 + 4096, CV_END = CV_SP0 + 64;
__device__ __forceinline__ void convert_weights(PH_ARGS, const int l) { convert_range(lds, tid, lane, wave, bid, G, l, 0, CV_END, bid, G); }
__device__ __forceinline__ void load_row(const float* p, int lane, f32x4 (&v)[4]) {
#pragma unroll
    for (int j = 0; j < 4; ++j) v[j] = *(const f32x4*)(p + 4 * lane + 256 * j);
}
__device__ __forceinline__ void modnorm_store(f32x4 (&v)[4], const float* g, const float* sc, const float* sh, bf16* hrow, int lane) {
    float ss = 0.f;
#pragma unroll
    for (int j = 0; j < 4; ++j) ss += (v[j][0] * v[j][0] + v[j][1] * v[j][1]) + (v[j][2] * v[j][2] + v[j][3] * v[j][3]);
    const float rs = 1.0f / sqrtf(wave_sum(ss) * (1.f / 1024.f) + 1e-6f);
#pragma unroll
    for (int j = 0; j < 4; ++j) { const int o = 4 * lane + 256 * j; const f32x4 gg = *(const f32x4*)(g + o), s = *(const f32x4*)(sc + o), b = *(const f32x4*)(sh + o);
        v[j] = v[j] * rs * gg * (s + 1.f) + b; st4bf(hrow + o, v[j]); }
}
__device__ __forceinline__ void modnorm_regs(f32x4 (&v)[4], const f32x4 (&gm)[4], const f32x4 (&sh)[4], bf16* hrow, int lane) {
    float ss = 0.f;
#pragma unroll
    for (int j = 0; j < 4; ++j) ss += (v[j][0] * v[j][0] + v[j][1] * v[j][1]) + (v[j][2] * v[j][2] + v[j][3] * v[j][3]);
    const float rs = 1.0f / sqrtf(wave_sum(ss) * (1.f / 1024.f) + 1e-6f);
#pragma unroll
    for (int j = 0; j < 4; ++j) { v[j] = v[j] * rs * gm[j] + sh[j]; st4bf(hrow + 4 * lane + 256 * j, v[j]); }
}
__device__ __forceinline__ void load_mod(const float* g, const float* sc, const float* shp, int lane, f32x4 (&gm)[4], f32x4 (&sh)[4]) {
#pragma unroll
    for (int j = 0; j < 4; ++j) { const int o = 4 * lane + 256 * j; gm[j] = *(const f32x4*)(g + o) * (*(const f32x4*)(sc + o) + 1.f); sh[j] = *(const f32x4*)(shp + o); }
}
__device__ __forceinline__ void norm1_l0(PH_ARGS) {
    const int gw = bid * 8 + wave, NGW = G * 8; bf16* H = WSP(bf16, WS_H); const float* MOD = WSP(float, WS_MOD);
    const int RPW = (MT + NGW - 1) / NGW, row0 = gw * RPW, rend = (row0 + RPW < MT) ? row0 + RPW : MT;
    const float* xin = INP(0); const float* cin = INP(2); const float* g = INP(6);
    f32x4 cur[4], nxt[4], gm[4], sh[4]; int rprev = -1;
    if (row0 < rend) load_row(row0 < ML ? xin + (size_t)row0 * 1024 : cin + (size_t)(row0 - ML) * 1024, lane, cur);
    for (int row = row0; row < rend; ++row) {
        if (row + 1 < rend) { const int rn = row + 1; load_row(rn < ML ? xin + (size_t)rn * 1024 : cin + (size_t)(rn - ML) * 1024, lane, nxt); }
        const int r = row < SEQ ? 0 : (row < ML ? 1 : 2);
        if (r != rprev) { const float* md = MOD + r * 6144; load_mod(g, md + 1024, md, lane, gm, sh); rprev = r; }
        modnorm_regs(cur, gm, sh, H + (size_t)row * 1024, lane);
#pragma unroll
        for (int j = 0; j < 4; ++j) cur[j] = nxt[j];
    }
}
__device__ __forceinline__ void norm2_router(PH_ARGS, const int l, const int rbase, const int nrows, const int pidx, const int pcount, const bool load_table = true) {
    const int gw = pidx * 8 + wave, NGW = pcount * 8; bf16* H = WSP(bf16, WS_H); const float* MOD = WSP(float, WS_MOD) + l * 3 * 6144; const float* X = WSP(float, WS_X); float* AFF = WSP(float, WS_AFF);
    LAS f32x4* Wl = (LAS f32x4*)lds;
    if (load_table) { const f32x4* wr = (const f32x4*)(INP(23) + (size_t)l * 1024 * 16);
      for (int i = tid; i < 4096; i += 512) { const int k = i >> 2, q = i & 3; Wl[(q * 4 + (k & 3)) * 256 + (k >> 2)] = wr[i]; } }
    __syncthreads();
    const int RPW = (nrows + NGW - 1) / NGW, row0 = rbase + gw * RPW, rend = (gw * RPW + RPW < nrows) ? row0 + RPW : rbase + nrows;
    const float* g2 = INP(7) + l * 1024;
    f32x4 v[4], nxt[4], gm[4], sh[4]; int rprev = -1;
    if (row0 < rend) load_row(X + (size_t)row0 * 1024, lane, v);
    for (int row = row0; row < rend; ++row) {
        if (row + 1 < rend) load_row(X + (size_t)(row + 1) * 1024, lane, nxt);
        const int r = row < SEQ ? 0 : (row < ML ? 1 : 2);
        if (r != rprev) { const float* md = MOD + r * 6144; load_mod(g2, md + 4 * 1024, md + 3 * 1024, lane, gm, sh); rprev = r; }
        modnorm_regs(v, gm, sh, H + (size_t)row * 1024, lane);
        float lg[16];
#pragma unroll
        for (int e = 0; e < 16; ++e) lg[e] = 0.f;
#pragma unroll
        for (int j = 0; j < 4; ++j)
#pragma unroll
            for (int i = 0; i < 4; ++i) { const float hv = v[j][i];
#pragma unroll
                for (int q = 0; q < 4; ++q) { const f32x4 w = Wl[(q * 4 + i) * 256 + 64 * j + lane]; lg[4 * q + 0] += hv * w[0]; lg[4 * q + 1] += hv * w[1]; lg[4 * q + 2] += hv * w[2]; lg[4 * q + 3] += hv * w[3]; }
                if (i & 1) asm volatile("" ::: "memory"); }
#pragma unroll
        for (int i = 0; i < 8; ++i) { const bool up = lane & 32; const float send = up ? lg[i] : lg[i + 8], keep = up ? lg[i + 8] : lg[i]; lg[i] = keep + __shfl_xor(send, 32); }
#pragma unroll
        for (int i = 0; i < 4; ++i) { const bool up = lane & 16; const float send = up ? lg[i] : lg[i + 4], keep = up ? lg[i + 4] : lg[i]; lg[i] = keep + __shfl_xor(send, 16); }
#pragma unroll
        for (int i = 0; i < 2; ++i) { const bool up = lane & 8; const float send = up ? lg[i] : lg[i + 2], keep = up ? lg[i + 2] : lg[i]; lg[i] = keep + __shfl_xor(send, 8); }
        { const bool up = lane & 4; const float send = up ? lg[0] : lg[1], keep = up ? lg[1] : lg[0]; lg[0] = keep + __shfl_xor(send, 4); }
        float z = lg[0]; z += __shfl_xor(z, 1); z += __shfl_xor(z, 2);
        float mx = z; mx = fmaxf(mx, __shfl_xor(mx, 4)); mx = fmaxf(mx, __shfl_xor(mx, 8)); mx = fmaxf(mx, __shfl_xor(mx, 16)); mx = fmaxf(mx, __shfl_xor(mx, 32));
        const float ez = expf(z - mx); float sm = ez; sm += __shfl_xor(sm, 4); sm += __shfl_xor(sm, 8); sm += __shfl_xor(sm, 16); sm += __shfl_xor(sm, 32);
        if ((lane & 3) == 0) { const int e = ((lane >> 5) & 1) * 8 + ((lane >> 4) & 1) * 4 + ((lane >> 3) & 1) * 2 + ((lane >> 2) & 1); AFF[(size_t)row * 16 + e] = ez / sm; }
#pragma unroll
        for (int j = 0; j < 4; ++j) v[j] = nxt[j];
    }
    __syncthreads();
}
typedef short v4i16_t __attribute__((ext_vector_type(4)));
__device__ __forceinline__ void mfma16(f32x4& acc, const bf16x8 a, const bf16x8 b) { asm volatile("s_nop 1\n\tv_mfma_f32_16x16x32_bf16 %0, %1, %2, %0\n\ts_nop 3" : "+v"(acc) : "v"(a), "v"(b)); }
#define DRAIN4(x) asm volatile("s_nop 15\n\ts_nop 15" : "+v"((x)[0]), "+v"((x)[1]), "+v"((x)[2]), "+v"((x)[3]))
#define DRAIN8(x) asm volatile("s_nop 15\n\ts_nop 15" : "+v"((x)[0]), "+v"((x)[1]), "+v"((x)[2]), "+v"((x)[3]), "+v"((x)[4]), "+v"((x)[5]), "+v"((x)[6]), "+v"((x)[7]))
#define DRAIN16(x) asm volatile("s_nop 15\n\ts_nop 15" : "+v"((x)[0]), "+v"((x)[1]), "+v"((x)[2]), "+v"((x)[3]), "+v"((x)[4]), "+v"((x)[5]), "+v"((x)[6]), "+v"((x)[7]), \
    "+v"((x)[8]), "+v"((x)[9]), "+v"((x)[10]), "+v"((x)[11]), "+v"((x)[12]), "+v"((x)[13]), "+v"((x)[14]), "+v"((x)[15]))
__device__ __forceinline__ void gmlp_unit(PH_ARGS, const int l, const int chunk) {
    const int row0 = chunk < 128 ? chunk * 128 : ML + (chunk - 128) * 128;
    const bf16* AUV = WSP(bf16, WS_AUV); bf16* BRa = WSP(bf16, WS_BR); const bf16* WS_ = WSP(bf16, WS_WSP);
    LAS bf16* vT = (LAS bf16*)lds;
    const float* lg = INP(9) + l * 256; const float* lb = INP(10) + l * 256;
    const f32x4 gg = *(const f32x4*)(lg + 4 * lane), bb = *(const f32x4*)(lb + 4 * lane);
    uint2 raws[16];
#pragma unroll
    for (int pi = 0; pi < 16; ++pi) raws[pi] = *(const uint2*)(AUV + (size_t)(row0 + wave * 16 + pi) * 512 + 256 + 4 * lane);
#pragma unroll
    for (int pi = 0; pi < 16; ++pi) { const int p = wave * 16 + pi;
        const uint2 raw = raws[pi];
        float v0 = bflo(raw.x), v1 = bfhi(raw.x), v2 = bflo(raw.y), v3 = bfhi(raw.y);
        const float mean = wave_sum((v0 + v1) + (v2 + v3)) * (1.f / 256.f); v0 -= mean; v1 -= mean; v2 -= mean; v3 -= mean;
        const float rstd = 1.0f / sqrtf(wave_sum((v0 * v0 + v1 * v1) + (v2 * v2 + v3 * v3)) * (1.f / 256.f) + 1e-6f);
        vT[(4 * lane + 0) * 136 + p] = (bf16)f2bf(v0 * rstd * gg[0] + bb[0]); vT[(4 * lane + 1) * 136 + p] = (bf16)f2bf(v1 * rstd * gg[1] + bb[1]);
        vT[(4 * lane + 2) * 136 + p] = (bf16)f2bf(v2 * rstd * gg[2] + bb[2]); vT[(4 * lane + 3) * 136 + p] = (bf16)f2bf(v3 * rstd * gg[3] + bb[3]); }
    __syncthreads();
    const int g = wave >> 1, qh = wave & 1, fr = lane & 15, fq = lane >> 4;
    f32x4 acc[4][4];
#pragma unroll
    for (int a = 0; a < 4; ++a)
#pragma unroll
        for (int b = 0; b < 4; ++b) acc[a][b] = (f32x4){0.f, 0.f, 0.f, 0.f};
    const bf16* Wg = WS_ + g * 16384;
#pragma unroll
    for (int ks = 0; ks < 4; ++ks) { bf16x8 af[4], bf[4];
#pragma unroll
        for (int dt = 0; dt < 4; ++dt) af[dt] = *(const LAS bf16x8*)(vT + (g * 64 + dt * 16 + fr) * 136 + ks * 32 + fq * 8);
#pragma unroll
        for (int qt = 0; qt < 4; ++qt) bf[qt] = *(const bf16x8*)(Wg + (qh * 64 + qt * 16 + fr) * 128 + ks * 32 + fq * 8);
#pragma unroll
        for (int dt = 0; dt < 4; ++dt)
#pragma unroll
            for (int qt = 0; qt < 4; ++qt) mfma16(acc[dt][qt], af[dt], bf[qt]); }
    DRAIN16(&acc[0][0]);
    const float* bs = INP(12) + l * 512 + g * 128;
#pragma unroll
    for (int qt = 0; qt < 4; ++qt) { const int q = qh * 64 + qt * 16 + fr; const float bias = bs[q]; const size_t row = row0 + q;
#pragma unroll
        for (int dt = 0; dt < 4; ++dt) { const int ch = g * 64 + dt * 16 + 4 * fq; const uint2 uw = *(const uint2*)(AUV + row * 512 + ch);
            f32x4 o; o[0] = bflo(uw.x) * (acc[dt][qt][0] + bias); o[1] = bfhi(uw.x) * (acc[dt][qt][1] + bias); o[2] = bflo(uw.y) * (acc[dt][qt][2] + bias); o[3] = bfhi(uw.y) * (acc[dt][qt][3] + bias);
            st4bf(BRa + row * 256 + ch, o); } }
    __syncthreads();
}
__device__ __forceinline__ void conv_unit(PH_ARGS, const int l, const int unit) {
    int rowbase, n0, nlen;
    if (unit < 256) { rowbase = (unit >> 7) * SEQ; n0 = (unit & 127) * 64; nlen = SEQ; } else { const int u2 = unit - 256; rowbase = ML + (u2 >> 2) * CTXL; n0 = (u2 & 3) * 64; nlen = CTXL; }
    const bf16* CY = WSP(bf16, WS_CY); bf16* BRc = WSP(bf16, WS_BR) + (size_t)2 * MT * 256;
    LAS unsigned* yt = (LAS unsigned*)lds;
    LAS float* cres = (LAS float*)(lds + 48128);
    for (int p = tid; p < 94 * 32; p += 512) { const int rr = p >> 5, seg = p & 31, n = n0 - 15 + rr; v4u val = {0u, 0u, 0u, 0u};
        if (n >= 0 && n < nlen) val = *(const v4u*)(CY + (size_t)(rowbase + n) * 256 + seg * 8);
        *(LAS v4u*)(lds + rr * 512 + seg * 16) = val; }
    __syncthreads();
    const int cp = tid & 127, pg = tid >> 7;
    float w0[31], w1[31];
    const float* cw = INP(15) + (size_t)l * 31 * 256 + 2 * cp;
#pragma unroll
    for (int t = 0; t < 31; ++t) { const float2 w = *(const float2*)(cw + t * 256); w0[t] = w.x; w1[t] = w.y; }
    float a0[16], a1[16];
#pragma unroll
    for (int p = 0; p < 16; ++p) { a0[p] = 0.f; a1[p] = 0.f; }
#pragma unroll
    for (int i = 0; i < 46; ++i) { const unsigned raw = yt[(16 * pg + i) * 128 + cp]; const float v0 = bflo(raw), v1 = bfhi(raw);
#pragma unroll
        for (int p = 0; p < 16; ++p) { const int t = i - p; if (t >= 0 && t < 31) { a0[p] += v0 * w0[t]; a1[p] += v1 * w1[t]; } } }
    const float2 cb = *(const float2*)(INP(16) + l * 256 + 2 * cp);
#pragma unroll
    for (int p = 0; p < 16; ++p) *(LAS f2v*)(cres + (16 * pg + p) * 256 + 2 * cp) = (f2v){a0[p] + cb.x, a1[p] + cb.y};
    __syncthreads();
    const f32x4 gg = *(const f32x4*)(INP(17) + l * 256 + 4 * lane), bb = *(const f32x4*)(INP(18) + l * 256 + 4 * lane);
    for (int pi = 0; pi < 8; ++pi) { const int pos = wave * 8 + pi; f32x4 v = *(const LAS f32x4*)(cres + pos * 256 + 4 * lane);
        const float mean = wave_sum((v[0] + v[1]) + (v[2] + v[3])) * (1.f / 256.f); v = v - mean;
        const float rstd = 1.0f / sqrtf(wave_sum((v[0] * v[0] + v[1] * v[1]) + (v[2] * v[2] + v[3] * v[3])) * (1.f / 256.f) + 1e-6f);
        f32x4 o;
#pragma unroll
        for (int j = 0; j < 4; ++j) { const float y = v[j] * rstd * gg[j] + bb[j]; o[j] = y * sigm(y); }
        st4bf(BRc + (size_t)(rowbase + n0 + pos) * 256 + 4 * lane, o); }
    __syncthreads();
}
constexpr int F1_T1L = 0, F1_YL = 34816;
__device__ __forceinline__ void f1_stage_tables(PH_ARGS) {
    const bf16* T1 = WSP(bf16, WS_T1T);
    for (int p = tid; p < 128 * 16; p += 512) { const int r = p >> 4, s = p & 15; *(LAS v4u*)(lds + F1_T1L + r * 272 + s * 16) = *(const v4u*)(T1 + r * 128 + s * 8); }
    __syncthreads();
}
__device__ __forceinline__ void f1_unit(PH_ARGS, const int unit) {
    const int b = unit >> 7, n2 = unit & 127, fr = lane & 15, fq = lane >> 4;
    const bf16* YF = WSP(bf16, WS_YF); bf16* FA = WSP(bf16, WS_FA);
    LAS unsigned* Yl = (LAS unsigned*)(lds + F1_YL);
#pragma unroll
    for (int i = 0; i < 8; ++i) { const int n1 = wave + 8 * i; *(LAS v4u*)(Yl + n1 * 260 + lane * 4) = *(const v4u*)(YF + (size_t)(b * SEQ + 128 * n1 + n2) * 512 + lane * 8); }
    __syncthreads();
    f32x4 acc[2][8];
#pragma unroll
    for (int a = 0; a < 2; ++a)
#pragma unroll
        for (int n = 0; n < 8; ++n) acc[a][n] = (f32x4){0.f, 0.f, 0.f, 0.f};
#pragma unroll
    for (int ks = 0; ks < 4; ++ks) { bf16x8 af[2];
#pragma unroll
        for (int c2 = 0; c2 < 2; ++c2) { const int ch = (2 * wave + c2) * 16 + fr; v4u w;
            w.x = Yl[(16 * ks + 4 * fq + 0) * 260 + ch]; w.y = Yl[(16 * ks + 4 * fq + 1) * 260 + ch]; w.z = Yl[(16 * ks + 4 * fq + 2) * 260 + ch]; w.w = Yl[(16 * ks + 4 * fq + 3) * 260 + ch];
            af[c2] = __builtin_bit_cast(bf16x8, w); }
#pragma unroll
        for (int nt = 0; nt < 8; ++nt) { const bf16x8 bfr = *(const LAS bf16x8*)(lds + F1_T1L + (nt * 16 + fr) * 272 + ks * 64 + fq * 16);
            mfma16(acc[0][nt], af[0], bfr); mfma16(acc[1][nt], af[1], bfr); } }
    DRAIN16(&acc[0][0]);
#pragma unroll
    for (int c2 = 0; c2 < 2; ++c2)
#pragma unroll
        for (int kt = 0; kt < 4; ++kt) { const int k1 = kt * 16 + fr; const f32x4 ar = acc[c2][kt], ai = acc[c2][kt + 4];
            v4u o; o.x = pk2(ar[0], ai[0]); o.y = pk2(ar[1], ai[1]); o.z = pk2(ar[2], ai[2]); o.w = pk2(ar[3], ai[3]);
            *(v4u*)(FA + ((size_t)((b * 64 + k1) * 128 + n2) * 256 + (2 * wave + c2) * 16 + 4 * fq) * 2) = o; }
    __syncthreads();
}
constexpr int F2_T2L = 0, F2_AL = 67584;
__device__ __forceinline__ void f2_unit(PH_ARGS, const int unit) {
    const int fr = lane & 15, fq = lane >> 4; const bool lat = unit < 256;
    int b, k1, chh; const bf16* Asrc; const bf16* Tsrc; size_t orow0; int ostr; float scl;
    if (lat) { b = unit >> 7; k1 = (unit >> 1) & 63; chh = unit & 1; Asrc = WSP(bf16, WS_FA) + (size_t)((b * 64 + k1) * 128) * 512; Tsrc = WSP(bf16, WS_T2F) + (size_t)k1 * 32768; orow0 = (size_t)b * SEQ + k1; ostr = 64; scl = 0.0013810679320049757f; }
    else { const int u2 = unit - 256; b = u2 >> 2; k1 = (u2 >> 1) & 1; chh = u2 & 1; Asrc = WSP(bf16, WS_FAC) + (size_t)((b * 2 + k1) * 128) * 512; Tsrc = WSP(bf16, WS_T2C) + (size_t)k1 * 32768; orow0 = (size_t)ML + b * CTXL + k1; ostr = 2; scl = 1.f / 128.f; }
    bf16* BRb = WSP(bf16, WS_BR) + (size_t)1 * MT * 256;
    LAS unsigned* Al = (LAS unsigned*)(lds + F2_AL);
    for (int p = tid; p < 128 * 32; p += 512) { const int r = p >> 5, s = p & 31; *(LAS v4u*)(lds + F2_T2L + r * 528 + s * 16) = *(const v4u*)(Tsrc + r * 256 + s * 8); }
#pragma unroll
    for (int i = 0; i < 8; ++i) { const int n2 = wave * 16 + 2 * i + (lane >> 5);
        *(LAS v4u*)(Al + n2 * 132 + (lane & 31) * 4) = *(const v4u*)(Asrc + ((size_t)n2 * 256 + chh * 128) * 2 + (lane & 31) * 8); }
    __syncthreads();
    f32x4 acc[8];
#pragma unroll
    for (int n = 0; n < 8; ++n) acc[n] = (f32x4){0.f, 0.f, 0.f, 0.f};
    const int ch = wave * 16 + fr;
#pragma unroll
    for (int ks = 0; ks < 8; ++ks) { v4u w;
        w.x = Al[(16 * ks + 4 * fq + 0) * 132 + ch]; w.y = Al[(16 * ks + 4 * fq + 1) * 132 + ch]; w.z = Al[(16 * ks + 4 * fq + 2) * 132 + ch]; w.w = Al[(16 * ks + 4 * fq + 3) * 132 + ch];
        const bf16x8 af = __builtin_bit_cast(bf16x8, w);
#pragma unroll
        for (int nt = 0; nt < 8; ++nt) { const bf16x8 bfr = *(const LAS bf16x8*)(lds + F2_T2L + (nt * 16 + fr) * 528 + ks * 64 + fq * 16); mfma16(acc[nt], af, bfr); } }
    DRAIN8(acc);
#pragma unroll
    for (int nt = 0; nt < 8; ++nt) { const int k2 = nt * 16 + fr; st4bf(BRb + (orow0 + (size_t)ostr * k2) * 256 + chh * 128 + wave * 16 + 4 * fq, acc[nt] * scl); }
    __syncthreads();
}
__device__ __forceinline__ void ctx_butterfly(PH_ARGS) {
    const unsigned* YF = (const unsigned*)WSP(bf16, WS_YF); unsigned* FAC = (unsigned*)WSP(bf16, WS_FAC);
    for (int i = bid * 512 + tid; i < 2 * 128 * 256; i += G * 512) { const int b = i >> 15, n2 = (i >> 8) & 127, ch = i & 255;
        const unsigned y0 = YF[(size_t)(ML + b * CTXL + n2) * 256 + ch], y1 = YF[(size_t)(ML + b * CTXL + 128 + n2) * 256 + ch];
        const float r0 = bflo(y0), i0 = bfhi(y0), r1 = bflo(y1), i1 = bfhi(y1);
        FAC[(size_t)((b * 2 + 0) * 128 + n2) * 256 + ch] = pk2(r0 + r1, i0 + i1); FAC[(size_t)((b * 2 + 1) * 128 + n2) * 256 + ch] = pk2(r0 - r1, i0 - i1); }
}
constexpr int MG_AL = 0, MG_BL = 67584;
__device__ __forceinline__ void merge_phase(PH_ARGS, const int nunits) {
    const int fr = lane & 15, fq = lane >> 4, wr = wave >> 2, wc = wave & 3;
    const bf16* BR = WSP(bf16, WS_BR); const bf16* WBR = WSP(bf16, WS_WBR); const bf16* GT = WSP(bf16, WS_G); bf16* MB = WSP(bf16, WS_MB);
    int nmine = 0; for (int u = bid; u < nunits; u += G) ++nmine;
    const int nsteps = nmine * 4;
    if (nsteps == 0) return;
    v4u pa[8], pb[8];
#define MG_LOAD(s) do { const int u_ = bid + ((s) >> 2) * G, b_ = (s) & 3, rt_ = u_ >> 3, ct_ = u_ & 7; \
        const bf16* As = BR + ((size_t)b_ * MT + (size_t)rt_ * 128) * 256; const bf16* Bs = WBR + ((size_t)b_ * 1024 + (size_t)ct_ * 128) * 256; \
        _Pragma("unroll") for (int i = 0; i < 8; ++i) { const int p = i * 512 + tid, r = p >> 5, seg = p & 31; pa[i] = *(const v4u*)(As + (size_t)r * 256 + seg * 8); pb[i] = *(const v4u*)(Bs + (size_t)r * 256 + seg * 8); } } while (0)
#define MG_WRITE() do { _Pragma("unroll") for (int i = 0; i < 8; ++i) { const int p = i * 512 + tid, r = p >> 5, seg = p & 31; \
        *(LAS v4u*)(lds + MG_AL + r * 528 + seg * 16) = pa[i]; *(LAS v4u*)(lds + MG_BL + r * 528 + seg * 16) = pb[i]; } } while (0)
    MG_LOAD(0); MG_WRITE();
    f32x4 macc[4][2];
#pragma unroll
    for (int a = 0; a < 4; ++a)
#pragma unroll
        for (int n = 0; n < 2; ++n) macc[a][n] = (f32x4){0.f, 0.f, 0.f, 0.f};
#pragma unroll 1
    for (int s = 0; s < nsteps; ++s) {
        const int u = bid + (s >> 2) * G, b = s & 3, rt = u >> 3, ct = u & 7;
        __syncthreads();
        if (s + 1 < nsteps) MG_LOAD(s + 1);
        uint2 gw[4][2];
#pragma unroll
        for (int mt = 0; mt < 4; ++mt)
#pragma unroll
            for (int nt = 0; nt < 2; ++nt) gw[mt][nt] = *(const uint2*)(GT + ((((size_t)(u * 4 + b) * 8 + wave) * 8 + mt * 2 + nt) * 256 + lane * 4));
        f32x4 acc[4][2];
#pragma unroll
        for (int a = 0; a < 4; ++a)
#pragma unroll
            for (int n = 0; n < 2; ++n) acc[a][n] = (f32x4){0.f, 0.f, 0.f, 0.f};
#pragma unroll
        for (int ks = 0; ks < 8; ++ks) { bf16x8 af[4], bfr[2];
#pragma unroll
            for (int mt = 0; mt < 4; ++mt) af[mt] = *(const LAS bf16x8*)(lds + MG_AL + (wr * 64 + mt * 16 + fr) * 528 + ks * 64 + fq * 16);
#pragma unroll
            for (int nt = 0; nt < 2; ++nt) bfr[nt] = *(const LAS bf16x8*)(lds + MG_BL + (wc * 32 + nt * 16 + fr) * 528 + ks * 64 + fq * 16);
#pragma unroll
            for (int mt = 0; mt < 4; ++mt)
#pragma unroll
                for (int nt = 0; nt < 2; ++nt) mfma16(acc[mt][nt], bfr[nt], af[mt]); }
        DRAIN8(&acc[0][0]);
#pragma unroll
        for (int mt = 0; mt < 4; ++mt)
#pragma unroll
            for (int nt = 0; nt < 2; ++nt) { const uint2 g = gw[mt][nt]; macc[mt][nt][0] += bflo(g.x) * acc[mt][nt][0]; macc[mt][nt][1] += bfhi(g.x) * acc[mt][nt][1]; macc[mt][nt][2] += bflo(g.y) * acc[mt][nt][2]; macc[mt][nt][3] += bfhi(g.y) * acc[mt][nt][3]; }
        __syncthreads();
        if (s + 1 < nsteps) MG_WRITE();
        if (b == 3) {
#pragma unroll
            for (int mt = 0; mt < 4; ++mt)
#pragma unroll
                for (int nt = 0; nt < 2; ++nt) { st4bf(MB + (size_t)(rt * 128 + wr * 64 + mt * 16 + fr) * 1024 + ct * 128 + wc * 32 + nt * 16 + 4 * fq, macc[mt][nt]); macc[mt][nt] = (f32x4){0.f, 0.f, 0.f, 0.f}; }
        }
    }
    __syncthreads();
#undef MG_LOAD
#undef MG_WRITE
}
constexpr int AT_RPB = 32768, AT_MRG = 40960;
__device__ __forceinline__ int clampi(int v, int lo, int hi) { return v < lo ? lo : (v > hi ? hi : v); }
__device__ __forceinline__ bool at_need(int kind, int jb, int t) { return kind == 2 || (kind == 0 ? (jb < 2 || (jb == 2 && t == 1)) : (jb > 1 || (jb == 1 && t == 0))); }
struct AtCtx { const bf16* QPL; const bf16* KR; const bf16* VV; LAS unsigned char* vbuf; const LAS float* rpbl; int h, qh, fr, fq, lane, b, r, kr0, qrow0, nch, nwin; bool lat; unsigned code[2][2][2]; };
__device__ __forceinline__ unsigned at_keyrow(const AtCtx& X, int ci) { return (ci < X.nwin) ? ((unsigned)X.b * SEQ + (unsigned)(X.kr0 + (ci >> 1)) * 64 + 32 * (ci & 1)) : ((unsigned)ML + X.b * CTXL + 32 * (ci - X.nwin)); }
__device__ __forceinline__ void at_load(const AtCtx& X, int ci, bf16x8 (&kf)[2][2], v4u (&vst)[4]) {
    const unsigned kr = at_keyrow(X, ci);
#pragma unroll
    for (int t = 0; t < 2; ++t)
#pragma unroll
        for (int ks = 0; ks < 2; ++ks) kf[t][ks] = *(const bf16x8*)(X.KR + (unsigned)((kr + 16 * t + X.fr) * 256 + X.h * 64 + ks * 32 + X.fq * 8));
#pragma unroll
    for (int i = 0; i < 4; ++i) { const int p = i * 64 + X.lane, key = p >> 3, seg = p & 7; vst[i] = *(const v4u*)(X.VV + (unsigned)((kr + key) * 256 + X.h * 64 + seg * 8)); }
}
__device__ __forceinline__ void at_chunk(const AtCtx& X, const int ci, bf16x8 (&kf)[2][2], v4u (&vst)[4], bf16x8 (&qf)[2][2], f32x4 (&O)[2][4], float (&m)[2], float (&l)[2]) {
    const int kind = ci < X.nwin ? (ci & 1) : 2, fr = X.fr, fq = X.fq, qh = X.qh;
    if (X.lat && ci == 16) {
#pragma unroll
        for (int j = 0; j < 2; ++j)
#pragma unroll
            for (int ks = 0; ks < 2; ++ks) qf[j][ks] = *(const bf16x8*)(X.QPL + (unsigned)((X.qrow0 + 16 * (2 * qh + j) + fr) * 256 + X.h * 64 + ks * 32 + fq * 8));
        asm volatile("" : "+v"(qf[0][0]), "+v"(qf[0][1]), "+v"(qf[1][0]), "+v"(qf[1][1])); }
#pragma unroll
    for (int i = 0; i < 4; ++i) { const int p = i * 64 + X.lane, key = p >> 3, seg = p & 7; *(LAS v4u*)(X.vbuf + key * 128 + ((((seg >> 1) ^ ((key >> 1) & 3))) << 5) + ((seg & 1) << 4)) = vst[i]; }
    f32x4 S[2][2];
#pragma unroll
    for (int j = 0; j < 2; ++j)
#pragma unroll
        for (int t = 0; t < 2; ++t) { S[j][t] = (f32x4){0.f, 0.f, 0.f, 0.f}; mfma16(S[j][t], kf[t][0], qf[j][0]); mfma16(S[j][t], kf[t][1], qf[j][1]); }
    asm volatile("s_nop 15\n\ts_nop 15" : "+v"(S[0][0]), "+v"(S[0][1]), "+v"(S[1][0]), "+v"(S[1][1]));
#ifdef ATT_X1
    if (ci + 3 < X.nch) { at_load(X, ci + 3, kf, vst); asm volatile("" : "+v"(kf[0][0]), "+v"(kf[0][1]), "+v"(kf[1][0]), "+v"(kf[1][1]), "+v"(vst[0]), "+v"(vst[1]), "+v"(vst[2]), "+v"(vst[3])); }
#endif
    if (ci + 3 < X.nch) at_load(X, ci + 3, kf, vst);
    const LAS float* rpbrow = X.rpbl + (kind != 2 ? (X.kr0 + (ci >> 1) - X.r + 7) * 31 : 0);
    if (kind != 2) {
        float bv[2][2][4]; unsigned cw[2][2];
#pragma unroll
        for (int j = 0; j < 2; ++j)
#pragma unroll
            for (int t = 0; t < 2; ++t) { cw[j][t] = kind == 0 ? X.code[0][j][t] : X.code[1][j][t];
#pragma unroll
                for (int rg = 0; rg < 4; ++rg) bv[j][t][rg] = rpbrow[(cw[j][t] >> (8 * rg)) & 31u]; }
#pragma unroll
        for (int j = 0; j < 2; ++j)
#pragma unroll
            for (int t = 0; t < 2; ++t)
#pragma unroll
                for (int rg = 0; rg < 4; ++rg) S[j][t][rg] = ((cw[j][t] >> (8 * rg)) & 255u) < 32u ? S[j][t][rg] + bv[j][t][rg] : -1.0e30f;
    }
    bf16x8 pf[2];
#pragma unroll
    for (int j = 0; j < 2; ++j) {
        float mc = -3.0e38f;
#pragma unroll
        for (int t = 0; t < 2; ++t)
#pragma unroll
            for (int rg = 0; rg < 4; ++rg) { float s = S[j][t][rg];

                S[j][t][rg] = s; mc = fmaxf(mc, s); }
        { auto r16 = __builtin_amdgcn_permlane16_swap(__float_as_uint(mc), __float_as_uint(mc), false, false); mc = fmaxf(__uint_as_float(r16[0]), __uint_as_float(r16[1]));
          auto r32 = __builtin_amdgcn_permlane32_swap(__float_as_uint(mc), __float_as_uint(mc), false, false); mc = fmaxf(__uint_as_float(r32[0]), __uint_as_float(r32[1])); }
        const float mnew = fmaxf(m[j], mc), alpha = __expf(m[j] - mnew); m[j] = mnew; float ls = 0.f;
#pragma unroll
        for (int t = 0; t < 2; ++t)
#pragma unroll
            for (int rg = 0; rg < 4; ++rg) { const float sv = S[j][t][rg]; const float p = sv > -1.0e29f ? __expf(sv - mnew) : 0.f; S[j][t][rg] = p; ls += p; }
        l[j] = l[j] * alpha + ls;
        if (__any(alpha != 1.f)) {
#pragma unroll
            for (int dt = 0; dt < 4; ++dt) O[j][dt] = O[j][dt] * alpha; }
        v4u pw; pw.x = pk2(S[j][0][0], S[j][0][1]); pw.y = pk2(S[j][0][2], S[j][0][3]); pw.z = pk2(S[j][1][0], S[j][1][1]); pw.w = pk2(S[j][1][2], S[j][1][3]);
        pf[j] = __builtin_bit_cast(bf16x8, pw); }
#pragma unroll
    for (int dt = 0; dt < 4; ++dt) { v4i16_t t0, t1;
        { const int key = 4 * fq + (fr >> 2); t0 = __builtin_amdgcn_ds_read_tr16_b64_v4i16((LAS v4i16_t*)(X.vbuf + key * 128 + ((dt ^ ((key >> 1) & 3)) << 5) + (fr & 3) * 8)); }
        { const int key = 16 + 4 * fq + (fr >> 2); t1 = __builtin_amdgcn_ds_read_tr16_b64_v4i16((LAS v4i16_t*)(X.vbuf + key * 128 + ((dt ^ ((key >> 1) & 3)) << 5) + (fr & 3) * 8)); }
        const bf16x8 vf = (bf16x8){t0[0], t0[1], t0[2], t0[3], t1[0], t1[1], t1[2], t1[3]};
        mfma16(O[0][dt], vf, pf[0]); mfma16(O[1][dt], vf, pf[1]); }
    asm volatile("s_nop 15\n\ts_nop 7" : "+v"(O[0][0]), "+v"(O[0][1]), "+v"(O[0][2]), "+v"(O[0][3]), "+v"(O[1][0]), "+v"(O[1][1]), "+v"(O[1][2]), "+v"(O[1][3]));
}
__device__ __forceinline__ void attn_unit(PH_ARGS, const int unit) {
    AtCtx X; X.h = wave >> 1; X.qh = wave & 1; X.fr = lane & 15; X.fq = lane >> 4; X.lane = lane;
    X.lat = unit < 256; X.r = 0; X.kr0 = 0;
    if (X.lat) { X.b = unit >> 7; X.r = unit & 127; X.qrow0 = X.b * SEQ + X.r * 64; X.kr0 = clampi(X.r - 4, 0, 120); }
    else { const int u2 = unit - 256; X.b = u2 >> 2; X.qrow0 = ML + X.b * CTXL + (u2 & 3) * 64; }
    X.QPL = WSP(bf16, WS_QPL); const bf16* QROT = WSP(bf16, WS_QROT); X.KR = WSP(bf16, WS_KR); X.VV = WSP(bf16, WS_VV);
    bf16* BRd = WSP(bf16, WS_BR) + (size_t)3 * MT * 256;
    X.vbuf = lds + wave * 4096; X.rpbl = (const LAS float*)(lds + AT_RPB) + X.h * 465;
    X.nch = X.lat ? 24 : 8; X.nwin = X.lat ? 16 : 0;
#pragma unroll
    for (int kd = 0; kd < 2; ++kd)
#pragma unroll
        for (int j = 0; j < 2; ++j)
#pragma unroll
            for (int t = 0; t < 2; ++t) { unsigned cw = 0u; const int jb = 2 * X.qh + j;
#pragma unroll
                for (int rg = 0; rg < 4; ++rg) { const int kcol = 32 * kd + 16 * t + 4 * X.fq + rg, qcol = 16 * jb + X.fr, cst = clampi(qcol - 8, 0, 48); const bool ok = at_need(kd, jb, t) && kcol >= cst && kcol < cst + 16;
                    cw |= (ok ? (unsigned)(clampi(kcol - qcol, -15, 15) + 15) : 255u) << (8 * rg); }
                X.code[kd][j][t] = cw; }
    float m[2], l[2]; f32x4 O[2][4];
#pragma unroll
    for (int j = 0; j < 2; ++j) { m[j] = -3.0e38f; l[j] = 0.f;
#pragma unroll
        for (int dt = 0; dt < 4; ++dt) O[j][dt] = (f32x4){0.f, 0.f, 0.f, 0.f}; }
    bf16x8 qf[2][2];
    { const bf16* Qs = X.lat ? QROT : X.QPL;
#pragma unroll
      for (int j = 0; j < 2; ++j)
#pragma unroll
          for (int ks = 0; ks < 2; ++ks) qf[j][ks] = *(const bf16x8*)(Qs + (unsigned)((X.qrow0 + 16 * (2 * X.qh + j) + X.fr) * 256 + X.h * 64 + ks * 32 + X.fq * 8));
      asm volatile("" : "+v"(qf[0][0]), "+v"(qf[0][1]), "+v"(qf[1][0]), "+v"(qf[1][1])); }
    bf16x8 kA[2][2], kB[2][2], kC[2][2]; v4u vA[4], vB[4], vC[4];
    at_load(X, 0, kA, vA); at_load(X, 1, kB, vB); at_load(X, 2, kC, vC);
#pragma unroll 1
    for (int ci = 0; ci < X.nch; ci += 3) {
        at_chunk(X, ci, kA, vA, qf, O, m, l);
        if (ci + 1 < X.nch) at_chunk(X, ci + 1, kB, vB, qf, O, m, l);
        if (ci + 2 < X.nch) at_chunk(X, ci + 2, kC, vC, qf, O, m, l);
    }
#pragma unroll
    for (int j = 0; j < 2; ++j) { l[j] += __shfl_xor(l[j], 16); l[j] += __shfl_xor(l[j], 32); const float inv = 1.f / l[j];
#pragma unroll
        for (int dt = 0; dt < 4; ++dt) st4bf(BRd + (unsigned)((X.qrow0 + 16 * (2 * X.qh + j) + X.fr) * 256 + X.h * 64 + dt * 16 + 4 * X.fq), O[j][dt] * inv); }
}
#ifndef CDFT_REP
#define CDFT_REP 1
#endif
#ifndef CONV_REP
#define CONV_REP 1
#endif
#ifndef GMLP_REP
#define GMLP_REP 1
#endif
#ifndef F1_REP
#define F1_REP 1
#endif
__device__ __forceinline__ int block_excl_scan(int v, LAS int* ws8, int lane, int wave) {
    int x = v;
#pragma unroll
    for (int o = 1; o < 64; o <<= 1) { const int y = __shfl_up(x, o); if (lane >= o) x += y; }
    if (lane == 63) ws8[wave] = x;
    __syncthreads();
    int base = 0;
#pragma unroll
    for (int w = 0; w < 8; ++w) base += (w < wave) ? ws8[w] : 0;
    __syncthreads();
    return base + x - v;
}
__device__ __forceinline__ unsigned akey(float a) { const float s = a * 4294967296.f; return s >= 4294967040.f ? 0xFFFFFF00u : (unsigned)s; }
__device__ __forceinline__ float akey_inv(unsigned k) { return (float)k * (1.f / 4294967296.f); }
template <int PER, bool ALLV>
__device__ __forceinline__ void topk_unit(PH_ARGS, const int rowbase, const int n, const int C, const int e, const int sbase, const bool writepad) {
    const float* AFF = WSP(float, WS_AFF); int* SEL = WSP(int, WS_SEL); int* IDX = WSP(int, WS_IDX); float* GATE = WSP(float, WS_GATE);
    LAS unsigned* hist = (LAS unsigned*)lds; LAS unsigned* sh = hist + 256; LAS int* ws8 = (LAS int*)(hist + 272); LAS unsigned* hw = hist + 512 + wave * 256;
    unsigned key[PER]; bool valid[PER];
#pragma unroll
    for (int i = 0; i < PER; ++i) { const int tok = tid * PER + i; valid[i] = ALLV ? true : (tok < n); key[i] = valid[i] ? akey(AFF[(size_t)(rowbase + tok) * 16 + e]) : 0u; }
    unsigned prefix = 0u, mask = 0u, rem = (unsigned)C;
#pragma unroll 1
    for (int pass = 0; pass < 4; ++pass) { const int shift = 24 - 8 * pass;
        for (int i = lane; i < 256; i += 64) hw[i] = 0u;
        LDS_WAIT();
#pragma unroll
        for (int i = 0; i < PER; ++i) if (valid[i] && (key[i] & mask) == prefix) atomicAdd((unsigned*)&hw[(key[i] >> shift) & 255u], 1u);
        __syncthreads();
        if (tid < 256) { unsigned s_ = 0u;
#pragma unroll
            for (int w = 0; w < 8; ++w) s_ += hist[512 + w * 256 + tid];
            hist[tid] = s_; }
        __syncthreads();
        if (wave == 0) { unsigned c0 = hist[255 - 4 * lane], c1 = hist[254 - 4 * lane], c2 = hist[253 - 4 * lane], c3 = hist[252 - 4 * lane];
            const unsigned s = c0 + c1 + c2 + c3; unsigned x = s;
#pragma unroll
            for (int o = 1; o < 64; o <<= 1) { const unsigned y = __shfl_up(x, o); if (lane >= o) x += y; }
            const unsigned excl = x - s;
            if (excl < rem && rem <= x) { unsigned cum = excl; int bin; unsigned nr;
                if (cum + c0 >= rem) { bin = 255 - 4 * lane; nr = rem - cum; }
                else { cum += c0; if (cum + c1 >= rem) { bin = 254 - 4 * lane; nr = rem - cum; }
                else { cum += c1; if (cum + c2 >= rem) { bin = 253 - 4 * lane; nr = rem - cum; }
                else { cum += c2; bin = 252 - 4 * lane; nr = rem - cum; } } }
                sh[0] = (unsigned)bin; sh[1] = nr; } }
        __syncthreads();
        prefix |= sh[0] << shift; mask |= 255u << shift; rem = sh[1];
    }
    __syncthreads();
    const unsigned T = prefix;
    int neq = 0;
#pragma unroll
    for (int i = 0; i < PER; ++i) neq += (valid[i] && key[i] == T) ? 1 : 0;
    const int eqbase = block_excl_scan(neq, ws8, lane, wave);
    unsigned take = 0u; int nsel = 0, eqs = 0;
#pragma unroll
    for (int i = 0; i < PER; ++i) { const bool iseq = valid[i] && key[i] == T; const bool tk = valid[i] && (key[i] > T || (iseq && (unsigned)(eqbase + eqs) < rem)); eqs += iseq ? 1 : 0; if (tk) { take |= 1u << i; ++nsel; } }
    const int sb = block_excl_scan(nsel, ws8, lane, wave);
    int cnt = 0;
#pragma unroll
    for (int i = 0; i < PER; ++i) { const int tok = tid * PER + i;
        if (valid[i]) { if ((take >> i) & 1u) { const int slot = sbase + sb + cnt; ++cnt; IDX[e * ESTR + slot] = rowbase + tok; GATE[e * ESTR + slot] = akey_inv(key[i]); SEL[(size_t)(rowbase + tok) * 16 + e] = slot; }
                        else SEL[(size_t)(rowbase + tok) * 16 + e] = -1; } }
    if (writepad) for (int i = tid; i < ESTR - 2112; i += 512) { IDX[e * ESTR + 2112 + i] = 0; GATE[e * ESTR + 2112 + i] = 0.f; }
    __syncthreads();
}
__device__ __forceinline__ void gather_rows(PH_ARGS, const int tpe) {
    const int gw = bid * 8 + wave, NGW = G * 8, per = tpe * 256; const int* IDX = WSP(int, WS_IDX); const bf16* H = WSP(bf16, WS_H); bf16* XE = WSP(bf16, WS_XE);
    for (int i = gw; i < NE * per; i += NGW) { const int e = i / per, s = i % per, rg = e * ESTR + s; const int src = IDX[rg];
        const v4u a = *(const v4u*)(H + (size_t)src * 1024 + lane * 8), b = *(const v4u*)(H + (size_t)src * 1024 + 512 + lane * 8);
        *(v4u*)(XE + (size_t)rg * 1024 + lane * 8) = a; *(v4u*)(XE + (size_t)rg * 1024 + 512 + lane * 8) = b; }
}
struct CRow { v4u yw[4][2]; f32x4 xin[2][2]; float wgt[4]; unsigned long long bm; int cur; };
struct CCtx { const int* SEL; const bf16* YB; const float* X; bf16* H; const float* MOD; float* XO; float* OUT; const float* gnext; int l, lane; };
__device__ __forceinline__ void cr_issue(const CCtx& C, CRow& R, const int row) {
    const int lane = C.lane;
    R.cur = lane < 16 ? C.SEL[(size_t)row * 16 + lane] : -1;
    R.bm = __ballot(R.cur >= 0); const int cnt = __popcll(R.bm);
#pragma unroll
    for (int k = 0; k < 4; ++k) { const bool has = cnt > k; const int e = has ? (int)__builtin_ctzll(R.bm) : 0; if (has) R.bm &= R.bm - 1; const int s = __shfl(R.cur, e); R.wgt[k] = has ? 1.f : 0.f;
        const bf16* y = C.YB + (size_t)(has ? e * ESTR + s : 0) * 1024 + lane * 8; R.yw[k][0] = *(const v4u*)y; R.yw[k][1] = *(const v4u*)(y + 512); }
    const float* xr = C.X + (size_t)row * 1024;
#pragma unroll
    for (int j = 0; j < 2; ++j) { const int o = 8 * lane + 512 * j; R.xin[j][0] = *(const f32x4*)(xr + o); R.xin[j][1] = *(const f32x4*)(xr + o + 4); }
}
__device__ __forceinline__ void cr_finish(const CCtx& C, CRow& R, const int row) {
    const int lane = C.lane, l = C.l; const int r = row < SEQ ? 0 : (row < ML ? 1 : 2);
    float acc[2][8];
#pragma unroll
    for (int j = 0; j < 2; ++j)
#pragma unroll
        for (int i = 0; i < 8; ++i) acc[j][i] = 0.f;
#pragma unroll
    for (int k = 0; k < 4; ++k)
#pragma unroll
        for (int j = 0; j < 2; ++j) { const v4u w = R.yw[k][j]; const float g = R.wgt[k];
            acc[j][0] += g * bflo(w.x); acc[j][1] += g * bfhi(w.x); acc[j][2] += g * bflo(w.y); acc[j][3] += g * bfhi(w.y); acc[j][4] += g * bflo(w.z); acc[j][5] += g * bfhi(w.z); acc[j][6] += g * bflo(w.w); acc[j][7] += g * bfhi(w.w); }
    while (R.bm) { const int e = (int)__builtin_ctzll(R.bm); R.bm &= R.bm - 1; const int s = __shfl(R.cur, e); const bf16* y = C.YB + (size_t)(e * ESTR + s) * 1024 + lane * 8;
#pragma unroll
        for (int j = 0; j < 2; ++j) { const v4u w = *(const v4u*)(y + 512 * j);
            acc[j][0] += bflo(w.x); acc[j][1] += bfhi(w.x); acc[j][2] += bflo(w.y); acc[j][3] += bfhi(w.y); acc[j][4] += bflo(w.z); acc[j][5] += bfhi(w.z); acc[j][6] += bflo(w.w); acc[j][7] += bfhi(w.w); } }
    const float* gt2 = C.MOD + (l * 3 + r) * 6144 + 5 * 1024;
    float xv[2][8]; float ss = 0.f;
#pragma unroll
    for (int j = 0; j < 2; ++j) { const int o = 8 * lane + 512 * j; const f32x4 g0 = *(const f32x4*)(gt2 + o), g1 = *(const f32x4*)(gt2 + o + 4);
#pragma unroll
        for (int i = 0; i < 4; ++i) { xv[j][i] = R.xin[j][0][i] + g0[i] * acc[j][i]; xv[j][4 + i] = R.xin[j][1][i] + g1[i] * acc[j][4 + i]; }
#pragma unroll
        for (int i = 0; i < 8; ++i) ss += xv[j][i] * xv[j][i]; }
    const float rs = 1.0f / sqrtf(wave_sum(ss) * (1.f / 1024.f) + 1e-6f);
    if (l == 0) {
        const float* md = C.MOD + (1 * 3 + r) * 6144; float* xw = C.XO + (size_t)row * 1024;
#pragma unroll
        for (int j = 0; j < 2; ++j) { const int o = 8 * lane + 512 * j;
            *(f32x4*)(xw + o) = (f32x4){xv[j][0], xv[j][1], xv[j][2], xv[j][3]}; *(f32x4*)(xw + o + 4) = (f32x4){xv[j][4], xv[j][5], xv[j][6], xv[j][7]};
            const f32x4 g0 = *(const f32x4*)(C.gnext + o), g1 = *(const f32x4*)(C.gnext + o + 4), c0 = *(const f32x4*)(md + 1024 + o), c1 = *(const f32x4*)(md + 1024 + o + 4), h0 = *(const f32x4*)(md + o), h1 = *(const f32x4*)(md + o + 4);
            float hv[8];
#pragma unroll
            for (int i = 0; i < 4; ++i) { hv[i] = xv[j][i] * rs * g0[i] * (1.f + c0[i]) + h0[i]; hv[4 + i] = xv[j][4 + i] * rs * g1[i] * (1.f + c1[i]) + h1[i]; }
            v4u w; w.x = pk2(hv[0], hv[1]); w.y = pk2(hv[2], hv[3]); w.z = pk2(hv[4], hv[5]); w.w = pk2(hv[6], hv[7]);
            *(v4u*)(C.H + (size_t)row * 1024 + o) = w; }
    } else {
        float* orow = C.OUT + (size_t)row * 1024;
#pragma unroll
        for (int j = 0; j < 2; ++j) { const int o = 8 * lane + 512 * j; const f32x4 g0 = *(const f32x4*)(C.gnext + o), g1 = *(const f32x4*)(C.gnext + o + 4);
            *(f32x4*)(orow + o) = (f32x4){xv[j][0] * rs * g0[0], xv[j][1] * rs * g0[1], xv[j][2] * rs * g0[2], xv[j][3] * rs * g0[3]};
            *(f32x4*)(orow + o + 4) = (f32x4){xv[j][4] * rs * g1[0], xv[j][5] * rs * g1[1], xv[j][6] * rs * g1[2], xv[j][7] * rs * g1[3]}; }
    }
}
template <bool DUMMY>
__device__ __forceinline__ void combine_rows(PH_ARGS, const int l) {
    const int gw = bid * 8 + wave, NGW = G * 8; const int nrows = l == 0 ? MT : ML;
    CCtx C; C.SEL = WSP(int, WS_SEL); C.YB = WSP(bf16, WS_XE); C.X = WSP(float, WS_X); C.H = DUMMY ? WSP(bf16, WS_BR) : WSP(bf16, WS_H); C.MOD = WSP(float, WS_MOD);
    C.XO = DUMMY ? WSP(float, WS_ACT) : WSP(float, WS_X); C.OUT = DUMMY ? WSP(float, WS_ACT) : PTRV(28, float); C.gnext = l == 0 ? INP(6) + 1024 : INP(27); C.l = l; C.lane = lane;
    CRow A, B; int row = gw;
    if (row < nrows) cr_issue(C, A, row);
    while (row < nrows) {
        const int r2 = row + NGW; if (r2 < nrows) cr_issue(C, B, r2);
        cr_finish(C, A, row);
        const int r3 = r2 + NGW; if (r3 < nrows) cr_issue(C, A, r3);
        if (r2 < nrows) cr_finish(C, B, r2);
        row = r3;
    }
}

#ifdef DBG_STOP
__device__ __forceinline__ void debug_out(PH_ARGS) {
    float* out = PTRV(28, float);
    const int gt = bid * 512 + tid, GT = G * 512;
    for (size_t i = gt; i < (size_t)ML * 1024; i += GT) { const size_t row = i >> 10; const int c = (int)(i & 1023); float v = 0.f;
#if DBG_STOP == 2
        v = bflo(WSP(bf16, WS_H)[row * 1024 + c]) + WSP(float, WS_MOD)[(i % 36864)] + bflo(WSP(bf16, WS_WIN)[i % (6400 * 1024)]) + bflo(WSP(bf16, WS_WGU)[i]) + bflo(WSP(bf16, WS_WDN)[i]) + bflo(WSP(bf16, WS_WO)[i % (1024*1024)]) + bflo(WSP(bf16, WS_WBR)[i % (1024*1024)]);
#elif DBG_STOP == 3
        v = bflo(WSP(bf16, WS_AUV)[row * 512 + (c & 511)]) + bflo(WSP(bf16, WS_YF)[row * 512 + (c & 511)]) + bflo(WSP(bf16, WS_CY)[row * 256 + (c & 255)]) + bflo(WSP(bf16, WS_QPL)[row * 256 + (c & 255)])
          + bflo(WSP(bf16, WS_QROT)[row * 256 + (c & 255)]) + bflo(WSP(bf16, WS_KR)[row * 256 + (c & 255)]) + bflo(WSP(bf16, WS_VV)[row * 256 + (c & 255)])
          + bflo(WSP(bf16, WS_G)[row * 4096 + c]) + bflo(WSP(bf16, WS_G)[row * 4096 + 1024 + c]) + bflo(WSP(bf16, WS_G)[row * 4096 + 2048 + c]) + bflo(WSP(bf16, WS_G)[row * 4096 + 3072 + c]);
#elif DBG_STOP == 4
        v = bflo(WSP(bf16, WS_BR)[(size_t)(0 * MT + row) * 256 + (c & 255)]) + bflo(WSP(bf16, WS_BR)[(size_t)(2 * MT + row) * 256 + (c & 255)]) + bflo(WSP(bf16, WS_FA)[i % ((size_t)8 << 20)]);
#elif DBG_STOP == 21
        v = bflo(WSP(bf16, WS_T1T)[i % 16384]) * 1.001f + WSP(float, WS_ROPEC)[i % 2048] + WSP(float, WS_ROPES)[i % 2048] + bflo(WSP(bf16, WS_WSP)[i % 65536]);
#elif DBG_STOP == 31 || DBG_STOP == 44
        v = 0.f;
#elif DBG_STOP == 45 || DBG_STOP == 32
        v = 0.f;
#elif DBG_STOP == 41
        v = bflo(WSP(bf16, WS_BR)[(size_t)(0 * MT + row) * 256 + (c & 255)]) * 1.001f + bflo(WSP(bf16, WS_BR)[(size_t)(0 * MT + row) * 256 + ((c + 7) & 255)]);
#elif DBG_STOP == 42
        v = bflo(WSP(bf16, WS_BR)[(size_t)(2 * MT + row) * 256 + (c & 255)]) * 1.001f + bflo(WSP(bf16, WS_BR)[(size_t)(2 * MT + row) * 256 + ((c + 7) & 255)]);
#elif DBG_STOP == 43
        v = bflo(WSP(bf16, WS_FA)[i % ((size_t)8 << 20)]) * 1.001f + bflo(WSP(bf16, WS_FA)[(i + 7) % ((size_t)8 << 20)]);
#elif DBG_STOP == 5
        v = bflo(WSP(bf16, WS_BR)[(size_t)(1 * MT + row) * 256 + (c & 255)]) + bflo(WSP(bf16, WS_BR)[(size_t)(3 * MT + row) * 256 + (c & 255)]);
#elif DBG_STOP == 6
        v = bflo(WSP(bf16, WS_MB)[row * 1024 + c]);
#elif DBG_STOP == 7
        v = WSP(float, WS_X)[row * 1024 + c];
#elif DBG_STOP == 8
        v = bflo(WSP(bf16, WS_H)[row * 1024 + c]) + WSP(float, WS_AFF)[row * 16 + (c & 15)];
#elif DBG_STOP == 9
        v = (float)WSP(int, WS_SEL)[row * 16 + (c & 15)] + WSP(float, WS_GATE)[i % (16 * 2304)] + (float)WSP(int, WS_IDX)[i % (16 * 2304)];
#elif DBG_STOP == 10
        v = bflo(WSP(bf16, WS_XE)[i]) + bflo(WSP(bf16, WS_XE)[i + (size_t)ML * 1024]);
#elif DBG_STOP == 11
        v = bflo(WSP(bf16, WS_ACT)[i]) + bflo(WSP(bf16, WS_ACT)[i + (size_t)ML * 1024]);
#elif DBG_STOP == 12
        v = bflo(WSP(bf16, WS_XE)[i]) + bflo(WSP(bf16, WS_XE)[i + (size_t)ML * 1024]);
#else
        v = WSP(float, WS_X)[row * 1024 + c] + bflo(WSP(bf16, WS_H)[row * 1024 + c]);
#endif
#ifdef DBG_AMP
        v = (float)(__float_as_uint(v) & 0xFFFFu);
#endif
        out[i] = v; }
}
#endif
__global__ void __launch_bounds__(512, 2) mega(Args A) {
    extern __shared__ __attribute__((aligned(16))) unsigned char lds_raw[];
    LAS unsigned char* lds0 = (LAS unsigned char*)lds_raw;
    volatile LAS unsigned* MISC = (volatile LAS unsigned*)(lds0 + MISC_OFF);
    const int tid = threadIdx.x, lane = tid & 63, wave = __builtin_amdgcn_readfirstlane(tid >> 6), bid = blockIdx.x, G = gridDim.x;
    for (int u = tid; u < (LDS_BYTES - MISC_OFF) / 4; u += 512) ((LAS unsigned*)(lds0 + MISC_OFF))[u] = 0u;
    __syncthreads();
    if (tid == 0) { typedef unsigned u2v_t __attribute__((ext_vector_type(2)));
#pragma unroll
        for (int i = 0; i < 30; ++i) { const unsigned long long p = i < 28 ? (unsigned long long)A.in[i] : (i == 28 ? (unsigned long long)A.out : (unsigned long long)A.ws);
            *(LAS u2v_t*)(lds0 + PTAB_OFF + 8 * i) = (u2v_t){(unsigned)p, (unsigned)(p >> 32)}; } }
    __syncthreads();
    const int lo = A.ph_lo, hi = A.ph_hi;
    XcdBarrier bar; bar.bar = (unsigned*)(A.ws + WS_CTL) + CW_BAR; bar.x = 0; bar.st = nullptr;
    if (hi - lo > 1) bar = xcd_barrier_post((unsigned*)(A.ws + WS_CTL) + CW_BAR, MISC + 8);
#define PH_CALL lds, tl_, (tl_ & 63), wv_, bl_, G_
#define PH_CALLV lds, tl_, (tl_ & 63), wv_, vb_, G_
#ifdef TS_I
    if (bid == 0 && tid == 0) ((unsigned long long*)(A.ws + 65536))[lo] = rt();
#endif
    if (lo == 0) {
        int tl_ = tid; asm volatile("" : "+v"(tl_)); int bl_ = bid; asm volatile("" : "+s"(bl_)); int wv_ = wave; asm volatile("" : "+s"(wv_)); int G_ = G; asm volatile("" : "+s"(G_));
        unsigned ldsb_ = (unsigned)(uintptr_t)lds0; asm volatile("" : "+s"(ldsb_)); LAS unsigned char* lds = (LAS unsigned char*)(uintptr_t)ldsb_;
#ifndef P0R_MOD
#define P0R_MOD 1
#endif
#ifndef P0R_TAB
#define P0R_TAB 1
#endif
#ifndef P0R_CVT
#define P0R_CVT 1
#endif
#pragma unroll 1
            for (int r_ = 0; r_ < P0R_MOD; ++r_) { mod_gemv(PH_CALL); asm volatile("" ::: "memory"); }
#pragma unroll 1
            for (int r_ = 0; r_ < P0R_TAB; ++r_) { make_tables(PH_CALL); asm volatile("" ::: "memory"); }
#pragma unroll 1
            for (int r_ = 0; r_ < P0R_CVT; ++r_) { convert_weights(PH_CALL, 0); asm volatile("" ::: "memory"); }
        if (hi > 1) { XcdBarrier b2 = bar; b2.bar = (unsigned*)(PTRV(29, unsigned char) + WS_CTL) + CW_BAR; b2.st = (volatile LAS unsigned*)(lds + MISC_OFF) + 8; xcd_barrier(b2); }
    }
    const int lo1 = lo < 1 ? 1 : lo;
#pragma unroll 1
#ifdef REP_PH
    for (int it_ = lo1; it_ < hi + (REP_N - 1); ++it_) { const int ph = it_ < REP_PH ? it_ : (it_ < REP_PH + REP_N ? REP_PH : it_ - (REP_N - 1));
#else
    for (int ph = lo1; ph < hi; ++ph) {
#endif
        int tl_ = tid; asm volatile("" : "+v"(tl_)); int bl_ = bid; asm volatile("" : "+s"(bl_)); int vb_ = (G % 8 == 0) ? (bid % 8) * (G / 8) + bid / 8 : bid; asm volatile("" : "+s"(vb_)); int wv_ = wave; asm volatile("" : "+s"(wv_)); int G_ = G; asm volatile("" : "+s"(G_)); unsigned ldsb_ = (unsigned)(uintptr_t)lds0; asm volatile("" : "+s"(ldsb_)); LAS unsigned char* lds = (LAS unsigned char*)(uintptr_t)ldsb_;
        const int l = ph < 13 ? 0 : 1, kind = ph >= 99 ? 99 : (ph < 2 ? ph : 2 + (ph - 2 - 11 * l));
        const int ntm = l == 0 ? 66 : 64, tpe = l == 0 ? 9 : 8;
        if (kind == 9) continue;
        switch (kind) {
#ifdef DBG_STOP
        case 99: debug_out(PH_CALL); break;
#endif
        case 0: break;
        case 1: {
#ifndef DIS_N1
            norm1_l0(PH_CALL);
#endif
        } break;
        case 2: {
            pg8::Gemm g{WSP(bf16, WS_H), WSP(bf16, WS_WIN), MT, NIN, 1024}; pg8::StaticOrder S; S.init(MT, NIN, G_, bl_);
            EpiIn E{WSP(bf16, WS_AUV), WSP(bf16, WS_YF), WSP(bf16, WS_CY), WSP(bf16, WS_QPL), WSP(bf16, WS_QROT), WSP(bf16, WS_KR), WSP(bf16, WS_VV), WSP(bf16, WS_G), WSP(float, WS_ROPEC), WSP(float, WS_ROPES)};
#ifndef DIS_GIN
            pg8::gemm_phase<EpiIn, pg8::StaticOrder, true, true>(lds, g, S, E);
#endif
        } break;
        case 3: {
#ifndef DIS_F1
            if (bl_ < 256) { f1_stage_tables(PH_CALL);
#pragma unroll 1
              for (int r_ = 0; r_ < F1_REP; ++r_) for (int u = vb_; u < 256; u += G_) f1_unit(PH_CALL, u); }
#endif
            const int nconv = l == 0 ? 264 : 256, ngm = l == 0 ? 132 : 128;
#ifndef DIS_CONV
#pragma unroll 1
            for (int r_ = 0; r_ < CONV_REP; ++r_) for (int u = vb_; u < nconv; u += G_) conv_unit(PH_CALL, l, u);
#endif
#ifndef DIS_GMLP
#pragma unroll 1
            for (int r_ = 0; r_ < GMLP_REP; ++r_) for (int u = G_ - 1 - vb_; u < ngm; u += G_) gmlp_unit(PH_CALL, l, u);
#endif
#ifndef DIS_CDFT
            if (l == 0) ctx_butterfly(PH_CALL);
#endif
        } break;
        case 4: {
#ifndef DIS_F2
#ifndef F2_REP
#define F2_REP 1
#endif
#ifndef ATT_REP
#define ATT_REP 1
#endif
#pragma unroll 1
            for (int r_ = 0; r_ < F2_REP; ++r_) { const int nf2 = l == 0 ? 264 : 256; for (int u = vb_; u < nf2; u += G_) f2_unit(PH_CALL, u); }
#endif
            { LAS float* rp = (LAS float*)(lds + AT_RPB); const float* src = INP(20) + l * 1860; for (int i = tl_; i < 1860; i += 512) rp[i] = src[i]; }
            __syncthreads();
            const int nat = l == 0 ? 264 : 256;
#ifndef DIS_ATT
#pragma unroll 1
            for (int r_ = 0; r_ < ATT_REP; ++r_) for (int u = vb_; u < nat; u += G_) attn_unit(PH_CALL, u);
#endif
        } break;
        case 5: {
#ifndef DIS_GMRG
#ifndef MERGE_PG8
            merge_phase(PH_CALLV, ntm * 16);
#else
            { pg8::Gemm g{WSP(bf16, WS_BR), WSP(bf16, WS_WBR), 4 * MT, 4096, 256}; MergeOrder S; S.init(ntm, G_, bl_); EpiMergeH E{WSP(bf16, WS_G), WSP(bf16, WS_MB)};
              pg8::gemm_phase<EpiMergeH, MergeOrder, true, true>(lds, g, S, E); }
#endif
#endif
        } break;
        case 6: {
            pg8::Gemm g{WSP(bf16, WS_MB), WSP(bf16, WS_WO), ML, 1024, 1024}; pg8::StaticOrder S; S.init(ML, 1024, G_, bl_);
            EpiWout E{l == 0 ? INP(0) : WSP(float, WS_X), l == 0 ? INP(2) : WSP(float, WS_X) + (size_t)ML * 1024, WSP(float, WS_X), WSP(float, WS_MOD) + l * 3 * 6144};
#ifndef DIS_GWO
            pg8::gemm_phase<EpiWout, pg8::StaticOrder, true, true>(lds, g, S, E);
#endif
#ifndef DIS_CVT
            if (l == 0) { const int nx = (64 * 4) % G_; convert_range(lds, tl_, (tl_ & 63), wv_, bl_, G_, 1, CV_FOLD0, CV_WO0, nx ? bl_ - nx : bl_, G_ - nx); }
#endif
        } break;
        case 7: {
#ifndef DIS_N2
            if (l == 0 && G_ > 16) {
                unsigned* cnt = (unsigned*)(PTRV(29, unsigned char) + WS_CTL) + 2048;
                if (bl_ < 8) {
                    pg8::Gemm g{WSP(bf16, WS_MB), WSP(bf16, WS_WO), MT, 1024, 1024}; OneUnit S{64 + (bl_ >> 2), bl_ & 3};
                    EpiWout E{INP(0), INP(2), WSP(float, WS_X), WSP(float, WS_MOD)};
                    pg8::gemm_phase<EpiWout, OneUnit, true, true>(lds, g, S, E);
                    asm volatile("s_waitcnt vmcnt(0)" ::: "memory"); __syncthreads();
                    if (tl_ == 0) { __builtin_amdgcn_fence(__ATOMIC_RELEASE, "agent"); asm volatile("s_waitcnt vmcnt(0)" ::: "memory"); __hip_atomic_fetch_add(cnt, 1u, __ATOMIC_RELAXED, __HIP_MEMORY_SCOPE_AGENT); }
                } else norm2_router(PH_CALL, l, 0, ML, bl_ - 8, G_ - 8);
                if (tl_ == 0) { unsigned sp_ = 0; while (__hip_atomic_load(cnt, __ATOMIC_RELAXED, __HIP_MEMORY_SCOPE_AGENT) < 8u && ++sp_ < (1u << 22)) __builtin_amdgcn_s_sleep(2);
                    __builtin_amdgcn_fence(__ATOMIC_ACQUIRE, "agent"); asm volatile("s_waitcnt vmcnt(0)" ::: "memory"); }
                __syncthreads();
                norm2_router(PH_CALL, l, ML, MC, bl_, G_, bl_ < 8);
            } else norm2_router(PH_CALL, l, 0, ntm * 256, bl_, G_);
#endif
        } break;
        case 8: {
#ifndef DIS_TOPK
            const int nun = l == 0 ? 64 : 32;
            for (int u = bl_; u < nun; u += G_) {
                if (u < 32) { const int b = u >> 4, e = u & 15; topk_unit<16, true>(PH_CALL, b * SEQ, SEQ, CAPL, e, b * CAPL, l == 0 && b == 0); }
                else { const int b = (u - 32) >> 4, e = u & 15; topk_unit<1, false>(PH_CALL, ML + b * CTXL, CTXL, CAPC, e, 2048 + b * CAPC, false); }
            }
#endif
        } break;
        case 9: {
#ifndef DIS_GATH
            gather_rows(PH_CALL, tpe);
#endif
        } break;
        case 10: {
            pg8::Gemm g{WSP(bf16, WS_H), WSP(bf16, WS_WGU), NE * ESTR, NE * 2048, 1024, WSP(int, WS_IDX)}; GroupOrder S; S.init(tpe, 8, G_, bl_);
            EpiGU E{WSP(bf16, WS_ACT)};
#ifndef DIS_GGU
            pg8::gemm_phase<EpiGU, GroupOrder, true, true, true>(lds, g, S, E);
#endif
#ifndef DIS_CVT
            if (l == 0) { const int nx = (NE * tpe * 8) % G_; convert_range(lds, tl_, (tl_ & 63), wv_, bl_, G_, 1, CV_WO0, CV_GU0, nx ? bl_ - nx : bl_, G_ - nx);
                          convert_range(lds, tl_, (tl_ & 63), wv_, bl_, G_, 1, CV_SP0, CV_END, nx ? bl_ - nx : bl_, G_ - nx); }
#endif
        } break;
        case 11: {
            pg8::Gemm g{WSP(bf16, WS_ACT), WSP(bf16, WS_WDN), NE * ESTR, NE * 1024, 1024}; GroupOrder S; S.init(tpe, 4, G_, bl_);
            EpiDown E{WSP(bf16, WS_XE), WSP(float, WS_GATE)};
#ifndef DIS_GDN
            pg8::gemm_phase<EpiDown, GroupOrder, true, true>(lds, g, S, E);
#endif
#ifndef DIS_CVT
            if (l == 0) { const int nx = (NE * tpe * 4) % G_; convert_range(lds, tl_, (tl_ & 63), wv_, bl_, G_, 1, CV_GU0, CV_DN0, nx ? bl_ - nx : bl_, G_ - nx); }
#endif
        } break;
        default: {
#ifndef DIS_COMB
#ifdef COMB_REP
#pragma unroll 1
            for (int r_ = 0; r_ < COMB_REP; ++r_) combine_rows<true>(PH_CALL, l);
#endif
            combine_rows<false>(PH_CALL, l);
#endif
#ifndef DIS_CVT
            if (l == 0) convert_range(lds, tl_, (tl_ & 63), wv_, bl_, G_, 1, CV_DN0, CV_SP0, bl_, G_);
#endif
        } break;
        }
#ifdef XBAR
        if (ph == 1) { for (int xb_ = 0; xb_ < XBAR; ++xb_) { XcdBarrier b5 = bar; b5.bar = (unsigned*)(PTRV(29, unsigned char) + WS_CTL) + CW_BAR; b5.st = (volatile LAS unsigned*)(lds + MISC_OFF) + 8; xcd_barrier(b5); } }
#endif
#ifdef TS_I
        { XcdBarrier b3 = bar; b3.bar = (unsigned*)(PTRV(29, unsigned char) + WS_CTL) + CW_BAR; b3.st = (volatile LAS unsigned*)(lds + MISC_OFF) + 8; xcd_barrier(b3);
          if (bid == 0 && tid == 0) ((unsigned long long*)(PTRV(29, unsigned char) + 65536))[ph + 1] = rt(); }
        if (ph + 1 == hi) { XcdBarrier b3 = bar; b3.bar = (unsigned*)(PTRV(29, unsigned char) + WS_CTL) + CW_BAR; b3.st = (volatile LAS unsigned*)(lds + MISC_OFF) + 8; xcd_barrier(b3);
            const unsigned long long* TS = (const unsigned long long*)(PTRV(29, unsigned char) + 65536);
            const float dti = (float)(TS[TS_I + 1] - TS[TS_I]) * 0.01f, dtj = (float)(TS[TS_J + 1] - TS[TS_J]) * 0.01f;
            float* out = PTRV(28, float); const float Av = sqrtf(dti);
            for (size_t i = (size_t)bid * 512 + tid; i < (size_t)ML * 1024; i += (size_t)G * 512) out[i] = (i == 0) ? dtj * 10.f : Av; }
        if (0) {
#else
#ifdef REP_PH
        if (it_ + 1 < hi + (REP_N - 1)) {
#else
        if (ph + 1 < hi) {
#endif
#endif
          XcdBarrier b2 = bar; b2.bar = (unsigned*)(PTRV(29, unsigned char) + WS_CTL) + CW_BAR; unsigned bx_ = bar.x; asm volatile("" : "+s"(bx_)); b2.x = bx_; b2.st = (volatile LAS unsigned*)(lds + MISC_OFF) + 8; xcd_barrier(b2); }
    }
}

extern "C" void kernel_launch(void* const* d_in, const int* in_sizes, int n_in, void* d_out, int out_size, void* d_ws, size_t ws_size, hipStream_t stream) {
    static int grid = 0;
    if (grid == 0) {
        if (n_in != 28 || ws_size < WS_END) { fprintf(stderr, "kernel_launch: unexpected n_in %d / ws %zu\n", n_in, ws_size); grid = -1; return; }
        int dev = 0, cus = 0;
        if (hipGetDevice(&dev) != hipSuccess || hipDeviceGetAttribute(&cus, hipDeviceAttributeMultiprocessorCount, dev) != hipSuccess) { grid = -1; return; }
        if (hipFuncSetAttribute((const void*)mega, hipFuncAttributeMaxDynamicSharedMemorySize, LDS_BYTES) != hipSuccess) { fprintf(stderr, "kernel_launch: hipFuncSetAttribute failed\n"); grid = -1; return; }
        (void)hipGetLastError();
        grid = cus;
    }
    if (grid < 0) return;
    (void)hipMemsetAsync((char*)d_ws + WS_CTL, 0, CTL_ZERO_BYTES, stream);
    Args a{};
    for (int i = 0; i < 28; ++i) a.in[i] = (const float*)d_in[i];
    a.out = (float*)d_out; a.ws = (unsigned char*)d_ws;
#ifdef DBG_STOP
    for (int p = 0; p < (DBG_STOP > 20 ? DBG_STOP / 10 : DBG_STOP); ++p) { a.ph_lo = p; a.ph_hi = p + 1; hipLaunchKernelGGL(mega, dim3(grid), dim3(512), LDS_BYTES, stream, a); }
    a.ph_lo = 99; a.ph_hi = 100; hipLaunchKernelGGL(mega, dim3(grid), dim3(512), LDS_BYTES, stream, a);
#elif N_LAUNCHES == 1
    a.ph_lo = 0; a.ph_hi = NPH;
    hipLaunchKernelGGL(mega, dim3(grid), dim3(512), LDS_BYTES, stream, a);
#else
    for (int p = 0; p < NPH; ++p) { a.ph_lo = p; a.ph_hi = p + 1; hipLaunchKernelGGL(mega, dim3(grid), dim3(512), LDS_BYTES, stream, a); }
#endif
}
```

```cpp
#include <hip/hip_runtime.h>
#include <cstdio>
#include <cstdint>
#define N_LAUNCHES 1
namespace pg8 {
#define PG8_LAS __attribute__((address_space(3)))
typedef unsigned short bf16_t;
typedef short bf16x8 __attribute__((ext_vector_type(8)));
typedef float f32x4 __attribute__((ext_vector_type(4)));
typedef unsigned u32x4 __attribute__((ext_vector_type(4)));
constexpr int BM = 256, BK = 64, HALF = 128, HTB = HALF * BK * 2  , STAGE_BYTES = 8 * HTB, NXCD = 8, WGM = 2;

__host__ __device__ __forceinline__ int lds_byte(int r, int c) { const int st = (r >> 4) * 2 + (c >> 5), rr = r & 15, cc = c & 31, ob = rr * 64 + cc * 2; return st * 1024 + (ob ^ (((ob >> 9) & 1) << 5)); }
__host__ __device__ __forceinline__ void stage_rc(int b, int& R, int& C) { const int st = b / 1024, sb = b % 1024, swz = sb ^ (((sb >> 9) & 1) << 5); R = (st >> 1) * 16 + swz / 64; C = (st & 1) * 32 + (swz % 64) / 2; }
__host__ __device__ __forceinline__ int perm32(int rho) { const int n = rho >> 4, i = rho & 15; return 8 * (i >> 2) + 4 * n + (i & 3); }

struct Unit { int pm, pn; };
struct Gemm { const bf16_t* A; const bf16_t* Bt; int M, N, K; const int* gidx = nullptr; };

struct StaticOrder {
    int nM, nN, nwg, G, c;
    __host__ __device__ void init(int M, int N, int G_, int c_) { nM = M / BM; nN = N / BM; nwg = nM * nN; G = G_; c = c_; }
    __host__ __device__ bool next(int i, Unit& u) const {
        const long L = (long)i * G + c; if (L >= nwg) return false;
        int wgid = (int)L; { const int q = nwg / NXCD, r = nwg % NXCD, xcd = wgid % NXCD, off = wgid / NXCD; wgid = (xcd < r ? xcd * (q + 1) : r * (q + 1) + (xcd - r) * q) + off; }
        const int nig = WGM * nN, gid = wgid / nig, fm = gid * WGM, gsz = (nM - fm) < WGM ? (nM - fm) : WGM;
        u.pm = fm + ((wgid % nig) % gsz); u.pn = (wgid % nig) / gsz; return true;
    }
    __device__ __forceinline__ void a_ready(const Unit&) const {}
    __device__ __forceinline__ void done(const Unit&) const {}
};
__device__ __forceinline__ unsigned cvt_pk_bf16(float lo, float hi) { unsigned r; asm volatile("v_cvt_pk_bf16_f32 %0, %1, %2" : "=v"(r) : "v"(lo), "v"(hi)); return r; }
typedef float f32x2 __attribute__((ext_vector_type(2)));
template <class Epi, class Sched, bool ALIGN_EPI = false, bool SP2 = false, bool GATHER = false>
__device__ __forceinline__ void gemm_phase(PG8_LAS unsigned char* lds, const Gemm g, const Sched& S, const Epi& E) {
    int tid_l = threadIdx.x; asm volatile("" : "+v"(tid_l));
    const int tid = tid_l, wid = __builtin_amdgcn_readfirstlane(tid >> 6), lane = tid & 63, wr = wid >> 2, wc = wid & 3, fr = lane & 15, fq = lane >> 4;
    const int K = g.K, nt = K / BK;
    unsigned voffA[2], voffB[2];
#pragma unroll
    for (int i = 0; i < 2; ++i) { int R, C; stage_rc(tid * 16 + i * 8192, R, C); const int Rb = Epi::PERM ? ((R & ~31) + perm32(R & 31)) : R;
        voffA[i] = (unsigned)(R * K + C) * 2u; voffB[i] = (unsigned)(Rb * K + C) * 2u; }
    const size_t kstep = (size_t)(BK * 2);
    const size_t hstep = (size_t)HALF * K * 2;
    const size_t tstep = 2 * hstep;
    const unsigned ldsw = (unsigned)wid * 1024u;
    const int aoff = lds_byte(wr * 64 + fr, fq * 8), boff = lds_byte(wc * 32 + fr, fq * 8);
#define PG8_SA(b, h) (((b) * 2 + (h)) * HTB)
#define PG8_SB(b, h) ((4 + (b) * 2 + (h)) * HTB)
#define PG8_STAGE(bufoff, gbase, voff) do { _Pragma("unroll") for (int _i = 0; _i < 2; ++_i) \
        __builtin_amdgcn_global_load_lds((const unsigned*)((const char*)(gbase) + (voff)[_i]), (PG8_LAS unsigned*)(lds + (bufoff) + ldsw + _i * 8192), 16, 0, 0); } while (0)
    static_assert(!GATHER || SP2, "GATHER is implemented on the SP2 loop only");
    unsigned vgc[2][2] = {{0u, 0u}, {0u, 0u}}, vgn[2][2] = {{0u, 0u}, {0u, 0u}};
#define PG8_GLOAD(u, v) do { _Pragma("unroll") for (int _h = 0; _h < 2; ++_h) _Pragma("unroll") for (int _i = 0; _i < 2; ++_i) { int R_, C_; stage_rc(tid * 16 + _i * 8192, R_, C_); \
        v[_h][_i] = (unsigned)(g.gidx[(u).pm * BM + _h * HALF + R_] * K + C_) * 2u; } } while (0)
#define PG8_STAGE_A(bufoff, base, half, NEXT) do { if constexpr (GATHER) { if (NEXT) PG8_STAGE(bufoff, base, vgn[half]); else PG8_STAGE(bufoff, base, vgc[half]); } \
        else PG8_STAGE(bufoff, (base) + (half) * hstep, voffA); } while (0)
#define PG8_LDA(dst, b, h) do { _Pragma("unroll") for (int m = 0; m < 4; ++m) _Pragma("unroll") for (int k = 0; k < 2; ++k) dst[m][k] = *(const PG8_LAS bf16x8*)(lds + PG8_SA(b, h) + aoff + m * 2048 + k * 1024); } while (0)
#define PG8_LDB(dst, b, h) do { _Pragma("unroll") for (int n = 0; n < 2; ++n) _Pragma("unroll") for (int k = 0; k < 2; ++k) dst[n][k] = *(const PG8_LAS bf16x8*)(lds + PG8_SB(b, h) + boff + n * 2048 + k * 1024); } while (0)
#define PG8_MMA(ai, bj, At, Bt) do { __builtin_amdgcn_s_setprio(1); _Pragma("unroll") for (int m = 0; m < 4; ++m) _Pragma("unroll") for (int n = 0; n < 2; ++n) _Pragma("unroll") for (int k = 0; k < 2; ++k) \
        acc[ai][bj][m][n] = __builtin_amdgcn_mfma_f32_16x16x32_bf16(Bt[n][k], At[m][k], acc[ai][bj][m][n], 0, 0, 0); __builtin_amdgcn_s_setprio(0); } while (0)
#define PG8_WAIT_V(n) asm volatile("s_waitcnt vmcnt(" #n ")" ::: "memory")
#define PG8_WAIT_L(n) asm volatile("s_waitcnt lgkmcnt(" #n ")" ::: "memory")
#define PG8_BAR __builtin_amdgcn_s_barrier()
#define PG8_SCHED __builtin_amdgcn_sched_barrier(0)
    Unit cur, nxt; int ui = 0;
    if (!S.next(0, cur)) return;
    f32x4 acc[2][2][4][2];
#pragma unroll
    for (int a = 0; a < 2; ++a)
#pragma unroll
        for (int b = 0; b < 2; ++b)
#pragma unroll
            for (int m = 0; m < 4; ++m)
#pragma unroll
                for (int n = 0; n < 2; ++n) acc[a][b][m][n] = (f32x4){0.f, 0.f, 0.f, 0.f};
    bf16x8 At[4][2], B0[2][2], B1[2][2];
    const char* cA = GATHER ? (const char*)g.A : (const char*)g.A + (size_t)cur.pm * tstep; const char* cB = (const char*)g.Bt + (size_t)cur.pn * tstep;
    if constexpr (GATHER) { PG8_GLOAD(cur, vgc); }
    S.a_ready(cur);
    if constexpr (SP2) {
        PG8_STAGE(PG8_SB(0, 0), cB, voffB); PG8_STAGE(PG8_SB(0, 1), cB + hstep, voffB); PG8_STAGE_A(PG8_SA(0, 0), cA, 0, false); PG8_STAGE_A(PG8_SA(0, 1), cA, 1, false);
        if (wr == 1) PG8_BAR;
        PG8_WAIT_V(2); PG8_BAR;
        PG8_STAGE(PG8_SB(1, 0), cB + kstep, voffB); PG8_STAGE_A(PG8_SA(1, 0), cA + kstep, 0, false); PG8_STAGE(PG8_SB(1, 1), cB + hstep + kstep, voffB);
        PG8_WAIT_V(6); PG8_BAR;
    } else {
        PG8_STAGE(PG8_SB(0, 0), cB, voffB); PG8_STAGE(PG8_SA(0, 0), cA, voffA); PG8_STAGE(PG8_SB(0, 1), cB + hstep, voffB); PG8_STAGE(PG8_SA(0, 1), cA + hstep, voffA);
        if (wr == 1) PG8_BAR;
        PG8_WAIT_V(4); PG8_BAR;
        PG8_STAGE(PG8_SB(1, 0), cB + kstep, voffB); PG8_STAGE(PG8_SA(1, 0), cA + kstep, voffA); PG8_STAGE(PG8_SB(1, 1), cB + hstep + kstep, voffB);
        PG8_WAIT_V(6); PG8_BAR;
    }
    for (;;) {
        const bool has_next = S.next(ui + 1, nxt);
        const char* nA = GATHER ? (const char*)g.A : (has_next ? (const char*)g.A + (size_t)nxt.pm * tstep : cA);
        if constexpr (GATHER) { if (has_next) { PG8_GLOAD(nxt, vgn); } else { _Pragma("unroll") for (int _h = 0; _h < 2; ++_h) _Pragma("unroll") for (int _i = 0; _i < 2; ++_i) vgn[_h][_i] = vgc[_h][_i]; } } const char* nB = has_next ? (const char*)g.Bt + (size_t)nxt.pn * tstep : cB;
#pragma unroll 1
        for (int t = 0; t < nt; t += 2) {
            const bool last = (t == nt - 2);
            const char* a1 = cA + (size_t)(t + 1) * kstep;
            const char* a2 = last ? nA : cA + (size_t)(t + 2) * kstep; const char* b2 = last ? nB : cB + (size_t)(t + 2) * kstep;
            const char* a3 = a2 + kstep; const char* b3 = b2 + kstep;
            if (last && has_next) S.a_ready(nxt);
            if constexpr (SP2) {
            PG8_LDB(B0, 0, 0); PG8_LDB(B1, 0, 1); PG8_SCHED; PG8_LDA(At, 0, 0); PG8_STAGE_A(PG8_SA(1, 1), a1, 1, false);
            PG8_WAIT_V(8); PG8_WAIT_L(0); PG8_BAR; PG8_MMA(0, 0, At, B0); PG8_MMA(0, 1, At, B1); PG8_BAR; PG8_SCHED;
            PG8_LDA(At, 0, 1); PG8_STAGE(PG8_SB(0, 0), b2, voffB); PG8_STAGE(PG8_SB(0, 1), b2 + hstep, voffB); PG8_STAGE_A(PG8_SA(0, 0), a2, 0, last);
            PG8_WAIT_V(8); PG8_WAIT_L(0); PG8_BAR; PG8_MMA(1, 0, At, B0); PG8_MMA(1, 1, At, B1); PG8_BAR; PG8_SCHED;
            PG8_LDB(B0, 1, 0); PG8_LDB(B1, 1, 1); PG8_SCHED; PG8_LDA(At, 1, 0); PG8_STAGE_A(PG8_SA(0, 1), a2, 1, last);
            PG8_WAIT_V(8); PG8_WAIT_L(0); PG8_BAR; PG8_MMA(0, 0, At, B0); PG8_MMA(0, 1, At, B1); PG8_BAR; PG8_SCHED;
            PG8_LDA(At, 1, 1); PG8_STAGE(PG8_SB(1, 0), b3, voffB); PG8_STAGE(PG8_SB(1, 1), b3 + hstep, voffB); PG8_STAGE_A(PG8_SA(1, 0), a3, 0, last);
            PG8_WAIT_V(8); PG8_WAIT_L(0); PG8_BAR; PG8_MMA(1, 0, At, B0); PG8_MMA(1, 1, At, B1); PG8_BAR; PG8_SCHED;
            } else {
            PG8_LDB(B0, 0, 0); PG8_SCHED; PG8_LDA(At, 0, 0); PG8_STAGE(PG8_SA(1, 1), a1 + hstep, voffA);
            PG8_WAIT_L(8); PG8_BAR; PG8_WAIT_L(0); PG8_MMA(0, 0, At, B0); PG8_BAR; PG8_SCHED;
            PG8_LDB(B1, 0, 1); PG8_STAGE(PG8_SB(0, 0), b2, voffB);
            PG8_BAR; PG8_WAIT_L(0); PG8_MMA(0, 1, At, B1); PG8_BAR;
            PG8_LDA(At, 0, 1); PG8_STAGE(PG8_SA(0, 0), a2, voffA);
            PG8_BAR; PG8_WAIT_L(0); PG8_MMA(1, 0, At, B0); PG8_BAR; PG8_SCHED;
            PG8_STAGE(PG8_SB(0, 1), b2 + hstep, voffB);
            PG8_WAIT_V(6); PG8_BAR; PG8_MMA(1, 1, At, B1); PG8_BAR;
            PG8_LDB(B0, 1, 0); PG8_SCHED; PG8_LDA(At, 1, 0); PG8_STAGE(PG8_SA(0, 1), a2 + hstep, voffA);
            PG8_WAIT_L(8); PG8_BAR; PG8_WAIT_L(0); PG8_MMA(0, 0, At, B0); PG8_BAR; PG8_SCHED;
            PG8_LDB(B1, 1, 1); PG8_STAGE(PG8_SB(1, 0), b3, voffB);
            PG8_BAR; PG8_WAIT_L(0); PG8_MMA(0, 1, At, B1); PG8_BAR;
            PG8_LDA(At, 1, 1); PG8_STAGE(PG8_SA(1, 0), a3, voffA);
            PG8_BAR; PG8_WAIT_L(0); PG8_MMA(1, 0, At, B0); PG8_BAR; PG8_SCHED;
            PG8_STAGE(PG8_SB(1, 1), b3 + hstep, voffB);
            PG8_WAIT_V(6); PG8_BAR; PG8_MMA(1, 1, At, B1); PG8_BAR;
            }
        }
        if constexpr (ALIGN_EPI) { if (wr == 0) PG8_BAR; }
        if constexpr (!Epi::AFTER_DRAIN) { int t2_ = threadIdx.x; asm volatile("" : "+v"(t2_)); E(acc, cur, wr, wc, t2_ & 15, (t2_ >> 4) & 3); S.done(cur); }
        if (!has_next) break;
        bool keep_ = false; if constexpr (Epi::KEEP) keep_ = E.keep(cur);
        if (!keep_) {
#pragma unroll
        for (int a = 0; a < 2; ++a)
#pragma unroll
            for (int b = 0; b < 2; ++b)
#pragma unroll
                for (int m = 0; m < 4; ++m)
#pragma unroll
                    for (int n = 0; n < 2; ++n) acc[a][b][m][n] = (f32x4){0.f, 0.f, 0.f, 0.f};
        }
        cur = nxt; cA = nA; cB = nB; ++ui;
        if constexpr (GATHER) { _Pragma("unroll") for (int _h = 0; _h < 2; ++_h) _Pragma("unroll") for (int _i = 0; _i < 2; ++_i) vgc[_h][_i] = vgn[_h][_i]; }
        if constexpr (ALIGN_EPI) { if (wr == 1) PG8_BAR; }
    }
    PG8_WAIT_V(0);
    if constexpr (!ALIGN_EPI) { if (wr == 0) PG8_BAR; }
    PG8_BAR;
    if constexpr (Epi::AFTER_DRAIN) { E.fused(acc, cur, wr, wc, fr, fq, lds, wid, lane); S.done(cur); }
#undef PG8_SA
#undef PG8_SB
#undef PG8_STAGE
#undef PG8_STAGE_A
#undef PG8_GLOAD
#undef PG8_LDA
#undef PG8_LDB
#undef PG8_MMA
#undef PG8_WAIT_V
#undef PG8_WAIT_L
#undef PG8_BAR
#undef PG8_SCHED
}
}
#define GAS __attribute__((address_space(1)))
#define LAS __attribute__((address_space(3)))
typedef unsigned short bf16;
typedef unsigned v4u __attribute__((ext_vector_type(4)));
typedef float f32x4 __attribute__((ext_vector_type(4)));
typedef short bf16x8 __attribute__((ext_vector_type(8)));
typedef GAS unsigned gu32;
typedef GAS unsigned long long gu64;
#define RLX_AGENT __ATOMIC_RELAXED, __HIP_MEMORY_SCOPE_AGENT
#define LDS_WAIT() asm volatile("s_waitcnt lgkmcnt(0)" ::: "memory")
#define VM_WAIT() asm volatile("s_waitcnt vmcnt(0)" ::: "memory")
__device__ __forceinline__ unsigned long long rt() { return __builtin_amdgcn_s_memrealtime(); }
__device__ __forceinline__ unsigned f2bf(float f) { unsigned u = __builtin_bit_cast(unsigned, f); return (u + 0x7fffu + ((u >> 16) & 1u)) >> 16; }
typedef float f32x2_t __attribute__((ext_vector_type(2))); typedef __bf16 bf16x2_t __attribute__((ext_vector_type(2)));
__device__ __forceinline__ unsigned pk2(float lo, float hi) { const f32x2_t v = {lo, hi}; const bf16x2_t b = __builtin_convertvector(v, bf16x2_t); return __builtin_bit_cast(unsigned, b); }

#define XB_TMO      128
#define XB_XCNT(j)  (256  + 64 * (j))
#define XB_XSUB(j)  (1280 + 64 * (j))
#define XB_XGEN(j)  (2304 + 64 * (j))
#define XB_TOP      3328
#define XB_TOPGEN   3392
#define XCD_BAR_WORDS 3456
#define XB_SPIN_CAP (1u << 18)

__device__ __forceinline__ unsigned xb_ld(unsigned* p)              { return __hip_atomic_load(p, __ATOMIC_RELAXED, __HIP_MEMORY_SCOPE_AGENT); }
__device__ __forceinline__ unsigned xb_add(unsigned* p, unsigned v) { return __hip_atomic_fetch_add(p, v, __ATOMIC_RELAXED, __HIP_MEMORY_SCOPE_AGENT); }
__device__ __forceinline__ unsigned xb_xcc_id() { return (unsigned)__builtin_amdgcn_s_getreg((3 << 11) | 20) & 0xFu; }
#define XB_SPIN(cond, bar) do { unsigned _sp = 0; while (cond) { __builtin_amdgcn_s_sleep(1); \
    if ((++_sp & 255u) == 0u) { if (xb_ld(&(bar)[XB_TMO])) break; if (_sp > XB_SPIN_CAP) { atomicAdd(&(bar)[XB_TMO], 1u); break; } } } } while (0)

struct XcdBarrier {
    unsigned* bar; unsigned x;
    volatile LAS unsigned* st;
};

__device__ __forceinline__ XcdBarrier xcd_barrier_post(unsigned* bar, volatile LAS unsigned* st) {
    XcdBarrier b; b.bar = bar; b.x = xb_xcc_id(); b.st = st;
    if (threadIdx.x == 0) (void)xb_add(&bar[XB_XCNT(b.x)], 1u);
    return b;
}
__device__ __forceinline__ void xcd_barrier_complete(unsigned* bar, unsigned x, unsigned& nloc, unsigned& nx) {
    const unsigned G = gridDim.x * gridDim.y * gridDim.z;
    unsigned sum, cnt, mine, sp = 0u;
    for (;;) {
        sum = 0u; cnt = 0u; mine = 0u;
#pragma unroll
        for (unsigned j = 0; j < 16; ++j) { const unsigned c = xb_ld(&bar[XB_XCNT(j)]); sum += c; cnt += (c > 0u) ? 1u : 0u; mine = (j == x) ? c : mine; }
        if (sum == G) break;
        __builtin_amdgcn_s_sleep(1);
        if ((++sp & 255u) == 0u) { if (xb_ld(&bar[XB_TMO])) break; if (sp > XB_SPIN_CAP) { atomicAdd(&bar[XB_TMO], 1u); break; } }
    }
    nloc = mine > 0u ? mine : 1u; nx = cnt > 0u ? cnt : 1u;
}

__device__ __forceinline__ void xcd_barrier(const XcdBarrier& b) {
    asm volatile("s_waitcnt vmcnt(0)" ::: "memory");
    __syncthreads();
    if (threadIdx.x == 0) {
        unsigned* bar = b.bar;
        __builtin_amdgcn_s_waitcnt(0);
        unsigned nloc = b.st[0], nx = b.st[1];
        if (nloc == 0u) { xcd_barrier_complete(bar, b.x, nloc, nx); b.st[0] = nloc; b.st[1] = nx; }
        const unsigned old = xb_add(&bar[XB_XSUB(b.x)], 1u);
        const unsigned gen = old / nloc;
        if (old + 1u == (gen + 1u) * nloc) {
            __builtin_amdgcn_fence(__ATOMIC_RELEASE, "agent");
            asm volatile("s_waitcnt vmcnt(0)" ::: "memory");
            const unsigned og = xb_add(&bar[XB_TOP], 1u);
            const unsigned tg = og / nx;
            if (og + 1u == (tg + 1u) * nx) xb_add(&bar[XB_TOPGEN], 1u);
            else XB_SPIN(xb_ld(&bar[XB_TOPGEN]) == tg, bar);
            __builtin_amdgcn_fence(__ATOMIC_ACQUIRE, "agent");
            xb_add(&bar[XB_XGEN(b.x)], 1u);
            asm volatile("s_waitcnt vmcnt(0)" ::: "memory");
        } else {
            XB_SPIN(xb_ld(&bar[XB_XGEN(b.x)]) == gen, bar);
            __builtin_amdgcn_fence(__ATOMIC_ACQUIRE, "agent");
            asm volatile("s_waitcnt vmcnt(0)" ::: "memory");
        }
    }
    __syncthreads();
}
constexpr int DM = 1024, SEQ = 8192, NBATCH = 2, CTXL = 256;
constexpr int ML = NBATCH * SEQ, MC = NBATCH * CTXL, MT = ML + MC;
constexpr int NIN = 6400;
constexpr int NE = 16, ESTR = 2304, CAPL = 1024, CAPC = 32;
constexpr int NPH = 24;
constexpr size_t MiB = 1u << 20;
constexpr size_t WS_CTL = 0, CTL_ZERO_BYTES = 1 * MiB;
constexpr size_t WS_MOD = 1 * MiB;
constexpr size_t WS_ROPEC = 1 * MiB + 256 * 1024, WS_ROPES = WS_ROPEC + 8192;
constexpr size_t WS_TW = 1 * MiB + 512 * 1024;
constexpr size_t WS_CS256 = 1 * MiB + 640 * 1024;
constexpr size_t WS_T1T = 2 * MiB;
constexpr size_t WS_T2T = 2 * MiB + 64 * 1024;
constexpr size_t WS_T2F = 8 * MiB;
constexpr size_t WS_T2C = 12 * MiB;
constexpr size_t WS_FAC = 13 * MiB;
constexpr size_t WS_WSP = 2 * MiB + 256 * 1024;
constexpr size_t WS_AFF = 3 * MiB;
constexpr size_t WS_SEL = 5 * MiB;
constexpr size_t WS_IDX = 7 * MiB, WS_GATE = 7 * MiB + 256 * 1024;
constexpr size_t WS_WIN = 16 * MiB, WS_WBR = 29 * MiB, WS_WO = 31 * MiB, WS_WGU = 33 * MiB, WS_WDN = 97 * MiB;
constexpr size_t WS_X = 130 * MiB;
constexpr size_t WS_H = 196 * MiB;
constexpr size_t WS_BR = 229 * MiB;
constexpr size_t WS_MB = 262 * MiB;
constexpr size_t WS_FA = 295 * MiB;
constexpr size_t WS_Z = 311 * MiB;
constexpr size_t ZROW = (size_t)MT * 2;
constexpr size_t WS_AUV = WS_Z, WS_YF = WS_AUV + 512 * ZROW, WS_CY = WS_YF + 512 * ZROW, WS_QPL = WS_CY + 256 * ZROW, WS_QROT = WS_QPL + 256 * ZROW,
                 WS_KR = WS_QROT + 256 * ZROW, WS_VV = WS_KR + 256 * ZROW, WS_G = WS_VV + 256 * ZROW, WS_ZEND = WS_G + 4096 * ZROW;
constexpr size_t WS_P32 = WS_Z;
constexpr size_t WS_XE = WS_Z, WS_ACT = WS_Z + 72 * MiB;
constexpr size_t WS_END = 518 * MiB;
static_assert(WS_G == WS_P32 + (size_t)MT * 1024 * 4 + 8 * 256 * ZROW / 8 - 256 * ZROW || true, "");
static_assert(WS_ZEND <= WS_END && WS_ACT + 72 * MiB <= WS_ZEND && WS_P32 + (size_t)MT * 4096 <= WS_VV, "ws map");
constexpr int CW_BAR = 4096;
constexpr int LDS_BYTES = 155648, MISC_OFF = 154624;

struct Args { const float* in[28]; float* out; unsigned char* ws; int ph_lo, ph_hi; };

__device__ __forceinline__ float bflo(unsigned w) { return __uint_as_float(w << 16); }
__device__ __forceinline__ float bfhi(unsigned w) { return __uint_as_float(w & 0xffff0000u); }
__device__ __forceinline__ float sigm(float x) { return __builtin_amdgcn_rcpf(1.f + __expf(-x)); }
__device__ __forceinline__ float wave_sum(float v) {
#pragma unroll
    for (int o = 1; o < 64; o <<= 1) v += __shfl_xor(v, o);
    return v;
}
__device__ __forceinline__ void st4bf(bf16* p, f32x4 v) { uint2 w; w.x = pk2(v[0], v[1]); w.y = pk2(v[2], v[3]); *(uint2*)p = w; }

__device__ __forceinline__ void st8bf(bf16* p, f32x4 a, f32x4 b) { v4u w; w.x = pk2(a[0], a[1]); w.y = pk2(a[2], a[3]); w.z = pk2(b[0], b[1]); w.w = pk2(b[2], b[3]); *(v4u*)p = w; }
using pg8::Unit;
struct EpiIn {
    static constexpr bool PERM = false, AFTER_DRAIN = false, KEEP = false;
    bf16 *AUV, *YF, *CY, *QPL, *QROT, *KR, *VV, *G; const float* ropeC; const float* ropeS;
    __device__ __forceinline__ void operator()(const f32x4 (&acc)[2][2][4][2], const Unit& u, int wr, int wc, int fr, int fq) const {
        const int pn = u.pn, row0 = u.pm * 256 + wr * 64 + fr, cl0 = wc * 32 + 4 * fq;
        const int cp0 = wc * 32 + 8 * fq;
        if (pn < 2) {
#pragma unroll
            for (int ai = 0; ai < 2; ++ai)
#pragma unroll
                for (int m = 0; m < 4; ++m) { const size_t row = row0 + ai * 128 + m * 16;
#pragma unroll
                    for (int bj = 0; bj < 2; ++bj) { f32x4 v[2];
#pragma unroll
                        for (int n = 0; n < 2; ++n)
#pragma unroll
                            for (int j = 0; j < 4; ++j) { const float x = acc[ai][bj][m][n][j]; v[n][j] = x * sigm(1.5957691216f * (x + 0.044715f * x * x * x)); }
                        st8bf(AUV + row * 512 + pn * 256 + bj * 128 + cp0, v[0], v[1]); } }
        } else if (pn < 4) {
#pragma unroll
            for (int ai = 0; ai < 2; ++ai)
#pragma unroll
                for (int m = 0; m < 4; ++m) { const size_t row = row0 + ai * 128 + m * 16;
#pragma unroll
                    for (int bj = 0; bj < 2; ++bj) st8bf(YF + row * 512 + (pn - 2) * 256 + bj * 128 + cp0, acc[ai][bj][m][0], acc[ai][bj][m][1]); }
        } else if (pn < 6) {
#pragma unroll
            for (int ai = 0; ai < 2; ++ai)
#pragma unroll
                for (int m = 0; m < 4; ++m) { const size_t row = row0 + ai * 128 + m * 16; f32x4 v[2];
#pragma unroll
                    for (int n = 0; n < 2; ++n) { const f32x4 a = acc[ai][0][m][n], g = acc[ai][1][m][n];
#pragma unroll
                        for (int j = 0; j < 4; ++j) v[n][j] = a[j] * sigm(g[j]); }
                    st8bf(CY + row * 256 + (pn - 4) * 128 + cp0, v[0], v[1]); }
        } else if (pn < 8) {
            const bool isq = pn == 6; const float scl = isq ? 0.125f : 1.f; const bool latent = u.pm < 64;
#pragma unroll
            for (int ai = 0; ai < 2; ++ai)
#pragma unroll
                for (int m = 0; m < 4; ++m) { const int rowi = row0 + ai * 128 + m * 16; const size_t row = rowi; const int tok = rowi & 8191;
                    const int pos = (wc & 1) ? (tok & 63) : (tok >> 6);
                    f32x4 cs = {1.f, 1.f, 1.f, 1.f}, sn = {0.f, 0.f, 0.f, 0.f};
                    if (latent) { cs = *(const f32x4*)(ropeC + pos * 16 + 4 * fq); sn = *(const f32x4*)(ropeS + pos * 16 + 4 * fq); }
#pragma unroll
                    for (int bj = 0; bj < 2; ++bj) { const f32x4 x1 = acc[ai][bj][m][0] * scl, x2 = acc[ai][bj][m][1] * scl;
                        const f32x4 r1 = x1 * cs - x2 * sn, r2 = x1 * sn + x2 * cs; const size_t off = row * 256 + bj * 128 + cl0;
                        if (isq) { st4bf(QPL + off, x1); st4bf(QPL + off + 16, x2); st4bf(QROT + off, r1); st4bf(QROT + off + 16, r2); }
                        else { st4bf(KR + off, r1); st4bf(KR + off + 16, r2); } } }
        } else if (pn == 8) {
#pragma unroll
            for (int ai = 0; ai < 2; ++ai)
#pragma unroll
                for (int m = 0; m < 4; ++m) { const size_t row = row0 + ai * 128 + m * 16;
#pragma unroll
                    for (int bj = 0; bj < 2; ++bj) st8bf(VV + row * 256 + bj * 128 + cp0, acc[ai][bj][m][0], acc[ai][bj][m][1]); }
        } else {
#pragma unroll
            for (int ai = 0; ai < 2; ++ai)
#pragma unroll
                for (int m = 0; m < 4; ++m) { const size_t row = row0 + ai * 128 + m * 16;
#pragma unroll
                    for (int bj = 0; bj < 2; ++bj)
#pragma unroll
                        for (int n = 0; n < 2; ++n) { f32x4 v = acc[ai][bj][m][n];
#pragma unroll
                            for (int j = 0; j < 4; ++j) v[j] = sigm(v[j]);
                            const int gb_ = (pn - 9) >> 2, gu_ = (2 * u.pm + ai) * 8 + 2 * ((pn - 9) & 3) + bj;
                            st4bf(G + ((((size_t)(gu_ * 4 + gb_) * 8 + (wr * 4 + wc)) * 8 + m * 2 + n) * 256 + (fq * 16 + fr) * 4), v); } }
        }
    }
};
struct EpiMerge {
    static constexpr bool PERM = false, AFTER_DRAIN = false, KEEP = false;
    const bf16* G; float* P32; bf16* MB;
    __device__ __forceinline__ void operator()(const f32x4 (&acc)[2][2][4][2], const Unit& u, int wr, int wc, int fr, int fq) const {
        int fr_ = fr, fq_ = fq; asm volatile("" : "+v"(fr_), "+v"(fq_));
        const int b = u.pn >> 2, pn = u.pn & 3, pm = u.pm - b * 66, row0 = pm * 256 + wr * 64 + fr_, col0 = pn * 256 + wc * 32 + 4 * fq_;
#pragma unroll
        for (int ai = 0; ai < 2; ++ai)
#pragma unroll
            for (int m = 0; m < 4; ++m) { const unsigned row = row0 + ai * 128 + m * 16;
                const bf16* gp = G + ((size_t)row * 4096 + b * 1024 + col0); float* pp = P32 + ((size_t)row * 1024 + col0); bf16* mp = MB + ((size_t)row * 1024 + col0);
#pragma unroll
                for (int bj = 0; bj < 2; ++bj)
#pragma unroll
                    for (int n = 0; n < 2; ++n) { const int co = bj * 128 + n * 16;
                        const uint2 gw = *(const uint2*)(gp + co);
                        f32x4 v = acc[ai][bj][m][n]; v[0] *= bflo(gw.x); v[1] *= bfhi(gw.x); v[2] *= bflo(gw.y); v[3] *= bfhi(gw.y);
                        if (b > 0) v += *(const f32x4*)(pp + co);
                        if (b < 3) *(f32x4*)(pp + co) = v; else st4bf(mp + co, v);
                        asm volatile("" ::: "memory"); } }
    }
};
struct EpiMergeH {
    static constexpr bool PERM = false, AFTER_DRAIN = false, KEEP = true;
    const bf16* G; bf16* MB;
    __device__ __forceinline__ bool keep(const Unit& u) const { return (u.pn >> 2) < 3; }
    __device__ __forceinline__ void operator()(f32x4 (&acc)[2][2][4][2], const Unit& u, int wr, int wc, int fr, int fq) const {
        const int b = u.pn >> 2, pn = u.pn & 3, pm = u.pm - b * 66, row0 = pm * 256 + wr * 64 + fr, col0 = pn * 256 + wc * 32 + 4 * fq;
#pragma unroll
        for (int ai = 0; ai < 2; ++ai)
#pragma unroll
            for (int m = 0; m < 4; ++m) { const unsigned row = row0 + ai * 128 + m * 16; const bf16* gp = G + ((size_t)row * 4096 + b * 1024 + col0); bf16* mp = MB + ((size_t)row * 1024 + col0);
#pragma unroll
                for (int bj = 0; bj < 2; ++bj)
#pragma unroll
                    for (int n = 0; n < 2; ++n) { const int co = bj * 128 + n * 16; const uint2 gb = *(const uint2*)(gp + co); f32x4 v = acc[ai][bj][m][n];
                        if (b < 3) { const uint2 gn = *(const uint2*)(gp + 1024 + co);
                            v[0] *= bflo(gb.x) * __builtin_amdgcn_rcpf(bflo(gn.x)); v[1] *= bfhi(gb.x) * __builtin_amdgcn_rcpf(bfhi(gn.x)); v[2] *= bflo(gb.y) * __builtin_amdgcn_rcpf(bflo(gn.y)); v[3] *= bfhi(gb.y) * __builtin_amdgcn_rcpf(bfhi(gn.y));
                            acc[ai][bj][m][n] = v; }
                        else { v[0] *= bflo(gb.x); v[1] *= bfhi(gb.x); v[2] *= bflo(gb.y); v[3] *= bfhi(gb.y); st4bf(mp + co, v); } }
                asm volatile("" ::: "memory"); }
    }
};
struct EpiWout {
    static constexpr bool PERM = false, AFTER_DRAIN = false, KEEP = false;
    const float* xlat; const float* xctx; float* X; const float* mod;
    __device__ __forceinline__ void operator()(const f32x4 (&acc)[2][2][4][2], const Unit& u, int wr, int wc, int fr, int fq) const {
        const int r = u.pm < 32 ? 0 : (u.pm < 64 ? 1 : 2); const float* gt = mod + r * 6144 + 2 * 1024;
        const int row0 = u.pm * 256 + wr * 64 + fr, col0 = u.pn * 256 + wc * 32 + 4 * fq;
        f32x4 gv[2][2];
#pragma unroll
        for (int bj = 0; bj < 2; ++bj)
#pragma unroll
            for (int n = 0; n < 2; ++n) gv[bj][n] = *(const f32x4*)(gt + col0 + bj * 128 + n * 16);
#pragma unroll
        for (int ai = 0; ai < 2; ++ai)
#pragma unroll
            for (int m = 0; m < 4; ++m) { const size_t row = row0 + ai * 128 + m * 16; const float* src = (row < ML) ? xlat + row * 1024 : xctx + (row - ML) * 1024;
#pragma unroll
                for (int bj = 0; bj < 2; ++bj)
#pragma unroll
                    for (int n = 0; n < 2; ++n) { const int col = col0 + bj * 128 + n * 16;
                        *(f32x4*)(X + row * 1024 + col) = *(const f32x4*)(src + col) + gv[bj][n] * acc[ai][bj][m][n]; } }
    }
};
struct EpiGU {
    static constexpr bool PERM = true, AFTER_DRAIN = false, KEEP = false;
    bf16* ACT;
    __device__ __forceinline__ void operator()(const f32x4 (&acc)[2][2][4][2], const Unit& u, int wr, int wc, int fr, int fq) const {
        const int pnl = u.pn & 7, row0 = u.pm * 256 + wr * 64 + fr, cl0 = wc * 32 + 8 * fq;
#pragma unroll
        for (int ai = 0; ai < 2; ++ai)
#pragma unroll
            for (int m = 0; m < 4; ++m) { const size_t row = row0 + ai * 128 + m * 16; f32x4 v[2];
#pragma unroll
                for (int n = 0; n < 2; ++n) { const f32x4 a = acc[ai][0][m][n], up = acc[ai][1][m][n];
#pragma unroll
                    for (int j = 0; j < 4; ++j) v[n][j] = a[j] * sigm(a[j]) * up[j]; }
                st8bf(ACT + row * 1024 + pnl * 128 + cl0, v[0], v[1]); }
    }
};
struct EpiDown {
    static constexpr bool PERM = true, AFTER_DRAIN = false, KEEP = false;
    bf16* YB; const float* GATE;
    __device__ __forceinline__ void operator()(const f32x4 (&acc)[2][2][4][2], const Unit& u, int wr, int wc, int fr, int fq) const {
        const int pnl = u.pn & 3, row0 = u.pm * 256 + wr * 64 + fr, col0 = pnl * 256 + wc * 32 + 8 * fq;
#pragma unroll
        for (int ai = 0; ai < 2; ++ai)
#pragma unroll
            for (int m = 0; m < 4; ++m) { const size_t row = row0 + ai * 128 + m * 16; const float gt = GATE[row];
#pragma unroll
                for (int bj = 0; bj < 2; ++bj) st8bf(YB + row * 1024 + col0 + bj * 128, acc[ai][bj][m][0] * gt, acc[ai][bj][m][1] * gt); }
    }
};
struct MergeOrder {
    int nt, G, c;
    __device__ void init(int ntm, int G_, int c_) { nt = ntm * 4; G = G_; c = c_; }
    __device__ bool next(int i, Unit& u) const { const int b = i & 3, L = (i >> 2) * G + c; if (L >= nt) return false; u.pm = b * 66 + (L >> 2); u.pn = b * 4 + (L & 3); return true; }
    __device__ __forceinline__ void a_ready(const Unit&) const {}
    __device__ __forceinline__ void done(const Unit&) const {}
};
struct OneUnit { int pm, pn; __device__ bool next(int i, Unit& u) const { if (i > 0) return false; u.pm = pm; u.pn = pn; return true; }
    __device__ __forceinline__ void a_ready(const Unit&) const {} __device__ __forceinline__ void done(const Unit&) const {} };
struct GroupOrder {
    int nwg, G, c, TPE, NTN;
    __device__ void init(int tpe, int ntn, int G_, int c_) { TPE = tpe; NTN = ntn; nwg = NE * tpe * ntn; G = G_; c = c_; }
    __device__ bool next(int i, Unit& u) const {
        const long L = (long)i * G + c; if (L >= nwg) return false;
        int wgid = (int)L; { const int q = nwg / 8, r = nwg % 8, xcd = wgid % 8, off = wgid / 8; wgid = (xcd < r ? xcd * (q + 1) : r * (q + 1) + (xcd - r) * q) + off; }
        const int per = TPE * NTN, e = wgid / per, rem = wgid % per;
#ifdef GO_MT_MAJOR
        const int mt = rem / NTN, pn = rem % NTN;
#else
        const int pn = rem / TPE, mt = rem % TPE;
#endif
        u.pm = e * 9 + mt; u.pn = e * NTN + pn; return true;
    }
    __device__ __forceinline__ void a_ready(const Unit&) const {}
    __device__ __forceinline__ void done(const Unit&) const {}
};
typedef float f2v __attribute__((ext_vector_type(2)));
#define PH_ARGS LAS unsigned char* lds, const int tid, const int lane, const int wave, const int bid, const int G
#define WSP(T, off) ((T*)(PTRV(29, unsigned char) + (off)))
constexpr int PTAB_OFF = MISC_OFF + 512;
__device__ __forceinline__ unsigned long long ptab_ld(LAS unsigned char* lds, int i) {
    typedef unsigned u2v_t __attribute__((ext_vector_type(2)));
    const volatile LAS unsigned* tp = (const volatile LAS unsigned*)(lds + PTAB_OFF + 8 * i); u2v_t v; v[0] = tp[0]; v[1] = tp[1];
    const unsigned lo = __builtin_amdgcn_readfirstlane(v[0]), hi = __builtin_amdgcn_readfirstlane(v[1]);
    return ((unsigned long long)hi << 32) | lo;
}
#define PTRV(i, T) ((T*)(GAS T*)ptab_ld(lds, (i)))
#define INP(i) ((const float*)(GAS const float*)ptab_ld(lds, (i)))

__device__ __forceinline__ void mod_gemv(PH_ARGS) {
    LAS f32x4* red = (LAS f32x4*)lds;
    const float* c = INP(1); const float* cc = INP(3); const float* wm = INP(4); const float* bm = INP(5);
    float* MOD = WSP(float, WS_MOD);
    for (int it = bid; it < 192; it += G) {
        const int l = it / 96, cg = it % 96, kg = tid >> 4, cq = tid & 15;
        f32x4 a0 = {0.f, 0.f, 0.f, 0.f}, a1 = a0, a2 = a0;
        const float* wb = wm + (size_t)l * 1024 * 6144 + cg * 64 + cq * 4;
#pragma unroll 4
        for (int i = 0; i < 32; ++i) { const int k = kg + 32 * i; const f32x4 w = *(const f32x4*)(wb + (size_t)k * 6144);
            const float x0 = c[k], x1 = c[1024 + k], x2 = cc[k];
            a0 += w * (x0 * sigm(x0)); a1 += w * (x1 * sigm(x1)); a2 += w * (x2 * sigm(x2)); }
        red[(kg * 3 + 0) * 16 + cq] = a0; red[(kg * 3 + 1) * 16 + cq] = a1; red[(kg * 3 + 2) * 16 + cq] = a2;
        __syncthreads();
        if (tid < 192) { const int r = tid >> 6, col = tid & 63; float s = 0.f; const LAS float* rf = (const LAS float*)red;
            for (int k2 = 0; k2 < 32; ++k2) s += rf[((k2 * 3 + r) * 16 + (col >> 2)) * 4 + (col & 3)];
            MOD[(l * 3 + r) * 6144 + cg * 64 + col] = s + bm[l * 6144 + cg * 64 + col]; }
        __syncthreads();
    }
}
__device__ __forceinline__ void make_tables(PH_ARGS) {
    const int gt = bid * 512 + tid, GT = G * 512;
    float* RC = WSP(float, WS_ROPEC); float* RS = WSP(float, WS_ROPES);
    bf16* T1 = WSP(bf16, WS_T1T);
    for (int i = gt; i < 2048; i += GT) { const int pos = i >> 4, f = i & 15; const float inv = powf(10000.f, -(float)f / 16.f), ang = (float)pos * inv; RC[i] = cosf(ang); RS[i] = sinf(ang); }
    for (int i = gt; i < 128 * 128; i += GT) { const int col = i >> 7, k = i & 127, ro = col >> 6, k1 = col & 63, n1 = k >> 1, ri = k & 1; float s, c; sincospif((float)((k1 * n1) & 63) / 32.f, &s, &c);
        const float v = ro == 0 ? (ri == 0 ? c : s) : (ri == 0 ? -s : c); T1[i] = (bf16)f2bf(v); }
    bf16* T2F = WSP(bf16, WS_T2F); bf16* T2C = WSP(bf16, WS_T2C);
    for (int i = gt; i < 64 * 128 * 256; i += GT) { const int k1 = i >> 15, k2 = (i >> 8) & 127, k = i & 255, n2 = k >> 1, ri = k & 1; float s, c;
        sincospif((float)((n2 * (k1 + 64 * k2)) & 8191) / 4096.f, &s, &c); T2F[i] = (bf16)f2bf(ri ? s : c); }
    for (int i = gt; i < 2 * 128 * 256; i += GT) { const int k1 = i >> 15, k2 = (i >> 8) & 127, k = i & 255, n2 = k >> 1, ri = k & 1; float s, c;
        sincospif((float)((n2 * (k1 + 2 * k2)) & 255) / 128.f, &s, &c); T2C[i] = (bf16)f2bf(ri ? s : c); }
}
__device__ __forceinline__ void tr_item(const float* W, size_t ldw, int col0, int k0, bf16* dst, int Kd, LAS float* scr, int lane) {
#pragma unroll 8
    for (int i = 0; i < 32; ++i) { const int kk = 2 * i + (lane >> 5); scr[kk * 33 + (lane & 31)] = W[(size_t)(k0 + kk) * ldw + col0 + (lane & 31)]; }
    LDS_WAIT(); asm volatile("" ::: "memory");
    const int c = lane & 7;
#pragma unroll
    for (int j = 0; j < 4; ++j) { const int n = (lane >> 3) + 8 * j; const LAS float* s = scr + (8 * c) * 33 + n;
        v4u o; o.x = pk2(s[0 * 33], s[1 * 33]); o.y = pk2(s[2 * 33], s[3 * 33]); o.z = pk2(s[4 * 33], s[5 * 33]); o.w = pk2(s[6 * 33], s[7 * 33]);
        *(v4u*)(dst + (size_t)n * Kd + k0 + 8 * c) = o; }
    LDS_WAIT(); asm volatile("" ::: "memory");
}
__device__ __forceinline__ int rho32(int c) { return 16 * ((c >> 2) & 1) + 4 * (c >> 3) + (c & 3); }
__device__ __forceinline__ void fold_item16(const float* W  , int f, bf16* WIN, LAS float* scr, const LAS f2v* tab, int lane) {
    const int kb = f >> 2, g = f & 3, k0 = kb * 16;
#pragma unroll
    for (int kk = 0; kk < 16; ++kk) scr[kk * 64 + lane] = W[(size_t)(k0 + kk) * 6144 + 512 + g * 64 + lane];
    LDS_WAIT(); asm volatile("" ::: "memory");
    float ar[16], ai[16];
#pragma unroll
    for (int kk = 0; kk < 16; ++kk) { ar[kk] = 0.f; ai[kk] = 0.f; }
#pragma unroll 4
    for (int c = 0; c < 64; ++c) { const f2v t = tab[(c * lane) & 63];
#pragma unroll
        for (int kk = 0; kk < 16; ++kk) { const float w = scr[kk * 64 + c]; ar[kk] += w * t[0]; ai[kk] -= w * t[1]; } }
    const int L0 = 2 * (g * 64 + lane);
    bf16* d0 = WIN + (size_t)(512 + (L0 & ~31) + rho32(L0 & 31)) * 1024 + k0; bf16* d1 = WIN + (size_t)(512 + (L0 & ~31) + rho32((L0 + 1) & 31)) * 1024 + k0;
    v4u o, p;
    o.x = pk2(ar[0], ar[1]); o.y = pk2(ar[2], ar[3]); o.z = pk2(ar[4], ar[5]); o.w = pk2(ar[6], ar[7]); p.x = pk2(ar[8], ar[9]); p.y = pk2(ar[10], ar[11]); p.z = pk2(ar[12], ar[13]); p.w = pk2(ar[14], ar[15]);
    *(v4u*)d0 = o; *(v4u*)(d0 + 8) = p;
    o.x = pk2(ai[0], ai[1]); o.y = pk2(ai[2], ai[3]); o.z = pk2(ai[4], ai[5]); o.w = pk2(ai[6], ai[7]); p.x = pk2(ai[8], ai[9]); p.y = pk2(ai[10], ai[11]); p.z = pk2(ai[12], ai[13]); p.w = pk2(ai[14], ai[15]);
    *(v4u*)d1 = o; *(v4u*)(d1 + 8) = p;
    LDS_WAIT(); asm volatile("" ::: "memory");
}
template <bool PERMROWS>
__device__ __forceinline__ void tr_item64(const float* W, size_t ldw, int col0, int k0, bf16* dst, int Kd, int lane) {
    const int kq = lane >> 4, n4 = lane & 15; const float* src = W + (size_t)(k0 + kq * 16) * ldw + col0 + n4 * 4;
    f32x4 v[16];
#pragma unroll
    for (int i = 0; i < 16; ++i) v[i] = *(const f32x4*)(src + (size_t)i * ldw);
#pragma unroll
    for (int j = 0; j < 4; ++j) { const int ns = n4 * 4 + j, nd = PERMROWS ? ((ns & 32) + rho32(ns & 31)) : ns; bf16* d = dst + (size_t)nd * Kd + k0 + kq * 16; v4u o, p;
        o.x = pk2(v[0][j], v[1][j]); o.y = pk2(v[2][j], v[3][j]); o.z = pk2(v[4][j], v[5][j]); o.w = pk2(v[6][j], v[7][j]);
        p.x = pk2(v[8][j], v[9][j]); p.y = pk2(v[10][j], v[11][j]); p.z = pk2(v[12][j], v[13][j]); p.w = pk2(v[14][j], v[15][j]);
        *(v4u*)d = o; *(v4u*)(d + 8) = p; }
}
__device__ __forceinline__ void convert_range(PH_ARGS, const int l, const int it_lo, const int it_hi, const int pidx, const int pcount) {
    if (pidx < 0) return;
    LAS float* scr = (LAS float*)(lds + wave * 16384);
    const int gw = pidx * 8 + wave, NGW = pcount * 8;
    bf16* WIN = WSP(bf16, WS_WIN); bf16* WBR = WSP(bf16, WS_WBR); bf16* WO = WSP(bf16, WS_WO); bf16* WGU = WSP(bf16, WS_WGU); bf16* WDN = WSP(bf16, WS_WDN); bf16* WS_ = WSP(bf16, WS_WSP);
    const float* win = INP(8) + (size_t)l * 1024 * 6144;
    LAS f2v* tab = (LAS f2v*)(scr + 2048); { float s_, c_; sincospif((float)lane / 32.f, &s_, &c_); tab[lane] = (f2v){c_, s_}; } LDS_WAIT(); asm volatile("" ::: "memory");
    constexpr int N_FOLD = 256, N_IN = 92 * 16, N_BR = 256, N_WO = 256, N_GU = 8192, N_DN = 4096, N_SP = 64;
    constexpr int NITEMS = N_FOLD + N_IN + N_BR + N_WO + N_GU + N_DN + N_SP;
    for (int it = it_lo + gw; it < it_hi && it < NITEMS; it += NGW) {
        int r = it;
        if (r < N_FOLD) { fold_item16(win, r, WIN, scr, tab, lane); continue; } r -= N_FOLD;
        if (r < N_IN) { const int dbp = r >> 4, kb = r & 15, db = dbp < 8 ? dbp : dbp + 8; int col;
            if (db < 8) col = db * 64;
            else if (db < 24) { const int t = db - 16, tile = t >> 2, sub = t & 3; col = (sub < 2 ? 768 : 1024) + tile * 128 + (sub & 1) * 64; }
            else if (db < 36) col = 1280 + (db - 24) * 64;
            else col = 2048 + (db - 36) * 64;
            if (db < 24 || (db >= 32 && db < 36)) tr_item64<true>(win, 6144, col, kb * 64, WIN + (size_t)db * 64 * 1024, 1024, lane);
            else tr_item64<false>(win, 6144, col, kb * 64, WIN + (size_t)db * 64 * 1024, 1024, lane);
            continue; } r -= N_IN;
        if (r < N_BR) { const int b = r >> 6, q = r & 63, kb = q >> 4, nb = q & 15; const int ii = b == 0 ? 13 : (b == 1 ? 14 : (b == 2 ? 19 : 21));
            tr_item64<false>(INP(ii) + (size_t)l * 256 * 1024, 1024, nb * 64, kb * 64, WBR + (size_t)(b * 1024 + nb * 64) * 256, 256, lane); continue; } r -= N_BR;
        if (r < N_WO) { const int kb = r >> 4, nb = r & 15; tr_item64<false>(INP(22) + (size_t)l * 1024 * 1024, 1024, nb * 64, kb * 64, WO + (size_t)nb * 64 * 1024, 1024, lane); continue; } r -= N_WO;
        if (r < N_GU) { const int e = r >> 9, q = r & 511, db = q >> 4, kb = q & 15, tile = db >> 2, sub = db & 3;
            const float* src = (sub < 2 ? INP(24) : INP(25)) + (size_t)(l * 16 + e) * 1024 * 1024;
            tr_item64<false>(src, 1024, tile * 128 + (sub & 1) * 64, kb * 64, WGU + ((size_t)e * 2048 + db * 64) * 1024, 1024, lane); continue; } r -= N_GU;
        if (r < N_DN) { const int e = r >> 8, q = r & 255, kb = q >> 4, nb = q & 15;
            tr_item64<false>(INP(26) + (size_t)(l * 16 + e) * 1024 * 1024, 1024, nb * 64, kb * 64, WDN + ((size_t)e * 1024 + nb * 64) * 1024, 1024, lane); continue; } r -= N_DN;
        { const float* s = INP(11) + (size_t)l * 65536 + r * 1024 + lane * 16; const f32x4 a = *(const f32x4*)s, b = *(const f32x4*)(s + 4), c = *(const f32x4*)(s + 8), d = *(const f32x4*)(s + 12);
          v4u o, p; o.x = pk2(a[0], a[1]); o.y = pk2(a[2], a[3]); o.z = pk2(b[0], b[1]); o.w = pk2(b[2], b[3]); p.x = pk2(c[0], c[1]); p.y = pk2(c[2], c[3]); p.z = pk2(d[0], d[1]); p.w = pk2(d[2], d[3]);
          *(v4u*)(WS_ + r * 1024 + lane * 16) = o; *(v4u*)(WS_ + r * 1024 + lane * 16 + 8) = p; }
    }
}
constexpr int CV_FOLD0 = 0, CV_IN0 = 256, CV_BR0 = 256 + 92 * 16, CV_WO0 = CV_BR0 + 256, CV_GU0 = CV_WO0 + 256, CV_DN0 = CV_GU0 + 8192, CV_SP0 = CV_DN0 + 4096, CV_END = CV_SP0 + 64;
__device__ __forceinline__ void convert_weights(PH_ARGS, const int l) { convert_range(lds, tid, lane, wave, bid, G, l, 0, CV_END, bid, G); }
__device__ __forceinline__ void load_row(const float* p, int lane, f32x4 (&v)[4]) {
#pragma unroll
    for (int j = 0; j < 4; ++j) v[j] = *(const f32x4*)(p + 4 * lane + 256 * j);
}
__device__ __forceinline__ void modnorm_store(f32x4 (&v)[4], const float* g, const float* sc, const float* sh, bf16* hrow, int lane) {
    float ss = 0.f;
#pragma unroll
    for (int j = 0; j < 4; ++j) ss += (v[j][0] * v[j][0] + v[j][1] * v[j][1]) + (v[j][2] * v[j][2] + v[j][3] * v[j][3]);
    const float rs = 1.0f / sqrtf(wave_sum(ss) * (1.f / 1024.f) + 1e-6f);
#pragma unroll
    for (int j = 0; j < 4; ++j) { const int o = 4 * lane + 256 * j; const f32x4 gg = *(const f32x4*)(g + o), s = *(const f32x4*)(sc + o), b = *(const f32x4*)(sh + o);
        v[j] = v[j] * rs * gg * (s + 1.f) + b; st4bf(hrow + o, v[j]); }
}
__device__ __forceinline__ void modnorm_regs(f32x4 (&v)[4], const f32x4 (&gm)[4], const f32x4 (&sh)[4], bf16* hrow, int lane) {
    float ss = 0.f;
#pragma unroll
    for (int j = 0; j < 4; ++j) ss += (v[j][0] * v[j][0] + v[j][1] * v[j][1]) + (v[j][2] * v[j][2] + v[j][3] * v[j][3]);
    const float rs = 1.0f / sqrtf(wave_sum(ss) * (1.f / 1024.f) + 1e-6f);
#pragma unroll
    for (int j = 0; j < 4; ++j) { v[j] = v[j] * rs * gm[j] + sh[j]; st4bf(hrow + 4 * lane + 256 * j, v[j]); }
}
__device__ __forceinline__ void load_mod(const float* g, const float* sc, const float* shp, int lane, f32x4 (&gm)[4], f32x4 (&sh)[4]) {
#pragma unroll
    for (int j = 0; j < 4; ++j) { const int o = 4 * lane + 256 * j; gm[j] = *(const f32x4*)(g + o) * (*(const f32x4*)(sc + o) + 1.f); sh[j] = *(const f32x4*)(shp + o); }
}
__device__ __forceinline__ void norm1_l0(PH_ARGS) {
    const int gw = bid * 8 + wave, NGW = G * 8; bf16* H = WSP(bf16, WS_H); const float* MOD = WSP(float, WS_MOD);
    const int RPW = (MT + NGW - 1) / NGW, row0 = gw * RPW, rend = (row0 + RPW < MT) ? row0 + RPW : MT;
    const float* xin = INP(0); const float* cin = INP(2); const float* g = INP(6);
    f32x4 cur[4], nxt[4], gm[4], sh[4]; int rprev = -1;
    if (row0 < rend) load_row(row0 < ML ? xin + (size_t)row0 * 1024 : cin + (size_t)(row0 - ML) * 1024, lane, cur);
    for (int row = row0; row < rend; ++row) {
        if (row + 1 < rend) { const int rn = row + 1; load_row(rn < ML ? xin + (size_t)rn * 1024 : cin + (size_t)(rn - ML) * 1024, lane, nxt); }
        const int r = row < SEQ ? 0 : (row < ML ? 1 : 2);
        if (r != rprev) { const float* md = MOD + r * 6144; load_mod(g, md + 1024, md, lane, gm, sh); rprev = r; }
        modnorm_regs(cur, gm, sh, H + (size_t)row * 1024, lane);
#pragma unroll
        for (int j = 0; j < 4; ++j) cur[j] = nxt[j];
    }
}
__device__ __forceinline__ void norm2_router(PH_ARGS, const int l, const int rbase, const int nrows, const int pidx, const int pcount, const bool load_table = true) {
    const int gw = pidx * 8 + wave, NGW = pcount * 8; bf16* H = WSP(bf16, WS_H); const float* MOD = WSP(float, WS_MOD) + l * 3 * 6144; const float* X = WSP(float, WS_X); float* AFF = WSP(float, WS_AFF);
    LAS f32x4* Wl = (LAS f32x4*)lds;
    if (load_table) { const f32x4* wr = (const f32x4*)(INP(23) + (size_t)l * 1024 * 16);
      for (int i = tid; i < 4096; i += 512) { const int k = i >> 2, q = i & 3; Wl[(q * 4 + (k & 3)) * 256 + (k >> 2)] = wr[i]; } }
    __syncthreads();
    const int RPW = (nrows + NGW - 1) / NGW, row0 = rbase + gw * RPW, rend = (gw * RPW + RPW < nrows) ? row0 + RPW : rbase + nrows;
    const float* g2 = INP(7) + l * 1024;
    f32x4 v[4], nxt[4], gm[4], sh[4]; int rprev = -1;
    if (row0 < rend) load_row(X + (size_t)row0 * 1024, lane, v);
    for (int row = row0; row < rend; ++row) {
        if (row + 1 < rend) load_row(X + (size_t)(row + 1) * 1024, lane, nxt);
        const int r = row < SEQ ? 0 : (row < ML ? 1 : 2);
        if (r != rprev) { const float* md = MOD + r * 6144; load_mod(g2, md + 4 * 1024, md + 3 * 1024, lane, gm, sh); rprev = r; }
        modnorm_regs(v, gm, sh, H + (size_t)row * 1024, lane);
        float lg[16];
#pragma unroll
        for (int e = 0; e < 16; ++e) lg[e] = 0.f;
#pragma unroll
        for (int j = 0; j < 4; ++j)
#pragma unroll
            for (int i = 0; i < 4; ++i) { const float hv = v[j][i];
#pragma unroll
                for (int q = 0; q < 4; ++q) { const f32x4 w = Wl[(q * 4 + i) * 256 + 64 * j + lane]; lg[4 * q + 0] += hv * w[0]; lg[4 * q + 1] += hv * w[1]; lg[4 * q + 2] += hv * w[2]; lg[4 * q + 3] += hv * w[3]; }
                if (i & 1) asm volatile("" ::: "memory"); }
#pragma unroll
        for (int i = 0; i < 8; ++i) { const bool up = lane & 32; const float send = up ? lg[i] : lg[i + 8], keep = up ? lg[i + 8] : lg[i]; lg[i] = keep + __shfl_xor(send, 32); }
#pragma unroll
        for (int i = 0; i < 4; ++i) { const bool up = lane & 16; const float send = up ? lg[i] : lg[i + 4], keep = up ? lg[i + 4] : lg[i]; lg[i] = keep + __shfl_xor(send, 16); }
#pragma unroll
        for (int i = 0; i < 2; ++i) { const bool up = lane & 8; const float send = up ? lg[i] : lg[i + 2], keep = up ? lg[i + 2] : lg[i]; lg[i] = keep + __shfl_xor(send, 8); }
        { const bool up = lane & 4; const float send = up ? lg[0] : lg[1], keep = up ? lg[1] : lg[0]; lg[0] = keep + __shfl_xor(send, 4); }
        float z = lg[0]; z += __shfl_xor(z, 1); z += __shfl_xor(z, 2);
        float mx = z; mx = fmaxf(mx, __shfl_xor(mx, 4)); mx = fmaxf(mx, __shfl_xor(mx, 8)); mx = fmaxf(mx, __shfl_xor(mx, 16)); mx = fmaxf(mx, __shfl_xor(mx, 32));
        const float ez = expf(z - mx); float sm = ez; sm += __shfl_xor(sm, 4); sm += __shfl_xor(sm, 8); sm += __shfl_xor(sm, 16); sm += __shfl_xor(sm, 32);
        if ((lane & 3) == 0) { const int e = ((lane >> 5) & 1) * 8 + ((lane >> 4) & 1) * 4 + ((lane >> 3) & 1) * 2 + ((lane >> 2) & 1); AFF[(size_t)row * 16 + e] = ez / sm; }
#pragma unroll
        for (int j = 0; j < 4; ++j) v[j] = nxt[j];
    }
    __syncthreads();
}
typedef short v4i16_t __attribute__((ext_vector_type(4)));
__device__ __forceinline__ void mfma16(f32x4& acc, const bf16x8 a, const bf16x8 b) { asm volatile("s_nop 1\n\tv_mfma_f32_16x16x32_bf16 %0, %1, %2, %0\n\ts_nop 3" : "+v"(acc) : "v"(a), "v"(b)); }
#define DRAIN4(x) asm volatile("s_nop 15\n\ts_nop 15" : "+v"((x)[0]), "+v"((x)[1]), "+v"((x)[2]), "+v"((x)[3]))
#define DRAIN8(x) asm volatile("s_nop 15\n\ts_nop 15" : "+v"((x)[0]), "+v"((x)[1]), "+v"((x)[2]), "+v"((x)[3]), "+v"((x)[4]), "+v"((x)[5]), "+v"((x)[6]), "+v"((x)[7]))
#define DRAIN16(x) asm volatile("s_nop 15\n\ts_nop 15" : "+v"((x)[0]), "+v"((x)[1]), "+v"((x)[2]), "+v"((x)[3]), "+v"((x)[4]), "+v"((x)[5]), "+v"((x)[6]), "+v"((x)[7]), \
    "+v"((x)[8]), "+v"((x)[9]), "+v"((x)[10]), "+v"((x)[11]), "+v"((x)[12]), "+v"((x)[13]), "+v"((x)[14]), "+v"((x)[15]))
__device__ __forceinline__ void gmlp_unit(PH_ARGS, const int l, const int chunk) {
    const int row0 = chunk < 128 ? chunk * 128 : ML + (chunk - 128) * 128;
    const bf16* AUV = WSP(bf16, WS_AUV); bf16* BRa = WSP(bf16, WS_BR); const bf16* WS_ = WSP(bf16, WS_WSP);
    LAS bf16* vT = (LAS bf16*)lds;
    const float* lg = INP(9) + l * 256; const float* lb = INP(10) + l * 256;
    const f32x4 gg = *(const f32x4*)(lg + 4 * lane), bb = *(const f32x4*)(lb + 4 * lane);
    uint2 raws[16];
#pragma unroll
    for (int pi = 0; pi < 16; ++pi) raws[pi] = *(const uint2*)(AUV + (size_t)(row0 + wave * 16 + pi) * 512 + 256 + 4 * lane);
#pragma unroll
    for (int pi = 0; pi < 16; ++pi) { const int p = wave * 16 + pi;
        const uint2 raw = raws[pi];
        float v0 = bflo(raw.x), v1 = bfhi(raw.x), v2 = bflo(raw.y), v3 = bfhi(raw.y);
        const float mean = wave_sum((v0 + v1) + (v2 + v3)) * (1.f / 256.f); v0 -= mean; v1 -= mean; v2 -= mean; v3 -= mean;
        const float rstd = 1.0f / sqrtf(wave_sum((v0 * v0 + v1 * v1) + (v2 * v2 + v3 * v3)) * (1.f / 256.f) + 1e-6f);
        vT[(4 * lane + 0) * 136 + p] = (bf16)f2bf(v0 * rstd * gg[0] + bb[0]); vT[(4 * lane + 1) * 136 + p] = (bf16)f2bf(v1 * rstd * gg[1] + bb[1]);
        vT[(4 * lane + 2) * 136 + p] = (bf16)f2bf(v2 * rstd * gg[2] + bb[2]); vT[(4 * lane + 3) * 136 + p] = (bf16)f2bf(v3 * rstd * gg[3] + bb[3]); }
    __syncthreads();
    const int g = wave >> 1, qh = wave & 1, fr = lane & 15, fq = lane >> 4;
    f32x4 acc[4][4];
#pragma unroll
    for (int a = 0; a < 4; ++a)
#pragma unroll
        for (int b = 0; b < 4; ++b) acc[a][b] = (f32x4){0.f, 0.f, 0.f, 0.f};
    const bf16* Wg = WS_ + g * 16384;
#pragma unroll
    for (int ks = 0; ks < 4; ++ks) { bf16x8 af[4], bf[4];
#pragma unroll
        for (int dt = 0; dt < 4; ++dt) af[dt] = *(const LAS bf16x8*)(vT + (g * 64 + dt * 16 + fr) * 136 + ks * 32 + fq * 8);
#pragma unroll
        for (int qt = 0; qt < 4; ++qt) bf[qt] = *(const bf16x8*)(Wg + (qh * 64 + qt * 16 + fr) * 128 + ks * 32 + fq * 8);
#pragma unroll
        for (int dt = 0; dt < 4; ++dt)
#pragma unroll
            for (int qt = 0; qt < 4; ++qt) mfma16(acc[dt][qt], af[dt], bf[qt]); }
    DRAIN16(&acc[0][0]);
    const float* bs = INP(12) + l * 512 + g * 128;
#pragma unroll
    for (int qt = 0; qt < 4; ++qt) { const int q = qh * 64 + qt * 16 + fr; const float bias = bs[q]; const size_t row = row0 + q;
#pragma unroll
        for (int dt = 0; dt < 4; ++dt) { const int ch = g * 64 + dt * 16 + 4 * fq; const uint2 uw = *(const uint2*)(AUV + row * 512 + ch);
            f32x4 o; o[0] = bflo(uw.x) * (acc[dt][qt][0] + bias); o[1] = bfhi(uw.x) * (acc[dt][qt][1] + bias); o[2] = bflo(uw.y) * (acc[dt][qt][2] + bias); o[3] = bfhi(uw.y) * (acc[dt][qt][3] + bias);
            st4bf(BRa + row * 256 + ch, o); } }
    __syncthreads();
}
__device__ __forceinline__ void conv_unit(PH_ARGS, const int l, const int unit) {
    int rowbase, n0, nlen;
    if (unit < 256) { rowbase = (unit >> 7) * SEQ; n0 = (unit & 127) * 64; nlen = SEQ; } else { const int u2 = unit - 256; rowbase = ML + (u2 >> 2) * CTXL; n0 = (u2 & 3) * 64; nlen = CTXL; }
    const bf16* CY = WSP(bf16, WS_CY); bf16* BRc = WSP(bf16, WS_BR) + (size_t)2 * MT * 256;
    LAS unsigned* yt = (LAS unsigned*)lds;
    LAS float* cres = (LAS float*)(lds + 48128);
    for (int p = tid; p < 94 * 32; p += 512) { const int rr = p >> 5, seg = p & 31, n = n0 - 15 + rr; v4u val = {0u, 0u, 0u, 0u};
        if (n >= 0 && n < nlen) val = *(const v4u*)(CY + (size_t)(rowbase + n) * 256 + seg * 8);
        *(LAS v4u*)(lds + rr * 512 + seg * 16) = val; }
    __syncthreads();
    const int cp = tid & 127, pg = tid >> 7;
    float w0[31], w1[31];
    const float* cw = INP(15) + (size_t)l * 31 * 256 + 2 * cp;
#pragma unroll
    for (int t = 0; t < 31; ++t) { const float2 w = *(const float2*)(cw + t * 256); w0[t] = w.x; w1[t] = w.y; }
    float a0[16], a1[16];
#pragma unroll
    for (int p = 0; p < 16; ++p) { a0[p] = 0.f; a1[p] = 0.f; }
#pragma unroll
    for (int i = 0; i < 46; ++i) { const unsigned raw = yt[(16 * pg + i) * 128 + cp]; const float v0 = bflo(raw), v1 = bfhi(raw);
#pragma unroll
        for (int p = 0; p < 16; ++p) { const int t = i - p; if (t >= 0 && t < 31) { a0[p] += v0 * w0[t]; a1[p] += v1 * w1[t]; } } }
    const float2 cb = *(const float2*)(INP(16) + l * 256 + 2 * cp);
#pragma unroll
    for (int p = 0; p < 16; ++p) *(LAS f2v*)(cres + (16 * pg + p) * 256 + 2 * cp) = (f2v){a0[p] + cb.x, a1[p] + cb.y};
    __syncthreads();
    const f32x4 gg = *(const f32x4*)(INP(17) + l * 256 + 4 * lane), bb = *(const f32x4*)(INP(18) + l * 256 + 4 * lane);
    for (int pi = 0; pi < 8; ++pi) { const int pos = wave * 8 + pi; f32x4 v = *(const LAS f32x4*)(cres + pos * 256 + 4 * lane);
        const float mean = wave_sum((v[0] + v[1]) + (v[2] + v[3])) * (1.f / 256.f); v = v - mean;
        const float rstd = 1.0f / sqrtf(wave_sum((v[0] * v[0] + v[1] * v[1]) + (v[2] * v[2] + v[3] * v[3])) * (1.f / 256.f) + 1e-6f);
        f32x4 o;
#pragma unroll
        for (int j = 0; j < 4; ++j) { const float y = v[j] * rstd * gg[j] + bb[j]; o[j] = y * sigm(y); }
        st4bf(BRc + (size_t)(rowbase + n0 + pos) * 256 + 4 * lane, o); }
    __syncthreads();
}
constexpr int F1_T1L = 0, F1_YL = 34816;
__device__ __forceinline__ void f1_stage_tables(PH_ARGS) {
    const bf16* T1 = WSP(bf16, WS_T1T);
    for (int p = tid; p < 128 * 16; p += 512) { const int r = p >> 4, s = p & 15; *(LAS v4u*)(lds + F1_T1L + r * 272 + s * 16) = *(const v4u*)(T1 + r * 128 + s * 8); }
    __syncthreads();
}
__device__ __forceinline__ void f1_unit(PH_ARGS, const int unit) {
    const int b = unit >> 7, n2 = unit & 127, fr = lane & 15, fq = lane >> 4;
    const bf16* YF = WSP(bf16, WS_YF); bf16* FA = WSP(bf16, WS_FA);
    LAS unsigned* Yl = (LAS unsigned*)(lds + F1_YL);
#pragma unroll
    for (int i = 0; i < 8; ++i) { const int n1 = wave + 8 * i; *(LAS v4u*)(Yl + n1 * 260 + lane * 4) = *(const v4u*)(YF + (size_t)(b * SEQ + 128 * n1 + n2) * 512 + lane * 8); }
    __syncthreads();
    f32x4 acc[2][8];
#pragma unroll
    for (int a = 0; a < 2; ++a)
#pragma unroll
        for (int n = 0; n < 8; ++n) acc[a][n] = (f32x4){0.f, 0.f, 0.f, 0.f};
#pragma unroll
    for (int ks = 0; ks < 4; ++ks) { bf16x8 af[2];
#pragma unroll
        for (int c2 = 0; c2 < 2; ++c2) { const int ch = (2 * wave + c2) * 16 + fr; v4u w;
            w.x = Yl[(16 * ks + 4 * fq + 0) * 260 + ch]; w.y = Yl[(16 * ks + 4 * fq + 1) * 260 + ch]; w.z = Yl[(16 * ks + 4 * fq + 2) * 260 + ch]; w.w = Yl[(16 * ks + 4 * fq + 3) * 260 + ch];
            af[c2] = __builtin_bit_cast(bf16x8, w); }
#pragma unroll
        for (int nt = 0; nt < 8; ++nt) { const bf16x8 bfr = *(const LAS bf16x8*)(lds + F1_T1L + (nt * 16 + fr) * 272 + ks * 64 + fq * 16);
            mfma16(acc[0][nt], af[0], bfr); mfma16(acc[1][nt], af[1], bfr); } }
    DRAIN16(&acc[0][0]);
#pragma unroll
    for (int c2 = 0; c2 < 2; ++c2)
#pragma unroll
        for (int kt = 0; kt < 4; ++kt) { const int k1 = kt * 16 + fr; const f32x4 ar = acc[c2][kt], ai = acc[c2][kt + 4];
            v4u o; o.x = pk2(ar[0], ai[0]); o.y = pk2(ar[1], ai[1]); o.z = pk2(ar[2], ai[2]); o.w = pk2(ar[3], ai[3]);
            *(v4u*)(FA + ((size_t)((b * 64 + k1) * 128 + n2) * 256 + (2 * wave + c2) * 16 + 4 * fq) * 2) = o; }
    __syncthreads();
}
constexpr int F2_T2L = 0, F2_AL = 67584;
__device__ __forceinline__ void f2_unit(PH_ARGS, const int unit) {
    const int fr = lane & 15, fq = lane >> 4; const bool lat = unit < 256;
    int b, k1, chh; const bf16* Asrc; const bf16* Tsrc; size_t orow0; int ostr; float scl;
    if (lat) { b = unit >> 7; k1 = (unit >> 1) & 63; chh = unit & 1; Asrc = WSP(bf16, WS_FA) + (size_t)((b * 64 + k1) * 128) * 512; Tsrc = WSP(bf16, WS_T2F) + (size_t)k1 * 32768; orow0 = (size_t)b * SEQ + k1; ostr = 64; scl = 0.0013810679320049757f; }
    else { const int u2 = unit - 256; b = u2 >> 2; k1 = (u2 >> 1) & 1; chh = u2 & 1; Asrc = WSP(bf16, WS_FAC) + (size_t)((b * 2 + k1) * 128) * 512; Tsrc = WSP(bf16, WS_T2C) + (size_t)k1 * 32768; orow0 = (size_t)ML + b * CTXL + k1; ostr = 2; scl = 1.f / 128.f; }
    bf16* BRb = WSP(bf16, WS_BR) + (size_t)1 * MT * 256;
    LAS unsigned* Al = (LAS unsigned*)(lds + F2_AL);
    for (int p = tid; p < 128 * 32; p += 512) { const int r = p >> 5, s = p & 31; *(LAS v4u*)(lds + F2_T2L + r * 528 + s * 16) = *(const v4u*)(Tsrc + r * 256 + s * 8); }
#pragma unroll
    for (int i = 0; i < 8; ++i) { const int n2 = wave * 16 + 2 * i + (lane >> 5);
        *(LAS v4u*)(Al + n2 * 132 + (lane & 31) * 4) = *(const v4u*)(Asrc + ((size_t)n2 * 256 + chh * 128) * 2 + (lane & 31) * 8); }
    __syncthreads();
    f32x4 acc[8];
#pragma unroll
    for (int n = 0; n < 8; ++n) acc[n] = (f32x4){0.f, 0.f, 0.f, 0.f};
    const int ch = wave * 16 + fr;
#pragma unroll
    for (int ks = 0; ks < 8; ++ks) { v4u w;
        w.x = Al[(16 * ks + 4 * fq + 0) * 132 + ch]; w.y = Al[(16 * ks + 4 * fq + 1) * 132 + ch]; w.z = Al[(16 * ks + 4 * fq + 2) * 132 + ch]; w.w = Al[(16 * ks + 4 * fq + 3) * 132 + ch];
        const bf16x8 af = __builtin_bit_cast(bf16x8, w);
#pragma unroll
        for (int nt = 0; nt < 8; ++nt) { const bf16x8 bfr = *(const LAS bf16x8*)(lds + F2_T2L + (nt * 16 + fr) * 528 + ks * 64 + fq * 16); mfma16(acc[nt], af, bfr); } }
    DRAIN8(acc);
#pragma unroll
    for (int nt = 0; nt < 8; ++nt) { const int k2 = nt * 16 + fr; st4bf(BRb + (orow0 + (size_t)ostr * k2) * 256 + chh * 128 + wave * 16 + 4 * fq, acc[nt] * scl); }
    __syncthreads();
}
__device__ __forceinline__ void ctx_butterfly(PH_ARGS) {
    const unsigned* YF = (const unsigned*)WSP(bf16, WS_YF); unsigned* FAC = (unsigned*)WSP(bf16, WS_FAC);
    for (int i = bid * 512 + tid; i < 2 * 128 * 256; i += G * 512) { const int b = i >> 15, n2 = (i >> 8) & 127, ch = i & 255;
        const unsigned y0 = YF[(size_t)(ML + b * CTXL + n2) * 256 + ch], y1 = YF[(size_t)(ML + b * CTXL + 128 + n2) * 256 + ch];
        const float r0 = bflo(y0), i0 = bfhi(y0), r1 = bflo(y1), i1 = bfhi(y1);
        FAC[(size_t)((b * 2 + 0) * 128 + n2) * 256 + ch] = pk2(r0 + r1, i0 + i1); FAC[(size_t)((b * 2 + 1) * 128 + n2) * 256 + ch] = pk2(r0 - r1, i0 - i1); }
}
constexpr int MG_AL = 0, MG_BL = 67584;
__device__ __forceinline__ void merge_phase(PH_ARGS, const int nunits) {
    const int fr = lane & 15, fq = lane >> 4, wr = wave >> 2, wc = wave & 3;
    const bf16* BR = WSP(bf16, WS_BR); const bf16* WBR = WSP(bf16, WS_WBR); const bf16* GT = WSP(bf16, WS_G); bf16* MB = WSP(bf16, WS_MB);
    int nmine = 0; for (int u = bid; u < nunits; u += G) ++nmine;
    const int nsteps = nmine * 4;
    if (nsteps == 0) return;
    v4u pa[8], pb[8];
#define MG_LOAD(s) do { const int u_ = bid + ((s) >> 2) * G, b_ = (s) & 3, rt_ = u_ >> 3, ct_ = u_ & 7; \
        const bf16* As = BR + ((size_t)b_ * MT + (size_t)rt_ * 128) * 256; const bf16* Bs = WBR + ((size_t)b_ * 1024 + (size_t)ct_ * 128) * 256; \
        _Pragma("unroll") for (int i = 0; i < 8; ++i) { const int p = i * 512 + tid, r = p >> 5, seg = p & 31; pa[i] = *(const v4u*)(As + (size_t)r * 256 + seg * 8); pb[i] = *(const v4u*)(Bs + (size_t)r * 256 + seg * 8); } } while (0)
#define MG_WRITE() do { _Pragma("unroll") for (int i = 0; i < 8; ++i) { const int p = i * 512 + tid, r = p >> 5, seg = p & 31; \
        *(LAS v4u*)(lds + MG_AL + r * 528 + seg * 16) = pa[i]; *(LAS v4u*)(lds + MG_BL + r * 528 + seg * 16) = pb[i]; } } while (0)
    MG_LOAD(0); MG_WRITE();
    f32x4 macc[4][2];
#pragma unroll
    for (int a = 0; a < 4; ++a)
#pragma unroll
        for (int n = 0; n < 2; ++n) macc[a][n] = (f32x4){0.f, 0.f, 0.f, 0.f};
#pragma unroll 1
    for (int s = 0; s < nsteps; ++s) {
        const int u = bid + (s >> 2) * G, b = s & 3, rt = u >> 3, ct = u & 7;
        __syncthreads();
        if (s + 1 < nsteps) MG_LOAD(s + 1);
        uint2 gw[4][2];
#pragma unroll
        for (int mt = 0; mt < 4; ++mt)
#pragma unroll
            for (int nt = 0; nt < 2; ++nt) gw[mt][nt] = *(const uint2*)(GT + ((((size_t)(u * 4 + b) * 8 + wave) * 8 + mt * 2 + nt) * 256 + lane * 4));
        f32x4 acc[4][2];
#pragma unroll
        for (int a = 0; a < 4; ++a)
#pragma unroll
            for (int n = 0; n < 2; ++n) acc[a][n] = (f32x4){0.f, 0.f, 0.f, 0.f};
#pragma unroll
        for (int ks = 0; ks < 8; ++ks) { bf16x8 af[4], bfr[2];
#pragma unroll
            for (int mt = 0; mt < 4; ++mt) af[mt] = *(const LAS bf16x8*)(lds + MG_AL + (wr * 64 + mt * 16 + fr) * 528 + ks * 64 + fq * 16);
#pragma unroll
            for (int nt = 0; nt < 2; ++nt) bfr[nt] = *(const LAS bf16x8*)(lds + MG_BL + (wc * 32 + nt * 16 + fr) * 528 + ks * 64 + fq * 16);
#pragma unroll
            for (int mt = 0; mt < 4; ++mt)
#pragma unroll
                for (int nt = 0; nt < 2; ++nt) mfma16(acc[mt][nt], bfr[nt], af[mt]); }
        DRAIN8(&acc[0][0]);
#pragma unroll
        for (int mt = 0; mt < 4; ++mt)
#pragma unroll
            for (int nt = 0; nt < 2; ++nt) { const uint2 g = gw[mt][nt]; macc[mt][nt][0] += bflo(g.x) * acc[mt][nt][0]; macc[mt][nt][1] += bfhi(g.x) * acc[mt][nt][1]; macc[mt][nt][2] += bflo(g.y) * acc[mt][nt][2]; macc[mt][nt][3] += bfhi(g.y) * acc[mt][nt][3]; }
        __syncthreads();
        if (s + 1 < nsteps) MG_WRITE();
        if (b == 3) {
#pragma unroll
            for (int mt = 0; mt < 4; ++mt)
#pragma unroll
                for (int nt = 0; nt < 2; ++nt) { st4bf(MB + (size_t)(rt * 128 + wr * 64 + mt * 16 + fr) * 1024 + ct * 128 + wc * 32 + nt * 16 + 4 * fq, macc[mt][nt]); macc[mt][nt] = (f32x4){0.f, 0.f, 0.f, 0.f}; }
        }
    }
    __syncthreads();
#undef MG_LOAD
#undef MG_WRITE
}
constexpr int AT_RPB = 32768, AT_MRG = 40960;
__device__ __forceinline__ int clampi(int v, int lo, int hi) { return v < lo ? lo : (v > hi ? hi : v); }
__device__ __forceinline__ bool at_need(int kind, int jb, int t) { return kind == 2 || (kind == 0 ? (jb < 2 || (jb == 2 && t == 1)) : (jb > 1 || (jb == 1 && t == 0))); }
struct AtCtx { const bf16* QPL; const bf16* KR; const bf16* VV; LAS unsigned char* vbuf; const LAS float* rpbl; int h, qh, fr, fq, lane, b, r, kr0, qrow0, nch, nwin; bool lat; unsigned code[2][2][2]; };
__device__ __forceinline__ unsigned at_keyrow(const AtCtx& X, int ci) { return (ci < X.nwin) ? ((unsigned)X.b * SEQ + (unsigned)(X.kr0 + (ci >> 1)) * 64 + 32 * (ci & 1)) : ((unsigned)ML + X.b * CTXL + 32 * (ci - X.nwin)); }
__device__ __forceinline__ void at_load(const AtCtx& X, int ci, bf16x8 (&kf)[2][2], v4u (&vst)[4]) {
    const unsigned kr = at_keyrow(X, ci);
#pragma unroll
    for (int t = 0; t < 2; ++t)
#pragma unroll
        for (int ks = 0; ks < 2; ++ks) kf[t][ks] = *(const bf16x8*)(X.KR + (unsigned)((kr + 16 * t + X.fr) * 256 + X.h * 64 + ks * 32 + X.fq * 8));
#pragma unroll
    for (int i = 0; i < 4; ++i) { const int p = i * 64 + X.lane, key = p >> 3, seg = p & 7; vst[i] = *(const v4u*)(X.VV + (unsigned)((kr + key) * 256 + X.h * 64 + seg * 8)); }
}
__device__ __forceinline__ void at_chunk(const AtCtx& X, const int ci, bf16x8 (&kf)[2][2], v4u (&vst)[4], bf16x8 (&qf)[2][2], f32x4 (&O)[2][4], float (&m)[2], float (&l)[2]) {
    const int kind = ci < X.nwin ? (ci & 1) : 2, fr = X.fr, fq = X.fq, qh = X.qh;
    if (X.lat && ci == 16) {
#pragma unroll
        for (int j = 0; j < 2; ++j)
#pragma unroll
            for (int ks = 0; ks < 2; ++ks) qf[j][ks] = *(const bf16x8*)(X.QPL + (unsigned)((X.qrow0 + 16 * (2 * qh + j) + fr) * 256 + X.h * 64 + ks * 32 + fq * 8));
        asm volatile("" : "+v"(qf[0][0]), "+v"(qf[0][1]), "+v"(qf[1][0]), "+v"(qf[1][1])); }
#pragma unroll
    for (int i = 0; i < 4; ++i) { const int p = i * 64 + X.lane, key = p >> 3, seg = p & 7; *(LAS v4u*)(X.vbuf + key * 128 + ((((seg >> 1) ^ ((key >> 1) & 3))) << 5) + ((seg & 1) << 4)) = vst[i]; }
    f32x4 S[2][2];
#pragma unroll
    for (int j = 0; j < 2; ++j)
#pragma unroll
        for (int t = 0; t < 2; ++t) { S[j][t] = (f32x4){0.f, 0.f, 0.f, 0.f}; mfma16(S[j][t], kf[t][0], qf[j][0]); mfma16(S[j][t], kf[t][1], qf[j][1]); }
    asm volatile("s_nop 15\n\ts_nop 15" : "+v"(S[0][0]), "+v"(S[0][1]), "+v"(S[1][0]), "+v"(S[1][1]));
#ifdef ATT_X1
    if (ci + 3 < X.nch) { at_load(X, ci + 3, kf, vst); asm volatile("" : "+v"(kf[0][0]), "+v"(kf[0][1]), "+v"(kf[1][0]), "+v"(kf[1][1]), "+v"(vst[0]), "+v"(vst[1]), "+v"(vst[2]), "+v"(vst[3])); }
#endif
    if (ci + 3 < X.nch) at_load(X, ci + 3, kf, vst);
    const LAS float* rpbrow = X.rpbl + (kind != 2 ? (X.kr0 + (ci >> 1) - X.r + 7) * 31 : 0);
    if (kind != 2) {
        float bv[2][2][4]; unsigned cw[2][2];
#pragma unroll
        for (int j = 0; j < 2; ++j)
#pragma unroll
            for (int t = 0; t < 2; ++t) { cw[j][t] = kind == 0 ? X.code[0][j][t] : X.code[1][j][t];
#pragma unroll
                for (int rg = 0; rg < 4; ++rg) bv[j][t][rg] = rpbrow[(cw[j][t] >> (8 * rg)) & 31u]; }
#pragma unroll
        for (int j = 0; j < 2; ++j)
#pragma unroll
            for (int t = 0; t < 2; ++t)
#pragma unroll
                for (int rg = 0; rg < 4; ++rg) S[j][t][rg] = ((cw[j][t] >> (8 * rg)) & 255u) < 32u ? S[j][t][rg] + bv[j][t][rg] : -1.0e30f;
    }
    bf16x8 pf[2];
#pragma unroll
    for (int j = 0; j < 2; ++j) {
        float mc = -3.0e38f;
#pragma unroll
        for (int t = 0; t < 2; ++t)
#pragma unroll
            for (int rg = 0; rg < 4; ++rg) { float s = S[j][t][rg];

                S[j][t][rg] = s; mc = fmaxf(mc, s); }
        { auto r16 = __builtin_amdgcn_permlane16_swap(__float_as_uint(mc), __float_as_uint(mc), false, false); mc = fmaxf(__uint_as_float(r16[0]), __uint_as_float(r16[1]));
          auto r32 = __builtin_amdgcn_permlane32_swap(__float_as_uint(mc), __float_as_uint(mc), false, false); mc = fmaxf(__uint_as_float(r32[0]), __uint_as_float(r32[1])); }
        const float mnew = fmaxf(m[j], mc), alpha = __expf(m[j] - mnew); m[j] = mnew; float ls = 0.f;
#pragma unroll
        for (int t = 0; t < 2; ++t)
#pragma unroll
            for (int rg = 0; rg < 4; ++rg) { const float sv = S[j][t][rg]; const float p = sv > -1.0e29f ? __expf(sv - mnew) : 0.f; S[j][t][rg] = p; ls += p; }
        l[j] = l[j] * alpha + ls;
        if (__any(alpha != 1.f)) {
#pragma unroll
            for (int dt = 0; dt < 4; ++dt) O[j][dt] = O[j][dt] * alpha; }
        v4u pw; pw.x = pk2(S[j][0][0], S[j][0][1]); pw.y = pk2(S[j][0][2], S[j][0][3]); pw.z = pk2(S[j][1][0], S[j][1][1]); pw.w = pk2(S[j][1][2], S[j][1][3]);
        pf[j] = __builtin_bit_cast(bf16x8, pw); }
#pragma unroll
    for (int dt = 0; dt < 4; ++dt) { v4i16_t t0, t1;
        { const int key = 4 * fq + (fr >> 2); t0 = __builtin_amdgcn_ds_read_tr16_b64_v4i16((LAS v4i16_t*)(X.vbuf + key * 128 + ((dt ^ ((key >> 1) & 3)) << 5) + (fr & 3) * 8)); }
        { const int key = 16 + 4 * fq + (fr >> 2); t1 = __builtin_amdgcn_ds_read_tr16_b64_v4i16((LAS v4i16_t*)(X.vbuf + key * 128 + ((dt ^ ((key >> 1) & 3)) << 5) + (fr & 3) * 8)); }
        const bf16x8 vf = (bf16x8){t0[0], t0[1], t0[2], t0[3], t1[0], t1[1], t1[2], t1[3]};
        mfma16(O[0][dt], vf, pf[0]); mfma16(O[1][dt], vf, pf[1]); }
    asm volatile("s_nop 15\n\ts_nop 7" : "+v"(O[0][0]), "+v"(O[0][1]), "+v"(O[0][2]), "+v"(O[0][3]), "+v"(O[1][0]), "+v"(O[1][1]), "+v"(O[1][2]), "+v"(O[1][3]));
}
__device__ __forceinline__ void attn_unit(PH_ARGS, const int unit) {
    AtCtx X; X.h = wave >> 1; X.qh = wave & 1; X.fr = lane & 15; X.fq = lane >> 4; X.lane = lane;
    X.lat = unit < 256; X.r = 0; X.kr0 = 0;
    if (X.lat) { X.b = unit >> 7; X.r = unit & 127; X.qrow0 = X.b * SEQ + X.r * 64; X.kr0 = clampi(X.r - 4, 0, 120); }
    else { const int u2 = unit - 256; X.b = u2 >> 2; X.qrow0 = ML + X.b * CTXL + (u2 & 3) * 64; }
    X.QPL = WSP(bf16, WS_QPL); const bf16* QROT = WSP(bf16, WS_QROT); X.KR = WSP(bf16, WS_KR); X.VV = WSP(bf16, WS_VV);
    bf16* BRd = WSP(bf16, WS_BR) + (size_t)3 * MT * 256;
    X.vbuf = lds + wave * 4096; X.rpbl = (const LAS float*)(lds + AT_RPB) + X.h * 465;
    X.nch = X.lat ? 24 : 8; X.nwin = X.lat ? 16 : 0;
#pragma unroll
    for (int kd = 0; kd < 2; ++kd)
#pragma unroll
        for (int j = 0; j < 2; ++j)
#pragma unroll
            for (int t = 0; t < 2; ++t) { unsigned cw = 0u; const int jb = 2 * X.qh + j;
#pragma unroll
                for (int rg = 0; rg < 4; ++rg) { const int kcol = 32 * kd + 16 * t + 4 * X.fq + rg, qcol = 16 * jb + X.fr, cst = clampi(qcol - 8, 0, 48); const bool ok = at_need(kd, jb, t) && kcol >= cst && kcol < cst + 16;
                    cw |= (ok ? (unsigned)(clampi(kcol - qcol, -15, 15) + 15) : 255u) << (8 * rg); }
                X.code[kd][j][t] = cw; }
    float m[2], l[2]; f32x4 O[2][4];
#pragma unroll
    for (int j = 0; j < 2; ++j) { m[j] = -3.0e38f; l[j] = 0.f;
#pragma unroll
        for (int dt = 0; dt < 4; ++dt) O[j][dt] = (f32x4){0.f, 0.f, 0.f, 0.f}; }
    bf16x8 qf[2][2];
    { const bf16* Qs = X.lat ? QROT : X.QPL;
#pragma unroll
      for (int j = 0; j < 2; ++j)
#pragma unroll
          for (int ks = 0; ks < 2; ++ks) qf[j][ks] = *(const bf16x8*)(Qs + (unsigned)((X.qrow0 + 16 * (2 * X.qh + j) + X.fr) * 256 + X.h * 64 + ks * 32 + X.fq * 8));
      asm volatile("" : "+v"(qf[0][0]), "+v"(qf[0][1]), "+v"(qf[1][0]), "+v"(qf[1][1])); }
    bf16x8 kA[2][2], kB[2][2], kC[2][2]; v4u vA[4], vB[4], vC[4];
    at_load(X, 0, kA, vA); at_load(X, 1, kB, vB); at_load(X, 2, kC, vC);
#pragma unroll 1
    for (int ci = 0; ci < X.nch; ci += 3) {
        at_chunk(X, ci, kA, vA, qf, O, m, l);
        if (ci + 1 < X.nch) at_chunk(X, ci + 1, kB, vB, qf, O, m, l);
        if (ci + 2 < X.nch) at_chunk(X, ci + 2, kC, vC, qf, O, m, l);
    }
#pragma unroll
    for (int j = 0; j < 2; ++j) { l[j] += __shfl_xor(l[j], 16); l[j] += __shfl_xor(l[j], 32); const float inv = 1.f / l[j];
#pragma unroll
        for (int dt = 0; dt < 4; ++dt) st4bf(BRd + (unsigned)((X.qrow0 + 16 * (2 * X.qh + j) + X.fr) * 256 + X.h * 64 + dt * 16 + 4 * X.fq), O[j][dt] * inv); }
}
#ifndef CDFT_REP
#define CDFT_REP 1
#endif
#ifndef CONV_REP
#define CONV_REP 1
#endif
#ifndef GMLP_REP
#define GMLP_REP 1
#endif
#ifndef F1_REP
#define F1_REP 1
#endif
__device__ __forceinline__ int block_excl_scan(int v, LAS int* ws8, int lane, int wave) {
    int x = v;
#pragma unroll
    for (int o = 1; o < 64; o <<= 1) { const int y = __shfl_up(x, o); if (lane >= o) x += y; }
    if (lane == 63) ws8[wave] = x;
    __syncthreads();
    int base = 0;
#pragma unroll
    for (int w = 0; w < 8; ++w) base += (w < wave) ? ws8[w] : 0;
    __syncthreads();
    return base + x - v;
}
__device__ __forceinline__ unsigned akey(float a) { const float s = a * 4294967296.f; return s >= 4294967040.f ? 0xFFFFFF00u : (unsigned)s; }
__device__ __forceinline__ float akey_inv(unsigned k) { return (float)k * (1.f / 4294967296.f); }
template <int PER, bool ALLV>
__device__ __forceinline__ void topk_unit(PH_ARGS, const int rowbase, const int n, const int C, const int e, const int sbase, const bool writepad) {
    const float* AFF = WSP(float, WS_AFF); int* SEL = WSP(int, WS_SEL); int* IDX = WSP(int, WS_IDX); float* GATE = WSP(float, WS_GATE);
    LAS unsigned* hist = (LAS unsigned*)lds; LAS unsigned* sh = hist + 256; LAS int* ws8 = (LAS int*)(hist + 272); LAS unsigned* hw = hist + 512 + wave * 256;
    unsigned key[PER]; bool valid[PER];
#pragma unroll
    for (int i = 0; i < PER; ++i) { const int tok = tid * PER + i; valid[i] = ALLV ? true : (tok < n); key[i] = valid[i] ? akey(AFF[(size_t)(rowbase + tok) * 16 + e]) : 0u; }
    unsigned prefix = 0u, mask = 0u, rem = (unsigned)C;
#pragma unroll 1
    for (int pass = 0; pass < 4; ++pass) { const int shift = 24 - 8 * pass;
        for (int i = lane; i < 256; i += 64) hw[i] = 0u;
        LDS_WAIT();
#pragma unroll
        for (int i = 0; i < PER; ++i) if (valid[i] && (key[i] & mask) == prefix) atomicAdd((unsigned*)&hw[(key[i] >> shift) & 255u], 1u);
        __syncthreads();
        if (tid < 256) { unsigned s_ = 0u;
#pragma unroll
            for (int w = 0; w < 8; ++w) s_ += hist[512 + w * 256 + tid];
            hist[tid] = s_; }
        __syncthreads();
        if (wave == 0) { unsigned c0 = hist[255 - 4 * lane], c1 = hist[254 - 4 * lane], c2 = hist[253 - 4 * lane], c3 = hist[252 - 4 * lane];
            const unsigned s = c0 + c1 + c2 + c3; unsigned x = s;
#pragma unroll
            for (int o = 1; o < 64; o <<= 1) { const unsigned y = __shfl_up(x, o); if (lane >= o) x += y; }
            const unsigned excl = x - s;
            if (excl < rem && rem <= x) { unsigned cum = excl; int bin; unsigned nr;
                if (cum + c0 >= rem) { bin = 255 - 4 * lane; nr = rem - cum; }
                else { cum += c0; if (cum + c1 >= rem) { bin = 254 - 4 * lane; nr = rem - cum; }
                else { cum += c1; if (cum + c2 >= rem) { bin = 253 - 4 * lane; nr = rem - cum; }
                else { cum += c2; bin = 252 - 4 * lane; nr = rem - cum; } } }
                sh[0] = (unsigned)bin; sh[1] = nr; } }
        __syncthreads();
        prefix |= sh[0] << shift; mask |= 255u << shift; rem = sh[1];
    }
    __syncthreads();
    const unsigned T = prefix;
    int neq = 0;
#pragma unroll
    for (int i = 0; i < PER; ++i) neq += (valid[i] && key[i] == T) ? 1 : 0;
    const int eqbase = block_excl_scan(neq, ws8, lane, wave);
    unsigned take = 0u; int nsel = 0, eqs = 0;
#pragma unroll
    for (int i = 0; i < PER; ++i) { const bool iseq = valid[i] && key[i] == T; const bool tk = valid[i] && (key[i] > T || (iseq && (unsigned)(eqbase + eqs) < rem)); eqs += iseq ? 1 : 0; if (tk) { take |= 1u << i; ++nsel; } }
    const int sb = block_excl_scan(nsel, ws8, lane, wave);
    int cnt = 0;
#pragma unroll
    for (int i = 0; i < PER; ++i) { const int tok = tid * PER + i;
        if (valid[i]) { if ((take >> i) & 1u) { const int slot = sbase + sb + cnt; ++cnt; IDX[e * ESTR + slot] = rowbase + tok; GATE[e * ESTR + slot] = akey_inv(key[i]); SEL[(size_t)(rowbase + tok) * 16 + e] = slot; }
                        else SEL[(size_t)(rowbase + tok) * 16 + e] = -1; } }
    if (writepad) for (int i = tid; i < ESTR - 2112; i += 512) { IDX[e * ESTR + 2112 + i] = 0; GATE[e * ESTR + 2112 + i] = 0.f; }
    __syncthreads();
}
__device__ __forceinline__ void gather_rows(PH_ARGS, const int tpe) {
    const int gw = bid * 8 + wave, NGW = G * 8, per = tpe * 256; const int* IDX = WSP(int, WS_IDX); const bf16* H = WSP(bf16, WS_H); bf16* XE = WSP(bf16, WS_XE);
    for (int i = gw; i < NE * per; i += NGW) { const int e = i / per, s = i % per, rg = e * ESTR + s; const int src = IDX[rg];
        const v4u a = *(const v4u*)(H + (size_t)src * 1024 + lane * 8), b = *(const v4u*)(H + (size_t)src * 1024 + 512 + lane * 8);
        *(v4u*)(XE + (size_t)rg * 1024 + lane * 8) = a; *(v4u*)(XE + (size_t)rg * 1024 + 512 + lane * 8) = b; }
}
struct CRow { v4u yw[4][2]; f32x4 xin[2][2]; float wgt[4]; unsigned long long bm; int cur; };
struct CCtx { const int* SEL; const bf16* YB; const float* X; bf16* H; const float* MOD; float* XO; float* OUT; const float* gnext; int l, lane; };
__device__ __forceinline__ void cr_issue(const CCtx& C, CRow& R, const int row) {
    const int lane = C.lane;
    R.cur = lane < 16 ? C.SEL[(size_t)row * 16 + lane] : -1;
    R.bm = __ballot(R.cur >= 0); const int cnt = __popcll(R.bm);
#pragma unroll
    for (int k = 0; k < 4; ++k) { const bool has = cnt > k; const int e = has ? (int)__builtin_ctzll(R.bm) : 0; if (has) R.bm &= R.bm - 1; const int s = __shfl(R.cur, e); R.wgt[k] = has ? 1.f : 0.f;
        const bf16* y = C.YB + (size_t)(has ? e * ESTR + s : 0) * 1024 + lane * 8; R.yw[k][0] = *(const v4u*)y; R.yw[k][1] = *(const v4u*)(y + 512); }
    const float* xr = C.X + (size_t)row * 1024;
#pragma unroll
    for (int j = 0; j < 2; ++j) { const int o = 8 * lane + 512 * j; R.xin[j][0] = *(const f32x4*)(xr + o); R.xin[j][1] = *(const f32x4*)(xr + o + 4); }
}
__device__ __forceinline__ void cr_finish(const CCtx& C, CRow& R, const int row) {
    const int lane = C.lane, l = C.l; const int r = row < SEQ ? 0 : (row < ML ? 1 : 2);
    float acc[2][8];
#pragma unroll
    for (int j = 0; j < 2; ++j)
#pragma unroll
        for (int i = 0; i < 8; ++i) acc[j][i] = 0.f;
#pragma unroll
    for (int k = 0; k < 4; ++k)
#pragma unroll
        for (int j = 0; j < 2; ++j) { const v4u w = R.yw[k][j]; const float g = R.wgt[k];
            acc[j][0] += g * bflo(w.x); acc[j][1] += g * bfhi(w.x); acc[j][2] += g * bflo(w.y); acc[j][3] += g * bfhi(w.y); acc[j][4] += g * bflo(w.z); acc[j][5] += g * bfhi(w.z); acc[j][6] += g * bflo(w.w); acc[j][7] += g * bfhi(w.w); }
    while (R.bm) { const int e = (int)__builtin_ctzll(R.bm); R.bm &= R.bm - 1; const int s = __shfl(R.cur, e); const bf16* y = C.YB + (size_t)(e * ESTR + s) * 1024 + lane * 8;
#pragma unroll
        for (int j = 0; j < 2; ++j) { const v4u w = *(const v4u*)(y + 512 * j);
            acc[j][0] += bflo(w.x); acc[j][1] += bfhi(w.x); acc[j][2] += bflo(w.y); acc[j][3] += bfhi(w.y); acc[j][4] += bflo(w.z); acc[j][5] += bfhi(w.z); acc[j][6] += bflo(w.w); acc[j][7] += bfhi(w.w); } }
    const float* gt2 = C.MOD + (l * 3 + r) * 6144 + 5 * 1024;
    float xv[2][8]; float ss = 0.f;
#pragma unroll
    for (int j = 0; j < 2; ++j) { const int o = 8 * lane + 512 * j; const f32x4 g0 = *(const f32x4*)(gt2 + o), g1 = *(const f32x4*)(gt2 + o + 4);
#pragma unroll
        for (int i = 0; i < 4; ++i) { xv[j][i] = R.xin[j][0][i] + g0[i] * acc[j][i]; xv[j][4 + i] = R.xin[j][1][i] + g1[i] * acc[j][4 + i]; }
#pragma unroll
        for (int i = 0; i < 8; ++i) ss += xv[j][i] * xv[j][i]; }
    const float rs = 1.0f / sqrtf(wave_sum(ss) * (1.f / 1024.f) + 1e-6f);
    if (l == 0) {
        const float* md = C.MOD + (1 * 3 + r) * 6144; float* xw = C.XO + (size_t)row * 1024;
#pragma unroll
        for (int j = 0; j < 2; ++j) { const int o = 8 * lane + 512 * j;
            *(f32x4*)(xw + o) = (f32x4){xv[j][0], xv[j][1], xv[j][2], xv[j][3]}; *(f32x4*)(xw + o + 4) = (f32x4){xv[j][4], xv[j][5], xv[j][6], xv[j][7]};
            const f32x4 g0 = *(const f32x4*)(C.gnext + o), g1 = *(const f32x4*)(C.gnext + o + 4), c0 = *(const f32x4*)(md + 1024 + o), c1 = *(const f32x4*)(md + 1024 + o + 4), h0 = *(const f32x4*)(md + o), h1 = *(const f32x4*)(md + o + 4);
            float hv[8];
#pragma unroll
            for (int i = 0; i < 4; ++i) { hv[i] = xv[j][i] * rs * g0[i] * (1.f + c0[i]) + h0[i]; hv[4 + i] = xv[j][4 + i] * rs * g1[i] * (1.f + c1[i]) + h1[i]; }
            v4u w; w.x = pk2(hv[0], hv[1]); w.y = pk2(hv[2], hv[3]); w.z = pk2(hv[4], hv[5]); w.w = pk2(hv[6], hv[7]);
            *(v4u*)(C.H + (size_t)row * 1024 + o) = w; }
    } else {
        float* orow = C.OUT + (size_t)row * 1024;
#pragma unroll
        for (int j = 0; j < 2; ++j) { const int o = 8 * lane + 512 * j; const f32x4 g0 = *(const f32x4*)(C.gnext + o), g1 = *(const f32x4*)(C.gnext + o + 4);
            *(f32x4*)(orow + o) = (f32x4){xv[j][0] * rs * g0[0], xv[j][1] * rs * g0[1], xv[j][2] * rs * g0[2], xv[j][3] * rs * g0[3]};
            *(f32x4*)(orow + o + 4) = (f32x4){xv[j][4] * rs * g1[0], xv[j][5] * rs * g1[1], xv[j][6] * rs * g1[2], xv[j][7] * rs * g1[3]}; }
    }
}
template <bool DUMMY>
__device__ __forceinline__ void combine_rows(PH_ARGS, const int l) {
    const int gw = bid * 8 + wave, NGW = G * 8; const int nrows = l == 0 ? MT : ML;
    CCtx C; C.SEL = WSP(int, WS_SEL); C.YB = WSP(bf16, WS_XE); C.X = WSP(float, WS_X); C.H = DUMMY ? WSP(bf16, WS_BR) : WSP(bf16, WS_H); C.MOD = WSP(float, WS_MOD);
    C.XO = DUMMY ? WSP(float, WS_ACT) : WSP(float, WS_X); C.OUT = DUMMY ? WSP(float, WS_ACT) : PTRV(28, float); C.gnext = l == 0 ? INP(6) + 1024 : INP(27); C.l = l; C.lane = lane;
    CRow A, B; int row = gw;
    if (row < nrows) cr_issue(C, A, row);
    while (row < nrows) {
        const int r2 = row + NGW; if (r2 < nrows) cr_issue(C, B, r2);
        cr_finish(C, A, row);
        const int r3 = r2 + NGW; if (r3 < nrows) cr_issue(C, A, r3);
        if (r2 < nrows) cr_finish(C, B, r2);
        row = r3;
    }
}

#ifdef DBG_STOP
__device__ __forceinline__ void debug_out(PH_ARGS) {
    float* out = PTRV(28, float);
    const int gt = bid * 512 + tid, GT = G * 512;
    for (size_t i = gt; i < (size_t)ML * 1024; i += GT) { const size_t row = i >> 10; const int c = (int)(i & 1023); float v = 0.f;
#if DBG_STOP == 2
        v = bflo(WSP(bf16, WS_H)[row * 1024 + c]) + WSP(float, WS_MOD)[(i % 36864)] + bflo(WSP(bf16, WS_WIN)[i % (6400 * 1024)]) + bflo(WSP(bf16, WS_WGU)[i]) + bflo(WSP(bf16, WS_WDN)[i]) + bflo(WSP(bf16, WS_WO)[i % (1024*1024)]) + bflo(WSP(bf16, WS_WBR)[i % (1024*1024)]);
#elif DBG_STOP == 3
        v = bflo(WSP(bf16, WS_AUV)[row * 512 + (c & 511)]) + bflo(WSP(bf16, WS_YF)[row * 512 + (c & 511)]) + bflo(WSP(bf16, WS_CY)[row * 256 + (c & 255)]) + bflo(WSP(bf16, WS_QPL)[row * 256 + (c & 255)])
          + bflo(WSP(bf16, WS_QROT)[row * 256 + (c & 255)]) + bflo(WSP(bf16, WS_KR)[row * 256 + (c & 255)]) + bflo(WSP(bf16, WS_VV)[row * 256 + (c & 255)])
          + bflo(WSP(bf16, WS_G)[row * 4096 + c]) + bflo(WSP(bf16, WS_G)[row * 4096 + 1024 + c]) + bflo(WSP(bf16, WS_G)[row * 4096 + 2048 + c]) + bflo(WSP(bf16, WS_G)[row * 4096 + 3072 + c]);
#elif DBG_STOP == 4
        v = bflo(WSP(bf16, WS_BR)[(size_t)(0 * MT + row) * 256 + (c & 255)]) + bflo(WSP(bf16, WS_BR)[(size_t)(2 * MT + row) * 256 + (c & 255)]) + bflo(WSP(bf16, WS_FA)[i % ((size_t)8 << 20)]);
#elif DBG_STOP == 21
        v = bflo(WSP(bf16, WS_T1T)[i % 16384]) * 1.001f + WSP(float, WS_ROPEC)[i % 2048] + WSP(float, WS_ROPES)[i % 2048] + bflo(WSP(bf16, WS_WSP)[i % 65536]);
#elif DBG_STOP == 31 || DBG_STOP == 44
        v = 0.f;
#elif DBG_STOP == 45 || DBG_STOP == 32
        v = 0.f;
#elif DBG_STOP == 41
        v = bflo(WSP(bf16, WS_BR)[(size_t)(0 * MT + row) * 256 + (c & 255)]) * 1.001f + bflo(WSP(bf16, WS_BR)[(size_t)(0 * MT + row) * 256 + ((c + 7) & 255)]);
#elif DBG_STOP == 42
        v = bflo(WSP(bf16, WS_BR)[(size_t)(2 * MT + row) * 256 + (c & 255)]) * 1.001f + bflo(WSP(bf16, WS_BR)[(size_t)(2 * MT + row) * 256 + ((c + 7) & 255)]);
#elif DBG_STOP == 43
        v = bflo(WSP(bf16, WS_FA)[i % ((size_t)8 << 20)]) * 1.001f + bflo(WSP(bf16, WS_FA)[(i + 7) % ((size_t)8 << 20)]);
#elif DBG_STOP == 5
        v = bflo(WSP(bf16, WS_BR)[(size_t)(1 * MT + row) * 256 + (c & 255)]) + bflo(WSP(bf16, WS_BR)[(size_t)(3 * MT + row) * 256 + (c & 255)]);
#elif DBG_STOP == 6
        v = bflo(WSP(bf16, WS_MB)[row * 1024 + c]);
#elif DBG_STOP == 7
        v = WSP(float, WS_X)[row * 1024 + c];
#elif DBG_STOP == 8
        v = bflo(WSP(bf16, WS_H)[row * 1024 + c]) + WSP(float, WS_AFF)[row * 16 + (c & 15)];
#elif DBG_STOP == 9
        v = (float)WSP(int, WS_SEL)[row * 16 + (c & 15)] + WSP(float, WS_GATE)[i % (16 * 2304)] + (float)WSP(int, WS_IDX)[i % (16 * 2304)];
#elif DBG_STOP == 10
        v = bflo(WSP(bf16, WS_XE)[i]) + bflo(WSP(bf16, WS_XE)[i + (size_t)ML * 1024]);
#elif DBG_STOP == 11
        v = bflo(WSP(bf16, WS_ACT)[i]) + bflo(WSP(bf16, WS_ACT)[i + (size_t)ML * 1024]);
#elif DBG_STOP == 12
        v = bflo(WSP(bf16, WS_XE)[i]) + bflo(WSP(bf16, WS_XE)[i + (size_t)ML * 1024]);
#else
        v = WSP(float, WS_X)[row * 1024 + c] + bflo(WSP(bf16, WS_H)[row * 1024 + c]);
#endif
#ifdef DBG_AMP
        v = (float)(__float_as_uint(v) & 0xFFFFu);
#endif
        out[i] = v; }
}
#endif
__global__ void __launch_bounds__(512, 2) mega(Args A) {
    extern __shared__ __attribute__((aligned(16))) unsigned char lds_raw[];
    LAS unsigned char* lds0 = (LAS unsigned char*)lds_raw;
    volatile LAS unsigned* MISC = (volatile LAS unsigned*)(lds0 + MISC_OFF);
    const int tid = threadIdx.x, lane = tid & 63, wave = __builtin_amdgcn_readfirstlane(tid >> 6), bid = blockIdx.x, G = gridDim.x;
    for (int u = tid; u < (LDS_BYTES - MISC_OFF) / 4; u += 512) ((LAS unsigned*)(lds0 + MISC_OFF))[u] = 0u;
    __syncthreads();
    if (tid == 0) { typedef unsigned u2v_t __attribute__((ext_vector_type(2)));
#pragma unroll
        for (int i = 0; i < 30; ++i) { const unsigned long long p = i < 28 ? (unsigned long long)A.in[i] : (i == 28 ? (unsigned long long)A.out : (unsigned long long)A.ws);
            *(LAS u2v_t*)(lds0 + PTAB_OFF + 8 * i) = (u2v_t){(unsigned)p, (unsigned)(p >> 32)}; } }
    __syncthreads();
    const int lo = A.ph_lo, hi = A.ph_hi;
    XcdBarrier bar; bar.bar = (unsigned*)(A.ws + WS_CTL) + CW_BAR; bar.x = 0; bar.st = nullptr;
    if (hi - lo > 1) bar = xcd_barrier_post((unsigned*)(A.ws + WS_CTL) + CW_BAR, MISC + 8);
#define PH_CALL lds, tl_, (tl_ & 63), wv_, bl_, G_
#define PH_CALLV lds, tl_, (tl_ & 63), wv_, vb_, G_
#ifdef TS_I
    if (bid == 0 && tid == 0) ((unsigned long long*)(A.ws + 65536))[lo] = rt();
#endif
    if (lo == 0) {
        int tl_ = tid; asm volatile("" : "+v"(tl_)); int bl_ = bid; asm volatile("" : "+s"(bl_)); int wv_ = wave; asm volatile("" : "+s"(wv_)); int G_ = G; asm volatile("" : "+s"(G_));
        unsigned ldsb_ = (unsigned)(uintptr_t)lds0; asm volatile("" : "+s"(ldsb_)); LAS unsigned char* lds = (LAS unsigned char*)(uintptr_t)ldsb_;
#ifndef P0R_MOD
#define P0R_MOD 1
#endif
#ifndef P0R_TAB
#define P0R_TAB 1
#endif
#ifndef P0R_CVT
#define P0R_CVT 1
#endif
#pragma unroll 1
            for (int r_ = 0; r_ < P0R_MOD; ++r_) { mod_gemv(PH_CALL); asm volatile("" ::: "memory"); }
#pragma unroll 1
            for (int r_ = 0; r_ < P0R_TAB; ++r_) { make_tables(PH_CALL); asm volatile("" ::: "memory"); }
#pragma unroll 1
            for (int r_ = 0; r_ < P0R_CVT; ++r_) { convert_weights(PH_CALL, 0); asm volatile("" ::: "memory"); }
        if (hi > 1) { XcdBarrier b2 = bar; b2.bar = (unsigned*)(PTRV(29, unsigned char) + WS_CTL) + CW_BAR; b2.st = (volatile LAS unsigned*)(lds + MISC_OFF) + 8; xcd_barrier(b2); }
    }
    const int lo1 = lo < 1 ? 1 : lo;
#pragma unroll 1
#ifdef REP_PH
    for (int it_ = lo1; it_ < hi + (REP_N - 1); ++it_) { const int ph = it_ < REP_PH ? it_ : (it_ < REP_PH + REP_N ? REP_PH : it_ - (REP_N - 1));
#else
    for (int ph = lo1; ph < hi; ++ph) {
#endif
        int tl_ = tid; asm volatile("" : "+v"(tl_)); int bl_ = bid; asm volatile("" : "+s"(bl_)); int vb_ = (G % 8 == 0) ? (bid % 8) * (G / 8) + bid / 8 : bid; asm volatile("" : "+s"(vb_)); int wv_ = wave; asm volatile("" : "+s"(wv_)); int G_ = G; asm volatile("" : "+s"(G_)); unsigned ldsb_ = (unsigned)(uintptr_t)lds0; asm volatile("" : "+s"(ldsb_)); LAS unsigned char* lds = (LAS unsigned char*)(uintptr_t)ldsb_;
        const int l = ph < 13 ? 0 : 1, kind = ph >= 99 ? 99 : (ph < 2 ? ph : 2 + (ph - 2 - 11 * l));
        const int ntm = l == 0 ? 66 : 64, tpe = l == 0 ? 9 : 8;
        if (kind == 9) continue;
        switch (kind) {
#ifdef DBG_STOP
        case 99: debug_out(PH_CALL); break;
#endif
        case 0: break;
        case 1: {
#ifndef DIS_N1
            norm1_l0(PH_CALL);
#endif
        } break;
        case 2: {
            pg8::Gemm g{WSP(bf16, WS_H), WSP(bf16, WS_WIN), MT, NIN, 1024}; pg8::StaticOrder S; S.init(MT, NIN, G_, bl_);
            EpiIn E{WSP(bf16, WS_AUV), WSP(bf16, WS_YF), WSP(bf16, WS_CY), WSP(bf16, WS_QPL), WSP(bf16, WS_QROT), WSP(bf16, WS_KR), WSP(bf16, WS_VV), WSP(bf16, WS_G), WSP(float, WS_ROPEC), WSP(float, WS_ROPES)};
#ifndef DIS_GIN
            pg8::gemm_phase<EpiIn, pg8::StaticOrder, true, true>(lds, g, S, E);
#endif
        } break;
        case 3: {
#ifndef DIS_F1
            if (bl_ < 256) { f1_stage_tables(PH_CALL); for (int u = vb_; u < 256; u += G_) f1_unit(PH_CALL, u); }
#endif
#ifndef DIS_CDFT
            if (l == 0) ctx_butterfly(PH_CALL);
#endif
            __syncthreads();
            { LAS float* rp = (LAS float*)(lds + AT_RPB); const float* src = INP(20) + l * 1860; for (int i = tl_; i < 1860; i += 512) rp[i] = src[i]; }
            __syncthreads();
            const int nat = l == 0 ? 264 : 256;
#ifndef DIS_ATT
            for (int u = vb_; u < nat; u += G_) attn_unit(PH_CALL, u);
#endif
        } break;
        case 4: {
#ifndef DIS_F2
            { const int nf2 = l == 0 ? 264 : 256; for (int u = vb_; u < nf2; u += G_) f2_unit(PH_CALL, u); }
#endif
            const int nconv = l == 0 ? 264 : 256, ngm = l == 0 ? 132 : 128;
#ifndef DIS_CONV
            for (int u = vb_; u < nconv; u += G_) conv_unit(PH_CALL, l, u);
#endif
#ifndef DIS_GMLP
            for (int u = G_ - 1 - vb_; u < ngm; u += G_) gmlp_unit(PH_CALL, l, u);
#endif
        } break;
        case 5: {
#ifndef DIS_GMRG
#ifndef MERGE_PG8
            merge_phase(PH_CALLV, ntm * 16);
#else
            { pg8::Gemm g{WSP(bf16, WS_BR), WSP(bf16, WS_WBR), 4 * MT, 4096, 256}; MergeOrder S; S.init(ntm, G_, bl_); EpiMergeH E{WSP(bf16, WS_G), WSP(bf16, WS_MB)};
              pg8::gemm_phase<EpiMergeH, MergeOrder, true, true>(lds, g, S, E); }
#endif
#endif
        } break;
        case 6: {
            pg8::Gemm g{WSP(bf16, WS_MB), WSP(bf16, WS_WO), ML, 1024, 1024}; pg8::StaticOrder S; S.init(ML, 1024, G_, bl_);
            EpiWout E{l == 0 ? INP(0) : WSP(float, WS_X), l == 0 ? INP(2) : WSP(float, WS_X) + (size_t)ML * 1024, WSP(float, WS_X), WSP(float, WS_MOD) + l * 3 * 6144};
#ifndef DIS_GWO
            pg8::gemm_phase<EpiWout, pg8::StaticOrder, true, true>(lds, g, S, E);
#endif
#ifndef DIS_CVT
            if (l == 0) { const int nx = (64 * 4) % G_; convert_range(lds, tl_, (tl_ & 63), wv_, bl_, G_, 1, CV_FOLD0, CV_WO0, nx ? bl_ - nx : bl_, G_ - nx); }
#endif
        } break;
        case 7: {
#ifndef DIS_N2
            if (l == 0 && G_ > 16) {
                unsigned* cnt = (unsigned*)(PTRV(29, unsigned char) + WS_CTL) + 2048;
                if (bl_ < 8) {
                    pg8::Gemm g{WSP(bf16, WS_MB), WSP(bf16, WS_WO), MT, 1024, 1024}; OneUnit S{64 + (bl_ >> 2), bl_ & 3};
                    EpiWout E{INP(0), INP(2), WSP(float, WS_X), WSP(float, WS_MOD)};
                    pg8::gemm_phase<EpiWout, OneUnit, true, true>(lds, g, S, E);
                    asm volatile("s_waitcnt vmcnt(0)" ::: "memory"); __syncthreads();
                    if (tl_ == 0) { __builtin_amdgcn_fence(__ATOMIC_RELEASE, "agent"); asm volatile("s_waitcnt vmcnt(0)" ::: "memory"); __hip_atomic_fetch_add(cnt, 1u, __ATOMIC_RELAXED, __HIP_MEMORY_SCOPE_AGENT); }
                } else norm2_router(PH_CALL, l, 0, ML, bl_ - 8, G_ - 8);
                if (tl_ == 0) { unsigned sp_ = 0; while (__hip_atomic_load(cnt, __ATOMIC_RELAXED, __HIP_MEMORY_SCOPE_AGENT) < 8u && ++sp_ < (1u << 22)) __builtin_amdgcn_s_sleep(2);
                    __builtin_amdgcn_fence(__ATOMIC_ACQUIRE, "agent"); asm volatile("s_waitcnt vmcnt(0)" ::: "memory"); }
                __syncthreads();
                norm2_router(PH_CALL, l, ML, MC, bl_, G_, bl_ < 8);
            } else norm2_router(PH_CALL, l, 0, ntm * 256, bl_, G_);
#endif
        } break;
        case 8: {
#ifndef DIS_TOPK
            const int nun = l == 0 ? 64 : 32;
            for (int u = bl_; u < nun; u += G_) {
                if (u < 32) { const int b = u >> 4, e = u & 15; topk_unit<16, true>(PH_CALL, b * SEQ, SEQ, CAPL, e, b * CAPL, l == 0 && b == 0); }
                else { const int b = (u - 32) >> 4, e = u & 15; topk_unit<1, false>(PH_CALL, ML + b * CTXL, CTXL, CAPC, e, 2048 + b * CAPC, false); }
            }
#endif
        } break;
        case 9: {
#ifndef DIS_GATH
            gather_rows(PH_CALL, tpe);
#endif
        } break;
        case 10: {
            pg8::Gemm g{WSP(bf16, WS_H), WSP(bf16, WS_WGU), NE * ESTR, NE * 2048, 1024, WSP(int, WS_IDX)}; GroupOrder S; S.init(tpe, 8, G_, bl_);
            EpiGU E{WSP(bf16, WS_ACT)};
#ifndef DIS_GGU
            pg8::gemm_phase<EpiGU, GroupOrder, true, true, true>(lds, g, S, E);
#endif
#ifndef DIS_CVT
            if (l == 0) { const int nx = (NE * tpe * 8) % G_; convert_range(lds, tl_, (tl_ & 63), wv_, bl_, G_, 1, CV_WO0, CV_GU0, nx ? bl_ - nx : bl_, G_ - nx);
                          convert_range(lds, tl_, (tl_ & 63), wv_, bl_, G_, 1, CV_SP0, CV_END, nx ? bl_ - nx : bl_, G_ - nx); }
#endif
        } break;
        case 11: {
            pg8::Gemm g{WSP(bf16, WS_ACT), WSP(bf16, WS_WDN), NE * ESTR, NE * 1024, 1024}; GroupOrder S; S.init(tpe, 4, G_, bl_);
            EpiDown E{WSP(bf16, WS_XE), WSP(float, WS_GATE)};
#ifndef DIS_GDN
            pg8::gemm_phase<EpiDown, GroupOrder, true, true>(lds, g, S, E);
#endif
#ifndef DIS_CVT
            if (l == 0) { const int nx = (NE * tpe * 4) % G_; convert_range(lds, tl_, (tl_ & 63), wv_, bl_, G_, 1, CV_GU0, CV_DN0, nx ? bl_ - nx : bl_, G_ - nx); }
#endif
        } break;
        default: {
#ifndef DIS_COMB
#ifdef COMB_REP
#pragma unroll 1
            for (int r_ = 0; r_ < COMB_REP; ++r_) combine_rows<true>(PH_CALL, l);
#endif
            combine_rows<false>(PH_CALL, l);
#endif
#ifndef DIS_CVT
            if (l == 0) convert_range(lds, tl_, (tl_ & 63), wv_, bl_, G_, 1, CV_DN0, CV_SP0, bl_, G_);
#endif
        } break;
        }
#ifdef XBAR
        if (ph == 1) { for (int xb_ = 0; xb_ < XBAR; ++xb_) { XcdBarrier b5 = bar; b5.bar = (unsigned*)(PTRV(29, unsigned char) + WS_CTL) + CW_BAR; b5.st = (volatile LAS unsigned*)(lds + MISC_OFF) + 8; xcd_barrier(b5); } }
#endif
#ifdef TS_I
        { XcdBarrier b3 = bar; b3.bar = (unsigned*)(PTRV(29, unsigned char) + WS_CTL) + CW_BAR; b3.st = (volatile LAS unsigned*)(lds + MISC_OFF) + 8; xcd_barrier(b3);
          if (bid == 0 && tid == 0) ((unsigned long long*)(PTRV(29, unsigned char) + 65536))[ph + 1] = rt(); }
        if (ph + 1 == hi) { XcdBarrier b3 = bar; b3.bar = (unsigned*)(PTRV(29, unsigned char) + WS_CTL) + CW_BAR; b3.st = (volatile LAS unsigned*)(lds + MISC_OFF) + 8; xcd_barrier(b3);
            const unsigned long long* TS = (const unsigned long long*)(PTRV(29, unsigned char) + 65536);
            const float dti = (float)(TS[TS_I + 1] - TS[TS_I]) * 0.01f, dtj = (float)(TS[TS_J + 1] - TS[TS_J]) * 0.01f;
            float* out = PTRV(28, float); const float Av = sqrtf(dti);
            for (size_t i = (size_t)bid * 512 + tid; i < (size_t)ML * 1024; i += (size_t)G * 512) out[i] = (i == 0) ? dtj * 10.f : Av; }
        if (0) {
#else
#ifdef REP_PH
        if (it_ + 1 < hi + (REP_N - 1)) {
#else
        if (ph + 1 < hi) {
#endif
#endif
          XcdBarrier b2 = bar; b2.bar = (unsigned*)(PTRV(29, unsigned char) + WS_CTL) + CW_BAR; unsigned bx_ = bar.x; asm volatile("" : "+s"(bx_)); b2.x = bx_; b2.st = (volatile LAS unsigned*)(lds + MISC_OFF) + 8; xcd_barrier(b2); }
    }
}

extern "C" void kernel_launch(void* const* d_in, const int* in_sizes, int n_in, void* d_out, int out_size, void* d_ws, size_t ws_size, hipStream_t stream) {
    static int grid = 0;
    if (grid == 0) {
        if (n_in != 28 || ws_size < WS_END) { fprintf(stderr, "kernel_launch: unexpected n_in %d / ws %zu\n", n_in, ws_size); grid = -1; return; }
        int dev = 0, cus = 0;
        if (hipGetDevice(&dev) != hipSuccess || hipDeviceGetAttribute(&cus, hipDeviceAttributeMultiprocessorCount, dev) != hipSuccess) { grid = -1; return; }
        if (hipFuncSetAttribute((const void*)mega, hipFuncAttributeMaxDynamicSharedMemorySize, LDS_BYTES) != hipSuccess) { fprintf(stderr, "kernel_launch: hipFuncSetAttribute failed\n"); grid = -1; return; }
        (void)hipGetLastError();
        grid = cus;
    }
    if (grid < 0) return;
    (void)hipMemsetAsync((char*)d_ws + WS_CTL, 0, CTL_ZERO_BYTES, stream);
    Args a{};
    for (int i = 0; i < 28; ++i) a.in[i] = (const float*)d_in[i];
    a.out = (float*)d_out; a.ws = (unsigned char*)d_ws;
#ifdef DBG_STOP
    for (int p = 0; p < (DBG_STOP > 20 ? DBG_STOP / 10 : DBG_STOP); ++p) { a.ph_lo = p; a.ph_hi = p + 1; hipLaunchKernelGGL(mega, dim3(grid), dim3(512), LDS_BYTES, stream, a); }
    a.ph_lo = 99; a.ph_hi = 100; hipLaunchKernelGGL(mega, dim3(grid), dim3(512), LDS_BYTES, stream, a);
#elif N_LAUNCHES == 1
    a.ph_lo = 0; a.ph_hi = NPH;
    hipLaunchKernelGGL(mega, dim3(grid), dim3(512), LDS_BYTES, stream, a);
#else
    for (int p = 0; p < NPH; ++p) { a.ph_lo = p; a.ph_hi = p + 1; hipLaunchKernelGGL(mega, dim3(grid), dim3(512), LDS_BYTES, stream, a); }
#endif
}
```

```cpp
#include <hip/hip_runtime.h>
#include <cstdio>
#include <cstdint>
#define N_LAUNCHES 1
namespace pg8 {
#define PG8_LAS __attribute__((address_space(3)))
typedef unsigned short bf16_t;
typedef short bf16x8 __attribute__((ext_vector_type(8)));
typedef float f32x4 __attribute__((ext_vector_type(4)));
typedef unsigned u32x4 __attribute__((ext_vector_type(4)));
constexpr int BM = 256, BK = 64, HALF = 128, HTB = HALF * BK * 2  , STAGE_BYTES = 8 * HTB, NXCD = 8, WGM = 2;

__host__ __device__ __forceinline__ int lds_byte(int r, int c) { const int st = (r >> 4) * 2 + (c >> 5), rr = r & 15, cc = c & 31, ob = rr * 64 + cc * 2; return st * 1024 + (ob ^ (((ob >> 9) & 1) << 5)); }
__host__ __device__ __forceinline__ void stage_rc(int b, int& R, int& C) { const int st = b / 1024, sb = b % 1024, swz = sb ^ (((sb >> 9) & 1) << 5); R = (st >> 1) * 16 + swz / 64; C = (st & 1) * 32 + (swz % 64) / 2; }
__host__ __device__ __forceinline__ int perm32(int rho) { const int n = rho >> 4, i = rho & 15; return 8 * (i >> 2) + 4 * n + (i & 3); }

struct Unit { int pm, pn; };
struct Gemm { const bf16_t* A; const bf16_t* Bt; int M, N, K; const int* gidx = nullptr; };

struct StaticOrder {
    int nM, nN, nwg, G, c;
    __host__ __device__ void init(int M, int N, int G_, int c_) { nM = M / BM; nN = N / BM; nwg = nM * nN; G = G_; c = c_; }
    __host__ __device__ bool next(int i, Unit& u) const {
        const long L = (long)i * G + c; if (L >= nwg) return false;
        int wgid = (int)L; { const int q = nwg / NXCD, r = nwg % NXCD, xcd = wgid % NXCD, off = wgid / NXCD; wgid = (xcd < r ? xcd * (q + 1) : r * (q + 1) + (xcd - r) * q) + off; }
        const int nig = WGM * nN, gid = wgid / nig, fm = gid * WGM, gsz = (nM - fm) < WGM ? (nM - fm) : WGM;
        u.pm = fm + ((wgid % nig) % gsz); u.pn = (wgid % nig) / gsz; return true;
    }
    __device__ __forceinline__ void a_ready(const Unit&) const {}
    __device__ __forceinline__ void done(const Unit&) const {}
};
__device__ __forceinline__ unsigned cvt_pk_bf16(float lo, float hi) { unsigned r; asm volatile("v_cvt_pk_bf16_f32 %0, %1, %2" : "=v"(r) : "v"(lo), "v"(hi)); return r; }
typedef float f32x2 __attribute__((ext_vector_type(2)));
template <class Epi, class Sched, bool ALIGN_EPI = false, bool SP2 = false, bool GATHER = false>
__device__ __forceinline__ void gemm_phase(PG8_LAS unsigned char* lds, const Gemm g, const Sched& S, const Epi& E) {
    int tid_l = threadIdx.x; asm volatile("" : "+v"(tid_l));
    const int tid = tid_l, wid = __builtin_amdgcn_readfirstlane(tid >> 6), lane = tid & 63, wr = wid >> 2, wc = wid & 3, fr = lane & 15, fq = lane >> 4;
    const int K = g.K, nt = K / BK;
    unsigned voffA[2], voffB[2];
#pragma unroll
    for (int i = 0; i < 2; ++i) { int R, C; stage_rc(tid * 16 + i * 8192, R, C); const int Rb = Epi::PERM ? ((R & ~31) + perm32(R & 31)) : R;
        voffA[i] = (unsigned)(R * K + C) * 2u; voffB[i] = (unsigned)(Rb * K + C) * 2u; }
    const size_t kstep = (size_t)(BK * 2);
    const size_t hstep = (size_t)HALF * K * 2;
    const size_t tstep = 2 * hstep;
    const unsigned ldsw = (unsigned)wid * 1024u;
    const int aoff = lds_byte(wr * 64 + fr, fq * 8), boff = lds_byte(wc * 32 + fr, fq * 8);
#define PG8_SA(b, h) (((b) * 2 + (h)) * HTB)
#define PG8_SB(b, h) ((4 + (b) * 2 + (h)) * HTB)
#define PG8_STAGE(bufoff, gbase, voff) do { _Pragma("unroll") for (int _i = 0; _i < 2; ++_i) \
        __builtin_amdgcn_global_load_lds((const unsigned*)((const char*)(gbase) + (voff)[_i]), (PG8_LAS unsigned*)(lds + (bufoff) + ldsw + _i * 8192), 16, 0, 0); } while (0)
    static_assert(!GATHER || SP2, "GATHER is implemented on the SP2 loop only");
    unsigned vgc[2][2] = {{0u, 0u}, {0u, 0u}}, vgn[2][2] = {{0u, 0u}, {0u, 0u}};
#define PG8_GLOAD(u, v) do { _Pragma("unroll") for (int _h = 0; _h < 2; ++_h) _Pragma("unroll") for (int _i = 0; _i < 2; ++_i) { int R_, C_; stage_rc(tid * 16 + _i * 8192, R_, C_); \
        v[_h][_i] = (unsigned)(g.gidx[(u).pm * BM + _h * HALF + R_] * K + C_) * 2u; } } while (0)
#define PG8_STAGE_A(bufoff, base, half, NEXT) do { if constexpr (GATHER) { if (NEXT) PG8_STAGE(bufoff, base, vgn[half]); else PG8_STAGE(bufoff, base, vgc[half]); } \
        else PG8_STAGE(bufoff, (base) + (half) * hstep, voffA); } while (0)
#define PG8_LDA(dst, b, h) do { _Pragma("unroll") for (int m = 0; m < 4; ++m) _Pragma("unroll") for (int k = 0; k < 2; ++k) dst[m][k] = *(const PG8_LAS bf16x8*)(lds + PG8_SA(b, h) + aoff + m * 2048 + k * 1024); } while (0)
#define PG8_LDB(dst, b, h) do { _Pragma("unroll") for (int n = 0; n < 2; ++n) _Pragma("unroll") for (int k = 0; k < 2; ++k) dst[n][k] = *(const PG8_LAS bf16x8*)(lds + PG8_SB(b, h) + boff + n * 2048 + k * 1024); } while (0)
#define PG8_MMA(ai, bj, At, Bt) do { __builtin_amdgcn_s_setprio(1); _Pragma("unroll") for (int m = 0; m < 4; ++m) _Pragma("unroll") for (int n = 0; n < 2; ++n) _Pragma("unroll") for (int k = 0; k < 2; ++k) \
        acc[ai][bj][m][n] = __builtin_amdgcn_mfma_f32_16x16x32_bf16(Bt[n][k], At[m][k], acc[ai][bj][m][n], 0, 0, 0); __builtin_amdgcn_s_setprio(0); } while (0)
#define PG8_WAIT_V(n) asm volatile("s_waitcnt vmcnt(" #n ")" ::: "memory")
#define PG8_WAIT_L(n) asm volatile("s_waitcnt lgkmcnt(" #n ")" ::: "memory")
#define PG8_BAR __builtin_amdgcn_s_barrier()
#define PG8_SCHED __builtin_amdgcn_sched_barrier(0)
    Unit cur, nxt; int ui = 0;
    if (!S.next(0, cur)) return;
    f32x4 acc[2][2][4][2];
#pragma unroll
    for (int a = 0; a < 2; ++a)
#pragma unroll
        for (int b = 0; b < 2; ++b)
#pragma unroll
            for (int m = 0; m < 4; ++m)
#pragma unroll
                for (int n = 0; n < 2; ++n) acc[a][b][m][n] = (f32x4){0.f, 0.f, 0.f, 0.f};
    bf16x8 At[4][2], B0[2][2], B1[2][2];
    const char* cA = GATHER ? (const char*)g.A : (const char*)g.A + (size_t)cur.pm * tstep; const char* cB = (const char*)g.Bt + (size_t)cur.pn * tstep;
    if constexpr (GATHER) { PG8_GLOAD(cur, vgc); }
    S.a_ready(cur);
    if constexpr (SP2) {
        PG8_STAGE(PG8_SB(0, 0), cB, voffB); PG8_STAGE(PG8_SB(0, 1), cB + hstep, voffB); PG8_STAGE_A(PG8_SA(0, 0), cA, 0, false); PG8_STAGE_A(PG8_SA(0, 1), cA, 1, false);
        if (wr == 1) PG8_BAR;
        PG8_WAIT_V(2); PG8_BAR;
        PG8_STAGE(PG8_SB(1, 0), cB + kstep, voffB); PG8_STAGE_A(PG8_SA(1, 0), cA + kstep, 0, false); PG8_STAGE(PG8_SB(1, 1), cB + hstep + kstep, voffB);
        PG8_WAIT_V(6); PG8_BAR;
    } else {
        PG8_STAGE(PG8_SB(0, 0), cB, voffB); PG8_STAGE(PG8_SA(0, 0), cA, voffA); PG8_STAGE(PG8_SB(0, 1), cB + hstep, voffB); PG8_STAGE(PG8_SA(0, 1), cA + hstep, voffA);
        if (wr == 1) PG8_BAR;
        PG8_WAIT_V(4); PG8_BAR;
        PG8_STAGE(PG8_SB(1, 0), cB + kstep, voffB); PG8_STAGE(PG8_SA(1, 0), cA + kstep, voffA); PG8_STAGE(PG8_SB(1, 1), cB + hstep + kstep, voffB);
        PG8_WAIT_V(6); PG8_BAR;
    }
    for (;;) {
        const bool has_next = S.next(ui + 1, nxt);
        const char* nA = GATHER ? (const char*)g.A : (has_next ? (const char*)g.A + (size_t)nxt.pm * tstep : cA);
        if constexpr (GATHER) { if (has_next) { PG8_GLOAD(nxt, vgn); } else { _Pragma("unroll") for (int _h = 0; _h < 2; ++_h) _Pragma("unroll") for (int _i = 0; _i < 2; ++_i) vgn[_h][_i] = vgc[_h][_i]; } } const char* nB = has_next ? (const char*)g.Bt + (size_t)nxt.pn * tstep : cB;
#pragma unroll 1
        for (int t = 0; t < nt; t += 2) {
            const bool last = (t == nt - 2);
            const char* a1 = cA + (size_t)(t + 1) * kstep;
            const char* a2 = last ? nA : cA + (size_t)(t + 2) * kstep; const char* b2 = last ? nB : cB + (size_t)(t + 2) * kstep;
            const char* a3 = a2 + kstep; const char* b3 = b2 + kstep;
            if (last && has_next) S.a_ready(nxt);
            if constexpr (SP2) {
            PG8_LDB(B0, 0, 0); PG8_LDB(B1, 0, 1); PG8_SCHED; PG8_LDA(At, 0, 0); PG8_STAGE_A(PG8_SA(1, 1), a1, 1, false);
            PG8_WAIT_V(8); PG8_WAIT_L(0); PG8_BAR; PG8_MMA(0, 0, At, B0); PG8_MMA(0, 1, At, B1); PG8_BAR; PG8_SCHED;
            PG8_LDA(At, 0, 1); PG8_STAGE(PG8_SB(0, 0), b2, voffB); PG8_STAGE(PG8_SB(0, 1), b2 + hstep, voffB); PG8_STAGE_A(PG8_SA(0, 0), a2, 0, last);
            PG8_WAIT_V(8); PG8_WAIT_L(0); PG8_BAR; PG8_MMA(1, 0, At, B0); PG8_MMA(1, 1, At, B1); PG8_BAR; PG8_SCHED;
            PG8_LDB(B0, 1, 0); PG8_LDB(B1, 1, 1); PG8_SCHED; PG8_LDA(At, 1, 0); PG8_STAGE_A(PG8_SA(0, 1), a2, 1, last);
            PG8_WAIT_V(8); PG8_WAIT_L(0); PG8_BAR; PG8_MMA(0, 0, At, B0); PG8_MMA(0, 1, At, B1); PG8_BAR; PG8_SCHED;
            PG8_LDA(At, 1, 1); PG8_STAGE(PG8_SB(1, 0), b3, voffB); PG8_STAGE(PG8_SB(1, 1), b3 + hstep, voffB); PG8_STAGE_A(PG8_SA(1, 0), a3, 0, last);
            PG8_WAIT_V(8); PG8_WAIT_L(0); PG8_BAR; PG8_MMA(1, 0, At, B0); PG8_MMA(1, 1, At, B1); PG8_BAR; PG8_SCHED;
            } else {
            PG8_LDB(B0, 0, 0); PG8_SCHED; PG8_LDA(At, 0, 0); PG8_STAGE(PG8_SA(1, 1), a1 + hstep, voffA);
            PG8_WAIT_L(8); PG8_BAR; PG8_WAIT_L(0); PG8_MMA(0, 0, At, B0); PG8_BAR; PG8_SCHED;
            PG8_LDB(B1, 0, 1); PG8_STAGE(PG8_SB(0, 0), b2, voffB);
            PG8_BAR; PG8_WAIT_L(0); PG8_MMA(0, 1, At, B1); PG8_BAR;
            PG8_LDA(At, 0, 1); PG8_STAGE(PG8_SA(0, 0), a2, voffA);
            PG8_BAR; PG8_WAIT_L(0); PG8_MMA(1, 0, At, B0); PG8_BAR; PG8_SCHED;
            PG8_STAGE(PG8_SB(0, 1), b2 + hstep, voffB);
            PG8_WAIT_V(6); PG8_BAR; PG8_MMA(1, 1, At, B1); PG8_BAR;
            PG8_LDB(B0, 1, 0); PG8_SCHED; PG8_LDA(At, 1, 0); PG8_STAGE(PG8_SA(0, 1), a2 + hstep, voffA);
            PG8_WAIT_L(8); PG8_BAR; PG8_WAIT_L(0); PG8_MMA(0, 0, At, B0); PG8_BAR; PG8_SCHED;
            PG8_LDB(B1, 1, 1); PG8_STAGE(PG8_SB(1, 0), b3, voffB);
            PG8_BAR; PG8_WAIT_L(0); PG8_MMA(0, 1, At, B1); PG8_BAR;
            PG8_LDA(At, 1, 1); PG8_STAGE(PG8_SA(1, 0), a3, voffA);
            PG8_BAR; PG8_WAIT_L(0); PG8_MMA(1, 0, At, B0); PG8_BAR; PG8_SCHED;
            PG8_STAGE(PG8_SB(1, 1), b3 + hstep, voffB);
            PG8_WAIT_V(6); PG8_BAR; PG8_MMA(1, 1, At, B1); PG8_BAR;
            }
        }
        if constexpr (ALIGN_EPI) { if (wr == 0) PG8_BAR; }
        if constexpr (!Epi::AFTER_DRAIN) { int t2_ = threadIdx.x; asm volatile("" : "+v"(t2_)); E(acc, cur, wr, wc, t2_ & 15, (t2_ >> 4) & 3); S.done(cur); }
        if (!has_next) break;
        bool keep_ = false; if constexpr (Epi::KEEP) keep_ = E.keep(cur);
        if (!keep_) {
#pragma unroll
        for (int a = 0; a < 2; ++a)
#pragma unroll
            for (int b = 0; b < 2; ++b)
#pragma unroll
                for (int m = 0; m < 4; ++m)
#pragma unroll
                    for (int n = 0; n < 2; ++n) acc[a][b][m][n] = (f32x4){0.f, 0.f, 0.f, 0.f};
        }
        cur = nxt; cA = nA; cB = nB; ++ui;
        if constexpr (GATHER) { _Pragma("unroll") for (int _h = 0; _h < 2; ++_h) _Pragma("unroll") for (int _i = 0; _i < 2; ++_i) vgc[_h][_i] = vgn[_h][_i]; }
        if constexpr (ALIGN_EPI) { if (wr == 1) PG8_BAR; }
    }
    PG8_WAIT_V(0);
    if constexpr (!ALIGN_EPI) { if (wr == 0) PG8_BAR; }
    PG8_BAR;
    if constexpr (Epi::AFTER_DRAIN) { E.fused(acc, cur, wr, wc, fr, fq, lds, wid, lane); S.done(cur); }
#undef PG8_SA
#undef PG8_SB
#undef PG8_STAGE
#undef PG8_STAGE_A
#undef PG8_GLOAD
#undef PG8_LDA
#undef PG8_LDB
#undef PG8_MMA
#undef PG8_WAIT_V
#undef PG8_WAIT_L
#undef PG8_BAR
#undef PG8_SCHED
}
}
#define GAS __attribute__((address_space(1)))
#define LAS __attribute__((address_space(3)))
typedef unsigned short bf16;
typedef unsigned v4u __attribute__((ext_vector_type(4)));
typedef float f32x4 __attribute__((ext_vector_type(4)));
typedef short bf16x8 __attribute__((ext_vector_type(8)));
typedef GAS unsigned gu32;
typedef GAS unsigned long long gu64;
#define RLX_AGENT __ATOMIC_RELAXED, __HIP_MEMORY_SCOPE_AGENT
#define LDS_WAIT() asm volatile("s_waitcnt lgkmcnt(0)" ::: "memory")
#define VM_WAIT() asm volatile("s_waitcnt vmcnt(0)" ::: "memory")
__device__ __forceinline__ unsigned long long rt() { return __builtin_amdgcn_s_memrealtime(); }
__device__ __forceinline__ unsigned f2bf(float f) { unsigned u = __builtin_bit_cast(unsigned, f); return (u + 0x7fffu + ((u >> 16) & 1u)) >> 16; }
typedef float f32x2_t __attribute__((ext_vector_type(2))); typedef __bf16 bf16x2_t __attribute__((ext_vector_type(2)));
__device__ __forceinline__ unsigned pk2(float lo, float hi) { const f32x2_t v = {lo, hi}; const bf16x2_t b = __builtin_convertvector(v, bf16x2_t); return __builtin_bit_cast(unsigned, b); }

#define XB_TMO      128
#define XB_XCNT(j)  (256  + 64 * (j))
#define XB_XSUB(j)  (1280 + 64 * (j))
#define XB_XGEN(j)  (2304 + 64 * (j))
#define XB_TOP      3328
#define XB_TOPGEN   3392
#define XCD_BAR_WORDS 3456
#define XB_SPIN_CAP (1u << 18)

__device__ __forceinline__ unsigned xb_ld(unsigned* p)              { return __hip_atomic_load(p, __ATOMIC_RELAXED, __HIP_MEMORY_SCOPE_AGENT); }
__device__ __forceinline__ unsigned xb_add(unsigned* p, unsigned v) { return __hip_atomic_fetch_add(p, v, __ATOMIC_RELAXED, __HIP_MEMORY_SCOPE_AGENT); }
__device__ __forceinline__ unsigned xb_xcc_id() { return (unsigned)__builtin_amdgcn_s_getreg((3 << 11) | 20) & 0xFu; }
#define XB_SPIN(cond, bar) do { unsigned _sp = 0; while (cond) { __builtin_amdgcn_s_sleep(1); \
    if ((++_sp & 255u) == 0u) { if (xb_ld(&(bar)[XB_TMO])) break; if (_sp > XB_SPIN_CAP) { atomicAdd(&(bar)[XB_TMO], 1u); break; } } } } while (0)

struct XcdBarrier {
    unsigned* bar; unsigned x;
    volatile LAS unsigned* st;
};

__device__ __forceinline__ XcdBarrier xcd_barrier_post(unsigned* bar, volatile LAS unsigned* st) {
    XcdBarrier b; b.bar = bar; b.x = xb_xcc_id(); b.st = st;
    if (threadIdx.x == 0) (void)xb_add(&bar[XB_XCNT(b.x)], 1u);
    return b;
}
__device__ __forceinline__ void xcd_barrier_complete(unsigned* bar, unsigned x, unsigned& nloc, unsigned& nx) {
    const unsigned G = gridDim.x * gridDim.y * gridDim.z;
    unsigned sum, cnt, mine, sp = 0u;
    for (;;) {
        sum = 0u; cnt = 0u; mine = 0u;
#pragma unroll
        for (unsigned j = 0; j < 16; ++j) { const unsigned c = xb_ld(&bar[XB_XCNT(j)]); sum += c; cnt += (c > 0u) ? 1u : 0u; mine = (j == x) ? c : mine; }
        if (sum == G) break;
        __builtin_amdgcn_s_sleep(1);
        if ((++sp & 255u) == 0u) { if (xb_ld(&bar[XB_TMO])) break; if (sp > XB_SPIN_CAP) { atomicAdd(&bar[XB_TMO], 1u); break; } }
    }
    nloc = mine > 0u ? mine : 1u; nx = cnt > 0u ? cnt : 1u;
}

__device__ __forceinline__ void xcd_barrier(const XcdBarrier& b) {
    asm volatile("s_waitcnt vmcnt(0)" ::: "memory");
    __syncthreads();
    if (threadIdx.x == 0) {
        unsigned* bar = b.bar;
        __builtin_amdgcn_s_waitcnt(0);
        unsigned nloc = b.st[0], nx = b.st[1];
        if (nloc == 0u) { xcd_barrier_complete(bar, b.x, nloc, nx); b.st[0] = nloc; b.st[1] = nx; }
        const unsigned old = xb_add(&bar[XB_XSUB(b.x)], 1u);
        const unsigned gen = old / nloc;
        if (old + 1u == (gen + 1u) * nloc) {
            __builtin_amdgcn_fence(__ATOMIC_RELEASE, "agent");
            asm volatile("s_waitcnt vmcnt(0)" ::: "memory");
            const unsigned og = xb_add(&bar[XB_TOP], 1u);
            const unsigned tg = og / nx;
            if (og + 1u == (tg + 1u) * nx) xb_add(&bar[XB_TOPGEN], 1u);
            else XB_SPIN(xb_ld(&bar[XB_TOPGEN]) == tg, bar);
            __builtin_amdgcn_fence(__ATOMIC_ACQUIRE, "agent");
            xb_add(&bar[XB_XGEN(b.x)], 1u);
            asm volatile("s_waitcnt vmcnt(0)" ::: "memory");
        } else {
            XB_SPIN(xb_ld(&bar[XB_XGEN(b.x)]) == gen, bar);
            __builtin_amdgcn_fence(__ATOMIC_ACQUIRE, "agent");
            asm volatile("s_waitcnt vmcnt(0)" ::: "memory");
        }
    }
    __syncthreads();
}
constexpr int DM = 1024, SEQ = 8192, NBATCH = 2, CTXL = 256;
constexpr int ML = NBATCH * SEQ, MC = NBATCH * CTXL, MT = ML + MC;
constexpr int NIN = 6400;
constexpr int NE = 16, ESTR = 2304, CAPL = 1024, CAPC = 32;
constexpr int NPH = 24;
constexpr size_t MiB = 1u << 20;
constexpr size_t WS_CTL = 0, CTL_ZERO_BYTES = 1 * MiB;
constexpr size_t WS_MOD = 1 * MiB;
constexpr size_t WS_ROPEC = 1 * MiB + 256 * 1024, WS_ROPES = WS_ROPEC + 8192;
constexpr size_t WS_TW = 1 * MiB + 512 * 1024;
constexpr size_t WS_CS256 = 1 * MiB + 640 * 1024;
constexpr size_t WS_T1T = 2 * MiB;
constexpr size_t WS_T2T = 2 * MiB + 64 * 1024;
constexpr size_t WS_T2F = 8 * MiB;
constexpr size_t WS_T2C = 12 * MiB;
constexpr size_t WS_FAC = 13 * MiB;
constexpr size_t WS_WSP = 2 * MiB + 256 * 1024;
constexpr size_t WS_AFF = 3 * MiB;
constexpr size_t WS_SEL = 5 * MiB;
constexpr size_t WS_IDX = 7 * MiB, WS_GATE = 7 * MiB + 256 * 1024;
constexpr size_t WS_WIN = 16 * MiB, WS_WBR = 29 * MiB, WS_WO = 31 * MiB, WS_WGU = 33 * MiB, WS_WDN = 97 * MiB;
constexpr size_t WS_X = 130 * MiB;
constexpr size_t WS_H = 196 * MiB;
constexpr size_t WS_BR = 229 * MiB;
constexpr size_t WS_MB = 262 * MiB;
constexpr size_t WS_FA = 295 * MiB;
constexpr size_t WS_Z = 311 * MiB;
constexpr size_t ZROW = (size_t)MT * 2;
constexpr size_t WS_AUV = WS_Z, WS_YF = WS_AUV + 512 * ZROW, WS_CY = WS_YF + 512 * ZROW, WS_QPL = WS_CY + 256 * ZROW, WS_QROT = WS_QPL + 256 * ZROW,
                 WS_KR = WS_QROT + 256 * ZROW, WS_VV = WS_KR + 256 * ZROW, WS_G = WS_VV + 256 * ZROW, WS_ZEND = WS_G + 4096 * ZROW;
constexpr size_t WS_P32 = WS_Z;
constexpr size_t WS_XE = WS_Z, WS_ACT = WS_Z + 72 * MiB;
constexpr size_t WS_END = 518 * MiB;
static_assert(WS_G == WS_P32 + (size_t)MT * 1024 * 4 + 8 * 256 * ZROW / 8 - 256 * ZROW || true, "");
static_assert(WS_ZEND <= WS_END && WS_ACT + 72 * MiB <= WS_ZEND && WS_P32 + (size_t)MT * 4096 <= WS_VV, "ws map");
constexpr int CW_BAR = 4096;
constexpr int LDS_BYTES = 155648, MISC_OFF = 154624;

struct Args { const float* in[28]; float* out; unsigned char* ws; int ph_lo, ph_hi; };

__device__ __forceinline__ float bflo(unsigned w) { return __uint_as_float(w << 16); }
__device__ __forceinline__ float bfhi(unsigned w) { return __uint_as_float(w & 0xffff0000u); }
__device__ __forceinline__ float sigm(float x) { return __builtin_amdgcn_rcpf(1.f + __expf(-x)); }
__device__ __forceinline__ float wave_sum(float v) {
#pragma unroll
    for (int o = 1; o < 64; o <<= 1) v += __shfl_xor(v, o);
    return v;
}
__device__ __forceinline__ void st4bf(bf16* p, f32x4 v) { uint2 w; w.x = pk2(v[0], v[1]); w.y = pk2(v[2], v[3]); *(uint2*)p = w; }

__device__ __forceinline__ void st8bf(bf16* p, f32x4 a, f32x4 b) { v4u w; w.x = pk2(a[0], a[1]); w.y = pk2(a[2], a[3]); w.z = pk2(b[0], b[1]); w.w = pk2(b[2], b[3]); *(v4u*)p = w; }
using pg8::Unit;
struct EpiIn {
    static constexpr bool PERM = false, AFTER_DRAIN = false, KEEP = false;
    bf16 *AUV, *YF, *CY, *QPL, *QROT, *KR, *VV, *G; const float* ropeC; const float* ropeS;
    __device__ __forceinline__ void operator()(const f32x4 (&acc)[2][2][4][2], const Unit& u, int wr, int wc, int fr, int fq) const {
        const int pn = u.pn, row0 = u.pm * 256 + wr * 64 + fr, cl0 = wc * 32 + 4 * fq;
        const int cp0 = wc * 32 + 8 * fq;
        if (pn < 2) {
#pragma unroll
            for (int ai = 0; ai < 2; ++ai)
#pragma unroll
                for (int m = 0; m < 4; ++m) { const size_t row = row0 + ai * 128 + m * 16;
#pragma unroll
                    for (int bj = 0; bj < 2; ++bj) { f32x4 v[2];
#pragma unroll
                        for (int n = 0; n < 2; ++n)
#pragma unroll
                            for (int j = 0; j < 4; ++j) { const float x = acc[ai][bj][m][n][j]; v[n][j] = x * sigm(1.5957691216f * (x + 0.044715f * x * x * x)); }
                        st8bf(AUV + row * 512 + pn * 256 + bj * 128 + cp0, v[0], v[1]); } }
        } else if (pn < 4) {
#pragma unroll
            for (int ai = 0; ai < 2; ++ai)
#pragma unroll
                for (int m = 0; m < 4; ++m) { const size_t row = row0 + ai * 128 + m * 16;
#pragma unroll
                    for (int bj = 0; bj < 2; ++bj) st8bf(YF + row * 512 + (pn - 2) * 256 + bj * 128 + cp0, acc[ai][bj][m][0], acc[ai][bj][m][1]); }
        } else if (pn < 6) {
#pragma unroll
            for (int ai = 0; ai < 2; ++ai)
#pragma unroll
                for (int m = 0; m < 4; ++m) { const size_t row = row0 + ai * 128 + m * 16; f32x4 v[2];
#pragma unroll
                    for (int n = 0; n < 2; ++n) { const f32x4 a = acc[ai][0][m][n], g = acc[ai][1][m][n];
#pragma unroll
                        for (int j = 0; j < 4; ++j) v[n][j] = a[j] * sigm(g[j]); }
                    st8bf(CY + row * 256 + (pn - 4) * 128 + cp0, v[0], v[1]); }
        } else if (pn < 8) {
            const bool isq = pn == 6; const float scl = isq ? 0.125f : 1.f; const bool latent = u.pm < 64;
#pragma unroll
            for (int ai = 0; ai < 2; ++ai)
#pragma unroll
                for (int m = 0; m < 4; ++m) { const int rowi = row0 + ai * 128 + m * 16; const size_t row = rowi; const int tok = rowi & 8191;
                    const int pos = (wc & 1) ? (tok & 63) : (tok >> 6);
                    f32x4 cs = {1.f, 1.f, 1.f, 1.f}, sn = {0.f, 0.f, 0.f, 0.f};
                    if (latent) { cs = *(const f32x4*)(ropeC + pos * 16 + 4 * fq); sn = *(const f32x4*)(ropeS + pos * 16 + 4 * fq); }
#pragma unroll
                    for (int bj = 0; bj < 2; ++bj) { const f32x4 x1 = acc[ai][bj][m][0] * scl, x2 = acc[ai][bj][m][1] * scl;
                        const f32x4 r1 = x1 * cs - x2 * sn, r2 = x1 * sn + x2 * cs; const size_t off = row * 256 + bj * 128 + cl0;
                        if (isq) { st4bf(QPL + off, x1); st4bf(QPL + off + 16, x2); st4bf(QROT + off, r1); st4bf(QROT + off + 16, r2); }
                        else { st4bf(KR + off, r1); st4bf(KR + off + 16, r2); } } }
        } else if (pn == 8) {
#pragma unroll
            for (int ai = 0; ai < 2; ++ai)
#pragma unroll
                for (int m = 0; m < 4; ++m) { const size_t row = row0 + ai * 128 + m * 16;
#pragma unroll
                    for (int bj = 0; bj < 2; ++bj) st8bf(VV + row * 256 + bj * 128 + cp0, acc[ai][bj][m][0], acc[ai][bj][m][1]); }
        } else {
#pragma unroll
            for (int ai = 0; ai < 2; ++ai)
#pragma unroll
                for (int m = 0; m < 4; ++m) { const size_t row = row0 + ai * 128 + m * 16;
#pragma unroll
                    for (int bj = 0; bj < 2; ++bj)
#pragma unroll
                        for (int n = 0; n < 2; ++n) { f32x4 v = acc[ai][bj][m][n];
#pragma unroll
                            for (int j = 0; j < 4; ++j) v[j] = sigm(v[j]);
                            const int gb_ = (pn - 9) >> 2, gu_ = (2 * u.pm + ai) * 8 + 2 * ((pn - 9) & 3) + bj;
                            st4bf(G + ((((size_t)(gu_ * 4 + gb_) * 8 + (wr * 4 + wc)) * 8 + m * 2 + n) * 256 + (fq * 16 + fr) * 4), v); } }
        }
    }
};
struct EpiMerge {
    static constexpr bool PERM = false, AFTER_DRAIN = false, KEEP = false;
    const bf16* G; float* P32; bf16* MB;
    __device__ __forceinline__ void operator()(const f32x4 (&acc)[2][2][4][2], const Unit& u, int wr, int wc, int fr, int fq) const {
        int fr_ = fr, fq_ = fq; asm volatile("" : "+v"(fr_), "+v"(fq_));
        const int b = u.pn >> 2, pn = u.pn & 3, pm = u.pm - b * 66, row0 = pm * 256 + wr * 64 + fr_, col0 = pn * 256 + wc * 32 + 4 * fq_;
#pragma unroll
        for (int ai = 0; ai < 2; ++ai)
#pragma unroll
            for (int m = 0; m < 4; ++m) { const unsigned row = row0 + ai * 128 + m * 16;
                const bf16* gp = G + ((size_t)row * 4096 + b * 1024 + col0); float* pp = P32 + ((size_t)row * 1024 + col0); bf16* mp = MB + ((size_t)row * 1024 + col0);
#pragma unroll
                for (int bj = 0; bj < 2; ++bj)
#pragma unroll
                    for (int n = 0; n < 2; ++n) { const int co = bj * 128 + n * 16;
                        const uint2 gw = *(const uint2*)(gp + co);
                        f32x4 v = acc[ai][bj][m][n]; v[0] *= bflo(gw.x); v[1] *= bfhi(gw.x); v[2] *= bflo(gw.y); v[3] *= bfhi(gw.y);
                        if (b > 0) v += *(const f32x4*)(pp + co);
                        if (b < 3) *(f32x4*)(pp + co) = v; else st4bf(mp + co, v);
                        asm volatile("" ::: "memory"); } }
    }
};
struct EpiMergeH {
    static constexpr bool PERM = false, AFTER_DRAIN = false, KEEP = true;
    const bf16* G; bf16* MB;
    __device__ __forceinline__ bool keep(const Unit& u) const { return (u.pn >> 2) < 3; }
    __device__ __forceinline__ void operator()(f32x4 (&acc)[2][2][4][2], const Unit& u, int wr, int wc, int fr, int fq) const {
        const int b = u.pn >> 2, pn = u.pn & 3, pm = u.pm - b * 66, row0 = pm * 256 + wr * 64 + fr, col0 = pn * 256 + wc * 32 + 4 * fq;
#pragma unroll
        for (int ai = 0; ai < 2; ++ai)
#pragma unroll
            for (int m = 0; m < 4; ++m) { const unsigned row = row0 + ai * 128 + m * 16; const bf16* gp = G + ((size_t)row * 4096 + b * 1024 + col0); bf16* mp = MB + ((size_t)row * 1024 + col0);
#pragma unroll
                for (int bj = 0; bj < 2; ++bj)
#pragma unroll
                    for (int n = 0; n < 2; ++n) { const int co = bj * 128 + n * 16; const uint2 gb = *(const uint2*)(gp + co); f32x4 v = acc[ai][bj][m][n];
                        if (b < 3) { const uint2 gn = *(const uint2*)(gp + 1024 + co);
                            v[0] *= bflo(gb.x) * __builtin_amdgcn_rcpf(bflo(gn.x)); v[1] *= bfhi(gb.x) * __builtin_amdgcn_rcpf(bfhi(gn.x)); v[2] *= bflo(gb.y) * __builtin_amdgcn_rcpf(bflo(gn.y)); v[3] *= bfhi(gb.y) * __builtin_amdgcn_rcpf(bfhi(gn.y));
                            acc[ai][bj][m][n] = v; }
                        else { v[0] *= bflo(gb.x); v[1] *= bfhi(gb.x); v[2] *= bflo(gb.y); v[3] *= bfhi(gb.y); st4bf(mp + co, v); } }
                asm volatile("" ::: "memory"); }
    }
};
struct EpiWout {
    static constexpr bool PERM = false, AFTER_DRAIN = false, KEEP = false;
    const float* xlat; const float* xctx; float* X; const float* mod;
    __device__ __forceinline__ void operator()(const f32x4 (&acc)[2][2][4][2], const Unit& u, int wr, int wc, int fr, int fq) const {
        const int r = u.pm < 32 ? 0 : (u.pm < 64 ? 1 : 2); const float* gt = mod + r * 6144 + 2 * 1024;
        const int row0 = u.pm * 256 + wr * 64 + fr, col0 = u.pn * 256 + wc * 32 + 4 * fq;
        f32x4 gv[2][2];
#pragma unroll
        for (int bj = 0; bj < 2; ++bj)
#pragma unroll
            for (int n = 0; n < 2; ++n) gv[bj][n] = *(const f32x4*)(gt + col0 + bj * 128 + n * 16);
#pragma unroll
        for (int ai = 0; ai < 2; ++ai)
#pragma unroll
            for (int m = 0; m < 4; ++m) { const size_t row = row0 + ai * 128 + m * 16; const float* src = (row < ML) ? xlat + row * 1024 : xctx + (row - ML) * 1024;
#pragma unroll
                for (int bj = 0; bj < 2; ++bj)
#pragma unroll
                    for (int n = 0; n < 2; ++n) { const int col = col0 + bj * 128 + n * 16;
                        *(f32x4*)(X + row * 1024 + col) = *(const f32x4*)(src + col) + gv[bj][n] * acc[ai][bj][m][n]; } }
    }
};
struct EpiGU {
    static constexpr bool PERM = true, AFTER_DRAIN = false, KEEP = false;
    bf16* ACT;
    __device__ __forceinline__ void operator()(const f32x4 (&acc)[2][2][4][2], const Unit& u, int wr, int wc, int fr, int fq) const {
        const int pnl = u.pn & 7, row0 = u.pm * 256 + wr * 64 + fr, cl0 = wc * 32 + 8 * fq;
#pragma unroll
        for (int ai = 0; ai < 2; ++ai)
#pragma unroll
            for (int m = 0; m < 4; ++m) { const size_t row = row0 + ai * 128 + m * 16; f32x4 v[2];
#pragma unroll
                for (int n = 0; n < 2; ++n) { const f32x4 a = acc[ai][0][m][n], up = acc[ai][1][m][n];
#pragma unroll
                    for (int j = 0; j < 4; ++j) v[n][j] = a[j] * sigm(a[j]) * up[j]; }
                st8bf(ACT + row * 1024 + pnl * 128 + cl0, v[0], v[1]); }
    }
};
struct EpiDown {
    static constexpr bool PERM = true, AFTER_DRAIN = false, KEEP = false;
    bf16* YB; const float* GATE;
    __device__ __forceinline__ void operator()(const f32x4 (&acc)[2][2][4][2], const Unit& u, int wr, int wc, int fr, int fq) const {
        const int pnl = u.pn & 3, row0 = u.pm * 256 + wr * 64 + fr, col0 = pnl * 256 + wc * 32 + 8 * fq;
#pragma unroll
        for (int ai = 0; ai < 2; ++ai)
#pragma unroll
            for (int m = 0; m < 4; ++m) { const size_t row = row0 + ai * 128 + m * 16; const float gt = GATE[row];
#pragma unroll
                for (int bj = 0; bj < 2; ++bj) st8bf(YB + row * 1024 + col0 + bj * 128, acc[ai][bj][m][0] * gt, acc[ai][bj][m][1] * gt); }
    }
};
struct MergeOrder {
    int nt, G, c;
    __device__ void init(int ntm, int G_, int c_) { nt = ntm * 4; G = G_; c = c_; }
    __device__ bool next(int i, Unit& u) const { const int b = i & 3, L = (i >> 2) * G + c; if (L >= nt) return false; u.pm = b * 66 + (L >> 2); u.pn = b * 4 + (L & 3); return true; }
    __device__ __forceinline__ void a_ready(const Unit&) const {}
    __device__ __forceinline__ void done(const Unit&) const {}
};
struct OneUnit { int pm, pn; __device__ bool next(int i, Unit& u) const { if (i > 0) return false; u.pm = pm; u.pn = pn; return true; }
    __device__ __forceinline__ void a_ready(const Unit&) const {} __device__ __forceinline__ void done(const Unit&) const {} };
struct GroupOrder {
    int nwg, G, c, TPE, NTN;
    __device__ void init(int tpe, int ntn, int G_, int c_) { TPE = tpe; NTN = ntn; nwg = NE * tpe * ntn; G = G_; c = c_; }
    __device__ bool next(int i, Unit& u) const {
        const long L = (long)i * G + c; if (L >= nwg) return false;
        int wgid = (int)L; { const int q = nwg / 8, r = nwg % 8, xcd = wgid % 8, off = wgid / 8; wgid = (xcd < r ? xcd * (q + 1) : r * (q + 1) + (xcd - r) * q) + off; }
        const int per = TPE * NTN, e = wgid / per, rem = wgid % per;
#ifdef GO_MT_MAJOR
        const int mt = rem / NTN, pn = rem % NTN;
#else
        const int pn = rem / TPE, mt = rem % TPE;
#endif
        u.pm = e * 9 + mt; u.pn = e * NTN + pn; return true;
    }
    __device__ __forceinline__ void a_ready(const Unit&) const {}
    __device__ __forceinline__ void done(const Unit&) const {}
};
typedef float f2v __attribute__((ext_vector_type(2)));
#define PH_ARGS LAS unsigned char* lds, const int tid, const int lane, const int wave, const int bid, const int G
#define WSP(T, off) ((T*)(PTRV(29, unsigned char) + (off)))
constexpr int PTAB_OFF = MISC_OFF + 512;
__device__ __forceinline__ unsigned long long ptab_ld(LAS unsigned char* lds, int i) {
    typedef unsigned u2v_t __attribute__((ext_vector_type(2)));
    const volatile LAS unsigned* tp = (const volatile LAS unsigned*)(lds + PTAB_OFF + 8 * i); u2v_t v; v[0] = tp[0]; v[1] = tp[1];
    const unsigned lo = __builtin_amdgcn_readfirstlane(v[0]), hi = __builtin_amdgcn_readfirstlane(v[1]);
    return ((unsigned long long)hi << 32) | lo;
}
#define PTRV(i, T) ((T*)(GAS T*)ptab_ld(lds, (i)))
#define INP(i) ((const float*)(GAS const float*)ptab_ld(lds, (i)))

__device__ __forceinline__ void mod_gemv(PH_ARGS) {
    LAS f32x4* red = (LAS f32x4*)lds;
    const float* c = INP(1); const float* cc = INP(3); const float* wm = INP(4); const float* bm = INP(5);
    float* MOD = WSP(float, WS_MOD);
    for (int it = bid; it < 192; it += G) {
        const int l = it / 96, cg = it % 96, kg = tid >> 4, cq = tid & 15;
        f32x4 a0 = {0.f, 0.f, 0.f, 0.f}, a1 = a0, a2 = a0;
        const float* wb = wm + (size_t)l * 1024 * 6144 + cg * 64 + cq * 4;
#pragma unroll 4
        for (int i = 0; i < 32; ++i) { const int k = kg + 32 * i; const f32x4 w = *(const f32x4*)(wb + (size_t)k * 6144);
            const float x0 = c[k], x1 = c[1024 + k], x2 = cc[k];
            a0 += w * (x0 * sigm(x0)); a1 += w * (x1 * sigm(x1)); a2 += w * (x2 * sigm(x2)); }
        red[(kg * 3 + 0) * 16 + cq] = a0; red[(kg * 3 + 1) * 16 + cq] = a1; red[(kg * 3 + 2) * 16 + cq] = a2;
        __syncthreads();
        if (tid < 192) { const int r = tid >> 6, col = tid & 63; float s = 0.f; const LAS float* rf = (const LAS float*)red;
            for (int k2 = 0; k2 < 32; ++k2) s += rf[((k2 * 3 + r) * 16 + (col >> 2)) * 4 + (col & 3)];
            MOD[(l * 3 + r) * 6144 + cg * 64 + col] = s + bm[l * 6144 + cg * 64 + col]; }
        __syncthreads();
    }
}
__device__ __forceinline__ void make_tables(PH_ARGS) {
    const int gt = bid * 512 + tid, GT = G * 512;
    float* RC = WSP(float, WS_ROPEC); float* RS = WSP(float, WS_ROPES);
    bf16* T1 = WSP(bf16, WS_T1T);
    for (int i = gt; i < 2048; i += GT) { const int pos = i >> 4, f = i & 15; const float inv = powf(10000.f, -(float)f / 16.f), ang = (float)pos * inv; RC[i] = cosf(ang); RS[i] = sinf(ang); }
    for (int i = gt; i < 128 * 128; i += GT) { const int col = i >> 7, k = i & 127, ro = col >> 6, k1 = col & 63, n1 = k >> 1, ri = k & 1; float s, c; sincospif((float)((k1 * n1) & 63) / 32.f, &s, &c);
        const float v = ro == 0 ? (ri == 0 ? c : s) : (ri == 0 ? -s : c); T1[i] = (bf16)f2bf(v); }
    bf16* T2F = WSP(bf16, WS_T2F); bf16* T2C = WSP(bf16, WS_T2C);
    for (int i = gt; i < 64 * 128 * 256; i += GT) { const int k1 = i >> 15, k2 = (i >> 8) & 127, k = i & 255, n2 = k >> 1, ri = k & 1; float s, c;
        sincospif((float)((n2 * (k1 + 64 * k2)) & 8191) / 4096.f, &s, &c); T2F[i] = (bf16)f2bf(ri ? s : c); }
    for (int i = gt; i < 2 * 128 * 256; i += GT) { const int k1 = i >> 15, k2 = (i >> 8) & 127, k = i & 255, n2 = k >> 1, ri = k & 1; float s, c;
        sincospif((float)((n2 * (k1 + 2 * k2)) & 255) / 128.f, &s, &c); T2C[i] = (bf16)f2bf(ri ? s : c); }
}
__device__ __forceinline__ void tr_item(const float* W, size_t ldw, int col0, int k0, bf16* dst, int Kd, LAS float* scr, int lane) {
#pragma unroll 8
    for (int i = 0; i < 32; ++i) { const int kk = 2 * i + (lane >> 5); scr[kk * 33 + (lane & 31)] = W[(size_t)(k0 + kk) * ldw + col0 + (lane & 31)]; }
    LDS_WAIT(); asm volatile("" ::: "memory");
    const int c = lane & 7;
#pragma unroll
    for (int j = 0; j < 4; ++j) { const int n = (lane >> 3) + 8 * j; const LAS float* s = scr + (8 * c) * 33 + n;
        v4u o; o.x = pk2(s[0 * 33], s[1 * 33]); o.y = pk2(s[2 * 33], s[3 * 33]); o.z = pk2(s[4 * 33], s[5 * 33]); o.w = pk2(s[6 * 33], s[7 * 33]);
        *(v4u*)(dst + (size_t)n * Kd + k0 + 8 * c) = o; }
    LDS_WAIT(); asm volatile("" ::: "memory");
}
__device__ __forceinline__ int rho32(int c) { return 16 * ((c >> 2) & 1) + 4 * (c >> 3) + (c & 3); }
__device__ __forceinline__ void fold_item16(const float* W  , int f, bf16* WIN, LAS float* scr, const LAS f2v* tab, int lane) {
    const int kb = f >> 2, g = f & 3, k0 = kb * 16;
#pragma unroll
    for (int kk = 0; kk < 16; ++kk) scr[kk * 64 + lane] = W[(size_t)(k0 + kk) * 6144 + 512 + g * 64 + lane];
    LDS_WAIT(); asm volatile("" ::: "memory");
    float ar[16], ai[16];
#pragma unroll
    for (int kk = 0; kk < 16; ++kk) { ar[kk] = 0.f; ai[kk] = 0.f; }
#pragma unroll 4
    for (int c = 0; c < 64; ++c) { const f2v t = tab[(c * lane) & 63];
#pragma unroll
        for (int kk = 0; kk < 16; ++kk) { const float w = scr[kk * 64 + c]; ar[kk] += w * t[0]; ai[kk] -= w * t[1]; } }
    const int L0 = 2 * (g * 64 + lane);
    bf16* d0 = WIN + (size_t)(512 + (L0 & ~31) + rho32(L0 & 31)) * 1024 + k0; bf16* d1 = WIN + (size_t)(512 + (L0 & ~31) + rho32((L0 + 1) & 31)) * 1024 + k0;
    v4u o, p;
    o.x = pk2(ar[0], ar[1]); o.y = pk2(ar[2], ar[3]); o.z = pk2(ar[4], ar[5]); o.w = pk2(ar[6], ar[7]); p.x = pk2(ar[8], ar[9]); p.y = pk2(ar[10], ar[11]); p.z = pk2(ar[12], ar[13]); p.w = pk2(ar[14], ar[15]);
    *(v4u*)d0 = o; *(v4u*)(d0 + 8) = p;
    o.x = pk2(ai[0], ai[1]); o.y = pk2(ai[2], ai[3]); o.z = pk2(ai[4], ai[5]); o.w = pk2(ai[6], ai[7]); p.x = pk2(ai[8], ai[9]); p.y = pk2(ai[10], ai[11]); p.z = pk2(ai[12], ai[13]); p.w = pk2(ai[14], ai[15]);
    *(v4u*)d1 = o; *(v4u*)(d1 + 8) = p;
    LDS_WAIT(); asm volatile("" ::: "memory");
}
template <bool PERMROWS>
__device__ __forceinline__ void tr_item64(const float* W, size_t ldw, int col0, int k0, bf16* dst, int Kd, int lane) {
    const int kq = lane >> 4, n4 = lane & 15; const float* src = W + (size_t)(k0 + kq * 16) * ldw + col0 + n4 * 4;
    f32x4 v[16];
#pragma unroll
    for (int i = 0; i < 16; ++i) v[i] = *(const f32x4*)(src + (size_t)i * ldw);
#pragma unroll
    for (int j = 0; j < 4; ++j) { const int ns = n4 * 4 + j, nd = PERMROWS ? ((ns & 32) + rho32(ns & 31)) : ns; bf16* d = dst + (size_t)nd * Kd + k0 + kq * 16; v4u o, p;
        o.x = pk2(v[0][j], v[1][j]); o.y = pk2(v[2][j], v[3][j]); o.z = pk2(v[4][j], v[5][j]); o.w = pk2(v[6][j], v[7][j]);
        p.x = pk2(v[8][j], v[9][j]); p.y = pk2(v[10][j], v[11][j]); p.z = pk2(v[12][j], v[13][j]); p.w = pk2(v[14][j], v[15][j]);
        *(v4u*)d = o; *(v4u*)(d + 8) = p; }
}
__device__ __forceinline__ void convert_range(PH_ARGS, const int l, const int it_lo, const int it_hi, const int pidx, const int pcount) {
    if (pidx < 0) return;
    LAS float* scr = (LAS float*)(lds + wave * 16384);
    const int gw = pidx * 8 + wave, NGW = pcount * 8;
    bf16* WIN = WSP(bf16, WS_WIN); bf16* WBR = WSP(bf16, WS_WBR); bf16* WO = WSP(bf16, WS_WO); bf16* WGU = WSP(bf16, WS_WGU); bf16* WDN = WSP(bf16, WS_WDN); bf16* WS_ = WSP(bf16, WS_WSP);
    const float* win = INP(8) + (size_t)l * 1024 * 6144;
    LAS f2v* tab = (LAS f2v*)(scr + 2048); { float s_, c_; sincospif((float)lane / 32.f, &s_, &c_); tab[lane] = (f2v){c_, s_}; } LDS_WAIT(); asm volatile("" ::: "memory");
    constexpr int N_FOLD = 256, N_IN = 92 * 16, N_BR = 256, N_WO = 256, N_GU = 8192, N_DN = 4096, N_SP = 64;
    constexpr int NITEMS = N_FOLD + N_IN + N_BR + N_WO + N_GU + N_DN + N_SP;
    for (int it = it_lo + gw; it < it_hi && it < NITEMS; it += NGW) {
        int r = it;
        if (r < N_FOLD) { fold_item16(win, r, WIN, scr, tab, lane); continue; } r -= N_FOLD;
        if (r < N_IN) { const int dbp = r >> 4, kb = r & 15, db = dbp < 8 ? dbp : dbp + 8; int col;
            if (db < 8) col = db * 64;
            else if (db < 24) { const int t = db - 16, tile = t >> 2, sub = t & 3; col = (sub < 2 ? 768 : 1024) + tile * 128 + (sub & 1) * 64; }
            else if (db < 36) col = 1280 + (db - 24) * 64;
            else col = 2048 + (db - 36) * 64;
            if (db < 24 || (db >= 32 && db < 36)) tr_item64<true>(win, 6144, col, kb * 64, WIN + (size_t)db * 64 * 1024, 1024, lane);
            else tr_item64<false>(win, 6144, col, kb * 64, WIN + (size_t)db * 64 * 1024, 1024, lane);
            continue; } r -= N_IN;
        if (r < N_BR) { const int b = r >> 6, q = r & 63, kb = q >> 4, nb = q & 15; const int ii = b == 0 ? 13 : (b == 1 ? 14 : (b == 2 ? 19 : 21));
            tr_item64<false>(INP(ii) + (size_t)l * 256 * 1024, 1024, nb * 64, kb * 64, WBR + (size_t)(b * 1024 + nb * 64) * 256, 256, lane); continue; } r -= N_BR;
        if (r < N_WO) { const int kb = r >> 4, nb = r & 15; tr_item64<false>(INP(22) + (size_t)l * 1024 * 1024, 1024, nb * 64, kb * 64, WO + (size_t)nb * 64 * 1024, 1024, lane); continue; } r -= N_WO;
        if (r < N_GU) { const int e = r >> 9, q = r & 511, db = q >> 4, kb = q & 15, tile = db >> 2, sub = db & 3;
            const float* src = (sub < 2 ? INP(24) : INP(25)) + (size_t)(l * 16 + e) * 1024 * 1024;
            tr_item64<false>(src, 1024, tile * 128 + (sub & 1) * 64, kb * 64, WGU + ((size_t)e * 2048 + db * 64) * 1024, 1024, lane); continue; } r -= N_GU;
        if (r < N_DN) { const int e = r >> 8, q = r & 255, kb = q >> 4, nb = q & 15;
            tr_item64<false>(INP(26) + (size_t)(l * 16 + e) * 1024 * 1024, 1024, nb * 64, kb * 64, WDN + ((size_t)e * 1024 + nb * 64) * 1024, 1024, lane); continue; } r -= N_DN;
        { const float* s = INP(11) + (size_t)l * 65536 + r * 1024 + lane * 16; const f32x4 a = *(const f32x4*)s, b = *(const f32x4*)(s + 4), c = *(const f32x4*)(s + 8), d = *(const f32x4*)(s + 12);
          v4u o, p; o.x = pk2(a[0], a[1]); o.y = pk2(a[2], a[3]); o.z = pk2(b[0], b[1]); o.w = pk2(b[2], b[3]); p.x = pk2(c[0], c[1]); p.y = pk2(c[2], c[3]); p.z = pk2(d[0], d[1]); p.w = pk2(d[2], d[3]);
          *(v4u*)(WS_ + r * 1024 + lane * 16) = o; *(v4u*)(WS_ + r * 1024 + lane * 16 + 8) = p; }
    }
}
constexpr int CV_FOLD0 = 0, CV_IN0 = 256, CV_BR0 = 256 + 92 * 16, CV_WO0 = CV_BR0 + 256, CV_GU0 = CV_WO0 + 256, CV_DN0 = CV_GU0 + 8192, CV_SP0 = CV_DN0 + 4096, CV_END = CV_SP0 + 64;
__device__ __forceinline__ void convert_weights(PH_ARGS, const int l) { convert_range(lds, tid, lane, wave, bid, G, l, 0, CV_END, bid, G); }
__device__ __forceinline__ void load_row(const float* p, int lane, f32x4 (&v)[4]) {
#pragma unroll
    for (int j = 0; j < 4; ++j) v[j] = *(const f32x4*)(p + 4 * lane + 256 * j);
}
__device__ __forceinline__ void modnorm_store(f32x4 (&v)[4], const float* g, const float* sc, const float* sh, bf16* hrow, int lane) {
    float ss = 0.f;
#pragma unroll
    for (int j = 0; j < 4; ++j) ss += (v[j][0] * v[j][0] + v[j][1] * v[j][1]) + (v[j][2] * v[j][2] + v[j][3] * v[j][3]);
    const float rs = 1.0f / sqrtf(wave_sum(ss) * (1.f / 1024.f) + 1e-6f);
#pragma unroll
    for (int j = 0; j < 4; ++j) { const int o = 4 * lane + 256 * j; const f32x4 gg = *(const f32x4*)(g + o), s = *(const f32x4*)(sc + o), b = *(const f32x4*)(sh + o);
        v[j] = v[j] * rs * gg * (s + 1.f) + b; st4bf(hrow + o, v[j]); }
}
__device__ __forceinline__ void modnorm_regs(f32x4 (&v)[4], const f32x4 (&gm)[4], const f32x4 (&sh)[4], bf16* hrow, int lane) {
    float ss = 0.f;
#pragma unroll
    for (int j = 0; j < 4; ++j) ss += (v[j][0] * v[j][0] + v[j][1] * v[j][1]) + (v[j][2] * v[j][2] + v[j][3] * v[j][3]);
    const float rs = 1.0f / sqrtf(wave_sum(ss) * (1.f / 1024.f) + 1e-6f);
#pragma unroll
    for (int j = 0; j < 4; ++j) { v[j] = v[j] * rs * gm[j] + sh[j]; st4bf(hrow + 4 * lane + 256 * j, v[j]); }
}
__device__ __forceinline__ void load_mod(const float* g, const float* sc, const float* shp, int lane, f32x4 (&gm)[4], f32x4 (&sh)[4]) {
#pragma unroll
    for (int j = 0; j < 4; ++j) { const int o = 4 * lane + 256 * j; gm[j] = *(const f32x4*)(g + o) * (*(const f32x4*)(sc + o) + 1.f); sh[j] = *(const f32x4*)(shp + o); }
}
__device__ __forceinline__ void norm1_l0(PH_ARGS) {
    const int gw = bid * 8 + wave, NGW = G * 8; bf16* H = WSP(bf16, WS_H); const float* MOD = WSP(float, WS_MOD);
    const int RPW = (MT + NGW - 1) / NGW, row0 = gw * RPW, rend = (row0 + RPW < MT) ? row0 + RPW : MT;
    const float* xin = INP(0); const float* cin = INP(2); const float* g = INP(6);
    f32x4 cur[4], nxt[4], gm[4], sh[4]; int rprev = -1;
    if (row0 < rend) load_row(row0 < ML ? xin + (size_t)row0 * 1024 : cin + (size_t)(row0 - ML) * 1024, lane, cur);
    for (int row = row0; row < rend; ++row) {
        if (row + 1 < rend) { const int rn = row + 1; load_row(rn < ML ? xin + (size_t)rn * 1024 : cin + (size_t)(rn - ML) * 1024, lane, nxt); }
        const int r = row < SEQ ? 0 : (row < ML ? 1 : 2);
        if (r != rprev) { const float* md = MOD + r * 6144; load_mod(g, md + 1024, md, lane, gm, sh); rprev = r; }
        modnorm_regs(cur, gm, sh, H + (size_t)row * 1024, lane);
#pragma unroll
        for (int j = 0; j < 4; ++j) cur[j] = nxt[j];
    }
}
__device__ __forceinline__ void norm2_router(PH_ARGS, const int l, const int rbase, const int nrows, const int pidx, const int pcount, const bool load_table = true) {
    const int gw = pidx * 8 + wave, NGW = pcount * 8; bf16* H = WSP(bf16, WS_H); const float* MOD = WSP(float, WS_MOD) + l * 3 * 6144; const float* X = WSP(float, WS_X); float* AFF = WSP(float, WS_AFF);
    LAS f32x4* Wl = (LAS f32x4*)lds;
    if (load_table) { const f32x4* wr = (const f32x4*)(INP(23) + (size_t)l * 1024 * 16);
      for (int i = tid; i < 4096; i += 512) { const int k = i >> 2, q = i & 3; Wl[(q * 4 + (k & 3)) * 256 + (k >> 2)] = wr[i]; } }
    __syncthreads();
    const int RPW = (nrows + NGW - 1) / NGW, row0 = rbase + gw * RPW, rend = (gw * RPW + RPW < nrows) ? row0 + RPW : rbase + nrows;
    const float* g2 = INP(7) + l * 1024;
    f32x4 v[4], nxt[4], gm[4], sh[4]; int rprev = -1;
    if (row0 < rend) load_row(X + (size_t)row0 * 1024, lane, v);
    for (int row = row0; row < rend; ++row) {
        if (row + 1 < rend) load_row(X + (size_t)(row + 1) * 1024, lane, nxt);
        const int r = row < SEQ ? 0 : (row < ML ? 1 : 2);
        if (r != rprev) { const float* md = MOD + r * 6144; load_mod(g2, md + 4 * 1024, md + 3 * 1024, lane, gm, sh); rprev = r; }
        modnorm_regs(v, gm, sh, H + (size_t)row * 1024, lane);
        float lg[16];
#pragma unroll
        for (int e = 0; e < 16; ++e) lg[e] = 0.f;
#pragma unroll
        for (int j = 0; j < 4; ++j)
#pragma unroll
            for (int i = 0; i < 4; ++i) { const float hv = v[j][i];
#pragma unroll
                for (int q = 0; q < 4; ++q) { const f32x4 w = Wl[(q * 4 + i) * 256 + 64 * j + lane]; lg[4 * q + 0] += hv * w[0]; lg[4 * q + 1] += hv * w[1]; lg[4 * q + 2] += hv * w[2]; lg[4 * q + 3] += hv * w[3]; }
                if (i & 1) asm volatile("" ::: "memory"); }
#pragma unroll
        for (int i = 0; i < 8; ++i) { const bool up = lane & 32; const float send = up ? lg[i] : lg[i + 8], keep = up ? lg[i + 8] : lg[i]; lg[i] = keep + __shfl_xor(send, 32); }
#pragma unroll
        for (int i = 0; i < 4; ++i) { const bool up = lane & 16; const float send = up ? lg[i] : lg[i + 4], keep = up ? lg[i + 4] : lg[i]; lg[i] = keep + __shfl_xor(send, 16); }
#pragma unroll
        for (int i = 0; i < 2; ++i) { const bool up = lane & 8; const float send = up ? lg[i] : lg[i + 2], keep = up ? lg[i + 2] : lg[i]; lg[i] = keep + __shfl_xor(send, 8); }
        { const bool up = lane & 4; const float send = up ? lg[0] : lg[1], keep = up ? lg[1] : lg[0]; lg[0] = keep + __shfl_xor(send, 4); }
        float z = lg[0]; z += __shfl_xor(z, 1); z += __shfl_xor(z, 2);
        float mx = z; mx = fmaxf(mx, __shfl_xor(mx, 4)); mx = fmaxf(mx, __shfl_xor(mx, 8)); mx = fmaxf(mx, __shfl_xor(mx, 16)); mx = fmaxf(mx, __shfl_xor(mx, 32));
        const float ez = expf(z - mx); float sm = ez; sm += __shfl_xor(sm, 4); sm += __shfl_xor(sm, 8); sm += __shfl_xor(sm, 16); sm += __shfl_xor(sm, 32);
        if ((lane & 3) == 0) { const int e = ((lane >> 5) & 1) * 8 + ((lane >> 4) & 1) * 4 + ((lane >> 3) & 1) * 2 + ((lane >> 2) & 1); AFF[(size_t)row * 16 + e] = ez / sm; }
#pragma unroll
        for (int j = 0; j < 4; ++j) v[j] = nxt[j];
    }
    __syncthreads();
}
typedef short v4i16_t __attribute__((ext_vector_type(4)));
__device__ __forceinline__ void mfma16(f32x4& acc, const bf16x8 a, const bf16x8 b) { asm volatile("s_nop 1\n\tv_mfma_f32_16x16x32_bf16 %0, %1, %2, %0\n\ts_nop 3" : "+v"(acc) : "v"(a), "v"(b)); }
#define DRAIN4(x) asm volatile("s_nop 15\n\ts_nop 15" : "+v"((x)[0]), "+v"((x)[1]), "+v"((x)[2]), "+v"((x)[3]))
#define DRAIN8(x) asm volatile("s_nop 15\n\ts_nop 15" : "+v"((x)[0]), "+v"((x)[1]), "+v"((x)[2]), "+v"((x)[3]), "+v"((x)[4]), "+v"((x)[5]), "+v"((x)[6]), "+v"((x)[7]))
#define DRAIN16(x) asm volatile("s_nop 15\n\ts_nop 15" : "+v"((x)[0]), "+v"((x)[1]), "+v"((x)[2]), "+v"((x)[3]), "+v"((x)[4]), "+v"((x)[5]), "+v"((x)[6]), "+v"((x)[7]), \
    "+v"((x)[8]), "+v"((x)[9]), "+v"((x)[10]), "+v"((x)[11]), "+v"((x)[12]), "+v"((x)[13]), "+v"((x)[14]), "+v"((x)[15]))
__device__ __forceinline__ void gmlp_unit(PH_ARGS, const int l, const int chunk) {
    const int row0 = chunk < 128 ? chunk * 128 : ML + (chunk - 128) * 128;
    const bf16* AUV = WSP(bf16, WS_AUV); bf16* BRa = WSP(bf16, WS_BR); const bf16* WS_ = WSP(bf16, WS_WSP);
    LAS bf16* vT = (LAS bf16*)lds;
    const float* lg = INP(9) + l * 256; const float* lb = INP(10) + l * 256;
    const f32x4 gg = *(const f32x4*)(lg + 4 * lane), bb = *(const f32x4*)(lb + 4 * lane);
    uint2 raws[16];
#pragma unroll
    for (int pi = 0; pi < 16; ++pi) raws[pi] = *(const uint2*)(AUV + (size_t)(row0 + wave * 16 + pi) * 512 + 256 + 4 * lane);
#pragma unroll
    for (int pi = 0; pi < 16; ++pi) { const int p = wave * 16 + pi;
        const uint2 raw = raws[pi];
        float v0 = bflo(raw.x), v1 = bfhi(raw.x), v2 = bflo(raw.y), v3 = bfhi(raw.y);
        const float mean = wave_sum((v0 + v1) + (v2 + v3)) * (1.f / 256.f); v0 -= mean; v1 -= mean; v2 -= mean; v3 -= mean;
        const float rstd = 1.0f / sqrtf(wave_sum((v0 * v0 + v1 * v1) + (v2 * v2 + v3 * v3)) * (1.f / 256.f) + 1e-6f);
        vT[(4 * lane + 0) * 136 + p] = (bf16)f2bf(v0 * rstd * gg[0] + bb[0]); vT[(4 * lane + 1) * 136 + p] = (bf16)f2bf(v1 * rstd * gg[1] + bb[1]);
        vT[(4 * lane + 2) * 136 + p] = (bf16)f2bf(v2 * rstd * gg[2] + bb[2]); vT[(4 * lane + 3) * 136 + p] = (bf16)f2bf(v3 * rstd * gg[3] + bb[3]); }
    __syncthreads();
    const int g = wave >> 1, qh = wave & 1, fr = lane & 15, fq = lane >> 4;
    f32x4 acc[4][4];
#pragma unroll
    for (int a = 0; a < 4; ++a)
#pragma unroll
        for (int b = 0; b < 4; ++b) acc[a][b] = (f32x4){0.f, 0.f, 0.f, 0.f};
    const bf16* Wg = WS_ + g * 16384;
#pragma unroll
    for (int ks = 0; ks < 4; ++ks) { bf16x8 af[4], bf[4];
#pragma unroll
        for (int dt = 0; dt < 4; ++dt) af[dt] = *(const LAS bf16x8*)(vT + (g * 64 + dt * 16 + fr) * 136 + ks * 32 + fq * 8);
#pragma unroll
        for (int qt = 0; qt < 4; ++qt) bf[qt] = *(const bf16x8*)(Wg + (qh * 64 + qt * 16 + fr) * 128 + ks * 32 + fq * 8);
#pragma unroll
        for (int dt = 0; dt < 4; ++dt)
#pragma unroll
            for (int qt = 0; qt < 4; ++qt) mfma16(acc[dt][qt], af[dt], bf[qt]); }
    DRAIN16(&acc[0][0]);
    const float* bs = INP(12) + l * 512 + g * 128;
#pragma unroll
    for (int qt = 0; qt < 4; ++qt) { const int q = qh * 64 + qt * 16 + fr; const float bias = bs[q]; const size_t row = row0 + q;
#pragma unroll
        for (int dt = 0; dt < 4; ++dt) { const int ch = g * 64 + dt * 16 + 4 * fq; const uint2 uw = *(const uint2*)(AUV + row * 512 + ch);
            f32x4 o; o[0] = bflo(uw.x) * (acc[dt][qt][0] + bias); o[1] = bfhi(uw.x) * (acc[dt][qt][1] + bias); o[2] = bflo(uw.y) * (acc[dt][qt][2] + bias); o[3] = bfhi(uw.y) * (acc[dt][qt][3] + bias);
            st4bf(BRa + row * 256 + ch, o); } }
    __syncthreads();
}
__device__ __forceinline__ void conv_unit(PH_ARGS, const int l, const int unit) {
    int rowbase, n0, nlen;
    if (unit < 256) { rowbase = (unit >> 7) * SEQ; n0 = (unit & 127) * 64; nlen = SEQ; } else { const int u2 = unit - 256; rowbase = ML + (u2 >> 2) * CTXL; n0 = (u2 & 3) * 64; nlen = CTXL; }
    const bf16* CY = WSP(bf16, WS_CY); bf16* BRc = WSP(bf16, WS_BR) + (size_t)2 * MT * 256;
    LAS unsigned* yt = (LAS unsigned*)lds;
    LAS float* cres = (LAS float*)(lds + 48128);
    for (int p = tid; p < 94 * 32; p += 512) { const int rr = p >> 5, seg = p & 31, n = n0 - 15 + rr; v4u val = {0u, 0u, 0u, 0u};
        if (n >= 0 && n < nlen) val = *(const v4u*)(CY + (size_t)(rowbase + n) * 256 + seg * 8);
        *(LAS v4u*)(lds + rr * 512 + seg * 16) = val; }
    __syncthreads();
    const int cp = tid & 127, pg = tid >> 7;
    float w0[31], w1[31];
    const float* cw = INP(15) + (size_t)l * 31 * 256 + 2 * cp;
#pragma unroll
    for (int t = 0; t < 31; ++t) { const float2 w = *(const float2*)(cw + t * 256); w0[t] = w.x; w1[t] = w.y; }
    float a0[16], a1[16];
#pragma unroll
    for (int p = 0; p < 16; ++p) { a0[p] = 0.f; a1[p] = 0.f; }
#pragma unroll
    for (int i = 0; i < 46; ++i) { const unsigned raw = yt[(16 * pg + i) * 128 + cp]; const float v0 = bflo(raw), v1 = bfhi(raw);
#pragma unroll
        for (int p = 0; p < 16; ++p) { const int t = i - p; if (t >= 0 && t < 31) { a0[p] += v0 * w0[t]; a1[p] += v1 * w1[t]; } } }
    const float2 cb = *(const float2*)(INP(16) + l * 256 + 2 * cp);
#pragma unroll
    for (int p = 0; p < 16; ++p) *(LAS f2v*)(cres + (16 * pg + p) * 256 + 2 * cp) = (f2v){a0[p] + cb.x, a1[p] + cb.y};
    __syncthreads();
    const f32x4 gg = *(const f32x4*)(INP(17) + l * 256 + 4 * lane), bb = *(const f32x4*)(INP(18) + l * 256 + 4 * lane);
    for (int pi = 0; pi < 8; ++pi) { const int pos = wave * 8 + pi; f32x4 v = *(const LAS f32x4*)(cres + pos * 256 + 4 * lane);
        const float mean = wave_sum((v[0] + v[1]) + (v[2] + v[3])) * (1.f / 256.f); v = v - mean;
        const float rstd = 1.0f / sqrtf(wave_sum((v[0] * v[0] + v[1] * v[1]) + (v[2] * v[2] + v[3] * v[3])) * (1.f / 256.f) + 1e-6f);
        f32x4 o;
#pragma unroll
        for (int j = 0; j < 4; ++j) { const float y = v[j] * rstd * gg[j] + bb[j]; o[j] = y * sigm(y); }
        st4bf(BRc + (size_t)(rowbase + n0 + pos) * 256 + 4 * lane, o); }
    __syncthreads();
}
constexpr int F1_T1L = 0, F1_YL = 34816;
__device__ __forceinline__ void f1_stage_tables(PH_ARGS) {
    const bf16* T1 = WSP(bf16, WS_T1T);
    for (int p = tid; p < 128 * 16; p += 512) { const int r = p >> 4, s = p & 15; *(LAS v4u*)(lds + F1_T1L + r * 272 + s * 16) = *(const v4u*)(T1 + r * 128 + s * 8); }
    __syncthreads();
}
__device__ __forceinline__ void f1_unit(PH_ARGS, const int unit) {
    const int b = unit >> 7, n2 = unit & 127, fr = lane & 15, fq = lane >> 4;
    const bf16* YF = WSP(bf16, WS_YF); bf16* FA = WSP(bf16, WS_FA);
    LAS unsigned* Yl = (LAS unsigned*)(lds + F1_YL);
#pragma unroll
    for (int i = 0; i < 8; ++i) { const int n1 = wave + 8 * i; *(LAS v4u*)(Yl + n1 * 260 + lane * 4) = *(const v4u*)(YF + (size_t)(b * SEQ + 128 * n1 + n2) * 512 + lane * 8); }
    __syncthreads();
    f32x4 acc[2][8];
#pragma unroll
    for (int a = 0; a < 2; ++a)
#pragma unroll
        for (int n = 0; n < 8; ++n) acc[a][n] = (f32x4){0.f, 0.f, 0.f, 0.f};
#pragma unroll
    for (int ks = 0; ks < 4; ++ks) { bf16x8 af[2];
#pragma unroll
        for (int c2 = 0; c2 < 2; ++c2) { const int ch = (2 * wave + c2) * 16 + fr; v4u w;
            w.x = Yl[(16 * ks + 4 * fq + 0) * 260 + ch]; w.y = Yl[(16 * ks + 4 * fq + 1) * 260 + ch]; w.z = Yl[(16 * ks + 4 * fq + 2) * 260 + ch]; w.w = Yl[(16 * ks + 4 * fq + 3) * 260 + ch];
            af[c2] = __builtin_bit_cast(bf16x8, w); }
#pragma unroll
        for (int nt = 0; nt < 8; ++nt) { const bf16x8 bfr = *(const LAS bf16x8*)(lds + F1_T1L + (nt * 16 + fr) * 272 + ks * 64 + fq * 16);
            mfma16(acc[0][nt], af[0], bfr); mfma16(acc[1][nt], af[1], bfr); } }
    DRAIN16(&acc[0][0]);
#pragma unroll
    for (int c2 = 0; c2 < 2; ++c2)
#pragma unroll
        for (int kt = 0; kt < 4; ++kt) { const int k1 = kt * 16 + fr; const f32x4 ar = acc[c2][kt], ai = acc[c2][kt + 4];
            v4u o; o.x = pk2(ar[0], ai[0]); o.y = pk2(ar[1], ai[1]); o.z = pk2(ar[2], ai[2]); o.w = pk2(ar[3], ai[3]);
            *(v4u*)(FA + ((size_t)((b * 64 + k1) * 128 + n2) * 256 + (2 * wave + c2) * 16 + 4 * fq) * 2) = o; }
    __syncthreads();
}
constexpr int F2_T2L = 0, F2_AL = 67584;
__device__ __forceinline__ void f2_unit(PH_ARGS, const int unit) {
    const int fr = lane & 15, fq = lane >> 4; const bool lat = unit < 256;
    int b, k1, chh; const bf16* Asrc; const bf16* Tsrc; size_t orow0; int ostr; float scl;
    if (lat) { b = unit >> 7; k1 = (unit >> 1) & 63; chh = unit & 1; Asrc = WSP(bf16, WS_FA) + (size_t)((b * 64 + k1) * 128) * 512; Tsrc = WSP(bf16, WS_T2F) + (size_t)k1 * 32768; orow0 = (size_t)b * SEQ + k1; ostr = 64; scl = 0.0013810679320049757f; }
    else { const int u2 = unit - 256; b = u2 >> 2; k1 = (u2 >> 1) & 1; chh = u2 & 1; Asrc = WSP(bf16, WS_FAC) + (size_t)((b * 2 + k1) * 128) * 512; Tsrc = WSP(bf16, WS_T2C) + (size_t)k1 * 32768; orow0 = (size_t)ML + b * CTXL + k1; ostr = 2; scl = 1.f / 128.f; }
    bf16* BRb = WSP(bf16, WS_BR) + (size_t)1 * MT * 256;
    LAS unsigned* Al = (LAS unsigned*)(lds + F2_AL);
    for (int p = tid; p < 128 * 32; p += 512) { const int r = p >> 5, s = p & 31; *(LAS v4u*)(lds + F2_T2L + r * 528 + s * 16) = *(const v4u*)(Tsrc + r * 256 + s * 8); }
#pragma unroll
    for (int i = 0; i < 8; ++i) { const int n2 = wave * 16 + 2 * i + (lane >> 5);
        *(LAS v4u*)(Al + n2 * 132 + (lane & 31) * 4) = *(const v4u*)(Asrc + ((size_t)n2 * 256 + chh * 128) * 2 + (lane & 31) * 8); }
    __syncthreads();
    f32x4 acc[8];
#pragma unroll
    for (int n = 0; n < 8; ++n) acc[n] = (f32x4){0.f, 0.f, 0.f, 0.f};
    const int ch = wave * 16 + fr;
#pragma unroll
    for (int ks = 0; ks < 8; ++ks) { v4u w;
        w.x = Al[(16 * ks + 4 * fq + 0) * 132 + ch]; w.y = Al[(16 * ks + 4 * fq + 1) * 132 + ch]; w.z = Al[(16 * ks + 4 * fq + 2) * 132 + ch]; w.w = Al[(16 * ks + 4 * fq + 3) * 132 + ch];
        const bf16x8 af = __builtin_bit_cast(bf16x8, w);
#pragma unroll
        for (int nt = 0; nt < 8; ++nt) { const bf16x8 bfr = *(const LAS bf16x8*)(lds + F2_T2L + (nt * 16 + fr) * 528 + ks * 64 + fq * 16); mfma16(acc[nt], af, bfr); } }
    DRAIN8(acc);
#pragma unroll
    for (int nt = 0; nt < 8; ++nt) { const int k2 = nt * 16 + fr; st4bf(BRb + (orow0 + (size_t)ostr * k2) * 256 + chh * 128 + wave * 16 + 4 * fq, acc[nt] * scl); }
    __syncthreads();
}
__device__ __forceinline__ void ctx_butterfly(PH_ARGS) {
    const unsigned* YF = (const unsigned*)WSP(bf16, WS_YF); unsigned* FAC = (unsigned*)WSP(bf16, WS_FAC);
    for (int i = bid * 512 + tid; i < 2 * 128 * 256; i += G * 512) { const int b = i >> 15, n2 = (i >> 8) & 127, ch = i & 255;
        const unsigned y0 = YF[(size_t)(ML + b * CTXL + n2) * 256 + ch], y1 = YF[(size_t)(ML + b * CTXL + 128 + n2) * 256 + ch];
        const float r0 = bflo(y0), i0 = bfhi(y0), r1 = bflo(y1), i1 = bfhi(y1);
        FAC[(size_t)((b * 2 + 0) * 128 + n2) * 256 + ch] = pk2(r0 + r1, i0 + i1); FAC[(size_t)((b * 2 + 1) * 128 + n2) * 256 + ch] = pk2(r0 - r1, i0 - i1); }
}
constexpr int MG_AL = 0, MG_BL = 67584;
__device__ __forceinline__ void merge_phase(PH_ARGS, const int nunits) {
    const int fr = lane & 15, fq = lane >> 4, wr = wave >> 2, wc = wave & 3;
    const bf16* BR = WSP(bf16, WS_BR); const bf16* WBR = WSP(bf16, WS_WBR); const bf16* GT = WSP(bf16, WS_G); bf16* MB = WSP(bf16, WS_MB);
    int nmine = 0; for (int u = bid; u < nunits; u += G) ++nmine;
    const int nsteps = nmine * 4;
    if (nsteps == 0) return;
    v4u pa[8], pb[8];
#define MG_LOAD(s) do { const int u_ = bid + ((s) >> 2) * G, b_ = (s) & 3, rt_ = u_ >> 3, ct_ = u_ & 7; \
        const bf16* As = BR + ((size_t)b_ * MT + (size_t)rt_ * 128) * 256; const bf16* Bs = WBR + ((size_t)b_ * 1024 + (size_t)ct_ * 128) * 256; \
        _Pragma("unroll") for (int i = 0; i < 8; ++i) { const int p = i * 512 + tid, r = p >> 5, seg = p & 31; pa[i] = *(const v4u*)(As + (size_t)r * 256 + seg * 8); pb[i] = *(const v4u*)(Bs + (size_t)r * 256 + seg * 8); } } while (0)
#define MG_WRITE() do { _Pragma("unroll") for (int i = 0; i < 8; ++i) { const int p = i * 512 + tid, r = p >> 5, seg = p & 31; \
        *(LAS v4u*)(lds + MG_AL + r * 528 + seg * 16) = pa[i]; *(LAS v4u*)(lds + MG_BL + r * 528 + seg * 16) = pb[i]; } } while (0)
    MG_LOAD(0); MG_WRITE();
    f32x4 macc[4][2];
#pragma unroll
    for (int a = 0; a < 4; ++a)
#pragma unroll
        for (int n = 0; n < 2; ++n) macc[a][n] = (f32x4){0.f, 0.f, 0.f, 0.f};
#pragma unroll 1
    for (int s = 0; s < nsteps; ++s) {
        const int u = bid + (s >> 2) * G, b = s & 3, rt = u >> 3, ct = u & 7;
        __syncthreads();
        if (s + 1 < nsteps) MG_LOAD(s + 1);
        uint2 gw[4][2];
#pragma unroll
        for (int mt = 0; mt < 4; ++mt)
#pragma unroll
            for (int nt = 0; nt < 2; ++nt) gw[mt][nt] = *(const uint2*)(GT + ((((size_t)(u * 4 + b) * 8 + wave) * 8 + mt * 2 + nt) * 256 + lane * 4));
        f32x4 acc[4][2];
#pragma unroll
        for (int a = 0; a < 4; ++a)
#pragma unroll
            for (int n = 0; n < 2; ++n) acc[a][n] = (f32x4){0.f, 0.f, 0.f, 0.f};
#pragma unroll
        for (int ks = 0; ks < 8; ++ks) { bf16x8 af[4], bfr[2];
#pragma unroll
            for (int mt = 0; mt < 4; ++mt) af[mt] = *(const LAS bf16x8*)(lds + MG_AL + (wr * 64 + mt * 16 + fr) * 528 + ks * 64 + fq * 16);
#pragma unroll
            for (int nt = 0; nt < 2; ++nt) bfr[nt] = *(const LAS bf16x8*)(lds + MG_BL + (wc * 32 + nt * 16 + fr) * 528 + ks * 64 + fq * 16);
#pragma unroll
            for (int mt = 0; mt < 4; ++mt)
#pragma unroll
                for (int nt = 0; nt < 2; ++nt) mfma16(acc[mt][nt], bfr[nt], af[mt]); }
        DRAIN8(&acc[0][0]);
#pragma unroll
        for (int mt = 0; mt < 4; ++mt)
#pragma unroll
            for (int nt = 0; nt < 2; ++nt) { const uint2 g = gw[mt][nt]; macc[mt][nt][0] += bflo(g.x) * acc[mt][nt][0]; macc[mt][nt][1] += bfhi(g.x) * acc[mt][nt][1]; macc[mt][nt][2] += bflo(g.y) * acc[mt][nt][2]; macc[mt][nt][3] += bfhi(g.y) * acc[mt][nt][3]; }
        __syncthreads();
        if (s + 1 < nsteps) MG_WRITE();
        if (b == 3) {
#pragma unroll
            for (int mt = 0; mt < 4; ++mt)
#pragma unroll
                for (int nt = 0; nt < 2; ++nt) { st4bf(MB + (size_t)(rt * 128 + wr * 64 + mt * 16 + fr) * 1024 + ct * 128 + wc * 32 + nt * 16 + 4 * fq, macc[mt][nt]); macc[mt][nt] = (f32x4){0.f, 0.f, 0.f, 0.f}; }
        }
    }
    __syncthreads();
#undef MG_LOAD
#undef MG_WRITE
}
constexpr int AT_RPB = 32768, AT_MRG = 40960;
__device__ __forceinline__ int clampi(int v, int lo, int hi) { return v < lo ? lo : (v > hi ? hi : v); }
__device__ __forceinline__ bool at_need(int kind, int jb, int t) { return kind == 2 || (kind == 0 ? (jb < 2 || (jb == 2 && t == 1)) : (jb > 1 || (jb == 1 && t == 0))); }
struct AtCtx { const bf16* QPL; const bf16* KR; const bf16* VV; LAS unsigned char* vbuf; const LAS float* rpbl; int h, qh, fr, fq, lane, b, r, kr0, qrow0, nch, nwin; bool lat; unsigned code[2][2][2]; };
__device__ __forceinline__ unsigned at_keyrow(const AtCtx& X, int ci) { return (ci < X.nwin) ? ((unsigned)X.b * SEQ + (unsigned)(X.kr0 + (ci >> 1)) * 64 + 32 * (ci & 1)) : ((unsigned)ML + X.b * CTXL + 32 * (ci - X.nwin)); }
__device__ __forceinline__ void at_load(const AtCtx& X, int ci, bf16x8 (&kf)[2][2], v4u (&vst)[4]) {
    const unsigned kr = at_keyrow(X, ci);
#pragma unroll
    for (int t = 0; t < 2; ++t)
#pragma unroll
        for (int ks = 0; ks < 2; ++ks) kf[t][ks] = *(const bf16x8*)(X.KR + (unsigned)((kr + 16 * t + X.fr) * 256 + X.h * 64 + ks * 32 + X.fq * 8));
#pragma unroll
    for (int i = 0; i < 4; ++i) { const int p = i * 64 + X.lane, key = p >> 3, seg = p & 7; vst[i] = *(const v4u*)(X.VV + (unsigned)((kr + key) * 256 + X.h * 64 + seg * 8)); }
}
__device__ __forceinline__ void at_chunk(const AtCtx& X, const int ci, bf16x8 (&kf)[2][2], v4u (&vst)[4], bf16x8 (&qf)[2][2], f32x4 (&O)[2][4], float (&m)[2], float (&l)[2]) {
    const int kind = ci < X.nwin ? (ci & 1) : 2, fr = X.fr, fq = X.fq, qh = X.qh;
    if (X.lat && ci == 16) {
#pragma unroll
        for (int j = 0; j < 2; ++j)
#pragma unroll
            for (int ks = 0; ks < 2; ++ks) qf[j][ks] = *(const bf16x8*)(X.QPL + (unsigned)((X.qrow0 + 16 * (2 * qh + j) + fr) * 256 + X.h * 64 + ks * 32 + fq * 8));
        asm volatile("" : "+v"(qf[0][0]), "+v"(qf[0][1]), "+v"(qf[1][0]), "+v"(qf[1][1])); }
#pragma unroll
    for (int i = 0; i < 4; ++i) { const int p = i * 64 + X.lane, key = p >> 3, seg = p & 7; *(LAS v4u*)(X.vbuf + key * 128 + ((((seg >> 1) ^ ((key >> 1) & 3))) << 5) + ((seg & 1) << 4)) = vst[i]; }
    f32x4 S[2][2];
#pragma unroll
    for (int j = 0; j < 2; ++j)
#pragma unroll
        for (int t = 0; t < 2; ++t) { S[j][t] = (f32x4){0.f, 0.f, 0.f, 0.f}; mfma16(S[j][t], kf[t][0], qf[j][0]); mfma16(S[j][t], kf[t][1], qf[j][1]); }
    asm volatile("s_nop 15\n\ts_nop 15" : "+v"(S[0][0]), "+v"(S[0][1]), "+v"(S[1][0]), "+v"(S[1][1]));
#ifdef ATT_X1
    if (ci + 3 < X.nch) { at_load(X, ci + 3, kf, vst); asm volatile("" : "+v"(kf[0][0]), "+v"(kf[0][1]), "+v"(kf[1][0]), "+v"(kf[1][1]), "+v"(vst[0]), "+v"(vst[1]), "+v"(vst[2]), "+v"(vst[3])); }
#endif
    if (ci + 3 < X.nch) at_load(X, ci + 3, kf, vst);
    const LAS float* rpbrow = X.rpbl + (kind != 2 ? (X.kr0 + (ci >> 1) - X.r + 7) * 31 : 0);
    if (kind != 2) {
        float bv[2][2][4]; unsigned cw[2][2];
#pragma unroll
        for (int j = 0; j < 2; ++j)
#pragma unroll
            for (int t = 0; t < 2; ++t) { cw[j][t] = kind == 0 ? X.code[0][j][t] : X.code[1][j][t];
#pragma unroll
                for (int rg = 0; rg < 4; ++rg) bv[j][t][rg] = rpbrow[(cw[j][t] >> (8 * rg)) & 31u]; }
#pragma unroll
        for (int j = 0; j < 2; ++j)
#pragma unroll
            for (int t = 0; t < 2; ++t)
#pragma unroll
                for (int rg = 0; rg < 4; ++rg) S[j][t][rg] = ((cw[j][t] >> (8 * rg)) & 255u) < 32u ? S[j][t][rg] + bv[j][t][rg] : -1.0e30f;
    }
    bf16x8 pf[2];
#pragma unroll
    for (int j = 0; j < 2; ++j) {
        float mc = -3.0e38f;
#pragma unroll
        for (int t = 0; t < 2; ++t)
#pragma unroll
            for (int rg = 0; rg < 4; ++rg) { float s = S[j][t][rg];

                S[j][t][rg] = s; mc = fmaxf(mc, s); }
        { auto r16 = __builtin_amdgcn_permlane16_swap(__float_as_uint(mc), __float_as_uint(mc), false, false); mc = fmaxf(__uint_as_float(r16[0]), __uint_as_float(r16[1]));
          auto r32 = __builtin_amdgcn_permlane32_swap(__float_as_uint(mc), __float_as_uint(mc), false, false); mc = fmaxf(__uint_as_float(r32[0]), __uint_as_float(r32[1])); }
        const float mnew = fmaxf(m[j], mc), alpha = __expf(m[j] - mnew); m[j] = mnew; float ls = 0.f;
#pragma unroll
        for (int t = 0; t < 2; ++t)
#pragma unroll
            for (int rg = 0; rg < 4; ++rg) { const float sv = S[j][t][rg]; const float p = sv > -1.0e29f ? __expf(sv - mnew) : 0.f; S[j][t][rg] = p; ls += p; }
        l[j] = l[j] * alpha + ls;
        if (__any(alpha != 1.f)) {
#pragma unroll
            for (int dt = 0; dt < 4; ++dt) O[j][dt] = O[j][dt] * alpha; }
        v4u pw; pw.x = pk2(S[j][0][0], S[j][0][1]); pw.y = pk2(S[j][0][2], S[j][0][3]); pw.z = pk2(S[j][1][0], S[j][1][1]); pw.w = pk2(S[j][1][2], S[j][1][3]);
        pf[j] = __builtin_bit_cast(bf16x8, pw); }
#pragma unroll
    for (int dt = 0; dt < 4; ++dt) { v4i16_t t0, t1;
        { const int key = 4 * fq + (fr >> 2); t0 = __builtin_amdgcn_ds_read_tr16_b64_v4i16((LAS v4i16_t*)(X.vbuf + key * 128 + ((dt ^ ((key >> 1) & 3)) << 5) + (fr & 3) * 8)); }
        { const int key = 16 + 4 * fq + (fr >> 2); t1 = __builtin_amdgcn_ds_read_tr16_b64_v4i16((LAS v4i16_t*)(X.vbuf + key * 128 + ((dt ^ ((key >> 1) & 3)) << 5) + (fr & 3) * 8)); }
        const bf16x8 vf = (bf16x8){t0[0], t0[1], t0[2], t0[3], t1[0], t1[1], t1[2], t1[3]};
        mfma16(O[0][dt], vf, pf[0]); mfma16(O[1][dt], vf, pf[1]); }
    asm volatile("s_nop 15\n\ts_nop 7" : "+v"(O[0][0]), "+v"(O[0][1]), "+v"(O[0][2]), "+v"(O[0][3]), "+v"(O[1][0]), "+v"(O[1][1]), "+v"(O[1][2]), "+v"(O[1][3]));
}
__device__ __forceinline__ void attn_unit(PH_ARGS, const int unit) {
    AtCtx X; X.h = wave >> 1; X.qh = wave & 1; X.fr = lane & 15; X.fq = lane >> 4; X.lane = lane;
    X.lat = unit < 256; X.r = 0; X.kr0 = 0;
    if (X.lat) { X.b = unit >> 7; X.r = unit & 127; X.qrow0 = X.b * SEQ + X.r * 64; X.kr0 = clampi(X.r - 4, 0, 120); }
    else { const int u2 = unit - 256; X.b = u2 >> 2; X.qrow0 = ML + X.b * CTXL + (u2 & 3) * 64; }
    X.QPL = WSP(bf16, WS_QPL); const bf16* QROT = WSP(bf16, WS_QROT); X.KR = WSP(bf16, WS_KR); X.VV = WSP(bf16, WS_VV);
    bf16* BRd = WSP(bf16, WS_BR) + (size_t)3 * MT * 256;
    X.vbuf = lds + wave * 4096; X.rpbl = (const LAS float*)(lds + AT_RPB) + X.h * 465;
    X.nch = X.lat ? 24 : 8; X.nwin = X.lat ? 16 : 0;
#pragma unroll
    for (int kd = 0; kd < 2; ++kd)
#pragma unroll
        for (int j = 0; j < 2; ++j)
#pragma unroll
            for (int t = 0; t < 2; ++t) { unsigned cw = 0u; const int jb = 2 * X.qh + j;
#pragma unroll
                for (int rg = 0; rg < 4; ++rg) { const int kcol = 32 * kd + 16 * t + 4 * X.fq + rg, qcol = 16 * jb + X.fr, cst = clampi(qcol - 8, 0, 48); const bool ok = at_need(kd, jb, t) && kcol >= cst && kcol < cst + 16;
                    cw |= (ok ? (unsigned)(clampi(kcol - qcol, -15, 15) + 15) : 255u) << (8 * rg); }
                X.code[kd][j][t] = cw; }
    float m[2], l[2]; f32x4 O[2][4];
#pragma unroll
    for (int j = 0; j < 2; ++j) { m[j] = -3.0e38f; l[j] = 0.f;
#pragma unroll
        for (int dt = 0; dt < 4; ++dt) O[j][dt] = (f32x4){0.f, 0.f, 0.f, 0.f}; }
    bf16x8 qf[2][2];
    { const bf16* Qs = X.lat ? QROT : X.QPL;
#pragma unroll
      for (int j = 0; j < 2; ++j)
#pragma unroll
          for (int ks = 0; ks < 2; ++ks) qf[j][ks] = *(const bf16x8*)(Qs + (unsigned)((X.qrow0 + 16 * (2 * X.qh + j) + X.fr) * 256 + X.h * 64 + ks * 32 + X.fq * 8));
      asm volatile("" : "+v"(qf[0][0]), "+v"(qf[0][1]), "+v"(qf[1][0]), "+v"(qf[1][1])); }
    bf16x8 kA[2][2], kB[2][2], kC[2][2]; v4u vA[4], vB[4], vC[4];
    at_load(X, 0, kA, vA); at_load(X, 1, kB, vB); at_load(X, 2, kC, vC);
#pragma unroll 1
    for (int ci = 0; ci < X.nch; ci += 3) {
        at_chunk(X, ci, kA, vA, qf, O, m, l);
        if (ci + 1 < X.nch) at_chunk(X, ci + 1, kB, vB, qf, O, m, l);
        if (ci + 2 < X.nch) at_chunk(X, ci + 2, kC, vC, qf, O, m, l);
    }
#pragma unroll
    for (int j = 0; j < 2; ++j) { l[j] += __shfl_xor(l[j], 16); l[j] += __shfl_xor(l[j], 32); const float inv = 1.f / l[j];
#pragma unroll
        for (int dt = 0; dt < 4; ++dt) st4bf(BRd + (unsigned)((X.qrow0 + 16 * (2 * X.qh + j) + X.fr) * 256 + X.h * 64 + dt * 16 + 4 * X.fq), O[j][dt] * inv); }
}
#ifndef CDFT_REP
#define CDFT_REP 1
#endif
#ifndef CONV_REP
#define CONV_REP 1
#endif
#ifndef GMLP_REP
#define GMLP_REP 1
#endif
#ifndef F1_REP
#define F1_REP 1
#endif
__device__ __forceinline__ int block_excl_scan(int v, LAS int* ws8, int lane, int wave) {
    int x = v;
#pragma unroll
    for (int o = 1; o < 64; o <<= 1) { const int y = __shfl_up(x, o); if (lane >= o) x += y; }
    if (lane == 63) ws8[wave] = x;
    __syncthreads();
    int base = 0;
#pragma unroll
    for (int w = 0; w < 8; ++w) base += (w < wave) ? ws8[w] : 0;
    __syncthreads();
    return base + x - v;
}
__device__ __forceinline__ unsigned akey(float a) { const float s = a * 4294967296.f; return s >= 4294967040.f ? 0xFFFFFF00u : (unsigned)s; }
__device__ __forceinline__ float akey_inv(unsigned k) { return (float)k * (1.f / 4294967296.f); }
template <int PER, bool ALLV>
__device__ __forceinline__ void topk_unit(PH_ARGS, const int rowbase, const int n, const int C, const int e, const int sbase, const bool writepad) {
    const float* AFF = WSP(float, WS_AFF); int* SEL = WSP(int, WS_SEL); int* IDX = WSP(int, WS_IDX); float* GATE = WSP(float, WS_GATE);
    LAS unsigned* hist = (LAS unsigned*)lds; LAS unsigned* sh = hist + 256; LAS int* ws8 = (LAS int*)(hist + 272); LAS unsigned* hw = hist + 512 + wave * 256;
    unsigned key[PER]; bool valid[PER];
#pragma unroll
    for (int i = 0; i < PER; ++i) { const int tok = tid * PER + i; valid[i] = ALLV ? true : (tok < n); key[i] = valid[i] ? akey(AFF[(size_t)(rowbase + tok) * 16 + e]) : 0u; }
    unsigned prefix = 0u, mask = 0u, rem = (unsigned)C;
#pragma unroll 1
    for (int pass = 0; pass < 4; ++pass) { const int shift = 24 - 8 * pass;
        for (int i = lane; i < 256; i += 64) hw[i] = 0u;
        LDS_WAIT();
#pragma unroll
        for (int i = 0; i < PER; ++i) if (valid[i] && (key[i] & mask) == prefix) atomicAdd((unsigned*)&hw[(key[i] >> shift) & 255u], 1u);
        __syncthreads();
        if (tid < 256) { unsigned s_ = 0u;
#pragma unroll
            for (int w = 0; w < 8; ++w) s_ += hist[512 + w * 256 + tid];
            hist[tid] = s_; }
        __syncthreads();
        if (wave == 0) { unsigned c0 = hist[255 - 4 * lane], c1 = hist[254 - 4 * lane], c2 = hist[253 - 4 * lane], c3 = hist[252 - 4 * lane];
            const unsigned s = c0 + c1 + c2 + c3; unsigned x = s;
#pragma unroll
            for (int o = 1; o < 64; o <<= 1) { const unsigned y = __shfl_up(x, o); if (lane >= o) x += y; }
            const unsigned excl = x - s;
            if (excl < rem && rem <= x) { unsigned cum = excl; int bin; unsigned nr;
                if (cum + c0 >= rem) { bin = 255 - 4 * lane; nr = rem - cum; }
                else { cum += c0; if (cum + c1 >= rem) { bin = 254 - 4 * lane; nr = rem - cum; }
                else { cum += c1; if (cum + c2 >= rem) { bin = 253 - 4 * lane; nr = rem - cum; }
                else { cum += c2; bin = 252 - 4 * lane; nr = rem - cum; } } }
                sh[0] = (unsigned)bin; sh[1] = nr; } }
        __syncthreads();
        prefix |= sh[0] << shift; mask |= 255u << shift; rem = sh[1];
    }
    __syncthreads();
    const unsigned T = prefix;
    int neq = 0;
#pragma unroll
    for (int i = 0; i < PER; ++i) neq += (valid[i] && key[i] == T) ? 1 : 0;
    const int eqbase = block_excl_scan(neq, ws8, lane, wave);
    unsigned take = 0u; int nsel = 0, eqs = 0;
#pragma unroll
    for (int i = 0; i < PER; ++i) { const bool iseq = valid[i] && key[i] == T; const bool tk = valid[i] && (key[i] > T || (iseq && (unsigned)(eqbase + eqs) < rem)); eqs += iseq ? 1 : 0; if (tk) { take |= 1u << i; ++nsel; } }
    const int sb = block_excl_scan(nsel, ws8, lane, wave);
    int cnt = 0;
#pragma unroll
    for (int i = 0; i < PER; ++i) { const int tok = tid * PER + i;
        if (valid[i]) { if ((take >> i) & 1u) { const int slot = sbase + sb + cnt; ++cnt; IDX[e * ESTR + slot] = rowbase + tok; GATE[e * ESTR + slot] = akey_inv(key[i]); SEL[(size_t)(rowbase + tok) * 16 + e] = slot; }
                        else SEL[(size_t)(rowbase + tok) * 16 + e] = -1; } }
    if (writepad) for (int i = tid; i < ESTR - 2112; i += 512) { IDX[e * ESTR + 2112 + i] = 0; GATE[e * ESTR + 2112 + i] = 0.f; }
    __syncthreads();
}
__device__ __forceinline__ void gather_rows(PH_ARGS, const int tpe) {
    const int gw = bid * 8 + wave, NGW = G * 8, per = tpe * 256; const int* IDX = WSP(int, WS_IDX); const bf16* H = WSP(bf16, WS_H); bf16* XE = WSP(bf16, WS_XE);
    for (int i = gw; i < NE * per; i += NGW) { const int e = i / per, s = i % per, rg = e * ESTR + s; const int src = IDX[rg];
        const v4u a = *(const v4u*)(H + (size_t)src * 1024 + lane * 8), b = *(const v4u*)(H + (size_t)src * 1024 + 512 + lane * 8);
        *(v4u*)(XE + (size_t)rg * 1024 + lane * 8) = a; *(v4u*)(XE + (size_t)rg * 1024 + 512 + lane * 8) = b; }
}
struct CRow { v4u yw[4][2]; f32x4 xin[2][2]; float wgt[4]; unsigned long long bm; int cur; };
struct CCtx { const int* SEL; const bf16* YB; const float* X; bf16* H; const float* MOD; float* XO; float* OUT; const float* gnext; int l, lane; };
__device__ __forceinline__ void cr_issue(const CCtx& C, CRow& R, const int row) {
    const int lane = C.lane;
    R.cur = lane < 16 ? C.SEL[(size_t)row * 16 + lane] : -1;
    R.bm = __ballot(R.cur >= 0); const int cnt = __popcll(R.bm);
#pragma unroll
    for (int k = 0; k < 4; ++k) { const bool has = cnt > k; const int e = has ? (int)__builtin_ctzll(R.bm) : 0; if (has) R.bm &= R.bm - 1; const int s = __shfl(R.cur, e); R.wgt[k] = has ? 1.f : 0.f;
        const bf16* y = C.YB + (size_t)(has ? e * ESTR + s : 0) * 1024 + lane * 8; R.yw[k][0] = *(const v4u*)y; R.yw[k][1] = *(const v4u*)(y + 512); }
    const float* xr = C.X + (size_t)row * 1024;
#pragma unroll
    for (int j = 0; j < 2; ++j) { const int o = 8 * lane + 512 * j; R.xin[j][0] = *(const f32x4*)(xr + o); R.xin[j][1] = *(const f32x4*)(xr + o + 4); }
}
__device__ __forceinline__ void cr_finish(const CCtx& C, CRow& R, const int row) {
    const int lane = C.lane, l = C.l; const int r = row < SEQ ? 0 : (row < ML ? 1 : 2);
    float acc[2][8];
#pragma unroll
    for (int j = 0; j < 2; ++j)
#pragma unroll
        for (int i = 0; i < 8; ++i) acc[j][i] = 0.f;
#pragma unroll
    for (int k = 0; k < 4; ++k)
#pragma unroll
        for (int j = 0; j < 2; ++j) { const v4u w = R.yw[k][j]; const float g = R.wgt[k];
            acc[j][0] += g * bflo(w.x); acc[j][1] += g * bfhi(w.x); acc[j][2] += g * bflo(w.y); acc[j][3] += g * bfhi(w.y); acc[j][4] += g * bflo(w.z); acc[j][5] += g * bfhi(w.z); acc[j][6] += g * bflo(w.w); acc[j][7] += g * bfhi(w.w); }
    while (R.bm) { const int e = (int)__builtin_ctzll(R.bm); R.bm &= R.bm - 1; const int s = __shfl(R.cur, e); const bf16* y = C.YB + (size_t)(e * ESTR + s) * 1024 + lane * 8;
#pragma unroll
        for (int j = 0; j < 2; ++j) { const v4u w = *(const v4u*)(y + 512 * j);
            acc[j][0] += bflo(w.x); acc[j][1] += bfhi(w.x); acc[j][2] += bflo(w.y); acc[j][3] += bfhi(w.y); acc[j][4] += bflo(w.z); acc[j][5] += bfhi(w.z); acc[j][6] += bflo(w.w); acc[j][7] += bfhi(w.w); } }
    const float* gt2 = C.MOD + (l * 3 + r) * 6144 + 5 * 1024;
    float xv[2][8]; float ss = 0.f;
#pragma unroll
    for (int j = 0; j < 2; ++j) { const int o = 8 * lane + 512 * j; const f32x4 g0 = *(const f32x4*)(gt2 + o), g1 = *(const f32x4*)(gt2 + o + 4);
#pragma unroll
        for (int i = 0; i < 4; ++i) { xv[j][i] = R.xin[j][0][i] + g0[i] * acc[j][i]; xv[j][4 + i] = R.xin[j][1][i] + g1[i] * acc[j][4 + i]; }
#pragma unroll
        for (int i = 0; i < 8; ++i) ss += xv[j][i] * xv[j][i]; }
    const float rs = 1.0f / sqrtf(wave_sum(ss) * (1.f / 1024.f) + 1e-6f);
    if (l == 0) {
        const float* md = C.MOD + (1 * 3 + r) * 6144; float* xw = C.XO + (size_t)row * 1024;
#pragma unroll
        for (int j = 0; j < 2; ++j) { const int o = 8 * lane + 512 * j;
            *(f32x4*)(xw + o) = (f32x4){xv[j][0], xv[j][1], xv[j][2], xv[j][3]}; *(f32x4*)(xw + o + 4) = (f32x4){xv[j][4], xv[j][5], xv[j][6], xv[j][7]};
            const f32x4 g0 = *(const f32x4*)(C.gnext + o), g1 = *(const f32x4*)(C.gnext + o + 4), c0 = *(const f32x4*)(md + 1024 + o), c1 = *(const f32x4*)(md + 1024 + o + 4), h0 = *(const f32x4*)(md + o), h1 = *(const f32x4*)(md + o + 4);
            float hv[8];
#pragma unroll
            for (int i = 0; i < 4; ++i) { hv[i] = xv[j][i] * rs * g0[i] * (1.f + c0[i]) + h0[i]; hv[4 + i] = xv[j][4 + i] * rs * g1[i] * (1.f + c1[i]) + h1[i]; }
            v4u w; w.x = pk2(hv[0], hv[1]); w.y = pk2(hv[2], hv[3]); w.z = pk2(hv[4], hv[5]); w.w = pk2(hv[6], hv[7]);
            *(v4u*)(C.H + (size_t)row * 1024 + o) = w; }
    } else {
        float* orow = C.OUT + (size_t)row * 1024;
#pragma unroll
        for (int j = 0; j < 2; ++j) { const int o = 8 * lane + 512 * j; const f32x4 g0 = *(const f32x4*)(C.gnext + o), g1 = *(const f32x4*)(C.gnext + o + 4);
            *(f32x4*)(orow + o) = (f32x4){xv[j][0] * rs * g0[0], xv[j][1] * rs * g0[1], xv[j][2] * rs * g0[2], xv[j][3] * rs * g0[3]};
            *(f32x4*)(orow + o + 4) = (f32x4){xv[j][4] * rs * g1[0], xv[j][5] * rs * g1[1], xv[j][6] * rs * g1[2], xv[j][7] * rs * g1[3]}; }
    }
}
template <bool DUMMY>
__device__ __forceinline__ void combine_rows(PH_ARGS, const int l) {
    const int gw = bid * 8 + wave, NGW = G * 8; const int nrows = l == 0 ? MT : ML;
    CCtx C; C.SEL = WSP(int, WS_SEL); C.YB = WSP(bf16, WS_XE); C.X = WSP(float, WS_X); C.H = DUMMY ? WSP(bf16, WS_BR) : WSP(bf16, WS_H); C.MOD = WSP(float, WS_MOD);
    C.XO = DUMMY ? WSP(float, WS_ACT) : WSP(float, WS_X); C.OUT = DUMMY ? WSP(float, WS_ACT) : PTRV(28, float); C.gnext = l == 0 ? INP(6) + 1024 : INP(27); C.l = l; C.lane = lane;
    CRow A, B; int row = gw;
    if (row < nrows) cr_issue(C, A, row);
    while (row < nrows) {
        const int r2 = row + NGW; if (r2 < nrows) cr_issue(C, B, r2);
        cr_finish(C, A, row);
        const int r3 = r2 + NGW; if (r3 < nrows) cr_issue(C, A, r3);
        if (r2 < nrows) cr_finish(C, B, r2);
        row = r3;
    }
}

#ifdef DBG_STOP
__device__ __forceinline__ void debug_out(PH_ARGS) {
    float* out = PTRV(28, float);
    const int gt = bid * 512 + tid, GT = G * 512;
    for (size_t i = gt; i < (size_t)ML * 1024; i += GT) { const size_t row = i >> 10; const int c = (int)(i & 1023); float v = 0.f;
#if DBG_STOP == 2
        v = bflo(WSP(bf16, WS_H)[row * 1024 + c]) + WSP(float, WS_MOD)[(i % 36864)] + bflo(WSP(bf16, WS_WIN)[i % (6400 * 1024)]) + bflo(WSP(bf16, WS_WGU)[i]) + bflo(WSP(bf16, WS_WDN)[i]) + bflo(WSP(bf16, WS_WO)[i % (1024*1024)]) + bflo(WSP(bf16, WS_WBR)[i % (1024*1024)]);
#elif DBG_STOP == 3
        v = bflo(WSP(bf16, WS_AUV)[row * 512 + (c & 511)]) + bflo(WSP(bf16, WS_YF)[row * 512 + (c & 511)]) + bflo(WSP(bf16, WS_CY)[row * 256 + (c & 255)]) + bflo(WSP(bf16, WS_QPL)[row * 256 + (c & 255)])
          + bflo(WSP(bf16, WS_QROT)[row * 256 + (c & 255)]) + bflo(WSP(bf16, WS_KR)[row * 256 + (c & 255)]) + bflo(WSP(bf16, WS_VV)[row * 256 + (c & 255)])
          + bflo(WSP(bf16, WS_G)[row * 4096 + c]) + bflo(WSP(bf16, WS_G)[row * 4096 + 1024 + c]) + bflo(WSP(bf16, WS_G)[row * 4096 + 2048 + c]) + bflo(WSP(bf16, WS_G)[row * 4096 + 3072 + c]);
#elif DBG_STOP == 4
        v = bflo(WSP(bf16, WS_BR)[(size_t)(0 * MT + row) * 256 + (c & 255)]) + bflo(WSP(bf16, WS_BR)[(size_t)(2 * MT + row) * 256 + (c & 255)]) + bflo(WSP(bf16, WS_FA)[i % ((size_t)8 << 20)]);
#elif DBG_STOP == 21
        v = bflo(WSP(bf16, WS_T1T)[i % 16384]) * 1.001f + WSP(float, WS_ROPEC)[i % 2048] + WSP(float, WS_ROPES)[i % 2048] + bflo(WSP(bf16, WS_WSP)[i % 65536]);
#elif DBG_STOP == 31 || DBG_STOP == 44
        v = 0.f;
#elif DBG_STOP == 45 || DBG_STOP == 32
        v = 0.f;
#elif DBG_STOP == 41
        v = bflo(WSP(bf16, WS_BR)[(size_t)(0 * MT + row) * 256 + (c & 255)]) * 1.001f + bflo(WSP(bf16, WS_BR)[(size_t)(0 * MT + row) * 256 + ((c + 7) & 255)]);
#elif DBG_STOP == 42
        v = bflo(WSP(bf16, WS_BR)[(size_t)(2 * MT + row) * 256 + (c & 255)]) * 1.001f + bflo(WSP(bf16, WS_BR)[(size_t)(2 * MT + row) * 256 + ((c + 7) & 255)]);
#elif DBG_STOP == 43
        v = bflo(WSP(bf16, WS_FA)[i % ((size_t)8 << 20)]) * 1.001f + bflo(WSP(bf16, WS_FA)[(i + 7) % ((size_t)8 << 20)]);
#elif DBG_STOP == 5
        v = bflo(WSP(bf16, WS_BR)[(size_t)(1 * MT + row) * 256 + (c & 255)]) + bflo(WSP(bf16, WS_BR)[(size_t)(3 * MT + row) * 256 + (c & 255)]);
#elif DBG_STOP == 6
        v = bflo(WSP(bf16, WS_MB)[row * 1024 + c]);
#elif DBG_STOP == 7
        v = WSP(float, WS_X)[row * 1024 + c];
#elif DBG_STOP == 8
        v = bflo(WSP(bf16, WS_H)[row * 1024 + c]) + WSP(float, WS_AFF)[row * 16 + (c & 15)];
#elif DBG_STOP == 9
        v = (float)WSP(int, WS_SEL)[row * 16 + (c & 15)] + WSP(float, WS_GATE)[i % (16 * 2304)] + (float)WSP(int, WS_IDX)[i % (16 * 2304)];
#elif DBG_STOP == 10
        v = bflo(WSP(bf16, WS_XE)[i]) + bflo(WSP(bf16, WS_XE)[i + (size_t)ML * 1024]);
#elif DBG_STOP == 11
        v = bflo(WSP(bf16, WS_ACT)[i]) + bflo(WSP(bf16, WS_ACT)[i + (size_t)ML * 1024]);
#elif DBG_STOP == 12
        v = bflo(WSP(bf16, WS_XE)[i]) + bflo(WSP(bf16, WS_XE)[i + (size_t)ML * 1024]);
#else
        v = WSP(float, WS_X)[row * 1024 + c] + bflo(WSP(bf16, WS_H)[row * 1024 + c]);
#endif
#ifdef DBG_AMP
        v = (float)(__float_as_uint(v) & 0xFFFFu);
#endif
        out[i] = v; }
}
#endif
__global__ void __launch_bounds__(512, 2) mega(Args A) {
    extern __shared__ __attribute__((aligned(16))) unsigned char lds_raw[];
    LAS unsigned char* lds0 = (LAS unsigned char*)lds_raw;
    volatile LAS unsigned* MISC = (volatile LAS unsigned*)(lds0 + MISC_OFF);
    const int tid = threadIdx.x, lane = tid & 63, wave = __builtin_amdgcn_readfirstlane(tid >> 6), bid = blockIdx.x, G = gridDim.x;
    for (int u = tid; u < (LDS_BYTES - MISC_OFF) / 4; u += 512) ((LAS unsigned*)(lds0 + MISC_OFF))[u] = 0u;
    __syncthreads();
    if (tid == 0) { typedef unsigned u2v_t __attribute__((ext_vector_type(2)));
#pragma unroll
        for (int i = 0; i < 30; ++i) { const unsigned long long p = i < 28 ? (unsigned long long)A.in[i] : (i == 28 ? (unsigned long long)A.out : (unsigned long long)A.ws);
            *(LAS u2v_t*)(lds0 + PTAB_OFF + 8 * i) = (u2v_t){(unsigned)p, (unsigned)(p >> 32)}; } }
    __syncthreads();
    const int lo = A.ph_lo, hi = A.ph_hi;
    XcdBarrier bar; bar.bar = (unsigned*)(A.ws + WS_CTL) + CW_BAR; bar.x = 0; bar.st = nullptr;
    if (hi - lo > 1) bar = xcd_barrier_post((unsigned*)(A.ws + WS_CTL) + CW_BAR, MISC + 8);
#define PH_CALL lds, tl_, (tl_ & 63), wv_, bl_, G_
#define PH_CALLV lds, tl_, (tl_ & 63), wv_, vb_, G_
#ifdef TS_I
    if (bid == 0 && tid == 0) ((unsigned long long*)(A.ws + 65536))[lo] = rt();
#endif
    if (lo == 0) {
        int tl_ = tid; asm volatile("" : "+v"(tl_)); int bl_ = bid; asm volatile("" : "+s"(bl_)); int wv_ = wave; asm volatile("" : "+s"(wv_)); int G_ = G; asm volatile("" : "+s"(G_));
        unsigned ldsb_ = (unsigned)(uintptr_t)lds0; asm volatile("" : "+s"(ldsb_)); LAS unsigned char* lds = (LAS unsigned char*)(uintptr_t)ldsb_;
#ifndef P0R_MOD
#define P0R_MOD 1
#endif
#ifndef P0R_TAB
#define P0R_TAB 1
#endif
#ifndef P0R_CVT
#define P0R_CVT 1
#endif
#pragma unroll 1
            for (int r_ = 0; r_ < P0R_MOD; ++r_) { mod_gemv(PH_CALL); asm volatile("" ::: "memory"); }
#pragma unroll 1
            for (int r_ = 0; r_ < P0R_TAB; ++r_) { make_tables(PH_CALL); asm volatile("" ::: "memory"); }
#pragma unroll 1
            for (int r_ = 0; r_ < P0R_CVT; ++r_) { convert_range(lds, tl_, (tl_ & 63), wv_, bl_, G_, 0, CV_FOLD0, CV_GU0, bl_, G_); convert_range(lds, tl_, (tl_ & 63), wv_, bl_, G_, 0, CV_SP0, CV_END, bl_, G_); asm volatile("" ::: "memory"); }
        if (hi > 1) { XcdBarrier b2 = bar; b2.bar = (unsigned*)(PTRV(29, unsigned char) + WS_CTL) + CW_BAR; b2.st = (volatile LAS unsigned*)(lds + MISC_OFF) + 8; xcd_barrier(b2); }
    }
    const int lo1 = lo < 1 ? 1 : lo;
#pragma unroll 1
#ifdef REP_PH
    for (int it_ = lo1; it_ < hi + (REP_N - 1); ++it_) { const int ph = it_ < REP_PH ? it_ : (it_ < REP_PH + REP_N ? REP_PH : it_ - (REP_N - 1));
#else
    for (int ph = lo1; ph < hi; ++ph) {
#endif
        int tl_ = tid; asm volatile("" : "+v"(tl_)); int bl_ = bid; asm volatile("" : "+s"(bl_)); int vb_ = (G % 8 == 0) ? (bid % 8) * (G / 8) + bid / 8 : bid; asm volatile("" : "+s"(vb_)); int wv_ = wave; asm volatile("" : "+s"(wv_)); int G_ = G; asm volatile("" : "+s"(G_)); unsigned ldsb_ = (unsigned)(uintptr_t)lds0; asm volatile("" : "+s"(ldsb_)); LAS unsigned char* lds = (LAS unsigned char*)(uintptr_t)ldsb_;
        const int l = ph < 13 ? 0 : 1, kind = ph >= 99 ? 99 : (ph < 2 ? ph : 2 + (ph - 2 - 11 * l));
        const int ntm = l == 0 ? 66 : 64, tpe = l == 0 ? 9 : 8;
        if (kind == 9) continue;
        switch (kind) {
#ifdef DBG_STOP
        case 99: debug_out(PH_CALL); break;
#endif
        case 0: break;
        case 1: {
#ifndef DIS_N1
            norm1_l0(PH_CALL);
#endif
        } break;
        case 2: {
            pg8::Gemm g{WSP(bf16, WS_H), WSP(bf16, WS_WIN), MT, NIN, 1024}; pg8::StaticOrder S; S.init(MT, NIN, G_, bl_);
            EpiIn E{WSP(bf16, WS_AUV), WSP(bf16, WS_YF), WSP(bf16, WS_CY), WSP(bf16, WS_QPL), WSP(bf16, WS_QROT), WSP(bf16, WS_KR), WSP(bf16, WS_VV), WSP(bf16, WS_G), WSP(float, WS_ROPEC), WSP(float, WS_ROPES)};
#ifndef DIS_GIN
            pg8::gemm_phase<EpiIn, pg8::StaticOrder, true, true>(lds, g, S, E);
#endif
#ifndef DIS_CVT
            if (l == 0) { const int nx = ((MT / 256) * (NIN / 256)) % G_; convert_range(lds, tl_, (tl_ & 63), wv_, bl_, G_, 0, CV_GU0, CV_DN0, nx ? bl_ - nx : bl_, G_ - nx); }
#endif
        } break;
        case 3: {
#ifndef DIS_F1
            if (bl_ < 256) { f1_stage_tables(PH_CALL); for (int u = vb_; u < 256; u += G_) f1_unit(PH_CALL, u); }
#endif
#ifndef DIS_CDFT
            if (l == 0) ctx_butterfly(PH_CALL);
#endif
            __syncthreads();
            { LAS float* rp = (LAS float*)(lds + AT_RPB); const float* src = INP(20) + l * 1860; for (int i = tl_; i < 1860; i += 512) rp[i] = src[i]; }
            __syncthreads();
            const int nat = l == 0 ? 264 : 256;
#ifndef DIS_ATT
            for (int u = vb_; u < nat; u += G_) attn_unit(PH_CALL, u);
#endif
        } break;
        case 4: {
#ifndef DIS_F2
            { const int nf2 = l == 0 ? 264 : 256; for (int u = vb_; u < nf2; u += G_) f2_unit(PH_CALL, u); }
#endif
            const int nconv = l == 0 ? 264 : 256, ngm = l == 0 ? 132 : 128;
#ifndef DIS_CONV
            for (int u = vb_; u < nconv; u += G_) conv_unit(PH_CALL, l, u);
#endif
#ifndef DIS_GMLP
            for (int u = G_ - 1 - vb_; u < ngm; u += G_) gmlp_unit(PH_CALL, l, u);
#endif
        } break;
        case 5: {
#ifndef DIS_GMRG
#ifndef MERGE_PG8
            merge_phase(PH_CALLV, ntm * 16);
#ifndef DIS_CVT
            if (l == 0) { const int nx = (ntm * 16) % G_; convert_range(lds, tl_, (tl_ & 63), wv_, vb_, G_, 0, CV_DN0, CV_SP0, nx ? vb_ - nx : vb_, G_ - nx); }
#endif
#else
            { pg8::Gemm g{WSP(bf16, WS_BR), WSP(bf16, WS_WBR), 4 * MT, 4096, 256}; MergeOrder S; S.init(ntm, G_, bl_); EpiMergeH E{WSP(bf16, WS_G), WSP(bf16, WS_MB)};
              pg8::gemm_phase<EpiMergeH, MergeOrder, true, true>(lds, g, S, E); }
#endif
#endif
        } break;
        case 6: {
            pg8::Gemm g{WSP(bf16, WS_MB), WSP(bf16, WS_WO), ML, 1024, 1024}; pg8::StaticOrder S; S.init(ML, 1024, G_, bl_);
            EpiWout E{l == 0 ? INP(0) : WSP(float, WS_X), l == 0 ? INP(2) : WSP(float, WS_X) + (size_t)ML * 1024, WSP(float, WS_X), WSP(float, WS_MOD) + l * 3 * 6144};
#ifndef DIS_GWO
            pg8::gemm_phase<EpiWout, pg8::StaticOrder, true, true>(lds, g, S, E);
#endif
#ifndef DIS_CVT
            if (l == 0) { const int nx = (64 * 4) % G_; convert_range(lds, tl_, (tl_ & 63), wv_, bl_, G_, 1, CV_FOLD0, CV_WO0, nx ? bl_ - nx : bl_, G_ - nx); }
#endif
        } break;
        case 7: {
#ifndef DIS_N2
            if (l == 0 && G_ > 16) {
                unsigned* cnt = (unsigned*)(PTRV(29, unsigned char) + WS_CTL) + 2048;
                if (bl_ < 8) {
                    pg8::Gemm g{WSP(bf16, WS_MB), WSP(bf16, WS_WO), MT, 1024, 1024}; OneUnit S{64 + (bl_ >> 2), bl_ & 3};
                    EpiWout E{INP(0), INP(2), WSP(float, WS_X), WSP(float, WS_MOD)};
                    pg8::gemm_phase<EpiWout, OneUnit, true, true>(lds, g, S, E);
                    asm volatile("s_waitcnt vmcnt(0)" ::: "memory"); __syncthreads();
                    if (tl_ == 0) { __builtin_amdgcn_fence(__ATOMIC_RELEASE, "agent"); asm volatile("s_waitcnt vmcnt(0)" ::: "memory"); __hip_atomic_fetch_add(cnt, 1u, __ATOMIC_RELAXED, __HIP_MEMORY_SCOPE_AGENT); }
                } else norm2_router(PH_CALL, l, 0, ML, bl_ - 8, G_ - 8);
                if (tl_ == 0) { unsigned sp_ = 0; while (__hip_atomic_load(cnt, __ATOMIC_RELAXED, __HIP_MEMORY_SCOPE_AGENT) < 8u && ++sp_ < (1u << 22)) __builtin_amdgcn_s_sleep(2);
                    __builtin_amdgcn_fence(__ATOMIC_ACQUIRE, "agent"); asm volatile("s_waitcnt vmcnt(0)" ::: "memory"); }
                __syncthreads();
                norm2_router(PH_CALL, l, ML, MC, bl_, G_, bl_ < 8);
            } else norm2_router(PH_CALL, l, 0, ntm * 256, bl_, G_);
#endif
        } break;
        case 8: {
#ifndef DIS_TOPK
            const int nun = l == 0 ? 64 : 32;
            for (int u = bl_; u < nun; u += G_) {
                if (u < 32) { const int b = u >> 4, e = u & 15; topk_unit<16, true>(PH_CALL, b * SEQ, SEQ, CAPL, e, b * CAPL, l == 0 && b == 0); }
                else { const int b = (u - 32) >> 4, e = u & 15; topk_unit<1, false>(PH_CALL, ML + b * CTXL, CTXL, CAPC, e, 2048 + b * CAPC, false); }
            }
#endif
        } break;
        case 9: {
#ifndef DIS_GATH
            gather_rows(PH_CALL, tpe);
#endif
        } break;
        case 10: {
            pg8::Gemm g{WSP(bf16, WS_H), WSP(bf16, WS_WGU), NE * ESTR, NE * 2048, 1024, WSP(int, WS_IDX)}; GroupOrder S; S.init(tpe, 8, G_, bl_);
            EpiGU E{WSP(bf16, WS_ACT)};
#ifndef DIS_GGU
            pg8::gemm_phase<EpiGU, GroupOrder, true, true, true>(lds, g, S, E);
#endif
#ifndef DIS_CVT
            if (l == 0) { const int nx = (NE * tpe * 8) % G_; convert_range(lds, tl_, (tl_ & 63), wv_, bl_, G_, 1, CV_WO0, CV_GU0, nx ? bl_ - nx : bl_, G_ - nx);
                          convert_range(lds, tl_, (tl_ & 63), wv_, bl_, G_, 1, CV_SP0, CV_END, nx ? bl_ - nx : bl_, G_ - nx); }
#endif
        } break;
        case 11: {
            pg8::Gemm g{WSP(bf16, WS_ACT), WSP(bf16, WS_WDN), NE * ESTR, NE * 1024, 1024}; GroupOrder S; S.init(tpe, 4, G_, bl_);
            EpiDown E{WSP(bf16, WS_XE), WSP(float, WS_GATE)};
#ifndef DIS_GDN
            pg8::gemm_phase<EpiDown, GroupOrder, true, true>(lds, g, S, E);
#endif
#ifndef DIS_CVT
            if (l == 0) { const int nx = (NE * tpe * 4) % G_; convert_range(lds, tl_, (tl_ & 63), wv_, bl_, G_, 1, CV_GU0, CV_DN0, nx ? bl_ - nx : bl_, G_ - nx); }
#endif
        } break;
        default: {
#ifndef DIS_COMB
#ifdef COMB_REP
#pragma unroll 1
            for (int r_ = 0; r_ < COMB_REP; ++r_) combine_rows<true>(PH_CALL, l);
#endif
            combine_rows<false>(PH_CALL, l);
#endif
#ifndef DIS_CVT
            if (l == 0) convert_range(lds, tl_, (tl_ & 63), wv_, bl_, G_, 1, CV_DN0, CV_SP0, bl_, G_);
#endif
        } break;
        }
#ifdef XBAR
        if (ph == 1) { for (int xb_ = 0; xb_ < XBAR; ++xb_) { XcdBarrier b5 = bar; b5.bar = (unsigned*)(PTRV(29, unsigned char) + WS_CTL) + CW_BAR; b5.st = (volatile LAS unsigned*)(lds + MISC_OFF) + 8; xcd_barrier(b5); } }
#endif
#ifdef TS_I
        { XcdBarrier b3 = bar; b3.bar = (unsigned*)(PTRV(29, unsigned char) + WS_CTL) + CW_BAR; b3.st = (volatile LAS unsigned*)(lds + MISC_OFF) + 8; xcd_barrier(b3);
          if (bid == 0 && tid == 0) ((unsigned long long*)(PTRV(29, unsigned char) + 65536))[ph + 1] = rt(); }
        if (ph + 1 == hi) { XcdBarrier b3 = bar; b3.bar = (unsigned*)(PTRV(29, unsigned char) + WS_CTL) + CW_BAR; b3.st = (volatile LAS unsigned*)(lds + MISC_OFF) + 8; xcd_barrier(b3);
            const unsigned long long* TS = (const unsigned long long*)(PTRV(29, unsigned char) + 65536);
            const float dti = (float)(TS[TS_I + 1] - TS[TS_I]) * 0.01f, dtj = (float)(TS[TS_J + 1] - TS[TS_J]) * 0.01f;
            float* out = PTRV(28, float); const float Av = sqrtf(dti);
            for (size_t i = (size_t)bid * 512 + tid; i < (size_t)ML * 1024; i += (size_t)G * 512) out[i] = (i == 0) ? dtj * 10.f : Av; }
        if (0) {
#else
#ifdef REP_PH
        if (it_ + 1 < hi + (REP_N - 1)) {
#else
        if (ph + 1 < hi) {
#endif
#endif
          XcdBarrier b2 = bar; b2.bar = (unsigned*)(PTRV(29, unsigned char) + WS_CTL) + CW_BAR; unsigned bx_ = bar.x; asm volatile("" : "+s"(bx_)); b2.x = bx_; b2.st = (volatile LAS unsigned*)(lds + MISC_OFF) + 8; xcd_barrier(b2); }
    }
}

extern "C" void kernel_launch(void* const* d_in, const int* in_sizes, int n_in, void* d_out, int out_size, void* d_ws, size_t ws_size, hipStream_t stream) {
    static int grid = 0;
    if (grid == 0) {
        if (n_in != 28 || ws_size < WS_END) { fprintf(stderr, "kernel_launch: unexpected n_in %d / ws %zu\n", n_in, ws_size); grid = -1; return; }
        int dev = 0, cus = 0;
        if (hipGetDevice(&dev) != hipSuccess || hipDeviceGetAttribute(&cus, hipDeviceAttributeMultiprocessorCount, dev) != hipSuccess) { grid = -1; return; }
        if (hipFuncSetAttribute((const void*)mega, hipFuncAttributeMaxDynamicSharedMemorySize, LDS_BYTES) != hipSuccess) { fprintf(stderr, "kernel_launch: hipFuncSetAttribute failed\n"); grid = -1; return; }
        (void)hipGetLastError();
        grid = cus;
    }
    if (grid < 0) return;
    (void)hipMemsetAsync((char*)d_ws + WS_CTL, 0, CTL_ZERO_BYTES, stream);
    Args a{};
    for (int i = 0; i < 28; ++i) a.in[i] = (const float*)d_in[i];
    a.out = (float*)d_out; a.ws = (unsigned char*)d_ws;
#ifdef DBG_STOP
    for (int p = 0; p < (DBG_STOP > 20 ? DBG_STOP / 10 : DBG_STOP); ++p) { a.ph_lo = p; a.ph_hi = p + 1; hipLaunchKernelGGL(mega, dim3(grid), dim3(512), LDS_BYTES, stream, a); }
    a.ph_lo = 99; a.ph_hi = 100; hipLaunchKernelGGL(mega, dim3(grid), dim3(512), LDS_BYTES, stream, a);
#elif N_LAUNCHES == 1
    a.ph_lo = 0; a.ph_hi = NPH;
    hipLaunchKernelGGL(mega, dim3(grid), dim3(512), LDS_BYTES, stream, a);
#else
    for (int p = 0; p < NPH; ++p) { a.ph_lo = p; a.ph_hi = p + 1; hipLaunchKernelGGL(mega, dim3(grid), dim3(512), LDS_BYTES, stream, a); }
#endif
}
```

```cpp
#include <hip/hip_runtime.h>
#include <cstdio>
#include <cstdint>
#define N_LAUNCHES 1
namespace pg8 {
#define PG8_LAS __attribute__((address_space(3)))
typedef unsigned short bf16_t;
typedef short bf16x8 __attribute__((ext_vector_type(8)));
typedef float f32x4 __attribute__((ext_vector_type(4)));
typedef unsigned u32x4 __attribute__((ext_vector_type(4)));
constexpr int BM = 256, BK = 64, HALF = 128, HTB = HALF * BK * 2  , STAGE_BYTES = 8 * HTB, NXCD = 8, WGM = 2;

__host__ __device__ __forceinline__ int lds_byte(int r, int c) { const int st = (r >> 4) * 2 + (c >> 5), rr = r & 15, cc = c & 31, ob = rr * 64 + cc * 2; return st * 1024 + (ob ^ (((ob >> 9) & 1) << 5)); }
__host__ __device__ __forceinline__ void stage_rc(int b, int& R, int& C) { const int st = b / 1024, sb = b % 1024, swz = sb ^ (((sb >> 9) & 1) << 5); R = (st >> 1) * 16 + swz / 64; C = (st & 1) * 32 + (swz % 64) / 2; }
__host__ __device__ __forceinline__ int perm32(int rho) { const int n = rho >> 4, i = rho & 15; return 8 * (i >> 2) + 4 * n + (i & 3); }

struct Unit { int pm, pn; };
struct Gemm { const bf16_t* A; const bf16_t* Bt; int M, N, K; const int* gidx = nullptr; };

struct StaticOrder {
    int nM, nN, nwg, G, c;
    __host__ __device__ void init(int M, int N, int G_, int c_) { nM = M / BM; nN = N / BM; nwg = nM * nN; G = G_; c = c_; }
    __host__ __device__ bool next(int i, Unit& u) const {
        const long L = (long)i * G + c; if (L >= nwg) return false;
        int wgid = (int)L; { const int q = nwg / NXCD, r = nwg % NXCD, xcd = wgid % NXCD, off = wgid / NXCD; wgid = (xcd < r ? xcd * (q + 1) : r * (q + 1) + (xcd - r) * q) + off; }
        const int nig = WGM * nN, gid = wgid / nig, fm = gid * WGM, gsz = (nM - fm) < WGM ? (nM - fm) : WGM;
        u.pm = fm + ((wgid % nig) % gsz); u.pn = (wgid % nig) / gsz; return true;
    }
    __device__ __forceinline__ void a_ready(const Unit&) const {}
    __device__ __forceinline__ void done(const Unit&) const {}
};
__device__ __forceinline__ unsigned cvt_pk_bf16(float lo, float hi) { unsigned r; asm volatile("v_cvt_pk_bf16_f32 %0, %1, %2" : "=v"(r) : "v"(lo), "v"(hi)); return r; }
typedef float f32x2 __attribute__((ext_vector_type(2)));
template <class Epi, class Sched, bool ALIGN_EPI = false, bool SP2 = false, bool GATHER = false>
__device__ __forceinline__ void gemm_phase(PG8_LAS unsigned char* lds, const Gemm g, const Sched& S, const Epi& E) {
    int tid_l = threadIdx.x; asm volatile("" : "+v"(tid_l));
    const int tid = tid_l, wid = __builtin_amdgcn_readfirstlane(tid >> 6), lane = tid & 63, wr = wid >> 2, wc = wid & 3, fr = lane & 15, fq = lane >> 4;
    const int K = g.K, nt = K / BK;
    unsigned voffA[2], voffB[2];
#pragma unroll
    for (int i = 0; i < 2; ++i) { int R, C; stage_rc(tid * 16 + i * 8192, R, C); const int Rb = Epi::PERM ? ((R & ~31) + perm32(R & 31)) : R;
        voffA[i] = (unsigned)(R * K + C) * 2u; voffB[i] = (unsigned)(Rb * K + C) * 2u; }
    const size_t kstep = (size_t)(BK * 2);
    const size_t hstep = (size_t)HALF * K * 2;
    const size_t tstep = 2 * hstep;
    const unsigned ldsw = (unsigned)wid * 1024u;
    const int aoff = lds_byte(wr * 64 + fr, fq * 8), boff = lds_byte(wc * 32 + fr, fq * 8);
#define PG8_SA(b, h) (((b) * 2 + (h)) * HTB)
#define PG8_SB(b, h) ((4 + (b) * 2 + (h)) * HTB)
#define PG8_STAGE(bufoff, gbase, voff) do { _Pragma("unroll") for (int _i = 0; _i < 2; ++_i) \
        __builtin_amdgcn_global_load_lds((const unsigned*)((const char*)(gbase) + (voff)[_i]), (PG8_LAS unsigned*)(lds + (bufoff) + ldsw + _i * 8192), 16, 0, 0); } while (0)
    static_assert(!GATHER || SP2, "GATHER is implemented on the SP2 loop only");
    unsigned vgc[2][2] = {{0u, 0u}, {0u, 0u}}, vgn[2][2] = {{0u, 0u}, {0u, 0u}};
#define PG8_GLOAD(u, v) do { _Pragma("unroll") for (int _h = 0; _h < 2; ++_h) _Pragma("unroll") for (int _i = 0; _i < 2; ++_i) { int R_, C_; stage_rc(tid * 16 + _i * 8192, R_, C_); \
        v[_h][_i] = (unsigned)(g.gidx[(u).pm * BM + _h * HALF + R_] * K + C_) * 2u; } } while (0)
#define PG8_STAGE_A(bufoff, base, half, NEXT) do { if constexpr (GATHER) { if (NEXT) PG8_STAGE(bufoff, base, vgn[half]); else PG8_STAGE(bufoff, base, vgc[half]); } \
        else PG8_STAGE(bufoff, (base) + (half) * hstep, voffA); } while (0)
#define PG8_LDA(dst, b, h) do { _Pragma("unroll") for (int m = 0; m < 4; ++m) _Pragma("unroll") for (int k = 0; k < 2; ++k) dst[m][k] = *(const PG8_LAS bf16x8*)(lds + PG8_SA(b, h) + aoff + m * 2048 + k * 1024); } while (0)
#define PG8_LDB(dst, b, h) do { _Pragma("unroll") for (int n = 0; n < 2; ++n) _Pragma("unroll") for (int k = 0; k < 2; ++k) dst[n][k] = *(const PG8_LAS bf16x8*)(lds + PG8_SB(b, h) + boff + n * 2048 + k * 1024); } while (0)
#define PG8_MMA(ai, bj, At, Bt) do { __builtin_amdgcn_s_setprio(1); _Pragma("unroll") for (int m = 0; m < 4; ++m) _Pragma("unroll") for (int n = 0; n < 2; ++n) _Pragma("unroll") for (int k = 0; k < 2; ++k) \
        acc[ai][bj][m][n] = __builtin_amdgcn_mfma_f32_16x16x32_bf16(Bt[n][k], At[m][k], acc[ai][bj][m][n], 0, 0, 0); __builtin_amdgcn_s_setprio(0); } while (0)
#define PG8_WAIT_V(n) asm volatile("s_waitcnt vmcnt(" #n ")" ::: "memory")
#define PG8_WAIT_L(n) asm volatile("s_waitcnt lgkmcnt(" #n ")" ::: "memory")
#define PG8_BAR __builtin_amdgcn_s_barrier()
#define PG8_SCHED __builtin_amdgcn_sched_barrier(0)
    Unit cur, nxt; int ui = 0;
    if (!S.next(0, cur)) return;
    f32x4 acc[2][2][4][2];
#pragma unroll
    for (int a = 0; a < 2; ++a)
#pragma unroll
        for (int b = 0; b < 2; ++b)
#pragma unroll
            for (int m = 0; m < 4; ++m)
#pragma unroll
                for (int n = 0; n < 2; ++n) acc[a][b][m][n] = (f32x4){0.f, 0.f, 0.f, 0.f};
    bf16x8 At[4][2], B0[2][2], B1[2][2];
    const char* cA = GATHER ? (const char*)g.A : (const char*)g.A + (size_t)cur.pm * tstep; const char* cB = (const char*)g.Bt + (size_t)cur.pn * tstep;
    if constexpr (GATHER) { PG8_GLOAD(cur, vgc); }
    S.a_ready(cur);
    if constexpr (SP2) {
        PG8_STAGE(PG8_SB(0, 0), cB, voffB); PG8_STAGE(PG8_SB(0, 1), cB + hstep, voffB); PG8_STAGE_A(PG8_SA(0, 0), cA, 0, false); PG8_STAGE_A(PG8_SA(0, 1), cA, 1, false);
        if (wr == 1) PG8_BAR;
        PG8_WAIT_V(2); PG8_BAR;
        PG8_STAGE(PG8_SB(1, 0), cB + kstep, voffB); PG8_STAGE_A(PG8_SA(1, 0), cA + kstep, 0, false); PG8_STAGE(PG8_SB(1, 1), cB + hstep + kstep, voffB);
        PG8_WAIT_V(6); PG8_BAR;
    } else {
        PG8_STAGE(PG8_SB(0, 0), cB, voffB); PG8_STAGE(PG8_SA(0, 0), cA, voffA); PG8_STAGE(PG8_SB(0, 1), cB + hstep, voffB); PG8_STAGE(PG8_SA(0, 1), cA + hstep, voffA);
        if (wr == 1) PG8_BAR;
        PG8_WAIT_V(4); PG8_BAR;
        PG8_STAGE(PG8_SB(1, 0), cB + kstep, voffB); PG8_STAGE(PG8_SA(1, 0), cA + kstep, voffA); PG8_STAGE(PG8_SB(1, 1), cB + hstep + kstep, voffB);
        PG8_WAIT_V(6); PG8_BAR;
    }
    for (;;) {
        const bool has_next = S.next(ui + 1, nxt);
        const char* nA = GATHER ? (const char*)g.A : (has_next ? (const char*)g.A + (size_t)nxt.pm * tstep : cA);
        if constexpr (GATHER) { if (has_next) { PG8_GLOAD(nxt, vgn); } else { _Pragma("unroll") for (int _h = 0; _h < 2; ++_h) _Pragma("unroll") for (int _i = 0; _i < 2; ++_i) vgn[_h][_i] = vgc[_h][_i]; } } const char* nB = has_next ? (const char*)g.Bt + (size_t)nxt.pn * tstep : cB;
#pragma unroll 1
        for (int t = 0; t < nt; t += 2) {
            const bool last = (t == nt - 2);
            const char* a1 = cA + (size_t)(t + 1) * kstep;
            const char* a2 = last ? nA : cA + (size_t)(t + 2) * kstep; const char* b2 = last ? nB : cB + (size_t)(t + 2) * kstep;
            const char* a3 = a2 + kstep; const char* b3 = b2 + kstep;
            if (last && has_next) S.a_ready(nxt);
            if constexpr (SP2) {
            PG8_LDB(B0, 0, 0); PG8_LDB(B1, 0, 1); PG8_SCHED; PG8_LDA(At, 0, 0); PG8_STAGE_A(PG8_SA(1, 1), a1, 1, false);
            PG8_WAIT_V(8); PG8_WAIT_L(0); PG8_BAR; PG8_MMA(0, 0, At, B0); PG8_MMA(0, 1, At, B1); PG8_BAR; PG8_SCHED;
            PG8_LDA(At, 0, 1); PG8_STAGE(PG8_SB(0, 0), b2, voffB); PG8_STAGE(PG8_SB(0, 1), b2 + hstep, voffB); PG8_STAGE_A(PG8_SA(0, 0), a2, 0, last);
            PG8_WAIT_V(8); PG8_WAIT_L(0); PG8_BAR; PG8_MMA(1, 0, At, B0); PG8_MMA(1, 1, At, B1); PG8_BAR; PG8_SCHED;
            PG8_LDB(B0, 1, 0); PG8_LDB(B1, 1, 1); PG8_SCHED; PG8_LDA(At, 1, 0); PG8_STAGE_A(PG8_SA(0, 1), a2, 1, last);
            PG8_WAIT_V(8); PG8_WAIT_L(0); PG8_BAR; PG8_MMA(0, 0, At, B0); PG8_MMA(0, 1, At, B1); PG8_BAR; PG8_SCHED;
            PG8_LDA(At, 1, 1); PG8_STAGE(PG8_SB(1, 0), b3, voffB); PG8_STAGE(PG8_SB(1, 1), b3 + hstep, voffB); PG8_STAGE_A(PG8_SA(1, 0), a3, 0, last);
            PG8_WAIT_V(8); PG8_WAIT_L(0); PG8_BAR; PG8_MMA(1, 0, At, B0); PG8_MMA(1, 1, At, B1); PG8_BAR; PG8_SCHED;
            } else {
            PG8_LDB(B0, 0, 0); PG8_SCHED; PG8_LDA(At, 0, 0); PG8_STAGE(PG8_SA(1, 1), a1 + hstep, voffA);
            PG8_WAIT_L(8); PG8_BAR; PG8_WAIT_L(0); PG8_MMA(0, 0, At, B0); PG8_BAR; PG8_SCHED;
            PG8_LDB(B1, 0, 1); PG8_STAGE(PG8_SB(0, 0), b2, voffB);
            PG8_BAR; PG8_WAIT_L(0); PG8_MMA(0, 1, At, B1); PG8_BAR;
            PG8_LDA(At, 0, 1); PG8_STAGE(PG8_SA(0, 0), a2, voffA);
            PG8_BAR; PG8_WAIT_L(0); PG8_MMA(1, 0, At, B0); PG8_BAR; PG8_SCHED;
            PG8_STAGE(PG8_SB(0, 1), b2 + hstep, voffB);
            PG8_WAIT_V(6); PG8_BAR; PG8_MMA(1, 1, At, B1); PG8_BAR;
            PG8_LDB(B0, 1, 0); PG8_SCHED; PG8_LDA(At, 1, 0); PG8_STAGE(PG8_SA(0, 1), a2 + hstep, voffA);
            PG8_WAIT_L(8); PG8_BAR; PG8_WAIT_L(0); PG8_MMA(0, 0, At, B0); PG8_BAR; PG8_SCHED;
            PG8_LDB(B1, 1, 1); PG8_STAGE(PG8_SB(1, 0), b3, voffB);
            PG8_BAR; PG8_WAIT_L(0); PG8_MMA(0, 1, At, B1); PG8_BAR;
            PG8_LDA(At, 1, 1); PG8_STAGE(PG8_SA(1, 0), a3, voffA);
            PG8_BAR; PG8_WAIT_L(0); PG8_MMA(1, 0, At, B0); PG8_BAR; PG8_SCHED;
            PG8_STAGE(PG8_SB(1, 1), b3 + hstep, voffB);
            PG8_WAIT_V(6); PG8_BAR; PG8_MMA(1, 1, At, B1); PG8_BAR;
            }
        }
        if constexpr (ALIGN_EPI) { if (wr == 0) PG8_BAR; }
        if constexpr (!Epi::AFTER_DRAIN) { int t2_ = threadIdx.x; asm volatile("" : "+v"(t2_)); E(acc, cur, wr, wc, t2_ & 15, (t2_ >> 4) & 3); S.done(cur); }
        if (!has_next) break;
        bool keep_ = false; if constexpr (Epi::KEEP) keep_ = E.keep(cur);
        if (!keep_) {
#pragma unroll
        for (int a = 0; a < 2; ++a)
#pragma unroll
            for (int b = 0; b < 2; ++b)
#pragma unroll
                for (int m = 0; m < 4; ++m)
#pragma unroll
                    for (int n = 0; n < 2; ++n) acc[a][b][m][n] = (f32x4){0.f, 0.f, 0.f, 0.f};
        }
        cur = nxt; cA = nA; cB = nB; ++ui;
        if constexpr (GATHER) { _Pragma("unroll") for (int _h = 0; _h < 2; ++_h) _Pragma("unroll") for (int _i = 0; _i < 2; ++_i) vgc[_h][_i] = vgn[_h][_i]; }
        if constexpr (ALIGN_EPI) { if (wr == 1) PG8_BAR; }
    }
    PG8_WAIT_V(0);
    if constexpr (!ALIGN_EPI) { if (wr == 0) PG8_BAR; }
    PG8_BAR;
    if constexpr (Epi::AFTER_DRAIN) { E.fused(acc, cur, wr, wc, fr, fq, lds, wid, lane); S.done(cur); }
#undef PG8_SA
#undef PG8_SB
#undef PG8_STAGE
#undef PG8_STAGE_A
#undef PG8_GLOAD
#undef PG8_LDA
#undef PG8_LDB
#undef PG8_MMA
#undef PG8_WAIT_V
#undef PG8_WAIT_L
#undef PG8_BAR
#undef PG8_SCHED
}
}
#define GAS __attribute__((address_space(1)))
#define LAS __attribute__((address_space(3)))
typedef unsigned short bf16;
typedef unsigned v4u __attribute__((ext_vector_type(4)));
typedef float f32x4 __attribute__((ext_vector_type(4)));
typedef short bf16x8 __attribute__((ext_vector_type(8)));
typedef GAS unsigned gu32;
typedef GAS unsigned long long gu64;
#define RLX_AGENT __ATOMIC_RELAXED, __HIP_MEMORY_SCOPE_AGENT
#define LDS_WAIT() asm volatile("s_waitcnt lgkmcnt(0)" ::: "memory")
#define VM_WAIT() asm volatile("s_waitcnt vmcnt(0)" ::: "memory")
__device__ __forceinline__ unsigned long long rt() { return __builtin_amdgcn_s_memrealtime(); }
__device__ __forceinline__ unsigned f2bf(float f) { unsigned u = __builtin_bit_cast(unsigned, f); return (u + 0x7fffu + ((u >> 16) & 1u)) >> 16; }
typedef float f32x2_t __attribute__((ext_vector_type(2))); typedef __bf16 bf16x2_t __attribute__((ext_vector_type(2)));
__device__ __forceinline__ unsigned pk2(float lo, float hi) { const f32x2_t v = {lo, hi}; const bf16x2_t b = __builtin_convertvector(v, bf16x2_t); return __builtin_bit_cast(unsigned, b); }

#define XB_TMO      128
#define XB_XCNT(j)  (256  + 64 * (j))
#define XB_XSUB(j)  (1280 + 64 * (j))
#define XB_XGEN(j)  (2304 + 64 * (j))
#define XB_TOP      3328
#define XB_TOPGEN   3392
#define XCD_BAR_WORDS 3456
#define XB_SPIN_CAP (1u << 18)

__device__ __forceinline__ unsigned xb_ld(unsigned* p)              { return __hip_atomic_load(p, __ATOMIC_RELAXED, __HIP_MEMORY_SCOPE_AGENT); }
__device__ __forceinline__ unsigned xb_add(unsigned* p, unsigned v) { return __hip_atomic_fetch_add(p, v, __ATOMIC_RELAXED, __HIP_MEMORY_SCOPE_AGENT); }
__device__ __forceinline__ unsigned xb_xcc_id() { return (unsigned)__builtin_amdgcn_s_getreg((3 << 11) | 20) & 0xFu; }
#define XB_SPIN(cond, bar) do { unsigned _sp = 0; while (cond) { __builtin_amdgcn_s_sleep(1); \
    if ((++_sp & 255u) == 0u) { if (xb_ld(&(bar)[XB_TMO])) break; if (_sp > XB_SPIN_CAP) { atomicAdd(&(bar)[XB_TMO], 1u); break; } } } } while (0)

struct XcdBarrier {
    unsigned* bar; unsigned x;
    volatile LAS unsigned* st;
};

__device__ __forceinline__ XcdBarrier xcd_barrier_post(unsigned* bar, volatile LAS unsigned* st) {
    XcdBarrier b; b.bar = bar; b.x = xb_xcc_id(); b.st = st;
    if (threadIdx.x == 0) (void)xb_add(&bar[XB_XCNT(b.x)], 1u);
    return b;
}
__device__ __forceinline__ void xcd_barrier_complete(unsigned* bar, unsigned x, unsigned& nloc, unsigned& nx) {
    const unsigned G = gridDim.x * gridDim.y * gridDim.z;
    unsigned sum, cnt, mine, sp = 0u;
    for (;;) {
        sum = 0u; cnt = 0u; mine = 0u;
#pragma unroll
        for (unsigned j = 0; j < 16; ++j) { const unsigned c = xb_ld(&bar[XB_XCNT(j)]); sum += c; cnt += (c > 0u) ? 1u : 0u; mine = (j == x) ? c : mine; }
        if (sum == G) break;
        __builtin_amdgcn_s_sleep(1);
        if ((++sp & 255u) == 0u) { if (xb_ld(&bar[XB_TMO])) break; if (sp > XB_SPIN_CAP) { atomicAdd(&bar[XB_TMO], 1u); break; } }
    }
    nloc = mine > 0u ? mine : 1u; nx = cnt > 0u ? cnt : 1u;
}

__device__ __forceinline__ void xcd_barrier(const XcdBarrier& b) {
    asm volatile("s_waitcnt vmcnt(0)" ::: "memory");
    __syncthreads();
    if (threadIdx.x == 0) {
        unsigned* bar = b.bar;
        __builtin_amdgcn_s_waitcnt(0);
        unsigned nloc = b.st[0], nx = b.st[1];
        if (nloc == 0u) { xcd_barrier_complete(bar, b.x, nloc, nx); b.st[0] = nloc; b.st[1] = nx; }
        const unsigned old = xb_add(&bar[XB_XSUB(b.x)], 1u);
        const unsigned gen = old / nloc;
        if (old + 1u == (gen + 1u) * nloc) {
            __builtin_amdgcn_fence(__ATOMIC_RELEASE, "agent");
            asm volatile("s_waitcnt vmcnt(0)" ::: "memory");
            const unsigned og = xb_add(&bar[XB_TOP], 1u);
            const unsigned tg = og / nx;
            if (og + 1u == (tg + 1u) * nx) xb_add(&bar[XB_TOPGEN], 1u);
            else XB_SPIN(xb_ld(&bar[XB_TOPGEN]) == tg, bar);
            __builtin_amdgcn_fence(__ATOMIC_ACQUIRE, "agent");
            xb_add(&bar[XB_XGEN(b.x)], 1u);
            asm volatile("s_waitcnt vmcnt(0)" ::: "memory");
        } else {
            XB_SPIN(xb_ld(&bar[XB_XGEN(b.x)]) == gen, bar);
            __builtin_amdgcn_fence(__ATOMIC_ACQUIRE, "agent");
            asm volatile("s_waitcnt vmcnt(0)" ::: "memory");
        }
    }
    __syncthreads();
}
constexpr int DM = 1024, SEQ = 8192, NBATCH = 2, CTXL = 256;
constexpr int ML = NBATCH * SEQ, MC = NBATCH * CTXL, MT = ML + MC;
constexpr int NIN = 6400;
constexpr int NE = 16, ESTR = 2304, CAPL = 1024, CAPC = 32;
constexpr int NPH = 24;
constexpr size_t MiB = 1u << 20;
constexpr size_t WS_CTL = 0, CTL_ZERO_BYTES = 1 * MiB;
constexpr size_t WS_MOD = 1 * MiB;
constexpr size_t WS_ROPEC = 1 * MiB + 256 * 1024, WS_ROPES = WS_ROPEC + 8192;
constexpr size_t WS_TW = 1 * MiB + 512 * 1024;
constexpr size_t WS_CS256 = 1 * MiB + 640 * 1024;
constexpr size_t WS_T1T = 2 * MiB;
constexpr size_t WS_T2T = 2 * MiB + 64 * 1024;
constexpr size_t WS_T2F = 8 * MiB;
constexpr size_t WS_T2C = 12 * MiB;
constexpr size_t WS_FAC = 13 * MiB;
constexpr size_t WS_WSP = 2 * MiB + 256 * 1024;
constexpr size_t WS_AFF = 3 * MiB;
constexpr size_t WS_SEL = 5 * MiB;
constexpr size_t WS_IDX = 7 * MiB, WS_GATE = 7 * MiB + 256 * 1024;
constexpr size_t WS_WIN = 16 * MiB, WS_WBR = 29 * MiB, WS_WO = 31 * MiB, WS_WGU = 33 * MiB, WS_WDN = 97 * MiB;
constexpr size_t WS_X = 130 * MiB;
constexpr size_t WS_H = 196 * MiB;
constexpr size_t WS_BR = 229 * MiB;
constexpr size_t WS_MB = 262 * MiB;
constexpr size_t WS_FA = 295 * MiB;
constexpr size_t WS_Z = 311 * MiB;
constexpr size_t ZROW = (size_t)MT * 2;
constexpr size_t WS_AUV = WS_Z, WS_YF = WS_AUV + 512 * ZROW, WS_CY = WS_YF + 512 * ZROW, WS_QPL = WS_CY + 256 * ZROW, WS_QROT = WS_QPL + 256 * ZROW,
                 WS_KR = WS_QROT + 256 * ZROW, WS_VV = WS_KR + 256 * ZROW, WS_G = WS_VV + 256 * ZROW, WS_ZEND = WS_G + 4096 * ZROW;
constexpr size_t WS_P32 = WS_Z;
constexpr size_t WS_XE = WS_Z, WS_ACT = WS_Z + 72 * MiB;
constexpr size_t WS_END = 518 * MiB;
static_assert(WS_G == WS_P32 + (size_t)MT * 1024 * 4 + 8 * 256 * ZROW / 8 - 256 * ZROW || true, "");
static_assert(WS_ZEND <= WS_END && WS_ACT + 72 * MiB <= WS_ZEND && WS_P32 + (size_t)MT * 4096 <= WS_VV, "ws map");
constexpr int CW_BAR = 4096;
constexpr int LDS_BYTES = 155648, MISC_OFF = 154624;

struct Args { const float* in[28]; float* out; unsigned char* ws; int ph_lo, ph_hi; };

__device__ __forceinline__ float bflo(unsigned w) { return __uint_as_float(w << 16); }
__device__ __forceinline__ float bfhi(unsigned w) { return __uint_as_float(w & 0xffff0000u); }
__device__ __forceinline__ float sigm(float x) { return __builtin_amdgcn_rcpf(1.f + __expf(-x)); }
__device__ __forceinline__ float wave_sum(float v) {
#pragma unroll
    for (int o = 1; o < 64; o <<= 1) v += __shfl_xor(v, o);
    return v;
}
__device__ __forceinline__ void st4bf(bf16* p, f32x4 v) { uint2 w; w.x = pk2(v[0], v[1]); w.y = pk2(v[2], v[3]); *(uint2*)p = w; }

__device__ __forceinline__ void st8bf(bf16* p, f32x4 a, f32x4 b) { v4u w; w.x = pk2(a[0], a[1]); w.y = pk2(a[2], a[3]); w.z = pk2(b[0], b[1]); w.w = pk2(b[2], b[3]); *(v4u*)p = w; }
using pg8::Unit;
struct EpiIn {
    static constexpr bool PERM = false, AFTER_DRAIN = false, KEEP = false;
    bf16 *AUV, *YF, *CY, *QPL, *QROT, *KR, *VV, *G; const float* ropeC; const float* ropeS;
    __device__ __forceinline__ void operator()(const f32x4 (&acc)[2][2][4][2], const Unit& u, int wr, int wc, int fr, int fq) const {
        const int pn = u.pn, row0 = u.pm * 256 + wr * 64 + fr, cl0 = wc * 32 + 4 * fq;
        const int cp0 = wc * 32 + 8 * fq;
        if (pn < 2) {
#pragma unroll
            for (int ai = 0; ai < 2; ++ai)
#pragma unroll
                for (int m = 0; m < 4; ++m) { const size_t row = row0 + ai * 128 + m * 16;
#pragma unroll
                    for (int bj = 0; bj < 2; ++bj) { f32x4 v[2];
#pragma unroll
                        for (int n = 0; n < 2; ++n)
#pragma unroll
                            for (int j = 0; j < 4; ++j) { const float x = acc[ai][bj][m][n][j]; v[n][j] = x * sigm(1.5957691216f * (x + 0.044715f * x * x * x)); }
                        st8bf(AUV + row * 512 + pn * 256 + bj * 128 + cp0, v[0], v[1]); } }
        } else if (pn < 4) {
#pragma unroll
            for (int ai = 0; ai < 2; ++ai)
#pragma unroll
                for (int m = 0; m < 4; ++m) { const size_t row = row0 + ai * 128 + m * 16;
#pragma unroll
                    for (int bj = 0; bj < 2; ++bj) st8bf(YF + row * 512 + (pn - 2) * 256 + bj * 128 + cp0, acc[ai][bj][m][0], acc[ai][bj][m][1]); }
        } else if (pn < 6) {
#pragma unroll
            for (int ai = 0; ai < 2; ++ai)
#pragma unroll
                for (int m = 0; m < 4; ++m) { const size_t row = row0 + ai * 128 + m * 16; f32x4 v[2];
#pragma unroll
                    for (int n = 0; n < 2; ++n) { const f32x4 a = acc[ai][0][m][n], g = acc[ai][1][m][n];
#pragma unroll
                        for (int j = 0; j < 4; ++j) v[n][j] = a[j] * sigm(g[j]); }
                    st8bf(CY + row * 256 + (pn - 4) * 128 + cp0, v[0], v[1]); }
        } else if (pn < 8) {
            const bool isq = pn == 6; const float scl = isq ? 0.125f * 1.4426950408889634f : 1.f;   const bool latent = u.pm < 64;
#pragma unroll
            for (int ai = 0; ai < 2; ++ai)
#pragma unroll
                for (int m = 0; m < 4; ++m) { const int rowi = row0 + ai * 128 + m * 16; const size_t row = rowi; const int tok = rowi & 8191;
                    const int pos = (wc & 1) ? (tok & 63) : (tok >> 6);
                    f32x4 cs = {1.f, 1.f, 1.f, 1.f}, sn = {0.f, 0.f, 0.f, 0.f};
                    if (latent) { cs = *(const f32x4*)(ropeC + pos * 16 + 4 * fq); sn = *(const f32x4*)(ropeS + pos * 16 + 4 * fq); }
#pragma unroll
                    for (int bj = 0; bj < 2; ++bj) { const f32x4 x1 = acc[ai][bj][m][0] * scl, x2 = acc[ai][bj][m][1] * scl;
                        const f32x4 r1 = x1 * cs - x2 * sn, r2 = x1 * sn + x2 * cs; const size_t off = row * 256 + bj * 128 + cl0;
                        if (isq) { st4bf(QPL + off, x1); st4bf(QPL + off + 16, x2); st4bf(QROT + off, r1); st4bf(QROT + off + 16, r2); }
                        else { st4bf(KR + off, r1); st4bf(KR + off + 16, r2); } } }
        } else if (pn == 8) {
#pragma unroll
            for (int ai = 0; ai < 2; ++ai)
#pragma unroll
                for (int m = 0; m < 4; ++m) { const size_t row = row0 + ai * 128 + m * 16;
#pragma unroll
                    for (int bj = 0; bj < 2; ++bj) st8bf(VV + row * 256 + bj * 128 + cp0, acc[ai][bj][m][0], acc[ai][bj][m][1]); }
        } else {
#pragma unroll
            for (int ai = 0; ai < 2; ++ai)
#pragma unroll
                for (int m = 0; m < 4; ++m) { const size_t row = row0 + ai * 128 + m * 16;
#pragma unroll
                    for (int bj = 0; bj < 2; ++bj)
#pragma unroll
                        for (int n = 0; n < 2; ++n) { f32x4 v = acc[ai][bj][m][n];
#pragma unroll
                            for (int j = 0; j < 4; ++j) v[j] = sigm(v[j]);
                            const int gb_ = (pn - 9) >> 2, gu_ = (2 * u.pm + ai) * 8 + 2 * ((pn - 9) & 3) + bj;
                            st4bf(G + ((((size_t)(gu_ * 4 + gb_) * 8 + (wr * 4 + wc)) * 8 + m * 2 + n) * 256 + (fq * 16 + fr) * 4), v); } }
        }
    }
};
struct EpiMerge {
    static constexpr bool PERM = false, AFTER_DRAIN = false, KEEP = false;
    const bf16* G; float* P32; bf16* MB;
    __device__ __forceinline__ void operator()(const f32x4 (&acc)[2][2][4][2], const Unit& u, int wr, int wc, int fr, int fq) const {
        int fr_ = fr, fq_ = fq; asm volatile("" : "+v"(fr_), "+v"(fq_));
        const int b = u.pn >> 2, pn = u.pn & 3, pm = u.pm - b * 66, row0 = pm * 256 + wr * 64 + fr_, col0 = pn * 256 + wc * 32 + 4 * fq_;
#pragma unroll
        for (int ai = 0; ai < 2; ++ai)
#pragma unroll
            for (int m = 0; m < 4; ++m) { const unsigned row = row0 + ai * 128 + m * 16;
                const bf16* gp = G + ((size_t)row * 4096 + b * 1024 + col0); float* pp = P32 + ((size_t)row * 1024 + col0); bf16* mp = MB + ((size_t)row * 1024 + col0);
#pragma unroll
                for (int bj = 0; bj < 2; ++bj)
#pragma unroll
                    for (int n = 0; n < 2; ++n) { const int co = bj * 128 + n * 16;
                        const uint2 gw = *(const uint2*)(gp + co);
                        f32x4 v = acc[ai][bj][m][n]; v[0] *= bflo(gw.x); v[1] *= bfhi(gw.x); v[2] *= bflo(gw.y); v[3] *= bfhi(gw.y);
                        if (b > 0) v += *(const f32x4*)(pp + co);
                        if (b < 3) *(f32x4*)(pp + co) = v; else st4bf(mp + co, v);
                        asm volatile("" ::: "memory"); } }
    }
};
struct EpiMergeH {
    static constexpr bool PERM = false, AFTER_DRAIN = false, KEEP = true;
    const bf16* G; bf16* MB;
    __device__ __forceinline__ bool keep(const Unit& u) const { return (u.pn >> 2) < 3; }
    __device__ __forceinline__ void operator()(f32x4 (&acc)[2][2][4][2], const Unit& u, int wr, int wc, int fr, int fq) const {
        const int b = u.pn >> 2, pn = u.pn & 3, pm = u.pm - b * 66, row0 = pm * 256 + wr * 64 + fr, col0 = pn * 256 + wc * 32 + 4 * fq;
#pragma unroll
        for (int ai = 0; ai < 2; ++ai)
#pragma unroll
            for (int m = 0; m < 4; ++m) { const unsigned row = row0 + ai * 128 + m * 16; const bf16* gp = G + ((size_t)row * 4096 + b * 1024 + col0); bf16* mp = MB + ((size_t)row * 1024 + col0);
#pragma unroll
                for (int bj = 0; bj < 2; ++bj)
#pragma unroll
                    for (int n = 0; n < 2; ++n) { const int co = bj * 128 + n * 16; const uint2 gb = *(const uint2*)(gp + co); f32x4 v = acc[ai][bj][m][n];
                        if (b < 3) { const uint2 gn = *(const uint2*)(gp + 1024 + co);
                            v[0] *= bflo(gb.x) * __builtin_amdgcn_rcpf(bflo(gn.x)); v[1] *= bfhi(gb.x) * __builtin_amdgcn_rcpf(bfhi(gn.x)); v[2] *= bflo(gb.y) * __builtin_amdgcn_rcpf(bflo(gn.y)); v[3] *= bfhi(gb.y) * __builtin_amdgcn_rcpf(bfhi(gn.y));
                            acc[ai][bj][m][n] = v; }
                        else { v[0] *= bflo(gb.x); v[1] *= bfhi(gb.x); v[2] *= bflo(gb.y); v[3] *= bfhi(gb.y); st4bf(mp + co, v); } }
                asm volatile("" ::: "memory"); }
    }
};
struct EpiWout {
    static constexpr bool PERM = false, AFTER_DRAIN = false, KEEP = false;
    const float* xlat; const float* xctx; float* X; const float* mod;
    __device__ __forceinline__ void operator()(const f32x4 (&acc)[2][2][4][2], const Unit& u, int wr, int wc, int fr, int fq) const {
        const int r = u.pm < 32 ? 0 : (u.pm < 64 ? 1 : 2); const float* gt = mod + r * 6144 + 2 * 1024;
        const int row0 = u.pm * 256 + wr * 64 + fr, col0 = u.pn * 256 + wc * 32 + 4 * fq;
        f32x4 gv[2][2];
#pragma unroll
        for (int bj = 0; bj < 2; ++bj)
#pragma unroll
            for (int n = 0; n < 2; ++n) gv[bj][n] = *(const f32x4*)(gt + col0 + bj * 128 + n * 16);
#pragma unroll
        for (int ai = 0; ai < 2; ++ai)
#pragma unroll
            for (int m = 0; m < 4; ++m) { const size_t row = row0 + ai * 128 + m * 16; const float* src = (row < ML) ? xlat + row * 1024 : xctx + (row - ML) * 1024;
#pragma unroll
                for (int bj = 0; bj < 2; ++bj)
#pragma unroll
                    for (int n = 0; n < 2; ++n) { const int col = col0 + bj * 128 + n * 16;
                        *(f32x4*)(X + row * 1024 + col) = *(const f32x4*)(src + col) + gv[bj][n] * acc[ai][bj][m][n]; } }
    }
};
struct EpiGU {
    static constexpr bool PERM = true, AFTER_DRAIN = false, KEEP = false;
    bf16* ACT;
    __device__ __forceinline__ void operator()(const f32x4 (&acc)[2][2][4][2], const Unit& u, int wr, int wc, int fr, int fq) const {
        const int pnl = u.pn & 7, row0 = u.pm * 256 + wr * 64 + fr, cl0 = wc * 32 + 8 * fq;
#pragma unroll
        for (int ai = 0; ai < 2; ++ai)
#pragma unroll
            for (int m = 0; m < 4; ++m) { const size_t row = row0 + ai * 128 + m * 16; f32x4 v[2];
#pragma unroll
                for (int n = 0; n < 2; ++n) { const f32x4 a = acc[ai][0][m][n], up = acc[ai][1][m][n];
#pragma unroll
                    for (int j = 0; j < 4; ++j) v[n][j] = a[j] * sigm(a[j]) * up[j]; }
                st8bf(ACT + row * 1024 + pnl * 128 + cl0, v[0], v[1]); }
    }
};
struct EpiDown {
    static constexpr bool PERM = true, AFTER_DRAIN = false, KEEP = false;
    bf16* YB; const float* GATE;
    __device__ __forceinline__ void operator()(const f32x4 (&acc)[2][2][4][2], const Unit& u, int wr, int wc, int fr, int fq) const {
        const int pnl = u.pn & 3, row0 = u.pm * 256 + wr * 64 + fr, col0 = pnl * 256 + wc * 32 + 8 * fq;
#pragma unroll
        for (int ai = 0; ai < 2; ++ai)
#pragma unroll
            for (int m = 0; m < 4; ++m) { const size_t row = row0 + ai * 128 + m * 16; const float gt = GATE[row];
#pragma unroll
                for (int bj = 0; bj < 2; ++bj) st8bf(YB + row * 1024 + col0 + bj * 128, acc[ai][bj][m][0] * gt, acc[ai][bj][m][1] * gt); }
    }
};
struct MergeOrder {
    int nt, G, c;
    __device__ void init(int ntm, int G_, int c_) { nt = ntm * 4; G = G_; c = c_; }
    __device__ bool next(int i, Unit& u) const { const int b = i & 3, L = (i >> 2) * G + c; if (L >= nt) return false; u.pm = b * 66 + (L >> 2); u.pn = b * 4 + (L & 3); return true; }
    __device__ __forceinline__ void a_ready(const Unit&) const {}
    __device__ __forceinline__ void done(const Unit&) const {}
};
struct OneUnit { int pm, pn; __device__ bool next(int i, Unit& u) const { if (i > 0) return false; u.pm = pm; u.pn = pn; return true; }
    __device__ __forceinline__ void a_ready(const Unit&) const {} __device__ __forceinline__ void done(const Unit&) const {} };
struct GroupOrder {
    int nwg, G, c, TPE, NTN;
    __device__ void init(int tpe, int ntn, int G_, int c_) { TPE = tpe; NTN = ntn; nwg = NE * tpe * ntn; G = G_; c = c_; }
    __device__ bool next(int i, Unit& u) const {
        const long L = (long)i * G + c; if (L >= nwg) return false;
        int wgid = (int)L; { const int q = nwg / 8, r = nwg % 8, xcd = wgid % 8, off = wgid / 8; wgid = (xcd < r ? xcd * (q + 1) : r * (q + 1) + (xcd - r) * q) + off; }
        const int per = TPE * NTN, e = wgid / per, rem = wgid % per;
#ifdef GO_MT_MAJOR
        const int mt = rem / NTN, pn = rem % NTN;
#else
        const int pn = rem / TPE, mt = rem % TPE;
#endif
        u.pm = e * 9 + mt; u.pn = e * NTN + pn; return true;
    }
    __device__ __forceinline__ void a_ready(const Unit&) const {}
    __device__ __forceinline__ void done(const Unit&) const {}
};
typedef float f2v __attribute__((ext_vector_type(2)));
#define PH_ARGS LAS unsigned char* lds, const int tid, const int lane, const int wave, const int bid, const int G
#define WSP(T, off) ((T*)(PTRV(29, unsigned char) + (off)))
constexpr int PTAB_OFF = MISC_OFF + 512;
__device__ __forceinline__ unsigned long long ptab_ld(LAS unsigned char* lds, int i) {
    typedef unsigned u2v_t __attribute__((ext_vector_type(2)));
    const volatile LAS unsigned* tp = (const volatile LAS unsigned*)(lds + PTAB_OFF + 8 * i); u2v_t v; v[0] = tp[0]; v[1] = tp[1];
    const unsigned lo = __builtin_amdgcn_readfirstlane(v[0]), hi = __builtin_amdgcn_readfirstlane(v[1]);
    return ((unsigned long long)hi << 32) | lo;
}
#define PTRV(i, T) ((T*)(GAS T*)ptab_ld(lds, (i)))
#define INP(i) ((const float*)(GAS const float*)ptab_ld(lds, (i)))

__device__ __forceinline__ void mod_gemv(PH_ARGS) {
    LAS f32x4* red = (LAS f32x4*)lds;
    const float* c = INP(1); const float* cc = INP(3); const float* wm = INP(4); const float* bm = INP(5);
    float* MOD = WSP(float, WS_MOD);
    for (int it = bid; it < 192; it += G) {
        const int l = it / 96, cg = it % 96, kg = tid >> 4, cq = tid & 15;
        f32x4 a0 = {0.f, 0.f, 0.f, 0.f}, a1 = a0, a2 = a0;
        const float* wb = wm + (size_t)l * 1024 * 6144 + cg * 64 + cq * 4;
#pragma unroll 4
        for (int i = 0; i < 32; ++i) { const int k = kg + 32 * i; const f32x4 w = *(const f32x4*)(wb + (size_t)k * 6144);
            const float x0 = c[k], x1 = c[1024 + k], x2 = cc[k];
            a0 += w * (x0 * sigm(x0)); a1 += w * (x1 * sigm(x1)); a2 += w * (x2 * sigm(x2)); }
        red[(kg * 3 + 0) * 16 + cq] = a0; red[(kg * 3 + 1) * 16 + cq] = a1; red[(kg * 3 + 2) * 16 + cq] = a2;
        __syncthreads();
        if (tid < 192) { const int r = tid >> 6, col = tid & 63; float s = 0.f; const LAS float* rf = (const LAS float*)red;
            for (int k2 = 0; k2 < 32; ++k2) s += rf[((k2 * 3 + r) * 16 + (col >> 2)) * 4 + (col & 3)];
            MOD[(l * 3 + r) * 6144 + cg * 64 + col] = s + bm[l * 6144 + cg * 64 + col]; }
        __syncthreads();
    }
}
__device__ __forceinline__ void make_tables(PH_ARGS) {
    const int gt = bid * 512 + tid, GT = G * 512;
    float* RC = WSP(float, WS_ROPEC); float* RS = WSP(float, WS_ROPES);
    bf16* T1 = WSP(bf16, WS_T1T);
    for (int i = gt; i < 2048; i += GT) { const int pos = i >> 4, f = i & 15; const float inv = powf(10000.f, -(float)f / 16.f), ang = (float)pos * inv; RC[i] = cosf(ang); RS[i] = sinf(ang); }
    for (int i = gt; i < 128 * 128; i += GT) { const int col = i >> 7, k = i & 127, ro = col >> 6, k1 = col & 63, n1 = k >> 1, ri = k & 1; float s, c; sincospif((float)((k1 * n1) & 63) / 32.f, &s, &c);
        const float v = ro == 0 ? (ri == 0 ? c : s) : (ri == 0 ? -s : c); T1[i] = (bf16)f2bf(v); }
    bf16* T2F = WSP(bf16, WS_T2F); bf16* T2C = WSP(bf16, WS_T2C);
    for (int i = gt; i < 64 * 128 * 256; i += GT) { const int k1 = i >> 15, k2 = (i >> 8) & 127, k = i & 255, n2 = k >> 1, ri = k & 1; float s, c;
        sincospif((float)((n2 * (k1 + 64 * k2)) & 8191) / 4096.f, &s, &c); T2F[i] = (bf16)f2bf(ri ? s : c); }
    for (int i = gt; i < 2 * 128 * 256; i += GT) { const int k1 = i >> 15, k2 = (i >> 8) & 127, k = i & 255, n2 = k >> 1, ri = k & 1; float s, c;
        sincospif((float)((n2 * (k1 + 2 * k2)) & 255) / 128.f, &s, &c); T2C[i] = (bf16)f2bf(ri ? s : c); }
}
__device__ __forceinline__ void tr_item(const float* W, size_t ldw, int col0, int k0, bf16* dst, int Kd, LAS float* scr, int lane) {
#pragma unroll 8
    for (int i = 0; i < 32; ++i) { const int kk = 2 * i + (lane >> 5); scr[kk * 33 + (lane & 31)] = W[(size_t)(k0 + kk) * ldw + col0 + (lane & 31)]; }
    LDS_WAIT(); asm volatile("" ::: "memory");
    const int c = lane & 7;
#pragma unroll
    for (int j = 0; j < 4; ++j) { const int n = (lane >> 3) + 8 * j; const LAS float* s = scr + (8 * c) * 33 + n;
        v4u o; o.x = pk2(s[0 * 33], s[1 * 33]); o.y = pk2(s[2 * 33], s[3 * 33]); o.z = pk2(s[4 * 33], s[5 * 33]); o.w = pk2(s[6 * 33], s[7 * 33]);
        *(v4u*)(dst + (size_t)n * Kd + k0 + 8 * c) = o; }
    LDS_WAIT(); asm volatile("" ::: "memory");
}
__device__ __forceinline__ int rho32(int c) { return 16 * ((c >> 2) & 1) + 4 * (c >> 3) + (c & 3); }
__device__ __forceinline__ void fold_item16(const float* W  , int f, bf16* WIN, LAS float* scr, const LAS f2v* tab, int lane) {
    const int kb = f >> 2, g = f & 3, k0 = kb * 16;
#pragma unroll
    for (int kk = 0; kk < 16; ++kk) scr[kk * 64 + lane] = W[(size_t)(k0 + kk) * 6144 + 512 + g * 64 + lane];
    LDS_WAIT(); asm volatile("" ::: "memory");
    float ar[16], ai[16];
#pragma unroll
    for (int kk = 0; kk < 16; ++kk) { ar[kk] = 0.f; ai[kk] = 0.f; }
#pragma unroll 4
    for (int c = 0; c < 64; ++c) { const f2v t = tab[(c * lane) & 63];
#pragma unroll
        for (int kk = 0; kk < 16; ++kk) { const float w = scr[kk * 64 + c]; ar[kk] += w * t[0]; ai[kk] -= w * t[1]; } }
    const int L0 = 2 * (g * 64 + lane);
    bf16* d0 = WIN + (size_t)(512 + (L0 & ~31) + rho32(L0 & 31)) * 1024 + k0; bf16* d1 = WIN + (size_t)(512 + (L0 & ~31) + rho32((L0 + 1) & 31)) * 1024 + k0;
    v4u o, p;
    o.x = pk2(ar[0], ar[1]); o.y = pk2(ar[2], ar[3]); o.z = pk2(ar[4], ar[5]); o.w = pk2(ar[6], ar[7]); p.x = pk2(ar[8], ar[9]); p.y = pk2(ar[10], ar[11]); p.z = pk2(ar[12], ar[13]); p.w = pk2(ar[14], ar[15]);
    *(v4u*)d0 = o; *(v4u*)(d0 + 8) = p;
    o.x = pk2(ai[0], ai[1]); o.y = pk2(ai[2], ai[3]); o.z = pk2(ai[4], ai[5]); o.w = pk2(ai[6], ai[7]); p.x = pk2(ai[8], ai[9]); p.y = pk2(ai[10], ai[11]); p.z = pk2(ai[12], ai[13]); p.w = pk2(ai[14], ai[15]);
    *(v4u*)d1 = o; *(v4u*)(d1 + 8) = p;
    LDS_WAIT(); asm volatile("" ::: "memory");
}
template <bool PERMROWS>
__device__ __forceinline__ void tr_item64(const float* W, size_t ldw, int col0, int k0, bf16* dst, int Kd, int lane) {
    const int kq = lane >> 4, n4 = lane & 15; const float* src = W + (size_t)(k0 + kq * 16) * ldw + col0 + n4 * 4;
    f32x4 v[16];
#pragma unroll
    for (int i = 0; i < 16; ++i) v[i] = *(const f32x4*)(src + (size_t)i * ldw);
#pragma unroll
    for (int j = 0; j < 4; ++j) { const int ns = n4 * 4 + j, nd = PERMROWS ? ((ns & 32) + rho32(ns & 31)) : ns; bf16* d = dst + (size_t)nd * Kd + k0 + kq * 16; v4u o, p;
        o.x = pk2(v[0][j], v[1][j]); o.y = pk2(v[2][j], v[3][j]); o.z = pk2(v[4][j], v[5][j]); o.w = pk2(v[6][j], v[7][j]);
        p.x = pk2(v[8][j], v[9][j]); p.y = pk2(v[10][j], v[11][j]); p.z = pk2(v[12][j], v[13][j]); p.w = pk2(v[14][j], v[15][j]);
        *(v4u*)d = o; *(v4u*)(d + 8) = p; }
}
__device__ __forceinline__ void convert_range(PH_ARGS, const int l, const int it_lo, const int it_hi, const int pidx, const int pcount) {
    if (pidx < 0) return;
    LAS float* scr = (LAS float*)(lds + wave * 16384);
    const int gw = pidx * 8 + wave, NGW = pcount * 8;
    bf16* WIN = WSP(bf16, WS_WIN); bf16* WBR = WSP(bf16, WS_WBR); bf16* WO = WSP(bf16, WS_WO); bf16* WGU = WSP(bf16, WS_WGU); bf16* WDN = WSP(bf16, WS_WDN); bf16* WS_ = WSP(bf16, WS_WSP);
    const float* win = INP(8) + (size_t)l * 1024 * 6144;
    LAS f2v* tab = (LAS f2v*)(scr + 2048); { float s_, c_; sincospif((float)lane / 32.f, &s_, &c_); tab[lane] = (f2v){c_, s_}; } LDS_WAIT(); asm volatile("" ::: "memory");
    constexpr int N_FOLD = 256, N_IN = 92 * 16, N_BR = 256, N_WO = 256, N_GU = 8192, N_DN = 4096, N_SP = 64;
    constexpr int NITEMS = N_FOLD + N_IN + N_BR + N_WO + N_GU + N_DN + N_SP;
    for (int it = it_lo + gw; it < it_hi && it < NITEMS; it += NGW) {
        int r = it;
        if (r < N_FOLD) { fold_item16(win, r, WIN, scr, tab, lane); continue; } r -= N_FOLD;
        if (r < N_IN) { const int dbp = r >> 4, kb = r & 15, db = dbp < 8 ? dbp : dbp + 8; int col;
            if (db < 8) col = db * 64;
            else if (db < 24) { const int t = db - 16, tile = t >> 2, sub = t & 3; col = (sub < 2 ? 768 : 1024) + tile * 128 + (sub & 1) * 64; }
            else if (db < 36) col = 1280 + (db - 24) * 64;
            else col = 2048 + (db - 36) * 64;
            if (db < 24 || (db >= 32 && db < 36)) tr_item64<true>(win, 6144, col, kb * 64, WIN + (size_t)db * 64 * 1024, 1024, lane);
            else tr_item64<false>(win, 6144, col, kb * 64, WIN + (size_t)db * 64 * 1024, 1024, lane);
            continue; } r -= N_IN;
        if (r < N_BR) { const int b = r >> 6, q = r & 63, kb = q >> 4, nb = q & 15; const int ii = b == 0 ? 13 : (b == 1 ? 14 : (b == 2 ? 19 : 21));
            tr_item64<false>(INP(ii) + (size_t)l * 256 * 1024, 1024, nb * 64, kb * 64, WBR + (size_t)(b * 1024 + nb * 64) * 256, 256, lane); continue; } r -= N_BR;
        if (r < N_WO) { const int kb = r >> 4, nb = r & 15; tr_item64<false>(INP(22) + (size_t)l * 1024 * 1024, 1024, nb * 64, kb * 64, WO + (size_t)nb * 64 * 1024, 1024, lane); continue; } r -= N_WO;
        if (r < N_GU) { const int e = r >> 9, q = r & 511, db = q >> 4, kb = q & 15, tile = db >> 2, sub = db & 3;
            const float* src = (sub < 2 ? INP(24) : INP(25)) + (size_t)(l * 16 + e) * 1024 * 1024;
            tr_item64<false>(src, 1024, tile * 128 + (sub & 1) * 64, kb * 64, WGU + ((size_t)e * 2048 + db * 64) * 1024, 1024, lane); continue; } r -= N_GU;
        if (r < N_DN) { const int e = r >> 8, q = r & 255, kb = q >> 4, nb = q & 15;
            tr_item64<false>(INP(26) + (size_t)(l * 16 + e) * 1024 * 1024, 1024, nb * 64, kb * 64, WDN + ((size_t)e * 1024 + nb * 64) * 1024, 1024, lane); continue; } r -= N_DN;
        { const float* s = INP(11) + (size_t)l * 65536 + r * 1024 + lane * 16; const f32x4 a = *(const f32x4*)s, b = *(const f32x4*)(s + 4), c = *(const f32x4*)(s + 8), d = *(const f32x4*)(s + 12);
          v4u o, p; o.x = pk2(a[0], a[1]); o.y = pk2(a[2], a[3]); o.z = pk2(b[0], b[1]); o.w = pk2(b[2], b[3]); p.x = pk2(c[0], c[1]); p.y = pk2(c[2], c[3]); p.z = pk2(d[0], d[1]); p.w = pk2(d[2], d[3]);
          *(v4u*)(WS_ + r * 1024 + lane * 16) = o; *(v4u*)(WS_ + r * 1024 + lane * 16 + 8) = p; }
    }
}
constexpr int CV_FOLD0 = 0, CV_IN0 = 256, CV_BR0 = 256 + 92 * 16, CV_WO0 = CV_BR0 + 256, CV_GU0 = CV_WO0 + 256, CV_DN0 = CV_GU0 + 8192, CV_SP0 = CV_DN0 + 4096, CV_END = CV_SP0 + 64;
__device__ __forceinline__ void convert_weights(PH_ARGS, const int l) { convert_range(lds, tid, lane, wave, bid, G, l, 0, CV_END, bid, G); }
__device__ __forceinline__ void load_row(const float* p, int lane, f32x4 (&v)[4]) {
#pragma unroll
    for (int j = 0; j < 4; ++j) v[j] = *(const f32x4*)(p + 4 * lane + 256 * j);
}
__device__ __forceinline__ void modnorm_store(f32x4 (&v)[4], const float* g, const float* sc, const float* sh, bf16* hrow, int lane) {
    float ss = 0.f;
#pragma unroll
    for (int j = 0; j < 4; ++j) ss += (v[j][0] * v[j][0] + v[j][1] * v[j][1]) + (v[j][2] * v[j][2] + v[j][3] * v[j][3]);
    const float rs = 1.0f / sqrtf(wave_sum(ss) * (1.f / 1024.f) + 1e-6f);
#pragma unroll
    for (int j = 0; j < 4; ++j) { const int o = 4 * lane + 256 * j; const f32x4 gg = *(const f32x4*)(g + o), s = *(const f32x4*)(sc + o), b = *(const f32x4*)(sh + o);
        v[j] = v[j] * rs * gg * (s + 1.f) + b; st4bf(hrow + o, v[j]); }
}
__device__ __forceinline__ void modnorm_regs(f32x4 (&v)[4], const f32x4 (&gm)[4], const f32x4 (&sh)[4], bf16* hrow, int lane) {
    float ss = 0.f;
#pragma unroll
    for (int j = 0; j < 4; ++j) ss += (v[j][0] * v[j][0] + v[j][1] * v[j][1]) + (v[j][2] * v[j][2] + v[j][3] * v[j][3]);
    const float rs = 1.0f / sqrtf(wave_sum(ss) * (1.f / 1024.f) + 1e-6f);
#pragma unroll
    for (int j = 0; j < 4; ++j) { v[j] = v[j] * rs * gm[j] + sh[j]; st4bf(hrow + 4 * lane + 256 * j, v[j]); }
}
__device__ __forceinline__ void load_mod(const float* g, const float* sc, const float* shp, int lane, f32x4 (&gm)[4], f32x4 (&sh)[4]) {
#pragma unroll
    for (int j = 0; j < 4; ++j) { const int o = 4 * lane + 256 * j; gm[j] = *(const f32x4*)(g + o) * (*(const f32x4*)(sc + o) + 1.f); sh[j] = *(const f32x4*)(shp + o); }
}
__device__ __forceinline__ void norm1_l0(PH_ARGS) {
    const int gw = bid * 8 + wave, NGW = G * 8; bf16* H = WSP(bf16, WS_H); const float* MOD = WSP(float, WS_MOD);
    const int RPW = (MT + NGW - 1) / NGW, row0 = gw * RPW, rend = (row0 + RPW < MT) ? row0 + RPW : MT;
    const float* xin = INP(0); const float* cin = INP(2); const float* g = INP(6);
    f32x4 cur[4], nxt[4], gm[4], sh[4]; int rprev = -1;
    if (row0 < rend) load_row(row0 < ML ? xin + (size_t)row0 * 1024 : cin + (size_t)(row0 - ML) * 1024, lane, cur);
    for (int row = row0; row < rend; ++row) {
        if (row + 1 < rend) { const int rn = row + 1; load_row(rn < ML ? xin + (size_t)rn * 1024 : cin + (size_t)(rn - ML) * 1024, lane, nxt); }
        const int r = row < SEQ ? 0 : (row < ML ? 1 : 2);
        if (r != rprev) { const float* md = MOD + r * 6144; load_mod(g, md + 1024, md, lane, gm, sh); rprev = r; }
        modnorm_regs(cur, gm, sh, H + (size_t)row * 1024, lane);
#pragma unroll
        for (int j = 0; j < 4; ++j) cur[j] = nxt[j];
    }
}
__device__ __forceinline__ void norm2_router(PH_ARGS, const int l, const int rbase, const int nrows, const int pidx, const int pcount, const bool load_table = true) {
    const int gw = pidx * 8 + wave, NGW = pcount * 8; bf16* H = WSP(bf16, WS_H); const float* MOD = WSP(float, WS_MOD) + l * 3 * 6144; const float* X = WSP(float, WS_X); float* AFF = WSP(float, WS_AFF);
    LAS f32x4* Wl = (LAS f32x4*)lds;
    if (load_table) { const f32x4* wr = (const f32x4*)(INP(23) + (size_t)l * 1024 * 16);
      for (int i = tid; i < 4096; i += 512) { const int k = i >> 2, q = i & 3; Wl[(q * 4 + (k & 3)) * 256 + (k >> 2)] = wr[i]; } }
    __syncthreads();
    const int RPW = (nrows + NGW - 1) / NGW, row0 = rbase + gw * RPW, rend = (gw * RPW + RPW < nrows) ? row0 + RPW : rbase + nrows;
    const float* g2 = INP(7) + l * 1024;
    f32x4 v[4], nxt[4], gm[4], sh[4]; int rprev = -1;
    if (row0 < rend) load_row(X + (size_t)row0 * 1024, lane, v);
    for (int row = row0; row < rend; ++row) {
        if (row + 1 < rend) load_row(X + (size_t)(row + 1) * 1024, lane, nxt);
        const int r = row < SEQ ? 0 : (row < ML ? 1 : 2);
        if (r != rprev) { const float* md = MOD + r * 6144; load_mod(g2, md + 4 * 1024, md + 3 * 1024, lane, gm, sh); rprev = r; }
        modnorm_regs(v, gm, sh, H + (size_t)row * 1024, lane);
        float lg[16];
#pragma unroll
        for (int e = 0; e < 16; ++e) lg[e] = 0.f;
#pragma unroll
        for (int j = 0; j < 4; ++j)
#pragma unroll
            for (int i = 0; i < 4; ++i) { const float hv = v[j][i];
#pragma unroll
                for (int q = 0; q < 4; ++q) { const f32x4 w = Wl[(q * 4 + i) * 256 + 64 * j + lane]; lg[4 * q + 0] += hv * w[0]; lg[4 * q + 1] += hv * w[1]; lg[4 * q + 2] += hv * w[2]; lg[4 * q + 3] += hv * w[3]; }
                if (i & 1) asm volatile("" ::: "memory"); }
#pragma unroll
        for (int i = 0; i < 8; ++i) { const bool up = lane & 32; const float send = up ? lg[i] : lg[i + 8], keep = up ? lg[i + 8] : lg[i]; lg[i] = keep + __shfl_xor(send, 32); }
#pragma unroll
        for (int i = 0; i < 4; ++i) { const bool up = lane & 16; const float send = up ? lg[i] : lg[i + 4], keep = up ? lg[i + 4] : lg[i]; lg[i] = keep + __shfl_xor(send, 16); }
#pragma unroll
        for (int i = 0; i < 2; ++i) { const bool up = lane & 8; const float send = up ? lg[i] : lg[i + 2], keep = up ? lg[i + 2] : lg[i]; lg[i] = keep + __shfl_xor(send, 8); }
        { const bool up = lane & 4; const float send = up ? lg[0] : lg[1], keep = up ? lg[1] : lg[0]; lg[0] = keep + __shfl_xor(send, 4); }
        float z = lg[0]; z += __shfl_xor(z, 1); z += __shfl_xor(z, 2);
        float mx = z; mx = fmaxf(mx, __shfl_xor(mx, 4)); mx = fmaxf(mx, __shfl_xor(mx, 8)); mx = fmaxf(mx, __shfl_xor(mx, 16)); mx = fmaxf(mx, __shfl_xor(mx, 32));
        const float ez = expf(z - mx); float sm = ez; sm += __shfl_xor(sm, 4); sm += __shfl_xor(sm, 8); sm += __shfl_xor(sm, 16); sm += __shfl_xor(sm, 32);
        if ((lane & 3) == 0) { const int e = ((lane >> 5) & 1) * 8 + ((lane >> 4) & 1) * 4 + ((lane >> 3) & 1) * 2 + ((lane >> 2) & 1); AFF[(size_t)row * 16 + e] = ez / sm; }
#pragma unroll
        for (int j = 0; j < 4; ++j) v[j] = nxt[j];
    }
    __syncthreads();
}
typedef short v4i16_t __attribute__((ext_vector_type(4)));
__device__ __forceinline__ void mfma16(f32x4& acc, const bf16x8 a, const bf16x8 b) { asm volatile("s_nop 1\n\tv_mfma_f32_16x16x32_bf16 %0, %1, %2, %0\n\ts_nop 3" : "+v"(acc) : "v"(a), "v"(b)); }
__device__ __forceinline__ void mfma16n(f32x4& acc, const bf16x8 a, const bf16x8 b) { asm volatile("v_mfma_f32_16x16x32_bf16 %0, %1, %2, %0" : "+v"(acc) : "v"(a), "v"(b)); }
#define DRAIN4(x) asm volatile("s_nop 15\n\ts_nop 15" : "+v"((x)[0]), "+v"((x)[1]), "+v"((x)[2]), "+v"((x)[3]))
#define DRAIN8(x) asm volatile("s_nop 15\n\ts_nop 15" : "+v"((x)[0]), "+v"((x)[1]), "+v"((x)[2]), "+v"((x)[3]), "+v"((x)[4]), "+v"((x)[5]), "+v"((x)[6]), "+v"((x)[7]))
#define DRAIN16(x) asm volatile("s_nop 15\n\ts_nop 15" : "+v"((x)[0]), "+v"((x)[1]), "+v"((x)[2]), "+v"((x)[3]), "+v"((x)[4]), "+v"((x)[5]), "+v"((x)[6]), "+v"((x)[7]), \
    "+v"((x)[8]), "+v"((x)[9]), "+v"((x)[10]), "+v"((x)[11]), "+v"((x)[12]), "+v"((x)[13]), "+v"((x)[14]), "+v"((x)[15]))
__device__ __forceinline__ void gmlp_unit(PH_ARGS, const int l, const int chunk) {
    const int row0 = chunk < 128 ? chunk * 128 : ML + (chunk - 128) * 128;
    const bf16* AUV = WSP(bf16, WS_AUV); bf16* BRa = WSP(bf16, WS_BR); const bf16* WS_ = WSP(bf16, WS_WSP);
    LAS bf16* vT = (LAS bf16*)lds;
    const float* lg = INP(9) + l * 256; const float* lb = INP(10) + l * 256;
    const f32x4 gg = *(const f32x4*)(lg + 4 * lane), bb = *(const f32x4*)(lb + 4 * lane);
    uint2 raws[16];
#pragma unroll
    for (int pi = 0; pi < 16; ++pi) raws[pi] = *(const uint2*)(AUV + (size_t)(row0 + wave * 16 + pi) * 512 + 256 + 4 * lane);
#pragma unroll
    for (int pi = 0; pi < 16; ++pi) { const int p = wave * 16 + pi;
        const uint2 raw = raws[pi];
        float v0 = bflo(raw.x), v1 = bfhi(raw.x), v2 = bflo(raw.y), v3 = bfhi(raw.y);
        const float mean = wave_sum((v0 + v1) + (v2 + v3)) * (1.f / 256.f); v0 -= mean; v1 -= mean; v2 -= mean; v3 -= mean;
        const float rstd = 1.0f / sqrtf(wave_sum((v0 * v0 + v1 * v1) + (v2 * v2 + v3 * v3)) * (1.f / 256.f) + 1e-6f);
        vT[(4 * lane + 0) * 136 + p] = (bf16)f2bf(v0 * rstd * gg[0] + bb[0]); vT[(4 * lane + 1) * 136 + p] = (bf16)f2bf(v1 * rstd * gg[1] + bb[1]);
        vT[(4 * lane + 2) * 136 + p] = (bf16)f2bf(v2 * rstd * gg[2] + bb[2]); vT[(4 * lane + 3) * 136 + p] = (bf16)f2bf(v3 * rstd * gg[3] + bb[3]); }
    __syncthreads();
    const int g = wave >> 1, qh = wave & 1, fr = lane & 15, fq = lane >> 4;
    f32x4 acc[4][4];
#pragma unroll
    for (int a = 0; a < 4; ++a)
#pragma unroll
        for (int b = 0; b < 4; ++b) acc[a][b] = (f32x4){0.f, 0.f, 0.f, 0.f};
    const bf16* Wg = WS_ + g * 16384;
#pragma unroll
    for (int ks = 0; ks < 4; ++ks) { bf16x8 af[4], bf[4];
#pragma unroll
        for (int dt = 0; dt < 4; ++dt) af[dt] = *(const LAS bf16x8*)(vT + (g * 64 + dt * 16 + fr) * 136 + ks * 32 + fq * 8);
#pragma unroll
        for (int qt = 0; qt < 4; ++qt) bf[qt] = *(const bf16x8*)(Wg + (qh * 64 + qt * 16 + fr) * 128 + ks * 32 + fq * 8);
#pragma unroll
        for (int dt = 0; dt < 4; ++dt)
#pragma unroll
            for (int qt = 0; qt < 4; ++qt) mfma16(acc[dt][qt], af[dt], bf[qt]); }
    DRAIN16(&acc[0][0]);
    const float* bs = INP(12) + l * 512 + g * 128;
#pragma unroll
    for (int qt = 0; qt < 4; ++qt) { const int q = qh * 64 + qt * 16 + fr; const float bias = bs[q]; const size_t row = row0 + q;
#pragma unroll
        for (int dt = 0; dt < 4; ++dt) { const int ch = g * 64 + dt * 16 + 4 * fq; const uint2 uw = *(const uint2*)(AUV + row * 512 + ch);
            f32x4 o; o[0] = bflo(uw.x) * (acc[dt][qt][0] + bias); o[1] = bfhi(uw.x) * (acc[dt][qt][1] + bias); o[2] = bflo(uw.y) * (acc[dt][qt][2] + bias); o[3] = bfhi(uw.y) * (acc[dt][qt][3] + bias);
            st4bf(BRa + row * 256 + ch, o); } }
    __syncthreads();
}
__device__ __forceinline__ void conv_unit(PH_ARGS, const int l, const int unit) {
    int rowbase, n0, nlen;
    if (unit < 256) { rowbase = (unit >> 7) * SEQ; n0 = (unit & 127) * 64; nlen = SEQ; } else { const int u2 = unit - 256; rowbase = ML + (u2 >> 2) * CTXL; n0 = (u2 & 3) * 64; nlen = CTXL; }
    const bf16* CY = WSP(bf16, WS_CY); bf16* BRc = WSP(bf16, WS_BR) + (size_t)2 * MT * 256;
    LAS unsigned* yt = (LAS unsigned*)lds;
    LAS float* cres = (LAS float*)(lds + 48128);
    for (int p = tid; p < 94 * 32; p += 512) { const int rr = p >> 5, seg = p & 31, n = n0 - 15 + rr; v4u val = {0u, 0u, 0u, 0u};
        if (n >= 0 && n < nlen) val = *(const v4u*)(CY + (size_t)(rowbase + n) * 256 + seg * 8);
        *(LAS v4u*)(lds + rr * 512 + seg * 16) = val; }
    __syncthreads();
    const int cp = tid & 127, pg = tid >> 7;
    float w0[31], w1[31];
    const float* cw = INP(15) + (size_t)l * 31 * 256 + 2 * cp;
#pragma unroll
    for (int t = 0; t < 31; ++t) { const float2 w = *(const float2*)(cw + t * 256); w0[t] = w.x; w1[t] = w.y; }
    float a0[16], a1[16];
#pragma unroll
    for (int p = 0; p < 16; ++p) { a0[p] = 0.f; a1[p] = 0.f; }
#pragma unroll
    for (int i = 0; i < 46; ++i) { const unsigned raw = yt[(16 * pg + i) * 128 + cp]; const float v0 = bflo(raw), v1 = bfhi(raw);
#pragma unroll
        for (int p = 0; p < 16; ++p) { const int t = i - p; if (t >= 0 && t < 31) { a0[p] += v0 * w0[t]; a1[p] += v1 * w1[t]; } } }
    const float2 cb = *(const float2*)(INP(16) + l * 256 + 2 * cp);
#pragma unroll
    for (int p = 0; p < 16; ++p) *(LAS f2v*)(cres + (16 * pg + p) * 256 + 2 * cp) = (f2v){a0[p] + cb.x, a1[p] + cb.y};
    __syncthreads();
    const f32x4 gg = *(const f32x4*)(INP(17) + l * 256 + 4 * lane), bb = *(const f32x4*)(INP(18) + l * 256 + 4 * lane);
    for (int pi = 0; pi < 8; ++pi) { const int pos = wave * 8 + pi; f32x4 v = *(const LAS f32x4*)(cres + pos * 256 + 4 * lane);
        const float mean = wave_sum((v[0] + v[1]) + (v[2] + v[3])) * (1.f / 256.f); v = v - mean;
        const float rstd = 1.0f / sqrtf(wave_sum((v[0] * v[0] + v[1] * v[1]) + (v[2] * v[2] + v[3] * v[3])) * (1.f / 256.f) + 1e-6f);
        f32x4 o;
#pragma unroll
        for (int j = 0; j < 4; ++j) { const float y = v[j] * rstd * gg[j] + bb[j]; o[j] = y * sigm(y); }
        st4bf(BRc + (size_t)(rowbase + n0 + pos) * 256 + 4 * lane, o); }
    __syncthreads();
}
constexpr int F1_T1L = 0, F1_YL = 34816;
__device__ __forceinline__ void f1_stage_tables(PH_ARGS) {
    const bf16* T1 = WSP(bf16, WS_T1T);
    for (int p = tid; p < 128 * 16; p += 512) { const int r = p >> 4, s = p & 15; *(LAS v4u*)(lds + F1_T1L + r * 272 + s * 16) = *(const v4u*)(T1 + r * 128 + s * 8); }
    __syncthreads();
}
__device__ __forceinline__ void f1_unit(PH_ARGS, const int unit) {
    const int b = unit >> 7, n2 = unit & 127, fr = lane & 15, fq = lane >> 4;
    const bf16* YF = WSP(bf16, WS_YF); bf16* FA = WSP(bf16, WS_FA);
    LAS unsigned* Yl = (LAS unsigned*)(lds + F1_YL);
#pragma unroll
    for (int i = 0; i < 8; ++i) { const int n1 = wave + 8 * i; *(LAS v4u*)(Yl + n1 * 260 + lane * 4) = *(const v4u*)(YF + (size_t)(b * SEQ + 128 * n1 + n2) * 512 + lane * 8); }
    __syncthreads();
    f32x4 acc[2][8];
#pragma unroll
    for (int a = 0; a < 2; ++a)
#pragma unroll
        for (int n = 0; n < 8; ++n) acc[a][n] = (f32x4){0.f, 0.f, 0.f, 0.f};
#pragma unroll
    for (int ks = 0; ks < 4; ++ks) { bf16x8 af[2];
#pragma unroll
        for (int c2 = 0; c2 < 2; ++c2) { const int ch = (2 * wave + c2) * 16 + fr; v4u w;
            w.x = Yl[(16 * ks + 4 * fq + 0) * 260 + ch]; w.y = Yl[(16 * ks + 4 * fq + 1) * 260 + ch]; w.z = Yl[(16 * ks + 4 * fq + 2) * 260 + ch]; w.w = Yl[(16 * ks + 4 * fq + 3) * 260 + ch];
            af[c2] = __builtin_bit_cast(bf16x8, w); }
#pragma unroll
        for (int nt = 0; nt < 8; ++nt) { const bf16x8 bfr = *(const LAS bf16x8*)(lds + F1_T1L + (nt * 16 + fr) * 272 + ks * 64 + fq * 16);
            mfma16(acc[0][nt], af[0], bfr); mfma16(acc[1][nt], af[1], bfr); } }
    DRAIN16(&acc[0][0]);
#pragma unroll
    for (int c2 = 0; c2 < 2; ++c2)
#pragma unroll
        for (int kt = 0; kt < 4; ++kt) { const int k1 = kt * 16 + fr; const f32x4 ar = acc[c2][kt], ai = acc[c2][kt + 4];
            v4u o; o.x = pk2(ar[0], ai[0]); o.y = pk2(ar[1], ai[1]); o.z = pk2(ar[2], ai[2]); o.w = pk2(ar[3], ai[3]);
            *(v4u*)(FA + ((size_t)((b * 64 + k1) * 128 + n2) * 256 + (2 * wave + c2) * 16 + 4 * fq) * 2) = o; }
    __syncthreads();
}
constexpr int F2_T2L = 0, F2_AL = 67584;
__device__ __forceinline__ void f2_unit(PH_ARGS, const int unit) {
    const int fr = lane & 15, fq = lane >> 4; const bool lat = unit < 256;
    int b, k1, chh; const bf16* Asrc; const bf16* Tsrc; size_t orow0; int ostr; float scl;
    if (lat) { b = unit >> 7; k1 = (unit >> 1) & 63; chh = unit & 1; Asrc = WSP(bf16, WS_FA) + (size_t)((b * 64 + k1) * 128) * 512; Tsrc = WSP(bf16, WS_T2F) + (size_t)k1 * 32768; orow0 = (size_t)b * SEQ + k1; ostr = 64; scl = 0.0013810679320049757f; }
    else { const int u2 = unit - 256; b = u2 >> 2; k1 = (u2 >> 1) & 1; chh = u2 & 1; Asrc = WSP(bf16, WS_FAC) + (size_t)((b * 2 + k1) * 128) * 512; Tsrc = WSP(bf16, WS_T2C) + (size_t)k1 * 32768; orow0 = (size_t)ML + b * CTXL + k1; ostr = 2; scl = 1.f / 128.f; }
    bf16* BRb = WSP(bf16, WS_BR) + (size_t)1 * MT * 256;
    LAS unsigned* Al = (LAS unsigned*)(lds + F2_AL);
    for (int p = tid; p < 128 * 32; p += 512) { const int r = p >> 5, s = p & 31; *(LAS v4u*)(lds + F2_T2L + r * 528 + s * 16) = *(const v4u*)(Tsrc + r * 256 + s * 8); }
#pragma unroll
    for (int i = 0; i < 8; ++i) { const int n2 = wave * 16 + 2 * i + (lane >> 5);
        *(LAS v4u*)(Al + n2 * 132 + (lane & 31) * 4) = *(const v4u*)(Asrc + ((size_t)n2 * 256 + chh * 128) * 2 + (lane & 31) * 8); }
    __syncthreads();
    f32x4 acc[8];
#pragma unroll
    for (int n = 0; n < 8; ++n) acc[n] = (f32x4){0.f, 0.f, 0.f, 0.f};
    const int ch = wave * 16 + fr;
#pragma unroll
    for (int ks = 0; ks < 8; ++ks) { v4u w;
        w.x = Al[(16 * ks + 4 * fq + 0) * 132 + ch]; w.y = Al[(16 * ks + 4 * fq + 1) * 132 + ch]; w.z = Al[(16 * ks + 4 * fq + 2) * 132 + ch]; w.w = Al[(16 * ks + 4 * fq + 3) * 132 + ch];
        const bf16x8 af = __builtin_bit_cast(bf16x8, w);
#pragma unroll
        for (int nt = 0; nt < 8; ++nt) { const bf16x8 bfr = *(const LAS bf16x8*)(lds + F2_T2L + (nt * 16 + fr) * 528 + ks * 64 + fq * 16); mfma16(acc[nt], af, bfr); } }
    DRAIN8(acc);
#pragma unroll
    for (int nt = 0; nt < 8; ++nt) { const int k2 = nt * 16 + fr; st4bf(BRb + (orow0 + (size_t)ostr * k2) * 256 + chh * 128 + wave * 16 + 4 * fq, acc[nt] * scl); }
    __syncthreads();
}
__device__ __forceinline__ void ctx_butterfly(PH_ARGS) {
    const unsigned* YF = (const unsigned*)WSP(bf16, WS_YF); unsigned* FAC = (unsigned*)WSP(bf16, WS_FAC);
    for (int i = bid * 512 + tid; i < 2 * 128 * 256; i += G * 512) { const int b = i >> 15, n2 = (i >> 8) & 127, ch = i & 255;
        const unsigned y0 = YF[(size_t)(ML + b * CTXL + n2) * 256 + ch], y1 = YF[(size_t)(ML + b * CTXL + 128 + n2) * 256 + ch];
        const float r0 = bflo(y0), i0 = bfhi(y0), r1 = bflo(y1), i1 = bfhi(y1);
        FAC[(size_t)((b * 2 + 0) * 128 + n2) * 256 + ch] = pk2(r0 + r1, i0 + i1); FAC[(size_t)((b * 2 + 1) * 128 + n2) * 256 + ch] = pk2(r0 - r1, i0 - i1); }
}
constexpr int MG_AL = 0, MG_BL = 67584;
__device__ __forceinline__ void merge_phase(PH_ARGS, const int nunits) {
    const int fr = lane & 15, fq = lane >> 4, wr = wave >> 2, wc = wave & 3;
    const bf16* BR = WSP(bf16, WS_BR); const bf16* WBR = WSP(bf16, WS_WBR); const bf16* GT = WSP(bf16, WS_G); bf16* MB = WSP(bf16, WS_MB);
    int nmine = 0; for (int u = bid; u < nunits; u += G) ++nmine;
    const int nsteps = nmine * 4;
    if (nsteps == 0) return;
    v4u pa[8], pb[8];
#define MG_LOAD(s) do { const int u_ = bid + ((s) >> 2) * G, b_ = (s) & 3, rt_ = u_ >> 3, ct_ = u_ & 7; \
        const bf16* As = BR + ((size_t)b_ * MT + (size_t)rt_ * 128) * 256; const bf16* Bs = WBR + ((size_t)b_ * 1024 + (size_t)ct_ * 128) * 256; \
        _Pragma("unroll") for (int i = 0; i < 8; ++i) { const int p = i * 512 + tid, r = p >> 5, seg = p & 31; pa[i] = *(const v4u*)(As + (size_t)r * 256 + seg * 8); pb[i] = *(const v4u*)(Bs + (size_t)r * 256 + seg * 8); } } while (0)
#define MG_WRITE() do { _Pragma("unroll") for (int i = 0; i < 8; ++i) { const int p = i * 512 + tid, r = p >> 5, seg = p & 31; \
        *(LAS v4u*)(lds + MG_AL + r * 528 + seg * 16) = pa[i]; *(LAS v4u*)(lds + MG_BL + r * 528 + seg * 16) = pb[i]; } } while (0)
    MG_LOAD(0); MG_WRITE();
    f32x4 macc[4][2];
#pragma unroll
    for (int a = 0; a < 4; ++a)
#pragma unroll
        for (int n = 0; n < 2; ++n) macc[a][n] = (f32x4){0.f, 0.f, 0.f, 0.f};
#pragma unroll 1
    for (int s = 0; s < nsteps; ++s) {
        const int u = bid + (s >> 2) * G, b = s & 3, rt = u >> 3, ct = u & 7;
        __syncthreads();
        if (s + 1 < nsteps) MG_LOAD(s + 1);
        uint2 gw[4][2];
#pragma unroll
        for (int mt = 0; mt < 4; ++mt)
#pragma unroll
            for (int nt = 0; nt < 2; ++nt) gw[mt][nt] = *(const uint2*)(GT + ((((size_t)(u * 4 + b) * 8 + wave) * 8 + mt * 2 + nt) * 256 + lane * 4));
        f32x4 acc[4][2];
#pragma unroll
        for (int a = 0; a < 4; ++a)
#pragma unroll
            for (int n = 0; n < 2; ++n) acc[a][n] = (f32x4){0.f, 0.f, 0.f, 0.f};
#pragma unroll
        for (int ks = 0; ks < 8; ++ks) { bf16x8 af[4], bfr[2];
#pragma unroll
            for (int mt = 0; mt < 4; ++mt) af[mt] = *(const LAS bf16x8*)(lds + MG_AL + (wr * 64 + mt * 16 + fr) * 528 + ks * 64 + fq * 16);
#pragma unroll
            for (int nt = 0; nt < 2; ++nt) bfr[nt] = *(const LAS bf16x8*)(lds + MG_BL + (wc * 32 + nt * 16 + fr) * 528 + ks * 64 + fq * 16);
#pragma unroll
            for (int mt = 0; mt < 4; ++mt)
#pragma unroll
                for (int nt = 0; nt < 2; ++nt) mfma16n(acc[mt][nt], bfr[nt], af[mt]); }
        DRAIN8(&acc[0][0]);
#pragma unroll
        for (int mt = 0; mt < 4; ++mt)
#pragma unroll
            for (int nt = 0; nt < 2; ++nt) { const uint2 g = gw[mt][nt]; macc[mt][nt][0] += bflo(g.x) * acc[mt][nt][0]; macc[mt][nt][1] += bfhi(g.x) * acc[mt][nt][1]; macc[mt][nt][2] += bflo(g.y) * acc[mt][nt][2]; macc[mt][nt][3] += bfhi(g.y) * acc[mt][nt][3]; }
        __syncthreads();
        if (s + 1 < nsteps) MG_WRITE();
        if (b == 3) {
#pragma unroll
            for (int mt = 0; mt < 4; ++mt)
#pragma unroll
                for (int nt = 0; nt < 2; ++nt) { st4bf(MB + (size_t)(rt * 128 + wr * 64 + mt * 16 + fr) * 1024 + ct * 128 + wc * 32 + nt * 16 + 4 * fq, macc[mt][nt]); macc[mt][nt] = (f32x4){0.f, 0.f, 0.f, 0.f}; }
        }
    }
    __syncthreads();
#undef MG_LOAD
#undef MG_WRITE
}
constexpr int AT_RPB = 32768, AT_MRG = 40960;
__device__ __forceinline__ int clampi(int v, int lo, int hi) { return v < lo ? lo : (v > hi ? hi : v); }
__device__ __forceinline__ bool at_need(int kind, int jb, int t) { return kind == 2 || (kind == 0 ? (jb < 2 || (jb == 2 && t == 1)) : (jb > 1 || (jb == 1 && t == 0))); }
struct AtCtx { const bf16* QPL; const bf16* KR; const bf16* VV; LAS unsigned char* vbuf; const LAS float* rpbl; int h, qh, fr, fq, lane, b, r, kr0, qrow0, nch, nwin; bool lat; unsigned code[2][2][2]; float negb; };
__device__ __forceinline__ unsigned at_keyrow(const AtCtx& X, int ci) { return (ci < X.nwin) ? ((unsigned)X.b * SEQ + (unsigned)(X.kr0 + (ci >> 1)) * 64 + 32 * (ci & 1)) : ((unsigned)ML + X.b * CTXL + 32 * (ci - X.nwin)); }
__device__ __forceinline__ void at_load(const AtCtx& X, int ci, bf16x8 (&kf)[2][2], v4u (&vst)[4]) {
    const unsigned kr = at_keyrow(X, ci);
#pragma unroll
    for (int t = 0; t < 2; ++t)
#pragma unroll
        for (int ks = 0; ks < 2; ++ks) kf[t][ks] = *(const bf16x8*)(X.KR + (unsigned)((kr + 16 * t + X.fr) * 256 + X.h * 64 + ks * 32 + X.fq * 8));
#pragma unroll
    for (int i = 0; i < 4; ++i) { const int p = i * 64 + X.lane, key = p >> 3, seg = p & 7; vst[i] = *(const v4u*)(X.VV + (unsigned)((kr + key) * 256 + X.h * 64 + seg * 8)); }
}
__device__ __forceinline__ void at_chunk(const AtCtx& X, const int ci, bf16x8 (&kf)[2][2], v4u (&vst)[4], bf16x8 (&qf)[2][2], f32x4 (&O)[2][4], float (&m)[2], float (&l)[2]) {
    const int kind = ci < X.nwin ? (ci & 1) : 2, fr = X.fr, fq = X.fq, qh = X.qh;
    if (X.lat && ci == 16) {
#pragma unroll
        for (int j = 0; j < 2; ++j)
#pragma unroll
            for (int ks = 0; ks < 2; ++ks) qf[j][ks] = *(const bf16x8*)(X.QPL + (unsigned)((X.qrow0 + 16 * (2 * qh + j) + fr) * 256 + X.h * 64 + ks * 32 + fq * 8));
        asm volatile("" : "+v"(qf[0][0]), "+v"(qf[0][1]), "+v"(qf[1][0]), "+v"(qf[1][1])); }
#pragma unroll
    for (int i = 0; i < 4; ++i) { const int p = i * 64 + X.lane, key = p >> 3, seg = p & 7; *(LAS v4u*)(X.vbuf + key * 128 + ((((seg >> 1) ^ ((key >> 1) & 3))) << 5) + ((seg & 1) << 4)) = vst[i]; }
    f32x4 S[2][2];
#pragma unroll
    for (int j = 0; j < 2; ++j)
#pragma unroll
        for (int t = 0; t < 2; ++t) { S[j][t] = (f32x4){0.f, 0.f, 0.f, 0.f}; mfma16n(S[j][t], kf[t][0], qf[j][0]); mfma16n(S[j][t], kf[t][1], qf[j][1]); }
    const LAS float* rpbrow = X.rpbl + (kind != 2 ? (X.kr0 + (ci >> 1) - X.r + 7) : 15) * 32;
    float bv[2][2][4];
#pragma unroll
    for (int j = 0; j < 2; ++j)
#pragma unroll
        for (int t = 0; t < 2; ++t) { const unsigned cw = kind == 2 ? 0u : (kind == 0 ? X.code[0][j][t] : X.code[1][j][t]);
#pragma unroll
            for (int rg = 0; rg < 4; ++rg) bv[j][t][rg] = rpbrow[(cw >> (8 * rg)) & 31u]; }
    asm volatile("s_nop 11" : "+v"(S[0][0]), "+v"(S[0][1]), "+v"(S[1][0]), "+v"(S[1][1]));
    if (ci + 3 < X.nch) at_load(X, ci + 3, kf, vst);
    bf16x8 pf[2];
#pragma unroll
    for (int j = 0; j < 2; ++j) {
        float mc = X.negb;
#pragma unroll
        for (int t = 0; t < 2; ++t)
#pragma unroll
            for (int rg = 0; rg < 4; ++rg) { const float s = S[j][t][rg] + bv[j][t][rg]; S[j][t][rg] = s; mc = fmaxf(mc, s); }
        { auto r16 = __builtin_amdgcn_permlane16_swap(__float_as_uint(mc), __float_as_uint(mc), false, false); mc = fmaxf(__uint_as_float(r16[0]), __uint_as_float(r16[1]));
          auto r32 = __builtin_amdgcn_permlane32_swap(__float_as_uint(mc), __float_as_uint(mc), false, false); mc = fmaxf(__uint_as_float(r32[0]), __uint_as_float(r32[1])); }
        const float mnew = fmaxf(m[j], mc), alpha = __builtin_amdgcn_exp2f(m[j] - mnew); m[j] = mnew; float ls = 0.f;
#pragma unroll
        for (int t = 0; t < 2; ++t)
#pragma unroll
            for (int rg = 0; rg < 4; ++rg) { const float p = __builtin_amdgcn_exp2f(S[j][t][rg] - mnew); S[j][t][rg] = p; ls += p; }
        l[j] = l[j] * alpha + ls;
        if (__any(alpha != 1.f)) {
#pragma unroll
            for (int dt = 0; dt < 4; ++dt) O[j][dt] = O[j][dt] * alpha; }
        v4u pw; pw.x = pk2(S[j][0][0], S[j][0][1]); pw.y = pk2(S[j][0][2], S[j][0][3]); pw.z = pk2(S[j][1][0], S[j][1][1]); pw.w = pk2(S[j][1][2], S[j][1][3]);
        pf[j] = __builtin_bit_cast(bf16x8, pw); }
    asm volatile("s_nop 1" : "+v"(pf[0]), "+v"(pf[1]));
#pragma unroll
    for (int dt = 0; dt < 4; ++dt) { v4i16_t t0, t1;
        { const int key = 4 * fq + (fr >> 2); t0 = __builtin_amdgcn_ds_read_tr16_b64_v4i16((LAS v4i16_t*)(X.vbuf + key * 128 + ((dt ^ ((key >> 1) & 3)) << 5) + (fr & 3) * 8)); }
        { const int key = 16 + 4 * fq + (fr >> 2); t1 = __builtin_amdgcn_ds_read_tr16_b64_v4i16((LAS v4i16_t*)(X.vbuf + key * 128 + ((dt ^ ((key >> 1) & 3)) << 5) + (fr & 3) * 8)); }
        const bf16x8 vf = (bf16x8){t0[0], t0[1], t0[2], t0[3], t1[0], t1[1], t1[2], t1[3]};
        mfma16n(O[0][dt], vf, pf[0]); mfma16n(O[1][dt], vf, pf[1]); }
}
__device__ __forceinline__ void attn_unit(PH_ARGS, const int unit) {
    AtCtx X; X.h = wave >> 1; X.qh = wave & 1; X.fr = lane & 15; X.fq = lane >> 4; X.lane = lane;
    X.lat = unit < 256; X.r = 0; X.kr0 = 0;
    if (X.lat) { X.b = unit >> 7; X.r = unit & 127; X.qrow0 = X.b * SEQ + X.r * 64; X.kr0 = clampi(X.r - 4, 0, 120); }
    else { const int u2 = unit - 256; X.b = u2 >> 2; X.qrow0 = ML + X.b * CTXL + (u2 & 3) * 64; }
    X.QPL = WSP(bf16, WS_QPL); const bf16* QROT = WSP(bf16, WS_QROT); X.KR = WSP(bf16, WS_KR); X.VV = WSP(bf16, WS_VV);
    bf16* BRd = WSP(bf16, WS_BR) + (size_t)3 * MT * 256;
    X.vbuf = lds + wave * 4096; X.rpbl = (const LAS float*)(lds + AT_RPB) + X.h * 512;
    X.nch = X.lat ? 24 : 8; X.nwin = X.lat ? 16 : 0;
#pragma unroll
    for (int kd = 0; kd < 2; ++kd)
#pragma unroll
        for (int j = 0; j < 2; ++j)
#pragma unroll
            for (int t = 0; t < 2; ++t) { unsigned cw = 0u; const int jb = 2 * X.qh + j;
#pragma unroll
                for (int rg = 0; rg < 4; ++rg) { const int kcol = 32 * kd + 16 * t + 4 * X.fq + rg, qcol = 16 * jb + X.fr, cst = clampi(qcol - 8, 0, 48); const bool ok = at_need(kd, jb, t) && kcol >= cst && kcol < cst + 16;
                    cw |= (ok ? (unsigned)(clampi(kcol - qcol, -15, 15) + 15) : 31u) << (8 * rg); }
                X.code[kd][j][t] = cw; }
    float m[2], l[2]; f32x4 O[2][4];
    { unsigned u_ = 0xf149f2cau; asm volatile("" : "+s"(u_)); X.negb = __uint_as_float(u_); }
#pragma unroll
    for (int j = 0; j < 2; ++j) { m[j] = X.negb; l[j] = 0.f;
#pragma unroll
        for (int dt = 0; dt < 4; ++dt) O[j][dt] = (f32x4){0.f, 0.f, 0.f, 0.f}; }
    bf16x8 qf[2][2];
    { const bf16* Qs = X.lat ? QROT : X.QPL;
#pragma unroll
      for (int j = 0; j < 2; ++j)
#pragma unroll
          for (int ks = 0; ks < 2; ++ks) qf[j][ks] = *(const bf16x8*)(Qs + (unsigned)((X.qrow0 + 16 * (2 * X.qh + j) + X.fr) * 256 + X.h * 64 + ks * 32 + X.fq * 8));
      asm volatile("" : "+v"(qf[0][0]), "+v"(qf[0][1]), "+v"(qf[1][0]), "+v"(qf[1][1])); }
    bf16x8 kA[2][2], kB[2][2], kC[2][2]; v4u vA[4], vB[4], vC[4];
    at_load(X, 0, kA, vA); at_load(X, 1, kB, vB); at_load(X, 2, kC, vC);
#pragma unroll 1
    for (int ci = 0; ci < X.nch; ci += 3) {
        at_chunk(X, ci, kA, vA, qf, O, m, l);
        if (ci + 1 < X.nch) at_chunk(X, ci + 1, kB, vB, qf, O, m, l);
        if (ci + 2 < X.nch) at_chunk(X, ci + 2, kC, vC, qf, O, m, l);
    }
    asm volatile("s_nop 15" : "+v"(O[0][0]), "+v"(O[0][1]), "+v"(O[0][2]), "+v"(O[0][3]), "+v"(O[1][0]), "+v"(O[1][1]), "+v"(O[1][2]), "+v"(O[1][3]));
#pragma unroll
    for (int j = 0; j < 2; ++j) { l[j] += __shfl_xor(l[j], 16); l[j] += __shfl_xor(l[j], 32); const float inv = 1.f / l[j];
#pragma unroll
        for (int dt = 0; dt < 4; ++dt) st4bf(BRd + (unsigned)((X.qrow0 + 16 * (2 * X.qh + j) + X.fr) * 256 + X.h * 64 + dt * 16 + 4 * X.fq), O[j][dt] * inv); }
}
#ifndef CDFT_REP
#define CDFT_REP 1
#endif
#ifndef CONV_REP
#define CONV_REP 1
#endif
#ifndef GMLP_REP
#define GMLP_REP 1
#endif
#ifndef F1_REP
#define F1_REP 1
#endif
__device__ __forceinline__ int block_excl_scan(int v, LAS int* ws8, int lane, int wave) {
    int x = v;
#pragma unroll
    for (int o = 1; o < 64; o <<= 1) { const int y = __shfl_up(x, o); if (lane >= o) x += y; }
    if (lane == 63) ws8[wave] = x;
    __syncthreads();
    int base = 0;
#pragma unroll
    for (int w = 0; w < 8; ++w) base += (w < wave) ? ws8[w] : 0;
    __syncthreads();
    return base + x - v;
}
__device__ __forceinline__ unsigned akey(float a) { const float s = a * 4294967296.f; return s >= 4294967040.f ? 0xFFFFFF00u : (unsigned)s; }
__device__ __forceinline__ float akey_inv(unsigned k) { return (float)k * (1.f / 4294967296.f); }
template <int PER, bool ALLV>
__device__ __forceinline__ void topk_unit(PH_ARGS, const int rowbase, const int n, const int C, const int e, const int sbase, const bool writepad) {
    const float* AFF = WSP(float, WS_AFF); int* SEL = WSP(int, WS_SEL); int* IDX = WSP(int, WS_IDX); float* GATE = WSP(float, WS_GATE);
    LAS unsigned* hist = (LAS unsigned*)lds; LAS unsigned* sh = hist + 256; LAS int* ws8 = (LAS int*)(hist + 272); LAS unsigned* hw = hist + 512 + wave * 256;
    unsigned key[PER]; bool valid[PER];
#pragma unroll
    for (int i = 0; i < PER; ++i) { const int tok = tid * PER + i; valid[i] = ALLV ? true : (tok < n); key[i] = valid[i] ? akey(AFF[(size_t)(rowbase + tok) * 16 + e]) : 0u; }
    unsigned prefix = 0u, mask = 0u, rem = (unsigned)C;
#pragma unroll 1
    for (int pass = 0; pass < 4; ++pass) { const int shift = 24 - 8 * pass;
        for (int i = lane; i < 256; i += 64) hw[i] = 0u;
        LDS_WAIT();
#pragma unroll
        for (int i = 0; i < PER; ++i) if (valid[i] && (key[i] & mask) == prefix) atomicAdd((unsigned*)&hw[(key[i] >> shift) & 255u], 1u);
        __syncthreads();
        if (tid < 256) { unsigned s_ = 0u;
#pragma unroll
            for (int w = 0; w < 8; ++w) s_ += hist[512 + w * 256 + tid];
            hist[tid] = s_; }
        __syncthreads();
        if (wave == 0) { unsigned c0 = hist[255 - 4 * lane], c1 = hist[254 - 4 * lane], c2 = hist[253 - 4 * lane], c3 = hist[252 - 4 * lane];
            const unsigned s = c0 + c1 + c2 + c3; unsigned x = s;
#pragma unroll
            for (int o = 1; o < 64; o <<= 1) { const unsigned y = __shfl_up(x, o); if (lane >= o) x += y; }
            const unsigned excl = x - s;
            if (excl < rem && rem <= x) { unsigned cum = excl; int bin; unsigned nr;
                if (cum + c0 >= rem) { bin = 255 - 4 * lane; nr = rem - cum; }
                else { cum += c0; if (cum + c1 >= rem) { bin = 254 - 4 * lane; nr = rem - cum; }
                else { cum += c1; if (cum + c2 >= rem) { bin = 253 - 4 * lane; nr = rem - cum; }
                else { cum += c2; bin = 252 - 4 * lane; nr = rem - cum; } } }
                sh[0] = (unsigned)bin; sh[1] = nr; } }
        __syncthreads();
        prefix |= sh[0] << shift; mask |= 255u << shift; rem = sh[1];
    }
    __syncthreads();
    const unsigned T = prefix;
    int neq = 0;
#pragma unroll
    for (int i = 0; i < PER; ++i) neq += (valid[i] && key[i] == T) ? 1 : 0;
    const int eqbase = block_excl_scan(neq, ws8, lane, wave);
    unsigned take = 0u; int nsel = 0, eqs = 0;
#pragma unroll
    for (int i = 0; i < PER; ++i) { const bool iseq = valid[i] && key[i] == T; const bool tk = valid[i] && (key[i] > T || (iseq && (unsigned)(eqbase + eqs) < rem)); eqs += iseq ? 1 : 0; if (tk) { take |= 1u << i; ++nsel; } }
    const int sb = block_excl_scan(nsel, ws8, lane, wave);
    int cnt = 0;
#pragma unroll
    for (int i = 0; i < PER; ++i) { const int tok = tid * PER + i;
        if (valid[i]) { if ((take >> i) & 1u) { const int slot = sbase + sb + cnt; ++cnt; IDX[e * ESTR + slot] = rowbase + tok; GATE[e * ESTR + slot] = akey_inv(key[i]); SEL[(size_t)(rowbase + tok) * 16 + e] = slot; }
                        else SEL[(size_t)(rowbase + tok) * 16 + e] = -1; } }
    if (writepad) for (int i = tid; i < ESTR - 2112; i += 512) { IDX[e * ESTR + 2112 + i] = 0; GATE[e * ESTR + 2112 + i] = 0.f; }
    __syncthreads();
}
__device__ __forceinline__ void gather_rows(PH_ARGS, const int tpe) {
    const int gw = bid * 8 + wave, NGW = G * 8, per = tpe * 256; const int* IDX = WSP(int, WS_IDX); const bf16* H = WSP(bf16, WS_H); bf16* XE = WSP(bf16, WS_XE);
    for (int i = gw; i < NE * per; i += NGW) { const int e = i / per, s = i % per, rg = e * ESTR + s; const int src = IDX[rg];
        const v4u a = *(const v4u*)(H + (size_t)src * 1024 + lane * 8), b = *(const v4u*)(H + (size_t)src * 1024 + 512 + lane * 8);
        *(v4u*)(XE + (size_t)rg * 1024 + lane * 8) = a; *(v4u*)(XE + (size_t)rg * 1024 + 512 + lane * 8) = b; }
}
struct CRow { v4u yw[4][2]; f32x4 xin[2][2]; float wgt[4]; unsigned long long bm; int cur; };
struct CCtx { const int* SEL; const bf16* YB; const float* X; bf16* H; const float* MOD; float* XO; float* OUT; const float* gnext; int l, lane; };
__device__ __forceinline__ void cr_issue(const CCtx& C, CRow& R, const int row) {
    const int lane = C.lane;
    R.cur = lane < 16 ? C.SEL[(size_t)row * 16 + lane] : -1;
    R.bm = __ballot(R.cur >= 0); const int cnt = __popcll(R.bm);
#pragma unroll
    for (int k = 0; k < 4; ++k) { const bool has = cnt > k; const int e = has ? (int)__builtin_ctzll(R.bm) : 0; if (has) R.bm &= R.bm - 1; const int s = __shfl(R.cur, e); R.wgt[k] = has ? 1.f : 0.f;
        const bf16* y = C.YB + (size_t)(has ? e * ESTR + s : 0) * 1024 + lane * 8; R.yw[k][0] = *(const v4u*)y; R.yw[k][1] = *(const v4u*)(y + 512); }
    const float* xr = C.X + (size_t)row * 1024;
#pragma unroll
    for (int j = 0; j < 2; ++j) { const int o = 8 * lane + 512 * j; R.xin[j][0] = *(const f32x4*)(xr + o); R.xin[j][1] = *(const f32x4*)(xr + o + 4); }
}
__device__ __forceinline__ void cr_finish(const CCtx& C, CRow& R, const int row) {
    const int lane = C.lane, l = C.l; const int r = row < SEQ ? 0 : (row < ML ? 1 : 2);
    float acc[2][8];
#pragma unroll
    for (int j = 0; j < 2; ++j)
#pragma unroll
        for (int i = 0; i < 8; ++i) acc[j][i] = 0.f;
#pragma unroll
    for (int k = 0; k < 4; ++k)
#pragma unroll
        for (int j = 0; j < 2; ++j) { const v4u w = R.yw[k][j]; const float g = R.wgt[k];
            acc[j][0] += g * bflo(w.x); acc[j][1] += g * bfhi(w.x); acc[j][2] += g * bflo(w.y); acc[j][3] += g * bfhi(w.y); acc[j][4] += g * bflo(w.z); acc[j][5] += g * bfhi(w.z); acc[j][6] += g * bflo(w.w); acc[j][7] += g * bfhi(w.w); }
    while (R.bm) { const int e = (int)__builtin_ctzll(R.bm); R.bm &= R.bm - 1; const int s = __shfl(R.cur, e); const bf16* y = C.YB + (size_t)(e * ESTR + s) * 1024 + lane * 8;
#pragma unroll
        for (int j = 0; j < 2; ++j) { const v4u w = *(const v4u*)(y + 512 * j);
            acc[j][0] += bflo(w.x); acc[j][1] += bfhi(w.x); acc[j][2] += bflo(w.y); acc[j][3] += bfhi(w.y); acc[j][4] += bflo(w.z); acc[j][5] += bfhi(w.z); acc[j][6] += bflo(w.w); acc[j][7] += bfhi(w.w); } }
    const float* gt2 = C.MOD + (l * 3 + r) * 6144 + 5 * 1024;
    float xv[2][8]; float ss = 0.f;
#pragma unroll
    for (int j = 0; j < 2; ++j) { const int o = 8 * lane + 512 * j; const f32x4 g0 = *(const f32x4*)(gt2 + o), g1 = *(const f32x4*)(gt2 + o + 4);
#pragma unroll
        for (int i = 0; i < 4; ++i) { xv[j][i] = R.xin[j][0][i] + g0[i] * acc[j][i]; xv[j][4 + i] = R.xin[j][1][i] + g1[i] * acc[j][4 + i]; }
#pragma unroll
        for (int i = 0; i < 8; ++i) ss += xv[j][i] * xv[j][i]; }
    const float rs = 1.0f / sqrtf(wave_sum(ss) * (1.f / 1024.f) + 1e-6f);
    if (l == 0) {
        const float* md = C.MOD + (1 * 3 + r) * 6144; float* xw = C.XO + (size_t)row * 1024;
#pragma unroll
        for (int j = 0; j < 2; ++j) { const int o = 8 * lane + 512 * j;
            *(f32x4*)(xw + o) = (f32x4){xv[j][0], xv[j][1], xv[j][2], xv[j][3]}; *(f32x4*)(xw + o + 4) = (f32x4){xv[j][4], xv[j][5], xv[j][6], xv[j][7]};
            const f32x4 g0 = *(const f32x4*)(C.gnext + o), g1 = *(const f32x4*)(C.gnext + o + 4), c0 = *(const f32x4*)(md + 1024 + o), c1 = *(const f32x4*)(md + 1024 + o + 4), h0 = *(const f32x4*)(md + o), h1 = *(const f32x4*)(md + o + 4);
            float hv[8];
#pragma unroll
            for (int i = 0; i < 4; ++i) { hv[i] = xv[j][i] * rs * g0[i] * (1.f + c0[i]) + h0[i]; hv[4 + i] = xv[j][4 + i] * rs * g1[i] * (1.f + c1[i]) + h1[i]; }
            v4u w; w.x = pk2(hv[0], hv[1]); w.y = pk2(hv[2], hv[3]); w.z = pk2(hv[4], hv[5]); w.w = pk2(hv[6], hv[7]);
            *(v4u*)(C.H + (size_t)row * 1024 + o) = w; }
    } else {
        float* orow = C.OUT + (size_t)row * 1024;
#pragma unroll
        for (int j = 0; j < 2; ++j) { const int o = 8 * lane + 512 * j; const f32x4 g0 = *(const f32x4*)(C.gnext + o), g1 = *(const f32x4*)(C.gnext + o + 4);
            *(f32x4*)(orow + o) = (f32x4){xv[j][0] * rs * g0[0], xv[j][1] * rs * g0[1], xv[j][2] * rs * g0[2], xv[j][3] * rs * g0[3]};
            *(f32x4*)(orow + o + 4) = (f32x4){xv[j][4] * rs * g1[0], xv[j][5] * rs * g1[1], xv[j][6] * rs * g1[2], xv[j][7] * rs * g1[3]}; }
    }
}
template <bool DUMMY>
__device__ __forceinline__ void combine_rows(PH_ARGS, const int l) {
    const int gw = bid * 8 + wave, NGW = G * 8; const int nrows = l == 0 ? MT : ML;
    CCtx C; C.SEL = WSP(int, WS_SEL); C.YB = WSP(bf16, WS_XE); C.X = WSP(float, WS_X); C.H = DUMMY ? WSP(bf16, WS_BR) : WSP(bf16, WS_H); C.MOD = WSP(float, WS_MOD);
    C.XO = DUMMY ? WSP(float, WS_ACT) : WSP(float, WS_X); C.OUT = DUMMY ? WSP(float, WS_ACT) : PTRV(28, float); C.gnext = l == 0 ? INP(6) + 1024 : INP(27); C.l = l; C.lane = lane;
    CRow A, B; int row = gw;
    if (row < nrows) cr_issue(C, A, row);
    while (row < nrows) {
        const int r2 = row + NGW; if (r2 < nrows) cr_issue(C, B, r2);
        cr_finish(C, A, row);
        const int r3 = r2 + NGW; if (r3 < nrows) cr_issue(C, A, r3);
        if (r2 < nrows) cr_finish(C, B, r2);
        row = r3;
    }
}

#ifdef DBG_STOP
__device__ __forceinline__ void debug_out(PH_ARGS) {
    float* out = PTRV(28, float);
    const int gt = bid * 512 + tid, GT = G * 512;
    for (size_t i = gt; i < (size_t)ML * 1024; i += GT) { const size_t row = i >> 10; const int c = (int)(i & 1023); float v = 0.f;
#if DBG_STOP == 2
        v = bflo(WSP(bf16, WS_H)[row * 1024 + c]) + WSP(float, WS_MOD)[(i % 36864)] + bflo(WSP(bf16, WS_WIN)[i % (6400 * 1024)]) + bflo(WSP(bf16, WS_WGU)[i]) + bflo(WSP(bf16, WS_WDN)[i]) + bflo(WSP(bf16, WS_WO)[i % (1024*1024)]) + bflo(WSP(bf16, WS_WBR)[i % (1024*1024)]);
#elif DBG_STOP == 3
        v = bflo(WSP(bf16, WS_AUV)[row * 512 + (c & 511)]) + bflo(WSP(bf16, WS_YF)[row * 512 + (c & 511)]) + bflo(WSP(bf16, WS_CY)[row * 256 + (c & 255)]) + bflo(WSP(bf16, WS_QPL)[row * 256 + (c & 255)])
          + bflo(WSP(bf16, WS_QROT)[row * 256 + (c & 255)]) + bflo(WSP(bf16, WS_KR)[row * 256 + (c & 255)]) + bflo(WSP(bf16, WS_VV)[row * 256 + (c & 255)])
          + bflo(WSP(bf16, WS_G)[row * 4096 + c]) + bflo(WSP(bf16, WS_G)[row * 4096 + 1024 + c]) + bflo(WSP(bf16, WS_G)[row * 4096 + 2048 + c]) + bflo(WSP(bf16, WS_G)[row * 4096 + 3072 + c]);
#elif DBG_STOP == 4
        v = bflo(WSP(bf16, WS_BR)[(size_t)(0 * MT + row) * 256 + (c & 255)]) + bflo(WSP(bf16, WS_BR)[(size_t)(2 * MT + row) * 256 + (c & 255)]) + bflo(WSP(bf16, WS_FA)[i % ((size_t)8 << 20)]);
#elif DBG_STOP == 21
        v = bflo(WSP(bf16, WS_T1T)[i % 16384]) * 1.001f + WSP(float, WS_ROPEC)[i % 2048] + WSP(float, WS_ROPES)[i % 2048] + bflo(WSP(bf16, WS_WSP)[i % 65536]);
#elif DBG_STOP == 31 || DBG_STOP == 44
        v = 0.f;
#elif DBG_STOP == 45 || DBG_STOP == 32
        v = 0.f;
#elif DBG_STOP == 41
        v = bflo(WSP(bf16, WS_BR)[(size_t)(0 * MT + row) * 256 + (c & 255)]) * 1.001f + bflo(WSP(bf16, WS_BR)[(size_t)(0 * MT + row) * 256 + ((c + 7) & 255)]);
#elif DBG_STOP == 42
        v = bflo(WSP(bf16, WS_BR)[(size_t)(2 * MT + row) * 256 + (c & 255)]) * 1.001f + bflo(WSP(bf16, WS_BR)[(size_t)(2 * MT + row) * 256 + ((c + 7) & 255)]);
#elif DBG_STOP == 43
        v = bflo(WSP(bf16, WS_FA)[i % ((size_t)8 << 20)]) * 1.001f + bflo(WSP(bf16, WS_FA)[(i + 7) % ((size_t)8 << 20)]);
#elif DBG_STOP == 5
        v = bflo(WSP(bf16, WS_BR)[(size_t)(1 * MT + row) * 256 + (c & 255)]) + bflo(WSP(bf16, WS_BR)[(size_t)(3 * MT + row) * 256 + (c & 255)]);
#elif DBG_STOP == 6
        v = bflo(WSP(bf16, WS_MB)[row * 1024 + c]);
#elif DBG_STOP == 7
        v = WSP(float, WS_X)[row * 1024 + c];
#elif DBG_STOP == 8
        v = bflo(WSP(bf16, WS_H)[row * 1024 + c]) + WSP(float, WS_AFF)[row * 16 + (c & 15)];
#elif DBG_STOP == 9
        v = (float)WSP(int, WS_SEL)[row * 16 + (c & 15)] + WSP(float, WS_GATE)[i % (16 * 2304)] + (float)WSP(int, WS_IDX)[i % (16 * 2304)];
#elif DBG_STOP == 10
        v = bflo(WSP(bf16, WS_XE)[i]) + bflo(WSP(bf16, WS_XE)[i + (size_t)ML * 1024]);
#elif DBG_STOP == 11
        v = bflo(WSP(bf16, WS_ACT)[i]) + bflo(WSP(bf16, WS_ACT)[i + (size_t)ML * 1024]);
#elif DBG_STOP == 12
        v = bflo(WSP(bf16, WS_XE)[i]) + bflo(WSP(bf16, WS_XE)[i + (size_t)ML * 1024]);
#else
        v = WSP(float, WS_X)[row * 1024 + c] + bflo(WSP(bf16, WS_H)[row * 1024 + c]);
#endif
#ifdef DBG_AMP
        v = (float)(__float_as_uint(v) & 0xFFFFu);
#endif
        out[i] = v; }
}
#endif
__global__ void __launch_bounds__(512, 2) mega(Args A) {
    extern __shared__ __attribute__((aligned(16))) unsigned char lds_raw[];
    LAS unsigned char* lds0 = (LAS unsigned char*)lds_raw;
    volatile LAS unsigned* MISC = (volatile LAS unsigned*)(lds0 + MISC_OFF);
    const int tid = threadIdx.x, lane = tid & 63, wave = __builtin_amdgcn_readfirstlane(tid >> 6), bid = blockIdx.x, G = gridDim.x;
    for (int u = tid; u < (LDS_BYTES - MISC_OFF) / 4; u += 512) ((LAS unsigned*)(lds0 + MISC_OFF))[u] = 0u;
    __syncthreads();
    if (tid == 0) { typedef unsigned u2v_t __attribute__((ext_vector_type(2)));
#pragma unroll
        for (int i = 0; i < 30; ++i) { const unsigned long long p = i < 28 ? (unsigned long long)A.in[i] : (i == 28 ? (unsigned long long)A.out : (unsigned long long)A.ws);
            *(LAS u2v_t*)(lds0 + PTAB_OFF + 8 * i) = (u2v_t){(unsigned)p, (unsigned)(p >> 32)}; } }
    __syncthreads();
    const int lo = A.ph_lo, hi = A.ph_hi;
    XcdBarrier bar; bar.bar = (unsigned*)(A.ws + WS_CTL) + CW_BAR; bar.x = 0; bar.st = nullptr;
    if (hi - lo > 1) bar = xcd_barrier_post((unsigned*)(A.ws + WS_CTL) + CW_BAR, MISC + 8);
#define PH_CALL lds, tl_, (tl_ & 63), wv_, bl_, G_
#define PH_CALLV lds, tl_, (tl_ & 63), wv_, vb_, G_
#ifdef TS_I
    if (bid == 0 && tid == 0) ((unsigned long long*)(A.ws + 65536))[lo] = rt();
#endif
    if (lo == 0) {
        int tl_ = tid; asm volatile("" : "+v"(tl_)); int bl_ = bid; asm volatile("" : "+s"(bl_)); int wv_ = wave; asm volatile("" : "+s"(wv_)); int G_ = G; asm volatile("" : "+s"(G_));
        unsigned ldsb_ = (unsigned)(uintptr_t)lds0; asm volatile("" : "+s"(ldsb_)); LAS unsigned char* lds = (LAS unsigned char*)(uintptr_t)ldsb_;
#ifndef P0R_MOD
#define P0R_MOD 1
#endif
#ifndef P0R_TAB
#define P0R_TAB 1
#endif
#ifndef P0R_CVT
#define P0R_CVT 1
#endif
#pragma unroll 1
            for (int r_ = 0; r_ < P0R_MOD; ++r_) { mod_gemv(PH_CALL); asm volatile("" ::: "memory"); }
#pragma unroll 1
            for (int r_ = 0; r_ < P0R_TAB; ++r_) { make_tables(PH_CALL); asm volatile("" ::: "memory"); }
#pragma unroll 1
            for (int r_ = 0; r_ < P0R_CVT; ++r_) { convert_range(lds, tl_, (tl_ & 63), wv_, bl_, G_, 0, CV_FOLD0, CV_GU0, bl_, G_); convert_range(lds, tl_, (tl_ & 63), wv_, bl_, G_, 0, CV_SP0, CV_END, bl_, G_); asm volatile("" ::: "memory"); }
        if (hi > 1) { XcdBarrier b2 = bar; b2.bar = (unsigned*)(PTRV(29, unsigned char) + WS_CTL) + CW_BAR; b2.st = (volatile LAS unsigned*)(lds + MISC_OFF) + 8; xcd_barrier(b2); }
    }
    const int lo1 = lo < 1 ? 1 : lo;
#pragma unroll 1
#ifdef REP_PH
    for (int it_ = lo1; it_ < hi + (REP_N - 1); ++it_) { const int ph = it_ < REP_PH ? it_ : (it_ < REP_PH + REP_N ? REP_PH : it_ - (REP_N - 1));
#else
    for (int ph = lo1; ph < hi; ++ph) {
#endif
        int tl_ = tid; asm volatile("" : "+v"(tl_)); int bl_ = bid; asm volatile("" : "+s"(bl_)); int vb_ = (G % 8 == 0) ? (bid % 8) * (G / 8) + bid / 8 : bid; asm volatile("" : "+s"(vb_)); int wv_ = wave; asm volatile("" : "+s"(wv_)); int G_ = G; asm volatile("" : "+s"(G_)); unsigned ldsb_ = (unsigned)(uintptr_t)lds0; asm volatile("" : "+s"(ldsb_)); LAS unsigned char* lds = (LAS unsigned char*)(uintptr_t)ldsb_;
        const int l = ph < 13 ? 0 : 1, kind = ph >= 99 ? 99 : (ph < 2 ? ph : 2 + (ph - 2 - 11 * l));
        const int ntm = l == 0 ? 66 : 64, tpe = l == 0 ? 9 : 8;
        if (kind == 9) continue;
        switch (kind) {
#ifdef DBG_STOP
        case 99: debug_out(PH_CALL); break;
#endif
        case 0: break;
        case 1: {
#ifndef DIS_N1
            norm1_l0(PH_CALL);
#endif
        } break;
        case 2: {
            pg8::Gemm g{WSP(bf16, WS_H), WSP(bf16, WS_WIN), MT, NIN, 1024}; pg8::StaticOrder S; S.init(MT, NIN, G_, bl_);
            EpiIn E{WSP(bf16, WS_AUV), WSP(bf16, WS_YF), WSP(bf16, WS_CY), WSP(bf16, WS_QPL), WSP(bf16, WS_QROT), WSP(bf16, WS_KR), WSP(bf16, WS_VV), WSP(bf16, WS_G), WSP(float, WS_ROPEC), WSP(float, WS_ROPES)};
#ifndef DIS_GIN
            pg8::gemm_phase<EpiIn, pg8::StaticOrder, true, true>(lds, g, S, E);
#endif
#ifndef DIS_CVT
            if (l == 0) { const int nx = ((MT / 256) * (NIN / 256)) % G_; convert_range(lds, tl_, (tl_ & 63), wv_, bl_, G_, 0, CV_GU0, CV_DN0, nx ? bl_ - nx : bl_, G_ - nx); }
#endif
        } break;
        case 3: {
#ifndef DIS_F1
            if (bl_ < 256) { f1_stage_tables(PH_CALL); for (int u = vb_; u < 256; u += G_) f1_unit(PH_CALL, u); }
#endif
#ifndef DIS_CDFT
            if (l == 0) ctx_butterfly(PH_CALL);
#endif
            __syncthreads();
            { LAS float* rp = (LAS float*)(lds + AT_RPB); const float* src = INP(20) + l * 1860;
              for (int i = tl_; i < 2048; i += 512) { const int hh = i >> 9, rw = (i >> 5) & 15, cc = i & 31; rp[i] = rw < 15 ? (cc < 31 ? src[hh * 465 + rw * 31 + cc] * 1.4426950408889634f : -3.0e38f) : 0.f; } }
            __syncthreads();
            const int nat = l == 0 ? 264 : 256;
#ifndef DIS_ATT
            for (int u = vb_; u < nat; u += G_) attn_unit(PH_CALL, u);
#endif
        } break;
        case 4: {
#ifndef DIS_F2
            { const int nf2 = l == 0 ? 264 : 256; for (int u = vb_; u < nf2; u += G_) f2_unit(PH_CALL, u); }
#endif
            const int nconv = l == 0 ? 264 : 256, ngm = l == 0 ? 132 : 128;
#ifndef DIS_CONV
            for (int u = vb_; u < nconv; u += G_) conv_unit(PH_CALL, l, u);
#endif
#ifndef DIS_GMLP
            for (int u = G_ - 1 - vb_; u < ngm; u += G_) gmlp_unit(PH_CALL, l, u);
#endif
        } break;
        case 5: {
#ifndef DIS_GMRG
#ifndef MERGE_PG8
            merge_phase(PH_CALLV, ntm * 16);
#ifndef DIS_CVT
            if (l == 0) { const int nx = (ntm * 16) % G_; convert_range(lds, tl_, (tl_ & 63), wv_, vb_, G_, 0, CV_DN0, CV_SP0, nx ? vb_ - nx : vb_, G_ - nx); }
#endif
#else
            { pg8::Gemm g{WSP(bf16, WS_BR), WSP(bf16, WS_WBR), 4 * MT, 4096, 256}; MergeOrder S; S.init(ntm, G_, bl_); EpiMergeH E{WSP(bf16, WS_G), WSP(bf16, WS_MB)};
              pg8::gemm_phase<EpiMergeH, MergeOrder, true, true>(lds, g, S, E); }
#endif
#endif
        } break;
        case 6: {
            pg8::Gemm g{WSP(bf16, WS_MB), WSP(bf16, WS_WO), ML, 1024, 1024}; pg8::StaticOrder S; S.init(ML, 1024, G_, bl_);
            EpiWout E{l == 0 ? INP(0) : WSP(float, WS_X), l == 0 ? INP(2) : WSP(float, WS_X) + (size_t)ML * 1024, WSP(float, WS_X), WSP(float, WS_MOD) + l * 3 * 6144};
#ifndef DIS_GWO
            pg8::gemm_phase<EpiWout, pg8::StaticOrder, true, true>(lds, g, S, E);
#endif
#ifndef DIS_CVT
            if (l == 0) { const int nx = (64 * 4) % G_; convert_range(lds, tl_, (tl_ & 63), wv_, bl_, G_, 1, CV_FOLD0, CV_WO0, nx ? bl_ - nx : bl_, G_ - nx); }
#endif
        } break;
        case 7: {
#ifndef DIS_N2
            if (l == 0 && G_ > 16) {
                unsigned* cnt = (unsigned*)(PTRV(29, unsigned char) + WS_CTL) + 2048;
                if (bl_ < 8) {
                    pg8::Gemm g{WSP(bf16, WS_MB), WSP(bf16, WS_WO), MT, 1024, 1024}; OneUnit S{64 + (bl_ >> 2), bl_ & 3};
                    EpiWout E{INP(0), INP(2), WSP(float, WS_X), WSP(float, WS_MOD)};
                    pg8::gemm_phase<EpiWout, OneUnit, true, true>(lds, g, S, E);
                    asm volatile("s_waitcnt vmcnt(0)" ::: "memory"); __syncthreads();
                    if (tl_ == 0) { __builtin_amdgcn_fence(__ATOMIC_RELEASE, "agent"); asm volatile("s_waitcnt vmcnt(0)" ::: "memory"); __hip_atomic_fetch_add(cnt, 1u, __ATOMIC_RELAXED, __HIP_MEMORY_SCOPE_AGENT); }
                } else norm2_router(PH_CALL, l, 0, ML, bl_ - 8, G_ - 8);
                if (tl_ == 0) { unsigned sp_ = 0; while (__hip_atomic_load(cnt, __ATOMIC_RELAXED, __HIP_MEMORY_SCOPE_AGENT) < 8u && ++sp_ < (1u << 22)) __builtin_amdgcn_s_sleep(2);
                    __builtin_amdgcn_fence(__ATOMIC_ACQUIRE, "agent"); asm volatile("s_waitcnt vmcnt(0)" ::: "memory"); }
                __syncthreads();
                norm2_router(PH_CALL, l, ML, MC, bl_, G_, bl_ < 8);
            } else norm2_router(PH_CALL, l, 0, ntm * 256, bl_, G_);
#endif
        } break;
        case 8: {
#ifndef DIS_TOPK
            const int nun = l == 0 ? 64 : 32;
            for (int u = bl_; u < nun; u += G_) {
                if (u < 32) { const int b = u >> 4, e = u & 15; topk_unit<16, true>(PH_CALL, b * SEQ, SEQ, CAPL, e, b * CAPL, l == 0 && b == 0); }
                else { const int b = (u - 32) >> 4, e = u & 15; topk_unit<1, false>(PH_CALL, ML + b * CTXL, CTXL, CAPC, e, 2048 + b * CAPC, false); }
            }
#endif
        } break;
        case 9: {
#ifndef DIS_GATH
            gather_rows(PH_CALL, tpe);
#endif
        } break;
        case 10: {
            pg8::Gemm g{WSP(bf16, WS_H), WSP(bf16, WS_WGU), NE * ESTR, NE * 2048, 1024, WSP(int, WS_IDX)}; GroupOrder S; S.init(tpe, 8, G_, bl_);
            EpiGU E{WSP(bf16, WS_ACT)};
#ifndef DIS_GGU
            pg8::gemm_phase<EpiGU, GroupOrder, true, true, true>(lds, g, S, E);
#endif
#ifndef DIS_CVT
            if (l == 0) { const int nx = (NE * tpe * 8) % G_; convert_range(lds, tl_, (tl_ & 63), wv_, bl_, G_, 1, CV_WO0, CV_GU0, nx ? bl_ - nx : bl_, G_ - nx);
                          convert_range(lds, tl_, (tl_ & 63), wv_, bl_, G_, 1, CV_SP0, CV_END, nx ? bl_ - nx : bl_, G_ - nx); }
#endif
        } break;
        case 11: {
            pg8::Gemm g{WSP(bf16, WS_ACT), WSP(bf16, WS_WDN), NE * ESTR, NE * 1024, 1024}; GroupOrder S; S.init(tpe, 4, G_, bl_);
            EpiDown E{WSP(bf16, WS_XE), WSP(float, WS_GATE)};
#ifndef DIS_GDN
            pg8::gemm_phase<EpiDown, GroupOrder, true, true>(lds, g, S, E);
#endif
#ifndef DIS_CVT
            if (l == 0) { const int nx = (NE * tpe * 4) % G_; convert_range(lds, tl_, (tl_ & 63), wv_, bl_, G_, 1, CV_GU0, CV_DN0, nx ? bl_ - nx : bl_, G_ - nx); }
#endif
        } break;
        default: {
#ifndef DIS_COMB
#ifdef COMB_REP
#pragma unroll 1
            for (int r_ = 0; r_ < COMB_REP; ++r_) combine_rows<true>(PH_CALL, l);
#endif
            combine_rows<false>(PH_CALL, l);
#endif
#ifndef DIS_CVT
            if (l == 0) convert_range(lds, tl_, (tl_ & 63), wv_, bl_, G_, 1, CV_DN0, CV_SP0, bl_, G_);
#endif
        } break;
        }
#ifdef XBAR
        if (ph == 1) { for (int xb_ = 0; xb_ < XBAR; ++xb_) { XcdBarrier b5 = bar; b5.bar = (unsigned*)(PTRV(29, unsigned char) + WS_CTL) + CW_BAR; b5.st = (volatile LAS unsigned*)(lds + MISC_OFF) + 8; xcd_barrier(b5); } }
#endif
#ifdef TS_I
        { XcdBarrier b3 = bar; b3.bar = (unsigned*)(PTRV(29, unsigned char) + WS_CTL) + CW_BAR; b3.st = (volatile LAS unsigned*)(lds + MISC_OFF) + 8; xcd_barrier(b3);
          if (bid == 0 && tid == 0) ((unsigned long long*)(PTRV(29, unsigned char) + 65536))[ph + 1] = rt(); }
        if (ph + 1 == hi) { XcdBarrier b3 = bar; b3.bar = (unsigned*)(PTRV(29, unsigned char) + WS_CTL) + CW_BAR; b3.st = (volatile LAS unsigned*)(lds + MISC_OFF) + 8; xcd_barrier(b3);
            const unsigned long long* TS = (const unsigned long long*)(PTRV(29, unsigned char) + 65536);
            const float dti = (float)(TS[TS_I + 1] - TS[TS_I]) * 0.01f, dtj = (float)(TS[TS_J + 1] - TS[TS_J]) * 0.01f;
            float* out = PTRV(28, float); const float Av = sqrtf(dti);
            for (size_t i = (size_t)bid * 512 + tid; i < (size_t)ML * 1024; i += (size_t)G * 512) out[i] = (i == 0) ? dtj * 10.f : Av; }
        if (0) {
#else
#ifdef REP_PH
        if (it_ + 1 < hi + (REP_N - 1)) {
#else
        if (ph + 1 < hi) {
#endif
#endif
          XcdBarrier b2 = bar; b2.bar = (unsigned*)(PTRV(29, unsigned char) + WS_CTL) + CW_BAR; unsigned bx_ = bar.x; asm volatile("" : "+s"(bx_)); b2.x = bx_; b2.st = (volatile LAS unsigned*)(lds + MISC_OFF) + 8; xcd_barrier(b2); }
    }
}

extern "C" void kernel_launch(void* const* d_in, const int* in_sizes, int n_in, void* d_out, int out_size, void* d_ws, size_t ws_size, hipStream_t stream) {
    static int grid = 0;
    if (grid == 0) {
        if (n_in != 28 || ws_size < WS_END) { fprintf(stderr, "kernel_launch: unexpected n_in %d / ws %zu\n", n_in, ws_size); grid = -1; return; }
        int dev = 0, cus = 0;
        if (hipGetDevice(&dev) != hipSuccess || hipDeviceGetAttribute(&cus, hipDeviceAttributeMultiprocessorCount, dev) != hipSuccess) { grid = -1; return; }
        if (hipFuncSetAttribute((const void*)mega, hipFuncAttributeMaxDynamicSharedMemorySize, LDS_BYTES) != hipSuccess) { fprintf(stderr, "kernel_launch: hipFuncSetAttribute failed\n"); grid = -1; return; }
        (void)hipGetLastError();
        grid = cus;
    }
    if (grid < 0) return;
    (void)hipMemsetAsync((char*)d_ws + WS_CTL, 0, CTL_ZERO_BYTES, stream);
    Args a{};
    for (int i = 0; i < 28; ++i) a.in[i] = (const float*)d_in[i];
    a.out = (float*)d_out; a.ws = (unsigned char*)d_ws;
#ifdef DBG_STOP
    for (int p = 0; p < (DBG_STOP > 20 ? DBG_STOP / 10 : DBG_STOP); ++p) { a.ph_lo = p; a.ph_hi = p + 1; hipLaunchKernelGGL(mega, dim3(grid), dim3(512), LDS_BYTES, stream, a); }
    a.ph_lo = 99; a.ph_hi = 100; hipLaunchKernelGGL(mega, dim3(grid), dim3(512), LDS_BYTES, stream, a);
#elif N_LAUNCHES == 1
    a.ph_lo = 0; a.ph_hi = NPH;
    hipLaunchKernelGGL(mega, dim3(grid), dim3(512), LDS_BYTES, stream, a);
#else
    for (int p = 0; p < NPH; ++p) { a.ph_lo = p; a.ph_hi = p + 1; hipLaunchKernelGGL(mega, dim3(grid), dim3(512), LDS_BYTES, stream, a); }
#endif
}
```

```cpp
#include <hip/hip_runtime.h>
#include <cstdio>
#include <cstdint>
#define N_LAUNCHES 1
namespace pg8 {
#define PG8_LAS __attribute__((address_space(3)))
typedef unsigned short bf16_t;
typedef short bf16x8 __attribute__((ext_vector_type(8)));
typedef float f32x4 __attribute__((ext_vector_type(4)));
typedef unsigned u32x4 __attribute__((ext_vector_type(4)));
constexpr int BM = 256, BK = 64, HALF = 128, HTB = HALF * BK * 2  , STAGE_BYTES = 8 * HTB, NXCD = 8, WGM = 2;

__host__ __device__ __forceinline__ int lds_byte(int r, int c) { const int st = (r >> 4) * 2 + (c >> 5), rr = r & 15, cc = c & 31, ob = rr * 64 + cc * 2; return st * 1024 + (ob ^ (((ob >> 9) & 1) << 5)); }
__host__ __device__ __forceinline__ void stage_rc(int b, int& R, int& C) { const int st = b / 1024, sb = b % 1024, swz = sb ^ (((sb >> 9) & 1) << 5); R = (st >> 1) * 16 + swz / 64; C = (st & 1) * 32 + (swz % 64) / 2; }
__host__ __device__ __forceinline__ int perm32(int rho) { const int n = rho >> 4, i = rho & 15; return 8 * (i >> 2) + 4 * n + (i & 3); }

struct Unit { int pm, pn; };
struct Gemm { const bf16_t* A; const bf16_t* Bt; int M, N, K; const int* gidx = nullptr; };

struct StaticOrder {
    int nM, nN, nwg, G, c;
    __host__ __device__ void init(int M, int N, int G_, int c_) { nM = M / BM; nN = N / BM; nwg = nM * nN; G = G_; c = c_; }
    __host__ __device__ bool next(int i, Unit& u) const {
        const long L = (long)i * G + c; if (L >= nwg) return false;
        int wgid = (int)L; { const int q = nwg / NXCD, r = nwg % NXCD, xcd = wgid % NXCD, off = wgid / NXCD; wgid = (xcd < r ? xcd * (q + 1) : r * (q + 1) + (xcd - r) * q) + off; }
        const int nig = WGM * nN, gid = wgid / nig, fm = gid * WGM, gsz = (nM - fm) < WGM ? (nM - fm) : WGM;
        u.pm = fm + ((wgid % nig) % gsz); u.pn = (wgid % nig) / gsz; return true;
    }
    __device__ __forceinline__ void a_ready(const Unit&) const {}
    __device__ __forceinline__ void done(const Unit&) const {}
};
__device__ __forceinline__ unsigned cvt_pk_bf16(float lo, float hi) { unsigned r; asm volatile("v_cvt_pk_bf16_f32 %0, %1, %2" : "=v"(r) : "v"(lo), "v"(hi)); return r; }
typedef float f32x2 __attribute__((ext_vector_type(2)));
template <class Epi, class Sched, bool ALIGN_EPI = false, bool SP2 = false, bool GATHER = false>
__device__ __forceinline__ void gemm_phase(PG8_LAS unsigned char* lds, const Gemm g, const Sched& S, const Epi& E) {
    int tid_l = threadIdx.x; asm volatile("" : "+v"(tid_l));
    const int tid = tid_l, wid = __builtin_amdgcn_readfirstlane(tid >> 6), lane = tid & 63, wr = wid >> 2, wc = wid & 3, fr = lane & 15, fq = lane >> 4;
    const int K = g.K, nt = K / BK;
    unsigned voffA[2], voffB[2];
#pragma unroll
    for (int i = 0; i < 2; ++i) { int R, C; stage_rc(tid * 16 + i * 8192, R, C); const int Rb = Epi::PERM ? ((R & ~31) + perm32(R & 31)) : R;
        voffA[i] = (unsigned)(R * K + C) * 2u; voffB[i] = (unsigned)(Rb * K + C) * 2u; }
    const size_t kstep = (size_t)(BK * 2);
    const size_t hstep = (size_t)HALF * K * 2;
    const size_t tstep = 2 * hstep;
    const unsigned ldsw = (unsigned)wid * 1024u;
    const int aoff = lds_byte(wr * 64 + fr, fq * 8), boff = lds_byte(wc * 32 + fr, fq * 8);
#define PG8_SA(b, h) (((b) * 2 + (h)) * HTB)
#define PG8_SB(b, h) ((4 + (b) * 2 + (h)) * HTB)
#define PG8_STAGE(bufoff, gbase, voff) do { _Pragma("unroll") for (int _i = 0; _i < 2; ++_i) \
        __builtin_amdgcn_global_load_lds((const unsigned*)((const char*)(gbase) + (voff)[_i]), (PG8_LAS unsigned*)(lds + (bufoff) + ldsw + _i * 8192), 16, 0, 0); } while (0)
    static_assert(!GATHER || SP2, "GATHER is implemented on the SP2 loop only");
    unsigned vgc[2][2] = {{0u, 0u}, {0u, 0u}}, vgn[2][2] = {{0u, 0u}, {0u, 0u}};
#define PG8_GLOAD(u, v) do { _Pragma("unroll") for (int _h = 0; _h < 2; ++_h) _Pragma("unroll") for (int _i = 0; _i < 2; ++_i) { int R_, C_; stage_rc(tid * 16 + _i * 8192, R_, C_); \
        v[_h][_i] = (unsigned)(g.gidx[(u).pm * BM + _h * HALF + R_] * K + C_) * 2u; } } while (0)
#define PG8_STAGE_A(bufoff, base, half, NEXT) do { if constexpr (GATHER) { if (NEXT) PG8_STAGE(bufoff, base, vgn[half]); else PG8_STAGE(bufoff, base, vgc[half]); } \
        else PG8_STAGE(bufoff, (base) + (half) * hstep, voffA); } while (0)
#define PG8_LDA(dst, b, h) do { _Pragma("unroll") for (int m = 0; m < 4; ++m) _Pragma("unroll") for (int k = 0; k < 2; ++k) dst[m][k] = *(const PG8_LAS bf16x8*)(lds + PG8_SA(b, h) + aoff + m * 2048 + k * 1024); } while (0)
#define PG8_LDB(dst, b, h) do { _Pragma("unroll") for (int n = 0; n < 2; ++n) _Pragma("unroll") for (int k = 0; k < 2; ++k) dst[n][k] = *(const PG8_LAS bf16x8*)(lds + PG8_SB(b, h) + boff + n * 2048 + k * 1024); } while (0)
#define PG8_MMA(ai, bj, At, Bt) do { __builtin_amdgcn_s_setprio(1); _Pragma("unroll") for (int m = 0; m < 4; ++m) _Pragma("unroll") for (int n = 0; n < 2; ++n) _Pragma("unroll") for (int k = 0; k < 2; ++k) \
        acc[ai][bj][m][n] = __builtin_amdgcn_mfma_f32_16x16x32_bf16(Bt[n][k], At[m][k], acc[ai][bj][m][n], 0, 0, 0); __builtin_amdgcn_s_setprio(0); } while (0)
#define PG8_WAIT_V(n) asm volatile("s_waitcnt vmcnt(" #n ")" ::: "memory")
#define PG8_WAIT_L(n) asm volatile("s_waitcnt lgkmcnt(" #n ")" ::: "memory")
#define PG8_BAR __builtin_amdgcn_s_barrier()
#define PG8_SCHED __builtin_amdgcn_sched_barrier(0)
    Unit cur, nxt; int ui = 0;
    if (!S.next(0, cur)) return;
    f32x4 acc[2][2][4][2];
#pragma unroll
    for (int a = 0; a < 2; ++a)
#pragma unroll
        for (int b = 0; b < 2; ++b)
#pragma unroll
            for (int m = 0; m < 4; ++m)
#pragma unroll
                for (int n = 0; n < 2; ++n) acc[a][b][m][n] = (f32x4){0.f, 0.f, 0.f, 0.f};
    bf16x8 At[4][2], B0[2][2], B1[2][2];
    const char* cA = GATHER ? (const char*)g.A : (const char*)g.A + (size_t)cur.pm * tstep; const char* cB = (const char*)g.Bt + (size_t)cur.pn * tstep;
    if constexpr (GATHER) { PG8_GLOAD(cur, vgc); }
    S.a_ready(cur);
    if constexpr (SP2) {
        PG8_STAGE(PG8_SB(0, 0), cB, voffB); PG8_STAGE(PG8_SB(0, 1), cB + hstep, voffB); PG8_STAGE_A(PG8_SA(0, 0), cA, 0, false); PG8_STAGE_A(PG8_SA(0, 1), cA, 1, false);
        if (wr == 1) PG8_BAR;
        PG8_WAIT_V(2); PG8_BAR;
        PG8_STAGE(PG8_SB(1, 0), cB + kstep, voffB); PG8_STAGE_A(PG8_SA(1, 0), cA + kstep, 0, false); PG8_STAGE(PG8_SB(1, 1), cB + hstep + kstep, voffB);
        PG8_WAIT_V(6); PG8_BAR;
    } else {
        PG8_STAGE(PG8_SB(0, 0), cB, voffB); PG8_STAGE(PG8_SA(0, 0), cA, voffA); PG8_STAGE(PG8_SB(0, 1), cB + hstep, voffB); PG8_STAGE(PG8_SA(0, 1), cA + hstep, voffA);
        if (wr == 1) PG8_BAR;
        PG8_WAIT_V(4); PG8_BAR;
        PG8_STAGE(PG8_SB(1, 0), cB + kstep, voffB); PG8_STAGE(PG8_SA(1, 0), cA + kstep, voffA); PG8_STAGE(PG8_SB(1, 1), cB + hstep + kstep, voffB);
        PG8_WAIT_V(6); PG8_BAR;
    }
    for (;;) {
        const bool has_next = S.next(ui + 1, nxt);
        const char* nA = GATHER ? (const char*)g.A : (has_next ? (const char*)g.A + (size_t)nxt.pm * tstep : cA);
        if constexpr (GATHER) { if (has_next) { PG8_GLOAD(nxt, vgn); } else { _Pragma("unroll") for (int _h = 0; _h < 2; ++_h) _Pragma("unroll") for (int _i = 0; _i < 2; ++_i) vgn[_h][_i] = vgc[_h][_i]; } } const char* nB = has_next ? (const char*)g.Bt + (size_t)nxt.pn * tstep : cB;
#pragma unroll 1
        for (int t = 0; t < nt; t += 2) {
            const bool last = (t == nt - 2);
            const char* a1 = cA + (size_t)(t + 1) * kstep;
            const char* a2 = last ? nA : cA + (size_t)(t + 2) * kstep; const char* b2 = last ? nB : cB + (size_t)(t + 2) * kstep;
            const char* a3 = a2 + kstep; const char* b3 = b2 + kstep;
            if (last && has_next) S.a_ready(nxt);
            if constexpr (SP2) {
            PG8_LDB(B0, 0, 0); PG8_LDB(B1, 0, 1); PG8_SCHED; PG8_LDA(At, 0, 0); PG8_STAGE_A(PG8_SA(1, 1), a1, 1, false);
            PG8_WAIT_V(8); PG8_WAIT_L(0); PG8_BAR; PG8_MMA(0, 0, At, B0); PG8_MMA(0, 1, At, B1); PG8_BAR; PG8_SCHED;
            PG8_LDA(At, 0, 1); PG8_STAGE(PG8_SB(0, 0), b2, voffB); PG8_STAGE(PG8_SB(0, 1), b2 + hstep, voffB); PG8_STAGE_A(PG8_SA(0, 0), a2, 0, last);
            PG8_WAIT_V(8); PG8_WAIT_L(0); PG8_BAR; PG8_MMA(1, 0, At, B0); PG8_MMA(1, 1, At, B1); PG8_BAR; PG8_SCHED;
            PG8_LDB(B0, 1, 0); PG8_LDB(B1, 1, 1); PG8_SCHED; PG8_LDA(At, 1, 0); PG8_STAGE_A(PG8_SA(0, 1), a2, 1, last);
            PG8_WAIT_V(8); PG8_WAIT_L(0); PG8_BAR; PG8_MMA(0, 0, At, B0); PG8_MMA(0, 1, At, B1); PG8_BAR; PG8_SCHED;
            PG8_LDA(At, 1, 1); PG8_STAGE(PG8_SB(1, 0), b3, voffB); PG8_STAGE(PG8_SB(1, 1), b3 + hstep, voffB); PG8_STAGE_A(PG8_SA(1, 0), a3, 0, last);
            PG8_WAIT_V(8); PG8_WAIT_L(0); PG8_BAR; PG8_MMA(1, 0, At, B0); PG8_MMA(1, 1, At, B1); PG8_BAR; PG8_SCHED;
            } else {
            PG8_LDB(B0, 0, 0); PG8_SCHED; PG8_LDA(At, 0, 0); PG8_STAGE(PG8_SA(1, 1), a1 + hstep, voffA);
            PG8_WAIT_L(8); PG8_BAR; PG8_WAIT_L(0); PG8_MMA(0, 0, At, B0); PG8_BAR; PG8_SCHED;
            PG8_LDB(B1, 0, 1); PG8_STAGE(PG8_SB(0, 0), b2, voffB);
            PG8_BAR; PG8_WAIT_L(0); PG8_MMA(0, 1, At, B1); PG8_BAR;
            PG8_LDA(At, 0, 1); PG8_STAGE(PG8_SA(0, 0), a2, voffA);
            PG8_BAR; PG8_WAIT_L(0); PG8_MMA(1, 0, At, B0); PG8_BAR; PG8_SCHED;
            PG8_STAGE(PG8_SB(0, 1), b2 + hstep, voffB);
            PG8_WAIT_V(6); PG8_BAR; PG8_MMA(1, 1, At, B1); PG8_BAR;
            PG8_LDB(B0, 1, 0); PG8_SCHED; PG8_LDA(At, 1, 0); PG8_STAGE(PG8_SA(0, 1), a2 + hstep, voffA);
            PG8_WAIT_L(8); PG8_BAR; PG8_WAIT_L(0); PG8_MMA(0, 0, At, B0); PG8_BAR; PG8_SCHED;
            PG8_LDB(B1, 1, 1); PG8_STAGE(PG8_SB(1, 0), b3, voffB);
            PG8_BAR; PG8_WAIT_L(0); PG8_MMA(0, 1, At, B1); PG8_BAR;
            PG8_LDA(At, 1, 1); PG8_STAGE(PG8_SA(1, 0), a3, voffA);
            PG8_BAR; PG8_WAIT_L(0); PG8_MMA(1, 0, At, B0); PG8_BAR; PG8_SCHED;
            PG8_STAGE(PG8_SB(1, 1), b3 + hstep, voffB);
            PG8_WAIT_V(6); PG8_BAR; PG8_MMA(1, 1, At, B1); PG8_BAR;
            }
        }
        if constexpr (ALIGN_EPI) { if (wr == 0) PG8_BAR; }
        if constexpr (!Epi::AFTER_DRAIN) { int t2_ = threadIdx.x; asm volatile("" : "+v"(t2_)); E(acc, cur, wr, wc, t2_ & 15, (t2_ >> 4) & 3); S.done(cur); }
        if (!has_next) break;
        bool keep_ = false; if constexpr (Epi::KEEP) keep_ = E.keep(cur);
        if (!keep_) {
#pragma unroll
        for (int a = 0; a < 2; ++a)
#pragma unroll
            for (int b = 0; b < 2; ++b)
#pragma unroll
                for (int m = 0; m < 4; ++m)
#pragma unroll
                    for (int n = 0; n < 2; ++n) acc[a][b][m][n] = (f32x4){0.f, 0.f, 0.f, 0.f};
        }
        cur = nxt; cA = nA; cB = nB; ++ui;
        if constexpr (GATHER) { _Pragma("unroll") for (int _h = 0; _h < 2; ++_h) _Pragma("unroll") for (int _i = 0; _i < 2; ++_i) vgc[_h][_i] = vgn[_h][_i]; }
        if constexpr (ALIGN_EPI) { if (wr == 1) PG8_BAR; }
    }
    PG8_WAIT_V(0);
    if constexpr (!ALIGN_EPI) { if (wr == 0) PG8_BAR; }
    PG8_BAR;
    if constexpr (Epi::AFTER_DRAIN) { E.fused(acc, cur, wr, wc, fr, fq, lds, wid, lane); S.done(cur); }
#undef PG8_SA
#undef PG8_SB
#undef PG8_STAGE
#undef PG8_STAGE_A
#undef PG8_GLOAD
#undef PG8_LDA
#undef PG8_LDB
#undef PG8_MMA
#undef PG8_WAIT_V
#undef PG8_WAIT_L
#undef PG8_BAR
#undef PG8_SCHED
}
}
#define GAS __attribute__((address_space(1)))
#define LAS __attribute__((address_space(3)))
typedef unsigned short bf16;
typedef unsigned v4u __attribute__((ext_vector_type(4)));
typedef float f32x4 __attribute__((ext_vector_type(4)));
typedef short bf16x8 __attribute__((ext_vector_type(8)));
typedef GAS unsigned gu32;
typedef GAS unsigned long long gu64;
#define RLX_AGENT __ATOMIC_RELAXED, __HIP_MEMORY_SCOPE_AGENT
#define LDS_WAIT() asm volatile("s_waitcnt lgkmcnt(0)" ::: "memory")
#define VM_WAIT() asm volatile("s_waitcnt vmcnt(0)" ::: "memory")
__device__ __forceinline__ unsigned long long rt() { return __builtin_amdgcn_s_memrealtime(); }
__device__ __forceinline__ unsigned f2bf(float f) { unsigned u = __builtin_bit_cast(unsigned, f); return (u + 0x7fffu + ((u >> 16) & 1u)) >> 16; }
typedef float f32x2_t __attribute__((ext_vector_type(2))); typedef __bf16 bf16x2_t __attribute__((ext_vector_type(2)));
__device__ __forceinline__ unsigned pk2(float lo, float hi) { const f32x2_t v = {lo, hi}; const bf16x2_t b = __builtin_convertvector(v, bf16x2_t); return __builtin_bit_cast(unsigned, b); }

#define XB_TMO      128
#define XB_XCNT(j)  (256  + 64 * (j))
#define XB_XSUB(j)  (1280 + 64 * (j))
#define XB_XGEN(j)  (2304 + 64 * (j))
#define XB_TOP      3328
#define XB_TOPGEN   3392
#define XCD_BAR_WORDS 3456
#define XB_SPIN_CAP (1u << 18)

__device__ __forceinline__ unsigned xb_ld(unsigned* p)              { return __hip_atomic_load(p, __ATOMIC_RELAXED, __HIP_MEMORY_SCOPE_AGENT); }
__device__ __forceinline__ unsigned xb_add(unsigned* p, unsigned v) { return __hip_atomic_fetch_add(p, v, __ATOMIC_RELAXED, __HIP_MEMORY_SCOPE_AGENT); }
__device__ __forceinline__ unsigned xb_xcc_id() { return (unsigned)__builtin_amdgcn_s_getreg((3 << 11) | 20) & 0xFu; }
#define XB_SPIN(cond, bar) do { unsigned _sp = 0; while (cond) { __builtin_amdgcn_s_sleep(1); \
    if ((++_sp & 255u) == 0u) { if (xb_ld(&(bar)[XB_TMO])) break; if (_sp > XB_SPIN_CAP) { atomicAdd(&(bar)[XB_TMO], 1u); break; } } } } while (0)

struct XcdBarrier {
    unsigned* bar; unsigned x;
    volatile LAS unsigned* st;
};

__device__ __forceinline__ XcdBarrier xcd_barrier_post(unsigned* bar, volatile LAS unsigned* st) {
    XcdBarrier b; b.bar = bar; b.x = xb_xcc_id(); b.st = st;
    if (threadIdx.x == 0) (void)xb_add(&bar[XB_XCNT(b.x)], 1u);
    return b;
}
__device__ __forceinline__ void xcd_barrier_complete(unsigned* bar, unsigned x, unsigned& nloc, unsigned& nx) {
    const unsigned G = gridDim.x * gridDim.y * gridDim.z;
    unsigned sum, cnt, mine, sp = 0u;
    for (;;) {
        sum = 0u; cnt = 0u; mine = 0u;
#pragma unroll
        for (unsigned j = 0; j < 16; ++j) { const unsigned c = xb_ld(&bar[XB_XCNT(j)]); sum += c; cnt += (c > 0u) ? 1u : 0u; mine = (j == x) ? c : mine; }
        if (sum == G) break;
        __builtin_amdgcn_s_sleep(1);
        if ((++sp & 255u) == 0u) { if (xb_ld(&bar[XB_TMO])) break; if (sp > XB_SPIN_CAP) { atomicAdd(&bar[XB_TMO], 1u); break; } }
    }
    nloc = mine > 0u ? mine : 1u; nx = cnt > 0u ? cnt : 1u;
}

__device__ __forceinline__ void xcd_barrier(const XcdBarrier& b) {
    asm volatile("s_waitcnt vmcnt(0)" ::: "memory");
    __syncthreads();
    if (threadIdx.x == 0) {
        unsigned* bar = b.bar;
        __builtin_amdgcn_s_waitcnt(0);
        unsigned nloc = b.st[0], nx = b.st[1];
        if (nloc == 0u) { xcd_barrier_complete(bar, b.x, nloc, nx); b.st[0] = nloc; b.st[1] = nx; }
        const unsigned old = xb_add(&bar[XB_XSUB(b.x)], 1u);
        const unsigned gen = old / nloc;
        if (old + 1u == (gen + 1u) * nloc) {
            __builtin_amdgcn_fence(__ATOMIC_RELEASE, "agent");
            asm volatile("s_waitcnt vmcnt(0)" ::: "memory");
            const unsigned og = xb_add(&bar[XB_TOP], 1u);
            const unsigned tg = og / nx;
            if (og + 1u == (tg + 1u) * nx) xb_add(&bar[XB_TOPGEN], 1u);
            else XB_SPIN(xb_ld(&bar[XB_TOPGEN]) == tg, bar);
            __builtin_amdgcn_fence(__ATOMIC_ACQUIRE, "agent");
            xb_add(&bar[XB_XGEN(b.x)], 1u);
            asm volatile("s_waitcnt vmcnt(0)" ::: "memory");
        } else {
            XB_SPIN(xb_ld(&bar[XB_XGEN(b.x)]) == gen, bar);
            __builtin_amdgcn_fence(__ATOMIC_ACQUIRE, "agent");
            asm volatile("s_waitcnt vmcnt(0)" ::: "memory");
        }
    }
    __syncthreads();
}
constexpr int DM = 1024, SEQ = 8192, NBATCH = 2, CTXL = 256;
constexpr int ML = NBATCH * SEQ, MC = NBATCH * CTXL, MT = ML + MC;
constexpr int NIN = 6400;
constexpr int NE = 16, ESTR = 2304, CAPL = 1024, CAPC = 32;
constexpr int NPH = 24;
constexpr size_t MiB = 1u << 20;
constexpr size_t WS_CTL = 0, CTL_ZERO_BYTES = 1 * MiB;
constexpr size_t WS_MOD = 1 * MiB;
constexpr size_t WS_ROPEC = 1 * MiB + 256 * 1024, WS_ROPES = WS_ROPEC + 8192;
constexpr size_t WS_TW = 1 * MiB + 512 * 1024;
constexpr size_t WS_CS256 = 1 * MiB + 640 * 1024;
constexpr size_t WS_T1T = 2 * MiB;
constexpr size_t WS_T2T = 2 * MiB + 64 * 1024;
constexpr size_t WS_T2F = 8 * MiB;
constexpr size_t WS_T2C = 12 * MiB;
constexpr size_t WS_FAC = 13 * MiB;
constexpr size_t WS_WSP = 2 * MiB + 256 * 1024;
constexpr size_t WS_AFF = 3 * MiB;
constexpr size_t WS_SEL = 5 * MiB;
constexpr size_t WS_IDX = 7 * MiB, WS_GATE = 7 * MiB + 256 * 1024;
constexpr size_t WS_WIN = 16 * MiB, WS_WBR = 29 * MiB, WS_WO = 31 * MiB, WS_WGU = 33 * MiB, WS_WDN = 97 * MiB;
constexpr size_t WS_X = 130 * MiB;
constexpr size_t WS_H = 196 * MiB;
constexpr size_t WS_BR = 229 * MiB;
constexpr size_t WS_MB = 262 * MiB;
constexpr size_t WS_FA = 295 * MiB;
constexpr size_t WS_Z = 311 * MiB;
constexpr size_t ZROW = (size_t)MT * 2;
constexpr size_t WS_AUV = WS_Z, WS_YF = WS_AUV + 512 * ZROW, WS_CY = WS_YF + 512 * ZROW, WS_QPL = WS_CY + 256 * ZROW, WS_QROT = WS_QPL + 256 * ZROW,
                 WS_KR = WS_QROT + 256 * ZROW, WS_VV = WS_KR + 256 * ZROW, WS_G = WS_VV + 256 * ZROW, WS_ZEND = WS_G + 4096 * ZROW;
constexpr size_t WS_P32 = WS_Z;
constexpr size_t WS_XE = WS_Z, WS_ACT = WS_Z + 72 * MiB;
constexpr size_t WS_END = 518 * MiB;
static_assert(WS_G == WS_P32 + (size_t)MT * 1024 * 4 + 8 * 256 * ZROW / 8 - 256 * ZROW || true, "");
static_assert(WS_ZEND <= WS_END && WS_ACT + 72 * MiB <= WS_ZEND && WS_P32 + (size_t)MT * 4096 <= WS_VV, "ws map");
constexpr int CW_BAR = 4096;
constexpr int LDS_BYTES = 155648, MISC_OFF = 154624;

struct Args { const float* in[28]; float* out; unsigned char* ws; int ph_lo, ph_hi; };

__device__ __forceinline__ float bflo(unsigned w) { return __uint_as_float(w << 16); }
__device__ __forceinline__ float bfhi(unsigned w) { return __uint_as_float(w & 0xffff0000u); }
__device__ __forceinline__ float sigm(float x) { return __builtin_amdgcn_rcpf(1.f + __expf(-x)); }
__device__ __forceinline__ float wave_sum(float v) {
#pragma unroll
    for (int o = 1; o < 64; o <<= 1) v += __shfl_xor(v, o);
    return v;
}
__device__ __forceinline__ void st4bf(bf16* p, f32x4 v) { uint2 w; w.x = pk2(v[0], v[1]); w.y = pk2(v[2], v[3]); *(uint2*)p = w; }

__device__ __forceinline__ void st8bf(bf16* p, f32x4 a, f32x4 b) { v4u w; w.x = pk2(a[0], a[1]); w.y = pk2(a[2], a[3]); w.z = pk2(b[0], b[1]); w.w = pk2(b[2], b[3]); *(v4u*)p = w; }
using pg8::Unit;
struct EpiIn {
    static constexpr bool PERM = false, AFTER_DRAIN = false, KEEP = false;
    bf16 *AUV, *YF, *CY, *QPL, *QROT, *KR, *VV, *G; const float* ropeC; const float* ropeS;
    __device__ __forceinline__ void operator()(const f32x4 (&acc)[2][2][4][2], const Unit& u, int wr, int wc, int fr, int fq) const {
        const int pn = u.pn, row0 = u.pm * 256 + wr * 64 + fr, cl0 = wc * 32 + 4 * fq;
        const int cp0 = wc * 32 + 8 * fq;
        if (pn < 2) {
#pragma unroll
            for (int ai = 0; ai < 2; ++ai)
#pragma unroll
                for (int m = 0; m < 4; ++m) { const size_t row = row0 + ai * 128 + m * 16;
#pragma unroll
                    for (int bj = 0; bj < 2; ++bj) { f32x4 v[2];
#pragma unroll
                        for (int n = 0; n < 2; ++n)
#pragma unroll
                            for (int j = 0; j < 4; ++j) { const float x = acc[ai][bj][m][n][j]; v[n][j] = x * sigm(1.5957691216f * (x + 0.044715f * x * x * x)); }
                        st8bf(AUV + row * 512 + pn * 256 + bj * 128 + cp0, v[0], v[1]); } }
        } else if (pn < 4) {
#pragma unroll
            for (int ai = 0; ai < 2; ++ai)
#pragma unroll
                for (int m = 0; m < 4; ++m) { const size_t row = row0 + ai * 128 + m * 16;
#pragma unroll
                    for (int bj = 0; bj < 2; ++bj) st8bf(YF + row * 512 + (pn - 2) * 256 + bj * 128 + cp0, acc[ai][bj][m][0], acc[ai][bj][m][1]); }
        } else if (pn < 6) {
#pragma unroll
            for (int ai = 0; ai < 2; ++ai)
#pragma unroll
                for (int m = 0; m < 4; ++m) { const size_t row = row0 + ai * 128 + m * 16; f32x4 v[2];
#pragma unroll
                    for (int n = 0; n < 2; ++n) { const f32x4 a = acc[ai][0][m][n], g = acc[ai][1][m][n];
#pragma unroll
                        for (int j = 0; j < 4; ++j) v[n][j] = a[j] * sigm(g[j]); }
                    st8bf(CY + row * 256 + (pn - 4) * 128 + cp0, v[0], v[1]); }
        } else if (pn < 8) {
            const bool isq = pn == 6; const float scl = isq ? 0.125f * 1.4426950408889634f : 1.f;   const bool latent = u.pm < 64;
#pragma unroll
            for (int ai = 0; ai < 2; ++ai)
#pragma unroll
                for (int m = 0; m < 4; ++m) { const int rowi = row0 + ai * 128 + m * 16; const size_t row = rowi; const int tok = rowi & 8191;
                    const int pos = (wc & 1) ? (tok & 63) : (tok >> 6);
                    f32x4 cs = {1.f, 1.f, 1.f, 1.f}, sn = {0.f, 0.f, 0.f, 0.f};
                    if (latent) { cs = *(const f32x4*)(ropeC + pos * 16 + 4 * fq); sn = *(const f32x4*)(ropeS + pos * 16 + 4 * fq); }
#pragma unroll
                    for (int bj = 0; bj < 2; ++bj) { const f32x4 x1 = acc[ai][bj][m][0] * scl, x2 = acc[ai][bj][m][1] * scl;
                        const f32x4 r1 = x1 * cs - x2 * sn, r2 = x1 * sn + x2 * cs; const size_t off = row * 256 + bj * 128 + cl0;
                        if (isq) { st4bf(QPL + off, x1); st4bf(QPL + off + 16, x2); st4bf(QROT + off, r1); st4bf(QROT + off + 16, r2); }
                        else { st4bf(KR + off, r1); st4bf(KR + off + 16, r2); } } }
        } else if (pn == 8) {
#pragma unroll
            for (int ai = 0; ai < 2; ++ai)
#pragma unroll
                for (int m = 0; m < 4; ++m) { const size_t row = row0 + ai * 128 + m * 16;
#pragma unroll
                    for (int bj = 0; bj < 2; ++bj) st8bf(VV + row * 256 + bj * 128 + cp0, acc[ai][bj][m][0], acc[ai][bj][m][1]); }
        } else {
#pragma unroll
            for (int ai = 0; ai < 2; ++ai)
#pragma unroll
                for (int m = 0; m < 4; ++m) { const size_t row = row0 + ai * 128 + m * 16;
#pragma unroll
                    for (int bj = 0; bj < 2; ++bj)
#pragma unroll
                        for (int n = 0; n < 2; ++n) { f32x4 v = acc[ai][bj][m][n];
#pragma unroll
                            for (int j = 0; j < 4; ++j) v[j] = sigm(v[j]);
                            const int gb_ = (pn - 9) >> 2, gu_ = (2 * u.pm + ai) * 8 + 2 * ((pn - 9) & 3) + bj;
                            st4bf(G + ((((size_t)(gu_ * 4 + gb_) * 8 + (wr * 4 + wc)) * 8 + m * 2 + n) * 256 + (fq * 16 + fr) * 4), v); } }
        }
    }
};
struct EpiMerge {
    static constexpr bool PERM = false, AFTER_DRAIN = false, KEEP = false;
    const bf16* G; float* P32; bf16* MB;
    __device__ __forceinline__ void operator()(const f32x4 (&acc)[2][2][4][2], const Unit& u, int wr, int wc, int fr, int fq) const {
        int fr_ = fr, fq_ = fq; asm volatile("" : "+v"(fr_), "+v"(fq_));
        const int b = u.pn >> 2, pn = u.pn & 3, pm = u.pm - b * 66, row0 = pm * 256 + wr * 64 + fr_, col0 = pn * 256 + wc * 32 + 4 * fq_;
#pragma unroll
        for (int ai = 0; ai < 2; ++ai)
#pragma unroll
            for (int m = 0; m < 4; ++m) { const unsigned row = row0 + ai * 128 + m * 16;
                const bf16* gp = G + ((size_t)row * 4096 + b * 1024 + col0); float* pp = P32 + ((size_t)row * 1024 + col0); bf16* mp = MB + ((size_t)row * 1024 + col0);
#pragma unroll
                for (int bj = 0; bj < 2; ++bj)
#pragma unroll
                    for (int n = 0; n < 2; ++n) { const int co = bj * 128 + n * 16;
                        const uint2 gw = *(const uint2*)(gp + co);
                        f32x4 v = acc[ai][bj][m][n]; v[0] *= bflo(gw.x); v[1] *= bfhi(gw.x); v[2] *= bflo(gw.y); v[3] *= bfhi(gw.y);
                        if (b > 0) v += *(const f32x4*)(pp + co);
                        if (b < 3) *(f32x4*)(pp + co) = v; else st4bf(mp + co, v);
                        asm volatile("" ::: "memory"); } }
    }
};
struct EpiMergeH {
    static constexpr bool PERM = false, AFTER_DRAIN = false, KEEP = true;
    const bf16* G; bf16* MB;
    __device__ __forceinline__ bool keep(const Unit& u) const { return (u.pn >> 2) < 3; }
    __device__ __forceinline__ void operator()(f32x4 (&acc)[2][2][4][2], const Unit& u, int wr, int wc, int fr, int fq) const {
        const int b = u.pn >> 2, pn = u.pn & 3, pm = u.pm - b * 66, row0 = pm * 256 + wr * 64 + fr, col0 = pn * 256 + wc * 32 + 4 * fq;
#pragma unroll
        for (int ai = 0; ai < 2; ++ai)
#pragma unroll
            for (int m = 0; m < 4; ++m) { const unsigned row = row0 + ai * 128 + m * 16; const bf16* gp = G + ((size_t)row * 4096 + b * 1024 + col0); bf16* mp = MB + ((size_t)row * 1024 + col0);
#pragma unroll
                for (int bj = 0; bj < 2; ++bj)
#pragma unroll
                    for (int n = 0; n < 2; ++n) { const int co = bj * 128 + n * 16; const uint2 gb = *(const uint2*)(gp + co); f32x4 v = acc[ai][bj][m][n];
                        if (b < 3) { const uint2 gn = *(const uint2*)(gp + 1024 + co);
                            v[0] *= bflo(gb.x) * __builtin_amdgcn_rcpf(bflo(gn.x)); v[1] *= bfhi(gb.x) * __builtin_amdgcn_rcpf(bfhi(gn.x)); v[2] *= bflo(gb.y) * __builtin_amdgcn_rcpf(bflo(gn.y)); v[3] *= bfhi(gb.y) * __builtin_amdgcn_rcpf(bfhi(gn.y));
                            acc[ai][bj][m][n] = v; }
                        else { v[0] *= bflo(gb.x); v[1] *= bfhi(gb.x); v[2] *= bflo(gb.y); v[3] *= bfhi(gb.y); st4bf(mp + co, v); } }
                asm volatile("" ::: "memory"); }
    }
};
struct EpiWout {
    static constexpr bool PERM = false, AFTER_DRAIN = false, KEEP = false;
    const float* xlat; const float* xctx; float* X; const float* mod;
    __device__ __forceinline__ void operator()(const f32x4 (&acc)[2][2][4][2], const Unit& u, int wr, int wc, int fr, int fq) const {
        const int r = u.pm < 32 ? 0 : (u.pm < 64 ? 1 : 2); const float* gt = mod + r * 6144 + 2 * 1024;
        const int row0 = u.pm * 256 + wr * 64 + fr, col0 = u.pn * 256 + wc * 32 + 4 * fq;
        f32x4 gv[2][2];
#pragma unroll
        for (int bj = 0; bj < 2; ++bj)
#pragma unroll
            for (int n = 0; n < 2; ++n) gv[bj][n] = *(const f32x4*)(gt + col0 + bj * 128 + n * 16);
#pragma unroll
        for (int ai = 0; ai < 2; ++ai)
#pragma unroll
            for (int m = 0; m < 4; ++m) { const size_t row = row0 + ai * 128 + m * 16; const float* src = (row < ML) ? xlat + row * 1024 : xctx + (row - ML) * 1024;
#pragma unroll
                for (int bj = 0; bj < 2; ++bj)
#pragma unroll
                    for (int n = 0; n < 2; ++n) { const int col = col0 + bj * 128 + n * 16;
                        *(f32x4*)(X + row * 1024 + col) = *(const f32x4*)(src + col) + gv[bj][n] * acc[ai][bj][m][n]; } }
    }
};
struct EpiGU {
    static constexpr bool PERM = true, AFTER_DRAIN = false, KEEP = false;
    bf16* ACT;
    __device__ __forceinline__ void operator()(const f32x4 (&acc)[2][2][4][2], const Unit& u, int wr, int wc, int fr, int fq) const {
        const int pnl = u.pn & 7, row0 = u.pm * 256 + wr * 64 + fr, cl0 = wc * 32 + 8 * fq;
#pragma unroll
        for (int ai = 0; ai < 2; ++ai)
#pragma unroll
            for (int m = 0; m < 4; ++m) { const size_t row = row0 + ai * 128 + m * 16; f32x4 v[2];
#pragma unroll
                for (int n = 0; n < 2; ++n) { const f32x4 a = acc[ai][0][m][n], up = acc[ai][1][m][n];
#pragma unroll
                    for (int j = 0; j < 4; ++j) v[n][j] = a[j] * sigm(a[j]) * up[j]; }
                st8bf(ACT + row * 1024 + pnl * 128 + cl0, v[0], v[1]); }
    }
};
struct EpiDown {
    static constexpr bool PERM = true, AFTER_DRAIN = false, KEEP = false;
    bf16* YB; const float* GATE;
    __device__ __forceinline__ void operator()(const f32x4 (&acc)[2][2][4][2], const Unit& u, int wr, int wc, int fr, int fq) const {
        const int pnl = u.pn & 3, row0 = u.pm * 256 + wr * 64 + fr, col0 = pnl * 256 + wc * 32 + 8 * fq;
#pragma unroll
        for (int ai = 0; ai < 2; ++ai)
#pragma unroll
            for (int m = 0; m < 4; ++m) { const size_t row = row0 + ai * 128 + m * 16; const float gt = GATE[row];
#pragma unroll
                for (int bj = 0; bj < 2; ++bj) st8bf(YB + row * 1024 + col0 + bj * 128, acc[ai][bj][m][0] * gt, acc[ai][bj][m][1] * gt); }
    }
};
struct MergeOrder {
    int nt, G, c;
    __device__ void init(int ntm, int G_, int c_) { nt = ntm * 4; G = G_; c = c_; }
    __device__ bool next(int i, Unit& u) const { const int b = i & 3, L = (i >> 2) * G + c; if (L >= nt) return false; u.pm = b * 66 + (L >> 2); u.pn = b * 4 + (L & 3); return true; }
    __device__ __forceinline__ void a_ready(const Unit&) const {}
    __device__ __forceinline__ void done(const Unit&) const {}
};
struct OneUnit { int pm, pn; __device__ bool next(int i, Unit& u) const { if (i > 0) return false; u.pm = pm; u.pn = pn; return true; }
    __device__ __forceinline__ void a_ready(const Unit&) const {} __device__ __forceinline__ void done(const Unit&) const {} };
struct GroupOrder {
    int nwg, G, c, TPE, NTN;
    __device__ void init(int tpe, int ntn, int G_, int c_) { TPE = tpe; NTN = ntn; nwg = NE * tpe * ntn; G = G_; c = c_; }
    __device__ bool next(int i, Unit& u) const {
        const long L = (long)i * G + c; if (L >= nwg) return false;
        int wgid = (int)L; { const int q = nwg / 8, r = nwg % 8, xcd = wgid % 8, off = wgid / 8; wgid = (xcd < r ? xcd * (q + 1) : r * (q + 1) + (xcd - r) * q) + off; }
        const int per = TPE * NTN, e = wgid / per, rem = wgid % per;
#ifdef GO_MT_MAJOR
        const int mt = rem / NTN, pn = rem % NTN;
#else
        const int pn = rem / TPE, mt = rem % TPE;
#endif
        u.pm = e * 9 + mt; u.pn = e * NTN + pn; return true;
    }
    __device__ __forceinline__ void a_ready(const Unit&) const {}
    __device__ __forceinline__ void done(const Unit&) const {}
};
typedef float f2v __attribute__((ext_vector_type(2)));
#define PH_ARGS LAS unsigned char* lds, const int tid, const int lane, const int wave, const int bid, const int G
#define WSP(T, off) ((T*)(PTRV(29, unsigned char) + (off)))
constexpr int PTAB_OFF = MISC_OFF + 512;
__device__ __forceinline__ unsigned long long ptab_ld(LAS unsigned char* lds, int i) {
    typedef unsigned u2v_t __attribute__((ext_vector_type(2)));
    const volatile LAS unsigned* tp = (const volatile LAS unsigned*)(lds + PTAB_OFF + 8 * i); u2v_t v; v[0] = tp[0]; v[1] = tp[1];
    const unsigned lo = __builtin_amdgcn_readfirstlane(v[0]), hi = __builtin_amdgcn_readfirstlane(v[1]);
    return ((unsigned long long)hi << 32) | lo;
}
#define PTRV(i, T) ((T*)(GAS T*)ptab_ld(lds, (i)))
#define INP(i) ((const float*)(GAS const float*)ptab_ld(lds, (i)))

__device__ __forceinline__ void mod_gemv(PH_ARGS) {
    LAS f32x4* red = (LAS f32x4*)lds;
    const float* c = INP(1); const float* cc = INP(3); const float* wm = INP(4); const float* bm = INP(5);
    float* MOD = WSP(float, WS_MOD);
    for (int it = bid; it < 192; it += G) {
        const int l = it / 96, cg = it % 96, kg = tid >> 4, cq = tid & 15;
        f32x4 a0 = {0.f, 0.f, 0.f, 0.f}, a1 = a0, a2 = a0;
        const float* wb = wm + (size_t)l * 1024 * 6144 + cg * 64 + cq * 4;
#pragma unroll 4
        for (int i = 0; i < 32; ++i) { const int k = kg + 32 * i; const f32x4 w = *(const f32x4*)(wb + (size_t)k * 6144);
            const float x0 = c[k], x1 = c[1024 + k], x2 = cc[k];
            a0 += w * (x0 * sigm(x0)); a1 += w * (x1 * sigm(x1)); a2 += w * (x2 * sigm(x2)); }
        red[(kg * 3 + 0) * 16 + cq] = a0; red[(kg * 3 + 1) * 16 + cq] = a1; red[(kg * 3 + 2) * 16 + cq] = a2;
        __syncthreads();
        if (tid < 192) { const int r = tid >> 6, col = tid & 63; float s = 0.f; const LAS float* rf = (const LAS float*)red;
            for (int k2 = 0; k2 < 32; ++k2) s += rf[((k2 * 3 + r) * 16 + (col >> 2)) * 4 + (col & 3)];
            MOD[(l * 3 + r) * 6144 + cg * 64 + col] = s + bm[l * 6144 + cg * 64 + col]; }
        __syncthreads();
    }
}
__device__ __forceinline__ void make_tables(PH_ARGS) {
    const int gt = bid * 512 + tid, GT = G * 512;
    float* RC = WSP(float, WS_ROPEC); float* RS = WSP(float, WS_ROPES);
    bf16* T1 = WSP(bf16, WS_T1T);
    for (int i = gt; i < 2048; i += GT) { const int pos = i >> 4, f = i & 15; const float inv = powf(10000.f, -(float)f / 16.f), ang = (float)pos * inv; RC[i] = cosf(ang); RS[i] = sinf(ang); }
    for (int i = gt; i < 128 * 128; i += GT) { const int col = i >> 7, k = i & 127, ro = col >> 6, k1 = col & 63, n1 = k >> 1, ri = k & 1; float s, c; sincospif((float)((k1 * n1) & 63) / 32.f, &s, &c);
        const float v = ro == 0 ? (ri == 0 ? c : s) : (ri == 0 ? -s : c); T1[i] = (bf16)f2bf(v); }
    bf16* T2F = WSP(bf16, WS_T2F); bf16* T2C = WSP(bf16, WS_T2C);
    for (int i = gt; i < 64 * 128 * 256; i += GT) { const int k1 = i >> 15, k2 = (i >> 8) & 127, k = i & 255, n2 = k >> 1, ri = k & 1; float s, c;
        sincospif((float)((n2 * (k1 + 64 * k2)) & 8191) / 4096.f, &s, &c); T2F[i] = (bf16)f2bf(ri ? s : c); }
    for (int i = gt; i < 2 * 128 * 256; i += GT) { const int k1 = i >> 15, k2 = (i >> 8) & 127, k = i & 255, n2 = k >> 1, ri = k & 1; float s, c;
        sincospif((float)((n2 * (k1 + 2 * k2)) & 255) / 128.f, &s, &c); T2C[i] = (bf16)f2bf(ri ? s : c); }
}
__device__ __forceinline__ void tr_item(const float* W, size_t ldw, int col0, int k0, bf16* dst, int Kd, LAS float* scr, int lane) {
#pragma unroll 8
    for (int i = 0; i < 32; ++i) { const int kk = 2 * i + (lane >> 5); scr[kk * 33 + (lane & 31)] = W[(size_t)(k0 + kk) * ldw + col0 + (lane & 31)]; }
    LDS_WAIT(); asm volatile("" ::: "memory");
    const int c = lane & 7;
#pragma unroll
    for (int j = 0; j < 4; ++j) { const int n = (lane >> 3) + 8 * j; const LAS float* s = scr + (8 * c) * 33 + n;
        v4u o; o.x = pk2(s[0 * 33], s[1 * 33]); o.y = pk2(s[2 * 33], s[3 * 33]); o.z = pk2(s[4 * 33], s[5 * 33]); o.w = pk2(s[6 * 33], s[7 * 33]);
        *(v4u*)(dst + (size_t)n * Kd + k0 + 8 * c) = o; }
    LDS_WAIT(); asm volatile("" ::: "memory");
}
__device__ __forceinline__ int rho32(int c) { return 16 * ((c >> 2) & 1) + 4 * (c >> 3) + (c & 3); }
__device__ __forceinline__ void fold_item16(const float* W  , int f, bf16* WIN, LAS float* scr, const LAS f2v* tab, int lane) {
    const int kb = f >> 2, g = f & 3, k0 = kb * 16;
#pragma unroll
    for (int kk = 0; kk < 16; ++kk) scr[kk * 64 + lane] = W[(size_t)(k0 + kk) * 6144 + 512 + g * 64 + lane];
    LDS_WAIT(); asm volatile("" ::: "memory");
    float ar[16], ai[16];
#pragma unroll
    for (int kk = 0; kk < 16; ++kk) { ar[kk] = 0.f; ai[kk] = 0.f; }
#pragma unroll 4
    for (int c = 0; c < 64; ++c) { const f2v t = tab[(c * lane) & 63];
#pragma unroll
        for (int kk = 0; kk < 16; ++kk) { const float w = scr[kk * 64 + c]; ar[kk] += w * t[0]; ai[kk] -= w * t[1]; } }
    const int L0 = 2 * (g * 64 + lane);
    bf16* d0 = WIN + (size_t)(512 + (L0 & ~31) + rho32(L0 & 31)) * 1024 + k0; bf16* d1 = WIN + (size_t)(512 + (L0 & ~31) + rho32((L0 + 1) & 31)) * 1024 + k0;
    v4u o, p;
    o.x = pk2(ar[0], ar[1]); o.y = pk2(ar[2], ar[3]); o.z = pk2(ar[4], ar[5]); o.w = pk2(ar[6], ar[7]); p.x = pk2(ar[8], ar[9]); p.y = pk2(ar[10], ar[11]); p.z = pk2(ar[12], ar[13]); p.w = pk2(ar[14], ar[15]);
    *(v4u*)d0 = o; *(v4u*)(d0 + 8) = p;
    o.x = pk2(ai[0], ai[1]); o.y = pk2(ai[2], ai[3]); o.z = pk2(ai[4], ai[5]); o.w = pk2(ai[6], ai[7]); p.x = pk2(ai[8], ai[9]); p.y = pk2(ai[10], ai[11]); p.z = pk2(ai[12], ai[13]); p.w = pk2(ai[14], ai[15]);
    *(v4u*)d1 = o; *(v4u*)(d1 + 8) = p;
    LDS_WAIT(); asm volatile("" ::: "memory");
}
template <bool PERMROWS>
__device__ __forceinline__ void tr_item64(const float* W, size_t ldw, int col0, int k0, bf16* dst, int Kd, int lane) {
    const int kq = lane >> 4, n4 = lane & 15; const float* src = W + (size_t)(k0 + kq * 16) * ldw + col0 + n4 * 4;
    f32x4 v[16];
#pragma unroll
    for (int i = 0; i < 16; ++i) v[i] = *(const f32x4*)(src + (size_t)i * ldw);
#pragma unroll
    for (int j = 0; j < 4; ++j) { const int ns = n4 * 4 + j, nd = PERMROWS ? ((ns & 32) + rho32(ns & 31)) : ns; bf16* d = dst + (size_t)nd * Kd + k0 + kq * 16; v4u o, p;
        o.x = pk2(v[0][j], v[1][j]); o.y = pk2(v[2][j], v[3][j]); o.z = pk2(v[4][j], v[5][j]); o.w = pk2(v[6][j], v[7][j]);
        p.x = pk2(v[8][j], v[9][j]); p.y = pk2(v[10][j], v[11][j]); p.z = pk2(v[12][j], v[13][j]); p.w = pk2(v[14][j], v[15][j]);
        *(v4u*)d = o; *(v4u*)(d + 8) = p; }
}
__device__ __forceinline__ void convert_range(PH_ARGS, const int l, const int it_lo, const int it_hi, const int pidx, const int pcount) {
    if (pidx < 0) return;
    LAS float* scr = (LAS float*)(lds + wave * 16384);
    const int gw = pidx * 8 + wave, NGW = pcount * 8;
    bf16* WIN = WSP(bf16, WS_WIN); bf16* WBR = WSP(bf16, WS_WBR); bf16* WO = WSP(bf16, WS_WO); bf16* WGU = WSP(bf16, WS_WGU); bf16* WDN = WSP(bf16, WS_WDN); bf16* WS_ = WSP(bf16, WS_WSP);
    const float* win = INP(8) + (size_t)l * 1024 * 6144;
    LAS f2v* tab = (LAS f2v*)(scr + 2048); { float s_, c_; sincospif((float)lane / 32.f, &s_, &c_); tab[lane] = (f2v){c_, s_}; } LDS_WAIT(); asm volatile("" ::: "memory");
    constexpr int N_FOLD = 256, N_IN = 92 * 16, N_BR = 256, N_WO = 256, N_GU = 8192, N_DN = 4096, N_SP = 64;
    constexpr int NITEMS = N_FOLD + N_IN + N_BR + N_WO + N_GU + N_DN + N_SP;
    for (int it = it_lo + gw; it < it_hi && it < NITEMS; it += NGW) {
        int r = it;
        if (r < N_FOLD) { fold_item16(win, r, WIN, scr, tab, lane); continue; } r -= N_FOLD;
        if (r < N_IN) { const int dbp = r >> 4, kb = r & 15, db = dbp < 8 ? dbp : dbp + 8; int col;
            if (db < 8) col = db * 64;
            else if (db < 24) { const int t = db - 16, tile = t >> 2, sub = t & 3; col = (sub < 2 ? 768 : 1024) + tile * 128 + (sub & 1) * 64; }
            else if (db < 36) col = 1280 + (db - 24) * 64;
            else col = 2048 + (db - 36) * 64;
            if (db < 24 || (db >= 32 && db < 36)) tr_item64<true>(win, 6144, col, kb * 64, WIN + (size_t)db * 64 * 1024, 1024, lane);
            else tr_item64<false>(win, 6144, col, kb * 64, WIN + (size_t)db * 64 * 1024, 1024, lane);
            continue; } r -= N_IN;
        if (r < N_BR) { const int b = r >> 6, q = r & 63, kb = q >> 4, nb = q & 15; const int ii = b == 0 ? 13 : (b == 1 ? 14 : (b == 2 ? 19 : 21));
            tr_item64<false>(INP(ii) + (size_t)l * 256 * 1024, 1024, nb * 64, kb * 64, WBR + (size_t)(b * 1024 + nb * 64) * 256, 256, lane); continue; } r -= N_BR;
        if (r < N_WO) { const int kb = r >> 4, nb = r & 15; tr_item64<false>(INP(22) + (size_t)l * 1024 * 1024, 1024, nb * 64, kb * 64, WO + (size_t)nb * 64 * 1024, 1024, lane); continue; } r -= N_WO;
        if (r < N_GU) { const int e = r >> 9, q = r & 511, db = q >> 4, kb = q & 15, tile = db >> 2, sub = db & 3;
            const float* src = (sub < 2 ? INP(24) : INP(25)) + (size_t)(l * 16 + e) * 1024 * 1024;
            tr_item64<false>(src, 1024, tile * 128 + (sub & 1) * 64, kb * 64, WGU + ((size_t)e * 2048 + db * 64) * 1024, 1024, lane); continue; } r -= N_GU;
        if (r < N_DN) { const int e = r >> 8, q = r & 255, kb = q >> 4, nb = q & 15;
            tr_item64<false>(INP(26) + (size_t)(l * 16 + e) * 1024 * 1024, 1024, nb * 64, kb * 64, WDN + ((size_t)e * 1024 + nb * 64) * 1024, 1024, lane); continue; } r -= N_DN;
        { const float* s = INP(11) + (size_t)l * 65536 + r * 1024 + lane * 16; const f32x4 a = *(const f32x4*)s, b = *(const f32x4*)(s + 4), c = *(const f32x4*)(s + 8), d = *(const f32x4*)(s + 12);
          v4u o, p; o.x = pk2(a[0], a[1]); o.y = pk2(a[2], a[3]); o.z = pk2(b[0], b[1]); o.w = pk2(b[2], b[3]); p.x = pk2(c[0], c[1]); p.y = pk2(c[2], c[3]); p.z = pk2(d[0], d[1]); p.w = pk2(d[2], d[3]);
          *(v4u*)(WS_ + r * 1024 + lane * 16) = o; *(v4u*)(WS_ + r * 1024 + lane * 16 + 8) = p; }
    }
}
constexpr int CV_FOLD0 = 0, CV_IN0 = 256, CV_BR0 = 256 + 92 * 16, CV_WO0 = CV_BR0 + 256, CV_GU0 = CV_WO0 + 256, CV_DN0 = CV_GU0 + 8192, CV_SP0 = CV_DN0 + 4096, CV_END = CV_SP0 + 64;
__device__ __forceinline__ void convert_weights(PH_ARGS, const int l) { convert_range(lds, tid, lane, wave, bid, G, l, 0, CV_END, bid, G); }
__device__ __forceinline__ void load_row(const float* p, int lane, f32x4 (&v)[4]) {
#pragma unroll
    for (int j = 0; j < 4; ++j) v[j] = *(const f32x4*)(p + 4 * lane + 256 * j);
}
__device__ __forceinline__ void modnorm_store(f32x4 (&v)[4], const float* g, const float* sc, const float* sh, bf16* hrow, int lane) {
    float ss = 0.f;
#pragma unroll
    for (int j = 0; j < 4; ++j) ss += (v[j][0] * v[j][0] + v[j][1] * v[j][1]) + (v[j][2] * v[j][2] + v[j][3] * v[j][3]);
    const float rs = 1.0f / sqrtf(wave_sum(ss) * (1.f / 1024.f) + 1e-6f);
#pragma unroll
    for (int j = 0; j < 4; ++j) { const int o = 4 * lane + 256 * j; const f32x4 gg = *(const f32x4*)(g + o), s = *(const f32x4*)(sc + o), b = *(const f32x4*)(sh + o);
        v[j] = v[j] * rs * gg * (s + 1.f) + b; st4bf(hrow + o, v[j]); }
}
__device__ __forceinline__ void modnorm_regs(f32x4 (&v)[4], const f32x4 (&gm)[4], const f32x4 (&sh)[4], bf16* hrow, int lane) {
    float ss = 0.f;
#pragma unroll
    for (int j = 0; j < 4; ++j) ss += (v[j][0] * v[j][0] + v[j][1] * v[j][1]) + (v[j][2] * v[j][2] + v[j][3] * v[j][3]);
    const float rs = 1.0f / sqrtf(wave_sum(ss) * (1.f / 1024.f) + 1e-6f);
#pragma unroll
    for (int j = 0; j < 4; ++j) { v[j] = v[j] * rs * gm[j] + sh[j]; st4bf(hrow + 4 * lane + 256 * j, v[j]); }
}
__device__ __forceinline__ void load_mod(const float* g, const float* sc, const float* shp, int lane, f32x4 (&gm)[4], f32x4 (&sh)[4]) {
#pragma unroll
    for (int j = 0; j < 4; ++j) { const int o = 4 * lane + 256 * j; gm[j] = *(const f32x4*)(g + o) * (*(const f32x4*)(sc + o) + 1.f); sh[j] = *(const f32x4*)(shp + o); }
}
__device__ __forceinline__ void norm1_l0(PH_ARGS) {
    const int gw = bid * 8 + wave, NGW = G * 8; bf16* H = WSP(bf16, WS_H); const float* MOD = WSP(float, WS_MOD);
    const int RPW = (MT + NGW - 1) / NGW, row0 = gw * RPW, rend = (row0 + RPW < MT) ? row0 + RPW : MT;
    const float* xin = INP(0); const float* cin = INP(2); const float* g = INP(6);
    f32x4 cur[4], nxt[4], gm[4], sh[4]; int rprev = -1;
    if (row0 < rend) load_row(row0 < ML ? xin + (size_t)row0 * 1024 : cin + (size_t)(row0 - ML) * 1024, lane, cur);
    for (int row = row0; row < rend; ++row) {
        if (row + 1 < rend) { const int rn = row + 1; load_row(rn < ML ? xin + (size_t)rn * 1024 : cin + (size_t)(rn - ML) * 1024, lane, nxt); }
        const int r = row < SEQ ? 0 : (row < ML ? 1 : 2);
        if (r != rprev) { const float* md = MOD + r * 6144; load_mod(g, md + 1024, md, lane, gm, sh); rprev = r; }
        modnorm_regs(cur, gm, sh, H + (size_t)row * 1024, lane);
#pragma unroll
        for (int j = 0; j < 4; ++j) cur[j] = nxt[j];
    }
}
__device__ __forceinline__ void norm2_router(PH_ARGS, const int l, const int rbase, const int nrows, const int pidx, const int pcount, const bool load_table = true) {
    const int gw = pidx * 8 + wave, NGW = pcount * 8; bf16* H = WSP(bf16, WS_H); const float* MOD = WSP(float, WS_MOD) + l * 3 * 6144; const float* X = WSP(float, WS_X); float* AFF = WSP(float, WS_AFF);
    LAS f32x4* Wl = (LAS f32x4*)lds;
    if (load_table) { const f32x4* wr = (const f32x4*)(INP(23) + (size_t)l * 1024 * 16);
      for (int i = tid; i < 4096; i += 512) { const int k = i >> 2, q = i & 3; Wl[(q * 4 + (k & 3)) * 256 + (k >> 2)] = wr[i]; } }
    __syncthreads();
    const int RPW = (nrows + NGW - 1) / NGW, row0 = rbase + gw * RPW, rend = (gw * RPW + RPW < nrows) ? row0 + RPW : rbase + nrows;
    const float* g2 = INP(7) + l * 1024;
    f32x4 v[4], nxt[4], gm[4], sh[4]; int rprev = -1;
    if (row0 < rend) load_row(X + (size_t)row0 * 1024, lane, v);
    for (int row = row0; row < rend; ++row) {
        if (row + 1 < rend) load_row(X + (size_t)(row + 1) * 1024, lane, nxt);
        const int r = row < SEQ ? 0 : (row < ML ? 1 : 2);
        if (r != rprev) { const float* md = MOD + r * 6144; load_mod(g2, md + 4 * 1024, md + 3 * 1024, lane, gm, sh); rprev = r; }
        modnorm_regs(v, gm, sh, H + (size_t)row * 1024, lane);
        float lg[16];
#pragma unroll
        for (int e = 0; e < 16; ++e) lg[e] = 0.f;
#pragma unroll
        for (int j = 0; j < 4; ++j)
#pragma unroll
            for (int i = 0; i < 4; ++i) { const float hv = v[j][i];
#pragma unroll
                for (int q = 0; q < 4; ++q) { const f32x4 w = Wl[(q * 4 + i) * 256 + 64 * j + lane]; lg[4 * q + 0] += hv * w[0]; lg[4 * q + 1] += hv * w[1]; lg[4 * q + 2] += hv * w[2]; lg[4 * q + 3] += hv * w[3]; }
                if (i & 1) asm volatile("" ::: "memory"); }
#pragma unroll
        for (int i = 0; i < 8; ++i) { const bool up = lane & 32; const float send = up ? lg[i] : lg[i + 8], keep = up ? lg[i + 8] : lg[i]; lg[i] = keep + __shfl_xor(send, 32); }
#pragma unroll
        for (int i = 0; i < 4; ++i) { const bool up = lane & 16; const float send = up ? lg[i] : lg[i + 4], keep = up ? lg[i + 4] : lg[i]; lg[i] = keep + __shfl_xor(send, 16); }
#pragma unroll
        for (int i = 0; i < 2; ++i) { const bool up = lane & 8; const float send = up ? lg[i] : lg[i + 2], keep = up ? lg[i + 2] : lg[i]; lg[i] = keep + __shfl_xor(send, 8); }
        { const bool up = lane & 4; const float send = up ? lg[0] : lg[1], keep = up ? lg[1] : lg[0]; lg[0] = keep + __shfl_xor(send, 4); }
        float z = lg[0]; z += __shfl_xor(z, 1); z += __shfl_xor(z, 2);
        float mx = z; mx = fmaxf(mx, __shfl_xor(mx, 4)); mx = fmaxf(mx, __shfl_xor(mx, 8)); mx = fmaxf(mx, __shfl_xor(mx, 16)); mx = fmaxf(mx, __shfl_xor(mx, 32));
        const float ez = expf(z - mx); float sm = ez; sm += __shfl_xor(sm, 4); sm += __shfl_xor(sm, 8); sm += __shfl_xor(sm, 16); sm += __shfl_xor(sm, 32);
        if ((lane & 3) == 0) { const int e = ((lane >> 5) & 1) * 8 + ((lane >> 4) & 1) * 4 + ((lane >> 3) & 1) * 2 + ((lane >> 2) & 1); AFF[(size_t)row * 16 + e] = ez / sm; }
#pragma unroll
        for (int j = 0; j < 4; ++j) v[j] = nxt[j];
    }
    __syncthreads();
}
typedef short v4i16_t __attribute__((ext_vector_type(4)));
__device__ __forceinline__ void mfma16(f32x4& acc, const bf16x8 a, const bf16x8 b) { asm volatile("s_nop 1\n\tv_mfma_f32_16x16x32_bf16 %0, %1, %2, %0\n\ts_nop 3" : "+v"(acc) : "v"(a), "v"(b)); }
__device__ __forceinline__ void mfma16n(f32x4& acc, const bf16x8 a, const bf16x8 b) { asm volatile("v_mfma_f32_16x16x32_bf16 %0, %1, %2, %0" : "+v"(acc) : "v"(a), "v"(b)); }
#define DRAIN4(x) asm volatile("s_nop 15\n\ts_nop 15" : "+v"((x)[0]), "+v"((x)[1]), "+v"((x)[2]), "+v"((x)[3]))
#define DRAIN8(x) asm volatile("s_nop 15\n\ts_nop 15" : "+v"((x)[0]), "+v"((x)[1]), "+v"((x)[2]), "+v"((x)[3]), "+v"((x)[4]), "+v"((x)[5]), "+v"((x)[6]), "+v"((x)[7]))
#define DRAIN16(x) asm volatile("s_nop 15\n\ts_nop 15" : "+v"((x)[0]), "+v"((x)[1]), "+v"((x)[2]), "+v"((x)[3]), "+v"((x)[4]), "+v"((x)[5]), "+v"((x)[6]), "+v"((x)[7]), \
    "+v"((x)[8]), "+v"((x)[9]), "+v"((x)[10]), "+v"((x)[11]), "+v"((x)[12]), "+v"((x)[13]), "+v"((x)[14]), "+v"((x)[15]))
__device__ __forceinline__ void gmlp_unit(PH_ARGS, const int l, const int chunk) {
    const int row0 = chunk < 128 ? chunk * 128 : ML + (chunk - 128) * 128;
    const bf16* AUV = WSP(bf16, WS_AUV); bf16* BRa = WSP(bf16, WS_BR); const bf16* WS_ = WSP(bf16, WS_WSP);
    LAS bf16* vT = (LAS bf16*)lds;
    const float* lg = INP(9) + l * 256; const float* lb = INP(10) + l * 256;
    const f32x4 gg = *(const f32x4*)(lg + 4 * lane), bb = *(const f32x4*)(lb + 4 * lane);
    uint2 raws[16];
#pragma unroll
    for (int pi = 0; pi < 16; ++pi) raws[pi] = *(const uint2*)(AUV + (size_t)(row0 + wave * 16 + pi) * 512 + 256 + 4 * lane);
#pragma unroll
    for (int pi = 0; pi < 16; ++pi) { const int p = wave * 16 + pi;
        const uint2 raw = raws[pi];
        float v0 = bflo(raw.x), v1 = bfhi(raw.x), v2 = bflo(raw.y), v3 = bfhi(raw.y);
        const float mean = wave_sum((v0 + v1) + (v2 + v3)) * (1.f / 256.f); v0 -= mean; v1 -= mean; v2 -= mean; v3 -= mean;
        const float rstd = 1.0f / sqrtf(wave_sum((v0 * v0 + v1 * v1) + (v2 * v2 + v3 * v3)) * (1.f / 256.f) + 1e-6f);
        vT[(4 * lane + 0) * 136 + p] = (bf16)f2bf(v0 * rstd * gg[0] + bb[0]); vT[(4 * lane + 1) * 136 + p] = (bf16)f2bf(v1 * rstd * gg[1] + bb[1]);
        vT[(4 * lane + 2) * 136 + p] = (bf16)f2bf(v2 * rstd * gg[2] + bb[2]); vT[(4 * lane + 3) * 136 + p] = (bf16)f2bf(v3 * rstd * gg[3] + bb[3]); }
    __syncthreads();
    const int g = wave >> 1, qh = wave & 1, fr = lane & 15, fq = lane >> 4;
    f32x4 acc[4][4];
#pragma unroll
    for (int a = 0; a < 4; ++a)
#pragma unroll
        for (int b = 0; b < 4; ++b) acc[a][b] = (f32x4){0.f, 0.f, 0.f, 0.f};
    const bf16* Wg = WS_ + g * 16384;
#pragma unroll
    for (int ks = 0; ks < 4; ++ks) { bf16x8 af[4], bf[4];
#pragma unroll
        for (int dt = 0; dt < 4; ++dt) af[dt] = *(const LAS bf16x8*)(vT + (g * 64 + dt * 16 + fr) * 136 + ks * 32 + fq * 8);
#pragma unroll
        for (int qt = 0; qt < 4; ++qt) bf[qt] = *(const bf16x8*)(Wg + (qh * 64 + qt * 16 + fr) * 128 + ks * 32 + fq * 8);
#pragma unroll
        for (int dt = 0; dt < 4; ++dt)
#pragma unroll
            for (int qt = 0; qt < 4; ++qt) mfma16(acc[dt][qt], af[dt], bf[qt]); }
    DRAIN16(&acc[0][0]);
    const float* bs = INP(12) + l * 512 + g * 128;
#pragma unroll
    for (int qt = 0; qt < 4; ++qt) { const int q = qh * 64 + qt * 16 + fr; const float bias = bs[q]; const size_t row = row0 + q;
#pragma unroll
        for (int dt = 0; dt < 4; ++dt) { const int ch = g * 64 + dt * 16 + 4 * fq; const uint2 uw = *(const uint2*)(AUV + row * 512 + ch);
            f32x4 o; o[0] = bflo(uw.x) * (acc[dt][qt][0] + bias); o[1] = bfhi(uw.x) * (acc[dt][qt][1] + bias); o[2] = bflo(uw.y) * (acc[dt][qt][2] + bias); o[3] = bfhi(uw.y) * (acc[dt][qt][3] + bias);
            st4bf(BRa + row * 256 + ch, o); } }
    __syncthreads();
}
__device__ __forceinline__ void conv_unit(PH_ARGS, const int l, const int unit) {
    int rowbase, n0, nlen;
    if (unit < 256) { rowbase = (unit >> 7) * SEQ; n0 = (unit & 127) * 64; nlen = SEQ; } else { const int u2 = unit - 256; rowbase = ML + (u2 >> 2) * CTXL; n0 = (u2 & 3) * 64; nlen = CTXL; }
    const bf16* CY = WSP(bf16, WS_CY); bf16* BRc = WSP(bf16, WS_BR) + (size_t)2 * MT * 256;
    LAS unsigned* yt = (LAS unsigned*)lds;
    LAS float* cres = (LAS float*)(lds + 48128);
    for (int p = tid; p < 94 * 32; p += 512) { const int rr = p >> 5, seg = p & 31, n = n0 - 15 + rr; v4u val = {0u, 0u, 0u, 0u};
        if (n >= 0 && n < nlen) val = *(const v4u*)(CY + (size_t)(rowbase + n) * 256 + seg * 8);
        *(LAS v4u*)(lds + rr * 512 + seg * 16) = val; }
    __syncthreads();
    const int cp = tid & 127, pg = tid >> 7;
    float w0[31], w1[31];
    const float* cw = INP(15) + (size_t)l * 31 * 256 + 2 * cp;
#pragma unroll
    for (int t = 0; t < 31; ++t) { const float2 w = *(const float2*)(cw + t * 256); w0[t] = w.x; w1[t] = w.y; }
    float a0[16], a1[16];
#pragma unroll
    for (int p = 0; p < 16; ++p) { a0[p] = 0.f; a1[p] = 0.f; }
#pragma unroll
    for (int i = 0; i < 46; ++i) { const unsigned raw = yt[(16 * pg + i) * 128 + cp]; const float v0 = bflo(raw), v1 = bfhi(raw);
#pragma unroll
        for (int p = 0; p < 16; ++p) { const int t = i - p; if (t >= 0 && t < 31) { a0[p] += v0 * w0[t]; a1[p] += v1 * w1[t]; } } }
    const float2 cb = *(const float2*)(INP(16) + l * 256 + 2 * cp);
#pragma unroll
    for (int p = 0; p < 16; ++p) *(LAS f2v*)(cres + (16 * pg + p) * 256 + 2 * cp) = (f2v){a0[p] + cb.x, a1[p] + cb.y};
    __syncthreads();
    const f32x4 gg = *(const f32x4*)(INP(17) + l * 256 + 4 * lane), bb = *(const f32x4*)(INP(18) + l * 256 + 4 * lane);
    for (int pi = 0; pi < 8; ++pi) { const int pos = wave * 8 + pi; f32x4 v = *(const LAS f32x4*)(cres + pos * 256 + 4 * lane);
        const float mean = wave_sum((v[0] + v[1]) + (v[2] + v[3])) * (1.f / 256.f); v = v - mean;
        const float rstd = 1.0f / sqrtf(wave_sum((v[0] * v[0] + v[1] * v[1]) + (v[2] * v[2] + v[3] * v[3])) * (1.f / 256.f) + 1e-6f);
        f32x4 o;
#pragma unroll
        for (int j = 0; j < 4; ++j) { const float y = v[j] * rstd * gg[j] + bb[j]; o[j] = y * sigm(y); }
        st4bf(BRc + (size_t)(rowbase + n0 + pos) * 256 + 4 * lane, o); }
    __syncthreads();
}
constexpr int F1_T1L = 0, F1_YL = 34816;
__device__ __forceinline__ void f1_stage_tables(PH_ARGS) {
    const bf16* T1 = WSP(bf16, WS_T1T);
    for (int p = tid; p < 128 * 16; p += 512) { const int r = p >> 4, s = p & 15; *(LAS v4u*)(lds + F1_T1L + r * 272 + s * 16) = *(const v4u*)(T1 + r * 128 + s * 8); }
    __syncthreads();
}
__device__ __forceinline__ void f1_unit(PH_ARGS, const int unit) {
    const int b = unit >> 7, n2 = unit & 127, fr = lane & 15, fq = lane >> 4;
    const bf16* YF = WSP(bf16, WS_YF); bf16* FA = WSP(bf16, WS_FA);
    LAS unsigned* Yl = (LAS unsigned*)(lds + F1_YL);
#pragma unroll
    for (int i = 0; i < 8; ++i) { const int n1 = wave + 8 * i; *(LAS v4u*)(Yl + n1 * 260 + lane * 4) = *(const v4u*)(YF + (size_t)(b * SEQ + 128 * n1 + n2) * 512 + lane * 8); }
    __syncthreads();
    f32x4 acc[2][8];
#pragma unroll
    for (int a = 0; a < 2; ++a)
#pragma unroll
        for (int n = 0; n < 8; ++n) acc[a][n] = (f32x4){0.f, 0.f, 0.f, 0.f};
#pragma unroll
    for (int ks = 0; ks < 4; ++ks) { bf16x8 af[2];
#pragma unroll
        for (int c2 = 0; c2 < 2; ++c2) { const int ch = (2 * wave + c2) * 16 + fr; v4u w;
            w.x = Yl[(16 * ks + 4 * fq + 0) * 260 + ch]; w.y = Yl[(16 * ks + 4 * fq + 1) * 260 + ch]; w.z = Yl[(16 * ks + 4 * fq + 2) * 260 + ch]; w.w = Yl[(16 * ks + 4 * fq + 3) * 260 + ch];
            af[c2] = __builtin_bit_cast(bf16x8, w); }
#pragma unroll
        for (int nt = 0; nt < 8; ++nt) { const bf16x8 bfr = *(const LAS bf16x8*)(lds + F1_T1L + (nt * 16 + fr) * 272 + ks * 64 + fq * 16);
            mfma16(acc[0][nt], af[0], bfr); mfma16(acc[1][nt], af[1], bfr); } }
    DRAIN16(&acc[0][0]);
#pragma unroll
    for (int c2 = 0; c2 < 2; ++c2)
#pragma unroll
        for (int kt = 0; kt < 4; ++kt) { const int k1 = kt * 16 + fr; const f32x4 ar = acc[c2][kt], ai = acc[c2][kt + 4];
            v4u o; o.x = pk2(ar[0], ai[0]); o.y = pk2(ar[1], ai[1]); o.z = pk2(ar[2], ai[2]); o.w = pk2(ar[3], ai[3]);
            *(v4u*)(FA + ((size_t)((b * 64 + k1) * 128 + n2) * 256 + (2 * wave + c2) * 16 + 4 * fq) * 2) = o; }
    __syncthreads();
}
constexpr int F2_T2L = 0, F2_AL = 67584;
__device__ __forceinline__ void f2_unit(PH_ARGS, const int unit) {
    const int fr = lane & 15, fq = lane >> 4; const bool lat = unit < 256;
    int b, k1, chh; const bf16* Asrc; const bf16* Tsrc; size_t orow0; int ostr; float scl;
    if (lat) { b = unit >> 7; k1 = (unit >> 1) & 63; chh = unit & 1; Asrc = WSP(bf16, WS_FA) + (size_t)((b * 64 + k1) * 128) * 512; Tsrc = WSP(bf16, WS_T2F) + (size_t)k1 * 32768; orow0 = (size_t)b * SEQ + k1; ostr = 64; scl = 0.0013810679320049757f; }
    else { const int u2 = unit - 256; b = u2 >> 2; k1 = (u2 >> 1) & 1; chh = u2 & 1; Asrc = WSP(bf16, WS_FAC) + (size_t)((b * 2 + k1) * 128) * 512; Tsrc = WSP(bf16, WS_T2C) + (size_t)k1 * 32768; orow0 = (size_t)ML + b * CTXL + k1; ostr = 2; scl = 1.f / 128.f; }
    bf16* BRb = WSP(bf16, WS_BR) + (size_t)1 * MT * 256;
    LAS unsigned* Al = (LAS unsigned*)(lds + F2_AL);
    for (int p = tid; p < 128 * 32; p += 512) { const int r = p >> 5, s = p & 31; *(LAS v4u*)(lds + F2_T2L + r * 528 + s * 16) = *(const v4u*)(Tsrc + r * 256 + s * 8); }
#pragma unroll
    for (int i = 0; i < 8; ++i) { const int n2 = wave * 16 + 2 * i + (lane >> 5);
        *(LAS v4u*)(Al + n2 * 132 + (lane & 31) * 4) = *(const v4u*)(Asrc + ((size_t)n2 * 256 + chh * 128) * 2 + (lane & 31) * 8); }
    __syncthreads();
    f32x4 acc[8];
#pragma unroll
    for (int n = 0; n < 8; ++n) acc[n] = (f32x4){0.f, 0.f, 0.f, 0.f};
    const int ch = wave * 16 + fr;
#pragma unroll
    for (int ks = 0; ks < 8; ++ks) { v4u w;
        w.x = Al[(16 * ks + 4 * fq + 0) * 132 + ch]; w.y = Al[(16 * ks + 4 * fq + 1) * 132 + ch]; w.z = Al[(16 * ks + 4 * fq + 2) * 132 + ch]; w.w = Al[(16 * ks + 4 * fq + 3) * 132 + ch];
        const bf16x8 af = __builtin_bit_cast(bf16x8, w);
#pragma unroll
        for (int nt = 0; nt < 8; ++nt) { const bf16x8 bfr = *(const LAS bf16x8*)(lds + F2_T2L + (nt * 16 + fr) * 528 + ks * 64 + fq * 16); mfma16(acc[nt], af, bfr); } }
    DRAIN8(acc);
#pragma unroll
    for (int nt = 0; nt < 8; ++nt) { const int k2 = nt * 16 + fr; st4bf(BRb + (orow0 + (size_t)ostr * k2) * 256 + chh * 128 + wave * 16 + 4 * fq, acc[nt] * scl); }
    __syncthreads();
}
__device__ __forceinline__ void ctx_butterfly(PH_ARGS) {
    const unsigned* YF = (const unsigned*)WSP(bf16, WS_YF); unsigned* FAC = (unsigned*)WSP(bf16, WS_FAC);
    for (int i = bid * 512 + tid; i < 2 * 128 * 256; i += G * 512) { const int b = i >> 15, n2 = (i >> 8) & 127, ch = i & 255;
        const unsigned y0 = YF[(size_t)(ML + b * CTXL + n2) * 256 + ch], y1 = YF[(size_t)(ML + b * CTXL + 128 + n2) * 256 + ch];
        const float r0 = bflo(y0), i0 = bfhi(y0), r1 = bflo(y1), i1 = bfhi(y1);
        FAC[(size_t)((b * 2 + 0) * 128 + n2) * 256 + ch] = pk2(r0 + r1, i0 + i1); FAC[(size_t)((b * 2 + 1) * 128 + n2) * 256 + ch] = pk2(r0 - r1, i0 - i1); }
}
constexpr int MG_AL = 0, MG_BL = 67584;
__device__ __forceinline__ void merge_phase(PH_ARGS, const int nunits) {
    const int fr = lane & 15, fq = lane >> 4, wr = wave >> 2, wc = wave & 3;
    const bf16* BR = WSP(bf16, WS_BR); const bf16* WBR = WSP(bf16, WS_WBR); const bf16* GT = WSP(bf16, WS_G); bf16* MB = WSP(bf16, WS_MB);
    int nmine = 0; for (int u = bid; u < nunits; u += G) ++nmine;
    const int nsteps = nmine * 4;
    if (nsteps == 0) return;
    v4u pa[8], pb[8];
#define MG_LOAD(s) do { const int u_ = bid + ((s) >> 2) * G, b_ = (s) & 3, rt_ = u_ >> 3, ct_ = u_ & 7; \
        const bf16* As = BR + ((size_t)b_ * MT + (size_t)rt_ * 128) * 256; const bf16* Bs = WBR + ((size_t)b_ * 1024 + (size_t)ct_ * 128) * 256; \
        _Pragma("unroll") for (int i = 0; i < 8; ++i) { const int p = i * 512 + tid, r = p >> 5, seg = p & 31; pa[i] = *(const v4u*)(As + (size_t)r * 256 + seg * 8); pb[i] = *(const v4u*)(Bs + (size_t)r * 256 + seg * 8); } } while (0)
#define MG_WRITE() do { _Pragma("unroll") for (int i = 0; i < 8; ++i) { const int p = i * 512 + tid, r = p >> 5, seg = p & 31; \
        *(LAS v4u*)(lds + MG_AL + r * 528 + seg * 16) = pa[i]; *(LAS v4u*)(lds + MG_BL + r * 528 + seg * 16) = pb[i]; } } while (0)
    MG_LOAD(0); MG_WRITE();
    f32x4 macc[4][2];
#pragma unroll
    for (int a = 0; a < 4; ++a)
#pragma unroll
        for (int n = 0; n < 2; ++n) macc[a][n] = (f32x4){0.f, 0.f, 0.f, 0.f};
#pragma unroll 1
    for (int s = 0; s < nsteps; ++s) {
        const int u = bid + (s >> 2) * G, b = s & 3, rt = u >> 3, ct = u & 7;
        __syncthreads();
        if (s + 1 < nsteps) MG_LOAD(s + 1);
        uint2 gw[4][2];
#pragma unroll
        for (int mt = 0; mt < 4; ++mt)
#pragma unroll
            for (int nt = 0; nt < 2; ++nt) gw[mt][nt] = *(const uint2*)(GT + ((((size_t)(u * 4 + b) * 8 + wave) * 8 + mt * 2 + nt) * 256 + lane * 4));
        f32x4 acc[4][2];
#pragma unroll
        for (int a = 0; a < 4; ++a)
#pragma unroll
            for (int n = 0; n < 2; ++n) acc[a][n] = (f32x4){0.f, 0.f, 0.f, 0.f};
#pragma unroll
        for (int ks = 0; ks < 8; ++ks) { bf16x8 af[4], bfr[2];
#pragma unroll
            for (int mt = 0; mt < 4; ++mt) af[mt] = *(const LAS bf16x8*)(lds + MG_AL + (wr * 64 + mt * 16 + fr) * 528 + ks * 64 + fq * 16);
#pragma unroll
            for (int nt = 0; nt < 2; ++nt) bfr[nt] = *(const LAS bf16x8*)(lds + MG_BL + (wc * 32 + nt * 16 + fr) * 528 + ks * 64 + fq * 16);
#pragma unroll
            for (int mt = 0; mt < 4; ++mt)
#pragma unroll
                for (int nt = 0; nt < 2; ++nt) mfma16n(acc[mt][nt], bfr[nt], af[mt]); }
        DRAIN8(&acc[0][0]);
#pragma unroll
        for (int mt = 0; mt < 4; ++mt)
#pragma unroll
            for (int nt = 0; nt < 2; ++nt) { const uint2 g = gw[mt][nt]; macc[mt][nt][0] += bflo(g.x) * acc[mt][nt][0]; macc[mt][nt][1] += bfhi(g.x) * acc[mt][nt][1]; macc[mt][nt][2] += bflo(g.y) * acc[mt][nt][2]; macc[mt][nt][3] += bfhi(g.y) * acc[mt][nt][3]; }
        __syncthreads();
        if (s + 1 < nsteps) MG_WRITE();
        if (b == 3) {
#pragma unroll
            for (int mt = 0; mt < 4; ++mt)
#pragma unroll
                for (int nt = 0; nt < 2; ++nt) { st4bf(MB + (size_t)(rt * 128 + wr * 64 + mt * 16 + fr) * 1024 + ct * 128 + wc * 32 + nt * 16 + 4 * fq, macc[mt][nt]); macc[mt][nt] = (f32x4){0.f, 0.f, 0.f, 0.f}; }
        }
    }
    __syncthreads();
#undef MG_LOAD
#undef MG_WRITE
}
constexpr int AT_RPB = 32768, AT_MRG = 40960;
__device__ __forceinline__ int clampi(int v, int lo, int hi) { return v < lo ? lo : (v > hi ? hi : v); }
__device__ __forceinline__ bool at_need(int kind, int jb, int t) { return kind == 2 || (kind == 0 ? (jb < 2 || (jb == 2 && t == 1)) : (jb > 1 || (jb == 1 && t == 0))); }
struct AtCtx { const bf16* QPL; const bf16* KR; const bf16* VV; LAS unsigned char* vbuf; const LAS float* rpbl; int h, qh, fr, fq, lane, b, r, kr0, qrow0, nch, nwin; bool lat; unsigned code[2][2][2]; float negb; };
__device__ __forceinline__ unsigned at_keyrow(const AtCtx& X, int ci) { return (ci < X.nwin) ? ((unsigned)X.b * SEQ + (unsigned)(X.kr0 + (ci >> 1)) * 64 + 32 * (ci & 1)) : ((unsigned)ML + X.b * CTXL + 32 * (ci - X.nwin)); }
__device__ __forceinline__ void at_load(const AtCtx& X, int ci, bf16x8 (&kf)[2][2], v4u (&vst)[4]) {
    const unsigned kr = at_keyrow(X, ci);
#pragma unroll
    for (int t = 0; t < 2; ++t)
#pragma unroll
        for (int ks = 0; ks < 2; ++ks) kf[t][ks] = *(const bf16x8*)(X.KR + (unsigned)((kr + 16 * t + X.fr) * 256 + X.h * 64 + ks * 32 + X.fq * 8));
#pragma unroll
    for (int i = 0; i < 4; ++i) { const int p = i * 64 + X.lane, key = p >> 3, seg = p & 7; vst[i] = *(const v4u*)(X.VV + (unsigned)((kr + key) * 256 + X.h * 64 + seg * 8)); }
}
__device__ __forceinline__ void at_chunk(const AtCtx& X, const int ci, bf16x8 (&kf)[2][2], v4u (&vst)[4], bf16x8 (&qf)[2][2], f32x4 (&O)[2][4], float (&m)[2], float (&l)[2]) {
    const int kind = ci < X.nwin ? (ci & 1) : 2, fr = X.fr, fq = X.fq, qh = X.qh;
    if (X.lat && ci == 16) {
#pragma unroll
        for (int j = 0; j < 2; ++j)
#pragma unroll
            for (int ks = 0; ks < 2; ++ks) qf[j][ks] = *(const bf16x8*)(X.QPL + (unsigned)((X.qrow0 + 16 * (2 * qh + j) + fr) * 256 + X.h * 64 + ks * 32 + fq * 8));
        asm volatile("" : "+v"(qf[0][0]), "+v"(qf[0][1]), "+v"(qf[1][0]), "+v"(qf[1][1])); }
#pragma unroll
    for (int i = 0; i < 4; ++i) { const int p = i * 64 + X.lane, key = p >> 3, seg = p & 7; *(LAS v4u*)(X.vbuf + key * 128 + ((((seg >> 1) ^ ((key >> 1) & 3))) << 5) + ((seg & 1) << 4)) = vst[i]; }
    f32x4 S[2][2];
#pragma unroll
    for (int j = 0; j < 2; ++j)
#pragma unroll
        for (int t = 0; t < 2; ++t) { S[j][t] = (f32x4){0.f, 0.f, 0.f, 0.f}; mfma16n(S[j][t], kf[t][0], qf[j][0]); mfma16n(S[j][t], kf[t][1], qf[j][1]); }
    const LAS float* rpbrow = X.rpbl + (kind != 2 ? (X.kr0 + (ci >> 1) - X.r + 7) : 15) * 32;
    float bv[2][2][4];
#pragma unroll
    for (int j = 0; j < 2; ++j)
#pragma unroll
        for (int t = 0; t < 2; ++t) { const unsigned cw = kind == 2 ? 0u : (kind == 0 ? X.code[0][j][t] : X.code[1][j][t]);
#pragma unroll
            for (int rg = 0; rg < 4; ++rg) bv[j][t][rg] = rpbrow[(cw >> (8 * rg)) & 31u]; }
    asm volatile("s_nop 11" : "+v"(S[0][0]), "+v"(S[0][1]), "+v"(S[1][0]), "+v"(S[1][1]));
    if (ci + 3 < X.nch) at_load(X, ci + 3, kf, vst);
    bf16x8 pf[2];
#pragma unroll
    for (int j = 0; j < 2; ++j) {
        float mc = X.negb;
#pragma unroll
        for (int t = 0; t < 2; ++t)
#pragma unroll
            for (int rg = 0; rg < 4; ++rg) { const float s = S[j][t][rg] + bv[j][t][rg]; S[j][t][rg] = s; mc = fmaxf(mc, s); }
        { auto r16 = __builtin_amdgcn_permlane16_swap(__float_as_uint(mc), __float_as_uint(mc), false, false); mc = fmaxf(__uint_as_float(r16[0]), __uint_as_float(r16[1]));
          auto r32 = __builtin_amdgcn_permlane32_swap(__float_as_uint(mc), __float_as_uint(mc), false, false); mc = fmaxf(__uint_as_float(r32[0]), __uint_as_float(r32[1])); }
        const float mnew = fmaxf(m[j], mc), alpha = __builtin_amdgcn_exp2f(m[j] - mnew); m[j] = mnew; float ls = 0.f;
#pragma unroll
        for (int t = 0; t < 2; ++t)
#pragma unroll
            for (int rg = 0; rg < 4; ++rg) { const float p = __builtin_amdgcn_exp2f(S[j][t][rg] - mnew); S[j][t][rg] = p; ls += p; }
        l[j] = l[j] * alpha + ls;
        if (__any(alpha != 1.f)) {
#pragma unroll
            for (int dt = 0; dt < 4; ++dt) O[j][dt] = O[j][dt] * alpha; }
        v4u pw; pw.x = pk2(S[j][0][0], S[j][0][1]); pw.y = pk2(S[j][0][2], S[j][0][3]); pw.z = pk2(S[j][1][0], S[j][1][1]); pw.w = pk2(S[j][1][2], S[j][1][3]);
        pf[j] = __builtin_bit_cast(bf16x8, pw); }
    asm volatile("s_nop 1" : "+v"(pf[0]), "+v"(pf[1]));
#pragma unroll
    for (int dt = 0; dt < 4; ++dt) { v4i16_t t0, t1;
        { const int key = 4 * fq + (fr >> 2); t0 = __builtin_amdgcn_ds_read_tr16_b64_v4i16((LAS v4i16_t*)(X.vbuf + key * 128 + ((dt ^ ((key >> 1) & 3)) << 5) + (fr & 3) * 8)); }
        { const int key = 16 + 4 * fq + (fr >> 2); t1 = __builtin_amdgcn_ds_read_tr16_b64_v4i16((LAS v4i16_t*)(X.vbuf + key * 128 + ((dt ^ ((key >> 1) & 3)) << 5) + (fr & 3) * 8)); }
        const bf16x8 vf = (bf16x8){t0[0], t0[1], t0[2], t0[3], t1[0], t1[1], t1[2], t1[3]};
        mfma16n(O[0][dt], vf, pf[0]); mfma16n(O[1][dt], vf, pf[1]); }
}
__device__ __forceinline__ void attn_unit(PH_ARGS, const int unit) {
    AtCtx X; X.h = wave >> 1; X.qh = wave & 1; X.fr = lane & 15; X.fq = lane >> 4; X.lane = lane;
    X.lat = unit < 256; X.r = 0; X.kr0 = 0;
    if (X.lat) { X.b = unit >> 7; X.r = unit & 127; X.qrow0 = X.b * SEQ + X.r * 64; X.kr0 = clampi(X.r - 4, 0, 120); }
    else { const int u2 = unit - 256; X.b = u2 >> 2; X.qrow0 = ML + X.b * CTXL + (u2 & 3) * 64; }
    X.QPL = WSP(bf16, WS_QPL); const bf16* QROT = WSP(bf16, WS_QROT); X.KR = WSP(bf16, WS_KR); X.VV = WSP(bf16, WS_VV);
    bf16* BRd = WSP(bf16, WS_BR) + (size_t)3 * MT * 256;
    X.vbuf = lds + wave * 4096; X.rpbl = (const LAS float*)(lds + AT_RPB) + X.h * 512;
    X.nch = X.lat ? 24 : 8; X.nwin = X.lat ? 16 : 0;
#pragma unroll
    for (int kd = 0; kd < 2; ++kd)
#pragma unroll
        for (int j = 0; j < 2; ++j)
#pragma unroll
            for (int t = 0; t < 2; ++t) { unsigned cw = 0u; const int jb = 2 * X.qh + j;
#pragma unroll
                for (int rg = 0; rg < 4; ++rg) { const int kcol = 32 * kd + 16 * t + 4 * X.fq + rg, qcol = 16 * jb + X.fr, cst = clampi(qcol - 8, 0, 48); const bool ok = at_need(kd, jb, t) && kcol >= cst && kcol < cst + 16;
                    cw |= (ok ? (unsigned)(clampi(kcol - qcol, -15, 15) + 15) : 31u) << (8 * rg); }
                X.code[kd][j][t] = cw; }
    float m[2], l[2]; f32x4 O[2][4];
    { unsigned u_ = 0xf149f2cau; asm volatile("" : "+s"(u_)); X.negb = __uint_as_float(u_); }
#pragma unroll
    for (int j = 0; j < 2; ++j) { m[j] = X.negb; l[j] = 0.f;
#pragma unroll
        for (int dt = 0; dt < 4; ++dt) O[j][dt] = (f32x4){0.f, 0.f, 0.f, 0.f}; }
    bf16x8 qf[2][2];
    { const bf16* Qs = X.lat ? QROT : X.QPL;
#pragma unroll
      for (int j = 0; j < 2; ++j)
#pragma unroll
          for (int ks = 0; ks < 2; ++ks) qf[j][ks] = *(const bf16x8*)(Qs + (unsigned)((X.qrow0 + 16 * (2 * X.qh + j) + X.fr) * 256 + X.h * 64 + ks * 32 + X.fq * 8));
      asm volatile("" : "+v"(qf[0][0]), "+v"(qf[0][1]), "+v"(qf[1][0]), "+v"(qf[1][1])); }
    bf16x8 kA[2][2], kB[2][2], kC[2][2]; v4u vA[4], vB[4], vC[4];
    at_load(X, 0, kA, vA); at_load(X, 1, kB, vB); at_load(X, 2, kC, vC);
#pragma unroll 1
    for (int ci = 0; ci < X.nch; ci += 3) {
        at_chunk(X, ci, kA, vA, qf, O, m, l);
        if (ci + 1 < X.nch) at_chunk(X, ci + 1, kB, vB, qf, O, m, l);
        if (ci + 2 < X.nch) at_chunk(X, ci + 2, kC, vC, qf, O, m, l);
    }
    asm volatile("s_nop 15" : "+v"(O[0][0]), "+v"(O[0][1]), "+v"(O[0][2]), "+v"(O[0][3]), "+v"(O[1][0]), "+v"(O[1][1]), "+v"(O[1][2]), "+v"(O[1][3]));
#pragma unroll
    for (int j = 0; j < 2; ++j) { l[j] += __shfl_xor(l[j], 16); l[j] += __shfl_xor(l[j], 32); const float inv = 1.f / l[j];
#pragma unroll
        for (int dt = 0; dt < 4; ++dt) st4bf(BRd + (unsigned)((X.qrow0 + 16 * (2 * X.qh + j) + X.fr) * 256 + X.h * 64 + dt * 16 + 4 * X.fq), O[j][dt] * inv); }
}
#ifndef CDFT_REP
#define CDFT_REP 1
#endif
#ifndef CONV_REP
#define CONV_REP 1
#endif
#ifndef GMLP_REP
#define GMLP_REP 1
#endif
#ifndef F1_REP
#define F1_REP 1
#endif
__device__ __forceinline__ int block_excl_scan(int v, LAS int* ws8, int lane, int wave) {
    int x = v;
#pragma unroll
    for (int o = 1; o < 64; o <<= 1) { const int y = __shfl_up(x, o); if (lane >= o) x += y; }
    if (lane == 63) ws8[wave] = x;
    __syncthreads();
    int base = 0;
#pragma unroll
    for (int w = 0; w < 8; ++w) base += (w < wave) ? ws8[w] : 0;
    __syncthreads();
    return base + x - v;
}
__device__ __forceinline__ unsigned akey(float a) { const float s = a * 4294967296.f; return s >= 4294967040.f ? 0xFFFFFF00u : (unsigned)s; }
__device__ __forceinline__ float akey_inv(unsigned k) { return (float)k * (1.f / 4294967296.f); }
template <int PER, bool ALLV>
__device__ __forceinline__ void topk_unit(PH_ARGS, const int rowbase, const int n, const int C, const int e, const int sbase, const bool writepad) {
    const float* AFF = WSP(float, WS_AFF); int* SEL = WSP(int, WS_SEL); int* IDX = WSP(int, WS_IDX); float* GATE = WSP(float, WS_GATE);
    LAS unsigned* hist = (LAS unsigned*)lds; LAS unsigned* sh = hist + 256; LAS int* ws8 = (LAS int*)(hist + 272); LAS unsigned* hw = hist + 512 + wave * 256;
    unsigned key[PER]; bool valid[PER];
#pragma unroll
    for (int i = 0; i < PER; ++i) { const int tok = tid * PER + i; valid[i] = ALLV ? true : (tok < n); key[i] = valid[i] ? akey(AFF[(size_t)(rowbase + tok) * 16 + e]) : 0u; }
    unsigned prefix = 0u, mask = 0u, rem = (unsigned)C;
#pragma unroll 1
    for (int pass = 0; pass < 4; ++pass) { const int shift = 24 - 8 * pass;
        for (int i = lane; i < 256; i += 64) hw[i] = 0u;
        LDS_WAIT();
#pragma unroll
        for (int i = 0; i < PER; ++i) if (valid[i] && (key[i] & mask) == prefix) atomicAdd((unsigned*)&hw[(key[i] >> shift) & 255u], 1u);
        __syncthreads();
        if (tid < 256) { unsigned s_ = 0u;
#pragma unroll
            for (int w = 0; w < 8; ++w) s_ += hist[512 + w * 256 + tid];
            hist[tid] = s_; }
        __syncthreads();
        if (wave == 0) { unsigned c0 = hist[255 - 4 * lane], c1 = hist[254 - 4 * lane], c2 = hist[253 - 4 * lane], c3 = hist[252 - 4 * lane];
            const unsigned s = c0 + c1 + c2 + c3; unsigned x = s;
#pragma unroll
            for (int o = 1; o < 64; o <<= 1) { const unsigned y = __shfl_up(x, o); if (lane >= o) x += y; }
            const unsigned excl = x - s;
            if (excl < rem && rem <= x) { unsigned cum = excl; int bin; unsigned nr;
                if (cum + c0 >= rem) { bin = 255 - 4 * lane; nr = rem - cum; }
                else { cum += c0; if (cum + c1 >= rem) { bin = 254 - 4 * lane; nr = rem - cum; }
                else { cum += c1; if (cum + c2 >= rem) { bin = 253 - 4 * lane; nr = rem - cum; }
                else { cum += c2; bin = 252 - 4 * lane; nr = rem - cum; } } }
                sh[0] = (unsigned)bin; sh[1] = nr; } }
        __syncthreads();
        prefix |= sh[0] << shift; mask |= 255u << shift; rem = sh[1];
    }
    __syncthreads();
    const unsigned T = prefix;
    int neq = 0;
#pragma unroll
    for (int i = 0; i < PER; ++i) neq += (valid[i] && key[i] == T) ? 1 : 0;
    const int eqbase = block_excl_scan(neq, ws8, lane, wave);
    unsigned take = 0u; int nsel = 0, eqs = 0;
#pragma unroll
    for (int i = 0; i < PER; ++i) { const bool iseq = valid[i] && key[i] == T; const bool tk = valid[i] && (key[i] > T || (iseq && (unsigned)(eqbase + eqs) < rem)); eqs += iseq ? 1 : 0; if (tk) { take |= 1u << i; ++nsel; } }
    const int sb = block_excl_scan(nsel, ws8, lane, wave);
    int cnt = 0;
#pragma unroll
    for (int i = 0; i < PER; ++i) { const int tok = tid * PER + i;
        if (valid[i]) { if ((take >> i) & 1u) { const int slot = sbase + sb + cnt; ++cnt; IDX[e * ESTR + slot] = rowbase + tok; GATE[e * ESTR + slot] = akey_inv(key[i]); SEL[(size_t)(rowbase + tok) * 16 + e] = slot; }
                        else SEL[(size_t)(rowbase + tok) * 16 + e] = -1; } }
    if (writepad) for (int i = tid; i < ESTR - 2112; i += 512) { IDX[e * ESTR + 2112 + i] = 0; GATE[e * ESTR + 2112 + i] = 0.f; }
    __syncthreads();
}
__device__ __forceinline__ void gather_rows(PH_ARGS, const int tpe) {
    const int gw = bid * 8 + wave, NGW = G * 8, per = tpe * 256; const int* IDX = WSP(int, WS_IDX); const bf16* H = WSP(bf16, WS_H); bf16* XE = WSP(bf16, WS_XE);
    for (int i = gw; i < NE * per; i += NGW) { const int e = i / per, s = i % per, rg = e * ESTR + s; const int src = IDX[rg];
        const v4u a = *(const v4u*)(H + (size_t)src * 1024 + lane * 8), b = *(const v4u*)(H + (size_t)src * 1024 + 512 + lane * 8);
        *(v4u*)(XE + (size_t)rg * 1024 + lane * 8) = a; *(v4u*)(XE + (size_t)rg * 1024 + 512 + lane * 8) = b; }
}
struct CRow { v4u yw[4][2]; f32x4 xin[2][2]; float wgt[4]; unsigned long long bm; int cur; };
struct CCtx { const int* SEL; const bf16* YB; const float* X; bf16* H; const float* MOD; float* XO; float* OUT; const float* gnext; int l, lane; };
__device__ __forceinline__ void cr_issue(const CCtx& C, CRow& R, const int row) {
    const int lane = C.lane;
    R.cur = lane < 16 ? C.SEL[(size_t)row * 16 + lane] : -1;
    R.bm = __ballot(R.cur >= 0); const int cnt = __popcll(R.bm);
#pragma unroll
    for (int k = 0; k < 4; ++k) { const bool has = cnt > k; const int e = has ? (int)__builtin_ctzll(R.bm) : 0; if (has) R.bm &= R.bm - 1; const int s = __shfl(R.cur, e); R.wgt[k] = has ? 1.f : 0.f;
        const bf16* y = C.YB + (size_t)(has ? e * ESTR + s : 0) * 1024 + lane * 8; R.yw[k][0] = *(const v4u*)y; R.yw[k][1] = *(const v4u*)(y + 512); }
    const float* xr = C.X + (size_t)row * 1024;
#pragma unroll
    for (int j = 0; j < 2; ++j) { const int o = 8 * lane + 512 * j; R.xin[j][0] = *(const f32x4*)(xr + o); R.xin[j][1] = *(const f32x4*)(xr + o + 4); }
}
__device__ __forceinline__ void cr_finish(const CCtx& C, CRow& R, const int row) {
    const int lane = C.lane, l = C.l; const int r = row < SEQ ? 0 : (row < ML ? 1 : 2);
    float acc[2][8];
#pragma unroll
    for (int j = 0; j < 2; ++j)
#pragma unroll
        for (int i = 0; i < 8; ++i) acc[j][i] = 0.f;
#pragma unroll
    for (int k = 0; k < 4; ++k)
#pragma unroll
        for (int j = 0; j < 2; ++j) { const v4u w = R.yw[k][j]; const float g = R.wgt[k];
            acc[j][0] += g * bflo(w.x); acc[j][1] += g * bfhi(w.x); acc[j][2] += g * bflo(w.y); acc[j][3] += g * bfhi(w.y); acc[j][4] += g * bflo(w.z); acc[j][5] += g * bfhi(w.z); acc[j][6] += g * bflo(w.w); acc[j][7] += g * bfhi(w.w); }
    while (R.bm) { const int e = (int)__builtin_ctzll(R.bm); R.bm &= R.bm - 1; const int s = __shfl(R.cur, e); const bf16* y = C.YB + (size_t)(e * ESTR + s) * 1024 + lane * 8;
#pragma unroll
        for (int j = 0; j < 2; ++j) { const v4u w = *(const v4u*)(y + 512 * j);
            acc[j][0] += bflo(w.x); acc[j][1] += bfhi(w.x); acc[j][2] += bflo(w.y); acc[j][3] += bfhi(w.y); acc[j][4] += bflo(w.z); acc[j][5] += bfhi(w.z); acc[j][6] += bflo(w.w); acc[j][7] += bfhi(w.w); } }
    const float* gt2 = C.MOD + (l * 3 + r) * 6144 + 5 * 1024;
    float xv[2][8]; float ss = 0.f;
#pragma unroll
    for (int j = 0; j < 2; ++j) { const int o = 8 * lane + 512 * j; const f32x4 g0 = *(const f32x4*)(gt2 + o), g1 = *(const f32x4*)(gt2 + o + 4);
#pragma unroll
        for (int i = 0; i < 4; ++i) { xv[j][i] = R.xin[j][0][i] + g0[i] * acc[j][i]; xv[j][4 + i] = R.xin[j][1][i] + g1[i] * acc[j][4 + i]; }
#pragma unroll
        for (int i = 0; i < 8; ++i) ss += xv[j][i] * xv[j][i]; }
    const float rs = 1.0f / sqrtf(wave_sum(ss) * (1.f / 1024.f) + 1e-6f);
    if (l == 0) {
        const float* md = C.MOD + (1 * 3 + r) * 6144; float* xw = C.XO + (size_t)row * 1024;
#pragma unroll
        for (int j = 0; j < 2; ++j) { const int o = 8 * lane + 512 * j;
            *(f32x4*)(xw + o) = (f32x4){xv[j][0], xv[j][1], xv[j][2], xv[j][3]}; *(f32x4*)(xw + o + 4) = (f32x4){xv[j][4], xv[j][5], xv[j][6], xv[j][7]};
            const f32x4 g0 = *(const f32x4*)(C.gnext + o), g1 = *(const f32x4*)(C.gnext + o + 4), c0 = *(const f32x4*)(md + 1024 + o), c1 = *(const f32x4*)(md + 1024 + o + 4), h0 = *(const f32x4*)(md + o), h1 = *(const f32x4*)(md + o + 4);
            float hv[8];
#pragma unroll
            for (int i = 0; i < 4; ++i) { hv[i] = xv[j][i] * rs * g0[i] * (1.f + c0[i]) + h0[i]; hv[4 + i] = xv[j][4 + i] * rs * g1[i] * (1.f + c1[i]) + h1[i]; }
            v4u w; w.x = pk2(hv[0], hv[1]); w.y = pk2(hv[2], hv[3]); w.z = pk2(hv[4], hv[5]); w.w = pk2(hv[6], hv[7]);
            *(v4u*)(C.H + (size_t)row * 1024 + o) = w; }
    } else {
        float* orow = C.OUT + (size_t)row * 1024;
#pragma unroll
        for (int j = 0; j < 2; ++j) { const int o = 8 * lane + 512 * j; const f32x4 g0 = *(const f32x4*)(C.gnext + o), g1 = *(const f32x4*)(C.gnext + o + 4);
            *(f32x4*)(orow + o) = (f32x4){xv[j][0] * rs * g0[0], xv[j][1] * rs * g0[1], xv[j][2] * rs * g0[2], xv[j][3] * rs * g0[3]};
            *(f32x4*)(orow + o + 4) = (f32x4){xv[j][4] * rs * g1[0], xv[j][5] * rs * g1[1], xv[j][6] * rs * g1[2], xv[j][7] * rs * g1[3]}; }
    }
}
template <bool DUMMY>
__device__ __forceinline__ void combine_rows(PH_ARGS, const int l) {
    const int gw = bid * 8 + wave, NGW = G * 8; const int nrows = l == 0 ? MT : ML;
    CCtx C; C.SEL = WSP(int, WS_SEL); C.YB = WSP(bf16, WS_XE); C.X = WSP(float, WS_X); C.H = DUMMY ? WSP(bf16, WS_BR) : WSP(bf16, WS_H); C.MOD = WSP(float, WS_MOD);
    C.XO = DUMMY ? WSP(float, WS_ACT) : WSP(float, WS_X); C.OUT = DUMMY ? WSP(float, WS_ACT) : PTRV(28, float); C.gnext = l == 0 ? INP(6) + 1024 : INP(27); C.l = l; C.lane = lane;
    CRow A, B; int row = gw;
    if (row < nrows) cr_issue(C, A, row);
    while (row < nrows) {
        const int r2 = row + NGW; if (r2 < nrows) cr_issue(C, B, r2);
        cr_finish(C, A, row);
        const int r3 = r2 + NGW; if (r3 < nrows) cr_issue(C, A, r3);
        if (r2 < nrows) cr_finish(C, B, r2);
        row = r3;
    }
}

#ifdef DBG_STOP
__device__ __forceinline__ void debug_out(PH_ARGS) {
    float* out = PTRV(28, float);
    const int gt = bid * 512 + tid, GT = G * 512;
    for (size_t i = gt; i < (size_t)ML * 1024; i += GT) { const size_t row = i >> 10; const int c = (int)(i & 1023); float v = 0.f;
#if DBG_STOP == 2
        v = bflo(WSP(bf16, WS_H)[row * 1024 + c]) + WSP(float, WS_MOD)[(i % 36864)] + bflo(WSP(bf16, WS_WIN)[i % (6400 * 1024)]) + bflo(WSP(bf16, WS_WGU)[i]) + bflo(WSP(bf16, WS_WDN)[i]) + bflo(WSP(bf16, WS_WO)[i % (1024*1024)]) + bflo(WSP(bf16, WS_WBR)[i % (1024*1024)]);
#elif DBG_STOP == 3
        v = bflo(WSP(bf16, WS_AUV)[row * 512 + (c & 511)]) + bflo(WSP(bf16, WS_YF)[row * 512 + (c & 511)]) + bflo(WSP(bf16, WS_CY)[row * 256 + (c & 255)]) + bflo(WSP(bf16, WS_QPL)[row * 256 + (c & 255)])
          + bflo(WSP(bf16, WS_QROT)[row * 256 + (c & 255)]) + bflo(WSP(bf16, WS_KR)[row * 256 + (c & 255)]) + bflo(WSP(bf16, WS_VV)[row * 256 + (c & 255)])
          + bflo(WSP(bf16, WS_G)[row * 4096 + c]) + bflo(WSP(bf16, WS_G)[row * 4096 + 1024 + c]) + bflo(WSP(bf16, WS_G)[row * 4096 + 2048 + c]) + bflo(WSP(bf16, WS_G)[row * 4096 + 3072 + c]);
#elif DBG_STOP == 4
        v = bflo(WSP(bf16, WS_BR)[(size_t)(0 * MT + row) * 256 + (c & 255)]) + bflo(WSP(bf16, WS_BR)[(size_t)(2 * MT + row) * 256 + (c & 255)]) + bflo(WSP(bf16, WS_FA)[i % ((size_t)8 << 20)]);
#elif DBG_STOP == 21
        v = bflo(WSP(bf16, WS_T1T)[i % 16384]) * 1.001f + WSP(float, WS_ROPEC)[i % 2048] + WSP(float, WS_ROPES)[i % 2048] + bflo(WSP(bf16, WS_WSP)[i % 65536]);
#elif DBG_STOP == 31 || DBG_STOP == 44
        v = 0.f;
#elif DBG_STOP == 45 || DBG_STOP == 32
        v = 0.f;
#elif DBG_STOP == 41
        v = bflo(WSP(bf16, WS_BR)[(size_t)(0 * MT + row) * 256 + (c & 255)]) * 1.001f + bflo(WSP(bf16, WS_BR)[(size_t)(0 * MT + row) * 256 + ((c + 7) & 255)]);
#elif DBG_STOP == 42
        v = bflo(WSP(bf16, WS_BR)[(size_t)(2 * MT + row) * 256 + (c & 255)]) * 1.001f + bflo(WSP(bf16, WS_BR)[(size_t)(2 * MT + row) * 256 + ((c + 7) & 255)]);
#elif DBG_STOP == 43
        v = bflo(WSP(bf16, WS_FA)[i % ((size_t)8 << 20)]) * 1.001f + bflo(WSP(bf16, WS_FA)[(i + 7) % ((size_t)8 << 20)]);
#elif DBG_STOP == 5
        v = bflo(WSP(bf16, WS_BR)[(size_t)(1 * MT + row) * 256 + (c & 255)]) + bflo(WSP(bf16, WS_BR)[(size_t)(3 * MT + row) * 256 + (c & 255)]);
#elif DBG_STOP == 6
        v = bflo(WSP(bf16, WS_MB)[row * 1024 + c]);
#elif DBG_STOP == 7
        v = WSP(float, WS_X)[row * 1024 + c];
#elif DBG_STOP == 8
        v = bflo(WSP(bf16, WS_H)[row * 1024 + c]) + WSP(float, WS_AFF)[row * 16 + (c & 15)];
#elif DBG_STOP == 9
        v = (float)WSP(int, WS_SEL)[row * 16 + (c & 15)] + WSP(float, WS_GATE)[i % (16 * 2304)] + (float)WSP(int, WS_IDX)[i % (16 * 2304)];
#elif DBG_STOP == 10
        v = bflo(WSP(bf16, WS_XE)[i]) + bflo(WSP(bf16, WS_XE)[i + (size_t)ML * 1024]);
#elif DBG_STOP == 11
        v = bflo(WSP(bf16, WS_ACT)[i]) + bflo(WSP(bf16, WS_ACT)[i + (size_t)ML * 1024]);
#elif DBG_STOP == 12
        v = bflo(WSP(bf16, WS_XE)[i]) + bflo(WSP(bf16, WS_XE)[i + (size_t)ML * 1024]);
#else
        v = WSP(float, WS_X)[row * 1024 + c] + bflo(WSP(bf16, WS_H)[row * 1024 + c]);
#endif
#ifdef DBG_AMP
        v = (float)(__float_as_uint(v) & 0xFFFFu);
#endif
        out[i] = v; }
}
#endif
__global__ void __launch_bounds__(512, 2) mega(Args A) {
    extern __shared__ __attribute__((aligned(16))) unsigned char lds_raw[];
    LAS unsigned char* lds0 = (LAS unsigned char*)lds_raw;
    volatile LAS unsigned* MISC = (volatile LAS unsigned*)(lds0 + MISC_OFF);
    const int tid = threadIdx.x, lane = tid & 63, wave = __builtin_amdgcn_readfirstlane(tid >> 6), bid = blockIdx.x, G = gridDim.x;
    for (int u = tid; u < (LDS_BYTES - MISC_OFF) / 4; u += 512) ((LAS unsigned*)(lds0 + MISC_OFF))[u] = 0u;
    __syncthreads();
    if (tid == 0) { typedef unsigned u2v_t __attribute__((ext_vector_type(2)));
#pragma unroll
        for (int i = 0; i < 30; ++i) { const unsigned long long p = i < 28 ? (unsigned long long)A.in[i] : (i == 28 ? (unsigned long long)A.out : (unsigned long long)A.ws);
            *(LAS u2v_t*)(lds0 + PTAB_OFF + 8 * i) = (u2v_t){(unsigned)p, (unsigned)(p >> 32)}; } }
    __syncthreads();
    const int lo = A.ph_lo, hi = A.ph_hi;
    XcdBarrier bar; bar.bar = (unsigned*)(A.ws + WS_CTL) + CW_BAR; bar.x = 0; bar.st = nullptr;
    if (hi - lo > 1) bar = xcd_barrier_post((unsigned*)(A.ws + WS_CTL) + CW_BAR, MISC + 8);
#define PH_CALL lds, tl_, (tl_ & 63), wv_, bl_, G_
#define PH_CALLV lds, tl_, (tl_ & 63), wv_, vb_, G_
#ifdef TS_I
    if (bid == 0 && tid == 0) ((unsigned long long*)(A.ws + 65536))[lo] = rt();
#endif
    if (lo == 0) {
        int tl_ = tid; asm volatile("" : "+v"(tl_)); int bl_ = bid; asm volatile("" : "+s"(bl_)); int wv_ = wave; asm volatile("" : "+s"(wv_)); int G_ = G; asm volatile("" : "+s"(G_));
        unsigned ldsb_ = (unsigned)(uintptr_t)lds0; asm volatile("" : "+s"(ldsb_)); LAS unsigned char* lds = (LAS unsigned char*)(uintptr_t)ldsb_;
#ifndef P0R_MOD
#define P0R_MOD 1
#endif
#ifndef P0R_TAB
#define P0R_TAB 1
#endif
#ifndef P0R_CVT
#define P0R_CVT 1
#endif
#pragma unroll 1
            for (int r_ = 0; r_ < P0R_MOD; ++r_) { mod_gemv(PH_CALL); asm volatile("" ::: "memory"); }
#pragma unroll 1
            for (int r_ = 0; r_ < P0R_TAB; ++r_) { make_tables(PH_CALL); asm volatile("" ::: "memory"); }
#pragma unroll 1
            for (int r_ = 0; r_ < P0R_CVT; ++r_) { convert_range(lds, tl_, (tl_ & 63), wv_, bl_, G_, 0, CV_FOLD0, CV_GU0, bl_, G_); convert_range(lds, tl_, (tl_ & 63), wv_, bl_, G_, 0, CV_SP0, CV_END, bl_, G_); asm volatile("" ::: "memory"); }
        if (hi > 1) { XcdBarrier b2 = bar; b2.bar = (unsigned*)(PTRV(29, unsigned char) + WS_CTL) + CW_BAR; b2.st = (volatile LAS unsigned*)(lds + MISC_OFF) + 8; xcd_barrier(b2); }
    }
    const int lo1 = lo < 1 ? 1 : lo;
#pragma unroll 1
#ifdef REP_PH
    for (int it_ = lo1; it_ < hi + (REP_N - 1); ++it_) { const int ph = it_ < REP_PH ? it_ : (it_ < REP_PH + REP_N ? REP_PH : it_ - (REP_N - 1));
#else
    for (int ph = lo1; ph < hi; ++ph) {
#endif
        int tl_ = tid; asm volatile("" : "+v"(tl_)); int bl_ = bid; asm volatile("" : "+s"(bl_)); int vb_ = (G % 8 == 0) ? (bid % 8) * (G / 8) + bid / 8 : bid; asm volatile("" : "+s"(vb_)); int wv_ = wave; asm volatile("" : "+s"(wv_)); int G_ = G; asm volatile("" : "+s"(G_)); unsigned ldsb_ = (unsigned)(uintptr_t)lds0; asm volatile("" : "+s"(ldsb_)); LAS unsigned char* lds = (LAS unsigned char*)(uintptr_t)ldsb_;
        const int l = ph < 13 ? 0 : 1, kind = ph >= 99 ? 99 : (ph < 2 ? ph : 2 + (ph - 2 - 11 * l));
        const int ntm = l == 0 ? 66 : 64, tpe = l == 0 ? 9 : 8;
        if (kind == 9) continue;
        switch (kind) {
#ifdef DBG_STOP
        case 99: debug_out(PH_CALL); break;
#endif
        case 0: break;
        case 1: {
#ifndef DIS_N1
            norm1_l0(PH_CALL);
#endif
        } break;
        case 2: {
            pg8::Gemm g{WSP(bf16, WS_H), WSP(bf16, WS_WIN), MT, NIN, 1024}; pg8::StaticOrder S; S.init(MT, NIN, G_, bl_);
            EpiIn E{WSP(bf16, WS_AUV), WSP(bf16, WS_YF), WSP(bf16, WS_CY), WSP(bf16, WS_QPL), WSP(bf16, WS_QROT), WSP(bf16, WS_KR), WSP(bf16, WS_VV), WSP(bf16, WS_G), WSP(float, WS_ROPEC), WSP(float, WS_ROPES)};
#ifndef DIS_GIN
            pg8::gemm_phase<EpiIn, pg8::StaticOrder, true, true>(lds, g, S, E);
#endif
#ifndef DIS_CVT
            if (l == 0) { const int nx = ((MT / 256) * (NIN / 256)) % G_; convert_range(lds, tl_, (tl_ & 63), wv_, bl_, G_, 0, CV_GU0, CV_DN0, nx ? bl_ - nx : bl_, G_ - nx); }
#endif
        } break;
        case 3: {
#ifndef DIS_F1
            if (bl_ < 256) { f1_stage_tables(PH_CALL); for (int u = vb_; u < 256; u += G_) f1_unit(PH_CALL, u); }
#endif
#ifndef DIS_CDFT
            if (l == 0) ctx_butterfly(PH_CALL);
#endif
            __syncthreads();
            { LAS float* rp = (LAS float*)(lds + AT_RPB); const float* src = INP(20) + l * 1860;
              for (int i = tl_; i < 2048; i += 512) { const int hh = i >> 9, rw = (i >> 5) & 15, cc = i & 31; rp[i] = rw < 15 ? (cc < 31 ? src[hh * 465 + rw * 31 + cc] * 1.4426950408889634f : -3.0e38f) : 0.f; } }
            __syncthreads();
#ifndef DIS_ATT
            { const int nat = l == 0 ? 264 : 256; for (int u = vb_; u < nat; u += G_) attn_unit(PH_CALL, u); }
#endif
        } break;
        case 4: {
#ifndef DIS_F2
            for (int u = vb_; u < 256; u += G_) f2_unit(PH_CALL, u);
#endif
#ifndef DIS_CONV
            for (int u = vb_; u < 256; u += G_) conv_unit(PH_CALL, l, u);
#endif
#ifndef DIS_GMLP
            for (int u = G_ - 1 - vb_; u < 128; u += G_) gmlp_unit(PH_CALL, l, u);
#endif
            if (l == 0) {
                const bool big = G_ >= 128;
                for (int u = big ? vb_ - 8 : vb_; u >= 0 && u < 8; u += G_) f2_unit(PH_CALL, 256 + u);
                for (int u = big ? vb_ - 16 : vb_; u >= 0 && u < 8; u += G_) conv_unit(PH_CALL, l, 256 + u);
                for (int u = big ? vb_ - 24 : vb_; u >= 0 && u < 4; u += G_) gmlp_unit(PH_CALL, l, 128 + u);
            }
        } break;
        case 5: {
#ifndef DIS_GMRG
#ifndef MERGE_PG8
            merge_phase(PH_CALLV, ntm * 16);
#ifndef DIS_CVT
            if (l == 0) { const int nx = (ntm * 16) % G_; convert_range(lds, tl_, (tl_ & 63), wv_, vb_, G_, 0, CV_DN0, CV_SP0, nx ? vb_ - nx : vb_, G_ - nx); }
#endif
#else
            { pg8::Gemm g{WSP(bf16, WS_BR), WSP(bf16, WS_WBR), 4 * MT, 4096, 256}; MergeOrder S; S.init(ntm, G_, bl_); EpiMergeH E{WSP(bf16, WS_G), WSP(bf16, WS_MB)};
              pg8::gemm_phase<EpiMergeH, MergeOrder, true, true>(lds, g, S, E); }
#endif
#endif
        } break;
        case 6: {
            pg8::Gemm g{WSP(bf16, WS_MB), WSP(bf16, WS_WO), ML, 1024, 1024}; pg8::StaticOrder S; S.init(ML, 1024, G_, bl_);
            EpiWout E{l == 0 ? INP(0) : WSP(float, WS_X), l == 0 ? INP(2) : WSP(float, WS_X) + (size_t)ML * 1024, WSP(float, WS_X), WSP(float, WS_MOD) + l * 3 * 6144};
#ifndef DIS_GWO
            pg8::gemm_phase<EpiWout, pg8::StaticOrder, true, true>(lds, g, S, E);
#endif
#ifndef DIS_CVT
            if (l == 0) { const int nx = (64 * 4) % G_; convert_range(lds, tl_, (tl_ & 63), wv_, bl_, G_, 1, CV_FOLD0, CV_WO0, nx ? bl_ - nx : bl_, G_ - nx); }
#endif
        } break;
        case 7: {
#ifndef DIS_N2
            if (l == 0 && G_ > 16) {
                unsigned* cnt = (unsigned*)(PTRV(29, unsigned char) + WS_CTL) + 2048;
                if (bl_ < 8) {
                    pg8::Gemm g{WSP(bf16, WS_MB), WSP(bf16, WS_WO), MT, 1024, 1024}; OneUnit S{64 + (bl_ >> 2), bl_ & 3};
                    EpiWout E{INP(0), INP(2), WSP(float, WS_X), WSP(float, WS_MOD)};
                    pg8::gemm_phase<EpiWout, OneUnit, true, true>(lds, g, S, E);
                    asm volatile("s_waitcnt vmcnt(0)" ::: "memory"); __syncthreads();
                    if (tl_ == 0) { __builtin_amdgcn_fence(__ATOMIC_RELEASE, "agent"); asm volatile("s_waitcnt vmcnt(0)" ::: "memory"); __hip_atomic_fetch_add(cnt, 1u, __ATOMIC_RELAXED, __HIP_MEMORY_SCOPE_AGENT); }
                } else norm2_router(PH_CALL, l, 0, ML, bl_ - 8, G_ - 8);
                if (tl_ == 0) { unsigned sp_ = 0; while (__hip_atomic_load(cnt, __ATOMIC_RELAXED, __HIP_MEMORY_SCOPE_AGENT) < 8u && ++sp_ < (1u << 22)) __builtin_amdgcn_s_sleep(2);
                    __builtin_amdgcn_fence(__ATOMIC_ACQUIRE, "agent"); asm volatile("s_waitcnt vmcnt(0)" ::: "memory"); }
                __syncthreads();
                norm2_router(PH_CALL, l, ML, MC, bl_, G_, bl_ < 8);
            } else norm2_router(PH_CALL, l, 0, ntm * 256, bl_, G_);
#endif
        } break;
        case 8: {
#ifndef DIS_TOPK
            const int nun = l == 0 ? 64 : 32;
            for (int u = bl_; u < nun; u += G_) {
                if (u < 32) { const int b = u >> 4, e = u & 15; topk_unit<16, true>(PH_CALL, b * SEQ, SEQ, CAPL, e, b * CAPL, l == 0 && b == 0); }
                else { const int b = (u - 32) >> 4, e = u & 15; topk_unit<1, false>(PH_CALL, ML + b * CTXL, CTXL, CAPC, e, 2048 + b * CAPC, false); }
            }
#endif
        } break;
        case 9: {
#ifndef DIS_GATH
            gather_rows(PH_CALL, tpe);
#endif
        } break;
        case 10: {
            pg8::Gemm g{WSP(bf16, WS_H), WSP(bf16, WS_WGU), NE * ESTR, NE * 2048, 1024, WSP(int, WS_IDX)}; GroupOrder S; S.init(tpe, 8, G_, bl_);
            EpiGU E{WSP(bf16, WS_ACT)};
#ifndef DIS_GGU
            pg8::gemm_phase<EpiGU, GroupOrder, true, true, true>(lds, g, S, E);
#endif
#ifndef DIS_CVT
            if (l == 0) { const int nx = (NE * tpe * 8) % G_; convert_range(lds, tl_, (tl_ & 63), wv_, bl_, G_, 1, CV_WO0, CV_GU0, nx ? bl_ - nx : bl_, G_ - nx);
                          convert_range(lds, tl_, (tl_ & 63), wv_, bl_, G_, 1, CV_SP0, CV_END, nx ? bl_ - nx : bl_, G_ - nx); }
#endif
        } break;
        case 11: {
            pg8::Gemm g{WSP(bf16, WS_ACT), WSP(bf16, WS_WDN), NE * ESTR, NE * 1024, 1024}; GroupOrder S; S.init(tpe, 4, G_, bl_);
            EpiDown E{WSP(bf16, WS_XE), WSP(float, WS_GATE)};
#ifndef DIS_GDN
            pg8::gemm_phase<EpiDown, GroupOrder, true, true>(lds, g, S, E);
#endif
#ifndef DIS_CVT
            if (l == 0) { const int nx = (NE * tpe * 4) % G_; convert_range(lds, tl_, (tl_ & 63), wv_, bl_, G_, 1, CV_GU0, CV_DN0, nx ? bl_ - nx : bl_, G_ - nx); }
#endif
        } break;
        default: {
#ifndef DIS_COMB
#ifdef COMB_REP
#pragma unroll 1
            for (int r_ = 0; r_ < COMB_REP; ++r_) combine_rows<true>(PH_CALL, l);
#endif
            combine_rows<false>(PH_CALL, l);
#endif
#ifndef DIS_CVT
            if (l == 0) convert_range(lds, tl_, (tl_ & 63), wv_, bl_, G_, 1, CV_DN0, CV_SP0, bl_, G_);
#endif
        } break;
        }
#ifdef XBAR
        if (ph == 1) { for (int xb_ = 0; xb_ < XBAR; ++xb_) { XcdBarrier b5 = bar; b5.bar = (unsigned*)(PTRV(29, unsigned char) + WS_CTL) + CW_BAR; b5.st = (volatile LAS unsigned*)(lds + MISC_OFF) + 8; xcd_barrier(b5); } }
#endif
#ifdef TS_I
        { XcdBarrier b3 = bar; b3.bar = (unsigned*)(PTRV(29, unsigned char) + WS_CTL) + CW_BAR; b3.st = (volatile LAS unsigned*)(lds + MISC_OFF) + 8; xcd_barrier(b3);
          if (bid == 0 && tid == 0) ((unsigned long long*)(PTRV(29, unsigned char) + 65536))[ph + 1] = rt(); }
        if (ph + 1 == hi) { XcdBarrier b3 = bar; b3.bar = (unsigned*)(PTRV(29, unsigned char) + WS_CTL) + CW_BAR; b3.st = (volatile LAS unsigned*)(lds + MISC_OFF) + 8; xcd_barrier(b3);
            const unsigned long long* TS = (const unsigned long long*)(PTRV(29, unsigned char) + 65536);
            const float dti = (float)(TS[TS_I + 1] - TS[TS_I]) * 0.01f, dtj = (float)(TS[TS_J + 1] - TS[TS_J]) * 0.01f;
            float* out = PTRV(28, float); const float Av = sqrtf(dti);
            for (size_t i = (size_t)bid * 512 + tid; i < (size_t)ML * 1024; i += (size_t)G * 512) out[i] = (i == 0) ? dtj * 10.f : Av; }
        if (0) {
#else
#ifdef REP_PH
        if (it_ + 1 < hi + (REP_N - 1)) {
#else
        if (ph + 1 < hi) {
#endif
#endif
          XcdBarrier b2 = bar; b2.bar = (unsigned*)(PTRV(29, unsigned char) + WS_CTL) + CW_BAR; unsigned bx_ = bar.x; asm volatile("" : "+s"(bx_)); b2.x = bx_; b2.st = (volatile LAS unsigned*)(lds + MISC_OFF) + 8; xcd_barrier(b2); }
    }
}

extern "C" void kernel_launch(void* const* d_in, const int* in_sizes, int n_in, void* d_out, int out_size, void* d_ws, size_t ws_size, hipStream_t stream) {
    static int grid = 0;
    if (grid == 0) {
        if (n_in != 28 || ws_size < WS_END) { fprintf(stderr, "kernel_launch: unexpected n_in %d / ws %zu\n", n_in, ws_size); grid = -1; return; }
        int dev = 0, cus = 0;
        if (hipGetDevice(&dev) != hipSuccess || hipDeviceGetAttribute(&cus, hipDeviceAttributeMultiprocessorCount, dev) != hipSuccess) { grid = -1; return; }
        if (hipFuncSetAttribute((const void*)mega, hipFuncAttributeMaxDynamicSharedMemorySize, LDS_BYTES) != hipSuccess) { fprintf(stderr, "kernel_launch: hipFuncSetAttribute failed\n"); grid = -1; return; }
        (void)hipGetLastError();
        grid = cus;
    }
    if (grid < 0) return;
    (void)hipMemsetAsync((char*)d_ws + WS_CTL, 0, CTL_ZERO_BYTES, stream);
    Args a{};
    for (int i = 0; i < 28; ++i) a.in[i] = (const float*)d_in[i];
    a.out = (float*)d_out; a.ws = (unsigned char*)d_ws;
#ifdef DBG_STOP
    for (int p = 0; p < (DBG_STOP > 20 ? DBG_STOP / 10 : DBG_STOP); ++p) { a.ph_lo = p; a.ph_hi = p + 1; hipLaunchKernelGGL(mega, dim3(grid), dim3(512), LDS_BYTES, stream, a); }
    a.ph_lo = 99; a.ph_hi = 100; hipLaunchKernelGGL(mega, dim3(grid), dim3(512), LDS_BYTES, stream, a);
#elif N_LAUNCHES == 1
    a.ph_lo = 0; a.ph_hi = NPH;
    hipLaunchKernelGGL(mega, dim3(grid), dim3(512), LDS_BYTES, stream, a);
#else
    for (int p = 0; p < NPH; ++p) { a.ph_lo = p; a.ph_hi = p + 1; hipLaunchKernelGGL(mega, dim3(grid), dim3(512), LDS_BYTES, stream, a); }
#endif
}
```

```cpp
#include <hip/hip_runtime.h>
#include <cstdio>
#include <cstdint>
#define N_LAUNCHES 1
namespace pg8 {
#define PG8_LAS __attribute__((address_space(3)))
typedef unsigned short bf16_t;
typedef short bf16x8 __attribute__((ext_vector_type(8)));
typedef float f32x4 __attribute__((ext_vector_type(4)));
typedef unsigned u32x4 __attribute__((ext_vector_type(4)));
constexpr int BM = 256, BK = 64, HALF = 128, HTB = HALF * BK * 2  , STAGE_BYTES = 8 * HTB, NXCD = 8, WGM = 2;

__host__ __device__ __forceinline__ int lds_byte(int r, int c) { const int st = (r >> 4) * 2 + (c >> 5), rr = r & 15, cc = c & 31, ob = rr * 64 + cc * 2; return st * 1024 + (ob ^ (((ob >> 9) & 1) << 5)); }
__host__ __device__ __forceinline__ void stage_rc(int b, int& R, int& C) { const int st = b / 1024, sb = b % 1024, swz = sb ^ (((sb >> 9) & 1) << 5); R = (st >> 1) * 16 + swz / 64; C = (st & 1) * 32 + (swz % 64) / 2; }
__host__ __device__ __forceinline__ int perm32(int rho) { const int n = rho >> 4, i = rho & 15; return 8 * (i >> 2) + 4 * n + (i & 3); }

struct Unit { int pm, pn; };
struct Gemm { const bf16_t* A; const bf16_t* Bt; int M, N, K; const int* gidx = nullptr; };

struct StaticOrder {
    int nM, nN, nwg, G, c;
    __host__ __device__ void init(int M, int N, int G_, int c_) { nM = M / BM; nN = N / BM; nwg = nM * nN; G = G_; c = c_; }
    __host__ __device__ bool next(int i, Unit& u) const {
        const long L = (long)i * G + c; if (L >= nwg) return false;
        int wgid = (int)L; { const int q = nwg / NXCD, r = nwg % NXCD, xcd = wgid % NXCD, off = wgid / NXCD; wgid = (xcd < r ? xcd * (q + 1) : r * (q + 1) + (xcd - r) * q) + off; }
        const int nig = WGM * nN, gid = wgid / nig, fm = gid * WGM, gsz = (nM - fm) < WGM ? (nM - fm) : WGM;
        u.pm = fm + ((wgid % nig) % gsz); u.pn = (wgid % nig) / gsz; return true;
    }
    __device__ __forceinline__ void a_ready(const Unit&) const {}
    __device__ __forceinline__ void done(const Unit&) const {}
};
__device__ __forceinline__ unsigned cvt_pk_bf16(float lo, float hi) { unsigned r; asm volatile("v_cvt_pk_bf16_f32 %0, %1, %2" : "=v"(r) : "v"(lo), "v"(hi)); return r; }
typedef float f32x2 __attribute__((ext_vector_type(2)));
template <class Epi, class Sched, bool ALIGN_EPI = false, bool SP2 = false, bool GATHER = false>
__device__ __forceinline__ void gemm_phase(PG8_LAS unsigned char* lds, const Gemm g, const Sched& S, const Epi& E) {
    int tid_l = threadIdx.x; asm volatile("" : "+v"(tid_l));
    const int tid = tid_l, wid = __builtin_amdgcn_readfirstlane(tid >> 6), lane = tid & 63, wr = wid >> 2, wc = wid & 3, fr = lane & 15, fq = lane >> 4;
    const int K = g.K, nt = K / BK;
    unsigned voffA[2], voffB[2];
#pragma unroll
    for (int i = 0; i < 2; ++i) { int R, C; stage_rc(tid * 16 + i * 8192, R, C); const int Rb = Epi::PERM ? ((R & ~31) + perm32(R & 31)) : R;
        voffA[i] = (unsigned)(R * K + C) * 2u; voffB[i] = (unsigned)(Rb * K + C) * 2u; }
    const size_t kstep = (size_t)(BK * 2);
    const size_t hstep = (size_t)HALF * K * 2;
    const size_t tstep = 2 * hstep;
    const unsigned ldsw = (unsigned)wid * 1024u;
    const int aoff = lds_byte(wr * 64 + fr, fq * 8), boff = lds_byte(wc * 32 + fr, fq * 8);
#define PG8_SA(b, h) (((b) * 2 + (h)) * HTB)
#define PG8_SB(b, h) ((4 + (b) * 2 + (h)) * HTB)
#define PG8_STAGE(bufoff, gbase, voff) do { _Pragma("unroll") for (int _i = 0; _i < 2; ++_i) \
        __builtin_amdgcn_global_load_lds((const unsigned*)((const char*)(gbase) + (voff)[_i]), (PG8_LAS unsigned*)(lds + (bufoff) + ldsw + _i * 8192), 16, 0, 0); } while (0)
    static_assert(!GATHER || SP2, "GATHER is implemented on the SP2 loop only");
    unsigned vgc[2][2] = {{0u, 0u}, {0u, 0u}}, vgn[2][2] = {{0u, 0u}, {0u, 0u}};
#define PG8_GLOAD(u, v) do { _Pragma("unroll") for (int _h = 0; _h < 2; ++_h) _Pragma("unroll") for (int _i = 0; _i < 2; ++_i) { int R_, C_; stage_rc(tid * 16 + _i * 8192, R_, C_); \
        v[_h][_i] = (unsigned)(g.gidx[(u).pm * BM + _h * HALF + R_] * K + C_) * 2u; } } while (0)
#define PG8_STAGE_A(bufoff, base, half, NEXT) do { if constexpr (GATHER) { if (NEXT) PG8_STAGE(bufoff, base, vgn[half]); else PG8_STAGE(bufoff, base, vgc[half]); } \
        else PG8_STAGE(bufoff, (base) + (half) * hstep, voffA); } while (0)
#define PG8_LDA(dst, b, h) do { _Pragma("unroll") for (int m = 0; m < 4; ++m) _Pragma("unroll") for (int k = 0; k < 2; ++k) dst[m][k] = *(const PG8_LAS bf16x8*)(lds + PG8_SA(b, h) + aoff + m * 2048 + k * 1024); } while (0)
#define PG8_LDB(dst, b, h) do { _Pragma("unroll") for (int n = 0; n < 2; ++n) _Pragma("unroll") for (int k = 0; k < 2; ++k) dst[n][k] = *(const PG8_LAS bf16x8*)(lds + PG8_SB(b, h) + boff + n * 2048 + k * 1024); } while (0)
#define PG8_MMA(ai, bj, At, Bt) do { __builtin_amdgcn_s_setprio(1); _Pragma("unroll") for (int m = 0; m < 4; ++m) _Pragma("unroll") for (int n = 0; n < 2; ++n) _Pragma("unroll") for (int k = 0; k < 2; ++k) \
        acc[ai][bj][m][n] = __builtin_amdgcn_mfma_f32_16x16x32_bf16(Bt[n][k], At[m][k], acc[ai][bj][m][n], 0, 0, 0); __builtin_amdgcn_s_setprio(0); } while (0)
#define PG8_WAIT_V(n) asm volatile("s_waitcnt vmcnt(" #n ")" ::: "memory")
#define PG8_WAIT_L(n) asm volatile("s_waitcnt lgkmcnt(" #n ")" ::: "memory")
#define PG8_BAR __builtin_amdgcn_s_barrier()
#define PG8_SCHED __builtin_amdgcn_sched_barrier(0)
    Unit cur, nxt; int ui = 0;
    if (!S.next(0, cur)) return;
    f32x4 acc[2][2][4][2];
#pragma unroll
    for (int a = 0; a < 2; ++a)
#pragma unroll
        for (int b = 0; b < 2; ++b)
#pragma unroll
            for (int m = 0; m < 4; ++m)
#pragma unroll
                for (int n = 0; n < 2; ++n) acc[a][b][m][n] = (f32x4){0.f, 0.f, 0.f, 0.f};
    bf16x8 At[4][2], B0[2][2], B1[2][2];
    const char* cA = GATHER ? (const char*)g.A : (const char*)g.A + (size_t)cur.pm * tstep; const char* cB = (const char*)g.Bt + (size_t)cur.pn * tstep;
    if constexpr (GATHER) { PG8_GLOAD(cur, vgc); }
    S.a_ready(cur);
    if constexpr (SP2) {
        PG8_STAGE(PG8_SB(0, 0), cB, voffB); PG8_STAGE(PG8_SB(0, 1), cB + hstep, voffB); PG8_STAGE_A(PG8_SA(0, 0), cA, 0, false); PG8_STAGE_A(PG8_SA(0, 1), cA, 1, false);
        if (wr == 1) PG8_BAR;
        PG8_WAIT_V(2); PG8_BAR;
        PG8_STAGE(PG8_SB(1, 0), cB + kstep, voffB); PG8_STAGE_A(PG8_SA(1, 0), cA + kstep, 0, false); PG8_STAGE(PG8_SB(1, 1), cB + hstep + kstep, voffB);
        PG8_WAIT_V(6); PG8_BAR;
    } else {
        PG8_STAGE(PG8_SB(0, 0), cB, voffB); PG8_STAGE(PG8_SA(0, 0), cA, voffA); PG8_STAGE(PG8_SB(0, 1), cB + hstep, voffB); PG8_STAGE(PG8_SA(0, 1), cA + hstep, voffA);
        if (wr == 1) PG8_BAR;
        PG8_WAIT_V(4); PG8_BAR;
        PG8_STAGE(PG8_SB(1, 0), cB + kstep, voffB); PG8_STAGE(PG8_SA(1, 0), cA + kstep, voffA); PG8_STAGE(PG8_SB(1, 1), cB + hstep + kstep, voffB);
        PG8_WAIT_V(6); PG8_BAR;
    }
    for (;;) {
        const bool has_next = S.next(ui + 1, nxt);
        const char* nA = GATHER ? (const char*)g.A : (has_next ? (const char*)g.A + (size_t)nxt.pm * tstep : cA);
        if constexpr (GATHER) { if (has_next) { PG8_GLOAD(nxt, vgn); } else { _Pragma("unroll") for (int _h = 0; _h < 2; ++_h) _Pragma("unroll") for (int _i = 0; _i < 2; ++_i) vgn[_h][_i] = vgc[_h][_i]; } } const char* nB = has_next ? (const char*)g.Bt + (size_t)nxt.pn * tstep : cB;
#pragma unroll 1
        for (int t = 0; t < nt; t += 2) {
            const bool last = (t == nt - 2);
            const char* a1 = cA + (size_t)(t + 1) * kstep;
            const char* a2 = last ? nA : cA + (size_t)(t + 2) * kstep; const char* b2 = last ? nB : cB + (size_t)(t + 2) * kstep;
            const char* a3 = a2 + kstep; const char* b3 = b2 + kstep;
            if (last && has_next) S.a_ready(nxt);
            if constexpr (SP2) {
            PG8_LDB(B0, 0, 0); PG8_LDB(B1, 0, 1); PG8_SCHED; PG8_LDA(At, 0, 0); PG8_STAGE_A(PG8_SA(1, 1), a1, 1, false);
            PG8_WAIT_V(8); PG8_WAIT_L(0); PG8_BAR; PG8_MMA(0, 0, At, B0); PG8_MMA(0, 1, At, B1); PG8_BAR; PG8_SCHED;
            PG8_LDA(At, 0, 1); PG8_STAGE(PG8_SB(0, 0), b2, voffB); PG8_STAGE(PG8_SB(0, 1), b2 + hstep, voffB); PG8_STAGE_A(PG8_SA(0, 0), a2, 0, last);
            PG8_WAIT_V(8); PG8_WAIT_L(0); PG8_BAR; PG8_MMA(1, 0, At, B0); PG8_MMA(1, 1, At, B1); PG8_BAR; PG8_SCHED;
            PG8_LDB(B0, 1, 0); PG8_LDB(B1, 1, 1); PG8_SCHED; PG8_LDA(At, 1, 0); PG8_STAGE_A(PG8_SA(0, 1), a2, 1, last);
            PG8_WAIT_V(8); PG8_WAIT_L(0); PG8_BAR; PG8_MMA(0, 0, At, B0); PG8_MMA(0, 1, At, B1); PG8_BAR; PG8_SCHED;
            PG8_LDA(At, 1, 1); PG8_STAGE(PG8_SB(1, 0), b3, voffB); PG8_STAGE(PG8_SB(1, 1), b3 + hstep, voffB); PG8_STAGE_A(PG8_SA(1, 0), a3, 0, last);
            PG8_WAIT_V(8); PG8_WAIT_L(0); PG8_BAR; PG8_MMA(1, 0, At, B0); PG8_MMA(1, 1, At, B1); PG8_BAR; PG8_SCHED;
            } else {
            PG8_LDB(B0, 0, 0); PG8_SCHED; PG8_LDA(At, 0, 0); PG8_STAGE(PG8_SA(1, 1), a1 + hstep, voffA);
            PG8_WAIT_L(8); PG8_BAR; PG8_WAIT_L(0); PG8_MMA(0, 0, At, B0); PG8_BAR; PG8_SCHED;
            PG8_LDB(B1, 0, 1); PG8_STAGE(PG8_SB(0, 0), b2, voffB);
            PG8_BAR; PG8_WAIT_L(0); PG8_MMA(0, 1, At, B1); PG8_BAR;
            PG8_LDA(At, 0, 1); PG8_STAGE(PG8_SA(0, 0), a2, voffA);
            PG8_BAR; PG8_WAIT_L(0); PG8_MMA(1, 0, At, B0); PG8_BAR; PG8_SCHED;
            PG8_STAGE(PG8_SB(0, 1), b2 + hstep, voffB);
            PG8_WAIT_V(6); PG8_BAR; PG8_MMA(1, 1, At, B1); PG8_BAR;
            PG8_LDB(B0, 1, 0); PG8_SCHED; PG8_LDA(At, 1, 0); PG8_STAGE(PG8_SA(0, 1), a2 + hstep, voffA);
            PG8_WAIT_L(8); PG8_BAR; PG8_WAIT_L(0); PG8_MMA(0, 0, At, B0); PG8_BAR; PG8_SCHED;
            PG8_LDB(B1, 1, 1); PG8_STAGE(PG8_SB(1, 0), b3, voffB);
            PG8_BAR; PG8_WAIT_L(0); PG8_MMA(0, 1, At, B1); PG8_BAR;
            PG8_LDA(At, 1, 1); PG8_STAGE(PG8_SA(1, 0), a3, voffA);
            PG8_BAR; PG8_WAIT_L(0); PG8_MMA(1, 0, At, B0); PG8_BAR; PG8_SCHED;
            PG8_STAGE(PG8_SB(1, 1), b3 + hstep, voffB);
            PG8_WAIT_V(6); PG8_BAR; PG8_MMA(1, 1, At, B1); PG8_BAR;
            }
        }
        if constexpr (ALIGN_EPI) { if (wr == 0) PG8_BAR; }
        if constexpr (!Epi::AFTER_DRAIN) { int t2_ = threadIdx.x; asm volatile("" : "+v"(t2_)); E(acc, cur, wr, wc, t2_ & 15, (t2_ >> 4) & 3); S.done(cur); }
        if (!has_next) break;
        bool keep_ = false; if constexpr (Epi::KEEP) keep_ = E.keep(cur);
        if (!keep_) {
#pragma unroll
        for (int a = 0; a < 2; ++a)
#pragma unroll
            for (int b = 0; b < 2; ++b)
#pragma unroll
                for (int m = 0; m < 4; ++m)
#pragma unroll
                    for (int n = 0; n < 2; ++n) acc[a][b][m][n] = (f32x4){0.f, 0.f, 0.f, 0.f};
        }
        cur = nxt; cA = nA; cB = nB; ++ui;
        if constexpr (GATHER) { _Pragma("unroll") for (int _h = 0; _h < 2; ++_h) _Pragma("unroll") for (int _i = 0; _i < 2; ++_i) vgc[_h][_i] = vgn[_h][_i]; }
        if constexpr (ALIGN_EPI) { if (wr == 1) PG8_BAR; }
    }
    PG8_WAIT_V(0);
    if constexpr (!ALIGN_EPI) { if (wr == 0) PG8_BAR; }
    PG8_BAR;
    if constexpr (Epi::AFTER_DRAIN) { E.fused(acc, cur, wr, wc, fr, fq, lds, wid, lane); S.done(cur); }
#undef PG8_SA
#undef PG8_SB
#undef PG8_STAGE
#undef PG8_STAGE_A
#undef PG8_GLOAD
#undef PG8_LDA
#undef PG8_LDB
#undef PG8_MMA
#undef PG8_WAIT_V
#undef PG8_WAIT_L
#undef PG8_BAR
#undef PG8_SCHED
}
}
#define GAS __attribute__((address_space(1)))
#define LAS __attribute__((address_space(3)))
typedef unsigned short bf16;
typedef unsigned v4u __attribute__((ext_vector_type(4)));
typedef float f32x4 __attribute__((ext_vector_type(4)));
typedef short bf16x8 __attribute__((ext_vector_type(8)));
typedef GAS unsigned gu32;
typedef GAS unsigned long long gu64;
#define RLX_AGENT __ATOMIC_RELAXED, __HIP_MEMORY_SCOPE_AGENT
#define LDS_WAIT() asm volatile("s_waitcnt lgkmcnt(0)" ::: "memory")
#define VM_WAIT() asm volatile("s_waitcnt vmcnt(0)" ::: "memory")
__device__ __forceinline__ unsigned long long rt() { return __builtin_amdgcn_s_memrealtime(); }
__device__ __forceinline__ unsigned f2bf(float f) { unsigned u = __builtin_bit_cast(unsigned, f); return (u + 0x7fffu + ((u >> 16) & 1u)) >> 16; }
typedef float f32x2_t __attribute__((ext_vector_type(2))); typedef __bf16 bf16x2_t __attribute__((ext_vector_type(2)));
__device__ __forceinline__ unsigned pk2(float lo, float hi) { const f32x2_t v = {lo, hi}; const bf16x2_t b = __builtin_convertvector(v, bf16x2_t); return __builtin_bit_cast(unsigned, b); }

#define XB_TMO      128
#define XB_XCNT(j)  (256  + 64 * (j))
#define XB_XSUB(j)  (1280 + 64 * (j))
#define XB_XGEN(j)  (2304 + 64 * (j))
#define XB_TOP      3328
#define XB_TOPGEN   3392
#define XCD_BAR_WORDS 3456
#define XB_SPIN_CAP (1u << 18)

__device__ __forceinline__ unsigned xb_ld(unsigned* p)              { return __hip_atomic_load(p, __ATOMIC_RELAXED, __HIP_MEMORY_SCOPE_AGENT); }
__device__ __forceinline__ unsigned xb_add(unsigned* p, unsigned v) { return __hip_atomic_fetch_add(p, v, __ATOMIC_RELAXED, __HIP_MEMORY_SCOPE_AGENT); }
__device__ __forceinline__ unsigned xb_xcc_id() { return (unsigned)__builtin_amdgcn_s_getreg((3 << 11) | 20) & 0xFu; }
#define XB_SPIN(cond, bar) do { unsigned _sp = 0; while (cond) { __builtin_amdgcn_s_sleep(1); \
    if ((++_sp & 255u) == 0u) { if (xb_ld(&(bar)[XB_TMO])) break; if (_sp > XB_SPIN_CAP) { atomicAdd(&(bar)[XB_TMO], 1u); break; } } } } while (0)

struct XcdBarrier {
    unsigned* bar; unsigned x;
    volatile LAS unsigned* st;
};

__device__ __forceinline__ XcdBarrier xcd_barrier_post(unsigned* bar, volatile LAS unsigned* st) {
    XcdBarrier b; b.bar = bar; b.x = xb_xcc_id(); b.st = st;
    if (threadIdx.x == 0) (void)xb_add(&bar[XB_XCNT(b.x)], 1u);
    return b;
}
__device__ __forceinline__ void xcd_barrier_complete(unsigned* bar, unsigned x, unsigned& nloc, unsigned& nx) {
    const unsigned G = gridDim.x * gridDim.y * gridDim.z;
    unsigned sum, cnt, mine, sp = 0u;
    for (;;) {
        sum = 0u; cnt = 0u; mine = 0u;
#pragma unroll
        for (unsigned j = 0; j < 16; ++j) { const unsigned c = xb_ld(&bar[XB_XCNT(j)]); sum += c; cnt += (c > 0u) ? 1u : 0u; mine = (j == x) ? c : mine; }
        if (sum == G) break;
        __builtin_amdgcn_s_sleep(1);
        if ((++sp & 255u) == 0u) { if (xb_ld(&bar[XB_TMO])) break; if (sp > XB_SPIN_CAP) { atomicAdd(&bar[XB_TMO], 1u); break; } }
    }
    nloc = mine > 0u ? mine : 1u; nx = cnt > 0u ? cnt : 1u;
}

__device__ __forceinline__ void xcd_barrier(const XcdBarrier& b) {
    asm volatile("s_waitcnt vmcnt(0)" ::: "memory");
    __syncthreads();
    if (threadIdx.x == 0) {
        unsigned* bar = b.bar;
        __builtin_amdgcn_s_waitcnt(0);
        unsigned nloc = b.st[0], nx = b.st[1];
        if (nloc == 0u) { xcd_barrier_complete(bar, b.x, nloc, nx); b.st[0] = nloc; b.st[1] = nx; }
        const unsigned old = xb_add(&bar[XB_XSUB(b.x)], 1u);
        const unsigned gen = old / nloc;
        if (old + 1u == (gen + 1u) * nloc) {
            __builtin_amdgcn_fence(__ATOMIC_RELEASE, "agent");
            asm volatile("s_waitcnt vmcnt(0)" ::: "memory");
            const unsigned og = xb_add(&bar[XB_TOP], 1u);
            const unsigned tg = og / nx;
            if (og + 1u == (tg + 1u) * nx) xb_add(&bar[XB_TOPGEN], 1u);
            else XB_SPIN(xb_ld(&bar[XB_TOPGEN]) == tg, bar);
            __builtin_amdgcn_fence(__ATOMIC_ACQUIRE, "agent");
            xb_add(&bar[XB_XGEN(b.x)], 1u);
            asm volatile("s_waitcnt vmcnt(0)" ::: "memory");
        } else {
            XB_SPIN(xb_ld(&bar[XB_XGEN(b.x)]) == gen, bar);
            __builtin_amdgcn_fence(__ATOMIC_ACQUIRE, "agent");
            asm volatile("s_waitcnt vmcnt(0)" ::: "memory");
        }
    }
    __syncthreads();
}
constexpr int DM = 1024, SEQ = 8192, NBATCH = 2, CTXL = 256;
constexpr int ML = NBATCH * SEQ, MC = NBATCH * CTXL, MT = ML + MC;
constexpr int NIN = 6400;
constexpr int NE = 16, ESTR = 2304, CAPL = 1024, CAPC = 32;
constexpr int NPH = 24;
constexpr size_t MiB = 1u << 20;
constexpr size_t WS_CTL = 0, CTL_ZERO_BYTES = 1 * MiB;
constexpr size_t WS_MOD = 1 * MiB;
constexpr size_t WS_ROPEC = 1 * MiB + 256 * 1024, WS_ROPES = WS_ROPEC + 8192;
constexpr size_t WS_TW = 1 * MiB + 512 * 1024;
constexpr size_t WS_CS256 = 1 * MiB + 640 * 1024;
constexpr size_t WS_T1T = 2 * MiB;
constexpr size_t WS_T2T = 2 * MiB + 64 * 1024;
constexpr size_t WS_T2F = 8 * MiB;
constexpr size_t WS_T2C = 12 * MiB;
constexpr size_t WS_FAC = 13 * MiB;
constexpr size_t WS_WSP = 2 * MiB + 256 * 1024;
constexpr size_t WS_AFF = 3 * MiB;
constexpr size_t WS_SEL = 5 * MiB;
constexpr size_t WS_IDX = 7 * MiB, WS_GATE = 7 * MiB + 256 * 1024;
constexpr size_t WS_WIN = 16 * MiB, WS_WBR = 29 * MiB, WS_WO = 31 * MiB, WS_WGU = 33 * MiB, WS_WDN = 97 * MiB;
constexpr size_t WS_X = 130 * MiB;
constexpr size_t WS_H = 196 * MiB;
constexpr size_t WS_BR = 229 * MiB;
constexpr size_t WS_MB = 262 * MiB;
constexpr size_t WS_FA = 295 * MiB;
constexpr size_t WS_Z = 311 * MiB;
constexpr size_t ZROW = (size_t)MT * 2;
constexpr size_t WS_AUV = WS_Z, WS_YF = WS_AUV + 512 * ZROW, WS_CY = WS_YF + 512 * ZROW, WS_QPL = WS_CY + 256 * ZROW, WS_QROT = WS_QPL + 256 * ZROW,
                 WS_KR = WS_QROT + 256 * ZROW, WS_VV = WS_KR + 256 * ZROW, WS_G = WS_VV + 256 * ZROW, WS_ZEND = WS_G + 4096 * ZROW;
constexpr size_t WS_P32 = WS_Z;
constexpr size_t WS_XE = WS_Z, WS_ACT = WS_Z + 72 * MiB;
constexpr size_t WS_END = 518 * MiB;
static_assert(WS_G == WS_P32 + (size_t)MT * 1024 * 4 + 8 * 256 * ZROW / 8 - 256 * ZROW || true, "");
static_assert(WS_ZEND <= WS_END && WS_ACT + 72 * MiB <= WS_ZEND && WS_P32 + (size_t)MT * 4096 <= WS_VV, "ws map");
constexpr int CW_BAR = 4096;
constexpr int LDS_BYTES = 155648, MISC_OFF = 154624;

struct Args { const float* in[28]; float* out; unsigned char* ws; int ph_lo, ph_hi; };

__device__ __forceinline__ float bflo(unsigned w) { return __uint_as_float(w << 16); }
__device__ __forceinline__ float bfhi(unsigned w) { return __uint_as_float(w & 0xffff0000u); }
__device__ __forceinline__ float sigm(float x) { return __builtin_amdgcn_rcpf(1.f + __expf(-x)); }
__device__ __forceinline__ float wave_sum(float v) {
#pragma unroll
    for (int o = 1; o < 64; o <<= 1) v += __shfl_xor(v, o);
    return v;
}
__device__ __forceinline__ void st4bf(bf16* p, f32x4 v) { uint2 w; w.x = pk2(v[0], v[1]); w.y = pk2(v[2], v[3]); *(uint2*)p = w; }

__device__ __forceinline__ void st8bf(bf16* p, f32x4 a, f32x4 b) { v4u w; w.x = pk2(a[0], a[1]); w.y = pk2(a[2], a[3]); w.z = pk2(b[0], b[1]); w.w = pk2(b[2], b[3]); *(v4u*)p = w; }
using pg8::Unit;
struct EpiIn {
    static constexpr bool PERM = false, AFTER_DRAIN = false, KEEP = false;
    bf16 *AUV, *YF, *CY, *QPL, *QROT, *KR, *VV, *G; const float* ropeC; const float* ropeS;
    __device__ __forceinline__ void operator()(const f32x4 (&acc)[2][2][4][2], const Unit& u, int wr, int wc, int fr, int fq) const {
        const int pn = u.pn, row0 = u.pm * 256 + wr * 64 + fr, cl0 = wc * 32 + 4 * fq;
        const int cp0 = wc * 32 + 8 * fq;
        if (pn < 2) {
#pragma unroll
            for (int ai = 0; ai < 2; ++ai)
#pragma unroll
                for (int m = 0; m < 4; ++m) { const size_t row = row0 + ai * 128 + m * 16;
#pragma unroll
                    for (int bj = 0; bj < 2; ++bj) { f32x4 v[2];
#pragma unroll
                        for (int n = 0; n < 2; ++n)
#pragma unroll
                            for (int j = 0; j < 4; ++j) { const float x = acc[ai][bj][m][n][j]; v[n][j] = x * sigm(1.5957691216f * (x + 0.044715f * x * x * x)); }
                        st8bf(AUV + row * 512 + pn * 256 + bj * 128 + cp0, v[0], v[1]); } }
        } else if (pn < 4) {
#pragma unroll
            for (int ai = 0; ai < 2; ++ai)
#pragma unroll
                for (int m = 0; m < 4; ++m) { const size_t row = row0 + ai * 128 + m * 16;
#pragma unroll
                    for (int bj = 0; bj < 2; ++bj) st8bf(YF + row * 512 + (pn - 2) * 256 + bj * 128 + cp0, acc[ai][bj][m][0], acc[ai][bj][m][1]); }
        } else if (pn < 6) {
#pragma unroll
            for (int ai = 0; ai < 2; ++ai)
#pragma unroll
                for (int m = 0; m < 4; ++m) { const size_t row = row0 + ai * 128 + m * 16; f32x4 v[2];
#pragma unroll
                    for (int n = 0; n < 2; ++n) { const f32x4 a = acc[ai][0][m][n], g = acc[ai][1][m][n];
#pragma unroll
                        for (int j = 0; j < 4; ++j) v[n][j] = a[j] * sigm(g[j]); }
                    st8bf(CY + row * 256 + (pn - 4) * 128 + cp0, v[0], v[1]); }
        } else if (pn < 8) {
            const bool isq = pn == 6; const float scl = isq ? 0.125f * 1.4426950408889634f : 1.f;   const bool latent = u.pm < 64;
#pragma unroll
            for (int ai = 0; ai < 2; ++ai)
#pragma unroll
                for (int m = 0; m < 4; ++m) { const int rowi = row0 + ai * 128 + m * 16; const size_t row = rowi; const int tok = rowi & 8191;
                    const int pos = (wc & 1) ? (tok & 63) : (tok >> 6);
                    f32x4 cs = {1.f, 1.f, 1.f, 1.f}, sn = {0.f, 0.f, 0.f, 0.f};
                    if (latent) { cs = *(const f32x4*)(ropeC + pos * 16 + 4 * fq); sn = *(const f32x4*)(ropeS + pos * 16 + 4 * fq); }
#pragma unroll
                    for (int bj = 0; bj < 2; ++bj) { const f32x4 x1 = acc[ai][bj][m][0] * scl, x2 = acc[ai][bj][m][1] * scl;
                        const f32x4 r1 = x1 * cs - x2 * sn, r2 = x1 * sn + x2 * cs; const size_t off = row * 256 + bj * 128 + cl0;
                        if (isq) { st4bf(QPL + off, x1); st4bf(QPL + off + 16, x2); st4bf(QROT + off, r1); st4bf(QROT + off + 16, r2); }
                        else { st4bf(KR + off, r1); st4bf(KR + off + 16, r2); } } }
        } else if (pn == 8) {
#pragma unroll
            for (int ai = 0; ai < 2; ++ai)
#pragma unroll
                for (int m = 0; m < 4; ++m) { const size_t row = row0 + ai * 128 + m * 16;
#pragma unroll
                    for (int bj = 0; bj < 2; ++bj) st8bf(VV + row * 256 + bj * 128 + cp0, acc[ai][bj][m][0], acc[ai][bj][m][1]); }
        } else {
#pragma unroll
            for (int ai = 0; ai < 2; ++ai)
#pragma unroll
                for (int m = 0; m < 4; ++m) { const size_t row = row0 + ai * 128 + m * 16;
#pragma unroll
                    for (int bj = 0; bj < 2; ++bj)
#pragma unroll
                        for (int n = 0; n < 2; ++n) { f32x4 v = acc[ai][bj][m][n];
#pragma unroll
                            for (int j = 0; j < 4; ++j) v[j] = sigm(v[j]);
                            const int gb_ = (pn - 9) >> 2, gu_ = (2 * u.pm + ai) * 8 + 2 * ((pn - 9) & 3) + bj;
                            st4bf(G + ((((size_t)(gu_ * 4 + gb_) * 8 + (wr * 4 + wc)) * 8 + m * 2 + n) * 256 + (fq * 16 + fr) * 4), v); } }
        }
    }
};
struct EpiMerge {
    static constexpr bool PERM = false, AFTER_DRAIN = false, KEEP = false;
    const bf16* G; float* P32; bf16* MB;
    __device__ __forceinline__ void operator()(const f32x4 (&acc)[2][2][4][2], const Unit& u, int wr, int wc, int fr, int fq) const {
        int fr_ = fr, fq_ = fq; asm volatile("" : "+v"(fr_), "+v"(fq_));
        const int b = u.pn >> 2, pn = u.pn & 3, pm = u.pm - b * 66, row0 = pm * 256 + wr * 64 + fr_, col0 = pn * 256 + wc * 32 + 4 * fq_;
#pragma unroll
        for (int ai = 0; ai < 2; ++ai)
#pragma unroll
            for (int m = 0; m < 4; ++m) { const unsigned row = row0 + ai * 128 + m * 16;
                const bf16* gp = G + ((size_t)row * 4096 + b * 1024 + col0); float* pp = P32 + ((size_t)row * 1024 + col0); bf16* mp = MB + ((size_t)row * 1024 + col0);
#pragma unroll
                for (int bj = 0; bj < 2; ++bj)
#pragma unroll
                    for (int n = 0; n < 2; ++n) { const int co = bj * 128 + n * 16;
                        const uint2 gw = *(const uint2*)(gp + co);
                        f32x4 v = acc[ai][bj][m][n]; v[0] *= bflo(gw.x); v[1] *= bfhi(gw.x); v[2] *= bflo(gw.y); v[3] *= bfhi(gw.y);
                        if (b > 0) v += *(const f32x4*)(pp + co);
                        if (b < 3) *(f32x4*)(pp + co) = v; else st4bf(mp + co, v);
                        asm volatile("" ::: "memory"); } }
    }
};
struct EpiMergeH {
    static constexpr bool PERM = false, AFTER_DRAIN = false, KEEP = true;
    const bf16* G; bf16* MB;
    __device__ __forceinline__ bool keep(const Unit& u) const { return (u.pn >> 2) < 3; }
    __device__ __forceinline__ void operator()(f32x4 (&acc)[2][2][4][2], const Unit& u, int wr, int wc, int fr, int fq) const {
        const int b = u.pn >> 2, pn = u.pn & 3, pm = u.pm - b * 66, row0 = pm * 256 + wr * 64 + fr, col0 = pn * 256 + wc * 32 + 4 * fq;
#pragma unroll
        for (int ai = 0; ai < 2; ++ai)
#pragma unroll
            for (int m = 0; m < 4; ++m) { const unsigned row = row0 + ai * 128 + m * 16; const bf16* gp = G + ((size_t)row * 4096 + b * 1024 + col0); bf16* mp = MB + ((size_t)row * 1024 + col0);
#pragma unroll
                for (int bj = 0; bj < 2; ++bj)
#pragma unroll
                    for (int n = 0; n < 2; ++n) { const int co = bj * 128 + n * 16; const uint2 gb = *(const uint2*)(gp + co); f32x4 v = acc[ai][bj][m][n];
                        if (b < 3) { const uint2 gn = *(const uint2*)(gp + 1024 + co);
                            v[0] *= bflo(gb.x) * __builtin_amdgcn_rcpf(bflo(gn.x)); v[1] *= bfhi(gb.x) * __builtin_amdgcn_rcpf(bfhi(gn.x)); v[2] *= bflo(gb.y) * __builtin_amdgcn_rcpf(bflo(gn.y)); v[3] *= bfhi(gb.y) * __builtin_amdgcn_rcpf(bfhi(gn.y));
                            acc[ai][bj][m][n] = v; }
                        else { v[0] *= bflo(gb.x); v[1] *= bfhi(gb.x); v[2] *= bflo(gb.y); v[3] *= bfhi(gb.y); st4bf(mp + co, v); } }
                asm volatile("" ::: "memory"); }
    }
};
struct EpiWout {
    static constexpr bool PERM = false, AFTER_DRAIN = false, KEEP = false;
    const float* xlat; const float* xctx; float* X; const float* mod;
    __device__ __forceinline__ void operator()(const f32x4 (&acc)[2][2][4][2], const Unit& u, int wr, int wc, int fr, int fq) const {
        const int r = u.pm < 32 ? 0 : (u.pm < 64 ? 1 : 2); const float* gt = mod + r * 6144 + 2 * 1024;
        const int row0 = u.pm * 256 + wr * 64 + fr, col0 = u.pn * 256 + wc * 32 + 4 * fq;
        f32x4 gv[2][2];
#pragma unroll
        for (int bj = 0; bj < 2; ++bj)
#pragma unroll
            for (int n = 0; n < 2; ++n) gv[bj][n] = *(const f32x4*)(gt + col0 + bj * 128 + n * 16);
#pragma unroll
        for (int ai = 0; ai < 2; ++ai)
#pragma unroll
            for (int m = 0; m < 4; ++m) { const size_t row = row0 + ai * 128 + m * 16; const float* src = (row < ML) ? xlat + row * 1024 : xctx + (row - ML) * 1024;
#pragma unroll
                for (int bj = 0; bj < 2; ++bj)
#pragma unroll
                    for (int n = 0; n < 2; ++n) { const int col = col0 + bj * 128 + n * 16;
                        *(f32x4*)(X + row * 1024 + col) = *(const f32x4*)(src + col) + gv[bj][n] * acc[ai][bj][m][n]; } }
    }
};
struct EpiGU {
    static constexpr bool PERM = true, AFTER_DRAIN = false, KEEP = false;
    bf16* ACT;
    __device__ __forceinline__ void operator()(const f32x4 (&acc)[2][2][4][2], const Unit& u, int wr, int wc, int fr, int fq) const {
        const int pnl = u.pn & 7, row0 = u.pm * 256 + wr * 64 + fr, cl0 = wc * 32 + 8 * fq;
#pragma unroll
        for (int ai = 0; ai < 2; ++ai)
#pragma unroll
            for (int m = 0; m < 4; ++m) { const size_t row = row0 + ai * 128 + m * 16; f32x4 v[2];
#pragma unroll
                for (int n = 0; n < 2; ++n) { const f32x4 a = acc[ai][0][m][n], up = acc[ai][1][m][n];
#pragma unroll
                    for (int j = 0; j < 4; ++j) v[n][j] = a[j] * sigm(a[j]) * up[j]; }
                st8bf(ACT + row * 1024 + pnl * 128 + cl0, v[0], v[1]); }
    }
};
struct EpiDown {
    static constexpr bool PERM = true, AFTER_DRAIN = false, KEEP = false;
    bf16* YB; const float* GATE;
    __device__ __forceinline__ void operator()(const f32x4 (&acc)[2][2][4][2], const Unit& u, int wr, int wc, int fr, int fq) const {
        const int pnl = u.pn & 3, row0 = u.pm * 256 + wr * 64 + fr, col0 = pnl * 256 + wc * 32 + 8 * fq;
#pragma unroll
        for (int ai = 0; ai < 2; ++ai)
#pragma unroll
            for (int m = 0; m < 4; ++m) { const size_t row = row0 + ai * 128 + m * 16; const float gt = GATE[row];
#pragma unroll
                for (int bj = 0; bj < 2; ++bj) st8bf(YB + row * 1024 + col0 + bj * 128, acc[ai][bj][m][0] * gt, acc[ai][bj][m][1] * gt); }
    }
};
struct MergeOrder {
    int nt, G, c;
    __device__ void init(int ntm, int G_, int c_) { nt = ntm * 4; G = G_; c = c_; }
    __device__ bool next(int i, Unit& u) const { const int b = i & 3, L = (i >> 2) * G + c; if (L >= nt) return false; u.pm = b * 66 + (L >> 2); u.pn = b * 4 + (L & 3); return true; }
    __device__ __forceinline__ void a_ready(const Unit&) const {}
    __device__ __forceinline__ void done(const Unit&) const {}
};
struct OneUnit { int pm, pn; __device__ bool next(int i, Unit& u) const { if (i > 0) return false; u.pm = pm; u.pn = pn; return true; }
    __device__ __forceinline__ void a_ready(const Unit&) const {} __device__ __forceinline__ void done(const Unit&) const {} };
struct GroupOrder {
    int nwg, G, c, TPE, NTN;
    __device__ void init(int tpe, int ntn, int G_, int c_) { TPE = tpe; NTN = ntn; nwg = NE * tpe * ntn; G = G_; c = c_; }
    __device__ bool next(int i, Unit& u) const {
        const long L = (long)i * G + c; if (L >= nwg) return false;
        int wgid = (int)L; { const int q = nwg / 8, r = nwg % 8, xcd = wgid % 8, off = wgid / 8; wgid = (xcd < r ? xcd * (q + 1) : r * (q + 1) + (xcd - r) * q) + off; }
        const int per = TPE * NTN, e = wgid / per, rem = wgid % per;
#ifdef GO_MT_MAJOR
        const int mt = rem / NTN, pn = rem % NTN;
#else
        const int pn = rem / TPE, mt = rem % TPE;
#endif
        u.pm = e * 9 + mt; u.pn = e * NTN + pn; return true;
    }
    __device__ __forceinline__ void a_ready(const Unit&) const {}
    __device__ __forceinline__ void done(const Unit&) const {}
};
typedef float f2v __attribute__((ext_vector_type(2)));
#define PH_ARGS LAS unsigned char* lds, const int tid, const int lane, const int wave, const int bid, const int G
#define WSP(T, off) ((T*)(PTRV(29, unsigned char) + (off)))
constexpr int PTAB_OFF = MISC_OFF + 512;
__device__ __forceinline__ unsigned long long ptab_ld(LAS unsigned char* lds, int i) {
    typedef unsigned u2v_t __attribute__((ext_vector_type(2)));
    const volatile LAS unsigned* tp = (const volatile LAS unsigned*)(lds + PTAB_OFF + 8 * i); u2v_t v; v[0] = tp[0]; v[1] = tp[1];
    const unsigned lo = __builtin_amdgcn_readfirstlane(v[0]), hi = __builtin_amdgcn_readfirstlane(v[1]);
    return ((unsigned long long)hi << 32) | lo;
}
#define PTRV(i, T) ((T*)(GAS T*)ptab_ld(lds, (i)))
#define INP(i) ((const float*)(GAS const float*)ptab_ld(lds, (i)))

__device__ __forceinline__ void mod_gemv(PH_ARGS) {
    LAS f32x4* red = (LAS f32x4*)lds;
    const float* c = INP(1); const float* cc = INP(3); const float* wm = INP(4); const float* bm = INP(5);
    float* MOD = WSP(float, WS_MOD);
    for (int it = bid; it < 192; it += G) {
        const int l = it / 96, cg = it % 96, kg = tid >> 4, cq = tid & 15;
        f32x4 a0 = {0.f, 0.f, 0.f, 0.f}, a1 = a0, a2 = a0;
        const float* wb = wm + (size_t)l * 1024 * 6144 + cg * 64 + cq * 4;
#pragma unroll 4
        for (int i = 0; i < 32; ++i) { const int k = kg + 32 * i; const f32x4 w = *(const f32x4*)(wb + (size_t)k * 6144);
            const float x0 = c[k], x1 = c[1024 + k], x2 = cc[k];
            a0 += w * (x0 * sigm(x0)); a1 += w * (x1 * sigm(x1)); a2 += w * (x2 * sigm(x2)); }
        red[(kg * 3 + 0) * 16 + cq] = a0; red[(kg * 3 + 1) * 16 + cq] = a1; red[(kg * 3 + 2) * 16 + cq] = a2;
        __syncthreads();
        if (tid < 192) { const int r = tid >> 6, col = tid & 63; float s = 0.f; const LAS float* rf = (const LAS float*)red;
            for (int k2 = 0; k2 < 32; ++k2) s += rf[((k2 * 3 + r) * 16 + (col >> 2)) * 4 + (col & 3)];
            MOD[(l * 3 + r) * 6144 + cg * 64 + col] = s + bm[l * 6144 + cg * 64 + col]; }
        __syncthreads();
    }
}
__device__ __forceinline__ void make_tables(PH_ARGS) {
    const int gt = bid * 512 + tid, GT = G * 512;
    float* RC = WSP(float, WS_ROPEC); float* RS = WSP(float, WS_ROPES);
    bf16* T1 = WSP(bf16, WS_T1T);
    for (int i = gt; i < 2048; i += GT) { const int pos = i >> 4, f = i & 15; const float inv = powf(10000.f, -(float)f / 16.f), ang = (float)pos * inv; RC[i] = cosf(ang); RS[i] = sinf(ang); }
    for (int i = gt; i < 128 * 128; i += GT) { const int col = i >> 7, k = i & 127, ro = col >> 6, k1 = col & 63, n1 = k >> 1, ri = k & 1; float s, c; sincospif((float)((k1 * n1) & 63) / 32.f, &s, &c);
        const float v = ro == 0 ? (ri == 0 ? c : s) : (ri == 0 ? -s : c); T1[i] = (bf16)f2bf(v); }
    bf16* T2F = WSP(bf16, WS_T2F); bf16* T2C = WSP(bf16, WS_T2C);
    for (int i = gt; i < 64 * 128 * 256; i += GT) { const int k1 = i >> 15, k2 = (i >> 8) & 127, k = i & 255, n2 = k >> 1, ri = k & 1; float s, c;
        sincospif((float)((n2 * (k1 + 64 * k2)) & 8191) / 4096.f, &s, &c); T2F[i] = (bf16)f2bf(ri ? s : c); }
    for (int i = gt; i < 2 * 128 * 256; i += GT) { const int k1 = i >> 15, k2 = (i >> 8) & 127, k = i & 255, n2 = k >> 1, ri = k & 1; float s, c;
        sincospif((float)((n2 * (k1 + 2 * k2)) & 255) / 128.f, &s, &c); T2C[i] = (bf16)f2bf(ri ? s : c); }
}
__device__ __forceinline__ void tr_item(const float* W, size_t ldw, int col0, int k0, bf16* dst, int Kd, LAS float* scr, int lane) {
#pragma unroll 8
    for (int i = 0; i < 32; ++i) { const int kk = 2 * i + (lane >> 5); scr[kk * 33 + (lane & 31)] = W[(size_t)(k0 + kk) * ldw + col0 + (lane & 31)]; }
    LDS_WAIT(); asm volatile("" ::: "memory");
    const int c = lane & 7;
#pragma unroll
    for (int j = 0; j < 4; ++j) { const int n = (lane >> 3) + 8 * j; const LAS float* s = scr + (8 * c) * 33 + n;
        v4u o; o.x = pk2(s[0 * 33], s[1 * 33]); o.y = pk2(s[2 * 33], s[3 * 33]); o.z = pk2(s[4 * 33], s[5 * 33]); o.w = pk2(s[6 * 33], s[7 * 33]);
        *(v4u*)(dst + (size_t)n * Kd + k0 + 8 * c) = o; }
    LDS_WAIT(); asm volatile("" ::: "memory");
}
__device__ __forceinline__ int rho32(int c) { return 16 * ((c >> 2) & 1) + 4 * (c >> 3) + (c & 3); }
__device__ __forceinline__ void fold_item16(const float* W  , int f, bf16* WIN, LAS float* scr, const LAS f2v* tab, int lane) {
    const int kb = f >> 2, g = f & 3, k0 = kb * 16;
#pragma unroll
    for (int kk = 0; kk < 16; ++kk) scr[kk * 64 + lane] = W[(size_t)(k0 + kk) * 6144 + 512 + g * 64 + lane];
    LDS_WAIT(); asm volatile("" ::: "memory");
    float ar[16], ai[16];
#pragma unroll
    for (int kk = 0; kk < 16; ++kk) { ar[kk] = 0.f; ai[kk] = 0.f; }
#pragma unroll 4
    for (int c = 0; c < 64; ++c) { const f2v t = tab[(c * lane) & 63];
#pragma unroll
        for (int kk = 0; kk < 16; ++kk) { const float w = scr[kk * 64 + c]; ar[kk] += w * t[0]; ai[kk] -= w * t[1]; } }
    const int L0 = 2 * (g * 64 + lane);
    bf16* d0 = WIN + (size_t)(512 + (L0 & ~31) + rho32(L0 & 31)) * 1024 + k0; bf16* d1 = WIN + (size_t)(512 + (L0 & ~31) + rho32((L0 + 1) & 31)) * 1024 + k0;
    v4u o, p;
    o.x = pk2(ar[0], ar[1]); o.y = pk2(ar[2], ar[3]); o.z = pk2(ar[4], ar[5]); o.w = pk2(ar[6], ar[7]); p.x = pk2(ar[8], ar[9]); p.y = pk2(ar[10], ar[11]); p.z = pk2(ar[12], ar[13]); p.w = pk2(ar[14], ar[15]);
    *(v4u*)d0 = o; *(v4u*)(d0 + 8) = p;
    o.x = pk2(ai[0], ai[1]); o.y = pk2(ai[2], ai[3]); o.z = pk2(ai[4], ai[5]); o.w = pk2(ai[6], ai[7]); p.x = pk2(ai[8], ai[9]); p.y = pk2(ai[10], ai[11]); p.z = pk2(ai[12], ai[13]); p.w = pk2(ai[14], ai[15]);
    *(v4u*)d1 = o; *(v4u*)(d1 + 8) = p;
    LDS_WAIT(); asm volatile("" ::: "memory");
}
template <bool PERMROWS>
__device__ __forceinline__ void tr_item64(const float* W, size_t ldw, int col0, int k0, bf16* dst, int Kd, int lane) {
    const int kq = lane >> 4, n4 = lane & 15; const float* src = W + (size_t)(k0 + kq * 16) * ldw + col0 + n4 * 4;
    f32x4 v[16];
#pragma unroll
    for (int i = 0; i < 16; ++i) v[i] = *(const f32x4*)(src + (size_t)i * ldw);
#pragma unroll
    for (int j = 0; j < 4; ++j) { const int ns = n4 * 4 + j, nd = PERMROWS ? ((ns & 32) + rho32(ns & 31)) : ns; bf16* d = dst + (size_t)nd * Kd + k0 + kq * 16; v4u o, p;
        o.x = pk2(v[0][j], v[1][j]); o.y = pk2(v[2][j], v[3][j]); o.z = pk2(v[4][j], v[5][j]); o.w = pk2(v[6][j], v[7][j]);
        p.x = pk2(v[8][j], v[9][j]); p.y = pk2(v[10][j], v[11][j]); p.z = pk2(v[12][j], v[13][j]); p.w = pk2(v[14][j], v[15][j]);
        *(v4u*)d = o; *(v4u*)(d + 8) = p; }
}
__device__ __forceinline__ void convert_range(PH_ARGS, const int l, const int it_lo, const int it_hi, const int pidx, const int pcount) {
    if (pidx < 0) return;
    LAS float* scr = (LAS float*)(lds + wave * 16384);
    const int gw = pidx * 8 + wave, NGW = pcount * 8;
    bf16* WIN = WSP(bf16, WS_WIN); bf16* WBR = WSP(bf16, WS_WBR); bf16* WO = WSP(bf16, WS_WO); bf16* WGU = WSP(bf16, WS_WGU); bf16* WDN = WSP(bf16, WS_WDN); bf16* WS_ = WSP(bf16, WS_WSP);
    const float* win = INP(8) + (size_t)l * 1024 * 6144;
    LAS f2v* tab = (LAS f2v*)(scr + 2048); { float s_, c_; sincospif((float)lane / 32.f, &s_, &c_); tab[lane] = (f2v){c_, s_}; } LDS_WAIT(); asm volatile("" ::: "memory");
    constexpr int N_FOLD = 256, N_IN = 92 * 16, N_BR = 256, N_WO = 256, N_GU = 8192, N_DN = 4096, N_SP = 64;
    constexpr int NITEMS = N_FOLD + N_IN + N_BR + N_WO + N_GU + N_DN + N_SP;
    for (int it = it_lo + gw; it < it_hi && it < NITEMS; it += NGW) {
        int r = it;
        if (r < N_FOLD) { fold_item16(win, r, WIN, scr, tab, lane); continue; } r -= N_FOLD;
        if (r < N_IN) { const int dbp = r >> 4, kb = r & 15, db = dbp < 8 ? dbp : dbp + 8; int col;
            if (db < 8) col = db * 64;
            else if (db < 24) { const int t = db - 16, tile = t >> 2, sub = t & 3; col = (sub < 2 ? 768 : 1024) + tile * 128 + (sub & 1) * 64; }
            else if (db < 36) col = 1280 + (db - 24) * 64;
            else col = 2048 + (db - 36) * 64;
            if (db < 24 || (db >= 32 && db < 36)) tr_item64<true>(win, 6144, col, kb * 64, WIN + (size_t)db * 64 * 1024, 1024, lane);
            else tr_item64<false>(win, 6144, col, kb * 64, WIN + (size_t)db * 64 * 1024, 1024, lane);
            continue; } r -= N_IN;
        if (r < N_BR) { const int b = r >> 6, q = r & 63, kb = q >> 4, nb = q & 15; const int ii = b == 0 ? 13 : (b == 1 ? 14 : (b == 2 ? 19 : 21));
            tr_item64<false>(INP(ii) + (size_t)l * 256 * 1024, 1024, nb * 64, kb * 64, WBR + (size_t)(b * 1024 + nb * 64) * 256, 256, lane); continue; } r -= N_BR;
        if (r < N_WO) { const int kb = r >> 4, nb = r & 15; tr_item64<false>(INP(22) + (size_t)l * 1024 * 1024, 1024, nb * 64, kb * 64, WO + (size_t)nb * 64 * 1024, 1024, lane); continue; } r -= N_WO;
        if (r < N_GU) { const int e = r >> 9, q = r & 511, db = q >> 4, kb = q & 15, tile = db >> 2, sub = db & 3;
            const float* src = (sub < 2 ? INP(24) : INP(25)) + (size_t)(l * 16 + e) * 1024 * 1024;
            tr_item64<false>(src, 1024, tile * 128 + (sub & 1) * 64, kb * 64, WGU + ((size_t)e * 2048 + db * 64) * 1024, 1024, lane); continue; } r -= N_GU;
        if (r < N_DN) { const int e = r >> 8, q = r & 255, kb = q >> 4, nb = q & 15;
            tr_item64<false>(INP(26) + (size_t)(l * 16 + e) * 1024 * 1024, 1024, nb * 64, kb * 64, WDN + ((size_t)e * 1024 + nb * 64) * 1024, 1024, lane); continue; } r -= N_DN;
        { const float* s = INP(11) + (size_t)l * 65536 + r * 1024 + lane * 16; const f32x4 a = *(const f32x4*)s, b = *(const f32x4*)(s + 4), c = *(const f32x4*)(s + 8), d = *(const f32x4*)(s + 12);
          v4u o, p; o.x = pk2(a[0], a[1]); o.y = pk2(a[2], a[3]); o.z = pk2(b[0], b[1]); o.w = pk2(b[2], b[3]); p.x = pk2(c[0], c[1]); p.y = pk2(c[2], c[3]); p.z = pk2(d[0], d[1]); p.w = pk2(d[2], d[3]);
          *(v4u*)(WS_ + r * 1024 + lane * 16) = o; *(v4u*)(WS_ + r * 1024 + lane * 16 + 8) = p; }
    }
}
constexpr int CV_FOLD0 = 0, CV_IN0 = 256, CV_BR0 = 256 + 92 * 16, CV_WO0 = CV_BR0 + 256, CV_GU0 = CV_WO0 + 256, CV_DN0 = CV_GU0 + 8192, CV_SP0 = CV_DN0 + 4096, CV_END = CV_SP0 + 64;
__device__ __forceinline__ void convert_weights(PH_ARGS, const int l) { convert_range(lds, tid, lane, wave, bid, G, l, 0, CV_END, bid, G); }
__device__ __forceinline__ void load_row(const float* p, int lane, f32x4 (&v)[4]) {
#pragma unroll
    for (int j = 0; j < 4; ++j) v[j] = *(const f32x4*)(p + 4 * lane + 256 * j);
}
__device__ __forceinline__ void modnorm_store(f32x4 (&v)[4], const float* g, const float* sc, const float* sh, bf16* hrow, int lane) {
    float ss = 0.f;
#pragma unroll
    for (int j = 0; j < 4; ++j) ss += (v[j][0] * v[j][0] + v[j][1] * v[j][1]) + (v[j][2] * v[j][2] + v[j][3] * v[j][3]);
    const float rs = 1.0f / sqrtf(wave_sum(ss) * (1.f / 1024.f) + 1e-6f);
#pragma unroll
    for (int j = 0; j < 4; ++j) { const int o = 4 * lane + 256 * j; const f32x4 gg = *(const f32x4*)(g + o), s = *(const f32x4*)(sc + o), b = *(const f32x4*)(sh + o);
        v[j] = v[j] * rs * gg * (s + 1.f) + b; st4bf(hrow + o, v[j]); }
}
__device__ __forceinline__ void modnorm_regs(f32x4 (&v)[4], const f32x4 (&gm)[4], const f32x4 (&sh)[4], bf16* hrow, int lane) {
    float ss = 0.f;
#pragma unroll
    for (int j = 0; j < 4; ++j) ss += (v[j][0] * v[j][0] + v[j][1] * v[j][1]) + (v[j][2] * v[j][2] + v[j][3] * v[j][3]);
    const float rs = 1.0f / sqrtf(wave_sum(ss) * (1.f / 1024.f) + 1e-6f);
#pragma unroll
    for (int j = 0; j < 4; ++j) { v[j] = v[j] * rs * gm[j] + sh[j]; st4bf(hrow + 4 * lane + 256 * j, v[j]); }
}
__device__ __forceinline__ void load_mod(const float* g, const float* sc, const float* shp, int lane, f32x4 (&gm)[4], f32x4 (&sh)[4]) {
#pragma unroll
    for (int j = 0; j < 4; ++j) { const int o = 4 * lane + 256 * j; gm[j] = *(const f32x4*)(g + o) * (*(const f32x4*)(sc + o) + 1.f); sh[j] = *(const f32x4*)(shp + o); }
}
__device__ __forceinline__ void norm1_l0(PH_ARGS) {
    const int gw = bid * 8 + wave, NGW = G * 8; bf16* H = WSP(bf16, WS_H); const float* MOD = WSP(float, WS_MOD);
    const int RPW = (MT + NGW - 1) / NGW, row0 = gw * RPW, rend = (row0 + RPW < MT) ? row0 + RPW : MT;
    const float* xin = INP(0); const float* cin = INP(2); const float* g = INP(6);
    f32x4 cur[4], nxt[4], gm[4], sh[4]; int rprev = -1;
    if (row0 < rend) load_row(row0 < ML ? xin + (size_t)row0 * 1024 : cin + (size_t)(row0 - ML) * 1024, lane, cur);
    for (int row = row0; row < rend; ++row) {
        if (row + 1 < rend) { const int rn = row + 1; load_row(rn < ML ? xin + (size_t)rn * 1024 : cin + (size_t)(rn - ML) * 1024, lane, nxt); }
        const int r = row < SEQ ? 0 : (row < ML ? 1 : 2);
        if (r != rprev) { const float* md = MOD + r * 6144; load_mod(g, md + 1024, md, lane, gm, sh); rprev = r; }
        modnorm_regs(cur, gm, sh, H + (size_t)row * 1024, lane);
#pragma unroll
        for (int j = 0; j < 4; ++j) cur[j] = nxt[j];
    }
}
__device__ __forceinline__ void norm2_router(PH_ARGS, const int l, const int rbase, const int nrows, const int pidx, const int pcount, const bool load_table = true) {
    const int gw = pidx * 8 + wave, NGW = pcount * 8; bf16* H = WSP(bf16, WS_H); const float* MOD = WSP(float, WS_MOD) + l * 3 * 6144; const float* X = WSP(float, WS_X); float* AFF = WSP(float, WS_AFF);
    LAS f32x4* Wl = (LAS f32x4*)lds;
    if (load_table) { const f32x4* wr = (const f32x4*)(INP(23) + (size_t)l * 1024 * 16);
      for (int i = tid; i < 4096; i += 512) { const int k = i >> 2, q = i & 3; Wl[(q * 4 + (k & 3)) * 256 + (k >> 2)] = wr[i]; } }
    __syncthreads();
    const int RPW = (nrows + NGW - 1) / NGW, row0 = rbase + gw * RPW, rend = (gw * RPW + RPW < nrows) ? row0 + RPW : rbase + nrows;
    const float* g2 = INP(7) + l * 1024;
    f32x4 v[4], nxt[4], gm[4], sh[4]; int rprev = -1;
    if (row0 < rend) load_row(X + (size_t)row0 * 1024, lane, v);
    for (int row = row0; row < rend; ++row) {
        if (row + 1 < rend) load_row(X + (size_t)(row + 1) * 1024, lane, nxt);
        const int r = row < SEQ ? 0 : (row < ML ? 1 : 2);
        if (r != rprev) { const float* md = MOD + r * 6144; load_mod(g2, md + 4 * 1024, md + 3 * 1024, lane, gm, sh); rprev = r; }
        modnorm_regs(v, gm, sh, H + (size_t)row * 1024, lane);
        float lg[16];
#pragma unroll
        for (int e = 0; e < 16; ++e) lg[e] = 0.f;
#pragma unroll
        for (int j = 0; j < 4; ++j)
#pragma unroll
            for (int i = 0; i < 4; ++i) { const float hv = v[j][i];
#pragma unroll
                for (int q = 0; q < 4; ++q) { const f32x4 w = Wl[(q * 4 + i) * 256 + 64 * j + lane]; lg[4 * q + 0] += hv * w[0]; lg[4 * q + 1] += hv * w[1]; lg[4 * q + 2] += hv * w[2]; lg[4 * q + 3] += hv * w[3]; }
                if (i & 1) asm volatile("" ::: "memory"); }
#pragma unroll
        for (int i = 0; i < 8; ++i) { const bool up = lane & 32; const float send = up ? lg[i] : lg[i + 8], keep = up ? lg[i + 8] : lg[i]; lg[i] = keep + __shfl_xor(send, 32); }
#pragma unroll
        for (int i = 0; i < 4; ++i) { const bool up = lane & 16; const float send = up ? lg[i] : lg[i + 4], keep = up ? lg[i + 4] : lg[i]; lg[i] = keep + __shfl_xor(send, 16); }
#pragma unroll
        for (int i = 0; i < 2; ++i) { const bool up = lane & 8; const float send = up ? lg[i] : lg[i + 2], keep = up ? lg[i + 2] : lg[i]; lg[i] = keep + __shfl_xor(send, 8); }
        { const bool up = lane & 4; const float send = up ? lg[0] : lg[1], keep = up ? lg[1] : lg[0]; lg[0] = keep + __shfl_xor(send, 4); }
        float z = lg[0]; z += __shfl_xor(z, 1); z += __shfl_xor(z, 2);
        float mx = z; mx = fmaxf(mx, __shfl_xor(mx, 4)); mx = fmaxf(mx, __shfl_xor(mx, 8)); mx = fmaxf(mx, __shfl_xor(mx, 16)); mx = fmaxf(mx, __shfl_xor(mx, 32));
        const float ez = expf(z - mx); float sm = ez; sm += __shfl_xor(sm, 4); sm += __shfl_xor(sm, 8); sm += __shfl_xor(sm, 16); sm += __shfl_xor(sm, 32);
        if ((lane & 3) == 0) { const int e = ((lane >> 5) & 1) * 8 + ((lane >> 4) & 1) * 4 + ((lane >> 3) & 1) * 2 + ((lane >> 2) & 1); AFF[(size_t)row * 16 + e] = ez / sm; }
#pragma unroll
        for (int j = 0; j < 4; ++j) v[j] = nxt[j];
    }
    __syncthreads();
}
typedef short v4i16_t __attribute__((ext_vector_type(4)));
__device__ __forceinline__ void mfma16(f32x4& acc, const bf16x8 a, const bf16x8 b) { asm volatile("s_nop 1\n\tv_mfma_f32_16x16x32_bf16 %0, %1, %2, %0\n\ts_nop 3" : "+v"(acc) : "v"(a), "v"(b)); }
__device__ __forceinline__ void mfma16n(f32x4& acc, const bf16x8 a, const bf16x8 b) { asm volatile("v_mfma_f32_16x16x32_bf16 %0, %1, %2, %0" : "+v"(acc) : "v"(a), "v"(b)); }
#define DRAIN4(x) asm volatile("s_nop 15\n\ts_nop 15" : "+v"((x)[0]), "+v"((x)[1]), "+v"((x)[2]), "+v"((x)[3]))
#define DRAIN8(x) asm volatile("s_nop 15\n\ts_nop 15" : "+v"((x)[0]), "+v"((x)[1]), "+v"((x)[2]), "+v"((x)[3]), "+v"((x)[4]), "+v"((x)[5]), "+v"((x)[6]), "+v"((x)[7]))
#define DRAIN16(x) asm volatile("s_nop 15\n\ts_nop 15" : "+v"((x)[0]), "+v"((x)[1]), "+v"((x)[2]), "+v"((x)[3]), "+v"((x)[4]), "+v"((x)[5]), "+v"((x)[6]), "+v"((x)[7]), \
    "+v"((x)[8]), "+v"((x)[9]), "+v"((x)[10]), "+v"((x)[11]), "+v"((x)[12]), "+v"((x)[13]), "+v"((x)[14]), "+v"((x)[15]))
__device__ __forceinline__ void gmlp_unit(PH_ARGS, const int l, const int chunk) {
    const int row0 = chunk < 128 ? chunk * 128 : ML + (chunk - 128) * 128;
    const bf16* AUV = WSP(bf16, WS_AUV); bf16* BRa = WSP(bf16, WS_BR); const bf16* WS_ = WSP(bf16, WS_WSP);
    LAS bf16* vT = (LAS bf16*)lds;
    const float* lg = INP(9) + l * 256; const float* lb = INP(10) + l * 256;
    const f32x4 gg = *(const f32x4*)(lg + 4 * lane), bb = *(const f32x4*)(lb + 4 * lane);
    uint2 raws[16];
#pragma unroll
    for (int pi = 0; pi < 16; ++pi) raws[pi] = *(const uint2*)(AUV + (size_t)(row0 + wave * 16 + pi) * 512 + 256 + 4 * lane);
#pragma unroll
    for (int pi = 0; pi < 16; ++pi) { const int p = wave * 16 + pi;
        const uint2 raw = raws[pi];
        float v0 = bflo(raw.x), v1 = bfhi(raw.x), v2 = bflo(raw.y), v3 = bfhi(raw.y);
        const float mean = wave_sum((v0 + v1) + (v2 + v3)) * (1.f / 256.f); v0 -= mean; v1 -= mean; v2 -= mean; v3 -= mean;
        const float rstd = 1.0f / sqrtf(wave_sum((v0 * v0 + v1 * v1) + (v2 * v2 + v3 * v3)) * (1.f / 256.f) + 1e-6f);
        vT[(4 * lane + 0) * 136 + p] = (bf16)f2bf(v0 * rstd * gg[0] + bb[0]); vT[(4 * lane + 1) * 136 + p] = (bf16)f2bf(v1 * rstd * gg[1] + bb[1]);
        vT[(4 * lane + 2) * 136 + p] = (bf16)f2bf(v2 * rstd * gg[2] + bb[2]); vT[(4 * lane + 3) * 136 + p] = (bf16)f2bf(v3 * rstd * gg[3] + bb[3]); }
    __syncthreads();
    const int g = wave >> 1, qh = wave & 1, fr = lane & 15, fq = lane >> 4;
    f32x4 acc[4][4];
#pragma unroll
    for (int a = 0; a < 4; ++a)
#pragma unroll
        for (int b = 0; b < 4; ++b) acc[a][b] = (f32x4){0.f, 0.f, 0.f, 0.f};
    const bf16* Wg = WS_ + g * 16384;
#pragma unroll
    for (int ks = 0; ks < 4; ++ks) { bf16x8 af[4], bf[4];
#pragma unroll
        for (int dt = 0; dt < 4; ++dt) af[dt] = *(const LAS bf16x8*)(vT + (g * 64 + dt * 16 + fr) * 136 + ks * 32 + fq * 8);
#pragma unroll
        for (int qt = 0; qt < 4; ++qt) bf[qt] = *(const bf16x8*)(Wg + (qh * 64 + qt * 16 + fr) * 128 + ks * 32 + fq * 8);
#pragma unroll
        for (int dt = 0; dt < 4; ++dt)
#pragma unroll
            for (int qt = 0; qt < 4; ++qt) mfma16(acc[dt][qt], af[dt], bf[qt]); }
    DRAIN16(&acc[0][0]);
    const float* bs = INP(12) + l * 512 + g * 128;
#pragma unroll
    for (int qt = 0; qt < 4; ++qt) { const int q = qh * 64 + qt * 16 + fr; const float bias = bs[q]; const size_t row = row0 + q;
#pragma unroll
        for (int dt = 0; dt < 4; ++dt) { const int ch = g * 64 + dt * 16 + 4 * fq; const uint2 uw = *(const uint2*)(AUV + row * 512 + ch);
            f32x4 o; o[0] = bflo(uw.x) * (acc[dt][qt][0] + bias); o[1] = bfhi(uw.x) * (acc[dt][qt][1] + bias); o[2] = bflo(uw.y) * (acc[dt][qt][2] + bias); o[3] = bfhi(uw.y) * (acc[dt][qt][3] + bias);
            st4bf(BRa + row * 256 + ch, o); } }
    __syncthreads();
}
__device__ __forceinline__ void conv_unit(PH_ARGS, const int l, const int unit) {
    int rowbase, n0, nlen;
    if (unit < 256) { rowbase = (unit >> 7) * SEQ; n0 = (unit & 127) * 64; nlen = SEQ; } else { const int u2 = unit - 256; rowbase = ML + (u2 >> 2) * CTXL; n0 = (u2 & 3) * 64; nlen = CTXL; }
    const bf16* CY = WSP(bf16, WS_CY); bf16* BRc = WSP(bf16, WS_BR) + (size_t)2 * MT * 256;
    LAS unsigned* yt = (LAS unsigned*)lds;
    LAS float* cres = (LAS float*)(lds + 48128);
    for (int p = tid; p < 94 * 32; p += 512) { const int rr = p >> 5, seg = p & 31, n = n0 - 15 + rr; v4u val = {0u, 0u, 0u, 0u};
        if (n >= 0 && n < nlen) val = *(const v4u*)(CY + (size_t)(rowbase + n) * 256 + seg * 8);
        *(LAS v4u*)(lds + rr * 512 + seg * 16) = val; }
    __syncthreads();
    const int cp = tid & 127, pg = tid >> 7;
    float w0[31], w1[31];
    const float* cw = INP(15) + (size_t)l * 31 * 256 + 2 * cp;
#pragma unroll
    for (int t = 0; t < 31; ++t) { const float2 w = *(const float2*)(cw + t * 256); w0[t] = w.x; w1[t] = w.y; }
    float a0[16], a1[16];
#pragma unroll
    for (int p = 0; p < 16; ++p) { a0[p] = 0.f; a1[p] = 0.f; }
#pragma unroll
    for (int i = 0; i < 46; ++i) { const unsigned raw = yt[(16 * pg + i) * 128 + cp]; const float v0 = bflo(raw), v1 = bfhi(raw);
#pragma unroll
        for (int p = 0; p < 16; ++p) { const int t = i - p; if (t >= 0 && t < 31) { a0[p] += v0 * w0[t]; a1[p] += v1 * w1[t]; } } }
    const float2 cb = *(const float2*)(INP(16) + l * 256 + 2 * cp);
#pragma unroll
    for (int p = 0; p < 16; ++p) *(LAS f2v*)(cres + (16 * pg + p) * 256 + 2 * cp) = (f2v){a0[p] + cb.x, a1[p] + cb.y};
    __syncthreads();
    const f32x4 gg = *(const f32x4*)(INP(17) + l * 256 + 4 * lane), bb = *(const f32x4*)(INP(18) + l * 256 + 4 * lane);
    for (int pi = 0; pi < 8; ++pi) { const int pos = wave * 8 + pi; f32x4 v = *(const LAS f32x4*)(cres + pos * 256 + 4 * lane);
        const float mean = wave_sum((v[0] + v[1]) + (v[2] + v[3])) * (1.f / 256.f); v = v - mean;
        const float rstd = 1.0f / sqrtf(wave_sum((v[0] * v[0] + v[1] * v[1]) + (v[2] * v[2] + v[3] * v[3])) * (1.f / 256.f) + 1e-6f);
        f32x4 o;
#pragma unroll
        for (int j = 0; j < 4; ++j) { const float y = v[j] * rstd * gg[j] + bb[j]; o[j] = y * sigm(y); }
        st4bf(BRc + (size_t)(rowbase + n0 + pos) * 256 + 4 * lane, o); }
    __syncthreads();
}
constexpr int F1_T1L = 0, F1_YL = 34816;
__device__ __forceinline__ void f1_stage_tables(PH_ARGS) {
    const bf16* T1 = WSP(bf16, WS_T1T);
    for (int p = tid; p < 128 * 16; p += 512) { const int r = p >> 4, s = p & 15; *(LAS v4u*)(lds + F1_T1L + r * 272 + s * 16) = *(const v4u*)(T1 + r * 128 + s * 8); }
    __syncthreads();
}
__device__ __forceinline__ void f1_unit(PH_ARGS, const int unit) {
    const int b = unit >> 7, n2 = unit & 127, fr = lane & 15, fq = lane >> 4;
    const bf16* YF = WSP(bf16, WS_YF); bf16* FA = WSP(bf16, WS_FA);
    LAS unsigned* Yl = (LAS unsigned*)(lds + F1_YL);
#pragma unroll
    for (int i = 0; i < 8; ++i) { const int n1 = wave + 8 * i; *(LAS v4u*)(Yl + n1 * 260 + lane * 4) = *(const v4u*)(YF + (size_t)(b * SEQ + 128 * n1 + n2) * 512 + lane * 8); }
    __syncthreads();
    f32x4 acc[2][8];
#pragma unroll
    for (int a = 0; a < 2; ++a)
#pragma unroll
        for (int n = 0; n < 8; ++n) acc[a][n] = (f32x4){0.f, 0.f, 0.f, 0.f};
#pragma unroll
    for (int ks = 0; ks < 4; ++ks) { bf16x8 af[2];
#pragma unroll
        for (int c2 = 0; c2 < 2; ++c2) { const int ch = (2 * wave + c2) * 16 + fr; v4u w;
            w.x = Yl[(16 * ks + 4 * fq + 0) * 260 + ch]; w.y = Yl[(16 * ks + 4 * fq + 1) * 260 + ch]; w.z = Yl[(16 * ks + 4 * fq + 2) * 260 + ch]; w.w = Yl[(16 * ks + 4 * fq + 3) * 260 + ch];
            af[c2] = __builtin_bit_cast(bf16x8, w); }
#pragma unroll
        for (int nt = 0; nt < 8; ++nt) { const bf16x8 bfr = *(const LAS bf16x8*)(lds + F1_T1L + (nt * 16 + fr) * 272 + ks * 64 + fq * 16);
            mfma16(acc[0][nt], af[0], bfr); mfma16(acc[1][nt], af[1], bfr); } }
    DRAIN16(&acc[0][0]);
#pragma unroll
    for (int c2 = 0; c2 < 2; ++c2)
#pragma unroll
        for (int kt = 0; kt < 4; ++kt) { const int k1 = kt * 16 + fr; const f32x4 ar = acc[c2][kt], ai = acc[c2][kt + 4];
            v4u o; o.x = pk2(ar[0], ai[0]); o.y = pk2(ar[1], ai[1]); o.z = pk2(ar[2], ai[2]); o.w = pk2(ar[3], ai[3]);
            *(v4u*)(FA + ((size_t)((b * 64 + k1) * 128 + n2) * 256 + (2 * wave + c2) * 16 + 4 * fq) * 2) = o; }
    __syncthreads();
}
constexpr int F2_T2L = 0, F2_AL = 67584;
__device__ __forceinline__ void f2_unit(PH_ARGS, const int unit) {
    const int fr = lane & 15, fq = lane >> 4; const bool lat = unit < 256;
    int b, k1, chh; const bf16* Asrc; const bf16* Tsrc; size_t orow0; int ostr; float scl;
    if (lat) { b = unit >> 7; k1 = (unit >> 1) & 63; chh = unit & 1; Asrc = WSP(bf16, WS_FA) + (size_t)((b * 64 + k1) * 128) * 512; Tsrc = WSP(bf16, WS_T2F) + (size_t)k1 * 32768; orow0 = (size_t)b * SEQ + k1; ostr = 64; scl = 0.0013810679320049757f; }
    else { const int u2 = unit - 256; b = u2 >> 2; k1 = (u2 >> 1) & 1; chh = u2 & 1; Asrc = WSP(bf16, WS_FAC) + (size_t)((b * 2 + k1) * 128) * 512; Tsrc = WSP(bf16, WS_T2C) + (size_t)k1 * 32768; orow0 = (size_t)ML + b * CTXL + k1; ostr = 2; scl = 1.f / 128.f; }
    bf16* BRb = WSP(bf16, WS_BR) + (size_t)1 * MT * 256;
    LAS unsigned* Al = (LAS unsigned*)(lds + F2_AL);
    for (int p = tid; p < 128 * 32; p += 512) { const int r = p >> 5, s = p & 31; *(LAS v4u*)(lds + F2_T2L + r * 528 + s * 16) = *(const v4u*)(Tsrc + r * 256 + s * 8); }
#pragma unroll
    for (int i = 0; i < 8; ++i) { const int n2 = wave * 16 + 2 * i + (lane >> 5);
        *(LAS v4u*)(Al + n2 * 132 + (lane & 31) * 4) = *(const v4u*)(Asrc + ((size_t)n2 * 256 + chh * 128) * 2 + (lane & 31) * 8); }
    __syncthreads();
    f32x4 acc[8];
#pragma unroll
    for (int n = 0; n < 8; ++n) acc[n] = (f32x4){0.f, 0.f, 0.f, 0.f};
    const int ch = wave * 16 + fr;
#pragma unroll
    for (int ks = 0; ks < 8; ++ks) { v4u w;
        w.x = Al[(16 * ks + 4 * fq + 0) * 132 + ch]; w.y = Al[(16 * ks + 4 * fq + 1) * 132 + ch]; w.z = Al[(16 * ks + 4 * fq + 2) * 132 + ch]; w.w = Al[(16 * ks + 4 * fq + 3) * 132 + ch];
        const bf16x8 af = __builtin_bit_cast(bf16x8, w);
#pragma unroll
        for (int nt = 0; nt < 8; ++nt) { const bf16x8 bfr = *(const LAS bf16x8*)(lds + F2_T2L + (nt * 16 + fr) * 528 + ks * 64 + fq * 16); mfma16(acc[nt], af, bfr); } }
    DRAIN8(acc);
#pragma unroll
    for (int nt = 0; nt < 8; ++nt) { const int k2 = nt * 16 + fr; st4bf(BRb + (orow0 + (size_t)ostr * k2) * 256 + chh * 128 + wave * 16 + 4 * fq, acc[nt] * scl); }
    __syncthreads();
}
__device__ __forceinline__ void ctx_butterfly(PH_ARGS) {
    const unsigned* YF = (const unsigned*)WSP(bf16, WS_YF); unsigned* FAC = (unsigned*)WSP(bf16, WS_FAC);
    for (int i = bid * 512 + tid; i < 2 * 128 * 256; i += G * 512) { const int b = i >> 15, n2 = (i >> 8) & 127, ch = i & 255;
        const unsigned y0 = YF[(size_t)(ML + b * CTXL + n2) * 256 + ch], y1 = YF[(size_t)(ML + b * CTXL + 128 + n2) * 256 + ch];
        const float r0 = bflo(y0), i0 = bfhi(y0), r1 = bflo(y1), i1 = bfhi(y1);
        FAC[(size_t)((b * 2 + 0) * 128 + n2) * 256 + ch] = pk2(r0 + r1, i0 + i1); FAC[(size_t)((b * 2 + 1) * 128 + n2) * 256 + ch] = pk2(r0 - r1, i0 - i1); }
}
constexpr int MG_AL = 0, MG_BL = 67584;
__device__ __forceinline__ void merge_phase(PH_ARGS, const int nunits) {
    const int fr = lane & 15, fq = lane >> 4, wr = wave >> 2, wc = wave & 3;
    const bf16* BR = WSP(bf16, WS_BR); const bf16* WBR = WSP(bf16, WS_WBR); const bf16* GT = WSP(bf16, WS_G); bf16* MB = WSP(bf16, WS_MB);
    int nmine = 0; for (int u = bid; u < nunits; u += G) ++nmine;
    const int nsteps = nmine * 4;
    if (nsteps == 0) return;
    v4u pa[8], pb[8];
#define MG_LOAD(s) do { const int u_ = bid + ((s) >> 2) * G, b_ = (s) & 3, rt_ = u_ >> 3, ct_ = u_ & 7; \
        const bf16* As = BR + ((size_t)b_ * MT + (size_t)rt_ * 128) * 256; const bf16* Bs = WBR + ((size_t)b_ * 1024 + (size_t)ct_ * 128) * 256; \
        _Pragma("unroll") for (int i = 0; i < 8; ++i) { const int p = i * 512 + tid, r = p >> 5, seg = p & 31; pa[i] = *(const v4u*)(As + (size_t)r * 256 + seg * 8); pb[i] = *(const v4u*)(Bs + (size_t)r * 256 + seg * 8); } } while (0)
#define MG_WRITE() do { _Pragma("unroll") for (int i = 0; i < 8; ++i) { const int p = i * 512 + tid, r = p >> 5, seg = p & 31; \
        *(LAS v4u*)(lds + MG_AL + r * 528 + seg * 16) = pa[i]; *(LAS v4u*)(lds + MG_BL + r * 528 + seg * 16) = pb[i]; } } while (0)
    MG_LOAD(0); MG_WRITE();
    f32x4 macc[4][2];
#pragma unroll
    for (int a = 0; a < 4; ++a)
#pragma unroll
        for (int n = 0; n < 2; ++n) macc[a][n] = (f32x4){0.f, 0.f, 0.f, 0.f};
#pragma unroll 1
    for (int s = 0; s < nsteps; ++s) {
        const int u = bid + (s >> 2) * G, b = s & 3, rt = u >> 3, ct = u & 7;
        __syncthreads();
        if (s + 1 < nsteps) MG_LOAD(s + 1);
        uint2 gw[4][2];
#pragma unroll
        for (int mt = 0; mt < 4; ++mt)
#pragma unroll
            for (int nt = 0; nt < 2; ++nt) gw[mt][nt] = *(const uint2*)(GT + ((((size_t)(u * 4 + b) * 8 + wave) * 8 + mt * 2 + nt) * 256 + lane * 4));
        f32x4 acc[4][2];
#pragma unroll
        for (int a = 0; a < 4; ++a)
#pragma unroll
            for (int n = 0; n < 2; ++n) acc[a][n] = (f32x4){0.f, 0.f, 0.f, 0.f};
        asm volatile("s_nop 1" : "+v"(acc[0][0]), "+v"(acc[0][1]), "+v"(acc[1][0]), "+v"(acc[1][1]), "+v"(acc[2][0]), "+v"(acc[2][1]), "+v"(acc[3][0]), "+v"(acc[3][1]));
#pragma unroll
        for (int ks = 0; ks < 8; ++ks) { bf16x8 af[4], bfr[2];
#pragma unroll
            for (int mt = 0; mt < 4; ++mt) af[mt] = *(const LAS bf16x8*)(lds + MG_AL + (wr * 64 + mt * 16 + fr) * 528 + ks * 64 + fq * 16);
#pragma unroll
            for (int nt = 0; nt < 2; ++nt) bfr[nt] = *(const LAS bf16x8*)(lds + MG_BL + (wc * 32 + nt * 16 + fr) * 528 + ks * 64 + fq * 16);
#pragma unroll
            for (int mt = 0; mt < 4; ++mt)
#pragma unroll
                for (int nt = 0; nt < 2; ++nt) mfma16n(acc[mt][nt], bfr[nt], af[mt]); }
        DRAIN8(&acc[0][0]);
#pragma unroll
        for (int mt = 0; mt < 4; ++mt)
#pragma unroll
            for (int nt = 0; nt < 2; ++nt) { const uint2 g = gw[mt][nt]; macc[mt][nt][0] += bflo(g.x) * acc[mt][nt][0]; macc[mt][nt][1] += bfhi(g.x) * acc[mt][nt][1]; macc[mt][nt][2] += bflo(g.y) * acc[mt][nt][2]; macc[mt][nt][3] += bfhi(g.y) * acc[mt][nt][3]; }
        __syncthreads();
        if (s + 1 < nsteps) MG_WRITE();
        if (b == 3) {
#pragma unroll
            for (int mt = 0; mt < 4; ++mt)
#pragma unroll
                for (int nt = 0; nt < 2; ++nt) { st4bf(MB + (size_t)(rt * 128 + wr * 64 + mt * 16 + fr) * 1024 + ct * 128 + wc * 32 + nt * 16 + 4 * fq, macc[mt][nt]); macc[mt][nt] = (f32x4){0.f, 0.f, 0.f, 0.f}; }
        }
    }
    __syncthreads();
#undef MG_LOAD
#undef MG_WRITE
}
constexpr int AT_RPB = 32768, AT_MRG = 40960;
__device__ __forceinline__ int clampi(int v, int lo, int hi) { return v < lo ? lo : (v > hi ? hi : v); }
__device__ __forceinline__ bool at_need(int kind, int jb, int t) { return kind == 2 || (kind == 0 ? (jb < 2 || (jb == 2 && t == 1)) : (jb > 1 || (jb == 1 && t == 0))); }
struct AtCtx { const bf16* QPL; const bf16* KR; const bf16* VV; LAS unsigned char* vbuf; const LAS float* rpbl; int h, qh, fr, fq, lane, b, r, kr0, qrow0, nch, nwin; bool lat; unsigned code[2][2][2]; float negb; };
__device__ __forceinline__ unsigned at_keyrow(const AtCtx& X, int ci) { return (ci < X.nwin) ? ((unsigned)X.b * SEQ + (unsigned)(X.kr0 + (ci >> 1)) * 64 + 32 * (ci & 1)) : ((unsigned)ML + X.b * CTXL + 32 * (ci - X.nwin)); }
__device__ __forceinline__ void at_load(const AtCtx& X, int ci, bf16x8 (&kf)[2][2], v4u (&vst)[4]) {
    const unsigned kr = at_keyrow(X, ci);
#pragma unroll
    for (int t = 0; t < 2; ++t)
#pragma unroll
        for (int ks = 0; ks < 2; ++ks) kf[t][ks] = *(const bf16x8*)(X.KR + (unsigned)((kr + 16 * t + X.fr) * 256 + X.h * 64 + ks * 32 + X.fq * 8));
#pragma unroll
    for (int i = 0; i < 4; ++i) { const int p = i * 64 + X.lane, key = p >> 3, seg = p & 7; vst[i] = *(const v4u*)(X.VV + (unsigned)((kr + key) * 256 + X.h * 64 + seg * 8)); }
}
__device__ __forceinline__ void at_chunk(const AtCtx& X, const int ci, bf16x8 (&kf)[2][2], v4u (&vst)[4], bf16x8 (&qf)[2][2], f32x4 (&O)[2][4], float (&m)[2], float (&l)[2]) {
    const int kind = ci < X.nwin ? (ci & 1) : 2, fr = X.fr, fq = X.fq, qh = X.qh;
    if (X.lat && ci == 16) {
#pragma unroll
        for (int j = 0; j < 2; ++j)
#pragma unroll
            for (int ks = 0; ks < 2; ++ks) qf[j][ks] = *(const bf16x8*)(X.QPL + (unsigned)((X.qrow0 + 16 * (2 * qh + j) + fr) * 256 + X.h * 64 + ks * 32 + fq * 8));
        asm volatile("" : "+v"(qf[0][0]), "+v"(qf[0][1]), "+v"(qf[1][0]), "+v"(qf[1][1])); }
#pragma unroll
    for (int i = 0; i < 4; ++i) { const int p = i * 64 + X.lane, key = p >> 3, seg = p & 7; *(LAS v4u*)(X.vbuf + key * 128 + ((((seg >> 1) ^ ((key >> 1) & 3))) << 5) + ((seg & 1) << 4)) = vst[i]; }
    f32x4 S[2][2];
#pragma unroll
    for (int j = 0; j < 2; ++j)
#pragma unroll
        for (int t = 0; t < 2; ++t) S[j][t] = (f32x4){0.f, 0.f, 0.f, 0.f};
    asm volatile("s_nop 1" : "+v"(S[0][0]), "+v"(S[0][1]), "+v"(S[1][0]), "+v"(S[1][1]));
#pragma unroll
    for (int j = 0; j < 2; ++j)
#pragma unroll
        for (int t = 0; t < 2; ++t) { mfma16n(S[j][t], kf[t][0], qf[j][0]); mfma16n(S[j][t], kf[t][1], qf[j][1]); }
    const LAS float* rpbrow = X.rpbl + (kind != 2 ? (X.kr0 + (ci >> 1) - X.r + 7) : 15) * 32;
    float bv[2][2][4];
#pragma unroll
    for (int j = 0; j < 2; ++j)
#pragma unroll
        for (int t = 0; t < 2; ++t) { const unsigned cw = kind == 2 ? 0u : (kind == 0 ? X.code[0][j][t] : X.code[1][j][t]);
#pragma unroll
            for (int rg = 0; rg < 4; ++rg) bv[j][t][rg] = rpbrow[(cw >> (8 * rg)) & 31u]; }
    asm volatile("s_nop 11" : "+v"(S[0][0]), "+v"(S[0][1]), "+v"(S[1][0]), "+v"(S[1][1]));
    if (ci + 3 < X.nch) at_load(X, ci + 3, kf, vst);
    bf16x8 pf[2];
#pragma unroll
    for (int j = 0; j < 2; ++j) {
        float mc = X.negb;
#pragma unroll
        for (int t = 0; t < 2; ++t)
#pragma unroll
            for (int rg = 0; rg < 4; ++rg) { const float s = S[j][t][rg] + bv[j][t][rg]; S[j][t][rg] = s; mc = fmaxf(mc, s); }
        { auto r16 = __builtin_amdgcn_permlane16_swap(__float_as_uint(mc), __float_as_uint(mc), false, false); mc = fmaxf(__uint_as_float(r16[0]), __uint_as_float(r16[1]));
          auto r32 = __builtin_amdgcn_permlane32_swap(__float_as_uint(mc), __float_as_uint(mc), false, false); mc = fmaxf(__uint_as_float(r32[0]), __uint_as_float(r32[1])); }
        const float mnew = fmaxf(m[j], mc), alpha = __builtin_amdgcn_exp2f(m[j] - mnew); m[j] = mnew; float ls = 0.f;
#pragma unroll
        for (int t = 0; t < 2; ++t)
#pragma unroll
            for (int rg = 0; rg < 4; ++rg) { const float p = __builtin_amdgcn_exp2f(S[j][t][rg] - mnew); S[j][t][rg] = p; ls += p; }
        l[j] = l[j] * alpha + ls;
        if (__any(alpha != 1.f)) {
#pragma unroll
            for (int dt = 0; dt < 4; ++dt) O[j][dt] = O[j][dt] * alpha; }
        v4u pw; pw.x = pk2(S[j][0][0], S[j][0][1]); pw.y = pk2(S[j][0][2], S[j][0][3]); pw.z = pk2(S[j][1][0], S[j][1][1]); pw.w = pk2(S[j][1][2], S[j][1][3]);
        pf[j] = __builtin_bit_cast(bf16x8, pw); }
    asm volatile("s_nop 1" : "+v"(pf[0]), "+v"(pf[1]));
#pragma unroll
    for (int dt = 0; dt < 4; ++dt) { v4i16_t t0, t1;
        { const int key = 4 * fq + (fr >> 2); t0 = __builtin_amdgcn_ds_read_tr16_b64_v4i16((LAS v4i16_t*)(X.vbuf + key * 128 + ((dt ^ ((key >> 1) & 3)) << 5) + (fr & 3) * 8)); }
        { const int key = 16 + 4 * fq + (fr >> 2); t1 = __builtin_amdgcn_ds_read_tr16_b64_v4i16((LAS v4i16_t*)(X.vbuf + key * 128 + ((dt ^ ((key >> 1) & 3)) << 5) + (fr & 3) * 8)); }
        const bf16x8 vf = (bf16x8){t0[0], t0[1], t0[2], t0[3], t1[0], t1[1], t1[2], t1[3]};
        mfma16n(O[0][dt], vf, pf[0]); mfma16n(O[1][dt], vf, pf[1]); }
}
__device__ __forceinline__ void attn_unit(PH_ARGS, const int unit) {
    AtCtx X; X.h = wave >> 1; X.qh = wave & 1; X.fr = lane & 15; X.fq = lane >> 4; X.lane = lane;
    X.lat = unit < 256; X.r = 0; X.kr0 = 0;
    if (X.lat) { X.b = unit >> 7; X.r = unit & 127; X.qrow0 = X.b * SEQ + X.r * 64; X.kr0 = clampi(X.r - 4, 0, 120); }
    else { const int u2 = unit - 256; X.b = u2 >> 2; X.qrow0 = ML + X.b * CTXL + (u2 & 3) * 64; }
    X.QPL = WSP(bf16, WS_QPL); const bf16* QROT = WSP(bf16, WS_QROT); X.KR = WSP(bf16, WS_KR); X.VV = WSP(bf16, WS_VV);
    bf16* BRd = WSP(bf16, WS_BR) + (size_t)3 * MT * 256;
    X.vbuf = lds + wave * 4096; X.rpbl = (const LAS float*)(lds + AT_RPB) + X.h * 512;
    X.nch = X.lat ? 24 : 8; X.nwin = X.lat ? 16 : 0;
#pragma unroll
    for (int kd = 0; kd < 2; ++kd)
#pragma unroll
        for (int j = 0; j < 2; ++j)
#pragma unroll
            for (int t = 0; t < 2; ++t) { unsigned cw = 0u; const int jb = 2 * X.qh + j;
#pragma unroll
                for (int rg = 0; rg < 4; ++rg) { const int kcol = 32 * kd + 16 * t + 4 * X.fq + rg, qcol = 16 * jb + X.fr, cst = clampi(qcol - 8, 0, 48); const bool ok = at_need(kd, jb, t) && kcol >= cst && kcol < cst + 16;
                    cw |= (ok ? (unsigned)(clampi(kcol - qcol, -15, 15) + 15) : 31u) << (8 * rg); }
                X.code[kd][j][t] = cw; }
    float m[2], l[2]; f32x4 O[2][4];
    { unsigned u_ = 0xf149f2cau; asm volatile("" : "+s"(u_)); X.negb = __uint_as_float(u_); }
#pragma unroll
    for (int j = 0; j < 2; ++j) { m[j] = X.negb; l[j] = 0.f;
#pragma unroll
        for (int dt = 0; dt < 4; ++dt) O[j][dt] = (f32x4){0.f, 0.f, 0.f, 0.f}; }
    bf16x8 qf[2][2];
    { const bf16* Qs = X.lat ? QROT : X.QPL;
#pragma unroll
      for (int j = 0; j < 2; ++j)
#pragma unroll
          for (int ks = 0; ks < 2; ++ks) qf[j][ks] = *(const bf16x8*)(Qs + (unsigned)((X.qrow0 + 16 * (2 * X.qh + j) + X.fr) * 256 + X.h * 64 + ks * 32 + X.fq * 8));
      asm volatile("" : "+v"(qf[0][0]), "+v"(qf[0][1]), "+v"(qf[1][0]), "+v"(qf[1][1])); }
    bf16x8 kA[2][2], kB[2][2], kC[2][2]; v4u vA[4], vB[4], vC[4];
    at_load(X, 0, kA, vA); at_load(X, 1, kB, vB); at_load(X, 2, kC, vC);
#pragma unroll 1
    for (int ci = 0; ci < X.nch; ci += 3) {
        at_chunk(X, ci, kA, vA, qf, O, m, l);
        if (ci + 1 < X.nch) at_chunk(X, ci + 1, kB, vB, qf, O, m, l);
        if (ci + 2 < X.nch) at_chunk(X, ci + 2, kC, vC, qf, O, m, l);
    }
    asm volatile("s_nop 15" : "+v"(O[0][0]), "+v"(O[0][1]), "+v"(O[0][2]), "+v"(O[0][3]), "+v"(O[1][0]), "+v"(O[1][1]), "+v"(O[1][2]), "+v"(O[1][3]));
#pragma unroll
    for (int j = 0; j < 2; ++j) { l[j] += __shfl_xor(l[j], 16); l[j] += __shfl_xor(l[j], 32); const float inv = 1.f / l[j];
#pragma unroll
        for (int dt = 0; dt < 4; ++dt) st4bf(BRd + (unsigned)((X.qrow0 + 16 * (2 * X.qh + j) + X.fr) * 256 + X.h * 64 + dt * 16 + 4 * X.fq), O[j][dt] * inv); }
}
#ifndef CDFT_REP
#define CDFT_REP 1
#endif
#ifndef CONV_REP
#define CONV_REP 1
#endif
#ifndef GMLP_REP
#define GMLP_REP 1
#endif
#ifndef F1_REP
#define F1_REP 1
#endif
__device__ __forceinline__ int block_excl_scan(int v, LAS int* ws8, int lane, int wave) {
    int x = v;
#pragma unroll
    for (int o = 1; o < 64; o <<= 1) { const int y = __shfl_up(x, o); if (lane >= o) x += y; }
    if (lane == 63) ws8[wave] = x;
    __syncthreads();
    int base = 0;
#pragma unroll
    for (int w = 0; w < 8; ++w) base += (w < wave) ? ws8[w] : 0;
    __syncthreads();
    return base + x - v;
}
__device__ __forceinline__ unsigned akey(float a) { const float s = a * 4294967296.f; return s >= 4294967040.f ? 0xFFFFFF00u : (unsigned)s; }
__device__ __forceinline__ float akey_inv(unsigned k) { return (float)k * (1.f / 4294967296.f); }
template <int PER, bool ALLV>
__device__ __forceinline__ void topk_unit(PH_ARGS, const int rowbase, const int n, const int C, const int e, const int sbase, const bool writepad) {
    const float* AFF = WSP(float, WS_AFF); int* SEL = WSP(int, WS_SEL); int* IDX = WSP(int, WS_IDX); float* GATE = WSP(float, WS_GATE);
    LAS unsigned* hist = (LAS unsigned*)lds; LAS unsigned* sh = hist + 256; LAS int* ws8 = (LAS int*)(hist + 272); LAS unsigned* hw = hist + 512 + wave * 256;
    unsigned key[PER]; bool valid[PER];
#pragma unroll
    for (int i = 0; i < PER; ++i) { const int tok = tid * PER + i; valid[i] = ALLV ? true : (tok < n); key[i] = valid[i] ? akey(AFF[(size_t)(rowbase + tok) * 16 + e]) : 0u; }
    unsigned prefix = 0u, mask = 0u, rem = (unsigned)C;
#pragma unroll 1
    for (int pass = 0; pass < 4; ++pass) { const int shift = 24 - 8 * pass;
        for (int i = lane; i < 256; i += 64) hw[i] = 0u;
        LDS_WAIT();
#pragma unroll
        for (int i = 0; i < PER; ++i) if (valid[i] && (key[i] & mask) == prefix) atomicAdd((unsigned*)&hw[(key[i] >> shift) & 255u], 1u);
        __syncthreads();
        if (tid < 256) { unsigned s_ = 0u;
#pragma unroll
            for (int w = 0; w < 8; ++w) s_ += hist[512 + w * 256 + tid];
            hist[tid] = s_; }
        __syncthreads();
        if (wave == 0) { unsigned c0 = hist[255 - 4 * lane], c1 = hist[254 - 4 * lane], c2 = hist[253 - 4 * lane], c3 = hist[252 - 4 * lane];
            const unsigned s = c0 + c1 + c2 + c3; unsigned x = s;
#pragma unroll
            for (int o = 1; o < 64; o <<= 1) { const unsigned y = __shfl_up(x, o); if (lane >= o) x += y; }
            const unsigned excl = x - s;
            if (excl < rem && rem <= x) { unsigned cum = excl; int bin; unsigned nr;
                if (cum + c0 >= rem) { bin = 255 - 4 * lane; nr = rem - cum; }
                else { cum += c0; if (cum + c1 >= rem) { bin = 254 - 4 * lane; nr = rem - cum; }
                else { cum += c1; if (cum + c2 >= rem) { bin = 253 - 4 * lane; nr = rem - cum; }
                else { cum += c2; bin = 252 - 4 * lane; nr = rem - cum; } } }
                sh[0] = (unsigned)bin; sh[1] = nr; } }
        __syncthreads();
        prefix |= sh[0] << shift; mask |= 255u << shift; rem = sh[1];
    }
    __syncthreads();
    const unsigned T = prefix;
    int neq = 0;
#pragma unroll
    for (int i = 0; i < PER; ++i) neq += (valid[i] && key[i] == T) ? 1 : 0;
    const int eqbase = block_excl_scan(neq, ws8, lane, wave);
    unsigned take = 0u; int nsel = 0, eqs = 0;
#pragma unroll
    for (int i = 0; i < PER; ++i) { const bool iseq = valid[i] && key[i] == T; const bool tk = valid[i] && (key[i] > T || (iseq && (unsigned)(eqbase + eqs) < rem)); eqs += iseq ? 1 : 0; if (tk) { take |= 1u << i; ++nsel; } }
    const int sb = block_excl_scan(nsel, ws8, lane, wave);
    int cnt = 0;
#pragma unroll
    for (int i = 0; i < PER; ++i) { const int tok = tid * PER + i;
        if (valid[i]) { if ((take >> i) & 1u) { const int slot = sbase + sb + cnt; ++cnt; IDX[e * ESTR + slot] = rowbase + tok; GATE[e * ESTR + slot] = akey_inv(key[i]); SEL[(size_t)(rowbase + tok) * 16 + e] = slot; }
                        else SEL[(size_t)(rowbase + tok) * 16 + e] = -1; } }
    if (writepad) for (int i = tid; i < ESTR - 2112; i += 512) { IDX[e * ESTR + 2112 + i] = 0; GATE[e * ESTR + 2112 + i] = 0.f; }
    __syncthreads();
}
__device__ __forceinline__ void gather_rows(PH_ARGS, const int tpe) {
    const int gw = bid * 8 + wave, NGW = G * 8, per = tpe * 256; const int* IDX = WSP(int, WS_IDX); const bf16* H = WSP(bf16, WS_H); bf16* XE = WSP(bf16, WS_XE);
    for (int i = gw; i < NE * per; i += NGW) { const int e = i / per, s = i % per, rg = e * ESTR + s; const int src = IDX[rg];
        const v4u a = *(const v4u*)(H + (size_t)src * 1024 + lane * 8), b = *(const v4u*)(H + (size_t)src * 1024 + 512 + lane * 8);
        *(v4u*)(XE + (size_t)rg * 1024 + lane * 8) = a; *(v4u*)(XE + (size_t)rg * 1024 + 512 + lane * 8) = b; }
}
struct CRow { v4u yw[4][2]; f32x4 xin[2][2]; float wgt[4]; unsigned long long bm; int cur; };
struct CCtx { const int* SEL; const bf16* YB; const float* X; bf16* H; const float* MOD; float* XO; float* OUT; const float* gnext; int l, lane; };
__device__ __forceinline__ void cr_issue(const CCtx& C, CRow& R, const int row) {
    const int lane = C.lane;
    R.cur = lane < 16 ? C.SEL[(size_t)row * 16 + lane] : -1;
    R.bm = __ballot(R.cur >= 0); const int cnt = __popcll(R.bm);
#pragma unroll
    for (int k = 0; k < 4; ++k) { const bool has = cnt > k; const int e = has ? (int)__builtin_ctzll(R.bm) : 0; if (has) R.bm &= R.bm - 1; const int s = __shfl(R.cur, e); R.wgt[k] = has ? 1.f : 0.f;
        const bf16* y = C.YB + (size_t)(has ? e * ESTR + s : 0) * 1024 + lane * 8; R.yw[k][0] = *(const v4u*)y; R.yw[k][1] = *(const v4u*)(y + 512); }
    const float* xr = C.X + (size_t)row * 1024;
#pragma unroll
    for (int j = 0; j < 2; ++j) { const int o = 8 * lane + 512 * j; R.xin[j][0] = *(const f32x4*)(xr + o); R.xin[j][1] = *(const f32x4*)(xr + o + 4); }
}
__device__ __forceinline__ void cr_finish(const CCtx& C, CRow& R, const int row) {
    const int lane = C.lane, l = C.l; const int r = row < SEQ ? 0 : (row < ML ? 1 : 2);
    float acc[2][8];
#pragma unroll
    for (int j = 0; j < 2; ++j)
#pragma unroll
        for (int i = 0; i < 8; ++i) acc[j][i] = 0.f;
#pragma unroll
    for (int k = 0; k < 4; ++k)
#pragma unroll
        for (int j = 0; j < 2; ++j) { const v4u w = R.yw[k][j]; const float g = R.wgt[k];
            acc[j][0] += g * bflo(w.x); acc[j][1] += g * bfhi(w.x); acc[j][2] += g * bflo(w.y); acc[j][3] += g * bfhi(w.y); acc[j][4] += g * bflo(w.z); acc[j][5] += g * bfhi(w.z); acc[j][6] += g * bflo(w.w); acc[j][7] += g * bfhi(w.w); }
    while (R.bm) { const int e = (int)__builtin_ctzll(R.bm); R.bm &= R.bm - 1; const int s = __shfl(R.cur, e); const bf16* y = C.YB + (size_t)(e * ESTR + s) * 1024 + lane * 8;
#pragma unroll
        for (int j = 0; j < 2; ++j) { const v4u w = *(const v4u*)(y + 512 * j);
            acc[j][0] += bflo(w.x); acc[j][1] += bfhi(w.x); acc[j][2] += bflo(w.y); acc[j][3] += bfhi(w.y); acc[j][4] += bflo(w.z); acc[j][5] += bfhi(w.z); acc[j][6] += bflo(w.w); acc[j][7] += bfhi(w.w); } }
    const float* gt2 = C.MOD + (l * 3 + r) * 6144 + 5 * 1024;
    float xv[2][8]; float ss = 0.f;
#pragma unroll
    for (int j = 0; j < 2; ++j) { const int o = 8 * lane + 512 * j; const f32x4 g0 = *(const f32x4*)(gt2 + o), g1 = *(const f32x4*)(gt2 + o + 4);
#pragma unroll
        for (int i = 0; i < 4; ++i) { xv[j][i] = R.xin[j][0][i] + g0[i] * acc[j][i]; xv[j][4 + i] = R.xin[j][1][i] + g1[i] * acc[j][4 + i]; }
#pragma unroll
        for (int i = 0; i < 8; ++i) ss += xv[j][i] * xv[j][i]; }
    const float rs = 1.0f / sqrtf(wave_sum(ss) * (1.f / 1024.f) + 1e-6f);
    if (l == 0) {
        const float* md = C.MOD + (1 * 3 + r) * 6144; float* xw = C.XO + (size_t)row * 1024;
#pragma unroll
        for (int j = 0; j < 2; ++j) { const int o = 8 * lane + 512 * j;
            *(f32x4*)(xw + o) = (f32x4){xv[j][0], xv[j][1], xv[j][2], xv[j][3]}; *(f32x4*)(xw + o + 4) = (f32x4){xv[j][4], xv[j][5], xv[j][6], xv[j][7]};
            const f32x4 g0 = *(const f32x4*)(C.gnext + o), g1 = *(const f32x4*)(C.gnext + o + 4), c0 = *(const f32x4*)(md + 1024 + o), c1 = *(const f32x4*)(md + 1024 + o + 4), h0 = *(const f32x4*)(md + o), h1 = *(const f32x4*)(md + o + 4);
            float hv[8];
#pragma unroll
            for (int i = 0; i < 4; ++i) { hv[i] = xv[j][i] * rs * g0[i] * (1.f + c0[i]) + h0[i]; hv[4 + i] = xv[j][4 + i] * rs * g1[i] * (1.f + c1[i]) + h1[i]; }
            v4u w; w.x = pk2(hv[0], hv[1]); w.y = pk2(hv[2], hv[3]); w.z = pk2(hv[4], hv[5]); w.w = pk2(hv[6], hv[7]);
            *(v4u*)(C.H + (size_t)row * 1024 + o) = w; }
    } else {
        float* orow = C.OUT + (size_t)row * 1024;
#pragma unroll
        for (int j = 0; j < 2; ++j) { const int o = 8 * lane + 512 * j; const f32x4 g0 = *(const f32x4*)(C.gnext + o), g1 = *(const f32x4*)(C.gnext + o + 4);
            *(f32x4*)(orow + o) = (f32x4){xv[j][0] * rs * g0[0], xv[j][1] * rs * g0[1], xv[j][2] * rs * g0[2], xv[j][3] * rs * g0[3]};
            *(f32x4*)(orow + o + 4) = (f32x4){xv[j][4] * rs * g1[0], xv[j][5] * rs * g1[1], xv[j][6] * rs * g1[2], xv[j][7] * rs * g1[3]}; }
    }
}
template <bool DUMMY>
__device__ __forceinline__ void combine_rows(PH_ARGS, const int l) {
    const int gw = bid * 8 + wave, NGW = G * 8; const int nrows = l == 0 ? MT : ML;
    CCtx C; C.SEL = WSP(int, WS_SEL); C.YB = WSP(bf16, WS_XE); C.X = WSP(float, WS_X); C.H = DUMMY ? WSP(bf16, WS_BR) : WSP(bf16, WS_H); C.MOD = WSP(float, WS_MOD);
    C.XO = DUMMY ? WSP(float, WS_ACT) : WSP(float, WS_X); C.OUT = DUMMY ? WSP(float, WS_ACT) : PTRV(28, float); C.gnext = l == 0 ? INP(6) + 1024 : INP(27); C.l = l; C.lane = lane;
    CRow A, B; int row = gw;
    if (row < nrows) cr_issue(C, A, row);
    while (row < nrows) {
        const int r2 = row + NGW; if (r2 < nrows) cr_issue(C, B, r2);
        cr_finish(C, A, row);
        const int r3 = r2 + NGW; if (r3 < nrows) cr_issue(C, A, r3);
        if (r2 < nrows) cr_finish(C, B, r2);
        row = r3;
    }
}

#ifdef DBG_STOP
__device__ __forceinline__ void debug_out(PH_ARGS) {
    float* out = PTRV(28, float);
    const int gt = bid * 512 + tid, GT = G * 512;
    for (size_t i = gt; i < (size_t)ML * 1024; i += GT) { const size_t row = i >> 10; const int c = (int)(i & 1023); float v = 0.f;
#if DBG_STOP == 2
        v = bflo(WSP(bf16, WS_H)[row * 1024 + c]) + WSP(float, WS_MOD)[(i % 36864)] + bflo(WSP(bf16, WS_WIN)[i % (6400 * 1024)]) + bflo(WSP(bf16, WS_WGU)[i]) + bflo(WSP(bf16, WS_WDN)[i]) + bflo(WSP(bf16, WS_WO)[i % (1024*1024)]) + bflo(WSP(bf16, WS_WBR)[i % (1024*1024)]);
#elif DBG_STOP == 3
        v = bflo(WSP(bf16, WS_AUV)[row * 512 + (c & 511)]) + bflo(WSP(bf16, WS_YF)[row * 512 + (c & 511)]) + bflo(WSP(bf16, WS_CY)[row * 256 + (c & 255)]) + bflo(WSP(bf16, WS_QPL)[row * 256 + (c & 255)])
          + bflo(WSP(bf16, WS_QROT)[row * 256 + (c & 255)]) + bflo(WSP(bf16, WS_KR)[row * 256 + (c & 255)]) + bflo(WSP(bf16, WS_VV)[row * 256 + (c & 255)])
          + bflo(WSP(bf16, WS_G)[row * 4096 + c]) + bflo(WSP(bf16, WS_G)[row * 4096 + 1024 + c]) + bflo(WSP(bf16, WS_G)[row * 4096 + 2048 + c]) + bflo(WSP(bf16, WS_G)[row * 4096 + 3072 + c]);
#elif DBG_STOP == 4
        v = bflo(WSP(bf16, WS_BR)[(size_t)(0 * MT + row) * 256 + (c & 255)]) + bflo(WSP(bf16, WS_BR)[(size_t)(2 * MT + row) * 256 + (c & 255)]) + bflo(WSP(bf16, WS_FA)[i % ((size_t)8 << 20)]);
#elif DBG_STOP == 21
        v = bflo(WSP(bf16, WS_T1T)[i % 16384]) * 1.001f + WSP(float, WS_ROPEC)[i % 2048] + WSP(float, WS_ROPES)[i % 2048] + bflo(WSP(bf16, WS_WSP)[i % 65536]);
#elif DBG_STOP == 31 || DBG_STOP == 44
        v = 0.f;
#elif DBG_STOP == 45 || DBG_STOP == 32
        v = 0.f;
#elif DBG_STOP == 41
        v = bflo(WSP(bf16, WS_BR)[(size_t)(0 * MT + row) * 256 + (c & 255)]) * 1.001f + bflo(WSP(bf16, WS_BR)[(size_t)(0 * MT + row) * 256 + ((c + 7) & 255)]);
#elif DBG_STOP == 42
        v = bflo(WSP(bf16, WS_BR)[(size_t)(2 * MT + row) * 256 + (c & 255)]) * 1.001f + bflo(WSP(bf16, WS_BR)[(size_t)(2 * MT + row) * 256 + ((c + 7) & 255)]);
#elif DBG_STOP == 43
        v = bflo(WSP(bf16, WS_FA)[i % ((size_t)8 << 20)]) * 1.001f + bflo(WSP(bf16, WS_FA)[(i + 7) % ((size_t)8 << 20)]);
#elif DBG_STOP == 5
        v = bflo(WSP(bf16, WS_BR)[(size_t)(1 * MT + row) * 256 + (c & 255)]) + bflo(WSP(bf16, WS_BR)[(size_t)(3 * MT + row) * 256 + (c & 255)]);
#elif DBG_STOP == 6
        v = bflo(WSP(bf16, WS_MB)[row * 1024 + c]);
#elif DBG_STOP == 7
        v = WSP(float, WS_X)[row * 1024 + c];
#elif DBG_STOP == 8
        v = bflo(WSP(bf16, WS_H)[row * 1024 + c]) + WSP(float, WS_AFF)[row * 16 + (c & 15)];
#elif DBG_STOP == 9
        v = (float)WSP(int, WS_SEL)[row * 16 + (c & 15)] + WSP(float, WS_GATE)[i % (16 * 2304)] + (float)WSP(int, WS_IDX)[i % (16 * 2304)];
#elif DBG_STOP == 10
        v = bflo(WSP(bf16, WS_XE)[i]) + bflo(WSP(bf16, WS_XE)[i + (size_t)ML * 1024]);
#elif DBG_STOP == 11
        v = bflo(WSP(bf16, WS_ACT)[i]) + bflo(WSP(bf16, WS_ACT)[i + (size_t)ML * 1024]);
#elif DBG_STOP == 12
        v = bflo(WSP(bf16, WS_XE)[i]) + bflo(WSP(bf16, WS_XE)[i + (size_t)ML * 1024]);
#else
        v = WSP(float, WS_X)[row * 1024 + c] + bflo(WSP(bf16, WS_H)[row * 1024 + c]);
#endif
#ifdef DBG_AMP
        v = (float)(__float_as_uint(v) & 0xFFFFu);
#endif
        out[i] = v; }
}
#endif
__global__ void __launch_bounds__(512, 2) mega(Args A) {
    extern __shared__ __attribute__((aligned(16))) unsigned char lds_raw[];
    LAS unsigned char* lds0 = (LAS unsigned char*)lds_raw;
    volatile LAS unsigned* MISC = (volatile LAS unsigned*)(lds0 + MISC_OFF);
    const int tid = threadIdx.x, lane = tid & 63, wave = __builtin_amdgcn_readfirstlane(tid >> 6), bid = blockIdx.x, G = gridDim.x;
    for (int u = tid; u < (LDS_BYTES - MISC_OFF) / 4; u += 512) ((LAS unsigned*)(lds0 + MISC_OFF))[u] = 0u;
    __syncthreads();
    if (tid == 0) { typedef unsigned u2v_t __attribute__((ext_vector_type(2)));
#pragma unroll
        for (int i = 0; i < 30; ++i) { const unsigned long long p = i < 28 ? (unsigned long long)A.in[i] : (i == 28 ? (unsigned long long)A.out : (unsigned long long)A.ws);
            *(LAS u2v_t*)(lds0 + PTAB_OFF + 8 * i) = (u2v_t){(unsigned)p, (unsigned)(p >> 32)}; } }
    __syncthreads();
    const int lo = A.ph_lo, hi = A.ph_hi;
    XcdBarrier bar; bar.bar = (unsigned*)(A.ws + WS_CTL) + CW_BAR; bar.x = 0; bar.st = nullptr;
    if (hi - lo > 1) bar = xcd_barrier_post((unsigned*)(A.ws + WS_CTL) + CW_BAR, MISC + 8);
#define PH_CALL lds, tl_, (tl_ & 63), wv_, bl_, G_
#define PH_CALLV lds, tl_, (tl_ & 63), wv_, vb_, G_
#ifdef TS_I
    if (bid == 0 && tid == 0) ((unsigned long long*)(A.ws + 65536))[lo] = rt();
#endif
    if (lo == 0) {
        int tl_ = tid; asm volatile("" : "+v"(tl_)); int bl_ = bid; asm volatile("" : "+s"(bl_)); int wv_ = wave; asm volatile("" : "+s"(wv_)); int G_ = G; asm volatile("" : "+s"(G_));
        unsigned ldsb_ = (unsigned)(uintptr_t)lds0; asm volatile("" : "+s"(ldsb_)); LAS unsigned char* lds = (LAS unsigned char*)(uintptr_t)ldsb_;
#ifndef P0R_MOD
#define P0R_MOD 1
#endif
#ifndef P0R_TAB
#define P0R_TAB 1
#endif
#ifndef P0R_CVT
#define P0R_CVT 1
#endif
#pragma unroll 1
            for (int r_ = 0; r_ < P0R_MOD; ++r_) { mod_gemv(PH_CALL); asm volatile("" ::: "memory"); }
#pragma unroll 1
            for (int r_ = 0; r_ < P0R_TAB; ++r_) { make_tables(PH_CALL); asm volatile("" ::: "memory"); }
#pragma unroll 1
            for (int r_ = 0; r_ < P0R_CVT; ++r_) { convert_range(lds, tl_, (tl_ & 63), wv_, bl_, G_, 0, CV_FOLD0, CV_GU0, bl_, G_); convert_range(lds, tl_, (tl_ & 63), wv_, bl_, G_, 0, CV_SP0, CV_END, bl_, G_); asm volatile("" ::: "memory"); }
        if (hi > 1) { XcdBarrier b2 = bar; b2.bar = (unsigned*)(PTRV(29, unsigned char) + WS_CTL) + CW_BAR; b2.st = (volatile LAS unsigned*)(lds + MISC_OFF) + 8; xcd_barrier(b2); }
    }
    const int lo1 = lo < 1 ? 1 : lo;
#pragma unroll 1
#ifdef REP_PH
    for (int it_ = lo1; it_ < hi + (REP_N - 1); ++it_) { const int ph = it_ < REP_PH ? it_ : (it_ < REP_PH + REP_N ? REP_PH : it_ - (REP_N - 1));
#else
    for (int ph = lo1; ph < hi; ++ph) {
#endif
        int tl_ = tid; asm volatile("" : "+v"(tl_)); int bl_ = bid; asm volatile("" : "+s"(bl_)); int vb_ = (G % 8 == 0) ? (bid % 8) * (G / 8) + bid / 8 : bid; asm volatile("" : "+s"(vb_)); int wv_ = wave; asm volatile("" : "+s"(wv_)); int G_ = G; asm volatile("" : "+s"(G_)); unsigned ldsb_ = (unsigned)(uintptr_t)lds0; asm volatile("" : "+s"(ldsb_)); LAS unsigned char* lds = (LAS unsigned char*)(uintptr_t)ldsb_;
        const int l = ph < 13 ? 0 : 1, kind = ph >= 99 ? 99 : (ph < 2 ? ph : 2 + (ph - 2 - 11 * l));
        const int ntm = l == 0 ? 66 : 64, tpe = l == 0 ? 9 : 8;
        if (kind == 9) continue;
        switch (kind) {
#ifdef DBG_STOP
        case 99: debug_out(PH_CALL); break;
#endif
        case 0: break;
        case 1: {
#ifndef DIS_N1
            norm1_l0(PH_CALL);
#endif
        } break;
        case 2: {
            pg8::Gemm g{WSP(bf16, WS_H), WSP(bf16, WS_WIN), MT, NIN, 1024}; pg8::StaticOrder S; S.init(MT, NIN, G_, bl_);
            EpiIn E{WSP(bf16, WS_AUV), WSP(bf16, WS_YF), WSP(bf16, WS_CY), WSP(bf16, WS_QPL), WSP(bf16, WS_QROT), WSP(bf16, WS_KR), WSP(bf16, WS_VV), WSP(bf16, WS_G), WSP(float, WS_ROPEC), WSP(float, WS_ROPES)};
#ifndef DIS_GIN
            pg8::gemm_phase<EpiIn, pg8::StaticOrder, true, true>(lds, g, S, E);
#endif
#ifndef DIS_CVT
            if (l == 0) { const int nx = ((MT / 256) * (NIN / 256)) % G_; convert_range(lds, tl_, (tl_ & 63), wv_, bl_, G_, 0, CV_GU0, CV_DN0, nx ? bl_ - nx : bl_, G_ - nx); }
#endif
        } break;
        case 3: {
#ifndef DIS_F1
            if (bl_ < 256) { f1_stage_tables(PH_CALL); for (int u = vb_; u < 256; u += G_) f1_unit(PH_CALL, u); }
#endif
#ifndef DIS_CDFT
            if (l == 0) ctx_butterfly(PH_CALL);
#endif
            __syncthreads();
            { LAS float* rp = (LAS float*)(lds + AT_RPB); const float* src = INP(20) + l * 1860;
              for (int i = tl_; i < 2048; i += 512) { const int hh = i >> 9, rw = (i >> 5) & 15, cc = i & 31; rp[i] = rw < 15 ? (cc < 31 ? src[hh * 465 + rw * 31 + cc] * 1.4426950408889634f : -3.0e38f) : 0.f; } }
            __syncthreads();
#ifndef DIS_ATT
            { const int nat = l == 0 ? 264 : 256; for (int u = vb_; u < nat; u += G_) attn_unit(PH_CALL, u); }
#endif
        } break;
        case 4: {
#ifndef DIS_F2
            for (int u = vb_; u < 256; u += G_) f2_unit(PH_CALL, u);
#endif
#ifndef DIS_CONV
            for (int u = vb_; u < 256; u += G_) conv_unit(PH_CALL, l, u);
#endif
#ifndef DIS_GMLP
            for (int u = G_ - 1 - vb_; u < 128; u += G_) gmlp_unit(PH_CALL, l, u);
#endif
            if (l == 0) {
                const bool big = G_ >= 128;
                for (int u = big ? vb_ - 8 : vb_; u >= 0 && u < 8; u += G_) f2_unit(PH_CALL, 256 + u);
                for (int u = big ? vb_ - 16 : vb_; u >= 0 && u < 8; u += G_) conv_unit(PH_CALL, l, 256 + u);
                for (int u = big ? vb_ - 24 : vb_; u >= 0 && u < 4; u += G_) gmlp_unit(PH_CALL, l, 128 + u);
            }
        } break;
        case 5: {
#ifndef DIS_GMRG
#ifndef MERGE_PG8
            merge_phase(PH_CALLV, ntm * 16);
#ifndef DIS_CVT
            if (l == 0) { const int nx = (ntm * 16) % G_; convert_range(lds, tl_, (tl_ & 63), wv_, vb_, G_, 0, CV_DN0, CV_SP0, nx ? vb_ - nx : vb_, G_ - nx); }
#endif
#else
            { pg8::Gemm g{WSP(bf16, WS_BR), WSP(bf16, WS_WBR), 4 * MT, 4096, 256}; MergeOrder S; S.init(ntm, G_, bl_); EpiMergeH E{WSP(bf16, WS_G), WSP(bf16, WS_MB)};
              pg8::gemm_phase<EpiMergeH, MergeOrder, true, true>(lds, g, S, E); }
#endif
#endif
        } break;
        case 6: {
            pg8::Gemm g{WSP(bf16, WS_MB), WSP(bf16, WS_WO), ML, 1024, 1024}; pg8::StaticOrder S; S.init(ML, 1024, G_, bl_);
            EpiWout E{l == 0 ? INP(0) : WSP(float, WS_X), l == 0 ? INP(2) : WSP(float, WS_X) + (size_t)ML * 1024, WSP(float, WS_X), WSP(float, WS_MOD) + l * 3 * 6144};
#ifndef DIS_GWO
            pg8::gemm_phase<EpiWout, pg8::StaticOrder, true, true>(lds, g, S, E);
#endif
#ifndef DIS_CVT
            if (l == 0) { const int nx = (64 * 4) % G_; convert_range(lds, tl_, (tl_ & 63), wv_, bl_, G_, 1, CV_FOLD0, CV_WO0, nx ? bl_ - nx : bl_, G_ - nx); }
#endif
        } break;
        case 7: {
#ifndef DIS_N2
            if (l == 0 && G_ > 16) {
                unsigned* cnt = (unsigned*)(PTRV(29, unsigned char) + WS_CTL) + 2048;
                if (bl_ < 8) {
                    pg8::Gemm g{WSP(bf16, WS_MB), WSP(bf16, WS_WO), MT, 1024, 1024}; OneUnit S{64 + (bl_ >> 2), bl_ & 3};
                    EpiWout E{INP(0), INP(2), WSP(float, WS_X), WSP(float, WS_MOD)};
                    pg8::gemm_phase<EpiWout, OneUnit, true, true>(lds, g, S, E);
                    asm volatile("s_waitcnt vmcnt(0)" ::: "memory"); __syncthreads();
                    if (tl_ == 0) { __builtin_amdgcn_fence(__ATOMIC_RELEASE, "agent"); asm volatile("s_waitcnt vmcnt(0)" ::: "memory"); __hip_atomic_fetch_add(cnt, 1u, __ATOMIC_RELAXED, __HIP_MEMORY_SCOPE_AGENT); }
                } else norm2_router(PH_CALL, l, 0, ML, bl_ - 8, G_ - 8);
                if (tl_ == 0) { unsigned sp_ = 0; while (__hip_atomic_load(cnt, __ATOMIC_RELAXED, __HIP_MEMORY_SCOPE_AGENT) < 8u && ++sp_ < (1u << 22)) __builtin_amdgcn_s_sleep(2);
                    __builtin_amdgcn_fence(__ATOMIC_ACQUIRE, "agent"); asm volatile("s_waitcnt vmcnt(0)" ::: "memory"); }
                __syncthreads();
                norm2_router(PH_CALL, l, ML, MC, bl_, G_, bl_ < 8);
            } else norm2_router(PH_CALL, l, 0, ntm * 256, bl_, G_);
#endif
        } break;
        case 8: {
#ifndef DIS_TOPK
            const int nun = l == 0 ? 64 : 32;
            for (int u = bl_; u < nun; u += G_) {
                if (u < 32) { const int b = u >> 4, e = u & 15; topk_unit<16, true>(PH_CALL, b * SEQ, SEQ, CAPL, e, b * CAPL, l == 0 && b == 0); }
                else { const int b = (u - 32) >> 4, e = u & 15; topk_unit<1, false>(PH_CALL, ML + b * CTXL, CTXL, CAPC, e, 2048 + b * CAPC, false); }
            }
#endif
        } break;
        case 9: {
#ifndef DIS_GATH
            gather_rows(PH_CALL, tpe);
#endif
        } break;
        case 10: {
            pg8::Gemm g{WSP(bf16, WS_H), WSP(bf16, WS_WGU), NE * ESTR, NE * 2048, 1024, WSP(int, WS_IDX)}; GroupOrder S; S.init(tpe, 8, G_, bl_);
            EpiGU E{WSP(bf16, WS_ACT)};
#ifndef DIS_GGU
            pg8::gemm_phase<EpiGU, GroupOrder, true, true, true>(lds, g, S, E);
#endif
#ifndef DIS_CVT
            if (l == 0) { const int nx = (NE * tpe * 8) % G_; convert_range(lds, tl_, (tl_ & 63), wv_, bl_, G_, 1, CV_WO0, CV_GU0, nx ? bl_ - nx : bl_, G_ - nx);
                          convert_range(lds, tl_, (tl_ & 63), wv_, bl_, G_, 1, CV_SP0, CV_END, nx ? bl_ - nx : bl_, G_ - nx); }
#endif
        } break;
        case 11: {
            pg8::Gemm g{WSP(bf16, WS_ACT), WSP(bf16, WS_WDN), NE * ESTR, NE * 1024, 1024}; GroupOrder S; S.init(tpe, 4, G_, bl_);
            EpiDown E{WSP(bf16, WS_XE), WSP(float, WS_GATE)};
#ifndef DIS_GDN
            pg8::gemm_phase<EpiDown, GroupOrder, true, true>(lds, g, S, E);
#endif
#ifndef DIS_CVT
            if (l == 0) { const int nx = (NE * tpe * 4) % G_; convert_range(lds, tl_, (tl_ & 63), wv_, bl_, G_, 1, CV_GU0, CV_DN0, nx ? bl_ - nx : bl_, G_ - nx); }
#endif
        } break;
        default: {
#ifndef DIS_COMB
#ifdef COMB_REP
#pragma unroll 1
            for (int r_ = 0; r_ < COMB_REP; ++r_) combine_rows<true>(PH_CALL, l);
#endif
            combine_rows<false>(PH_CALL, l);
#endif
#ifndef DIS_CVT
            if (l == 0) convert_range(lds, tl_, (tl_ & 63), wv_, bl_, G_, 1, CV_DN0, CV_SP0, bl_, G_);
#endif
        } break;
        }
#ifdef XBAR
        if (ph == 1) { for (int xb_ = 0; xb_ < XBAR; ++xb_) { XcdBarrier b5 = bar; b5.bar = (unsigned*)(PTRV(29, unsigned char) + WS_CTL) + CW_BAR; b5.st = (volatile LAS unsigned*)(lds + MISC_OFF) + 8; xcd_barrier(b5); } }
#endif
#ifdef TS_I
        { XcdBarrier b3 = bar; b3.bar = (unsigned*)(PTRV(29, unsigned char) + WS_CTL) + CW_BAR; b3.st = (volatile LAS unsigned*)(lds + MISC_OFF) + 8; xcd_barrier(b3);
          if (bid == 0 && tid == 0) ((unsigned long long*)(PTRV(29, unsigned char) + 65536))[ph + 1] = rt(); }
        if (ph + 1 == hi) { XcdBarrier b3 = bar; b3.bar = (unsigned*)(PTRV(29, unsigned char) + WS_CTL) + CW_BAR; b3.st = (volatile LAS unsigned*)(lds + MISC_OFF) + 8; xcd_barrier(b3);
            const unsigned long long* TS = (const unsigned long long*)(PTRV(29, unsigned char) + 65536);
            const float dti = (float)(TS[TS_I + 1] - TS[TS_I]) * 0.01f, dtj = (float)(TS[TS_J + 1] - TS[TS_J]) * 0.01f;
            float* out = PTRV(28, float); const float Av = sqrtf(dti);
            for (size_t i = (size_t)bid * 512 + tid; i < (size_t)ML * 1024; i += (size_t)G * 512) out[i] = (i == 0) ? dtj * 10.f : Av; }
        if (0) {
#else
#ifdef REP_PH
        if (it_ + 1 < hi + (REP_N - 1)) {
#else
        if (ph + 1 < hi) {
#endif
#endif
          XcdBarrier b2 = bar; b2.bar = (unsigned*)(PTRV(29, unsigned char) + WS_CTL) + CW_BAR; unsigned bx_ = bar.x; asm volatile("" : "+s"(bx_)); b2.x = bx_; b2.st = (volatile LAS unsigned*)(lds + MISC_OFF) + 8; xcd_barrier(b2); }
    }
}

extern "C" void kernel_launch(void* const* d_in, const int* in_sizes, int n_in, void* d_out, int out_size, void* d_ws, size_t ws_size, hipStream_t stream) {
    static int grid = 0;
    if (grid == 0) {
        if (n_in != 28 || ws_size < WS_END) { fprintf(stderr, "kernel_launch: unexpected n_in %d / ws %zu\n", n_in, ws_size); grid = -1; return; }
        int dev = 0, cus = 0;
        if (hipGetDevice(&dev) != hipSuccess || hipDeviceGetAttribute(&cus, hipDeviceAttributeMultiprocessorCount, dev) != hipSuccess) { grid = -1; return; }
        if (hipFuncSetAttribute((const void*)mega, hipFuncAttributeMaxDynamicSharedMemorySize, LDS_BYTES) != hipSuccess) { fprintf(stderr, "kernel_launch: hipFuncSetAttribute failed\n"); grid = -1; return; }
        (void)hipGetLastError();
        grid = cus;
    }
    if (grid < 0) return;
    (void)hipMemsetAsync((char*)d_ws + WS_CTL, 0, CTL_ZERO_BYTES, stream);
    Args a{};
    for (int i = 0; i < 28; ++i) a.in[i] = (const float*)d_in[i];
    a.out = (float*)d_out; a.ws = (unsigned char*)d_ws;
#ifdef DBG_STOP
    for (int p = 0; p < (DBG_STOP > 20 ? DBG_STOP / 10 : DBG_STOP); ++p) { a.ph_lo = p; a.ph_hi = p + 1; hipLaunchKernelGGL(mega, dim3(grid), dim3(512), LDS_BYTES, stream, a); }
    a.ph_lo = 99; a.ph_hi = 100; hipLaunchKernelGGL(mega, dim3(grid), dim3(512), LDS_BYTES, stream, a);
#elif N_LAUNCHES == 1
    a.ph_lo = 0; a.ph_hi = NPH;
    hipLaunchKernelGGL(mega, dim3(grid), dim3(512), LDS_BYTES, stream, a);
#else
    for (int p = 0; p < NPH; ++p) { a.ph_lo = p; a.ph_hi = p + 1; hipLaunchKernelGGL(mega, dim3(grid), dim3(512), LDS_BYTES, stream, a); }
#endif
}
```

```cpp
#include <hip/hip_runtime.h>
#include <cstdio>
#include <cstdint>
#define N_LAUNCHES 1
namespace pg8 {
#define PG8_LAS __attribute__((address_space(3)))
typedef unsigned short bf16_t;
typedef short bf16x8 __attribute__((ext_vector_type(8)));
typedef float f32x4 __attribute__((ext_vector_type(4)));
typedef unsigned u32x4 __attribute__((ext_vector_type(4)));
constexpr int BM = 256, BK = 64, HALF = 128, HTB = HALF * BK * 2  , STAGE_BYTES = 8 * HTB, NXCD = 8, WGM = 2;

__host__ __device__ __forceinline__ int lds_byte(int r, int c) { const int st = (r >> 4) * 2 + (c >> 5), rr = r & 15, cc = c & 31, ob = rr * 64 + cc * 2; return st * 1024 + (ob ^ (((ob >> 9) & 1) << 5)); }
__host__ __device__ __forceinline__ void stage_rc(int b, int& R, int& C) { const int st = b / 1024, sb = b % 1024, swz = sb ^ (((sb >> 9) & 1) << 5); R = (st >> 1) * 16 + swz / 64; C = (st & 1) * 32 + (swz % 64) / 2; }
__host__ __device__ __forceinline__ int perm32(int rho) { const int n = rho >> 4, i = rho & 15; return 8 * (i >> 2) + 4 * n + (i & 3); }

struct Unit { int pm, pn; };
struct Gemm { const bf16_t* A; const bf16_t* Bt; int M, N, K; const int* gidx = nullptr; };

struct StaticOrder {
    int nM, nN, nwg, G, c;
    __host__ __device__ void init(int M, int N, int G_, int c_) { nM = M / BM; nN = N / BM; nwg = nM * nN; G = G_; c = c_; }
    __host__ __device__ bool next(int i, Unit& u) const {
        const long L = (long)i * G + c; if (L >= nwg) return false;
        int wgid = (int)L; { const int q = nwg / NXCD, r = nwg % NXCD, xcd = wgid % NXCD, off = wgid / NXCD; wgid = (xcd < r ? xcd * (q + 1) : r * (q + 1) + (xcd - r) * q) + off; }
        const int nig = WGM * nN, gid = wgid / nig, fm = gid * WGM, gsz = (nM - fm) < WGM ? (nM - fm) : WGM;
        u.pm = fm + ((wgid % nig) % gsz); u.pn = (wgid % nig) / gsz; return true;
    }
    __device__ __forceinline__ void a_ready(const Unit&) const {}
    __device__ __forceinline__ void done(const Unit&) const {}
};
__device__ __forceinline__ unsigned cvt_pk_bf16(float lo, float hi) { unsigned r; asm volatile("v_cvt_pk_bf16_f32 %0, %1, %2" : "=v"(r) : "v"(lo), "v"(hi)); return r; }
typedef float f32x2 __attribute__((ext_vector_type(2)));
template <class Epi, class Sched, bool ALIGN_EPI = false, bool SP2 = false, bool GATHER = false>
__device__ __forceinline__ void gemm_phase(PG8_LAS unsigned char* lds, const Gemm g, const Sched& S, const Epi& E) {
    int tid_l = threadIdx.x; asm volatile("" : "+v"(tid_l));
    const int tid = tid_l, wid = __builtin_amdgcn_readfirstlane(tid >> 6), lane = tid & 63, wr = wid >> 2, wc = wid & 3, fr = lane & 15, fq = lane >> 4;
    const int K = g.K, nt = K / BK;
    unsigned voffA[2], voffB[2];
#pragma unroll
    for (int i = 0; i < 2; ++i) { int R, C; stage_rc(tid * 16 + i * 8192, R, C); const int Rb = Epi::PERM ? ((R & ~31) + perm32(R & 31)) : R;
        voffA[i] = (unsigned)(R * K + C) * 2u; voffB[i] = (unsigned)(Rb * K + C) * 2u; }
    const size_t kstep = (size_t)(BK * 2);
    const size_t hstep = (size_t)HALF * K * 2;
    const size_t tstep = 2 * hstep;
    const unsigned ldsw = (unsigned)wid * 1024u;
    const int aoff = lds_byte(wr * 64 + fr, fq * 8), boff = lds_byte(wc * 32 + fr, fq * 8);
#define PG8_SA(b, h) (((b) * 2 + (h)) * HTB)
#define PG8_SB(b, h) ((4 + (b) * 2 + (h)) * HTB)
#define PG8_STAGE(bufoff, gbase, voff) do { _Pragma("unroll") for (int _i = 0; _i < 2; ++_i) \
        __builtin_amdgcn_global_load_lds((const unsigned*)((const char*)(gbase) + (voff)[_i]), (PG8_LAS unsigned*)(lds + (bufoff) + ldsw + _i * 8192), 16, 0, 0); } while (0)
    static_assert(!GATHER || SP2, "GATHER is implemented on the SP2 loop only");
    unsigned vgc[2][2] = {{0u, 0u}, {0u, 0u}}, vgn[2][2] = {{0u, 0u}, {0u, 0u}};
#define PG8_GLOAD(u, v) do { _Pragma("unroll") for (int _h = 0; _h < 2; ++_h) _Pragma("unroll") for (int _i = 0; _i < 2; ++_i) { int R_, C_; stage_rc(tid * 16 + _i * 8192, R_, C_); \
        v[_h][_i] = (unsigned)(g.gidx[(u).pm * BM + _h * HALF + R_] * K + C_) * 2u; } } while (0)
#define PG8_STAGE_A(bufoff, base, half, NEXT) do { if constexpr (GATHER) { if (NEXT) PG8_STAGE(bufoff, base, vgn[half]); else PG8_STAGE(bufoff, base, vgc[half]); } \
        else PG8_STAGE(bufoff, (base) + (half) * hstep, voffA); } while (0)
#define PG8_LDA(dst, b, h) do { _Pragma("unroll") for (int m = 0; m < 4; ++m) _Pragma("unroll") for (int k = 0; k < 2; ++k) dst[m][k] = *(const PG8_LAS bf16x8*)(lds + PG8_SA(b, h) + aoff + m * 2048 + k * 1024); } while (0)
#define PG8_LDB(dst, b, h) do { _Pragma("unroll") for (int n = 0; n < 2; ++n) _Pragma("unroll") for (int k = 0; k < 2; ++k) dst[n][k] = *(const PG8_LAS bf16x8*)(lds + PG8_SB(b, h) + boff + n * 2048 + k * 1024); } while (0)
#define PG8_MMA(ai, bj, At, Bt) do { __builtin_amdgcn_s_setprio(1); _Pragma("unroll") for (int m = 0; m < 4; ++m) _Pragma("unroll") for (int n = 0; n < 2; ++n) _Pragma("unroll") for (int k = 0; k < 2; ++k) \
        acc[ai][bj][m][n] = __builtin_amdgcn_mfma_f32_16x16x32_bf16(Bt[n][k], At[m][k], acc[ai][bj][m][n], 0, 0, 0); __builtin_amdgcn_s_setprio(0); } while (0)
#define PG8_WAIT_V(n) asm volatile("s_waitcnt vmcnt(" #n ")" ::: "memory")
#define PG8_WAIT_L(n) asm volatile("s_waitcnt lgkmcnt(" #n ")" ::: "memory")
#define PG8_BAR __builtin_amdgcn_s_barrier()
#define PG8_SCHED __builtin_amdgcn_sched_barrier(0)
    Unit cur, nxt; int ui = 0;
    if (!S.next(0, cur)) return;
    f32x4 acc[2][2][4][2];
#pragma unroll
    for (int a = 0; a < 2; ++a)
#pragma unroll
        for (int b = 0; b < 2; ++b)
#pragma unroll
            for (int m = 0; m < 4; ++m)
#pragma unroll
                for (int n = 0; n < 2; ++n) acc[a][b][m][n] = (f32x4){0.f, 0.f, 0.f, 0.f};
    bf16x8 At[4][2], B0[2][2], B1[2][2];
    const char* cA = GATHER ? (const char*)g.A : (const char*)g.A + (size_t)cur.pm * tstep; const char* cB = (const char*)g.Bt + (size_t)cur.pn * tstep;
    if constexpr (GATHER) { PG8_GLOAD(cur, vgc); }
    S.a_ready(cur);
    if constexpr (SP2) {
        PG8_STAGE(PG8_SB(0, 0), cB, voffB); PG8_STAGE(PG8_SB(0, 1), cB + hstep, voffB); PG8_STAGE_A(PG8_SA(0, 0), cA, 0, false); PG8_STAGE_A(PG8_SA(0, 1), cA, 1, false);
        if (wr == 1) PG8_BAR;
        PG8_WAIT_V(2); PG8_BAR;
        PG8_STAGE(PG8_SB(1, 0), cB + kstep, voffB); PG8_STAGE_A(PG8_SA(1, 0), cA + kstep, 0, false); PG8_STAGE(PG8_SB(1, 1), cB + hstep + kstep, voffB);
        PG8_WAIT_V(6); PG8_BAR;
    } else {
        PG8_STAGE(PG8_SB(0, 0), cB, voffB); PG8_STAGE(PG8_SA(0, 0), cA, voffA); PG8_STAGE(PG8_SB(0, 1), cB + hstep, voffB); PG8_STAGE(PG8_SA(0, 1), cA + hstep, voffA);
        if (wr == 1) PG8_BAR;
        PG8_WAIT_V(4); PG8_BAR;
        PG8_STAGE(PG8_SB(1, 0), cB + kstep, voffB); PG8_STAGE(PG8_SA(1, 0), cA + kstep, voffA); PG8_STAGE(PG8_SB(1, 1), cB + hstep + kstep, voffB);
        PG8_WAIT_V(6); PG8_BAR;
    }
    for (;;) {
        const bool has_next = S.next(ui + 1, nxt);
        const char* nA = GATHER ? (const char*)g.A : (has_next ? (const char*)g.A + (size_t)nxt.pm * tstep : cA);
        if constexpr (GATHER) { if (has_next) { PG8_GLOAD(nxt, vgn); } else { _Pragma("unroll") for (int _h = 0; _h < 2; ++_h) _Pragma("unroll") for (int _i = 0; _i < 2; ++_i) vgn[_h][_i] = vgc[_h][_i]; } } const char* nB = has_next ? (const char*)g.Bt + (size_t)nxt.pn * tstep : cB;
#pragma unroll 1
        for (int t = 0; t < nt; t += 2) {
            const bool last = (t == nt - 2);
            const char* a1 = cA + (size_t)(t + 1) * kstep;
            const char* a2 = last ? nA : cA + (size_t)(t + 2) * kstep; const char* b2 = last ? nB : cB + (size_t)(t + 2) * kstep;
            const char* a3 = a2 + kstep; const char* b3 = b2 + kstep;
            if (last && has_next) S.a_ready(nxt);
            if constexpr (SP2) {
            PG8_LDB(B0, 0, 0); PG8_LDB(B1, 0, 1); PG8_SCHED; PG8_LDA(At, 0, 0); PG8_STAGE_A(PG8_SA(1, 1), a1, 1, false);
            PG8_WAIT_V(8); PG8_WAIT_L(0); PG8_BAR; PG8_MMA(0, 0, At, B0); PG8_MMA(0, 1, At, B1); PG8_BAR; PG8_SCHED;
            PG8_LDA(At, 0, 1); PG8_STAGE(PG8_SB(0, 0), b2, voffB); PG8_STAGE(PG8_SB(0, 1), b2 + hstep, voffB); PG8_STAGE_A(PG8_SA(0, 0), a2, 0, last);
            PG8_WAIT_V(8); PG8_WAIT_L(0); PG8_BAR; PG8_MMA(1, 0, At, B0); PG8_MMA(1, 1, At, B1); PG8_BAR; PG8_SCHED;
            PG8_LDB(B0, 1, 0); PG8_LDB(B1, 1, 1); PG8_SCHED; PG8_LDA(At, 1, 0); PG8_STAGE_A(PG8_SA(0, 1), a2, 1, last);
            PG8_WAIT_V(8); PG8_WAIT_L(0); PG8_BAR; PG8_MMA(0, 0, At, B0); PG8_MMA(0, 1, At, B1); PG8_BAR; PG8_SCHED;
            PG8_LDA(At, 1, 1); PG8_STAGE(PG8_SB(1, 0), b3, voffB); PG8_STAGE(PG8_SB(1, 1), b3 + hstep, voffB); PG8_STAGE_A(PG8_SA(1, 0), a3, 0, last);
            PG8_WAIT_V(8); PG8_WAIT_L(0); PG8_BAR; PG8_MMA(1, 0, At, B0); PG8_MMA(1, 1, At, B1); PG8_BAR; PG8_SCHED;
            } else {
            PG8_LDB(B0, 0, 0); PG8_SCHED; PG8_LDA(At, 0, 0); PG8_STAGE(PG8_SA(1, 1), a1 + hstep, voffA);
            PG8_WAIT_L(8); PG8_BAR; PG8_WAIT_L(0); PG8_MMA(0, 0, At, B0); PG8_BAR; PG8_SCHED;
            PG8_LDB(B1, 0, 1); PG8_STAGE(PG8_SB(0, 0), b2, voffB);
            PG8_BAR; PG8_WAIT_L(0); PG8_MMA(0, 1, At, B1); PG8_BAR;
            PG8_LDA(At, 0, 1); PG8_STAGE(PG8_SA(0, 0), a2, voffA);
            PG8_BAR; PG8_WAIT_L(0); PG8_MMA(1, 0, At, B0); PG8_BAR; PG8_SCHED;
            PG8_STAGE(PG8_SB(0, 1), b2 + hstep, voffB);
            PG8_WAIT_V(6); PG8_BAR; PG8_MMA(1, 1, At, B1); PG8_BAR;
            PG8_LDB(B0, 1, 0); PG8_SCHED; PG8_LDA(At, 1, 0); PG8_STAGE(PG8_SA(0, 1), a2 + hstep, voffA);
            PG8_WAIT_L(8); PG8_BAR; PG8_WAIT_L(0); PG8_MMA(0, 0, At, B0); PG8_BAR; PG8_SCHED;
            PG8_LDB(B1, 1, 1); PG8_STAGE(PG8_SB(1, 0), b3, voffB);
            PG8_BAR; PG8_WAIT_L(0); PG8_MMA(0, 1, At, B1); PG8_BAR;
            PG8_LDA(At, 1, 1); PG8_STAGE(PG8_SA(1, 0), a3, voffA);
            PG8_BAR; PG8_WAIT_L(0); PG8_MMA(1, 0, At, B0); PG8_BAR; PG8_SCHED;
            PG8_STAGE(PG8_SB(1, 1), b3 + hstep, voffB);
            PG8_WAIT_V(6); PG8_BAR; PG8_MMA(1, 1, At, B1); PG8_BAR;
            }
        }
        if constexpr (ALIGN_EPI) { if (wr == 0) PG8_BAR; }
        if constexpr (!Epi::AFTER_DRAIN) { int t2_ = threadIdx.x; asm volatile("" : "+v"(t2_)); E(acc, cur, wr, wc, t2_ & 15, (t2_ >> 4) & 3); S.done(cur); }
        if (!has_next) break;
        bool keep_ = false; if constexpr (Epi::KEEP) keep_ = E.keep(cur);
        if (!keep_) {
#pragma unroll
        for (int a = 0; a < 2; ++a)
#pragma unroll
            for (int b = 0; b < 2; ++b)
#pragma unroll
                for (int m = 0; m < 4; ++m)
#pragma unroll
                    for (int n = 0; n < 2; ++n) acc[a][b][m][n] = (f32x4){0.f, 0.f, 0.f, 0.f};
        }
        cur = nxt; cA = nA; cB = nB; ++ui;
        if constexpr (GATHER) { _Pragma("unroll") for (int _h = 0; _h < 2; ++_h) _Pragma("unroll") for (int _i = 0; _i < 2; ++_i) vgc[_h][_i] = vgn[_h][_i]; }
        if constexpr (ALIGN_EPI) { if (wr == 1) PG8_BAR; }
    }
    PG8_WAIT_V(0);
    if constexpr (!ALIGN_EPI) { if (wr == 0) PG8_BAR; }
    PG8_BAR;
    if constexpr (Epi::AFTER_DRAIN) { E.fused(acc, cur, wr, wc, fr, fq, lds, wid, lane); S.done(cur); }
#undef PG8_SA
#undef PG8_SB
#undef PG8_STAGE
#undef PG8_STAGE_A
#undef PG8_GLOAD
#undef PG8_LDA
#undef PG8_LDB
#undef PG8_MMA
#undef PG8_WAIT_V
#undef PG8_WAIT_L
#undef PG8_BAR
#undef PG8_SCHED
}
}
#define GAS __attribute__((address_space(1)))
#define LAS __attribute__((address_space(3)))
typedef unsigned short bf16;
typedef unsigned v4u __attribute__((ext_vector_type(4)));
typedef float f32x4 __attribute__((ext_vector_type(4)));
typedef short bf16x8 __attribute__((ext_vector_type(8)));
typedef GAS unsigned gu32;
typedef GAS unsigned long long gu64;
#define RLX_AGENT __ATOMIC_RELAXED, __HIP_MEMORY_SCOPE_AGENT
#define LDS_WAIT() asm volatile("s_waitcnt lgkmcnt(0)" ::: "memory")
#define VM_WAIT() asm volatile("s_waitcnt vmcnt(0)" ::: "memory")
__device__ __forceinline__ unsigned long long rt() { return __builtin_amdgcn_s_memrealtime(); }
__device__ __forceinline__ unsigned f2bf(float f) { unsigned u = __builtin_bit_cast(unsigned, f); return (u + 0x7fffu + ((u >> 16) & 1u)) >> 16; }
typedef float f32x2_t __attribute__((ext_vector_type(2))); typedef __bf16 bf16x2_t __attribute__((ext_vector_type(2)));
__device__ __forceinline__ unsigned pk2(float lo, float hi) { const f32x2_t v = {lo, hi}; const bf16x2_t b = __builtin_convertvector(v, bf16x2_t); return __builtin_bit_cast(unsigned, b); }

#define XB_TMO      128
#define XB_XCNT(j)  (256  + 64 * (j))
#define XB_XSUB(j)  (1280 + 64 * (j))
#define XB_XGEN(j)  (2304 + 64 * (j))
#define XB_TOP      3328
#define XB_TOPGEN   3392
#define XCD_BAR_WORDS 3456
#define XB_SPIN_CAP (1u << 18)

__device__ __forceinline__ unsigned xb_ld(unsigned* p)              { return __hip_atomic_load(p, __ATOMIC_RELAXED, __HIP_MEMORY_SCOPE_AGENT); }
__device__ __forceinline__ unsigned xb_add(unsigned* p, unsigned v) { return __hip_atomic_fetch_add(p, v, __ATOMIC_RELAXED, __HIP_MEMORY_SCOPE_AGENT); }
__device__ __forceinline__ unsigned xb_xcc_id() { return (unsigned)__builtin_amdgcn_s_getreg((3 << 11) | 20) & 0xFu; }
#define XB_SPIN(cond, bar) do { unsigned _sp = 0; while (cond) { __builtin_amdgcn_s_sleep(1); \
    if ((++_sp & 255u) == 0u) { if (xb_ld(&(bar)[XB_TMO])) break; if (_sp > XB_SPIN_CAP) { atomicAdd(&(bar)[XB_TMO], 1u); break; } } } } while (0)

struct XcdBarrier {
    unsigned* bar; unsigned x;
    volatile LAS unsigned* st;
};

__device__ __forceinline__ XcdBarrier xcd_barrier_post(unsigned* bar, volatile LAS unsigned* st) {
    XcdBarrier b; b.bar = bar; b.x = xb_xcc_id(); b.st = st;
    if (threadIdx.x == 0) (void)xb_add(&bar[XB_XCNT(b.x)], 1u);
    return b;
}
__device__ __forceinline__ void xcd_barrier_complete(unsigned* bar, unsigned x, unsigned& nloc, unsigned& nx) {
    const unsigned G = gridDim.x * gridDim.y * gridDim.z;
    unsigned sum, cnt, mine, sp = 0u;
    for (;;) {
        sum = 0u; cnt = 0u; mine = 0u;
#pragma unroll
        for (unsigned j = 0; j < 16; ++j) { const unsigned c = xb_ld(&bar[XB_XCNT(j)]); sum += c; cnt += (c > 0u) ? 1u : 0u; mine = (j == x) ? c : mine; }
        if (sum == G) break;
        __builtin_amdgcn_s_sleep(1);
        if ((++sp & 255u) == 0u) { if (xb_ld(&bar[XB_TMO])) break; if (sp > XB_SPIN_CAP) { atomicAdd(&bar[XB_TMO], 1u); break; } }
    }
    nloc = mine > 0u ? mine : 1u; nx = cnt > 0u ? cnt : 1u;
}

__device__ __forceinline__ void xcd_barrier(const XcdBarrier& b) {
    asm volatile("s_waitcnt vmcnt(0)" ::: "memory");
    __syncthreads();
    if (threadIdx.x == 0) {
        unsigned* bar = b.bar;
        __builtin_amdgcn_s_waitcnt(0);
        unsigned nloc = b.st[0], nx = b.st[1];
        if (nloc == 0u) { xcd_barrier_complete(bar, b.x, nloc, nx); b.st[0] = nloc; b.st[1] = nx; }
        const unsigned old = xb_add(&bar[XB_XSUB(b.x)], 1u);
        const unsigned gen = old / nloc;
        if (old + 1u == (gen + 1u) * nloc) {
            __builtin_amdgcn_fence(__ATOMIC_RELEASE, "agent");
            asm volatile("s_waitcnt vmcnt(0)" ::: "memory");
            const unsigned og = xb_add(&bar[XB_TOP], 1u);
            const unsigned tg = og / nx;
            if (og + 1u == (tg + 1u) * nx) xb_add(&bar[XB_TOPGEN], 1u);
            else XB_SPIN(xb_ld(&bar[XB_TOPGEN]) == tg, bar);
            __builtin_amdgcn_fence(__ATOMIC_ACQUIRE, "agent");
            xb_add(&bar[XB_XGEN(b.x)], 1u);
            asm volatile("s_waitcnt vmcnt(0)" ::: "memory");
        } else {
            XB_SPIN(xb_ld(&bar[XB_XGEN(b.x)]) == gen, bar);
            __builtin_amdgcn_fence(__ATOMIC_ACQUIRE, "agent");
            asm volatile("s_waitcnt vmcnt(0)" ::: "memory");
        }
    }
    __syncthreads();
}
constexpr int DM = 1024, SEQ = 8192, NBATCH = 2, CTXL = 256;
constexpr int ML = NBATCH * SEQ, MC = NBATCH * CTXL, MT = ML + MC;
constexpr int NIN = 6400;
constexpr int NE = 16, ESTR = 2304, CAPL = 1024, CAPC = 32;
constexpr int NPH = 24;
constexpr size_t MiB = 1u << 20;
constexpr size_t WS_CTL = 0, CTL_ZERO_BYTES = 32768;
constexpr size_t WS_MOD = 1 * MiB;
constexpr size_t WS_ROPEC = 1 * MiB + 256 * 1024, WS_ROPES = WS_ROPEC + 8192;
constexpr size_t WS_TW = 1 * MiB + 512 * 1024;
constexpr size_t WS_CS256 = 1 * MiB + 640 * 1024;
constexpr size_t WS_T1T = 2 * MiB;
constexpr size_t WS_T2T = 2 * MiB + 64 * 1024;
constexpr size_t WS_T2F = 8 * MiB;
constexpr size_t WS_T2C = 12 * MiB;
constexpr size_t WS_FAC = 13 * MiB;
constexpr size_t WS_WSP = 2 * MiB + 256 * 1024;
constexpr size_t WS_AFF = 3 * MiB;
constexpr size_t WS_SEL = 5 * MiB;
constexpr size_t WS_IDX = 7 * MiB, WS_GATE = 7 * MiB + 256 * 1024;
constexpr size_t WS_WIN = 16 * MiB, WS_WBR = 29 * MiB, WS_WO = 31 * MiB, WS_WGU = 33 * MiB, WS_WDN = 97 * MiB;
constexpr size_t WS_X = 130 * MiB;
constexpr size_t WS_H = 196 * MiB;
constexpr size_t WS_BR = 229 * MiB;
constexpr size_t WS_MB = 262 * MiB;
constexpr size_t WS_FA = 295 * MiB;
constexpr size_t WS_Z = 311 * MiB;
constexpr size_t ZROW = (size_t)MT * 2;
constexpr size_t WS_AUV = WS_Z, WS_YF = WS_AUV + 512 * ZROW, WS_CY = WS_YF + 512 * ZROW, WS_QPL = WS_CY + 256 * ZROW, WS_QROT = WS_QPL + 256 * ZROW,
                 WS_KR = WS_QROT + 256 * ZROW, WS_VV = WS_KR + 256 * ZROW, WS_G = WS_VV + 256 * ZROW, WS_ZEND = WS_G + 4096 * ZROW;
constexpr size_t WS_P32 = WS_Z;
constexpr size_t WS_XE = WS_Z, WS_ACT = WS_Z + 72 * MiB;
constexpr size_t WS_END = 518 * MiB;
static_assert(WS_G == WS_P32 + (size_t)MT * 1024 * 4 + 8 * 256 * ZROW / 8 - 256 * ZROW || true, "");
static_assert(WS_ZEND <= WS_END && WS_ACT + 72 * MiB <= WS_ZEND && WS_P32 + (size_t)MT * 4096 <= WS_VV, "ws map");
constexpr int CW_BAR = 4096;
constexpr int LDS_BYTES = 155648, MISC_OFF = 154624;

struct Args { const float* in[28]; float* out; unsigned char* ws; int ph_lo, ph_hi; };

__device__ __forceinline__ float bflo(unsigned w) { return __uint_as_float(w << 16); }
__device__ __forceinline__ float bfhi(unsigned w) { return __uint_as_float(w & 0xffff0000u); }
__device__ __forceinline__ float sigm(float x) { return __builtin_amdgcn_rcpf(1.f + __expf(-x)); }
__device__ __forceinline__ float wave_sum(float v) {
#pragma unroll
    for (int o = 1; o < 64; o <<= 1) v += __shfl_xor(v, o);
    return v;
}
__device__ __forceinline__ void st4bf(bf16* p, f32x4 v) { uint2 w; w.x = pk2(v[0], v[1]); w.y = pk2(v[2], v[3]); *(uint2*)p = w; }

__device__ __forceinline__ void st8bf(bf16* p, f32x4 a, f32x4 b) { v4u w; w.x = pk2(a[0], a[1]); w.y = pk2(a[2], a[3]); w.z = pk2(b[0], b[1]); w.w = pk2(b[2], b[3]); *(v4u*)p = w; }
using pg8::Unit;
struct EpiIn {
    static constexpr bool PERM = false, AFTER_DRAIN = false, KEEP = false;
    bf16 *AUV, *YF, *CY, *QPL, *QROT, *KR, *VV, *G; const float* ropeC; const float* ropeS;
    __device__ __forceinline__ void operator()(const f32x4 (&acc)[2][2][4][2], const Unit& u, int wr, int wc, int fr, int fq) const {
        const int pn = u.pn, row0 = u.pm * 256 + wr * 64 + fr, cl0 = wc * 32 + 4 * fq;
        const int cp0 = wc * 32 + 8 * fq;
        if (pn < 2) {
#pragma unroll
            for (int ai = 0; ai < 2; ++ai)
#pragma unroll
                for (int m = 0; m < 4; ++m) { const size_t row = row0 + ai * 128 + m * 16;
#pragma unroll
                    for (int bj = 0; bj < 2; ++bj) { f32x4 v[2];
#pragma unroll
                        for (int n = 0; n < 2; ++n)
#pragma unroll
                            for (int j = 0; j < 4; ++j) { const float x = acc[ai][bj][m][n][j]; v[n][j] = x * sigm(1.5957691216f * (x + 0.044715f * x * x * x)); }
                        st8bf(AUV + row * 512 + pn * 256 + bj * 128 + cp0, v[0], v[1]); } }
        } else if (pn < 4) {
#pragma unroll
            for (int ai = 0; ai < 2; ++ai)
#pragma unroll
                for (int m = 0; m < 4; ++m) { const size_t row = row0 + ai * 128 + m * 16;
#pragma unroll
                    for (int bj = 0; bj < 2; ++bj) st8bf(YF + row * 512 + (pn - 2) * 256 + bj * 128 + cp0, acc[ai][bj][m][0], acc[ai][bj][m][1]); }
        } else if (pn < 6) {
#pragma unroll
            for (int ai = 0; ai < 2; ++ai)
#pragma unroll
                for (int m = 0; m < 4; ++m) { const size_t row = row0 + ai * 128 + m * 16; f32x4 v[2];
#pragma unroll
                    for (int n = 0; n < 2; ++n) { const f32x4 a = acc[ai][0][m][n], g = acc[ai][1][m][n];
#pragma unroll
                        for (int j = 0; j < 4; ++j) v[n][j] = a[j] * sigm(g[j]); }
                    st8bf(CY + row * 256 + (pn - 4) * 128 + cp0, v[0], v[1]); }
        } else if (pn < 8) {
            const bool isq = pn == 6; const float scl = isq ? 0.125f * 1.4426950408889634f : 1.f;   const bool latent = u.pm < 64;
#pragma unroll
            for (int ai = 0; ai < 2; ++ai)
#pragma unroll
                for (int m = 0; m < 4; ++m) { const int rowi = row0 + ai * 128 + m * 16; const size_t row = rowi; const int tok = rowi & 8191;
                    const int pos = (wc & 1) ? (tok & 63) : (tok >> 6);
                    f32x4 cs = {1.f, 1.f, 1.f, 1.f}, sn = {0.f, 0.f, 0.f, 0.f};
                    if (latent) { cs = *(const f32x4*)(ropeC + pos * 16 + 4 * fq); sn = *(const f32x4*)(ropeS + pos * 16 + 4 * fq); }
#pragma unroll
                    for (int bj = 0; bj < 2; ++bj) { const f32x4 x1 = acc[ai][bj][m][0] * scl, x2 = acc[ai][bj][m][1] * scl;
                        const f32x4 r1 = x1 * cs - x2 * sn, r2 = x1 * sn + x2 * cs; const size_t off = row * 256 + bj * 128 + cl0;
                        if (isq) { st4bf(QPL + off, x1); st4bf(QPL + off + 16, x2); st4bf(QROT + off, r1); st4bf(QROT + off + 16, r2); }
                        else { st4bf(KR + off, r1); st4bf(KR + off + 16, r2); } } }
        } else if (pn == 8) {
#pragma unroll
            for (int ai = 0; ai < 2; ++ai)
#pragma unroll
                for (int m = 0; m < 4; ++m) { const size_t row = row0 + ai * 128 + m * 16;
#pragma unroll
                    for (int bj = 0; bj < 2; ++bj) st8bf(VV + row * 256 + bj * 128 + cp0, acc[ai][bj][m][0], acc[ai][bj][m][1]); }
        } else {
#pragma unroll
            for (int ai = 0; ai < 2; ++ai)
#pragma unroll
                for (int m = 0; m < 4; ++m) { const size_t row = row0 + ai * 128 + m * 16;
#pragma unroll
                    for (int bj = 0; bj < 2; ++bj)
#pragma unroll
                        for (int n = 0; n < 2; ++n) { f32x4 v = acc[ai][bj][m][n];
#pragma unroll
                            for (int j = 0; j < 4; ++j) v[j] = sigm(v[j]);
                            const int gb_ = (pn - 9) >> 2, gu_ = (2 * u.pm + ai) * 8 + 2 * ((pn - 9) & 3) + bj;
                            st4bf(G + ((((size_t)(gu_ * 4 + gb_) * 8 + (wr * 4 + wc)) * 8 + m * 2 + n) * 256 + (fq * 16 + fr) * 4), v); } }
        }
    }
};
struct EpiMerge {
    static constexpr bool PERM = false, AFTER_DRAIN = false, KEEP = false;
    const bf16* G; float* P32; bf16* MB;
    __device__ __forceinline__ void operator()(const f32x4 (&acc)[2][2][4][2], const Unit& u, int wr, int wc, int fr, int fq) const {
        int fr_ = fr, fq_ = fq; asm volatile("" : "+v"(fr_), "+v"(fq_));
        const int b = u.pn >> 2, pn = u.pn & 3, pm = u.pm - b * 66, row0 = pm * 256 + wr * 64 + fr_, col0 = pn * 256 + wc * 32 + 4 * fq_;
#pragma unroll
        for (int ai = 0; ai < 2; ++ai)
#pragma unroll
            for (int m = 0; m < 4; ++m) { const unsigned row = row0 + ai * 128 + m * 16;
                const bf16* gp = G + ((size_t)row * 4096 + b * 1024 + col0); float* pp = P32 + ((size_t)row * 1024 + col0); bf16* mp = MB + ((size_t)row * 1024 + col0);
#pragma unroll
                for (int bj = 0; bj < 2; ++bj)
#pragma unroll
                    for (int n = 0; n < 2; ++n) { const int co = bj * 128 + n * 16;
                        const uint2 gw = *(const uint2*)(gp + co);
                        f32x4 v = acc[ai][bj][m][n]; v[0] *= bflo(gw.x); v[1] *= bfhi(gw.x); v[2] *= bflo(gw.y); v[3] *= bfhi(gw.y);
                        if (b > 0) v += *(const f32x4*)(pp + co);
                        if (b < 3) *(f32x4*)(pp + co) = v; else st4bf(mp + co, v);
                        asm volatile("" ::: "memory"); } }
    }
};
struct EpiMergeH {
    static constexpr bool PERM = false, AFTER_DRAIN = false, KEEP = true;
    const bf16* G; bf16* MB;
    __device__ __forceinline__ bool keep(const Unit& u) const { return (u.pn >> 2) < 3; }
    __device__ __forceinline__ void operator()(f32x4 (&acc)[2][2][4][2], const Unit& u, int wr, int wc, int fr, int fq) const {
        const int b = u.pn >> 2, pn = u.pn & 3, pm = u.pm - b * 66, row0 = pm * 256 + wr * 64 + fr, col0 = pn * 256 + wc * 32 + 4 * fq;
#pragma unroll
        for (int ai = 0; ai < 2; ++ai)
#pragma unroll
            for (int m = 0; m < 4; ++m) { const unsigned row = row0 + ai * 128 + m * 16; const bf16* gp = G + ((size_t)row * 4096 + b * 1024 + col0); bf16* mp = MB + ((size_t)row * 1024 + col0);
#pragma unroll
                for (int bj = 0; bj < 2; ++bj)
#pragma unroll
                    for (int n = 0; n < 2; ++n) { const int co = bj * 128 + n * 16; const uint2 gb = *(const uint2*)(gp + co); f32x4 v = acc[ai][bj][m][n];
                        if (b < 3) { const uint2 gn = *(const uint2*)(gp + 1024 + co);
                            v[0] *= bflo(gb.x) * __builtin_amdgcn_rcpf(bflo(gn.x)); v[1] *= bfhi(gb.x) * __builtin_amdgcn_rcpf(bfhi(gn.x)); v[2] *= bflo(gb.y) * __builtin_amdgcn_rcpf(bflo(gn.y)); v[3] *= bfhi(gb.y) * __builtin_amdgcn_rcpf(bfhi(gn.y));
                            acc[ai][bj][m][n] = v; }
                        else { v[0] *= bflo(gb.x); v[1] *= bfhi(gb.x); v[2] *= bflo(gb.y); v[3] *= bfhi(gb.y); st4bf(mp + co, v); } }
                asm volatile("" ::: "memory"); }
    }
};
struct EpiWout {
    static constexpr bool PERM = false, AFTER_DRAIN = false, KEEP = false;
    const float* xlat; const float* xctx; float* X; const float* mod;
    __device__ __forceinline__ void operator()(const f32x4 (&acc)[2][2][4][2], const Unit& u, int wr, int wc, int fr, int fq) const {
        const int r = u.pm < 32 ? 0 : (u.pm < 64 ? 1 : 2); const float* gt = mod + r * 6144 + 2 * 1024;
        const int row0 = u.pm * 256 + wr * 64 + fr, col0 = u.pn * 256 + wc * 32 + 4 * fq;
        f32x4 gv[2][2];
#pragma unroll
        for (int bj = 0; bj < 2; ++bj)
#pragma unroll
            for (int n = 0; n < 2; ++n) gv[bj][n] = *(const f32x4*)(gt + col0 + bj * 128 + n * 16);
#pragma unroll
        for (int ai = 0; ai < 2; ++ai)
#pragma unroll
            for (int m = 0; m < 4; ++m) { const size_t row = row0 + ai * 128 + m * 16; const float* src = (row < ML) ? xlat + row * 1024 : xctx + (row - ML) * 1024;
#pragma unroll
                for (int bj = 0; bj < 2; ++bj)
#pragma unroll
                    for (int n = 0; n < 2; ++n) { const int col = col0 + bj * 128 + n * 16;
                        *(f32x4*)(X + row * 1024 + col) = *(const f32x4*)(src + col) + gv[bj][n] * acc[ai][bj][m][n]; } }
    }
};
struct EpiGU {
    static constexpr bool PERM = true, AFTER_DRAIN = false, KEEP = false;
    bf16* ACT;
    __device__ __forceinline__ void operator()(const f32x4 (&acc)[2][2][4][2], const Unit& u, int wr, int wc, int fr, int fq) const {
        const int pnl = u.pn & 7, row0 = u.pm * 256 + wr * 64 + fr, cl0 = wc * 32 + 8 * fq;
#pragma unroll
        for (int ai = 0; ai < 2; ++ai)
#pragma unroll
            for (int m = 0; m < 4; ++m) { const size_t row = row0 + ai * 128 + m * 16; f32x4 v[2];
#pragma unroll
                for (int n = 0; n < 2; ++n) { const f32x4 a = acc[ai][0][m][n], up = acc[ai][1][m][n];
#pragma unroll
                    for (int j = 0; j < 4; ++j) v[n][j] = a[j] * sigm(a[j]) * up[j]; }
                st8bf(ACT + row * 1024 + pnl * 128 + cl0, v[0], v[1]); }
    }
};
struct EpiDown {
    static constexpr bool PERM = true, AFTER_DRAIN = false, KEEP = false;
    bf16* YB; const float* GATE;
    __device__ __forceinline__ void operator()(const f32x4 (&acc)[2][2][4][2], const Unit& u, int wr, int wc, int fr, int fq) const {
        const int pnl = u.pn & 3, row0 = u.pm * 256 + wr * 64 + fr, col0 = pnl * 256 + wc * 32 + 8 * fq;
#pragma unroll
        for (int ai = 0; ai < 2; ++ai)
#pragma unroll
            for (int m = 0; m < 4; ++m) { const size_t row = row0 + ai * 128 + m * 16; const float gt = GATE[row];
#pragma unroll
                for (int bj = 0; bj < 2; ++bj) st8bf(YB + row * 1024 + col0 + bj * 128, acc[ai][bj][m][0] * gt, acc[ai][bj][m][1] * gt); }
    }
};
struct MergeOrder {
    int nt, G, c;
    __device__ void init(int ntm, int G_, int c_) { nt = ntm * 4; G = G_; c = c_; }
    __device__ bool next(int i, Unit& u) const { const int b = i & 3, L = (i >> 2) * G + c; if (L >= nt) return false; u.pm = b * 66 + (L >> 2); u.pn = b * 4 + (L & 3); return true; }
    __device__ __forceinline__ void a_ready(const Unit&) const {}
    __device__ __forceinline__ void done(const Unit&) const {}
};
struct OneUnit { int pm, pn; __device__ bool next(int i, Unit& u) const { if (i > 0) return false; u.pm = pm; u.pn = pn; return true; }
    __device__ __forceinline__ void a_ready(const Unit&) const {} __device__ __forceinline__ void done(const Unit&) const {} };
struct GroupOrder {
    int nwg, G, c, TPE, NTN;
    __device__ void init(int tpe, int ntn, int G_, int c_) { TPE = tpe; NTN = ntn; nwg = NE * tpe * ntn; G = G_; c = c_; }
    __device__ bool next(int i, Unit& u) const {
        const long L = (long)i * G + c; if (L >= nwg) return false;
        int wgid = (int)L; { const int q = nwg / 8, r = nwg % 8, xcd = wgid % 8, off = wgid / 8; wgid = (xcd < r ? xcd * (q + 1) : r * (q + 1) + (xcd - r) * q) + off; }
        const int per = TPE * NTN, e = wgid / per, rem = wgid % per;
#ifdef GO_MT_MAJOR
        const int mt = rem / NTN, pn = rem % NTN;
#else
        const int pn = rem / TPE, mt = rem % TPE;
#endif
        u.pm = e * 9 + mt; u.pn = e * NTN + pn; return true;
    }
    __device__ __forceinline__ void a_ready(const Unit&) const {}
    __device__ __forceinline__ void done(const Unit&) const {}
};
typedef float f2v __attribute__((ext_vector_type(2)));
#define PH_ARGS LAS unsigned char* lds, const int tid, const int lane, const int wave, const int bid, const int G
#define WSP(T, off) ((T*)(PTRV(29, unsigned char) + (off)))
constexpr int PTAB_OFF = MISC_OFF + 512;
__device__ __forceinline__ unsigned long long ptab_ld(LAS unsigned char* lds, int i) {
    typedef unsigned u2v_t __attribute__((ext_vector_type(2)));
    const volatile LAS unsigned* tp = (const volatile LAS unsigned*)(lds + PTAB_OFF + 8 * i); u2v_t v; v[0] = tp[0]; v[1] = tp[1];
    const unsigned lo = __builtin_amdgcn_readfirstlane(v[0]), hi = __builtin_amdgcn_readfirstlane(v[1]);
    return ((unsigned long long)hi << 32) | lo;
}
#define PTRV(i, T) ((T*)(GAS T*)ptab_ld(lds, (i)))
#define INP(i) ((const float*)(GAS const float*)ptab_ld(lds, (i)))

__device__ __forceinline__ void mod_gemv(PH_ARGS) {
    LAS f32x4* red = (LAS f32x4*)lds;
    const float* c = INP(1); const float* cc = INP(3); const float* wm = INP(4); const float* bm = INP(5);
    float* MOD = WSP(float, WS_MOD);
    for (int it = bid; it < 192; it += G) {
        const int l = it / 96, cg = it % 96, kg = tid >> 4, cq = tid & 15;
        f32x4 a0 = {0.f, 0.f, 0.f, 0.f}, a1 = a0, a2 = a0;
        const float* wb = wm + (size_t)l * 1024 * 6144 + cg * 64 + cq * 4;
#pragma unroll 4
        for (int i = 0; i < 32; ++i) { const int k = kg + 32 * i; const f32x4 w = *(const f32x4*)(wb + (size_t)k * 6144);
            const float x0 = c[k], x1 = c[1024 + k], x2 = cc[k];
            a0 += w * (x0 * sigm(x0)); a1 += w * (x1 * sigm(x1)); a2 += w * (x2 * sigm(x2)); }
        red[(kg * 3 + 0) * 16 + cq] = a0; red[(kg * 3 + 1) * 16 + cq] = a1; red[(kg * 3 + 2) * 16 + cq] = a2;
        __syncthreads();
        if (tid < 192) { const int r = tid >> 6, col = tid & 63; float s = 0.f; const LAS float* rf = (const LAS float*)red;
            for (int k2 = 0; k2 < 32; ++k2) s += rf[((k2 * 3 + r) * 16 + (col >> 2)) * 4 + (col & 3)];
            MOD[(l * 3 + r) * 6144 + cg * 64 + col] = s + bm[l * 6144 + cg * 64 + col]; }
        __syncthreads();
    }
}
__device__ __forceinline__ void make_tables(PH_ARGS) {
    const int gt = bid * 512 + tid, GT = G * 512;
    float* RC = WSP(float, WS_ROPEC); float* RS = WSP(float, WS_ROPES);
    bf16* T1 = WSP(bf16, WS_T1T);
    for (int i = gt; i < 2048; i += GT) { const int pos = i >> 4, f = i & 15; const float inv = powf(10000.f, -(float)f / 16.f), ang = (float)pos * inv; RC[i] = cosf(ang); RS[i] = sinf(ang); }
    for (int i = gt; i < 128 * 128; i += GT) { const int col = i >> 7, k = i & 127, ro = col >> 6, k1 = col & 63, n1 = k >> 1, ri = k & 1; float s, c; sincospif((float)((k1 * n1) & 63) / 32.f, &s, &c);
        const float v = ro == 0 ? (ri == 0 ? c : s) : (ri == 0 ? -s : c); T1[i] = (bf16)f2bf(v); }
    bf16* T2F = WSP(bf16, WS_T2F); bf16* T2C = WSP(bf16, WS_T2C);
    for (int i = gt; i < 64 * 128 * 256; i += GT) { const int k1 = i >> 15, k2 = (i >> 8) & 127, k = i & 255, n2 = k >> 1, ri = k & 1; float s, c;
        sincospif((float)((n2 * (k1 + 64 * k2)) & 8191) / 4096.f, &s, &c); T2F[i] = (bf16)f2bf(ri ? s : c); }
    for (int i = gt; i < 2 * 128 * 256; i += GT) { const int k1 = i >> 15, k2 = (i >> 8) & 127, k = i & 255, n2 = k >> 1, ri = k & 1; float s, c;
        sincospif((float)((n2 * (k1 + 2 * k2)) & 255) / 128.f, &s, &c); T2C[i] = (bf16)f2bf(ri ? s : c); }
}
__device__ __forceinline__ void tr_item(const float* W, size_t ldw, int col0, int k0, bf16* dst, int Kd, LAS float* scr, int lane) {
#pragma unroll 8
    for (int i = 0; i < 32; ++i) { const int kk = 2 * i + (lane >> 5); scr[kk * 33 + (lane & 31)] = W[(size_t)(k0 + kk) * ldw + col0 + (lane & 31)]; }
    LDS_WAIT(); asm volatile("" ::: "memory");
    const int c = lane & 7;
#pragma unroll
    for (int j = 0; j < 4; ++j) { const int n = (lane >> 3) + 8 * j; const LAS float* s = scr + (8 * c) * 33 + n;
        v4u o; o.x = pk2(s[0 * 33], s[1 * 33]); o.y = pk2(s[2 * 33], s[3 * 33]); o.z = pk2(s[4 * 33], s[5 * 33]); o.w = pk2(s[6 * 33], s[7 * 33]);
        *(v4u*)(dst + (size_t)n * Kd + k0 + 8 * c) = o; }
    LDS_WAIT(); asm volatile("" ::: "memory");
}
__device__ __forceinline__ int rho32(int c) { return 16 * ((c >> 2) & 1) + 4 * (c >> 3) + (c & 3); }
__device__ __forceinline__ void fold_item16(const float* W  , int f, bf16* WIN, LAS float* scr, const LAS f2v* tab, int lane) {
    const int kb = f >> 2, g = f & 3, k0 = kb * 16;
#pragma unroll
    for (int kk = 0; kk < 16; ++kk) scr[kk * 64 + lane] = W[(size_t)(k0 + kk) * 6144 + 512 + g * 64 + lane];
    LDS_WAIT(); asm volatile("" ::: "memory");
    float ar[16], ai[16];
#pragma unroll
    for (int kk = 0; kk < 16; ++kk) { ar[kk] = 0.f; ai[kk] = 0.f; }
#pragma unroll 4
    for (int c = 0; c < 64; ++c) { const f2v t = tab[(c * lane) & 63];
#pragma unroll
        for (int kk = 0; kk < 16; ++kk) { const float w = scr[kk * 64 + c]; ar[kk] += w * t[0]; ai[kk] -= w * t[1]; } }
    const int L0 = 2 * (g * 64 + lane);
    bf16* d0 = WIN + (size_t)(512 + (L0 & ~31) + rho32(L0 & 31)) * 1024 + k0; bf16* d1 = WIN + (size_t)(512 + (L0 & ~31) + rho32((L0 + 1) & 31)) * 1024 + k0;
    v4u o, p;
    o.x = pk2(ar[0], ar[1]); o.y = pk2(ar[2], ar[3]); o.z = pk2(ar[4], ar[5]); o.w = pk2(ar[6], ar[7]); p.x = pk2(ar[8], ar[9]); p.y = pk2(ar[10], ar[11]); p.z = pk2(ar[12], ar[13]); p.w = pk2(ar[14], ar[15]);
    *(v4u*)d0 = o; *(v4u*)(d0 + 8) = p;
    o.x = pk2(ai[0], ai[1]); o.y = pk2(ai[2], ai[3]); o.z = pk2(ai[4], ai[5]); o.w = pk2(ai[6], ai[7]); p.x = pk2(ai[8], ai[9]); p.y = pk2(ai[10], ai[11]); p.z = pk2(ai[12], ai[13]); p.w = pk2(ai[14], ai[15]);
    *(v4u*)d1 = o; *(v4u*)(d1 + 8) = p;
    LDS_WAIT(); asm volatile("" ::: "memory");
}
template <bool PERMROWS>
__device__ __forceinline__ void tr_item64(const float* W, size_t ldw, int col0, int k0, bf16* dst, int Kd, int lane) {
    const int kq = lane >> 4, n4 = lane & 15; const float* src = W + (size_t)(k0 + kq * 16) * ldw + col0 + n4 * 4;
    f32x4 v[16];
#pragma unroll
    for (int i = 0; i < 16; ++i) v[i] = *(const f32x4*)(src + (size_t)i * ldw);
#pragma unroll
    for (int j = 0; j < 4; ++j) { const int ns = n4 * 4 + j, nd = PERMROWS ? ((ns & 32) + rho32(ns & 31)) : ns; bf16* d = dst + (size_t)nd * Kd + k0 + kq * 16; v4u o, p;
        o.x = pk2(v[0][j], v[1][j]); o.y = pk2(v[2][j], v[3][j]); o.z = pk2(v[4][j], v[5][j]); o.w = pk2(v[6][j], v[7][j]);
        p.x = pk2(v[8][j], v[9][j]); p.y = pk2(v[10][j], v[11][j]); p.z = pk2(v[12][j], v[13][j]); p.w = pk2(v[14][j], v[15][j]);
        *(v4u*)d = o; *(v4u*)(d + 8) = p; }
}
__device__ __forceinline__ void convert_range(PH_ARGS, const int l, const int it_lo, const int it_hi, const int pidx, const int pcount) {
    if (pidx < 0) return;
    LAS float* scr = (LAS float*)(lds + wave * 16384);
    const int gw = pidx * 8 + wave, NGW = pcount * 8;
    bf16* WIN = WSP(bf16, WS_WIN); bf16* WBR = WSP(bf16, WS_WBR); bf16* WO = WSP(bf16, WS_WO); bf16* WGU = WSP(bf16, WS_WGU); bf16* WDN = WSP(bf16, WS_WDN); bf16* WS_ = WSP(bf16, WS_WSP);
    const float* win = INP(8) + (size_t)l * 1024 * 6144;
    LAS f2v* tab = (LAS f2v*)(scr + 2048); { float s_, c_; sincospif((float)lane / 32.f, &s_, &c_); tab[lane] = (f2v){c_, s_}; } LDS_WAIT(); asm volatile("" ::: "memory");
    constexpr int N_FOLD = 256, N_IN = 92 * 16, N_BR = 256, N_WO = 256, N_GU = 8192, N_DN = 4096, N_SP = 64;
    constexpr int NITEMS = N_FOLD + N_IN + N_BR + N_WO + N_GU + N_DN + N_SP;
    for (int it = it_lo + gw; it < it_hi && it < NITEMS; it += NGW) {
        int r = it;
        if (r < N_FOLD) { fold_item16(win, r, WIN, scr, tab, lane); continue; } r -= N_FOLD;
        if (r < N_IN) { const int dbp = r >> 4, kb = r & 15, db = dbp < 8 ? dbp : dbp + 8; int col;
            if (db < 8) col = db * 64;
            else if (db < 24) { const int t = db - 16, tile = t >> 2, sub = t & 3; col = (sub < 2 ? 768 : 1024) + tile * 128 + (sub & 1) * 64; }
            else if (db < 36) col = 1280 + (db - 24) * 64;
            else col = 2048 + (db - 36) * 64;
            if (db < 24 || (db >= 32 && db < 36)) tr_item64<true>(win, 6144, col, kb * 64, WIN + (size_t)db * 64 * 1024, 1024, lane);
            else tr_item64<false>(win, 6144, col, kb * 64, WIN + (size_t)db * 64 * 1024, 1024, lane);
            continue; } r -= N_IN;
        if (r < N_BR) { const int b = r >> 6, q = r & 63, kb = q >> 4, nb = q & 15; const int ii = b == 0 ? 13 : (b == 1 ? 14 : (b == 2 ? 19 : 21));
            tr_item64<false>(INP(ii) + (size_t)l * 256 * 1024, 1024, nb * 64, kb * 64, WBR + (size_t)(b * 1024 + nb * 64) * 256, 256, lane); continue; } r -= N_BR;
        if (r < N_WO) { const int kb = r >> 4, nb = r & 15; tr_item64<false>(INP(22) + (size_t)l * 1024 * 1024, 1024, nb * 64, kb * 64, WO + (size_t)nb * 64 * 1024, 1024, lane); continue; } r -= N_WO;
        if (r < N_GU) { const int e = r >> 9, q = r & 511, db = q >> 4, kb = q & 15, tile = db >> 2, sub = db & 3;
            const float* src = (sub < 2 ? INP(24) : INP(25)) + (size_t)(l * 16 + e) * 1024 * 1024;
            tr_item64<false>(src, 1024, tile * 128 + (sub & 1) * 64, kb * 64, WGU + ((size_t)e * 2048 + db * 64) * 1024, 1024, lane); continue; } r -= N_GU;
        if (r < N_DN) { const int e = r >> 8, q = r & 255, kb = q >> 4, nb = q & 15;
            tr_item64<false>(INP(26) + (size_t)(l * 16 + e) * 1024 * 1024, 1024, nb * 64, kb * 64, WDN + ((size_t)e * 1024 + nb * 64) * 1024, 1024, lane); continue; } r -= N_DN;
        { const float* s = INP(11) + (size_t)l * 65536 + r * 1024 + lane * 16; const f32x4 a = *(const f32x4*)s, b = *(const f32x4*)(s + 4), c = *(const f32x4*)(s + 8), d = *(const f32x4*)(s + 12);
          v4u o, p; o.x = pk2(a[0], a[1]); o.y = pk2(a[2], a[3]); o.z = pk2(b[0], b[1]); o.w = pk2(b[2], b[3]); p.x = pk2(c[0], c[1]); p.y = pk2(c[2], c[3]); p.z = pk2(d[0], d[1]); p.w = pk2(d[2], d[3]);
          *(v4u*)(WS_ + r * 1024 + lane * 16) = o; *(v4u*)(WS_ + r * 1024 + lane * 16 + 8) = p; }
    }
}
constexpr int CV_FOLD0 = 0, CV_IN0 = 256, CV_BR0 = 256 + 92 * 16, CV_WO0 = CV_BR0 + 256, CV_GU0 = CV_WO0 + 256, CV_DN0 = CV_GU0 + 8192, CV_SP0 = CV_DN0 + 4096, CV_END = CV_SP0 + 64;
__device__ __forceinline__ void convert_weights(PH_ARGS, const int l) { convert_range(lds, tid, lane, wave, bid, G, l, 0, CV_END, bid, G); }
__device__ __forceinline__ void load_row(const float* p, int lane, f32x4 (&v)[4]) {
#pragma unroll
    for (int j = 0; j < 4; ++j) v[j] = *(const f32x4*)(p + 4 * lane + 256 * j);
}
__device__ __forceinline__ void modnorm_store(f32x4 (&v)[4], const float* g, const float* sc, const float* sh, bf16* hrow, int lane) {
    float ss = 0.f;
#pragma unroll
    for (int j = 0; j < 4; ++j) ss += (v[j][0] * v[j][0] + v[j][1] * v[j][1]) + (v[j][2] * v[j][2] + v[j][3] * v[j][3]);
    const float rs = 1.0f / sqrtf(wave_sum(ss) * (1.f / 1024.f) + 1e-6f);
#pragma unroll
    for (int j = 0; j < 4; ++j) { const int o = 4 * lane + 256 * j; const f32x4 gg = *(const f32x4*)(g + o), s = *(const f32x4*)(sc + o), b = *(const f32x4*)(sh + o);
        v[j] = v[j] * rs * gg * (s + 1.f) + b; st4bf(hrow + o, v[j]); }
}
__device__ __forceinline__ void modnorm_regs(f32x4 (&v)[4], const f32x4 (&gm)[4], const f32x4 (&sh)[4], bf16* hrow, int lane) {
    float ss = 0.f;
#pragma unroll
    for (int j = 0; j < 4; ++j) ss += (v[j][0] * v[j][0] + v[j][1] * v[j][1]) + (v[j][2] * v[j][2] + v[j][3] * v[j][3]);
    const float rs = 1.0f / sqrtf(wave_sum(ss) * (1.f / 1024.f) + 1e-6f);
#pragma unroll
    for (int j = 0; j < 4; ++j) { v[j] = v[j] * rs * gm[j] + sh[j]; st4bf(hrow + 4 * lane + 256 * j, v[j]); }
}
__device__ __forceinline__ void load_mod(const float* g, const float* sc, const float* shp, int lane, f32x4 (&gm)[4], f32x4 (&sh)[4]) {
#pragma unroll
    for (int j = 0; j < 4; ++j) { const int o = 4 * lane + 256 * j; gm[j] = *(const f32x4*)(g + o) * (*(const f32x4*)(sc + o) + 1.f); sh[j] = *(const f32x4*)(shp + o); }
}
__device__ __forceinline__ void norm1_l0(PH_ARGS) {
    const int gw = bid * 8 + wave, NGW = G * 8; bf16* H = WSP(bf16, WS_H); const float* MOD = WSP(float, WS_MOD);
    const int RPW = (MT + NGW - 1) / NGW, row0 = gw * RPW, rend = (row0 + RPW < MT) ? row0 + RPW : MT;
    const float* xin = INP(0); const float* cin = INP(2); const float* g = INP(6);
    f32x4 cur[4], nxt[4], gm[4], sh[4]; int rprev = -1;
    if (row0 < rend) load_row(row0 < ML ? xin + (size_t)row0 * 1024 : cin + (size_t)(row0 - ML) * 1024, lane, cur);
    for (int row = row0; row < rend; ++row) {
        if (row + 1 < rend) { const int rn = row + 1; load_row(rn < ML ? xin + (size_t)rn * 1024 : cin + (size_t)(rn - ML) * 1024, lane, nxt); }
        const int r = row < SEQ ? 0 : (row < ML ? 1 : 2);
        if (r != rprev) { const float* md = MOD + r * 6144; load_mod(g, md + 1024, md, lane, gm, sh); rprev = r; }
        modnorm_regs(cur, gm, sh, H + (size_t)row * 1024, lane);
#pragma unroll
        for (int j = 0; j < 4; ++j) cur[j] = nxt[j];
    }
}
__device__ __forceinline__ void norm2_router(PH_ARGS, const int l, const int rbase, const int nrows, const int pidx, const int pcount, const bool load_table = true) {
    const int gw = pidx * 8 + wave, NGW = pcount * 8; bf16* H = WSP(bf16, WS_H); const float* MOD = WSP(float, WS_MOD) + l * 3 * 6144; const float* X = WSP(float, WS_X); float* AFF = WSP(float, WS_AFF);
    LAS f32x4* Wl = (LAS f32x4*)lds;
    if (load_table) { const f32x4* wr = (const f32x4*)(INP(23) + (size_t)l * 1024 * 16);
      for (int i = tid; i < 4096; i += 512) { const int k = i >> 2, q = i & 3; Wl[(q * 4 + (k & 3)) * 256 + (k >> 2)] = wr[i]; } }
    __syncthreads();
    const int RPW = (nrows + NGW - 1) / NGW, row0 = rbase + gw * RPW, rend = (gw * RPW + RPW < nrows) ? row0 + RPW : rbase + nrows;
    const float* g2 = INP(7) + l * 1024;
    f32x4 v[4], nxt[4], gm[4], sh[4]; int rprev = -1;
    if (row0 < rend) load_row(X + (size_t)row0 * 1024, lane, v);
    for (int row = row0; row < rend; ++row) {
        if (row + 1 < rend) load_row(X + (size_t)(row + 1) * 1024, lane, nxt);
        const int r = row < SEQ ? 0 : (row < ML ? 1 : 2);
        if (r != rprev) { const float* md = MOD + r * 6144; load_mod(g2, md + 4 * 1024, md + 3 * 1024, lane, gm, sh); rprev = r; }
        modnorm_regs(v, gm, sh, H + (size_t)row * 1024, lane);
        float lg[16];
#pragma unroll
        for (int e = 0; e < 16; ++e) lg[e] = 0.f;
#pragma unroll
        for (int j = 0; j < 4; ++j)
#pragma unroll
            for (int i = 0; i < 4; ++i) { const float hv = v[j][i];
#pragma unroll
                for (int q = 0; q < 4; ++q) { const f32x4 w = Wl[(q * 4 + i) * 256 + 64 * j + lane]; lg[4 * q + 0] += hv * w[0]; lg[4 * q + 1] += hv * w[1]; lg[4 * q + 2] += hv * w[2]; lg[4 * q + 3] += hv * w[3]; }
                if (i & 1) asm volatile("" ::: "memory"); }
#pragma unroll
        for (int i = 0; i < 8; ++i) { const bool up = lane & 32; const float send = up ? lg[i] : lg[i + 8], keep = up ? lg[i + 8] : lg[i]; lg[i] = keep + __shfl_xor(send, 32); }
#pragma unroll
        for (int i = 0; i < 4; ++i) { const bool up = lane & 16; const float send = up ? lg[i] : lg[i + 4], keep = up ? lg[i + 4] : lg[i]; lg[i] = keep + __shfl_xor(send, 16); }
#pragma unroll
        for (int i = 0; i < 2; ++i) { const bool up = lane & 8; const float send = up ? lg[i] : lg[i + 2], keep = up ? lg[i + 2] : lg[i]; lg[i] = keep + __shfl_xor(send, 8); }
        { const bool up = lane & 4; const float send = up ? lg[0] : lg[1], keep = up ? lg[1] : lg[0]; lg[0] = keep + __shfl_xor(send, 4); }
        float z = lg[0]; z += __shfl_xor(z, 1); z += __shfl_xor(z, 2);
        float mx = z; mx = fmaxf(mx, __shfl_xor(mx, 4)); mx = fmaxf(mx, __shfl_xor(mx, 8)); mx = fmaxf(mx, __shfl_xor(mx, 16)); mx = fmaxf(mx, __shfl_xor(mx, 32));
        const float ez = expf(z - mx); float sm = ez; sm += __shfl_xor(sm, 4); sm += __shfl_xor(sm, 8); sm += __shfl_xor(sm, 16); sm += __shfl_xor(sm, 32);
        if ((lane & 3) == 0) { const int e = ((lane >> 5) & 1) * 8 + ((lane >> 4) & 1) * 4 + ((lane >> 3) & 1) * 2 + ((lane >> 2) & 1); AFF[(size_t)row * 16 + e] = ez / sm; }
#pragma unroll
        for (int j = 0; j < 4; ++j) v[j] = nxt[j];
    }
    __syncthreads();
}
typedef short v4i16_t __attribute__((ext_vector_type(4)));
__device__ __forceinline__ void mfma16(f32x4& acc, const bf16x8 a, const bf16x8 b) { asm volatile("s_nop 1\n\tv_mfma_f32_16x16x32_bf16 %0, %1, %2, %0\n\ts_nop 3" : "+v"(acc) : "v"(a), "v"(b)); }
__device__ __forceinline__ void mfma16n(f32x4& acc, const bf16x8 a, const bf16x8 b) { asm volatile("v_mfma_f32_16x16x32_bf16 %0, %1, %2, %0" : "+v"(acc) : "v"(a), "v"(b)); }
#define DRAIN4(x) asm volatile("s_nop 15\n\ts_nop 15" : "+v"((x)[0]), "+v"((x)[1]), "+v"((x)[2]), "+v"((x)[3]))
#define DRAIN8(x) asm volatile("s_nop 15\n\ts_nop 15" : "+v"((x)[0]), "+v"((x)[1]), "+v"((x)[2]), "+v"((x)[3]), "+v"((x)[4]), "+v"((x)[5]), "+v"((x)[6]), "+v"((x)[7]))
#define DRAIN16(x) asm volatile("s_nop 15\n\ts_nop 15" : "+v"((x)[0]), "+v"((x)[1]), "+v"((x)[2]), "+v"((x)[3]), "+v"((x)[4]), "+v"((x)[5]), "+v"((x)[6]), "+v"((x)[7]), \
    "+v"((x)[8]), "+v"((x)[9]), "+v"((x)[10]), "+v"((x)[11]), "+v"((x)[12]), "+v"((x)[13]), "+v"((x)[14]), "+v"((x)[15]))
__device__ __forceinline__ void gmlp_unit(PH_ARGS, const int l, const int chunk) {
    const int row0 = chunk < 128 ? chunk * 128 : ML + (chunk - 128) * 128;
    const bf16* AUV = WSP(bf16, WS_AUV); bf16* BRa = WSP(bf16, WS_BR); const bf16* WS_ = WSP(bf16, WS_WSP);
    LAS bf16* vT = (LAS bf16*)lds;
    const float* lg = INP(9) + l * 256; const float* lb = INP(10) + l * 256;
    const f32x4 gg = *(const f32x4*)(lg + 4 * lane), bb = *(const f32x4*)(lb + 4 * lane);
    uint2 raws[16];
#pragma unroll
    for (int pi = 0; pi < 16; ++pi) raws[pi] = *(const uint2*)(AUV + (size_t)(row0 + wave * 16 + pi) * 512 + 256 + 4 * lane);
#pragma unroll
    for (int pi = 0; pi < 16; ++pi) { const int p = wave * 16 + pi;
        const uint2 raw = raws[pi];
        float v0 = bflo(raw.x), v1 = bfhi(raw.x), v2 = bflo(raw.y), v3 = bfhi(raw.y);
        const float mean = wave_sum((v0 + v1) + (v2 + v3)) * (1.f / 256.f); v0 -= mean; v1 -= mean; v2 -= mean; v3 -= mean;
        const float rstd = 1.0f / sqrtf(wave_sum((v0 * v0 + v1 * v1) + (v2 * v2 + v3 * v3)) * (1.f / 256.f) + 1e-6f);
        vT[(4 * lane + 0) * 136 + p] = (bf16)f2bf(v0 * rstd * gg[0] + bb[0]); vT[(4 * lane + 1) * 136 + p] = (bf16)f2bf(v1 * rstd * gg[1] + bb[1]);
        vT[(4 * lane + 2) * 136 + p] = (bf16)f2bf(v2 * rstd * gg[2] + bb[2]); vT[(4 * lane + 3) * 136 + p] = (bf16)f2bf(v3 * rstd * gg[3] + bb[3]); }
    __syncthreads();
    const int g = wave >> 1, qh = wave & 1, fr = lane & 15, fq = lane >> 4;
    f32x4 acc[4][4];
#pragma unroll
    for (int a = 0; a < 4; ++a)
#pragma unroll
        for (int b = 0; b < 4; ++b) acc[a][b] = (f32x4){0.f, 0.f, 0.f, 0.f};
    const bf16* Wg = WS_ + g * 16384;
#pragma unroll
    for (int ks = 0; ks < 4; ++ks) { bf16x8 af[4], bf[4];
#pragma unroll
        for (int dt = 0; dt < 4; ++dt) af[dt] = *(const LAS bf16x8*)(vT + (g * 64 + dt * 16 + fr) * 136 + ks * 32 + fq * 8);
#pragma unroll
        for (int qt = 0; qt < 4; ++qt) bf[qt] = *(const bf16x8*)(Wg + (qh * 64 + qt * 16 + fr) * 128 + ks * 32 + fq * 8);
#pragma unroll
        for (int dt = 0; dt < 4; ++dt)
#pragma unroll
            for (int qt = 0; qt < 4; ++qt) mfma16(acc[dt][qt], af[dt], bf[qt]); }
    DRAIN16(&acc[0][0]);
    const float* bs = INP(12) + l * 512 + g * 128;
#pragma unroll
    for (int qt = 0; qt < 4; ++qt) { const int q = qh * 64 + qt * 16 + fr; const float bias = bs[q]; const size_t row = row0 + q;
#pragma unroll
        for (int dt = 0; dt < 4; ++dt) { const int ch = g * 64 + dt * 16 + 4 * fq; const uint2 uw = *(const uint2*)(AUV + row * 512 + ch);
            f32x4 o; o[0] = bflo(uw.x) * (acc[dt][qt][0] + bias); o[1] = bfhi(uw.x) * (acc[dt][qt][1] + bias); o[2] = bflo(uw.y) * (acc[dt][qt][2] + bias); o[3] = bfhi(uw.y) * (acc[dt][qt][3] + bias);
            st4bf(BRa + row * 256 + ch, o); } }
    __syncthreads();
}
__device__ __forceinline__ void conv_unit(PH_ARGS, const int l, const int unit) {
    int rowbase, n0, nlen;
    if (unit < 256) { rowbase = (unit >> 7) * SEQ; n0 = (unit & 127) * 64; nlen = SEQ; } else { const int u2 = unit - 256; rowbase = ML + (u2 >> 2) * CTXL; n0 = (u2 & 3) * 64; nlen = CTXL; }
    const bf16* CY = WSP(bf16, WS_CY); bf16* BRc = WSP(bf16, WS_BR) + (size_t)2 * MT * 256;
    LAS unsigned* yt = (LAS unsigned*)lds;
    LAS float* cres = (LAS float*)(lds + 48128);
    for (int p = tid; p < 94 * 32; p += 512) { const int rr = p >> 5, seg = p & 31, n = n0 - 15 + rr; v4u val = {0u, 0u, 0u, 0u};
        if (n >= 0 && n < nlen) val = *(const v4u*)(CY + (size_t)(rowbase + n) * 256 + seg * 8);
        *(LAS v4u*)(lds + rr * 512 + seg * 16) = val; }
    __syncthreads();
    const int cp = tid & 127, pg = tid >> 7;
    float w0[31], w1[31];
    const float* cw = INP(15) + (size_t)l * 31 * 256 + 2 * cp;
#pragma unroll
    for (int t = 0; t < 31; ++t) { const float2 w = *(const float2*)(cw + t * 256); w0[t] = w.x; w1[t] = w.y; }
    float a0[16], a1[16];
#pragma unroll
    for (int p = 0; p < 16; ++p) { a0[p] = 0.f; a1[p] = 0.f; }
#pragma unroll
    for (int i = 0; i < 46; ++i) { const unsigned raw = yt[(16 * pg + i) * 128 + cp]; const float v0 = bflo(raw), v1 = bfhi(raw);
#pragma unroll
        for (int p = 0; p < 16; ++p) { const int t = i - p; if (t >= 0 && t < 31) { a0[p] += v0 * w0[t]; a1[p] += v1 * w1[t]; } } }
    const float2 cb = *(const float2*)(INP(16) + l * 256 + 2 * cp);
#pragma unroll
    for (int p = 0; p < 16; ++p) *(LAS f2v*)(cres + (16 * pg + p) * 256 + 2 * cp) = (f2v){a0[p] + cb.x, a1[p] + cb.y};
    __syncthreads();
    const f32x4 gg = *(const f32x4*)(INP(17) + l * 256 + 4 * lane), bb = *(const f32x4*)(INP(18) + l * 256 + 4 * lane);
    for (int pi = 0; pi < 8; ++pi) { const int pos = wave * 8 + pi; f32x4 v = *(const LAS f32x4*)(cres + pos * 256 + 4 * lane);
        const float mean = wave_sum((v[0] + v[1]) + (v[2] + v[3])) * (1.f / 256.f); v = v - mean;
        const float rstd = 1.0f / sqrtf(wave_sum((v[0] * v[0] + v[1] * v[1]) + (v[2] * v[2] + v[3] * v[3])) * (1.f / 256.f) + 1e-6f);
        f32x4 o;
#pragma unroll
        for (int j = 0; j < 4; ++j) { const float y = v[j] * rstd * gg[j] + bb[j]; o[j] = y * sigm(y); }
        st4bf(BRc + (size_t)(rowbase + n0 + pos) * 256 + 4 * lane, o); }
    __syncthreads();
}
constexpr int F1_T1L = 0, F1_YL = 34816;
__device__ __forceinline__ void f1_stage_tables(PH_ARGS) {
    const bf16* T1 = WSP(bf16, WS_T1T);
    for (int p = tid; p < 128 * 16; p += 512) { const int r = p >> 4, s = p & 15; *(LAS v4u*)(lds + F1_T1L + r * 272 + s * 16) = *(const v4u*)(T1 + r * 128 + s * 8); }
    __syncthreads();
}
__device__ __forceinline__ void f1_unit(PH_ARGS, const int unit) {
    const int b = unit >> 7, n2 = unit & 127, fr = lane & 15, fq = lane >> 4;
    const bf16* YF = WSP(bf16, WS_YF); bf16* FA = WSP(bf16, WS_FA);
    LAS unsigned* Yl = (LAS unsigned*)(lds + F1_YL);
#pragma unroll
    for (int i = 0; i < 8; ++i) { const int n1 = wave + 8 * i; *(LAS v4u*)(Yl + n1 * 260 + lane * 4) = *(const v4u*)(YF + (size_t)(b * SEQ + 128 * n1 + n2) * 512 + lane * 8); }
    __syncthreads();
    f32x4 acc[2][8];
#pragma unroll
    for (int a = 0; a < 2; ++a)
#pragma unroll
        for (int n = 0; n < 8; ++n) acc[a][n] = (f32x4){0.f, 0.f, 0.f, 0.f};
#pragma unroll
    for (int ks = 0; ks < 4; ++ks) { bf16x8 af[2];
#pragma unroll
        for (int c2 = 0; c2 < 2; ++c2) { const int ch = (2 * wave + c2) * 16 + fr; v4u w;
            w.x = Yl[(16 * ks + 4 * fq + 0) * 260 + ch]; w.y = Yl[(16 * ks + 4 * fq + 1) * 260 + ch]; w.z = Yl[(16 * ks + 4 * fq + 2) * 260 + ch]; w.w = Yl[(16 * ks + 4 * fq + 3) * 260 + ch];
            af[c2] = __builtin_bit_cast(bf16x8, w); }
#pragma unroll
        for (int nt = 0; nt < 8; ++nt) { const bf16x8 bfr = *(const LAS bf16x8*)(lds + F1_T1L + (nt * 16 + fr) * 272 + ks * 64 + fq * 16);
            mfma16(acc[0][nt], af[0], bfr); mfma16(acc[1][nt], af[1], bfr); } }
    DRAIN16(&acc[0][0]);
#pragma unroll
    for (int c2 = 0; c2 < 2; ++c2)
#pragma unroll
        for (int kt = 0; kt < 4; ++kt) { const int k1 = kt * 16 + fr; const f32x4 ar = acc[c2][kt], ai = acc[c2][kt + 4];
            v4u o; o.x = pk2(ar[0], ai[0]); o.y = pk2(ar[1], ai[1]); o.z = pk2(ar[2], ai[2]); o.w = pk2(ar[3], ai[3]);
            *(v4u*)(FA + ((size_t)((b * 64 + k1) * 128 + n2) * 256 + (2 * wave + c2) * 16 + 4 * fq) * 2) = o; }
    __syncthreads();
}
constexpr int F2_T2L = 0, F2_AL = 67584;
__device__ __forceinline__ void f2_unit(PH_ARGS, const int unit) {
    const int fr = lane & 15, fq = lane >> 4; const bool lat = unit < 256;
    int b, k1, chh; const bf16* Asrc; const bf16* Tsrc; size_t orow0; int ostr; float scl;
    if (lat) { b = unit >> 7; k1 = (unit >> 1) & 63; chh = unit & 1; Asrc = WSP(bf16, WS_FA) + (size_t)((b * 64 + k1) * 128) * 512; Tsrc = WSP(bf16, WS_T2F) + (size_t)k1 * 32768; orow0 = (size_t)b * SEQ + k1; ostr = 64; scl = 0.0013810679320049757f; }
    else { const int u2 = unit - 256; b = u2 >> 2; k1 = (u2 >> 1) & 1; chh = u2 & 1; Asrc = WSP(bf16, WS_FAC) + (size_t)((b * 2 + k1) * 128) * 512; Tsrc = WSP(bf16, WS_T2C) + (size_t)k1 * 32768; orow0 = (size_t)ML + b * CTXL + k1; ostr = 2; scl = 1.f / 128.f; }
    bf16* BRb = WSP(bf16, WS_BR) + (size_t)1 * MT * 256;
    LAS unsigned* Al = (LAS unsigned*)(lds + F2_AL);
    for (int p = tid; p < 128 * 32; p += 512) { const int r = p >> 5, s = p & 31; *(LAS v4u*)(lds + F2_T2L + r * 528 + s * 16) = *(const v4u*)(Tsrc + r * 256 + s * 8); }
#pragma unroll
    for (int i = 0; i < 8; ++i) { const int n2 = wave * 16 + 2 * i + (lane >> 5);
        *(LAS v4u*)(Al + n2 * 132 + (lane & 31) * 4) = *(const v4u*)(Asrc + ((size_t)n2 * 256 + chh * 128) * 2 + (lane & 31) * 8); }
    __syncthreads();
    f32x4 acc[8];
#pragma unroll
    for (int n = 0; n < 8; ++n) acc[n] = (f32x4){0.f, 0.f, 0.f, 0.f};
    const int ch = wave * 16 + fr;
#pragma unroll
    for (int ks = 0; ks < 8; ++ks) { v4u w;
        w.x = Al[(16 * ks + 4 * fq + 0) * 132 + ch]; w.y = Al[(16 * ks + 4 * fq + 1) * 132 + ch]; w.z = Al[(16 * ks + 4 * fq + 2) * 132 + ch]; w.w = Al[(16 * ks + 4 * fq + 3) * 132 + ch];
        const bf16x8 af = __builtin_bit_cast(bf16x8, w);
#pragma unroll
        for (int nt = 0; nt < 8; ++nt) { const bf16x8 bfr = *(const LAS bf16x8*)(lds + F2_T2L + (nt * 16 + fr) * 528 + ks * 64 + fq * 16); mfma16(acc[nt], af, bfr); } }
    DRAIN8(acc);
#pragma unroll
    for (int nt = 0; nt < 8; ++nt) { const int k2 = nt * 16 + fr; st4bf(BRb + (orow0 + (size_t)ostr * k2) * 256 + chh * 128 + wave * 16 + 4 * fq, acc[nt] * scl); }
    __syncthreads();
}
__device__ __forceinline__ void ctx_butterfly(PH_ARGS) {
    const unsigned* YF = (const unsigned*)WSP(bf16, WS_YF); unsigned* FAC = (unsigned*)WSP(bf16, WS_FAC);
    for (int i = bid * 512 + tid; i < 2 * 128 * 256; i += G * 512) { const int b = i >> 15, n2 = (i >> 8) & 127, ch = i & 255;
        const unsigned y0 = YF[(size_t)(ML + b * CTXL + n2) * 256 + ch], y1 = YF[(size_t)(ML + b * CTXL + 128 + n2) * 256 + ch];
        const float r0 = bflo(y0), i0 = bfhi(y0), r1 = bflo(y1), i1 = bfhi(y1);
        FAC[(size_t)((b * 2 + 0) * 128 + n2) * 256 + ch] = pk2(r0 + r1, i0 + i1); FAC[(size_t)((b * 2 + 1) * 128 + n2) * 256 + ch] = pk2(r0 - r1, i0 - i1); }
}
constexpr int MG_AL = 0, MG_BL = 67584;
__device__ __forceinline__ void merge_phase(PH_ARGS, const int nunits) {
    const int fr = lane & 15, fq = lane >> 4, wr = wave >> 2, wc = wave & 3;
    const bf16* BR = WSP(bf16, WS_BR); const bf16* WBR = WSP(bf16, WS_WBR); const bf16* GT = WSP(bf16, WS_G); bf16* MB = WSP(bf16, WS_MB);
    int nmine = 0; for (int u = bid; u < nunits; u += G) ++nmine;
    const int nsteps = nmine * 4;
    if (nsteps == 0) return;
    v4u pa[8], pb[8];
#define MG_LOAD(s) do { const int u_ = bid + ((s) >> 2) * G, b_ = (s) & 3, rt_ = u_ >> 3, ct_ = u_ & 7; \
        const bf16* As = BR + ((size_t)b_ * MT + (size_t)rt_ * 128) * 256; const bf16* Bs = WBR + ((size_t)b_ * 1024 + (size_t)ct_ * 128) * 256; \
        _Pragma("unroll") for (int i = 0; i < 8; ++i) { const int p = i * 512 + tid, r = p >> 5, seg = p & 31; pa[i] = *(const v4u*)(As + (size_t)r * 256 + seg * 8); pb[i] = *(const v4u*)(Bs + (size_t)r * 256 + seg * 8); } } while (0)
#define MG_WRITE() do { _Pragma("unroll") for (int i = 0; i < 8; ++i) { const int p = i * 512 + tid, r = p >> 5, seg = p & 31; \
        *(LAS v4u*)(lds + MG_AL + r * 528 + seg * 16) = pa[i]; *(LAS v4u*)(lds + MG_BL + r * 528 + seg * 16) = pb[i]; } } while (0)
    MG_LOAD(0); MG_WRITE();
    f32x4 macc[4][2];
#pragma unroll
    for (int a = 0; a < 4; ++a)
#pragma unroll
        for (int n = 0; n < 2; ++n) macc[a][n] = (f32x4){0.f, 0.f, 0.f, 0.f};
#pragma unroll 1
    for (int s = 0; s < nsteps; ++s) {
        const int u = bid + (s >> 2) * G, b = s & 3, rt = u >> 3, ct = u & 7;
        __syncthreads();
        if (s + 1 < nsteps) MG_LOAD(s + 1);
        uint2 gw[4][2];
#pragma unroll
        for (int mt = 0; mt < 4; ++mt)
#pragma unroll
            for (int nt = 0; nt < 2; ++nt) gw[mt][nt] = *(const uint2*)(GT + ((((size_t)(u * 4 + b) * 8 + wave) * 8 + mt * 2 + nt) * 256 + lane * 4));
        f32x4 acc[4][2];
#pragma unroll
        for (int a = 0; a < 4; ++a)
#pragma unroll
            for (int n = 0; n < 2; ++n) acc[a][n] = (f32x4){0.f, 0.f, 0.f, 0.f};
        asm volatile("s_nop 1" : "+v"(acc[0][0]), "+v"(acc[0][1]), "+v"(acc[1][0]), "+v"(acc[1][1]), "+v"(acc[2][0]), "+v"(acc[2][1]), "+v"(acc[3][0]), "+v"(acc[3][1]));
#pragma unroll
        for (int ks = 0; ks < 8; ++ks) { bf16x8 af[4], bfr[2];
#pragma unroll
            for (int mt = 0; mt < 4; ++mt) af[mt] = *(const LAS bf16x8*)(lds + MG_AL + (wr * 64 + mt * 16 + fr) * 528 + ks * 64 + fq * 16);
#pragma unroll
            for (int nt = 0; nt < 2; ++nt) bfr[nt] = *(const LAS bf16x8*)(lds + MG_BL + (wc * 32 + nt * 16 + fr) * 528 + ks * 64 + fq * 16);
#pragma unroll
            for (int mt = 0; mt < 4; ++mt)
#pragma unroll
                for (int nt = 0; nt < 2; ++nt) mfma16n(acc[mt][nt], bfr[nt], af[mt]); }
        DRAIN8(&acc[0][0]);
#pragma unroll
        for (int mt = 0; mt < 4; ++mt)
#pragma unroll
            for (int nt = 0; nt < 2; ++nt) { const uint2 g = gw[mt][nt]; macc[mt][nt][0] += bflo(g.x) * acc[mt][nt][0]; macc[mt][nt][1] += bfhi(g.x) * acc[mt][nt][1]; macc[mt][nt][2] += bflo(g.y) * acc[mt][nt][2]; macc[mt][nt][3] += bfhi(g.y) * acc[mt][nt][3]; }
        __syncthreads();
        if (s + 1 < nsteps) MG_WRITE();
        if (b == 3) {
#pragma unroll
            for (int mt = 0; mt < 4; ++mt)
#pragma unroll
                for (int nt = 0; nt < 2; ++nt) { st4bf(MB + (size_t)(rt * 128 + wr * 64 + mt * 16 + fr) * 1024 + ct * 128 + wc * 32 + nt * 16 + 4 * fq, macc[mt][nt]); macc[mt][nt] = (f32x4){0.f, 0.f, 0.f, 0.f}; }
        }
    }
    __syncthreads();
#undef MG_LOAD
#undef MG_WRITE
}
constexpr int AT_RPB = 32768, AT_MRG = 40960;
__device__ __forceinline__ int clampi(int v, int lo, int hi) { return v < lo ? lo : (v > hi ? hi : v); }
__device__ __forceinline__ bool at_need(int kind, int jb, int t) { return kind == 2 || (kind == 0 ? (jb < 2 || (jb == 2 && t == 1)) : (jb > 1 || (jb == 1 && t == 0))); }
struct AtCtx { const bf16* QPL; const bf16* KR; const bf16* VV; LAS unsigned char* vbuf; const LAS float* rpbl; int h, qh, fr, fq, lane, b, r, kr0, qrow0, nch, nwin; bool lat; unsigned code[2][2][2]; float negb; };
__device__ __forceinline__ unsigned at_keyrow(const AtCtx& X, int ci) { return (ci < X.nwin) ? ((unsigned)X.b * SEQ + (unsigned)(X.kr0 + (ci >> 1)) * 64 + 32 * (ci & 1)) : ((unsigned)ML + X.b * CTXL + 32 * (ci - X.nwin)); }
__device__ __forceinline__ void at_load(const AtCtx& X, int ci, bf16x8 (&kf)[2][2], v4u (&vst)[4]) {
    const unsigned kr = at_keyrow(X, ci);
#pragma unroll
    for (int t = 0; t < 2; ++t)
#pragma unroll
        for (int ks = 0; ks < 2; ++ks) kf[t][ks] = *(const bf16x8*)(X.KR + (unsigned)((kr + 16 * t + X.fr) * 256 + X.h * 64 + ks * 32 + X.fq * 8));
#pragma unroll
    for (int i = 0; i < 4; ++i) { const int p = i * 64 + X.lane, key = p >> 3, seg = p & 7; vst[i] = *(const v4u*)(X.VV + (unsigned)((kr + key) * 256 + X.h * 64 + seg * 8)); }
}
__device__ __forceinline__ void at_chunk(const AtCtx& X, const int ci, bf16x8 (&kf)[2][2], v4u (&vst)[4], bf16x8 (&qf)[2][2], f32x4 (&O)[2][4], float (&m)[2], float (&l)[2]) {
    const int kind = ci < X.nwin ? (ci & 1) : 2, fr = X.fr, fq = X.fq, qh = X.qh;
    if (X.lat && ci == 16) {
#pragma unroll
        for (int j = 0; j < 2; ++j)
#pragma unroll
            for (int ks = 0; ks < 2; ++ks) qf[j][ks] = *(const bf16x8*)(X.QPL + (unsigned)((X.qrow0 + 16 * (2 * qh + j) + fr) * 256 + X.h * 64 + ks * 32 + fq * 8));
        asm volatile("" : "+v"(qf[0][0]), "+v"(qf[0][1]), "+v"(qf[1][0]), "+v"(qf[1][1])); }
#pragma unroll
    for (int i = 0; i < 4; ++i) { const int p = i * 64 + X.lane, key = p >> 3, seg = p & 7; *(LAS v4u*)(X.vbuf + key * 128 + ((((seg >> 1) ^ ((key >> 1) & 3))) << 5) + ((seg & 1) << 4)) = vst[i]; }
    f32x4 S[2][2];
#pragma unroll
    for (int j = 0; j < 2; ++j)
#pragma unroll
        for (int t = 0; t < 2; ++t) S[j][t] = (f32x4){0.f, 0.f, 0.f, 0.f};
    asm volatile("s_nop 1" : "+v"(S[0][0]), "+v"(S[0][1]), "+v"(S[1][0]), "+v"(S[1][1]));
#pragma unroll
    for (int j = 0; j < 2; ++j)
#pragma unroll
        for (int t = 0; t < 2; ++t) { mfma16n(S[j][t], kf[t][0], qf[j][0]); mfma16n(S[j][t], kf[t][1], qf[j][1]); }
    const LAS float* rpbrow = X.rpbl + (kind != 2 ? (X.kr0 + (ci >> 1) - X.r + 7) : 15) * 32;
    float bv[2][2][4];
#pragma unroll
    for (int j = 0; j < 2; ++j)
#pragma unroll
        for (int t = 0; t < 2; ++t) { const unsigned cw = kind == 2 ? 0u : (kind == 0 ? X.code[0][j][t] : X.code[1][j][t]);
#pragma unroll
            for (int rg = 0; rg < 4; ++rg) bv[j][t][rg] = rpbrow[(cw >> (8 * rg)) & 31u]; }
    asm volatile("s_nop 11" : "+v"(S[0][0]), "+v"(S[0][1]), "+v"(S[1][0]), "+v"(S[1][1]));
    if (ci + 3 < X.nch) at_load(X, ci + 3, kf, vst);
    bf16x8 pf[2];
#pragma unroll
    for (int j = 0; j < 2; ++j) {
        float mc = X.negb;
#pragma unroll
        for (int t = 0; t < 2; ++t)
#pragma unroll
            for (int rg = 0; rg < 4; ++rg) { const float s = S[j][t][rg] + bv[j][t][rg]; S[j][t][rg] = s; mc = fmaxf(mc, s); }
        { auto r16 = __builtin_amdgcn_permlane16_swap(__float_as_uint(mc), __float_as_uint(mc), false, false); mc = fmaxf(__uint_as_float(r16[0]), __uint_as_float(r16[1]));
          auto r32 = __builtin_amdgcn_permlane32_swap(__float_as_uint(mc), __float_as_uint(mc), false, false); mc = fmaxf(__uint_as_float(r32[0]), __uint_as_float(r32[1])); }
        const float mnew = fmaxf(m[j], mc), alpha = __builtin_amdgcn_exp2f(m[j] - mnew); m[j] = mnew; float ls = 0.f;
#pragma unroll
        for (int t = 0; t < 2; ++t)
#pragma unroll
            for (int rg = 0; rg < 4; ++rg) { const float p = __builtin_amdgcn_exp2f(S[j][t][rg] - mnew); S[j][t][rg] = p; ls += p; }
        l[j] = l[j] * alpha + ls;
        if (__any(alpha != 1.f)) {
#pragma unroll
            for (int dt = 0; dt < 4; ++dt) O[j][dt] = O[j][dt] * alpha; }
        v4u pw; pw.x = pk2(S[j][0][0], S[j][0][1]); pw.y = pk2(S[j][0][2], S[j][0][3]); pw.z = pk2(S[j][1][0], S[j][1][1]); pw.w = pk2(S[j][1][2], S[j][1][3]);
        pf[j] = __builtin_bit_cast(bf16x8, pw); }
    asm volatile("s_nop 1" : "+v"(pf[0]), "+v"(pf[1]));
#pragma unroll
    for (int dt = 0; dt < 4; ++dt) { v4i16_t t0, t1;
        { const int key = 4 * fq + (fr >> 2); t0 = __builtin_amdgcn_ds_read_tr16_b64_v4i16((LAS v4i16_t*)(X.vbuf + key * 128 + ((dt ^ ((key >> 1) & 3)) << 5) + (fr & 3) * 8)); }
        { const int key = 16 + 4 * fq + (fr >> 2); t1 = __builtin_amdgcn_ds_read_tr16_b64_v4i16((LAS v4i16_t*)(X.vbuf + key * 128 + ((dt ^ ((key >> 1) & 3)) << 5) + (fr & 3) * 8)); }
        const bf16x8 vf = (bf16x8){t0[0], t0[1], t0[2], t0[3], t1[0], t1[1], t1[2], t1[3]};
        mfma16n(O[0][dt], vf, pf[0]); mfma16n(O[1][dt], vf, pf[1]); }
}
__device__ __forceinline__ void attn_unit(PH_ARGS, const int unit) {
    AtCtx X; X.h = wave >> 1; X.qh = wave & 1; X.fr = lane & 15; X.fq = lane >> 4; X.lane = lane;
    X.lat = unit < 256; X.r = 0; X.kr0 = 0;
    if (X.lat) { X.b = unit >> 7; X.r = unit & 127; X.qrow0 = X.b * SEQ + X.r * 64; X.kr0 = clampi(X.r - 4, 0, 120); }
    else { const int u2 = unit - 256; X.b = u2 >> 2; X.qrow0 = ML + X.b * CTXL + (u2 & 3) * 64; }
    X.QPL = WSP(bf16, WS_QPL); const bf16* QROT = WSP(bf16, WS_QROT); X.KR = WSP(bf16, WS_KR); X.VV = WSP(bf16, WS_VV);
    bf16* BRd = WSP(bf16, WS_BR) + (size_t)3 * MT * 256;
    X.vbuf = lds + wave * 4096; X.rpbl = (const LAS float*)(lds + AT_RPB) + X.h * 512;
    X.nch = X.lat ? 24 : 8; X.nwin = X.lat ? 16 : 0;
#pragma unroll
    for (int kd = 0; kd < 2; ++kd)
#pragma unroll
        for (int j = 0; j < 2; ++j)
#pragma unroll
            for (int t = 0; t < 2; ++t) { unsigned cw = 0u; const int jb = 2 * X.qh + j;
#pragma unroll
                for (int rg = 0; rg < 4; ++rg) { const int kcol = 32 * kd + 16 * t + 4 * X.fq + rg, qcol = 16 * jb + X.fr, cst = clampi(qcol - 8, 0, 48); const bool ok = at_need(kd, jb, t) && kcol >= cst && kcol < cst + 16;
                    cw |= (ok ? (unsigned)(clampi(kcol - qcol, -15, 15) + 15) : 31u) << (8 * rg); }
                X.code[kd][j][t] = cw; }
    float m[2], l[2]; f32x4 O[2][4];
    { unsigned u_ = 0xf149f2cau; asm volatile("" : "+s"(u_)); X.negb = __uint_as_float(u_); }
#pragma unroll
    for (int j = 0; j < 2; ++j) { m[j] = X.negb; l[j] = 0.f;
#pragma unroll
        for (int dt = 0; dt < 4; ++dt) O[j][dt] = (f32x4){0.f, 0.f, 0.f, 0.f}; }
    bf16x8 qf[2][2];
    { const bf16* Qs = X.lat ? QROT : X.QPL;
#pragma unroll
      for (int j = 0; j < 2; ++j)
#pragma unroll
          for (int ks = 0; ks < 2; ++ks) qf[j][ks] = *(const bf16x8*)(Qs + (unsigned)((X.qrow0 + 16 * (2 * X.qh + j) + X.fr) * 256 + X.h * 64 + ks * 32 + X.fq * 8));
      asm volatile("" : "+v"(qf[0][0]), "+v"(qf[0][1]), "+v"(qf[1][0]), "+v"(qf[1][1])); }
    bf16x8 kA[2][2], kB[2][2], kC[2][2]; v4u vA[4], vB[4], vC[4];
    at_load(X, 0, kA, vA); at_load(X, 1, kB, vB); at_load(X, 2, kC, vC);
#pragma unroll 1
    for (int ci = 0; ci < X.nch; ci += 3) {
        at_chunk(X, ci, kA, vA, qf, O, m, l);
        if (ci + 1 < X.nch) at_chunk(X, ci + 1, kB, vB, qf, O, m, l);
        if (ci + 2 < X.nch) at_chunk(X, ci + 2, kC, vC, qf, O, m, l);
    }
    asm volatile("s_nop 15" : "+v"(O[0][0]), "+v"(O[0][1]), "+v"(O[0][2]), "+v"(O[0][3]), "+v"(O[1][0]), "+v"(O[1][1]), "+v"(O[1][2]), "+v"(O[1][3]));
#pragma unroll
    for (int j = 0; j < 2; ++j) { l[j] += __shfl_xor(l[j], 16); l[j] += __shfl_xor(l[j], 32); const float inv = 1.f / l[j];
#pragma unroll
        for (int dt = 0; dt < 4; ++dt) st4bf(BRd + (unsigned)((X.qrow0 + 16 * (2 * X.qh + j) + X.fr) * 256 + X.h * 64 + dt * 16 + 4 * X.fq), O[j][dt] * inv); }
}
#ifndef CDFT_REP
#define CDFT_REP 1
#endif
#ifndef CONV_REP
#define CONV_REP 1
#endif
#ifndef GMLP_REP
#define GMLP_REP 1
#endif
#ifndef F1_REP
#define F1_REP 1
#endif
__device__ __forceinline__ int block_excl_scan(int v, LAS int* ws8, int lane, int wave) {
    int x = v;
#pragma unroll
    for (int o = 1; o < 64; o <<= 1) { const int y = __shfl_up(x, o); if (lane >= o) x += y; }
    if (lane == 63) ws8[wave] = x;
    __syncthreads();
    int base = 0;
#pragma unroll
    for (int w = 0; w < 8; ++w) base += (w < wave) ? ws8[w] : 0;
    __syncthreads();
    return base + x - v;
}
__device__ __forceinline__ unsigned akey(float a) { const float s = a * 4294967296.f; return s >= 4294967040.f ? 0xFFFFFF00u : (unsigned)s; }
__device__ __forceinline__ float akey_inv(unsigned k) { return (float)k * (1.f / 4294967296.f); }
template <int PER, bool ALLV>
__device__ __forceinline__ void topk_unit(PH_ARGS, const int rowbase, const int n, const int C, const int e, const int sbase, const bool writepad) {
    const float* AFF = WSP(float, WS_AFF); int* SEL = WSP(int, WS_SEL); int* IDX = WSP(int, WS_IDX); float* GATE = WSP(float, WS_GATE);
    LAS unsigned* hist = (LAS unsigned*)lds; LAS unsigned* sh = hist + 256; LAS int* ws8 = (LAS int*)(hist + 272); LAS unsigned* hw = hist + 512 + wave * 256;
    unsigned key[PER]; bool valid[PER];
#pragma unroll
    for (int i = 0; i < PER; ++i) { const int tok = tid * PER + i; valid[i] = ALLV ? true : (tok < n); key[i] = valid[i] ? akey(AFF[(size_t)(rowbase + tok) * 16 + e]) : 0u; }
    unsigned prefix = 0u, mask = 0u, rem = (unsigned)C;
#pragma unroll 1
    for (int pass = 0; pass < 4; ++pass) { const int shift = 24 - 8 * pass;
        for (int i = lane; i < 256; i += 64) hw[i] = 0u;
        LDS_WAIT();
#pragma unroll
        for (int i = 0; i < PER; ++i) if (valid[i] && (key[i] & mask) == prefix) atomicAdd((unsigned*)&hw[(key[i] >> shift) & 255u], 1u);
        __syncthreads();
        if (tid < 256) { unsigned s_ = 0u;
#pragma unroll
            for (int w = 0; w < 8; ++w) s_ += hist[512 + w * 256 + tid];
            hist[tid] = s_; }
        __syncthreads();
        if (wave == 0) { unsigned c0 = hist[255 - 4 * lane], c1 = hist[254 - 4 * lane], c2 = hist[253 - 4 * lane], c3 = hist[252 - 4 * lane];
            const unsigned s = c0 + c1 + c2 + c3; unsigned x = s;
#pragma unroll
            for (int o = 1; o < 64; o <<= 1) { const unsigned y = __shfl_up(x, o); if (lane >= o) x += y; }
            const unsigned excl = x - s;
            if (excl < rem && rem <= x) { unsigned cum = excl; int bin; unsigned nr;
                if (cum + c0 >= rem) { bin = 255 - 4 * lane; nr = rem - cum; }
                else { cum += c0; if (cum + c1 >= rem) { bin = 254 - 4 * lane; nr = rem - cum; }
                else { cum += c1; if (cum + c2 >= rem) { bin = 253 - 4 * lane; nr = rem - cum; }
                else { cum += c2; bin = 252 - 4 * lane; nr = rem - cum; } } }
                sh[0] = (unsigned)bin; sh[1] = nr; } }
        __syncthreads();
        prefix |= sh[0] << shift; mask |= 255u << shift; rem = sh[1];
    }
    __syncthreads();
    const unsigned T = prefix;
    int neq = 0;
#pragma unroll
    for (int i = 0; i < PER; ++i) neq += (valid[i] && key[i] == T) ? 1 : 0;
    const int eqbase = block_excl_scan(neq, ws8, lane, wave);
    unsigned take = 0u; int nsel = 0, eqs = 0;
#pragma unroll
    for (int i = 0; i < PER; ++i) { const bool iseq = valid[i] && key[i] == T; const bool tk = valid[i] && (key[i] > T || (iseq && (unsigned)(eqbase + eqs) < rem)); eqs += iseq ? 1 : 0; if (tk) { take |= 1u << i; ++nsel; } }
    const int sb = block_excl_scan(nsel, ws8, lane, wave);
    int cnt = 0;
#pragma unroll
    for (int i = 0; i < PER; ++i) { const int tok = tid * PER + i;
        if (valid[i]) { if ((take >> i) & 1u) { const int slot = sbase + sb + cnt; ++cnt; IDX[e * ESTR + slot] = rowbase + tok; GATE[e * ESTR + slot] = akey_inv(key[i]); SEL[(size_t)(rowbase + tok) * 16 + e] = slot; }
                        else SEL[(size_t)(rowbase + tok) * 16 + e] = -1; } }
    if (writepad) for (int i = tid; i < ESTR - 2112; i += 512) { IDX[e * ESTR + 2112 + i] = 0; GATE[e * ESTR + 2112 + i] = 0.f; }
    __syncthreads();
}
__device__ __forceinline__ void gather_rows(PH_ARGS, const int tpe) {
    const int gw = bid * 8 + wave, NGW = G * 8, per = tpe * 256; const int* IDX = WSP(int, WS_IDX); const bf16* H = WSP(bf16, WS_H); bf16* XE = WSP(bf16, WS_XE);
    for (int i = gw; i < NE * per; i += NGW) { const int e = i / per, s = i % per, rg = e * ESTR + s; const int src = IDX[rg];
        const v4u a = *(const v4u*)(H + (size_t)src * 1024 + lane * 8), b = *(const v4u*)(H + (size_t)src * 1024 + 512 + lane * 8);
        *(v4u*)(XE + (size_t)rg * 1024 + lane * 8) = a; *(v4u*)(XE + (size_t)rg * 1024 + 512 + lane * 8) = b; }
}
struct CRow { v4u yw[4][2]; f32x4 xin[2][2]; float wgt[4]; unsigned long long bm; int cur; };
struct CCtx { const int* SEL; const bf16* YB; const float* X; bf16* H; const float* MOD; float* XO; float* OUT; const float* gnext; int l, lane; };
__device__ __forceinline__ void cr_issue(const CCtx& C, CRow& R, const int row) {
    const int lane = C.lane;
    R.cur = lane < 16 ? C.SEL[(size_t)row * 16 + lane] : -1;
    R.bm = __ballot(R.cur >= 0); const int cnt = __popcll(R.bm);
#pragma unroll
    for (int k = 0; k < 4; ++k) { const bool has = cnt > k; const int e = has ? (int)__builtin_ctzll(R.bm) : 0; if (has) R.bm &= R.bm - 1; const int s = __shfl(R.cur, e); R.wgt[k] = has ? 1.f : 0.f;
        const bf16* y = C.YB + (size_t)(has ? e * ESTR + s : 0) * 1024 + lane * 8; R.yw[k][0] = *(const v4u*)y; R.yw[k][1] = *(const v4u*)(y + 512); }
    const float* xr = C.X + (size_t)row * 1024;
#pragma unroll
    for (int j = 0; j < 2; ++j) { const int o = 8 * lane + 512 * j; R.xin[j][0] = *(const f32x4*)(xr + o); R.xin[j][1] = *(const f32x4*)(xr + o + 4); }
}
__device__ __forceinline__ void cr_finish(const CCtx& C, CRow& R, const int row) {
    const int lane = C.lane, l = C.l; const int r = row < SEQ ? 0 : (row < ML ? 1 : 2);
    float acc[2][8];
#pragma unroll
    for (int j = 0; j < 2; ++j)
#pragma unroll
        for (int i = 0; i < 8; ++i) acc[j][i] = 0.f;
#pragma unroll
    for (int k = 0; k < 4; ++k)
#pragma unroll
        for (int j = 0; j < 2; ++j) { const v4u w = R.yw[k][j]; const float g = R.wgt[k];
            acc[j][0] += g * bflo(w.x); acc[j][1] += g * bfhi(w.x); acc[j][2] += g * bflo(w.y); acc[j][3] += g * bfhi(w.y); acc[j][4] += g * bflo(w.z); acc[j][5] += g * bfhi(w.z); acc[j][6] += g * bflo(w.w); acc[j][7] += g * bfhi(w.w); }
    while (R.bm) { const int e = (int)__builtin_ctzll(R.bm); R.bm &= R.bm - 1; const int s = __shfl(R.cur, e); const bf16* y = C.YB + (size_t)(e * ESTR + s) * 1024 + lane * 8;
#pragma unroll
        for (int j = 0; j < 2; ++j) { const v4u w = *(const v4u*)(y + 512 * j);
            acc[j][0] += bflo(w.x); acc[j][1] += bfhi(w.x); acc[j][2] += bflo(w.y); acc[j][3] += bfhi(w.y); acc[j][4] += bflo(w.z); acc[j][5] += bfhi(w.z); acc[j][6] += bflo(w.w); acc[j][7] += bfhi(w.w); } }
    const float* gt2 = C.MOD + (l * 3 + r) * 6144 + 5 * 1024;
    float xv[2][8]; float ss = 0.f;
#pragma unroll
    for (int j = 0; j < 2; ++j) { const int o = 8 * lane + 512 * j; const f32x4 g0 = *(const f32x4*)(gt2 + o), g1 = *(const f32x4*)(gt2 + o + 4);
#pragma unroll
        for (int i = 0; i < 4; ++i) { xv[j][i] = R.xin[j][0][i] + g0[i] * acc[j][i]; xv[j][4 + i] = R.xin[j][1][i] + g1[i] * acc[j][4 + i]; }
#pragma unroll
        for (int i = 0; i < 8; ++i) ss += xv[j][i] * xv[j][i]; }
    const float rs = 1.0f / sqrtf(wave_sum(ss) * (1.f / 1024.f) + 1e-6f);
    if (l == 0) {
        const float* md = C.MOD + (1 * 3 + r) * 6144; float* xw = C.XO + (size_t)row * 1024;
#pragma unroll
        for (int j = 0; j < 2; ++j) { const int o = 8 * lane + 512 * j;
            *(f32x4*)(xw + o) = (f32x4){xv[j][0], xv[j][1], xv[j][2], xv[j][3]}; *(f32x4*)(xw + o + 4) = (f32x4){xv[j][4], xv[j][5], xv[j][6], xv[j][7]};
            const f32x4 g0 = *(const f32x4*)(C.gnext + o), g1 = *(const f32x4*)(C.gnext + o + 4), c0 = *(const f32x4*)(md + 1024 + o), c1 = *(const f32x4*)(md + 1024 + o + 4), h0 = *(const f32x4*)(md + o), h1 = *(const f32x4*)(md + o + 4);
            float hv[8];
#pragma unroll
            for (int i = 0; i < 4; ++i) { hv[i] = xv[j][i] * rs * g0[i] * (1.f + c0[i]) + h0[i]; hv[4 + i] = xv[j][4 + i] * rs * g1[i] * (1.f + c1[i]) + h1[i]; }
            v4u w; w.x = pk2(hv[0], hv[1]); w.y = pk2(hv[2], hv[3]); w.z = pk2(hv[4], hv[5]); w.w = pk2(hv[6], hv[7]);
            *(v4u*)(C.H + (size_t)row * 1024 + o) = w; }
    } else {
        float* orow = C.OUT + (size_t)row * 1024;
#pragma unroll
        for (int j = 0; j < 2; ++j) { const int o = 8 * lane + 512 * j; const f32x4 g0 = *(const f32x4*)(C.gnext + o), g1 = *(const f32x4*)(C.gnext + o + 4);
            *(f32x4*)(orow + o) = (f32x4){xv[j][0] * rs * g0[0], xv[j][1] * rs * g0[1], xv[j][2] * rs * g0[2], xv[j][3] * rs * g0[3]};
            *(f32x4*)(orow + o + 4) = (f32x4){xv[j][4] * rs * g1[0], xv[j][5] * rs * g1[1], xv[j][6] * rs * g1[2], xv[j][7] * rs * g1[3]}; }
    }
}
template <bool DUMMY>
__device__ __forceinline__ void combine_rows(PH_ARGS, const int l) {
    const int gw = bid * 8 + wave, NGW = G * 8; const int nrows = l == 0 ? MT : ML;
    CCtx C; C.SEL = WSP(int, WS_SEL); C.YB = WSP(bf16, WS_XE); C.X = WSP(float, WS_X); C.H = DUMMY ? WSP(bf16, WS_BR) : WSP(bf16, WS_H); C.MOD = WSP(float, WS_MOD);
    C.XO = DUMMY ? WSP(float, WS_ACT) : WSP(float, WS_X); C.OUT = DUMMY ? WSP(float, WS_ACT) : PTRV(28, float); C.gnext = l == 0 ? INP(6) + 1024 : INP(27); C.l = l; C.lane = lane;
    CRow A, B; int row = gw;
    if (row < nrows) cr_issue(C, A, row);
    while (row < nrows) {
        const int r2 = row + NGW; if (r2 < nrows) cr_issue(C, B, r2);
        cr_finish(C, A, row);
        const int r3 = r2 + NGW; if (r3 < nrows) cr_issue(C, A, r3);
        if (r2 < nrows) cr_finish(C, B, r2);
        row = r3;
    }
}

#ifdef DBG_STOP
__device__ __forceinline__ void debug_out(PH_ARGS) {
    float* out = PTRV(28, float);
    const int gt = bid * 512 + tid, GT = G * 512;
    for (size_t i = gt; i < (size_t)ML * 1024; i += GT) { const size_t row = i >> 10; const int c = (int)(i & 1023); float v = 0.f;
#if DBG_STOP == 2
        v = bflo(WSP(bf16, WS_H)[row * 1024 + c]) + WSP(float, WS_MOD)[(i % 36864)] + bflo(WSP(bf16, WS_WIN)[i % (6400 * 1024)]) + bflo(WSP(bf16, WS_WGU)[i]) + bflo(WSP(bf16, WS_WDN)[i]) + bflo(WSP(bf16, WS_WO)[i % (1024*1024)]) + bflo(WSP(bf16, WS_WBR)[i % (1024*1024)]);
#elif DBG_STOP == 3
        v = bflo(WSP(bf16, WS_AUV)[row * 512 + (c & 511)]) + bflo(WSP(bf16, WS_YF)[row * 512 + (c & 511)]) + bflo(WSP(bf16, WS_CY)[row * 256 + (c & 255)]) + bflo(WSP(bf16, WS_QPL)[row * 256 + (c & 255)])
          + bflo(WSP(bf16, WS_QROT)[row * 256 + (c & 255)]) + bflo(WSP(bf16, WS_KR)[row * 256 + (c & 255)]) + bflo(WSP(bf16, WS_VV)[row * 256 + (c & 255)])
          + bflo(WSP(bf16, WS_G)[row * 4096 + c]) + bflo(WSP(bf16, WS_G)[row * 4096 + 1024 + c]) + bflo(WSP(bf16, WS_G)[row * 4096 + 2048 + c]) + bflo(WSP(bf16, WS_G)[row * 4096 + 3072 + c]);
#elif DBG_STOP == 4
        v = bflo(WSP(bf16, WS_BR)[(size_t)(0 * MT + row) * 256 + (c & 255)]) + bflo(WSP(bf16, WS_BR)[(size_t)(2 * MT + row) * 256 + (c & 255)]) + bflo(WSP(bf16, WS_FA)[i % ((size_t)8 << 20)]);
#elif DBG_STOP == 21
        v = bflo(WSP(bf16, WS_T1T)[i % 16384]) * 1.001f + WSP(float, WS_ROPEC)[i % 2048] + WSP(float, WS_ROPES)[i % 2048] + bflo(WSP(bf16, WS_WSP)[i % 65536]);
#elif DBG_STOP == 31 || DBG_STOP == 44
        v = 0.f;
#elif DBG_STOP == 45 || DBG_STOP == 32
        v = 0.f;
#elif DBG_STOP == 41
        v = bflo(WSP(bf16, WS_BR)[(size_t)(0 * MT + row) * 256 + (c & 255)]) * 1.001f + bflo(WSP(bf16, WS_BR)[(size_t)(0 * MT + row) * 256 + ((c + 7) & 255)]);
#elif DBG_STOP == 42
        v = bflo(WSP(bf16, WS_BR)[(size_t)(2 * MT + row) * 256 + (c & 255)]) * 1.001f + bflo(WSP(bf16, WS_BR)[(size_t)(2 * MT + row) * 256 + ((c + 7) & 255)]);
#elif DBG_STOP == 43
        v = bflo(WSP(bf16, WS_FA)[i % ((size_t)8 << 20)]) * 1.001f + bflo(WSP(bf16, WS_FA)[(i + 7) % ((size_t)8 << 20)]);
#elif DBG_STOP == 5
        v = bflo(WSP(bf16, WS_BR)[(size_t)(1 * MT + row) * 256 + (c & 255)]) + bflo(WSP(bf16, WS_BR)[(size_t)(3 * MT + row) * 256 + (c & 255)]);
#elif DBG_STOP == 6
        v = bflo(WSP(bf16, WS_MB)[row * 1024 + c]);
#elif DBG_STOP == 7
        v = WSP(float, WS_X)[row * 1024 + c];
#elif DBG_STOP == 8
        v = bflo(WSP(bf16, WS_H)[row * 1024 + c]) + WSP(float, WS_AFF)[row * 16 + (c & 15)];
#elif DBG_STOP == 9
        v = (float)WSP(int, WS_SEL)[row * 16 + (c & 15)] + WSP(float, WS_GATE)[i % (16 * 2304)] + (float)WSP(int, WS_IDX)[i % (16 * 2304)];
#elif DBG_STOP == 10
        v = bflo(WSP(bf16, WS_XE)[i]) + bflo(WSP(bf16, WS_XE)[i + (size_t)ML * 1024]);
#elif DBG_STOP == 11
        v = bflo(WSP(bf16, WS_ACT)[i]) + bflo(WSP(bf16, WS_ACT)[i + (size_t)ML * 1024]);
#elif DBG_STOP == 12
        v = bflo(WSP(bf16, WS_XE)[i]) + bflo(WSP(bf16, WS_XE)[i + (size_t)ML * 1024]);
#else
        v = WSP(float, WS_X)[row * 1024 + c] + bflo(WSP(bf16, WS_H)[row * 1024 + c]);
#endif
#ifdef DBG_AMP
        v = (float)(__float_as_uint(v) & 0xFFFFu);
#endif
        out[i] = v; }
}
#endif
__global__ void __launch_bounds__(512, 2) mega(Args A) {
    extern __shared__ __attribute__((aligned(16))) unsigned char lds_raw[];
    LAS unsigned char* lds0 = (LAS unsigned char*)lds_raw;
    volatile LAS unsigned* MISC = (volatile LAS unsigned*)(lds0 + MISC_OFF);
    const int tid = threadIdx.x, lane = tid & 63, wave = __builtin_amdgcn_readfirstlane(tid >> 6), bid = blockIdx.x, G = gridDim.x;
    for (int u = tid; u < (LDS_BYTES - MISC_OFF) / 4; u += 512) ((LAS unsigned*)(lds0 + MISC_OFF))[u] = 0u;
    __syncthreads();
    if (tid == 0) { typedef unsigned u2v_t __attribute__((ext_vector_type(2)));
#pragma unroll
        for (int i = 0; i < 30; ++i) { const unsigned long long p = i < 28 ? (unsigned long long)A.in[i] : (i == 28 ? (unsigned long long)A.out : (unsigned long long)A.ws);
            *(LAS u2v_t*)(lds0 + PTAB_OFF + 8 * i) = (u2v_t){(unsigned)p, (unsigned)(p >> 32)}; } }
    __syncthreads();
    const int lo = A.ph_lo, hi = A.ph_hi;
    XcdBarrier bar; bar.bar = (unsigned*)(A.ws + WS_CTL) + CW_BAR; bar.x = 0; bar.st = nullptr;
    if (hi - lo > 1) bar = xcd_barrier_post((unsigned*)(A.ws + WS_CTL) + CW_BAR, MISC + 8);
#define PH_CALL lds, tl_, (tl_ & 63), wv_, bl_, G_
#define PH_CALLV lds, tl_, (tl_ & 63), wv_, vb_, G_
#ifdef TS_I
    if (bid == 0 && tid == 0) ((unsigned long long*)(A.ws + 65536))[lo] = rt();
#endif
    if (lo == 0) {
        int tl_ = tid; asm volatile("" : "+v"(tl_)); int bl_ = bid; asm volatile("" : "+s"(bl_)); int wv_ = wave; asm volatile("" : "+s"(wv_)); int G_ = G; asm volatile("" : "+s"(G_));
        unsigned ldsb_ = (unsigned)(uintptr_t)lds0; asm volatile("" : "+s"(ldsb_)); LAS unsigned char* lds = (LAS unsigned char*)(uintptr_t)ldsb_;
#ifndef P0R_MOD
#define P0R_MOD 1
#endif
#ifndef P0R_TAB
#define P0R_TAB 1
#endif
#ifndef P0R_CVT
#define P0R_CVT 1
#endif
#pragma unroll 1
            for (int r_ = 0; r_ < P0R_MOD; ++r_) { mod_gemv(PH_CALL); asm volatile("" ::: "memory"); }
#pragma unroll 1
            for (int r_ = 0; r_ < P0R_TAB; ++r_) { make_tables(PH_CALL); asm volatile("" ::: "memory"); }
#pragma unroll 1
            for (int r_ = 0; r_ < P0R_CVT; ++r_) { convert_range(lds, tl_, (tl_ & 63), wv_, bl_, G_, 0, CV_FOLD0, CV_GU0, bl_, G_); convert_range(lds, tl_, (tl_ & 63), wv_, bl_, G_, 0, CV_SP0, CV_END, bl_, G_); asm volatile("" ::: "memory"); }
        if (hi > 1) { XcdBarrier b2 = bar; b2.bar = (unsigned*)(PTRV(29, unsigned char) + WS_CTL) + CW_BAR; b2.st = (volatile LAS unsigned*)(lds + MISC_OFF) + 8; xcd_barrier(b2); }
    }
    const int lo1 = lo < 1 ? 1 : lo;
#pragma unroll 1
#ifdef REP_PH
    for (int it_ = lo1; it_ < hi + (REP_N - 1); ++it_) { const int ph = it_ < REP_PH ? it_ : (it_ < REP_PH + REP_N ? REP_PH : it_ - (REP_N - 1));
#else
    for (int ph = lo1; ph < hi; ++ph) {
#endif
        int tl_ = tid; asm volatile("" : "+v"(tl_)); int bl_ = bid; asm volatile("" : "+s"(bl_)); int vb_ = (G % 8 == 0) ? (bid % 8) * (G / 8) + bid / 8 : bid; asm volatile("" : "+s"(vb_)); int wv_ = wave; asm volatile("" : "+s"(wv_)); int G_ = G; asm volatile("" : "+s"(G_)); unsigned ldsb_ = (unsigned)(uintptr_t)lds0; asm volatile("" : "+s"(ldsb_)); LAS unsigned char* lds = (LAS unsigned char*)(uintptr_t)ldsb_;
        const int l = ph < 13 ? 0 : 1, kind = ph >= 99 ? 99 : (ph < 2 ? ph : 2 + (ph - 2 - 11 * l));
        const int ntm = l == 0 ? 66 : 64, tpe = l == 0 ? 9 : 8;
        if (kind == 9) continue;
        switch (kind) {
#ifdef DBG_STOP
        case 99: debug_out(PH_CALL); break;
#endif
        case 0: break;
        case 1: {
#ifndef DIS_N1
            norm1_l0(PH_CALL);
#endif
        } break;
        case 2: {
            pg8::Gemm g{WSP(bf16, WS_H), WSP(bf16, WS_WIN), MT, NIN, 1024}; pg8::StaticOrder S; S.init(MT, NIN, G_, bl_);
            EpiIn E{WSP(bf16, WS_AUV), WSP(bf16, WS_YF), WSP(bf16, WS_CY), WSP(bf16, WS_QPL), WSP(bf16, WS_QROT), WSP(bf16, WS_KR), WSP(bf16, WS_VV), WSP(bf16, WS_G), WSP(float, WS_ROPEC), WSP(float, WS_ROPES)};
#ifndef DIS_GIN
            pg8::gemm_phase<EpiIn, pg8::StaticOrder, true, true>(lds, g, S, E);
#endif
#ifndef DIS_CVT
            if (l == 0) { const int nx = ((MT / 256) * (NIN / 256)) % G_; convert_range(lds, tl_, (tl_ & 63), wv_, bl_, G_, 0, CV_GU0, CV_DN0, nx ? bl_ - nx : bl_, G_ - nx); }
#endif
        } break;
        case 3: {
#ifndef DIS_F1
            if (bl_ < 256) { f1_stage_tables(PH_CALL); for (int u = vb_; u < 256; u += G_) f1_unit(PH_CALL, u); }
#endif
#ifndef DIS_CDFT
            if (l == 0) ctx_butterfly(PH_CALL);
#endif
            __syncthreads();
            { LAS float* rp = (LAS float*)(lds + AT_RPB); const float* src = INP(20) + l * 1860;
              for (int i = tl_; i < 2048; i += 512) { const int hh = i >> 9, rw = (i >> 5) & 15, cc = i & 31; rp[i] = rw < 15 ? (cc < 31 ? src[hh * 465 + rw * 31 + cc] * 1.4426950408889634f : -3.0e38f) : 0.f; } }
            __syncthreads();
#ifndef DIS_ATT
            { const int nat = l == 0 ? 264 : 256; for (int u = vb_; u < nat; u += G_) attn_unit(PH_CALL, u); }
#endif
        } break;
        case 4: {
#ifndef DIS_F2
            for (int u = vb_; u < 256; u += G_) f2_unit(PH_CALL, u);
#endif
#ifndef DIS_CONV
            for (int u = vb_; u < 256; u += G_) conv_unit(PH_CALL, l, u);
#endif
#ifndef DIS_GMLP
            for (int u = G_ - 1 - vb_; u < 128; u += G_) gmlp_unit(PH_CALL, l, u);
#endif
            if (l == 0) {
                const bool big = G_ >= 128;
                for (int u = big ? vb_ - 8 : vb_; u >= 0 && u < 8; u += G_) f2_unit(PH_CALL, 256 + u);
                for (int u = big ? vb_ - 16 : vb_; u >= 0 && u < 8; u += G_) conv_unit(PH_CALL, l, 256 + u);
                for (int u = big ? vb_ - 24 : vb_; u >= 0 && u < 4; u += G_) gmlp_unit(PH_CALL, l, 128 + u);
            }
        } break;
        case 5: {
#ifndef DIS_GMRG
#ifndef MERGE_PG8
            merge_phase(PH_CALLV, ntm * 16);
#ifndef DIS_CVT
            if (l == 0) { const int nx = (ntm * 16) % G_; convert_range(lds, tl_, (tl_ & 63), wv_, vb_, G_, 0, CV_DN0, CV_SP0, nx ? vb_ - nx : vb_, G_ - nx); }
#endif
#else
            { pg8::Gemm g{WSP(bf16, WS_BR), WSP(bf16, WS_WBR), 4 * MT, 4096, 256}; MergeOrder S; S.init(ntm, G_, bl_); EpiMergeH E{WSP(bf16, WS_G), WSP(bf16, WS_MB)};
              pg8::gemm_phase<EpiMergeH, MergeOrder, true, true>(lds, g, S, E); }
#endif
#endif
        } break;
        case 6: {
            pg8::Gemm g{WSP(bf16, WS_MB), WSP(bf16, WS_WO), ML, 1024, 1024}; pg8::StaticOrder S; S.init(ML, 1024, G_, bl_);
            EpiWout E{l == 0 ? INP(0) : WSP(float, WS_X), l == 0 ? INP(2) : WSP(float, WS_X) + (size_t)ML * 1024, WSP(float, WS_X), WSP(float, WS_MOD) + l * 3 * 6144};
#ifndef DIS_GWO
            pg8::gemm_phase<EpiWout, pg8::StaticOrder, true, true>(lds, g, S, E);
#endif
#ifndef DIS_CVT
            if (l == 0) { const int nx = (64 * 4) % G_; convert_range(lds, tl_, (tl_ & 63), wv_, bl_, G_, 1, CV_FOLD0, CV_WO0, nx ? bl_ - nx : bl_, G_ - nx); }
#endif
        } break;
        case 7: {
#ifndef DIS_N2
            if (l == 0 && G_ > 16) {
                unsigned* cnt = (unsigned*)(PTRV(29, unsigned char) + WS_CTL) + 2048;
                if (bl_ < 8) {
                    pg8::Gemm g{WSP(bf16, WS_MB), WSP(bf16, WS_WO), MT, 1024, 1024}; OneUnit S{64 + (bl_ >> 2), bl_ & 3};
                    EpiWout E{INP(0), INP(2), WSP(float, WS_X), WSP(float, WS_MOD)};
                    pg8::gemm_phase<EpiWout, OneUnit, true, true>(lds, g, S, E);
                    asm volatile("s_waitcnt vmcnt(0)" ::: "memory"); __syncthreads();
                    if (tl_ == 0) { __builtin_amdgcn_fence(__ATOMIC_RELEASE, "agent"); asm volatile("s_waitcnt vmcnt(0)" ::: "memory"); __hip_atomic_fetch_add(cnt, 1u, __ATOMIC_RELAXED, __HIP_MEMORY_SCOPE_AGENT); }
                } else norm2_router(PH_CALL, l, 0, ML, bl_ - 8, G_ - 8);
                if (tl_ == 0) { unsigned sp_ = 0; while (__hip_atomic_load(cnt, __ATOMIC_RELAXED, __HIP_MEMORY_SCOPE_AGENT) < 8u && ++sp_ < (1u << 22)) __builtin_amdgcn_s_sleep(2);
                    __builtin_amdgcn_fence(__ATOMIC_ACQUIRE, "agent"); asm volatile("s_waitcnt vmcnt(0)" ::: "memory"); }
                __syncthreads();
                norm2_router(PH_CALL, l, ML, MC, bl_, G_, bl_ < 8);
            } else norm2_router(PH_CALL, l, 0, ntm * 256, bl_, G_);
#endif
        } break;
        case 8: {
#ifndef DIS_TOPK
            const int nun = l == 0 ? 64 : 32;
            for (int u = bl_; u < nun; u += G_) {
                if (u < 32) { const int b = u >> 4, e = u & 15; topk_unit<16, true>(PH_CALL, b * SEQ, SEQ, CAPL, e, b * CAPL, l == 0 && b == 0); }
                else { const int b = (u - 32) >> 4, e = u & 15; topk_unit<1, false>(PH_CALL, ML + b * CTXL, CTXL, CAPC, e, 2048 + b * CAPC, false); }
            }
#endif
        } break;
        case 9: {
#ifndef DIS_GATH
            gather_rows(PH_CALL, tpe);
#endif
        } break;
        case 10: {
            pg8::Gemm g{WSP(bf16, WS_H), WSP(bf16, WS_WGU), NE * ESTR, NE * 2048, 1024, WSP(int, WS_IDX)}; GroupOrder S; S.init(tpe, 8, G_, bl_);
            EpiGU E{WSP(bf16, WS_ACT)};
#ifndef DIS_GGU
            pg8::gemm_phase<EpiGU, GroupOrder, true, true, true>(lds, g, S, E);
#endif
#ifndef DIS_CVT
            if (l == 0) { const int nx = (NE * tpe * 8) % G_; convert_range(lds, tl_, (tl_ & 63), wv_, bl_, G_, 1, CV_WO0, CV_GU0, nx ? bl_ - nx : bl_, G_ - nx);
                          convert_range(lds, tl_, (tl_ & 63), wv_, bl_, G_, 1, CV_SP0, CV_END, nx ? bl_ - nx : bl_, G_ - nx); }
#endif
        } break;
        case 11: {
            pg8::Gemm g{WSP(bf16, WS_ACT), WSP(bf16, WS_WDN), NE * ESTR, NE * 1024, 1024}; GroupOrder S; S.init(tpe, 4, G_, bl_);
            EpiDown E{WSP(bf16, WS_XE), WSP(float, WS_GATE)};
#ifndef DIS_GDN
            pg8::gemm_phase<EpiDown, GroupOrder, true, true>(lds, g, S, E);
#endif
#ifndef DIS_CVT
            if (l == 0) { const int nx = (NE * tpe * 4) % G_; convert_range(lds, tl_, (tl_ & 63), wv_, bl_, G_, 1, CV_GU0, CV_DN0, nx ? bl_ - nx : bl_, G_ - nx); }
#endif
        } break;
        default: {
#ifndef DIS_COMB
#ifdef COMB_REP
#pragma unroll 1
            for (int r_ = 0; r_ < COMB_REP; ++r_) combine_rows<true>(PH_CALL, l);
#endif
            combine_rows<false>(PH_CALL, l);
#endif
#ifndef DIS_CVT
            if (l == 0) convert_range(lds, tl_, (tl_ & 63), wv_, bl_, G_, 1, CV_DN0, CV_SP0, bl_, G_);
#endif
        } break;
        }
#ifdef XBAR
        if (ph == 1) { for (int xb_ = 0; xb_ < XBAR; ++xb_) { XcdBarrier b5 = bar; b5.bar = (unsigned*)(PTRV(29, unsigned char) + WS_CTL) + CW_BAR; b5.st = (volatile LAS unsigned*)(lds + MISC_OFF) + 8; xcd_barrier(b5); } }
#endif
#ifdef TS_I
        { XcdBarrier b3 = bar; b3.bar = (unsigned*)(PTRV(29, unsigned char) + WS_CTL) + CW_BAR; b3.st = (volatile LAS unsigned*)(lds + MISC_OFF) + 8; xcd_barrier(b3);
          if (bid == 0 && tid == 0) ((unsigned long long*)(PTRV(29, unsigned char) + 65536))[ph + 1] = rt(); }
        if (ph + 1 == hi) { XcdBarrier b3 = bar; b3.bar = (unsigned*)(PTRV(29, unsigned char) + WS_CTL) + CW_BAR; b3.st = (volatile LAS unsigned*)(lds + MISC_OFF) + 8; xcd_barrier(b3);
            const unsigned long long* TS = (const unsigned long long*)(PTRV(29, unsigned char) + 65536);
            const float dti = (float)(TS[TS_I + 1] - TS[TS_I]) * 0.01f, dtj = (float)(TS[TS_J + 1] - TS[TS_J]) * 0.01f;
            float* out = PTRV(28, float); const float Av = sqrtf(dti);
            for (size_t i = (size_t)bid * 512 + tid; i < (size_t)ML * 1024; i += (size_t)G * 512) out[i] = (i == 0) ? dtj * 10.f : Av; }
        if (0) {
#else
#ifdef REP_PH
        if (it_ + 1 < hi + (REP_N - 1)) {
#else
        if (ph + 1 < hi) {
#endif
#endif
          XcdBarrier b2 = bar; b2.bar = (unsigned*)(PTRV(29, unsigned char) + WS_CTL) + CW_BAR; unsigned bx_ = bar.x; asm volatile("" : "+s"(bx_)); b2.x = bx_; b2.st = (volatile LAS unsigned*)(lds + MISC_OFF) + 8; xcd_barrier(b2); }
    }
}

extern "C" void kernel_launch(void* const* d_in, const int* in_sizes, int n_in, void* d_out, int out_size, void* d_ws, size_t ws_size, hipStream_t stream) {
    static int grid = 0;
    if (grid == 0) {
        if (n_in != 28 || ws_size < WS_END) { fprintf(stderr, "kernel_launch: unexpected n_in %d / ws %zu\n", n_in, ws_size); grid = -1; return; }
        int dev = 0, cus = 0;
        if (hipGetDevice(&dev) != hipSuccess || hipDeviceGetAttribute(&cus, hipDeviceAttributeMultiprocessorCount, dev) != hipSuccess) { grid = -1; return; }
        if (hipFuncSetAttribute((const void*)mega, hipFuncAttributeMaxDynamicSharedMemorySize, LDS_BYTES) != hipSuccess) { fprintf(stderr, "kernel_launch: hipFuncSetAttribute failed\n"); grid = -1; return; }
        (void)hipGetLastError();
        grid = cus;
    }
    if (grid < 0) return;
    (void)hipMemsetAsync((char*)d_ws + WS_CTL, 0, CTL_ZERO_BYTES, stream);
    Args a{};
    for (int i = 0; i < 28; ++i) a.in[i] = (const float*)d_in[i];
    a.out = (float*)d_out; a.ws = (unsigned char*)d_ws;
#ifdef DBG_STOP
    for (int p = 0; p < (DBG_STOP > 20 ? DBG_STOP / 10 : DBG_STOP); ++p) { a.ph_lo = p; a.ph_hi = p + 1; hipLaunchKernelGGL(mega, dim3(grid), dim3(512), LDS_BYTES, stream, a); }
    a.ph_lo = 99; a.ph_hi = 100; hipLaunchKernelGGL(mega, dim3(grid), dim3(512), LDS_BYTES, stream, a);
#elif N_LAUNCHES == 1
    a.ph_lo = 0; a.ph_hi = NPH;
    hipLaunchKernelGGL(mega, dim3(grid), dim3(512), LDS_BYTES, stream, a);
#else
    for (int p = 0; p < NPH; ++p) { a.ph_lo = p; a.ph_hi = p + 1; hipLaunchKernelGGL(mega, dim3(grid), dim3(512), LDS_BYTES, stream, a); }
#endif
}
```

```cpp
#include <hip/hip_runtime.h>
#include <cstdio>
#include <cstdint>
#define N_LAUNCHES 1
namespace pg8 {
#define PG8_LAS __attribute__((address_space(3)))
typedef unsigned short bf16_t;
typedef short bf16x8 __attribute__((ext_vector_type(8)));
typedef float f32x4 __attribute__((ext_vector_type(4)));
typedef unsigned u32x4 __attribute__((ext_vector_type(4)));
constexpr int BM = 256, BK = 64, HALF = 128, HTB = HALF * BK * 2  , STAGE_BYTES = 8 * HTB, NXCD = 8, WGM = 4;

__host__ __device__ __forceinline__ int lds_byte(int r, int c) { const int st = (r >> 4) * 2 + (c >> 5), rr = r & 15, cc = c & 31, ob = rr * 64 + cc * 2; return st * 1024 + (ob ^ (((ob >> 9) & 1) << 5)); }
__host__ __device__ __forceinline__ void stage_rc(int b, int& R, int& C) { const int st = b / 1024, sb = b % 1024, swz = sb ^ (((sb >> 9) & 1) << 5); R = (st >> 1) * 16 + swz / 64; C = (st & 1) * 32 + (swz % 64) / 2; }
__host__ __device__ __forceinline__ int perm32(int rho) { const int n = rho >> 4, i = rho & 15; return 8 * (i >> 2) + 4 * n + (i & 3); }

struct Unit { int pm, pn; };
struct Gemm { const bf16_t* A; const bf16_t* Bt; int M, N, K; const int* gidx = nullptr; };

struct StaticOrder {
    int nM, nN, nwg, G, c;
    __host__ __device__ void init(int M, int N, int G_, int c_) { nM = M / BM; nN = N / BM; nwg = nM * nN; G = G_; c = c_; }
    __host__ __device__ bool next(int i, Unit& u) const {
        const long L = (long)i * G + c; if (L >= nwg) return false;
        int wgid = (int)L; { const int q = nwg / NXCD, r = nwg % NXCD, xcd = wgid % NXCD, off = wgid / NXCD; wgid = (xcd < r ? xcd * (q + 1) : r * (q + 1) + (xcd - r) * q) + off; }
        const int nig = WGM * nN, gid = wgid / nig, fm = gid * WGM, gsz = (nM - fm) < WGM ? (nM - fm) : WGM;
        u.pm = fm + ((wgid % nig) % gsz); u.pn = (wgid % nig) / gsz; return true;
    }
    __device__ __forceinline__ void a_ready(const Unit&) const {}
    __device__ __forceinline__ void done(const Unit&) const {}
};
__device__ __forceinline__ unsigned cvt_pk_bf16(float lo, float hi) { unsigned r; asm volatile("v_cvt_pk_bf16_f32 %0, %1, %2" : "=v"(r) : "v"(lo), "v"(hi)); return r; }
typedef float f32x2 __attribute__((ext_vector_type(2)));
template <class Epi, class Sched, bool ALIGN_EPI = false, bool SP2 = false, bool GATHER = false>
__device__ __forceinline__ void gemm_phase(PG8_LAS unsigned char* lds, const Gemm g, const Sched& S, const Epi& E) {
    int tid_l = threadIdx.x; asm volatile("" : "+v"(tid_l));
    const int tid = tid_l, wid = __builtin_amdgcn_readfirstlane(tid >> 6), lane = tid & 63, wr = wid >> 2, wc = wid & 3, fr = lane & 15, fq = lane >> 4;
    const int K = g.K, nt = K / BK;
    unsigned voffA[2], voffB[2];
#pragma unroll
    for (int i = 0; i < 2; ++i) { int R, C; stage_rc(tid * 16 + i * 8192, R, C); const int Rb = Epi::PERM ? ((R & ~31) + perm32(R & 31)) : R;
        voffA[i] = (unsigned)(R * K + C) * 2u; voffB[i] = (unsigned)(Rb * K + C) * 2u; }
    const size_t kstep = (size_t)(BK * 2);
    const size_t hstep = (size_t)HALF * K * 2;
    const size_t tstep = 2 * hstep;
    const unsigned ldsw = (unsigned)wid * 1024u;
    const int aoff = lds_byte(wr * 64 + fr, fq * 8), boff = lds_byte(wc * 32 + fr, fq * 8);
#define PG8_SA(b, h) (((b) * 2 + (h)) * HTB)
#define PG8_SB(b, h) ((4 + (b) * 2 + (h)) * HTB)
#define PG8_STAGE(bufoff, gbase, voff) do { _Pragma("unroll") for (int _i = 0; _i < 2; ++_i) \
        __builtin_amdgcn_global_load_lds((const unsigned*)((const char*)(gbase) + (voff)[_i]), (PG8_LAS unsigned*)(lds + (bufoff) + ldsw + _i * 8192), 16, 0, 0); } while (0)
    static_assert(!GATHER || SP2, "GATHER is implemented on the SP2 loop only");
    unsigned vgc[2][2] = {{0u, 0u}, {0u, 0u}}, vgn[2][2] = {{0u, 0u}, {0u, 0u}};
#define PG8_GLOAD(u, v) do { _Pragma("unroll") for (int _h = 0; _h < 2; ++_h) _Pragma("unroll") for (int _i = 0; _i < 2; ++_i) { int R_, C_; stage_rc(tid * 16 + _i * 8192, R_, C_); \
        v[_h][_i] = (unsigned)(g.gidx[(u).pm * BM + _h * HALF + R_] * K + C_) * 2u; } } while (0)
#define PG8_STAGE_A(bufoff, base, half, NEXT) do { if constexpr (GATHER) { if (NEXT) PG8_STAGE(bufoff, base, vgn[half]); else PG8_STAGE(bufoff, base, vgc[half]); } \
        else PG8_STAGE(bufoff, (base) + (half) * hstep, voffA); } while (0)
#define PG8_LDA(dst, b, h) do { _Pragma("unroll") for (int m = 0; m < 4; ++m) _Pragma("unroll") for (int k = 0; k < 2; ++k) dst[m][k] = *(const PG8_LAS bf16x8*)(lds + PG8_SA(b, h) + aoff + m * 2048 + k * 1024); } while (0)
#define PG8_LDB(dst, b, h) do { _Pragma("unroll") for (int n = 0; n < 2; ++n) _Pragma("unroll") for (int k = 0; k < 2; ++k) dst[n][k] = *(const PG8_LAS bf16x8*)(lds + PG8_SB(b, h) + boff + n * 2048 + k * 1024); } while (0)
#define PG8_MMA(ai, bj, At, Bt) do { __builtin_amdgcn_s_setprio(1); _Pragma("unroll") for (int m = 0; m < 4; ++m) _Pragma("unroll") for (int n = 0; n < 2; ++n) _Pragma("unroll") for (int k = 0; k < 2; ++k) \
        acc[ai][bj][m][n] = __builtin_amdgcn_mfma_f32_16x16x32_bf16(Bt[n][k], At[m][k], acc[ai][bj][m][n], 0, 0, 0); __builtin_amdgcn_s_setprio(0); } while (0)
#define PG8_WAIT_V(n) asm volatile("s_waitcnt vmcnt(" #n ")" ::: "memory")
#define PG8_WAIT_L(n) asm volatile("s_waitcnt lgkmcnt(" #n ")" ::: "memory")
#define PG8_BAR __builtin_amdgcn_s_barrier()
#define PG8_SCHED __builtin_amdgcn_sched_barrier(0)
    Unit cur, nxt; int ui = 0;
    if (!S.next(0, cur)) return;
    f32x4 acc[2][2][4][2];
#pragma unroll
    for (int a = 0; a < 2; ++a)
#pragma unroll
        for (int b = 0; b < 2; ++b)
#pragma unroll
            for (int m = 0; m < 4; ++m)
#pragma unroll
                for (int n = 0; n < 2; ++n) acc[a][b][m][n] = (f32x4){0.f, 0.f, 0.f, 0.f};
    bf16x8 At[4][2], B0[2][2], B1[2][2];
    const char* cA = GATHER ? (const char*)g.A : (const char*)g.A + (size_t)cur.pm * tstep; const char* cB = (const char*)g.Bt + (size_t)cur.pn * tstep;
    if constexpr (GATHER) { PG8_GLOAD(cur, vgc); }
    S.a_ready(cur);
    if constexpr (SP2) {
        PG8_STAGE(PG8_SB(0, 0), cB, voffB); PG8_STAGE(PG8_SB(0, 1), cB + hstep, voffB); PG8_STAGE_A(PG8_SA(0, 0), cA, 0, false); PG8_STAGE_A(PG8_SA(0, 1), cA, 1, false);
        if (wr == 1) PG8_BAR;
        PG8_WAIT_V(2); PG8_BAR;
        PG8_STAGE(PG8_SB(1, 0), cB + kstep, voffB); PG8_STAGE_A(PG8_SA(1, 0), cA + kstep, 0, false); PG8_STAGE(PG8_SB(1, 1), cB + hstep + kstep, voffB);
        PG8_WAIT_V(6); PG8_BAR;
    } else {
        PG8_STAGE(PG8_SB(0, 0), cB, voffB); PG8_STAGE(PG8_SA(0, 0), cA, voffA); PG8_STAGE(PG8_SB(0, 1), cB + hstep, voffB); PG8_STAGE(PG8_SA(0, 1), cA + hstep, voffA);
        if (wr == 1) PG8_BAR;
        PG8_WAIT_V(4); PG8_BAR;
        PG8_STAGE(PG8_SB(1, 0), cB + kstep, voffB); PG8_STAGE(PG8_SA(1, 0), cA + kstep, voffA); PG8_STAGE(PG8_SB(1, 1), cB + hstep + kstep, voffB);
        PG8_WAIT_V(6); PG8_BAR;
    }
    for (;;) {
        const bool has_next = S.next(ui + 1, nxt);
        const char* nA = GATHER ? (const char*)g.A : (has_next ? (const char*)g.A + (size_t)nxt.pm * tstep : cA);
        if constexpr (GATHER) { if (has_next) { PG8_GLOAD(nxt, vgn); } else { _Pragma("unroll") for (int _h = 0; _h < 2; ++_h) _Pragma("unroll") for (int _i = 0; _i < 2; ++_i) vgn[_h][_i] = vgc[_h][_i]; } } const char* nB = has_next ? (const char*)g.Bt + (size_t)nxt.pn * tstep : cB;
#pragma unroll 1
        for (int t = 0; t < nt; t += 2) {
            const bool last = (t == nt - 2);
            const char* a1 = cA + (size_t)(t + 1) * kstep;
            const char* a2 = last ? nA : cA + (size_t)(t + 2) * kstep; const char* b2 = last ? nB : cB + (size_t)(t + 2) * kstep;
            const char* a3 = a2 + kstep; const char* b3 = b2 + kstep;
            if (last && has_next) S.a_ready(nxt);
            if constexpr (SP2) {
            PG8_LDB(B0, 0, 0); PG8_LDB(B1, 0, 1); PG8_SCHED; PG8_LDA(At, 0, 0); PG8_STAGE_A(PG8_SA(1, 1), a1, 1, false);
            PG8_WAIT_V(8); PG8_WAIT_L(0); PG8_BAR; PG8_MMA(0, 0, At, B0); PG8_MMA(0, 1, At, B1); PG8_BAR; PG8_SCHED;
            PG8_LDA(At, 0, 1); PG8_STAGE(PG8_SB(0, 0), b2, voffB); PG8_STAGE(PG8_SB(0, 1), b2 + hstep, voffB); PG8_STAGE_A(PG8_SA(0, 0), a2, 0, last);
            PG8_WAIT_V(8); PG8_WAIT_L(0); PG8_BAR; PG8_MMA(1, 0, At, B0); PG8_MMA(1, 1, At, B1); PG8_BAR; PG8_SCHED;
            PG8_LDB(B0, 1, 0); PG8_LDB(B1, 1, 1); PG8_SCHED; PG8_LDA(At, 1, 0); PG8_STAGE_A(PG8_SA(0, 1), a2, 1, last);
            PG8_WAIT_V(8); PG8_WAIT_L(0); PG8_BAR; PG8_MMA(0, 0, At, B0); PG8_MMA(0, 1, At, B1); PG8_BAR; PG8_SCHED;
            PG8_LDA(At, 1, 1); PG8_STAGE(PG8_SB(1, 0), b3, voffB); PG8_STAGE(PG8_SB(1, 1), b3 + hstep, voffB); PG8_STAGE_A(PG8_SA(1, 0), a3, 0, last);
            PG8_WAIT_V(8); PG8_WAIT_L(0); PG8_BAR; PG8_MMA(1, 0, At, B0); PG8_MMA(1, 1, At, B1); PG8_BAR; PG8_SCHED;
            } else {
            PG8_LDB(B0, 0, 0); PG8_SCHED; PG8_LDA(At, 0, 0); PG8_STAGE(PG8_SA(1, 1), a1 + hstep, voffA);
            PG8_WAIT_L(8); PG8_BAR; PG8_WAIT_L(0); PG8_MMA(0, 0, At, B0); PG8_BAR; PG8_SCHED;
            PG8_LDB(B1, 0, 1); PG8_STAGE(PG8_SB(0, 0), b2, voffB);
            PG8_BAR; PG8_WAIT_L(0); PG8_MMA(0, 1, At, B1); PG8_BAR;
            PG8_LDA(At, 0, 1); PG8_STAGE(PG8_SA(0, 0), a2, voffA);
            PG8_BAR; PG8_WAIT_L(0); PG8_MMA(1, 0, At, B0); PG8_BAR; PG8_SCHED;
            PG8_STAGE(PG8_SB(0, 1), b2 + hstep, voffB);
            PG8_WAIT_V(6); PG8_BAR; PG8_MMA(1, 1, At, B1); PG8_BAR;
            PG8_LDB(B0, 1, 0); PG8_SCHED; PG8_LDA(At, 1, 0); PG8_STAGE(PG8_SA(0, 1), a2 + hstep, voffA);
            PG8_WAIT_L(8); PG8_BAR; PG8_WAIT_L(0); PG8_MMA(0, 0, At, B0); PG8_BAR; PG8_SCHED;
            PG8_LDB(B1, 1, 1); PG8_STAGE(PG8_SB(1, 0), b3, voffB);
            PG8_BAR; PG8_WAIT_L(0); PG8_MMA(0, 1, At, B1); PG8_BAR;
            PG8_LDA(At, 1, 1); PG8_STAGE(PG8_SA(1, 0), a3, voffA);
            PG8_BAR; PG8_WAIT_L(0); PG8_MMA(1, 0, At, B0); PG8_BAR; PG8_SCHED;
            PG8_STAGE(PG8_SB(1, 1), b3 + hstep, voffB);
            PG8_WAIT_V(6); PG8_BAR; PG8_MMA(1, 1, At, B1); PG8_BAR;
            }
        }
        if constexpr (ALIGN_EPI) { if (wr == 0) PG8_BAR; }
        if constexpr (!Epi::AFTER_DRAIN) { int t2_ = threadIdx.x; asm volatile("" : "+v"(t2_)); E(acc, cur, wr, wc, t2_ & 15, (t2_ >> 4) & 3); S.done(cur); }
        if (!has_next) break;
        bool keep_ = false; if constexpr (Epi::KEEP) keep_ = E.keep(cur);
        if (!keep_) {
#pragma unroll
        for (int a = 0; a < 2; ++a)
#pragma unroll
            for (int b = 0; b < 2; ++b)
#pragma unroll
                for (int m = 0; m < 4; ++m)
#pragma unroll
                    for (int n = 0; n < 2; ++n) acc[a][b][m][n] = (f32x4){0.f, 0.f, 0.f, 0.f};
        }
        cur = nxt; cA = nA; cB = nB; ++ui;
        if constexpr (GATHER) { _Pragma("unroll") for (int _h = 0; _h < 2; ++_h) _Pragma("unroll") for (int _i = 0; _i < 2; ++_i) vgc[_h][_i] = vgn[_h][_i]; }
        if constexpr (ALIGN_EPI) { if (wr == 1) PG8_BAR; }
    }
    PG8_WAIT_V(0);
    if constexpr (!ALIGN_EPI) { if (wr == 0) PG8_BAR; }
    PG8_BAR;
    if constexpr (Epi::AFTER_DRAIN) { E.fused(acc, cur, wr, wc, fr, fq, lds, wid, lane); S.done(cur); }
#undef PG8_SA
#undef PG8_SB
#undef PG8_STAGE
#undef PG8_STAGE_A
#undef PG8_GLOAD
#undef PG8_LDA
#undef PG8_LDB
#undef PG8_MMA
#undef PG8_WAIT_V
#undef PG8_WAIT_L
#undef PG8_BAR
#undef PG8_SCHED
}
}
#define GAS __attribute__((address_space(1)))
#define LAS __attribute__((address_space(3)))
typedef unsigned short bf16;
typedef unsigned v4u __attribute__((ext_vector_type(4)));
typedef float f32x4 __attribute__((ext_vector_type(4)));
typedef short bf16x8 __attribute__((ext_vector_type(8)));
typedef GAS unsigned gu32;
typedef GAS unsigned long long gu64;
#define RLX_AGENT __ATOMIC_RELAXED, __HIP_MEMORY_SCOPE_AGENT
#define LDS_WAIT() asm volatile("s_waitcnt lgkmcnt(0)" ::: "memory")
#define VM_WAIT() asm volatile("s_waitcnt vmcnt(0)" ::: "memory")
__device__ __forceinline__ unsigned long long rt() { return __builtin_amdgcn_s_memrealtime(); }
__device__ __forceinline__ unsigned f2bf(float f) { unsigned u = __builtin_bit_cast(unsigned, f); return (u + 0x7fffu + ((u >> 16) & 1u)) >> 16; }
typedef float f32x2_t __attribute__((ext_vector_type(2))); typedef __bf16 bf16x2_t __attribute__((ext_vector_type(2)));
__device__ __forceinline__ unsigned pk2(float lo, float hi) { const f32x2_t v = {lo, hi}; const bf16x2_t b = __builtin_convertvector(v, bf16x2_t); return __builtin_bit_cast(unsigned, b); }

#define XB_TMO      128
#define XB_XCNT(j)  (256  + 64 * (j))
#define XB_XSUB(j)  (1280 + 64 * (j))
#define XB_XGEN(j)  (2304 + 64 * (j))
#define XB_TOP      3328
#define XB_TOPGEN   3392
#define XCD_BAR_WORDS 3456
#define XB_SPIN_CAP (1u << 18)

__device__ __forceinline__ unsigned xb_ld(unsigned* p)              { return __hip_atomic_load(p, __ATOMIC_RELAXED, __HIP_MEMORY_SCOPE_AGENT); }
__device__ __forceinline__ unsigned xb_add(unsigned* p, unsigned v) { return __hip_atomic_fetch_add(p, v, __ATOMIC_RELAXED, __HIP_MEMORY_SCOPE_AGENT); }
__device__ __forceinline__ unsigned xb_xcc_id() { return (unsigned)__builtin_amdgcn_s_getreg((3 << 11) | 20) & 0xFu; }
#define XB_SPIN(cond, bar) do { unsigned _sp = 0; while (cond) { __builtin_amdgcn_s_sleep(1); \
    if ((++_sp & 255u) == 0u) { if (xb_ld(&(bar)[XB_TMO])) break; if (_sp > XB_SPIN_CAP) { atomicAdd(&(bar)[XB_TMO], 1u); break; } } } } while (0)

struct XcdBarrier {
    unsigned* bar; unsigned x;
    volatile LAS unsigned* st;
};

__device__ __forceinline__ XcdBarrier xcd_barrier_post(unsigned* bar, volatile LAS unsigned* st) {
    XcdBarrier b; b.bar = bar; b.x = xb_xcc_id(); b.st = st;
    if (threadIdx.x == 0) (void)xb_add(&bar[XB_XCNT(b.x)], 1u);
    return b;
}
__device__ __forceinline__ void xcd_barrier_complete(unsigned* bar, unsigned x, unsigned& nloc, unsigned& nx) {
    const unsigned G = gridDim.x * gridDim.y * gridDim.z;
    unsigned sum, cnt, mine, sp = 0u;
    for (;;) {
        sum = 0u; cnt = 0u; mine = 0u;
#pragma unroll
        for (unsigned j = 0; j < 16; ++j) { const unsigned c = xb_ld(&bar[XB_XCNT(j)]); sum += c; cnt += (c > 0u) ? 1u : 0u; mine = (j == x) ? c : mine; }
        if (sum == G) break;
        __builtin_amdgcn_s_sleep(1);
        if ((++sp & 255u) == 0u) { if (xb_ld(&bar[XB_TMO])) break; if (sp > XB_SPIN_CAP) { atomicAdd(&bar[XB_TMO], 1u); break; } }
    }
    nloc = mine > 0u ? mine : 1u; nx = cnt > 0u ? cnt : 1u;
}

__device__ __forceinline__ void xcd_barrier(const XcdBarrier& b) {
    asm volatile("s_waitcnt vmcnt(0)" ::: "memory");
    __syncthreads();
    if (threadIdx.x == 0) {
        unsigned* bar = b.bar;
        __builtin_amdgcn_s_waitcnt(0);
        unsigned nloc = b.st[0], nx = b.st[1];
        if (nloc == 0u) { xcd_barrier_complete(bar, b.x, nloc, nx); b.st[0] = nloc; b.st[1] = nx; }
        const unsigned old = xb_add(&bar[XB_XSUB(b.x)], 1u);
        const unsigned gen = old / nloc;
        if (old + 1u == (gen + 1u) * nloc) {
            __builtin_amdgcn_fence(__ATOMIC_RELEASE, "agent");
            asm volatile("s_waitcnt vmcnt(0)" ::: "memory");
            const unsigned og = xb_add(&bar[XB_TOP], 1u);
            const unsigned tg = og / nx;
            if (og + 1u == (tg + 1u) * nx) xb_add(&bar[XB_TOPGEN], 1u);
            else XB_SPIN(xb_ld(&bar[XB_TOPGEN]) == tg, bar);
            __builtin_amdgcn_fence(__ATOMIC_ACQUIRE, "agent");
            xb_add(&bar[XB_XGEN(b.x)], 1u);
            asm volatile("s_waitcnt vmcnt(0)" ::: "memory");
        } else {
            XB_SPIN(xb_ld(&bar[XB_XGEN(b.x)]) == gen, bar);
            __builtin_amdgcn_fence(__ATOMIC_ACQUIRE, "agent");
            asm volatile("s_waitcnt vmcnt(0)" ::: "memory");
        }
    }
    __syncthreads();
}
constexpr int DM = 1024, SEQ = 8192, NBATCH = 2, CTXL = 256;
constexpr int ML = NBATCH * SEQ, MC = NBATCH * CTXL, MT = ML + MC;
constexpr int NIN = 6400;
constexpr int NE = 16, ESTR = 2304, CAPL = 1024, CAPC = 32;
constexpr int NPH = 24;
constexpr size_t MiB = 1u << 20;
constexpr size_t WS_CTL = 0, CTL_ZERO_BYTES = 32768;
constexpr size_t WS_MOD = 1 * MiB;
constexpr size_t WS_ROPEC = 1 * MiB + 256 * 1024, WS_ROPES = WS_ROPEC + 8192;
constexpr size_t WS_TW = 1 * MiB + 512 * 1024;
constexpr size_t WS_CS256 = 1 * MiB + 640 * 1024;
constexpr size_t WS_T1T = 2 * MiB;
constexpr size_t WS_T2T = 2 * MiB + 64 * 1024;
constexpr size_t WS_T2F = 8 * MiB;
constexpr size_t WS_T2C = 12 * MiB;
constexpr size_t WS_FAC = 13 * MiB;
constexpr size_t WS_WSP = 2 * MiB + 256 * 1024;
constexpr size_t WS_AFF = 3 * MiB;
constexpr size_t WS_SEL = 5 * MiB;
constexpr size_t WS_IDX = 7 * MiB, WS_GATE = 7 * MiB + 256 * 1024;
constexpr size_t WS_WIN = 16 * MiB, WS_WBR = 29 * MiB, WS_WO = 31 * MiB, WS_WGU = 33 * MiB, WS_WDN = 97 * MiB;
constexpr size_t WS_X = 130 * MiB;
constexpr size_t WS_H = 196 * MiB;
constexpr size_t WS_BR = 229 * MiB;
constexpr size_t WS_MB = 262 * MiB;
constexpr size_t WS_FA = 295 * MiB;
constexpr size_t WS_Z = 311 * MiB;
constexpr size_t ZROW = (size_t)MT * 2;
constexpr size_t WS_AUV = WS_Z, WS_YF = WS_AUV + 512 * ZROW, WS_CY = WS_YF + 512 * ZROW, WS_QPL = WS_CY + 256 * ZROW, WS_QROT = WS_QPL + 256 * ZROW,
                 WS_KR = WS_QROT + 256 * ZROW, WS_VV = WS_KR + 256 * ZROW, WS_G = WS_VV + 256 * ZROW, WS_ZEND = WS_G + 2048 * ZROW;
constexpr size_t WS_P32 = WS_Z;
constexpr size_t WS_XE = WS_Z, WS_ACT = WS_Z + 72 * MiB;
constexpr size_t WS_WGU1 = 456 * MiB;
constexpr size_t WS_END = 520 * MiB;
static_assert(WS_G == WS_P32 + (size_t)MT * 1024 * 4 + 8 * 256 * ZROW / 8 - 256 * ZROW || true, "");
static_assert(WS_ZEND <= WS_WGU1 && WS_ACT + 72 * MiB <= WS_WGU1 && WS_WGU1 + 64 * MiB <= WS_END, "ws map");
constexpr int CW_BAR = 4096;
constexpr int LDS_BYTES = 155648, MISC_OFF = 154624;

struct Args { const float* in[28]; float* out; unsigned char* ws; int ph_lo, ph_hi; };

__device__ __forceinline__ float bflo(unsigned w) { return __uint_as_float(w << 16); }
__device__ __forceinline__ float bfhi(unsigned w) { return __uint_as_float(w & 0xffff0000u); }
__device__ __forceinline__ float sigm(float x) { return __builtin_amdgcn_rcpf(1.f + __expf(-x)); }
template <int CTRL> __device__ __forceinline__ float dppf(float v) { return __int_as_float(__builtin_amdgcn_update_dpp(0, __float_as_int(v), CTRL, 0xF, 0xF, true)); }
__device__ __forceinline__ void swp16(float& a, float& b) { const auto r = __builtin_amdgcn_permlane16_swap(__float_as_uint(a), __float_as_uint(b), false, false); a = __uint_as_float(r[0]); b = __uint_as_float(r[1]); }
__device__ __forceinline__ void swp32(float& a, float& b) { const auto r = __builtin_amdgcn_permlane32_swap(__float_as_uint(a), __float_as_uint(b), false, false); a = __uint_as_float(r[0]); b = __uint_as_float(r[1]); }
__device__ __forceinline__ float wave_sum(float v) {
    v += dppf<0xB1>(v); v += dppf<0x4E>(v); v += dppf<0x141>(v); v += dppf<0x140>(v);
    { float a = v, b = v; swp16(a, b); v = a + b; } { float a = v, b = v; swp32(a, b); v = a + b; }
    return v;
}
__device__ __forceinline__ void st4bf(bf16* p, f32x4 v) { uint2 w; w.x = pk2(v[0], v[1]); w.y = pk2(v[2], v[3]); *(uint2*)p = w; }

__device__ __forceinline__ void st8bf(bf16* p, f32x4 a, f32x4 b) { v4u w; w.x = pk2(a[0], a[1]); w.y = pk2(a[2], a[3]); w.z = pk2(b[0], b[1]); w.w = pk2(b[2], b[3]); *(v4u*)p = w; }
__device__ __forceinline__ void st4bf2(bf16* p, f32x4 a, f32x4 b) { const unsigned ax = pk2(a[0], a[1]), ay = pk2(a[2], a[3]), bx = pk2(b[0], b[1]), by = pk2(b[2], b[3]);
    const auto rx = __builtin_amdgcn_permlane16_swap(ax, bx, false, false); const auto ry = __builtin_amdgcn_permlane16_swap(ay, by, false, false);
    v4u w; w.x = rx[0]; w.y = ry[0]; w.z = rx[1]; w.w = ry[1]; *(v4u*)p = w; }
using pg8::Unit;
#ifndef MG_SIG_HERE
#define MG_SIG_HERE 0
#endif
struct EpiIn {
    static constexpr bool PERM = false, AFTER_DRAIN = false, KEEP = false;
    bf16 *AUV, *YF, *CY, *QPL, *QROT, *KR, *VV, *G; const float* ropeC; const float* ropeS;
    __device__ __forceinline__ void operator()(const f32x4 (&acc)[2][2][4][2], const Unit& u, int wr, int wc, int fr, int fq) const {
        const int pn = u.pn, row0 = u.pm * 256 + wr * 64 + fr, cl0 = wc * 32 + 4 * fq;
        const int cp0 = wc * 32 + 8 * fq;
        if (pn < 2) {
#pragma unroll
            for (int ai = 0; ai < 2; ++ai)
#pragma unroll
                for (int m = 0; m < 4; ++m) { const size_t row = row0 + ai * 128 + m * 16;
#pragma unroll
                    for (int bj = 0; bj < 2; ++bj) { f32x4 v[2];
#pragma unroll
                        for (int n = 0; n < 2; ++n)
#pragma unroll
                            for (int j = 0; j < 4; ++j) { const float x = acc[ai][bj][m][n][j]; v[n][j] = x * sigm(1.5957691216f * (x + 0.044715f * x * x * x)); }
                        st8bf(AUV + row * 512 + pn * 256 + bj * 128 + cp0, v[0], v[1]); } }
        } else if (pn < 4) {
#pragma unroll
            for (int ai = 0; ai < 2; ++ai)
#pragma unroll
                for (int m = 0; m < 4; ++m) { const size_t row = row0 + ai * 128 + m * 16;
#pragma unroll
                    for (int bj = 0; bj < 2; ++bj) st8bf(YF + row * 512 + (pn - 2) * 256 + bj * 128 + cp0, acc[ai][bj][m][0], acc[ai][bj][m][1]); }
        } else if (pn < 6) {
#pragma unroll
            for (int ai = 0; ai < 2; ++ai)
#pragma unroll
                for (int m = 0; m < 4; ++m) { const size_t row = row0 + ai * 128 + m * 16; f32x4 v[2];
#pragma unroll
                    for (int n = 0; n < 2; ++n) { const f32x4 a = acc[ai][0][m][n], g = acc[ai][1][m][n];
#pragma unroll
                        for (int j = 0; j < 4; ++j) v[n][j] = a[j] * sigm(g[j]); }
                    st8bf(CY + row * 256 + (pn - 4) * 128 + cp0, v[0], v[1]); }
        } else if (pn < 8) {
            const bool isq = pn == 6; const float scl = isq ? 0.125f * 1.4426950408889634f : 1.f;   const bool latent = u.pm < 64;
#pragma unroll
            for (int ai = 0; ai < 2; ++ai)
#pragma unroll
                for (int m = 0; m < 4; ++m) { const int rowi = row0 + ai * 128 + m * 16; const size_t row = rowi; const int tok = rowi & 8191;
                    const int pos = (wc & 1) ? (tok & 63) : (tok >> 6);
                    f32x4 cs = {1.f, 1.f, 1.f, 1.f}, sn = {0.f, 0.f, 0.f, 0.f};
                    if (latent) { cs = *(const f32x4*)(ropeC + pos * 16 + 4 * fq); sn = *(const f32x4*)(ropeS + pos * 16 + 4 * fq); }
#pragma unroll
                    for (int bj = 0; bj < 2; ++bj) { const f32x4 x1 = acc[ai][bj][m][0] * scl, x2 = acc[ai][bj][m][1] * scl;
                        const f32x4 r1 = x1 * cs - x2 * sn, r2 = x1 * sn + x2 * cs; const size_t off = row * 256 + bj * 128 + wc * 32 + (fq & 1) * 16 + (fq >> 1) * 8;
                        if (isq) { st4bf2(QPL + off, x1, x2); st4bf2(QROT + off, r1, r2); }
                        else st4bf2(KR + off, r1, r2); } }
        } else if (pn == 8) {
#pragma unroll
            for (int ai = 0; ai < 2; ++ai)
#pragma unroll
                for (int m = 0; m < 4; ++m) { const size_t row = row0 + ai * 128 + m * 16;
#pragma unroll
                    for (int bj = 0; bj < 2; ++bj) st8bf(VV + row * 256 + bj * 128 + cp0, acc[ai][bj][m][0], acc[ai][bj][m][1]); }
        } else {
            unsigned char* G8 = (unsigned char*)G;
#pragma unroll
            for (int ai = 0; ai < 2; ++ai)
#pragma unroll
                for (int bj = 0; bj < 2; ++bj) { const int gb_ = (pn - 9) >> 2, gu_ = (2 * u.pm + ai) * 8 + 2 * ((pn - 9) & 3) + bj;
#pragma unroll
                    for (int mp = 0; mp < 2; ++mp) { v4u w;
#pragma unroll
                        for (int h = 0; h < 2; ++h)
#pragma unroll
                            for (int n = 0; n < 2; ++n) { const f32x4 a = acc[ai][bj][2 * mp + h][n]; unsigned q[4];
#pragma unroll
                                for (int jj = 0; jj < 4; ++jj) q[jj] = (unsigned)(sigm(a[jj]) * 255.f + 0.5f);
                                w[2 * h + n] = q[0] | (q[1] << 8) | (q[2] << 16) | (q[3] << 24); }
                        *(v4u*)(G8 + ((((size_t)(gu_ * 4 + gb_) * 8 + (wr * 4 + wc)) * 2 + mp) * 64 + (fq * 16 + fr)) * 16) = w; } }
        }
    }
};
struct EpiMerge {
    static constexpr bool PERM = false, AFTER_DRAIN = false, KEEP = false;
    const bf16* G; float* P32; bf16* MB;
    __device__ __forceinline__ void operator()(const f32x4 (&acc)[2][2][4][2], const Unit& u, int wr, int wc, int fr, int fq) const {
        int fr_ = fr, fq_ = fq; asm volatile("" : "+v"(fr_), "+v"(fq_));
        const int b = u.pn >> 2, pn = u.pn & 3, pm = u.pm - b * 66, row0 = pm * 256 + wr * 64 + fr_, col0 = pn * 256 + wc * 32 + 4 * fq_;
#pragma unroll
        for (int ai = 0; ai < 2; ++ai)
#pragma unroll
            for (int m = 0; m < 4; ++m) { const unsigned row = row0 + ai * 128 + m * 16;
                const bf16* gp = G + ((size_t)row * 4096 + b * 1024 + col0); float* pp = P32 + ((size_t)row * 1024 + col0); bf16* mp = MB + ((size_t)row * 1024 + col0);
#pragma unroll
                for (int bj = 0; bj < 2; ++bj)
#pragma unroll
                    for (int n = 0; n < 2; ++n) { const int co = bj * 128 + n * 16;
                        const uint2 gw = *(const uint2*)(gp + co);
                        f32x4 v = acc[ai][bj][m][n]; v[0] *= bflo(gw.x); v[1] *= bfhi(gw.x); v[2] *= bflo(gw.y); v[3] *= bfhi(gw.y);
                        if (b > 0) v += *(const f32x4*)(pp + co);
                        if (b < 3) *(f32x4*)(pp + co) = v; else st4bf(mp + co, v);
                        asm volatile("" ::: "memory"); } }
    }
};
struct EpiMergeH {
    static constexpr bool PERM = false, AFTER_DRAIN = false, KEEP = true;
    const bf16* G; bf16* MB;
    __device__ __forceinline__ bool keep(const Unit& u) const { return (u.pn >> 2) < 3; }
    __device__ __forceinline__ void operator()(f32x4 (&acc)[2][2][4][2], const Unit& u, int wr, int wc, int fr, int fq) const {
        const int b = u.pn >> 2, pn = u.pn & 3, pm = u.pm - b * 66, row0 = pm * 256 + wr * 64 + fr, col0 = pn * 256 + wc * 32 + 4 * fq;
#pragma unroll
        for (int ai = 0; ai < 2; ++ai)
#pragma unroll
            for (int m = 0; m < 4; ++m) { const unsigned row = row0 + ai * 128 + m * 16; const bf16* gp = G + ((size_t)row * 4096 + b * 1024 + col0); bf16* mp = MB + ((size_t)row * 1024 + col0);
#pragma unroll
                for (int bj = 0; bj < 2; ++bj)
#pragma unroll
                    for (int n = 0; n < 2; ++n) { const int co = bj * 128 + n * 16; const uint2 gb = *(const uint2*)(gp + co); f32x4 v = acc[ai][bj][m][n];
                        if (b < 3) { const uint2 gn = *(const uint2*)(gp + 1024 + co);
                            v[0] *= bflo(gb.x) * __builtin_amdgcn_rcpf(bflo(gn.x)); v[1] *= bfhi(gb.x) * __builtin_amdgcn_rcpf(bfhi(gn.x)); v[2] *= bflo(gb.y) * __builtin_amdgcn_rcpf(bflo(gn.y)); v[3] *= bfhi(gb.y) * __builtin_amdgcn_rcpf(bfhi(gn.y));
                            acc[ai][bj][m][n] = v; }
                        else { v[0] *= bflo(gb.x); v[1] *= bfhi(gb.x); v[2] *= bflo(gb.y); v[3] *= bfhi(gb.y); st4bf(mp + co, v); } }
                asm volatile("" ::: "memory"); }
    }
};
struct EpiWout {
    static constexpr bool PERM = false, AFTER_DRAIN = false, KEEP = false, DUP = false;
    const float* xlat; const float* xctx; bf16* X; const float* mod; int fromx;
    __device__ __forceinline__ void operator()(const f32x4 (&acc)[2][2][4][2], const Unit& u, int wr, int wc, int fr, int fq) const {
        const int r = u.pm < 32 ? 0 : (u.pm < 64 ? 1 : 2); const float* gt = mod + r * 6144 + 2 * 1024;
        const int row0 = u.pm * 256 + wr * 64 + fr, col0 = u.pn * 256 + wc * 32 + 4 * fq, colw = u.pn * 256 + wc * 32 + (fq & 1) * 16 + (fq >> 1) * 8;
        f32x4 gv[2][2];
#pragma unroll
        for (int bj = 0; bj < 2; ++bj)
#pragma unroll
            for (int n = 0; n < 2; ++n) gv[bj][n] = *(const f32x4*)(gt + col0 + bj * 128 + n * 16);
#pragma unroll
        for (int ai = 0; ai < 2; ++ai)
#pragma unroll
            for (int m = 0; m < 4; ++m) { const size_t row = row0 + ai * 128 + m * 16; const float* src = (row < ML) ? xlat + row * 1024 : xctx + (row - ML) * 1024;
#pragma unroll
                for (int bj = 0; bj < 2; ++bj) { f32x4 s0, s1; bf16* xp = X + row * 1024 + colw + bj * 128;
                    if (fromx) { const v4u w = *(const v4u*)xp;
                        const auto rx = __builtin_amdgcn_permlane16_swap(w.x, w.z, false, false); const auto ry = __builtin_amdgcn_permlane16_swap(w.y, w.w, false, false);
                        s0 = (f32x4){bflo(rx[0]), bfhi(rx[0]), bflo(ry[0]), bfhi(ry[0])}; s1 = (f32x4){bflo(rx[1]), bfhi(rx[1]), bflo(ry[1]), bfhi(ry[1])}; }
                    else { s0 = *(const f32x4*)(src + col0 + bj * 128); s1 = *(const f32x4*)(src + col0 + bj * 128 + 16); }
                    st4bf2(xp, s0 + gv[bj][0] * acc[ai][bj][m][0], s1 + gv[bj][1] * acc[ai][bj][m][1]); } }
    }
};
struct EpiGU {
    static constexpr bool PERM = true, AFTER_DRAIN = false, KEEP = false;
    bf16* ACT;
    __device__ __forceinline__ void operator()(const f32x4 (&acc)[2][2][4][2], const Unit& u, int wr, int wc, int fr, int fq) const {
        const int pnl = u.pn & 7, row0 = u.pm * 256 + wr * 64 + fr, cl0 = wc * 32 + 8 * fq;
#pragma unroll
        for (int ai = 0; ai < 2; ++ai)
#pragma unroll
            for (int m = 0; m < 4; ++m) { const size_t row = row0 + ai * 128 + m * 16; f32x4 v[2];
#pragma unroll
                for (int n = 0; n < 2; ++n) { const f32x4 a = acc[ai][0][m][n], up = acc[ai][1][m][n];
#pragma unroll
                    for (int j = 0; j < 4; ++j) v[n][j] = a[j] * sigm(a[j]) * up[j]; }
                st8bf(ACT + row * 1024 + pnl * 128 + cl0, v[0], v[1]); }
    }
};
struct EpiDown {
    static constexpr bool PERM = true, AFTER_DRAIN = false, KEEP = false;
    bf16* YB; const float* GATE;
    __device__ __forceinline__ void operator()(const f32x4 (&acc)[2][2][4][2], const Unit& u, int wr, int wc, int fr, int fq) const {
        const int pnl = u.pn & 3, row0 = u.pm * 256 + wr * 64 + fr, col0 = pnl * 256 + wc * 32 + 8 * fq;
#pragma unroll
        for (int ai = 0; ai < 2; ++ai)
#pragma unroll
            for (int m = 0; m < 4; ++m) { const size_t row = row0 + ai * 128 + m * 16;
#pragma unroll
                for (int bj = 0; bj < 2; ++bj) st8bf(YB + row * 1024 + col0 + bj * 128, acc[ai][bj][m][0], acc[ai][bj][m][1]); }
    }
};
struct MergeOrder {
    int nt, G, c;
    __device__ void init(int ntm, int G_, int c_) { nt = ntm * 4; G = G_; c = c_; }
    __device__ bool next(int i, Unit& u) const { const int b = i & 3, L = (i >> 2) * G + c; if (L >= nt) return false; u.pm = b * 66 + (L >> 2); u.pn = b * 4 + (L & 3); return true; }
    __device__ __forceinline__ void a_ready(const Unit&) const {}
    __device__ __forceinline__ void done(const Unit&) const {}
};
struct OneUnit { int pm, pn; __device__ bool next(int i, Unit& u) const { if (i > 0) return false; u.pm = pm; u.pn = pn; return true; }
    __device__ __forceinline__ void a_ready(const Unit&) const {} __device__ __forceinline__ void done(const Unit&) const {} };
struct GroupOrder {
    int nwg, G, c, TPE, NTN;
    __device__ void init(int tpe, int ntn, int G_, int c_) { TPE = tpe; NTN = ntn; nwg = NE * tpe * ntn; G = G_; c = c_; }
    __device__ bool next(int i, Unit& u) const {
        const long L = (long)i * G + c; if (L >= nwg) return false;
        int wgid = (int)L; { const int q = nwg / 8, r = nwg % 8, xcd = wgid % 8, off = wgid / 8; wgid = (xcd < r ? xcd * (q + 1) : r * (q + 1) + (xcd - r) * q) + off; }
        const int per = TPE * NTN, e = wgid / per, rem = wgid % per;
#ifdef GO_MT_MAJOR
        const int mt = rem / NTN, pn = rem % NTN;
#else
        const int pn = rem / TPE, mt = rem % TPE;
#endif
        u.pm = e * 9 + mt; u.pn = e * NTN + pn; return true;
    }
    __device__ __forceinline__ void a_ready(const Unit&) const {}
    __device__ __forceinline__ void done(const Unit&) const {}
};
typedef float f2v __attribute__((ext_vector_type(2)));
#define PH_ARGS LAS unsigned char* lds, const int tid, const int lane, const int wave, const int bid, const int G
#define PH_CALL_IN lds, tid, lane, wave, bid, G
#define WSP(T, off) ((T*)(PTRV(29, unsigned char) + (off)))
constexpr int PTAB_OFF = MISC_OFF + 512;
__device__ __forceinline__ unsigned long long ptab_ld(LAS unsigned char* lds, int i) {
    typedef unsigned u2v_t __attribute__((ext_vector_type(2)));
    const volatile LAS unsigned* tp = (const volatile LAS unsigned*)(lds + PTAB_OFF + 8 * i); u2v_t v; v[0] = tp[0]; v[1] = tp[1];
    const unsigned lo = __builtin_amdgcn_readfirstlane(v[0]), hi = __builtin_amdgcn_readfirstlane(v[1]);
    return ((unsigned long long)hi << 32) | lo;
}
#define PTRV(i, T) ((T*)(GAS T*)ptab_ld(lds, (i)))
#define INP(i) ((const float*)(GAS const float*)ptab_ld(lds, (i)))

__device__ __forceinline__ void mod_gemv(PH_ARGS) {
    LAS f32x4* red = (LAS f32x4*)lds;
    const float* c = INP(1); const float* cc = INP(3); const float* wm = INP(4); const float* bm = INP(5);
    float* MOD = WSP(float, WS_MOD);
    if (bid >= 192) return;
    LAS float* act = (LAS float*)(lds + 32768);
    for (int i = tid; i < 3072; i += 512) { const int r = i >> 10, k = i & 1023; const float x = r == 0 ? c[k] : (r == 1 ? c[1024 + k] : cc[k]); act[i] = x * sigm(x); }
    __syncthreads();
    for (int it = bid; it < 192; it += G) {
        const int l = it / 96, cg = it % 96, kg = tid >> 4, cq = tid & 15;
        f32x4 a0 = {0.f, 0.f, 0.f, 0.f}, a1 = a0, a2 = a0;
        const float* wb = wm + (size_t)l * 1024 * 6144 + cg * 64 + cq * 4;
        f32x4 wv[32];
#pragma unroll
        for (int i = 0; i < 32; ++i) wv[i] = *(const f32x4*)(wb + (size_t)(kg + 32 * i) * 6144);
#pragma unroll
        for (int i = 0; i < 32; ++i) { const int k = kg + 32 * i; const f32x4 w = wv[i];
            a0 += w * act[k]; a1 += w * act[1024 + k]; a2 += w * act[2048 + k]; }
        red[(kg * 3 + 0) * 16 + cq] = a0; red[(kg * 3 + 1) * 16 + cq] = a1; red[(kg * 3 + 2) * 16 + cq] = a2;
        __syncthreads();
        if (tid < 192) { const int r = tid >> 6, col = tid & 63; float s = 0.f; const LAS float* rf = (const LAS float*)red;
            for (int k2 = 0; k2 < 32; ++k2) s += rf[((k2 * 3 + r) * 16 + (col >> 2)) * 4 + (col & 3)];
            MOD[(l * 3 + r) * 6144 + cg * 64 + col] = s + bm[l * 6144 + cg * 64 + col]; }
        asm volatile("s_waitcnt vmcnt(0)" ::: "memory");
        __syncthreads();
        if (it < 32 && tid == 0) {
            __builtin_amdgcn_fence(__ATOMIC_RELEASE, "agent"); asm volatile("s_waitcnt vmcnt(0)" ::: "memory");
            __hip_atomic_fetch_add((unsigned*)(PTRV(29, unsigned char) + WS_CTL) + 2049, 1u, __ATOMIC_RELAXED, __HIP_MEMORY_SCOPE_AGENT); }
    }
}
__device__ __forceinline__ void make_tables(PH_ARGS) {
    const int gt = bid * 512 + tid, GT = G * 512;
    float* RC = WSP(float, WS_ROPEC); float* RS = WSP(float, WS_ROPES);
    bf16* T1 = WSP(bf16, WS_T1T);
    for (int i = gt; i < 2048; i += GT) { const int pos = i >> 4, f = i & 15; const float inv = powf(10000.f, -(float)f / 16.f), ang = (float)pos * inv; RC[i] = cosf(ang); RS[i] = sinf(ang); }
    for (int i2 = gt; i2 < 128 * 64; i2 += GT) { const int i = 2 * i2, col = i >> 7, k = i & 127, ro = col >> 6, k1 = col & 63, n1 = k >> 1; float s, c; sincospif((float)((k1 * n1) & 63) / 32.f, &s, &c);
        *(unsigned*)(T1 + i) = ro == 0 ? pk2(c, s) : pk2(-s, c); }
    bf16* T2F = WSP(bf16, WS_T2F); bf16* T2C = WSP(bf16, WS_T2C);
    for (int i8 = gt; i8 < 64 * 128 * 32; i8 += GT) { const int i = 8 * i8, k1 = i >> 15, k2 = (i >> 8) & 127, n20 = (i & 255) >> 1; v4u w;
#pragma unroll
        for (int q = 0; q < 4; ++q) { float s, c; sincospif((float)(((n20 + q) * (k1 + 64 * k2)) & 8191) / 4096.f, &s, &c); w[q] = pk2(c, s); }
        *(v4u*)(T2F + i) = w; }
    for (int i8 = gt; i8 < 2 * 128 * 32; i8 += GT) { const int i = 8 * i8, k1 = i >> 15, k2 = (i >> 8) & 127, n20 = (i & 255) >> 1; v4u w;
#pragma unroll
        for (int q = 0; q < 4; ++q) { float s, c; sincospif((float)(((n20 + q) * (k1 + 2 * k2)) & 255) / 128.f, &s, &c); w[q] = pk2(c, s); }
        *(v4u*)(T2C + i) = w; }
}
__device__ __forceinline__ void tr_item(const float* W, size_t ldw, int col0, int k0, bf16* dst, int Kd, LAS float* scr, int lane) {
#pragma unroll 8
    for (int i = 0; i < 32; ++i) { const int kk = 2 * i + (lane >> 5); scr[kk * 33 + (lane & 31)] = W[(size_t)(k0 + kk) * ldw + col0 + (lane & 31)]; }
    LDS_WAIT(); asm volatile("" ::: "memory");
    const int c = lane & 7;
#pragma unroll
    for (int j = 0; j < 4; ++j) { const int n = (lane >> 3) + 8 * j; const LAS float* s = scr + (8 * c) * 33 + n;
        v4u o; o.x = pk2(s[0 * 33], s[1 * 33]); o.y = pk2(s[2 * 33], s[3 * 33]); o.z = pk2(s[4 * 33], s[5 * 33]); o.w = pk2(s[6 * 33], s[7 * 33]);
        *(v4u*)(dst + (size_t)n * Kd + k0 + 8 * c) = o; }
    LDS_WAIT(); asm volatile("" ::: "memory");
}
__device__ __forceinline__ int rho32(int c) { return 16 * ((c >> 2) & 1) + 4 * (c >> 3) + (c & 3); }
__device__ __forceinline__ void fold_item16(const float* W  , int f, bf16* WIN, LAS float* scr, const LAS f2v* tab, int lane) {
    const int kb = f >> 2, g = f & 3, k0 = kb * 16;
#pragma unroll
    for (int kk = 0; kk < 16; ++kk) scr[kk * 64 + lane] = W[(size_t)(k0 + kk) * 6144 + 512 + g * 64 + lane];
    LDS_WAIT(); asm volatile("" ::: "memory");
    float ar[16], ai[16];
#pragma unroll
    for (int kk = 0; kk < 16; ++kk) { ar[kk] = 0.f; ai[kk] = 0.f; }
#pragma unroll 4
    for (int c = 0; c < 64; ++c) { const f2v t = tab[(c * lane) & 63];
#pragma unroll
        for (int kk = 0; kk < 16; ++kk) { const float w = scr[kk * 64 + c]; ar[kk] += w * t[0]; ai[kk] -= w * t[1]; } }
    const int L0 = 2 * (g * 64 + lane);
    bf16* d0 = WIN + (size_t)(512 + (L0 & ~31) + rho32(L0 & 31)) * 1024 + k0; bf16* d1 = WIN + (size_t)(512 + (L0 & ~31) + rho32((L0 + 1) & 31)) * 1024 + k0;
    v4u o, p;
    o.x = pk2(ar[0], ar[1]); o.y = pk2(ar[2], ar[3]); o.z = pk2(ar[4], ar[5]); o.w = pk2(ar[6], ar[7]); p.x = pk2(ar[8], ar[9]); p.y = pk2(ar[10], ar[11]); p.z = pk2(ar[12], ar[13]); p.w = pk2(ar[14], ar[15]);
    *(v4u*)d0 = o; *(v4u*)(d0 + 8) = p;
    o.x = pk2(ai[0], ai[1]); o.y = pk2(ai[2], ai[3]); o.z = pk2(ai[4], ai[5]); o.w = pk2(ai[6], ai[7]); p.x = pk2(ai[8], ai[9]); p.y = pk2(ai[10], ai[11]); p.z = pk2(ai[12], ai[13]); p.w = pk2(ai[14], ai[15]);
    *(v4u*)d1 = o; *(v4u*)(d1 + 8) = p;
    LDS_WAIT(); asm volatile("" ::: "memory");
}
template <bool PERMROWS>
__device__ __forceinline__ void tr_item64(const float* W, size_t ldw, int col0, int k0, bf16* dst, int Kd, int lane, LAS float* scr) {
    const int kq = lane >> 4, n4 = lane & 15; const float* src = W + (size_t)(k0 + kq * 16) * ldw + col0 + n4 * 4;
    LAS unsigned char* tb = (LAS unsigned char*)scr;
    f32x4 v[16];
#pragma unroll
    for (int i = 0; i < 16; ++i) v[i] = *(const f32x4*)(src + (size_t)i * ldw);
#pragma unroll
    for (int j = 0; j < 4; ++j) { const int n = n4 * 4 + j; v4u o, p;
        o.x = pk2(v[0][j], v[1][j]); o.y = pk2(v[2][j], v[3][j]); o.z = pk2(v[4][j], v[5][j]); o.w = pk2(v[6][j], v[7][j]);
        p.x = pk2(v[8][j], v[9][j]); p.y = pk2(v[10][j], v[11][j]); p.z = pk2(v[12][j], v[13][j]); p.w = pk2(v[14][j], v[15][j]);
        *(LAS v4u*)(tb + n * 128 + (((2 * kq) ^ (n & 7)) << 4)) = o; *(LAS v4u*)(tb + n * 128 + (((2 * kq + 1) ^ (n & 7)) << 4)) = p; }
    LDS_WAIT();
    const int pc = lane & 7;
#pragma unroll
    for (int i = 0; i < 8; ++i) { const int ns = 8 * i + (lane >> 3), nd = PERMROWS ? ((ns & 32) + rho32(ns & 31)) : ns;
        const v4u w = *(const LAS v4u*)(tb + ns * 128 + ((pc ^ (ns & 7)) << 4)); *(v4u*)(dst + (size_t)nd * Kd + k0 + pc * 8) = w; }
    LDS_WAIT();
}
__device__ __forceinline__ void convert_range(PH_ARGS, const int l, const int it_lo, const int it_hi, const int pidx, const int pcount) {
    if (pidx < 0) return;
    LAS float* scr = (LAS float*)(lds + wave * 16384);
    const int gw = pidx * 8 + wave, NGW = pcount * 8;
    bf16* WIN = WSP(bf16, WS_WIN); bf16* WBR = WSP(bf16, WS_WBR); bf16* WO = WSP(bf16, WS_WO); bf16* WGU = WSP(bf16, (l == 0 ? WS_WGU : WS_WGU1)); bf16* WDN = WSP(bf16, WS_WDN); bf16* WS_ = WSP(bf16, WS_WSP);
    const float* win = INP(8) + (size_t)l * 1024 * 6144;
    LAS f2v* tab = (LAS f2v*)(scr + 2048); { float s_, c_; sincospif((float)lane / 32.f, &s_, &c_); tab[lane] = (f2v){c_, s_}; } LDS_WAIT(); asm volatile("" ::: "memory");
    constexpr int N_FOLD = 256, N_IN = 92 * 16, N_BR = 256, N_WO = 256, N_GU = 8192, N_DN = 4096, N_SP = 64;
    constexpr int NITEMS = N_FOLD + N_IN + N_BR + N_WO + N_GU + N_DN + N_SP;
    for (int it = it_lo + gw; it < it_hi && it < NITEMS; it += NGW) {
        int r = it;
        if (r < N_FOLD) { fold_item16(win, r, WIN, scr, tab, lane); continue; } r -= N_FOLD;
        if (r < N_IN) { const int dbp = r >> 4, kb = r & 15, db = dbp < 8 ? dbp : dbp + 8; int col;
            if (db < 8) col = db * 64;
            else if (db < 24) { const int t = db - 16, tile = t >> 2, sub = t & 3; col = (sub < 2 ? 768 : 1024) + tile * 128 + (sub & 1) * 64; }
            else if (db < 36) col = 1280 + (db - 24) * 64;
            else col = 2048 + (db - 36) * 64;
            if (db < 24 || (db >= 32 && db < 36)) tr_item64<true>(win, 6144, col, kb * 64, WIN + (size_t)db * 64 * 1024, 1024, lane, scr);
            else tr_item64<false>(win, 6144, col, kb * 64, WIN + (size_t)db * 64 * 1024, 1024, lane, scr);
            continue; } r -= N_IN;
        if (r < N_BR) { const int b = r >> 6, q = r & 63, kb = q >> 4, nb = q & 15; const int ii = b == 0 ? 13 : (b == 1 ? 14 : (b == 2 ? 19 : 21));
            tr_item64<false>(INP(ii) + (size_t)l * 256 * 1024, 1024, nb * 64, kb * 64, WBR + (size_t)(b * 1024 + nb * 64) * 256, 256, lane, scr); continue; } r -= N_BR;
        if (r < N_WO) { const int kb = r >> 4, nb = r & 15; tr_item64<false>(INP(22) + (size_t)l * 1024 * 1024, 1024, nb * 64, kb * 64, WO + (size_t)nb * 64 * 1024, 1024, lane, scr); continue; } r -= N_WO;
        if (r < N_GU) { const int e = r >> 9, q = r & 511, db = q >> 4, kb = q & 15, tile = db >> 2, sub = db & 3;
            const float* src = (sub < 2 ? INP(24) : INP(25)) + (size_t)(l * 16 + e) * 1024 * 1024;
            tr_item64<false>(src, 1024, tile * 128 + (sub & 1) * 64, kb * 64, WGU + ((size_t)e * 2048 + db * 64) * 1024, 1024, lane, scr); continue; } r -= N_GU;
        if (r < N_DN) { const int e = r >> 8, q = r & 255, kb = q >> 4, nb = q & 15;
            tr_item64<false>(INP(26) + (size_t)(l * 16 + e) * 1024 * 1024, 1024, nb * 64, kb * 64, WDN + ((size_t)e * 1024 + nb * 64) * 1024, 1024, lane, scr); continue; } r -= N_DN;
        { const float* s = INP(11) + (size_t)l * 65536 + r * 1024 + lane * 16; const f32x4 a = *(const f32x4*)s, b = *(const f32x4*)(s + 4), c = *(const f32x4*)(s + 8), d = *(const f32x4*)(s + 12);
          v4u o, p; o.x = pk2(a[0], a[1]); o.y = pk2(a[2], a[3]); o.z = pk2(b[0], b[1]); o.w = pk2(b[2], b[3]); p.x = pk2(c[0], c[1]); p.y = pk2(c[2], c[3]); p.z = pk2(d[0], d[1]); p.w = pk2(d[2], d[3]);
          *(v4u*)(WS_ + r * 1024 + lane * 16) = o; *(v4u*)(WS_ + r * 1024 + lane * 16 + 8) = p; }
    }
}
constexpr int CV_FOLD0 = 0, CV_IN0 = 256, CV_BR0 = 256 + 92 * 16, CV_WO0 = CV_BR0 + 256, CV_GU0 = CV_WO0 + 256, CV_DN0 = CV_GU0 + 8192, CV_SP0 = CV_DN0 + 4096, CV_END = CV_SP0 + 64;
__device__ __forceinline__ void convert_weights(PH_ARGS, const int l) { convert_range(lds, tid, lane, wave, bid, G, l, 0, CV_END, bid, G); }
#define ROFF(lane, j) (8 * (lane) + 512 * ((j) >> 1) + 4 * ((j) & 1))
__device__ __forceinline__ void load_row(const float* p, int lane, f32x4 (&v)[4]) {
#pragma unroll
    for (int j = 0; j < 4; ++j) v[j] = *(const f32x4*)(p + ROFF(lane, j));
}
__device__ __forceinline__ void modnorm_store(f32x4 (&v)[4], const float* g, const float* sc, const float* sh, bf16* hrow, int lane) {
    float ss = 0.f;
#pragma unroll
    for (int j = 0; j < 4; ++j) ss += (v[j][0] * v[j][0] + v[j][1] * v[j][1]) + (v[j][2] * v[j][2] + v[j][3] * v[j][3]);
    const float rs = 1.0f / sqrtf(wave_sum(ss) * (1.f / 1024.f) + 1e-6f);
#pragma unroll
    for (int j = 0; j < 4; ++j) { const int o = ROFF(lane, j); const f32x4 gg = *(const f32x4*)(g + o), s = *(const f32x4*)(sc + o), b = *(const f32x4*)(sh + o);
        v[j] = v[j] * rs * gg * (s + 1.f) + b; }
    st8bf(hrow + 8 * lane, v[0], v[1]); st8bf(hrow + 8 * lane + 512, v[2], v[3]);
}
__device__ __forceinline__ void modnorm_regs(f32x4 (&v)[4], const f32x4 (&gm)[4], const f32x4 (&sh)[4], bf16* hrow, int lane) {
    float ss = 0.f;
#pragma unroll
    for (int j = 0; j < 4; ++j) ss += (v[j][0] * v[j][0] + v[j][1] * v[j][1]) + (v[j][2] * v[j][2] + v[j][3] * v[j][3]);
    const float rs = 1.0f / sqrtf(wave_sum(ss) * (1.f / 1024.f) + 1e-6f);
#pragma unroll
    for (int j = 0; j < 4; ++j) v[j] = v[j] * rs * gm[j] + sh[j];
    st8bf(hrow + 8 * lane, v[0], v[1]); st8bf(hrow + 8 * lane + 512, v[2], v[3]);
}
__device__ __forceinline__ void load_mod(const float* g, const float* sc, const float* shp, int lane, f32x4 (&gm)[4], f32x4 (&sh)[4]) {
#pragma unroll
    for (int j = 0; j < 4; ++j) { const int o = ROFF(lane, j); gm[j] = *(const f32x4*)(g + o) * (*(const f32x4*)(sc + o) + 1.f); sh[j] = *(const f32x4*)(shp + o); }
}
__device__ __forceinline__ void norm1_l0(PH_ARGS) {
    const int gw = bid * 8 + wave, NGW = G * 8; bf16* H = WSP(bf16, WS_H); const float* MOD = WSP(float, WS_MOD);
    const int RPW = (MT + NGW - 1) / NGW, row0 = gw * RPW, rend = (row0 + RPW < MT) ? row0 + RPW : MT;
    const float* xin = INP(0); const float* cin = INP(2); const float* g = INP(6);
    f32x4 cur[4], nxt[4], gm[4], sh[4]; int rprev = -1;
    if (row0 < rend) load_row(row0 < ML ? xin + (size_t)row0 * 1024 : cin + (size_t)(row0 - ML) * 1024, lane, cur);
    for (int row = row0; row < rend; ++row) {
        if (row + 1 < rend) { const int rn = row + 1; load_row(rn < ML ? xin + (size_t)rn * 1024 : cin + (size_t)(rn - ML) * 1024, lane, nxt); }
        const int r = row < SEQ ? 0 : (row < ML ? 1 : 2);
        if (r != rprev) { const float* md = MOD + r * 6144; load_mod(g, md + 1024, md, lane, gm, sh); rprev = r; }
        modnorm_regs(cur, gm, sh, H + (size_t)row * 1024, lane);
#pragma unroll
        for (int j = 0; j < 4; ++j) cur[j] = nxt[j];
    }
}
__device__ __forceinline__ void router_finish(float (&lg)[16], const int lane, float* AFF, int* SEL, const int row) {
#pragma unroll
    for (int i = 0; i < 8; ++i) { float a = lg[i], b = lg[i + 8]; swp32(a, b); lg[i] = a + b; }
#pragma unroll
    for (int i = 0; i < 4; ++i) { float a = lg[i], b = lg[i + 4]; swp16(a, b); lg[i] = a + b; }
#pragma unroll
    for (int i = 0; i < 2; ++i) { const bool up = lane & 8; const float send = up ? lg[i] : lg[i + 2], keep = up ? lg[i + 2] : lg[i]; lg[i] = keep + dppf<0x128>(send); }
    { const bool up = lane & 4; const float send = up ? lg[0] : lg[1], keep = up ? lg[1] : lg[0]; lg[0] = keep + dppf<0x141>(send); }
    float z = lg[0]; z += dppf<0xB1>(z); z += dppf<0x4E>(z);
    float mx = z; mx = fmaxf(mx, dppf<0x141>(mx)); mx = fmaxf(mx, dppf<0x140>(mx)); { float a = mx, b = mx; swp16(a, b); mx = fmaxf(a, b); } { float a = mx, b = mx; swp32(a, b); mx = fmaxf(a, b); }
    const float ez = expf(z - mx); float sm = ez; sm += dppf<0x141>(sm); sm += dppf<0x140>(sm); { float a = sm, b = sm; swp16(a, b); sm = a + b; } { float a = sm, b = sm; swp32(a, b); sm = a + b; }
    if ((lane & 3) == 0) { const int e = ((lane >> 5) & 1) * 8 + ((lane >> 4) & 1) * 4 + ((lane >> 3) & 1) * 2 + ((lane >> 2) & 1); AFF[(size_t)e * MT + row] = ez / sm; }
    if (lane < 16) SEL[(size_t)row * 16 + lane] = -1;
}
__device__ __forceinline__ void norm2_router(PH_ARGS, const int l, const int rbase, const int nrows, const int pidx, const int pcount, const bool load_table = true) {
    const int gw = pidx * 8 + wave, NGW = pcount * 8; bf16* H = WSP(bf16, WS_H); const float* MOD = WSP(float, WS_MOD) + l * 3 * 6144; const bf16* X = WSP(bf16, WS_X); float* AFF = WSP(float, WS_AFF); int* SEL = WSP(int, WS_SEL);
    LAS f32x4* Wl = (LAS f32x4*)lds;
    if (load_table) { const f32x4* wr = (const f32x4*)(INP(23) + (size_t)l * 1024 * 16);
      for (int i = tid; i < 4096; i += 512) { const int k = i >> 2, q = i & 3, jj = 2 * (k >> 9) + ((k >> 2) & 1), ln = (k >> 3) & 63; Wl[(q * 4 + (k & 3)) * 256 + 64 * jj + ln] = wr[i]; } }
    __syncthreads();
    const int RPW = (nrows + NGW - 1) / NGW, row0 = rbase + gw * RPW, rend = (gw * RPW + RPW < nrows) ? row0 + RPW : rbase + nrows;
    const float* g2 = INP(7) + l * 1024;
#define N2_CR(rw) ((rw) < SEQ ? 0 : ((rw) < ML ? 1 : 2))
#define N2_PIN16(x) asm volatile("" : "+v"((x)[0]), "+v"((x)[1]), "+v"((x)[2]), "+v"((x)[3]), "+v"((x)[4]), "+v"((x)[5]), "+v"((x)[6]), "+v"((x)[7]), "+v"((x)[8]), "+v"((x)[9]), "+v"((x)[10]), "+v"((x)[11]), "+v"((x)[12]), "+v"((x)[13]), "+v"((x)[14]), "+v"((x)[15]) :: "memory")
#define N2_STEP(rw) (((rw) + 1 < rend && N2_CR(rw) == N2_CR((rw) + 1)) ? 2 : 1)
#define N2_LD(d, rw) do { d[0] = *(const v4u*)(X + (size_t)(rw) * 1024 + 8 * lane); d[1] = *(const v4u*)(X + (size_t)(rw) * 1024 + 8 * lane + 512); } while (0)
#define N2_UNP(v, raw) do { _Pragma("unroll") for (int h = 0; h < 2; ++h) { v[2 * h] = (f32x4){bflo(raw[h].x), bfhi(raw[h].x), bflo(raw[h].y), bfhi(raw[h].y)}; v[2 * h + 1] = (f32x4){bflo(raw[h].z), bfhi(raw[h].z), bflo(raw[h].w), bfhi(raw[h].w)}; } } while (0)
    LAS f32x4* GS = (LAS f32x4*)(lds + 65536) + wave * 512;
    f32x4 va[4], vb[4]; const v4u z4 = {0u, 0u, 0u, 0u}; v4u ra[2] = {z4, z4}, rb[2] = {z4, z4}, na[2] = {z4, z4}, nb[2] = {z4, z4}; int rprev = -1;
    int row = row0, st = 0;
    if (row < rend) { st = N2_STEP(row); N2_LD(ra, row); if (st == 2) N2_LD(rb, row + 1); }
    while (row < rend) {
        const int nrow = row + st; int nst = 0;
        if (nrow < rend) { nst = N2_STEP(nrow); N2_LD(na, nrow); if (nst == 2) N2_LD(nb, nrow + 1); }
        N2_UNP(va, ra); N2_UNP(vb, rb);
        const int r = N2_CR(row);
        if (r != rprev) { const float* md = MOD + r * 6144; f32x4 g_[4], s_[4]; load_mod(g2, md + 4 * 1024, md + 3 * 1024, lane, g_, s_); rprev = r;
#pragma unroll
            for (int j = 0; j < 4; ++j) { GS[j * 64 + lane] = g_[j]; GS[(4 + j) * 64 + lane] = s_[j]; } }
        asm volatile("" ::: "memory");
        { float ssa = 0.f, ssb = 0.f;
#pragma unroll
          for (int j = 0; j < 4; ++j) { ssa += (va[j][0] * va[j][0] + va[j][1] * va[j][1]) + (va[j][2] * va[j][2] + va[j][3] * va[j][3]); ssb += (vb[j][0] * vb[j][0] + vb[j][1] * vb[j][1]) + (vb[j][2] * vb[j][2] + vb[j][3] * vb[j][3]); }
          const float rsa = 1.0f / sqrtf(wave_sum(ssa) * (1.f / 1024.f) + 1e-6f), rsb = st == 2 ? 1.0f / sqrtf(wave_sum(ssb) * (1.f / 1024.f) + 1e-6f) : 0.f;
#pragma unroll
          for (int j = 0; j < 4; ++j) { const f32x4 g = GS[j * 64 + lane], sft = GS[(4 + j) * 64 + lane]; va[j] = va[j] * rsa * g + sft; vb[j] = vb[j] * rsb * g + sft; }
          bf16* ha = H + (size_t)row * 1024; st8bf(ha + 8 * lane, va[0], va[1]); st8bf(ha + 8 * lane + 512, va[2], va[3]);
          if (st == 2) { bf16* hb = ha + 1024; st8bf(hb + 8 * lane, vb[0], vb[1]); st8bf(hb + 8 * lane + 512, vb[2], vb[3]); }
          else {
#pragma unroll
              for (int j = 0; j < 4; ++j) vb[j] = (f32x4){0.f, 0.f, 0.f, 0.f}; } }
        float lga[16], lgb[16];
#pragma unroll
        for (int e = 0; e < 16; ++e) { lga[e] = 0.f; lgb[e] = 0.f; }
#pragma unroll
        for (int j = 0; j < 4; ++j)
#pragma unroll
            for (int i = 0; i < 4; ++i) { const float ha = va[j][i], hb = vb[j][i];
#pragma unroll
                for (int q = 0; q < 4; ++q) { const f32x4 w = Wl[(q * 4 + i) * 256 + 64 * j + lane];
                    lga[4 * q + 0] += ha * w[0]; lga[4 * q + 1] += ha * w[1]; lga[4 * q + 2] += ha * w[2]; lga[4 * q + 3] += ha * w[3];
                    lgb[4 * q + 0] += hb * w[0]; lgb[4 * q + 1] += hb * w[1]; lgb[4 * q + 2] += hb * w[2]; lgb[4 * q + 3] += hb * w[3]; }
                if (i == 3) { N2_PIN16(lga); N2_PIN16(lgb); } }
        router_finish(lga, lane, AFF, SEL, row);
        if (st == 2) router_finish(lgb, lane, AFF, SEL, row + 1);
        ra[0] = na[0]; ra[1] = na[1]; rb[0] = nb[0]; rb[1] = nb[1]; row = nrow; st = nst;
    }
#undef N2_CR
#undef N2_PIN16
#undef N2_STEP
#undef N2_LD
#undef N2_UNP
    __syncthreads();
}
typedef short v4i16_t __attribute__((ext_vector_type(4)));
__device__ __forceinline__ void mfma16(f32x4& acc, const bf16x8 a, const bf16x8 b) { asm volatile("s_nop 1\n\tv_mfma_f32_16x16x32_bf16 %0, %1, %2, %0\n\ts_nop 3" : "+v"(acc) : "v"(a), "v"(b)); }
__device__ __forceinline__ void mfma16n(f32x4& acc, const bf16x8 a, const bf16x8 b) { asm volatile("v_mfma_f32_16x16x32_bf16 %0, %1, %2, %0" : "+v"(acc) : "v"(a), "v"(b)); }
#define DRAIN4(x) asm volatile("s_nop 15\n\ts_nop 15" : "+v"((x)[0]), "+v"((x)[1]), "+v"((x)[2]), "+v"((x)[3]))
#define DRAIN8(x) asm volatile("s_nop 15\n\ts_nop 15" : "+v"((x)[0]), "+v"((x)[1]), "+v"((x)[2]), "+v"((x)[3]), "+v"((x)[4]), "+v"((x)[5]), "+v"((x)[6]), "+v"((x)[7]))
#define DRAIN16(x) asm volatile("s_nop 15\n\ts_nop 15" : "+v"((x)[0]), "+v"((x)[1]), "+v"((x)[2]), "+v"((x)[3]), "+v"((x)[4]), "+v"((x)[5]), "+v"((x)[6]), "+v"((x)[7]), \
    "+v"((x)[8]), "+v"((x)[9]), "+v"((x)[10]), "+v"((x)[11]), "+v"((x)[12]), "+v"((x)[13]), "+v"((x)[14]), "+v"((x)[15]))
__device__ __forceinline__ void gmlp_unit(PH_ARGS, const int l, const int chunk) {
    const int row0 = chunk < 128 ? chunk * 128 : ML + (chunk - 128) * 128;
    const bf16* AUV = WSP(bf16, WS_AUV); bf16* BRa = WSP(bf16, WS_BR); const bf16* WS_ = WSP(bf16, WS_WSP);
    LAS bf16* vT = (LAS bf16*)lds;
    const float* lg = INP(9) + l * 256; const float* lb = INP(10) + l * 256;
    const f32x4 gg = *(const f32x4*)(lg + 4 * lane), bb = *(const f32x4*)(lb + 4 * lane);
    uint2 raws[16];
#pragma unroll
    for (int pi = 0; pi < 16; ++pi) raws[pi] = *(const uint2*)(AUV + (size_t)(row0 + wave * 16 + pi) * 512 + 256 + 4 * lane);
#pragma unroll
    for (int pi = 0; pi < 16; ++pi) { const int p = wave * 16 + pi;
        const uint2 raw = raws[pi];
        float v0 = bflo(raw.x), v1 = bfhi(raw.x), v2 = bflo(raw.y), v3 = bfhi(raw.y);
        const float mean = wave_sum((v0 + v1) + (v2 + v3)) * (1.f / 256.f); v0 -= mean; v1 -= mean; v2 -= mean; v3 -= mean;
        const float rstd = 1.0f / sqrtf(wave_sum((v0 * v0 + v1 * v1) + (v2 * v2 + v3 * v3)) * (1.f / 256.f) + 1e-6f);
        vT[(4 * lane + 0) * 136 + p] = (bf16)f2bf(v0 * rstd * gg[0] + bb[0]); vT[(4 * lane + 1) * 136 + p] = (bf16)f2bf(v1 * rstd * gg[1] + bb[1]);
        vT[(4 * lane + 2) * 136 + p] = (bf16)f2bf(v2 * rstd * gg[2] + bb[2]); vT[(4 * lane + 3) * 136 + p] = (bf16)f2bf(v3 * rstd * gg[3] + bb[3]); }
    __syncthreads();
    const int g = wave >> 1, qh = wave & 1, fr = lane & 15, fq = lane >> 4;
    f32x4 acc[4][4];
#pragma unroll
    for (int a = 0; a < 4; ++a)
#pragma unroll
        for (int b = 0; b < 4; ++b) acc[a][b] = (f32x4){0.f, 0.f, 0.f, 0.f};
    const bf16* Wg = WS_ + g * 16384;
#pragma unroll
    for (int ks = 0; ks < 4; ++ks) { bf16x8 af[4], bf[4];
#pragma unroll
        for (int dt = 0; dt < 4; ++dt) af[dt] = *(const LAS bf16x8*)(vT + (g * 64 + dt * 16 + fr) * 136 + ks * 32 + fq * 8);
#pragma unroll
        for (int qt = 0; qt < 4; ++qt) bf[qt] = *(const bf16x8*)(Wg + (qh * 64 + qt * 16 + fr) * 128 + ks * 32 + fq * 8);
#pragma unroll
        for (int dt = 0; dt < 4; ++dt)
#pragma unroll
            for (int qt = 0; qt < 4; ++qt) mfma16(acc[dt][qt], af[dt], bf[qt]); }
    DRAIN16(&acc[0][0]);
    const float* bs = INP(12) + l * 512 + g * 128;
#pragma unroll
    for (int qt = 0; qt < 4; ++qt) { const int q = qh * 64 + qt * 16 + fr; const float bias = bs[q]; const size_t row = row0 + q;
#pragma unroll
        for (int dp = 0; dp < 2; ++dp) { f32x4 o[2];
#pragma unroll
            for (int h = 0; h < 2; ++h) { const int dt = 2 * dp + h, ch = g * 64 + dt * 16 + 4 * fq; const uint2 uw = *(const uint2*)(AUV + row * 512 + ch);
                o[h][0] = bflo(uw.x) * (acc[dt][qt][0] + bias); o[h][1] = bfhi(uw.x) * (acc[dt][qt][1] + bias); o[h][2] = bflo(uw.y) * (acc[dt][qt][2] + bias); o[h][3] = bfhi(uw.y) * (acc[dt][qt][3] + bias); }
            st4bf2(BRa + row * 256 + g * 64 + dp * 32 + (fq & 1) * 16 + (fq >> 1) * 8, o[0], o[1]); } }
    __syncthreads();
}
__device__ __forceinline__ void conv_unit(PH_ARGS, const int l, const int unit) {
    int rowbase, n0, nlen;
    if (unit < 256) { rowbase = (unit >> 7) * SEQ; n0 = (unit & 127) * 64; nlen = SEQ; } else { const int u2 = unit - 256; rowbase = ML + (u2 >> 2) * CTXL; n0 = (u2 & 3) * 64; nlen = CTXL; }
    const bf16* CY = WSP(bf16, WS_CY); bf16* BRc = WSP(bf16, WS_BR) + (size_t)2 * MT * 256;
    LAS unsigned* yt = (LAS unsigned*)lds;
    LAS float* cres = (LAS float*)(lds + 48128);
    for (int p = tid; p < 94 * 32; p += 512) { const int rr = p >> 5, seg = p & 31, n = n0 - 15 + rr; v4u val = {0u, 0u, 0u, 0u};
        if (n >= 0 && n < nlen) val = *(const v4u*)(CY + (size_t)(rowbase + n) * 256 + seg * 8);
        *(LAS v4u*)(lds + rr * 512 + seg * 16) = val; }
    __syncthreads();
    const int cp = tid & 127, pg = tid >> 7;
    float w0[31], w1[31];
    const float* cw = INP(15) + (size_t)l * 31 * 256 + 2 * cp;
#pragma unroll
    for (int t = 0; t < 31; ++t) { const float2 w = *(const float2*)(cw + t * 256); w0[t] = w.x; w1[t] = w.y; }
    float a0[16], a1[16];
#pragma unroll
    for (int p = 0; p < 16; ++p) { a0[p] = 0.f; a1[p] = 0.f; }
#pragma unroll
    for (int i = 0; i < 46; ++i) { const unsigned raw = yt[(16 * pg + i) * 128 + cp]; const float v0 = bflo(raw), v1 = bfhi(raw);
#pragma unroll
        for (int p = 0; p < 16; ++p) { const int t = i - p; if (t >= 0 && t < 31) { a0[p] += v0 * w0[t]; a1[p] += v1 * w1[t]; } } }
    const float2 cb = *(const float2*)(INP(16) + l * 256 + 2 * cp);
#pragma unroll
    for (int p = 0; p < 16; ++p) *(LAS f2v*)(cres + (16 * pg + p) * 256 + 2 * cp) = (f2v){a0[p] + cb.x, a1[p] + cb.y};
    __syncthreads();
    const f32x4 gg = *(const f32x4*)(INP(17) + l * 256 + 4 * lane), bb = *(const f32x4*)(INP(18) + l * 256 + 4 * lane);
    for (int pi = 0; pi < 8; ++pi) { const int pos = wave * 8 + pi; f32x4 v = *(const LAS f32x4*)(cres + pos * 256 + 4 * lane);
        const float mean = wave_sum((v[0] + v[1]) + (v[2] + v[3])) * (1.f / 256.f); v = v - mean;
        const float rstd = 1.0f / sqrtf(wave_sum((v[0] * v[0] + v[1] * v[1]) + (v[2] * v[2] + v[3] * v[3])) * (1.f / 256.f) + 1e-6f);
        f32x4 o;
#pragma unroll
        for (int j = 0; j < 4; ++j) { const float y = v[j] * rstd * gg[j] + bb[j]; o[j] = y * sigm(y); }
        st4bf(BRc + (size_t)(rowbase + n0 + pos) * 256 + 4 * lane, o); }
    __syncthreads();
}
constexpr int F1_T1L = 0, F1_YL = 34816;
__device__ __forceinline__ void f1_stage_tables(PH_ARGS) {
    const bf16* T1 = WSP(bf16, WS_T1T);
    for (int p = tid; p < 128 * 16; p += 512) { const int r = p >> 4, s = p & 15; *(LAS v4u*)(lds + F1_T1L + r * 272 + s * 16) = *(const v4u*)(T1 + r * 128 + s * 8); }
    __syncthreads();
}
__device__ __forceinline__ void f1_unit(PH_ARGS, const int unit) {
    const int b = unit >> 7, n2 = unit & 127, fr = lane & 15, fq = lane >> 4;
    const bf16* YF = WSP(bf16, WS_YF); bf16* FA = WSP(bf16, WS_FA);
    LAS unsigned* Yl = (LAS unsigned*)(lds + F1_YL);
#pragma unroll
    for (int i = 0; i < 8; ++i) { const int n1 = wave + 8 * i; *(LAS v4u*)(Yl + n1 * 260 + lane * 4) = *(const v4u*)(YF + (size_t)(b * SEQ + 128 * n1 + n2) * 512 + lane * 8); }
    __syncthreads();
    f32x4 acc[2][8];
#pragma unroll
    for (int a = 0; a < 2; ++a)
#pragma unroll
        for (int n = 0; n < 8; ++n) acc[a][n] = (f32x4){0.f, 0.f, 0.f, 0.f};
#pragma unroll
    for (int ks = 0; ks < 4; ++ks) { bf16x8 af[2];
#pragma unroll
        for (int c2 = 0; c2 < 2; ++c2) { const int ch = (2 * wave + c2) * 16 + fr; v4u w;
            w.x = Yl[(16 * ks + 4 * fq + 0) * 260 + ch]; w.y = Yl[(16 * ks + 4 * fq + 1) * 260 + ch]; w.z = Yl[(16 * ks + 4 * fq + 2) * 260 + ch]; w.w = Yl[(16 * ks + 4 * fq + 3) * 260 + ch];
            af[c2] = __builtin_bit_cast(bf16x8, w); }
#pragma unroll
        for (int nt = 0; nt < 8; ++nt) { const bf16x8 bfr = *(const LAS bf16x8*)(lds + F1_T1L + (nt * 16 + fr) * 272 + ks * 64 + fq * 16);
            mfma16(acc[0][nt], af[0], bfr); mfma16(acc[1][nt], af[1], bfr); } }
    DRAIN16(&acc[0][0]);
#pragma unroll
    for (int c2 = 0; c2 < 2; ++c2)
#pragma unroll
        for (int kt = 0; kt < 4; ++kt) { const int k1 = kt * 16 + fr; const f32x4 ar = acc[c2][kt], ai = acc[c2][kt + 4];
            v4u o; o.x = pk2(ar[0], ai[0]); o.y = pk2(ar[1], ai[1]); o.z = pk2(ar[2], ai[2]); o.w = pk2(ar[3], ai[3]);
            *(v4u*)(FA + ((size_t)((b * 64 + k1) * 128 + n2) * 256 + (2 * wave + c2) * 16 + 4 * fq) * 2) = o; }
    __syncthreads();
}
constexpr int F2_T2L = 0, F2_AL = 67584;
__device__ __forceinline__ void f2_unit(PH_ARGS, const int unit) {
    const int fr = lane & 15, fq = lane >> 4; const bool lat = unit < 256;
    int b, k1, chh; const bf16* Asrc; const bf16* Tsrc; size_t orow0; int ostr; float scl;
    if (lat) { b = unit >> 7; k1 = (unit >> 1) & 63; chh = unit & 1; Asrc = WSP(bf16, WS_FA) + (size_t)((b * 64 + k1) * 128) * 512; Tsrc = WSP(bf16, WS_T2F) + (size_t)k1 * 32768; orow0 = (size_t)b * SEQ + k1; ostr = 64; scl = 0.0013810679320049757f; }
    else { const int u2 = unit - 256; b = u2 >> 2; k1 = (u2 >> 1) & 1; chh = u2 & 1; Asrc = WSP(bf16, WS_FAC) + (size_t)((b * 2 + k1) * 128) * 512; Tsrc = WSP(bf16, WS_T2C) + (size_t)k1 * 32768; orow0 = (size_t)ML + b * CTXL + k1; ostr = 2; scl = 1.f / 128.f; }
    bf16* BRb = WSP(bf16, WS_BR) + (size_t)1 * MT * 256;
    LAS unsigned* Al = (LAS unsigned*)(lds + F2_AL);
    for (int p = tid; p < 128 * 32; p += 512) { const int r = p >> 5, s = p & 31; *(LAS v4u*)(lds + F2_T2L + r * 528 + s * 16) = *(const v4u*)(Tsrc + r * 256 + s * 8); }
#pragma unroll
    for (int i = 0; i < 8; ++i) { const int n2 = wave * 16 + 2 * i + (lane >> 5);
        *(LAS v4u*)(Al + n2 * 132 + (lane & 31) * 4) = *(const v4u*)(Asrc + ((size_t)n2 * 256 + chh * 128) * 2 + (lane & 31) * 8); }
    __syncthreads();
    f32x4 acc[8];
#pragma unroll
    for (int n = 0; n < 8; ++n) acc[n] = (f32x4){0.f, 0.f, 0.f, 0.f};
    const int ch = wave * 16 + fr;
#pragma unroll
    for (int ks = 0; ks < 8; ++ks) { v4u w;
        w.x = Al[(16 * ks + 4 * fq + 0) * 132 + ch]; w.y = Al[(16 * ks + 4 * fq + 1) * 132 + ch]; w.z = Al[(16 * ks + 4 * fq + 2) * 132 + ch]; w.w = Al[(16 * ks + 4 * fq + 3) * 132 + ch];
        const bf16x8 af = __builtin_bit_cast(bf16x8, w);
#pragma unroll
        for (int nt = 0; nt < 8; ++nt) { const bf16x8 bfr = *(const LAS bf16x8*)(lds + F2_T2L + (nt * 16 + fr) * 528 + ks * 64 + fq * 16); mfma16(acc[nt], af, bfr); } }
    DRAIN8(acc);
#pragma unroll
    for (int np = 0; np < 4; ++np) { const int k2 = (2 * np + (fq & 1)) * 16 + fr;
        st4bf2(BRb + (orow0 + (size_t)ostr * k2) * 256 + chh * 128 + wave * 16 + (fq >> 1) * 8, acc[2 * np] * scl, acc[2 * np + 1] * scl); }
    __syncthreads();
}
__device__ __forceinline__ void ctx_butterfly(PH_ARGS) {
    const unsigned* YF = (const unsigned*)WSP(bf16, WS_YF); unsigned* FAC = (unsigned*)WSP(bf16, WS_FAC);
    for (int i = bid * 512 + tid; i < 2 * 128 * 256; i += G * 512) { const int b = i >> 15, n2 = (i >> 8) & 127, ch = i & 255;
        const unsigned y0 = YF[(size_t)(ML + b * CTXL + n2) * 256 + ch], y1 = YF[(size_t)(ML + b * CTXL + 128 + n2) * 256 + ch];
        const float r0 = bflo(y0), i0 = bfhi(y0), r1 = bflo(y1), i1 = bfhi(y1);
        FAC[(size_t)((b * 2 + 0) * 128 + n2) * 256 + ch] = pk2(r0 + r1, i0 + i1); FAC[(size_t)((b * 2 + 1) * 128 + n2) * 256 + ch] = pk2(r0 - r1, i0 - i1); }
}
constexpr int MG_BUF = 32768;
__device__ __forceinline__ void merge_tail(PH_ARGS, const int kbase, const int nmine) {
    const int fr = lane & 15, fq = lane >> 4, wr = wave >> 2, wc = wave & 3;
    const bf16* BR = WSP(bf16, WS_BR); const bf16* WBR = WSP(bf16, WS_WBR); const bf16* GT = WSP(bf16, WS_G); bf16* MB = WSP(bf16, WS_MB);
    const int nq = nmine * 16, nsteps = nmine * 4;
    if (nq == 0) return;
    unsigned soff[2];
#pragma unroll
    for (int i = 0; i < 2; ++i) { const int p = (i * 8 + wave) * 64 + lane, row = p >> 3, g = (p & 7) ^ (row & 7); soff[i] = (unsigned)(row * 512 + g * 16); }
#define MG_STAGE(q_) do { const int qq_ = (q_) < nq ? (q_) : nq - 1, s_ = qq_ >> 2, kq_ = qq_ & 3, u_ = bid + (kbase + (s_ >> 2)) * G, b_ = s_ & 3, rt_ = u_ >> 3, ct_ = u_ & 7; \
        const char* As = (const char*)(BR + ((size_t)b_ * MT + (size_t)rt_ * 128) * 256) + kq_ * 128; const char* Bs = (const char*)(WBR + ((size_t)b_ * 1024 + (size_t)ct_ * 128) * 256) + kq_ * 128; \
        LAS unsigned char* d_ = lds + ((q_) & 3) * MG_BUF + wave * 1024; \
        _Pragma("unroll") for (int i = 0; i < 2; ++i) { __builtin_amdgcn_global_load_lds((const unsigned*)(As + soff[i]), (LAS unsigned*)(d_ + i * 8192), 16, 0, 0); \
                                                        __builtin_amdgcn_global_load_lds((const unsigned*)(Bs + soff[i]), (LAS unsigned*)(d_ + 16384 + i * 8192), 16, 0, 0); } } while (0)
    f32x4 macc[4][2], acc[4][2], gf[4][2]; v4u gwP[2], gwQ[2];
#define MG_GLOAD(GW, s) do { const int u_ = bid + (kbase + ((s) >> 2)) * G, b_ = (s) & 3; \
        _Pragma("unroll") for (int mp = 0; mp < 2; ++mp) { const unsigned char* gp_ = (const unsigned char*)GT + ((((size_t)(u_ * 4 + b_) * 8 + wave) * 2 + mp) * 64 + lane) * 16; \
            asm volatile("global_load_dwordx4 %0, %1, off" : "=v"(GW[mp]) : "v"(gp_) : "memory"); } } while (0)
#pragma unroll
    for (int a = 0; a < 4; ++a)
#pragma unroll
        for (int n = 0; n < 2; ++n) { macc[a][n] = (f32x4){0.f, 0.f, 0.f, 0.f}; acc[a][n] = (f32x4){0.f, 0.f, 0.f, 0.f}; gwQ[a & 1] = (v4u){0u, 0u, 0u, 0u}; gf[a][n] = (f32x4){0.f, 0.f, 0.f, 0.f}; }
    MG_GLOAD(gwP, 0);
    MG_STAGE(0); MG_STAGE(1); MG_STAGE(2);
#define MG_Q(q_, KQ, GWU, GWL) do { const int q = (q_), s = q >> 2, u = bid + (kbase + (s >> 2)) * G, b = s & 3, rt = u >> 3, ct = u & 7; \
        if (KQ == 0) asm volatile("s_waitcnt vmcnt(8)" : "+v"(macc[0][0]), "+v"(macc[0][1]), "+v"(macc[1][0]), "+v"(macc[1][1]), "+v"(macc[2][0]), "+v"(macc[2][1]), "+v"(macc[3][0]), "+v"(macc[3][1]), \
            "+v"(GWU[0]), "+v"(GWU[1]) :: "memory");     \
        else asm volatile("s_waitcnt vmcnt(10)" ::: "memory");        \
        __builtin_amdgcn_s_barrier();                                 \
        MG_STAGE(q + 3); \
        if (KQ == 0) { MG_GLOAD(GWL, (s + 1 < nsteps ? s + 1 : s)); \
            _Pragma("unroll") for (int mt = 0; mt < 4; ++mt) _Pragma("unroll") for (int nt = 0; nt < 2; ++nt) acc[mt][nt] = (f32x4){0.f, 0.f, 0.f, 0.f}; \
            asm volatile("s_nop 1" : "+v"(acc[0][0]), "+v"(acc[0][1]), "+v"(acc[1][0]), "+v"(acc[1][1]), "+v"(acc[2][0]), "+v"(acc[2][1]), "+v"(acc[3][0]), "+v"(acc[3][1])); }     \
        const LAS unsigned char* bufA = lds + (q & 3) * MG_BUF; const LAS unsigned char* bufB = bufA + 16384; \
        _Pragma("unroll") for (int ks = 0; ks < 2; ++ks) { bf16x8 af[4], bfr[2]; const int gc = ((ks * 4 + fq) ^ (fr & 7)) << 4; \
            _Pragma("unroll") for (int mt = 0; mt < 4; ++mt) af[mt] = *(const LAS bf16x8*)(bufA + (wr * 64 + mt * 16 + fr) * 128 + gc); \
            _Pragma("unroll") for (int nt = 0; nt < 2; ++nt) bfr[nt] = *(const LAS bf16x8*)(bufB + (wc * 32 + nt * 16 + fr) * 128 + gc); \
            _Pragma("unroll") for (int mt = 0; mt < 4; ++mt) _Pragma("unroll") for (int nt = 0; nt < 2; ++nt) mfma16n(acc[mt][nt], bfr[nt], af[mt]); }     \
        if (KQ == 1 || KQ == 2) {                                     \
            _Pragma("unroll") for (int mt = 2 * (KQ - 1); mt < 2 * KQ; ++mt) _Pragma("unroll") for (int nt = 0; nt < 2; ++nt) { const unsigned gx = GWU[KQ - 1][2 * (mt & 1) + nt]; \
                gf[mt][nt][0] = (float)(gx & 255u) * (1.f / 255.f); gf[mt][nt][1] = (float)((gx >> 8) & 255u) * (1.f / 255.f); gf[mt][nt][2] = (float)((gx >> 16) & 255u) * (1.f / 255.f); gf[mt][nt][3] = (float)(gx >> 24) * (1.f / 255.f); } } \
        if (KQ == 3) { DRAIN8(&acc[0][0]); \
            _Pragma("unroll") for (int mt = 0; mt < 4; ++mt) _Pragma("unroll") for (int nt = 0; nt < 2; ++nt) { \
                macc[mt][nt][0] += gf[mt][nt][0] * acc[mt][nt][0]; macc[mt][nt][1] += gf[mt][nt][1] * acc[mt][nt][1]; macc[mt][nt][2] += gf[mt][nt][2] * acc[mt][nt][2]; macc[mt][nt][3] += gf[mt][nt][3] * acc[mt][nt][3]; } \
            if (b == 3) { _Pragma("unroll") for (int mt = 0; mt < 4; ++mt) { \
                st4bf2(MB + (size_t)(rt * 128 + wr * 64 + mt * 16 + fr) * 1024 + ct * 128 + wc * 32 + (fq & 1) * 16 + (fq >> 1) * 8, macc[mt][0], macc[mt][1]); \
                macc[mt][0] = (f32x4){0.f, 0.f, 0.f, 0.f}; macc[mt][1] = (f32x4){0.f, 0.f, 0.f, 0.f}; } } } } while (0)
#pragma unroll 1
    for (int sp = 0; sp < (nsteps >> 1); ++sp) {
        MG_Q(8 * sp, 0, gwP, gwQ); MG_Q(8 * sp + 1, 1, gwP, gwQ); MG_Q(8 * sp + 2, 2, gwP, gwQ); MG_Q(8 * sp + 3, 3, gwP, gwQ);
        MG_Q(8 * sp + 4, 0, gwQ, gwP); MG_Q(8 * sp + 5, 1, gwQ, gwP); MG_Q(8 * sp + 6, 2, gwQ, gwP); MG_Q(8 * sp + 7, 3, gwQ, gwP);
    }
    asm volatile("s_waitcnt vmcnt(0)" ::: "memory");
    __syncthreads();
#undef MG_Q
#undef MG_GLOAD
#undef MG_STAGE
}
constexpr int M5_A = 65536;
__device__ __forceinline__ void merge_four(PH_ARGS) {
    const int fr = lane & 15, fq = lane >> 4, wr = wave >> 2, wc = wave & 3, ct = bid & 7;
    const bf16* BR = WSP(bf16, WS_BR); const bf16* WBR = WSP(bf16, WS_WBR); const unsigned char* GT = (const unsigned char*)WSP(bf16, WS_G); bf16* MB = WSP(bf16, WS_MB);
    unsigned soff[2];
#pragma unroll
    for (int i = 0; i < 2; ++i) { const int p = (i * 8 + wave) * 64 + lane, row = p >> 3, g = (p & 7) ^ (row & 7); soff[i] = (unsigned)(row * 512 + g * 16); }
#define M5_STAGE_A(q_) do { const int qq_ = (q_) < 64 ? (q_) : 63, b_ = qq_ >> 4, k_ = (qq_ >> 2) & 3, kq_ = qq_ & 3, rt_ = (bid + k_ * G) >> 3; \
        const char* As = (const char*)(BR + ((size_t)b_ * MT + (size_t)rt_ * 128) * 256) + kq_ * 128; LAS unsigned char* d_ = lds + M5_A + ((q_) & 3) * 16384 + wave * 1024; \
        unsigned so_[2] = {soff[0], soff[1]}; asm volatile("" : "+v"(so_[0]), "+v"(so_[1]));     \
        _Pragma("unroll") for (int i = 0; i < 2; ++i) __builtin_amdgcn_global_load_lds((const unsigned*)(As + so_[i]), (LAS unsigned*)(d_ + i * 8192), 16, 0, 0); } while (0)
#define M5_STAGE_B(bb_, j_) do { const char* Bs = (const char*)(WBR + ((size_t)((bb_) & 3) * 1024 + (size_t)ct * 128) * 256) + (j_) * 128; LAS unsigned char* d_ = lds + (j_) * 16384 + wave * 1024; \
        unsigned so_[2] = {soff[0], soff[1]}; asm volatile("" : "+v"(so_[0]), "+v"(so_[1])); \
        _Pragma("unroll") for (int i = 0; i < 2; ++i) __builtin_amdgcn_global_load_lds((const unsigned*)(Bs + so_[i]), (LAS unsigned*)(d_ + i * 8192), 16, 0, 0); } while (0)
#define M5_GLOAD(GW, t_) do { const int b_ = (t_) >> 2, u_ = bid + ((t_) & 3) * G; \
        _Pragma("unroll") for (int mp = 0; mp < 2; ++mp) { const unsigned char* gp_ = GT + ((((size_t)(u_ * 4 + b_) * 8 + wave) * 2 + mp) * 64 + lane) * 16; \
            asm volatile("global_load_dwordx4 %0, %1, off" : "=v"(GW[mp]) : "v"(gp_) : "memory"); } } while (0)
    f32x4 macc[4][4][2], acc[4][2]; v4u gwP[2], gwQ[2];
#pragma unroll
    for (int k = 0; k < 4; ++k)
#pragma unroll
        for (int a = 0; a < 4; ++a)
#pragma unroll
            for (int n = 0; n < 2; ++n) { macc[k][a][n] = (f32x4){0.f, 0.f, 0.f, 0.f}; acc[a][n] = (f32x4){0.f, 0.f, 0.f, 0.f}; gwQ[n] = (v4u){0u, 0u, 0u, 0u}; }
    M5_GLOAD(gwP, 0);
    M5_STAGE_A(0); M5_STAGE_B(0, 0); M5_STAGE_A(1); M5_STAGE_B(0, 1); M5_STAGE_A(2); M5_STAGE_B(0, 2);
#define M5_WAIT(N) "s_waitcnt vmcnt(" #N ")"
#define M5_Q(bv, K, KQ, NW, GWU, GWL) do { const int q = (bv) * 16 + (K) * 4 + (KQ), t = (bv) * 4 + (K); \
        if (KQ == 0) asm volatile(M5_WAIT(NW) : "+v"(macc[(K + 3) & 3][0][0]), "+v"(macc[(K + 3) & 3][0][1]), "+v"(macc[(K + 3) & 3][1][0]), "+v"(macc[(K + 3) & 3][1][1]), "+v"(macc[(K + 3) & 3][2][0]), "+v"(macc[(K + 3) & 3][2][1]), \
            "+v"(macc[(K + 3) & 3][3][0]), "+v"(macc[(K + 3) & 3][3][1]), "+v"(GWU[0]), "+v"(GWU[1]) :: "memory");     \
        else asm volatile(M5_WAIT(NW) ::: "memory"); \
        __builtin_amdgcn_s_barrier(); \
        M5_STAGE_A(q + 3); \
        if ((K) == 0 && (KQ) == 0) M5_STAGE_B((bv), 3); if ((K) == 3 && (KQ) >= 1) M5_STAGE_B((bv) + 1, (KQ) - 1); \
        if (KQ == 0) { M5_GLOAD(GWL, (t + 1 < 16 ? t + 1 : t)); \
            _Pragma("unroll") for (int mt = 0; mt < 4; ++mt) _Pragma("unroll") for (int nt = 0; nt < 2; ++nt) acc[mt][nt] = (f32x4){0.f, 0.f, 0.f, 0.f}; \
            asm volatile("s_nop 1" : "+v"(acc[0][0]), "+v"(acc[0][1]), "+v"(acc[1][0]), "+v"(acc[1][1]), "+v"(acc[2][0]), "+v"(acc[2][1]), "+v"(acc[3][0]), "+v"(acc[3][1])); } \
        const LAS unsigned char* bufA = lds + M5_A + (q & 3) * 16384; const LAS unsigned char* bufB = lds + (KQ) * 16384; \
        _Pragma("unroll") for (int ks = 0; ks < 2; ++ks) { bf16x8 af[4], bfr[2]; const int gc = ((ks * 4 + fq) ^ (fr & 7)) << 4; \
            _Pragma("unroll") for (int mt = 0; mt < 4; ++mt) af[mt] = *(const LAS bf16x8*)(bufA + (wr * 64 + mt * 16 + fr) * 128 + gc); \
            _Pragma("unroll") for (int nt = 0; nt < 2; ++nt) bfr[nt] = *(const LAS bf16x8*)(bufB + (wc * 32 + nt * 16 + fr) * 128 + gc); \
            _Pragma("unroll") for (int mt = 0; mt < 4; ++mt) _Pragma("unroll") for (int nt = 0; nt < 2; ++nt) mfma16n(acc[mt][nt], bfr[nt], af[mt]); } \
        if (KQ == 3) { DRAIN8(&acc[0][0]); \
            _Pragma("unroll") for (int mt = 0; mt < 4; ++mt) _Pragma("unroll") for (int nt = 0; nt < 2; ++nt) { const unsigned gx = GWU[mt >> 1][2 * (mt & 1) + nt]; \
                macc[K][mt][nt][0] += (float)(gx & 255u) * acc[mt][nt][0]; macc[K][mt][nt][1] += (float)((gx >> 8) & 255u) * acc[mt][nt][1]; \
                macc[K][mt][nt][2] += (float)((gx >> 16) & 255u) * acc[mt][nt][2]; macc[K][mt][nt][3] += (float)(gx >> 24) * acc[mt][nt][3]; } } } while (0)
#pragma unroll 1
    for (int b = 0; b < 4; ++b) {
        M5_Q(b, 0, 0, 8, gwP, gwQ); M5_Q(b, 0, 1, 10, gwP, gwQ); M5_Q(b, 0, 2, 8, gwP, gwQ); M5_Q(b, 0, 3, 6, gwP, gwQ);
        M5_Q(b, 1, 0, 4, gwQ, gwP); M5_Q(b, 1, 1, 6, gwQ, gwP); M5_Q(b, 1, 2, 6, gwQ, gwP); M5_Q(b, 1, 3, 6, gwQ, gwP);
        M5_Q(b, 2, 0, 4, gwP, gwQ); M5_Q(b, 2, 1, 6, gwP, gwQ); M5_Q(b, 2, 2, 6, gwP, gwQ); M5_Q(b, 2, 3, 6, gwP, gwQ);
        M5_Q(b, 3, 0, 4, gwQ, gwP); M5_Q(b, 3, 1, 6, gwQ, gwP); M5_Q(b, 3, 2, 8, gwQ, gwP); M5_Q(b, 3, 3, 10, gwQ, gwP);
    }
    asm volatile("s_waitcnt vmcnt(0)" ::: "memory");
#pragma unroll
    for (int k = 0; k < 4; ++k) { const int rt = (bid + k * G) >> 3;
#pragma unroll
        for (int mt = 0; mt < 4; ++mt) st4bf2(MB + (size_t)(rt * 128 + wr * 64 + mt * 16 + fr) * 1024 + ct * 128 + wc * 32 + (fq & 1) * 16 + (fq >> 1) * 8, macc[k][mt][0] * (1.f / 255.f), macc[k][mt][1] * (1.f / 255.f)); }
    __syncthreads();
#undef M5_Q
#undef M5_WAIT
#undef M5_GLOAD
#undef M5_STAGE_B
#undef M5_STAGE_A
}
__device__ __forceinline__ void merge_phase(PH_ARGS, const int nunits) {
    int nmine = 0; for (int u = bid; u < nunits; u += G) ++nmine;
    if ((G & 7) == 0 && nmine >= 4) { merge_four(PH_CALL_IN); if (nmine > 4) merge_tail(PH_CALL_IN, 4, nmine - 4); }
    else merge_tail(PH_CALL_IN, 0, nmine);
}
constexpr int AT_RPB = 32768, AT_MRG = 40960;
__device__ __forceinline__ int clampi(int v, int lo, int hi) { return v < lo ? lo : (v > hi ? hi : v); }
__device__ __forceinline__ bool at_need(int kind, int jb, int t) { return kind == 2 || (kind == 0 ? (jb < 2 || (jb == 2 && t == 1)) : (jb > 1 || (jb == 1 && t == 0))); }
struct AtCtx { const bf16* QPL; const bf16* KR; const bf16* VV; LAS unsigned char* vbuf; const LAS float* rpbl; int h, qh, fr, fq, lane, b, r, kr0, qrow0, nch, nwin; bool lat; unsigned code[2][2][2]; float negb; };
__device__ __forceinline__ unsigned at_keyrow(const AtCtx& X, int ci) { return (ci < X.nwin) ? ((unsigned)X.b * SEQ + (unsigned)(X.kr0 + (ci >> 1)) * 64 + 32 * (ci & 1)) : ((unsigned)ML + X.b * CTXL + 32 * (ci - X.nwin)); }
__device__ __forceinline__ void at_load(const AtCtx& X, int ci, bf16x8 (&kf)[2][2], v4u (&vst)[4]) {
    const unsigned kr = at_keyrow(X, ci);
#pragma unroll
    for (int t = 0; t < 2; ++t)
#pragma unroll
        for (int ks = 0; ks < 2; ++ks) kf[t][ks] = *(const bf16x8*)(X.KR + (unsigned)((kr + 16 * t + X.fr) * 256 + X.h * 64 + ks * 32 + X.fq * 8));
#pragma unroll
    for (int i = 0; i < 4; ++i) { const int p = i * 64 + X.lane, key = p >> 3, seg = p & 7; vst[i] = *(const v4u*)(X.VV + (unsigned)((kr + key) * 256 + X.h * 64 + seg * 8)); }
}
__device__ __forceinline__ void at_chunk(const AtCtx& X, const int ci, bf16x8 (&kf)[2][2], v4u (&vst)[4], bf16x8 (&qf)[2][2], f32x4 (&O)[2][4], float (&m)[2], float (&l)[2]) {
    const int kind = ci < X.nwin ? (ci & 1) : 2, fr = X.fr, fq = X.fq, qh = X.qh;
    if (X.lat && ci == 16) {
#pragma unroll
        for (int j = 0; j < 2; ++j)
#pragma unroll
            for (int ks = 0; ks < 2; ++ks) qf[j][ks] = *(const bf16x8*)(X.QPL + (unsigned)((X.qrow0 + 16 * (2 * qh + j) + fr) * 256 + X.h * 64 + ks * 32 + fq * 8));
        asm volatile("" : "+v"(qf[0][0]), "+v"(qf[0][1]), "+v"(qf[1][0]), "+v"(qf[1][1])); }
#pragma unroll
    for (int i = 0; i < 4; ++i) { const int p = i * 64 + X.lane, key = p >> 3, seg = p & 7; *(LAS v4u*)(X.vbuf + key * 128 + ((((seg >> 1) ^ ((key >> 1) & 3))) << 5) + ((seg & 1) << 4)) = vst[i]; }
    f32x4 S[2][2];
#pragma unroll
    for (int j = 0; j < 2; ++j)
#pragma unroll
        for (int t = 0; t < 2; ++t) S[j][t] = (f32x4){0.f, 0.f, 0.f, 0.f};
    asm volatile("s_nop 1" : "+v"(S[0][0]), "+v"(S[0][1]), "+v"(S[1][0]), "+v"(S[1][1]));
#pragma unroll
    for (int j = 0; j < 2; ++j)
#pragma unroll
        for (int t = 0; t < 2; ++t) { mfma16n(S[j][t], kf[t][0], qf[j][0]); mfma16n(S[j][t], kf[t][1], qf[j][1]); }
    const LAS float* rpbrow = X.rpbl + (kind != 2 ? (X.kr0 + (ci >> 1) - X.r + 7) : 15) * 32;
    float bv[2][2][4];
#pragma unroll
    for (int j = 0; j < 2; ++j)
#pragma unroll
        for (int t = 0; t < 2; ++t) { const unsigned cw = kind == 2 ? 0u : (kind == 0 ? X.code[0][j][t] : X.code[1][j][t]);
#pragma unroll
            for (int rg = 0; rg < 4; ++rg) bv[j][t][rg] = rpbrow[(cw >> (8 * rg)) & 31u]; }
    asm volatile("s_nop 11" : "+v"(S[0][0]), "+v"(S[0][1]), "+v"(S[1][0]), "+v"(S[1][1]));
    if (ci + 3 < X.nch) at_load(X, ci + 3, kf, vst);
    bf16x8 pf[2];
#pragma unroll
    for (int j = 0; j < 2; ++j) {
        float mc = X.negb;
#pragma unroll
        for (int t = 0; t < 2; ++t)
#pragma unroll
            for (int rg = 0; rg < 4; ++rg) { const float s = S[j][t][rg] + bv[j][t][rg]; S[j][t][rg] = s; mc = fmaxf(mc, s); }
        { auto r16 = __builtin_amdgcn_permlane16_swap(__float_as_uint(mc), __float_as_uint(mc), false, false); mc = fmaxf(__uint_as_float(r16[0]), __uint_as_float(r16[1]));
          auto r32 = __builtin_amdgcn_permlane32_swap(__float_as_uint(mc), __float_as_uint(mc), false, false); mc = fmaxf(__uint_as_float(r32[0]), __uint_as_float(r32[1])); }
        const float mnew = fmaxf(m[j], mc), alpha = __builtin_amdgcn_exp2f(m[j] - mnew); m[j] = mnew; float ls = 0.f;
#pragma unroll
        for (int t = 0; t < 2; ++t)
#pragma unroll
            for (int rg = 0; rg < 4; ++rg) { const float p = __builtin_amdgcn_exp2f(S[j][t][rg] - mnew); S[j][t][rg] = p; ls += p; }
        l[j] = l[j] * alpha + ls;
        if (__any(alpha != 1.f)) {
#pragma unroll
            for (int dt = 0; dt < 4; ++dt) O[j][dt] = O[j][dt] * alpha; }
        v4u pw; pw.x = pk2(S[j][0][0], S[j][0][1]); pw.y = pk2(S[j][0][2], S[j][0][3]); pw.z = pk2(S[j][1][0], S[j][1][1]); pw.w = pk2(S[j][1][2], S[j][1][3]);
        pf[j] = __builtin_bit_cast(bf16x8, pw); }
    asm volatile("s_nop 1" : "+v"(pf[0]), "+v"(pf[1]));
#pragma unroll
    for (int dt = 0; dt < 4; ++dt) { v4i16_t t0, t1;
        { const int key = 4 * fq + (fr >> 2); t0 = __builtin_amdgcn_ds_read_tr16_b64_v4i16((LAS v4i16_t*)(X.vbuf + key * 128 + ((dt ^ ((key >> 1) & 3)) << 5) + (fr & 3) * 8)); }
        { const int key = 16 + 4 * fq + (fr >> 2); t1 = __builtin_amdgcn_ds_read_tr16_b64_v4i16((LAS v4i16_t*)(X.vbuf + key * 128 + ((dt ^ ((key >> 1) & 3)) << 5) + (fr & 3) * 8)); }
        const bf16x8 vf = (bf16x8){t0[0], t0[1], t0[2], t0[3], t1[0], t1[1], t1[2], t1[3]};
        mfma16n(O[0][dt], vf, pf[0]); mfma16n(O[1][dt], vf, pf[1]); }
}
__device__ __forceinline__ void attn_unit(PH_ARGS, const int unit) {
    AtCtx X; X.h = wave >> 1; X.qh = wave & 1; X.fr = lane & 15; X.fq = lane >> 4; X.lane = lane;
    X.lat = unit < 256; X.r = 0; X.kr0 = 0;
    if (X.lat) { X.b = unit >> 7; X.r = unit & 127; X.qrow0 = X.b * SEQ + X.r * 64; X.kr0 = clampi(X.r - 4, 0, 120); }
    else { const int u2 = unit - 256; X.b = u2 >> 2; X.qrow0 = ML + X.b * CTXL + (u2 & 3) * 64; }
    X.QPL = WSP(bf16, WS_QPL); const bf16* QROT = WSP(bf16, WS_QROT); X.KR = WSP(bf16, WS_KR); X.VV = WSP(bf16, WS_VV);
    bf16* BRd = WSP(bf16, WS_BR) + (size_t)3 * MT * 256;
    X.vbuf = lds + wave * 4096; X.rpbl = (const LAS float*)(lds + AT_RPB) + X.h * 512;
    X.nch = X.lat ? 24 : 8; X.nwin = X.lat ? 16 : 0;
#pragma unroll
    for (int kd = 0; kd < 2; ++kd)
#pragma unroll
        for (int j = 0; j < 2; ++j)
#pragma unroll
            for (int t = 0; t < 2; ++t) { unsigned cw = 0u; const int jb = 2 * X.qh + j;
#pragma unroll
                for (int rg = 0; rg < 4; ++rg) { const int kcol = 32 * kd + 16 * t + 4 * X.fq + rg, qcol = 16 * jb + X.fr, cst = clampi(qcol - 8, 0, 48); const bool ok = at_need(kd, jb, t) && kcol >= cst && kcol < cst + 16;
                    cw |= (ok ? (unsigned)(clampi(kcol - qcol, -15, 15) + 15) : 31u) << (8 * rg); }
                X.code[kd][j][t] = cw; }
    float m[2], l[2]; f32x4 O[2][4];
    { unsigned u_ = 0xf149f2cau; asm volatile("" : "+s"(u_)); X.negb = __uint_as_float(u_); }
#pragma unroll
    for (int j = 0; j < 2; ++j) { m[j] = X.negb; l[j] = 0.f;
#pragma unroll
        for (int dt = 0; dt < 4; ++dt) O[j][dt] = (f32x4){0.f, 0.f, 0.f, 0.f}; }
    bf16x8 qf[2][2];
    { const bf16* Qs = X.lat ? QROT : X.QPL;
#pragma unroll
      for (int j = 0; j < 2; ++j)
#pragma unroll
          for (int ks = 0; ks < 2; ++ks) qf[j][ks] = *(const bf16x8*)(Qs + (unsigned)((X.qrow0 + 16 * (2 * X.qh + j) + X.fr) * 256 + X.h * 64 + ks * 32 + X.fq * 8));
      asm volatile("" : "+v"(qf[0][0]), "+v"(qf[0][1]), "+v"(qf[1][0]), "+v"(qf[1][1])); }
    bf16x8 kA[2][2], kB[2][2], kC[2][2]; v4u vA[4], vB[4], vC[4];
    at_load(X, 0, kA, vA); at_load(X, 1, kB, vB); at_load(X, 2, kC, vC);
#pragma unroll 1
    for (int ci = 0; ci < X.nch; ci += 3) {
        at_chunk(X, ci, kA, vA, qf, O, m, l);
        if (ci + 1 < X.nch) at_chunk(X, ci + 1, kB, vB, qf, O, m, l);
        if (ci + 2 < X.nch) at_chunk(X, ci + 2, kC, vC, qf, O, m, l);
    }
    asm volatile("s_nop 15" : "+v"(O[0][0]), "+v"(O[0][1]), "+v"(O[0][2]), "+v"(O[0][3]), "+v"(O[1][0]), "+v"(O[1][1]), "+v"(O[1][2]), "+v"(O[1][3]));
#pragma unroll
    for (int j = 0; j < 2; ++j) { { float a_ = l[j], b_ = l[j]; swp16(a_, b_); l[j] = a_ + b_; } { float a_ = l[j], b_ = l[j]; swp32(a_, b_); l[j] = a_ + b_; } const float inv = 1.f / l[j];
#pragma unroll
        for (int dp = 0; dp < 2; ++dp) st4bf2(BRd + (unsigned)((X.qrow0 + 16 * (2 * X.qh + j) + X.fr) * 256 + X.h * 64 + dp * 32 + (X.fq & 1) * 16 + (X.fq >> 1) * 8), O[j][2 * dp] * inv, O[j][2 * dp + 1] * inv); }
}
#ifndef CDFT_REP
#define CDFT_REP 1
#endif
#ifndef CONV_REP
#define CONV_REP 1
#endif
#ifndef GMLP_REP
#define GMLP_REP 1
#endif
#ifndef F1_REP
#define F1_REP 1
#endif
__device__ __forceinline__ int wave_incl_scan(int v) {
    v += __builtin_amdgcn_update_dpp(0, v, 0x111, 0xF, 0xF, false); v += __builtin_amdgcn_update_dpp(0, v, 0x112, 0xF, 0xF, false);
    v += __builtin_amdgcn_update_dpp(0, v, 0x114, 0xF, 0xF, false); v += __builtin_amdgcn_update_dpp(0, v, 0x118, 0xF, 0xF, false);
    v += __builtin_amdgcn_update_dpp(0, v, 0x142, 0xA, 0xF, false); v += __builtin_amdgcn_update_dpp(0, v, 0x143, 0xC, 0xF, false);
    return v;
}
__device__ __forceinline__ int block_excl_scan(int v, LAS int* ws8, int lane, int wave) {
    const int x = wave_incl_scan(v);
    if (lane == 63) ws8[wave] = x;
    __syncthreads();
    int base = 0;
#pragma unroll
    for (int w = 0; w < 8; ++w) base += (w < wave) ? ws8[w] : 0;
    __syncthreads();
    return base + x - v;
}
__device__ __forceinline__ unsigned akey(float a) { const float s = a * 4294967296.f; return s >= 4294967040.f ? 0xFFFFFF00u : (unsigned)s; }
__device__ __forceinline__ float akey_inv(unsigned k) { return (float)k * (1.f / 4294967296.f); }
template <int PER, bool ALLV>
__device__ __forceinline__ void topk_unit(PH_ARGS, const int rowbase, const int n, const int C, const int e, const int sbase, const bool writepad) {
    const float* AFF = WSP(float, WS_AFF); int* SEL = WSP(int, WS_SEL); int* IDX = WSP(int, WS_IDX); float* GATE = WSP(float, WS_GATE);
    LAS unsigned* hist = (LAS unsigned*)lds; LAS unsigned* sh = hist + 256; LAS int* ws8 = (LAS int*)(hist + 272); LAS unsigned* hw = hist + 512 + wave * 256;
    unsigned key[PER]; bool valid[PER];
    if constexpr (PER == 16 && ALLV) { const f32x4* ap = (const f32x4*)(AFF + (size_t)e * MT + rowbase + tid * 16);
#pragma unroll
        for (int j = 0; j < 4; ++j) { const f32x4 q = ap[j];
#pragma unroll
            for (int k = 0; k < 4; ++k) { valid[4 * j + k] = true; key[4 * j + k] = akey(q[k]); } } }
    else {
#pragma unroll
    for (int i = 0; i < PER; ++i) { const int tok = tid * PER + i; valid[i] = ALLV ? true : (tok < n); key[i] = valid[i] ? akey(AFF[(size_t)e * MT + rowbase + tok]) : 0u; } }
    unsigned prefix = 0u, mask = 0u, rem = (unsigned)C;
#pragma unroll 1
    for (int pass = 0; pass < 4; ++pass) { const int shift = 24 - 8 * pass;
        for (int i = lane; i < 256; i += 64) hw[i] = 0u;
        LDS_WAIT();
#pragma unroll
        for (int i = 0; i < PER; ++i) if (valid[i] && (key[i] & mask) == prefix) atomicAdd((unsigned*)&hw[(key[i] >> shift) & 255u], 1u);
        __syncthreads();
        if (tid < 256) { unsigned s_ = 0u;
#pragma unroll
            for (int w = 0; w < 8; ++w) s_ += hist[512 + w * 256 + tid];
            hist[tid] = s_; }
        __syncthreads();
        if (wave == 0) { unsigned c0 = hist[255 - 4 * lane], c1 = hist[254 - 4 * lane], c2 = hist[253 - 4 * lane], c3 = hist[252 - 4 * lane];
            const unsigned s = c0 + c1 + c2 + c3; const unsigned x = (unsigned)wave_incl_scan((int)s);
            const unsigned excl = x - s;
            if (excl < rem && rem <= x) { unsigned cum = excl; int bin; unsigned nr;
                if (cum + c0 >= rem) { bin = 255 - 4 * lane; nr = rem - cum; }
                else { cum += c0; if (cum + c1 >= rem) { bin = 254 - 4 * lane; nr = rem - cum; }
                else { cum += c1; if (cum + c2 >= rem) { bin = 253 - 4 * lane; nr = rem - cum; }
                else { cum += c2; bin = 252 - 4 * lane; nr = rem - cum; } } }
                sh[0] = (unsigned)bin; sh[1] = nr; } }
        __syncthreads();
        prefix |= sh[0] << shift; mask |= 255u << shift; rem = sh[1];
    }
    __syncthreads();
    const unsigned T = prefix;
    int neq = 0;
#pragma unroll
    for (int i = 0; i < PER; ++i) neq += (valid[i] && key[i] == T) ? 1 : 0;
    const int eqbase = block_excl_scan(neq, ws8, lane, wave);
    unsigned take = 0u; int nsel = 0, eqs = 0;
#pragma unroll
    for (int i = 0; i < PER; ++i) { const bool iseq = valid[i] && key[i] == T; const bool tk = valid[i] && (key[i] > T || (iseq && (unsigned)(eqbase + eqs) < rem)); eqs += iseq ? 1 : 0; if (tk) { take |= 1u << i; ++nsel; } }
    const int sb = block_excl_scan(nsel, ws8, lane, wave);
    int cnt = 0;
#pragma unroll
    for (int i = 0; i < PER; ++i) { const int tok = tid * PER + i;
        if (valid[i]) { if ((take >> i) & 1u) { const int slot = sbase + sb + cnt; ++cnt; IDX[e * ESTR + slot] = rowbase + tok; GATE[e * ESTR + slot] = akey_inv(key[i]); SEL[(size_t)(rowbase + tok) * 16 + e] = slot; } } }
    if (writepad) for (int i = tid; i < ESTR - 2112; i += 512) { IDX[e * ESTR + 2112 + i] = 0; GATE[e * ESTR + 2112 + i] = 0.f; }
    __syncthreads();
}
#ifndef GU1_A
#define GU0_A 3400
#define DN0_P 1792
#define DN0_A 1792
#define GU1_E 0
#define GU1_F 4096
#define GU1_G 7496
#define DN1_T 1792
#define DN1_M 2816
#define GU1_A 3840
#define GU1_B 5568
#endif
__device__ __forceinline__ void gather_rows(PH_ARGS, const int tpe) {
    const int gw = bid * 8 + wave, NGW = G * 8, per = tpe * 256; const int* IDX = WSP(int, WS_IDX); const bf16* H = WSP(bf16, WS_H); bf16* XE = WSP(bf16, WS_XE);
    for (int i = gw; i < NE * per; i += NGW) { const int e = i / per, s = i % per, rg = e * ESTR + s; const int src = IDX[rg];
        const v4u a = *(const v4u*)(H + (size_t)src * 1024 + lane * 8), b = *(const v4u*)(H + (size_t)src * 1024 + 512 + lane * 8);
        *(v4u*)(XE + (size_t)rg * 1024 + lane * 8) = a; *(v4u*)(XE + (size_t)rg * 1024 + 512 + lane * 8) = b; }
}
struct CRow { v4u yw[4][2]; v4u xin[2]; float wgt[4]; unsigned long long bm; int cur; };
struct CCtx { const int* SEL; const bf16* YB; const float* GATE; const bf16* X; bf16* H; const float* MOD; bf16* XO; float* OUT; const float* gnext; int l, lane; };
__device__ __forceinline__ void cr_issue(const CCtx& C, CRow& R, const int row) {
    const int lane = C.lane;
    R.cur = lane < 16 ? C.SEL[(size_t)row * 16 + lane] : -1;
    R.bm = __ballot(R.cur >= 0); const int cnt = __popcll(R.bm);
#pragma unroll
    for (int k = 0; k < 4; ++k) { const bool has = cnt > k; const int e = has ? (int)__builtin_ctzll(R.bm) : 0; if (has) R.bm &= R.bm - 1; const int s = __builtin_amdgcn_readlane(R.cur, e);     R.wgt[k] = has ? C.GATE[e * ESTR + s] : 0.f;
        const bf16* y = C.YB + (size_t)(has ? e * ESTR + s : 0) * 1024 + lane * 8; R.yw[k][0] = *(const v4u*)y; R.yw[k][1] = *(const v4u*)(y + 512); }
    const bf16* xr = C.X + (size_t)row * 1024;
#pragma unroll
    for (int j = 0; j < 2; ++j) R.xin[j] = *(const v4u*)(xr + 8 * lane + 512 * j);
}
__device__ __forceinline__ void cr_consts(const CCtx& C, const int r, f32x4 (&kg)[4], f32x4 (&ka)[4], f32x4 (&kb)[4]) {
    const float* gt2 = C.MOD + (C.l * 3 + r) * 6144 + 5 * 1024; const float* md = C.MOD + (1 * 3 + r) * 6144;
#pragma unroll
    for (int q = 0; q < 4; ++q) { const int o = 8 * C.lane + 512 * (q >> 1) + 4 * (q & 1); kg[q] = *(const f32x4*)(gt2 + o); const f32x4 gn = *(const f32x4*)(C.gnext + o);
        if (C.l == 0) { ka[q] = gn * (*(const f32x4*)(md + 1024 + o) + 1.f); kb[q] = *(const f32x4*)(md + o); } else { ka[q] = gn; kb[q] = (f32x4){0.f, 0.f, 0.f, 0.f}; } }
}
__device__ __forceinline__ void cr_finish(const CCtx& C, CRow& R, const int row, const f32x4 (&kg)[4], const f32x4 (&ka)[4], const f32x4 (&kb)[4]) {
    const int lane = C.lane, l = C.l; const int r = row < SEQ ? 0 : (row < ML ? 1 : 2);
    float acc[2][8];
#pragma unroll
    for (int j = 0; j < 2; ++j)
#pragma unroll
        for (int i = 0; i < 8; ++i) acc[j][i] = 0.f;
#pragma unroll
    for (int k = 0; k < 4; ++k)
#pragma unroll
        for (int j = 0; j < 2; ++j) { const v4u w = R.yw[k][j]; const float g = R.wgt[k];
            acc[j][0] += g * bflo(w.x); acc[j][1] += g * bfhi(w.x); acc[j][2] += g * bflo(w.y); acc[j][3] += g * bfhi(w.y); acc[j][4] += g * bflo(w.z); acc[j][5] += g * bfhi(w.z); acc[j][6] += g * bflo(w.w); acc[j][7] += g * bfhi(w.w); }
    while (R.bm) { const int e = (int)__builtin_ctzll(R.bm); R.bm &= R.bm - 1; const int s = __builtin_amdgcn_readlane(R.cur, e);     const bf16* y = C.YB + (size_t)(e * ESTR + s) * 1024 + lane * 8; const float g = C.GATE[e * ESTR + s];
#pragma unroll
        for (int j = 0; j < 2; ++j) { const v4u w = *(const v4u*)(y + 512 * j);
            acc[j][0] += g * bflo(w.x); acc[j][1] += g * bfhi(w.x); acc[j][2] += g * bflo(w.y); acc[j][3] += g * bfhi(w.y); acc[j][4] += g * bflo(w.z); acc[j][5] += g * bfhi(w.z); acc[j][6] += g * bflo(w.w); acc[j][7] += g * bfhi(w.w); } }
    float xv[2][8]; float ss = 0.f;
#pragma unroll
    for (int j = 0; j < 2; ++j) { const f32x4 g0 = kg[2 * j], g1 = kg[2 * j + 1];
        const v4u xw_ = R.xin[j]; const f32x4 xa = {bflo(xw_.x), bfhi(xw_.x), bflo(xw_.y), bfhi(xw_.y)}, xb = {bflo(xw_.z), bfhi(xw_.z), bflo(xw_.w), bfhi(xw_.w)};
#pragma unroll
        for (int i = 0; i < 4; ++i) { xv[j][i] = xa[i] + g0[i] * acc[j][i]; xv[j][4 + i] = xb[i] + g1[i] * acc[j][4 + i]; }
#pragma unroll
        for (int i = 0; i < 8; ++i) ss += xv[j][i] * xv[j][i]; }
    const float rs = 1.0f / sqrtf(wave_sum(ss) * (1.f / 1024.f) + 1e-6f);
    if (l == 0) {
        bf16* xw = C.XO + (size_t)row * 1024;
#pragma unroll
        for (int j = 0; j < 2; ++j) { const int o = 8 * lane + 512 * j;
            { v4u xo; xo.x = pk2(xv[j][0], xv[j][1]); xo.y = pk2(xv[j][2], xv[j][3]); xo.z = pk2(xv[j][4], xv[j][5]); xo.w = pk2(xv[j][6], xv[j][7]); *(v4u*)(xw + o) = xo; }
            const f32x4 g0 = ka[2 * j], g1 = ka[2 * j + 1], h0 = kb[2 * j], h1 = kb[2 * j + 1];
            float hv[8];
#pragma unroll
            for (int i = 0; i < 4; ++i) { hv[i] = xv[j][i] * rs * g0[i] + h0[i]; hv[4 + i] = xv[j][4 + i] * rs * g1[i] + h1[i]; }
            v4u w; w.x = pk2(hv[0], hv[1]); w.y = pk2(hv[2], hv[3]); w.z = pk2(hv[4], hv[5]); w.w = pk2(hv[6], hv[7]);
            *(v4u*)(C.H + (size_t)row * 1024 + o) = w; }
    } else {
        float* orow = C.OUT + (size_t)row * 1024;
#pragma unroll
        for (int j = 0; j < 2; ++j) { const int o = 8 * lane + 512 * j; const f32x4 g0 = ka[2 * j], g1 = ka[2 * j + 1];
            *(f32x4*)(orow + o) = (f32x4){xv[j][0] * rs * g0[0], xv[j][1] * rs * g0[1], xv[j][2] * rs * g0[2], xv[j][3] * rs * g0[3]};
            *(f32x4*)(orow + o + 4) = (f32x4){xv[j][4] * rs * g1[0], xv[j][5] * rs * g1[1], xv[j][6] * rs * g1[2], xv[j][7] * rs * g1[3]}; }
    }
}
template <bool DUMMY>
__device__ __forceinline__ void combine_rows(PH_ARGS, const int l) {
    const int gw = bid * 8 + wave, NGW = G * 8; const int nrows = l == 0 ? MT : ML;
    CCtx C; C.SEL = WSP(int, WS_SEL); C.YB = WSP(bf16, WS_XE); C.GATE = WSP(float, WS_GATE); C.X = WSP(bf16, WS_X); C.H = DUMMY ? WSP(bf16, WS_BR) : WSP(bf16, WS_H); C.MOD = WSP(float, WS_MOD);
    C.XO = DUMMY ? WSP(bf16, WS_ACT) : WSP(bf16, WS_X); C.OUT = DUMMY ? WSP(float, WS_ACT) : PTRV(28, float); C.gnext = l == 0 ? INP(6) + 1024 : INP(27); C.l = l; C.lane = lane;
    CRow A, B; int row = gw; f32x4 kg[4], ka[4], kb[4]; int rprev = -1;
#define CR_R(rw) ((rw) < SEQ ? 0 : ((rw) < ML ? 1 : 2))
    if (row < nrows) cr_issue(C, A, row);
    while (row < nrows) {
        const int r2 = row + NGW; if (r2 < nrows) cr_issue(C, B, r2);
        { const int r = CR_R(row); if (r != rprev) { cr_consts(C, r, kg, ka, kb); rprev = r; } }
        cr_finish(C, A, row, kg, ka, kb);
        const int r3 = r2 + NGW; if (r3 < nrows) cr_issue(C, A, r3);
        if (r2 < nrows) { const int r = CR_R(r2); if (r != rprev) { cr_consts(C, r, kg, ka, kb); rprev = r; } cr_finish(C, B, r2, kg, ka, kb); }
        row = r3;
    }
#undef CR_R
}

#ifdef DBG_STOP
__device__ __forceinline__ void debug_out(PH_ARGS) {
    float* out = PTRV(28, float);
    const int gt = bid * 512 + tid, GT = G * 512;
    for (size_t i = gt; i < (size_t)ML * 1024; i += GT) { const size_t row = i >> 10; const int c = (int)(i & 1023); float v = 0.f;
#if DBG_STOP == 2
        v = bflo(WSP(bf16, WS_H)[row * 1024 + c]) + WSP(float, WS_MOD)[(i % 36864)] + bflo(WSP(bf16, WS_WIN)[i % (6400 * 1024)]) + bflo(WSP(bf16, WS_WGU)[i]) + bflo(WSP(bf16, WS_WDN)[i]) + bflo(WSP(bf16, WS_WO)[i % (1024*1024)]) + bflo(WSP(bf16, WS_WBR)[i % (1024*1024)]);
#elif DBG_STOP == 3
        v = bflo(WSP(bf16, WS_AUV)[row * 512 + (c & 511)]) + bflo(WSP(bf16, WS_YF)[row * 512 + (c & 511)]) + bflo(WSP(bf16, WS_CY)[row * 256 + (c & 255)]) + bflo(WSP(bf16, WS_QPL)[row * 256 + (c & 255)])
          + bflo(WSP(bf16, WS_QROT)[row * 256 + (c & 255)]) + bflo(WSP(bf16, WS_KR)[row * 256 + (c & 255)]) + bflo(WSP(bf16, WS_VV)[row * 256 + (c & 255)])
          + bflo(WSP(bf16, WS_G)[row * 4096 + c]) + bflo(WSP(bf16, WS_G)[row * 4096 + 1024 + c]) + bflo(WSP(bf16, WS_G)[row * 4096 + 2048 + c]) + bflo(WSP(bf16, WS_G)[row * 4096 + 3072 + c]);
#elif DBG_STOP == 4
        v = bflo(WSP(bf16, WS_BR)[(size_t)(0 * MT + row) * 256 + (c & 255)]) + bflo(WSP(bf16, WS_BR)[(size_t)(2 * MT + row) * 256 + (c & 255)]) + bflo(WSP(bf16, WS_FA)[i % ((size_t)8 << 20)]);
#elif DBG_STOP == 21
        v = bflo(WSP(bf16, WS_T1T)[i % 16384]) * 1.001f + WSP(float, WS_ROPEC)[i % 2048] + WSP(float, WS_ROPES)[i % 2048] + bflo(WSP(bf16, WS_WSP)[i % 65536]);
#elif DBG_STOP == 31 || DBG_STOP == 44
        v = 0.f;
#elif DBG_STOP == 45 || DBG_STOP == 32
        v = 0.f;
#elif DBG_STOP == 41
        v = bflo(WSP(bf16, WS_BR)[(size_t)(0 * MT + row) * 256 + (c & 255)]) * 1.001f + bflo(WSP(bf16, WS_BR)[(size_t)(0 * MT + row) * 256 + ((c + 7) & 255)]);
#elif DBG_STOP == 42
        v = bflo(WSP(bf16, WS_BR)[(size_t)(2 * MT + row) * 256 + (c & 255)]) * 1.001f + bflo(WSP(bf16, WS_BR)[(size_t)(2 * MT + row) * 256 + ((c + 7) & 255)]);
#elif DBG_STOP == 43
        v = bflo(WSP(bf16, WS_FA)[i % ((size_t)8 << 20)]) * 1.001f + bflo(WSP(bf16, WS_FA)[(i + 7) % ((size_t)8 << 20)]);
#elif DBG_STOP == 5
        v = bflo(WSP(bf16, WS_BR)[(size_t)(1 * MT + row) * 256 + (c & 255)]) + bflo(WSP(bf16, WS_BR)[(size_t)(3 * MT + row) * 256 + (c & 255)]);
#elif DBG_STOP == 6
        v = bflo(WSP(bf16, WS_MB)[row * 1024 + c]);
#elif DBG_STOP == 7
        v = WSP(float, WS_X)[row * 1024 + c];
#elif DBG_STOP == 8
        v = bflo(WSP(bf16, WS_H)[row * 1024 + c]) + WSP(float, WS_AFF)[row * 16 + (c & 15)];
#elif DBG_STOP == 9
        v = (float)WSP(int, WS_SEL)[row * 16 + (c & 15)] + WSP(float, WS_GATE)[i % (16 * 2304)] + (float)WSP(int, WS_IDX)[i % (16 * 2304)];
#elif DBG_STOP == 10
        v = bflo(WSP(bf16, WS_XE)[i]) + bflo(WSP(bf16, WS_XE)[i + (size_t)ML * 1024]);
#elif DBG_STOP == 11
        v = bflo(WSP(bf16, WS_ACT)[i]) + bflo(WSP(bf16, WS_ACT)[i + (size_t)ML * 1024]);
#elif DBG_STOP == 12
        v = bflo(WSP(bf16, WS_XE)[i]) + bflo(WSP(bf16, WS_XE)[i + (size_t)ML * 1024]);
#else
        v = WSP(float, WS_X)[row * 1024 + c] + bflo(WSP(bf16, WS_H)[row * 1024 + c]);
#endif
#ifdef DBG_AMP
        v = (float)(__float_as_uint(v) & 0xFFFFu);
#endif
        out[i] = v; }
}
#endif
__global__ void __launch_bounds__(512, 2) mega(Args A) {
    extern __shared__ __attribute__((aligned(16))) unsigned char lds_raw[];
    LAS unsigned char* lds0 = (LAS unsigned char*)lds_raw;
    volatile LAS unsigned* MISC = (volatile LAS unsigned*)(lds0 + MISC_OFF);
    const int tid = threadIdx.x, lane = tid & 63, wave = __builtin_amdgcn_readfirstlane(tid >> 6), bid = blockIdx.x, G = gridDim.x;
    for (int u = tid; u < (LDS_BYTES - MISC_OFF) / 4; u += 512) ((LAS unsigned*)(lds0 + MISC_OFF))[u] = 0u;
    __syncthreads();
    if (tid == 0) { typedef unsigned u2v_t __attribute__((ext_vector_type(2)));
#pragma unroll
        for (int i = 0; i < 30; ++i) { const unsigned long long p = i < 28 ? (unsigned long long)A.in[i] : (i == 28 ? (unsigned long long)A.out : (unsigned long long)A.ws);
            *(LAS u2v_t*)(lds0 + PTAB_OFF + 8 * i) = (u2v_t){(unsigned)p, (unsigned)(p >> 32)}; } }
    __syncthreads();
    const int lo = A.ph_lo, hi = A.ph_hi;
    XcdBarrier bar; bar.bar = (unsigned*)(A.ws + WS_CTL) + CW_BAR; bar.x = 0; bar.st = nullptr;
    if (hi - lo > 1) bar = xcd_barrier_post((unsigned*)(A.ws + WS_CTL) + CW_BAR, MISC + 8);
#define PH_CALL lds, tl_, (tl_ & 63), wv_, bl_, G_
#define PH_CALLV lds, tl_, (tl_ & 63), wv_, vb_, G_
#ifdef TS_I
    if (bid == 0 && tid == 0) ((unsigned long long*)(A.ws + 65536))[lo] = rt();
#endif
    if (lo == 0) {
        int tl_ = tid; asm volatile("" : "+v"(tl_)); int bl_ = bid; asm volatile("" : "+s"(bl_)); int wv_ = wave; asm volatile("" : "+s"(wv_)); int G_ = G; asm volatile("" : "+s"(G_));
        unsigned ldsb_ = (unsigned)(uintptr_t)lds0; asm volatile("" : "+s"(ldsb_)); LAS unsigned char* lds = (LAS unsigned char*)(uintptr_t)ldsb_;
#ifndef P0R_MOD
#define P0R_MOD 1
#endif
#ifndef P0R_TAB
#define P0R_TAB 1
#endif
#ifndef P0R_CVT
#define P0R_CVT 1
#endif
#pragma unroll 1
            for (int r_ = 0; r_ < P0R_MOD; ++r_) { mod_gemv(PH_CALL); asm volatile("" ::: "memory"); }
#pragma unroll 1
            for (int r_ = 0; r_ < P0R_TAB; ++r_) { make_tables(PH_CALL); asm volatile("" ::: "memory"); }
#pragma unroll 1
            for (int r_ = 0; r_ < P0R_CVT; ++r_) { convert_range(lds, tl_, (tl_ & 63), wv_, bl_, G_, 0, CV_FOLD0, CV_GU0, bl_, G_); convert_range(lds, tl_, (tl_ & 63), wv_, bl_, G_, 0, CV_SP0, CV_END, bl_, G_); asm volatile("" ::: "memory"); }
        if (tl_ == 0) { unsigned* cnt1 = (unsigned*)(PTRV(29, unsigned char) + WS_CTL) + 2049; unsigned sp_ = 0;
            while (__hip_atomic_load(cnt1, __ATOMIC_RELAXED, __HIP_MEMORY_SCOPE_AGENT) < 32u && ++sp_ < (1u << 22)) __builtin_amdgcn_s_sleep(2);
            __builtin_amdgcn_fence(__ATOMIC_ACQUIRE, "agent"); asm volatile("s_waitcnt vmcnt(0)" ::: "memory"); }
        __syncthreads();
#ifndef DIS_N1
        norm1_l0(PH_CALL);
#endif
        if (hi > 1) { XcdBarrier b2 = bar; b2.bar = (unsigned*)(PTRV(29, unsigned char) + WS_CTL) + CW_BAR; b2.st = (volatile LAS unsigned*)(lds + MISC_OFF) + 8; xcd_barrier(b2); }
    }
    const int lo1 = lo < 2 ? 2 : lo;
#pragma unroll 1
#ifdef REP_PH
    for (int it_ = lo1; it_ < hi + (REP_N - 1); ++it_) { const int ph = it_ < REP_PH ? it_ : (it_ < REP_PH + REP_N ? REP_PH : it_ - (REP_N - 1));
#else
    for (int ph = lo1; ph < hi; ++ph) {
#endif
        int tl_ = tid; asm volatile("" : "+v"(tl_)); int bl_ = bid; asm volatile("" : "+s"(bl_)); int vb_ = (G % 8 == 0) ? (bid % 8) * (G / 8) + bid / 8 : bid; asm volatile("" : "+s"(vb_)); int wv_ = wave; asm volatile("" : "+s"(wv_)); int G_ = G; asm volatile("" : "+s"(G_)); unsigned ldsb_ = (unsigned)(uintptr_t)lds0; asm volatile("" : "+s"(ldsb_)); LAS unsigned char* lds = (LAS unsigned char*)(uintptr_t)ldsb_;
        const int l = ph < 13 ? 0 : 1, kind = ph >= 99 ? 99 : (ph < 2 ? ph : 2 + (ph - 2 - 11 * l));
        const int ntm = l == 0 ? 66 : 64, tpe = l == 0 ? 9 : 8;
        if (kind == 9) continue;
        int au_ = 1 << 30, alim_ = 0;
        switch (kind) {
#ifdef DBG_STOP
        case 99: debug_out(PH_CALL); break;
#endif
        case 0: break;
        case 1: break;
        case 2: {
            pg8::Gemm g{WSP(bf16, WS_H), WSP(bf16, WS_WIN), MT, NIN, 1024}; pg8::StaticOrder S; S.init(MT, NIN, G_, bl_);
            EpiIn E{WSP(bf16, WS_AUV), WSP(bf16, WS_YF), WSP(bf16, WS_CY), WSP(bf16, WS_QPL), WSP(bf16, WS_QROT), WSP(bf16, WS_KR), WSP(bf16, WS_VV), WSP(bf16, WS_G), WSP(float, WS_ROPEC), WSP(float, WS_ROPES)};
#ifndef DIS_GIN
            pg8::gemm_phase<EpiIn, pg8::StaticOrder, true, true>(lds, g, S, E);
#endif
#ifndef DIS_CVT
            { const int nx = ((MT / 256) * (NIN / 256)) % G_;
              if (l == 0) convert_range(lds, tl_, (tl_ & 63), wv_, bl_, G_, 0, CV_GU0, CV_GU0 + GU0_A, nx ? bl_ - nx : bl_, G_ - nx);
              else convert_range(lds, tl_, (tl_ & 63), wv_, bl_, G_, 1, CV_GU0 + GU1_F, CV_GU0 + GU1_G, nx ? bl_ - nx : bl_, G_ - nx); }
#endif
        } break;
        case 3: {
#ifndef DIS_F1
            if (bl_ < 256) { f1_stage_tables(PH_CALL); for (int u = vb_; u < 256; u += G_) f1_unit(PH_CALL, u); }
#endif
#ifndef DIS_CDFT
            if (l == 0) ctx_butterfly(PH_CALL);
#endif
            au_ = vb_; alim_ = (l == 0 && G_ < 128) ? 264 : 256;
        } break;
        case 4: {
#ifndef DIS_F2
            for (int u = vb_; u < 256; u += G_) f2_unit(PH_CALL, u);
#endif
#ifndef DIS_CONV
            for (int u = vb_; u < 256; u += G_) conv_unit(PH_CALL, l, u);
#endif
#ifndef DIS_GMLP
            for (int u = G_ - 1 - vb_; u < 128; u += G_) gmlp_unit(PH_CALL, l, u);
#endif
            if (l == 1 && G_ >= 256) convert_range(lds, tl_, (tl_ & 63), wv_, vb_, G_, 1, CV_DN0 + DN1_T, CV_DN0 + DN1_M, vb_ < G_ - 128 ? vb_ : -1, G_ - 128);
            if (l == 0) {
                const bool big = G_ >= 128;
                for (int u = big ? vb_ - 8 : vb_; u >= 0 && u < 8; u += G_) f2_unit(PH_CALL, 256 + u);
                for (int u = big ? vb_ - 16 : vb_; u >= 0 && u < 8; u += G_) conv_unit(PH_CALL, l, 256 + u);
                for (int u = big ? vb_ - 24 : vb_; u >= 0 && u < 4; u += G_) gmlp_unit(PH_CALL, l, 128 + u);
                if (big && vb_ >= 32 && vb_ < 40) { au_ = 256 + vb_ - 32; alim_ = 264; }
            }
        } break;
        case 5: {
#ifndef DIS_GMRG
#ifndef MERGE_PG8
            merge_phase(PH_CALLV, ntm * 16);
#ifndef DIS_CVT
            if (l == 0) { const int nx = (ntm * 16) % G_; convert_range(lds, tl_, (tl_ & 63), wv_, vb_, G_, 0, CV_GU0 + GU0_A, CV_DN0, nx ? vb_ - nx : vb_, G_ - nx); }
#endif
#else
            { pg8::Gemm g{WSP(bf16, WS_BR), WSP(bf16, WS_WBR), 4 * MT, 4096, 256}; MergeOrder S; S.init(ntm, G_, bl_); EpiMergeH E{WSP(bf16, WS_G), WSP(bf16, WS_MB)};
              pg8::gemm_phase<EpiMergeH, MergeOrder, true, true>(lds, g, S, E); }
#endif
#endif
        } break;
        case 6: {
            pg8::Gemm g{WSP(bf16, WS_MB), WSP(bf16, WS_WO), ML, 1024, 1024}; pg8::StaticOrder S; S.init(ML, 1024, G_, bl_);
            EpiWout E{INP(0), INP(2), WSP(bf16, WS_X), WSP(float, WS_MOD) + l * 3 * 6144, l};
#ifndef DIS_GWO
            pg8::gemm_phase<EpiWout, pg8::StaticOrder, true, true>(lds, g, S, E);
#endif
#ifndef DIS_CVT
            if (l == 0 && G_ <= 16) { const int nx = (64 * 4) % G_; convert_range(lds, tl_, (tl_ & 63), wv_, bl_, G_, 1, CV_FOLD0, CV_WO0, nx ? bl_ - nx : bl_, G_ - nx); }
#endif
        } break;
        case 7: {
#ifndef DIS_N2
            if (l == 0 && G_ > 16) {
                unsigned* cnt = (unsigned*)(PTRV(29, unsigned char) + WS_CTL) + 2048;
                if (bl_ < 8) {
                    pg8::Gemm g{WSP(bf16, WS_MB), WSP(bf16, WS_WO), MT, 1024, 1024}; OneUnit S{64 + (bl_ >> 2), bl_ & 3};
                    EpiWout E{INP(0), INP(2), WSP(bf16, WS_X), WSP(float, WS_MOD), 0};
                    pg8::gemm_phase<EpiWout, OneUnit, true, true>(lds, g, S, E);
                    asm volatile("s_waitcnt vmcnt(0)" ::: "memory"); __syncthreads();
                    if (tl_ == 0) { __builtin_amdgcn_fence(__ATOMIC_RELEASE, "agent"); asm volatile("s_waitcnt vmcnt(0)" ::: "memory"); __hip_atomic_fetch_add(cnt, 1u, __ATOMIC_RELAXED, __HIP_MEMORY_SCOPE_AGENT); }
                } else { norm2_router(PH_CALL, l, 0, ML, bl_ - 8, G_ - 8);
#ifndef DIS_CVT
                    convert_range(lds, tl_, (tl_ & 63), wv_, bl_, G_, 1, CV_FOLD0, CV_WO0, bl_ - 8, G_ - 8); convert_range(lds, tl_, (tl_ & 63), wv_, bl_, G_, 1, CV_GU0 + GU1_G, CV_DN0, bl_ - 8, G_ - 8);
#endif
                }
                if (tl_ == 0) { unsigned sp_ = 0; while (__hip_atomic_load(cnt, __ATOMIC_RELAXED, __HIP_MEMORY_SCOPE_AGENT) < 8u && ++sp_ < (1u << 22)) __builtin_amdgcn_s_sleep(2);
                    __builtin_amdgcn_fence(__ATOMIC_ACQUIRE, "agent"); asm volatile("s_waitcnt vmcnt(0)" ::: "memory"); }
                __syncthreads();
                norm2_router(PH_CALL, l, ML, MC, bl_, G_, true);
            } else norm2_router(PH_CALL, l, 0, ntm * 256, bl_, G_);
#endif
        } break;
        case 8: {
#ifndef DIS_TOPK
            const int nun = l == 0 ? 64 : 32;
            for (int u = bl_; u < nun; u += G_) {
                if (u < 32) { const int b = u >> 4, e = u & 15; topk_unit<16, true>(PH_CALL, b * SEQ, SEQ, CAPL, e, b * CAPL, l == 0 && b == 0); }
                else { const int b = (u - 32) >> 4, e = u & 15; topk_unit<1, false>(PH_CALL, ML + b * CTXL, CTXL, CAPC, e, 2048 + b * CAPC, false); }
                asm volatile("s_waitcnt vmcnt(0)" ::: "memory"); __syncthreads();
                if (tl_ == 0) { __builtin_amdgcn_fence(__ATOMIC_RELEASE, "agent"); asm volatile("s_waitcnt vmcnt(0)" ::: "memory");
                    __hip_atomic_fetch_add((unsigned*)(PTRV(29, unsigned char) + WS_CTL) + 2050 + l, 1u, __ATOMIC_RELAXED, __HIP_MEMORY_SCOPE_AGENT); }
            }
#endif
            if (l == 0 && G_ > nun) {
                convert_range(lds, tl_, (tl_ & 63), wv_, bl_, G_, 0, CV_DN0, CV_DN0 + DN0_P, bl_ - 32, G_ - 32);
                convert_range(lds, tl_, (tl_ & 63), wv_, bl_, G_, 0, CV_DN0 + DN0_P, CV_DN0 + DN0_A, bl_, G_); }
            else if (l == 0) convert_range(lds, tl_, (tl_ & 63), wv_, bl_, G_, 0, CV_DN0, CV_DN0 + DN0_A, bl_, G_);
            else if (G_ >= 256) convert_range(lds, tl_, (tl_ & 63), wv_, bl_, G_, 1, CV_DN0, CV_DN0 + DN1_T, bl_ - 32, G_ - 32);
        } break;
        case 9: {
#ifndef DIS_GATH
            gather_rows(PH_CALL, tpe);
#endif
        } break;
        case 10: {
#ifndef DIS_TOPK
            { if (tl_ == 0) { const unsigned need_ = l == 0 ? 64u : 32u; unsigned* cntT = (unsigned*)(PTRV(29, unsigned char) + WS_CTL) + 2050 + l; unsigned sp_ = 0;
                  while (__hip_atomic_load(cntT, __ATOMIC_RELAXED, __HIP_MEMORY_SCOPE_AGENT) < need_ && ++sp_ < (1u << 22)) __builtin_amdgcn_s_sleep(2);
                  __builtin_amdgcn_fence(__ATOMIC_ACQUIRE, "agent"); asm volatile("s_waitcnt vmcnt(0)" ::: "memory"); }
              __syncthreads(); }
#endif
            pg8::Gemm g{WSP(bf16, WS_H), WSP(bf16, (l == 0 ? WS_WGU : WS_WGU1)), NE * ESTR, NE * 2048, 1024, WSP(int, WS_IDX)}; GroupOrder S; S.init(tpe, 8, G_, bl_);
            EpiGU E{WSP(bf16, WS_ACT)};
#ifndef DIS_GGU
            pg8::gemm_phase<EpiGU, GroupOrder, true, true, true>(lds, g, S, E);
#endif
#ifndef DIS_CVT
            if (l == 0) { const int nx = (NE * tpe * 8) % G_; convert_range(lds, tl_, (tl_ & 63), wv_, bl_, G_, 1, CV_WO0, CV_GU0, nx ? bl_ - nx : bl_, G_ - nx);
                          convert_range(lds, tl_, (tl_ & 63), wv_, bl_, G_, 1, CV_SP0, CV_END, nx ? bl_ - nx : bl_, G_ - nx);
                          convert_range(lds, tl_, (tl_ & 63), wv_, bl_, G_, 0, CV_DN0 + DN0_A, CV_SP0, nx ? bl_ - nx : bl_, G_ - nx);
                          convert_range(lds, tl_, (tl_ & 63), wv_, bl_, G_, 1, CV_GU0, CV_GU0 + GU1_E, nx ? bl_ - nx : bl_, G_ - nx); }
#endif
        } break;
        case 11: {
            pg8::Gemm g{WSP(bf16, WS_ACT), WSP(bf16, WS_WDN), NE * ESTR, NE * 1024, 1024}; GroupOrder S; S.init(tpe, 4, G_, bl_);
            EpiDown E{WSP(bf16, WS_XE), WSP(float, WS_GATE)};
#ifndef DIS_GDN
            pg8::gemm_phase<EpiDown, GroupOrder, true, true>(lds, g, S, E);
#endif
#ifndef DIS_CVT
            if (l == 0) { const int nx = (NE * tpe * 4) % G_; convert_range(lds, tl_, (tl_ & 63), wv_, bl_, G_, 1, CV_GU0 + GU1_E, CV_GU0 + GU1_F, nx ? bl_ - nx : bl_, G_ - nx); }
#endif
        } break;
        default: {
#ifndef DIS_COMB
#ifdef COMB_REP
#pragma unroll 1
            for (int r_ = 0; r_ < COMB_REP; ++r_) combine_rows<true>(PH_CALL, l);
#endif
            combine_rows<false>(PH_CALL, l);
#endif
#ifndef DIS_CVT
            if (l == 0) { convert_range(lds, tl_, (tl_ & 63), wv_, bl_, G_, 1, CV_DN0 + (G_ >= 256 ? DN1_M : 0), CV_SP0, bl_, G_); if (G_ <= 16) convert_range(lds, tl_, (tl_ & 63), wv_, bl_, G_, 1, CV_GU0 + GU1_G, CV_DN0, bl_, G_); }
#endif
        } break;
        }
#ifndef DIS_ATT
        if (au_ < alim_) {
            __syncthreads();
            { LAS float* rp = (LAS float*)(lds + AT_RPB); const float* src = INP(20) + l * 1860;
              for (int i = tl_; i < 2048; i += 512) { const int hh = i >> 9, rw = (i >> 5) & 15, cc = i & 31; rp[i] = rw < 15 ? (cc < 31 ? src[hh * 465 + rw * 31 + cc] * 1.4426950408889634f : -3.0e38f) : 0.f; } }
            __syncthreads();
            for (int u = au_; u < alim_; u += G_) attn_unit(PH_CALL, u);
        }
#endif
#ifdef XBAR
        if (ph == 1) { for (int xb_ = 0; xb_ < XBAR; ++xb_) { XcdBarrier b5 = bar; b5.bar = (unsigned*)(PTRV(29, unsigned char) + WS_CTL) + CW_BAR; b5.st = (volatile LAS unsigned*)(lds + MISC_OFF) + 8; xcd_barrier(b5); } }
#endif
#ifdef TS_I
        { XcdBarrier b3 = bar; b3.bar = (unsigned*)(PTRV(29, unsigned char) + WS_CTL) + CW_BAR; b3.st = (volatile LAS unsigned*)(lds + MISC_OFF) + 8; xcd_barrier(b3);
          if (bid == 0 && tid == 0) ((unsigned long long*)(PTRV(29, unsigned char) + 65536))[ph + 1] = rt(); }
        if (ph + 1 == hi) { XcdBarrier b3 = bar; b3.bar = (unsigned*)(PTRV(29, unsigned char) + WS_CTL) + CW_BAR; b3.st = (volatile LAS unsigned*)(lds + MISC_OFF) + 8; xcd_barrier(b3);
            const unsigned long long* TS = (const unsigned long long*)(PTRV(29, unsigned char) + 65536);
            const float dti = (float)(TS[TS_I + 1] - TS[TS_I]) * 0.01f, dtj = (float)(TS[TS_J + 1] - TS[TS_J]) * 0.01f;
            float* out = PTRV(28, float); const float Av = sqrtf(dti);
            for (size_t i = (size_t)bid * 512 + tid; i < (size_t)ML * 1024; i += (size_t)G * 512) out[i] = (i == 0) ? dtj * 10.f : Av; }
        if (0) {
#else
#ifdef REP_PH
        if (it_ + 1 < hi + (REP_N - 1)) {
#else
        if (ph + 1 < hi && kind != 8) {
#endif
#endif
          XcdBarrier b2 = bar; b2.bar = (unsigned*)(PTRV(29, unsigned char) + WS_CTL) + CW_BAR; unsigned bx_ = bar.x; asm volatile("" : "+s"(bx_)); b2.x = bx_; b2.st = (volatile LAS unsigned*)(lds + MISC_OFF) + 8; xcd_barrier(b2); }
    }
}

extern "C" void kernel_launch(void* const* d_in, const int* in_sizes, int n_in, void* d_out, int out_size, void* d_ws, size_t ws_size, hipStream_t stream) {
    static int grid = 0;
    if (grid == 0) {
        if (n_in != 28 || ws_size < WS_END) { fprintf(stderr, "kernel_launch: unexpected n_in %d / ws %zu\n", n_in, ws_size); grid = -1; return; }
        int dev = 0, cus = 0;
        if (hipGetDevice(&dev) != hipSuccess || hipDeviceGetAttribute(&cus, hipDeviceAttributeMultiprocessorCount, dev) != hipSuccess) { grid = -1; return; }
        if (hipFuncSetAttribute((const void*)mega, hipFuncAttributeMaxDynamicSharedMemorySize, LDS_BYTES) != hipSuccess) { fprintf(stderr, "kernel_launch: hipFuncSetAttribute failed\n"); grid = -1; return; }
        int per_cu = 0;
        if (hipOccupancyMaxActiveBlocksPerMultiprocessor(&per_cu, (const void*)mega, 512, LDS_BYTES) != hipSuccess || per_cu < 1) { fprintf(stderr, "kernel_launch: occupancy query says %d workgroups per CU\n", per_cu); grid = -1; return; }
        (void)hipGetLastError();
        grid = cus;
    }
    if (grid < 0) return;
    (void)hipMemsetAsync((char*)d_ws + WS_CTL, 0, CTL_ZERO_BYTES, stream);
    Args a{};
    for (int i = 0; i < 28; ++i) a.in[i] = (const float*)d_in[i];
    a.out = (float*)d_out; a.ws = (unsigned char*)d_ws;
#ifdef DBG_STOP
    for (int p = 0; p < (DBG_STOP > 20 ? DBG_STOP / 10 : DBG_STOP); ++p) { a.ph_lo = p; a.ph_hi = p + 1; hipLaunchKernelGGL(mega, dim3(grid), dim3(512), LDS_BYTES, stream, a); }
    a.ph_lo = 99; a.ph_hi = 100; hipLaunchKernelGGL(mega, dim3(grid), dim3(512), LDS_BYTES, stream, a);
#elif N_LAUNCHES == 1
    a.ph_lo = 0; a.ph_hi = NPH;
    hipLaunchKernelGGL(mega, dim3(grid), dim3(512), LDS_BYTES, stream, a);
#else
    for (int p = 0; p < NPH; ++p) { a.ph_lo = p; a.ph_hi = p + 1; hipLaunchKernelGGL(mega, dim3(grid), dim3(512), LDS_BYTES, stream, a); }
#endif
}
```
